# Optimizing an MI355X kernel written in HIP

```python
import math
import jax, jax.numpy as jnp
from jax import lax
import numpy as np

D_MODEL = 1024
BATCH = 2
SEQ = 8192
DEPTH = 2

GRID_W = 64
CTX_LEN = 256
EPS = 1e-6

D_MIX = D_MODEL
D_GROUP = D_MIX // 4
CONV_A = 31
CHUNK_B = 128
HEADS_B = 4
HEAD_DIM_C = 64
HEADS_C = D_GROUP // HEAD_DIM_C
GROUPS_C = 2
STATE_C = 128
CONV_C = 5
CHUNK_C = 128
HEAD_DIM_D = 64
HEADS_D = D_GROUP // HEAD_DIM_D
LORA_W = 64
LORA_A = 64
LORA_G = 128
GN_EPS_D = 64e-5
N_KEYS = 128
N_EXPERTS = N_KEYS * N_KEYS
PEER_HEADS = 8
PEER_DK = 256
PEER_TOPK = 16
PEER_BLOCK = 128

C_XBC = D_GROUP + 2 * GROUPS_C * STATE_C
A_COLS = 2 * D_GROUP
B_COLS = 2 * D_GROUP
C_COLS = D_GROUP + C_XBC + 2 * HEADS_C
D_COLS = 3 * D_GROUP + 2 * LORA_W + 2 * LORA_A + LORA_G
OFF_B = A_COLS
OFF_C = OFF_B + B_COLS
OFF_D = OFF_C + C_COLS
IN_COLS = OFF_D + D_COLS

kernel_name = "hybrid_headgroup_diffusion_block"


def rmsnorm(x, g):
    xf = x.astype(jnp.float32)
    y = xf * lax.rsqrt(jnp.mean(xf * xf, -1, keepdims=True) + EPS)
    return (y * g).astype(x.dtype)


def layernorm(x, g, b, eps=1e-5):
    xf = x.astype(jnp.float32)
    mu = jnp.mean(xf, -1, keepdims=True)
    var = jnp.mean(jnp.square(xf - mu), -1, keepdims=True)
    return ((xf - mu) * lax.rsqrt(var + eps) * g + b).astype(x.dtype)


def modulate(h, shift, scale):
    return h * (1 + scale) + shift


def depthwise_conv(x, w, b):
    k = w.shape[0]
    y = lax.conv_general_dilated(x, w[:, None, :].astype(x.dtype), window_strides=(1,),
                                 padding=[((k - 1) // 2, (k - 1) // 2)],
                                 dimension_numbers=('NWC', 'WIO', 'NWC'),
                                 feature_group_count=x.shape[-1])
    return y + b.astype(x.dtype)


def sincos_2d(t_len):
    rows = t_len // GRID_W
    row = jnp.repeat(jnp.arange(rows), GRID_W).astype(jnp.float32)
    col = jnp.tile(jnp.arange(GRID_W), rows).astype(jnp.float32)
    q = D_MODEL // 4
    freq = 10000.0 ** (-jnp.arange(q, dtype=jnp.float32) / q)
    ar = row[:, None] * freq
    ac = col[:, None] * freq
    return jnp.concatenate([jnp.sin(ar), jnp.cos(ar), jnp.sin(ac), jnp.cos(ac)], -1)


def mixer_conformer(p, conv_w, conv_b, ln_g, ln_b):
    hg = p[..., :D_GROUP] * jax.nn.sigmoid(p[..., D_GROUP:])
    hg = depthwise_conv(hg, conv_w, conv_b)
    return jax.nn.silu(layernorm(hg, ln_g, ln_b))


def mixer_chunk_mlp(p, ln_g, ln_b, w_s, b_s):
    bsz, t_len, _ = p.shape
    u, v = p[..., :D_GROUP], p[..., D_GROUP:]
    v = layernorm(v, ln_g, ln_b)
    v = v.reshape(bsz, t_len // CHUNK_B, CHUNK_B, HEADS_B, D_GROUP // HEADS_B)
    mixed = jnp.einsum('hij,bcjhd->bcihd', w_s, v) + b_s.T[None, None, :, :, None]
    return u * mixed.reshape(bsz, t_len, D_GROUP)


def segsum_exp(a):
    l = a.shape[-1]
    xe = jnp.broadcast_to(a[..., :, None], a.shape + (l,))
    strict = jnp.tril(jnp.ones((l, l), bool), -1)
    ss = jnp.cumsum(jnp.where(strict, xe, 0.0), axis=-2)
    return jnp.where(jnp.tril(jnp.ones((l, l), bool)), jnp.exp(ss), 0.0)


def ssd_scan(xdt, da, bm, cm, init, emit):
    b, t_len, h, pd = xdt.shape
    nc = t_len // CHUNK_C
    xc = xdt.reshape(b, nc, CHUNK_C, h, pd)
    bc = bm.reshape(b, nc, CHUNK_C, h, -1)
    cc = cm.reshape(b, nc, CHUNK_C, h, -1)
    ac = da.reshape(b, nc, CHUNK_C, h).transpose(0, 3, 1, 2).astype(jnp.float32)
    a_cs = jnp.cumsum(ac, -1)
    decay_states = jnp.exp(a_cs[..., -1:] - a_cs)
    states = jnp.einsum('bclhn,bhcl,bclhp->bchpn', bc, decay_states, xc)
    states = jnp.concatenate([init[:, None].astype(states.dtype), states], 1)
    decay_chunk = segsum_exp(jnp.pad(a_cs[..., -1], ((0, 0), (0, 0), (1, 0))))
    new_states = jnp.einsum('bhzc,bchpn->bzhpn', decay_chunk, states)
    final = new_states[:, -1]
    if not emit:
        return None, final
    lmat = segsum_exp(ac)
    y_diag = jnp.einsum('bclhn,bcshn,bhcls,bcshp->bclhp', cc, bc, lmat, xc)
    y_off = jnp.einsum('bclhn,bchpn,bhcl->bclhp', cc, new_states[:, :-1], jnp.exp(a_cs))
    return (y_diag + y_off).reshape(b, t_len, h, pd), final


def mamba_prepare(p, conv_w, conv_b):
    b, t_len, _ = p.shape
    z = p[..., :D_GROUP]
    xbc = jax.nn.silu(depthwise_conv(p[..., D_GROUP:D_GROUP + C_XBC], conv_w, conv_b))
    dt_raw = p[..., D_GROUP + C_XBC:].reshape(b, t_len, 2, HEADS_C)
    xs = xbc[..., :D_GROUP].reshape(b, t_len, HEADS_C, HEAD_DIM_C)
    gs = GROUPS_C * STATE_C
    bm = xbc[..., D_GROUP:D_GROUP + gs].reshape(b, t_len, GROUPS_C, STATE_C)
    cm = xbc[..., D_GROUP + gs:].reshape(b, t_len, GROUPS_C, STATE_C)
    rep = HEADS_C // GROUPS_C
    return z, xs, jnp.repeat(bm, rep, 2), jnp.repeat(cm, rep, 2), dt_raw


def mamba_output(prep, y, d_skip, norm_g):
    z, xs, _, _, _ = prep
    b, t_len = xs.shape[:2]
    y = (y + d_skip[:, None] * xs).reshape(b, t_len, D_GROUP)
    return rmsnorm(y * jax.nn.silu(z), norm_g)


def mixer_mamba(pl, pc, conv_w, conv_b, dt_bias, a_log, d_skip, norm_g, emit_ctx):
    lat = mamba_prepare(pl, conv_w, conv_b)
    cx = mamba_prepare(pc, conv_w, conv_b)
    init = jnp.zeros((pl.shape[0], HEADS_C, HEAD_DIM_C, STATE_C), jnp.float32)
    yl, yc = [], []
    for d in range(2):
        flip = (lambda t: jnp.flip(t, 1)) if d == 1 else (lambda t: t)
        a_d = -jnp.exp(a_log[d])

        def ssd_args(prep):
            _, xs, bm, cm, dt_raw = prep
            dt = jax.nn.softplus(dt_raw[:, :, d].astype(jnp.float32) + dt_bias[d])
            return flip(xs * dt[..., None]), flip(dt * a_d), flip(bm), flip(cm)

        y_c, s_ctx = ssd_scan(*ssd_args(cx), init, emit_ctx)
        y_l, _ = ssd_scan(*ssd_args(lat), s_ctx, True)
        yl.append(flip(y_l))
        if emit_ctx:
            yc.append(flip(y_c))
    out_l = mamba_output(lat, yl[0] + yl[1], d_skip, norm_g)
    out_c = mamba_output(cx, yc[0] + yc[1], d_skip, norm_g) if emit_ctx else None
    return out_l, out_c


def shift_lerp(p, mu_prev, mu_next):
    prev = jnp.pad(p, ((0, 0), (1, 0), (0, 0)))[:, :-1]
    nxt = jnp.pad(p, ((0, 0), (0, 1), (0, 0)))[:, 1:]
    return p + mu_prev * (prev - p) + mu_next * (nxt - p)


def rwkv_prepare(p, mu_prev, mu_next, w0, w2, a0, a2, k_k, k_a):
    p = shift_lerp(p, mu_prev, mu_next)
    b, t_len, _ = p.shape
    heads = lambda t: t.reshape(t.shape[:-1] + (HEADS_D, HEAD_DIM_D))
    r = p[..., :D_GROUP]
    k = p[..., D_GROUP:2 * D_GROUP]
    v = p[..., 2 * D_GROUP:3 * D_GROUP]
    o = 3 * D_GROUP
    wd = p[..., o:o + 2 * LORA_W].reshape(b, t_len, 2, LORA_W)
    o += 2 * LORA_W
    ad = p[..., o:o + 2 * LORA_A].reshape(b, t_len, 2, LORA_A)
    o += 2 * LORA_A
    gd = p[..., o:]
    w = w0 + jnp.einsum('btdr,drc->btdc', jnp.tanh(wd), w2)
    decay = jnp.exp(-jnp.exp(-jax.nn.softplus(-w.astype(jnp.float32)) - 0.5))
    a = jax.nn.sigmoid(a0 + jnp.einsum('btdr,drc->btdc', ad, a2))
    kk = heads(k * k_k).astype(jnp.float32)
    kk = kk * lax.rsqrt(jnp.sum(kk * kk, -1, keepdims=True) + 1e-12)
    kd = k[:, :, None] * (1 + (a - 1) * k_a)
    return heads(r), heads(v), heads(decay), heads(a), kk, heads(kd), gd


def rwkv_scan(prep, d, init, reverse, emit):
    r, v, decay, a, kk, kd, _ = prep
    xs = (decay[:, :, d], kk, kk * a[:, :, d], kd[:, :, d], v) + ((r,) if emit else ())
    xs = tuple(jnp.moveaxis(t, 1, 0) for t in xs)

    def step(s, inp):
        w_t, kk_t, kka_t, k_t, v_t = inp[:5]
        s = (s * w_t[:, :, None, :]
             - jnp.einsum('bhvk,bhk->bhv', s, kk_t)[..., None] * kka_t[:, :, None, :]
             + v_t[..., None] * k_t[:, :, None, :])
        y = jnp.einsum('bhvk,bhk->bhv', s, inp[5]) if emit else None
        return s, y

    s, ys = lax.scan(step, init, xs, reverse=reverse)
    return s, (jnp.moveaxis(ys, 0, 1) if emit else None)


def rwkv_output(prep, y, g2, r_k, gn_g, gn_b):
    r, v, _, _, _, kd, gd = prep
    b, t_len = r.shape[:2]
    mu = jnp.mean(y, -1, keepdims=True)
    var = jnp.mean(jnp.square(y - mu), -1, keepdims=True)
    yn = ((y - mu) * lax.rsqrt(var + GN_EPS_D)).reshape(b, t_len, D_GROUP) * gn_g + gn_b
    bonus = jnp.sum(r[:, :, None] * kd * r_k, axis=(2, 4))[..., None] * v
    g = jax.nn.sigmoid(gd) @ g2
    return (yn + bonus.reshape(b, t_len, D_GROUP)) * g


def mixer_rwkv(pl, pc, mu_prev, mu_next, w0, w2, a0, a2, g2, k_k, k_a, r_k, gn_g, gn_b, emit_ctx):
    lat = rwkv_prepare(pl, mu_prev, mu_next, w0, w2, a0, a2, k_k, k_a)
    cx = rwkv_prepare(pc, mu_prev, mu_next, w0, w2, a0, a2, k_k, k_a)
    init = jnp.zeros((pl.shape[0], HEADS_D, HEAD_DIM_D, HEAD_DIM_D), jnp.float32)
    yl, yc = [], []
    for d in range(2):
        s_ctx, y_c = rwkv_scan(cx, d, init, d == 1, emit_ctx)
        _, y_l = rwkv_scan(lat, d, s_ctx, d == 1, True)
        yl.append(y_l)
        if emit_ctx:
            yc.append(y_c)
    out_l = rwkv_output(lat, yl[0] + yl[1], g2, r_k, gn_g, gn_b)
    out_c = rwkv_output(cx, yc[0] + yc[1], g2, r_k, gn_g, gn_b) if emit_ctx else None
    return out_l, out_c


def peer_ffn(f, wq, k1, k2, u_tab, v_tab):
    b, t_len, _ = f.shape
    blocks = f.reshape(-1, PEER_BLOCK, D_MODEL)
    nc = PEER_TOPK * PEER_TOPK

    def block(fb):
        q = (fb @ wq).reshape(PEER_BLOCK, PEER_HEADS, 2, PEER_DK // 2)
        s1 = jnp.einsum('thd,kd->thk', q[:, :, 0], k1).astype(jnp.float32)
        s2 = jnp.einsum('thd,kd->thk', q[:, :, 1], k2).astype(jnp.float32)
        v1, i1 = lax.top_k(s1, PEER_TOPK)
        v2, i2 = lax.top_k(s2, PEER_TOPK)
        cand = (v1[..., :, None] + v2[..., None, :]).reshape(PEER_BLOCK, PEER_HEADS, nc)
        cand_idx = (i1[..., :, None] * N_KEYS + i2[..., None, :]).reshape(PEER_BLOCK, PEER_HEADS, nc)
        top, pos = lax.top_k(cand, PEER_TOPK)
        idx = jnp.take_along_axis(cand_idx, pos, axis=-1)
        gate = jax.nn.softmax(top, axis=-1)
        act = jax.nn.gelu(jnp.einsum('thkd,td->thk', u_tab[idx], fb)) * gate
        return jnp.einsum('thk,thkd->td', act, v_tab[idx])

    return lax.map(block, blocks).reshape(b, t_len, D_MODEL)


def setup_inputs(seed: int = 0) -> dict:
    key = jax.random.key(seed)
    ks = iter(jax.random.split(key, 64))
    f32 = jnp.float32
    L = DEPTH

    def nrm(shape, scale=1.0):
        return jax.random.normal(next(ks), shape, f32) * scale

    def gain(shape):
        return 1.0 + nrm(shape, 0.05)

    def unif(shape, lo, hi):
        return jax.random.uniform(next(ks), shape, f32, lo, hi)

    dt = jnp.exp(unif((L, 2, HEADS_C), math.log(1e-3), math.log(1e-1)))
    return {
        'x': nrm((BATCH, SEQ, D_MODEL)),
        'c': nrm((BATCH, D_MODEL)),
        'ctx': nrm((BATCH, CTX_LEN, D_MODEL)),
        'c_ctx': nrm((D_MODEL,)),
        'ada_w': nrm((L, D_MODEL, 6 * D_MODEL), 0.5 * D_MODEL ** -0.5),
        'ada_b': nrm((L, 6 * D_MODEL), 0.02),
        'norm_mix_g': gain((L, D_MODEL)),
        'norm_ffn_g': gain((L, D_MODEL)),
        'w_in': nrm((L, D_MODEL, IN_COLS), D_MODEL ** -0.5),
        'w_out': nrm((L, D_MIX, D_MODEL), D_MIX ** -0.5),
        'a_conv_w': nrm((L, CONV_A, D_GROUP), CONV_A ** -0.5),
        'a_conv_b': nrm((L, D_GROUP), 0.02),
        'a_ln_g': gain((L, D_GROUP)),
        'a_ln_b': nrm((L, D_GROUP), 0.02),
        'b_ln_g': gain((L, D_GROUP)),
        'b_ln_b': nrm((L, D_GROUP), 0.02),
        'b_ws': nrm((L, HEADS_B, CHUNK_B, CHUNK_B), CHUNK_B ** -0.5),
        'b_bs': gain((L, HEADS_B, CHUNK_B)),
        'c_conv_w': nrm((L, CONV_C, C_XBC), CONV_C ** -0.5),
        'c_conv_b': nrm((L, C_XBC), 0.02),
        'c_dt_bias': dt + jnp.log(-jnp.expm1(-dt)),
        'c_a_log': jnp.log(unif((L, 2, HEADS_C), 1.0, 16.0)),
        'c_d': 1.0 + nrm((L, HEADS_C), 0.1),
        'c_norm_g': gain((L, D_GROUP)),
        'd_mu_prev': unif((L, D_COLS), 0.0, 0.5),
        'd_mu_next': unif((L, D_COLS), 0.0, 0.5),
        'd_w0': nrm((L, 2, D_GROUP), 0.5),
        'd_w2': nrm((L, 2, LORA_W, D_GROUP), 0.1),
        'd_a0': nrm((L, 2, D_GROUP), 0.5),
        'd_a2': nrm((L, 2, LORA_A, D_GROUP), 0.1),
        'd_g2': nrm((L, LORA_G, D_GROUP), LORA_G ** -0.5),
        'd_k_k': 0.85 + nrm((L, D_GROUP), 0.05),
        'd_k_a': gain((L, D_GROUP)),
        'd_r_k': nrm((L, HEADS_D, HEAD_DIM_D), 0.1),
        'd_gn_g': gain((L, D_GROUP)),
        'd_gn_b': nrm((L, D_GROUP), 0.02),
        'peer_wq': nrm((L, D_MODEL, PEER_HEADS * PEER_DK), D_MODEL ** -0.5),
        'peer_k1': nrm((L, N_KEYS, PEER_DK // 2), (PEER_DK // 2) ** -0.5),
        'peer_k2': nrm((L, N_KEYS, PEER_DK // 2), (PEER_DK // 2) ** -0.5),
        'peer_u': nrm((L, N_EXPERTS, D_MODEL), D_MODEL ** -0.5),
        'peer_v': nrm((L, N_EXPERTS, D_MODEL), 0.5),
        'final_g': gain((D_MODEL,)),
    }


def reference(x, c, ctx, c_ctx, ada_w, ada_b, norm_mix_g, norm_ffn_g, w_in, w_out,
              a_conv_w, a_conv_b, a_ln_g, a_ln_b, b_ln_g, b_ln_b, b_ws, b_bs,
              c_conv_w, c_conv_b, c_dt_bias, c_a_log, c_d, c_norm_g,
              d_mu_prev, d_mu_next, d_w0, d_w2, d_a0, d_a2, d_g2, d_k_k, d_k_a, d_r_k,
              d_gn_g, d_gn_b, peer_wq, peer_k1, peer_k2, peer_u, peer_v, final_g):
    h = x + sincos_2d(x.shape[1]).astype(x.dtype)
    hc = ctx
    for i in range(DEPTH):
        emit = i < DEPTH - 1
        m = (jax.nn.silu(c) @ ada_w[i] + ada_b[i]).reshape(c.shape[0], 6, 1, D_MODEL)
        mc = (jax.nn.silu(c_ctx) @ ada_w[i] + ada_b[i]).reshape(6, 1, D_MODEL)
        col0 = 0 if emit else OFF_C
        pl = modulate(rmsnorm(h, norm_mix_g[i]), m[:, 0], m[:, 1]) @ w_in[i]
        pc = modulate(rmsnorm(hc, norm_mix_g[i]), mc[0], mc[1]) @ w_in[i][:, col0:]
        y_a = mixer_conformer(pl[..., :OFF_B], a_conv_w[i], a_conv_b[i], a_ln_g[i], a_ln_b[i])
        y_b = mixer_chunk_mlp(pl[..., OFF_B:OFF_C], b_ln_g[i], b_ln_b[i], b_ws[i], b_bs[i])
        y_c, yc_c = mixer_mamba(pl[..., OFF_C:OFF_D], pc[..., OFF_C - col0:OFF_D - col0],
                                c_conv_w[i], c_conv_b[i], c_dt_bias[i], c_a_log[i], c_d[i],
                                c_norm_g[i], emit)
        y_d, yc_d = mixer_rwkv(pl[..., OFF_D:], pc[..., OFF_D - col0:], d_mu_prev[i], d_mu_next[i],
                               d_w0[i], d_w2[i], d_a0[i], d_a2[i], d_g2[i], d_k_k[i], d_k_a[i],
                               d_r_k[i], d_gn_g[i], d_gn_b[i], emit)
        h = h + m[:, 2] * (jnp.concatenate([y_a, y_b, y_c, y_d], -1) @ w_out[i])
        f = modulate(rmsnorm(h, norm_ffn_g[i]), m[:, 3], m[:, 4])
        h = h + m[:, 5] * peer_ffn(f, peer_wq[i], peer_k1[i], peer_k2[i], peer_u[i], peer_v[i])
        if emit:
            yc_a = mixer_conformer(pc[..., :OFF_B], a_conv_w[i], a_conv_b[i], a_ln_g[i], a_ln_b[i])
            yc_b = mixer_chunk_mlp(pc[..., OFF_B:OFF_C], b_ln_g[i], b_ln_b[i], b_ws[i], b_bs[i])
            hc = hc + mc[2] * (jnp.concatenate([yc_a, yc_b, yc_c, yc_d], -1) @ w_out[i])
            fc = modulate(rmsnorm(hc, norm_ffn_g[i]), mc[3], mc[4])
            hc = hc + mc[5] * peer_ffn(fc, peer_wq[i], peer_k1[i], peer_k2[i], peer_u[i], peer_v[i])
    return rmsnorm(h, final_g)
```

```cpp
#include <hip/hip_runtime.h>
#include <cstdio>
#include <cstdint>
namespace pg8 {
#define PG8_LAS __attribute__((address_space(3)))
typedef unsigned short bf16_t;
typedef short bf16x8 __attribute__((ext_vector_type(8)));
typedef float f32x4 __attribute__((ext_vector_type(4)));
typedef unsigned u32x4 __attribute__((ext_vector_type(4)));
constexpr int BM = 256, BK = 64, HALF = 128, HTB = HALF * BK * 2  , STAGE_BYTES = 8 * HTB, NXCD = 8, WGM = 8;

__host__ __device__ __forceinline__ int lds_byte(int r, int c) { const int st = (r >> 4) * 2 + (c >> 5), rr = r & 15, cc = c & 31, ob = rr * 64 + cc * 2; return st * 1024 + (ob ^ (((ob >> 9) & 1) << 5)); }
__host__ __device__ __forceinline__ void stage_rc(int b, int& R, int& C) { const int st = b / 1024, sb = b % 1024, swz = sb ^ (((sb >> 9) & 1) << 5); R = (st >> 1) * 16 + swz / 64; C = (st & 1) * 32 + (swz % 64) / 2; }
__host__ __device__ __forceinline__ int perm32(int rho) { const int n = rho >> 4, i = rho & 15; return 8 * (i >> 2) + 4 * n + (i & 3); }

struct Unit { int pm, pn; };
struct Gemm { const bf16_t* A; const bf16_t* Bt; int M, N, K; };

struct StaticOrder {
    int nM, nN, nwg, G, c;
    __host__ __device__ void init(int M, int N, int G_, int c_) { nM = M / BM; nN = N / BM; nwg = nM * nN; G = G_; c = c_; }
    __host__ __device__ bool next(int i, Unit& u) const {
        const long L = (long)i * G + c; if (L >= nwg) return false;
        int wgid = (int)L; { const int q = nwg / NXCD, r = nwg % NXCD, xcd = wgid % NXCD, off = wgid / NXCD; wgid = (xcd < r ? xcd * (q + 1) : r * (q + 1) + (xcd - r) * q) + off; }
        const int nig = WGM * nN, gid = wgid / nig, fm = gid * WGM, gsz = (nM - fm) < WGM ? (nM - fm) : WGM;
        u.pm = fm + ((wgid % nig) % gsz); u.pn = (wgid % nig) / gsz; return true;
    }
    __device__ __forceinline__ void a_ready(const Unit&) const {}
    __device__ __forceinline__ void done(const Unit&) const {}
};
struct CountedOrder : StaticOrder {
    const unsigned* ready; unsigned need; unsigned* tmo;
    __device__ __forceinline__ void a_ready(const Unit& u) const {
        if (threadIdx.x < 64) {
            const unsigned long long t0 = __builtin_amdgcn_s_memrealtime(); unsigned polls = 0;
            while ((unsigned)__builtin_amdgcn_readfirstlane(__hip_atomic_load(ready + 64 * u.pm, __ATOMIC_RELAXED, __HIP_MEMORY_SCOPE_AGENT)) < need) {
                if ((++polls & 255u) == 0u && __builtin_amdgcn_readfirstlane(__hip_atomic_load(tmo, __ATOMIC_RELAXED, __HIP_MEMORY_SCOPE_AGENT)) != 0u) break;
                if (__builtin_amdgcn_s_memrealtime() - t0 > 2000000ull) {
                    if (threadIdx.x == 0) { unsigned expect = 0u; __hip_atomic_compare_exchange_strong(tmo + 1, &expect, 0x600u | (unsigned)(u.pm & 0xff), __ATOMIC_RELAXED, __ATOMIC_RELAXED, __HIP_MEMORY_SCOPE_AGENT); __hip_atomic_store(tmo, 1u, __ATOMIC_RELAXED, __HIP_MEMORY_SCOPE_AGENT); }
                    break; }
                __builtin_amdgcn_s_sleep(2); }
            __builtin_amdgcn_fence(__ATOMIC_ACQUIRE, "agent");
            asm volatile("s_waitcnt vmcnt(0)" ::: "memory");
        }
#if !defined(BROKEN_HOOK_NO_BARRIER)
        asm volatile("" ::: "memory"); __builtin_amdgcn_s_barrier(); asm volatile("" ::: "memory");
#endif
    }
};

__device__ __forceinline__ unsigned cvt_pk_bf16(float lo, float hi) { unsigned r; asm volatile("v_cvt_pk_bf16_f32 %0, %1, %2" : "=v"(r) : "v"(lo), "v"(hi)); return r; }
typedef float f32x2 __attribute__((ext_vector_type(2)));
__device__ __forceinline__ f32x2 gelu_pk(f32x2 v) {
    const f32x2 av = __builtin_elementwise_abs(v), d = av * 0.2316418882f + 1.0f;
    f32x2 t; t.x = __builtin_amdgcn_rcpf(d.x); t.y = __builtin_amdgcn_rcpf(d.y);
    f32x2 q = t * 0.5307027145f + (-0.7265760135f); q = q * t + 0.7107068705f; q = q * t + (-0.142248368f); q = q * t + 0.127414796f; q = q * t;
    const f32x2 s = (v * v) * (-0.72134752044f);
    f32x2 e; e.x = __builtin_amdgcn_exp2f(s.x); e.y = __builtin_amdgcn_exp2f(s.y);
    const f32x2 m = v * (q * e), r = v - m;
    f32x2 o; o.x = v.x < 0.f ? m.x : r.x; o.y = v.y < 0.f ? m.y : r.y; return o;
}

struct EpiF32 {
    static constexpr bool PERM = false, AFTER_DRAIN = false;
    float* C; int ldc; const float* bias;
    __device__ __forceinline__ void operator()(const f32x4 (&acc)[2][2][4][2], const Unit& u, int wr, int wc, int fr, int fq) const {
        const int row0 = u.pm * BM + wr * 64 + fr, col0 = u.pn * BM + wc * 32 + 4 * fq;
        f32x4 bv[2][2];
#pragma unroll
        for (int bj = 0; bj < 2; ++bj)
#pragma unroll
            for (int n = 0; n < 2; ++n) bv[bj][n] = bias ? *(const f32x4*)(bias + col0 + bj * HALF + n * 16) : (f32x4){0.f, 0.f, 0.f, 0.f};
#pragma unroll
        for (int ai = 0; ai < 2; ++ai)
#pragma unroll
            for (int m = 0; m < 4; ++m) { float* rowp = C + (size_t)(row0 + ai * HALF + m * 16) * ldc + col0;
#pragma unroll
                for (int bj = 0; bj < 2; ++bj)
#pragma unroll
                    for (int n = 0; n < 2; ++n) *(f32x4*)(rowp + bj * HALF + n * 16) = acc[ai][bj][m][n] + bv[bj][n]; }
    }
};
template <int ACT  > struct EpiBf16 {
    static constexpr bool PERM = true, AFTER_DRAIN = false;
    bf16_t* O; int ldc; const float* bias; int split_cols; size_t split_stride;
    __device__ __forceinline__ void operator()(const f32x4 (&acc)[2][2][4][2], const Unit& u, int wr, int wc, int fr, int fq) const {
        const int row0 = u.pm * BM + wr * 64 + fr; int colt = u.pn * BM; bf16_t* base = O;
        if (split_cols) { const int t = colt / split_cols; base += (size_t)t * split_stride; colt -= t * split_cols; }
        const int col0 = colt + wc * 32 + 8 * fq, bcol0 = u.pn * BM + wc * 32 + 8 * fq;
        f32x4 bv[2][2];
#pragma unroll
        for (int bj = 0; bj < 2; ++bj)
#pragma unroll
            for (int n = 0; n < 2; ++n) bv[bj][n] = bias ? *(const f32x4*)(bias + bcol0 + bj * HALF + 4 * n) : (f32x4){0.f, 0.f, 0.f, 0.f};
#pragma unroll
        for (int ai = 0; ai < 2; ++ai)
#pragma unroll
            for (int m = 0; m < 4; ++m) { bf16_t* rowp = base + (size_t)(row0 + ai * HALF + m * 16) * ldc + col0;
#pragma unroll
                for (int bj = 0; bj < 2; ++bj) { f32x4 v0 = acc[ai][bj][m][0] + bv[bj][0], v1 = acc[ai][bj][m][1] + bv[bj][1];
                    if (ACT == 1) { f32x2 a = gelu_pk((f32x2){v0[0], v0[1]}), b = gelu_pk((f32x2){v0[2], v0[3]}), c = gelu_pk((f32x2){v1[0], v1[1]}), d = gelu_pk((f32x2){v1[2], v1[3]});
                        v0 = (f32x4){a.x, a.y, b.x, b.y}; v1 = (f32x4){c.x, c.y, d.x, d.y}; }
                    if (ACT == 2) {
#pragma unroll
                        for (int j = 0; j < 4; ++j) { v0[j] = 0.5f * v0[j] * (1.0f + erff(v0[j] * 0.70710678f)); v1[j] = 0.5f * v1[j] * (1.0f + erff(v1[j] * 0.70710678f)); } }
                    u32x4 w; w.x = cvt_pk_bf16(v0[0], v0[1]); w.y = cvt_pk_bf16(v0[2], v0[3]); w.z = cvt_pk_bf16(v1[0], v1[1]); w.w = cvt_pk_bf16(v1[2], v1[3]);
                    *(u32x4*)(rowp + bj * HALF) = w; } }
    }
};
template <class Epi, class Sched, bool STAMP = false>
__device__ __forceinline__ void gemm_phase(PG8_LAS unsigned char* lds, const Gemm g, const Sched& S, const Epi& E, unsigned long long* stamps) {
    int tid_ = threadIdx.x; asm volatile("" : "+v"(tid_));
    const int tid = tid_, wid = __builtin_amdgcn_readfirstlane(tid >> 6), lane = tid & 63, wr = wid >> 2, wc = wid & 3, fr = lane & 15, fq = lane >> 4;
    const int K = g.K, nt = K / BK;
    int ts_lo = 0, ts_hi = 0, nts = 0; const unsigned long long rt_entry = STAMP ? (unsigned long long)wall_clock64() : 0ull;
#define PG8_STAMP() do { if (STAMP && wid == 0 && nts < 64) { const unsigned long long _c = (unsigned long long)clock64(); \
        ts_lo = (lane == nts) ? (int)(unsigned)_c : ts_lo; ts_hi = (lane == nts) ? (int)(unsigned)(_c >> 32) : ts_hi; ++nts; } } while (0)
    PG8_STAMP();
    unsigned voffA[2], voffB[2];
#pragma unroll
    for (int i = 0; i < 2; ++i) { int R, C; stage_rc(tid * 16 + i * 8192, R, C); const int Rb = Epi::PERM ? ((R & ~31) + perm32(R & 31)) : R;
        voffA[i] = (unsigned)(R * K + C) * 2u; voffB[i] = (unsigned)(Rb * K + C) * 2u; }
    const size_t kstep = (size_t)(BK * 2);
    const size_t hstep = (size_t)HALF * K * 2;
    const size_t tstep = 2 * hstep;
    const unsigned ldsw = (unsigned)wid * 1024u;
    const int aoff = lds_byte(wr * 64 + fr, fq * 8), boff = lds_byte(wc * 32 + fr, fq * 8);
#define PG8_SA(b, h) (((b) * 2 + (h)) * HTB)
#define PG8_SB(b, h) ((4 + (b) * 2 + (h)) * HTB)
#define PG8_STAGE(bufoff, gbase, voff) do { _Pragma("unroll") for (int _i = 0; _i < 2; ++_i) \
        __builtin_amdgcn_global_load_lds((const unsigned*)((const char*)(gbase) + (voff)[_i]), (PG8_LAS unsigned*)(lds + (bufoff) + ldsw + _i * 8192), 16, 0, 0); } while (0)
#define PG8_LDA(dst, b, h) do { _Pragma("unroll") for (int m = 0; m < 4; ++m) _Pragma("unroll") for (int k = 0; k < 2; ++k) dst[m][k] = *(const PG8_LAS bf16x8*)(lds + PG8_SA(b, h) + aoff + m * 2048 + k * 1024); } while (0)
#define PG8_LDB(dst, b, h) do { _Pragma("unroll") for (int n = 0; n < 2; ++n) _Pragma("unroll") for (int k = 0; k < 2; ++k) dst[n][k] = *(const PG8_LAS bf16x8*)(lds + PG8_SB(b, h) + boff + n * 2048 + k * 1024); } while (0)
#define PG8_MMA(ai, bj, At, Bt) do { __builtin_amdgcn_s_setprio(1); _Pragma("unroll") for (int m = 0; m < 4; ++m) _Pragma("unroll") for (int n = 0; n < 2; ++n) _Pragma("unroll") for (int k = 0; k < 2; ++k) \
        acc[ai][bj][m][n] = __builtin_amdgcn_mfma_f32_16x16x32_bf16(Bt[n][k], At[m][k], acc[ai][bj][m][n], 0, 0, 0); __builtin_amdgcn_s_setprio(0); } while (0)
#define PG8_WAIT_V(n) asm volatile("s_waitcnt vmcnt(" #n ")" ::: "memory")
#define PG8_WAIT_L(n) asm volatile("s_waitcnt lgkmcnt(" #n ")" ::: "memory")
#define PG8_BAR __builtin_amdgcn_s_barrier()
#define PG8_SCHED __builtin_amdgcn_sched_barrier(0)
    Unit cur, nxt; int ui = 0;
    if (!S.next(0, cur)) return;
    f32x4 acc[2][2][4][2];
#pragma unroll
    for (int a = 0; a < 2; ++a)
#pragma unroll
        for (int b = 0; b < 2; ++b)
#pragma unroll
            for (int m = 0; m < 4; ++m)
#pragma unroll
                for (int n = 0; n < 2; ++n) acc[a][b][m][n] = (f32x4){0.f, 0.f, 0.f, 0.f};
    bf16x8 At[4][2], B0[2][2], B1[2][2];
    const char* cA = (const char*)g.A + (size_t)cur.pm * tstep; const char* cB = (const char*)g.Bt + (size_t)cur.pn * tstep;
    S.a_ready(cur);
    PG8_STAGE(PG8_SB(0, 0), cB, voffB); PG8_STAGE(PG8_SA(0, 0), cA, voffA); PG8_STAGE(PG8_SB(0, 1), cB + hstep, voffB); PG8_STAGE(PG8_SA(0, 1), cA + hstep, voffA);
    if (wr == 1) PG8_BAR;
    PG8_WAIT_V(4); PG8_BAR;
    PG8_STAGE(PG8_SB(1, 0), cB + kstep, voffB); PG8_STAGE(PG8_SA(1, 0), cA + kstep, voffA); PG8_STAGE(PG8_SB(1, 1), cB + hstep + kstep, voffB);
    PG8_WAIT_V(6); PG8_BAR;
    PG8_STAMP();
    for (;;) {
        const bool has_next = S.next(ui + 1, nxt);
        const char* nA = has_next ? (const char*)g.A + (size_t)nxt.pm * tstep : cA; const char* nB = has_next ? (const char*)g.Bt + (size_t)nxt.pn * tstep : cB;
        for (int t = 0; t < nt; t += 2) {
            const bool last = (t == nt - 2);
            const char* a1 = cA + (size_t)(t + 1) * kstep;
            const char* a2 = last ? nA : cA + (size_t)(t + 2) * kstep; const char* b2 = last ? nB : cB + (size_t)(t + 2) * kstep;
            const char* a3 = a2 + kstep; const char* b3 = b2 + kstep;
            if (last && has_next) S.a_ready(nxt);
            PG8_LDB(B0, 0, 0); PG8_SCHED; PG8_LDA(At, 0, 0); PG8_STAGE(PG8_SA(1, 1), a1 + hstep, voffA);
            PG8_WAIT_L(8); PG8_BAR; PG8_WAIT_L(0); PG8_MMA(0, 0, At, B0); PG8_BAR; PG8_SCHED;
            PG8_LDB(B1, 0, 1); PG8_STAGE(PG8_SB(0, 0), b2, voffB);
            PG8_BAR; PG8_WAIT_L(0); PG8_MMA(0, 1, At, B1); PG8_BAR;
            PG8_LDA(At, 0, 1); PG8_STAGE(PG8_SA(0, 0), a2, voffA);
            PG8_BAR; PG8_WAIT_L(0); PG8_MMA(1, 0, At, B0); PG8_BAR; PG8_SCHED;
            PG8_STAGE(PG8_SB(0, 1), b2 + hstep, voffB);
            PG8_WAIT_V(6); PG8_BAR; PG8_MMA(1, 1, At, B1); PG8_BAR;
            PG8_LDB(B0, 1, 0); PG8_SCHED; PG8_LDA(At, 1, 0); PG8_STAGE(PG8_SA(0, 1), a2 + hstep, voffA);
            PG8_WAIT_L(8); PG8_BAR; PG8_WAIT_L(0); PG8_MMA(0, 0, At, B0); PG8_BAR; PG8_SCHED;
            PG8_LDB(B1, 1, 1); PG8_STAGE(PG8_SB(1, 0), b3, voffB);
            PG8_BAR; PG8_WAIT_L(0); PG8_MMA(0, 1, At, B1); PG8_BAR;
            PG8_LDA(At, 1, 1); PG8_STAGE(PG8_SA(1, 0), a3, voffA);
            PG8_BAR; PG8_WAIT_L(0); PG8_MMA(1, 0, At, B0); PG8_BAR; PG8_SCHED;
            PG8_STAGE(PG8_SB(1, 1), b3 + hstep, voffB);
            PG8_WAIT_V(6); PG8_BAR; PG8_MMA(1, 1, At, B1); PG8_BAR;
        }
        PG8_STAMP();
        if constexpr (!Epi::AFTER_DRAIN) { E(acc, cur, wr, wc, fr, fq); S.done(cur); }
        PG8_STAMP();
        if (!has_next) break;
#pragma unroll
        for (int a = 0; a < 2; ++a)
#pragma unroll
            for (int b = 0; b < 2; ++b)
#pragma unroll
                for (int m = 0; m < 4; ++m)
#pragma unroll
                    for (int n = 0; n < 2; ++n) acc[a][b][m][n] = (f32x4){0.f, 0.f, 0.f, 0.f};
        cur = nxt; cA = nA; cB = nB; ++ui;
    }
    PG8_WAIT_V(0);
    if (wr == 0) PG8_BAR;
    PG8_BAR;
    if constexpr (Epi::AFTER_DRAIN) { E.fused(acc, cur, wr, wc, fr, fq, lds, wid, lane); S.done(cur); }
    PG8_STAMP();
    if (STAMP && wid == 0) { stamps[lane] = lane < nts ? (((unsigned long long)(unsigned)ts_hi << 32) | (unsigned)ts_lo) : 0ull;
        if (lane == 62) stamps[62] = rt_entry; if (lane == 63) stamps[63] = (unsigned long long)wall_clock64(); }
#undef PG8_STAMP
#undef PG8_SA
#undef PG8_SB
#undef PG8_STAGE
#undef PG8_LDA
#undef PG8_LDB
#undef PG8_MMA
#undef PG8_WAIT_V
#undef PG8_WAIT_L
#undef PG8_BAR
#undef PG8_SCHED
}
}
#define XB_TMO      128
#define XB_XCNT(j)  (256  + 64 * (j))
#define XB_XSUB(j)  (1280 + 64 * (j))
#define XB_XGEN(j)  (2304 + 64 * (j))
#define XB_TOP      3328
#define XB_TOPGEN   3392
#define XCD_BAR_WORDS 3456
#define XB_SPIN_CAP (1u << 18)
#define LAS __attribute__((address_space(3)))

__device__ __forceinline__ unsigned xb_ld(unsigned* p)              { return __hip_atomic_load(p, __ATOMIC_RELAXED, __HIP_MEMORY_SCOPE_AGENT); }
__device__ __forceinline__ unsigned xb_add(unsigned* p, unsigned v) { return __hip_atomic_fetch_add(p, v, __ATOMIC_RELAXED, __HIP_MEMORY_SCOPE_AGENT); }
__device__ __forceinline__ unsigned xb_xcc_id() { return (unsigned)__builtin_amdgcn_s_getreg((3 << 11) | 20) & 0xFu; }
#define XB_SPIN(cond, bar) do { unsigned _sp = 0; while (cond) { __builtin_amdgcn_s_sleep(1); \
    if ((++_sp & 255u) == 0u) { if (xb_ld(&(bar)[XB_TMO])) break; if (_sp > XB_SPIN_CAP) { atomicAdd(&(bar)[XB_TMO], 1u); break; } } } } while (0)

struct XcdBarrier {
    unsigned* bar; unsigned x;
    volatile LAS unsigned* st;
};

__device__ __forceinline__ XcdBarrier xcd_barrier_post(unsigned* bar, volatile LAS unsigned* st) {
    XcdBarrier b; b.bar = bar; b.x = xb_xcc_id(); b.st = st;
    if (threadIdx.x == 0) (void)xb_add(&bar[XB_XCNT(b.x)], 1u);
    return b;
}
__device__ __forceinline__ void xcd_barrier_complete(unsigned* bar, unsigned x, unsigned& nloc, unsigned& nx) {
    const unsigned G = gridDim.x * gridDim.y * gridDim.z;
    unsigned sum, cnt, mine, sp = 0u;
    for (;;) {
        sum = 0u; cnt = 0u; mine = 0u;
#pragma unroll
        for (unsigned j = 0; j < 16; ++j) { const unsigned c = xb_ld(&bar[XB_XCNT(j)]); sum += c; cnt += (c > 0u) ? 1u : 0u; mine = (j == x) ? c : mine; }
        if (sum == G) break;
        __builtin_amdgcn_s_sleep(1);
        if ((++sp & 255u) == 0u) { if (xb_ld(&bar[XB_TMO])) break; if (sp > XB_SPIN_CAP) { atomicAdd(&bar[XB_TMO], 1u); break; } }
    }
    nloc = mine > 0u ? mine : 1u; nx = cnt > 0u ? cnt : 1u;
}

__device__ __forceinline__ void xcd_barrier(const XcdBarrier& b) {
    asm volatile("s_waitcnt vmcnt(0)" ::: "memory");
    __syncthreads();
    if (threadIdx.x == 0) {
        unsigned* bar = b.bar;
        __builtin_amdgcn_s_waitcnt(0);
        unsigned nloc = b.st[0], nx = b.st[1];
        if (nloc == 0u) { xcd_barrier_complete(bar, b.x, nloc, nx); b.st[0] = nloc; b.st[1] = nx; }
        const unsigned old = xb_add(&bar[XB_XSUB(b.x)], 1u);
        const unsigned gen = old / nloc;
        if (old + 1u == (gen + 1u) * nloc) {
            __builtin_amdgcn_fence(__ATOMIC_RELEASE, "agent");
            asm volatile("s_waitcnt vmcnt(0)" ::: "memory");
            const unsigned og = xb_add(&bar[XB_TOP], 1u);
            const unsigned tg = og / nx;
            if (og + 1u == (tg + 1u) * nx) xb_add(&bar[XB_TOPGEN], 1u);
            else XB_SPIN(xb_ld(&bar[XB_TOPGEN]) == tg, bar);
            __builtin_amdgcn_fence(__ATOMIC_ACQUIRE, "agent");
            xb_add(&bar[XB_XGEN(b.x)], 1u);
            asm volatile("s_waitcnt vmcnt(0)" ::: "memory");
        } else {
            XB_SPIN(xb_ld(&bar[XB_XGEN(b.x)]) == gen, bar);
            __builtin_amdgcn_fence(__ATOMIC_ACQUIRE, "agent");
            asm volatile("s_waitcnt vmcnt(0)" ::: "memory");
        }
    }
    __syncthreads();
}

namespace mk {
using pg8::bf16_t; using pg8::bf16x8; using pg8::f32x4; using pg8::u32x4;
typedef unsigned u32x2 __attribute__((ext_vector_type(2)));
typedef __bf16 bf16x2_t __attribute__((ext_vector_type(2)));
typedef LAS unsigned char* lds_t;

constexpr int DM = 1024, NLAT = 16384, NROW = 16896;
constexpr int OFF_B = 512, OFF_C = 1024, OFF_D = 2056, INC = 3208, NP = 3328;
constexpr int NCH = 132, NSLOT = 16 * NCH;
constexpr int NEXP = 16384;

constexpr size_t WS_CTL  = 0;
constexpr size_t WS_MOD  = 65536;
constexpr size_t WS_WIN  = WS_MOD + 147456;
constexpr size_t WS_WOUT = WS_WIN + 2ull * NP * DM * 2;
constexpr size_t WS_WQ   = WS_WOUT + 2ull * DM * DM * 2;
constexpr size_t WS_H    = WS_WQ + 2ull * 2048 * DM * 2;
constexpr size_t WS_ACT  = WS_H + (size_t)NROW * DM * 4;
constexpr size_t WS_UB   = WS_ACT + (size_t)NROW * DM * 2;
constexpr size_t WS_VB   = WS_UB + (size_t)NEXP * DM * 2;
constexpr size_t WS_P    = WS_VB + (size_t)NEXP * DM * 2;
constexpr size_t WS_Q    = WS_P;
constexpr size_t WS_SELI = WS_Q + (size_t)NROW * 2048 * 2;
constexpr size_t WS_SELG = WS_SELI + (size_t)NROW * 128 * 4;
constexpr size_t WS_MST  = WS_P + (size_t)NROW * NP * 2;
constexpr size_t WS_MCD  = WS_MST + (size_t)NSLOT * 8192 * 4;
constexpr size_t WS_RG   = WS_MCD + 16384;
constexpr size_t WS_RJ   = WS_RG + (size_t)NSLOT * 8192;
constexpr size_t WS_RY   = WS_RJ + (size_t)NSLOT * 16384;
constexpr size_t WS_RL   = WS_RY + (size_t)NSLOT * 8192;
constexpr size_t WS_RH   = WS_RL + (size_t)NSLOT * 8192;
constexpr size_t WS_BON  = WS_RH + (size_t)NSLOT * 8192;
constexpr size_t WS_END  = WS_BON + (size_t)NROW * 8 * 4;
static_assert(WS_SELG + (size_t)NROW * 128 * 4 <= WS_MST, "Q + selections must fit in P's region");

constexpr int LDS_BYTES = 157440;
constexpr int LDS_XB = 157184;

struct Args { const float* in[42]; float* out; unsigned char* ws; int ph_lo, ph_hi; };

struct Ctx {
    const float* const* in; float* out; unsigned char* ws; lds_t lds;
    int tid, lane, wid, bid, G;
};

__device__ __forceinline__ float bf2f(unsigned short x) { return __uint_as_float(((unsigned)x) << 16); }
__device__ __forceinline__ float bflo(unsigned w) { return __uint_as_float(w << 16); }
__device__ __forceinline__ float bfhi(unsigned w) { return __uint_as_float(w & 0xffff0000u); }
__device__ __forceinline__ unsigned pk2(float lo, float hi) { return pg8::cvt_pk_bf16(lo, hi); }
__device__ __forceinline__ unsigned short f2bf(float f) { return (unsigned short)(pk2(f, 0.f) & 0xffffu); }
__device__ __forceinline__ float wave_sum(float v) {
#pragma unroll
    for (int o = 1; o < 64; o <<= 1) v += __shfl_xor(v, o);
    return v;
}
__device__ __forceinline__ float sigm(float x) { return 1.f / (1.f + expf(-x)); }
__device__ __forceinline__ float silu(float x) { return x / (1.f + expf(-x)); }
__device__ __forceinline__ float softplus(float x) { return fmaxf(x, 0.f) + log1pf(expf(-fabsf(x))); }
__device__ __forceinline__ float gelu_tanh(float x) { const float u = 0.7978845608028654f * (x + 0.044715f * x * x * x); return 0.5f * x * (1.f + tanhf(u)); }
__device__ __forceinline__ float dot2bf(unsigned a, unsigned b, float acc) { return __builtin_amdgcn_fdot2_f32_bf16(__builtin_bit_cast(bf16x2_t, a), __builtin_bit_cast(bf16x2_t, b), acc, false); }

struct ChunkInfo { int row0, lo, hi, b, tc, isctx; };
__device__ __forceinline__ ChunkInfo chunk_info(int gc) {
    ChunkInfo c; c.row0 = gc * 64;
    if (gc < 256) { c.b = gc >> 7; c.tc = gc & 127; c.isctx = 0; c.lo = c.b * 8192; c.hi = c.lo + 8192; }
    else { const int q = gc - 256; c.b = q >> 2; c.tc = q & 3; c.isctx = 1; c.lo = NLAT + c.b * 256; c.hi = c.lo + 256; }
    return c;
}
__device__ __forceinline__ int cpos_of(const ChunkInfo& c, int d) { return c.isctx ? (d ? 3 - c.tc : c.tc) : (d ? 4 + 127 - c.tc : 4 + c.tc); }
__device__ __forceinline__ int slot_of(int b, int h, int d, int cpos) { return ((b * 4 + h) * 2 + d) * NCH + cpos; }

template <int MT, int NT, int KS, class Epi>
__device__ __forceinline__ void blk_mma(const LAS bf16_t* A, int lda, const LAS bf16_t* Bt, int ldb, int wid, int lane, Epi epi) {
    const int fr = lane & 15, fq = lane >> 4;
    for (int tt = wid; tt < MT * NT; tt += 8) {
        const int tm = tt / NT, tn = tt % NT;
        f32x4 acc = {0.f, 0.f, 0.f, 0.f};
#pragma unroll
        for (int ks = 0; ks < KS; ++ks) {
            const bf16x8 a = *(const LAS bf16x8*)(A + (tm * 16 + fr) * lda + ks * 32 + fq * 8);
            const bf16x8 b = *(const LAS bf16x8*)(Bt + (tn * 16 + fr) * ldb + ks * 32 + fq * 8);
            acc = __builtin_amdgcn_mfma_f32_16x16x32_bf16(a, b, acc, 0, 0, 0);
        }
        epi(tm * 16 + fq * 4, tn * 16 + fr, acc);
    }
}
template <int MT, int NT, int KS, class Epi>
__device__ __forceinline__ void blk_mma2(const LAS bf16_t* A1, const LAS bf16_t* B1, const LAS bf16_t* A2, const LAS bf16_t* B2, int ld, int wid, int lane, Epi epi) {
    const int fr = lane & 15, fq = lane >> 4;
    for (int tt = wid; tt < MT * NT; tt += 8) {
        const int tm = tt / NT, tn = tt % NT;
        f32x4 acc1 = {0.f, 0.f, 0.f, 0.f}, acc2 = {0.f, 0.f, 0.f, 0.f};
#pragma unroll
        for (int ks = 0; ks < KS; ++ks) {
            const bf16x8 a1 = *(const LAS bf16x8*)(A1 + (tm * 16 + fr) * ld + ks * 32 + fq * 8);
            const bf16x8 b1 = *(const LAS bf16x8*)(B1 + (tn * 16 + fr) * ld + ks * 32 + fq * 8);
            acc1 = __builtin_amdgcn_mfma_f32_16x16x32_bf16(a1, b1, acc1, 0, 0, 0);
            const bf16x8 a2 = *(const LAS bf16x8*)(A2 + (tm * 16 + fr) * ld + ks * 32 + fq * 8);
            const bf16x8 b2 = *(const LAS bf16x8*)(B2 + (tn * 16 + fr) * ld + ks * 32 + fq * 8);
            acc2 = __builtin_amdgcn_mfma_f32_16x16x32_bf16(a2, b2, acc2, 0, 0, 0);
        }
        epi(tm * 16 + fq * 4, tn * 16 + fr, acc1, acc2);
    }
}

__device__ __forceinline__ void transpose_item(const float* W, int K, int N, int nblk, bf16_t* WT, LAS float* scr, int item, int lane) {
    const int kb = item / nblk, nb = item % nblk, k0 = 64 * kb, n0 = 32 * nb;
    const int nn = n0 + (lane & 31);
#pragma unroll 8
    for (int i = 0; i < 32; ++i) { const int kk = 2 * i + (lane >> 5); scr[kk * 33 + (lane & 31)] = (nn < N) ? W[(size_t)(k0 + kk) * N + nn] : 0.f; }
    asm volatile("s_waitcnt lgkmcnt(0)" ::: "memory");
    const int c = lane & 7;
#pragma unroll
    for (int j = 0; j < 4; ++j) { const int n = (lane >> 3) + 8 * j; const LAS float* s = scr + (8 * c) * 33 + n;
        u32x4 o; o.x = pk2(s[0 * 33], s[1 * 33]); o.y = pk2(s[2 * 33], s[3 * 33]); o.z = pk2(s[4 * 33], s[5 * 33]); o.w = pk2(s[6 * 33], s[7 * 33]);
        *(u32x4*)(WT + (size_t)(n0 + n) * K + k0 + 8 * c) = o; }
    asm volatile("s_waitcnt lgkmcnt(0)" ::: "memory");
}
__device__ __forceinline__ void convert_tables(const Ctx& C, int layer) {
    const float* U = C.in[39] + (size_t)layer * NEXP * DM; const float* V = C.in[40] + (size_t)layer * NEXP * DM;
    bf16_t* UB = (bf16_t*)(C.ws + WS_UB); bf16_t* VB = (bf16_t*)(C.ws + WS_VB);
    const size_t n8 = (size_t)NEXP * DM / 8;
    for (size_t i = (size_t)C.bid * 512 + C.tid; i < 2 * n8; i += (size_t)C.G * 512) {
        const bool isv = i >= n8; const size_t j = isv ? i - n8 : i;
        const f32x4 a = *(const f32x4*)((isv ? V : U) + j * 8), b = *(const f32x4*)((isv ? V : U) + j * 8 + 4);
        u32x4 o; o.x = pk2(a.x, a.y); o.y = pk2(a.z, a.w); o.z = pk2(b.x, b.y); o.w = pk2(b.z, b.w);
        *(u32x4*)((isv ? VB : UB) + j * 8) = o;
    }
}
__device__ __forceinline__ void ph_prologue(const Ctx& C) {
    const int gw = C.bid * 8 + C.wid, NGW = C.G * 8;
    {
        LAS float* scr = (LAS float*)(C.lds + C.wid * 16384);
        bf16_t* WIN = (bf16_t*)(C.ws + WS_WIN); bf16_t* WOUT = (bf16_t*)(C.ws + WS_WOUT); bf16_t* WQ = (bf16_t*)(C.ws + WS_WQ);
        for (int it = gw; it < 6400; it += NGW) {
            const int layer = it / 3200; int r = it % 3200;
            if (r < 1664) { transpose_item(C.in[8] + (size_t)layer * DM * INC, DM, INC, 104, WIN + (size_t)layer * NP * DM, scr, r, C.lane); continue; } r -= 1664;
            if (r < 512) { transpose_item(C.in[9] + (size_t)layer * DM * DM, DM, DM, 32, WOUT + (size_t)layer * DM * DM, scr, r, C.lane); continue; } r -= 512;
            transpose_item(C.in[36] + (size_t)layer * DM * 2048, DM, 2048, 64, WQ + (size_t)layer * 2048 * DM, scr, r, C.lane);
        }
    }
    __syncthreads();
    {
        LAS float* sv = (LAS float*)C.lds;
        LAS float* red = (LAS float*)(C.lds + 12288);
        for (int i = C.tid; i < 3 * 1024; i += 512) { const int w = i >> 10, k = i & 1023; const float x = (w < 2) ? C.in[1][w * 1024 + k] : C.in[3][k]; sv[i] = silu(x); }
        __syncthreads();
        float* MOD = (float*)(C.ws + WS_MOD);
        for (int it = C.bid; it < 192; it += C.G) {
            const int layer = it / 96, col0 = (it % 96) * 64, col = C.tid & 63, kg = C.tid >> 6;
            const float* W = C.in[4] + (size_t)layer * DM * 6144 + col0 + col;
            float a0 = 0.f, a1 = 0.f, a2 = 0.f;
#pragma unroll 8
            for (int k = kg * 128; k < kg * 128 + 128; ++k) { const float w = W[(size_t)k * 6144]; a0 += sv[k] * w; a1 += sv[1024 + k] * w; a2 += sv[2048 + k] * w; }
            red[(kg * 3 + 0) * 64 + col] = a0; red[(kg * 3 + 1) * 64 + col] = a1; red[(kg * 3 + 2) * 64 + col] = a2;
            __syncthreads();
            if (C.tid < 192) { const int w = C.tid >> 6, c2 = C.tid & 63; float s = 0.f;
#pragma unroll
                for (int g = 0; g < 8; ++g) s += red[(g * 3 + w) * 64 + c2];
                MOD[((size_t)layer * 3 + w) * 6144 + col0 + c2] = s + C.in[5][layer * 6144 + col0 + c2]; }
            __syncthreads();
        }
    }
    {
        float* H = (float*)(C.ws + WS_H);
        const size_t n4 = (size_t)NROW * 256;
        for (size_t i = (size_t)C.bid * 512 + C.tid; i < n4; i += (size_t)C.G * 512) {
            const int row = (int)(i >> 8), c4 = (int)(i & 255) * 4;
            f32x4 v;
            if (row < NLAT) {
                v = *(const f32x4*)(C.in[0] + (size_t)row * DM + c4);
                const int t = row & 8191, quarter = c4 >> 8; const float pos = (quarter < 2) ? (float)(t >> 6) : (float)(t & 63);
                float e[4];
#pragma unroll
                for (int j = 0; j < 4; ++j) { const int jj = (c4 & 255) + j; const float fr = exp2f(-(float)jj * (13.287712379549449f / 256.f)); const float a = pos * fr; e[j] = (quarter & 1) ? cosf(a) : sinf(a); }
                v.x += e[0]; v.y += e[1]; v.z += e[2]; v.w += e[3];
            } else v = *(const f32x4*)(C.in[2] + (size_t)(row - NLAT) * DM + c4);
            *(f32x4*)(H + (size_t)row * DM + c4) = v;
        }
    }
    convert_tables(C, 0);
}

struct Row16 { float v[16]; };
__device__ __forceinline__ Row16 load_row16(const float* p, int lane) {
    Row16 r; const f32x4 a = *(const f32x4*)(p + 8 * lane), b = *(const f32x4*)(p + 8 * lane + 4), c = *(const f32x4*)(p + 512 + 8 * lane), d = *(const f32x4*)(p + 512 + 8 * lane + 4);
    r.v[0] = a.x; r.v[1] = a.y; r.v[2] = a.z; r.v[3] = a.w; r.v[4] = b.x; r.v[5] = b.y; r.v[6] = b.z; r.v[7] = b.w;
    r.v[8] = c.x; r.v[9] = c.y; r.v[10] = c.z; r.v[11] = c.w; r.v[12] = d.x; r.v[13] = d.y; r.v[14] = d.z; r.v[15] = d.w; return r;
}
__device__ __forceinline__ void store_row16_f32(float* p, int lane, const Row16& r) {
    *(f32x4*)(p + 8 * lane) = (f32x4){r.v[0], r.v[1], r.v[2], r.v[3]}; *(f32x4*)(p + 8 * lane + 4) = (f32x4){r.v[4], r.v[5], r.v[6], r.v[7]};
    *(f32x4*)(p + 512 + 8 * lane) = (f32x4){r.v[8], r.v[9], r.v[10], r.v[11]}; *(f32x4*)(p + 512 + 8 * lane + 4) = (f32x4){r.v[12], r.v[13], r.v[14], r.v[15]};
}
__device__ __forceinline__ void store_row16_bf16(bf16_t* p, int lane, const Row16& r) {
    u32x4 a, b; a.x = pk2(r.v[0], r.v[1]); a.y = pk2(r.v[2], r.v[3]); a.z = pk2(r.v[4], r.v[5]); a.w = pk2(r.v[6], r.v[7]);
    b.x = pk2(r.v[8], r.v[9]); b.y = pk2(r.v[10], r.v[11]); b.z = pk2(r.v[12], r.v[13]); b.w = pk2(r.v[14], r.v[15]);
    *(u32x4*)(p + 8 * lane) = a; *(u32x4*)(p + 512 + 8 * lane) = b;
}
__device__ __forceinline__ Row16 norm_mod_row(const Row16& x, const float* g, const float* shift, const float* scale, int lane) {
    float ss = 0.f;
#pragma unroll
    for (int i = 0; i < 16; ++i) ss += x.v[i] * x.v[i];
    const float rs = rsqrtf(wave_sum(ss) * (1.f / 1024.f) + 1e-6f);
    const Row16 gg = load_row16(g, lane), sh = load_row16(shift, lane), sc = load_row16(scale, lane);
    Row16 o;
#pragma unroll
    for (int i = 0; i < 16; ++i) o.v[i] = (x.v[i] * rs * gg.v[i]) * (1.f + sc.v[i]) + sh.v[i];
    return o;
}
__device__ __forceinline__ int which_of(int row) { return row < 8192 ? 0 : (row < NLAT ? 1 : 2); }
__device__ __forceinline__ void ph_norm(const Ctx& C, int layer, const float* gain, int sidx, int nrows) {
    const float* H = (const float*)(C.ws + WS_H); bf16_t* ACT = (bf16_t*)(C.ws + WS_ACT); const float* MOD = (const float*)(C.ws + WS_MOD);
    for (int row = C.bid * 8 + C.wid; row < nrows; row += C.G * 8) {
        const float* m = MOD + ((size_t)layer * 3 + which_of(row)) * 6144;
        const Row16 x = load_row16(H + (size_t)row * DM, C.lane);
        const Row16 o = norm_mod_row(x, gain, m + sidx * 1024, m + (sidx + 1) * 1024, C.lane);
        store_row16_bf16(ACT + (size_t)row * DM, C.lane, o);
    }
}
struct EpiResid {
    static constexpr bool PERM = false, AFTER_DRAIN = false;
    float* H; const float* modl;
    __device__ __forceinline__ void operator()(const f32x4 (&acc)[2][2][4][2], const pg8::Unit& u, int wr, int wc, int fr, int fq) const {
        const int row0 = u.pm * 256 + wr * 64 + fr, col0 = u.pn * 256 + wc * 32 + 4 * fq;
        const int which = u.pm < 32 ? 0 : (u.pm < 64 ? 1 : 2);
        const float* gate = modl + ((size_t)which * 6 + 2) * 1024;
        f32x4 gv[2][2];
#pragma unroll
        for (int bj = 0; bj < 2; ++bj)
#pragma unroll
            for (int n = 0; n < 2; ++n) gv[bj][n] = *(const f32x4*)(gate + col0 + bj * 128 + n * 16);
#pragma unroll
        for (int ai = 0; ai < 2; ++ai)
#pragma unroll
            for (int m = 0; m < 4; ++m) { float* rowp = H + (size_t)(row0 + ai * 128 + m * 16) * DM + col0;
#pragma unroll
                for (int bj = 0; bj < 2; ++bj)
#pragma unroll
                    for (int n = 0; n < 2; ++n) { f32x4* p = (f32x4*)(rowp + bj * 128 + n * 16); *p = *p + gv[bj][n] * acc[ai][bj][m][n]; } }
    }
};

__device__ __forceinline__ void item_conformer(const Ctx& C, int layer, int gc) {
    const ChunkInfo ci = chunk_info(gc);
    const bf16_t* P = (const bf16_t*)(C.ws + WS_P); bf16_t* YC = (bf16_t*)(C.ws + WS_ACT);
    LAS bf16_t* HG = (LAS bf16_t*)C.lds;
    LAS float* CO = (LAS float*)(C.lds + 49152);
    for (int e = C.tid; e < 94 * 128; e += 512) {
        const int rr = e >> 7, cp = e & 127, grow = ci.row0 - 15 + rr;
        unsigned o = 0u;
        if (grow >= ci.lo && grow < ci.hi) {
            const unsigned v = *(const unsigned*)(P + (size_t)grow * NP + 2 * cp), g = *(const unsigned*)(P + (size_t)grow * NP + 256 + 2 * cp);
            o = pk2(bflo(v) * sigm(bflo(g)), bfhi(v) * sigm(bfhi(g)));
        }
        *(LAS unsigned*)(HG + rr * 256 + 2 * cp) = o;
    }
    __syncthreads();
    {
        const int c = C.tid & 255, half = C.tid >> 8;
        const float* cw = C.in[10] + (size_t)layer * 31 * 256 + c;
        float w[31];
#pragma unroll
        for (int j = 0; j < 31; ++j) w[j] = cw[j * 256];
        const float bias = C.in[11][layer * 256 + c];
        for (int tt = 0; tt < 32; ++tt) {
            const int t = half * 32 + tt; float acc = bias;
#pragma unroll
            for (int j = 0; j < 31; ++j) acc += w[j] * bf2f(HG[(t + j) * 256 + c]);
            CO[t * 256 + c] = acc;
        }
    }
    __syncthreads();
    {
        const float* lg = C.in[12] + layer * 256 + 4 * C.lane; const float* lb = C.in[13] + layer * 256 + 4 * C.lane;
        const f32x4 g4 = *(const f32x4*)lg, b4 = *(const f32x4*)lb;
        for (int i = 0; i < 8; ++i) {
            const int t = C.wid * 8 + i;
            const f32x4 x = *(const LAS f32x4*)(CO + t * 256 + 4 * C.lane);
            const float mean = wave_sum((x.x + x.y) + (x.z + x.w)) * (1.f / 256.f);
            const f32x4 d = x - mean;
            const float var = wave_sum((d.x * d.x + d.y * d.y) + (d.z * d.z + d.w * d.w)) * (1.f / 256.f);
            const float rs = rsqrtf(var + 1e-5f);
            const f32x4 y = d * rs * g4 + b4;
            u32x2 o; o.x = pk2(silu(y.x), silu(y.y)); o.y = pk2(silu(y.z), silu(y.w));
            *(u32x2*)(YC + (size_t)(ci.row0 + t) * DM + 4 * C.lane) = o;
        }
    }
    __syncthreads();
}

__device__ __forceinline__ void item_chunkmlp(const Ctx& C, int layer, int gb) {
    const int row0 = gb * 128;
    const bf16_t* P = (const bf16_t*)(C.ws + WS_P); bf16_t* YC = (bf16_t*)(C.ws + WS_ACT);
    LAS bf16_t* VNT = (LAS bf16_t*)C.lds;
    LAS bf16_t* WS = (LAS bf16_t*)(C.lds + 69632);
    {
        const f32x4 g4 = *(const f32x4*)(C.in[14] + layer * 256 + 4 * C.lane), b4 = *(const f32x4*)(C.in[15] + layer * 256 + 4 * C.lane);
        for (int i = 0; i < 16; ++i) {
            const int j = C.wid * 16 + i;
            const u32x2 raw = *(const u32x2*)(P + (size_t)(row0 + j) * NP + 768 + 4 * C.lane);
            const f32x4 x = {bflo(raw.x), bfhi(raw.x), bflo(raw.y), bfhi(raw.y)};
            const float mean = wave_sum((x.x + x.y) + (x.z + x.w)) * (1.f / 256.f);
            const f32x4 d = x - mean;
            const float var = wave_sum((d.x * d.x + d.y * d.y) + (d.z * d.z + d.w * d.w)) * (1.f / 256.f);
            const f32x4 y = d * rsqrtf(var + 1e-5f) * g4 + b4;
            VNT[(4 * C.lane + 0) * 136 + j] = f2bf(y.x); VNT[(4 * C.lane + 1) * 136 + j] = f2bf(y.y);
            VNT[(4 * C.lane + 2) * 136 + j] = f2bf(y.z); VNT[(4 * C.lane + 3) * 136 + j] = f2bf(y.w);
        }
    }
    for (int h = 0; h < 4; ++h) {
        const float* ws = C.in[16] + ((size_t)layer * 4 + h) * 128 * 128;
        for (int e = C.tid; e < 4096; e += 512) { const int i = e >> 5, j4 = (e & 31) * 4; const f32x4 w = *(const f32x4*)(ws + i * 128 + j4);
            u32x2 o; o.x = pk2(w.x, w.y); o.y = pk2(w.z, w.w); *(LAS u32x2*)(WS + i * 136 + j4) = o; }
        __syncthreads();
        const float* bs = C.in[17] + ((size_t)layer * 4 + h) * 128;
        blk_mma<8, 4, 4>(WS, 136, VNT + h * 64 * 136, 136, C.wid, C.lane, [=](int r0, int col, const f32x4& acc) {
#pragma unroll
            for (int jj = 0; jj < 4; ++jj) { const int i = r0 + jj; const size_t row = (size_t)(row0 + i);
                const float u = bf2f(P[row * NP + 512 + h * 64 + col]);
                YC[row * DM + 256 + h * 64 + col] = f2bf((acc[jj] + bs[i]) * u); }
        });
        __syncthreads();
    }
}

__device__ __forceinline__ void item_mamba_local(const Ctx& C, int layer, int gc) {
    const ChunkInfo ci = chunk_info(gc);
    const bf16_t* P = (const bf16_t*)(C.ws + WS_P);
    float* MST = (float*)(C.ws + WS_MST); float* MCD = (float*)(C.ws + WS_MCD);
    LAS float* DA = (LAS float*)C.lds;
    LAS float* DT = (LAS float*)(C.lds + 2048);
    LAS float* FAC = (LAS float*)(C.lds + 4096);
    LAS bf16_t* XDT = (LAS bf16_t*)(C.lds + 8192);
    LAS bf16_t* BTT = (LAS bf16_t*)(C.lds + 8192 + 73728);
    {
        const int s = C.tid >> 3, dh = C.tid & 7, d = dh >> 2, h = dh & 3;
        const float raw = bf2f(P[(size_t)(ci.row0 + s) * NP + OFF_C + 1024 + dh]);
        const float dt = softplus(raw + C.in[20][layer * 8 + dh]);
        DT[dh * 64 + s] = dt; DA[dh * 64 + s] = dt * (-expf(C.in[21][layer * 8 + dh]));
        (void)d; (void)h;
    }
    __syncthreads();
    if (C.tid < 8) {
        const int dh = C.tid, d = dh >> 2, h = dh & 3; float run = 0.f;
        if (d == 0) { for (int s = 63; s >= 0; --s) { FAC[dh * 64 + s] = expf(run); run += DA[dh * 64 + s]; } }
        else { for (int s = 0; s < 64; ++s) { FAC[dh * 64 + s] = expf(run); run += DA[dh * 64 + s]; } }
        MCD[slot_of(ci.b, h, d, cpos_of(ci, d))] = expf(run);
    }
    __syncthreads();
    {
        const int cp = C.tid & 255, half = C.tid >> 8, c0 = 2 * cp;
        const float* cw = C.in[18] + (size_t)layer * 5 * 768 + c0; const float* cb = C.in[19] + layer * 768 + c0;
        float w0[5], w1[5];
#pragma unroll
        for (int j = 0; j < 5; ++j) { w0[j] = cw[j * 768]; w1[j] = cw[j * 768 + 1]; }
        const float b0 = cb[0], b1 = cb[1];
        const int s0 = half * 32;
        unsigned win[5];
#pragma unroll
        for (int j = 0; j < 4; ++j) { const int row = ci.row0 + s0 - 2 + j; win[j + 1] = (row >= ci.lo && row < ci.hi) ? *(const unsigned*)(P + (size_t)row * NP + OFF_C + 256 + c0) : 0u; }
        for (int tt = 0; tt < 32; ++tt) {
            const int s = s0 + tt;
#pragma unroll
            for (int j = 0; j < 4; ++j) win[j] = win[j + 1];
            { const int row = ci.row0 + s + 2; win[4] = (row >= ci.lo && row < ci.hi) ? *(const unsigned*)(P + (size_t)row * NP + OFF_C + 256 + c0) : 0u; }
            float a0 = b0, a1 = b1;
#pragma unroll
            for (int j = 0; j < 5; ++j) { a0 += w0[j] * bflo(win[j]); a1 += w1[j] * bfhi(win[j]); }
            a0 = silu(a0); a1 = silu(a1);
            if (c0 < 256) { const int h = c0 >> 6;
#pragma unroll
                for (int d = 0; d < 2; ++d) { const float f = DT[(d * 4 + h) * 64 + s] * FAC[(d * 4 + h) * 64 + s];
                    XDT[(d * 256 + c0) * 72 + s] = f2bf(a0 * f); XDT[(d * 256 + c0 + 1) * 72 + s] = f2bf(a1 * f); }
            } else { const int q = c0 - 256; BTT[q * 72 + s] = f2bf(a0); BTT[(q + 1) * 72 + s] = f2bf(a1); }
        }
    }
    __syncthreads();
    for (int hd = 0; hd < 8; ++hd) {
        const int d = hd >> 2, h = hd & 3;
        float* dst = MST + (size_t)slot_of(ci.b, h, d, cpos_of(ci, d)) * 8192;
        blk_mma<4, 8, 2>(XDT + (d * 256 + h * 64) * 72, 72, BTT + (h >> 1) * 128 * 72, 72, C.wid, C.lane, [=](int r0, int col, const f32x4& acc) {
#pragma unroll
            for (int jj = 0; jj < 4; ++jj) dst[(r0 + jj) * 128 + col] = acc[jj];
        });
    }
    __syncthreads();
}


#ifndef MK_DIAG2
#define MK_DIAG2 1
#endif
#if MK_DIAG2
#define DBGF(stage, cond) do { if (cond) atomicOr((unsigned*)(C.ws + 32768) + (stage), 1u); } while (0)
#define DBGL(stage, cond) do { if (cond) atomicOr(dbgflags + (stage), 1u); } while (0)
#else
#define DBGF(stage, cond) do {} while (0)
#define DBGL(stage, cond) do {} while (0)
#endif
__device__ __forceinline__ bool badv(float x, float lim) { return !(fabsf(x) < lim); }
__device__ __forceinline__ void tri_inverse(const LAS float* ABf, LAS float* Tf, LAS float* Rt, LAS bf16_t* TT, int tid, int wid, int lane) {
    if (wid == 0) {
        const int bi = lane >> 4, j = lane & 15; const LAS float* Ab = ABf + (16 * bi) * 68 + 16 * bi;
        float col[16];
#pragma unroll
        for (int r = 0; r < 16; ++r) { float acc = (r == j) ? 1.f : 0.f;
#pragma unroll
            for (int s = 0; s < r; ++s) acc -= Ab[r * 68 + s] * col[s];
            col[r] = acc; }
#pragma unroll
        for (int r = 0; r < 16; ++r) Tf[(16 * bi + r) * 68 + 16 * bi + j] = col[r];
    }
    __syncthreads();
    for (int i = 1; i < 4; ++i) {
        const int nc = 16 * i;
        for (int e = tid; e < 16 * nc; e += 512) { const int r = e / nc, c = e % nc; float sum = 0.f;
            for (int s2 = (c & ~15); s2 < nc; ++s2) sum += ABf[(nc + r) * 68 + s2] * Tf[s2 * 68 + c];
            Rt[r * 68 + c] = -sum; }
        __syncthreads();
        for (int e = tid; e < 16 * nc; e += 512) { const int r = e / nc, c = e % nc; float sum = 0.f;
            for (int r2 = 0; r2 <= r; ++r2) sum += Tf[(nc + r) * 68 + nc + r2] * Rt[r2 * 68 + c];
            Tf[(nc + r) * 68 + c] = sum; }
        __syncthreads();
    }
    for (int e = tid; e < 4096; e += 512) { const int t = e >> 6, s2 = e & 63; TT[t * 72 + s2] = ((s2 >> 4) <= (t >> 4)) ? f2bf(Tf[t * 68 + s2]) : (unsigned short)0; }
}
constexpr int D1_LW = 0, D1_CS = 17408, D1_AA = 34816, D1_RB = 52224, D1_KB = 61440, D1_VB = 70656, D1_TW = 79872, D1_AD = 89088, D1_W2T = 98304, D1_A2T = 107520;
constexpr int D1_Y = 82944;
constexpr int D1_ABF = 0, D1_AK = 17408, D1_ARK = 26624, D1_ARB = 35840, D1_TT = 45056, D1_W1T = 54272, D1_AKVT = 63488, D1_W2TT = 72704;
constexpr int D1_GL = 156672;
__device__ __forceinline__ void item_rwkv_local(const Ctx& C, int layer, int it) {
    const int gc = it >> 3, hd = it & 7, h = hd & 3, d = hd >> 2;
    const ChunkInfo ci = chunk_info(gc);
    const int slot = slot_of(ci.b, h, d, cpos_of(ci, d));
    const bf16_t* P = (const bf16_t*)(C.ws + WS_P);
    const float* mup = C.in[24] + layer * 1152; const float* mun = C.in[25] + layer * 1152;
    lds_t L = C.lds;
    LAS float* LW = (LAS float*)(L + D1_LW); LAS float* CS = (LAS float*)(L + D1_CS); LAS float* AA = (LAS float*)(L + D1_AA); LAS float* GL = (LAS float*)(L + D1_GL);
    LAS bf16_t* Rb = (LAS bf16_t*)(L + D1_RB); LAS bf16_t* Kb = (LAS bf16_t*)(L + D1_KB); LAS bf16_t* Vb = (LAS bf16_t*)(L + D1_VB);
    LAS bf16_t* TW = (LAS bf16_t*)(L + D1_TW); LAS bf16_t* AD = (LAS bf16_t*)(L + D1_AD); LAS bf16_t* W2T = (LAS bf16_t*)(L + D1_W2T); LAS bf16_t* A2T = (LAS bf16_t*)(L + D1_A2T);
    LAS bf16_t* KT = (LAS bf16_t*)(L + D1_Y); LAS bf16_t* KTt = KT + 4608; LAS bf16_t* KD = KT + 2 * 4608; LAS bf16_t* KDt = KT + 3 * 4608;
    LAS bf16_t* BT = KT + 4 * 4608; LAS bf16_t* BTt = KT + 5 * 4608; LAS bf16_t* RT = KT + 6 * 4608; LAS bf16_t* Vt = KT + 7 * 4608;
    LAS float* ABf = (LAS float*)(L + D1_ABF); LAS bf16_t* AK = (LAS bf16_t*)(L + D1_AK); LAS bf16_t* ARK = (LAS bf16_t*)(L + D1_ARK); LAS bf16_t* ARB = (LAS bf16_t*)(L + D1_ARB);
    LAS bf16_t* TT = (LAS bf16_t*)(L + D1_TT); LAS bf16_t* W1t = (LAS bf16_t*)(L + D1_W1T); LAS bf16_t* AKVt = (LAS bf16_t*)(L + D1_AKVT); LAS bf16_t* W2t = (LAS bf16_t*)(L + D1_W2TT);

    for (int e = C.tid; e < 64 * 160; e += 512) {
        const int l = e / 160, q = e % 160, grp = q >> 5, c = (q & 31) * 2;
        const int j = (grp == 0 ? h * 64 : grp == 1 ? 256 + h * 64 : grp == 2 ? 512 + h * 64 : grp == 3 ? 768 + d * 64 : 896 + d * 64) + c;
        const int row = ci.row0 + (d ? 63 - l : l);
        const bf16_t* pp = P + (size_t)row * NP + OFF_D + j;
        const unsigned x = *(const unsigned*)pp;
        const unsigned xp = (row - 1 >= ci.lo) ? *(const unsigned*)(pp - NP) : 0u, xn = (row + 1 < ci.hi) ? *(const unsigned*)(pp + NP) : 0u;
        const float x0 = bflo(x), x1 = bfhi(x);
        const float v0 = x0 + mup[j] * (bflo(xp) - x0) + mun[j] * (bflo(xn) - x0);
        const float v1 = x1 + mup[j + 1] * (bfhi(xp) - x1) + mun[j + 1] * (bfhi(xn) - x1);
        unsigned o;
        DBGF(1, badv(v0, 1e4f) || badv(v1, 1e4f));
        if (grp == 3) o = pk2(tanhf(v0), tanhf(v1)); else o = pk2(v0, v1);
        LAS bf16_t* dst = (grp == 0 ? Rb : grp == 1 ? Kb : grp == 2 ? Vb : grp == 3 ? TW : AD);
        *(LAS unsigned*)(dst + l * 72 + c) = o;
    }
    {
        const float* w2 = C.in[27] + ((size_t)layer * 2 + d) * 64 * 256 + h * 64; const float* a2 = C.in[29] + ((size_t)layer * 2 + d) * 64 * 256 + h * 64;
        for (int e = C.tid; e < 4096; e += 512) { const int r = e >> 6, c = e & 63; W2T[c * 72 + r] = f2bf(w2[r * 256 + c]); A2T[c * 72 + r] = f2bf(a2[r * 256 + c]); }
    }
    __syncthreads();
    {
        unsigned* dbgflags = (unsigned*)(C.ws + 32768); (void)dbgflags;
        const float* w0 = C.in[26] + ((size_t)layer * 2 + d) * 256 + h * 64; const float* a0 = C.in[28] + ((size_t)layer * 2 + d) * 256 + h * 64;
        blk_mma<4, 4, 2>(TW, 72, W2T, 72, C.wid, C.lane, [=](int r0, int col, const f32x4& acc) {
#pragma unroll
            for (int jj = 0; jj < 4; ++jj) { const float w = w0[col] + acc[jj]; DBGL(2, badv(w, 1e4f)); LW[(r0 + jj) * 68 + col] = -expf(-softplus(-w) - 0.5f); }
        });
        blk_mma<4, 4, 2>(AD, 72, A2T, 72, C.wid, C.lane, [=](int r0, int col, const f32x4& acc) {
#pragma unroll
            for (int jj = 0; jj < 4; ++jj) { DBGL(2, badv(acc[jj], 1e4f)); AA[(r0 + jj) * 68 + col] = sigm(a0[col] + acc[jj]); }
        });
    }
    __syncthreads();
    if (C.tid < 64) { float run = 0.f; for (int l = 0; l < 64; ++l) { run += LW[l * 68 + C.tid]; CS[l * 68 + C.tid] = run; } GL[C.tid] = expf(run); }
    __syncthreads();
    {
        const int l = C.tid >> 3, sub = C.tid & 7;
        const float* kkw = C.in[31] + layer * 256 + h * 64; const float* kaw = C.in[32] + layer * 256 + h * 64; const float* rkw = C.in[33] + layer * 256 + h * 64;
        float kk[8], kdv[8], aa[8], rr[8], vv[8]; float ss = 0.f, bon = 0.f;
#pragma unroll
        for (int i = 0; i < 8; ++i) { const int c = sub * 8 + i; const float k = bf2f(Kb[l * 72 + c]); rr[i] = bf2f(Rb[l * 72 + c]); vv[i] = bf2f(Vb[l * 72 + c]); aa[i] = AA[l * 68 + c];
            kk[i] = k * kkw[c]; ss += kk[i] * kk[i]; kdv[i] = k * (1.f + (aa[i] - 1.f) * kaw[c]); bon += rr[i] * kdv[i] * rkw[c]; }
        ss += __shfl_xor(ss, 1); ss += __shfl_xor(ss, 2); ss += __shfl_xor(ss, 4);
        bon += __shfl_xor(bon, 1); bon += __shfl_xor(bon, 2); bon += __shfl_xor(bon, 4);
        const float inv = rsqrtf(ss + 1e-12f);
        if (sub == 0) ((float*)(C.ws + WS_BON))[(size_t)(ci.row0 + (d ? 63 - l : l)) * 8 + h * 2 + d] = bon;
#pragma unroll
        for (int i = 0; i < 8; ++i) { const int c = sub * 8 + i; const float cs = CS[l * 68 + c], lw = LW[l * 68 + c];
            const float ge = expf(cs - lw), gi = expf(cs), gn = expf(-cs); const float kkn = kk[i] * inv;
            DBGF(3, badv(cs, 50.f) || cs > 0.f || badv(lw, 1.f)); DBGF(4, badv(kkn * ge, 10.f) || badv(rr[i] * gi, 1e4f) || badv(vv[i], 1e4f)); DBGF(5, badv(kdv[i] * gn, 1e25f) || badv(kkn * aa[i] * gn, 1e25f));
            const unsigned short kt = f2bf(kkn * ge), kd = f2bf(kdv[i] * gn), bt = f2bf(kkn * aa[i] * gn), rt = f2bf(rr[i] * gi);
            KT[l * 72 + c] = kt; KTt[c * 72 + l] = kt; KD[l * 72 + c] = kd; KDt[c * 72 + l] = kd; BT[l * 72 + c] = bt; BTt[c * 72 + l] = bt; RT[l * 72 + c] = rt; Vt[c * 72 + l] = f2bf(vv[i]); }
    }
    __syncthreads();
    unsigned* dbgflags = (unsigned*)(C.ws + 32768); (void)dbgflags;
    blk_mma2<4, 4, 2>(KT, BT, KT, KD, 72, C.wid, C.lane, [=](int r0, int col, const f32x4& ab, const f32x4& ak) {
        unsigned short o[4];
#pragma unroll
        for (int jj = 0; jj < 4; ++jj) { const bool lo = col < r0 + jj; DBGL(6, lo && (badv(ab[jj], 1e3f) || badv(ak[jj], 1e4f))); ABf[(r0 + jj) * 68 + col] = lo ? ab[jj] : 0.f; o[jj] = f2bf(lo ? ak[jj] : 0.f); AK[(r0 + jj) * 72 + col] = o[jj]; }
    });
    blk_mma2<4, 4, 2>(RT, KD, RT, BT, 72, C.wid, C.lane, [=](int r0, int col, const f32x4& rk, const f32x4& rb) {
#pragma unroll
        for (int jj = 0; jj < 4; ++jj) { const bool le = col <= r0 + jj; DBGL(7, le && (badv(rk[jj], 1e5f) || badv(rb[jj], 1e5f))); ARK[(r0 + jj) * 72 + col] = f2bf(le ? rk[jj] : 0.f); ARB[(r0 + jj) * 72 + col] = f2bf(le ? rb[jj] : 0.f); }
    });
    __syncthreads();
    tri_inverse(ABf, (LAS float*)(L + 54272), (LAS float*)(L + 71680), TT, C.tid, C.wid, C.lane);
    __syncthreads();
#if MK_DIAG2
    for (int e = C.tid; e < 4096; e += 512) DBGF(8, badv(bf2f(TT[(e >> 6) * 72 + (e & 63)]), 1e3f));
#endif
    blk_mma2<4, 4, 2>(TT, KTt, AK, Vt, 72, C.wid, C.lane, [=](int r0, int col, const f32x4& w1, const f32x4& akv) {
        DBGL(9, badv(w1[0], 1e3f) || badv(w1[1], 1e3f) || badv(w1[2], 1e3f) || badv(w1[3], 1e3f)); DBGL(10, badv(akv[0], 1e5f) || badv(akv[1], 1e5f) || badv(akv[2], 1e5f) || badv(akv[3], 1e5f));
        u32x2 a, b; a.x = pk2(w1[0], w1[1]); a.y = pk2(w1[2], w1[3]); b.x = pk2(akv[0], akv[1]); b.y = pk2(akv[2], akv[3]);
        *(LAS u32x2*)(W1t + col * 72 + r0) = a; *(LAS u32x2*)(AKVt + col * 72 + r0) = b;
    });
    __syncthreads();
    blk_mma<4, 4, 2>(TT, 72, AKVt, 72, C.wid, C.lane, [=](int r0, int col, const f32x4& w2) {
        DBGL(11, badv(w2[0], 1e5f) || badv(w2[1], 1e5f) || badv(w2[2], 1e5f) || badv(w2[3], 1e5f));
        u32x2 a; a.x = pk2(w2[0], w2[1]); a.y = pk2(w2[2], w2[3]); *(LAS u32x2*)(W2t + col * 72 + r0) = a;
    });
    __syncthreads();
    {
        bf16_t* Gg = (bf16_t*)(C.ws + WS_RG) + (size_t)slot * 4096; float* Jg = (float*)(C.ws + WS_RJ) + (size_t)slot * 4096;
        bf16_t* Ryg = (bf16_t*)(C.ws + WS_RY) + (size_t)slot * 4096; bf16_t* Ylg = (bf16_t*)(C.ws + WS_RL) + (size_t)slot * 4096;
        blk_mma2<4, 4, 2>(BTt, W1t, ARB, W1t, 72, C.wid, C.lane, [=](int r0, int col, const f32x4& gp, const f32x4& rbw) {
#pragma unroll
            for (int jj = 0; jj < 4; ++jj) { const int r = r0 + jj;
                Gg[r * 64 + col] = f2bf(GL[r] * ((r == col ? 1.f : 0.f) - gp[jj]));
                Ryg[r * 64 + col] = f2bf(bf2f(RT[r * 72 + col]) - rbw[jj]); }
        });
        blk_mma2<4, 4, 2>(KDt, Vt, BTt, W2t, 72, C.wid, C.lane, [=](int r0, int col, const f32x4& kv, const f32x4& bw) {
            f32x4 o;
#pragma unroll
            for (int jj = 0; jj < 4; ++jj) { o[jj] = GL[r0 + jj] * (kv[jj] - bw[jj]); DBGL(12, badv(GL[r0 + jj] * kv[jj], 1e5f)); DBGL(13, badv(GL[r0 + jj] * bw[jj], 1e5f)); DBGL(14, badv(o[jj], 1e5f)); }
            *(f32x4*)(Jg + col * 64 + r0) = o;
        });
        blk_mma2<4, 4, 2>(ARK, Vt, ARB, W2t, 72, C.wid, C.lane, [=](int r0, int col, const f32x4& a, const f32x4& b) {
            u32x2 o; o.x = pk2(a[0] - b[0], a[1] - b[1]); o.y = pk2(a[2] - b[2], a[3] - b[3]);
            *(u32x2*)(Ylg + col * 64 + r0) = o;
        });
    }
    __syncthreads();
}

__device__ __forceinline__ void ph_scan(const Ctx& C) {
    if (C.bid < 16) {
        const int chain = C.bid, fr = C.lane & 15, fq = C.lane >> 4;
        LAS bf16_t* HT = (LAS bf16_t*)C.lds;
        const bf16_t* Gg = (const bf16_t*)(C.ws + WS_RG); const float* Jg = (const float*)(C.ws + WS_RJ); bf16_t* Hg = (bf16_t*)(C.ws + WS_RH);
        f32x4 acc[2] = {{0.f, 0.f, 0.f, 0.f}, {0.f, 0.f, 0.f, 0.f}};
        int buf = 0;
        for (int cpos = 0; cpos < NCH; ++cpos) {
            const size_t slot = (size_t)chain * NCH + cpos;
#pragma unroll
            for (int i = 0; i < 2; ++i) { const int tt = C.wid * 2 + i, tm = tt >> 2, tn = tt & 3;
                u32x2 o; o.x = pk2(acc[i][0], acc[i][1]); o.y = pk2(acc[i][2], acc[i][3]);
                *(LAS u32x2*)(HT + buf * 4608 + (tn * 16 + fr) * 72 + tm * 16 + fq * 4) = o;
                *(u32x2*)(Hg + slot * 4096 + (tn * 16 + fr) * 64 + tm * 16 + fq * 4) = o; }
            __syncthreads();
#pragma unroll
            for (int i = 0; i < 2; ++i) { const int tt = C.wid * 2 + i, tm = tt >> 2, tn = tt & 3;
                f32x4 a = *(const f32x4*)(Jg + slot * 4096 + (tn * 16 + fr) * 64 + tm * 16 + fq * 4);
#pragma unroll
                for (int ks = 0; ks < 2; ++ks) {
                    const bf16x8 g = *(const bf16x8*)(Gg + slot * 4096 + (tm * 16 + fr) * 64 + ks * 32 + fq * 8);
                    const bf16x8 hb = *(const LAS bf16x8*)(HT + buf * 4608 + (tn * 16 + fr) * 72 + ks * 32 + fq * 8);
                    a = __builtin_amdgcn_mfma_f32_16x16x32_bf16(g, hb, a, 0, 0, 0);
                }
                acc[i] = a; }
            buf ^= 1;
        }
    } else {
        float* MST = (float*)(C.ws + WS_MST); const float* MCD = (const float*)(C.ws + WS_MCD);
        const int nthr = (C.G - 16) * 512;
        for (int e = (C.bid - 16) * 512 + C.tid; e < 16 * 8192; e += nthr) {
            const int chain = e >> 13, el = e & 8191; float run = 0.f;
            float* p = MST + (size_t)chain * NCH * 8192 + el; const float* cd = MCD + chain * NCH;
#pragma unroll 4
            for (int cpos = 0; cpos < NCH; ++cpos) { const float tmp = p[(size_t)cpos * 8192]; p[(size_t)cpos * 8192] = run; run = run * cd[cpos] + tmp; }
        }
    }
}

__device__ __forceinline__ void item_mamba_out(const Ctx& C, int layer, int gc) {
    const ChunkInfo ci = chunk_info(gc);
    const bf16_t* P = (const bf16_t*)(C.ws + WS_P); bf16_t* YC = (bf16_t*)(C.ws + WS_ACT); const float* MST = (const float*)(C.ws + WS_MST);
    lds_t L = C.lds;
    LAS float* DT = (LAS float*)L;
    LAS float* DA = (LAS float*)(L + 2048);
    LAS float* CSI = (LAS float*)(L + 4096);
    LAS float* SSQ = (LAS float*)(L + 6144);
    LAS bf16_t* CG = (LAS bf16_t*)(L + 10240);
    LAS bf16_t* BG = (LAS bf16_t*)(L + 27648);
    LAS bf16_t* XT = (LAS bf16_t*)(L + 45056);
    LAS float* CBm = (LAS float*)(L + 63488);
    LAS bf16_t* MP = (LAS bf16_t*)(L + 80896);
    LAS bf16_t* S0 = (LAS bf16_t*)(L + 90112);
    LAS bf16_t* YPRE = (LAS bf16_t*)(L + 107520);
    const int fr = C.lane & 15, fq = C.lane >> 4;
    {
        const int s = C.tid >> 3, dh = C.tid & 7;
        const float raw = bf2f(P[(size_t)(ci.row0 + s) * NP + OFF_C + 1024 + dh]);
        const float dt = softplus(raw + C.in[20][layer * 8 + dh]);
        DT[dh * 64 + s] = dt; DA[dh * 64 + s] = dt * (-expf(C.in[21][layer * 8 + dh]));
    }
    __syncthreads();
    if (C.tid < 8) { const int dh = C.tid; float run = 0.f;
        if (dh < 4) { for (int s = 0; s < 64; ++s) { run += DA[dh * 64 + s]; CSI[dh * 64 + s] = run; } }
        else { for (int s = 63; s >= 0; --s) { run += DA[dh * 64 + s]; CSI[dh * 64 + s] = run; } } }
    for (int g = 0; g < 2; ++g) {
        __syncthreads();
        {
            const int cp = C.tid & 255, half = C.tid >> 8;
            if (cp < 192) {
                const int kind = cp >> 6, cl = (cp & 63) * 2, c0 = kind * 256 + g * 128 + cl;
                const float* cw = C.in[18] + (size_t)layer * 5 * 768 + c0; const float* cb = C.in[19] + layer * 768 + c0;
                float w0[5], w1[5];
#pragma unroll
                for (int j = 0; j < 5; ++j) { w0[j] = cw[j * 768]; w1[j] = cw[j * 768 + 1]; }
                const float b0 = cb[0], b1 = cb[1];
                const int s0 = half * 32;
                unsigned win[5];
#pragma unroll
                for (int j = 0; j < 4; ++j) { const int row = ci.row0 + s0 - 2 + j; win[j + 1] = (row >= ci.lo && row < ci.hi) ? *(const unsigned*)(P + (size_t)row * NP + OFF_C + 256 + c0) : 0u; }
                for (int tt = 0; tt < 32; ++tt) {
                    const int s = s0 + tt;
#pragma unroll
                    for (int j = 0; j < 4; ++j) win[j] = win[j + 1];
                    { const int row = ci.row0 + s + 2; win[4] = (row >= ci.lo && row < ci.hi) ? *(const unsigned*)(P + (size_t)row * NP + OFF_C + 256 + c0) : 0u; }
                    float a0 = b0, a1 = b1;
#pragma unroll
                    for (int j = 0; j < 5; ++j) { a0 += w0[j] * bflo(win[j]); a1 += w1[j] * bfhi(win[j]); }
                    const unsigned short o0 = f2bf(silu(a0)), o1 = f2bf(silu(a1));
                    if (kind == 0) { XT[cl * 72 + s] = o0; XT[(cl + 1) * 72 + s] = o1; }
                    else if (kind == 1) { *(LAS unsigned*)(BG + s * 136 + cl) = (unsigned)o0 | ((unsigned)o1 << 16); }
                    else { *(LAS unsigned*)(CG + s * 136 + cl) = (unsigned)o0 | ((unsigned)o1 << 16); }
                }
            }
        }
        __syncthreads();
        blk_mma<4, 4, 4>(CG, 136, BG, 136, C.wid, C.lane, [=](int r0, int col, const f32x4& acc) {
#pragma unroll
            for (int jj = 0; jj < 4; ++jj) CBm[(r0 + jj) * 68 + col] = acc[jj];
        });
        for (int hh = 0; hh < 2; ++hh) {
            const int h = 2 * g + hh;
            f32x4 yacc[2] = {{0.f, 0.f, 0.f, 0.f}, {0.f, 0.f, 0.f, 0.f}};
            for (int d = 0; d < 2; ++d) {
                const int dh = d * 4 + h;
                __syncthreads();
                for (int e = C.tid; e < 4096; e += 512) { const int l = e >> 6, s = e & 63; const bool ok = d ? (s >= l) : (s <= l);
                    MP[l * 72 + s] = ok ? f2bf(CBm[l * 68 + s] * expf(CSI[dh * 64 + l] - CSI[dh * 64 + s]) * DT[dh * 64 + s]) : (unsigned short)0; }
                { const float* src = MST + (size_t)slot_of(ci.b, h, d, cpos_of(ci, d)) * 8192;
                  for (int e = C.tid; e < 2048; e += 512) { const int p = e >> 5, n4 = (e & 31) * 4; const f32x4 v = *(const f32x4*)(src + p * 128 + n4);
                      u32x2 o; o.x = pk2(v.x, v.y); o.y = pk2(v.z, v.w); *(LAS u32x2*)(S0 + p * 136 + n4) = o; } }
                __syncthreads();
#pragma unroll
                for (int i = 0; i < 2; ++i) { const int tt = C.wid + 8 * i, tm = tt >> 2, tn = tt & 3;
                    f32x4 a1 = {0.f, 0.f, 0.f, 0.f}, a2 = {0.f, 0.f, 0.f, 0.f};
#pragma unroll
                    for (int ks = 0; ks < 2; ++ks) a1 = __builtin_amdgcn_mfma_f32_16x16x32_bf16(*(const LAS bf16x8*)(MP + (tm * 16 + fr) * 72 + ks * 32 + fq * 8),
                                                                                                 *(const LAS bf16x8*)(XT + (hh * 64 + tn * 16 + fr) * 72 + ks * 32 + fq * 8), a1, 0, 0, 0);
#pragma unroll
                    for (int ks = 0; ks < 4; ++ks) a2 = __builtin_amdgcn_mfma_f32_16x16x32_bf16(*(const LAS bf16x8*)(CG + (tm * 16 + fr) * 136 + ks * 32 + fq * 8),
                                                                                                 *(const LAS bf16x8*)(S0 + (tn * 16 + fr) * 136 + ks * 32 + fq * 8), a2, 0, 0, 0);
#pragma unroll
                    for (int j = 0; j < 4; ++j) yacc[i][j] += a1[j] + a2[j] * expf(CSI[dh * 64 + tm * 16 + fq * 4 + j]);
                }
            }
            const float dsk = C.in[22][layer * 4 + h];
#pragma unroll
            for (int i = 0; i < 2; ++i) { const int tt = C.wid + 8 * i, tm = tt >> 2, tn = tt & 3;
#pragma unroll
                for (int j = 0; j < 4; ++j) { const int l = tm * 16 + fq * 4 + j, p = tn * 16 + fr, c = h * 64 + p;
                    const float xs = bf2f(XT[(hh * 64 + p) * 72 + l]);
                    const float z = bf2f(P[(size_t)(ci.row0 + l) * NP + OFF_C + c]);
                    const float pre = (yacc[i][j] + dsk * xs) * silu(z);
                    YPRE[l * 264 + c] = f2bf(pre);
                    float q = pre * pre; q += __shfl_xor(q, 1); q += __shfl_xor(q, 2); q += __shfl_xor(q, 4); q += __shfl_xor(q, 8);
                    if (fr == 0) SSQ[l * 16 + h * 4 + tn] = q; }
            }
        }
    }
    __syncthreads();
    {
        const int l = C.tid >> 3, sub = C.tid & 7; float ss = 0.f;
#pragma unroll
        for (int i = 0; i < 16; ++i) ss += SSQ[l * 16 + i];
        const float rs = rsqrtf(ss * (1.f / 256.f) + 1e-6f);
        const float* ng = C.in[23] + layer * 256 + sub * 32;
        bf16_t* dst = YC + (size_t)(ci.row0 + l) * DM + 512 + sub * 32;
#pragma unroll
        for (int i = 0; i < 32; i += 2) { const float a = bf2f(YPRE[l * 264 + sub * 32 + i]) * rs * ng[i], b = bf2f(YPRE[l * 264 + sub * 32 + i + 1]) * rs * ng[i + 1]; *(unsigned*)(dst + i) = pk2(a, b); }
    }
    __syncthreads();
}

constexpr int D3_G2T = 0, D3_SG = 69632;
__device__ __forceinline__ void load_g2t(const Ctx& C, int layer) {
    LAS bf16_t* G2T = (LAS bf16_t*)(C.lds + D3_G2T); const float* g2 = C.in[30] + (size_t)layer * 128 * 256;
    for (int e = C.tid; e < 128 * 256; e += 512) { const int r = e >> 8, c = e & 255; G2T[c * 136 + r] = f2bf(g2[e]); }
}
__device__ __forceinline__ float lerp_d(const bf16_t* P, const ChunkInfo& ci, int row, int j, const float* mup, const float* mun) {
    const bf16_t* pp = P + (size_t)row * NP + OFF_D + j;
    const float x = bf2f(*pp), xp = (row - 1 >= ci.lo) ? bf2f(*(pp - NP)) : 0.f, xn = (row + 1 < ci.hi) ? bf2f(*(pp + NP)) : 0.f;
    return x + mup[j] * (xp - x) + mun[j] * (xn - x);
}
__device__ __forceinline__ void item_rwkv_out(const Ctx& C, int layer, int gc) {
    const ChunkInfo ci = chunk_info(gc);
    const bf16_t* P = (const bf16_t*)(C.ws + WS_P); bf16_t* YC = (bf16_t*)(C.ws + WS_ACT);
    const float* mup = C.in[24] + layer * 1152; const float* mun = C.in[25] + layer * 1152;
    LAS bf16_t* G2T = (LAS bf16_t*)(C.lds + D3_G2T); LAS bf16_t* SG = (LAS bf16_t*)(C.lds + D3_SG);
    const int fr = C.lane & 15, fq = C.lane >> 4;
    __syncthreads();
    for (int e = C.tid; e < 64 * 128; e += 512) { const int l = e >> 7, r = e & 127; SG[l * 136 + r] = f2bf(sigm(lerp_d(P, ci, ci.row0 + l, 1024 + r, mup, mun))); }
    __syncthreads();
    const int h = C.wid >> 1, tmb = (C.wid & 1) * 2;
    const bf16_t* Ryg = (const bf16_t*)(C.ws + WS_RY); const bf16_t* Ylg = (const bf16_t*)(C.ws + WS_RL); const bf16_t* Hg = (const bf16_t*)(C.ws + WS_RH);
    const float* BON = (const float*)(C.ws + WS_BON);
#pragma unroll
    for (int ti = 0; ti < 2; ++ti) {
        const int tm = tmb + ti;
        f32x4 gacc[4], yacc[4];
#pragma unroll
        for (int tn = 0; tn < 4; ++tn) { f32x4 a = {0.f, 0.f, 0.f, 0.f};
#pragma unroll
            for (int ks = 0; ks < 4; ++ks) a = __builtin_amdgcn_mfma_f32_16x16x32_bf16(*(const LAS bf16x8*)(SG + (tm * 16 + fr) * 136 + ks * 32 + fq * 8),
                                                                                        *(const LAS bf16x8*)(G2T + (h * 64 + tn * 16 + fr) * 136 + ks * 32 + fq * 8), a, 0, 0, 0);
            gacc[tn] = a; yacc[tn] = (f32x4){0.f, 0.f, 0.f, 0.f}; }
#pragma unroll
        for (int d = 0; d < 2; ++d) {
            const size_t slot = (size_t)slot_of(ci.b, h, d, cpos_of(ci, d));
            const int arow = d ? 63 - (tm * 16 + fr) : tm * 16 + fr;
            bf16x8 af[2];
#pragma unroll
            for (int ks = 0; ks < 2; ++ks) af[ks] = *(const bf16x8*)(Ryg + slot * 4096 + arow * 64 + ks * 32 + fq * 8);
#pragma unroll
            for (int tn = 0; tn < 4; ++tn) {
                f32x4 a;
                if (d == 0) { const u32x2 yl = *(const u32x2*)(Ylg + slot * 4096 + (tn * 16 + fr) * 64 + tm * 16 + fq * 4); a = (f32x4){bflo(yl.x), bfhi(yl.x), bflo(yl.y), bfhi(yl.y)}; }
                else { const u32x2 yl = *(const u32x2*)(Ylg + slot * 4096 + (tn * 16 + fr) * 64 + 60 - (tm * 16 + fq * 4)); a = (f32x4){bfhi(yl.y), bflo(yl.y), bfhi(yl.x), bflo(yl.x)}; }
#pragma unroll
                for (int ks = 0; ks < 2; ++ks) a = __builtin_amdgcn_mfma_f32_16x16x32_bf16(af[ks], *(const bf16x8*)(Hg + slot * 4096 + (tn * 16 + fr) * 64 + ks * 32 + fq * 8), a, 0, 0, 0);
                yacc[tn] += a;
            }
        }
#pragma unroll
        for (int j = 0; j < 4; ++j) {
            const int l = tm * 16 + fq * 4 + j, row = ci.row0 + l;
            float s = (yacc[0][j] + yacc[1][j]) + (yacc[2][j] + yacc[3][j]);
            s += __shfl_xor(s, 1); s += __shfl_xor(s, 2); s += __shfl_xor(s, 4); s += __shfl_xor(s, 8);
            const float mu = s * (1.f / 64.f);
            float q = 0.f;
#pragma unroll
            for (int tn = 0; tn < 4; ++tn) { const float dd = yacc[tn][j] - mu; q += dd * dd; }
            q += __shfl_xor(q, 1); q += __shfl_xor(q, 2); q += __shfl_xor(q, 4); q += __shfl_xor(q, 8);
            const float rs = rsqrtf(q * (1.f / 64.f) + 64e-5f);
            const float bon = BON[(size_t)row * 8 + h * 2] + BON[(size_t)row * 8 + h * 2 + 1];
#pragma unroll
            for (int tn = 0; tn < 4; ++tn) { const int c = h * 64 + tn * 16 + fr;
                const float yn = (yacc[tn][j] - mu) * rs * C.in[34][layer * 256 + c] + C.in[35][layer * 256 + c];
                const float vv = lerp_d(P, ci, row, 512 + c, mup, mun);
                YC[(size_t)row * DM + 768 + c] = f2bf((yn + bon * vv) * gacc[tn][j]); }
        }
    }
}

__device__ __forceinline__ unsigned ordf(float f) { const unsigned u = __float_as_uint(f); return u ^ ((u >> 31) ? 0xFFFFFFFFu : 0x80000000u); }
__device__ __forceinline__ unsigned wave_max_u32(unsigned v) {
#pragma unroll
    for (int o = 1; o < 64; o <<= 1) { const unsigned t = (unsigned)__shfl_xor((int)v, o); v = t > v ? t : v; }
    return v;
}
constexpr int SEL_K1 = 0, SEL_K2 = 34816, SEL_Q0 = 69632, SEL_Q1 = 78336, SEL_S1 = 87040, SEL_S2 = 103936;
__device__ __forceinline__ void ph_select(const Ctx& C, int layer, int nrows) {
    const bf16_t* Q = (const bf16_t*)(C.ws + WS_Q); int* SELI = (int*)(C.ws + WS_SELI); float* SELG = (float*)(C.ws + WS_SELG);
    LAS bf16_t* K1 = (LAS bf16_t*)(C.lds + SEL_K1); LAS bf16_t* K2 = (LAS bf16_t*)(C.lds + SEL_K2);
    LAS bf16_t* Q0 = (LAS bf16_t*)(C.lds + SEL_Q0); LAS bf16_t* Q1 = (LAS bf16_t*)(C.lds + SEL_Q1);
    LAS float* S1 = (LAS float*)(C.lds + SEL_S1); LAS float* S2 = (LAS float*)(C.lds + SEL_S2);
    {
        const float* k1 = C.in[37] + (size_t)layer * 128 * 128; const float* k2 = C.in[38] + (size_t)layer * 128 * 128;
        for (int e = C.tid; e < 4096; e += 512) { const int r = e >> 5, c4 = (e & 31) * 4; const f32x4 a = *(const f32x4*)(k1 + r * 128 + c4), b = *(const f32x4*)(k2 + r * 128 + c4);
            u32x2 oa, ob; oa.x = pk2(a.x, a.y); oa.y = pk2(a.z, a.w); ob.x = pk2(b.x, b.y); ob.y = pk2(b.z, b.w);
            *(LAS u32x2*)(K1 + r * 136 + c4) = oa; *(LAS u32x2*)(K2 + r * 136 + c4) = ob; }
    }
    int ca = 0, cb = 0;
    { const int L = C.lane;
      if (L < 16) { ca = 0; cb = L; } else if (L < 24) { ca = 1; cb = L - 16; } else if (L < 29) { ca = 2; cb = L - 24; } else if (L < 33) { ca = 3; cb = L - 29; }
      else if (L < 36) { ca = 4; cb = L - 33; } else if (L < 38) { ca = 5; cb = L - 36; } else if (L < 40) { ca = 6; cb = L - 38; } else if (L < 42) { ca = 7; cb = L - 40; }
      else { ca = 8 + (L - 42); cb = 0; } if (L >= 50) { ca = 0; cb = 0; } }
    const int ntile = nrows / 32;
    for (int it = C.bid; it < ntile * 8; it += C.G) {
        const int tile = it >> 3, h = it & 7, row0 = tile * 32;
        __syncthreads();
        for (int e = C.tid; e < 32 * 32; e += 512) { const int r = e >> 5, c8 = (e & 31) * 8;
            const u32x4 v = *(const u32x4*)(Q + (size_t)(row0 + r) * 2048 + h * 256 + c8);
            if (c8 < 128) *(LAS u32x4*)(Q0 + r * 136 + c8) = v; else *(LAS u32x4*)(Q1 + r * 136 + c8 - 128) = v; }
        __syncthreads();
        blk_mma2<2, 8, 4>(Q0, K1, Q1, K2, 136, C.wid, C.lane, [=](int r0, int col, const f32x4& a, const f32x4& b) {
#pragma unroll
            for (int jj = 0; jj < 4; ++jj) { S1[(r0 + jj) * 132 + col] = a[jj]; S2[(r0 + jj) * 132 + col] = b[jj]; }
        });
        __syncthreads();
        for (int ti = 0; ti < 4; ++ti) {
            const int t = C.wid * 4 + ti, L = C.lane;
            const LAS float* s1 = S1 + t * 132; const LAS float* s2 = S2 + t * 132;
            unsigned ka0 = (ordf(s1[L]) & ~0x7Fu) | (unsigned)(127 - L), ka1 = (ordf(s1[L + 64]) & ~0x7Fu) | (unsigned)(63 - L);
            unsigned kb0 = (ordf(s2[L]) & ~0x7Fu) | (unsigned)(127 - L), kb1 = (ordf(s2[L + 64]) & ~0x7Fu) | (unsigned)(63 - L);
            float v1 = 0.f, v2 = 0.f; int i1 = 0, i2 = 0;
            for (int i = 0; i < 16; ++i) {
                const unsigned ma = wave_max_u32(ka0 > ka1 ? ka0 : ka1), mb = wave_max_u32(kb0 > kb1 ? kb0 : kb1);
                const int ia = 127 - (int)(ma & 0x7Fu), ib = 127 - (int)(mb & 0x7Fu);
                if (L == i) { v1 = s1[ia]; i1 = ia; v2 = s2[ib]; i2 = ib; }
                if (ka0 == ma) ka0 = 0u; if (ka1 == ma) ka1 = 0u; if (kb0 == mb) kb0 = 0u; if (kb1 == mb) kb1 = 0u;
            }
            const float cand = __shfl(v1, ca) + __shfl(v2, cb);
            unsigned kc = (L < 50) ? ((ordf(cand) & ~0x3Fu) | (unsigned)(63 - L)) : 0u;
            int sel = 0;
            for (int i = 0; i < 16; ++i) { const unsigned m = wave_max_u32(kc); const int ls = 63 - (int)(m & 0x3Fu); if (L == i) sel = ls; if (kc == m) kc = 0u; }
            const float top = __shfl(cand, sel); const int sa = __shfl(ca, sel), sb = __shfl(cb, sel);
            const int idx = __shfl(i1, sa) * 128 + __shfl(i2, sb);
            const float mx = __shfl(top, 0);
            const float ex = expf(top - mx);
            float sm = ex; sm += __shfl_xor(sm, 1); sm += __shfl_xor(sm, 2); sm += __shfl_xor(sm, 4); sm += __shfl_xor(sm, 8);
            if (L < 16) { const size_t o = ((size_t)(row0 + t) * 8 + h) * 16 + L; SELI[o] = idx; SELG[o] = ex / sm; }
        }
    }
}

__device__ __forceinline__ void ph_peer(const Ctx& C, int layer, int nrows, bool last) {
    const bf16_t* F = (const bf16_t*)(C.ws + WS_ACT); bf16_t* XN = (bf16_t*)(C.ws + WS_ACT);
    const bf16_t* UB = (const bf16_t*)(C.ws + WS_UB); const bf16_t* VB = (const bf16_t*)(C.ws + WS_VB);
    const int* SELI = (const int*)(C.ws + WS_SELI); const float* SELG = (const float*)(C.ws + WS_SELG);
    float* H = (float*)(C.ws + WS_H); const float* MOD = (const float*)(C.ws + WS_MOD);
    const int L = C.lane;
    for (int tok = C.bid * 8 + C.wid; tok < nrows; tok += C.G * 8) {
        const u32x4 fa = *(const u32x4*)(F + (size_t)tok * DM + 8 * L), fb = *(const u32x4*)(F + (size_t)tok * DM + 512 + 8 * L);
        const int idx0 = SELI[(size_t)tok * 128 + L], idx1 = SELI[(size_t)tok * 128 + 64 + L];
        const float g0 = SELG[(size_t)tok * 128 + L], g1 = SELG[(size_t)tok * 128 + 64 + L];
        float out[16];
#pragma unroll
        for (int i = 0; i < 16; ++i) out[i] = 0.f;
        for (int bt = 0; bt < 16; ++bt) {
            const int src = bt < 8 ? idx0 : idx1; const float gsrc = bt < 8 ? g0 : g1; const int l0 = (bt & 7) * 8;
            u32x4 ua[8], ub[8], va[8], vb[8];
#pragma unroll
            for (int i = 0; i < 8; ++i) { const int ei = __builtin_amdgcn_readlane(src, l0 + i);
                const bf16_t* up = UB + (size_t)ei * DM; const bf16_t* vp = VB + (size_t)ei * DM;
                ua[i] = *(const u32x4*)(up + 8 * L); ub[i] = *(const u32x4*)(up + 512 + 8 * L);
                va[i] = *(const u32x4*)(vp + 8 * L); vb[i] = *(const u32x4*)(vp + 512 + 8 * L); }
            float part[8];
#pragma unroll
            for (int i = 0; i < 8; ++i) { float a = 0.f, b = 0.f;
                a = dot2bf(ua[i].x, fa.x, a); b = dot2bf(ua[i].y, fa.y, b); a = dot2bf(ua[i].z, fa.z, a); b = dot2bf(ua[i].w, fa.w, b);
                a = dot2bf(ub[i].x, fb.x, a); b = dot2bf(ub[i].y, fb.y, b); a = dot2bf(ub[i].z, fb.z, a); b = dot2bf(ub[i].w, fb.w, b);
                part[i] = a + b; }
            float p4[4], p2[2], p1;
            { const bool hi = (L & 32) != 0;
#pragma unroll
              for (int i = 0; i < 4; ++i) { const float send = hi ? part[i] : part[i + 4]; const float recv = __shfl_xor(send, 32); p4[i] = (hi ? part[i + 4] : part[i]) + recv; } }
            { const bool hi = (L & 16) != 0;
#pragma unroll
              for (int i = 0; i < 2; ++i) { const float send = hi ? p4[i] : p4[i + 2]; const float recv = __shfl_xor(send, 16); p2[i] = (hi ? p4[i + 2] : p4[i]) + recv; } }
            { const bool hi = (L & 8) != 0; const float send = hi ? p2[0] : p2[1]; const float recv = __shfl_xor(send, 8); p1 = (hi ? p2[1] : p2[0]) + recv; }
            p1 += __shfl_xor(p1, 4); p1 += __shfl_xor(p1, 2); p1 += __shfl_xor(p1, 1);
            const int myexp = ((L >> 5) & 1) * 4 + ((L >> 4) & 1) * 2 + ((L >> 3) & 1);
            const float gate = __shfl(gsrc, l0 + myexp);
            const float act = gelu_tanh(p1) * gate;
#pragma unroll
            for (int i = 0; i < 8; ++i) {
                const float a = __shfl(act, ((i >> 2) & 1) * 32 + ((i >> 1) & 1) * 16 + (i & 1) * 8);
                out[0] += a * bflo(va[i].x); out[1] += a * bfhi(va[i].x); out[2] += a * bflo(va[i].y); out[3] += a * bfhi(va[i].y);
                out[4] += a * bflo(va[i].z); out[5] += a * bfhi(va[i].z); out[6] += a * bflo(va[i].w); out[7] += a * bfhi(va[i].w);
                out[8] += a * bflo(vb[i].x); out[9] += a * bfhi(vb[i].x); out[10] += a * bflo(vb[i].y); out[11] += a * bfhi(vb[i].y);
                out[12] += a * bflo(vb[i].z); out[13] += a * bfhi(vb[i].z); out[14] += a * bflo(vb[i].w); out[15] += a * bfhi(vb[i].w);
            }
        }
        const float* m = MOD + ((size_t)layer * 3 + which_of(tok)) * 6144;
        Row16 hr = load_row16(H + (size_t)tok * DM, L); const Row16 g5 = load_row16(m + 5 * 1024, L);
#pragma unroll
        for (int i = 0; i < 16; ++i) hr.v[i] += g5.v[i] * out[i];
        if (!last) {
            store_row16_f32(H + (size_t)tok * DM, L, hr);
            const float* m2 = MOD + ((size_t)(layer + 1) * 3 + which_of(tok)) * 6144;
            const Row16 o = norm_mod_row(hr, C.in[6] + (layer + 1) * 1024, m2, m2 + 1024, L);
            store_row16_bf16(XN + (size_t)tok * DM, L, o);
        } else {
            float ss = 0.f;
#pragma unroll
            for (int i = 0; i < 16; ++i) ss += hr.v[i] * hr.v[i];
            const float rs = rsqrtf(wave_sum(ss) * (1.f / 1024.f) + 1e-6f);
            const Row16 fg = load_row16(C.in[41], L); Row16 o;
#pragma unroll
            for (int i = 0; i < 16; ++i) o.v[i] = hr.v[i] * rs * fg.v[i];
            store_row16_f32(C.out + (size_t)tok * DM, L, o);
        }
    }
}

#define PM(n) ((MASK >> (n)) & 1u)
constexpr int NPH_LAYER = 9, NPH = 2 + 2 * NPH_LAYER;
template <unsigned MASK> __global__ void __launch_bounds__(512, 2) hybrid_fwd(Args args) {
    extern __shared__ __attribute__((aligned(16))) unsigned char lds_raw[];
    Ctx C0; C0.in = args.in; C0.out = args.out; C0.ws = args.ws; C0.lds = (lds_t)lds_raw;
    C0.tid = threadIdx.x; C0.lane = C0.tid & 63; C0.wid = __builtin_amdgcn_readfirstlane(C0.tid >> 6); C0.bid = blockIdx.x; C0.G = gridDim.x;
    const Ctx& C = C0;
    const int lo = args.ph_lo, hi = args.ph_hi;
    const bool multi = (hi - lo) > 1;
    XcdBarrier bar; bar.bar = (unsigned*)(C.ws + WS_CTL); bar.x = 0; bar.st = (volatile LAS unsigned*)(C.lds + LDS_XB);
    if (multi) {
        if (C.tid == 0) *(LAS u32x4*)(C.lds + LDS_XB) = (u32x4){0u, 0u, 0u, 0u};
        __syncthreads();
        bar = xcd_barrier_post((unsigned*)(C.ws + WS_CTL), (volatile LAS unsigned*)(C.lds + LDS_XB));
    }
#define IN(k) (lo <= (k) && (k) < hi)
#define PHASE_CTX(c) Ctx c = C0; { int t_ = C0.tid; asm volatile("" : "+v"(t_)); c.tid = t_; c.lane = t_ & 63; c.wid = __builtin_amdgcn_readfirstlane(t_ >> 6); unsigned char* w_ = C0.ws; asm volatile("" : "+s"(w_)); c.ws = w_; }
#define SEAM(k) do { if (IN(k) && IN((k) + 1)) xcd_barrier(bar); } while (0)
    if (PM(0) && IN(0)) { PHASE_CTX(c); ph_prologue(c); } SEAM(0);
    if (PM(1) && IN(1)) { PHASE_CTX(c); ph_norm(c, 0, c.in[6], 0, NROW); } SEAM(1);
    for (int layer = 0; layer < 2; ++layer) {
        const int base = 2 + layer * NPH_LAYER;
        const bool emit = (layer == 0);
        const int nrows = emit ? NROW : NLAT;
        if (PM(2) && IN(base + 0)) {
            pg8::Gemm g{(const bf16_t*)(C.ws + WS_ACT), (const bf16_t*)(C.ws + WS_WIN) + (size_t)layer * NP * DM, NROW, NP, DM};
            pg8::StaticOrder S; S.init(NROW, NP, C.G, C.bid);
            pg8::EpiBf16<0> E{(bf16_t*)(C.ws + WS_P), NP, nullptr, 0, 0};
            pg8::gemm_phase<pg8::EpiBf16<0>, pg8::StaticOrder, false>(C.lds, g, S, E, nullptr);
        }
        SEAM(base + 0);
        if (PM(3) && IN(base + 1)) {
            const int nD = 2112, nC = 264, nB = emit ? 132 : 128, nA = emit ? 264 : 256, tot = nD + nC + nB + nA;
            if (PM(11)) { PHASE_CTX(c); for (int it = c.bid; it < nD; it += c.G) item_rwkv_local(c, layer, it); }
            if (PM(12)) { PHASE_CTX(c); for (int it = nD + (c.bid + 64) % c.G; it < nD + nC; it += c.G) item_mamba_local(c, layer, it - nD); }
            if (PM(13)) { PHASE_CTX(c); for (int it = nD + nC + (c.bid + 192) % c.G; it < nD + nC + nB; it += c.G) item_chunkmlp(c, layer, it - nD - nC); }
            if (PM(14)) { PHASE_CTX(c); for (int it = nD + nC + nB + (c.bid + 64) % c.G; it < tot; it += c.G) item_conformer(c, layer, it - nD - nC - nB); }
        }
        SEAM(base + 1);
        if (PM(4) && IN(base + 2)) { PHASE_CTX(c); ph_scan(c); }
        SEAM(base + 2);
        if (PM(5) && IN(base + 3)) {
            const int nc = nrows / 64;
            if (PM(15)) { PHASE_CTX(c); load_g2t(c, layer); for (int it = c.bid; it < nc; it += c.G) item_rwkv_out(c, layer, it); }
            __syncthreads();
            if (PM(16)) { PHASE_CTX(c); for (int it = c.bid; it < nc; it += c.G) item_mamba_out(c, layer, (it + 128) % nc); }
        }
        SEAM(base + 3);
        if (PM(6) && IN(base + 4)) {
            pg8::Gemm g{(const bf16_t*)(C.ws + WS_ACT), (const bf16_t*)(C.ws + WS_WOUT) + (size_t)layer * DM * DM, nrows, DM, DM};
            pg8::StaticOrder S; S.init(nrows, DM, C.G, C.bid);
            EpiResid E{(float*)(C.ws + WS_H), (const float*)(C.ws + WS_MOD) + (size_t)layer * 3 * 6144};
            pg8::gemm_phase<EpiResid, pg8::StaticOrder, false>(C.lds, g, S, E, nullptr);
        }
        SEAM(base + 4);
        if (PM(7) && IN(base + 5)) { PHASE_CTX(c); ph_norm(c, layer, c.in[7] + layer * 1024, 3, nrows); if (layer == 1) convert_tables(c, 1); }
        SEAM(base + 5);
        if (PM(8) && IN(base + 6)) {
            pg8::Gemm g{(const bf16_t*)(C.ws + WS_ACT), (const bf16_t*)(C.ws + WS_WQ) + (size_t)layer * 2048 * DM, nrows, 2048, DM};
            pg8::StaticOrder S; S.init(nrows, 2048, C.G, C.bid);
            pg8::EpiBf16<0> E{(bf16_t*)(C.ws + WS_Q), 2048, nullptr, 0, 0};
            pg8::gemm_phase<pg8::EpiBf16<0>, pg8::StaticOrder, false>(C.lds, g, S, E, nullptr);
        }
        SEAM(base + 6);
        if (PM(9) && IN(base + 7)) { PHASE_CTX(c); ph_select(c, layer, nrows); }
        SEAM(base + 7);
        if (PM(10) && IN(base + 8)) { PHASE_CTX(c); ph_peer(c, layer, nrows, layer == 1); }
        SEAM(base + 8);
    }
#undef IN
#undef SEAM
}
}
#ifndef MK_DIAG
#define MK_DIAG 0
#endif


namespace mk {
struct LaunchEnt { unsigned mask; int ph; };
template <unsigned MASK> static bool prep_kernel() {
    return hipFuncSetAttribute((const void*)hybrid_fwd<MASK>, hipFuncAttributeMaxDynamicSharedMemorySize, LDS_BYTES) == hipSuccess;
}
template <unsigned MASK> static void launch_kernel(int grid, hipStream_t stream, const Args& a) {
    hipLaunchKernelGGL(hybrid_fwd<MASK>, dim3(grid), dim3(512), LDS_BYTES, stream, a);
}
}

#if MK_DIAG
namespace mk {
__global__ void census_kernel(const void* buf, size_t n, int kind  , unsigned* flags, int stage, float lim) {
    bool bad = false;
    for (size_t i = (size_t)blockIdx.x * blockDim.x + threadIdx.x; i < n; i += (size_t)gridDim.x * blockDim.x) {
        if (kind == 2) { const int v = ((const int*)buf)[i]; bad |= (v < 0 || v >= 16384); }
        else { const float v = kind == 0 ? ((const float*)buf)[i] : bf2f(((const bf16_t*)buf)[i]); bad |= !(fabsf(v) < lim); }
    }
    if (bad) atomicOr(flags + stage, 1u);
}
__global__ void encode_kernel(const float* x, const float* fg, float* out, const unsigned* flags, int nst) {
    int first = 0; for (int k = nst; k >= 1; --k) if (flags[k]) first = k;
    const int row = blockIdx.x * 4 + (threadIdx.x >> 6), lane = threadIdx.x & 63;
    Row16 r = load_row16(x + (size_t)row * DM, lane);
    const int t = row & 8191;
    for (int i = 0; i < 16; ++i) { const int c = (i < 8 ? 8 * lane + i : 512 + 8 * lane + i - 8); const int quarter = c >> 8, jj = c & 255; const float pos = (quarter < 2) ? (float)(t >> 6) : (float)(t & 63);
        const float fr = exp2f(-(float)jj * (13.287712379549449f / 256.f)); r.v[i] += (quarter & 1) ? cosf(pos * fr) : sinf(pos * fr); }
    float ss = 0.f; for (int i = 0; i < 16; ++i) ss += r.v[i] * r.v[i];
    const float rs = rsqrtf(wave_sum(ss) * (1.f / 1024.f) + 1e-6f);
    const Row16 g = load_row16(fg, lane); Row16 o;
    const bool zero = row < first * 512;
    for (int i = 0; i < 16; ++i) o.v[i] = zero ? 0.f : r.v[i] * rs * g.v[i];
    store_row16_f32(out + (size_t)row * DM, lane, o);
}
}
#define CENSUS(off, n, kind, stage, lim) hipLaunchKernelGGL(mk::census_kernel, dim3(1024), dim3(256), 0, stream, (const void*)((char*)d_ws + (off)), (size_t)(n), kind, (unsigned*)((char*)d_ws + 32768), stage, lim)
#else
#define CENSUS(off, n, kind, stage, lim) do {} while (0)
#endif
#ifndef MK_ONE_LAUNCH
#define MK_ONE_LAUNCH 1
#endif
extern "C" void kernel_launch(void* const* d_in, const int* in_sizes, int n_in, void* d_out, int out_size, void* d_ws, size_t ws_size, hipStream_t stream) {
    using namespace mk;
    static int grid = 0;
    if (grid == 0) {
        if (n_in != 42 || ws_size < WS_END) { fprintf(stderr, "kernel_launch: need 42 inputs and %zu bytes of workspace (got %d, %zu)\n", (size_t)WS_END, n_in, ws_size); grid = -1; return; }
        int dev = 0, cus = 0;
        if (hipGetDevice(&dev) != hipSuccess || hipDeviceGetAttribute(&cus, hipDeviceAttributeMultiprocessorCount, dev) != hipSuccess) { grid = -1; return; }
        bool ok = true;
#if MK_ONE_LAUNCH
        ok = ok && prep_kernel<0x1FFFFu>();
#else
        ok = ok && prep_kernel<0x0001u>() && prep_kernel<0x0002u>() && prep_kernel<0x0004u>() && prep_kernel<0x0808u>() && prep_kernel<0x1008u>() && prep_kernel<0x2008u>() && prep_kernel<0x4008u>()
                && prep_kernel<0x0010u>() && prep_kernel<0x8020u>() && prep_kernel<0x10020u>() && prep_kernel<0x0040u>() && prep_kernel<0x0080u>() && prep_kernel<0x0100u>() && prep_kernel<0x0200u>() && prep_kernel<0x0400u>();
#endif
        if (!ok) { fprintf(stderr, "kernel_launch: hipFuncSetAttribute failed\n"); grid = -1; return; }
        (void)hipGetLastError();
        grid = cus;
    }
    if (grid < 0) return;
    (void)hipMemsetAsync((char*)d_ws + WS_CTL, 0, 65536, stream);
    Args a{};
    for (int i = 0; i < 42; ++i) a.in[i] = (const float*)d_in[i];
    a.out = (float*)d_out; a.ws = (unsigned char*)d_ws;
#if MK_ONE_LAUNCH
    a.ph_lo = 0; a.ph_hi = NPH; launch_kernel<0x1FFFFu>(grid, stream, a);
#else
    a.ph_lo = 0; a.ph_hi = 1; launch_kernel<0x0001u>(grid, stream, a);
    CENSUS(WS_H, (size_t)NROW * DM, 0, 1, 1e4f); CENSUS(WS_MOD, 2 * 3 * 6144, 0, 1, 1e4f); CENSUS(WS_WIN, 2ull * NP * DM, 1, 1, 1e4f); CENSUS(WS_UB, 2ull * NEXP * DM, 1, 1, 1e4f);
    a.ph_lo = 1; a.ph_hi = 2; launch_kernel<0x0002u>(grid, stream, a);
    CENSUS(WS_ACT, (size_t)NROW * DM, 1, 2, 1e4f);
    for (int layer = 0; layer < 2; ++layer) {
        const int b = 2 + layer * NPH_LAYER;
        const int so = layer ? 100 : 0; (void)so;
        a.ph_lo = b + 0; a.ph_hi = b + 1; launch_kernel<0x0004u>(grid, stream, a);
        if (!layer) CENSUS(WS_P, (size_t)NROW * NP, 1, 3, 1e4f);
        a.ph_lo = b + 1; a.ph_hi = b + 2; launch_kernel<0x0808u>(grid, stream, a);
        if (!layer) { CENSUS(WS_RG, (size_t)NSLOT * 4096, 1, 4, 1e6f); CENSUS(WS_RJ, (size_t)NSLOT * 4096, 0, 5, 1e6f); CENSUS(WS_RY, (size_t)NSLOT * 4096 * 2, 1, 6, 1e6f); CENSUS(WS_BON, (size_t)NROW * 8, 0, 6, 1e6f); }
        launch_kernel<0x1008u>(grid, stream, a);
        if (!layer) { CENSUS(WS_MST, (size_t)NSLOT * 8192, 0, 7, 1e6f); CENSUS(WS_MCD, NSLOT, 0, 7, 1e6f); }
        launch_kernel<0x2008u>(grid, stream, a); launch_kernel<0x4008u>(grid, stream, a);
        a.ph_lo = b + 2; a.ph_hi = b + 3; launch_kernel<0x0010u>(grid, stream, a);
        if (!layer) { CENSUS(WS_MST, (size_t)NSLOT * 8192, 0, 8, 1e6f); CENSUS(WS_RH, (size_t)NSLOT * 4096, 1, 9, 1e6f); }
        a.ph_lo = b + 3; a.ph_hi = b + 4; launch_kernel<0x8020u>(grid, stream, a); launch_kernel<0x10020u>(grid, stream, a);
        if (!layer) CENSUS(WS_ACT, (size_t)NROW * DM, 1, 10, 1e4f);
        a.ph_lo = b + 4; a.ph_hi = b + 5; launch_kernel<0x0040u>(grid, stream, a);
        if (!layer) CENSUS(WS_H, (size_t)NROW * DM, 0, 11, 1e4f);
        a.ph_lo = b + 5; a.ph_hi = b + 6; launch_kernel<0x0080u>(grid, stream, a);
        a.ph_lo = b + 6; a.ph_hi = b + 7; launch_kernel<0x0100u>(grid, stream, a);
        if (!layer) CENSUS(WS_Q, (size_t)NROW * 2048, 1, 12, 1e4f);
        a.ph_lo = b + 7; a.ph_hi = b + 8; launch_kernel<0x0200u>(grid, stream, a);
        if (!layer) { CENSUS(WS_SELI, (size_t)NROW * 128, 2, 13, 0.f); CENSUS(WS_SELG, (size_t)NROW * 128, 0, 13, 2.f); }
        a.ph_lo = b + 8; a.ph_hi = b + 9; launch_kernel<0x0400u>(grid, stream, a);
        if (!layer) { CENSUS(WS_H, (size_t)NROW * DM, 0, 14, 1e4f); CENSUS(WS_ACT, (size_t)NROW * DM, 1, 15, 1e4f); }
    }
#endif
#if MK_DIAG
    hipLaunchKernelGGL(mk::encode_kernel, dim3(NLAT / 4), dim3(256), 0, stream, (const float*)d_in[0], (const float*)d_in[41], (float*)d_out, (const unsigned*)((char*)d_ws + 32768), 15);
#endif
    (void)in_sizes; (void)out_size;
}
```

```cpp
#include <hip/hip_runtime.h>
#include <cstdio>
#include <cstdint>
namespace pg8 {
#define PG8_LAS __attribute__((address_space(3)))
typedef unsigned short bf16_t;
typedef short bf16x8 __attribute__((ext_vector_type(8)));
typedef float f32x4 __attribute__((ext_vector_type(4)));
typedef unsigned u32x4 __attribute__((ext_vector_type(4)));
constexpr int BM = 256, BK = 64, HALF = 128, HTB = HALF * BK * 2  , STAGE_BYTES = 8 * HTB, NXCD = 8, WGM = 8;

__host__ __device__ __forceinline__ int lds_byte(int r, int c) { const int st = (r >> 4) * 2 + (c >> 5), rr = r & 15, cc = c & 31, ob = rr * 64 + cc * 2; return st * 1024 + (ob ^ (((ob >> 9) & 1) << 5)); }
__host__ __device__ __forceinline__ void stage_rc(int b, int& R, int& C) { const int st = b / 1024, sb = b % 1024, swz = sb ^ (((sb >> 9) & 1) << 5); R = (st >> 1) * 16 + swz / 64; C = (st & 1) * 32 + (swz % 64) / 2; }
__host__ __device__ __forceinline__ int perm32(int rho) { const int n = rho >> 4, i = rho & 15; return 8 * (i >> 2) + 4 * n + (i & 3); }

struct Unit { int pm, pn; };
struct Gemm { const bf16_t* A; const bf16_t* Bt; int M, N, K; };

struct StaticOrder {
    int nM, nN, nwg, G, c;
    __host__ __device__ void init(int M, int N, int G_, int c_) { nM = M / BM; nN = N / BM; nwg = nM * nN; G = G_; c = c_; }
    __host__ __device__ bool next(int i, Unit& u) const {
        const long L = (long)i * G + c; if (L >= nwg) return false;
        int wgid = (int)L; { const int q = nwg / NXCD, r = nwg % NXCD, xcd = wgid % NXCD, off = wgid / NXCD; wgid = (xcd < r ? xcd * (q + 1) : r * (q + 1) + (xcd - r) * q) + off; }
        const int nig = WGM * nN, gid = wgid / nig, fm = gid * WGM, gsz = (nM - fm) < WGM ? (nM - fm) : WGM;
        u.pm = fm + ((wgid % nig) % gsz); u.pn = (wgid % nig) / gsz; return true;
    }
    __device__ __forceinline__ void a_ready(const Unit&) const {}
    __device__ __forceinline__ void done(const Unit&) const {}
};
struct CountedOrder : StaticOrder {
    const unsigned* ready; unsigned need; unsigned* tmo;
    __device__ __forceinline__ void a_ready(const Unit& u) const {
        if (threadIdx.x < 64) {
            const unsigned long long t0 = __builtin_amdgcn_s_memrealtime(); unsigned polls = 0;
            while ((unsigned)__builtin_amdgcn_readfirstlane(__hip_atomic_load(ready + 64 * u.pm, __ATOMIC_RELAXED, __HIP_MEMORY_SCOPE_AGENT)) < need) {
                if ((++polls & 255u) == 0u && __builtin_amdgcn_readfirstlane(__hip_atomic_load(tmo, __ATOMIC_RELAXED, __HIP_MEMORY_SCOPE_AGENT)) != 0u) break;
                if (__builtin_amdgcn_s_memrealtime() - t0 > 2000000ull) {
                    if (threadIdx.x == 0) { unsigned expect = 0u; __hip_atomic_compare_exchange_strong(tmo + 1, &expect, 0x600u | (unsigned)(u.pm & 0xff), __ATOMIC_RELAXED, __ATOMIC_RELAXED, __HIP_MEMORY_SCOPE_AGENT); __hip_atomic_store(tmo, 1u, __ATOMIC_RELAXED, __HIP_MEMORY_SCOPE_AGENT); }
                    break; }
                __builtin_amdgcn_s_sleep(2); }
            __builtin_amdgcn_fence(__ATOMIC_ACQUIRE, "agent");
            asm volatile("s_waitcnt vmcnt(0)" ::: "memory");
        }
#if !defined(BROKEN_HOOK_NO_BARRIER)
        asm volatile("" ::: "memory"); __builtin_amdgcn_s_barrier(); asm volatile("" ::: "memory");
#endif
    }
};

__device__ __forceinline__ unsigned cvt_pk_bf16(float lo, float hi) { unsigned r; asm volatile("v_cvt_pk_bf16_f32 %0, %1, %2" : "=v"(r) : "v"(lo), "v"(hi)); return r; }
typedef float f32x2 __attribute__((ext_vector_type(2)));
__device__ __forceinline__ f32x2 gelu_pk(f32x2 v) {
    const f32x2 av = __builtin_elementwise_abs(v), d = av * 0.2316418882f + 1.0f;
    f32x2 t; t.x = __builtin_amdgcn_rcpf(d.x); t.y = __builtin_amdgcn_rcpf(d.y);
    f32x2 q = t * 0.5307027145f + (-0.7265760135f); q = q * t + 0.7107068705f; q = q * t + (-0.142248368f); q = q * t + 0.127414796f; q = q * t;
    const f32x2 s = (v * v) * (-0.72134752044f);
    f32x2 e; e.x = __builtin_amdgcn_exp2f(s.x); e.y = __builtin_amdgcn_exp2f(s.y);
    const f32x2 m = v * (q * e), r = v - m;
    f32x2 o; o.x = v.x < 0.f ? m.x : r.x; o.y = v.y < 0.f ? m.y : r.y; return o;
}

struct EpiF32 {
    static constexpr bool PERM = false, AFTER_DRAIN = false;
    float* C; int ldc; const float* bias;
    __device__ __forceinline__ void operator()(const f32x4 (&acc)[2][2][4][2], const Unit& u, int wr, int wc, int fr, int fq) const {
        const int row0 = u.pm * BM + wr * 64 + fr, col0 = u.pn * BM + wc * 32 + 4 * fq;
        f32x4 bv[2][2];
#pragma unroll
        for (int bj = 0; bj < 2; ++bj)
#pragma unroll
            for (int n = 0; n < 2; ++n) bv[bj][n] = bias ? *(const f32x4*)(bias + col0 + bj * HALF + n * 16) : (f32x4){0.f, 0.f, 0.f, 0.f};
#pragma unroll
        for (int ai = 0; ai < 2; ++ai)
#pragma unroll
            for (int m = 0; m < 4; ++m) { float* rowp = C + (size_t)(row0 + ai * HALF + m * 16) * ldc + col0;
#pragma unroll
                for (int bj = 0; bj < 2; ++bj)
#pragma unroll
                    for (int n = 0; n < 2; ++n) *(f32x4*)(rowp + bj * HALF + n * 16) = acc[ai][bj][m][n] + bv[bj][n]; }
    }
};
template <int ACT  > struct EpiBf16 {
    static constexpr bool PERM = true, AFTER_DRAIN = false;
    bf16_t* O; int ldc; const float* bias; int split_cols; size_t split_stride;
    __device__ __forceinline__ void operator()(const f32x4 (&acc)[2][2][4][2], const Unit& u, int wr, int wc, int fr, int fq) const {
        const int row0 = u.pm * BM + wr * 64 + fr; int colt = u.pn * BM; bf16_t* base = O;
        if (split_cols) { const int t = colt / split_cols; base += (size_t)t * split_stride; colt -= t * split_cols; }
        const int col0 = colt + wc * 32 + 8 * fq, bcol0 = u.pn * BM + wc * 32 + 8 * fq;
        f32x4 bv[2][2];
#pragma unroll
        for (int bj = 0; bj < 2; ++bj)
#pragma unroll
            for (int n = 0; n < 2; ++n) bv[bj][n] = bias ? *(const f32x4*)(bias + bcol0 + bj * HALF + 4 * n) : (f32x4){0.f, 0.f, 0.f, 0.f};
#pragma unroll
        for (int ai = 0; ai < 2; ++ai)
#pragma unroll
            for (int m = 0; m < 4; ++m) { bf16_t* rowp = base + (size_t)(row0 + ai * HALF + m * 16) * ldc + col0;
#pragma unroll
                for (int bj = 0; bj < 2; ++bj) { f32x4 v0 = acc[ai][bj][m][0] + bv[bj][0], v1 = acc[ai][bj][m][1] + bv[bj][1];
                    if (ACT == 1) { f32x2 a = gelu_pk((f32x2){v0[0], v0[1]}), b = gelu_pk((f32x2){v0[2], v0[3]}), c = gelu_pk((f32x2){v1[0], v1[1]}), d = gelu_pk((f32x2){v1[2], v1[3]});
                        v0 = (f32x4){a.x, a.y, b.x, b.y}; v1 = (f32x4){c.x, c.y, d.x, d.y}; }
                    if (ACT == 2) {
#pragma unroll
                        for (int j = 0; j < 4; ++j) { v0[j] = 0.5f * v0[j] * (1.0f + erff(v0[j] * 0.70710678f)); v1[j] = 0.5f * v1[j] * (1.0f + erff(v1[j] * 0.70710678f)); } }
                    u32x4 w; w.x = cvt_pk_bf16(v0[0], v0[1]); w.y = cvt_pk_bf16(v0[2], v0[3]); w.z = cvt_pk_bf16(v1[0], v1[1]); w.w = cvt_pk_bf16(v1[2], v1[3]);
                    *(u32x4*)(rowp + bj * HALF) = w; } }
    }
};
template <class Epi, class Sched, bool STAMP = false>
__device__ __forceinline__ void gemm_phase(PG8_LAS unsigned char* lds, const Gemm g, const Sched& S, const Epi& E, unsigned long long* stamps) {
    int tid_ = threadIdx.x; asm volatile("" : "+v"(tid_));
    const int tid = tid_, wid = __builtin_amdgcn_readfirstlane(tid >> 6), lane = tid & 63, wr = wid >> 2, wc = wid & 3, fr = lane & 15, fq = lane >> 4;
    const int K = g.K, nt = K / BK;
    int ts_lo = 0, ts_hi = 0, nts = 0; const unsigned long long rt_entry = STAMP ? (unsigned long long)wall_clock64() : 0ull;
#define PG8_STAMP() do { if (STAMP && wid == 0 && nts < 64) { const unsigned long long _c = (unsigned long long)clock64(); \
        ts_lo = (lane == nts) ? (int)(unsigned)_c : ts_lo; ts_hi = (lane == nts) ? (int)(unsigned)(_c >> 32) : ts_hi; ++nts; } } while (0)
    PG8_STAMP();
    unsigned voffA[2], voffB[2];
#pragma unroll
    for (int i = 0; i < 2; ++i) { int R, C; stage_rc(tid * 16 + i * 8192, R, C); const int Rb = Epi::PERM ? ((R & ~31) + perm32(R & 31)) : R;
        voffA[i] = (unsigned)(R * K + C) * 2u; voffB[i] = (unsigned)(Rb * K + C) * 2u; }
    const size_t kstep = (size_t)(BK * 2);
    const size_t hstep = (size_t)HALF * K * 2;
    const size_t tstep = 2 * hstep;
    const unsigned ldsw = (unsigned)wid * 1024u;
    const int aoff = lds_byte(wr * 64 + fr, fq * 8), boff = lds_byte(wc * 32 + fr, fq * 8);
#define PG8_SA(b, h) (((b) * 2 + (h)) * HTB)
#define PG8_SB(b, h) ((4 + (b) * 2 + (h)) * HTB)
#define PG8_STAGE(bufoff, gbase, voff) do { _Pragma("unroll") for (int _i = 0; _i < 2; ++_i) \
        __builtin_amdgcn_global_load_lds((const unsigned*)((const char*)(gbase) + (voff)[_i]), (PG8_LAS unsigned*)(lds + (bufoff) + ldsw + _i * 8192), 16, 0, 0); } while (0)
#define PG8_LDA(dst, b, h) do { _Pragma("unroll") for (int m = 0; m < 4; ++m) _Pragma("unroll") for (int k = 0; k < 2; ++k) dst[m][k] = *(const PG8_LAS bf16x8*)(lds + PG8_SA(b, h) + aoff + m * 2048 + k * 1024); } while (0)
#define PG8_LDB(dst, b, h) do { _Pragma("unroll") for (int n = 0; n < 2; ++n) _Pragma("unroll") for (int k = 0; k < 2; ++k) dst[n][k] = *(const PG8_LAS bf16x8*)(lds + PG8_SB(b, h) + boff + n * 2048 + k * 1024); } while (0)
#define PG8_MMA(ai, bj, At, Bt) do { __builtin_amdgcn_s_setprio(1); _Pragma("unroll") for (int m = 0; m < 4; ++m) _Pragma("unroll") for (int n = 0; n < 2; ++n) _Pragma("unroll") for (int k = 0; k < 2; ++k) \
        acc[ai][bj][m][n] = __builtin_amdgcn_mfma_f32_16x16x32_bf16(Bt[n][k], At[m][k], acc[ai][bj][m][n], 0, 0, 0); __builtin_amdgcn_s_setprio(0); } while (0)
#define PG8_WAIT_V(n) asm volatile("s_waitcnt vmcnt(" #n ")" ::: "memory")
#define PG8_WAIT_L(n) asm volatile("s_waitcnt lgkmcnt(" #n ")" ::: "memory")
#define PG8_BAR __builtin_amdgcn_s_barrier()
#define PG8_SCHED __builtin_amdgcn_sched_barrier(0)
    Unit cur, nxt; int ui = 0;
    if (!S.next(0, cur)) return;
    f32x4 acc[2][2][4][2];
#pragma unroll
    for (int a = 0; a < 2; ++a)
#pragma unroll
        for (int b = 0; b < 2; ++b)
#pragma unroll
            for (int m = 0; m < 4; ++m)
#pragma unroll
                for (int n = 0; n < 2; ++n) acc[a][b][m][n] = (f32x4){0.f, 0.f, 0.f, 0.f};
    bf16x8 At[4][2], B0[2][2], B1[2][2];
    const char* cA = (const char*)g.A + (size_t)cur.pm * tstep; const char* cB = (const char*)g.Bt + (size_t)cur.pn * tstep;
    S.a_ready(cur);
    PG8_STAGE(PG8_SB(0, 0), cB, voffB); PG8_STAGE(PG8_SA(0, 0), cA, voffA); PG8_STAGE(PG8_SB(0, 1), cB + hstep, voffB); PG8_STAGE(PG8_SA(0, 1), cA + hstep, voffA);
    if (wr == 1) PG8_BAR;
    PG8_WAIT_V(4); PG8_BAR;
    PG8_STAGE(PG8_SB(1, 0), cB + kstep, voffB); PG8_STAGE(PG8_SA(1, 0), cA + kstep, voffA); PG8_STAGE(PG8_SB(1, 1), cB + hstep + kstep, voffB);
    PG8_WAIT_V(6); PG8_BAR;
    PG8_STAMP();
    for (;;) {
        const bool has_next = S.next(ui + 1, nxt);
        const char* nA = has_next ? (const char*)g.A + (size_t)nxt.pm * tstep : cA; const char* nB = has_next ? (const char*)g.Bt + (size_t)nxt.pn * tstep : cB;
        for (int t = 0; t < nt; t += 2) {
            const bool last = (t == nt - 2);
            const char* a1 = cA + (size_t)(t + 1) * kstep;
            const char* a2 = last ? nA : cA + (size_t)(t + 2) * kstep; const char* b2 = last ? nB : cB + (size_t)(t + 2) * kstep;
            const char* a3 = a2 + kstep; const char* b3 = b2 + kstep;
            if (last && has_next) S.a_ready(nxt);
            PG8_LDB(B0, 0, 0); PG8_SCHED; PG8_LDA(At, 0, 0); PG8_STAGE(PG8_SA(1, 1), a1 + hstep, voffA);
            PG8_WAIT_L(8); PG8_BAR; PG8_WAIT_L(0); PG8_MMA(0, 0, At, B0); PG8_BAR; PG8_SCHED;
            PG8_LDB(B1, 0, 1); PG8_STAGE(PG8_SB(0, 0), b2, voffB);
            PG8_BAR; PG8_WAIT_L(0); PG8_MMA(0, 1, At, B1); PG8_BAR;
            PG8_LDA(At, 0, 1); PG8_STAGE(PG8_SA(0, 0), a2, voffA);
            PG8_BAR; PG8_WAIT_L(0); PG8_MMA(1, 0, At, B0); PG8_BAR; PG8_SCHED;
            PG8_STAGE(PG8_SB(0, 1), b2 + hstep, voffB);
            PG8_WAIT_V(6); PG8_BAR; PG8_MMA(1, 1, At, B1); PG8_BAR;
            PG8_LDB(B0, 1, 0); PG8_SCHED; PG8_LDA(At, 1, 0); PG8_STAGE(PG8_SA(0, 1), a2 + hstep, voffA);
            PG8_WAIT_L(8); PG8_BAR; PG8_WAIT_L(0); PG8_MMA(0, 0, At, B0); PG8_BAR; PG8_SCHED;
            PG8_LDB(B1, 1, 1); PG8_STAGE(PG8_SB(1, 0), b3, voffB);
            PG8_BAR; PG8_WAIT_L(0); PG8_MMA(0, 1, At, B1); PG8_BAR;
            PG8_LDA(At, 1, 1); PG8_STAGE(PG8_SA(1, 0), a3, voffA);
            PG8_BAR; PG8_WAIT_L(0); PG8_MMA(1, 0, At, B0); PG8_BAR; PG8_SCHED;
            PG8_STAGE(PG8_SB(1, 1), b3 + hstep, voffB);
            PG8_WAIT_V(6); PG8_BAR; PG8_MMA(1, 1, At, B1); PG8_BAR;
        }
        PG8_STAMP();
        if constexpr (!Epi::AFTER_DRAIN) { E(acc, cur, wr, wc, fr, fq); S.done(cur); }
        PG8_STAMP();
        if (!has_next) break;
#pragma unroll
        for (int a = 0; a < 2; ++a)
#pragma unroll
            for (int b = 0; b < 2; ++b)
#pragma unroll
                for (int m = 0; m < 4; ++m)
#pragma unroll
                    for (int n = 0; n < 2; ++n) acc[a][b][m][n] = (f32x4){0.f, 0.f, 0.f, 0.f};
        cur = nxt; cA = nA; cB = nB; ++ui;
    }
    PG8_WAIT_V(0);
    if (wr == 0) PG8_BAR;
    PG8_BAR;
    if constexpr (Epi::AFTER_DRAIN) { E.fused(acc, cur, wr, wc, fr, fq, lds, wid, lane); S.done(cur); }
    PG8_STAMP();
    if (STAMP && wid == 0) { stamps[lane] = lane < nts ? (((unsigned long long)(unsigned)ts_hi << 32) | (unsigned)ts_lo) : 0ull;
        if (lane == 62) stamps[62] = rt_entry; if (lane == 63) stamps[63] = (unsigned long long)wall_clock64(); }
#undef PG8_STAMP
#undef PG8_SA
#undef PG8_SB
#undef PG8_STAGE
#undef PG8_LDA
#undef PG8_LDB
#undef PG8_MMA
#undef PG8_WAIT_V
#undef PG8_WAIT_L
#undef PG8_BAR
#undef PG8_SCHED
}
}
#define XB_TMO      128
#define XB_XCNT(j)  (256  + 64 * (j))
#define XB_XSUB(j)  (1280 + 64 * (j))
#define XB_XGEN(j)  (2304 + 64 * (j))
#define XB_TOP      3328
#define XB_TOPGEN   3392
#define XCD_BAR_WORDS 3456
#define XB_SPIN_CAP (1u << 18)
#define LAS __attribute__((address_space(3)))

__device__ __forceinline__ unsigned xb_ld(unsigned* p)              { return __hip_atomic_load(p, __ATOMIC_RELAXED, __HIP_MEMORY_SCOPE_AGENT); }
__device__ __forceinline__ unsigned xb_add(unsigned* p, unsigned v) { return __hip_atomic_fetch_add(p, v, __ATOMIC_RELAXED, __HIP_MEMORY_SCOPE_AGENT); }
__device__ __forceinline__ unsigned xb_xcc_id() { return (unsigned)__builtin_amdgcn_s_getreg((3 << 11) | 20) & 0xFu; }
#define XB_SPIN(cond, bar) do { unsigned _sp = 0; while (cond) { __builtin_amdgcn_s_sleep(1); \
    if ((++_sp & 255u) == 0u) { if (xb_ld(&(bar)[XB_TMO])) break; if (_sp > XB_SPIN_CAP) { atomicAdd(&(bar)[XB_TMO], 1u); break; } } } } while (0)

struct XcdBarrier {
    unsigned* bar; unsigned x;
    volatile LAS unsigned* st;
};

__device__ __forceinline__ XcdBarrier xcd_barrier_post(unsigned* bar, volatile LAS unsigned* st) {
    XcdBarrier b; b.bar = bar; b.x = xb_xcc_id(); b.st = st;
    if (threadIdx.x == 0) (void)xb_add(&bar[XB_XCNT(b.x)], 1u);
    return b;
}
__device__ __forceinline__ void xcd_barrier_complete(unsigned* bar, unsigned x, unsigned& nloc, unsigned& nx) {
    const unsigned G = gridDim.x * gridDim.y * gridDim.z;
    unsigned sum, cnt, mine, sp = 0u;
    for (;;) {
        sum = 0u; cnt = 0u; mine = 0u;
#pragma unroll
        for (unsigned j = 0; j < 16; ++j) { const unsigned c = xb_ld(&bar[XB_XCNT(j)]); sum += c; cnt += (c > 0u) ? 1u : 0u; mine = (j == x) ? c : mine; }
        if (sum == G) break;
        __builtin_amdgcn_s_sleep(1);
        if ((++sp & 255u) == 0u) { if (xb_ld(&bar[XB_TMO])) break; if (sp > XB_SPIN_CAP) { atomicAdd(&bar[XB_TMO], 1u); break; } }
    }
    nloc = mine > 0u ? mine : 1u; nx = cnt > 0u ? cnt : 1u;
}

__device__ __forceinline__ void xcd_barrier(const XcdBarrier& b) {
    asm volatile("s_waitcnt vmcnt(0)" ::: "memory");
    __syncthreads();
    if (threadIdx.x == 0) {
        unsigned* bar = b.bar;
        __builtin_amdgcn_s_waitcnt(0);
        unsigned nloc = b.st[0], nx = b.st[1];
        if (nloc == 0u) { xcd_barrier_complete(bar, b.x, nloc, nx); b.st[0] = nloc; b.st[1] = nx; }
        const unsigned old = xb_add(&bar[XB_XSUB(b.x)], 1u);
        const unsigned gen = old / nloc;
        if (old + 1u == (gen + 1u) * nloc) {
            __builtin_amdgcn_fence(__ATOMIC_RELEASE, "agent");
            asm volatile("s_waitcnt vmcnt(0)" ::: "memory");
            const unsigned og = xb_add(&bar[XB_TOP], 1u);
            const unsigned tg = og / nx;
            if (og + 1u == (tg + 1u) * nx) xb_add(&bar[XB_TOPGEN], 1u);
            else XB_SPIN(xb_ld(&bar[XB_TOPGEN]) == tg, bar);
            __builtin_amdgcn_fence(__ATOMIC_ACQUIRE, "agent");
            xb_add(&bar[XB_XGEN(b.x)], 1u);
            asm volatile("s_waitcnt vmcnt(0)" ::: "memory");
        } else {
            XB_SPIN(xb_ld(&bar[XB_XGEN(b.x)]) == gen, bar);
            __builtin_amdgcn_fence(__ATOMIC_ACQUIRE, "agent");
            asm volatile("s_waitcnt vmcnt(0)" ::: "memory");
        }
    }
    __syncthreads();
}

namespace mk {
using pg8::bf16_t; using pg8::bf16x8; using pg8::f32x4; using pg8::u32x4;
typedef unsigned u32x2 __attribute__((ext_vector_type(2)));
typedef __bf16 bf16x2_t __attribute__((ext_vector_type(2)));
typedef LAS unsigned char* lds_t;

constexpr int DM = 1024, NLAT = 16384, NROW = 16896;
constexpr int OFF_B = 512, OFF_C = 1024, OFF_D = 2056, INC = 3208, NP = 3328;
constexpr int NCH = 132, NSLOT = 16 * NCH;
constexpr int NEXP = 16384;

constexpr size_t WS_CTL  = 0;
constexpr size_t WS_MOD  = 65536;
constexpr size_t WS_WIN  = WS_MOD + 147456;
constexpr size_t WS_WOUT = WS_WIN + 2ull * NP * DM * 2;
constexpr size_t WS_WQ   = WS_WOUT + 2ull * DM * DM * 2;
constexpr size_t WS_H    = WS_WQ + 2ull * 2048 * DM * 2;
constexpr size_t WS_ACT  = WS_H + (size_t)NROW * DM * 4;
constexpr size_t WS_UB   = WS_ACT + (size_t)NROW * DM * 2;
constexpr size_t WS_VB   = WS_UB + (size_t)NEXP * DM * 2;
constexpr size_t WS_SU   = WS_UB + (size_t)NEXP * DM;
constexpr size_t WS_SV   = WS_VB + (size_t)NEXP * DM;
constexpr size_t WS_P    = WS_VB + (size_t)NEXP * DM * 2;
constexpr size_t WS_Q    = WS_P;
constexpr size_t WS_SELI = WS_Q + (size_t)NROW * 2048 * 2;
constexpr size_t WS_SELG = WS_SELI + (size_t)NROW * 128 * 4;
constexpr size_t WS_MST  = WS_P + (size_t)NROW * NP * 2;
constexpr size_t WS_MCD  = WS_MST + (size_t)NSLOT * 8192 * 4;
constexpr size_t WS_RG   = WS_MCD + 16384;
constexpr size_t WS_RJ   = WS_RG + (size_t)NSLOT * 8192;
constexpr size_t WS_RY   = WS_RJ + (size_t)NSLOT * 16384;
constexpr size_t WS_RL   = WS_RY + (size_t)NSLOT * 8192;
constexpr size_t WS_RH   = WS_RL + (size_t)NSLOT * 8192;
constexpr size_t WS_BON  = WS_RH + (size_t)NSLOT * 8192;
constexpr size_t WS_END  = WS_BON + (size_t)NROW * 8 * 4;
static_assert(WS_SELG + (size_t)NROW * 128 * 4 <= WS_MST, "Q + selections must fit in P's region");

constexpr int LDS_BYTES = 157440;
constexpr int LDS_XB = 157184;

struct Args { const float* in[42]; float* out; unsigned char* ws; int ph_lo, ph_hi; };

struct Ctx {
    const float* const* in; float* out; unsigned char* ws; lds_t lds;
    int tid, lane, wid, bid, G;
};

__device__ __forceinline__ float bf2f(unsigned short x) { return __uint_as_float(((unsigned)x) << 16); }
__device__ __forceinline__ float bflo(unsigned w) { return __uint_as_float(w << 16); }
__device__ __forceinline__ float bfhi(unsigned w) { return __uint_as_float(w & 0xffff0000u); }
__device__ __forceinline__ unsigned pk2(float lo, float hi) { return pg8::cvt_pk_bf16(lo, hi); }
__device__ __forceinline__ unsigned short f2bf(float f) { return (unsigned short)(pk2(f, 0.f) & 0xffffu); }
__device__ __forceinline__ float wave_sum(float v) {
#pragma unroll
    for (int o = 1; o < 64; o <<= 1) v += __shfl_xor(v, o);
    return v;
}
__device__ __forceinline__ float sigm(float x) { return 1.f / (1.f + expf(-x)); }
__device__ __forceinline__ float silu(float x) { return x / (1.f + expf(-x)); }
__device__ __forceinline__ float softplus(float x) { return fmaxf(x, 0.f) + log1pf(expf(-fabsf(x))); }
__device__ __forceinline__ float gelu_tanh(float x) { const float u = 0.7978845608028654f * (x + 0.044715f * x * x * x); return 0.5f * x * (1.f + tanhf(u)); }
__device__ __forceinline__ float dot2bf(unsigned a, unsigned b, float acc) { return __builtin_amdgcn_fdot2_f32_bf16(__builtin_bit_cast(bf16x2_t, a), __builtin_bit_cast(bf16x2_t, b), acc, false); }

struct ChunkInfo { int row0, lo, hi, b, tc, isctx; };
__device__ __forceinline__ ChunkInfo chunk_info(int gc) {
    ChunkInfo c; c.row0 = gc * 64;
    if (gc < 256) { c.b = gc >> 7; c.tc = gc & 127; c.isctx = 0; c.lo = c.b * 8192; c.hi = c.lo + 8192; }
    else { const int q = gc - 256; c.b = q >> 2; c.tc = q & 3; c.isctx = 1; c.lo = NLAT + c.b * 256; c.hi = c.lo + 256; }
    return c;
}
__device__ __forceinline__ int cpos_of(const ChunkInfo& c, int d) { return c.isctx ? (d ? 3 - c.tc : c.tc) : (d ? 4 + 127 - c.tc : 4 + c.tc); }
__device__ __forceinline__ int slot_of(int b, int h, int d, int cpos) { return ((b * 4 + h) * 2 + d) * NCH + cpos; }

template <int MT, int NT, int KS, class Epi>
__device__ __forceinline__ void blk_mma(const LAS bf16_t* A, int lda, const LAS bf16_t* Bt, int ldb, int wid, int lane, Epi epi) {
    const int fr = lane & 15, fq = lane >> 4;
    for (int tt = wid; tt < MT * NT; tt += 8) {
        const int tm = tt / NT, tn = tt % NT;
        f32x4 acc = {0.f, 0.f, 0.f, 0.f};
#pragma unroll
        for (int ks = 0; ks < KS; ++ks) {
            const bf16x8 a = *(const LAS bf16x8*)(A + (tm * 16 + fr) * lda + ks * 32 + fq * 8);
            const bf16x8 b = *(const LAS bf16x8*)(Bt + (tn * 16 + fr) * ldb + ks * 32 + fq * 8);
            acc = __builtin_amdgcn_mfma_f32_16x16x32_bf16(a, b, acc, 0, 0, 0);
        }
        epi(tm * 16 + fq * 4, tn * 16 + fr, acc);
    }
}
template <int MT, int NT, int KS, class Epi>
__device__ __forceinline__ void blk_mma2(const LAS bf16_t* A1, const LAS bf16_t* B1, const LAS bf16_t* A2, const LAS bf16_t* B2, int ld, int wid, int lane, Epi epi) {
    const int fr = lane & 15, fq = lane >> 4;
    for (int tt = wid; tt < MT * NT; tt += 8) {
        const int tm = tt / NT, tn = tt % NT;
        f32x4 acc1 = {0.f, 0.f, 0.f, 0.f}, acc2 = {0.f, 0.f, 0.f, 0.f};
#pragma unroll
        for (int ks = 0; ks < KS; ++ks) {
            const bf16x8 a1 = *(const LAS bf16x8*)(A1 + (tm * 16 + fr) * ld + ks * 32 + fq * 8);
            const bf16x8 b1 = *(const LAS bf16x8*)(B1 + (tn * 16 + fr) * ld + ks * 32 + fq * 8);
            acc1 = __builtin_amdgcn_mfma_f32_16x16x32_bf16(a1, b1, acc1, 0, 0, 0);
            const bf16x8 a2 = *(const LAS bf16x8*)(A2 + (tm * 16 + fr) * ld + ks * 32 + fq * 8);
            const bf16x8 b2 = *(const LAS bf16x8*)(B2 + (tn * 16 + fr) * ld + ks * 32 + fq * 8);
            acc2 = __builtin_amdgcn_mfma_f32_16x16x32_bf16(a2, b2, acc2, 0, 0, 0);
        }
        epi(tm * 16 + fq * 4, tn * 16 + fr, acc1, acc2);
    }
}

__device__ __forceinline__ void transpose_item(const float* W, int K, int N, int nblk, bf16_t* WT, LAS float* scr, int item, int lane) {
    const int kb = item / nblk, nb = item % nblk, k0 = 64 * kb, n0 = 32 * nb;
    const int nn = n0 + (lane & 31);
#pragma unroll 8
    for (int i = 0; i < 32; ++i) { const int kk = 2 * i + (lane >> 5); scr[kk * 33 + (lane & 31)] = (nn < N) ? W[(size_t)(k0 + kk) * N + nn] : 0.f; }
    asm volatile("s_waitcnt lgkmcnt(0)" ::: "memory");
    const int c = lane & 7;
#pragma unroll
    for (int j = 0; j < 4; ++j) { const int n = (lane >> 3) + 8 * j; const LAS float* s = scr + (8 * c) * 33 + n;
        u32x4 o; o.x = pk2(s[0 * 33], s[1 * 33]); o.y = pk2(s[2 * 33], s[3 * 33]); o.z = pk2(s[4 * 33], s[5 * 33]); o.w = pk2(s[6 * 33], s[7 * 33]);
        *(u32x4*)(WT + (size_t)(n0 + n) * K + k0 + 8 * c) = o; }
    asm volatile("s_waitcnt lgkmcnt(0)" ::: "memory");
}
__device__ __forceinline__ float wave_maxf(float v) {
#pragma unroll
    for (int o = 1; o < 64; o <<= 1) v = fmaxf(v, __shfl_xor(v, o));
    return v;
}
__device__ __forceinline__ void convert_tables(const Ctx& C, int layer) {
    const float* U = C.in[39] + (size_t)layer * NEXP * DM; const float* V = C.in[40] + (size_t)layer * NEXP * DM;
    unsigned char* UB = C.ws + WS_UB; unsigned char* VB = C.ws + WS_VB; float* SU = (float*)(C.ws + WS_SU); float* SV = (float*)(C.ws + WS_SV);
    for (int r = C.bid * 8 + C.wid; r < 2 * NEXP; r += C.G * 8) {
        const bool isv = r >= NEXP; const int row = isv ? r - NEXP : r;
        const float* src = (isv ? V : U) + (size_t)row * DM + 16 * C.lane;
        f32x4 x[4]; float m = 0.f;
#pragma unroll
        for (int k = 0; k < 4; ++k) { x[k] = *(const f32x4*)(src + 4 * k); m = fmaxf(fmaxf(m, fmaxf(fabsf(x[k].x), fabsf(x[k].y))), fmaxf(fabsf(x[k].z), fabsf(x[k].w))); }
        m = wave_maxf(m);
        const float sc = m > 0.f ? 224.f / m : 1.f;
        u32x4 o;
#pragma unroll
        for (int k = 0; k < 4; ++k) { int w = __builtin_amdgcn_cvt_pk_fp8_f32(x[k].x * sc, x[k].y * sc, 0, false); w = __builtin_amdgcn_cvt_pk_fp8_f32(x[k].z * sc, x[k].w * sc, w, true); o[k] = (unsigned)w; }
        *(u32x4*)((isv ? VB : UB) + (size_t)row * DM + 16 * C.lane) = o;
        if (C.lane == 0) (isv ? SV : SU)[row] = m > 0.f ? m * (1.f / 224.f) : 1.f;
    }
}
__device__ __forceinline__ void ph_prologue(const Ctx& C) {
    const int gw = C.bid * 8 + C.wid, NGW = C.G * 8;
    {
        LAS float* scr = (LAS float*)(C.lds + C.wid * 16384);
        bf16_t* WIN = (bf16_t*)(C.ws + WS_WIN); bf16_t* WOUT = (bf16_t*)(C.ws + WS_WOUT); bf16_t* WQ = (bf16_t*)(C.ws + WS_WQ);
        for (int it = gw; it < 6400; it += NGW) {
            const int layer = it / 3200; int r = it % 3200;
            if (r < 1664) { transpose_item(C.in[8] + (size_t)layer * DM * INC, DM, INC, 104, WIN + (size_t)layer * NP * DM, scr, r, C.lane); continue; } r -= 1664;
            if (r < 512) { transpose_item(C.in[9] + (size_t)layer * DM * DM, DM, DM, 32, WOUT + (size_t)layer * DM * DM, scr, r, C.lane); continue; } r -= 512;
            transpose_item(C.in[36] + (size_t)layer * DM * 2048, DM, 2048, 64, WQ + (size_t)layer * 2048 * DM, scr, r, C.lane);
        }
    }
    __syncthreads();
    {
        LAS float* sv = (LAS float*)C.lds;
        LAS float* red = (LAS float*)(C.lds + 12288);
        for (int i = C.tid; i < 3 * 1024; i += 512) { const int w = i >> 10, k = i & 1023; const float x = (w < 2) ? C.in[1][w * 1024 + k] : C.in[3][k]; sv[i] = silu(x); }
        __syncthreads();
        float* MOD = (float*)(C.ws + WS_MOD);
        for (int it = C.bid; it < 192; it += C.G) {
            const int layer = it / 96, col0 = (it % 96) * 64, col = C.tid & 63, kg = C.tid >> 6;
            const float* W = C.in[4] + (size_t)layer * DM * 6144 + col0 + col;
            float a0 = 0.f, a1 = 0.f, a2 = 0.f;
#pragma unroll 8
            for (int k = kg * 128; k < kg * 128 + 128; ++k) { const float w = W[(size_t)k * 6144]; a0 += sv[k] * w; a1 += sv[1024 + k] * w; a2 += sv[2048 + k] * w; }
            red[(kg * 3 + 0) * 64 + col] = a0; red[(kg * 3 + 1) * 64 + col] = a1; red[(kg * 3 + 2) * 64 + col] = a2;
            __syncthreads();
            if (C.tid < 192) { const int w = C.tid >> 6, c2 = C.tid & 63; float s = 0.f;
#pragma unroll
                for (int g = 0; g < 8; ++g) s += red[(g * 3 + w) * 64 + c2];
                MOD[((size_t)layer * 3 + w) * 6144 + col0 + c2] = s + C.in[5][layer * 6144 + col0 + c2]; }
            __syncthreads();
        }
    }
    {
        float* H = (float*)(C.ws + WS_H);
        const size_t n4 = (size_t)NROW * 256;
        for (size_t i = (size_t)C.bid * 512 + C.tid; i < n4; i += (size_t)C.G * 512) {
            const int row = (int)(i >> 8), c4 = (int)(i & 255) * 4;
            f32x4 v;
            if (row < NLAT) {
                v = *(const f32x4*)(C.in[0] + (size_t)row * DM + c4);
                const int t = row & 8191, quarter = c4 >> 8; const float pos = (quarter < 2) ? (float)(t >> 6) : (float)(t & 63);
                float e[4];
#pragma unroll
                for (int j = 0; j < 4; ++j) { const int jj = (c4 & 255) + j; const float fr = exp2f(-(float)jj * (13.287712379549449f / 256.f)); const float a = pos * fr; e[j] = (quarter & 1) ? cosf(a) : sinf(a); }
                v.x += e[0]; v.y += e[1]; v.z += e[2]; v.w += e[3];
            } else v = *(const f32x4*)(C.in[2] + (size_t)(row - NLAT) * DM + c4);
            *(f32x4*)(H + (size_t)row * DM + c4) = v;
        }
    }
    convert_tables(C, 0);
}

struct Row16 { float v[16]; };
__device__ __forceinline__ Row16 load_row16(const float* p, int lane) {
    Row16 r; const f32x4 a = *(const f32x4*)(p + 8 * lane), b = *(const f32x4*)(p + 8 * lane + 4), c = *(const f32x4*)(p + 512 + 8 * lane), d = *(const f32x4*)(p + 512 + 8 * lane + 4);
    r.v[0] = a.x; r.v[1] = a.y; r.v[2] = a.z; r.v[3] = a.w; r.v[4] = b.x; r.v[5] = b.y; r.v[6] = b.z; r.v[7] = b.w;
    r.v[8] = c.x; r.v[9] = c.y; r.v[10] = c.z; r.v[11] = c.w; r.v[12] = d.x; r.v[13] = d.y; r.v[14] = d.z; r.v[15] = d.w; return r;
}
__device__ __forceinline__ void store_row16_f32(float* p, int lane, const Row16& r) {
    *(f32x4*)(p + 8 * lane) = (f32x4){r.v[0], r.v[1], r.v[2], r.v[3]}; *(f32x4*)(p + 8 * lane + 4) = (f32x4){r.v[4], r.v[5], r.v[6], r.v[7]};
    *(f32x4*)(p + 512 + 8 * lane) = (f32x4){r.v[8], r.v[9], r.v[10], r.v[11]}; *(f32x4*)(p + 512 + 8 * lane + 4) = (f32x4){r.v[12], r.v[13], r.v[14], r.v[15]};
}
__device__ __forceinline__ void store_row16_bf16(bf16_t* p, int lane, const Row16& r) {
    u32x4 a, b; a.x = pk2(r.v[0], r.v[1]); a.y = pk2(r.v[2], r.v[3]); a.z = pk2(r.v[4], r.v[5]); a.w = pk2(r.v[6], r.v[7]);
    b.x = pk2(r.v[8], r.v[9]); b.y = pk2(r.v[10], r.v[11]); b.z = pk2(r.v[12], r.v[13]); b.w = pk2(r.v[14], r.v[15]);
    *(u32x4*)(p + 8 * lane) = a; *(u32x4*)(p + 512 + 8 * lane) = b;
}
__device__ __forceinline__ Row16 norm_mod_row(const Row16& x, const float* g, const float* shift, const float* scale, int lane) {
    float ss = 0.f;
#pragma unroll
    for (int i = 0; i < 16; ++i) ss += x.v[i] * x.v[i];
    const float rs = rsqrtf(wave_sum(ss) * (1.f / 1024.f) + 1e-6f);
    const Row16 gg = load_row16(g, lane), sh = load_row16(shift, lane), sc = load_row16(scale, lane);
    Row16 o;
#pragma unroll
    for (int i = 0; i < 16; ++i) o.v[i] = (x.v[i] * rs * gg.v[i]) * (1.f + sc.v[i]) + sh.v[i];
    return o;
}
__device__ __forceinline__ int which_of(int row) { return row < 8192 ? 0 : (row < NLAT ? 1 : 2); }
__device__ __forceinline__ void ph_norm(const Ctx& C, int layer, const float* gain, int sidx, int nrows) {
    const float* H = (const float*)(C.ws + WS_H); bf16_t* ACT = (bf16_t*)(C.ws + WS_ACT); const float* MOD = (const float*)(C.ws + WS_MOD);
    for (int row = C.bid * 8 + C.wid; row < nrows; row += C.G * 8) {
        const float* m = MOD + ((size_t)layer * 3 + which_of(row)) * 6144;
        const Row16 x = load_row16(H + (size_t)row * DM, C.lane);
        const Row16 o = norm_mod_row(x, gain, m + sidx * 1024, m + (sidx + 1) * 1024, C.lane);
        store_row16_bf16(ACT + (size_t)row * DM, C.lane, o);
    }
}
struct EpiResid {
    static constexpr bool PERM = false, AFTER_DRAIN = false;
    float* H; const float* modl;
    __device__ __forceinline__ void operator()(const f32x4 (&acc)[2][2][4][2], const pg8::Unit& u, int wr, int wc, int fr, int fq) const {
        const int row0 = u.pm * 256 + wr * 64 + fr, col0 = u.pn * 256 + wc * 32 + 4 * fq;
        const int which = u.pm < 32 ? 0 : (u.pm < 64 ? 1 : 2);
        const float* gate = modl + ((size_t)which * 6 + 2) * 1024;
        f32x4 gv[2][2];
#pragma unroll
        for (int bj = 0; bj < 2; ++bj)
#pragma unroll
            for (int n = 0; n < 2; ++n) gv[bj][n] = *(const f32x4*)(gate + col0 + bj * 128 + n * 16);
#pragma unroll
        for (int ai = 0; ai < 2; ++ai)
#pragma unroll
            for (int m = 0; m < 4; ++m) { float* rowp = H + (size_t)(row0 + ai * 128 + m * 16) * DM + col0;
#pragma unroll
                for (int bj = 0; bj < 2; ++bj)
#pragma unroll
                    for (int n = 0; n < 2; ++n) { f32x4* p = (f32x4*)(rowp + bj * 128 + n * 16); *p = *p + gv[bj][n] * acc[ai][bj][m][n]; } }
    }
};

__device__ __forceinline__ void item_conformer(const Ctx& C, int layer, int gc) {
    const ChunkInfo ci = chunk_info(gc);
    const bf16_t* P = (const bf16_t*)(C.ws + WS_P); bf16_t* YC = (bf16_t*)(C.ws + WS_ACT);
    LAS bf16_t* HG = (LAS bf16_t*)C.lds;
    LAS float* CO = (LAS float*)(C.lds + 49152);
    for (int e = C.tid; e < 94 * 128; e += 512) {
        const int rr = e >> 7, cp = e & 127, grow = ci.row0 - 15 + rr;
        unsigned o = 0u;
        if (grow >= ci.lo && grow < ci.hi) {
            const unsigned v = *(const unsigned*)(P + (size_t)grow * NP + 2 * cp), g = *(const unsigned*)(P + (size_t)grow * NP + 256 + 2 * cp);
            o = pk2(bflo(v) * sigm(bflo(g)), bfhi(v) * sigm(bfhi(g)));
        }
        *(LAS unsigned*)(HG + rr * 256 + 2 * cp) = o;
    }
    __syncthreads();
    {
        const int c = C.tid & 255, half = C.tid >> 8;
        const float* cw = C.in[10] + (size_t)layer * 31 * 256 + c;
        float w[31];
#pragma unroll
        for (int j = 0; j < 31; ++j) w[j] = cw[j * 256];
        const float bias = C.in[11][layer * 256 + c];
        for (int tt = 0; tt < 32; ++tt) {
            const int t = half * 32 + tt; float acc = bias;
#pragma unroll
            for (int j = 0; j < 31; ++j) acc += w[j] * bf2f(HG[(t + j) * 256 + c]);
            CO[t * 256 + c] = acc;
        }
    }
    __syncthreads();
    {
        const float* lg = C.in[12] + layer * 256 + 4 * C.lane; const float* lb = C.in[13] + layer * 256 + 4 * C.lane;
        const f32x4 g4 = *(const f32x4*)lg, b4 = *(const f32x4*)lb;
        for (int i = 0; i < 8; ++i) {
            const int t = C.wid * 8 + i;
            const f32x4 x = *(const LAS f32x4*)(CO + t * 256 + 4 * C.lane);
            const float mean = wave_sum((x.x + x.y) + (x.z + x.w)) * (1.f / 256.f);
            const f32x4 d = x - mean;
            const float var = wave_sum((d.x * d.x + d.y * d.y) + (d.z * d.z + d.w * d.w)) * (1.f / 256.f);
            const float rs = rsqrtf(var + 1e-5f);
            const f32x4 y = d * rs * g4 + b4;
            u32x2 o; o.x = pk2(silu(y.x), silu(y.y)); o.y = pk2(silu(y.z), silu(y.w));
            *(u32x2*)(YC + (size_t)(ci.row0 + t) * DM + 4 * C.lane) = o;
        }
    }
    __syncthreads();
}

__device__ __forceinline__ void item_chunkmlp(const Ctx& C, int layer, int gb) {
    const int row0 = gb * 128;
    const bf16_t* P = (const bf16_t*)(C.ws + WS_P); bf16_t* YC = (bf16_t*)(C.ws + WS_ACT);
    LAS bf16_t* VNT = (LAS bf16_t*)C.lds;
    LAS bf16_t* WS = (LAS bf16_t*)(C.lds + 69632);
    {
        const f32x4 g4 = *(const f32x4*)(C.in[14] + layer * 256 + 4 * C.lane), b4 = *(const f32x4*)(C.in[15] + layer * 256 + 4 * C.lane);
        for (int i = 0; i < 16; ++i) {
            const int j = C.wid * 16 + i;
            const u32x2 raw = *(const u32x2*)(P + (size_t)(row0 + j) * NP + 768 + 4 * C.lane);
            const f32x4 x = {bflo(raw.x), bfhi(raw.x), bflo(raw.y), bfhi(raw.y)};
            const float mean = wave_sum((x.x + x.y) + (x.z + x.w)) * (1.f / 256.f);
            const f32x4 d = x - mean;
            const float var = wave_sum((d.x * d.x + d.y * d.y) + (d.z * d.z + d.w * d.w)) * (1.f / 256.f);
            const f32x4 y = d * rsqrtf(var + 1e-5f) * g4 + b4;
            VNT[(4 * C.lane + 0) * 136 + j] = f2bf(y.x); VNT[(4 * C.lane + 1) * 136 + j] = f2bf(y.y);
            VNT[(4 * C.lane + 2) * 136 + j] = f2bf(y.z); VNT[(4 * C.lane + 3) * 136 + j] = f2bf(y.w);
        }
    }
    for (int h = 0; h < 4; ++h) {
        const float* ws = C.in[16] + ((size_t)layer * 4 + h) * 128 * 128;
        for (int e = C.tid; e < 4096; e += 512) { const int i = e >> 5, j4 = (e & 31) * 4; const f32x4 w = *(const f32x4*)(ws + i * 128 + j4);
            u32x2 o; o.x = pk2(w.x, w.y); o.y = pk2(w.z, w.w); *(LAS u32x2*)(WS + i * 136 + j4) = o; }
        __syncthreads();
        const float* bs = C.in[17] + ((size_t)layer * 4 + h) * 128;
        blk_mma<8, 4, 4>(WS, 136, VNT + h * 64 * 136, 136, C.wid, C.lane, [=](int r0, int col, const f32x4& acc) {
#pragma unroll
            for (int jj = 0; jj < 4; ++jj) { const int i = r0 + jj; const size_t row = (size_t)(row0 + i);
                const float u = bf2f(P[row * NP + 512 + h * 64 + col]);
                YC[row * DM + 256 + h * 64 + col] = f2bf((acc[jj] + bs[i]) * u); }
        });
        __syncthreads();
    }
}

__device__ __forceinline__ void item_mamba_local(const Ctx& C, int layer, int gc) {
    const ChunkInfo ci = chunk_info(gc);
    const bf16_t* P = (const bf16_t*)(C.ws + WS_P);
    float* MST = (float*)(C.ws + WS_MST); float* MCD = (float*)(C.ws + WS_MCD);
    LAS float* DA = (LAS float*)C.lds;
    LAS float* DT = (LAS float*)(C.lds + 2048);
    LAS float* FAC = (LAS float*)(C.lds + 4096);
    LAS bf16_t* XDT = (LAS bf16_t*)(C.lds + 8192);
    LAS bf16_t* BTT = (LAS bf16_t*)(C.lds + 8192 + 73728);
    {
        const int s = C.tid >> 3, dh = C.tid & 7, d = dh >> 2, h = dh & 3;
        const float raw = bf2f(P[(size_t)(ci.row0 + s) * NP + OFF_C + 1024 + dh]);
        const float dt = softplus(raw + C.in[20][layer * 8 + dh]);
        DT[dh * 64 + s] = dt; DA[dh * 64 + s] = dt * (-expf(C.in[21][layer * 8 + dh]));
        (void)d; (void)h;
    }
    __syncthreads();
    if (C.tid < 8) {
        const int dh = C.tid, d = dh >> 2, h = dh & 3; float run = 0.f;
        if (d == 0) { for (int s = 63; s >= 0; --s) { FAC[dh * 64 + s] = expf(run); run += DA[dh * 64 + s]; } }
        else { for (int s = 0; s < 64; ++s) { FAC[dh * 64 + s] = expf(run); run += DA[dh * 64 + s]; } }
        MCD[slot_of(ci.b, h, d, cpos_of(ci, d))] = expf(run);
    }
    __syncthreads();
    {
        const int cp = C.tid & 255, half = C.tid >> 8, c0 = 2 * cp;
        const float* cw = C.in[18] + (size_t)layer * 5 * 768 + c0; const float* cb = C.in[19] + layer * 768 + c0;
        float w0[5], w1[5];
#pragma unroll
        for (int j = 0; j < 5; ++j) { w0[j] = cw[j * 768]; w1[j] = cw[j * 768 + 1]; }
        const float b0 = cb[0], b1 = cb[1];
        const int s0 = half * 32;
        unsigned win[5];
#pragma unroll
        for (int j = 0; j < 4; ++j) { const int row = ci.row0 + s0 - 2 + j; win[j + 1] = (row >= ci.lo && row < ci.hi) ? *(const unsigned*)(P + (size_t)row * NP + OFF_C + 256 + c0) : 0u; }
        for (int tt = 0; tt < 32; ++tt) {
            const int s = s0 + tt;
#pragma unroll
            for (int j = 0; j < 4; ++j) win[j] = win[j + 1];
            { const int row = ci.row0 + s + 2; win[4] = (row >= ci.lo && row < ci.hi) ? *(const unsigned*)(P + (size_t)row * NP + OFF_C + 256 + c0) : 0u; }
            float a0 = b0, a1 = b1;
#pragma unroll
            for (int j = 0; j < 5; ++j) { a0 += w0[j] * bflo(win[j]); a1 += w1[j] * bfhi(win[j]); }
            a0 = silu(a0); a1 = silu(a1);
            if (c0 < 256) { const int h = c0 >> 6;
#pragma unroll
                for (int d = 0; d < 2; ++d) { const float f = DT[(d * 4 + h) * 64 + s] * FAC[(d * 4 + h) * 64 + s];
                    XDT[(d * 256 + c0) * 72 + s] = f2bf(a0 * f); XDT[(d * 256 + c0 + 1) * 72 + s] = f2bf(a1 * f); }
            } else { const int q = c0 - 256; BTT[q * 72 + s] = f2bf(a0); BTT[(q + 1) * 72 + s] = f2bf(a1); }
        }
    }
    __syncthreads();
    for (int hd = 0; hd < 8; ++hd) {
        const int d = hd >> 2, h = hd & 3;
        float* dst = MST + (size_t)slot_of(ci.b, h, d, cpos_of(ci, d)) * 8192;
        blk_mma<4, 8, 2>(XDT + (d * 256 + h * 64) * 72, 72, BTT + (h >> 1) * 128 * 72, 72, C.wid, C.lane, [=](int r0, int col, const f32x4& acc) {
#pragma unroll
            for (int jj = 0; jj < 4; ++jj) dst[(r0 + jj) * 128 + col] = acc[jj];
        });
    }
    __syncthreads();
}


#ifndef MK_DIAG2
#define MK_DIAG2 1
#endif
#if MK_DIAG2
#define DBGF(stage, cond) do { if (cond) atomicOr((unsigned*)(C.ws + 32768) + (stage), 1u); } while (0)
#define DBGL(stage, cond) do { if (cond) atomicOr(dbgflags + (stage), 1u); } while (0)
#else
#define DBGF(stage, cond) do {} while (0)
#define DBGL(stage, cond) do {} while (0)
#endif
__device__ __forceinline__ bool badv(float x, float lim) { return !(fabsf(x) < lim); }
__device__ __forceinline__ void tri_inverse(const LAS float* ABf, LAS float* Tf, LAS float* Rt, LAS bf16_t* TT, int tid, int wid, int lane) {
    if (wid == 0) {
        const int bi = lane >> 4, j = lane & 15; const LAS float* Ab = ABf + (16 * bi) * 68 + 16 * bi;
        float col[16];
#pragma unroll
        for (int r = 0; r < 16; ++r) { float acc = (r == j) ? 1.f : 0.f;
#pragma unroll
            for (int s = 0; s < r; ++s) acc -= Ab[r * 68 + s] * col[s];
            col[r] = acc; }
#pragma unroll
        for (int r = 0; r < 16; ++r) Tf[(16 * bi + r) * 68 + 16 * bi + j] = col[r];
    }
    __syncthreads();
    for (int i = 1; i < 4; ++i) {
        const int nc = 16 * i;
        for (int e = tid; e < 16 * nc; e += 512) { const int r = e / nc, c = e % nc; float sum = 0.f;
            for (int s2 = (c & ~15); s2 < nc; ++s2) sum += ABf[(nc + r) * 68 + s2] * Tf[s2 * 68 + c];
            Rt[r * 68 + c] = -sum; }
        __syncthreads();
        for (int e = tid; e < 16 * nc; e += 512) { const int r = e / nc, c = e % nc; float sum = 0.f;
            for (int r2 = 0; r2 <= r; ++r2) sum += Tf[(nc + r) * 68 + nc + r2] * Rt[r2 * 68 + c];
            Tf[(nc + r) * 68 + c] = sum; }
        __syncthreads();
    }
    for (int e = tid; e < 4096; e += 512) { const int t = e >> 6, s2 = e & 63; TT[t * 72 + s2] = ((s2 >> 4) <= (t >> 4)) ? f2bf(Tf[t * 68 + s2]) : (unsigned short)0; }
}
constexpr int D1_LW = 0, D1_CS = 17408, D1_AA = 34816, D1_RB = 52224, D1_KB = 61440, D1_VB = 70656, D1_TW = 79872, D1_AD = 89088, D1_W2T = 98304, D1_A2T = 107520;
constexpr int D1_Y = 82944;
constexpr int D1_ABF = 0, D1_AK = 17408, D1_ARK = 26624, D1_ARB = 35840, D1_TT = 45056, D1_W1T = 54272, D1_AKVT = 63488, D1_W2TT = 72704;
constexpr int D1_GL = 156672;
__device__ __forceinline__ void item_rwkv_local(const Ctx& C, int layer, int it) {
    const int gc = it >> 3, hd = it & 7, h = hd & 3, d = hd >> 2;
    const ChunkInfo ci = chunk_info(gc);
    const int slot = slot_of(ci.b, h, d, cpos_of(ci, d));
    const bf16_t* P = (const bf16_t*)(C.ws + WS_P);
    const float* mup = C.in[24] + layer * 1152; const float* mun = C.in[25] + layer * 1152;
    lds_t L = C.lds;
    LAS float* LW = (LAS float*)(L + D1_LW); LAS float* CS = (LAS float*)(L + D1_CS); LAS float* AA = (LAS float*)(L + D1_AA); LAS float* GL = (LAS float*)(L + D1_GL);
    LAS bf16_t* Rb = (LAS bf16_t*)(L + D1_RB); LAS bf16_t* Kb = (LAS bf16_t*)(L + D1_KB); LAS bf16_t* Vb = (LAS bf16_t*)(L + D1_VB);
    LAS bf16_t* TW = (LAS bf16_t*)(L + D1_TW); LAS bf16_t* AD = (LAS bf16_t*)(L + D1_AD); LAS bf16_t* W2T = (LAS bf16_t*)(L + D1_W2T); LAS bf16_t* A2T = (LAS bf16_t*)(L + D1_A2T);
    LAS bf16_t* KT = (LAS bf16_t*)(L + D1_Y); LAS bf16_t* KTt = KT + 4608; LAS bf16_t* KD = KT + 2 * 4608; LAS bf16_t* KDt = KT + 3 * 4608;
    LAS bf16_t* BT = KT + 4 * 4608; LAS bf16_t* BTt = KT + 5 * 4608; LAS bf16_t* RT = KT + 6 * 4608; LAS bf16_t* Vt = KT + 7 * 4608;
    LAS float* ABf = (LAS float*)(L + D1_ABF); LAS bf16_t* AK = (LAS bf16_t*)(L + D1_AK); LAS bf16_t* ARK = (LAS bf16_t*)(L + D1_ARK); LAS bf16_t* ARB = (LAS bf16_t*)(L + D1_ARB);
    LAS bf16_t* TT = (LAS bf16_t*)(L + D1_TT); LAS bf16_t* W1t = (LAS bf16_t*)(L + D1_W1T); LAS bf16_t* AKVt = (LAS bf16_t*)(L + D1_AKVT); LAS bf16_t* W2t = (LAS bf16_t*)(L + D1_W2TT);

#pragma unroll 4
    for (int e = C.tid; e < 64 * 160; e += 512) {
        const int l = e / 160, q = e % 160, grp = q >> 5, c = (q & 31) * 2;
        const int j = (grp == 0 ? h * 64 : grp == 1 ? 256 + h * 64 : grp == 2 ? 512 + h * 64 : grp == 3 ? 768 + d * 64 : 896 + d * 64) + c;
        const int row = ci.row0 + (d ? 63 - l : l);
        const bf16_t* pp = P + (size_t)row * NP + OFF_D + j;
        const unsigned x = *(const unsigned*)pp;
        const unsigned xp = (row - 1 >= ci.lo) ? *(const unsigned*)(pp - NP) : 0u, xn = (row + 1 < ci.hi) ? *(const unsigned*)(pp + NP) : 0u;
        const float x0 = bflo(x), x1 = bfhi(x);
        const float v0 = x0 + mup[j] * (bflo(xp) - x0) + mun[j] * (bflo(xn) - x0);
        const float v1 = x1 + mup[j + 1] * (bfhi(xp) - x1) + mun[j + 1] * (bfhi(xn) - x1);
        unsigned o;
        DBGF(1, badv(v0, 1e4f) || badv(v1, 1e4f));
        if (grp == 3) o = pk2(tanhf(v0), tanhf(v1)); else o = pk2(v0, v1);
        LAS bf16_t* dst = (grp == 0 ? Rb : grp == 1 ? Kb : grp == 2 ? Vb : grp == 3 ? TW : AD);
        *(LAS unsigned*)(dst + l * 72 + c) = o;
    }
    {
        const float* w2 = C.in[27] + ((size_t)layer * 2 + d) * 64 * 256 + h * 64; const float* a2 = C.in[29] + ((size_t)layer * 2 + d) * 64 * 256 + h * 64;
        for (int e = C.tid; e < 4096; e += 512) { const int r = e >> 6, c = e & 63; W2T[c * 72 + r] = f2bf(w2[r * 256 + c]); A2T[c * 72 + r] = f2bf(a2[r * 256 + c]); }
    }
    __syncthreads();
    {
        unsigned* dbgflags = (unsigned*)(C.ws + 32768); (void)dbgflags;
        const float* w0 = C.in[26] + ((size_t)layer * 2 + d) * 256 + h * 64; const float* a0 = C.in[28] + ((size_t)layer * 2 + d) * 256 + h * 64;
        blk_mma<4, 4, 2>(TW, 72, W2T, 72, C.wid, C.lane, [=](int r0, int col, const f32x4& acc) {
#pragma unroll
            for (int jj = 0; jj < 4; ++jj) { const float w = w0[col] + acc[jj]; DBGL(2, badv(w, 1e4f)); LW[(r0 + jj) * 68 + col] = -expf(-softplus(-w) - 0.5f); }
        });
        blk_mma<4, 4, 2>(AD, 72, A2T, 72, C.wid, C.lane, [=](int r0, int col, const f32x4& acc) {
#pragma unroll
            for (int jj = 0; jj < 4; ++jj) { DBGL(2, badv(acc[jj], 1e4f)); AA[(r0 + jj) * 68 + col] = sigm(a0[col] + acc[jj]); }
        });
    }
    __syncthreads();
    if (C.tid < 64) { float run = 0.f; for (int l = 0; l < 64; ++l) { run += LW[l * 68 + C.tid]; CS[l * 68 + C.tid] = run; } GL[C.tid] = expf(run); }
    __syncthreads();
    {
        const int l = C.tid >> 3, sub = C.tid & 7;
        const float* kkw = C.in[31] + layer * 256 + h * 64; const float* kaw = C.in[32] + layer * 256 + h * 64; const float* rkw = C.in[33] + layer * 256 + h * 64;
        float kk[8], kdv[8], aa[8], rr[8], vv[8]; float ss = 0.f, bon = 0.f;
#pragma unroll
        for (int i = 0; i < 8; ++i) { const int c = sub * 8 + i; const float k = bf2f(Kb[l * 72 + c]); rr[i] = bf2f(Rb[l * 72 + c]); vv[i] = bf2f(Vb[l * 72 + c]); aa[i] = AA[l * 68 + c];
            kk[i] = k * kkw[c]; ss += kk[i] * kk[i]; kdv[i] = k * (1.f + (aa[i] - 1.f) * kaw[c]); bon += rr[i] * kdv[i] * rkw[c]; }
        ss += __shfl_xor(ss, 1); ss += __shfl_xor(ss, 2); ss += __shfl_xor(ss, 4);
        bon += __shfl_xor(bon, 1); bon += __shfl_xor(bon, 2); bon += __shfl_xor(bon, 4);
        const float inv = rsqrtf(ss + 1e-12f);
        if (sub == 0) ((float*)(C.ws + WS_BON))[(size_t)(ci.row0 + (d ? 63 - l : l)) * 8 + h * 2 + d] = bon;
#pragma unroll
        for (int i = 0; i < 8; ++i) { const int c = sub * 8 + i; const float cs = CS[l * 68 + c], lw = LW[l * 68 + c];
            const float ge = expf(cs - lw), gi = expf(cs), gn = expf(-cs); const float kkn = kk[i] * inv;
            DBGF(3, badv(cs, 50.f) || cs > 0.f || badv(lw, 1.f)); DBGF(4, badv(kkn * ge, 10.f) || badv(rr[i] * gi, 1e4f) || badv(vv[i], 1e4f)); DBGF(5, badv(kdv[i] * gn, 1e25f) || badv(kkn * aa[i] * gn, 1e25f));
            const unsigned short kt = f2bf(kkn * ge), kd = f2bf(kdv[i] * gn), bt = f2bf(kkn * aa[i] * gn), rt = f2bf(rr[i] * gi);
            KT[l * 72 + c] = kt; KTt[c * 72 + l] = kt; KD[l * 72 + c] = kd; KDt[c * 72 + l] = kd; BT[l * 72 + c] = bt; BTt[c * 72 + l] = bt; RT[l * 72 + c] = rt; Vt[c * 72 + l] = f2bf(vv[i]); }
    }
    __syncthreads();
    unsigned* dbgflags = (unsigned*)(C.ws + 32768); (void)dbgflags;
    blk_mma2<4, 4, 2>(KT, BT, KT, KD, 72, C.wid, C.lane, [=](int r0, int col, const f32x4& ab, const f32x4& ak) {
        unsigned short o[4];
#pragma unroll
        for (int jj = 0; jj < 4; ++jj) { const bool lo = col < r0 + jj; DBGL(6, lo && (badv(ab[jj], 1e3f) || badv(ak[jj], 1e4f))); ABf[(r0 + jj) * 68 + col] = lo ? ab[jj] : 0.f; o[jj] = f2bf(lo ? ak[jj] : 0.f); AK[(r0 + jj) * 72 + col] = o[jj]; }
    });
    blk_mma2<4, 4, 2>(RT, KD, RT, BT, 72, C.wid, C.lane, [=](int r0, int col, const f32x4& rk, const f32x4& rb) {
#pragma unroll
        for (int jj = 0; jj < 4; ++jj) { const bool le = col <= r0 + jj; DBGL(7, le && (badv(rk[jj], 1e5f) || badv(rb[jj], 1e5f))); ARK[(r0 + jj) * 72 + col] = f2bf(le ? rk[jj] : 0.f); ARB[(r0 + jj) * 72 + col] = f2bf(le ? rb[jj] : 0.f); }
    });
    __syncthreads();
    tri_inverse(ABf, (LAS float*)(L + 54272), (LAS float*)(L + 71680), TT, C.tid, C.wid, C.lane);
    __syncthreads();
#if MK_DIAG2
    for (int e = C.tid; e < 4096; e += 512) DBGF(8, badv(bf2f(TT[(e >> 6) * 72 + (e & 63)]), 1e3f));
#endif
    blk_mma2<4, 4, 2>(TT, KTt, AK, Vt, 72, C.wid, C.lane, [=](int r0, int col, const f32x4& w1, const f32x4& akv) {
        DBGL(9, badv(w1[0], 1e3f) || badv(w1[1], 1e3f) || badv(w1[2], 1e3f) || badv(w1[3], 1e3f)); DBGL(10, badv(akv[0], 1e5f) || badv(akv[1], 1e5f) || badv(akv[2], 1e5f) || badv(akv[3], 1e5f));
        u32x2 a, b; a.x = pk2(w1[0], w1[1]); a.y = pk2(w1[2], w1[3]); b.x = pk2(akv[0], akv[1]); b.y = pk2(akv[2], akv[3]);
        *(LAS u32x2*)(W1t + col * 72 + r0) = a; *(LAS u32x2*)(AKVt + col * 72 + r0) = b;
    });
    __syncthreads();
    blk_mma<4, 4, 2>(TT, 72, AKVt, 72, C.wid, C.lane, [=](int r0, int col, const f32x4& w2) {
        DBGL(11, badv(w2[0], 1e5f) || badv(w2[1], 1e5f) || badv(w2[2], 1e5f) || badv(w2[3], 1e5f));
        u32x2 a; a.x = pk2(w2[0], w2[1]); a.y = pk2(w2[2], w2[3]); *(LAS u32x2*)(W2t + col * 72 + r0) = a;
    });
    __syncthreads();
    {
        bf16_t* Gg = (bf16_t*)(C.ws + WS_RG) + (size_t)slot * 4096; float* Jg = (float*)(C.ws + WS_RJ) + (size_t)slot * 4096;
        bf16_t* Ryg = (bf16_t*)(C.ws + WS_RY) + (size_t)slot * 4096; bf16_t* Ylg = (bf16_t*)(C.ws + WS_RL) + (size_t)slot * 4096;
        blk_mma2<4, 4, 2>(BTt, W1t, ARB, W1t, 72, C.wid, C.lane, [=](int r0, int col, const f32x4& gp, const f32x4& rbw) {
#pragma unroll
            for (int jj = 0; jj < 4; ++jj) { const int r = r0 + jj;
                Gg[r * 64 + col] = f2bf(GL[r] * ((r == col ? 1.f : 0.f) - gp[jj]));
                Ryg[r * 64 + col] = f2bf(bf2f(RT[r * 72 + col]) - rbw[jj]); }
        });
        blk_mma2<4, 4, 2>(KDt, Vt, BTt, W2t, 72, C.wid, C.lane, [=](int r0, int col, const f32x4& kv, const f32x4& bw) {
            f32x4 o;
#pragma unroll
            for (int jj = 0; jj < 4; ++jj) { o[jj] = GL[r0 + jj] * (kv[jj] - bw[jj]); DBGL(12, badv(GL[r0 + jj] * kv[jj], 1e5f)); DBGL(13, badv(GL[r0 + jj] * bw[jj], 1e5f)); DBGL(14, badv(o[jj], 1e5f)); }
            *(f32x4*)(Jg + col * 64 + r0) = o;
        });
        blk_mma2<4, 4, 2>(ARK, Vt, ARB, W2t, 72, C.wid, C.lane, [=](int r0, int col, const f32x4& a, const f32x4& b) {
            u32x2 o; o.x = pk2(a[0] - b[0], a[1] - b[1]); o.y = pk2(a[2] - b[2], a[3] - b[3]);
            *(u32x2*)(Ylg + col * 64 + r0) = o;
        });
    }
    __syncthreads();
}

typedef float f32x2p __attribute__((ext_vector_type(2)));
__device__ __forceinline__ void ph_scan(const Ctx& C) {
    if (C.bid < 16) {
        const int chain = C.bid, fr = C.lane & 15, fq = C.lane >> 4;
        LAS bf16_t* HT = (LAS bf16_t*)C.lds;
        const bf16_t* Gg = (const bf16_t*)(C.ws + WS_RG); const float* Jg = (const float*)(C.ws + WS_RJ); bf16_t* Hg = (bf16_t*)(C.ws + WS_RH);
        f32x4 acc[2] = {{0.f, 0.f, 0.f, 0.f}, {0.f, 0.f, 0.f, 0.f}};
        int buf = 0;
        const int tm = C.wid >> 1, tnb = (C.wid & 1) * 2;
        const bf16_t* gp = Gg + (size_t)chain * NCH * 4096 + (tm * 16 + fr) * 64 + fq * 8;
        const float* jp = Jg + (size_t)chain * NCH * 4096 + (tnb * 16 + fr) * 64 + tm * 16 + fq * 4;
        bf16x8 gn[2]; f32x4 jn[2];
        gn[0] = *(const bf16x8*)gp; gn[1] = *(const bf16x8*)(gp + 32); jn[0] = *(const f32x4*)jp; jn[1] = *(const f32x4*)(jp + 16 * 64);
        for (int cpos = 0; cpos < NCH; ++cpos) {
            const size_t slot = (size_t)chain * NCH + cpos;
            const bf16x8 g0 = gn[0], g1 = gn[1]; const f32x4 j0 = jn[0], j1 = jn[1];
            if (cpos + 1 < NCH) { const bf16_t* gq = gp + (size_t)(cpos + 1) * 4096; const float* jq = jp + (size_t)(cpos + 1) * 4096;
                gn[0] = *(const bf16x8*)gq; gn[1] = *(const bf16x8*)(gq + 32); jn[0] = *(const f32x4*)jq; jn[1] = *(const f32x4*)(jq + 16 * 64); }
#pragma unroll
            for (int i = 0; i < 2; ++i) { const int tn = tnb + i;
                u32x2 o; o.x = pk2(acc[i][0], acc[i][1]); o.y = pk2(acc[i][2], acc[i][3]);
                *(LAS u32x2*)(HT + buf * 4608 + (tn * 16 + fr) * 72 + tm * 16 + fq * 4) = o;
                *(u32x2*)(Hg + slot * 4096 + (tn * 16 + fr) * 64 + tm * 16 + fq * 4) = o; }
            __syncthreads();
#pragma unroll
            for (int i = 0; i < 2; ++i) { const int tn = tnb + i;
                f32x4 a = i ? j1 : j0;
                a = __builtin_amdgcn_mfma_f32_16x16x32_bf16(g0, *(const LAS bf16x8*)(HT + buf * 4608 + (tn * 16 + fr) * 72 + fq * 8), a, 0, 0, 0);
                a = __builtin_amdgcn_mfma_f32_16x16x32_bf16(g1, *(const LAS bf16x8*)(HT + buf * 4608 + (tn * 16 + fr) * 72 + 32 + fq * 8), a, 0, 0, 0);
                acc[i] = a; }
            buf ^= 1;
        }
    } else {
        float* MST = (float*)(C.ws + WS_MST); const float* MCD = (const float*)(C.ws + WS_MCD);
        const int nthr = (C.G - 16) * 512;
        for (int e = (C.bid - 16) * 512 + C.tid; e < 16 * 4096; e += nthr) {
            const int chain = e >> 12, el = (e & 4095) * 2; f32x2p run = {0.f, 0.f};
            float* p = MST + (size_t)chain * NCH * 8192 + el; const float* cd = MCD + chain * NCH;
#pragma unroll 12
            for (int cpos = 0; cpos < NCH; ++cpos) { const f32x2p tmp = *(const f32x2p*)(p + (size_t)cpos * 8192); *(f32x2p*)(p + (size_t)cpos * 8192) = run; run = run * cd[cpos] + tmp; }
        }
    }
}

__device__ __forceinline__ void item_mamba_out(const Ctx& C, int layer, int gc) {
    const ChunkInfo ci = chunk_info(gc);
    const bf16_t* P = (const bf16_t*)(C.ws + WS_P); bf16_t* YC = (bf16_t*)(C.ws + WS_ACT); const float* MST = (const float*)(C.ws + WS_MST);
    lds_t L = C.lds;
    LAS float* DT = (LAS float*)L;
    LAS float* DA = (LAS float*)(L + 2048);
    LAS float* CSI = (LAS float*)(L + 4096);
    LAS float* SSQ = (LAS float*)(L + 6144);
    LAS bf16_t* CG = (LAS bf16_t*)(L + 10240);
    LAS bf16_t* BG = (LAS bf16_t*)(L + 27648);
    LAS bf16_t* XT = (LAS bf16_t*)(L + 45056);
    LAS float* CBm = (LAS float*)(L + 63488);
    LAS bf16_t* MP = (LAS bf16_t*)(L + 80896);
    LAS bf16_t* S0 = (LAS bf16_t*)(L + 90112);
    LAS bf16_t* YPRE = (LAS bf16_t*)(L + 107520);
    const int fr = C.lane & 15, fq = C.lane >> 4;
    {
        const int s = C.tid >> 3, dh = C.tid & 7;
        const float raw = bf2f(P[(size_t)(ci.row0 + s) * NP + OFF_C + 1024 + dh]);
        const float dt = softplus(raw + C.in[20][layer * 8 + dh]);
        DT[dh * 64 + s] = dt; DA[dh * 64 + s] = dt * (-expf(C.in[21][layer * 8 + dh]));
    }
    __syncthreads();
    if (C.tid < 8) { const int dh = C.tid; float run = 0.f;
        if (dh < 4) { for (int s = 0; s < 64; ++s) { run += DA[dh * 64 + s]; CSI[dh * 64 + s] = run; } }
        else { for (int s = 63; s >= 0; --s) { run += DA[dh * 64 + s]; CSI[dh * 64 + s] = run; } } }
    for (int g = 0; g < 2; ++g) {
        __syncthreads();
        {
            const int cp = C.tid & 255, half = C.tid >> 8;
            if (cp < 192) {
                const int kind = cp >> 6, cl = (cp & 63) * 2, c0 = kind * 256 + g * 128 + cl;
                const float* cw = C.in[18] + (size_t)layer * 5 * 768 + c0; const float* cb = C.in[19] + layer * 768 + c0;
                float w0[5], w1[5];
#pragma unroll
                for (int j = 0; j < 5; ++j) { w0[j] = cw[j * 768]; w1[j] = cw[j * 768 + 1]; }
                const float b0 = cb[0], b1 = cb[1];
                const int s0 = half * 32;
                unsigned win[5];
#pragma unroll
                for (int j = 0; j < 4; ++j) { const int row = ci.row0 + s0 - 2 + j; win[j + 1] = (row >= ci.lo && row < ci.hi) ? *(const unsigned*)(P + (size_t)row * NP + OFF_C + 256 + c0) : 0u; }
                for (int tt = 0; tt < 32; ++tt) {
                    const int s = s0 + tt;
#pragma unroll
                    for (int j = 0; j < 4; ++j) win[j] = win[j + 1];
                    { const int row = ci.row0 + s + 2; win[4] = (row >= ci.lo && row < ci.hi) ? *(const unsigned*)(P + (size_t)row * NP + OFF_C + 256 + c0) : 0u; }
                    float a0 = b0, a1 = b1;
#pragma unroll
                    for (int j = 0; j < 5; ++j) { a0 += w0[j] * bflo(win[j]); a1 += w1[j] * bfhi(win[j]); }
                    const unsigned short o0 = f2bf(silu(a0)), o1 = f2bf(silu(a1));
                    if (kind == 0) { XT[cl * 72 + s] = o0; XT[(cl + 1) * 72 + s] = o1; }
                    else if (kind == 1) { *(LAS unsigned*)(BG + s * 136 + cl) = (unsigned)o0 | ((unsigned)o1 << 16); }
                    else { *(LAS unsigned*)(CG + s * 136 + cl) = (unsigned)o0 | ((unsigned)o1 << 16); }
                }
            }
        }
        __syncthreads();
        blk_mma<4, 4, 4>(CG, 136, BG, 136, C.wid, C.lane, [=](int r0, int col, const f32x4& acc) {
#pragma unroll
            for (int jj = 0; jj < 4; ++jj) CBm[(r0 + jj) * 68 + col] = acc[jj];
        });
        for (int hh = 0; hh < 2; ++hh) {
            const int h = 2 * g + hh;
            f32x4 yacc[2] = {{0.f, 0.f, 0.f, 0.f}, {0.f, 0.f, 0.f, 0.f}};
            for (int d = 0; d < 2; ++d) {
                const int dh = d * 4 + h;
                __syncthreads();
                for (int e = C.tid; e < 4096; e += 512) { const int l = e >> 6, s = e & 63; const bool ok = d ? (s >= l) : (s <= l);
                    MP[l * 72 + s] = ok ? f2bf(CBm[l * 68 + s] * expf(CSI[dh * 64 + l] - CSI[dh * 64 + s]) * DT[dh * 64 + s]) : (unsigned short)0; }
                { const float* src = MST + (size_t)slot_of(ci.b, h, d, cpos_of(ci, d)) * 8192;
                  for (int e = C.tid; e < 2048; e += 512) { const int p = e >> 5, n4 = (e & 31) * 4; const f32x4 v = *(const f32x4*)(src + p * 128 + n4);
                      u32x2 o; o.x = pk2(v.x, v.y); o.y = pk2(v.z, v.w); *(LAS u32x2*)(S0 + p * 136 + n4) = o; } }
                __syncthreads();
#pragma unroll
                for (int i = 0; i < 2; ++i) { const int tt = C.wid + 8 * i, tm = tt >> 2, tn = tt & 3;
                    f32x4 a1 = {0.f, 0.f, 0.f, 0.f}, a2 = {0.f, 0.f, 0.f, 0.f};
#pragma unroll
                    for (int ks = 0; ks < 2; ++ks) a1 = __builtin_amdgcn_mfma_f32_16x16x32_bf16(*(const LAS bf16x8*)(MP + (tm * 16 + fr) * 72 + ks * 32 + fq * 8),
                                                                                                 *(const LAS bf16x8*)(XT + (hh * 64 + tn * 16 + fr) * 72 + ks * 32 + fq * 8), a1, 0, 0, 0);
#pragma unroll
                    for (int ks = 0; ks < 4; ++ks) a2 = __builtin_amdgcn_mfma_f32_16x16x32_bf16(*(const LAS bf16x8*)(CG + (tm * 16 + fr) * 136 + ks * 32 + fq * 8),
                                                                                                 *(const LAS bf16x8*)(S0 + (tn * 16 + fr) * 136 + ks * 32 + fq * 8), a2, 0, 0, 0);
#pragma unroll
                    for (int j = 0; j < 4; ++j) yacc[i][j] += a1[j] + a2[j] * expf(CSI[dh * 64 + tm * 16 + fq * 4 + j]);
                }
            }
            const float dsk = C.in[22][layer * 4 + h];
#pragma unroll
            for (int i = 0; i < 2; ++i) { const int tt = C.wid + 8 * i, tm = tt >> 2, tn = tt & 3;
#pragma unroll
                for (int j = 0; j < 4; ++j) { const int l = tm * 16 + fq * 4 + j, p = tn * 16 + fr, c = h * 64 + p;
                    const float xs = bf2f(XT[(hh * 64 + p) * 72 + l]);
                    const float z = bf2f(P[(size_t)(ci.row0 + l) * NP + OFF_C + c]);
                    const float pre = (yacc[i][j] + dsk * xs) * silu(z);
                    YPRE[l * 264 + c] = f2bf(pre);
                    float q = pre * pre; q += __shfl_xor(q, 1); q += __shfl_xor(q, 2); q += __shfl_xor(q, 4); q += __shfl_xor(q, 8);
                    if (fr == 0) SSQ[l * 16 + h * 4 + tn] = q; }
            }
        }
    }
    __syncthreads();
    {
        const int l = C.tid >> 3, sub = C.tid & 7; float ss = 0.f;
#pragma unroll
        for (int i = 0; i < 16; ++i) ss += SSQ[l * 16 + i];
        const float rs = rsqrtf(ss * (1.f / 256.f) + 1e-6f);
        const float* ng = C.in[23] + layer * 256 + sub * 32;
        bf16_t* dst = YC + (size_t)(ci.row0 + l) * DM + 512 + sub * 32;
#pragma unroll
        for (int i = 0; i < 32; i += 2) { const float a = bf2f(YPRE[l * 264 + sub * 32 + i]) * rs * ng[i], b = bf2f(YPRE[l * 264 + sub * 32 + i + 1]) * rs * ng[i + 1]; *(unsigned*)(dst + i) = pk2(a, b); }
    }
    __syncthreads();
}

constexpr int D3_G2T = 0, D3_SG = 69632;
__device__ __forceinline__ void load_g2t(const Ctx& C, int layer) {
    LAS bf16_t* G2T = (LAS bf16_t*)(C.lds + D3_G2T); const float* g2 = C.in[30] + (size_t)layer * 128 * 256;
    for (int e = C.tid; e < 128 * 256; e += 512) { const int r = e >> 8, c = e & 255; G2T[c * 136 + r] = f2bf(g2[e]); }
}
__device__ __forceinline__ float lerp_d(const bf16_t* P, const ChunkInfo& ci, int row, int j, const float* mup, const float* mun) {
    const bf16_t* pp = P + (size_t)row * NP + OFF_D + j;
    const float x = bf2f(*pp), xp = (row - 1 >= ci.lo) ? bf2f(*(pp - NP)) : 0.f, xn = (row + 1 < ci.hi) ? bf2f(*(pp + NP)) : 0.f;
    return x + mup[j] * (xp - x) + mun[j] * (xn - x);
}
__device__ __forceinline__ void item_rwkv_out(const Ctx& C, int layer, int gc) {
    const ChunkInfo ci = chunk_info(gc);
    const bf16_t* P = (const bf16_t*)(C.ws + WS_P); bf16_t* YC = (bf16_t*)(C.ws + WS_ACT);
    const float* mup = C.in[24] + layer * 1152; const float* mun = C.in[25] + layer * 1152;
    LAS bf16_t* G2T = (LAS bf16_t*)(C.lds + D3_G2T); LAS bf16_t* SG = (LAS bf16_t*)(C.lds + D3_SG);
    const int fr = C.lane & 15, fq = C.lane >> 4;
    __syncthreads();
    for (int e = C.tid; e < 64 * 128; e += 512) { const int l = e >> 7, r = e & 127; SG[l * 136 + r] = f2bf(sigm(lerp_d(P, ci, ci.row0 + l, 1024 + r, mup, mun))); }
    __syncthreads();
    const int h = C.wid >> 1, tmb = (C.wid & 1) * 2;
    const bf16_t* Ryg = (const bf16_t*)(C.ws + WS_RY); const bf16_t* Ylg = (const bf16_t*)(C.ws + WS_RL); const bf16_t* Hg = (const bf16_t*)(C.ws + WS_RH);
    const float* BON = (const float*)(C.ws + WS_BON);
#pragma unroll
    for (int ti = 0; ti < 2; ++ti) {
        const int tm = tmb + ti;
        f32x4 gacc[4], yacc[4];
#pragma unroll
        for (int tn = 0; tn < 4; ++tn) { f32x4 a = {0.f, 0.f, 0.f, 0.f};
#pragma unroll
            for (int ks = 0; ks < 4; ++ks) a = __builtin_amdgcn_mfma_f32_16x16x32_bf16(*(const LAS bf16x8*)(SG + (tm * 16 + fr) * 136 + ks * 32 + fq * 8),
                                                                                        *(const LAS bf16x8*)(G2T + (h * 64 + tn * 16 + fr) * 136 + ks * 32 + fq * 8), a, 0, 0, 0);
            gacc[tn] = a; yacc[tn] = (f32x4){0.f, 0.f, 0.f, 0.f}; }
#pragma unroll
        for (int d = 0; d < 2; ++d) {
            const size_t slot = (size_t)slot_of(ci.b, h, d, cpos_of(ci, d));
            const int arow = d ? 63 - (tm * 16 + fr) : tm * 16 + fr;
            bf16x8 af[2];
#pragma unroll
            for (int ks = 0; ks < 2; ++ks) af[ks] = *(const bf16x8*)(Ryg + slot * 4096 + arow * 64 + ks * 32 + fq * 8);
#pragma unroll
            for (int tn = 0; tn < 4; ++tn) {
                f32x4 a;
                if (d == 0) { const u32x2 yl = *(const u32x2*)(Ylg + slot * 4096 + (tn * 16 + fr) * 64 + tm * 16 + fq * 4); a = (f32x4){bflo(yl.x), bfhi(yl.x), bflo(yl.y), bfhi(yl.y)}; }
                else { const u32x2 yl = *(const u32x2*)(Ylg + slot * 4096 + (tn * 16 + fr) * 64 + 60 - (tm * 16 + fq * 4)); a = (f32x4){bfhi(yl.y), bflo(yl.y), bfhi(yl.x), bflo(yl.x)}; }
#pragma unroll
                for (int ks = 0; ks < 2; ++ks) a = __builtin_amdgcn_mfma_f32_16x16x32_bf16(af[ks], *(const bf16x8*)(Hg + slot * 4096 + (tn * 16 + fr) * 64 + ks * 32 + fq * 8), a, 0, 0, 0);
                yacc[tn] += a;
            }
        }
#pragma unroll
        for (int j = 0; j < 4; ++j) {
            const int l = tm * 16 + fq * 4 + j, row = ci.row0 + l;
            float s = (yacc[0][j] + yacc[1][j]) + (yacc[2][j] + yacc[3][j]);
            s += __shfl_xor(s, 1); s += __shfl_xor(s, 2); s += __shfl_xor(s, 4); s += __shfl_xor(s, 8);
            const float mu = s * (1.f / 64.f);
            float q = 0.f;
#pragma unroll
            for (int tn = 0; tn < 4; ++tn) { const float dd = yacc[tn][j] - mu; q += dd * dd; }
            q += __shfl_xor(q, 1); q += __shfl_xor(q, 2); q += __shfl_xor(q, 4); q += __shfl_xor(q, 8);
            const float rs = rsqrtf(q * (1.f / 64.f) + 64e-5f);
            const float bon = BON[(size_t)row * 8 + h * 2] + BON[(size_t)row * 8 + h * 2 + 1];
#pragma unroll
            for (int tn = 0; tn < 4; ++tn) { const int c = h * 64 + tn * 16 + fr;
                const float yn = (yacc[tn][j] - mu) * rs * C.in[34][layer * 256 + c] + C.in[35][layer * 256 + c];
                const float vv = lerp_d(P, ci, row, 512 + c, mup, mun);
                YC[(size_t)row * DM + 768 + c] = f2bf((yn + bon * vv) * gacc[tn][j]); }
        }
    }
}

__device__ __forceinline__ unsigned ordf(float f) { const unsigned u = __float_as_uint(f); return u ^ ((u >> 31) ? 0xFFFFFFFFu : 0x80000000u); }
__device__ __forceinline__ unsigned wave_max_u32(unsigned v) {
#pragma unroll
    for (int o = 1; o < 64; o <<= 1) { const unsigned t = (unsigned)__shfl_xor((int)v, o); v = t > v ? t : v; }
    return v;
}
constexpr int SEL_K1 = 0, SEL_K2 = 34816, SEL_Q0 = 69632, SEL_Q1 = 78336, SEL_S1 = 87040, SEL_S2 = 103936;
__device__ __forceinline__ void ph_select(const Ctx& C, int layer, int nrows) {
    const bf16_t* Q = (const bf16_t*)(C.ws + WS_Q); int* SELI = (int*)(C.ws + WS_SELI); float* SELG = (float*)(C.ws + WS_SELG);
    LAS bf16_t* K1 = (LAS bf16_t*)(C.lds + SEL_K1); LAS bf16_t* K2 = (LAS bf16_t*)(C.lds + SEL_K2);
    LAS bf16_t* Q0 = (LAS bf16_t*)(C.lds + SEL_Q0); LAS bf16_t* Q1 = (LAS bf16_t*)(C.lds + SEL_Q1);
    LAS float* S1 = (LAS float*)(C.lds + SEL_S1); LAS float* S2 = (LAS float*)(C.lds + SEL_S2);
    {
        const float* k1 = C.in[37] + (size_t)layer * 128 * 128; const float* k2 = C.in[38] + (size_t)layer * 128 * 128;
        for (int e = C.tid; e < 4096; e += 512) { const int r = e >> 5, c4 = (e & 31) * 4; const f32x4 a = *(const f32x4*)(k1 + r * 128 + c4), b = *(const f32x4*)(k2 + r * 128 + c4);
            u32x2 oa, ob; oa.x = pk2(a.x, a.y); oa.y = pk2(a.z, a.w); ob.x = pk2(b.x, b.y); ob.y = pk2(b.z, b.w);
            *(LAS u32x2*)(K1 + r * 136 + c4) = oa; *(LAS u32x2*)(K2 + r * 136 + c4) = ob; }
    }
    int ca = 0, cb = 0;
    { const int L = C.lane;
      if (L < 16) { ca = 0; cb = L; } else if (L < 24) { ca = 1; cb = L - 16; } else if (L < 29) { ca = 2; cb = L - 24; } else if (L < 33) { ca = 3; cb = L - 29; }
      else if (L < 36) { ca = 4; cb = L - 33; } else if (L < 38) { ca = 5; cb = L - 36; } else if (L < 40) { ca = 6; cb = L - 38; } else if (L < 42) { ca = 7; cb = L - 40; }
      else { ca = 8 + (L - 42); cb = 0; } if (L >= 50) { ca = 0; cb = 0; } }
    const int ntile = nrows / 32;
    for (int it = C.bid; it < ntile * 8; it += C.G) {
        const int tile = it >> 3, h = it & 7, row0 = tile * 32;
        __syncthreads();
        for (int e = C.tid; e < 32 * 32; e += 512) { const int r = e >> 5, c8 = (e & 31) * 8;
            const u32x4 v = *(const u32x4*)(Q + (size_t)(row0 + r) * 2048 + h * 256 + c8);
            if (c8 < 128) *(LAS u32x4*)(Q0 + r * 136 + c8) = v; else *(LAS u32x4*)(Q1 + r * 136 + c8 - 128) = v; }
        __syncthreads();
        blk_mma2<2, 8, 4>(Q0, K1, Q1, K2, 136, C.wid, C.lane, [=](int r0, int col, const f32x4& a, const f32x4& b) {
#pragma unroll
            for (int jj = 0; jj < 4; ++jj) { S1[(r0 + jj) * 132 + col] = a[jj]; S2[(r0 + jj) * 132 + col] = b[jj]; }
        });
        __syncthreads();
        for (int ti = 0; ti < 4; ++ti) {
            const int t = C.wid * 4 + ti, L = C.lane;
            const LAS float* s1 = S1 + t * 132; const LAS float* s2 = S2 + t * 132;
            unsigned ka0 = (ordf(s1[L]) & ~0x7Fu) | (unsigned)(127 - L), ka1 = (ordf(s1[L + 64]) & ~0x7Fu) | (unsigned)(63 - L);
            unsigned kb0 = (ordf(s2[L]) & ~0x7Fu) | (unsigned)(127 - L), kb1 = (ordf(s2[L + 64]) & ~0x7Fu) | (unsigned)(63 - L);
            float v1 = 0.f, v2 = 0.f; int i1 = 0, i2 = 0;
            for (int i = 0; i < 16; ++i) {
                const unsigned ma = wave_max_u32(ka0 > ka1 ? ka0 : ka1), mb = wave_max_u32(kb0 > kb1 ? kb0 : kb1);
                const int ia = 127 - (int)(ma & 0x7Fu), ib = 127 - (int)(mb & 0x7Fu);
                if (L == i) { v1 = s1[ia]; i1 = ia; v2 = s2[ib]; i2 = ib; }
                if (ka0 == ma) ka0 = 0u; if (ka1 == ma) ka1 = 0u; if (kb0 == mb) kb0 = 0u; if (kb1 == mb) kb1 = 0u;
            }
            const float cand = __shfl(v1, ca) + __shfl(v2, cb);
            unsigned kc = (L < 50) ? ((ordf(cand) & ~0x3Fu) | (unsigned)(63 - L)) : 0u;
            int sel = 0;
            for (int i = 0; i < 16; ++i) { const unsigned m = wave_max_u32(kc); const int ls = 63 - (int)(m & 0x3Fu); if (L == i) sel = ls; if (kc == m) kc = 0u; }
            const float top = __shfl(cand, sel); const int sa = __shfl(ca, sel), sb = __shfl(cb, sel);
            const int idx = __shfl(i1, sa) * 128 + __shfl(i2, sb);
            const float mx = __shfl(top, 0);
            const float ex = expf(top - mx);
            float sm = ex; sm += __shfl_xor(sm, 1); sm += __shfl_xor(sm, 2); sm += __shfl_xor(sm, 4); sm += __shfl_xor(sm, 8);
            if (L < 16) { const size_t o = ((size_t)(row0 + t) * 8 + h) * 16 + L; SELI[o] = idx; SELG[o] = ex / sm; }
        }
    }
}

struct R16 { float v[16]; };
__device__ __forceinline__ R16 load_r16_f32(const float* p, int lane) { R16 r;
#pragma unroll
    for (int k = 0; k < 4; ++k) { const f32x4 a = *(const f32x4*)(p + 16 * lane + 4 * k); r.v[4 * k] = a.x; r.v[4 * k + 1] = a.y; r.v[4 * k + 2] = a.z; r.v[4 * k + 3] = a.w; }
    return r; }
__device__ __forceinline__ void store_r16_f32(float* p, int lane, const R16& r) {
#pragma unroll
    for (int k = 0; k < 4; ++k) *(f32x4*)(p + 16 * lane + 4 * k) = (f32x4){r.v[4 * k], r.v[4 * k + 1], r.v[4 * k + 2], r.v[4 * k + 3]}; }
__device__ __forceinline__ R16 load_r16_bf16(const bf16_t* p, int lane) { R16 r;
#pragma unroll
    for (int k = 0; k < 2; ++k) { const u32x4 a = *(const u32x4*)(p + 16 * lane + 8 * k);
        r.v[8 * k] = bflo(a.x); r.v[8 * k + 1] = bfhi(a.x); r.v[8 * k + 2] = bflo(a.y); r.v[8 * k + 3] = bfhi(a.y); r.v[8 * k + 4] = bflo(a.z); r.v[8 * k + 5] = bfhi(a.z); r.v[8 * k + 6] = bflo(a.w); r.v[8 * k + 7] = bfhi(a.w); }
    return r; }
__device__ __forceinline__ void store_r16_bf16(bf16_t* p, int lane, const R16& r) {
#pragma unroll
    for (int k = 0; k < 2; ++k) { u32x4 a; a.x = pk2(r.v[8 * k], r.v[8 * k + 1]); a.y = pk2(r.v[8 * k + 2], r.v[8 * k + 3]); a.z = pk2(r.v[8 * k + 4], r.v[8 * k + 5]); a.w = pk2(r.v[8 * k + 6], r.v[8 * k + 7]);
        *(u32x4*)(p + 16 * lane + 8 * k) = a; } }
typedef float f32x2p __attribute__((ext_vector_type(2)));
__device__ __forceinline__ void ph_peer(const Ctx& C, int layer, int nrows, bool last) {
    const bf16_t* F = (const bf16_t*)(C.ws + WS_ACT); bf16_t* XN = (bf16_t*)(C.ws + WS_ACT);
    const unsigned char* UB = C.ws + WS_UB; const unsigned char* VB = C.ws + WS_VB; const float* SU = (const float*)(C.ws + WS_SU); const float* SV = (const float*)(C.ws + WS_SV);
    const int* SELI = (const int*)(C.ws + WS_SELI); const float* SELG = (const float*)(C.ws + WS_SELG);
    float* H = (float*)(C.ws + WS_H); const float* MOD = (const float*)(C.ws + WS_MOD);
    const int L = C.lane;
    for (int tok = C.bid * 8 + C.wid; tok < nrows; tok += C.G * 8) {
        const R16 f = load_r16_bf16(F + (size_t)tok * DM, L);
        const int idx0 = SELI[(size_t)tok * 128 + L], idx1 = SELI[(size_t)tok * 128 + 64 + L];
        const float su0 = SU[idx0], su1 = SU[idx1];
        const float gsv0 = SELG[(size_t)tok * 128 + L] * SV[idx0], gsv1 = SELG[(size_t)tok * 128 + 64 + L] * SV[idx1];
        f32x2p out[8];
#pragma unroll
        for (int i = 0; i < 8; ++i) out[i] = (f32x2p){0.f, 0.f};
        for (int bt = 0; bt < 8; ++bt) {
            const int src = bt < 4 ? idx0 : idx1; const float susrc = bt < 4 ? su0 : su1, gsrc = bt < 4 ? gsv0 : gsv1; const int l0 = (bt & 3) * 16;
            u32x4 ua[16], va[16];
#pragma unroll
            for (int i = 0; i < 16; ++i) { const int ei = __builtin_amdgcn_readlane(src, l0 + i);
                ua[i] = *(const u32x4*)(UB + (size_t)ei * DM + 16 * L); va[i] = *(const u32x4*)(VB + (size_t)ei * DM + 16 * L); }
            float part[16];
#pragma unroll
            for (int i = 0; i < 16; ++i) { f32x2p acc = {0.f, 0.f};
#pragma unroll
                for (int k = 0; k < 4; ++k) { const f32x2p lo = __builtin_amdgcn_cvt_pk_f32_fp8((int)ua[i][k], false), hi = __builtin_amdgcn_cvt_pk_f32_fp8((int)ua[i][k], true);
                    acc += lo * (f32x2p){f.v[4 * k], f.v[4 * k + 1]}; acc += hi * (f32x2p){f.v[4 * k + 2], f.v[4 * k + 3]}; }
                part[i] = acc.x + acc.y; }
            float p8[8], p4[4], p2[2], p1;
            { const bool hi = (L & 32) != 0;
#pragma unroll
              for (int i = 0; i < 8; ++i) { const float send = hi ? part[i] : part[i + 8]; const float recv = __shfl_xor(send, 32); p8[i] = (hi ? part[i + 8] : part[i]) + recv; } }
            { const bool hi = (L & 16) != 0;
#pragma unroll
              for (int i = 0; i < 4; ++i) { const float send = hi ? p8[i] : p8[i + 4]; const float recv = __shfl_xor(send, 16); p4[i] = (hi ? p8[i + 4] : p8[i]) + recv; } }
            { const bool hi = (L & 8) != 0;
#pragma unroll
              for (int i = 0; i < 2; ++i) { const float send = hi ? p4[i] : p4[i + 2]; const float recv = __shfl_xor(send, 8); p2[i] = (hi ? p4[i + 2] : p4[i]) + recv; } }
            { const bool hi = (L & 4) != 0; const float send = hi ? p2[0] : p2[1]; const float recv = __shfl_xor(send, 4); p1 = (hi ? p2[1] : p2[0]) + recv; }
            p1 += __shfl_xor(p1, 2); p1 += __shfl_xor(p1, 1);
            const int myexp = ((L >> 5) & 1) * 8 + ((L >> 4) & 1) * 4 + ((L >> 3) & 1) * 2 + ((L >> 2) & 1);
            const float act = gelu_tanh(p1 * __shfl(susrc, l0 + myexp)) * __shfl(gsrc, l0 + myexp);
#pragma unroll
            for (int i = 0; i < 16; ++i) {
                const float a = __shfl(act, ((i >> 3) & 1) * 32 + ((i >> 2) & 1) * 16 + ((i >> 1) & 1) * 8 + (i & 1) * 4); const f32x2p a2 = {a, a};
#pragma unroll
                for (int k = 0; k < 4; ++k) { out[2 * k] += a2 * __builtin_amdgcn_cvt_pk_f32_fp8((int)va[i][k], false); out[2 * k + 1] += a2 * __builtin_amdgcn_cvt_pk_f32_fp8((int)va[i][k], true); }
            }
        }
        const float* m = MOD + ((size_t)layer * 3 + which_of(tok)) * 6144;
        R16 hr = load_r16_f32(H + (size_t)tok * DM, L); const R16 g5 = load_r16_f32(m + 5 * 1024, L);
#pragma unroll
        for (int i = 0; i < 8; ++i) { hr.v[2 * i] += g5.v[2 * i] * out[i].x; hr.v[2 * i + 1] += g5.v[2 * i + 1] * out[i].y; }
        float ss = 0.f;
#pragma unroll
        for (int i = 0; i < 16; ++i) ss += hr.v[i] * hr.v[i];
        const float rs = rsqrtf(wave_sum(ss) * (1.f / 1024.f) + 1e-6f);
        if (!last) {
            store_r16_f32(H + (size_t)tok * DM, L, hr);
            const float* m2 = MOD + ((size_t)(layer + 1) * 3 + which_of(tok)) * 6144;
            const R16 gg = load_r16_f32(C.in[6] + (layer + 1) * 1024, L), sh = load_r16_f32(m2, L), sc = load_r16_f32(m2 + 1024, L); R16 o;
#pragma unroll
            for (int i = 0; i < 16; ++i) o.v[i] = (hr.v[i] * rs * gg.v[i]) * (1.f + sc.v[i]) + sh.v[i];
            store_r16_bf16(XN + (size_t)tok * DM, L, o);
        } else {
            const R16 fg = load_r16_f32(C.in[41], L); R16 o;
#pragma unroll
            for (int i = 0; i < 16; ++i) o.v[i] = hr.v[i] * rs * fg.v[i];
            store_r16_f32(C.out + (size_t)tok * DM, L, o);
        }
    }
}

#define PM(n) ((MASK >> (n)) & 1u)
constexpr int NPH_LAYER = 9, NPH = 2 + 2 * NPH_LAYER;
template <unsigned MASK> __global__ void __launch_bounds__(512, 2) hybrid_fwd(Args args) {
    extern __shared__ __attribute__((aligned(16))) unsigned char lds_raw[];
    Ctx C0; C0.in = args.in; C0.out = args.out; C0.ws = args.ws; C0.lds = (lds_t)lds_raw;
    C0.tid = threadIdx.x; C0.lane = C0.tid & 63; C0.wid = __builtin_amdgcn_readfirstlane(C0.tid >> 6); C0.bid = blockIdx.x; C0.G = gridDim.x;
    const Ctx& C = C0;
    const int lo = args.ph_lo, hi = args.ph_hi;
    const bool multi = (hi - lo) > 1;
    XcdBarrier bar; bar.bar = (unsigned*)(C.ws + WS_CTL); bar.x = 0; bar.st = (volatile LAS unsigned*)(C.lds + LDS_XB);
    if (multi) {
        if (C.tid == 0) *(LAS u32x4*)(C.lds + LDS_XB) = (u32x4){0u, 0u, 0u, 0u};
        __syncthreads();
        bar = xcd_barrier_post((unsigned*)(C.ws + WS_CTL), (volatile LAS unsigned*)(C.lds + LDS_XB));
    }
#define IN(k) (lo <= (k) && (k) < hi)
#define PHASE_CTX(c) Ctx c = C0; { int t_ = C0.tid; asm volatile("" : "+v"(t_)); c.tid = t_; c.lane = t_ & 63; c.wid = __builtin_amdgcn_readfirstlane(t_ >> 6); }
#define SEAM(k) do { if (IN(k) && IN((k) + 1)) xcd_barrier(bar); } while (0)
    if (PM(0) && IN(0)) { PHASE_CTX(c); ph_prologue(c); } SEAM(0);
    if (PM(1) && IN(1)) { PHASE_CTX(c); ph_norm(c, 0, c.in[6], 0, NROW); } SEAM(1);
    for (int layer = 0; layer < 2; ++layer) {
        const int base = 2 + layer * NPH_LAYER;
        const bool emit = (layer == 0);
        const int nrows = emit ? NROW : NLAT;
        if (PM(2) && IN(base + 0)) {
            pg8::Gemm g{(const bf16_t*)(C.ws + WS_ACT), (const bf16_t*)(C.ws + WS_WIN) + (size_t)layer * NP * DM, NROW, NP, DM};
            pg8::StaticOrder S; S.init(NROW, NP, C.G, C.bid);
            pg8::EpiBf16<0> E{(bf16_t*)(C.ws + WS_P), NP, nullptr, 0, 0};
            pg8::gemm_phase<pg8::EpiBf16<0>, pg8::StaticOrder, false>(C.lds, g, S, E, nullptr);
        }
        SEAM(base + 0);
        if (PM(3) && IN(base + 1)) {
            const int nD = 2112, nC = 264, nB = emit ? 132 : 128, nA = emit ? 264 : 256, tot = nD + nC + nB + nA;
            if (PM(11)) { PHASE_CTX(c); for (int it = c.bid; it < nD; it += c.G) item_rwkv_local(c, layer, it); }
            if (PM(12)) { PHASE_CTX(c); for (int it = nD + (c.bid + 64) % c.G; it < nD + nC; it += c.G) item_mamba_local(c, layer, it - nD); }
            if (PM(13)) { PHASE_CTX(c); for (int it = nD + nC + (c.bid + 192) % c.G; it < nD + nC + nB; it += c.G) item_chunkmlp(c, layer, it - nD - nC); }
            if (PM(14)) { PHASE_CTX(c); for (int it = nD + nC + nB + (c.bid + 64) % c.G; it < tot; it += c.G) item_conformer(c, layer, it - nD - nC - nB); }
        }
        SEAM(base + 1);
        if (PM(4) && IN(base + 2)) { PHASE_CTX(c); ph_scan(c); }
        SEAM(base + 2);
        if (PM(5) && IN(base + 3)) {
            const int nc = nrows / 64;
            if (PM(15)) { PHASE_CTX(c); load_g2t(c, layer); for (int it = c.bid; it < nc; it += c.G) item_rwkv_out(c, layer, it); }
            __syncthreads();
            if (PM(16)) { PHASE_CTX(c); for (int it = c.bid; it < nc; it += c.G) item_mamba_out(c, layer, (it + 128) % nc); }
        }
        SEAM(base + 3);
        if (PM(6) && IN(base + 4)) {
            pg8::Gemm g{(const bf16_t*)(C.ws + WS_ACT), (const bf16_t*)(C.ws + WS_WOUT) + (size_t)layer * DM * DM, nrows, DM, DM};
            pg8::StaticOrder S; S.init(nrows, DM, C.G, C.bid);
            EpiResid E{(float*)(C.ws + WS_H), (const float*)(C.ws + WS_MOD) + (size_t)layer * 3 * 6144};
            pg8::gemm_phase<EpiResid, pg8::StaticOrder, false>(C.lds, g, S, E, nullptr);
        }
        SEAM(base + 4);
        if (PM(7) && IN(base + 5)) { PHASE_CTX(c); ph_norm(c, layer, c.in[7] + layer * 1024, 3, nrows); if (layer == 1) convert_tables(c, 1); }
        SEAM(base + 5);
        if (PM(8) && IN(base + 6)) {
            pg8::Gemm g{(const bf16_t*)(C.ws + WS_ACT), (const bf16_t*)(C.ws + WS_WQ) + (size_t)layer * 2048 * DM, nrows, 2048, DM};
            pg8::StaticOrder S; S.init(nrows, 2048, C.G, C.bid);
            pg8::EpiBf16<0> E{(bf16_t*)(C.ws + WS_Q), 2048, nullptr, 0, 0};
            pg8::gemm_phase<pg8::EpiBf16<0>, pg8::StaticOrder, false>(C.lds, g, S, E, nullptr);
        }
        SEAM(base + 6);
        if (PM(9) && IN(base + 7)) { PHASE_CTX(c); ph_select(c, layer, nrows); }
        SEAM(base + 7);
        if (PM(10) && IN(base + 8)) { PHASE_CTX(c); ph_peer(c, layer, nrows, layer == 1); }
        SEAM(base + 8);
    }
#undef IN
#undef SEAM
}
}
#ifndef MK_DIAG
#define MK_DIAG 0
#endif


namespace mk {
struct LaunchEnt { unsigned mask; int ph; };
template <unsigned MASK> static bool prep_kernel() {
    return hipFuncSetAttribute((const void*)hybrid_fwd<MASK>, hipFuncAttributeMaxDynamicSharedMemorySize, LDS_BYTES) == hipSuccess;
}
template <unsigned MASK> static void launch_kernel(int grid, hipStream_t stream, const Args& a) {
    hipLaunchKernelGGL(hybrid_fwd<MASK>, dim3(grid), dim3(512), LDS_BYTES, stream, a);
}
}

#if MK_DIAG
namespace mk {
__global__ void census_kernel(const void* buf, size_t n, int kind  , unsigned* flags, int stage, float lim) {
    bool bad = false;
    for (size_t i = (size_t)blockIdx.x * blockDim.x + threadIdx.x; i < n; i += (size_t)gridDim.x * blockDim.x) {
        if (kind == 2) { const int v = ((const int*)buf)[i]; bad |= (v < 0 || v >= 16384); }
        else { const float v = kind == 0 ? ((const float*)buf)[i] : bf2f(((const bf16_t*)buf)[i]); bad |= !(fabsf(v) < lim); }
    }
    if (bad) atomicOr(flags + stage, 1u);
}
__global__ void encode_kernel(const float* x, const float* fg, float* out, const unsigned* flags, int nst) {
    int first = 0; for (int k = nst; k >= 1; --k) if (flags[k]) first = k;
    const int row = blockIdx.x * 4 + (threadIdx.x >> 6), lane = threadIdx.x & 63;
    Row16 r = load_row16(x + (size_t)row * DM, lane);
    const int t = row & 8191;
    for (int i = 0; i < 16; ++i) { const int c = (i < 8 ? 8 * lane + i : 512 + 8 * lane + i - 8); const int quarter = c >> 8, jj = c & 255; const float pos = (quarter < 2) ? (float)(t >> 6) : (float)(t & 63);
        const float fr = exp2f(-(float)jj * (13.287712379549449f / 256.f)); r.v[i] += (quarter & 1) ? cosf(pos * fr) : sinf(pos * fr); }
    float ss = 0.f; for (int i = 0; i < 16; ++i) ss += r.v[i] * r.v[i];
    const float rs = rsqrtf(wave_sum(ss) * (1.f / 1024.f) + 1e-6f);
    const Row16 g = load_row16(fg, lane); Row16 o;
    const bool zero = row < first * 512;
    for (int i = 0; i < 16; ++i) o.v[i] = zero ? 0.f : r.v[i] * rs * g.v[i];
    store_row16_f32(out + (size_t)row * DM, lane, o);
}
}
#define CENSUS(off, n, kind, stage, lim) hipLaunchKernelGGL(mk::census_kernel, dim3(1024), dim3(256), 0, stream, (const void*)((char*)d_ws + (off)), (size_t)(n), kind, (unsigned*)((char*)d_ws + 32768), stage, lim)
#else
#define CENSUS(off, n, kind, stage, lim) do {} while (0)
#endif
#ifndef MK_ONE_LAUNCH
#define MK_ONE_LAUNCH 1
#endif
extern "C" void kernel_launch(void* const* d_in, const int* in_sizes, int n_in, void* d_out, int out_size, void* d_ws, size_t ws_size, hipStream_t stream) {
    using namespace mk;
    static int grid = 0;
    if (grid == 0) {
        if (n_in != 42 || ws_size < WS_END) { fprintf(stderr, "kernel_launch: need 42 inputs and %zu bytes of workspace (got %d, %zu)\n", (size_t)WS_END, n_in, ws_size); grid = -1; return; }
        int dev = 0, cus = 0;
        if (hipGetDevice(&dev) != hipSuccess || hipDeviceGetAttribute(&cus, hipDeviceAttributeMultiprocessorCount, dev) != hipSuccess) { grid = -1; return; }
        bool ok = true;
#if MK_ONE_LAUNCH
        ok = ok && prep_kernel<0x1FFFFu>();
#else
        ok = ok && prep_kernel<0x0001u>() && prep_kernel<0x0002u>() && prep_kernel<0x0004u>() && prep_kernel<0x0808u>() && prep_kernel<0x1008u>() && prep_kernel<0x2008u>() && prep_kernel<0x4008u>()
                && prep_kernel<0x0010u>() && prep_kernel<0x8020u>() && prep_kernel<0x10020u>() && prep_kernel<0x0040u>() && prep_kernel<0x0080u>() && prep_kernel<0x0100u>() && prep_kernel<0x0200u>() && prep_kernel<0x0400u>();
#endif
        if (!ok) { fprintf(stderr, "kernel_launch: hipFuncSetAttribute failed\n"); grid = -1; return; }
        (void)hipGetLastError();
        grid = cus;
    }
    if (grid < 0) return;
    (void)hipMemsetAsync((char*)d_ws + WS_CTL, 0, 65536, stream);
    Args a{};
    for (int i = 0; i < 42; ++i) a.in[i] = (const float*)d_in[i];
    a.out = (float*)d_out; a.ws = (unsigned char*)d_ws;
#if MK_ONE_LAUNCH
    a.ph_lo = 0; a.ph_hi = NPH; launch_kernel<0x1FFFFu>(grid, stream, a);
#else
    a.ph_lo = 0; a.ph_hi = 1; launch_kernel<0x0001u>(grid, stream, a);
    CENSUS(WS_H, (size_t)NROW * DM, 0, 1, 1e4f); CENSUS(WS_MOD, 2 * 3 * 6144, 0, 1, 1e4f); CENSUS(WS_WIN, 2ull * NP * DM, 1, 1, 1e4f); CENSUS(WS_UB, 2ull * NEXP * DM, 1, 1, 1e4f);
    a.ph_lo = 1; a.ph_hi = 2; launch_kernel<0x0002u>(grid, stream, a);
    CENSUS(WS_ACT, (size_t)NROW * DM, 1, 2, 1e4f);
    for (int layer = 0; layer < 2; ++layer) {
        const int b = 2 + layer * NPH_LAYER;
        const int so = layer ? 100 : 0; (void)so;
        a.ph_lo = b + 0; a.ph_hi = b + 1; launch_kernel<0x0004u>(grid, stream, a);
        if (!layer) CENSUS(WS_P, (size_t)NROW * NP, 1, 3, 1e4f);
        a.ph_lo = b + 1; a.ph_hi = b + 2; launch_kernel<0x0808u>(grid, stream, a);
        if (!layer) { CENSUS(WS_RG, (size_t)NSLOT * 4096, 1, 4, 1e6f); CENSUS(WS_RJ, (size_t)NSLOT * 4096, 0, 5, 1e6f); CENSUS(WS_RY, (size_t)NSLOT * 4096 * 2, 1, 6, 1e6f); CENSUS(WS_BON, (size_t)NROW * 8, 0, 6, 1e6f); }
        launch_kernel<0x1008u>(grid, stream, a);
        if (!layer) { CENSUS(WS_MST, (size_t)NSLOT * 8192, 0, 7, 1e6f); CENSUS(WS_MCD, NSLOT, 0, 7, 1e6f); }
        launch_kernel<0x2008u>(grid, stream, a); launch_kernel<0x4008u>(grid, stream, a);
        a.ph_lo = b + 2; a.ph_hi = b + 3; launch_kernel<0x0010u>(grid, stream, a);
        if (!layer) { CENSUS(WS_MST, (size_t)NSLOT * 8192, 0, 8, 1e6f); CENSUS(WS_RH, (size_t)NSLOT * 4096, 1, 9, 1e6f); }
        a.ph_lo = b + 3; a.ph_hi = b + 4; launch_kernel<0x8020u>(grid, stream, a); launch_kernel<0x10020u>(grid, stream, a);
        if (!layer) CENSUS(WS_ACT, (size_t)NROW * DM, 1, 10, 1e4f);
        a.ph_lo = b + 4; a.ph_hi = b + 5; launch_kernel<0x0040u>(grid, stream, a);
        if (!layer) CENSUS(WS_H, (size_t)NROW * DM, 0, 11, 1e4f);
        a.ph_lo = b + 5; a.ph_hi = b + 6; launch_kernel<0x0080u>(grid, stream, a);
        a.ph_lo = b + 6; a.ph_hi = b + 7; launch_kernel<0x0100u>(grid, stream, a);
        if (!layer) CENSUS(WS_Q, (size_t)NROW * 2048, 1, 12, 1e4f);
        a.ph_lo = b + 7; a.ph_hi = b + 8; launch_kernel<0x0200u>(grid, stream, a);
        if (!layer) { CENSUS(WS_SELI, (size_t)NROW * 128, 2, 13, 0.f); CENSUS(WS_SELG, (size_t)NROW * 128, 0, 13, 2.f); }
        a.ph_lo = b + 8; a.ph_hi = b + 9; launch_kernel<0x0400u>(grid, stream, a);
        if (!layer) { CENSUS(WS_H, (size_t)NROW * DM, 0, 14, 1e4f); CENSUS(WS_ACT, (size_t)NROW * DM, 1, 15, 1e4f); }
    }
#endif
#if MK_DIAG
    hipLaunchKernelGGL(mk::encode_kernel, dim3(NLAT / 4), dim3(256), 0, stream, (const float*)d_in[0], (const float*)d_in[41], (float*)d_out, (const unsigned*)((char*)d_ws + 32768), 15);
#endif
    (void)in_sizes; (void)out_size;
}
```

```cpp
#include <hip/hip_runtime.h>
#include <cstdio>
#include <cstdint>
namespace pg8 {
#define PG8_LAS __attribute__((address_space(3)))
typedef unsigned short bf16_t;
typedef short bf16x8 __attribute__((ext_vector_type(8)));
typedef float f32x4 __attribute__((ext_vector_type(4)));
typedef unsigned u32x4 __attribute__((ext_vector_type(4)));
constexpr int BM = 256, BK = 64, HALF = 128, HTB = HALF * BK * 2  , STAGE_BYTES = 8 * HTB, NXCD = 8, WGM = 8;

__host__ __device__ __forceinline__ int lds_byte(int r, int c) { const int st = (r >> 4) * 2 + (c >> 5), rr = r & 15, cc = c & 31, ob = rr * 64 + cc * 2; return st * 1024 + (ob ^ (((ob >> 9) & 1) << 5)); }
__host__ __device__ __forceinline__ void stage_rc(int b, int& R, int& C) { const int st = b / 1024, sb = b % 1024, swz = sb ^ (((sb >> 9) & 1) << 5); R = (st >> 1) * 16 + swz / 64; C = (st & 1) * 32 + (swz % 64) / 2; }
__host__ __device__ __forceinline__ int perm32(int rho) { const int n = rho >> 4, i = rho & 15; return 8 * (i >> 2) + 4 * n + (i & 3); }

struct Unit { int pm, pn; };
struct Gemm { const bf16_t* A; const bf16_t* Bt; int M, N, K; };

struct StaticOrder {
    int nM, nN, nwg, G, c;
    __host__ __device__ void init(int M, int N, int G_, int c_) { nM = M / BM; nN = N / BM; nwg = nM * nN; G = G_; c = c_; }
    __host__ __device__ bool next(int i, Unit& u) const {
        const long L = (long)i * G + c; if (L >= nwg) return false;
        int wgid = (int)L; { const int q = nwg / NXCD, r = nwg % NXCD, xcd = wgid % NXCD, off = wgid / NXCD; wgid = (xcd < r ? xcd * (q + 1) : r * (q + 1) + (xcd - r) * q) + off; }
        const int nig = WGM * nN, gid = wgid / nig, fm = gid * WGM, gsz = (nM - fm) < WGM ? (nM - fm) : WGM;
        u.pm = fm + ((wgid % nig) % gsz); u.pn = (wgid % nig) / gsz; return true;
    }
    __device__ __forceinline__ void a_ready(const Unit&) const {}
    __device__ __forceinline__ void done(const Unit&) const {}
};
struct CountedOrder : StaticOrder {
    const unsigned* ready; unsigned need; unsigned* tmo;
    __device__ __forceinline__ void a_ready(const Unit& u) const {
        if (threadIdx.x < 64) {
            const unsigned long long t0 = __builtin_amdgcn_s_memrealtime(); unsigned polls = 0;
            while ((unsigned)__builtin_amdgcn_readfirstlane(__hip_atomic_load(ready + 64 * u.pm, __ATOMIC_RELAXED, __HIP_MEMORY_SCOPE_AGENT)) < need) {
                if ((++polls & 255u) == 0u && __builtin_amdgcn_readfirstlane(__hip_atomic_load(tmo, __ATOMIC_RELAXED, __HIP_MEMORY_SCOPE_AGENT)) != 0u) break;
                if (__builtin_amdgcn_s_memrealtime() - t0 > 2000000ull) {
                    if (threadIdx.x == 0) { unsigned expect = 0u; __hip_atomic_compare_exchange_strong(tmo + 1, &expect, 0x600u | (unsigned)(u.pm & 0xff), __ATOMIC_RELAXED, __ATOMIC_RELAXED, __HIP_MEMORY_SCOPE_AGENT); __hip_atomic_store(tmo, 1u, __ATOMIC_RELAXED, __HIP_MEMORY_SCOPE_AGENT); }
                    break; }
                __builtin_amdgcn_s_sleep(2); }
            __builtin_amdgcn_fence(__ATOMIC_ACQUIRE, "agent");
            asm volatile("s_waitcnt vmcnt(0)" ::: "memory");
        }
#if !defined(BROKEN_HOOK_NO_BARRIER)
        asm volatile("" ::: "memory"); __builtin_amdgcn_s_barrier(); asm volatile("" ::: "memory");
#endif
    }
};

__device__ __forceinline__ unsigned cvt_pk_bf16(float lo, float hi) { unsigned r; asm volatile("v_cvt_pk_bf16_f32 %0, %1, %2" : "=v"(r) : "v"(lo), "v"(hi)); return r; }
typedef float f32x2 __attribute__((ext_vector_type(2)));
__device__ __forceinline__ f32x2 gelu_pk(f32x2 v) {
    const f32x2 av = __builtin_elementwise_abs(v), d = av * 0.2316418882f + 1.0f;
    f32x2 t; t.x = __builtin_amdgcn_rcpf(d.x); t.y = __builtin_amdgcn_rcpf(d.y);
    f32x2 q = t * 0.5307027145f + (-0.7265760135f); q = q * t + 0.7107068705f; q = q * t + (-0.142248368f); q = q * t + 0.127414796f; q = q * t;
    const f32x2 s = (v * v) * (-0.72134752044f);
    f32x2 e; e.x = __builtin_amdgcn_exp2f(s.x); e.y = __builtin_amdgcn_exp2f(s.y);
    const f32x2 m = v * (q * e), r = v - m;
    f32x2 o; o.x = v.x < 0.f ? m.x : r.x; o.y = v.y < 0.f ? m.y : r.y; return o;
}

struct EpiF32 {
    static constexpr bool PERM = false, AFTER_DRAIN = false;
    float* C; int ldc; const float* bias;
    __device__ __forceinline__ void operator()(const f32x4 (&acc)[2][2][4][2], const Unit& u, int wr, int wc, int fr, int fq) const {
        const int row0 = u.pm * BM + wr * 64 + fr, col0 = u.pn * BM + wc * 32 + 4 * fq;
        f32x4 bv[2][2];
#pragma unroll
        for (int bj = 0; bj < 2; ++bj)
#pragma unroll
            for (int n = 0; n < 2; ++n) bv[bj][n] = bias ? *(const f32x4*)(bias + col0 + bj * HALF + n * 16) : (f32x4){0.f, 0.f, 0.f, 0.f};
#pragma unroll
        for (int ai = 0; ai < 2; ++ai)
#pragma unroll
            for (int m = 0; m < 4; ++m) { float* rowp = C + (size_t)(row0 + ai * HALF + m * 16) * ldc + col0;
#pragma unroll
                for (int bj = 0; bj < 2; ++bj)
#pragma unroll
                    for (int n = 0; n < 2; ++n) *(f32x4*)(rowp + bj * HALF + n * 16) = acc[ai][bj][m][n] + bv[bj][n]; }
    }
};
template <int ACT  > struct EpiBf16 {
    static constexpr bool PERM = true, AFTER_DRAIN = false;
    bf16_t* O; int ldc; const float* bias; int split_cols; size_t split_stride;
    __device__ __forceinline__ void operator()(const f32x4 (&acc)[2][2][4][2], const Unit& u, int wr, int wc, int fr, int fq) const {
        const int row0 = u.pm * BM + wr * 64 + fr; int colt = u.pn * BM; bf16_t* base = O;
        if (split_cols) { const int t = colt / split_cols; base += (size_t)t * split_stride; colt -= t * split_cols; }
        const int col0 = colt + wc * 32 + 8 * fq, bcol0 = u.pn * BM + wc * 32 + 8 * fq;
        f32x4 bv[2][2];
#pragma unroll
        for (int bj = 0; bj < 2; ++bj)
#pragma unroll
            for (int n = 0; n < 2; ++n) bv[bj][n] = bias ? *(const f32x4*)(bias + bcol0 + bj * HALF + 4 * n) : (f32x4){0.f, 0.f, 0.f, 0.f};
#pragma unroll
        for (int ai = 0; ai < 2; ++ai)
#pragma unroll
            for (int m = 0; m < 4; ++m) { bf16_t* rowp = base + (size_t)(row0 + ai * HALF + m * 16) * ldc + col0;
#pragma unroll
                for (int bj = 0; bj < 2; ++bj) { f32x4 v0 = acc[ai][bj][m][0] + bv[bj][0], v1 = acc[ai][bj][m][1] + bv[bj][1];
                    if (ACT == 1) { f32x2 a = gelu_pk((f32x2){v0[0], v0[1]}), b = gelu_pk((f32x2){v0[2], v0[3]}), c = gelu_pk((f32x2){v1[0], v1[1]}), d = gelu_pk((f32x2){v1[2], v1[3]});
                        v0 = (f32x4){a.x, a.y, b.x, b.y}; v1 = (f32x4){c.x, c.y, d.x, d.y}; }
                    if (ACT == 2) {
#pragma unroll
                        for (int j = 0; j < 4; ++j) { v0[j] = 0.5f * v0[j] * (1.0f + erff(v0[j] * 0.70710678f)); v1[j] = 0.5f * v1[j] * (1.0f + erff(v1[j] * 0.70710678f)); } }
                    u32x4 w; w.x = cvt_pk_bf16(v0[0], v0[1]); w.y = cvt_pk_bf16(v0[2], v0[3]); w.z = cvt_pk_bf16(v1[0], v1[1]); w.w = cvt_pk_bf16(v1[2], v1[3]);
                    *(u32x4*)(rowp + bj * HALF) = w; } }
    }
};
template <class Epi, class Sched, bool STAMP = false>
__device__ __forceinline__ void gemm_phase(PG8_LAS unsigned char* lds, const Gemm g, const Sched& S, const Epi& E, unsigned long long* stamps) {
    int tid_ = threadIdx.x; asm volatile("" : "+v"(tid_));
    const int tid = tid_, wid = __builtin_amdgcn_readfirstlane(tid >> 6), lane = tid & 63, wr = wid >> 2, wc = wid & 3, fr = lane & 15, fq = lane >> 4;
    const int K = g.K, nt = K / BK;
    int ts_lo = 0, ts_hi = 0, nts = 0; const unsigned long long rt_entry = STAMP ? (unsigned long long)wall_clock64() : 0ull;
#define PG8_STAMP() do { if (STAMP && wid == 0 && nts < 64) { const unsigned long long _c = (unsigned long long)clock64(); \
        ts_lo = (lane == nts) ? (int)(unsigned)_c : ts_lo; ts_hi = (lane == nts) ? (int)(unsigned)(_c >> 32) : ts_hi; ++nts; } } while (0)
    PG8_STAMP();
    unsigned voffA[2], voffB[2];
#pragma unroll
    for (int i = 0; i < 2; ++i) { int R, C; stage_rc(tid * 16 + i * 8192, R, C); const int Rb = Epi::PERM ? ((R & ~31) + perm32(R & 31)) : R;
        voffA[i] = (unsigned)(R * K + C) * 2u; voffB[i] = (unsigned)(Rb * K + C) * 2u; }
    const size_t kstep = (size_t)(BK * 2);
    const size_t hstep = (size_t)HALF * K * 2;
    const size_t tstep = 2 * hstep;
    const unsigned ldsw = (unsigned)wid * 1024u;
    const int aoff = lds_byte(wr * 64 + fr, fq * 8), boff = lds_byte(wc * 32 + fr, fq * 8);
#define PG8_SA(b, h) (((b) * 2 + (h)) * HTB)
#define PG8_SB(b, h) ((4 + (b) * 2 + (h)) * HTB)
#define PG8_STAGE(bufoff, gbase, voff) do { _Pragma("unroll") for (int _i = 0; _i < 2; ++_i) \
        __builtin_amdgcn_global_load_lds((const unsigned*)((const char*)(gbase) + (voff)[_i]), (PG8_LAS unsigned*)(lds + (bufoff) + ldsw + _i * 8192), 16, 0, 0); } while (0)
#define PG8_LDA(dst, b, h) do { _Pragma("unroll") for (int m = 0; m < 4; ++m) _Pragma("unroll") for (int k = 0; k < 2; ++k) dst[m][k] = *(const PG8_LAS bf16x8*)(lds + PG8_SA(b, h) + aoff + m * 2048 + k * 1024); } while (0)
#define PG8_LDB(dst, b, h) do { _Pragma("unroll") for (int n = 0; n < 2; ++n) _Pragma("unroll") for (int k = 0; k < 2; ++k) dst[n][k] = *(const PG8_LAS bf16x8*)(lds + PG8_SB(b, h) + boff + n * 2048 + k * 1024); } while (0)
#define PG8_MMA(ai, bj, At, Bt) do { __builtin_amdgcn_s_setprio(1); _Pragma("unroll") for (int m = 0; m < 4; ++m) _Pragma("unroll") for (int n = 0; n < 2; ++n) _Pragma("unroll") for (int k = 0; k < 2; ++k) \
        acc[ai][bj][m][n] = __builtin_amdgcn_mfma_f32_16x16x32_bf16(Bt[n][k], At[m][k], acc[ai][bj][m][n], 0, 0, 0); __builtin_amdgcn_s_setprio(0); } while (0)
#define PG8_WAIT_V(n) asm volatile("s_waitcnt vmcnt(" #n ")" ::: "memory")
#define PG8_WAIT_L(n) asm volatile("s_waitcnt lgkmcnt(" #n ")" ::: "memory")
#define PG8_BAR __builtin_amdgcn_s_barrier()
#define PG8_SCHED __builtin_amdgcn_sched_barrier(0)
    Unit cur, nxt; int ui = 0;
    if (!S.next(0, cur)) return;
    f32x4 acc[2][2][4][2];
#pragma unroll
    for (int a = 0; a < 2; ++a)
#pragma unroll
        for (int b = 0; b < 2; ++b)
#pragma unroll
            for (int m = 0; m < 4; ++m)
#pragma unroll
                for (int n = 0; n < 2; ++n) acc[a][b][m][n] = (f32x4){0.f, 0.f, 0.f, 0.f};
    bf16x8 At[4][2], B0[2][2], B1[2][2];
    const char* cA = (const char*)g.A + (size_t)cur.pm * tstep; const char* cB = (const char*)g.Bt + (size_t)cur.pn * tstep;
    S.a_ready(cur);
    PG8_STAGE(PG8_SB(0, 0), cB, voffB); PG8_STAGE(PG8_SA(0, 0), cA, voffA); PG8_STAGE(PG8_SB(0, 1), cB + hstep, voffB); PG8_STAGE(PG8_SA(0, 1), cA + hstep, voffA);
    if (wr == 1) PG8_BAR;
    PG8_WAIT_V(4); PG8_BAR;
    PG8_STAGE(PG8_SB(1, 0), cB + kstep, voffB); PG8_STAGE(PG8_SA(1, 0), cA + kstep, voffA); PG8_STAGE(PG8_SB(1, 1), cB + hstep + kstep, voffB);
    PG8_WAIT_V(6); PG8_BAR;
    PG8_STAMP();
    for (;;) {
        const bool has_next = S.next(ui + 1, nxt);
        const char* nA = has_next ? (const char*)g.A + (size_t)nxt.pm * tstep : cA; const char* nB = has_next ? (const char*)g.Bt + (size_t)nxt.pn * tstep : cB;
        for (int t = 0; t < nt; t += 2) {
            const bool last = (t == nt - 2);
            const char* a1 = cA + (size_t)(t + 1) * kstep;
            const char* a2 = last ? nA : cA + (size_t)(t + 2) * kstep; const char* b2 = last ? nB : cB + (size_t)(t + 2) * kstep;
            const char* a3 = a2 + kstep; const char* b3 = b2 + kstep;
            if (last && has_next) S.a_ready(nxt);
            PG8_LDB(B0, 0, 0); PG8_SCHED; PG8_LDA(At, 0, 0); PG8_STAGE(PG8_SA(1, 1), a1 + hstep, voffA);
            PG8_WAIT_L(8); PG8_BAR; PG8_WAIT_L(0); PG8_MMA(0, 0, At, B0); PG8_BAR; PG8_SCHED;
            PG8_LDB(B1, 0, 1); PG8_STAGE(PG8_SB(0, 0), b2, voffB);
            PG8_BAR; PG8_WAIT_L(0); PG8_MMA(0, 1, At, B1); PG8_BAR;
            PG8_LDA(At, 0, 1); PG8_STAGE(PG8_SA(0, 0), a2, voffA);
            PG8_BAR; PG8_WAIT_L(0); PG8_MMA(1, 0, At, B0); PG8_BAR; PG8_SCHED;
            PG8_STAGE(PG8_SB(0, 1), b2 + hstep, voffB);
            PG8_WAIT_V(6); PG8_BAR; PG8_MMA(1, 1, At, B1); PG8_BAR;
            PG8_LDB(B0, 1, 0); PG8_SCHED; PG8_LDA(At, 1, 0); PG8_STAGE(PG8_SA(0, 1), a2 + hstep, voffA);
            PG8_WAIT_L(8); PG8_BAR; PG8_WAIT_L(0); PG8_MMA(0, 0, At, B0); PG8_BAR; PG8_SCHED;
            PG8_LDB(B1, 1, 1); PG8_STAGE(PG8_SB(1, 0), b3, voffB);
            PG8_BAR; PG8_WAIT_L(0); PG8_MMA(0, 1, At, B1); PG8_BAR;
            PG8_LDA(At, 1, 1); PG8_STAGE(PG8_SA(1, 0), a3, voffA);
            PG8_BAR; PG8_WAIT_L(0); PG8_MMA(1, 0, At, B0); PG8_BAR; PG8_SCHED;
            PG8_STAGE(PG8_SB(1, 1), b3 + hstep, voffB);
            PG8_WAIT_V(6); PG8_BAR; PG8_MMA(1, 1, At, B1); PG8_BAR;
        }
        PG8_STAMP();
        if constexpr (!Epi::AFTER_DRAIN) { E(acc, cur, wr, wc, fr, fq); S.done(cur); }
        PG8_STAMP();
        if (!has_next) break;
#pragma unroll
        for (int a = 0; a < 2; ++a)
#pragma unroll
            for (int b = 0; b < 2; ++b)
#pragma unroll
                for (int m = 0; m < 4; ++m)
#pragma unroll
                    for (int n = 0; n < 2; ++n) acc[a][b][m][n] = (f32x4){0.f, 0.f, 0.f, 0.f};
        cur = nxt; cA = nA; cB = nB; ++ui;
    }
    PG8_WAIT_V(0);
    if (wr == 0) PG8_BAR;
    PG8_BAR;
    if constexpr (Epi::AFTER_DRAIN) { E.fused(acc, cur, wr, wc, fr, fq, lds, wid, lane); S.done(cur); }
    PG8_STAMP();
    if (STAMP && wid == 0) { stamps[lane] = lane < nts ? (((unsigned long long)(unsigned)ts_hi << 32) | (unsigned)ts_lo) : 0ull;
        if (lane == 62) stamps[62] = rt_entry; if (lane == 63) stamps[63] = (unsigned long long)wall_clock64(); }
#undef PG8_STAMP
#undef PG8_SA
#undef PG8_SB
#undef PG8_STAGE
#undef PG8_LDA
#undef PG8_LDB
#undef PG8_MMA
#undef PG8_WAIT_V
#undef PG8_WAIT_L
#undef PG8_BAR
#undef PG8_SCHED
}
}
#define XB_TMO      128
#define XB_XCNT(j)  (256  + 64 * (j))
#define XB_XSUB(j)  (1280 + 64 * (j))
#define XB_XGEN(j)  (2304 + 64 * (j))
#define XB_TOP      3328
#define XB_TOPGEN   3392
#define XCD_BAR_WORDS 3456
#define XB_SPIN_CAP (1u << 18)
#define LAS __attribute__((address_space(3)))

__device__ __forceinline__ unsigned xb_ld(unsigned* p)              { return __hip_atomic_load(p, __ATOMIC_RELAXED, __HIP_MEMORY_SCOPE_AGENT); }
__device__ __forceinline__ unsigned xb_add(unsigned* p, unsigned v) { return __hip_atomic_fetch_add(p, v, __ATOMIC_RELAXED, __HIP_MEMORY_SCOPE_AGENT); }
__device__ __forceinline__ unsigned xb_xcc_id() { return (unsigned)__builtin_amdgcn_s_getreg((3 << 11) | 20) & 0xFu; }
#define XB_SPIN(cond, bar) do { unsigned _sp = 0; while (cond) { __builtin_amdgcn_s_sleep(1); \
    if ((++_sp & 255u) == 0u) { if (xb_ld(&(bar)[XB_TMO])) break; if (_sp > XB_SPIN_CAP) { atomicAdd(&(bar)[XB_TMO], 1u); break; } } } } while (0)

struct XcdBarrier {
    unsigned* bar; unsigned x;
    volatile LAS unsigned* st;
};

__device__ __forceinline__ XcdBarrier xcd_barrier_post(unsigned* bar, volatile LAS unsigned* st) {
    XcdBarrier b; b.bar = bar; b.x = xb_xcc_id(); b.st = st;
    if (threadIdx.x == 0) (void)xb_add(&bar[XB_XCNT(b.x)], 1u);
    return b;
}
__device__ __forceinline__ void xcd_barrier_complete(unsigned* bar, unsigned x, unsigned& nloc, unsigned& nx) {
    const unsigned G = gridDim.x * gridDim.y * gridDim.z;
    unsigned sum, cnt, mine, sp = 0u;
    for (;;) {
        sum = 0u; cnt = 0u; mine = 0u;
#pragma unroll
        for (unsigned j = 0; j < 16; ++j) { const unsigned c = xb_ld(&bar[XB_XCNT(j)]); sum += c; cnt += (c > 0u) ? 1u : 0u; mine = (j == x) ? c : mine; }
        if (sum == G) break;
        __builtin_amdgcn_s_sleep(1);
        if ((++sp & 255u) == 0u) { if (xb_ld(&bar[XB_TMO])) break; if (sp > XB_SPIN_CAP) { atomicAdd(&bar[XB_TMO], 1u); break; } }
    }
    nloc = mine > 0u ? mine : 1u; nx = cnt > 0u ? cnt : 1u;
}

__device__ __forceinline__ void xcd_barrier(const XcdBarrier& b) {
    asm volatile("s_waitcnt vmcnt(0)" ::: "memory");
    __syncthreads();
    if (threadIdx.x == 0) {
        unsigned* bar = b.bar;
        __builtin_amdgcn_s_waitcnt(0);
        unsigned nloc = b.st[0], nx = b.st[1];
        if (nloc == 0u) { xcd_barrier_complete(bar, b.x, nloc, nx); b.st[0] = nloc; b.st[1] = nx; }
        const unsigned old = xb_add(&bar[XB_XSUB(b.x)], 1u);
        const unsigned gen = old / nloc;
        if (old + 1u == (gen + 1u) * nloc) {
            __builtin_amdgcn_fence(__ATOMIC_RELEASE, "agent");
            asm volatile("s_waitcnt vmcnt(0)" ::: "memory");
            const unsigned og = xb_add(&bar[XB_TOP], 1u);
            const unsigned tg = og / nx;
            if (og + 1u == (tg + 1u) * nx) xb_add(&bar[XB_TOPGEN], 1u);
            else XB_SPIN(xb_ld(&bar[XB_TOPGEN]) == tg, bar);
            __builtin_amdgcn_fence(__ATOMIC_ACQUIRE, "agent");
            xb_add(&bar[XB_XGEN(b.x)], 1u);
            asm volatile("s_waitcnt vmcnt(0)" ::: "memory");
        } else {
            XB_SPIN(xb_ld(&bar[XB_XGEN(b.x)]) == gen, bar);
            __builtin_amdgcn_fence(__ATOMIC_ACQUIRE, "agent");
            asm volatile("s_waitcnt vmcnt(0)" ::: "memory");
        }
    }
    __syncthreads();
}

namespace mk {
using pg8::bf16_t; using pg8::bf16x8; using pg8::f32x4; using pg8::u32x4;
typedef unsigned u32x2 __attribute__((ext_vector_type(2)));
typedef __bf16 bf16x2_t __attribute__((ext_vector_type(2)));
typedef LAS unsigned char* lds_t;

constexpr int DM = 1024, NLAT = 16384, NROW = 16896;
constexpr int OFF_B = 512, OFF_C = 1024, OFF_D = 2056, INC = 3208, NP = 3328;
constexpr int NCH = 132, NSLOT = 16 * NCH;
constexpr int NEXP = 16384;

constexpr size_t WS_CTL  = 0;
constexpr size_t WS_MOD  = 65536;
constexpr size_t WS_WIN  = WS_MOD + 147456;
constexpr size_t WS_WOUT = WS_WIN + 2ull * NP * DM * 2;
constexpr size_t WS_WQ   = WS_WOUT + 2ull * DM * DM * 2;
constexpr size_t WS_H    = WS_WQ + 2ull * 2048 * DM * 2;
constexpr size_t WS_ACT  = WS_H + (size_t)NROW * DM * 4;
constexpr size_t WS_UB   = WS_ACT + (size_t)NROW * DM * 2;
constexpr size_t WS_VB   = WS_UB + (size_t)NEXP * DM * 2;
constexpr size_t WS_SU   = WS_UB + (size_t)NEXP * DM;
constexpr size_t WS_SV   = WS_VB + (size_t)NEXP * DM;
constexpr size_t WS_P    = WS_VB + (size_t)NEXP * DM * 2;
constexpr size_t WS_Q    = WS_P;
constexpr size_t WS_SELI = WS_Q + (size_t)NROW * 2048 * 2;
constexpr size_t WS_SELG = WS_SELI + (size_t)NROW * 128 * 4;
constexpr size_t WS_MST  = WS_P + (size_t)NROW * NP * 2;
constexpr size_t WS_MCD  = WS_MST + (size_t)NSLOT * 8192 * 4;
constexpr size_t WS_RG   = WS_MCD + 16384;
constexpr size_t WS_RJ   = WS_RG + (size_t)NSLOT * 8192;
constexpr size_t WS_RY   = WS_RJ + (size_t)NSLOT * 16384;
constexpr size_t WS_RL   = WS_RY + (size_t)NSLOT * 8192;
constexpr size_t WS_RH   = WS_RL + (size_t)NSLOT * 8192;
constexpr size_t WS_BON  = WS_RH + (size_t)NSLOT * 8192;
constexpr size_t WS_END  = WS_BON + (size_t)NROW * 8 * 4;
static_assert(WS_SELG + (size_t)NROW * 128 * 4 <= WS_MST, "Q + selections must fit in P's region");

constexpr int LDS_BYTES = 157440;
constexpr int LDS_XB = 157184;

struct Args { const float* in[42]; float* out; unsigned char* ws; int ph_lo, ph_hi; };

struct Ctx {
    const float* const* in; float* out; unsigned char* ws; lds_t lds;
    int tid, lane, wid, bid, G;
};

__device__ __forceinline__ float bf2f(unsigned short x) { return __uint_as_float(((unsigned)x) << 16); }
__device__ __forceinline__ float bflo(unsigned w) { return __uint_as_float(w << 16); }
__device__ __forceinline__ float bfhi(unsigned w) { return __uint_as_float(w & 0xffff0000u); }
__device__ __forceinline__ unsigned pk2(float lo, float hi) { return pg8::cvt_pk_bf16(lo, hi); }
__device__ __forceinline__ unsigned short f2bf(float f) { return (unsigned short)(pk2(f, 0.f) & 0xffffu); }
__device__ __forceinline__ float wave_sum(float v) {
#pragma unroll
    for (int o = 1; o < 64; o <<= 1) v += __shfl_xor(v, o);
    return v;
}
__device__ __forceinline__ float wave_incl_scan(float v, int lane) {
#pragma unroll
    for (int o = 1; o < 64; o <<= 1) { const float t = __shfl_up(v, o); v += (lane >= o) ? t : 0.f; }
    return v;
}
__device__ __forceinline__ float sigm(float x) { return 1.f / (1.f + expf(-x)); }
__device__ __forceinline__ float silu(float x) { return x / (1.f + expf(-x)); }
__device__ __forceinline__ float softplus(float x) { return fmaxf(x, 0.f) + log1pf(expf(-fabsf(x))); }
__device__ __forceinline__ float gelu_tanh(float x) { const float u = 0.7978845608028654f * (x + 0.044715f * x * x * x); return 0.5f * x * (1.f + tanhf(u)); }
__device__ __forceinline__ float dot2bf(unsigned a, unsigned b, float acc) { return __builtin_amdgcn_fdot2_f32_bf16(__builtin_bit_cast(bf16x2_t, a), __builtin_bit_cast(bf16x2_t, b), acc, false); }

struct ChunkInfo { int row0, lo, hi, b, tc, isctx; };
__device__ __forceinline__ ChunkInfo chunk_info(int gc) {
    ChunkInfo c; c.row0 = gc * 64;
    if (gc < 256) { c.b = gc >> 7; c.tc = gc & 127; c.isctx = 0; c.lo = c.b * 8192; c.hi = c.lo + 8192; }
    else { const int q = gc - 256; c.b = q >> 2; c.tc = q & 3; c.isctx = 1; c.lo = NLAT + c.b * 256; c.hi = c.lo + 256; }
    return c;
}
__device__ __forceinline__ int cpos_of(const ChunkInfo& c, int d) { return c.isctx ? (d ? 3 - c.tc : c.tc) : (d ? 4 + 127 - c.tc : 4 + c.tc); }
__device__ __forceinline__ int slot_of(int b, int h, int d, int cpos) { return ((b * 4 + h) * 2 + d) * NCH + cpos; }

template <int MT, int NT, int KS, class Epi>
__device__ __forceinline__ void blk_mma(const LAS bf16_t* A, int lda, const LAS bf16_t* Bt, int ldb, int wid, int lane, Epi epi) {
    const int fr = lane & 15, fq = lane >> 4;
    for (int tt = wid; tt < MT * NT; tt += 8) {
        const int tm = tt / NT, tn = tt % NT;
        f32x4 acc = {0.f, 0.f, 0.f, 0.f};
#pragma unroll
        for (int ks = 0; ks < KS; ++ks) {
            const bf16x8 a = *(const LAS bf16x8*)(A + (tm * 16 + fr) * lda + ks * 32 + fq * 8);
            const bf16x8 b = *(const LAS bf16x8*)(Bt + (tn * 16 + fr) * ldb + ks * 32 + fq * 8);
            acc = __builtin_amdgcn_mfma_f32_16x16x32_bf16(a, b, acc, 0, 0, 0);
        }
        epi(tm * 16 + fq * 4, tn * 16 + fr, acc);
    }
}
template <int MT, int NT, int KS, class Epi>
__device__ __forceinline__ void blk_mma2(const LAS bf16_t* A1, const LAS bf16_t* B1, const LAS bf16_t* A2, const LAS bf16_t* B2, int ld, int wid, int lane, Epi epi) {
    const int fr = lane & 15, fq = lane >> 4;
    for (int tt = wid; tt < MT * NT; tt += 8) {
        const int tm = tt / NT, tn = tt % NT;
        f32x4 acc1 = {0.f, 0.f, 0.f, 0.f}, acc2 = {0.f, 0.f, 0.f, 0.f};
#pragma unroll
        for (int ks = 0; ks < KS; ++ks) {
            const bf16x8 a1 = *(const LAS bf16x8*)(A1 + (tm * 16 + fr) * ld + ks * 32 + fq * 8);
            const bf16x8 b1 = *(const LAS bf16x8*)(B1 + (tn * 16 + fr) * ld + ks * 32 + fq * 8);
            acc1 = __builtin_amdgcn_mfma_f32_16x16x32_bf16(a1, b1, acc1, 0, 0, 0);
            const bf16x8 a2 = *(const LAS bf16x8*)(A2 + (tm * 16 + fr) * ld + ks * 32 + fq * 8);
            const bf16x8 b2 = *(const LAS bf16x8*)(B2 + (tn * 16 + fr) * ld + ks * 32 + fq * 8);
            acc2 = __builtin_amdgcn_mfma_f32_16x16x32_bf16(a2, b2, acc2, 0, 0, 0);
        }
        epi(tm * 16 + fq * 4, tn * 16 + fr, acc1, acc2);
    }
}

__device__ __forceinline__ void transpose_item(const float* W, int K, int N, int nblk, bf16_t* WT, LAS float* scr, int item, int lane) {
    const int kb = item / nblk, nb = item % nblk, k0 = 64 * kb, n0 = 32 * nb;
    const int nn = n0 + (lane & 31);
#pragma unroll 8
    for (int i = 0; i < 32; ++i) { const int kk = 2 * i + (lane >> 5); scr[kk * 33 + (lane & 31)] = (nn < N) ? W[(size_t)(k0 + kk) * N + nn] : 0.f; }
    asm volatile("s_waitcnt lgkmcnt(0)" ::: "memory");
    const int c = lane & 7;
#pragma unroll
    for (int j = 0; j < 4; ++j) { const int n = (lane >> 3) + 8 * j; const LAS float* s = scr + (8 * c) * 33 + n;
        u32x4 o; o.x = pk2(s[0 * 33], s[1 * 33]); o.y = pk2(s[2 * 33], s[3 * 33]); o.z = pk2(s[4 * 33], s[5 * 33]); o.w = pk2(s[6 * 33], s[7 * 33]);
        *(u32x4*)(WT + (size_t)(n0 + n) * K + k0 + 8 * c) = o; }
    asm volatile("s_waitcnt lgkmcnt(0)" ::: "memory");
}
__device__ __forceinline__ float wave_maxf(float v) {
#pragma unroll
    for (int o = 1; o < 64; o <<= 1) v = fmaxf(v, __shfl_xor(v, o));
    return v;
}
__device__ __forceinline__ void convert_tables(const Ctx& C, int layer) {
    const float* U = C.in[39] + (size_t)layer * NEXP * DM; const float* V = C.in[40] + (size_t)layer * NEXP * DM;
    unsigned char* UB = C.ws + WS_UB; unsigned char* VB = C.ws + WS_VB; float* SU = (float*)(C.ws + WS_SU); float* SV = (float*)(C.ws + WS_SV);
    for (int r = C.bid * 8 + C.wid; r < 2 * NEXP; r += C.G * 8) {
        const bool isv = r >= NEXP; const int row = isv ? r - NEXP : r;
        const float* src = (isv ? V : U) + (size_t)row * DM + 16 * C.lane;
        f32x4 x[4]; float m = 0.f;
#pragma unroll
        for (int k = 0; k < 4; ++k) { x[k] = *(const f32x4*)(src + 4 * k); m = fmaxf(fmaxf(m, fmaxf(fabsf(x[k].x), fabsf(x[k].y))), fmaxf(fabsf(x[k].z), fabsf(x[k].w))); }
        m = wave_maxf(m);
        const float sc = m > 0.f ? 224.f / m : 1.f;
        u32x4 o;
#pragma unroll
        for (int k = 0; k < 4; ++k) { int w = __builtin_amdgcn_cvt_pk_fp8_f32(x[k].x * sc, x[k].y * sc, 0, false); w = __builtin_amdgcn_cvt_pk_fp8_f32(x[k].z * sc, x[k].w * sc, w, true); o[k] = (unsigned)w; }
        *(u32x4*)((isv ? VB : UB) + (size_t)row * DM + 16 * C.lane) = o;
        if (C.lane == 0) (isv ? SV : SU)[row] = m > 0.f ? m * (1.f / 224.f) : 1.f;
    }
}
__device__ __forceinline__ void ph_prologue(const Ctx& C) {
    const int gw = C.bid * 8 + C.wid, NGW = C.G * 8;
    {
        LAS float* scr = (LAS float*)(C.lds + C.wid * 16384);
        bf16_t* WIN = (bf16_t*)(C.ws + WS_WIN); bf16_t* WOUT = (bf16_t*)(C.ws + WS_WOUT); bf16_t* WQ = (bf16_t*)(C.ws + WS_WQ);
        for (int it = gw; it < 6400; it += NGW) {
            const int layer = it / 3200; int r = it % 3200;
            if (r < 1664) { transpose_item(C.in[8] + (size_t)layer * DM * INC, DM, INC, 104, WIN + (size_t)layer * NP * DM, scr, r, C.lane); continue; } r -= 1664;
            if (r < 512) { transpose_item(C.in[9] + (size_t)layer * DM * DM, DM, DM, 32, WOUT + (size_t)layer * DM * DM, scr, r, C.lane); continue; } r -= 512;
            transpose_item(C.in[36] + (size_t)layer * DM * 2048, DM, 2048, 64, WQ + (size_t)layer * 2048 * DM, scr, r, C.lane);
        }
    }
    __syncthreads();
    {
        LAS float* sv = (LAS float*)C.lds;
        LAS float* red = (LAS float*)(C.lds + 12288);
        for (int i = C.tid; i < 3 * 1024; i += 512) { const int w = i >> 10, k = i & 1023; const float x = (w < 2) ? C.in[1][w * 1024 + k] : C.in[3][k]; sv[i] = silu(x); }
        __syncthreads();
        float* MOD = (float*)(C.ws + WS_MOD);
        for (int it = C.bid; it < 192; it += C.G) {
            const int layer = it / 96, col0 = (it % 96) * 64, col = C.tid & 63, kg = C.tid >> 6;
            const float* W = C.in[4] + (size_t)layer * DM * 6144 + col0 + col;
            float a0 = 0.f, a1 = 0.f, a2 = 0.f;
#pragma unroll 8
            for (int k = kg * 128; k < kg * 128 + 128; ++k) { const float w = W[(size_t)k * 6144]; a0 += sv[k] * w; a1 += sv[1024 + k] * w; a2 += sv[2048 + k] * w; }
            red[(kg * 3 + 0) * 64 + col] = a0; red[(kg * 3 + 1) * 64 + col] = a1; red[(kg * 3 + 2) * 64 + col] = a2;
            __syncthreads();
            if (C.tid < 192) { const int w = C.tid >> 6, c2 = C.tid & 63; float s = 0.f;
#pragma unroll
                for (int g = 0; g < 8; ++g) s += red[(g * 3 + w) * 64 + c2];
                MOD[((size_t)layer * 3 + w) * 6144 + col0 + c2] = s + C.in[5][layer * 6144 + col0 + c2]; }
            __syncthreads();
        }
    }
    {
        float* H = (float*)(C.ws + WS_H);
        const size_t n4 = (size_t)NROW * 256;
        for (size_t i = (size_t)C.bid * 512 + C.tid; i < n4; i += (size_t)C.G * 512) {
            const int row = (int)(i >> 8), c4 = (int)(i & 255) * 4;
            f32x4 v;
            if (row < NLAT) {
                v = *(const f32x4*)(C.in[0] + (size_t)row * DM + c4);
                const int t = row & 8191, quarter = c4 >> 8; const float pos = (quarter < 2) ? (float)(t >> 6) : (float)(t & 63);
                float e[4];
#pragma unroll
                for (int j = 0; j < 4; ++j) { const int jj = (c4 & 255) + j; const float fr = exp2f(-(float)jj * (13.287712379549449f / 256.f)); const float a = pos * fr; e[j] = (quarter & 1) ? cosf(a) : sinf(a); }
                v.x += e[0]; v.y += e[1]; v.z += e[2]; v.w += e[3];
            } else v = *(const f32x4*)(C.in[2] + (size_t)(row - NLAT) * DM + c4);
            *(f32x4*)(H + (size_t)row * DM + c4) = v;
        }
    }
    convert_tables(C, 0);
}

struct Row16 { float v[16]; };
__device__ __forceinline__ Row16 load_row16(const float* p, int lane) {
    Row16 r; const f32x4 a = *(const f32x4*)(p + 8 * lane), b = *(const f32x4*)(p + 8 * lane + 4), c = *(const f32x4*)(p + 512 + 8 * lane), d = *(const f32x4*)(p + 512 + 8 * lane + 4);
    r.v[0] = a.x; r.v[1] = a.y; r.v[2] = a.z; r.v[3] = a.w; r.v[4] = b.x; r.v[5] = b.y; r.v[6] = b.z; r.v[7] = b.w;
    r.v[8] = c.x; r.v[9] = c.y; r.v[10] = c.z; r.v[11] = c.w; r.v[12] = d.x; r.v[13] = d.y; r.v[14] = d.z; r.v[15] = d.w; return r;
}
__device__ __forceinline__ void store_row16_f32(float* p, int lane, const Row16& r) {
    *(f32x4*)(p + 8 * lane) = (f32x4){r.v[0], r.v[1], r.v[2], r.v[3]}; *(f32x4*)(p + 8 * lane + 4) = (f32x4){r.v[4], r.v[5], r.v[6], r.v[7]};
    *(f32x4*)(p + 512 + 8 * lane) = (f32x4){r.v[8], r.v[9], r.v[10], r.v[11]}; *(f32x4*)(p + 512 + 8 * lane + 4) = (f32x4){r.v[12], r.v[13], r.v[14], r.v[15]};
}
__device__ __forceinline__ void store_row16_bf16(bf16_t* p, int lane, const Row16& r) {
    u32x4 a, b; a.x = pk2(r.v[0], r.v[1]); a.y = pk2(r.v[2], r.v[3]); a.z = pk2(r.v[4], r.v[5]); a.w = pk2(r.v[6], r.v[7]);
    b.x = pk2(r.v[8], r.v[9]); b.y = pk2(r.v[10], r.v[11]); b.z = pk2(r.v[12], r.v[13]); b.w = pk2(r.v[14], r.v[15]);
    *(u32x4*)(p + 8 * lane) = a; *(u32x4*)(p + 512 + 8 * lane) = b;
}
__device__ __forceinline__ Row16 norm_mod_row(const Row16& x, const float* g, const float* shift, const float* scale, int lane) {
    float ss = 0.f;
#pragma unroll
    for (int i = 0; i < 16; ++i) ss += x.v[i] * x.v[i];
    const float rs = rsqrtf(wave_sum(ss) * (1.f / 1024.f) + 1e-6f);
    const Row16 gg = load_row16(g, lane), sh = load_row16(shift, lane), sc = load_row16(scale, lane);
    Row16 o;
#pragma unroll
    for (int i = 0; i < 16; ++i) o.v[i] = (x.v[i] * rs * gg.v[i]) * (1.f + sc.v[i]) + sh.v[i];
    return o;
}
__device__ __forceinline__ int which_of(int row) { return row < 8192 ? 0 : (row < NLAT ? 1 : 2); }
__device__ __forceinline__ void ph_norm(const Ctx& C, int layer, const float* gain, int sidx, int nrows) {
    const float* H = (const float*)(C.ws + WS_H); bf16_t* ACT = (bf16_t*)(C.ws + WS_ACT); const float* MOD = (const float*)(C.ws + WS_MOD);
    for (int row = C.bid * 8 + C.wid; row < nrows; row += C.G * 8) {
        const float* m = MOD + ((size_t)layer * 3 + which_of(row)) * 6144;
        const Row16 x = load_row16(H + (size_t)row * DM, C.lane);
        const Row16 o = norm_mod_row(x, gain, m + sidx * 1024, m + (sidx + 1) * 1024, C.lane);
        store_row16_bf16(ACT + (size_t)row * DM, C.lane, o);
    }
}
struct EpiResid {
    static constexpr bool PERM = false, AFTER_DRAIN = false;
    float* H; const float* modl;
    __device__ __forceinline__ void operator()(const f32x4 (&acc)[2][2][4][2], const pg8::Unit& u, int wr, int wc, int fr, int fq) const {
        const int row0 = u.pm * 256 + wr * 64 + fr, col0 = u.pn * 256 + wc * 32 + 4 * fq;
        const int which = u.pm < 32 ? 0 : (u.pm < 64 ? 1 : 2);
        const float* gate = modl + ((size_t)which * 6 + 2) * 1024;
        f32x4 gv[2][2];
#pragma unroll
        for (int bj = 0; bj < 2; ++bj)
#pragma unroll
            for (int n = 0; n < 2; ++n) gv[bj][n] = *(const f32x4*)(gate + col0 + bj * 128 + n * 16);
#pragma unroll
        for (int ai = 0; ai < 2; ++ai)
#pragma unroll
            for (int m = 0; m < 4; ++m) { float* rowp = H + (size_t)(row0 + ai * 128 + m * 16) * DM + col0;
#pragma unroll
                for (int bj = 0; bj < 2; ++bj)
#pragma unroll
                    for (int n = 0; n < 2; ++n) { f32x4* p = (f32x4*)(rowp + bj * 128 + n * 16); *p = *p + gv[bj][n] * acc[ai][bj][m][n]; } }
    }
};

__device__ __forceinline__ void item_conformer(const Ctx& C, int layer, int gc) {
    const ChunkInfo ci = chunk_info(gc);
    const bf16_t* P = (const bf16_t*)(C.ws + WS_P); bf16_t* YC = (bf16_t*)(C.ws + WS_ACT);
    LAS bf16_t* HG = (LAS bf16_t*)C.lds;
    LAS float* CO = (LAS float*)(C.lds + 49152);
    for (int e = C.tid; e < 94 * 128; e += 512) {
        const int rr = e >> 7, cp = e & 127, grow = ci.row0 - 15 + rr;
        unsigned o = 0u;
        if (grow >= ci.lo && grow < ci.hi) {
            const unsigned v = *(const unsigned*)(P + (size_t)grow * NP + 2 * cp), g = *(const unsigned*)(P + (size_t)grow * NP + 256 + 2 * cp);
            o = pk2(bflo(v) * sigm(bflo(g)), bfhi(v) * sigm(bfhi(g)));
        }
        *(LAS unsigned*)(HG + rr * 256 + 2 * cp) = o;
    }
    __syncthreads();
    {
        const int c = C.tid & 255, half = C.tid >> 8;
        const float* cw = C.in[10] + (size_t)layer * 31 * 256 + c;
        float w[31];
#pragma unroll
        for (int j = 0; j < 31; ++j) w[j] = cw[j * 256];
        const float bias = C.in[11][layer * 256 + c];
        for (int tt = 0; tt < 32; ++tt) {
            const int t = half * 32 + tt; float acc = bias;
#pragma unroll
            for (int j = 0; j < 31; ++j) acc += w[j] * bf2f(HG[(t + j) * 256 + c]);
            CO[t * 256 + c] = acc;
        }
    }
    __syncthreads();
    {
        const float* lg = C.in[12] + layer * 256 + 4 * C.lane; const float* lb = C.in[13] + layer * 256 + 4 * C.lane;
        const f32x4 g4 = *(const f32x4*)lg, b4 = *(const f32x4*)lb;
        for (int i = 0; i < 8; ++i) {
            const int t = C.wid * 8 + i;
            const f32x4 x = *(const LAS f32x4*)(CO + t * 256 + 4 * C.lane);
            const float mean = wave_sum((x.x + x.y) + (x.z + x.w)) * (1.f / 256.f);
            const f32x4 d = x - mean;
            const float var = wave_sum((d.x * d.x + d.y * d.y) + (d.z * d.z + d.w * d.w)) * (1.f / 256.f);
            const float rs = rsqrtf(var + 1e-5f);
            const f32x4 y = d * rs * g4 + b4;
            u32x2 o; o.x = pk2(silu(y.x), silu(y.y)); o.y = pk2(silu(y.z), silu(y.w));
            *(u32x2*)(YC + (size_t)(ci.row0 + t) * DM + 4 * C.lane) = o;
        }
    }
    __syncthreads();
}

__device__ __forceinline__ void item_chunkmlp(const Ctx& C, int layer, int gb) {
    const int row0 = gb * 128;
    const bf16_t* P = (const bf16_t*)(C.ws + WS_P); bf16_t* YC = (bf16_t*)(C.ws + WS_ACT);
    LAS bf16_t* VNT = (LAS bf16_t*)C.lds;
    LAS bf16_t* WS = (LAS bf16_t*)(C.lds + 69632);
    {
        const f32x4 g4 = *(const f32x4*)(C.in[14] + layer * 256 + 4 * C.lane), b4 = *(const f32x4*)(C.in[15] + layer * 256 + 4 * C.lane);
        for (int i = 0; i < 16; ++i) {
            const int j = C.wid * 16 + i;
            const u32x2 raw = *(const u32x2*)(P + (size_t)(row0 + j) * NP + 768 + 4 * C.lane);
            const f32x4 x = {bflo(raw.x), bfhi(raw.x), bflo(raw.y), bfhi(raw.y)};
            const float mean = wave_sum((x.x + x.y) + (x.z + x.w)) * (1.f / 256.f);
            const f32x4 d = x - mean;
            const float var = wave_sum((d.x * d.x + d.y * d.y) + (d.z * d.z + d.w * d.w)) * (1.f / 256.f);
            const f32x4 y = d * rsqrtf(var + 1e-5f) * g4 + b4;
            VNT[(4 * C.lane + 0) * 136 + j] = f2bf(y.x); VNT[(4 * C.lane + 1) * 136 + j] = f2bf(y.y);
            VNT[(4 * C.lane + 2) * 136 + j] = f2bf(y.z); VNT[(4 * C.lane + 3) * 136 + j] = f2bf(y.w);
        }
    }
    for (int h = 0; h < 4; ++h) {
        const float* ws = C.in[16] + ((size_t)layer * 4 + h) * 128 * 128;
        for (int e = C.tid; e < 4096; e += 512) { const int i = e >> 5, j4 = (e & 31) * 4; const f32x4 w = *(const f32x4*)(ws + i * 128 + j4);
            u32x2 o; o.x = pk2(w.x, w.y); o.y = pk2(w.z, w.w); *(LAS u32x2*)(WS + i * 136 + j4) = o; }
        __syncthreads();
        const float* bs = C.in[17] + ((size_t)layer * 4 + h) * 128;
        blk_mma<8, 4, 4>(WS, 136, VNT + h * 64 * 136, 136, C.wid, C.lane, [=](int r0, int col, const f32x4& acc) {
#pragma unroll
            for (int jj = 0; jj < 4; ++jj) { const int i = r0 + jj; const size_t row = (size_t)(row0 + i);
                const float u = bf2f(P[row * NP + 512 + h * 64 + col]);
                YC[row * DM + 256 + h * 64 + col] = f2bf((acc[jj] + bs[i]) * u); }
        });
        __syncthreads();
    }
}

__device__ __forceinline__ void item_mamba_local(const Ctx& C, int layer, int gc) {
    const ChunkInfo ci = chunk_info(gc);
    const bf16_t* P = (const bf16_t*)(C.ws + WS_P);
    float* MST = (float*)(C.ws + WS_MST); float* MCD = (float*)(C.ws + WS_MCD);
    LAS float* DA = (LAS float*)C.lds;
    LAS float* DT = (LAS float*)(C.lds + 2048);
    LAS float* FAC = (LAS float*)(C.lds + 4096);
    LAS bf16_t* XDT = (LAS bf16_t*)(C.lds + 8192);
    LAS bf16_t* BTT = (LAS bf16_t*)(C.lds + 8192 + 73728);
    {
        const int s = C.lane, dh = C.wid, d = dh >> 2, h = dh & 3;
        const float raw = bf2f(P[(size_t)(ci.row0 + s) * NP + OFF_C + 1024 + dh]);
        const float dt = softplus(raw + C.in[20][layer * 8 + dh]);
        const float da = dt * (-expf(C.in[21][layer * 8 + dh]));
        const float incl = wave_incl_scan(da, s), total = __shfl(incl, 63);
        DT[dh * 64 + s] = dt; DA[dh * 64 + s] = da;
        FAC[dh * 64 + s] = d ? expf(incl - da) : expf(total - incl);
        if (s == 0) MCD[slot_of(ci.b, h, d, cpos_of(ci, d))] = expf(total);
    }
    __syncthreads();
    {
        const int cp = C.tid & 255, half = C.tid >> 8, c0 = 2 * cp;
        const float* cw = C.in[18] + (size_t)layer * 5 * 768 + c0; const float* cb = C.in[19] + layer * 768 + c0;
        float w0[5], w1[5];
#pragma unroll
        for (int j = 0; j < 5; ++j) { w0[j] = cw[j * 768]; w1[j] = cw[j * 768 + 1]; }
        const float b0 = cb[0], b1 = cb[1];
        const int s0 = half * 32;
        unsigned win[5];
#pragma unroll
        for (int j = 0; j < 4; ++j) { const int row = ci.row0 + s0 - 2 + j; win[j + 1] = (row >= ci.lo && row < ci.hi) ? *(const unsigned*)(P + (size_t)row * NP + OFF_C + 256 + c0) : 0u; }
        for (int tt = 0; tt < 32; ++tt) {
            const int s = s0 + tt;
#pragma unroll
            for (int j = 0; j < 4; ++j) win[j] = win[j + 1];
            { const int row = ci.row0 + s + 2; win[4] = (row >= ci.lo && row < ci.hi) ? *(const unsigned*)(P + (size_t)row * NP + OFF_C + 256 + c0) : 0u; }
            float a0 = b0, a1 = b1;
#pragma unroll
            for (int j = 0; j < 5; ++j) { a0 += w0[j] * bflo(win[j]); a1 += w1[j] * bfhi(win[j]); }
            a0 = silu(a0); a1 = silu(a1);
            if (c0 < 256) { const int h = c0 >> 6;
#pragma unroll
                for (int d = 0; d < 2; ++d) { const float f = DT[(d * 4 + h) * 64 + s] * FAC[(d * 4 + h) * 64 + s];
                    XDT[(d * 256 + c0) * 72 + s] = f2bf(a0 * f); XDT[(d * 256 + c0 + 1) * 72 + s] = f2bf(a1 * f); }
            } else { const int q = c0 - 256; BTT[q * 72 + s] = f2bf(a0); BTT[(q + 1) * 72 + s] = f2bf(a1); }
        }
    }
    __syncthreads();
    for (int hd = 0; hd < 8; ++hd) {
        const int d = hd >> 2, h = hd & 3;
        float* dst = MST + (size_t)slot_of(ci.b, h, d, cpos_of(ci, d)) * 8192;
        blk_mma<4, 8, 2>(XDT + (d * 256 + h * 64) * 72, 72, BTT + (h >> 1) * 128 * 72, 72, C.wid, C.lane, [=](int r0, int col, const f32x4& acc) {
#pragma unroll
            for (int jj = 0; jj < 4; ++jj) dst[(r0 + jj) * 128 + col] = acc[jj];
        });
    }
    __syncthreads();
}


#ifndef MK_DIAG2
#define MK_DIAG2 1
#endif
#if MK_DIAG2
#define DBGF(stage, cond) do { if (cond) atomicOr((unsigned*)(C.ws + 32768) + (stage), 1u); } while (0)
#define DBGL(stage, cond) do { if (cond) atomicOr(dbgflags + (stage), 1u); } while (0)
#else
#define DBGF(stage, cond) do {} while (0)
#define DBGL(stage, cond) do {} while (0)
#endif
__device__ __forceinline__ bool badv(float x, float lim) { return !(fabsf(x) < lim); }
__device__ __forceinline__ void tri_inverse(const LAS float* ABf, LAS float* Tf, LAS float* Rt, LAS bf16_t* TT, int tid, int wid, int lane) {
    if (wid == 0) {
        const int bi = lane >> 4, j = lane & 15; const LAS float* Ab = ABf + (16 * bi) * 68 + 16 * bi;
        float col[16];
#pragma unroll
        for (int r = 0; r < 16; ++r) { float acc = (r == j) ? 1.f : 0.f;
#pragma unroll
            for (int s = 0; s < r; ++s) acc -= Ab[r * 68 + s] * col[s];
            col[r] = acc; }
#pragma unroll
        for (int r = 0; r < 16; ++r) Tf[(16 * bi + r) * 68 + 16 * bi + j] = col[r];
    } else {
        for (int e = tid - 64; e < 64 * 64; e += 448) { const int t = e >> 6, s2 = e & 63; if ((s2 >> 4) > (t >> 4)) Tf[t * 68 + s2] = 0.f; }
    }
    __syncthreads();
#pragma unroll
    for (int i = 1; i < 4; ++i) {
        const int nc = 16 * i;
        for (int e = tid; e < 16 * nc; e += 512) { const int r = e / nc, c = e % nc; float s0 = 0.f, s1 = 0.f;
#pragma unroll
            for (int s2 = 0; s2 < nc; s2 += 2) { s0 += ABf[(nc + r) * 68 + s2] * Tf[s2 * 68 + c]; s1 += ABf[(nc + r) * 68 + s2 + 1] * Tf[(s2 + 1) * 68 + c]; }
            Rt[r * 68 + c] = -(s0 + s1); }
        __syncthreads();
        for (int e = tid; e < 16 * nc; e += 512) { const int r = e / nc, c = e % nc; float s0 = 0.f, s1 = 0.f;
#pragma unroll
            for (int r2 = 0; r2 < 16; r2 += 2) { s0 += Tf[(nc + r) * 68 + nc + r2] * Rt[r2 * 68 + c]; s1 += Tf[(nc + r) * 68 + nc + r2 + 1] * Rt[(r2 + 1) * 68 + c]; }
            Tf[(nc + r) * 68 + c] = s0 + s1; }
        __syncthreads();
    }
    for (int e = tid; e < 4096; e += 512) { const int t = e >> 6, s2 = e & 63; TT[t * 72 + s2] = f2bf(Tf[t * 68 + s2]); }
}
constexpr int D1_LW = 0, D1_CS = 17408, D1_AA = 34816, D1_RB = 52224, D1_KB = 61440, D1_VB = 70656, D1_TW = 79872, D1_AD = 89088, D1_W2T = 98304, D1_A2T = 107520;
constexpr int D1_Y = 82944;
constexpr int D1_ABF = 0, D1_AK = 17408, D1_ARK = 26624, D1_ARB = 35840, D1_TT = 45056, D1_W1T = 54272, D1_AKVT = 63488, D1_W2TT = 72704;
constexpr int D1_GL = 156672;
__device__ __forceinline__ void item_rwkv_local(const Ctx& C, int layer, int it) {
    const int gc = it >> 3, hd = it & 7, h = hd & 3, d = hd >> 2;
    const ChunkInfo ci = chunk_info(gc);
    const int slot = slot_of(ci.b, h, d, cpos_of(ci, d));
    const bf16_t* P = (const bf16_t*)(C.ws + WS_P);
    const float* mup = C.in[24] + layer * 1152; const float* mun = C.in[25] + layer * 1152;
    lds_t L = C.lds;
    LAS float* LW = (LAS float*)(L + D1_LW); LAS float* CS = (LAS float*)(L + D1_CS); LAS float* AA = (LAS float*)(L + D1_AA); LAS float* GL = (LAS float*)(L + D1_GL);
    LAS bf16_t* Rb = (LAS bf16_t*)(L + D1_RB); LAS bf16_t* Kb = (LAS bf16_t*)(L + D1_KB); LAS bf16_t* Vb = (LAS bf16_t*)(L + D1_VB);
    LAS bf16_t* TW = (LAS bf16_t*)(L + D1_TW); LAS bf16_t* AD = (LAS bf16_t*)(L + D1_AD); LAS bf16_t* W2T = (LAS bf16_t*)(L + D1_W2T); LAS bf16_t* A2T = (LAS bf16_t*)(L + D1_A2T);
    LAS bf16_t* KT = (LAS bf16_t*)(L + D1_Y); LAS bf16_t* KTt = KT + 4608; LAS bf16_t* KD = KT + 2 * 4608; LAS bf16_t* KDt = KT + 3 * 4608;
    LAS bf16_t* BT = KT + 4 * 4608; LAS bf16_t* BTt = KT + 5 * 4608; LAS bf16_t* RT = KT + 6 * 4608; LAS bf16_t* Vt = KT + 7 * 4608;
    LAS float* ABf = (LAS float*)(L + D1_ABF); LAS bf16_t* AK = (LAS bf16_t*)(L + D1_AK); LAS bf16_t* ARK = (LAS bf16_t*)(L + D1_ARK); LAS bf16_t* ARB = (LAS bf16_t*)(L + D1_ARB);
    LAS bf16_t* TT = (LAS bf16_t*)(L + D1_TT); LAS bf16_t* W1t = (LAS bf16_t*)(L + D1_W1T); LAS bf16_t* AKVt = (LAS bf16_t*)(L + D1_AKVT); LAS bf16_t* W2t = (LAS bf16_t*)(L + D1_W2TT);

    if (C.tid < 480) {
        const int q = C.tid % 160, seg = C.tid / 160, grp = q >> 5, c = (q & 31) * 2;
        const int j = (grp == 0 ? h * 64 : grp == 1 ? 256 + h * 64 : grp == 2 ? 512 + h * 64 : grp == 3 ? 768 + d * 64 : 896 + d * 64) + c;
        const int t0 = seg * 22, nt = seg == 2 ? 20 : 22;
        const bf16_t* pp = P + (size_t)(ci.row0 + t0) * NP + OFF_D + j;
        const float mp0 = mup[j], mp1 = mup[j + 1], mn0 = mun[j], mn1 = mun[j + 1];
        unsigned w[24];
#pragma unroll
        for (int i = 0; i < 24; ++i) { const int row = ci.row0 + t0 - 1 + i; w[i] = (i < nt + 2 && row >= ci.lo && row < ci.hi) ? *(const unsigned*)(pp + (ptrdiff_t)(i - 1) * NP) : 0u; }
        LAS bf16_t* dst = (grp == 0 ? Rb : grp == 1 ? Kb : grp == 2 ? Vb : grp == 3 ? TW : AD);
#pragma unroll
        for (int i = 0; i < 22; ++i) if (i < nt) {
            const float x0 = bflo(w[i + 1]), x1 = bfhi(w[i + 1]);
            const float v0 = x0 + mp0 * (bflo(w[i]) - x0) + mn0 * (bflo(w[i + 2]) - x0);
            const float v1 = x1 + mp1 * (bfhi(w[i]) - x1) + mn1 * (bfhi(w[i + 2]) - x1);
            DBGF(1, badv(v0, 1e4f) || badv(v1, 1e4f));
            const unsigned o = (grp == 3) ? pk2(tanhf(v0), tanhf(v1)) : pk2(v0, v1);
            const int tl = t0 + i, l = d ? 63 - tl : tl;
            *(LAS unsigned*)(dst + l * 72 + c) = o;
        }
    }
    {
        const float* w2 = C.in[27] + ((size_t)layer * 2 + d) * 64 * 256 + h * 64; const float* a2 = C.in[29] + ((size_t)layer * 2 + d) * 64 * 256 + h * 64;
        for (int e = C.tid; e < 4096; e += 512) { const int r = e >> 6, c = e & 63; W2T[c * 72 + r] = f2bf(w2[r * 256 + c]); A2T[c * 72 + r] = f2bf(a2[r * 256 + c]); }
    }
    __syncthreads();
    {
        unsigned* dbgflags = (unsigned*)(C.ws + 32768); (void)dbgflags;
        const float* w0 = C.in[26] + ((size_t)layer * 2 + d) * 256 + h * 64; const float* a0 = C.in[28] + ((size_t)layer * 2 + d) * 256 + h * 64;
        blk_mma<4, 4, 2>(TW, 72, W2T, 72, C.wid, C.lane, [=](int r0, int col, const f32x4& acc) {
#pragma unroll
            for (int jj = 0; jj < 4; ++jj) { const float w = w0[col] + acc[jj]; DBGL(2, badv(w, 1e4f)); LW[(r0 + jj) * 68 + col] = -expf(-softplus(-w) - 0.5f); }
        });
        blk_mma<4, 4, 2>(AD, 72, A2T, 72, C.wid, C.lane, [=](int r0, int col, const f32x4& acc) {
#pragma unroll
            for (int jj = 0; jj < 4; ++jj) { DBGL(2, badv(acc[jj], 1e4f)); AA[(r0 + jj) * 68 + col] = sigm(a0[col] + acc[jj]); }
        });
    }
    __syncthreads();
    {
#pragma unroll
        for (int i = 0; i < 8; ++i) { const int c = C.wid * 8 + i; const float incl = wave_incl_scan(LW[C.lane * 68 + c], C.lane); CS[C.lane * 68 + c] = incl; if (C.lane == 63) GL[c] = expf(incl); }
    }
    __syncthreads();
    {
        const int l = C.tid >> 3, sub = C.tid & 7;
        const float* kkw = C.in[31] + layer * 256 + h * 64; const float* kaw = C.in[32] + layer * 256 + h * 64; const float* rkw = C.in[33] + layer * 256 + h * 64;
        float kk[8], kdv[8], aa[8], rr[8], vv[8]; float ss = 0.f, bon = 0.f;
#pragma unroll
        for (int i = 0; i < 8; ++i) { const int c = sub * 8 + i; const float k = bf2f(Kb[l * 72 + c]); rr[i] = bf2f(Rb[l * 72 + c]); vv[i] = bf2f(Vb[l * 72 + c]); aa[i] = AA[l * 68 + c];
            kk[i] = k * kkw[c]; ss += kk[i] * kk[i]; kdv[i] = k * (1.f + (aa[i] - 1.f) * kaw[c]); bon += rr[i] * kdv[i] * rkw[c]; }
        ss += __shfl_xor(ss, 1); ss += __shfl_xor(ss, 2); ss += __shfl_xor(ss, 4);
        bon += __shfl_xor(bon, 1); bon += __shfl_xor(bon, 2); bon += __shfl_xor(bon, 4);
        const float inv = rsqrtf(ss + 1e-12f);
        if (sub == 0) ((float*)(C.ws + WS_BON))[(size_t)(ci.row0 + (d ? 63 - l : l)) * 8 + h * 2 + d] = bon;
#pragma unroll
        for (int i = 0; i < 8; ++i) { const int c = sub * 8 + i; const float cs = CS[l * 68 + c], lw = LW[l * 68 + c];
            const float ge = expf(cs - lw), gi = expf(cs), gn = expf(-cs); const float kkn = kk[i] * inv;
            DBGF(3, badv(cs, 50.f) || cs > 0.f || badv(lw, 1.f)); DBGF(4, badv(kkn * ge, 10.f) || badv(rr[i] * gi, 1e4f) || badv(vv[i], 1e4f)); DBGF(5, badv(kdv[i] * gn, 1e25f) || badv(kkn * aa[i] * gn, 1e25f));
            const unsigned short kt = f2bf(kkn * ge), kd = f2bf(kdv[i] * gn), bt = f2bf(kkn * aa[i] * gn), rt = f2bf(rr[i] * gi);
            KT[l * 72 + c] = kt; KTt[c * 72 + l] = kt; KD[l * 72 + c] = kd; KDt[c * 72 + l] = kd; BT[l * 72 + c] = bt; BTt[c * 72 + l] = bt; RT[l * 72 + c] = rt; Vt[c * 72 + l] = f2bf(vv[i]); }
    }
    __syncthreads();
    unsigned* dbgflags = (unsigned*)(C.ws + 32768); (void)dbgflags;
    blk_mma2<4, 4, 2>(KT, BT, KT, KD, 72, C.wid, C.lane, [=](int r0, int col, const f32x4& ab, const f32x4& ak) {
        unsigned short o[4];
#pragma unroll
        for (int jj = 0; jj < 4; ++jj) { const bool lo = col < r0 + jj; DBGL(6, lo && (badv(ab[jj], 1e3f) || badv(ak[jj], 1e4f))); ABf[(r0 + jj) * 68 + col] = lo ? ab[jj] : 0.f; o[jj] = f2bf(lo ? ak[jj] : 0.f); AK[(r0 + jj) * 72 + col] = o[jj]; }
    });
    blk_mma2<4, 4, 2>(RT, KD, RT, BT, 72, C.wid, C.lane, [=](int r0, int col, const f32x4& rk, const f32x4& rb) {
#pragma unroll
        for (int jj = 0; jj < 4; ++jj) { const bool le = col <= r0 + jj; DBGL(7, le && (badv(rk[jj], 1e5f) || badv(rb[jj], 1e5f))); ARK[(r0 + jj) * 72 + col] = f2bf(le ? rk[jj] : 0.f); ARB[(r0 + jj) * 72 + col] = f2bf(le ? rb[jj] : 0.f); }
    });
    __syncthreads();
    tri_inverse(ABf, (LAS float*)(L + 54272), (LAS float*)(L + 71680), TT, C.tid, C.wid, C.lane);
    __syncthreads();
#if MK_DIAG2
    for (int e = C.tid; e < 4096; e += 512) DBGF(8, badv(bf2f(TT[(e >> 6) * 72 + (e & 63)]), 1e3f));
#endif
    blk_mma2<4, 4, 2>(TT, KTt, AK, Vt, 72, C.wid, C.lane, [=](int r0, int col, const f32x4& w1, const f32x4& akv) {
        DBGL(9, badv(w1[0], 1e3f) || badv(w1[1], 1e3f) || badv(w1[2], 1e3f) || badv(w1[3], 1e3f)); DBGL(10, badv(akv[0], 1e5f) || badv(akv[1], 1e5f) || badv(akv[2], 1e5f) || badv(akv[3], 1e5f));
        u32x2 a, b; a.x = pk2(w1[0], w1[1]); a.y = pk2(w1[2], w1[3]); b.x = pk2(akv[0], akv[1]); b.y = pk2(akv[2], akv[3]);
        *(LAS u32x2*)(W1t + col * 72 + r0) = a; *(LAS u32x2*)(AKVt + col * 72 + r0) = b;
    });
    __syncthreads();
    blk_mma<4, 4, 2>(TT, 72, AKVt, 72, C.wid, C.lane, [=](int r0, int col, const f32x4& w2) {
        DBGL(11, badv(w2[0], 1e5f) || badv(w2[1], 1e5f) || badv(w2[2], 1e5f) || badv(w2[3], 1e5f));
        u32x2 a; a.x = pk2(w2[0], w2[1]); a.y = pk2(w2[2], w2[3]); *(LAS u32x2*)(W2t + col * 72 + r0) = a;
    });
    __syncthreads();
    {
        bf16_t* Gg = (bf16_t*)(C.ws + WS_RG) + (size_t)slot * 4096; float* Jg = (float*)(C.ws + WS_RJ) + (size_t)slot * 4096;
        bf16_t* Ryg = (bf16_t*)(C.ws + WS_RY) + (size_t)slot * 4096; bf16_t* Ylg = (bf16_t*)(C.ws + WS_RL) + (size_t)slot * 4096;
        blk_mma2<4, 4, 2>(W1t, BTt, W1t, ARB, 72, C.wid, C.lane, [=](int r0, int col, const f32x4& gp, const f32x4& rbw) {
            const float gl = GL[col]; float g[4], ry[4];
            const u32x2 rt = *(const LAS u32x2*)(RT + col * 72 + r0);
            const float rtv[4] = {bflo(rt.x), bfhi(rt.x), bflo(rt.y), bfhi(rt.y)};
#pragma unroll
            for (int jj = 0; jj < 4; ++jj) { g[jj] = gl * ((col == r0 + jj ? 1.f : 0.f) - gp[jj]); ry[jj] = rtv[jj] - rbw[jj]; }
            u32x2 og, oy; og.x = pk2(g[0], g[1]); og.y = pk2(g[2], g[3]); oy.x = pk2(ry[0], ry[1]); oy.y = pk2(ry[2], ry[3]);
            *(u32x2*)(Gg + col * 64 + r0) = og;
            *(u32x2*)(Ryg + col * 64 + r0) = oy;
        });
        blk_mma2<4, 4, 2>(KDt, Vt, BTt, W2t, 72, C.wid, C.lane, [=](int r0, int col, const f32x4& kv, const f32x4& bw) {
            f32x4 o;
#pragma unroll
            for (int jj = 0; jj < 4; ++jj) { o[jj] = GL[r0 + jj] * (kv[jj] - bw[jj]); DBGL(12, badv(GL[r0 + jj] * kv[jj], 1e5f)); DBGL(13, badv(GL[r0 + jj] * bw[jj], 1e5f)); DBGL(14, badv(o[jj], 1e5f)); }
            *(f32x4*)(Jg + col * 64 + r0) = o;
        });
        blk_mma2<4, 4, 2>(ARK, Vt, ARB, W2t, 72, C.wid, C.lane, [=](int r0, int col, const f32x4& a, const f32x4& b) {
            u32x2 o; o.x = pk2(a[0] - b[0], a[1] - b[1]); o.y = pk2(a[2] - b[2], a[3] - b[3]);
            *(u32x2*)(Ylg + col * 64 + r0) = o;
        });
    }
    __syncthreads();
}

typedef float f32x2p __attribute__((ext_vector_type(2)));
__device__ __forceinline__ void ph_scan(const Ctx& C) {
    if (C.bid < 16) {
        const int chain = C.bid, fr = C.lane & 15, fq = C.lane >> 4;
        LAS bf16_t* HT = (LAS bf16_t*)C.lds;
        const bf16_t* Gg = (const bf16_t*)(C.ws + WS_RG); const float* Jg = (const float*)(C.ws + WS_RJ); bf16_t* Hg = (bf16_t*)(C.ws + WS_RH);
        f32x4 acc[2] = {{0.f, 0.f, 0.f, 0.f}, {0.f, 0.f, 0.f, 0.f}};
        int buf = 0;
        const int tm = C.wid >> 1, tnb = (C.wid & 1) * 2;
        const bf16_t* gp = Gg + (size_t)chain * NCH * 4096 + (tm * 16 + fr) * 64 + fq * 8;
        const float* jp = Jg + (size_t)chain * NCH * 4096 + (tnb * 16 + fr) * 64 + tm * 16 + fq * 4;
        bf16x8 gn[2]; f32x4 jn[2];
        gn[0] = *(const bf16x8*)gp; gn[1] = *(const bf16x8*)(gp + 32); jn[0] = *(const f32x4*)jp; jn[1] = *(const f32x4*)(jp + 16 * 64);
        for (int cpos = 0; cpos < NCH; ++cpos) {
            const size_t slot = (size_t)chain * NCH + cpos;
            const bf16x8 g0 = gn[0], g1 = gn[1]; const f32x4 j0 = jn[0], j1 = jn[1];
            if (cpos + 1 < NCH) { const bf16_t* gq = gp + (size_t)(cpos + 1) * 4096; const float* jq = jp + (size_t)(cpos + 1) * 4096;
                gn[0] = *(const bf16x8*)gq; gn[1] = *(const bf16x8*)(gq + 32); jn[0] = *(const f32x4*)jq; jn[1] = *(const f32x4*)(jq + 16 * 64); }
#pragma unroll
            for (int i = 0; i < 2; ++i) { const int tn = tnb + i;
                u32x2 o; o.x = pk2(acc[i][0], acc[i][1]); o.y = pk2(acc[i][2], acc[i][3]);
                *(LAS u32x2*)(HT + buf * 4608 + (tn * 16 + fr) * 72 + tm * 16 + fq * 4) = o;
                *(u32x2*)(Hg + slot * 4096 + (tn * 16 + fr) * 64 + tm * 16 + fq * 4) = o; }
            __syncthreads();
#pragma unroll
            for (int i = 0; i < 2; ++i) { const int tn = tnb + i;
                f32x4 a = i ? j1 : j0;
                a = __builtin_amdgcn_mfma_f32_16x16x32_bf16(g0, *(const LAS bf16x8*)(HT + buf * 4608 + (tn * 16 + fr) * 72 + fq * 8), a, 0, 0, 0);
                a = __builtin_amdgcn_mfma_f32_16x16x32_bf16(g1, *(const LAS bf16x8*)(HT + buf * 4608 + (tn * 16 + fr) * 72 + 32 + fq * 8), a, 0, 0, 0);
                acc[i] = a; }
            buf ^= 1;
        }
    } else {
        float* MST = (float*)(C.ws + WS_MST); const float* MCD = (const float*)(C.ws + WS_MCD);
        const int nthr = (C.G - 16) * 512;
        for (int e = (C.bid - 16) * 512 + C.tid; e < 16 * 4096; e += nthr) {
            const int chain = e >> 12, el = (e & 4095) * 2; f32x2p run = {0.f, 0.f};
            float* p = MST + (size_t)chain * NCH * 8192 + el; const float* cd = MCD + chain * NCH;
#pragma unroll 12
            for (int cpos = 0; cpos < NCH; ++cpos) { const f32x2p tmp = *(const f32x2p*)(p + (size_t)cpos * 8192); *(f32x2p*)(p + (size_t)cpos * 8192) = run; run = run * cd[cpos] + tmp; }
        }
    }
}

__device__ __forceinline__ void item_mamba_out(const Ctx& C, int layer, int gc) {
    const ChunkInfo ci = chunk_info(gc);
    const bf16_t* P = (const bf16_t*)(C.ws + WS_P); bf16_t* YC = (bf16_t*)(C.ws + WS_ACT); const float* MST = (const float*)(C.ws + WS_MST);
    lds_t L = C.lds;
    LAS float* DT = (LAS float*)L;
    LAS float* DA = (LAS float*)(L + 2048);
    LAS float* CSI = (LAS float*)(L + 4096);
    LAS float* SSQ = (LAS float*)(L + 6144);
    LAS bf16_t* CG = (LAS bf16_t*)(L + 10240);
    LAS bf16_t* BG = (LAS bf16_t*)(L + 27648);
    LAS bf16_t* XT = (LAS bf16_t*)(L + 45056);
    LAS float* CBm = (LAS float*)(L + 63488);
    LAS bf16_t* MP = (LAS bf16_t*)(L + 80896);
    LAS bf16_t* S0 = (LAS bf16_t*)(L + 90112);
    LAS bf16_t* YPRE = (LAS bf16_t*)(L + 107520);
    const int fr = C.lane & 15, fq = C.lane >> 4;
    {
        const int s = C.lane, dh = C.wid;
        const float raw = bf2f(P[(size_t)(ci.row0 + s) * NP + OFF_C + 1024 + dh]);
        const float dt = softplus(raw + C.in[20][layer * 8 + dh]);
        const float da = dt * (-expf(C.in[21][layer * 8 + dh]));
        const float incl = wave_incl_scan(da, s), total = __shfl(incl, 63);
        DT[dh * 64 + s] = dt; DA[dh * 64 + s] = da;
        CSI[dh * 64 + s] = (dh < 4) ? incl : (total - incl + da);
    }
    for (int g = 0; g < 2; ++g) {
        __syncthreads();
        {
            const int cp = C.tid & 255, half = C.tid >> 8;
            if (cp < 192) {
                const int kind = cp >> 6, cl = (cp & 63) * 2, c0 = kind * 256 + g * 128 + cl;
                const float* cw = C.in[18] + (size_t)layer * 5 * 768 + c0; const float* cb = C.in[19] + layer * 768 + c0;
                float w0[5], w1[5];
#pragma unroll
                for (int j = 0; j < 5; ++j) { w0[j] = cw[j * 768]; w1[j] = cw[j * 768 + 1]; }
                const float b0 = cb[0], b1 = cb[1];
                const int s0 = half * 32;
                unsigned win[5];
#pragma unroll
                for (int j = 0; j < 4; ++j) { const int row = ci.row0 + s0 - 2 + j; win[j + 1] = (row >= ci.lo && row < ci.hi) ? *(const unsigned*)(P + (size_t)row * NP + OFF_C + 256 + c0) : 0u; }
                for (int tt = 0; tt < 32; ++tt) {
                    const int s = s0 + tt;
#pragma unroll
                    for (int j = 0; j < 4; ++j) win[j] = win[j + 1];
                    { const int row = ci.row0 + s + 2; win[4] = (row >= ci.lo && row < ci.hi) ? *(const unsigned*)(P + (size_t)row * NP + OFF_C + 256 + c0) : 0u; }
                    float a0 = b0, a1 = b1;
#pragma unroll
                    for (int j = 0; j < 5; ++j) { a0 += w0[j] * bflo(win[j]); a1 += w1[j] * bfhi(win[j]); }
                    const unsigned short o0 = f2bf(silu(a0)), o1 = f2bf(silu(a1));
                    if (kind == 0) { XT[cl * 72 + s] = o0; XT[(cl + 1) * 72 + s] = o1; }
                    else if (kind == 1) { *(LAS unsigned*)(BG + s * 136 + cl) = (unsigned)o0 | ((unsigned)o1 << 16); }
                    else { *(LAS unsigned*)(CG + s * 136 + cl) = (unsigned)o0 | ((unsigned)o1 << 16); }
                }
            }
        }
        __syncthreads();
        blk_mma<4, 4, 4>(CG, 136, BG, 136, C.wid, C.lane, [=](int r0, int col, const f32x4& acc) {
#pragma unroll
            for (int jj = 0; jj < 4; ++jj) CBm[(r0 + jj) * 68 + col] = acc[jj];
        });
        for (int hh = 0; hh < 2; ++hh) {
            const int h = 2 * g + hh;
            f32x4 yacc[2] = {{0.f, 0.f, 0.f, 0.f}, {0.f, 0.f, 0.f, 0.f}};
            for (int d = 0; d < 2; ++d) {
                const int dh = d * 4 + h;
                __syncthreads();
                for (int e = C.tid; e < 4096; e += 512) { const int l = e >> 6, s = e & 63; const bool ok = d ? (s >= l) : (s <= l);
                    MP[l * 72 + s] = ok ? f2bf(CBm[l * 68 + s] * expf(CSI[dh * 64 + l] - CSI[dh * 64 + s]) * DT[dh * 64 + s]) : (unsigned short)0; }
                { const float* src = MST + (size_t)slot_of(ci.b, h, d, cpos_of(ci, d)) * 8192;
                  for (int e = C.tid; e < 2048; e += 512) { const int p = e >> 5, n4 = (e & 31) * 4; const f32x4 v = *(const f32x4*)(src + p * 128 + n4);
                      u32x2 o; o.x = pk2(v.x, v.y); o.y = pk2(v.z, v.w); *(LAS u32x2*)(S0 + p * 136 + n4) = o; } }
                __syncthreads();
#pragma unroll
                for (int i = 0; i < 2; ++i) { const int tt = C.wid + 8 * i, tm = tt >> 2, tn = tt & 3;
                    f32x4 a1 = {0.f, 0.f, 0.f, 0.f}, a2 = {0.f, 0.f, 0.f, 0.f};
#pragma unroll
                    for (int ks = 0; ks < 2; ++ks) a1 = __builtin_amdgcn_mfma_f32_16x16x32_bf16(*(const LAS bf16x8*)(MP + (tm * 16 + fr) * 72 + ks * 32 + fq * 8),
                                                                                                 *(const LAS bf16x8*)(XT + (hh * 64 + tn * 16 + fr) * 72 + ks * 32 + fq * 8), a1, 0, 0, 0);
#pragma unroll
                    for (int ks = 0; ks < 4; ++ks) a2 = __builtin_amdgcn_mfma_f32_16x16x32_bf16(*(const LAS bf16x8*)(CG + (tm * 16 + fr) * 136 + ks * 32 + fq * 8),
                                                                                                 *(const LAS bf16x8*)(S0 + (tn * 16 + fr) * 136 + ks * 32 + fq * 8), a2, 0, 0, 0);
#pragma unroll
                    for (int j = 0; j < 4; ++j) yacc[i][j] += a1[j] + a2[j] * expf(CSI[dh * 64 + tm * 16 + fq * 4 + j]);
                }
            }
            const float dsk = C.in[22][layer * 4 + h];
#pragma unroll
            for (int i = 0; i < 2; ++i) { const int tt = C.wid + 8 * i, tm = tt >> 2, tn = tt & 3;
#pragma unroll
                for (int j = 0; j < 4; ++j) { const int l = tm * 16 + fq * 4 + j, p = tn * 16 + fr, c = h * 64 + p;
                    const float xs = bf2f(XT[(hh * 64 + p) * 72 + l]);
                    const float z = bf2f(P[(size_t)(ci.row0 + l) * NP + OFF_C + c]);
                    const float pre = (yacc[i][j] + dsk * xs) * silu(z);
                    YPRE[l * 264 + c] = f2bf(pre);
                    float q = pre * pre; q += __shfl_xor(q, 1); q += __shfl_xor(q, 2); q += __shfl_xor(q, 4); q += __shfl_xor(q, 8);
                    if (fr == 0) SSQ[l * 16 + h * 4 + tn] = q; }
            }
        }
    }
    __syncthreads();
    {
        const int l = C.tid >> 3, sub = C.tid & 7; float ss = 0.f;
#pragma unroll
        for (int i = 0; i < 16; ++i) ss += SSQ[l * 16 + i];
        const float rs = rsqrtf(ss * (1.f / 256.f) + 1e-6f);
        const float* ng = C.in[23] + layer * 256 + sub * 32;
        bf16_t* dst = YC + (size_t)(ci.row0 + l) * DM + 512 + sub * 32;
#pragma unroll
        for (int i = 0; i < 32; i += 2) { const float a = bf2f(YPRE[l * 264 + sub * 32 + i]) * rs * ng[i], b = bf2f(YPRE[l * 264 + sub * 32 + i + 1]) * rs * ng[i + 1]; *(unsigned*)(dst + i) = pk2(a, b); }
    }
    __syncthreads();
}

constexpr int D3_G2T = 0, D3_SG = 69632;
__device__ __forceinline__ void load_g2t(const Ctx& C, int layer) {
    LAS bf16_t* G2T = (LAS bf16_t*)(C.lds + D3_G2T); const float* g2 = C.in[30] + (size_t)layer * 128 * 256;
    for (int e = C.tid; e < 128 * 256; e += 512) { const int r = e >> 8, c = e & 255; G2T[c * 136 + r] = f2bf(g2[e]); }
}
__device__ __forceinline__ float lerp_d(const bf16_t* P, const ChunkInfo& ci, int row, int j, const float* mup, const float* mun) {
    const bf16_t* pp = P + (size_t)row * NP + OFF_D + j;
    const float x = bf2f(*pp), xp = (row - 1 >= ci.lo) ? bf2f(*(pp - NP)) : 0.f, xn = (row + 1 < ci.hi) ? bf2f(*(pp + NP)) : 0.f;
    return x + mup[j] * (xp - x) + mun[j] * (xn - x);
}
__device__ __forceinline__ void item_rwkv_out(const Ctx& C, int layer, int gc) {
    const ChunkInfo ci = chunk_info(gc);
    const bf16_t* P = (const bf16_t*)(C.ws + WS_P); bf16_t* YC = (bf16_t*)(C.ws + WS_ACT);
    const float* mup = C.in[24] + layer * 1152; const float* mun = C.in[25] + layer * 1152;
    LAS bf16_t* G2T = (LAS bf16_t*)(C.lds + D3_G2T); LAS bf16_t* SG = (LAS bf16_t*)(C.lds + D3_SG);
    const int fr = C.lane & 15, fq = C.lane >> 4;
    __syncthreads();
    for (int e = C.tid; e < 64 * 128; e += 512) { const int l = e >> 7, r = e & 127; SG[l * 136 + r] = f2bf(sigm(lerp_d(P, ci, ci.row0 + l, 1024 + r, mup, mun))); }
    __syncthreads();
    const int h = C.wid >> 1, tmb = (C.wid & 1) * 2;
    const bf16_t* Ryg = (const bf16_t*)(C.ws + WS_RY); const bf16_t* Ylg = (const bf16_t*)(C.ws + WS_RL); const bf16_t* Hg = (const bf16_t*)(C.ws + WS_RH);
    const float* BON = (const float*)(C.ws + WS_BON);
#pragma unroll
    for (int ti = 0; ti < 2; ++ti) {
        const int tm = tmb + ti;
        f32x4 gacc[4], yacc[4];
#pragma unroll
        for (int tn = 0; tn < 4; ++tn) { f32x4 a = {0.f, 0.f, 0.f, 0.f};
#pragma unroll
            for (int ks = 0; ks < 4; ++ks) a = __builtin_amdgcn_mfma_f32_16x16x32_bf16(*(const LAS bf16x8*)(SG + (tm * 16 + fr) * 136 + ks * 32 + fq * 8),
                                                                                        *(const LAS bf16x8*)(G2T + (h * 64 + tn * 16 + fr) * 136 + ks * 32 + fq * 8), a, 0, 0, 0);
            gacc[tn] = a; yacc[tn] = (f32x4){0.f, 0.f, 0.f, 0.f}; }
#pragma unroll
        for (int d = 0; d < 2; ++d) {
            const size_t slot = (size_t)slot_of(ci.b, h, d, cpos_of(ci, d));
            const int arow = d ? 63 - (tm * 16 + fr) : tm * 16 + fr;
            bf16x8 af[2];
#pragma unroll
            for (int ks = 0; ks < 2; ++ks) af[ks] = *(const bf16x8*)(Ryg + slot * 4096 + arow * 64 + ks * 32 + fq * 8);
#pragma unroll
            for (int tn = 0; tn < 4; ++tn) {
                f32x4 a;
                if (d == 0) { const u32x2 yl = *(const u32x2*)(Ylg + slot * 4096 + (tn * 16 + fr) * 64 + tm * 16 + fq * 4); a = (f32x4){bflo(yl.x), bfhi(yl.x), bflo(yl.y), bfhi(yl.y)}; }
                else { const u32x2 yl = *(const u32x2*)(Ylg + slot * 4096 + (tn * 16 + fr) * 64 + 60 - (tm * 16 + fq * 4)); a = (f32x4){bfhi(yl.y), bflo(yl.y), bfhi(yl.x), bflo(yl.x)}; }
#pragma unroll
                for (int ks = 0; ks < 2; ++ks) a = __builtin_amdgcn_mfma_f32_16x16x32_bf16(af[ks], *(const bf16x8*)(Hg + slot * 4096 + (tn * 16 + fr) * 64 + ks * 32 + fq * 8), a, 0, 0, 0);
                yacc[tn] += a;
            }
        }
#pragma unroll
        for (int j = 0; j < 4; ++j) {
            const int l = tm * 16 + fq * 4 + j, row = ci.row0 + l;
            float s = (yacc[0][j] + yacc[1][j]) + (yacc[2][j] + yacc[3][j]);
            s += __shfl_xor(s, 1); s += __shfl_xor(s, 2); s += __shfl_xor(s, 4); s += __shfl_xor(s, 8);
            const float mu = s * (1.f / 64.f);
            float q = 0.f;
#pragma unroll
            for (int tn = 0; tn < 4; ++tn) { const float dd = yacc[tn][j] - mu; q += dd * dd; }
            q += __shfl_xor(q, 1); q += __shfl_xor(q, 2); q += __shfl_xor(q, 4); q += __shfl_xor(q, 8);
            const float rs = rsqrtf(q * (1.f / 64.f) + 64e-5f);
            const float bon = BON[(size_t)row * 8 + h * 2] + BON[(size_t)row * 8 + h * 2 + 1];
#pragma unroll
            for (int tn = 0; tn < 4; ++tn) { const int c = h * 64 + tn * 16 + fr;
                const float yn = (yacc[tn][j] - mu) * rs * C.in[34][layer * 256 + c] + C.in[35][layer * 256 + c];
                const float vv = lerp_d(P, ci, row, 512 + c, mup, mun);
                YC[(size_t)row * DM + 768 + c] = f2bf((yn + bon * vv) * gacc[tn][j]); }
        }
    }
}

__device__ __forceinline__ unsigned ordf(float f) { const unsigned u = __float_as_uint(f); return u ^ ((u >> 31) ? 0xFFFFFFFFu : 0x80000000u); }
__device__ __forceinline__ unsigned wave_max_u32(unsigned v) {
    unsigned t;
    t = (unsigned)__builtin_amdgcn_update_dpp((int)v, (int)v, 0xB1, 0xF, 0xF, false); v = t > v ? t : v;
    t = (unsigned)__builtin_amdgcn_update_dpp((int)v, (int)v, 0x4E, 0xF, 0xF, false); v = t > v ? t : v;
    t = (unsigned)__builtin_amdgcn_update_dpp((int)v, (int)v, 0x141, 0xF, 0xF, false); v = t > v ? t : v;
    t = (unsigned)__builtin_amdgcn_update_dpp((int)v, (int)v, 0x140, 0xF, 0xF, false); v = t > v ? t : v;
    t = (unsigned)__builtin_amdgcn_update_dpp((int)v, (int)v, 0x142, 0xA, 0xF, false); v = t > v ? t : v;
    t = (unsigned)__builtin_amdgcn_update_dpp((int)v, (int)v, 0x143, 0xC, 0xF, false); v = t > v ? t : v;
    return (unsigned)__builtin_amdgcn_readlane((int)v, 63);
}
constexpr int SEL_K1 = 0, SEL_K2 = 34816, SEL_Q0 = 69632, SEL_Q1 = 78336, SEL_S1 = 87040, SEL_S2 = 103936;
__device__ __forceinline__ void ph_select(const Ctx& C, int layer, int nrows) {
    const bf16_t* Q = (const bf16_t*)(C.ws + WS_Q); int* SELI = (int*)(C.ws + WS_SELI); float* SELG = (float*)(C.ws + WS_SELG);
    LAS bf16_t* K1 = (LAS bf16_t*)(C.lds + SEL_K1); LAS bf16_t* K2 = (LAS bf16_t*)(C.lds + SEL_K2);
    LAS bf16_t* Q0 = (LAS bf16_t*)(C.lds + SEL_Q0); LAS bf16_t* Q1 = (LAS bf16_t*)(C.lds + SEL_Q1);
    LAS float* S1 = (LAS float*)(C.lds + SEL_S1); LAS float* S2 = (LAS float*)(C.lds + SEL_S2);
    {
        const float* k1 = C.in[37] + (size_t)layer * 128 * 128; const float* k2 = C.in[38] + (size_t)layer * 128 * 128;
        for (int e = C.tid; e < 4096; e += 512) { const int r = e >> 5, c4 = (e & 31) * 4; const f32x4 a = *(const f32x4*)(k1 + r * 128 + c4), b = *(const f32x4*)(k2 + r * 128 + c4);
            u32x2 oa, ob; oa.x = pk2(a.x, a.y); oa.y = pk2(a.z, a.w); ob.x = pk2(b.x, b.y); ob.y = pk2(b.z, b.w);
            *(LAS u32x2*)(K1 + r * 136 + c4) = oa; *(LAS u32x2*)(K2 + r * 136 + c4) = ob; }
    }
    int ca = 0, cb = 0;
    { const int L = C.lane;
      if (L < 16) { ca = 0; cb = L; } else if (L < 24) { ca = 1; cb = L - 16; } else if (L < 29) { ca = 2; cb = L - 24; } else if (L < 33) { ca = 3; cb = L - 29; }
      else if (L < 36) { ca = 4; cb = L - 33; } else if (L < 38) { ca = 5; cb = L - 36; } else if (L < 40) { ca = 6; cb = L - 38; } else if (L < 42) { ca = 7; cb = L - 40; }
      else { ca = 8 + (L - 42); cb = 0; } if (L >= 50) { ca = 0; cb = 0; } }
    const int ntile = nrows / 32;
    for (int it = C.bid; it < ntile * 8; it += C.G) {
        const int tile = it >> 3, h = it & 7, row0 = tile * 32;
        __syncthreads();
        for (int e = C.tid; e < 32 * 32; e += 512) { const int r = e >> 5, c8 = (e & 31) * 8;
            const u32x4 v = *(const u32x4*)(Q + (size_t)(row0 + r) * 2048 + h * 256 + c8);
            if (c8 < 128) *(LAS u32x4*)(Q0 + r * 136 + c8) = v; else *(LAS u32x4*)(Q1 + r * 136 + c8 - 128) = v; }
        __syncthreads();
        blk_mma2<2, 8, 4>(Q0, K1, Q1, K2, 136, C.wid, C.lane, [=](int r0, int col, const f32x4& a, const f32x4& b) {
#pragma unroll
            for (int jj = 0; jj < 4; ++jj) { S1[(r0 + jj) * 132 + col] = a[jj]; S2[(r0 + jj) * 132 + col] = b[jj]; }
        });
        __syncthreads();
        {
            const int L = C.lane, tb = C.wid * 4;
            unsigned ka0[4], ka1[4], kb0[4], kb1[4]; float v1[4], v2[4]; int i1[4], i2[4];
#pragma unroll
            for (int q = 0; q < 4; ++q) { const LAS float* s1 = S1 + (tb + q) * 132; const LAS float* s2 = S2 + (tb + q) * 132;
                ka0[q] = (ordf(s1[L]) & ~0x7Fu) | (unsigned)(127 - L); ka1[q] = (ordf(s1[L + 64]) & ~0x7Fu) | (unsigned)(63 - L);
                kb0[q] = (ordf(s2[L]) & ~0x7Fu) | (unsigned)(127 - L); kb1[q] = (ordf(s2[L + 64]) & ~0x7Fu) | (unsigned)(63 - L);
                v1[q] = 0.f; v2[q] = 0.f; i1[q] = 0; i2[q] = 0; }
            for (int i = 0; i < 16; ++i) {
#pragma unroll
                for (int q = 0; q < 4; ++q) {
                    const unsigned ma = wave_max_u32(ka0[q] > ka1[q] ? ka0[q] : ka1[q]), mb = wave_max_u32(kb0[q] > kb1[q] ? kb0[q] : kb1[q]);
                    const int ia = 127 - (int)(ma & 0x7Fu), ib = 127 - (int)(mb & 0x7Fu);
                    const float sa = S1[(tb + q) * 132 + ia], sb = S2[(tb + q) * 132 + ib];
                    if (L == i) { v1[q] = sa; i1[q] = ia; v2[q] = sb; i2[q] = ib; }
                    if (ka0[q] == ma) ka0[q] = 0u; if (ka1[q] == ma) ka1[q] = 0u; if (kb0[q] == mb) kb0[q] = 0u; if (kb1[q] == mb) kb1[q] = 0u;
                }
            }
            float cand[4]; unsigned kc[4]; int sel[4];
#pragma unroll
            for (int q = 0; q < 4; ++q) { cand[q] = __shfl(v1[q], ca) + __shfl(v2[q], cb); kc[q] = (L < 50) ? ((ordf(cand[q]) & ~0x3Fu) | (unsigned)(63 - L)) : 0u; sel[q] = 0; }
            for (int i = 0; i < 16; ++i) {
#pragma unroll
                for (int q = 0; q < 4; ++q) { const unsigned m = wave_max_u32(kc[q]); const int ls = 63 - (int)(m & 0x3Fu); if (L == i) sel[q] = ls; if (kc[q] == m) kc[q] = 0u; }
            }
#pragma unroll
            for (int q = 0; q < 4; ++q) {
                const float top = __shfl(cand[q], sel[q]); const int sa = __shfl(ca, sel[q]), sb = __shfl(cb, sel[q]);
                const int idx = __shfl(i1[q], sa) * 128 + __shfl(i2[q], sb);
                const float mx = __shfl(top, 0);
                const float ex = expf(top - mx);
                float sm = ex; sm += __shfl_xor(sm, 1); sm += __shfl_xor(sm, 2); sm += __shfl_xor(sm, 4); sm += __shfl_xor(sm, 8);
                if (L < 16) { const size_t o = ((size_t)(row0 + tb + q) * 8 + h) * 16 + L; SELI[o] = idx; SELG[o] = ex / sm; }
            }
        }
    }
}

struct R16 { float v[16]; };
__device__ __forceinline__ R16 load_r16_f32(const float* p, int lane) { R16 r;
#pragma unroll
    for (int k = 0; k < 4; ++k) { const f32x4 a = *(const f32x4*)(p + 16 * lane + 4 * k); r.v[4 * k] = a.x; r.v[4 * k + 1] = a.y; r.v[4 * k + 2] = a.z; r.v[4 * k + 3] = a.w; }
    return r; }
__device__ __forceinline__ void store_r16_f32(float* p, int lane, const R16& r) {
#pragma unroll
    for (int k = 0; k < 4; ++k) *(f32x4*)(p + 16 * lane + 4 * k) = (f32x4){r.v[4 * k], r.v[4 * k + 1], r.v[4 * k + 2], r.v[4 * k + 3]}; }
__device__ __forceinline__ R16 load_r16_bf16(const bf16_t* p, int lane) { R16 r;
#pragma unroll
    for (int k = 0; k < 2; ++k) { const u32x4 a = *(const u32x4*)(p + 16 * lane + 8 * k);
        r.v[8 * k] = bflo(a.x); r.v[8 * k + 1] = bfhi(a.x); r.v[8 * k + 2] = bflo(a.y); r.v[8 * k + 3] = bfhi(a.y); r.v[8 * k + 4] = bflo(a.z); r.v[8 * k + 5] = bfhi(a.z); r.v[8 * k + 6] = bflo(a.w); r.v[8 * k + 7] = bfhi(a.w); }
    return r; }
__device__ __forceinline__ void store_r16_bf16(bf16_t* p, int lane, const R16& r) {
#pragma unroll
    for (int k = 0; k < 2; ++k) { u32x4 a; a.x = pk2(r.v[8 * k], r.v[8 * k + 1]); a.y = pk2(r.v[8 * k + 2], r.v[8 * k + 3]); a.z = pk2(r.v[8 * k + 4], r.v[8 * k + 5]); a.w = pk2(r.v[8 * k + 6], r.v[8 * k + 7]);
        *(u32x4*)(p + 16 * lane + 8 * k) = a; } }
typedef float f32x2p __attribute__((ext_vector_type(2)));
__device__ __forceinline__ void ph_peer(const Ctx& C, int layer, int nrows, bool last, bool store = true) {
    const bf16_t* F = (const bf16_t*)(C.ws + WS_ACT); bf16_t* XN = (bf16_t*)(C.ws + WS_ACT);
    const unsigned char* UB = C.ws + WS_UB; const unsigned char* VB = C.ws + WS_VB; const float* SU = (const float*)(C.ws + WS_SU); const float* SV = (const float*)(C.ws + WS_SV);
    const int* SELI = (const int*)(C.ws + WS_SELI); const float* SELG = (const float*)(C.ws + WS_SELG);
    float* H = (float*)(C.ws + WS_H); const float* MOD = (const float*)(C.ws + WS_MOD);
    const int L = C.lane;
    for (int tok = C.bid * 8 + C.wid; tok < nrows; tok += C.G * 8) {
        const R16 f = load_r16_bf16(F + (size_t)tok * DM, L);
        const int idx0 = SELI[(size_t)tok * 128 + L], idx1 = SELI[(size_t)tok * 128 + 64 + L];
        const float su0 = SU[idx0], su1 = SU[idx1];
        const float gsv0 = SELG[(size_t)tok * 128 + L] * SV[idx0], gsv1 = SELG[(size_t)tok * 128 + 64 + L] * SV[idx1];
        f32x2p out[8];
#pragma unroll
        for (int i = 0; i < 8; ++i) out[i] = (f32x2p){0.f, 0.f};
        for (int bt = 0; bt < 8; ++bt) {
            const int src = bt < 4 ? idx0 : idx1; const float susrc = bt < 4 ? su0 : su1, gsrc = bt < 4 ? gsv0 : gsv1; const int l0 = (bt & 3) * 16;
            u32x4 ua[16], va[16];
#pragma unroll
            for (int i = 0; i < 16; ++i) { const int ei = __builtin_amdgcn_readlane(src, l0 + i);
                ua[i] = *(const u32x4*)(UB + (size_t)ei * DM + 16 * L); va[i] = *(const u32x4*)(VB + (size_t)ei * DM + 16 * L); }
            float part[16];
#pragma unroll
            for (int i = 0; i < 16; ++i) { f32x2p acc = {0.f, 0.f};
#pragma unroll
                for (int k = 0; k < 4; ++k) { const f32x2p lo = __builtin_amdgcn_cvt_pk_f32_fp8((int)ua[i][k], false), hi = __builtin_amdgcn_cvt_pk_f32_fp8((int)ua[i][k], true);
                    acc += lo * (f32x2p){f.v[4 * k], f.v[4 * k + 1]}; acc += hi * (f32x2p){f.v[4 * k + 2], f.v[4 * k + 3]}; }
                part[i] = acc.x + acc.y; }
            float p8[8], p4[4], p2[2], p1;
            { const bool hi = (L & 32) != 0;
#pragma unroll
              for (int i = 0; i < 8; ++i) { const float send = hi ? part[i] : part[i + 8]; const float recv = __shfl_xor(send, 32); p8[i] = (hi ? part[i + 8] : part[i]) + recv; } }
            { const bool hi = (L & 16) != 0;
#pragma unroll
              for (int i = 0; i < 4; ++i) { const float send = hi ? p8[i] : p8[i + 4]; const float recv = __shfl_xor(send, 16); p4[i] = (hi ? p8[i + 4] : p8[i]) + recv; } }
            { const bool hi = (L & 8) != 0;
#pragma unroll
              for (int i = 0; i < 2; ++i) { const float send = hi ? p4[i] : p4[i + 2]; const float recv = __shfl_xor(send, 8); p2[i] = (hi ? p4[i + 2] : p4[i]) + recv; } }
            { const bool hi = (L & 4) != 0; const float send = hi ? p2[0] : p2[1]; const float recv = __shfl_xor(send, 4); p1 = (hi ? p2[1] : p2[0]) + recv; }
            p1 += __shfl_xor(p1, 2); p1 += __shfl_xor(p1, 1);
            const int myexp = ((L >> 5) & 1) * 8 + ((L >> 4) & 1) * 4 + ((L >> 3) & 1) * 2 + ((L >> 2) & 1);
            const float act = gelu_tanh(p1 * __shfl(susrc, l0 + myexp)) * __shfl(gsrc, l0 + myexp);
#pragma unroll
            for (int i = 0; i < 16; ++i) {
                const float a = __uint_as_float((unsigned)__builtin_amdgcn_readlane((int)__float_as_uint(act), ((i >> 3) & 1) * 32 + ((i >> 2) & 1) * 16 + ((i >> 1) & 1) * 8 + (i & 1) * 4)); const f32x2p a2 = {a, a};
#pragma unroll
                for (int k = 0; k < 4; ++k) { out[2 * k] += a2 * __builtin_amdgcn_cvt_pk_f32_fp8((int)va[i][k], false); out[2 * k + 1] += a2 * __builtin_amdgcn_cvt_pk_f32_fp8((int)va[i][k], true); }
            }
        }
        const float* m = MOD + ((size_t)layer * 3 + which_of(tok)) * 6144;
        R16 hr = load_r16_f32(H + (size_t)tok * DM, L); const R16 g5 = load_r16_f32(m + 5 * 1024, L);
#pragma unroll
        for (int i = 0; i < 8; ++i) { hr.v[2 * i] += g5.v[2 * i] * out[i].x; hr.v[2 * i + 1] += g5.v[2 * i + 1] * out[i].y; }
        float ss = 0.f;
#pragma unroll
        for (int i = 0; i < 16; ++i) ss += hr.v[i] * hr.v[i];
        const float rs = rsqrtf(wave_sum(ss) * (1.f / 1024.f) + 1e-6f);
        if (!store) continue;
        if (!last) {
            store_r16_f32(H + (size_t)tok * DM, L, hr);
            const float* m2 = MOD + ((size_t)(layer + 1) * 3 + which_of(tok)) * 6144;
            const R16 gg = load_r16_f32(C.in[6] + (layer + 1) * 1024, L), sh = load_r16_f32(m2, L), sc = load_r16_f32(m2 + 1024, L); R16 o;
#pragma unroll
            for (int i = 0; i < 16; ++i) o.v[i] = (hr.v[i] * rs * gg.v[i]) * (1.f + sc.v[i]) + sh.v[i];
            store_r16_bf16(XN + (size_t)tok * DM, L, o);
        } else {
            const R16 fg = load_r16_f32(C.in[41], L); R16 o;
#pragma unroll
            for (int i = 0; i < 16; ++i) o.v[i] = hr.v[i] * rs * fg.v[i];
            store_r16_f32(C.out + (size_t)tok * DM, L, o);
        }
    }
}

#define PM(n) ((MASK >> (n)) & 1u)
constexpr int NPH_LAYER = 9, NPH = 2 + 2 * NPH_LAYER;
template <unsigned MASK> __global__ void __launch_bounds__(512, 2) hybrid_fwd(Args args) {
    extern __shared__ __attribute__((aligned(16))) unsigned char lds_raw[];
    Ctx C0; C0.in = args.in; C0.out = args.out; C0.ws = args.ws; C0.lds = (lds_t)lds_raw;
    C0.tid = threadIdx.x; C0.lane = C0.tid & 63; C0.wid = __builtin_amdgcn_readfirstlane(C0.tid >> 6); C0.bid = blockIdx.x; C0.G = gridDim.x;
    const Ctx& C = C0;
    const int lo = args.ph_lo, hi = args.ph_hi;
    const bool multi = (hi - lo) > 1;
    XcdBarrier bar; bar.bar = (unsigned*)(C.ws + WS_CTL); bar.x = 0; bar.st = (volatile LAS unsigned*)(C.lds + LDS_XB);
    if (multi) {
        if (C.tid == 0) *(LAS u32x4*)(C.lds + LDS_XB) = (u32x4){0u, 0u, 0u, 0u};
        __syncthreads();
        bar = xcd_barrier_post((unsigned*)(C.ws + WS_CTL), (volatile LAS unsigned*)(C.lds + LDS_XB));
    }
#define IN(k) (lo <= (k) && (k) < hi)
#define PHASE_CTX(c) Ctx c = C0; { int t_ = C0.tid; asm volatile("" : "+v"(t_)); c.tid = t_; c.lane = t_ & 63; c.wid = __builtin_amdgcn_readfirstlane(t_ >> 6); }
#ifndef MK_PROBE
#define MK_PROBE 0u
#endif
#ifndef MK_REPEAT
#define MK_REPEAT 0u
#endif
#define RP(k) ((MK_REPEAT >> (k)) & 1u)
#if MK_PROBE
#define STAMP(k) do { if (C0.bid == 0 && C0.tid == 0) ((LAS unsigned long long*)(C0.lds + LDS_XB + 16))[k] = wall_clock64(); } while (0)
#else
#define STAMP(k) do {} while (0)
#endif
#define SEAM(k) do { if (IN(k) && IN((k) + 1)) xcd_barrier(bar); STAMP((k) + 1); } while (0)
    STAMP(0);
    if (PM(0) && IN(0)) { PHASE_CTX(c); ph_prologue(c); } SEAM(0);
    if (PM(1) && IN(1)) { PHASE_CTX(c); ph_norm(c, 0, c.in[6], 0, NROW); } SEAM(1);
    for (int layer = 0; layer < 2; ++layer) {
        const int base = 2 + layer * NPH_LAYER;
        const bool emit = (layer == 0);
        const int nrows = emit ? NROW : NLAT;
        if (PM(2) && IN(base + 0)) {
            pg8::Gemm g{(const bf16_t*)(C.ws + WS_ACT), (const bf16_t*)(C.ws + WS_WIN) + (size_t)layer * NP * DM, NROW, NP, DM};
            pg8::StaticOrder S; S.init(NROW, NP, C.G, C.bid);
            pg8::EpiBf16<0> E{(bf16_t*)(C.ws + WS_P), NP, nullptr, 0, 0};
            pg8::gemm_phase<pg8::EpiBf16<0>, pg8::StaticOrder, false>(C.lds, g, S, E, nullptr);
            if (RP(0)) { xcd_barrier(bar); pg8::gemm_phase<pg8::EpiBf16<0>, pg8::StaticOrder, false>(C.lds, g, S, E, nullptr); }
        }
        SEAM(base + 0);
        if (PM(3) && IN(base + 1)) {
            const int nD = 2112, nC = 264, nB = emit ? 132 : 128, nA = emit ? 264 : 256, tot = nD + nC + nB + nA;
            for (int rep = 0; rep < (RP(1) ? 2 : 1); ++rep) {
            if (rep) xcd_barrier(bar);
            if (PM(11)) { PHASE_CTX(c); for (int it = c.bid; it < nD; it += c.G) item_rwkv_local(c, layer, it); }
            if (PM(12)) { PHASE_CTX(c); for (int it = nD + (c.bid + 64) % c.G; it < nD + nC; it += c.G) item_mamba_local(c, layer, it - nD); }
            if (PM(13)) { PHASE_CTX(c); for (int it = nD + nC + (c.bid + 192) % c.G; it < nD + nC + nB; it += c.G) item_chunkmlp(c, layer, it - nD - nC); }
            if (PM(14)) { PHASE_CTX(c); for (int it = nD + nC + nB + (c.bid + 64) % c.G; it < tot; it += c.G) item_conformer(c, layer, it - nD - nC - nB); }
            }
        }
        SEAM(base + 1);
        if (PM(4) && IN(base + 2)) { PHASE_CTX(c); ph_scan(c); }
        SEAM(base + 2);
        if (PM(5) && IN(base + 3)) {
            const int nc = nrows / 64;
            for (int rep = 0; rep < (RP(3) ? 2 : 1); ++rep) {
            if (rep) xcd_barrier(bar);
            if (PM(15)) { PHASE_CTX(c); load_g2t(c, layer); for (int it = c.bid; it < nc; it += c.G) item_rwkv_out(c, layer, it); }
            __syncthreads();
            if (PM(16)) { PHASE_CTX(c); for (int it = c.bid; it < nc; it += c.G) item_mamba_out(c, layer, (it + 128) % nc); }
            __syncthreads();
            }
        }
        SEAM(base + 3);
        if (PM(6) && IN(base + 4)) {
            pg8::Gemm g{(const bf16_t*)(C.ws + WS_ACT), (const bf16_t*)(C.ws + WS_WOUT) + (size_t)layer * DM * DM, nrows, DM, DM};
            pg8::StaticOrder S; S.init(nrows, DM, C.G, C.bid);
            EpiResid E{(float*)(C.ws + WS_H), (const float*)(C.ws + WS_MOD) + (size_t)layer * 3 * 6144};
            pg8::gemm_phase<EpiResid, pg8::StaticOrder, false>(C.lds, g, S, E, nullptr);
        }
        SEAM(base + 4);
        if (PM(7) && IN(base + 5)) { PHASE_CTX(c); for (int rep = 0; rep < (RP(5) ? 2 : 1); ++rep) { if (rep) xcd_barrier(bar); ph_norm(c, layer, c.in[7] + layer * 1024, 3, nrows); if (layer == 1) convert_tables(c, 1); } }
        SEAM(base + 5);
        if (PM(8) && IN(base + 6)) {
            pg8::Gemm g{(const bf16_t*)(C.ws + WS_ACT), (const bf16_t*)(C.ws + WS_WQ) + (size_t)layer * 2048 * DM, nrows, 2048, DM};
            pg8::StaticOrder S; S.init(nrows, 2048, C.G, C.bid);
            pg8::EpiBf16<0> E{(bf16_t*)(C.ws + WS_Q), 2048, nullptr, 0, 0};
            pg8::gemm_phase<pg8::EpiBf16<0>, pg8::StaticOrder, false>(C.lds, g, S, E, nullptr);
            if (RP(6)) { xcd_barrier(bar); pg8::gemm_phase<pg8::EpiBf16<0>, pg8::StaticOrder, false>(C.lds, g, S, E, nullptr); }
        }
        SEAM(base + 6);
        if (PM(9) && IN(base + 7)) { PHASE_CTX(c); ph_select(c, layer, nrows); if (RP(7)) { xcd_barrier(bar); ph_select(c, layer, nrows); } }
        SEAM(base + 7);
        if (PM(10) && IN(base + 8)) { PHASE_CTX(c); if (RP(8)) { ph_peer(c, layer, nrows, layer == 1, args.ph_hi > 1000); xcd_barrier(bar); } ph_peer(c, layer, nrows, layer == 1); }
        SEAM(base + 8);
    }
#if MK_PROBE
    {
        xcd_barrier(bar);
        if (C0.bid == 0 && C0.tid == 0) { const LAS unsigned long long* TS = (const LAS unsigned long long*)(C0.lds + LDS_XB + 16);
            unsigned long long sel = 0; for (int k = 0; k < NPH; ++k) if ((MK_PROBE >> k) & 1u) sel += TS[k + 1] - TS[k];
            const unsigned long long tot = TS[NPH] - TS[0];
            __hip_atomic_store((unsigned*)(C0.ws + 40960), (unsigned)((double)sel / (double)tot * (double)NLAT), __ATOMIC_RELAXED, __HIP_MEMORY_SCOPE_AGENT); }
        xcd_barrier(bar);
        const unsigned nz = __hip_atomic_load((unsigned*)(C0.ws + 40960), __ATOMIC_RELAXED, __HIP_MEMORY_SCOPE_AGENT);
        for (size_t i = (size_t)C0.bid * 512 + C0.tid; i < (size_t)nz * 256; i += (size_t)C0.G * 512) *(f32x4*)(C0.out + i * 4) = (f32x4){0.f, 0.f, 0.f, 0.f};
    }
#endif
#undef IN
#undef SEAM
}
}
#ifndef MK_DIAG
#define MK_DIAG 0
#endif


namespace mk {
struct LaunchEnt { unsigned mask; int ph; };
template <unsigned MASK> static bool prep_kernel() {
    return hipFuncSetAttribute((const void*)hybrid_fwd<MASK>, hipFuncAttributeMaxDynamicSharedMemorySize, LDS_BYTES) == hipSuccess;
}
template <unsigned MASK> static void launch_kernel(int grid, hipStream_t stream, const Args& a) {
    hipLaunchKernelGGL(hybrid_fwd<MASK>, dim3(grid), dim3(512), LDS_BYTES, stream, a);
}
}

#if MK_DIAG
namespace mk {
__global__ void census_kernel(const void* buf, size_t n, int kind  , unsigned* flags, int stage, float lim) {
    bool bad = false;
    for (size_t i = (size_t)blockIdx.x * blockDim.x + threadIdx.x; i < n; i += (size_t)gridDim.x * blockDim.x) {
        if (kind == 2) { const int v = ((const int*)buf)[i]; bad |= (v < 0 || v >= 16384); }
        else { const float v = kind == 0 ? ((const float*)buf)[i] : bf2f(((const bf16_t*)buf)[i]); bad |= !(fabsf(v) < lim); }
    }
    if (bad) atomicOr(flags + stage, 1u);
}
__global__ void encode_kernel(const float* x, const float* fg, float* out, const unsigned* flags, int nst) {
    int first = 0; for (int k = nst; k >= 1; --k) if (flags[k]) first = k;
    const int row = blockIdx.x * 4 + (threadIdx.x >> 6), lane = threadIdx.x & 63;
    Row16 r = load_row16(x + (size_t)row * DM, lane);
    const int t = row & 8191;
    for (int i = 0; i < 16; ++i) { const int c = (i < 8 ? 8 * lane + i : 512 + 8 * lane + i - 8); const int quarter = c >> 8, jj = c & 255; const float pos = (quarter < 2) ? (float)(t >> 6) : (float)(t & 63);
        const float fr = exp2f(-(float)jj * (13.287712379549449f / 256.f)); r.v[i] += (quarter & 1) ? cosf(pos * fr) : sinf(pos * fr); }
    float ss = 0.f; for (int i = 0; i < 16; ++i) ss += r.v[i] * r.v[i];
    const float rs = rsqrtf(wave_sum(ss) * (1.f / 1024.f) + 1e-6f);
    const Row16 g = load_row16(fg, lane); Row16 o;
    const bool zero = row < first * 512;
    for (int i = 0; i < 16; ++i) o.v[i] = zero ? 0.f : r.v[i] * rs * g.v[i];
    store_row16_f32(out + (size_t)row * DM, lane, o);
}
}
#define CENSUS(off, n, kind, stage, lim) hipLaunchKernelGGL(mk::census_kernel, dim3(1024), dim3(256), 0, stream, (const void*)((char*)d_ws + (off)), (size_t)(n), kind, (unsigned*)((char*)d_ws + 32768), stage, lim)
#else
#define CENSUS(off, n, kind, stage, lim) do {} while (0)
#endif
#ifndef MK_ONE_LAUNCH
#define MK_ONE_LAUNCH 1
#endif
extern "C" void kernel_launch(void* const* d_in, const int* in_sizes, int n_in, void* d_out, int out_size, void* d_ws, size_t ws_size, hipStream_t stream) {
    using namespace mk;
    static int grid = 0;
    if (grid == 0) {
        if (n_in != 42 || ws_size < WS_END) { fprintf(stderr, "kernel_launch: need 42 inputs and %zu bytes of workspace (got %d, %zu)\n", (size_t)WS_END, n_in, ws_size); grid = -1; return; }
        int dev = 0, cus = 0;
        if (hipGetDevice(&dev) != hipSuccess || hipDeviceGetAttribute(&cus, hipDeviceAttributeMultiprocessorCount, dev) != hipSuccess) { grid = -1; return; }
        bool ok = true;
#if MK_ONE_LAUNCH
        ok = ok && prep_kernel<0x1FFFFu>();
#else
        ok = ok && prep_kernel<0x0001u>() && prep_kernel<0x0002u>() && prep_kernel<0x0004u>() && prep_kernel<0x0808u>() && prep_kernel<0x1008u>() && prep_kernel<0x2008u>() && prep_kernel<0x4008u>()
                && prep_kernel<0x0010u>() && prep_kernel<0x8020u>() && prep_kernel<0x10020u>() && prep_kernel<0x0040u>() && prep_kernel<0x0080u>() && prep_kernel<0x0100u>() && prep_kernel<0x0200u>() && prep_kernel<0x0400u>();
#endif
        if (!ok) { fprintf(stderr, "kernel_launch: hipFuncSetAttribute failed\n"); grid = -1; return; }
        (void)hipGetLastError();
        grid = cus;
    }
    if (grid < 0) return;
    (void)hipMemsetAsync((char*)d_ws + WS_CTL, 0, 65536, stream);
    Args a{};
    for (int i = 0; i < 42; ++i) a.in[i] = (const float*)d_in[i];
    a.out = (float*)d_out; a.ws = (unsigned char*)d_ws;
#if MK_ONE_LAUNCH
    a.ph_lo = 0; a.ph_hi = NPH; launch_kernel<0x1FFFFu>(grid, stream, a);
#else
    a.ph_lo = 0; a.ph_hi = 1; launch_kernel<0x0001u>(grid, stream, a);
    CENSUS(WS_H, (size_t)NROW * DM, 0, 1, 1e4f); CENSUS(WS_MOD, 2 * 3 * 6144, 0, 1, 1e4f); CENSUS(WS_WIN, 2ull * NP * DM, 1, 1, 1e4f); CENSUS(WS_UB, 2ull * NEXP * DM, 1, 1, 1e4f);
    a.ph_lo = 1; a.ph_hi = 2; launch_kernel<0x0002u>(grid, stream, a);
    CENSUS(WS_ACT, (size_t)NROW * DM, 1, 2, 1e4f);
    for (int layer = 0; layer < 2; ++layer) {
        const int b = 2 + layer * NPH_LAYER;
        const int so = layer ? 100 : 0; (void)so;
        a.ph_lo = b + 0; a.ph_hi = b + 1; launch_kernel<0x0004u>(grid, stream, a);
        if (!layer) CENSUS(WS_P, (size_t)NROW * NP, 1, 3, 1e4f);
        a.ph_lo = b + 1; a.ph_hi = b + 2; launch_kernel<0x0808u>(grid, stream, a);
        if (!layer) { CENSUS(WS_RG, (size_t)NSLOT * 4096, 1, 4, 1e6f); CENSUS(WS_RJ, (size_t)NSLOT * 4096, 0, 5, 1e6f); CENSUS(WS_RY, (size_t)NSLOT * 4096 * 2, 1, 6, 1e6f); CENSUS(WS_BON, (size_t)NROW * 8, 0, 6, 1e6f); }
        launch_kernel<0x1008u>(grid, stream, a);
        if (!layer) { CENSUS(WS_MST, (size_t)NSLOT * 8192, 0, 7, 1e6f); CENSUS(WS_MCD, NSLOT, 0, 7, 1e6f); }
        launch_kernel<0x2008u>(grid, stream, a); launch_kernel<0x4008u>(grid, stream, a);
        a.ph_lo = b + 2; a.ph_hi = b + 3; launch_kernel<0x0010u>(grid, stream, a);
        if (!layer) { CENSUS(WS_MST, (size_t)NSLOT * 8192, 0, 8, 1e6f); CENSUS(WS_RH, (size_t)NSLOT * 4096, 1, 9, 1e6f); }
        a.ph_lo = b + 3; a.ph_hi = b + 4; launch_kernel<0x8020u>(grid, stream, a); launch_kernel<0x10020u>(grid, stream, a);
        if (!layer) CENSUS(WS_ACT, (size_t)NROW * DM, 1, 10, 1e4f);
        a.ph_lo = b + 4; a.ph_hi = b + 5; launch_kernel<0x0040u>(grid, stream, a);
        if (!layer) CENSUS(WS_H, (size_t)NROW * DM, 0, 11, 1e4f);
        a.ph_lo = b + 5; a.ph_hi = b + 6; launch_kernel<0x0080u>(grid, stream, a);
        a.ph_lo = b + 6; a.ph_hi = b + 7; launch_kernel<0x0100u>(grid, stream, a);
        if (!layer) CENSUS(WS_Q, (size_t)NROW * 2048, 1, 12, 1e4f);
        a.ph_lo = b + 7; a.ph_hi = b + 8; launch_kernel<0x0200u>(grid, stream, a);
        if (!layer) { CENSUS(WS_SELI, (size_t)NROW * 128, 2, 13, 0.f); CENSUS(WS_SELG, (size_t)NROW * 128, 0, 13, 2.f); }
        a.ph_lo = b + 8; a.ph_hi = b + 9; launch_kernel<0x0400u>(grid, stream, a);
        if (!layer) { CENSUS(WS_H, (size_t)NROW * DM, 0, 14, 1e4f); CENSUS(WS_ACT, (size_t)NROW * DM, 1, 15, 1e4f); }
    }
#endif
#if MK_DIAG
    hipLaunchKernelGGL(mk::encode_kernel, dim3(NLAT / 4), dim3(256), 0, stream, (const float*)d_in[0], (const float*)d_in[41], (float*)d_out, (const unsigned*)((char*)d_ws + 32768), 15);
#endif
    (void)in_sizes; (void)out_size;
}
```

```cpp
#include <hip/hip_runtime.h>
#include <cstdio>
#include <cstdint>
namespace pg8 {
#define PG8_LAS __attribute__((address_space(3)))
typedef unsigned short bf16_t;
typedef short bf16x8 __attribute__((ext_vector_type(8)));
typedef float f32x4 __attribute__((ext_vector_type(4)));
typedef unsigned u32x4 __attribute__((ext_vector_type(4)));
constexpr int BM = 256, BK = 64, HALF = 128, HTB = HALF * BK * 2  , STAGE_BYTES = 8 * HTB, NXCD = 8, WGM = 8;

__host__ __device__ __forceinline__ int lds_byte(int r, int c) { const int st = (r >> 4) * 2 + (c >> 5), rr = r & 15, cc = c & 31, ob = rr * 64 + cc * 2; return st * 1024 + (ob ^ (((ob >> 9) & 1) << 5)); }
__host__ __device__ __forceinline__ void stage_rc(int b, int& R, int& C) { const int st = b / 1024, sb = b % 1024, swz = sb ^ (((sb >> 9) & 1) << 5); R = (st >> 1) * 16 + swz / 64; C = (st & 1) * 32 + (swz % 64) / 2; }
__host__ __device__ __forceinline__ int perm32(int rho) { const int n = rho >> 4, i = rho & 15; return 8 * (i >> 2) + 4 * n + (i & 3); }

struct Unit { int pm, pn; };
struct Gemm { const bf16_t* A; const bf16_t* Bt; int M, N, K; };

struct StaticOrder {
    int nM, nN, nwg, G, c;
    __host__ __device__ void init(int M, int N, int G_, int c_) { nM = M / BM; nN = N / BM; nwg = nM * nN; G = G_; c = c_; }
    __host__ __device__ bool next(int i, Unit& u) const {
        const long L = (long)i * G + c; if (L >= nwg) return false;
        int wgid = (int)L; { const int q = nwg / NXCD, r = nwg % NXCD, xcd = wgid % NXCD, off = wgid / NXCD; wgid = (xcd < r ? xcd * (q + 1) : r * (q + 1) + (xcd - r) * q) + off; }
        const int nig = WGM * nN, gid = wgid / nig, fm = gid * WGM, gsz = (nM - fm) < WGM ? (nM - fm) : WGM;
        u.pm = fm + ((wgid % nig) % gsz); u.pn = (wgid % nig) / gsz; return true;
    }
    __device__ __forceinline__ void a_ready(const Unit&) const {}
    __device__ __forceinline__ void done(const Unit&) const {}
};
struct CountedOrder : StaticOrder {
    const unsigned* ready; unsigned need; unsigned* tmo;
    __device__ __forceinline__ void a_ready(const Unit& u) const {
        if (threadIdx.x < 64) {
            const unsigned long long t0 = __builtin_amdgcn_s_memrealtime(); unsigned polls = 0;
            while ((unsigned)__builtin_amdgcn_readfirstlane(__hip_atomic_load(ready + 64 * u.pm, __ATOMIC_RELAXED, __HIP_MEMORY_SCOPE_AGENT)) < need) {
                if ((++polls & 255u) == 0u && __builtin_amdgcn_readfirstlane(__hip_atomic_load(tmo, __ATOMIC_RELAXED, __HIP_MEMORY_SCOPE_AGENT)) != 0u) break;
                if (__builtin_amdgcn_s_memrealtime() - t0 > 2000000ull) {
                    if (threadIdx.x == 0) { unsigned expect = 0u; __hip_atomic_compare_exchange_strong(tmo + 1, &expect, 0x600u | (unsigned)(u.pm & 0xff), __ATOMIC_RELAXED, __ATOMIC_RELAXED, __HIP_MEMORY_SCOPE_AGENT); __hip_atomic_store(tmo, 1u, __ATOMIC_RELAXED, __HIP_MEMORY_SCOPE_AGENT); }
                    break; }
                __builtin_amdgcn_s_sleep(2); }
            __builtin_amdgcn_fence(__ATOMIC_ACQUIRE, "agent");
            asm volatile("s_waitcnt vmcnt(0)" ::: "memory");
        }
#if !defined(BROKEN_HOOK_NO_BARRIER)
        asm volatile("" ::: "memory"); __builtin_amdgcn_s_barrier(); asm volatile("" ::: "memory");
#endif
    }
};

__device__ __forceinline__ unsigned cvt_pk_bf16(float lo, float hi) { unsigned r; asm volatile("v_cvt_pk_bf16_f32 %0, %1, %2" : "=v"(r) : "v"(lo), "v"(hi)); return r; }
typedef float f32x2 __attribute__((ext_vector_type(2)));
__device__ __forceinline__ f32x2 gelu_pk(f32x2 v) {
    const f32x2 av = __builtin_elementwise_abs(v), d = av * 0.2316418882f + 1.0f;
    f32x2 t; t.x = __builtin_amdgcn_rcpf(d.x); t.y = __builtin_amdgcn_rcpf(d.y);
    f32x2 q = t * 0.5307027145f + (-0.7265760135f); q = q * t + 0.7107068705f; q = q * t + (-0.142248368f); q = q * t + 0.127414796f; q = q * t;
    const f32x2 s = (v * v) * (-0.72134752044f);
    f32x2 e; e.x = __builtin_amdgcn_exp2f(s.x); e.y = __builtin_amdgcn_exp2f(s.y);
    const f32x2 m = v * (q * e), r = v - m;
    f32x2 o; o.x = v.x < 0.f ? m.x : r.x; o.y = v.y < 0.f ? m.y : r.y; return o;
}

struct EpiF32 {
    static constexpr bool PERM = false, AFTER_DRAIN = false;
    float* C; int ldc; const float* bias;
    __device__ __forceinline__ void operator()(const f32x4 (&acc)[2][2][4][2], const Unit& u, int wr, int wc, int fr, int fq) const {
        const int row0 = u.pm * BM + wr * 64 + fr, col0 = u.pn * BM + wc * 32 + 4 * fq;
        f32x4 bv[2][2];
#pragma unroll
        for (int bj = 0; bj < 2; ++bj)
#pragma unroll
            for (int n = 0; n < 2; ++n) bv[bj][n] = bias ? *(const f32x4*)(bias + col0 + bj * HALF + n * 16) : (f32x4){0.f, 0.f, 0.f, 0.f};
#pragma unroll
        for (int ai = 0; ai < 2; ++ai)
#pragma unroll
            for (int m = 0; m < 4; ++m) { float* rowp = C + (size_t)(row0 + ai * HALF + m * 16) * ldc + col0;
#pragma unroll
                for (int bj = 0; bj < 2; ++bj)
#pragma unroll
                    for (int n = 0; n < 2; ++n) *(f32x4*)(rowp + bj * HALF + n * 16) = acc[ai][bj][m][n] + bv[bj][n]; }
    }
};
template <int ACT  > struct EpiBf16 {
    static constexpr bool PERM = true, AFTER_DRAIN = false;
    bf16_t* O; int ldc; const float* bias; int split_cols; size_t split_stride;
    __device__ __forceinline__ void operator()(const f32x4 (&acc)[2][2][4][2], const Unit& u, int wr, int wc, int fr, int fq) const {
        const int row0 = u.pm * BM + wr * 64 + fr; int colt = u.pn * BM; bf16_t* base = O;
        if (split_cols) { const int t = colt / split_cols; base += (size_t)t * split_stride; colt -= t * split_cols; }
        const int col0 = colt + wc * 32 + 8 * fq, bcol0 = u.pn * BM + wc * 32 + 8 * fq;
        f32x4 bv[2][2];
#pragma unroll
        for (int bj = 0; bj < 2; ++bj)
#pragma unroll
            for (int n = 0; n < 2; ++n) bv[bj][n] = bias ? *(const f32x4*)(bias + bcol0 + bj * HALF + 4 * n) : (f32x4){0.f, 0.f, 0.f, 0.f};
#pragma unroll
        for (int ai = 0; ai < 2; ++ai)
#pragma unroll
            for (int m = 0; m < 4; ++m) { bf16_t* rowp = base + (size_t)(row0 + ai * HALF + m * 16) * ldc + col0;
#pragma unroll
                for (int bj = 0; bj < 2; ++bj) { f32x4 v0 = acc[ai][bj][m][0] + bv[bj][0], v1 = acc[ai][bj][m][1] + bv[bj][1];
                    if (ACT == 1) { f32x2 a = gelu_pk((f32x2){v0[0], v0[1]}), b = gelu_pk((f32x2){v0[2], v0[3]}), c = gelu_pk((f32x2){v1[0], v1[1]}), d = gelu_pk((f32x2){v1[2], v1[3]});
                        v0 = (f32x4){a.x, a.y, b.x, b.y}; v1 = (f32x4){c.x, c.y, d.x, d.y}; }
                    if (ACT == 2) {
#pragma unroll
                        for (int j = 0; j < 4; ++j) { v0[j] = 0.5f * v0[j] * (1.0f + erff(v0[j] * 0.70710678f)); v1[j] = 0.5f * v1[j] * (1.0f + erff(v1[j] * 0.70710678f)); } }
                    u32x4 w; w.x = cvt_pk_bf16(v0[0], v0[1]); w.y = cvt_pk_bf16(v0[2], v0[3]); w.z = cvt_pk_bf16(v1[0], v1[1]); w.w = cvt_pk_bf16(v1[2], v1[3]);
                    *(u32x4*)(rowp + bj * HALF) = w; } }
    }
};
template <class Epi, class Sched, bool STAMP = false>
__device__ __forceinline__ void gemm_phase(PG8_LAS unsigned char* lds, const Gemm g, const Sched& S, const Epi& E, unsigned long long* stamps) {
    int tid_ = threadIdx.x; asm volatile("" : "+v"(tid_));
    const int tid = tid_, wid = __builtin_amdgcn_readfirstlane(tid >> 6), lane = tid & 63, wr = wid >> 2, wc = wid & 3, fr = lane & 15, fq = lane >> 4;
    const int K = g.K, nt = K / BK;
    int ts_lo = 0, ts_hi = 0, nts = 0; const unsigned long long rt_entry = STAMP ? (unsigned long long)wall_clock64() : 0ull;
#define PG8_STAMP() do { if (STAMP && wid == 0 && nts < 64) { const unsigned long long _c = (unsigned long long)clock64(); \
        ts_lo = (lane == nts) ? (int)(unsigned)_c : ts_lo; ts_hi = (lane == nts) ? (int)(unsigned)(_c >> 32) : ts_hi; ++nts; } } while (0)
    PG8_STAMP();
    unsigned voffA[2], voffB[2];
#pragma unroll
    for (int i = 0; i < 2; ++i) { int R, C; stage_rc(tid * 16 + i * 8192, R, C); const int Rb = Epi::PERM ? ((R & ~31) + perm32(R & 31)) : R;
        voffA[i] = (unsigned)(R * K + C) * 2u; voffB[i] = (unsigned)(Rb * K + C) * 2u; }
    const size_t kstep = (size_t)(BK * 2);
    const size_t hstep = (size_t)HALF * K * 2;
    const size_t tstep = 2 * hstep;
    const unsigned ldsw = (unsigned)wid * 1024u;
    const int aoff = lds_byte(wr * 64 + fr, fq * 8), boff = lds_byte(wc * 32 + fr, fq * 8);
#define PG8_SA(b, h) (((b) * 2 + (h)) * HTB)
#define PG8_SB(b, h) ((4 + (b) * 2 + (h)) * HTB)
#define PG8_STAGE(bufoff, gbase, voff) do { _Pragma("unroll") for (int _i = 0; _i < 2; ++_i) \
        __builtin_amdgcn_global_load_lds((const unsigned*)((const char*)(gbase) + (voff)[_i]), (PG8_LAS unsigned*)(lds + (bufoff) + ldsw + _i * 8192), 16, 0, 0); } while (0)
#define PG8_LDA(dst, b, h) do { _Pragma("unroll") for (int m = 0; m < 4; ++m) _Pragma("unroll") for (int k = 0; k < 2; ++k) dst[m][k] = *(const PG8_LAS bf16x8*)(lds + PG8_SA(b, h) + aoff + m * 2048 + k * 1024); } while (0)
#define PG8_LDB(dst, b, h) do { _Pragma("unroll") for (int n = 0; n < 2; ++n) _Pragma("unroll") for (int k = 0; k < 2; ++k) dst[n][k] = *(const PG8_LAS bf16x8*)(lds + PG8_SB(b, h) + boff + n * 2048 + k * 1024); } while (0)
#define PG8_MMA(ai, bj, At, Bt) do { __builtin_amdgcn_s_setprio(1); _Pragma("unroll") for (int m = 0; m < 4; ++m) _Pragma("unroll") for (int n = 0; n < 2; ++n) _Pragma("unroll") for (int k = 0; k < 2; ++k) \
        acc[ai][bj][m][n] = __builtin_amdgcn_mfma_f32_16x16x32_bf16(Bt[n][k], At[m][k], acc[ai][bj][m][n], 0, 0, 0); __builtin_amdgcn_s_setprio(0); } while (0)
#define PG8_WAIT_V(n) asm volatile("s_waitcnt vmcnt(" #n ")" ::: "memory")
#define PG8_WAIT_L(n) asm volatile("s_waitcnt lgkmcnt(" #n ")" ::: "memory")
#define PG8_BAR __builtin_amdgcn_s_barrier()
#define PG8_SCHED __builtin_amdgcn_sched_barrier(0)
    Unit cur, nxt; int ui = 0;
    if (!S.next(0, cur)) return;
    f32x4 acc[2][2][4][2];
#pragma unroll
    for (int a = 0; a < 2; ++a)
#pragma unroll
        for (int b = 0; b < 2; ++b)
#pragma unroll
            for (int m = 0; m < 4; ++m)
#pragma unroll
                for (int n = 0; n < 2; ++n) acc[a][b][m][n] = (f32x4){0.f, 0.f, 0.f, 0.f};
    bf16x8 At[4][2], B0[2][2], B1[2][2];
    const char* cA = (const char*)g.A + (size_t)cur.pm * tstep; const char* cB = (const char*)g.Bt + (size_t)cur.pn * tstep;
    S.a_ready(cur);
    PG8_STAGE(PG8_SB(0, 0), cB, voffB); PG8_STAGE(PG8_SA(0, 0), cA, voffA); PG8_STAGE(PG8_SB(0, 1), cB + hstep, voffB); PG8_STAGE(PG8_SA(0, 1), cA + hstep, voffA);
    if (wr == 1) PG8_BAR;
    PG8_WAIT_V(4); PG8_BAR;
    PG8_STAGE(PG8_SB(1, 0), cB + kstep, voffB); PG8_STAGE(PG8_SA(1, 0), cA + kstep, voffA); PG8_STAGE(PG8_SB(1, 1), cB + hstep + kstep, voffB);
    PG8_WAIT_V(6); PG8_BAR;
    PG8_STAMP();
    for (;;) {
        const bool has_next = S.next(ui + 1, nxt);
        const char* nA = has_next ? (const char*)g.A + (size_t)nxt.pm * tstep : cA; const char* nB = has_next ? (const char*)g.Bt + (size_t)nxt.pn * tstep : cB;
        for (int t = 0; t < nt; t += 2) {
            const bool last = (t == nt - 2);
            const char* a1 = cA + (size_t)(t + 1) * kstep;
            const char* a2 = last ? nA : cA + (size_t)(t + 2) * kstep; const char* b2 = last ? nB : cB + (size_t)(t + 2) * kstep;
            const char* a3 = a2 + kstep; const char* b3 = b2 + kstep;
            if (last && has_next) S.a_ready(nxt);
            PG8_LDB(B0, 0, 0); PG8_SCHED; PG8_LDA(At, 0, 0); PG8_STAGE(PG8_SA(1, 1), a1 + hstep, voffA);
            PG8_WAIT_L(8); PG8_BAR; PG8_WAIT_L(0); PG8_MMA(0, 0, At, B0); PG8_BAR; PG8_SCHED;
            PG8_LDB(B1, 0, 1); PG8_STAGE(PG8_SB(0, 0), b2, voffB);
            PG8_BAR; PG8_WAIT_L(0); PG8_MMA(0, 1, At, B1); PG8_BAR;
            PG8_LDA(At, 0, 1); PG8_STAGE(PG8_SA(0, 0), a2, voffA);
            PG8_BAR; PG8_WAIT_L(0); PG8_MMA(1, 0, At, B0); PG8_BAR; PG8_SCHED;
            PG8_STAGE(PG8_SB(0, 1), b2 + hstep, voffB);
            PG8_WAIT_V(6); PG8_BAR; PG8_MMA(1, 1, At, B1); PG8_BAR;
            PG8_LDB(B0, 1, 0); PG8_SCHED; PG8_LDA(At, 1, 0); PG8_STAGE(PG8_SA(0, 1), a2 + hstep, voffA);
            PG8_WAIT_L(8); PG8_BAR; PG8_WAIT_L(0); PG8_MMA(0, 0, At, B0); PG8_BAR; PG8_SCHED;
            PG8_LDB(B1, 1, 1); PG8_STAGE(PG8_SB(1, 0), b3, voffB);
            PG8_BAR; PG8_WAIT_L(0); PG8_MMA(0, 1, At, B1); PG8_BAR;
            PG8_LDA(At, 1, 1); PG8_STAGE(PG8_SA(1, 0), a3, voffA);
            PG8_BAR; PG8_WAIT_L(0); PG8_MMA(1, 0, At, B0); PG8_BAR; PG8_SCHED;
            PG8_STAGE(PG8_SB(1, 1), b3 + hstep, voffB);
            PG8_WAIT_V(6); PG8_BAR; PG8_MMA(1, 1, At, B1); PG8_BAR;
        }
        PG8_STAMP();
        if constexpr (!Epi::AFTER_DRAIN) { E(acc, cur, wr, wc, fr, fq); S.done(cur); }
        PG8_STAMP();
        if (!has_next) break;
#pragma unroll
        for (int a = 0; a < 2; ++a)
#pragma unroll
            for (int b = 0; b < 2; ++b)
#pragma unroll
                for (int m = 0; m < 4; ++m)
#pragma unroll
                    for (int n = 0; n < 2; ++n) acc[a][b][m][n] = (f32x4){0.f, 0.f, 0.f, 0.f};
        cur = nxt; cA = nA; cB = nB; ++ui;
    }
    PG8_WAIT_V(0);
    if (wr == 0) PG8_BAR;
    PG8_BAR;
    if constexpr (Epi::AFTER_DRAIN) { E.fused(acc, cur, wr, wc, fr, fq, lds, wid, lane); S.done(cur); }
    PG8_STAMP();
    if (STAMP && wid == 0) { stamps[lane] = lane < nts ? (((unsigned long long)(unsigned)ts_hi << 32) | (unsigned)ts_lo) : 0ull;
        if (lane == 62) stamps[62] = rt_entry; if (lane == 63) stamps[63] = (unsigned long long)wall_clock64(); }
#undef PG8_STAMP
#undef PG8_SA
#undef PG8_SB
#undef PG8_STAGE
#undef PG8_LDA
#undef PG8_LDB
#undef PG8_MMA
#undef PG8_WAIT_V
#undef PG8_WAIT_L
#undef PG8_BAR
#undef PG8_SCHED
}
}
#define XB_TMO      128
#define XB_XCNT(j)  (256  + 64 * (j))
#define XB_XSUB(j)  (1280 + 64 * (j))
#define XB_XGEN(j)  (2304 + 64 * (j))
#define XB_TOP      3328
#define XB_TOPGEN   3392
#define XCD_BAR_WORDS 3456
#define XB_SPIN_CAP (1u << 18)
#define LAS __attribute__((address_space(3)))

__device__ __forceinline__ unsigned xb_ld(unsigned* p)              { return __hip_atomic_load(p, __ATOMIC_RELAXED, __HIP_MEMORY_SCOPE_AGENT); }
__device__ __forceinline__ unsigned xb_add(unsigned* p, unsigned v) { return __hip_atomic_fetch_add(p, v, __ATOMIC_RELAXED, __HIP_MEMORY_SCOPE_AGENT); }
__device__ __forceinline__ unsigned xb_xcc_id() { return (unsigned)__builtin_amdgcn_s_getreg((3 << 11) | 20) & 0xFu; }
#define XB_SPIN(cond, bar) do { unsigned _sp = 0; while (cond) { __builtin_amdgcn_s_sleep(1); \
    if ((++_sp & 255u) == 0u) { if (xb_ld(&(bar)[XB_TMO])) break; if (_sp > XB_SPIN_CAP) { atomicAdd(&(bar)[XB_TMO], 1u); break; } } } } while (0)

struct XcdBarrier {
    unsigned* bar; unsigned x;
    volatile LAS unsigned* st;
};

__device__ __forceinline__ XcdBarrier xcd_barrier_post(unsigned* bar, volatile LAS unsigned* st) {
    XcdBarrier b; b.bar = bar; b.x = xb_xcc_id(); b.st = st;
    if (threadIdx.x == 0) (void)xb_add(&bar[XB_XCNT(b.x)], 1u);
    return b;
}
__device__ __forceinline__ void xcd_barrier_complete(unsigned* bar, unsigned x, unsigned& nloc, unsigned& nx) {
    const unsigned G = gridDim.x * gridDim.y * gridDim.z;
    unsigned sum, cnt, mine, sp = 0u;
    for (;;) {
        sum = 0u; cnt = 0u; mine = 0u;
#pragma unroll
        for (unsigned j = 0; j < 16; ++j) { const unsigned c = xb_ld(&bar[XB_XCNT(j)]); sum += c; cnt += (c > 0u) ? 1u : 0u; mine = (j == x) ? c : mine; }
        if (sum == G) break;
        __builtin_amdgcn_s_sleep(1);
        if ((++sp & 255u) == 0u) { if (xb_ld(&bar[XB_TMO])) break; if (sp > XB_SPIN_CAP) { atomicAdd(&bar[XB_TMO], 1u); break; } }
    }
    nloc = mine > 0u ? mine : 1u; nx = cnt > 0u ? cnt : 1u;
}

__device__ __forceinline__ void xcd_barrier(const XcdBarrier& b) {
    asm volatile("s_waitcnt vmcnt(0)" ::: "memory");
    __syncthreads();
    if (threadIdx.x == 0) {
        unsigned* bar = b.bar;
        __builtin_amdgcn_s_waitcnt(0);
        unsigned nloc = b.st[0], nx = b.st[1];
        if (nloc == 0u) { xcd_barrier_complete(bar, b.x, nloc, nx); b.st[0] = nloc; b.st[1] = nx; }
        const unsigned old = xb_add(&bar[XB_XSUB(b.x)], 1u);
        const unsigned gen = old / nloc;
        if (old + 1u == (gen + 1u) * nloc) {
            __builtin_amdgcn_fence(__ATOMIC_RELEASE, "agent");
            asm volatile("s_waitcnt vmcnt(0)" ::: "memory");
            const unsigned og = xb_add(&bar[XB_TOP], 1u);
            const unsigned tg = og / nx;
            if (og + 1u == (tg + 1u) * nx) xb_add(&bar[XB_TOPGEN], 1u);
            else XB_SPIN(xb_ld(&bar[XB_TOPGEN]) == tg, bar);
            __builtin_amdgcn_fence(__ATOMIC_ACQUIRE, "agent");
            xb_add(&bar[XB_XGEN(b.x)], 1u);
            asm volatile("s_waitcnt vmcnt(0)" ::: "memory");
        } else {
            XB_SPIN(xb_ld(&bar[XB_XGEN(b.x)]) == gen, bar);
            __builtin_amdgcn_fence(__ATOMIC_ACQUIRE, "agent");
            asm volatile("s_waitcnt vmcnt(0)" ::: "memory");
        }
    }
    __syncthreads();
}

namespace mk {
using pg8::bf16_t; using pg8::bf16x8; using pg8::f32x4; using pg8::u32x4;
typedef unsigned u32x2 __attribute__((ext_vector_type(2)));
typedef __bf16 bf16x2_t __attribute__((ext_vector_type(2)));
typedef LAS unsigned char* lds_t;

constexpr int DM = 1024, NLAT = 16384, NROW = 16896;
constexpr int OFF_B = 512, OFF_C = 1024, OFF_D = 2056, INC = 3208, NP = 3328;
constexpr int NCH = 132, NSLOT = 16 * NCH;
constexpr int NEXP = 16384;

constexpr size_t WS_CTL  = 0;
constexpr size_t WS_MOD  = 65536;
constexpr size_t WS_WIN  = WS_MOD + 147456;
constexpr size_t WS_WOUT = WS_WIN + 2ull * NP * DM * 2;
constexpr size_t WS_WQ   = WS_WOUT + 2ull * DM * DM * 2;
constexpr size_t WS_H    = WS_WQ + 2ull * 2048 * DM * 2;
constexpr size_t WS_ACT  = WS_H + (size_t)NROW * DM * 4;
constexpr size_t WS_UB   = WS_ACT + (size_t)NROW * DM * 2;
constexpr size_t WS_VB   = WS_UB + (size_t)NEXP * DM * 2;
constexpr size_t WS_SU   = WS_UB + (size_t)NEXP * DM;
constexpr size_t WS_SV   = WS_VB + (size_t)NEXP * DM;
constexpr size_t WS_P    = WS_VB + (size_t)NEXP * DM * 2;
constexpr size_t WS_Q    = WS_P;
constexpr size_t WS_SELI = WS_Q + (size_t)NROW * 2048 * 2;
constexpr size_t WS_SELG = WS_SELI + (size_t)NROW * 128 * 4;
constexpr size_t WS_MST  = WS_P + (size_t)NROW * NP * 2;
constexpr size_t WS_MCD  = WS_MST + (size_t)NSLOT * 8192 * 4;
constexpr size_t WS_RG   = WS_MCD + 16384;
constexpr size_t WS_RJ   = WS_RG + (size_t)NSLOT * 8192;
constexpr size_t WS_RY   = WS_RJ + (size_t)NSLOT * 16384;
constexpr size_t WS_RL   = WS_RY + (size_t)NSLOT * 8192;
constexpr size_t WS_RH   = WS_RL + (size_t)NSLOT * 8192;
constexpr size_t WS_BON  = WS_RH + (size_t)NSLOT * 8192;
constexpr size_t WS_END  = WS_BON + (size_t)NROW * 8 * 4;
static_assert(WS_SELG + (size_t)NROW * 128 * 4 <= WS_MST, "Q + selections must fit in P's region");

constexpr int LDS_BYTES = 157440;
constexpr int LDS_XB = 157184;

struct Args { const float* in[42]; float* out; unsigned char* ws; int ph_lo, ph_hi; };

struct Ctx {
    const float* const* in; float* out; unsigned char* ws; lds_t lds;
    int tid, lane, wid, bid, G;
};

__device__ __forceinline__ float bf2f(unsigned short x) { return __uint_as_float(((unsigned)x) << 16); }
__device__ __forceinline__ float bflo(unsigned w) { return __uint_as_float(w << 16); }
__device__ __forceinline__ float bfhi(unsigned w) { return __uint_as_float(w & 0xffff0000u); }
typedef __bf16 bf16pair_t __attribute__((ext_vector_type(2)));
__device__ __forceinline__ unsigned pk2(float lo, float hi) { const bf16pair_t v = {(__bf16)lo, (__bf16)hi}; return __builtin_bit_cast(unsigned, v); }
__device__ __forceinline__ unsigned short f2bf(float f) { return (unsigned short)(pk2(f, 0.f) & 0xffffu); }
__device__ __forceinline__ float wave_sum(float v) {
#pragma unroll
    for (int o = 1; o < 64; o <<= 1) v += __shfl_xor(v, o);
    return v;
}
__device__ __forceinline__ float wave_incl_scan(float v, int lane) {
#pragma unroll
    for (int o = 1; o < 64; o <<= 1) { const float t = __shfl_up(v, o); v += (lane >= o) ? t : 0.f; }
    return v;
}
__device__ __forceinline__ float sigm(float x) { return 1.f / (1.f + expf(-x)); }
__device__ __forceinline__ float silu(float x) { return x / (1.f + expf(-x)); }
__device__ __forceinline__ float softplus(float x) { return fmaxf(x, 0.f) + log1pf(expf(-fabsf(x))); }
__device__ __forceinline__ float gelu_tanh(float x) { const float u = 0.7978845608028654f * (x + 0.044715f * x * x * x); return 0.5f * x * (1.f + tanhf(u)); }
__device__ __forceinline__ float dot2bf(unsigned a, unsigned b, float acc) { return __builtin_amdgcn_fdot2_f32_bf16(__builtin_bit_cast(bf16x2_t, a), __builtin_bit_cast(bf16x2_t, b), acc, false); }

struct ChunkInfo { int row0, lo, hi, b, tc, isctx; };
__device__ __forceinline__ ChunkInfo chunk_info(int gc) {
    ChunkInfo c; c.row0 = gc * 64;
    if (gc < 256) { c.b = gc >> 7; c.tc = gc & 127; c.isctx = 0; c.lo = c.b * 8192; c.hi = c.lo + 8192; }
    else { const int q = gc - 256; c.b = q >> 2; c.tc = q & 3; c.isctx = 1; c.lo = NLAT + c.b * 256; c.hi = c.lo + 256; }
    return c;
}
__device__ __forceinline__ int cpos_of(const ChunkInfo& c, int d) { return c.isctx ? (d ? 3 - c.tc : c.tc) : (d ? 4 + 127 - c.tc : 4 + c.tc); }
__device__ __forceinline__ int slot_of(int b, int h, int d, int cpos) { return ((b * 4 + h) * 2 + d) * NCH + cpos; }

template <int MT, int NT, int KS, class Epi>
__device__ __forceinline__ void blk_mma(const LAS bf16_t* A, int lda, const LAS bf16_t* Bt, int ldb, int wid, int lane, Epi epi) {
    const int fr = lane & 15, fq = lane >> 4;
    for (int tt = wid; tt < MT * NT; tt += 8) {
        const int tm = tt / NT, tn = tt % NT;
        f32x4 acc = {0.f, 0.f, 0.f, 0.f};
#pragma unroll
        for (int ks = 0; ks < KS; ++ks) {
            const bf16x8 a = *(const LAS bf16x8*)(A + (tm * 16 + fr) * lda + ks * 32 + fq * 8);
            const bf16x8 b = *(const LAS bf16x8*)(Bt + (tn * 16 + fr) * ldb + ks * 32 + fq * 8);
            acc = __builtin_amdgcn_mfma_f32_16x16x32_bf16(a, b, acc, 0, 0, 0);
        }
        epi(tm * 16 + fq * 4, tn * 16 + fr, acc);
    }
}
template <int MT, int NT, int KS, class Epi>
__device__ __forceinline__ void blk_mma2(const LAS bf16_t* A1, const LAS bf16_t* B1, const LAS bf16_t* A2, const LAS bf16_t* B2, int ld, int wid, int lane, Epi epi) {
    const int fr = lane & 15, fq = lane >> 4;
    for (int tt = wid; tt < MT * NT; tt += 8) {
        const int tm = tt / NT, tn = tt % NT;
        f32x4 acc1 = {0.f, 0.f, 0.f, 0.f}, acc2 = {0.f, 0.f, 0.f, 0.f};
#pragma unroll
        for (int ks = 0; ks < KS; ++ks) {
            const bf16x8 a1 = *(const LAS bf16x8*)(A1 + (tm * 16 + fr) * ld + ks * 32 + fq * 8);
            const bf16x8 b1 = *(const LAS bf16x8*)(B1 + (tn * 16 + fr) * ld + ks * 32 + fq * 8);
            acc1 = __builtin_amdgcn_mfma_f32_16x16x32_bf16(a1, b1, acc1, 0, 0, 0);
            const bf16x8 a2 = *(const LAS bf16x8*)(A2 + (tm * 16 + fr) * ld + ks * 32 + fq * 8);
            const bf16x8 b2 = *(const LAS bf16x8*)(B2 + (tn * 16 + fr) * ld + ks * 32 + fq * 8);
            acc2 = __builtin_amdgcn_mfma_f32_16x16x32_bf16(a2, b2, acc2, 0, 0, 0);
        }
        epi(tm * 16 + fq * 4, tn * 16 + fr, acc1, acc2);
    }
}

__device__ __forceinline__ void transpose_item(const float* W, int K, int N, int nblk, bf16_t* WT, LAS float* scr, int item, int lane) {
    const int kb = item / nblk, nb = item % nblk, k0 = 64 * kb, n0 = 32 * nb;
    const int nn = n0 + (lane & 31);
#pragma unroll 8
    for (int i = 0; i < 32; ++i) { const int kk = 2 * i + (lane >> 5); scr[kk * 33 + (lane & 31)] = (nn < N) ? W[(size_t)(k0 + kk) * N + nn] : 0.f; }
    asm volatile("s_waitcnt lgkmcnt(0)" ::: "memory");
    const int c = lane & 7;
#pragma unroll
    for (int j = 0; j < 4; ++j) { const int n = (lane >> 3) + 8 * j; const LAS float* s = scr + (8 * c) * 33 + n;
        u32x4 o; o.x = pk2(s[0 * 33], s[1 * 33]); o.y = pk2(s[2 * 33], s[3 * 33]); o.z = pk2(s[4 * 33], s[5 * 33]); o.w = pk2(s[6 * 33], s[7 * 33]);
        *(u32x4*)(WT + (size_t)(n0 + n) * K + k0 + 8 * c) = o; }
    asm volatile("s_waitcnt lgkmcnt(0)" ::: "memory");
}
__device__ __forceinline__ float wave_maxf(float v) {
#pragma unroll
    for (int o = 1; o < 64; o <<= 1) v = fmaxf(v, __shfl_xor(v, o));
    return v;
}
__device__ __forceinline__ void convert_tables(const Ctx& C, int layer) {
    const float* U = C.in[39] + (size_t)layer * NEXP * DM; const float* V = C.in[40] + (size_t)layer * NEXP * DM;
    unsigned char* UB = C.ws + WS_UB; unsigned char* VB = C.ws + WS_VB; float* SU = (float*)(C.ws + WS_SU); float* SV = (float*)(C.ws + WS_SV);
    for (int r = C.bid * 8 + C.wid; r < 2 * NEXP; r += C.G * 8) {
        const bool isv = r >= NEXP; const int row = isv ? r - NEXP : r;
        const float* src = (isv ? V : U) + (size_t)row * DM + 16 * C.lane;
        f32x4 x[4]; float m = 0.f;
#pragma unroll
        for (int k = 0; k < 4; ++k) { x[k] = *(const f32x4*)(src + 4 * k); m = fmaxf(fmaxf(m, fmaxf(fabsf(x[k].x), fabsf(x[k].y))), fmaxf(fabsf(x[k].z), fabsf(x[k].w))); }
        m = wave_maxf(m);
        const float sc = m > 0.f ? 224.f / m : 1.f;
        u32x4 o;
#pragma unroll
        for (int k = 0; k < 4; ++k) { int w = __builtin_amdgcn_cvt_pk_fp8_f32(x[k].x * sc, x[k].y * sc, 0, false); w = __builtin_amdgcn_cvt_pk_fp8_f32(x[k].z * sc, x[k].w * sc, w, true); o[k] = (unsigned)w; }
        *(u32x4*)((isv ? VB : UB) + (size_t)row * DM + 16 * C.lane) = o;
        if (C.lane == 0) (isv ? SV : SU)[row] = m > 0.f ? m * (1.f / 224.f) : 1.f;
    }
}
__device__ __forceinline__ void ph_prologue(const Ctx& C) {
    const int gw = C.bid * 8 + C.wid, NGW = C.G * 8;
    {
        LAS float* scr = (LAS float*)(C.lds + C.wid * 16384);
        bf16_t* WIN = (bf16_t*)(C.ws + WS_WIN); bf16_t* WOUT = (bf16_t*)(C.ws + WS_WOUT); bf16_t* WQ = (bf16_t*)(C.ws + WS_WQ);
        for (int it = gw; it < 6400; it += NGW) {
            const int layer = it / 3200; int r = it % 3200;
            if (r < 1664) { transpose_item(C.in[8] + (size_t)layer * DM * INC, DM, INC, 104, WIN + (size_t)layer * NP * DM, scr, r, C.lane); continue; } r -= 1664;
            if (r < 512) { transpose_item(C.in[9] + (size_t)layer * DM * DM, DM, DM, 32, WOUT + (size_t)layer * DM * DM, scr, r, C.lane); continue; } r -= 512;
            transpose_item(C.in[36] + (size_t)layer * DM * 2048, DM, 2048, 64, WQ + (size_t)layer * 2048 * DM, scr, r, C.lane);
        }
    }
    __syncthreads();
    {
        LAS float* sv = (LAS float*)C.lds;
        LAS float* red = (LAS float*)(C.lds + 12288);
        for (int i = C.tid; i < 3 * 1024; i += 512) { const int w = i >> 10, k = i & 1023; const float x = (w < 2) ? C.in[1][w * 1024 + k] : C.in[3][k]; sv[i] = silu(x); }
        __syncthreads();
        float* MOD = (float*)(C.ws + WS_MOD);
        for (int it = C.bid; it < 192; it += C.G) {
            const int layer = it / 96, col0 = (it % 96) * 64, col = C.tid & 63, kg = C.tid >> 6;
            const float* W = C.in[4] + (size_t)layer * DM * 6144 + col0 + col;
            float a0 = 0.f, a1 = 0.f, a2 = 0.f;
#pragma unroll 8
            for (int k = kg * 128; k < kg * 128 + 128; ++k) { const float w = W[(size_t)k * 6144]; a0 += sv[k] * w; a1 += sv[1024 + k] * w; a2 += sv[2048 + k] * w; }
            red[(kg * 3 + 0) * 64 + col] = a0; red[(kg * 3 + 1) * 64 + col] = a1; red[(kg * 3 + 2) * 64 + col] = a2;
            __syncthreads();
            if (C.tid < 192) { const int w = C.tid >> 6, c2 = C.tid & 63; float s = 0.f;
#pragma unroll
                for (int g = 0; g < 8; ++g) s += red[(g * 3 + w) * 64 + c2];
                MOD[((size_t)layer * 3 + w) * 6144 + col0 + c2] = s + C.in[5][layer * 6144 + col0 + c2]; }
            __syncthreads();
        }
    }
    {
        float* H = (float*)(C.ws + WS_H);
        const size_t n4 = (size_t)NROW * 256;
        for (size_t i = (size_t)C.bid * 512 + C.tid; i < n4; i += (size_t)C.G * 512) {
            const int row = (int)(i >> 8), c4 = (int)(i & 255) * 4;
            f32x4 v;
            if (row < NLAT) {
                v = *(const f32x4*)(C.in[0] + (size_t)row * DM + c4);
                const int t = row & 8191, quarter = c4 >> 8; const float pos = (quarter < 2) ? (float)(t >> 6) : (float)(t & 63);
                float e[4];
#pragma unroll
                for (int j = 0; j < 4; ++j) { const int jj = (c4 & 255) + j; const float fr = exp2f(-(float)jj * (13.287712379549449f / 256.f)); const float a = pos * fr; e[j] = (quarter & 1) ? cosf(a) : sinf(a); }
                v.x += e[0]; v.y += e[1]; v.z += e[2]; v.w += e[3];
            } else v = *(const f32x4*)(C.in[2] + (size_t)(row - NLAT) * DM + c4);
            *(f32x4*)(H + (size_t)row * DM + c4) = v;
        }
    }
    convert_tables(C, 0);
}

struct Row16 { float v[16]; };
__device__ __forceinline__ Row16 load_row16(const float* p, int lane) {
    Row16 r; const f32x4 a = *(const f32x4*)(p + 8 * lane), b = *(const f32x4*)(p + 8 * lane + 4), c = *(const f32x4*)(p + 512 + 8 * lane), d = *(const f32x4*)(p + 512 + 8 * lane + 4);
    r.v[0] = a.x; r.v[1] = a.y; r.v[2] = a.z; r.v[3] = a.w; r.v[4] = b.x; r.v[5] = b.y; r.v[6] = b.z; r.v[7] = b.w;
    r.v[8] = c.x; r.v[9] = c.y; r.v[10] = c.z; r.v[11] = c.w; r.v[12] = d.x; r.v[13] = d.y; r.v[14] = d.z; r.v[15] = d.w; return r;
}
__device__ __forceinline__ void store_row16_f32(float* p, int lane, const Row16& r) {
    *(f32x4*)(p + 8 * lane) = (f32x4){r.v[0], r.v[1], r.v[2], r.v[3]}; *(f32x4*)(p + 8 * lane + 4) = (f32x4){r.v[4], r.v[5], r.v[6], r.v[7]};
    *(f32x4*)(p + 512 + 8 * lane) = (f32x4){r.v[8], r.v[9], r.v[10], r.v[11]}; *(f32x4*)(p + 512 + 8 * lane + 4) = (f32x4){r.v[12], r.v[13], r.v[14], r.v[15]};
}
__device__ __forceinline__ void store_row16_bf16(bf16_t* p, int lane, const Row16& r) {
    u32x4 a, b; a.x = pk2(r.v[0], r.v[1]); a.y = pk2(r.v[2], r.v[3]); a.z = pk2(r.v[4], r.v[5]); a.w = pk2(r.v[6], r.v[7]);
    b.x = pk2(r.v[8], r.v[9]); b.y = pk2(r.v[10], r.v[11]); b.z = pk2(r.v[12], r.v[13]); b.w = pk2(r.v[14], r.v[15]);
    *(u32x4*)(p + 8 * lane) = a; *(u32x4*)(p + 512 + 8 * lane) = b;
}
__device__ __forceinline__ Row16 norm_mod_row(const Row16& x, const float* g, const float* shift, const float* scale, int lane) {
    float ss = 0.f;
#pragma unroll
    for (int i = 0; i < 16; ++i) ss += x.v[i] * x.v[i];
    const float rs = rsqrtf(wave_sum(ss) * (1.f / 1024.f) + 1e-6f);
    const Row16 gg = load_row16(g, lane), sh = load_row16(shift, lane), sc = load_row16(scale, lane);
    Row16 o;
#pragma unroll
    for (int i = 0; i < 16; ++i) o.v[i] = (x.v[i] * rs * gg.v[i]) * (1.f + sc.v[i]) + sh.v[i];
    return o;
}
__device__ __forceinline__ int which_of(int row) { return row < 8192 ? 0 : (row < NLAT ? 1 : 2); }
__device__ __forceinline__ void ph_norm(const Ctx& C, int layer, const float* gain, int sidx, int nrows) {
    const float* H = (const float*)(C.ws + WS_H); bf16_t* ACT = (bf16_t*)(C.ws + WS_ACT); const float* MOD = (const float*)(C.ws + WS_MOD);
    for (int row = C.bid * 8 + C.wid; row < nrows; row += C.G * 8) {
        const float* m = MOD + ((size_t)layer * 3 + which_of(row)) * 6144;
        const Row16 x = load_row16(H + (size_t)row * DM, C.lane);
        const Row16 o = norm_mod_row(x, gain, m + sidx * 1024, m + (sidx + 1) * 1024, C.lane);
        store_row16_bf16(ACT + (size_t)row * DM, C.lane, o);
    }
}
struct EpiResid {
    static constexpr bool PERM = false, AFTER_DRAIN = false;
    float* H; const float* modl;
    __device__ __forceinline__ void operator()(const f32x4 (&acc)[2][2][4][2], const pg8::Unit& u, int wr, int wc, int fr, int fq) const {
        const int row0 = u.pm * 256 + wr * 64 + fr, col0 = u.pn * 256 + wc * 32 + 4 * fq;
        const int which = u.pm < 32 ? 0 : (u.pm < 64 ? 1 : 2);
        const float* gate = modl + ((size_t)which * 6 + 2) * 1024;
        f32x4 gv[2][2];
#pragma unroll
        for (int bj = 0; bj < 2; ++bj)
#pragma unroll
            for (int n = 0; n < 2; ++n) gv[bj][n] = *(const f32x4*)(gate + col0 + bj * 128 + n * 16);
#pragma unroll
        for (int ai = 0; ai < 2; ++ai)
#pragma unroll
            for (int m = 0; m < 4; ++m) { float* rowp = H + (size_t)(row0 + ai * 128 + m * 16) * DM + col0;
#pragma unroll
                for (int bj = 0; bj < 2; ++bj)
#pragma unroll
                    for (int n = 0; n < 2; ++n) { f32x4* p = (f32x4*)(rowp + bj * 128 + n * 16); *p = *p + gv[bj][n] * acc[ai][bj][m][n]; } }
    }
};

__device__ __forceinline__ void item_conformer(const Ctx& C, int layer, int gc) {
    const ChunkInfo ci = chunk_info(gc);
    const bf16_t* P = (const bf16_t*)(C.ws + WS_P); bf16_t* YC = (bf16_t*)(C.ws + WS_ACT);
    LAS bf16_t* HG = (LAS bf16_t*)C.lds;
    LAS float* CO = (LAS float*)(C.lds + 49152);
    for (int e = C.tid; e < 94 * 128; e += 512) {
        const int rr = e >> 7, cp = e & 127, grow = ci.row0 - 15 + rr;
        unsigned o = 0u;
        if (grow >= ci.lo && grow < ci.hi) {
            const unsigned v = *(const unsigned*)(P + (size_t)grow * NP + 2 * cp), g = *(const unsigned*)(P + (size_t)grow * NP + 256 + 2 * cp);
            o = pk2(bflo(v) * sigm(bflo(g)), bfhi(v) * sigm(bfhi(g)));
        }
        *(LAS unsigned*)(HG + rr * 256 + 2 * cp) = o;
    }
    __syncthreads();
    {
        const int c = C.tid & 255, half = C.tid >> 8;
        const float* cw = C.in[10] + (size_t)layer * 31 * 256 + c;
        float w[31];
#pragma unroll
        for (int j = 0; j < 31; ++j) w[j] = cw[j * 256];
        const float bias = C.in[11][layer * 256 + c];
        for (int tt = 0; tt < 32; ++tt) {
            const int t = half * 32 + tt; float acc = bias;
#pragma unroll
            for (int j = 0; j < 31; ++j) acc += w[j] * bf2f(HG[(t + j) * 256 + c]);
            CO[t * 256 + c] = acc;
        }
    }
    __syncthreads();
    {
        const float* lg = C.in[12] + layer * 256 + 4 * C.lane; const float* lb = C.in[13] + layer * 256 + 4 * C.lane;
        const f32x4 g4 = *(const f32x4*)lg, b4 = *(const f32x4*)lb;
        for (int i = 0; i < 8; ++i) {
            const int t = C.wid * 8 + i;
            const f32x4 x = *(const LAS f32x4*)(CO + t * 256 + 4 * C.lane);
            const float mean = wave_sum((x.x + x.y) + (x.z + x.w)) * (1.f / 256.f);
            const f32x4 d = x - mean;
            const float var = wave_sum((d.x * d.x + d.y * d.y) + (d.z * d.z + d.w * d.w)) * (1.f / 256.f);
            const float rs = rsqrtf(var + 1e-5f);
            const f32x4 y = d * rs * g4 + b4;
            u32x2 o; o.x = pk2(silu(y.x), silu(y.y)); o.y = pk2(silu(y.z), silu(y.w));
            *(u32x2*)(YC + (size_t)(ci.row0 + t) * DM + 4 * C.lane) = o;
        }
    }
    __syncthreads();
}

__device__ __forceinline__ void item_chunkmlp(const Ctx& C, int layer, int gb) {
    const int row0 = gb * 128;
    const bf16_t* P = (const bf16_t*)(C.ws + WS_P); bf16_t* YC = (bf16_t*)(C.ws + WS_ACT);
    LAS bf16_t* VNT = (LAS bf16_t*)C.lds;
    LAS bf16_t* WS = (LAS bf16_t*)(C.lds + 69632);
    {
        const f32x4 g4 = *(const f32x4*)(C.in[14] + layer * 256 + 4 * C.lane), b4 = *(const f32x4*)(C.in[15] + layer * 256 + 4 * C.lane);
        for (int i = 0; i < 16; ++i) {
            const int j = C.wid * 16 + i;
            const u32x2 raw = *(const u32x2*)(P + (size_t)(row0 + j) * NP + 768 + 4 * C.lane);
            const f32x4 x = {bflo(raw.x), bfhi(raw.x), bflo(raw.y), bfhi(raw.y)};
            const float mean = wave_sum((x.x + x.y) + (x.z + x.w)) * (1.f / 256.f);
            const f32x4 d = x - mean;
            const float var = wave_sum((d.x * d.x + d.y * d.y) + (d.z * d.z + d.w * d.w)) * (1.f / 256.f);
            const f32x4 y = d * rsqrtf(var + 1e-5f) * g4 + b4;
            VNT[(4 * C.lane + 0) * 136 + j] = f2bf(y.x); VNT[(4 * C.lane + 1) * 136 + j] = f2bf(y.y);
            VNT[(4 * C.lane + 2) * 136 + j] = f2bf(y.z); VNT[(4 * C.lane + 3) * 136 + j] = f2bf(y.w);
        }
    }
    for (int h = 0; h < 4; ++h) {
        const float* ws = C.in[16] + ((size_t)layer * 4 + h) * 128 * 128;
        for (int e = C.tid; e < 4096; e += 512) { const int i = e >> 5, j4 = (e & 31) * 4; const f32x4 w = *(const f32x4*)(ws + i * 128 + j4);
            u32x2 o; o.x = pk2(w.x, w.y); o.y = pk2(w.z, w.w); *(LAS u32x2*)(WS + i * 136 + j4) = o; }
        __syncthreads();
        const float* bs = C.in[17] + ((size_t)layer * 4 + h) * 128;
        blk_mma<8, 4, 4>(WS, 136, VNT + h * 64 * 136, 136, C.wid, C.lane, [=](int r0, int col, const f32x4& acc) {
#pragma unroll
            for (int jj = 0; jj < 4; ++jj) { const int i = r0 + jj; const size_t row = (size_t)(row0 + i);
                const float u = bf2f(P[row * NP + 512 + h * 64 + col]);
                YC[row * DM + 256 + h * 64 + col] = f2bf((acc[jj] + bs[i]) * u); }
        });
        __syncthreads();
    }
}

__device__ __forceinline__ void item_mamba_local(const Ctx& C, int layer, int gc) {
    const ChunkInfo ci = chunk_info(gc);
    const bf16_t* P = (const bf16_t*)(C.ws + WS_P);
    float* MST = (float*)(C.ws + WS_MST); float* MCD = (float*)(C.ws + WS_MCD);
    LAS float* DA = (LAS float*)C.lds;
    LAS float* DT = (LAS float*)(C.lds + 2048);
    LAS float* FAC = (LAS float*)(C.lds + 4096);
    LAS bf16_t* XDT = (LAS bf16_t*)(C.lds + 8192);
    LAS bf16_t* BTT = (LAS bf16_t*)(C.lds + 8192 + 73728);
    {
        const int s = C.lane, dh = C.wid, d = dh >> 2, h = dh & 3;
        const float raw = bf2f(P[(size_t)(ci.row0 + s) * NP + OFF_C + 1024 + dh]);
        const float dt = softplus(raw + C.in[20][layer * 8 + dh]);
        const float da = dt * (-expf(C.in[21][layer * 8 + dh]));
        const float incl = wave_incl_scan(da, s), total = __shfl(incl, 63);
        DT[dh * 64 + s] = dt; DA[dh * 64 + s] = da;
        FAC[dh * 64 + s] = d ? expf(incl - da) : expf(total - incl);
        if (s == 0) MCD[slot_of(ci.b, h, d, cpos_of(ci, d))] = expf(total);
    }
    __syncthreads();
    {
        const int cp = C.tid & 255, half = C.tid >> 8, c0 = 2 * cp;
        const float* cw = C.in[18] + (size_t)layer * 5 * 768 + c0; const float* cb = C.in[19] + layer * 768 + c0;
        float w0[5], w1[5];
#pragma unroll
        for (int j = 0; j < 5; ++j) { w0[j] = cw[j * 768]; w1[j] = cw[j * 768 + 1]; }
        const float b0 = cb[0], b1 = cb[1];
        const int s0 = half * 32;
        unsigned win[5];
#pragma unroll
        for (int j = 0; j < 4; ++j) { const int row = ci.row0 + s0 - 2 + j; win[j + 1] = (row >= ci.lo && row < ci.hi) ? *(const unsigned*)(P + (size_t)row * NP + OFF_C + 256 + c0) : 0u; }
        for (int tt = 0; tt < 32; ++tt) {
            const int s = s0 + tt;
#pragma unroll
            for (int j = 0; j < 4; ++j) win[j] = win[j + 1];
            { const int row = ci.row0 + s + 2; win[4] = (row >= ci.lo && row < ci.hi) ? *(const unsigned*)(P + (size_t)row * NP + OFF_C + 256 + c0) : 0u; }
            float a0 = b0, a1 = b1;
#pragma unroll
            for (int j = 0; j < 5; ++j) { a0 += w0[j] * bflo(win[j]); a1 += w1[j] * bfhi(win[j]); }
            a0 = silu(a0); a1 = silu(a1);
            if (c0 < 256) { const int h = c0 >> 6;
#pragma unroll
                for (int d = 0; d < 2; ++d) { const float f = DT[(d * 4 + h) * 64 + s] * FAC[(d * 4 + h) * 64 + s];
                    XDT[(d * 256 + c0) * 72 + s] = f2bf(a0 * f); XDT[(d * 256 + c0 + 1) * 72 + s] = f2bf(a1 * f); }
            } else { const int q = c0 - 256; BTT[q * 72 + s] = f2bf(a0); BTT[(q + 1) * 72 + s] = f2bf(a1); }
        }
    }
    __syncthreads();
    for (int hd = 0; hd < 8; ++hd) {
        const int d = hd >> 2, h = hd & 3;
        float* dst = MST + (size_t)slot_of(ci.b, h, d, cpos_of(ci, d)) * 8192;
        blk_mma<4, 8, 2>(XDT + (d * 256 + h * 64) * 72, 72, BTT + (h >> 1) * 128 * 72, 72, C.wid, C.lane, [=](int r0, int col, const f32x4& acc) {
#pragma unroll
            for (int jj = 0; jj < 4; ++jj) dst[(r0 + jj) * 128 + col] = acc[jj];
        });
    }
    __syncthreads();
}


#ifndef MK_DIAG2
#define MK_DIAG2 0
#endif
#if MK_DIAG2
#define DBGF(stage, cond) do { if (cond) atomicOr((unsigned*)(C.ws + 32768) + (stage), 1u); } while (0)
#define DBGL(stage, cond) do { if (cond) atomicOr(dbgflags + (stage), 1u); } while (0)
#else
#define DBGF(stage, cond) do {} while (0)
#define DBGL(stage, cond) do {} while (0)
#endif
__device__ __forceinline__ bool badv(float x, float lim) { return !(fabsf(x) < lim); }
__device__ __forceinline__ void tri_inverse(const LAS float* ABf, LAS float* Tf, LAS float* Rt, LAS bf16_t* TT, int tid, int wid, int lane) {
    if (wid == 0) {
        const int bi = lane >> 4, j = lane & 15; const LAS float* Ab = ABf + (16 * bi) * 68 + 16 * bi;
        float col[16];
#pragma unroll
        for (int r = 0; r < 16; ++r) { float acc = (r == j) ? 1.f : 0.f;
#pragma unroll
            for (int s = 0; s < r; ++s) acc -= Ab[r * 68 + s] * col[s];
            col[r] = acc; }
#pragma unroll
        for (int r = 0; r < 16; ++r) Tf[(16 * bi + r) * 68 + 16 * bi + j] = col[r];
    } else {
        for (int e = tid - 64; e < 64 * 64; e += 448) { const int t = e >> 6, s2 = e & 63; if ((s2 >> 4) > (t >> 4)) Tf[t * 68 + s2] = 0.f; }
    }
    __syncthreads();
#pragma unroll
    for (int i = 1; i < 4; ++i) {
        const int nc = 16 * i;
        for (int e = tid; e < 16 * nc; e += 512) { const int r = e / nc, c = e % nc; float s0 = 0.f, s1 = 0.f;
#pragma unroll
            for (int s2 = 0; s2 < nc; s2 += 2) { s0 += ABf[(nc + r) * 68 + s2] * Tf[s2 * 68 + c]; s1 += ABf[(nc + r) * 68 + s2 + 1] * Tf[(s2 + 1) * 68 + c]; }
            Rt[r * 68 + c] = -(s0 + s1); }
        __syncthreads();
        for (int e = tid; e < 16 * nc; e += 512) { const int r = e / nc, c = e % nc; float s0 = 0.f, s1 = 0.f;
#pragma unroll
            for (int r2 = 0; r2 < 16; r2 += 2) { s0 += Tf[(nc + r) * 68 + nc + r2] * Rt[r2 * 68 + c]; s1 += Tf[(nc + r) * 68 + nc + r2 + 1] * Rt[(r2 + 1) * 68 + c]; }
            Tf[(nc + r) * 68 + c] = s0 + s1; }
        __syncthreads();
    }
    for (int e = tid; e < 4096; e += 512) { const int t = e >> 6, s2 = e & 63; TT[t * 72 + s2] = f2bf(Tf[t * 68 + s2]); }
}
constexpr int D1_LW = 0, D1_CS = 17408, D1_AA = 34816, D1_RB = 52224, D1_KB = 61440, D1_VB = 70656, D1_TW = 79872, D1_AD = 89088, D1_W2T = 98304, D1_A2T = 107520;
constexpr int D1_Y = 82944;
constexpr int D1_ABF = 0, D1_AK = 17408, D1_ARK = 26624, D1_ARB = 35840, D1_TT = 45056, D1_W1T = 54272, D1_AKVT = 63488, D1_W2TT = 72704;
constexpr int D1_GL = 156672;
__device__ __forceinline__ void item_rwkv_local(const Ctx& C, int layer, int it) {
    const int gc = it >> 3, hd = it & 7, h = hd & 3, d = hd >> 2;
    const ChunkInfo ci = chunk_info(gc);
    const int slot = slot_of(ci.b, h, d, cpos_of(ci, d));
    const bf16_t* P = (const bf16_t*)(C.ws + WS_P);
    const float* mup = C.in[24] + layer * 1152; const float* mun = C.in[25] + layer * 1152;
    lds_t L = C.lds;
    LAS float* LW = (LAS float*)(L + D1_LW); LAS float* CS = (LAS float*)(L + D1_CS); LAS float* AA = (LAS float*)(L + D1_AA); LAS float* GL = (LAS float*)(L + D1_GL);
    LAS bf16_t* Rb = (LAS bf16_t*)(L + D1_RB); LAS bf16_t* Kb = (LAS bf16_t*)(L + D1_KB); LAS bf16_t* Vb = (LAS bf16_t*)(L + D1_VB);
    LAS bf16_t* TW = (LAS bf16_t*)(L + D1_TW); LAS bf16_t* AD = (LAS bf16_t*)(L + D1_AD); LAS bf16_t* W2T = (LAS bf16_t*)(L + D1_W2T); LAS bf16_t* A2T = (LAS bf16_t*)(L + D1_A2T);
    LAS bf16_t* KT = (LAS bf16_t*)(L + D1_Y); LAS bf16_t* KTt = KT + 4608; LAS bf16_t* KD = KT + 2 * 4608; LAS bf16_t* KDt = KT + 3 * 4608;
    LAS bf16_t* BT = KT + 4 * 4608; LAS bf16_t* BTt = KT + 5 * 4608; LAS bf16_t* RT = KT + 6 * 4608; LAS bf16_t* Vt = KT + 7 * 4608;
    LAS float* ABf = (LAS float*)(L + D1_ABF); LAS bf16_t* AK = (LAS bf16_t*)(L + D1_AK); LAS bf16_t* ARK = (LAS bf16_t*)(L + D1_ARK); LAS bf16_t* ARB = (LAS bf16_t*)(L + D1_ARB);
    LAS bf16_t* TT = (LAS bf16_t*)(L + D1_TT); LAS bf16_t* W1t = (LAS bf16_t*)(L + D1_W1T); LAS bf16_t* AKVt = (LAS bf16_t*)(L + D1_AKVT); LAS bf16_t* W2t = (LAS bf16_t*)(L + D1_W2TT);

    if (C.tid < 480) {
        const int q = C.tid % 160, seg = C.tid / 160, grp = q >> 5, c = (q & 31) * 2;
        const int j = (grp == 0 ? h * 64 : grp == 1 ? 256 + h * 64 : grp == 2 ? 512 + h * 64 : grp == 3 ? 768 + d * 64 : 896 + d * 64) + c;
        const int t0 = seg * 22, nt = seg == 2 ? 20 : 22;
        const bf16_t* pp = P + (size_t)(ci.row0 + t0) * NP + OFF_D + j;
        const float mp0 = mup[j], mp1 = mup[j + 1], mn0 = mun[j], mn1 = mun[j + 1];
        unsigned w[24];
#pragma unroll
        for (int i = 0; i < 24; ++i) { const int row = ci.row0 + t0 - 1 + i; w[i] = (i < nt + 2 && row >= ci.lo && row < ci.hi) ? *(const unsigned*)(pp + (ptrdiff_t)(i - 1) * NP) : 0u; }
        LAS bf16_t* dst = (grp == 0 ? Rb : grp == 1 ? Kb : grp == 2 ? Vb : grp == 3 ? TW : AD);
#pragma unroll
        for (int i = 0; i < 22; ++i) if (i < nt) {
            const float x0 = bflo(w[i + 1]), x1 = bfhi(w[i + 1]);
            const float v0 = x0 + mp0 * (bflo(w[i]) - x0) + mn0 * (bflo(w[i + 2]) - x0);
            const float v1 = x1 + mp1 * (bfhi(w[i]) - x1) + mn1 * (bfhi(w[i + 2]) - x1);
            DBGF(1, badv(v0, 1e4f) || badv(v1, 1e4f));
            const unsigned o = (grp == 3) ? pk2(tanhf(v0), tanhf(v1)) : pk2(v0, v1);
            const int tl = t0 + i, l = d ? 63 - tl : tl;
            *(LAS unsigned*)(dst + l * 72 + c) = o;
        }
    }
    {
        const float* w2 = C.in[27] + ((size_t)layer * 2 + d) * 64 * 256 + h * 64; const float* a2 = C.in[29] + ((size_t)layer * 2 + d) * 64 * 256 + h * 64;
        for (int e = C.tid; e < 4096; e += 512) { const int r = e >> 6, c = e & 63; W2T[c * 72 + r] = f2bf(w2[r * 256 + c]); A2T[c * 72 + r] = f2bf(a2[r * 256 + c]); }
    }
    __syncthreads();
    {
        unsigned* dbgflags = (unsigned*)(C.ws + 32768); (void)dbgflags;
        const float* w0 = C.in[26] + ((size_t)layer * 2 + d) * 256 + h * 64; const float* a0 = C.in[28] + ((size_t)layer * 2 + d) * 256 + h * 64;
        blk_mma<4, 4, 2>(TW, 72, W2T, 72, C.wid, C.lane, [=](int r0, int col, const f32x4& acc) {
#pragma unroll
            for (int jj = 0; jj < 4; ++jj) { const float w = w0[col] + acc[jj]; DBGL(2, badv(w, 1e4f)); LW[(r0 + jj) * 68 + col] = -expf(-softplus(-w) - 0.5f); }
        });
        blk_mma<4, 4, 2>(AD, 72, A2T, 72, C.wid, C.lane, [=](int r0, int col, const f32x4& acc) {
#pragma unroll
            for (int jj = 0; jj < 4; ++jj) { DBGL(2, badv(acc[jj], 1e4f)); AA[(r0 + jj) * 68 + col] = sigm(a0[col] + acc[jj]); }
        });
    }
    __syncthreads();
    {
#pragma unroll
        for (int i = 0; i < 8; ++i) { const int c = C.wid * 8 + i; const float incl = wave_incl_scan(LW[C.lane * 68 + c], C.lane); CS[C.lane * 68 + c] = incl; if (C.lane == 63) GL[c] = expf(incl); }
    }
    __syncthreads();
    {
        const int l = C.tid >> 3, sub = C.tid & 7;
        const float* kkw = C.in[31] + layer * 256 + h * 64; const float* kaw = C.in[32] + layer * 256 + h * 64; const float* rkw = C.in[33] + layer * 256 + h * 64;
        float kk[8], kdv[8], aa[8], rr[8], vv[8]; float ss = 0.f, bon = 0.f;
#pragma unroll
        for (int i = 0; i < 8; ++i) { const int c = sub * 8 + i; const float k = bf2f(Kb[l * 72 + c]); rr[i] = bf2f(Rb[l * 72 + c]); vv[i] = bf2f(Vb[l * 72 + c]); aa[i] = AA[l * 68 + c];
            kk[i] = k * kkw[c]; ss += kk[i] * kk[i]; kdv[i] = k * (1.f + (aa[i] - 1.f) * kaw[c]); bon += rr[i] * kdv[i] * rkw[c]; }
        ss += __shfl_xor(ss, 1); ss += __shfl_xor(ss, 2); ss += __shfl_xor(ss, 4);
        bon += __shfl_xor(bon, 1); bon += __shfl_xor(bon, 2); bon += __shfl_xor(bon, 4);
        const float inv = rsqrtf(ss + 1e-12f);
        if (sub == 0) ((float*)(C.ws + WS_BON))[(size_t)(ci.row0 + (d ? 63 - l : l)) * 8 + h * 2 + d] = bon;
#pragma unroll
        for (int i = 0; i < 8; ++i) { const int c = sub * 8 + i; const float cs = CS[l * 68 + c], lw = LW[l * 68 + c];
            const float ge = expf(cs - lw), gi = expf(cs), gn = expf(-cs); const float kkn = kk[i] * inv;
            DBGF(3, badv(cs, 50.f) || cs > 0.f || badv(lw, 1.f)); DBGF(4, badv(kkn * ge, 10.f) || badv(rr[i] * gi, 1e4f) || badv(vv[i], 1e4f)); DBGF(5, badv(kdv[i] * gn, 1e25f) || badv(kkn * aa[i] * gn, 1e25f));
            const unsigned short kt = f2bf(kkn * ge), kd = f2bf(kdv[i] * gn), bt = f2bf(kkn * aa[i] * gn), rt = f2bf(rr[i] * gi);
            KT[l * 72 + c] = kt; KTt[c * 72 + l] = kt; KD[l * 72 + c] = kd; KDt[c * 72 + l] = kd; BT[l * 72 + c] = bt; BTt[c * 72 + l] = bt; RT[l * 72 + c] = rt; Vt[c * 72 + l] = f2bf(vv[i]); }
    }
    __syncthreads();
    unsigned* dbgflags = (unsigned*)(C.ws + 32768); (void)dbgflags;
    blk_mma2<4, 4, 2>(KT, BT, KT, KD, 72, C.wid, C.lane, [=](int r0, int col, const f32x4& ab, const f32x4& ak) {
        unsigned short o[4];
#pragma unroll
        for (int jj = 0; jj < 4; ++jj) { const bool lo = col < r0 + jj; DBGL(6, lo && (badv(ab[jj], 1e3f) || badv(ak[jj], 1e4f))); ABf[(r0 + jj) * 68 + col] = lo ? ab[jj] : 0.f; o[jj] = f2bf(lo ? ak[jj] : 0.f); AK[(r0 + jj) * 72 + col] = o[jj]; }
    });
    blk_mma2<4, 4, 2>(RT, KD, RT, BT, 72, C.wid, C.lane, [=](int r0, int col, const f32x4& rk, const f32x4& rb) {
#pragma unroll
        for (int jj = 0; jj < 4; ++jj) { const bool le = col <= r0 + jj; DBGL(7, le && (badv(rk[jj], 1e5f) || badv(rb[jj], 1e5f))); ARK[(r0 + jj) * 72 + col] = f2bf(le ? rk[jj] : 0.f); ARB[(r0 + jj) * 72 + col] = f2bf(le ? rb[jj] : 0.f); }
    });
    __syncthreads();
    tri_inverse(ABf, (LAS float*)(L + 54272), (LAS float*)(L + 71680), TT, C.tid, C.wid, C.lane);
    __syncthreads();
#if MK_DIAG2
    for (int e = C.tid; e < 4096; e += 512) DBGF(8, badv(bf2f(TT[(e >> 6) * 72 + (e & 63)]), 1e3f));
#endif
    blk_mma2<4, 4, 2>(TT, KTt, AK, Vt, 72, C.wid, C.lane, [=](int r0, int col, const f32x4& w1, const f32x4& akv) {
        DBGL(9, badv(w1[0], 1e3f) || badv(w1[1], 1e3f) || badv(w1[2], 1e3f) || badv(w1[3], 1e3f)); DBGL(10, badv(akv[0], 1e5f) || badv(akv[1], 1e5f) || badv(akv[2], 1e5f) || badv(akv[3], 1e5f));
        u32x2 a, b; a.x = pk2(w1[0], w1[1]); a.y = pk2(w1[2], w1[3]); b.x = pk2(akv[0], akv[1]); b.y = pk2(akv[2], akv[3]);
        *(LAS u32x2*)(W1t + col * 72 + r0) = a; *(LAS u32x2*)(AKVt + col * 72 + r0) = b;
    });
    __syncthreads();
    blk_mma<4, 4, 2>(TT, 72, AKVt, 72, C.wid, C.lane, [=](int r0, int col, const f32x4& w2) {
        DBGL(11, badv(w2[0], 1e5f) || badv(w2[1], 1e5f) || badv(w2[2], 1e5f) || badv(w2[3], 1e5f));
        u32x2 a; a.x = pk2(w2[0], w2[1]); a.y = pk2(w2[2], w2[3]); *(LAS u32x2*)(W2t + col * 72 + r0) = a;
    });
    __syncthreads();
    {
        bf16_t* Gg = (bf16_t*)(C.ws + WS_RG) + (size_t)slot * 4096; float* Jg = (float*)(C.ws + WS_RJ) + (size_t)slot * 4096;
        bf16_t* Ryg = (bf16_t*)(C.ws + WS_RY) + (size_t)slot * 4096; bf16_t* Ylg = (bf16_t*)(C.ws + WS_RL) + (size_t)slot * 4096;
        blk_mma2<4, 4, 2>(W1t, BTt, W1t, ARB, 72, C.wid, C.lane, [=](int r0, int col, const f32x4& gp, const f32x4& rbw) {
            const float gl = GL[col]; float g[4], ry[4];
            const u32x2 rt = *(const LAS u32x2*)(RT + col * 72 + r0);
            const float rtv[4] = {bflo(rt.x), bfhi(rt.x), bflo(rt.y), bfhi(rt.y)};
#pragma unroll
            for (int jj = 0; jj < 4; ++jj) { g[jj] = gl * ((col == r0 + jj ? 1.f : 0.f) - gp[jj]); ry[jj] = rtv[jj] - rbw[jj]; }
            u32x2 og, oy; og.x = pk2(g[0], g[1]); og.y = pk2(g[2], g[3]); oy.x = pk2(ry[0], ry[1]); oy.y = pk2(ry[2], ry[3]);
            *(u32x2*)(Gg + col * 64 + r0) = og;
            *(u32x2*)(Ryg + col * 64 + r0) = oy;
        });
        blk_mma2<4, 4, 2>(KDt, Vt, BTt, W2t, 72, C.wid, C.lane, [=](int r0, int col, const f32x4& kv, const f32x4& bw) {
            f32x4 o;
#pragma unroll
            for (int jj = 0; jj < 4; ++jj) { o[jj] = GL[r0 + jj] * (kv[jj] - bw[jj]); DBGL(12, badv(GL[r0 + jj] * kv[jj], 1e5f)); DBGL(13, badv(GL[r0 + jj] * bw[jj], 1e5f)); DBGL(14, badv(o[jj], 1e5f)); }
            *(f32x4*)(Jg + col * 64 + r0) = o;
        });
        blk_mma2<4, 4, 2>(ARK, Vt, ARB, W2t, 72, C.wid, C.lane, [=](int r0, int col, const f32x4& a, const f32x4& b) {
            u32x2 o; o.x = pk2(a[0] - b[0], a[1] - b[1]); o.y = pk2(a[2] - b[2], a[3] - b[3]);
            *(u32x2*)(Ylg + col * 64 + r0) = o;
        });
    }
    __syncthreads();
}

typedef float f32x2p __attribute__((ext_vector_type(2)));
__device__ __forceinline__ void ph_scan(const Ctx& C) {
    if (C.bid < 16) {
        const int chain = C.bid, fr = C.lane & 15, fq = C.lane >> 4;
        LAS bf16_t* HT = (LAS bf16_t*)C.lds;
        const bf16_t* Gg = (const bf16_t*)(C.ws + WS_RG); const float* Jg = (const float*)(C.ws + WS_RJ); bf16_t* Hg = (bf16_t*)(C.ws + WS_RH);
        f32x4 acc[2] = {{0.f, 0.f, 0.f, 0.f}, {0.f, 0.f, 0.f, 0.f}};
        int buf = 0;
        const int tm = C.wid >> 1, tnb = (C.wid & 1) * 2;
        const bf16_t* gp = Gg + (size_t)chain * NCH * 4096 + (tm * 16 + fr) * 64 + fq * 8;
        const float* jp = Jg + (size_t)chain * NCH * 4096 + (tnb * 16 + fr) * 64 + tm * 16 + fq * 4;
        bf16x8 gn[2]; f32x4 jn[2];
        gn[0] = *(const bf16x8*)gp; gn[1] = *(const bf16x8*)(gp + 32); jn[0] = *(const f32x4*)jp; jn[1] = *(const f32x4*)(jp + 16 * 64);
        for (int cpos = 0; cpos < NCH; ++cpos) {
            const size_t slot = (size_t)chain * NCH + cpos;
            const bf16x8 g0 = gn[0], g1 = gn[1]; const f32x4 j0 = jn[0], j1 = jn[1];
            if (cpos + 1 < NCH) { const bf16_t* gq = gp + (size_t)(cpos + 1) * 4096; const float* jq = jp + (size_t)(cpos + 1) * 4096;
                gn[0] = *(const bf16x8*)gq; gn[1] = *(const bf16x8*)(gq + 32); jn[0] = *(const f32x4*)jq; jn[1] = *(const f32x4*)(jq + 16 * 64); }
#pragma unroll
            for (int i = 0; i < 2; ++i) { const int tn = tnb + i;
                u32x2 o; o.x = pk2(acc[i][0], acc[i][1]); o.y = pk2(acc[i][2], acc[i][3]);
                *(LAS u32x2*)(HT + buf * 4608 + (tn * 16 + fr) * 72 + tm * 16 + fq * 4) = o;
                *(u32x2*)(Hg + slot * 4096 + (tn * 16 + fr) * 64 + tm * 16 + fq * 4) = o; }
            __syncthreads();
#pragma unroll
            for (int i = 0; i < 2; ++i) { const int tn = tnb + i;
                f32x4 a = i ? j1 : j0;
                a = __builtin_amdgcn_mfma_f32_16x16x32_bf16(g0, *(const LAS bf16x8*)(HT + buf * 4608 + (tn * 16 + fr) * 72 + fq * 8), a, 0, 0, 0);
                a = __builtin_amdgcn_mfma_f32_16x16x32_bf16(g1, *(const LAS bf16x8*)(HT + buf * 4608 + (tn * 16 + fr) * 72 + 32 + fq * 8), a, 0, 0, 0);
                acc[i] = a; }
            buf ^= 1;
        }
    } else {
        float* MST = (float*)(C.ws + WS_MST); const float* MCD = (const float*)(C.ws + WS_MCD);
        const int nthr = (C.G - 16) * 512;
        for (int e = (C.bid - 16) * 512 + C.tid; e < 16 * 4096; e += nthr) {
            const int chain = e >> 12, el = (e & 4095) * 2; f32x2p run = {0.f, 0.f};
            float* p = MST + (size_t)chain * NCH * 8192 + el; const float* cd = MCD + chain * NCH;
#pragma unroll 12
            for (int cpos = 0; cpos < NCH; ++cpos) { const f32x2p tmp = *(const f32x2p*)(p + (size_t)cpos * 8192); *(f32x2p*)(p + (size_t)cpos * 8192) = run; run = run * cd[cpos] + tmp; }
        }
    }
}

__device__ __forceinline__ void item_mamba_out(const Ctx& C, int layer, int gc) {
    const ChunkInfo ci = chunk_info(gc);
    const bf16_t* P = (const bf16_t*)(C.ws + WS_P); bf16_t* YC = (bf16_t*)(C.ws + WS_ACT); const float* MST = (const float*)(C.ws + WS_MST);
    lds_t L = C.lds;
    LAS float* DT = (LAS float*)L;
    LAS float* DA = (LAS float*)(L + 2048);
    LAS float* CSI = (LAS float*)(L + 4096);
    LAS float* SSQ = (LAS float*)(L + 6144);
    LAS bf16_t* CG = (LAS bf16_t*)(L + 10240);
    LAS bf16_t* BG = (LAS bf16_t*)(L + 27648);
    LAS bf16_t* XT = (LAS bf16_t*)(L + 45056);
    LAS float* CBm = (LAS float*)(L + 63488);
    LAS bf16_t* MP = (LAS bf16_t*)(L + 80896);
    LAS bf16_t* S0 = (LAS bf16_t*)(L + 90112);
    LAS bf16_t* YPRE = (LAS bf16_t*)(L + 107520);
    const int fr = C.lane & 15, fq = C.lane >> 4;
    {
        const int s = C.lane, dh = C.wid;
        const float raw = bf2f(P[(size_t)(ci.row0 + s) * NP + OFF_C + 1024 + dh]);
        const float dt = softplus(raw + C.in[20][layer * 8 + dh]);
        const float da = dt * (-expf(C.in[21][layer * 8 + dh]));
        const float incl = wave_incl_scan(da, s), total = __shfl(incl, 63);
        DT[dh * 64 + s] = dt; DA[dh * 64 + s] = da;
        CSI[dh * 64 + s] = (dh < 4) ? incl : (total - incl + da);
    }
    for (int g = 0; g < 2; ++g) {
        __syncthreads();
        {
            const int cp = C.tid & 255, half = C.tid >> 8;
            if (cp < 192) {
                const int kind = cp >> 6, cl = (cp & 63) * 2, c0 = kind * 256 + g * 128 + cl;
                const float* cw = C.in[18] + (size_t)layer * 5 * 768 + c0; const float* cb = C.in[19] + layer * 768 + c0;
                float w0[5], w1[5];
#pragma unroll
                for (int j = 0; j < 5; ++j) { w0[j] = cw[j * 768]; w1[j] = cw[j * 768 + 1]; }
                const float b0 = cb[0], b1 = cb[1];
                const int s0 = half * 32;
                unsigned win[5];
#pragma unroll
                for (int j = 0; j < 4; ++j) { const int row = ci.row0 + s0 - 2 + j; win[j + 1] = (row >= ci.lo && row < ci.hi) ? *(const unsigned*)(P + (size_t)row * NP + OFF_C + 256 + c0) : 0u; }
                for (int tt = 0; tt < 32; ++tt) {
                    const int s = s0 + tt;
#pragma unroll
                    for (int j = 0; j < 4; ++j) win[j] = win[j + 1];
                    { const int row = ci.row0 + s + 2; win[4] = (row >= ci.lo && row < ci.hi) ? *(const unsigned*)(P + (size_t)row * NP + OFF_C + 256 + c0) : 0u; }
                    float a0 = b0, a1 = b1;
#pragma unroll
                    for (int j = 0; j < 5; ++j) { a0 += w0[j] * bflo(win[j]); a1 += w1[j] * bfhi(win[j]); }
                    const unsigned short o0 = f2bf(silu(a0)), o1 = f2bf(silu(a1));
                    if (kind == 0) { XT[cl * 72 + s] = o0; XT[(cl + 1) * 72 + s] = o1; }
                    else if (kind == 1) { *(LAS unsigned*)(BG + s * 136 + cl) = (unsigned)o0 | ((unsigned)o1 << 16); }
                    else { *(LAS unsigned*)(CG + s * 136 + cl) = (unsigned)o0 | ((unsigned)o1 << 16); }
                }
            }
        }
        __syncthreads();
        blk_mma<4, 4, 4>(CG, 136, BG, 136, C.wid, C.lane, [=](int r0, int col, const f32x4& acc) {
#pragma unroll
            for (int jj = 0; jj < 4; ++jj) CBm[(r0 + jj) * 68 + col] = acc[jj];
        });
        for (int hh = 0; hh < 2; ++hh) {
            const int h = 2 * g + hh;
            f32x4 yacc[2] = {{0.f, 0.f, 0.f, 0.f}, {0.f, 0.f, 0.f, 0.f}};
            for (int d = 0; d < 2; ++d) {
                const int dh = d * 4 + h;
                __syncthreads();
                for (int e = C.tid; e < 4096; e += 512) { const int l = e >> 6, s = e & 63; const bool ok = d ? (s >= l) : (s <= l);
                    MP[l * 72 + s] = ok ? f2bf(CBm[l * 68 + s] * expf(CSI[dh * 64 + l] - CSI[dh * 64 + s]) * DT[dh * 64 + s]) : (unsigned short)0; }
                { const float* src = MST + (size_t)slot_of(ci.b, h, d, cpos_of(ci, d)) * 8192;
                  for (int e = C.tid; e < 2048; e += 512) { const int p = e >> 5, n4 = (e & 31) * 4; const f32x4 v = *(const f32x4*)(src + p * 128 + n4);
                      u32x2 o; o.x = pk2(v.x, v.y); o.y = pk2(v.z, v.w); *(LAS u32x2*)(S0 + p * 136 + n4) = o; } }
                __syncthreads();
#pragma unroll
                for (int i = 0; i < 2; ++i) { const int tt = C.wid + 8 * i, tm = tt >> 2, tn = tt & 3;
                    f32x4 a1 = {0.f, 0.f, 0.f, 0.f}, a2 = {0.f, 0.f, 0.f, 0.f};
#pragma unroll
                    for (int ks = 0; ks < 2; ++ks) a1 = __builtin_amdgcn_mfma_f32_16x16x32_bf16(*(const LAS bf16x8*)(MP + (tm * 16 + fr) * 72 + ks * 32 + fq * 8),
                                                                                                 *(const LAS bf16x8*)(XT + (hh * 64 + tn * 16 + fr) * 72 + ks * 32 + fq * 8), a1, 0, 0, 0);
#pragma unroll
                    for (int ks = 0; ks < 4; ++ks) a2 = __builtin_amdgcn_mfma_f32_16x16x32_bf16(*(const LAS bf16x8*)(CG + (tm * 16 + fr) * 136 + ks * 32 + fq * 8),
                                                                                                 *(const LAS bf16x8*)(S0 + (tn * 16 + fr) * 136 + ks * 32 + fq * 8), a2, 0, 0, 0);
#pragma unroll
                    for (int j = 0; j < 4; ++j) yacc[i][j] += a1[j] + a2[j] * expf(CSI[dh * 64 + tm * 16 + fq * 4 + j]);
                }
            }
            const float dsk = C.in[22][layer * 4 + h];
#pragma unroll
            for (int i = 0; i < 2; ++i) { const int tt = C.wid + 8 * i, tm = tt >> 2, tn = tt & 3;
#pragma unroll
                for (int j = 0; j < 4; ++j) { const int l = tm * 16 + fq * 4 + j, p = tn * 16 + fr, c = h * 64 + p;
                    const float xs = bf2f(XT[(hh * 64 + p) * 72 + l]);
                    const float z = bf2f(P[(size_t)(ci.row0 + l) * NP + OFF_C + c]);
                    const float pre = (yacc[i][j] + dsk * xs) * silu(z);
                    YPRE[l * 264 + c] = f2bf(pre);
                    float q = pre * pre; q += __shfl_xor(q, 1); q += __shfl_xor(q, 2); q += __shfl_xor(q, 4); q += __shfl_xor(q, 8);
                    if (fr == 0) SSQ[l * 16 + h * 4 + tn] = q; }
            }
        }
    }
    __syncthreads();
    {
        const int l = C.tid >> 3, sub = C.tid & 7; float ss = 0.f;
#pragma unroll
        for (int i = 0; i < 16; ++i) ss += SSQ[l * 16 + i];
        const float rs = rsqrtf(ss * (1.f / 256.f) + 1e-6f);
        const float* ng = C.in[23] + layer * 256 + sub * 32;
        bf16_t* dst = YC + (size_t)(ci.row0 + l) * DM + 512 + sub * 32;
#pragma unroll
        for (int i = 0; i < 32; i += 2) { const float a = bf2f(YPRE[l * 264 + sub * 32 + i]) * rs * ng[i], b = bf2f(YPRE[l * 264 + sub * 32 + i + 1]) * rs * ng[i + 1]; *(unsigned*)(dst + i) = pk2(a, b); }
    }
    __syncthreads();
}

constexpr int D3_G2T = 0, D3_SG = 69632;
__device__ __forceinline__ void load_g2t(const Ctx& C, int layer) {
    LAS bf16_t* G2T = (LAS bf16_t*)(C.lds + D3_G2T); const float* g2 = C.in[30] + (size_t)layer * 128 * 256;
    for (int e = C.tid; e < 128 * 256; e += 512) { const int r = e >> 8, c = e & 255; G2T[c * 136 + r] = f2bf(g2[e]); }
}
__device__ __forceinline__ float lerp_d(const bf16_t* P, const ChunkInfo& ci, int row, int j, const float* mup, const float* mun) {
    const bf16_t* pp = P + (size_t)row * NP + OFF_D + j;
    const float x = bf2f(*pp), xp = (row - 1 >= ci.lo) ? bf2f(*(pp - NP)) : 0.f, xn = (row + 1 < ci.hi) ? bf2f(*(pp + NP)) : 0.f;
    return x + mup[j] * (xp - x) + mun[j] * (xn - x);
}
__device__ __forceinline__ void item_rwkv_out(const Ctx& C, int layer, int gc) {
    const ChunkInfo ci = chunk_info(gc);
    const bf16_t* P = (const bf16_t*)(C.ws + WS_P); bf16_t* YC = (bf16_t*)(C.ws + WS_ACT);
    const float* mup = C.in[24] + layer * 1152; const float* mun = C.in[25] + layer * 1152;
    LAS bf16_t* G2T = (LAS bf16_t*)(C.lds + D3_G2T); LAS bf16_t* SG = (LAS bf16_t*)(C.lds + D3_SG);
    const int fr = C.lane & 15, fq = C.lane >> 4;
    __syncthreads();
    for (int e = C.tid; e < 64 * 128; e += 512) { const int l = e >> 7, r = e & 127; SG[l * 136 + r] = f2bf(sigm(lerp_d(P, ci, ci.row0 + l, 1024 + r, mup, mun))); }
    __syncthreads();
    const int h = C.wid >> 1, tmb = (C.wid & 1) * 2;
    const bf16_t* Ryg = (const bf16_t*)(C.ws + WS_RY); const bf16_t* Ylg = (const bf16_t*)(C.ws + WS_RL); const bf16_t* Hg = (const bf16_t*)(C.ws + WS_RH);
    const float* BON = (const float*)(C.ws + WS_BON);
#pragma unroll
    for (int ti = 0; ti < 2; ++ti) {
        const int tm = tmb + ti;
        f32x4 gacc[4], yacc[4];
#pragma unroll
        for (int tn = 0; tn < 4; ++tn) { f32x4 a = {0.f, 0.f, 0.f, 0.f};
#pragma unroll
            for (int ks = 0; ks < 4; ++ks) a = __builtin_amdgcn_mfma_f32_16x16x32_bf16(*(const LAS bf16x8*)(SG + (tm * 16 + fr) * 136 + ks * 32 + fq * 8),
                                                                                        *(const LAS bf16x8*)(G2T + (h * 64 + tn * 16 + fr) * 136 + ks * 32 + fq * 8), a, 0, 0, 0);
            gacc[tn] = a; yacc[tn] = (f32x4){0.f, 0.f, 0.f, 0.f}; }
#pragma unroll
        for (int d = 0; d < 2; ++d) {
            const size_t slot = (size_t)slot_of(ci.b, h, d, cpos_of(ci, d));
            const int arow = d ? 63 - (tm * 16 + fr) : tm * 16 + fr;
            bf16x8 af[2];
#pragma unroll
            for (int ks = 0; ks < 2; ++ks) af[ks] = *(const bf16x8*)(Ryg + slot * 4096 + arow * 64 + ks * 32 + fq * 8);
#pragma unroll
            for (int tn = 0; tn < 4; ++tn) {
                f32x4 a;
                if (d == 0) { const u32x2 yl = *(const u32x2*)(Ylg + slot * 4096 + (tn * 16 + fr) * 64 + tm * 16 + fq * 4); a = (f32x4){bflo(yl.x), bfhi(yl.x), bflo(yl.y), bfhi(yl.y)}; }
                else { const u32x2 yl = *(const u32x2*)(Ylg + slot * 4096 + (tn * 16 + fr) * 64 + 60 - (tm * 16 + fq * 4)); a = (f32x4){bfhi(yl.y), bflo(yl.y), bfhi(yl.x), bflo(yl.x)}; }
#pragma unroll
                for (int ks = 0; ks < 2; ++ks) a = __builtin_amdgcn_mfma_f32_16x16x32_bf16(af[ks], *(const bf16x8*)(Hg + slot * 4096 + (tn * 16 + fr) * 64 + ks * 32 + fq * 8), a, 0, 0, 0);
                yacc[tn] += a;
            }
        }
#pragma unroll
        for (int j = 0; j < 4; ++j) {
            const int l = tm * 16 + fq * 4 + j, row = ci.row0 + l;
            float s = (yacc[0][j] + yacc[1][j]) + (yacc[2][j] + yacc[3][j]);
            s += __shfl_xor(s, 1); s += __shfl_xor(s, 2); s += __shfl_xor(s, 4); s += __shfl_xor(s, 8);
            const float mu = s * (1.f / 64.f);
            float q = 0.f;
#pragma unroll
            for (int tn = 0; tn < 4; ++tn) { const float dd = yacc[tn][j] - mu; q += dd * dd; }
            q += __shfl_xor(q, 1); q += __shfl_xor(q, 2); q += __shfl_xor(q, 4); q += __shfl_xor(q, 8);
            const float rs = rsqrtf(q * (1.f / 64.f) + 64e-5f);
            const float bon = BON[(size_t)row * 8 + h * 2] + BON[(size_t)row * 8 + h * 2 + 1];
#pragma unroll
            for (int tn = 0; tn < 4; ++tn) { const int c = h * 64 + tn * 16 + fr;
                const float yn = (yacc[tn][j] - mu) * rs * C.in[34][layer * 256 + c] + C.in[35][layer * 256 + c];
                const float vv = lerp_d(P, ci, row, 512 + c, mup, mun);
                YC[(size_t)row * DM + 768 + c] = f2bf((yn + bon * vv) * gacc[tn][j]); }
        }
    }
}

__device__ __forceinline__ unsigned ordf(float f) { const unsigned u = __float_as_uint(f); return u ^ ((u >> 31) ? 0xFFFFFFFFu : 0x80000000u); }
__device__ __forceinline__ unsigned wave_max_u32(unsigned v) {
    unsigned t;
    t = (unsigned)__builtin_amdgcn_update_dpp((int)v, (int)v, 0xB1, 0xF, 0xF, false); v = t > v ? t : v;
    t = (unsigned)__builtin_amdgcn_update_dpp((int)v, (int)v, 0x4E, 0xF, 0xF, false); v = t > v ? t : v;
    t = (unsigned)__builtin_amdgcn_update_dpp((int)v, (int)v, 0x141, 0xF, 0xF, false); v = t > v ? t : v;
    t = (unsigned)__builtin_amdgcn_update_dpp((int)v, (int)v, 0x140, 0xF, 0xF, false); v = t > v ? t : v;
    t = (unsigned)__builtin_amdgcn_update_dpp((int)v, (int)v, 0x142, 0xA, 0xF, false); v = t > v ? t : v;
    t = (unsigned)__builtin_amdgcn_update_dpp((int)v, (int)v, 0x143, 0xC, 0xF, false); v = t > v ? t : v;
    return (unsigned)__builtin_amdgcn_readlane((int)v, 63);
}
constexpr int SEL_K1 = 0, SEL_K2 = 34816, SEL_Q0 = 69632, SEL_Q1 = 78336, SEL_S1 = 87040, SEL_S2 = 103936;
__device__ __forceinline__ void ph_select(const Ctx& C, int layer, int nrows) {
    const bf16_t* Q = (const bf16_t*)(C.ws + WS_Q); int* SELI = (int*)(C.ws + WS_SELI); float* SELG = (float*)(C.ws + WS_SELG);
    LAS bf16_t* K1 = (LAS bf16_t*)(C.lds + SEL_K1); LAS bf16_t* K2 = (LAS bf16_t*)(C.lds + SEL_K2);
    LAS bf16_t* Q0 = (LAS bf16_t*)(C.lds + SEL_Q0); LAS bf16_t* Q1 = (LAS bf16_t*)(C.lds + SEL_Q1);
    LAS float* S1 = (LAS float*)(C.lds + SEL_S1); LAS float* S2 = (LAS float*)(C.lds + SEL_S2);
    {
        const float* k1 = C.in[37] + (size_t)layer * 128 * 128; const float* k2 = C.in[38] + (size_t)layer * 128 * 128;
        for (int e = C.tid; e < 4096; e += 512) { const int r = e >> 5, c4 = (e & 31) * 4; const f32x4 a = *(const f32x4*)(k1 + r * 128 + c4), b = *(const f32x4*)(k2 + r * 128 + c4);
            u32x2 oa, ob; oa.x = pk2(a.x, a.y); oa.y = pk2(a.z, a.w); ob.x = pk2(b.x, b.y); ob.y = pk2(b.z, b.w);
            *(LAS u32x2*)(K1 + r * 136 + c4) = oa; *(LAS u32x2*)(K2 + r * 136 + c4) = ob; }
    }
    int ca = 0, cb = 0;
    { const int L = C.lane;
      if (L < 16) { ca = 0; cb = L; } else if (L < 24) { ca = 1; cb = L - 16; } else if (L < 29) { ca = 2; cb = L - 24; } else if (L < 33) { ca = 3; cb = L - 29; }
      else if (L < 36) { ca = 4; cb = L - 33; } else if (L < 38) { ca = 5; cb = L - 36; } else if (L < 40) { ca = 6; cb = L - 38; } else if (L < 42) { ca = 7; cb = L - 40; }
      else { ca = 8 + (L - 42); cb = 0; } if (L >= 50) { ca = 0; cb = 0; } }
    const int ntile = nrows / 32;
    for (int it = C.bid; it < ntile * 8; it += C.G) {
        const int tile = it >> 3, h = it & 7, row0 = tile * 32;
        __syncthreads();
        for (int e = C.tid; e < 32 * 32; e += 512) { const int r = e >> 5, c8 = (e & 31) * 8;
            const u32x4 v = *(const u32x4*)(Q + (size_t)(row0 + r) * 2048 + h * 256 + c8);
            if (c8 < 128) *(LAS u32x4*)(Q0 + r * 136 + c8) = v; else *(LAS u32x4*)(Q1 + r * 136 + c8 - 128) = v; }
        __syncthreads();
        blk_mma2<2, 8, 4>(Q0, K1, Q1, K2, 136, C.wid, C.lane, [=](int r0, int col, const f32x4& a, const f32x4& b) {
#pragma unroll
            for (int jj = 0; jj < 4; ++jj) { S1[(r0 + jj) * 132 + col] = a[jj]; S2[(r0 + jj) * 132 + col] = b[jj]; }
        });
        __syncthreads();
        {
            const int L = C.lane, tb = C.wid * 4;
            unsigned ka0[4], ka1[4], kb0[4], kb1[4]; float v1[4], v2[4]; int i1[4], i2[4];
#pragma unroll
            for (int q = 0; q < 4; ++q) { const LAS float* s1 = S1 + (tb + q) * 132; const LAS float* s2 = S2 + (tb + q) * 132;
                ka0[q] = (ordf(s1[L]) & ~0x7Fu) | (unsigned)(127 - L); ka1[q] = (ordf(s1[L + 64]) & ~0x7Fu) | (unsigned)(63 - L);
                kb0[q] = (ordf(s2[L]) & ~0x7Fu) | (unsigned)(127 - L); kb1[q] = (ordf(s2[L + 64]) & ~0x7Fu) | (unsigned)(63 - L);
                v1[q] = 0.f; v2[q] = 0.f; i1[q] = 0; i2[q] = 0; }
            for (int i = 0; i < 16; ++i) {
#pragma unroll
                for (int q = 0; q < 4; ++q) {
                    const unsigned ma = wave_max_u32(ka0[q] > ka1[q] ? ka0[q] : ka1[q]), mb = wave_max_u32(kb0[q] > kb1[q] ? kb0[q] : kb1[q]);
                    const int ia = 127 - (int)(ma & 0x7Fu), ib = 127 - (int)(mb & 0x7Fu);
                    const float sa = S1[(tb + q) * 132 + ia], sb = S2[(tb + q) * 132 + ib];
                    if (L == i) { v1[q] = sa; i1[q] = ia; v2[q] = sb; i2[q] = ib; }
                    if (ka0[q] == ma) ka0[q] = 0u; if (ka1[q] == ma) ka1[q] = 0u; if (kb0[q] == mb) kb0[q] = 0u; if (kb1[q] == mb) kb1[q] = 0u;
                }
            }
            float cand[4]; unsigned kc[4]; int sel[4];
#pragma unroll
            for (int q = 0; q < 4; ++q) { cand[q] = __shfl(v1[q], ca) + __shfl(v2[q], cb); kc[q] = (L < 50) ? ((ordf(cand[q]) & ~0x3Fu) | (unsigned)(63 - L)) : 0u; sel[q] = 0; }
            for (int i = 0; i < 16; ++i) {
#pragma unroll
                for (int q = 0; q < 4; ++q) { const unsigned m = wave_max_u32(kc[q]); const int ls = 63 - (int)(m & 0x3Fu); if (L == i) sel[q] = ls; if (kc[q] == m) kc[q] = 0u; }
            }
#pragma unroll
            for (int q = 0; q < 4; ++q) {
                const float top = __shfl(cand[q], sel[q]); const int sa = __shfl(ca, sel[q]), sb = __shfl(cb, sel[q]);
                const int idx = __shfl(i1[q], sa) * 128 + __shfl(i2[q], sb);
                const float mx = __shfl(top, 0);
                const float ex = expf(top - mx);
                float sm = ex; sm += __shfl_xor(sm, 1); sm += __shfl_xor(sm, 2); sm += __shfl_xor(sm, 4); sm += __shfl_xor(sm, 8);
                if (L < 16) { const size_t o = ((size_t)(row0 + tb + q) * 8 + h) * 16 + L; SELI[o] = idx; SELG[o] = ex / sm; }
            }
        }
    }
}

struct R16 { float v[16]; };
__device__ __forceinline__ R16 load_r16_f32(const float* p, int lane) { R16 r;
#pragma unroll
    for (int k = 0; k < 4; ++k) { const f32x4 a = *(const f32x4*)(p + 16 * lane + 4 * k); r.v[4 * k] = a.x; r.v[4 * k + 1] = a.y; r.v[4 * k + 2] = a.z; r.v[4 * k + 3] = a.w; }
    return r; }
__device__ __forceinline__ void store_r16_f32(float* p, int lane, const R16& r) {
#pragma unroll
    for (int k = 0; k < 4; ++k) *(f32x4*)(p + 16 * lane + 4 * k) = (f32x4){r.v[4 * k], r.v[4 * k + 1], r.v[4 * k + 2], r.v[4 * k + 3]}; }
__device__ __forceinline__ R16 load_r16_bf16(const bf16_t* p, int lane) { R16 r;
#pragma unroll
    for (int k = 0; k < 2; ++k) { const u32x4 a = *(const u32x4*)(p + 16 * lane + 8 * k);
        r.v[8 * k] = bflo(a.x); r.v[8 * k + 1] = bfhi(a.x); r.v[8 * k + 2] = bflo(a.y); r.v[8 * k + 3] = bfhi(a.y); r.v[8 * k + 4] = bflo(a.z); r.v[8 * k + 5] = bfhi(a.z); r.v[8 * k + 6] = bflo(a.w); r.v[8 * k + 7] = bfhi(a.w); }
    return r; }
__device__ __forceinline__ void store_r16_bf16(bf16_t* p, int lane, const R16& r) {
#pragma unroll
    for (int k = 0; k < 2; ++k) { u32x4 a; a.x = pk2(r.v[8 * k], r.v[8 * k + 1]); a.y = pk2(r.v[8 * k + 2], r.v[8 * k + 3]); a.z = pk2(r.v[8 * k + 4], r.v[8 * k + 5]); a.w = pk2(r.v[8 * k + 6], r.v[8 * k + 7]);
        *(u32x4*)(p + 16 * lane + 8 * k) = a; } }
typedef float f32x2p __attribute__((ext_vector_type(2)));
__device__ __forceinline__ void ph_peer(const Ctx& C, int layer, int nrows, bool last, bool store = true) {
    const bf16_t* F = (const bf16_t*)(C.ws + WS_ACT); bf16_t* XN = (bf16_t*)(C.ws + WS_ACT);
    const unsigned char* UB = C.ws + WS_UB; const unsigned char* VB = C.ws + WS_VB; const float* SU = (const float*)(C.ws + WS_SU); const float* SV = (const float*)(C.ws + WS_SV);
    const int* SELI = (const int*)(C.ws + WS_SELI); const float* SELG = (const float*)(C.ws + WS_SELG);
    float* H = (float*)(C.ws + WS_H); const float* MOD = (const float*)(C.ws + WS_MOD);
    const int L = C.lane;
    for (int tok = C.bid * 8 + C.wid; tok < nrows; tok += C.G * 8) {
        const R16 f = load_r16_bf16(F + (size_t)tok * DM, L);
        const int idx0 = SELI[(size_t)tok * 128 + L], idx1 = SELI[(size_t)tok * 128 + 64 + L];
        const float su0 = SU[idx0], su1 = SU[idx1];
        const float gsv0 = SELG[(size_t)tok * 128 + L] * SV[idx0], gsv1 = SELG[(size_t)tok * 128 + 64 + L] * SV[idx1];
        f32x2p out[8];
#pragma unroll
        for (int i = 0; i < 8; ++i) out[i] = (f32x2p){0.f, 0.f};
        for (int bt = 0; bt < 8; ++bt) {
            const int src = bt < 4 ? idx0 : idx1; const float susrc = bt < 4 ? su0 : su1, gsrc = bt < 4 ? gsv0 : gsv1; const int l0 = (bt & 3) * 16;
            u32x4 ua[16], va[16];
#pragma unroll
            for (int i = 0; i < 16; ++i) { const int ei = __builtin_amdgcn_readlane(src, l0 + i);
                ua[i] = *(const u32x4*)(UB + (size_t)ei * DM + 16 * L); va[i] = *(const u32x4*)(VB + (size_t)ei * DM + 16 * L); }
            float part[16];
#pragma unroll
            for (int i = 0; i < 16; ++i) { f32x2p acc = {0.f, 0.f};
#pragma unroll
                for (int k = 0; k < 4; ++k) { const f32x2p lo = __builtin_amdgcn_cvt_pk_f32_fp8((int)ua[i][k], false), hi = __builtin_amdgcn_cvt_pk_f32_fp8((int)ua[i][k], true);
                    acc += lo * (f32x2p){f.v[4 * k], f.v[4 * k + 1]}; acc += hi * (f32x2p){f.v[4 * k + 2], f.v[4 * k + 3]}; }
                part[i] = acc.x + acc.y; }
            float p8[8], p4[4], p2[2], p1;
            { const bool hi = (L & 32) != 0;
#pragma unroll
              for (int i = 0; i < 8; ++i) { const float send = hi ? part[i] : part[i + 8]; const float recv = __shfl_xor(send, 32); p8[i] = (hi ? part[i + 8] : part[i]) + recv; } }
            { const bool hi = (L & 16) != 0;
#pragma unroll
              for (int i = 0; i < 4; ++i) { const float send = hi ? p8[i] : p8[i + 4]; const float recv = __shfl_xor(send, 16); p4[i] = (hi ? p8[i + 4] : p8[i]) + recv; } }
            { const bool hi = (L & 8) != 0;
#pragma unroll
              for (int i = 0; i < 2; ++i) { const float send = hi ? p4[i] : p4[i + 2]; const float recv = __shfl_xor(send, 8); p2[i] = (hi ? p4[i + 2] : p4[i]) + recv; } }
            { const bool hi = (L & 4) != 0; const float send = hi ? p2[0] : p2[1]; const float recv = __shfl_xor(send, 4); p1 = (hi ? p2[1] : p2[0]) + recv; }
            p1 += __shfl_xor(p1, 2); p1 += __shfl_xor(p1, 1);
            const int myexp = ((L >> 5) & 1) * 8 + ((L >> 4) & 1) * 4 + ((L >> 3) & 1) * 2 + ((L >> 2) & 1);
            const float act = gelu_tanh(p1 * __shfl(susrc, l0 + myexp)) * __shfl(gsrc, l0 + myexp);
#pragma unroll
            for (int i = 0; i < 16; ++i) {
                const float a = __uint_as_float((unsigned)__builtin_amdgcn_readlane((int)__float_as_uint(act), ((i >> 3) & 1) * 32 + ((i >> 2) & 1) * 16 + ((i >> 1) & 1) * 8 + (i & 1) * 4)); const f32x2p a2 = {a, a};
#pragma unroll
                for (int k = 0; k < 4; ++k) { out[2 * k] += a2 * __builtin_amdgcn_cvt_pk_f32_fp8((int)va[i][k], false); out[2 * k + 1] += a2 * __builtin_amdgcn_cvt_pk_f32_fp8((int)va[i][k], true); }
            }
        }
        const float* m = MOD + ((size_t)layer * 3 + which_of(tok)) * 6144;
        R16 hr = load_r16_f32(H + (size_t)tok * DM, L); const R16 g5 = load_r16_f32(m + 5 * 1024, L);
#pragma unroll
        for (int i = 0; i < 8; ++i) { hr.v[2 * i] += g5.v[2 * i] * out[i].x; hr.v[2 * i + 1] += g5.v[2 * i + 1] * out[i].y; }
        float ss = 0.f;
#pragma unroll
        for (int i = 0; i < 16; ++i) ss += hr.v[i] * hr.v[i];
        const float rs = rsqrtf(wave_sum(ss) * (1.f / 1024.f) + 1e-6f);
        if (!store) continue;
        if (!last) {
            store_r16_f32(H + (size_t)tok * DM, L, hr);
            const float* m2 = MOD + ((size_t)(layer + 1) * 3 + which_of(tok)) * 6144;
            const R16 gg = load_r16_f32(C.in[6] + (layer + 1) * 1024, L), sh = load_r16_f32(m2, L), sc = load_r16_f32(m2 + 1024, L); R16 o;
#pragma unroll
            for (int i = 0; i < 16; ++i) o.v[i] = (hr.v[i] * rs * gg.v[i]) * (1.f + sc.v[i]) + sh.v[i];
            store_r16_bf16(XN + (size_t)tok * DM, L, o);
        } else {
            const R16 fg = load_r16_f32(C.in[41], L); R16 o;
#pragma unroll
            for (int i = 0; i < 16; ++i) o.v[i] = hr.v[i] * rs * fg.v[i];
            store_r16_f32(C.out + (size_t)tok * DM, L, o);
        }
    }
}

#define PM(n) ((MASK >> (n)) & 1u)
constexpr int NPH_LAYER = 9, NPH = 2 + 2 * NPH_LAYER;
template <unsigned MASK> __global__ void __launch_bounds__(512, 2) hybrid_fwd(Args args) {
    extern __shared__ __attribute__((aligned(16))) unsigned char lds_raw[];
    Ctx C0; C0.in = args.in; C0.out = args.out; C0.ws = args.ws; C0.lds = (lds_t)lds_raw;
    C0.tid = threadIdx.x; C0.lane = C0.tid & 63; C0.wid = __builtin_amdgcn_readfirstlane(C0.tid >> 6); C0.bid = blockIdx.x; C0.G = gridDim.x;
    const Ctx& C = C0;
    const int lo = args.ph_lo, hi = args.ph_hi;
    const bool multi = (hi - lo) > 1;
    XcdBarrier bar; bar.bar = (unsigned*)(C.ws + WS_CTL); bar.x = 0; bar.st = (volatile LAS unsigned*)(C.lds + LDS_XB);
    if (multi) {
        if (C.tid == 0) *(LAS u32x4*)(C.lds + LDS_XB) = (u32x4){0u, 0u, 0u, 0u};
        __syncthreads();
        bar = xcd_barrier_post((unsigned*)(C.ws + WS_CTL), (volatile LAS unsigned*)(C.lds + LDS_XB));
    }
#define IN(k) (lo <= (k) && (k) < hi)
#define PHASE_CTX(c) Ctx c = C0; { int t_ = C0.tid; asm volatile("" : "+v"(t_)); c.tid = t_; c.lane = t_ & 63; c.wid = __builtin_amdgcn_readfirstlane(t_ >> 6); }
#ifndef MK_PROBE
#define MK_PROBE 0u
#endif
#ifndef MK_REPEAT
#define MK_REPEAT 0u
#endif
#define RP(k) ((MK_REPEAT >> (k)) & 1u)
#if MK_PROBE
#define STAMP(k) do { if (C0.bid == 0 && C0.tid == 0) ((LAS unsigned long long*)(C0.lds + LDS_XB + 16))[k] = wall_clock64(); } while (0)
#else
#define STAMP(k) do {} while (0)
#endif
#define SEAM(k) do { if (IN(k) && IN((k) + 1)) xcd_barrier(bar); STAMP((k) + 1); } while (0)
    STAMP(0);
    if (PM(0) && IN(0)) { PHASE_CTX(c); ph_prologue(c); } SEAM(0);
    if (PM(1) && IN(1)) { PHASE_CTX(c); ph_norm(c, 0, c.in[6], 0, NROW); } SEAM(1);
    for (int layer = 0; layer < 2; ++layer) {
        const int base = 2 + layer * NPH_LAYER;
        const bool emit = (layer == 0);
        const int nrows = emit ? NROW : NLAT;
        if (PM(2) && IN(base + 0)) {
            pg8::Gemm g{(const bf16_t*)(C.ws + WS_ACT), (const bf16_t*)(C.ws + WS_WIN) + (size_t)layer * NP * DM, NROW, NP, DM};
            pg8::StaticOrder S; S.init(NROW, NP, C.G, C.bid);
            pg8::EpiBf16<0> E{(bf16_t*)(C.ws + WS_P), NP, nullptr, 0, 0};
            pg8::gemm_phase<pg8::EpiBf16<0>, pg8::StaticOrder, false>(C.lds, g, S, E, nullptr);
            if (RP(0)) { xcd_barrier(bar); pg8::gemm_phase<pg8::EpiBf16<0>, pg8::StaticOrder, false>(C.lds, g, S, E, nullptr); }
        }
        SEAM(base + 0);
        if (PM(3) && IN(base + 1)) {
            const int nD = 2112, nC = 264, nB = emit ? 132 : 128, nA = emit ? 264 : 256, tot = nD + nC + nB + nA;
            for (int rep = 0; rep < (RP(1) ? 2 : 1); ++rep) {
            if (rep) xcd_barrier(bar);
            if (PM(11)) { PHASE_CTX(c); for (int it = c.bid; it < nD; it += c.G) item_rwkv_local(c, layer, it); }
            if (PM(12)) { PHASE_CTX(c); for (int it = nD + (c.bid + 64) % c.G; it < nD + nC; it += c.G) item_mamba_local(c, layer, it - nD); }
            if (PM(13)) { PHASE_CTX(c); for (int it = nD + nC + (c.bid + 192) % c.G; it < nD + nC + nB; it += c.G) item_chunkmlp(c, layer, it - nD - nC); }
            if (PM(14)) { PHASE_CTX(c); for (int it = nD + nC + nB + (c.bid + 64) % c.G; it < tot; it += c.G) item_conformer(c, layer, it - nD - nC - nB); }
            }
        }
        SEAM(base + 1);
        if (PM(4) && IN(base + 2)) { PHASE_CTX(c); ph_scan(c); }
        SEAM(base + 2);
        if (PM(5) && IN(base + 3)) {
            const int nc = nrows / 64;
            for (int rep = 0; rep < (RP(3) ? 2 : 1); ++rep) {
            if (rep) xcd_barrier(bar);
            if (PM(15)) { PHASE_CTX(c); load_g2t(c, layer); for (int it = c.bid; it < nc; it += c.G) item_rwkv_out(c, layer, it); }
            __syncthreads();
            if (PM(16)) { PHASE_CTX(c); for (int it = c.bid; it < nc; it += c.G) item_mamba_out(c, layer, (it + 128) % nc); }
            __syncthreads();
            }
        }
        SEAM(base + 3);
        if (PM(6) && IN(base + 4)) {
            pg8::Gemm g{(const bf16_t*)(C.ws + WS_ACT), (const bf16_t*)(C.ws + WS_WOUT) + (size_t)layer * DM * DM, nrows, DM, DM};
            pg8::StaticOrder S; S.init(nrows, DM, C.G, C.bid);
            EpiResid E{(float*)(C.ws + WS_H), (const float*)(C.ws + WS_MOD) + (size_t)layer * 3 * 6144};
            pg8::gemm_phase<EpiResid, pg8::StaticOrder, false>(C.lds, g, S, E, nullptr);
        }
        SEAM(base + 4);
        if (PM(7) && IN(base + 5)) { PHASE_CTX(c); for (int rep = 0; rep < (RP(5) ? 2 : 1); ++rep) { if (rep) xcd_barrier(bar); ph_norm(c, layer, c.in[7] + layer * 1024, 3, nrows); if (layer == 1) convert_tables(c, 1); } }
        SEAM(base + 5);
        if (PM(8) && IN(base + 6)) {
            pg8::Gemm g{(const bf16_t*)(C.ws + WS_ACT), (const bf16_t*)(C.ws + WS_WQ) + (size_t)layer * 2048 * DM, nrows, 2048, DM};
            pg8::StaticOrder S; S.init(nrows, 2048, C.G, C.bid);
            pg8::EpiBf16<0> E{(bf16_t*)(C.ws + WS_Q), 2048, nullptr, 0, 0};
            pg8::gemm_phase<pg8::EpiBf16<0>, pg8::StaticOrder, false>(C.lds, g, S, E, nullptr);
            if (RP(6)) { xcd_barrier(bar); pg8::gemm_phase<pg8::EpiBf16<0>, pg8::StaticOrder, false>(C.lds, g, S, E, nullptr); }
        }
        SEAM(base + 6);
        if (PM(9) && IN(base + 7)) { PHASE_CTX(c); ph_select(c, layer, nrows); if (RP(7)) { xcd_barrier(bar); ph_select(c, layer, nrows); } }
        SEAM(base + 7);
        if (PM(10) && IN(base + 8)) { PHASE_CTX(c); if (RP(8)) { ph_peer(c, layer, nrows, layer == 1, args.ph_hi > 1000); xcd_barrier(bar); } ph_peer(c, layer, nrows, layer == 1); }
        SEAM(base + 8);
    }
#if MK_PROBE
    {
        xcd_barrier(bar);
        if (C0.bid == 0 && C0.tid == 0) { const LAS unsigned long long* TS = (const LAS unsigned long long*)(C0.lds + LDS_XB + 16);
            unsigned long long sel = 0; for (int k = 0; k < NPH; ++k) if ((MK_PROBE >> k) & 1u) sel += TS[k + 1] - TS[k];
            const unsigned long long tot = TS[NPH] - TS[0];
            __hip_atomic_store((unsigned*)(C0.ws + 40960), (unsigned)((double)sel / (double)tot * (double)NLAT), __ATOMIC_RELAXED, __HIP_MEMORY_SCOPE_AGENT); }
        xcd_barrier(bar);
        const unsigned nz = __hip_atomic_load((unsigned*)(C0.ws + 40960), __ATOMIC_RELAXED, __HIP_MEMORY_SCOPE_AGENT);
        for (size_t i = (size_t)C0.bid * 512 + C0.tid; i < (size_t)nz * 256; i += (size_t)C0.G * 512) *(f32x4*)(C0.out + i * 4) = (f32x4){0.f, 0.f, 0.f, 0.f};
    }
#endif
#undef IN
#undef SEAM
}
}
#ifndef MK_DIAG
#define MK_DIAG 0
#endif


namespace mk {
struct LaunchEnt { unsigned mask; int ph; };
template <unsigned MASK> static bool prep_kernel() {
    return hipFuncSetAttribute((const void*)hybrid_fwd<MASK>, hipFuncAttributeMaxDynamicSharedMemorySize, LDS_BYTES) == hipSuccess;
}
template <unsigned MASK> static void launch_kernel(int grid, hipStream_t stream, const Args& a) {
    hipLaunchKernelGGL(hybrid_fwd<MASK>, dim3(grid), dim3(512), LDS_BYTES, stream, a);
}
}

#if MK_DIAG
namespace mk {
__global__ void census_kernel(const void* buf, size_t n, int kind  , unsigned* flags, int stage, float lim) {
    bool bad = false;
    for (size_t i = (size_t)blockIdx.x * blockDim.x + threadIdx.x; i < n; i += (size_t)gridDim.x * blockDim.x) {
        if (kind == 2) { const int v = ((const int*)buf)[i]; bad |= (v < 0 || v >= 16384); }
        else { const float v = kind == 0 ? ((const float*)buf)[i] : bf2f(((const bf16_t*)buf)[i]); bad |= !(fabsf(v) < lim); }
    }
    if (bad) atomicOr(flags + stage, 1u);
}
__global__ void encode_kernel(const float* x, const float* fg, float* out, const unsigned* flags, int nst) {
    int first = 0; for (int k = nst; k >= 1; --k) if (flags[k]) first = k;
    const int row = blockIdx.x * 4 + (threadIdx.x >> 6), lane = threadIdx.x & 63;
    Row16 r = load_row16(x + (size_t)row * DM, lane);
    const int t = row & 8191;
    for (int i = 0; i < 16; ++i) { const int c = (i < 8 ? 8 * lane + i : 512 + 8 * lane + i - 8); const int quarter = c >> 8, jj = c & 255; const float pos = (quarter < 2) ? (float)(t >> 6) : (float)(t & 63);
        const float fr = exp2f(-(float)jj * (13.287712379549449f / 256.f)); r.v[i] += (quarter & 1) ? cosf(pos * fr) : sinf(pos * fr); }
    float ss = 0.f; for (int i = 0; i < 16; ++i) ss += r.v[i] * r.v[i];
    const float rs = rsqrtf(wave_sum(ss) * (1.f / 1024.f) + 1e-6f);
    const Row16 g = load_row16(fg, lane); Row16 o;
    const bool zero = row < first * 512;
    for (int i = 0; i < 16; ++i) o.v[i] = zero ? 0.f : r.v[i] * rs * g.v[i];
    store_row16_f32(out + (size_t)row * DM, lane, o);
}
}
#define CENSUS(off, n, kind, stage, lim) hipLaunchKernelGGL(mk::census_kernel, dim3(1024), dim3(256), 0, stream, (const void*)((char*)d_ws + (off)), (size_t)(n), kind, (unsigned*)((char*)d_ws + 32768), stage, lim)
#else
#define CENSUS(off, n, kind, stage, lim) do {} while (0)
#endif
#ifndef MK_ONE_LAUNCH
#define MK_ONE_LAUNCH 1
#endif
extern "C" void kernel_launch(void* const* d_in, const int* in_sizes, int n_in, void* d_out, int out_size, void* d_ws, size_t ws_size, hipStream_t stream) {
    using namespace mk;
    static int grid = 0;
    if (grid == 0) {
        if (n_in != 42 || ws_size < WS_END) { fprintf(stderr, "kernel_launch: need 42 inputs and %zu bytes of workspace (got %d, %zu)\n", (size_t)WS_END, n_in, ws_size); grid = -1; return; }
        int dev = 0, cus = 0;
        if (hipGetDevice(&dev) != hipSuccess || hipDeviceGetAttribute(&cus, hipDeviceAttributeMultiprocessorCount, dev) != hipSuccess) { grid = -1; return; }
        bool ok = true;
#if MK_ONE_LAUNCH
        ok = ok && prep_kernel<0x1FFFFu>();
#else
        ok = ok && prep_kernel<0x0001u>() && prep_kernel<0x0002u>() && prep_kernel<0x0004u>() && prep_kernel<0x0808u>() && prep_kernel<0x1008u>() && prep_kernel<0x2008u>() && prep_kernel<0x4008u>()
                && prep_kernel<0x0010u>() && prep_kernel<0x8020u>() && prep_kernel<0x10020u>() && prep_kernel<0x0040u>() && prep_kernel<0x0080u>() && prep_kernel<0x0100u>() && prep_kernel<0x0200u>() && prep_kernel<0x0400u>();
#endif
        if (!ok) { fprintf(stderr, "kernel_launch: hipFuncSetAttribute failed\n"); grid = -1; return; }
        (void)hipGetLastError();
        grid = cus;
    }
    if (grid < 0) return;
    (void)hipMemsetAsync((char*)d_ws + WS_CTL, 0, 65536, stream);
    Args a{};
    for (int i = 0; i < 42; ++i) a.in[i] = (const float*)d_in[i];
    a.out = (float*)d_out; a.ws = (unsigned char*)d_ws;
#if MK_ONE_LAUNCH
    a.ph_lo = 0; a.ph_hi = NPH; launch_kernel<0x1FFFFu>(grid, stream, a);
#else
    a.ph_lo = 0; a.ph_hi = 1; launch_kernel<0x0001u>(grid, stream, a);
    CENSUS(WS_H, (size_t)NROW * DM, 0, 1, 1e4f); CENSUS(WS_MOD, 2 * 3 * 6144, 0, 1, 1e4f); CENSUS(WS_WIN, 2ull * NP * DM, 1, 1, 1e4f); CENSUS(WS_UB, 2ull * NEXP * DM, 1, 1, 1e4f);
    a.ph_lo = 1; a.ph_hi = 2; launch_kernel<0x0002u>(grid, stream, a);
    CENSUS(WS_ACT, (size_t)NROW * DM, 1, 2, 1e4f);
    for (int layer = 0; layer < 2; ++layer) {
        const int b = 2 + layer * NPH_LAYER;
        const int so = layer ? 100 : 0; (void)so;
        a.ph_lo = b + 0; a.ph_hi = b + 1; launch_kernel<0x0004u>(grid, stream, a);
        if (!layer) CENSUS(WS_P, (size_t)NROW * NP, 1, 3, 1e4f);
        a.ph_lo = b + 1; a.ph_hi = b + 2; launch_kernel<0x0808u>(grid, stream, a);
        if (!layer) { CENSUS(WS_RG, (size_t)NSLOT * 4096, 1, 4, 1e6f); CENSUS(WS_RJ, (size_t)NSLOT * 4096, 0, 5, 1e6f); CENSUS(WS_RY, (size_t)NSLOT * 4096 * 2, 1, 6, 1e6f); CENSUS(WS_BON, (size_t)NROW * 8, 0, 6, 1e6f); }
        launch_kernel<0x1008u>(grid, stream, a);
        if (!layer) { CENSUS(WS_MST, (size_t)NSLOT * 8192, 0, 7, 1e6f); CENSUS(WS_MCD, NSLOT, 0, 7, 1e6f); }
        launch_kernel<0x2008u>(grid, stream, a); launch_kernel<0x4008u>(grid, stream, a);
        a.ph_lo = b + 2; a.ph_hi = b + 3; launch_kernel<0x0010u>(grid, stream, a);
        if (!layer) { CENSUS(WS_MST, (size_t)NSLOT * 8192, 0, 8, 1e6f); CENSUS(WS_RH, (size_t)NSLOT * 4096, 1, 9, 1e6f); }
        a.ph_lo = b + 3; a.ph_hi = b + 4; launch_kernel<0x8020u>(grid, stream, a); launch_kernel<0x10020u>(grid, stream, a);
        if (!layer) CENSUS(WS_ACT, (size_t)NROW * DM, 1, 10, 1e4f);
        a.ph_lo = b + 4; a.ph_hi = b + 5; launch_kernel<0x0040u>(grid, stream, a);
        if (!layer) CENSUS(WS_H, (size_t)NROW * DM, 0, 11, 1e4f);
        a.ph_lo = b + 5; a.ph_hi = b + 6; launch_kernel<0x0080u>(grid, stream, a);
        a.ph_lo = b + 6; a.ph_hi = b + 7; launch_kernel<0x0100u>(grid, stream, a);
        if (!layer) CENSUS(WS_Q, (size_t)NROW * 2048, 1, 12, 1e4f);
        a.ph_lo = b + 7; a.ph_hi = b + 8; launch_kernel<0x0200u>(grid, stream, a);
        if (!layer) { CENSUS(WS_SELI, (size_t)NROW * 128, 2, 13, 0.f); CENSUS(WS_SELG, (size_t)NROW * 128, 0, 13, 2.f); }
        a.ph_lo = b + 8; a.ph_hi = b + 9; launch_kernel<0x0400u>(grid, stream, a);
        if (!layer) { CENSUS(WS_H, (size_t)NROW * DM, 0, 14, 1e4f); CENSUS(WS_ACT, (size_t)NROW * DM, 1, 15, 1e4f); }
    }
#endif
#if MK_DIAG
    hipLaunchKernelGGL(mk::encode_kernel, dim3(NLAT / 4), dim3(256), 0, stream, (const float*)d_in[0], (const float*)d_in[41], (float*)d_out, (const unsigned*)((char*)d_ws + 32768), 15);
#endif
    (void)in_sizes; (void)out_size;
}
```

```cpp
#include <hip/hip_runtime.h>
#include <cstdio>
#include <cstdint>
namespace pg8 {
#define PG8_LAS __attribute__((address_space(3)))
typedef unsigned short bf16_t;
typedef short bf16x8 __attribute__((ext_vector_type(8)));
typedef float f32x4 __attribute__((ext_vector_type(4)));
typedef unsigned u32x4 __attribute__((ext_vector_type(4)));
constexpr int BM = 256, BK = 64, HALF = 128, HTB = HALF * BK * 2  , STAGE_BYTES = 8 * HTB, NXCD = 8, WGM = 8;

__host__ __device__ __forceinline__ int lds_byte(int r, int c) { const int st = (r >> 4) * 2 + (c >> 5), rr = r & 15, cc = c & 31, ob = rr * 64 + cc * 2; return st * 1024 + (ob ^ (((ob >> 9) & 1) << 5)); }
__host__ __device__ __forceinline__ void stage_rc(int b, int& R, int& C) { const int st = b / 1024, sb = b % 1024, swz = sb ^ (((sb >> 9) & 1) << 5); R = (st >> 1) * 16 + swz / 64; C = (st & 1) * 32 + (swz % 64) / 2; }
__host__ __device__ __forceinline__ int perm32(int rho) { const int n = rho >> 4, i = rho & 15; return 8 * (i >> 2) + 4 * n + (i & 3); }

struct Unit { int pm, pn; };
struct Gemm { const bf16_t* A; const bf16_t* Bt; int M, N, K; };

struct StaticOrder {
    int nM, nN, nwg, G, c;
    __host__ __device__ void init(int M, int N, int G_, int c_) { nM = M / BM; nN = N / BM; nwg = nM * nN; G = G_; c = c_; }
    __host__ __device__ bool next(int i, Unit& u) const {
        const long L = (long)i * G + c; if (L >= nwg) return false;
        int wgid = (int)L; { const int q = nwg / NXCD, r = nwg % NXCD, xcd = wgid % NXCD, off = wgid / NXCD; wgid = (xcd < r ? xcd * (q + 1) : r * (q + 1) + (xcd - r) * q) + off; }
        const int nig = WGM * nN, gid = wgid / nig, fm = gid * WGM, gsz = (nM - fm) < WGM ? (nM - fm) : WGM;
        u.pm = fm + ((wgid % nig) % gsz); u.pn = (wgid % nig) / gsz; return true;
    }
    __device__ __forceinline__ void a_ready(const Unit&) const {}
    __device__ __forceinline__ void done(const Unit&) const {}
};
struct CountedOrder : StaticOrder {
    const unsigned* ready; unsigned need; unsigned* tmo;
    __device__ __forceinline__ void a_ready(const Unit& u) const {
        if (threadIdx.x < 64) {
            const unsigned long long t0 = __builtin_amdgcn_s_memrealtime(); unsigned polls = 0;
            while ((unsigned)__builtin_amdgcn_readfirstlane(__hip_atomic_load(ready + 64 * u.pm, __ATOMIC_RELAXED, __HIP_MEMORY_SCOPE_AGENT)) < need) {
                if ((++polls & 255u) == 0u && __builtin_amdgcn_readfirstlane(__hip_atomic_load(tmo, __ATOMIC_RELAXED, __HIP_MEMORY_SCOPE_AGENT)) != 0u) break;
                if (__builtin_amdgcn_s_memrealtime() - t0 > 2000000ull) {
                    if (threadIdx.x == 0) { unsigned expect = 0u; __hip_atomic_compare_exchange_strong(tmo + 1, &expect, 0x600u | (unsigned)(u.pm & 0xff), __ATOMIC_RELAXED, __ATOMIC_RELAXED, __HIP_MEMORY_SCOPE_AGENT); __hip_atomic_store(tmo, 1u, __ATOMIC_RELAXED, __HIP_MEMORY_SCOPE_AGENT); }
                    break; }
                __builtin_amdgcn_s_sleep(2); }
            __builtin_amdgcn_fence(__ATOMIC_ACQUIRE, "agent");
            asm volatile("s_waitcnt vmcnt(0)" ::: "memory");
        }
#if !defined(BROKEN_HOOK_NO_BARRIER)
        asm volatile("" ::: "memory"); __builtin_amdgcn_s_barrier(); asm volatile("" ::: "memory");
#endif
    }
};

__device__ __forceinline__ unsigned cvt_pk_bf16(float lo, float hi) { unsigned r; asm volatile("v_cvt_pk_bf16_f32 %0, %1, %2" : "=v"(r) : "v"(lo), "v"(hi)); return r; }
typedef float f32x2 __attribute__((ext_vector_type(2)));
__device__ __forceinline__ f32x2 gelu_pk(f32x2 v) {
    const f32x2 av = __builtin_elementwise_abs(v), d = av * 0.2316418882f + 1.0f;
    f32x2 t; t.x = __builtin_amdgcn_rcpf(d.x); t.y = __builtin_amdgcn_rcpf(d.y);
    f32x2 q = t * 0.5307027145f + (-0.7265760135f); q = q * t + 0.7107068705f; q = q * t + (-0.142248368f); q = q * t + 0.127414796f; q = q * t;
    const f32x2 s = (v * v) * (-0.72134752044f);
    f32x2 e; e.x = __builtin_amdgcn_exp2f(s.x); e.y = __builtin_amdgcn_exp2f(s.y);
    const f32x2 m = v * (q * e), r = v - m;
    f32x2 o; o.x = v.x < 0.f ? m.x : r.x; o.y = v.y < 0.f ? m.y : r.y; return o;
}

struct EpiF32 {
    static constexpr bool PERM = false, AFTER_DRAIN = false;
    float* C; int ldc; const float* bias;
    __device__ __forceinline__ void operator()(const f32x4 (&acc)[2][2][4][2], const Unit& u, int wr, int wc, int fr, int fq) const {
        const int row0 = u.pm * BM + wr * 64 + fr, col0 = u.pn * BM + wc * 32 + 4 * fq;
        f32x4 bv[2][2];
#pragma unroll
        for (int bj = 0; bj < 2; ++bj)
#pragma unroll
            for (int n = 0; n < 2; ++n) bv[bj][n] = bias ? *(const f32x4*)(bias + col0 + bj * HALF + n * 16) : (f32x4){0.f, 0.f, 0.f, 0.f};
#pragma unroll
        for (int ai = 0; ai < 2; ++ai)
#pragma unroll
            for (int m = 0; m < 4; ++m) { float* rowp = C + (size_t)(row0 + ai * HALF + m * 16) * ldc + col0;
#pragma unroll
                for (int bj = 0; bj < 2; ++bj)
#pragma unroll
                    for (int n = 0; n < 2; ++n) *(f32x4*)(rowp + bj * HALF + n * 16) = acc[ai][bj][m][n] + bv[bj][n]; }
    }
};
template <int ACT  > struct EpiBf16 {
    static constexpr bool PERM = true, AFTER_DRAIN = false;
    bf16_t* O; int ldc; const float* bias; int split_cols; size_t split_stride;
    __device__ __forceinline__ void operator()(const f32x4 (&acc)[2][2][4][2], const Unit& u, int wr, int wc, int fr, int fq) const {
        const int row0 = u.pm * BM + wr * 64 + fr; int colt = u.pn * BM; bf16_t* base = O;
        if (split_cols) { const int t = colt / split_cols; base += (size_t)t * split_stride; colt -= t * split_cols; }
        const int col0 = colt + wc * 32 + 8 * fq, bcol0 = u.pn * BM + wc * 32 + 8 * fq;
        f32x4 bv[2][2];
#pragma unroll
        for (int bj = 0; bj < 2; ++bj)
#pragma unroll
            for (int n = 0; n < 2; ++n) bv[bj][n] = bias ? *(const f32x4*)(bias + bcol0 + bj * HALF + 4 * n) : (f32x4){0.f, 0.f, 0.f, 0.f};
#pragma unroll
        for (int ai = 0; ai < 2; ++ai)
#pragma unroll
            for (int m = 0; m < 4; ++m) { bf16_t* rowp = base + (size_t)(row0 + ai * HALF + m * 16) * ldc + col0;
#pragma unroll
                for (int bj = 0; bj < 2; ++bj) { f32x4 v0 = acc[ai][bj][m][0] + bv[bj][0], v1 = acc[ai][bj][m][1] + bv[bj][1];
                    if (ACT == 1) { f32x2 a = gelu_pk((f32x2){v0[0], v0[1]}), b = gelu_pk((f32x2){v0[2], v0[3]}), c = gelu_pk((f32x2){v1[0], v1[1]}), d = gelu_pk((f32x2){v1[2], v1[3]});
                        v0 = (f32x4){a.x, a.y, b.x, b.y}; v1 = (f32x4){c.x, c.y, d.x, d.y}; }
                    if (ACT == 2) {
#pragma unroll
                        for (int j = 0; j < 4; ++j) { v0[j] = 0.5f * v0[j] * (1.0f + erff(v0[j] * 0.70710678f)); v1[j] = 0.5f * v1[j] * (1.0f + erff(v1[j] * 0.70710678f)); } }
                    u32x4 w; w.x = cvt_pk_bf16(v0[0], v0[1]); w.y = cvt_pk_bf16(v0[2], v0[3]); w.z = cvt_pk_bf16(v1[0], v1[1]); w.w = cvt_pk_bf16(v1[2], v1[3]);
                    *(u32x4*)(rowp + bj * HALF) = w; } }
    }
};
template <class Epi, class Sched, bool STAMP = false>
__device__ __forceinline__ void gemm_phase(PG8_LAS unsigned char* lds, const Gemm g, const Sched& S, const Epi& E, unsigned long long* stamps) {
    int tid_ = threadIdx.x; asm volatile("" : "+v"(tid_));
    const int tid = tid_, wid = __builtin_amdgcn_readfirstlane(tid >> 6), lane = tid & 63, wr = wid >> 2, wc = wid & 3, fr = lane & 15, fq = lane >> 4;
    const int K = g.K, nt = K / BK;
    int ts_lo = 0, ts_hi = 0, nts = 0; const unsigned long long rt_entry = STAMP ? (unsigned long long)wall_clock64() : 0ull;
#define PG8_STAMP() do { if (STAMP && wid == 0 && nts < 64) { const unsigned long long _c = (unsigned long long)clock64(); \
        ts_lo = (lane == nts) ? (int)(unsigned)_c : ts_lo; ts_hi = (lane == nts) ? (int)(unsigned)(_c >> 32) : ts_hi; ++nts; } } while (0)
    PG8_STAMP();
    unsigned voffA[2], voffB[2];
#pragma unroll
    for (int i = 0; i < 2; ++i) { int R, C; stage_rc(tid * 16 + i * 8192, R, C); const int Rb = Epi::PERM ? ((R & ~31) + perm32(R & 31)) : R;
        voffA[i] = (unsigned)(R * K + C) * 2u; voffB[i] = (unsigned)(Rb * K + C) * 2u; }
    const size_t kstep = (size_t)(BK * 2);
    const size_t hstep = (size_t)HALF * K * 2;
    const size_t tstep = 2 * hstep;
    const unsigned ldsw = (unsigned)wid * 1024u;
    const int aoff = lds_byte(wr * 64 + fr, fq * 8), boff = lds_byte(wc * 32 + fr, fq * 8);
#define PG8_SA(b, h) (((b) * 2 + (h)) * HTB)
#define PG8_SB(b, h) ((4 + (b) * 2 + (h)) * HTB)
#define PG8_STAGE(bufoff, gbase, voff) do { _Pragma("unroll") for (int _i = 0; _i < 2; ++_i) \
        __builtin_amdgcn_global_load_lds((const unsigned*)((const char*)(gbase) + (voff)[_i]), (PG8_LAS unsigned*)(lds + (bufoff) + ldsw + _i * 8192), 16, 0, 0); } while (0)
#define PG8_LDA(dst, b, h) do { _Pragma("unroll") for (int m = 0; m < 4; ++m) _Pragma("unroll") for (int k = 0; k < 2; ++k) dst[m][k] = *(const PG8_LAS bf16x8*)(lds + PG8_SA(b, h) + aoff + m * 2048 + k * 1024); } while (0)
#define PG8_LDB(dst, b, h) do { _Pragma("unroll") for (int n = 0; n < 2; ++n) _Pragma("unroll") for (int k = 0; k < 2; ++k) dst[n][k] = *(const PG8_LAS bf16x8*)(lds + PG8_SB(b, h) + boff + n * 2048 + k * 1024); } while (0)
#define PG8_MMA(ai, bj, At, Bt) do { __builtin_amdgcn_s_setprio(1); _Pragma("unroll") for (int m = 0; m < 4; ++m) _Pragma("unroll") for (int n = 0; n < 2; ++n) _Pragma("unroll") for (int k = 0; k < 2; ++k) \
        acc[ai][bj][m][n] = __builtin_amdgcn_mfma_f32_16x16x32_bf16(Bt[n][k], At[m][k], acc[ai][bj][m][n], 0, 0, 0); __builtin_amdgcn_s_setprio(0); } while (0)
#define PG8_WAIT_V(n) asm volatile("s_waitcnt vmcnt(" #n ")" ::: "memory")
#define PG8_WAIT_L(n) asm volatile("s_waitcnt lgkmcnt(" #n ")" ::: "memory")
#define PG8_BAR __builtin_amdgcn_s_barrier()
#define PG8_SCHED __builtin_amdgcn_sched_barrier(0)
    Unit cur, nxt; int ui = 0;
    if (!S.next(0, cur)) return;
    f32x4 acc[2][2][4][2];
#pragma unroll
    for (int a = 0; a < 2; ++a)
#pragma unroll
        for (int b = 0; b < 2; ++b)
#pragma unroll
            for (int m = 0; m < 4; ++m)
#pragma unroll
                for (int n = 0; n < 2; ++n) acc[a][b][m][n] = (f32x4){0.f, 0.f, 0.f, 0.f};
    bf16x8 At[4][2], B0[2][2], B1[2][2];
    const char* cA = (const char*)g.A + (size_t)cur.pm * tstep; const char* cB = (const char*)g.Bt + (size_t)cur.pn * tstep;
    S.a_ready(cur);
    PG8_STAGE(PG8_SB(0, 0), cB, voffB); PG8_STAGE(PG8_SA(0, 0), cA, voffA); PG8_STAGE(PG8_SB(0, 1), cB + hstep, voffB); PG8_STAGE(PG8_SA(0, 1), cA + hstep, voffA);
    if (wr == 1) PG8_BAR;
    PG8_WAIT_V(4); PG8_BAR;
    PG8_STAGE(PG8_SB(1, 0), cB + kstep, voffB); PG8_STAGE(PG8_SA(1, 0), cA + kstep, voffA); PG8_STAGE(PG8_SB(1, 1), cB + hstep + kstep, voffB);
    PG8_WAIT_V(6); PG8_BAR;
    PG8_STAMP();
    for (;;) {
        const bool has_next = S.next(ui + 1, nxt);
        const char* nA = has_next ? (const char*)g.A + (size_t)nxt.pm * tstep : cA; const char* nB = has_next ? (const char*)g.Bt + (size_t)nxt.pn * tstep : cB;
        for (int t = 0; t < nt; t += 2) {
            const bool last = (t == nt - 2);
            const char* a1 = cA + (size_t)(t + 1) * kstep;
            const char* a2 = last ? nA : cA + (size_t)(t + 2) * kstep; const char* b2 = last ? nB : cB + (size_t)(t + 2) * kstep;
            const char* a3 = a2 + kstep; const char* b3 = b2 + kstep;
            if (last && has_next) S.a_ready(nxt);
            PG8_LDB(B0, 0, 0); PG8_SCHED; PG8_LDA(At, 0, 0); PG8_STAGE(PG8_SA(1, 1), a1 + hstep, voffA);
            PG8_WAIT_L(8); PG8_BAR; PG8_WAIT_L(0); PG8_MMA(0, 0, At, B0); PG8_BAR; PG8_SCHED;
            PG8_LDB(B1, 0, 1); PG8_STAGE(PG8_SB(0, 0), b2, voffB);
            PG8_BAR; PG8_WAIT_L(0); PG8_MMA(0, 1, At, B1); PG8_BAR;
            PG8_LDA(At, 0, 1); PG8_STAGE(PG8_SA(0, 0), a2, voffA);
            PG8_BAR; PG8_WAIT_L(0); PG8_MMA(1, 0, At, B0); PG8_BAR; PG8_SCHED;
            PG8_STAGE(PG8_SB(0, 1), b2 + hstep, voffB);
            PG8_WAIT_V(6); PG8_BAR; PG8_MMA(1, 1, At, B1); PG8_BAR;
            PG8_LDB(B0, 1, 0); PG8_SCHED; PG8_LDA(At, 1, 0); PG8_STAGE(PG8_SA(0, 1), a2 + hstep, voffA);
            PG8_WAIT_L(8); PG8_BAR; PG8_WAIT_L(0); PG8_MMA(0, 0, At, B0); PG8_BAR; PG8_SCHED;
            PG8_LDB(B1, 1, 1); PG8_STAGE(PG8_SB(1, 0), b3, voffB);
            PG8_BAR; PG8_WAIT_L(0); PG8_MMA(0, 1, At, B1); PG8_BAR;
            PG8_LDA(At, 1, 1); PG8_STAGE(PG8_SA(1, 0), a3, voffA);
            PG8_BAR; PG8_WAIT_L(0); PG8_MMA(1, 0, At, B0); PG8_BAR; PG8_SCHED;
            PG8_STAGE(PG8_SB(1, 1), b3 + hstep, voffB);
            PG8_WAIT_V(6); PG8_BAR; PG8_MMA(1, 1, At, B1); PG8_BAR;
        }
        PG8_STAMP();
        if constexpr (!Epi::AFTER_DRAIN) { E(acc, cur, wr, wc, fr, fq); S.done(cur); }
        PG8_STAMP();
        if (!has_next) break;
#pragma unroll
        for (int a = 0; a < 2; ++a)
#pragma unroll
            for (int b = 0; b < 2; ++b)
#pragma unroll
                for (int m = 0; m < 4; ++m)
#pragma unroll
                    for (int n = 0; n < 2; ++n) acc[a][b][m][n] = (f32x4){0.f, 0.f, 0.f, 0.f};
        cur = nxt; cA = nA; cB = nB; ++ui;
    }
    PG8_WAIT_V(0);
    if (wr == 0) PG8_BAR;
    PG8_BAR;
    if constexpr (Epi::AFTER_DRAIN) { E.fused(acc, cur, wr, wc, fr, fq, lds, wid, lane); S.done(cur); }
    PG8_STAMP();
    if (STAMP && wid == 0) { stamps[lane] = lane < nts ? (((unsigned long long)(unsigned)ts_hi << 32) | (unsigned)ts_lo) : 0ull;
        if (lane == 62) stamps[62] = rt_entry; if (lane == 63) stamps[63] = (unsigned long long)wall_clock64(); }
#undef PG8_STAMP
#undef PG8_SA
#undef PG8_SB
#undef PG8_STAGE
#undef PG8_LDA
#undef PG8_LDB
#undef PG8_MMA
#undef PG8_WAIT_V
#undef PG8_WAIT_L
#undef PG8_BAR
#undef PG8_SCHED
}
}
#define XB_TMO      128
#define XB_XCNT(j)  (256  + 64 * (j))
#define XB_XSUB(j)  (1280 + 64 * (j))
#define XB_XGEN(j)  (2304 + 64 * (j))
#define XB_TOP      3328
#define XB_TOPGEN   3392
#define XCD_BAR_WORDS 3456
#define XB_SPIN_CAP (1u << 18)
#define LAS __attribute__((address_space(3)))

__device__ __forceinline__ unsigned xb_ld(unsigned* p)              { return __hip_atomic_load(p, __ATOMIC_RELAXED, __HIP_MEMORY_SCOPE_AGENT); }
__device__ __forceinline__ unsigned xb_add(unsigned* p, unsigned v) { return __hip_atomic_fetch_add(p, v, __ATOMIC_RELAXED, __HIP_MEMORY_SCOPE_AGENT); }
__device__ __forceinline__ unsigned xb_xcc_id() { return (unsigned)__builtin_amdgcn_s_getreg((3 << 11) | 20) & 0xFu; }
#define XB_SPIN(cond, bar) do { unsigned _sp = 0; while (cond) { __builtin_amdgcn_s_sleep(1); \
    if ((++_sp & 255u) == 0u) { if (xb_ld(&(bar)[XB_TMO])) break; if (_sp > XB_SPIN_CAP) { atomicAdd(&(bar)[XB_TMO], 1u); break; } } } } while (0)

struct XcdBarrier {
    unsigned* bar; unsigned x;
    volatile LAS unsigned* st;
};

__device__ __forceinline__ XcdBarrier xcd_barrier_post(unsigned* bar, volatile LAS unsigned* st) {
    XcdBarrier b; b.bar = bar; b.x = xb_xcc_id(); b.st = st;
    if (threadIdx.x == 0) (void)xb_add(&bar[XB_XCNT(b.x)], 1u);
    return b;
}
__device__ __forceinline__ void xcd_barrier_complete(unsigned* bar, unsigned x, unsigned& nloc, unsigned& nx) {
    const unsigned G = gridDim.x * gridDim.y * gridDim.z;
    unsigned sum, cnt, mine, sp = 0u;
    for (;;) {
        sum = 0u; cnt = 0u; mine = 0u;
#pragma unroll
        for (unsigned j = 0; j < 16; ++j) { const unsigned c = xb_ld(&bar[XB_XCNT(j)]); sum += c; cnt += (c > 0u) ? 1u : 0u; mine = (j == x) ? c : mine; }
        if (sum == G) break;
        __builtin_amdgcn_s_sleep(1);
        if ((++sp & 255u) == 0u) { if (xb_ld(&bar[XB_TMO])) break; if (sp > XB_SPIN_CAP) { atomicAdd(&bar[XB_TMO], 1u); break; } }
    }
    nloc = mine > 0u ? mine : 1u; nx = cnt > 0u ? cnt : 1u;
}

__device__ __forceinline__ void xcd_barrier(const XcdBarrier& b) {
    asm volatile("s_waitcnt vmcnt(0)" ::: "memory");
    __syncthreads();
    if (threadIdx.x == 0) {
        unsigned* bar = b.bar;
        __builtin_amdgcn_s_waitcnt(0);
        unsigned nloc = b.st[0], nx = b.st[1];
        if (nloc == 0u) { xcd_barrier_complete(bar, b.x, nloc, nx); b.st[0] = nloc; b.st[1] = nx; }
        const unsigned old = xb_add(&bar[XB_XSUB(b.x)], 1u);
        const unsigned gen = old / nloc;
        if (old + 1u == (gen + 1u) * nloc) {
            __builtin_amdgcn_fence(__ATOMIC_RELEASE, "agent");
            asm volatile("s_waitcnt vmcnt(0)" ::: "memory");
            const unsigned og = xb_add(&bar[XB_TOP], 1u);
            const unsigned tg = og / nx;
            if (og + 1u == (tg + 1u) * nx) xb_add(&bar[XB_TOPGEN], 1u);
            else XB_SPIN(xb_ld(&bar[XB_TOPGEN]) == tg, bar);
            __builtin_amdgcn_fence(__ATOMIC_ACQUIRE, "agent");
            xb_add(&bar[XB_XGEN(b.x)], 1u);
            asm volatile("s_waitcnt vmcnt(0)" ::: "memory");
        } else {
            XB_SPIN(xb_ld(&bar[XB_XGEN(b.x)]) == gen, bar);
            __builtin_amdgcn_fence(__ATOMIC_ACQUIRE, "agent");
            asm volatile("s_waitcnt vmcnt(0)" ::: "memory");
        }
    }
    __syncthreads();
}

namespace mk {
using pg8::bf16_t; using pg8::bf16x8; using pg8::f32x4; using pg8::u32x4;
typedef unsigned u32x2 __attribute__((ext_vector_type(2)));
typedef __bf16 bf16x2_t __attribute__((ext_vector_type(2)));
typedef LAS unsigned char* lds_t;

constexpr int DM = 1024, NLAT = 16384, NROW = 16896;
constexpr int OFF_B = 512, OFF_C = 1024, OFF_D = 2056, INC = 3208, NP = 3328;
constexpr int NCH = 132, NSLOT = 16 * NCH;
constexpr int NEXP = 16384;

constexpr size_t WS_CTL  = 0;
constexpr size_t WS_MOD  = 65536;
constexpr size_t WS_WIN  = WS_MOD + 147456;
constexpr size_t WS_WOUT = WS_WIN + 2ull * NP * DM * 2;
constexpr size_t WS_WQ   = WS_WOUT + 2ull * DM * DM * 2;
constexpr size_t WS_H    = WS_WQ + 2ull * 2048 * DM * 2;
constexpr size_t WS_ACT  = WS_H + (size_t)NROW * DM * 4;
constexpr size_t WS_UB   = WS_ACT + (size_t)NROW * DM * 2;
constexpr size_t WS_VB   = WS_UB + (size_t)NEXP * DM * 2;
constexpr size_t WS_SU   = WS_UB + (size_t)NEXP * DM;
constexpr size_t WS_SV   = WS_VB + (size_t)NEXP * DM;
constexpr size_t WS_P    = WS_VB + (size_t)NEXP * DM * 2;
constexpr size_t WS_Q    = WS_P;
constexpr size_t WS_SELI = WS_Q + (size_t)NROW * 2048 * 2;
constexpr size_t WS_SELG = WS_SELI + (size_t)NROW * 128 * 4;
constexpr size_t WS_MST  = WS_P + (size_t)NROW * NP * 2;
constexpr size_t WS_MCD  = WS_MST + (size_t)NSLOT * 8192 * 4;
constexpr size_t WS_RG   = WS_MCD + 16384;
constexpr size_t WS_RJ   = WS_RG + (size_t)NSLOT * 8192;
constexpr size_t WS_RY   = WS_RJ + (size_t)NSLOT * 16384;
constexpr size_t WS_RL   = WS_RY + (size_t)NSLOT * 8192;
constexpr size_t WS_RH   = WS_RL + (size_t)NSLOT * 8192;
constexpr size_t WS_BON  = WS_RH + (size_t)NSLOT * 8192;
constexpr size_t WS_END  = WS_BON + (size_t)NROW * 8 * 4;
static_assert(WS_SELG + (size_t)NROW * 128 * 4 <= WS_MST, "Q + selections must fit in P's region");

constexpr int LDS_BYTES = 157440;
constexpr int LDS_XB = 157184;

struct Args { const float* in[42]; float* out; unsigned char* ws; int ph_lo, ph_hi; };

struct Ctx {
    const float* const* in; float* out; unsigned char* ws; lds_t lds;
    int tid, lane, wid, bid, G;
};

__device__ __forceinline__ float bf2f(unsigned short x) { return __uint_as_float(((unsigned)x) << 16); }
__device__ __forceinline__ float bflo(unsigned w) { return __uint_as_float(w << 16); }
__device__ __forceinline__ float bfhi(unsigned w) { return __uint_as_float(w & 0xffff0000u); }
typedef __bf16 bf16pair_t __attribute__((ext_vector_type(2)));
__device__ __forceinline__ unsigned pk2(float lo, float hi) { const bf16pair_t v = {(__bf16)lo, (__bf16)hi}; return __builtin_bit_cast(unsigned, v); }
__device__ __forceinline__ unsigned short f2bf(float f) { return (unsigned short)(pk2(f, 0.f) & 0xffffu); }
__device__ __forceinline__ float wave_sum(float v) {
#pragma unroll
    for (int o = 1; o < 64; o <<= 1) v += __shfl_xor(v, o);
    return v;
}
__device__ __forceinline__ float wave_incl_scan(float v, int lane) {
#pragma unroll
    for (int o = 1; o < 64; o <<= 1) { const float t = __shfl_up(v, o); v += (lane >= o) ? t : 0.f; }
    return v;
}
__device__ __forceinline__ float sigm(float x) { return 1.f / (1.f + expf(-x)); }
__device__ __forceinline__ float silu(float x) { return x / (1.f + expf(-x)); }
__device__ __forceinline__ float softplus(float x) { return fmaxf(x, 0.f) + log1pf(expf(-fabsf(x))); }
__device__ __forceinline__ float gelu_tanh(float x) { const float u = 0.7978845608028654f * (x + 0.044715f * x * x * x); return 0.5f * x * (1.f + tanhf(u)); }
__device__ __forceinline__ float dot2bf(unsigned a, unsigned b, float acc) { return __builtin_amdgcn_fdot2_f32_bf16(__builtin_bit_cast(bf16x2_t, a), __builtin_bit_cast(bf16x2_t, b), acc, false); }

struct ChunkInfo { int row0, lo, hi, b, tc, isctx; };
__device__ __forceinline__ ChunkInfo chunk_info(int gc) {
    ChunkInfo c; c.row0 = gc * 64;
    if (gc < 256) { c.b = gc >> 7; c.tc = gc & 127; c.isctx = 0; c.lo = c.b * 8192; c.hi = c.lo + 8192; }
    else { const int q = gc - 256; c.b = q >> 2; c.tc = q & 3; c.isctx = 1; c.lo = NLAT + c.b * 256; c.hi = c.lo + 256; }
    return c;
}
__device__ __forceinline__ int cpos_of(const ChunkInfo& c, int d) { return c.isctx ? (d ? 3 - c.tc : c.tc) : (d ? 4 + 127 - c.tc : 4 + c.tc); }
__device__ __forceinline__ int slot_of(int b, int h, int d, int cpos) { return ((b * 4 + h) * 2 + d) * NCH + cpos; }

template <int MT, int NT, int KS, class Epi>
__device__ __forceinline__ void blk_mma(const LAS bf16_t* A, int lda, const LAS bf16_t* Bt, int ldb, int wid, int lane, Epi epi) {
    const int fr = lane & 15, fq = lane >> 4;
    for (int tt = wid; tt < MT * NT; tt += 8) {
        const int tm = tt / NT, tn = tt % NT;
        f32x4 acc = {0.f, 0.f, 0.f, 0.f};
#pragma unroll
        for (int ks = 0; ks < KS; ++ks) {
            const bf16x8 a = *(const LAS bf16x8*)(A + (tm * 16 + fr) * lda + ks * 32 + fq * 8);
            const bf16x8 b = *(const LAS bf16x8*)(Bt + (tn * 16 + fr) * ldb + ks * 32 + fq * 8);
            acc = __builtin_amdgcn_mfma_f32_16x16x32_bf16(a, b, acc, 0, 0, 0);
        }
        epi(tm * 16 + fq * 4, tn * 16 + fr, acc);
    }
}
template <int MT, int NT, int KS, class Epi>
__device__ __forceinline__ void blk_mma2(const LAS bf16_t* A1, const LAS bf16_t* B1, const LAS bf16_t* A2, const LAS bf16_t* B2, int ld, int wid, int lane, Epi epi) {
    const int fr = lane & 15, fq = lane >> 4;
    for (int tt = wid; tt < MT * NT; tt += 8) {
        const int tm = tt / NT, tn = tt % NT;
        f32x4 acc1 = {0.f, 0.f, 0.f, 0.f}, acc2 = {0.f, 0.f, 0.f, 0.f};
#pragma unroll
        for (int ks = 0; ks < KS; ++ks) {
            const bf16x8 a1 = *(const LAS bf16x8*)(A1 + (tm * 16 + fr) * ld + ks * 32 + fq * 8);
            const bf16x8 b1 = *(const LAS bf16x8*)(B1 + (tn * 16 + fr) * ld + ks * 32 + fq * 8);
            acc1 = __builtin_amdgcn_mfma_f32_16x16x32_bf16(a1, b1, acc1, 0, 0, 0);
            const bf16x8 a2 = *(const LAS bf16x8*)(A2 + (tm * 16 + fr) * ld + ks * 32 + fq * 8);
            const bf16x8 b2 = *(const LAS bf16x8*)(B2 + (tn * 16 + fr) * ld + ks * 32 + fq * 8);
            acc2 = __builtin_amdgcn_mfma_f32_16x16x32_bf16(a2, b2, acc2, 0, 0, 0);
        }
        epi(tm * 16 + fq * 4, tn * 16 + fr, acc1, acc2);
    }
}

__device__ __forceinline__ void transpose_item(const float* W, int K, int N, int nblk, bf16_t* WT, LAS float* scr, int item, int lane) {
    const int kb = item / nblk, nb = item % nblk, k0 = 64 * kb, n0 = 32 * nb;
    const int nn = n0 + (lane & 31);
#pragma unroll 8
    for (int i = 0; i < 32; ++i) { const int kk = 2 * i + (lane >> 5); scr[kk * 33 + (lane & 31)] = (nn < N) ? W[(size_t)(k0 + kk) * N + nn] : 0.f; }
    asm volatile("s_waitcnt lgkmcnt(0)" ::: "memory");
    const int c = lane & 7;
#pragma unroll
    for (int j = 0; j < 4; ++j) { const int n = (lane >> 3) + 8 * j; const LAS float* s = scr + (8 * c) * 33 + n;
        u32x4 o; o.x = pk2(s[0 * 33], s[1 * 33]); o.y = pk2(s[2 * 33], s[3 * 33]); o.z = pk2(s[4 * 33], s[5 * 33]); o.w = pk2(s[6 * 33], s[7 * 33]);
        *(u32x4*)(WT + (size_t)(n0 + n) * K + k0 + 8 * c) = o; }
    asm volatile("s_waitcnt lgkmcnt(0)" ::: "memory");
}
__device__ __forceinline__ float wave_maxf(float v) {
#pragma unroll
    for (int o = 1; o < 64; o <<= 1) v = fmaxf(v, __shfl_xor(v, o));
    return v;
}
__device__ __forceinline__ void convert_tables(const Ctx& C, int layer) {
    const float* U = C.in[39] + (size_t)layer * NEXP * DM; const float* V = C.in[40] + (size_t)layer * NEXP * DM;
    unsigned char* UB = C.ws + WS_UB; unsigned char* VB = C.ws + WS_VB; float* SU = (float*)(C.ws + WS_SU); float* SV = (float*)(C.ws + WS_SV);
    for (int r = C.bid * 8 + C.wid; r < 2 * NEXP; r += C.G * 8) {
        const bool isv = r >= NEXP; const int row = isv ? r - NEXP : r;
        const float* src = (isv ? V : U) + (size_t)row * DM + 16 * C.lane;
        f32x4 x[4]; float m = 0.f;
#pragma unroll
        for (int k = 0; k < 4; ++k) { x[k] = *(const f32x4*)(src + 4 * k); m = fmaxf(fmaxf(m, fmaxf(fabsf(x[k].x), fabsf(x[k].y))), fmaxf(fabsf(x[k].z), fabsf(x[k].w))); }
        m = wave_maxf(m);
        const float sc = m > 0.f ? 224.f / m : 1.f;
        u32x4 o;
#pragma unroll
        for (int k = 0; k < 4; ++k) { int w = __builtin_amdgcn_cvt_pk_fp8_f32(x[k].x * sc, x[k].y * sc, 0, false); w = __builtin_amdgcn_cvt_pk_fp8_f32(x[k].z * sc, x[k].w * sc, w, true); o[k] = (unsigned)w; }
        *(u32x4*)((isv ? VB : UB) + (size_t)row * DM + 16 * C.lane) = o;
        if (C.lane == 0) (isv ? SV : SU)[row] = m > 0.f ? m * (1.f / 224.f) : 1.f;
    }
}
__device__ __forceinline__ void ph_prologue(const Ctx& C) {
    const int gw = C.bid * 8 + C.wid, NGW = C.G * 8;
    {
        LAS float* scr = (LAS float*)(C.lds + C.wid * 16384);
        bf16_t* WIN = (bf16_t*)(C.ws + WS_WIN); bf16_t* WOUT = (bf16_t*)(C.ws + WS_WOUT); bf16_t* WQ = (bf16_t*)(C.ws + WS_WQ);
        for (int it = gw; it < 6400; it += NGW) {
            const int layer = it / 3200; int r = it % 3200;
            if (r < 1664) { transpose_item(C.in[8] + (size_t)layer * DM * INC, DM, INC, 104, WIN + (size_t)layer * NP * DM, scr, r, C.lane); continue; } r -= 1664;
            if (r < 512) { transpose_item(C.in[9] + (size_t)layer * DM * DM, DM, DM, 32, WOUT + (size_t)layer * DM * DM, scr, r, C.lane); continue; } r -= 512;
            transpose_item(C.in[36] + (size_t)layer * DM * 2048, DM, 2048, 64, WQ + (size_t)layer * 2048 * DM, scr, r, C.lane);
        }
    }
    __syncthreads();
    {
        LAS float* sv = (LAS float*)C.lds;
        LAS float* red = (LAS float*)(C.lds + 12288);
        for (int i = C.tid; i < 3 * 1024; i += 512) { const int w = i >> 10, k = i & 1023; const float x = (w < 2) ? C.in[1][w * 1024 + k] : C.in[3][k]; sv[i] = silu(x); }
        __syncthreads();
        float* MOD = (float*)(C.ws + WS_MOD);
        for (int it = C.bid; it < 192; it += C.G) {
            const int layer = it / 96, col0 = (it % 96) * 64, col = C.tid & 63, kg = C.tid >> 6;
            const float* W = C.in[4] + (size_t)layer * DM * 6144 + col0 + col;
            float a0 = 0.f, a1 = 0.f, a2 = 0.f;
#pragma unroll 8
            for (int k = kg * 128; k < kg * 128 + 128; ++k) { const float w = W[(size_t)k * 6144]; a0 += sv[k] * w; a1 += sv[1024 + k] * w; a2 += sv[2048 + k] * w; }
            red[(kg * 3 + 0) * 64 + col] = a0; red[(kg * 3 + 1) * 64 + col] = a1; red[(kg * 3 + 2) * 64 + col] = a2;
            __syncthreads();
            if (C.tid < 192) { const int w = C.tid >> 6, c2 = C.tid & 63; float s = 0.f;
#pragma unroll
                for (int g = 0; g < 8; ++g) s += red[(g * 3 + w) * 64 + c2];
                MOD[((size_t)layer * 3 + w) * 6144 + col0 + c2] = s + C.in[5][layer * 6144 + col0 + c2]; }
            __syncthreads();
        }
    }
    {
        float* H = (float*)(C.ws + WS_H);
        const size_t n4 = (size_t)NROW * 256;
        for (size_t i = (size_t)C.bid * 512 + C.tid; i < n4; i += (size_t)C.G * 512) {
            const int row = (int)(i >> 8), c4 = (int)(i & 255) * 4;
            f32x4 v;
            if (row < NLAT) {
                v = *(const f32x4*)(C.in[0] + (size_t)row * DM + c4);
                const int t = row & 8191, quarter = c4 >> 8; const float pos = (quarter < 2) ? (float)(t >> 6) : (float)(t & 63);
                float e[4];
#pragma unroll
                for (int j = 0; j < 4; ++j) { const int jj = (c4 & 255) + j; const float fr = exp2f(-(float)jj * (13.287712379549449f / 256.f)); const float a = pos * fr; e[j] = (quarter & 1) ? cosf(a) : sinf(a); }
                v.x += e[0]; v.y += e[1]; v.z += e[2]; v.w += e[3];
            } else v = *(const f32x4*)(C.in[2] + (size_t)(row - NLAT) * DM + c4);
            *(f32x4*)(H + (size_t)row * DM + c4) = v;
        }
    }
    convert_tables(C, 0);
}

struct Row16 { float v[16]; };
__device__ __forceinline__ Row16 load_row16(const float* p, int lane) {
    Row16 r; const f32x4 a = *(const f32x4*)(p + 8 * lane), b = *(const f32x4*)(p + 8 * lane + 4), c = *(const f32x4*)(p + 512 + 8 * lane), d = *(const f32x4*)(p + 512 + 8 * lane + 4);
    r.v[0] = a.x; r.v[1] = a.y; r.v[2] = a.z; r.v[3] = a.w; r.v[4] = b.x; r.v[5] = b.y; r.v[6] = b.z; r.v[7] = b.w;
    r.v[8] = c.x; r.v[9] = c.y; r.v[10] = c.z; r.v[11] = c.w; r.v[12] = d.x; r.v[13] = d.y; r.v[14] = d.z; r.v[15] = d.w; return r;
}
__device__ __forceinline__ void store_row16_f32(float* p, int lane, const Row16& r) {
    *(f32x4*)(p + 8 * lane) = (f32x4){r.v[0], r.v[1], r.v[2], r.v[3]}; *(f32x4*)(p + 8 * lane + 4) = (f32x4){r.v[4], r.v[5], r.v[6], r.v[7]};
    *(f32x4*)(p + 512 + 8 * lane) = (f32x4){r.v[8], r.v[9], r.v[10], r.v[11]}; *(f32x4*)(p + 512 + 8 * lane + 4) = (f32x4){r.v[12], r.v[13], r.v[14], r.v[15]};
}
__device__ __forceinline__ void store_row16_bf16(bf16_t* p, int lane, const Row16& r) {
    u32x4 a, b; a.x = pk2(r.v[0], r.v[1]); a.y = pk2(r.v[2], r.v[3]); a.z = pk2(r.v[4], r.v[5]); a.w = pk2(r.v[6], r.v[7]);
    b.x = pk2(r.v[8], r.v[9]); b.y = pk2(r.v[10], r.v[11]); b.z = pk2(r.v[12], r.v[13]); b.w = pk2(r.v[14], r.v[15]);
    *(u32x4*)(p + 8 * lane) = a; *(u32x4*)(p + 512 + 8 * lane) = b;
}
__device__ __forceinline__ Row16 norm_mod_row(const Row16& x, const float* g, const float* shift, const float* scale, int lane) {
    float ss = 0.f;
#pragma unroll
    for (int i = 0; i < 16; ++i) ss += x.v[i] * x.v[i];
    const float rs = rsqrtf(wave_sum(ss) * (1.f / 1024.f) + 1e-6f);
    const Row16 gg = load_row16(g, lane), sh = load_row16(shift, lane), sc = load_row16(scale, lane);
    Row16 o;
#pragma unroll
    for (int i = 0; i < 16; ++i) o.v[i] = (x.v[i] * rs * gg.v[i]) * (1.f + sc.v[i]) + sh.v[i];
    return o;
}
__device__ __forceinline__ int which_of(int row) { return row < 8192 ? 0 : (row < NLAT ? 1 : 2); }
__device__ __forceinline__ void ph_norm(const Ctx& C, int layer, const float* gain, int sidx, int nrows) {
    const float* H = (const float*)(C.ws + WS_H); bf16_t* ACT = (bf16_t*)(C.ws + WS_ACT); const float* MOD = (const float*)(C.ws + WS_MOD);
    for (int row = C.bid * 8 + C.wid; row < nrows; row += C.G * 8) {
        const float* m = MOD + ((size_t)layer * 3 + which_of(row)) * 6144;
        const Row16 x = load_row16(H + (size_t)row * DM, C.lane);
        const Row16 o = norm_mod_row(x, gain, m + sidx * 1024, m + (sidx + 1) * 1024, C.lane);
        store_row16_bf16(ACT + (size_t)row * DM, C.lane, o);
    }
}
struct EpiResid {
    static constexpr bool PERM = false, AFTER_DRAIN = false;
    float* H; const float* modl;
    __device__ __forceinline__ void operator()(const f32x4 (&acc)[2][2][4][2], const pg8::Unit& u, int wr, int wc, int fr, int fq) const {
        const int row0 = u.pm * 256 + wr * 64 + fr, col0 = u.pn * 256 + wc * 32 + 4 * fq;
        const int which = u.pm < 32 ? 0 : (u.pm < 64 ? 1 : 2);
        const float* gate = modl + ((size_t)which * 6 + 2) * 1024;
        f32x4 gv[2][2];
#pragma unroll
        for (int bj = 0; bj < 2; ++bj)
#pragma unroll
            for (int n = 0; n < 2; ++n) gv[bj][n] = *(const f32x4*)(gate + col0 + bj * 128 + n * 16);
#pragma unroll
        for (int ai = 0; ai < 2; ++ai)
#pragma unroll
            for (int m = 0; m < 4; ++m) { float* rowp = H + (size_t)(row0 + ai * 128 + m * 16) * DM + col0;
#pragma unroll
                for (int bj = 0; bj < 2; ++bj)
#pragma unroll
                    for (int n = 0; n < 2; ++n) { f32x4* p = (f32x4*)(rowp + bj * 128 + n * 16); *p = *p + gv[bj][n] * acc[ai][bj][m][n]; } }
    }
};

__device__ __forceinline__ void item_conformer(const Ctx& C, int layer, int gc) {
    const ChunkInfo ci = chunk_info(gc);
    const bf16_t* P = (const bf16_t*)(C.ws + WS_P); bf16_t* YC = (bf16_t*)(C.ws + WS_ACT);
    LAS bf16_t* HG = (LAS bf16_t*)C.lds;
    LAS float* CO = (LAS float*)(C.lds + 49152);
    for (int e = C.tid; e < 94 * 128; e += 512) {
        const int rr = e >> 7, cp = e & 127, grow = ci.row0 - 15 + rr;
        unsigned o = 0u;
        if (grow >= ci.lo && grow < ci.hi) {
            const unsigned v = *(const unsigned*)(P + (size_t)grow * NP + 2 * cp), g = *(const unsigned*)(P + (size_t)grow * NP + 256 + 2 * cp);
            o = pk2(bflo(v) * sigm(bflo(g)), bfhi(v) * sigm(bfhi(g)));
        }
        *(LAS unsigned*)(HG + rr * 256 + 2 * cp) = o;
    }
    __syncthreads();
    {
        const int c = C.tid & 255, half = C.tid >> 8;
        const float* cw = C.in[10] + (size_t)layer * 31 * 256 + c;
        float w[31];
#pragma unroll
        for (int j = 0; j < 31; ++j) w[j] = cw[j * 256];
        const float bias = C.in[11][layer * 256 + c];
        for (int tt = 0; tt < 32; ++tt) {
            const int t = half * 32 + tt; float acc = bias;
#pragma unroll
            for (int j = 0; j < 31; ++j) acc += w[j] * bf2f(HG[(t + j) * 256 + c]);
            CO[t * 256 + c] = acc;
        }
    }
    __syncthreads();
    {
        const float* lg = C.in[12] + layer * 256 + 4 * C.lane; const float* lb = C.in[13] + layer * 256 + 4 * C.lane;
        const f32x4 g4 = *(const f32x4*)lg, b4 = *(const f32x4*)lb;
        for (int i = 0; i < 8; ++i) {
            const int t = C.wid * 8 + i;
            const f32x4 x = *(const LAS f32x4*)(CO + t * 256 + 4 * C.lane);
            const float mean = wave_sum((x.x + x.y) + (x.z + x.w)) * (1.f / 256.f);
            const f32x4 d = x - mean;
            const float var = wave_sum((d.x * d.x + d.y * d.y) + (d.z * d.z + d.w * d.w)) * (1.f / 256.f);
            const float rs = rsqrtf(var + 1e-5f);
            const f32x4 y = d * rs * g4 + b4;
            u32x2 o; o.x = pk2(silu(y.x), silu(y.y)); o.y = pk2(silu(y.z), silu(y.w));
            *(u32x2*)(YC + (size_t)(ci.row0 + t) * DM + 4 * C.lane) = o;
        }
    }
    __syncthreads();
}

__device__ __forceinline__ void item_chunkmlp(const Ctx& C, int layer, int gb) {
    const int row0 = gb * 128;
    const bf16_t* P = (const bf16_t*)(C.ws + WS_P); bf16_t* YC = (bf16_t*)(C.ws + WS_ACT);
    LAS bf16_t* VNT = (LAS bf16_t*)C.lds;
    LAS bf16_t* WS = (LAS bf16_t*)(C.lds + 69632);
    {
        const f32x4 g4 = *(const f32x4*)(C.in[14] + layer * 256 + 4 * C.lane), b4 = *(const f32x4*)(C.in[15] + layer * 256 + 4 * C.lane);
        for (int i = 0; i < 16; ++i) {
            const int j = C.wid * 16 + i;
            const u32x2 raw = *(const u32x2*)(P + (size_t)(row0 + j) * NP + 768 + 4 * C.lane);
            const f32x4 x = {bflo(raw.x), bfhi(raw.x), bflo(raw.y), bfhi(raw.y)};
            const float mean = wave_sum((x.x + x.y) + (x.z + x.w)) * (1.f / 256.f);
            const f32x4 d = x - mean;
            const float var = wave_sum((d.x * d.x + d.y * d.y) + (d.z * d.z + d.w * d.w)) * (1.f / 256.f);
            const f32x4 y = d * rsqrtf(var + 1e-5f) * g4 + b4;
            VNT[(4 * C.lane + 0) * 136 + j] = f2bf(y.x); VNT[(4 * C.lane + 1) * 136 + j] = f2bf(y.y);
            VNT[(4 * C.lane + 2) * 136 + j] = f2bf(y.z); VNT[(4 * C.lane + 3) * 136 + j] = f2bf(y.w);
        }
    }
    for (int h = 0; h < 4; ++h) {
        const float* ws = C.in[16] + ((size_t)layer * 4 + h) * 128 * 128;
        for (int e = C.tid; e < 4096; e += 512) { const int i = e >> 5, j4 = (e & 31) * 4; const f32x4 w = *(const f32x4*)(ws + i * 128 + j4);
            u32x2 o; o.x = pk2(w.x, w.y); o.y = pk2(w.z, w.w); *(LAS u32x2*)(WS + i * 136 + j4) = o; }
        __syncthreads();
        const float* bs = C.in[17] + ((size_t)layer * 4 + h) * 128;
        blk_mma<8, 4, 4>(WS, 136, VNT + h * 64 * 136, 136, C.wid, C.lane, [=](int r0, int col, const f32x4& acc) {
#pragma unroll
            for (int jj = 0; jj < 4; ++jj) { const int i = r0 + jj; const size_t row = (size_t)(row0 + i);
                const float u = bf2f(P[row * NP + 512 + h * 64 + col]);
                YC[row * DM + 256 + h * 64 + col] = f2bf((acc[jj] + bs[i]) * u); }
        });
        __syncthreads();
    }
}

__device__ __forceinline__ void item_mamba_local(const Ctx& C, int layer, int gc) {
    const ChunkInfo ci = chunk_info(gc);
    const bf16_t* P = (const bf16_t*)(C.ws + WS_P);
    float* MST = (float*)(C.ws + WS_MST); float* MCD = (float*)(C.ws + WS_MCD);
    LAS float* DA = (LAS float*)C.lds;
    LAS float* DT = (LAS float*)(C.lds + 2048);
    LAS float* FAC = (LAS float*)(C.lds + 4096);
    LAS bf16_t* XDT = (LAS bf16_t*)(C.lds + 8192);
    LAS bf16_t* BTT = (LAS bf16_t*)(C.lds + 8192 + 73728);
    {
        const int s = C.lane, dh = C.wid, d = dh >> 2, h = dh & 3;
        const float raw = bf2f(P[(size_t)(ci.row0 + s) * NP + OFF_C + 1024 + dh]);
        const float dt = softplus(raw + C.in[20][layer * 8 + dh]);
        const float da = dt * (-expf(C.in[21][layer * 8 + dh]));
        const float incl = wave_incl_scan(da, s), total = __shfl(incl, 63);
        DT[dh * 64 + s] = dt; DA[dh * 64 + s] = da;
        FAC[dh * 64 + s] = d ? expf(incl - da) : expf(total - incl);
        if (s == 0) MCD[slot_of(ci.b, h, d, cpos_of(ci, d))] = expf(total);
    }
    __syncthreads();
    {
        const int cp = C.tid & 255, half = C.tid >> 8, c0 = 2 * cp;
        const float* cw = C.in[18] + (size_t)layer * 5 * 768 + c0; const float* cb = C.in[19] + layer * 768 + c0;
        float w0[5], w1[5];
#pragma unroll
        for (int j = 0; j < 5; ++j) { w0[j] = cw[j * 768]; w1[j] = cw[j * 768 + 1]; }
        const float b0 = cb[0], b1 = cb[1];
        const int s0 = half * 32;
        unsigned win[5];
#pragma unroll
        for (int j = 0; j < 4; ++j) { const int row = ci.row0 + s0 - 2 + j; win[j + 1] = (row >= ci.lo && row < ci.hi) ? *(const unsigned*)(P + (size_t)row * NP + OFF_C + 256 + c0) : 0u; }
        for (int tt = 0; tt < 32; ++tt) {
            const int s = s0 + tt;
#pragma unroll
            for (int j = 0; j < 4; ++j) win[j] = win[j + 1];
            { const int row = ci.row0 + s + 2; win[4] = (row >= ci.lo && row < ci.hi) ? *(const unsigned*)(P + (size_t)row * NP + OFF_C + 256 + c0) : 0u; }
            float a0 = b0, a1 = b1;
#pragma unroll
            for (int j = 0; j < 5; ++j) { a0 += w0[j] * bflo(win[j]); a1 += w1[j] * bfhi(win[j]); }
            a0 = silu(a0); a1 = silu(a1);
            if (c0 < 256) { const int h = c0 >> 6;
#pragma unroll
                for (int d = 0; d < 2; ++d) { const float f = DT[(d * 4 + h) * 64 + s] * FAC[(d * 4 + h) * 64 + s];
                    XDT[(d * 256 + c0) * 72 + s] = f2bf(a0 * f); XDT[(d * 256 + c0 + 1) * 72 + s] = f2bf(a1 * f); }
            } else { const int q = c0 - 256; BTT[q * 72 + s] = f2bf(a0); BTT[(q + 1) * 72 + s] = f2bf(a1); }
        }
    }
    __syncthreads();
    for (int hd = 0; hd < 8; ++hd) {
        const int d = hd >> 2, h = hd & 3;
        float* dst = MST + (size_t)slot_of(ci.b, h, d, cpos_of(ci, d)) * 8192;
        blk_mma<4, 8, 2>(XDT + (d * 256 + h * 64) * 72, 72, BTT + (h >> 1) * 128 * 72, 72, C.wid, C.lane, [=](int r0, int col, const f32x4& acc) {
#pragma unroll
            for (int jj = 0; jj < 4; ++jj) dst[(r0 + jj) * 128 + col] = acc[jj];
        });
    }
    __syncthreads();
}


#ifndef MK_DIAG2
#define MK_DIAG2 0
#endif
#if MK_DIAG2
#define DBGF(stage, cond) do { if (cond) atomicOr((unsigned*)(C.ws + 32768) + (stage), 1u); } while (0)
#define DBGL(stage, cond) do { if (cond) atomicOr(dbgflags + (stage), 1u); } while (0)
#else
#define DBGF(stage, cond) do {} while (0)
#define DBGL(stage, cond) do {} while (0)
#endif
__device__ __forceinline__ bool badv(float x, float lim) { return !(fabsf(x) < lim); }
__device__ __forceinline__ void tri_inverse(const LAS float* ABf, LAS float* Tf, LAS float* Rt, LAS bf16_t* TT, int tid, int wid, int lane) {
    if (wid == 0) {
        const int bi = lane >> 4, j = lane & 15; const LAS float* Ab = ABf + (16 * bi) * 68 + 16 * bi;
        float col[16];
#pragma unroll
        for (int r = 0; r < 16; ++r) { float acc = (r == j) ? 1.f : 0.f;
#pragma unroll
            for (int s = 0; s < r; ++s) acc -= Ab[r * 68 + s] * col[s];
            col[r] = acc; }
#pragma unroll
        for (int r = 0; r < 16; ++r) Tf[(16 * bi + r) * 68 + 16 * bi + j] = col[r];
    } else {
        for (int e = tid - 64; e < 64 * 64; e += 448) { const int t = e >> 6, s2 = e & 63; if ((s2 >> 4) > (t >> 4)) Tf[t * 68 + s2] = 0.f; }
    }
    __syncthreads();
#pragma unroll
    for (int i = 1; i < 4; ++i) {
        const int nc = 16 * i;
        for (int e = tid; e < 16 * nc; e += 512) { const int r = e / nc, c = e % nc; float s0 = 0.f, s1 = 0.f;
#pragma unroll
            for (int s2 = 0; s2 < nc; s2 += 2) { s0 += ABf[(nc + r) * 68 + s2] * Tf[s2 * 68 + c]; s1 += ABf[(nc + r) * 68 + s2 + 1] * Tf[(s2 + 1) * 68 + c]; }
            Rt[r * 68 + c] = -(s0 + s1); }
        __syncthreads();
        for (int e = tid; e < 16 * nc; e += 512) { const int r = e / nc, c = e % nc; float s0 = 0.f, s1 = 0.f;
#pragma unroll
            for (int r2 = 0; r2 < 16; r2 += 2) { s0 += Tf[(nc + r) * 68 + nc + r2] * Rt[r2 * 68 + c]; s1 += Tf[(nc + r) * 68 + nc + r2 + 1] * Rt[(r2 + 1) * 68 + c]; }
            Tf[(nc + r) * 68 + c] = s0 + s1; }
        __syncthreads();
    }
    for (int e = tid; e < 4096; e += 512) { const int t = e >> 6, s2 = e & 63; TT[t * 72 + s2] = f2bf(Tf[t * 68 + s2]); }
}
constexpr int D1_LW = 0, D1_CS = 17408, D1_AA = 34816, D1_RB = 52224, D1_KB = 61440, D1_VB = 70656, D1_TW = 79872, D1_AD = 89088, D1_W2T = 98304, D1_A2T = 107520;
constexpr int D1_Y = 82944;
constexpr int D1_ABF = 0, D1_AK = 17408, D1_ARK = 26624, D1_ARB = 35840, D1_TT = 45056, D1_W1T = 54272, D1_AKVT = 63488, D1_W2TT = 72704;
constexpr int D1_GL = 156672;
__device__ __forceinline__ void item_rwkv_local(const Ctx& C, int layer, int it) {
    const int gc = it >> 3, hd = it & 7, h = hd & 3, d = hd >> 2;
    const ChunkInfo ci = chunk_info(gc);
    const int slot = slot_of(ci.b, h, d, cpos_of(ci, d));
    const bf16_t* P = (const bf16_t*)(C.ws + WS_P);
    const float* mup = C.in[24] + layer * 1152; const float* mun = C.in[25] + layer * 1152;
    lds_t L = C.lds;
    LAS float* LW = (LAS float*)(L + D1_LW); LAS float* CS = (LAS float*)(L + D1_CS); LAS float* AA = (LAS float*)(L + D1_AA); LAS float* GL = (LAS float*)(L + D1_GL);
    LAS bf16_t* Rb = (LAS bf16_t*)(L + D1_RB); LAS bf16_t* Kb = (LAS bf16_t*)(L + D1_KB); LAS bf16_t* Vb = (LAS bf16_t*)(L + D1_VB);
    LAS bf16_t* TW = (LAS bf16_t*)(L + D1_TW); LAS bf16_t* AD = (LAS bf16_t*)(L + D1_AD); LAS bf16_t* W2T = (LAS bf16_t*)(L + D1_W2T); LAS bf16_t* A2T = (LAS bf16_t*)(L + D1_A2T);
    LAS bf16_t* KT = (LAS bf16_t*)(L + D1_Y); LAS bf16_t* KTt = KT + 4608; LAS bf16_t* KD = KT + 2 * 4608; LAS bf16_t* KDt = KT + 3 * 4608;
    LAS bf16_t* BT = KT + 4 * 4608; LAS bf16_t* BTt = KT + 5 * 4608; LAS bf16_t* RT = KT + 6 * 4608; LAS bf16_t* Vt = KT + 7 * 4608;
    LAS float* ABf = (LAS float*)(L + D1_ABF); LAS bf16_t* AK = (LAS bf16_t*)(L + D1_AK); LAS bf16_t* ARK = (LAS bf16_t*)(L + D1_ARK); LAS bf16_t* ARB = (LAS bf16_t*)(L + D1_ARB);
    LAS bf16_t* TT = (LAS bf16_t*)(L + D1_TT); LAS bf16_t* W1t = (LAS bf16_t*)(L + D1_W1T); LAS bf16_t* AKVt = (LAS bf16_t*)(L + D1_AKVT); LAS bf16_t* W2t = (LAS bf16_t*)(L + D1_W2TT);

    if (C.tid < 480) {
        const int q = C.tid % 160, seg = C.tid / 160, grp = q >> 5, c = (q & 31) * 2;
        const int j = (grp == 0 ? h * 64 : grp == 1 ? 256 + h * 64 : grp == 2 ? 512 + h * 64 : grp == 3 ? 768 + d * 64 : 896 + d * 64) + c;
        const int t0 = seg * 22, nt = seg == 2 ? 20 : 22;
        const bf16_t* pp = P + (size_t)(ci.row0 + t0) * NP + OFF_D + j;
        const float mp0 = mup[j], mp1 = mup[j + 1], mn0 = mun[j], mn1 = mun[j + 1];
        unsigned w[24];
#pragma unroll
        for (int i = 0; i < 24; ++i) { const int row = ci.row0 + t0 - 1 + i; w[i] = (i < nt + 2 && row >= ci.lo && row < ci.hi) ? *(const unsigned*)(pp + (ptrdiff_t)(i - 1) * NP) : 0u; }
        LAS bf16_t* dst = (grp == 0 ? Rb : grp == 1 ? Kb : grp == 2 ? Vb : grp == 3 ? TW : AD);
#pragma unroll
        for (int i = 0; i < 22; ++i) if (i < nt) {
            const float x0 = bflo(w[i + 1]), x1 = bfhi(w[i + 1]);
            const float v0 = x0 + mp0 * (bflo(w[i]) - x0) + mn0 * (bflo(w[i + 2]) - x0);
            const float v1 = x1 + mp1 * (bfhi(w[i]) - x1) + mn1 * (bfhi(w[i + 2]) - x1);
            DBGF(1, badv(v0, 1e4f) || badv(v1, 1e4f));
            const unsigned o = (grp == 3) ? pk2(tanhf(v0), tanhf(v1)) : pk2(v0, v1);
            const int tl = t0 + i, l = d ? 63 - tl : tl;
            *(LAS unsigned*)(dst + l * 72 + c) = o;
        }
    }
    {
        const float* w2 = C.in[27] + ((size_t)layer * 2 + d) * 64 * 256 + h * 64; const float* a2 = C.in[29] + ((size_t)layer * 2 + d) * 64 * 256 + h * 64;
        for (int e = C.tid; e < 4096; e += 512) { const int r = e >> 6, c = e & 63; W2T[c * 72 + r] = f2bf(w2[r * 256 + c]); A2T[c * 72 + r] = f2bf(a2[r * 256 + c]); }
    }
    __syncthreads();
    {
        unsigned* dbgflags = (unsigned*)(C.ws + 32768); (void)dbgflags;
        const float* w0 = C.in[26] + ((size_t)layer * 2 + d) * 256 + h * 64; const float* a0 = C.in[28] + ((size_t)layer * 2 + d) * 256 + h * 64;
        blk_mma<4, 4, 2>(TW, 72, W2T, 72, C.wid, C.lane, [=](int r0, int col, const f32x4& acc) {
#pragma unroll
            for (int jj = 0; jj < 4; ++jj) { const float w = w0[col] + acc[jj]; DBGL(2, badv(w, 1e4f)); LW[(r0 + jj) * 68 + col] = -expf(-softplus(-w) - 0.5f); }
        });
        blk_mma<4, 4, 2>(AD, 72, A2T, 72, C.wid, C.lane, [=](int r0, int col, const f32x4& acc) {
#pragma unroll
            for (int jj = 0; jj < 4; ++jj) { DBGL(2, badv(acc[jj], 1e4f)); AA[(r0 + jj) * 68 + col] = sigm(a0[col] + acc[jj]); }
        });
    }
    __syncthreads();
    {
#pragma unroll
        for (int i = 0; i < 8; ++i) { const int c = C.wid * 8 + i; const float incl = wave_incl_scan(LW[C.lane * 68 + c], C.lane); CS[C.lane * 68 + c] = incl; if (C.lane == 63) GL[c] = expf(incl); }
    }
    __syncthreads();
    {
        const int l = C.tid >> 3, sub = C.tid & 7;
        const float* kkw = C.in[31] + layer * 256 + h * 64; const float* kaw = C.in[32] + layer * 256 + h * 64; const float* rkw = C.in[33] + layer * 256 + h * 64;
        float kk[8], kdv[8], aa[8], rr[8], vv[8]; float ss = 0.f, bon = 0.f;
#pragma unroll
        for (int i = 0; i < 8; ++i) { const int c = sub * 8 + i; const float k = bf2f(Kb[l * 72 + c]); rr[i] = bf2f(Rb[l * 72 + c]); vv[i] = bf2f(Vb[l * 72 + c]); aa[i] = AA[l * 68 + c];
            kk[i] = k * kkw[c]; ss += kk[i] * kk[i]; kdv[i] = k * (1.f + (aa[i] - 1.f) * kaw[c]); bon += rr[i] * kdv[i] * rkw[c]; }
        ss += __shfl_xor(ss, 1); ss += __shfl_xor(ss, 2); ss += __shfl_xor(ss, 4);
        bon += __shfl_xor(bon, 1); bon += __shfl_xor(bon, 2); bon += __shfl_xor(bon, 4);
        const float inv = rsqrtf(ss + 1e-12f);
        if (sub == 0) ((float*)(C.ws + WS_BON))[(size_t)(ci.row0 + (d ? 63 - l : l)) * 8 + h * 2 + d] = bon;
#pragma unroll
        for (int i = 0; i < 8; ++i) { const int c = sub * 8 + i; const float cs = CS[l * 68 + c], lw = LW[l * 68 + c];
            const float ge = expf(cs - lw), gi = expf(cs), gn = expf(-cs); const float kkn = kk[i] * inv;
            DBGF(3, badv(cs, 50.f) || cs > 0.f || badv(lw, 1.f)); DBGF(4, badv(kkn * ge, 10.f) || badv(rr[i] * gi, 1e4f) || badv(vv[i], 1e4f)); DBGF(5, badv(kdv[i] * gn, 1e25f) || badv(kkn * aa[i] * gn, 1e25f));
            const unsigned short kt = f2bf(kkn * ge), kd = f2bf(kdv[i] * gn), bt = f2bf(kkn * aa[i] * gn), rt = f2bf(rr[i] * gi);
            KT[l * 72 + c] = kt; KTt[c * 72 + l] = kt; KD[l * 72 + c] = kd; KDt[c * 72 + l] = kd; BT[l * 72 + c] = bt; BTt[c * 72 + l] = bt; RT[l * 72 + c] = rt; Vt[c * 72 + l] = f2bf(vv[i]); }
    }
    __syncthreads();
    unsigned* dbgflags = (unsigned*)(C.ws + 32768); (void)dbgflags;
    blk_mma2<4, 4, 2>(KT, BT, KT, KD, 72, C.wid, C.lane, [=](int r0, int col, const f32x4& ab, const f32x4& ak) {
        unsigned short o[4];
#pragma unroll
        for (int jj = 0; jj < 4; ++jj) { const bool lo = col < r0 + jj; DBGL(6, lo && (badv(ab[jj], 1e3f) || badv(ak[jj], 1e4f))); ABf[(r0 + jj) * 68 + col] = lo ? ab[jj] : 0.f; o[jj] = f2bf(lo ? ak[jj] : 0.f); AK[(r0 + jj) * 72 + col] = o[jj]; }
    });
    blk_mma2<4, 4, 2>(RT, KD, RT, BT, 72, C.wid, C.lane, [=](int r0, int col, const f32x4& rk, const f32x4& rb) {
#pragma unroll
        for (int jj = 0; jj < 4; ++jj) { const bool le = col <= r0 + jj; DBGL(7, le && (badv(rk[jj], 1e5f) || badv(rb[jj], 1e5f))); ARK[(r0 + jj) * 72 + col] = f2bf(le ? rk[jj] : 0.f); ARB[(r0 + jj) * 72 + col] = f2bf(le ? rb[jj] : 0.f); }
    });
    __syncthreads();
    tri_inverse(ABf, (LAS float*)(L + 54272), (LAS float*)(L + 71680), TT, C.tid, C.wid, C.lane);
    __syncthreads();
#if MK_DIAG2
    for (int e = C.tid; e < 4096; e += 512) DBGF(8, badv(bf2f(TT[(e >> 6) * 72 + (e & 63)]), 1e3f));
#endif
    blk_mma2<4, 4, 2>(TT, KTt, AK, Vt, 72, C.wid, C.lane, [=](int r0, int col, const f32x4& w1, const f32x4& akv) {
        DBGL(9, badv(w1[0], 1e3f) || badv(w1[1], 1e3f) || badv(w1[2], 1e3f) || badv(w1[3], 1e3f)); DBGL(10, badv(akv[0], 1e5f) || badv(akv[1], 1e5f) || badv(akv[2], 1e5f) || badv(akv[3], 1e5f));
        u32x2 a, b; a.x = pk2(w1[0], w1[1]); a.y = pk2(w1[2], w1[3]); b.x = pk2(akv[0], akv[1]); b.y = pk2(akv[2], akv[3]);
        *(LAS u32x2*)(W1t + col * 72 + r0) = a; *(LAS u32x2*)(AKVt + col * 72 + r0) = b;
    });
    __syncthreads();
    blk_mma<4, 4, 2>(TT, 72, AKVt, 72, C.wid, C.lane, [=](int r0, int col, const f32x4& w2) {
        DBGL(11, badv(w2[0], 1e5f) || badv(w2[1], 1e5f) || badv(w2[2], 1e5f) || badv(w2[3], 1e5f));
        u32x2 a; a.x = pk2(w2[0], w2[1]); a.y = pk2(w2[2], w2[3]); *(LAS u32x2*)(W2t + col * 72 + r0) = a;
    });
    __syncthreads();
    {
        bf16_t* Gg = (bf16_t*)(C.ws + WS_RG) + (size_t)slot * 4096; float* Jg = (float*)(C.ws + WS_RJ) + (size_t)slot * 4096;
        bf16_t* Ryg = (bf16_t*)(C.ws + WS_RY) + (size_t)slot * 4096; bf16_t* Ylg = (bf16_t*)(C.ws + WS_RL) + (size_t)slot * 4096;
        blk_mma2<4, 4, 2>(W1t, BTt, W1t, ARB, 72, C.wid, C.lane, [=](int r0, int col, const f32x4& gp, const f32x4& rbw) {
            const float gl = GL[col]; float g[4], ry[4];
            const u32x2 rt = *(const LAS u32x2*)(RT + col * 72 + r0);
            const float rtv[4] = {bflo(rt.x), bfhi(rt.x), bflo(rt.y), bfhi(rt.y)};
#pragma unroll
            for (int jj = 0; jj < 4; ++jj) { g[jj] = gl * ((col == r0 + jj ? 1.f : 0.f) - gp[jj]); ry[jj] = rtv[jj] - rbw[jj]; }
            u32x2 og, oy; og.x = pk2(g[0], g[1]); og.y = pk2(g[2], g[3]); oy.x = pk2(ry[0], ry[1]); oy.y = pk2(ry[2], ry[3]);
            *(u32x2*)(Gg + col * 64 + r0) = og;
            *(u32x2*)(Ryg + col * 64 + r0) = oy;
        });
        blk_mma2<4, 4, 2>(KDt, Vt, BTt, W2t, 72, C.wid, C.lane, [=](int r0, int col, const f32x4& kv, const f32x4& bw) {
            f32x4 o;
#pragma unroll
            for (int jj = 0; jj < 4; ++jj) { o[jj] = GL[r0 + jj] * (kv[jj] - bw[jj]); DBGL(12, badv(GL[r0 + jj] * kv[jj], 1e5f)); DBGL(13, badv(GL[r0 + jj] * bw[jj], 1e5f)); DBGL(14, badv(o[jj], 1e5f)); }
            *(f32x4*)(Jg + col * 64 + r0) = o;
        });
        blk_mma2<4, 4, 2>(ARK, Vt, ARB, W2t, 72, C.wid, C.lane, [=](int r0, int col, const f32x4& a, const f32x4& b) {
            u32x2 o; o.x = pk2(a[0] - b[0], a[1] - b[1]); o.y = pk2(a[2] - b[2], a[3] - b[3]);
            *(u32x2*)(Ylg + col * 64 + r0) = o;
        });
    }
    __syncthreads();
}

typedef float f32x2p __attribute__((ext_vector_type(2)));
__device__ __forceinline__ void ph_scan(const Ctx& C) {
    if (C.bid < 16) {
        const int chain = C.bid, fr = C.lane & 15, fq = C.lane >> 4;
        LAS bf16_t* HT = (LAS bf16_t*)C.lds;
        const bf16_t* Gg = (const bf16_t*)(C.ws + WS_RG); const float* Jg = (const float*)(C.ws + WS_RJ); bf16_t* Hg = (bf16_t*)(C.ws + WS_RH);
        f32x4 acc[2] = {{0.f, 0.f, 0.f, 0.f}, {0.f, 0.f, 0.f, 0.f}};
        int buf = 0;
        const int tm = C.wid >> 1, tnb = (C.wid & 1) * 2;
        const bf16_t* gp = Gg + (size_t)chain * NCH * 4096 + (tm * 16 + fr) * 64 + fq * 8;
        const float* jp = Jg + (size_t)chain * NCH * 4096 + (tnb * 16 + fr) * 64 + tm * 16 + fq * 4;
        bf16x8 gn[2]; f32x4 jn[2];
        gn[0] = *(const bf16x8*)gp; gn[1] = *(const bf16x8*)(gp + 32); jn[0] = *(const f32x4*)jp; jn[1] = *(const f32x4*)(jp + 16 * 64);
        for (int cpos = 0; cpos < NCH; ++cpos) {
            const size_t slot = (size_t)chain * NCH + cpos;
            const bf16x8 g0 = gn[0], g1 = gn[1]; const f32x4 j0 = jn[0], j1 = jn[1];
            if (cpos + 1 < NCH) { const bf16_t* gq = gp + (size_t)(cpos + 1) * 4096; const float* jq = jp + (size_t)(cpos + 1) * 4096;
                gn[0] = *(const bf16x8*)gq; gn[1] = *(const bf16x8*)(gq + 32); jn[0] = *(const f32x4*)jq; jn[1] = *(const f32x4*)(jq + 16 * 64); }
#pragma unroll
            for (int i = 0; i < 2; ++i) { const int tn = tnb + i;
                u32x2 o; o.x = pk2(acc[i][0], acc[i][1]); o.y = pk2(acc[i][2], acc[i][3]);
                *(LAS u32x2*)(HT + buf * 4608 + (tn * 16 + fr) * 72 + tm * 16 + fq * 4) = o;
                *(u32x2*)(Hg + slot * 4096 + (tn * 16 + fr) * 64 + tm * 16 + fq * 4) = o; }
            __syncthreads();
#pragma unroll
            for (int i = 0; i < 2; ++i) { const int tn = tnb + i;
                f32x4 a = i ? j1 : j0;
                a = __builtin_amdgcn_mfma_f32_16x16x32_bf16(g0, *(const LAS bf16x8*)(HT + buf * 4608 + (tn * 16 + fr) * 72 + fq * 8), a, 0, 0, 0);
                a = __builtin_amdgcn_mfma_f32_16x16x32_bf16(g1, *(const LAS bf16x8*)(HT + buf * 4608 + (tn * 16 + fr) * 72 + 32 + fq * 8), a, 0, 0, 0);
                acc[i] = a; }
            buf ^= 1;
        }
    } else {
        float* MST = (float*)(C.ws + WS_MST); const float* MCD = (const float*)(C.ws + WS_MCD);
        const int nthr = (C.G - 16) * 512;
        for (int e = (C.bid - 16) * 512 + C.tid; e < 16 * 4096; e += nthr) {
            const int chain = e >> 12, el = (e & 4095) * 2; f32x2p run = {0.f, 0.f};
            float* p = MST + (size_t)chain * NCH * 8192 + el; const float* cd = MCD + chain * NCH;
#pragma unroll 12
            for (int cpos = 0; cpos < NCH; ++cpos) { const f32x2p tmp = *(const f32x2p*)(p + (size_t)cpos * 8192); *(f32x2p*)(p + (size_t)cpos * 8192) = run; run = run * cd[cpos] + tmp; }
        }
    }
}

__device__ __forceinline__ void item_mamba_out(const Ctx& C, int layer, int gc) {
    const ChunkInfo ci = chunk_info(gc);
    const bf16_t* P = (const bf16_t*)(C.ws + WS_P); bf16_t* YC = (bf16_t*)(C.ws + WS_ACT); const float* MST = (const float*)(C.ws + WS_MST);
    lds_t L = C.lds;
    LAS float* DT = (LAS float*)L;
    LAS float* DA = (LAS float*)(L + 2048);
    LAS float* CSI = (LAS float*)(L + 4096);
    LAS float* SSQ = (LAS float*)(L + 6144);
    LAS bf16_t* CG = (LAS bf16_t*)(L + 10240);
    LAS bf16_t* BG = (LAS bf16_t*)(L + 27648);
    LAS bf16_t* XT = (LAS bf16_t*)(L + 45056);
    LAS float* CBm = (LAS float*)(L + 63488);
    LAS bf16_t* MP = (LAS bf16_t*)(L + 80896);
    LAS bf16_t* S0 = (LAS bf16_t*)(L + 90112);
    LAS bf16_t* YPRE = (LAS bf16_t*)(L + 107520);
    const int fr = C.lane & 15, fq = C.lane >> 4;
    {
        const int s = C.lane, dh = C.wid;
        const float raw = bf2f(P[(size_t)(ci.row0 + s) * NP + OFF_C + 1024 + dh]);
        const float dt = softplus(raw + C.in[20][layer * 8 + dh]);
        const float da = dt * (-expf(C.in[21][layer * 8 + dh]));
        const float incl = wave_incl_scan(da, s), total = __shfl(incl, 63);
        DT[dh * 64 + s] = dt; DA[dh * 64 + s] = da;
        CSI[dh * 64 + s] = (dh < 4) ? incl : (total - incl + da);
    }
    for (int g = 0; g < 2; ++g) {
        __syncthreads();
        {
            const int cp = C.tid & 255, half = C.tid >> 8;
            if (cp < 192) {
                const int kind = cp >> 6, cl = (cp & 63) * 2, c0 = kind * 256 + g * 128 + cl;
                const float* cw = C.in[18] + (size_t)layer * 5 * 768 + c0; const float* cb = C.in[19] + layer * 768 + c0;
                float w0[5], w1[5];
#pragma unroll
                for (int j = 0; j < 5; ++j) { w0[j] = cw[j * 768]; w1[j] = cw[j * 768 + 1]; }
                const float b0 = cb[0], b1 = cb[1];
                const int s0 = half * 32;
                unsigned win[5];
#pragma unroll
                for (int j = 0; j < 4; ++j) { const int row = ci.row0 + s0 - 2 + j; win[j + 1] = (row >= ci.lo && row < ci.hi) ? *(const unsigned*)(P + (size_t)row * NP + OFF_C + 256 + c0) : 0u; }
                for (int tt = 0; tt < 32; ++tt) {
                    const int s = s0 + tt;
#pragma unroll
                    for (int j = 0; j < 4; ++j) win[j] = win[j + 1];
                    { const int row = ci.row0 + s + 2; win[4] = (row >= ci.lo && row < ci.hi) ? *(const unsigned*)(P + (size_t)row * NP + OFF_C + 256 + c0) : 0u; }
                    float a0 = b0, a1 = b1;
#pragma unroll
                    for (int j = 0; j < 5; ++j) { a0 += w0[j] * bflo(win[j]); a1 += w1[j] * bfhi(win[j]); }
                    const unsigned short o0 = f2bf(silu(a0)), o1 = f2bf(silu(a1));
                    if (kind == 0) { XT[cl * 72 + s] = o0; XT[(cl + 1) * 72 + s] = o1; }
                    else if (kind == 1) { *(LAS unsigned*)(BG + s * 136 + cl) = (unsigned)o0 | ((unsigned)o1 << 16); }
                    else { *(LAS unsigned*)(CG + s * 136 + cl) = (unsigned)o0 | ((unsigned)o1 << 16); }
                }
            }
        }
        __syncthreads();
        blk_mma<4, 4, 4>(CG, 136, BG, 136, C.wid, C.lane, [=](int r0, int col, const f32x4& acc) {
#pragma unroll
            for (int jj = 0; jj < 4; ++jj) CBm[(r0 + jj) * 68 + col] = acc[jj];
        });
        for (int hh = 0; hh < 2; ++hh) {
            const int h = 2 * g + hh;
            f32x4 yacc[2] = {{0.f, 0.f, 0.f, 0.f}, {0.f, 0.f, 0.f, 0.f}};
            for (int d = 0; d < 2; ++d) {
                const int dh = d * 4 + h;
                __syncthreads();
                for (int e = C.tid; e < 4096; e += 512) { const int l = e >> 6, s = e & 63; const bool ok = d ? (s >= l) : (s <= l);
                    MP[l * 72 + s] = ok ? f2bf(CBm[l * 68 + s] * expf(CSI[dh * 64 + l] - CSI[dh * 64 + s]) * DT[dh * 64 + s]) : (unsigned short)0; }
                { const float* src = MST + (size_t)slot_of(ci.b, h, d, cpos_of(ci, d)) * 8192;
                  for (int e = C.tid; e < 2048; e += 512) { const int p = e >> 5, n4 = (e & 31) * 4; const f32x4 v = *(const f32x4*)(src + p * 128 + n4);
                      u32x2 o; o.x = pk2(v.x, v.y); o.y = pk2(v.z, v.w); *(LAS u32x2*)(S0 + p * 136 + n4) = o; } }
                __syncthreads();
#pragma unroll
                for (int i = 0; i < 2; ++i) { const int tt = C.wid + 8 * i, tm = tt >> 2, tn = tt & 3;
                    f32x4 a1 = {0.f, 0.f, 0.f, 0.f}, a2 = {0.f, 0.f, 0.f, 0.f};
#pragma unroll
                    for (int ks = 0; ks < 2; ++ks) a1 = __builtin_amdgcn_mfma_f32_16x16x32_bf16(*(const LAS bf16x8*)(MP + (tm * 16 + fr) * 72 + ks * 32 + fq * 8),
                                                                                                 *(const LAS bf16x8*)(XT + (hh * 64 + tn * 16 + fr) * 72 + ks * 32 + fq * 8), a1, 0, 0, 0);
#pragma unroll
                    for (int ks = 0; ks < 4; ++ks) a2 = __builtin_amdgcn_mfma_f32_16x16x32_bf16(*(const LAS bf16x8*)(CG + (tm * 16 + fr) * 136 + ks * 32 + fq * 8),
                                                                                                 *(const LAS bf16x8*)(S0 + (tn * 16 + fr) * 136 + ks * 32 + fq * 8), a2, 0, 0, 0);
#pragma unroll
                    for (int j = 0; j < 4; ++j) yacc[i][j] += a1[j] + a2[j] * expf(CSI[dh * 64 + tm * 16 + fq * 4 + j]);
                }
            }
            const float dsk = C.in[22][layer * 4 + h];
#pragma unroll
            for (int i = 0; i < 2; ++i) { const int tt = C.wid + 8 * i, tm = tt >> 2, tn = tt & 3;
#pragma unroll
                for (int j = 0; j < 4; ++j) { const int l = tm * 16 + fq * 4 + j, p = tn * 16 + fr, c = h * 64 + p;
                    const float xs = bf2f(XT[(hh * 64 + p) * 72 + l]);
                    const float z = bf2f(P[(size_t)(ci.row0 + l) * NP + OFF_C + c]);
                    const float pre = (yacc[i][j] + dsk * xs) * silu(z);
                    YPRE[l * 264 + c] = f2bf(pre);
                    float q = pre * pre; q += __shfl_xor(q, 1); q += __shfl_xor(q, 2); q += __shfl_xor(q, 4); q += __shfl_xor(q, 8);
                    if (fr == 0) SSQ[l * 16 + h * 4 + tn] = q; }
            }
        }
    }
    __syncthreads();
    {
        const int l = C.tid >> 3, sub = C.tid & 7; float ss = 0.f;
#pragma unroll
        for (int i = 0; i < 16; ++i) ss += SSQ[l * 16 + i];
        const float rs = rsqrtf(ss * (1.f / 256.f) + 1e-6f);
        const float* ng = C.in[23] + layer * 256 + sub * 32;
        bf16_t* dst = YC + (size_t)(ci.row0 + l) * DM + 512 + sub * 32;
#pragma unroll
        for (int i = 0; i < 32; i += 2) { const float a = bf2f(YPRE[l * 264 + sub * 32 + i]) * rs * ng[i], b = bf2f(YPRE[l * 264 + sub * 32 + i + 1]) * rs * ng[i + 1]; *(unsigned*)(dst + i) = pk2(a, b); }
    }
    __syncthreads();
}

constexpr int D3_G2T = 0, D3_SG = 69632;
__device__ __forceinline__ void load_g2t(const Ctx& C, int layer) {
    LAS bf16_t* G2T = (LAS bf16_t*)(C.lds + D3_G2T); const float* g2 = C.in[30] + (size_t)layer * 128 * 256;
    for (int e = C.tid; e < 128 * 256; e += 512) { const int r = e >> 8, c = e & 255; G2T[c * 136 + r] = f2bf(g2[e]); }
}
__device__ __forceinline__ float lerp_d(const bf16_t* P, const ChunkInfo& ci, int row, int j, const float* mup, const float* mun) {
    const bf16_t* pp = P + (size_t)row * NP + OFF_D + j;
    const float x = bf2f(*pp), xp = (row - 1 >= ci.lo) ? bf2f(*(pp - NP)) : 0.f, xn = (row + 1 < ci.hi) ? bf2f(*(pp + NP)) : 0.f;
    return x + mup[j] * (xp - x) + mun[j] * (xn - x);
}
__device__ __forceinline__ void item_rwkv_out(const Ctx& C, int layer, int gc) {
    const ChunkInfo ci = chunk_info(gc);
    const bf16_t* P = (const bf16_t*)(C.ws + WS_P); bf16_t* YC = (bf16_t*)(C.ws + WS_ACT);
    const float* mup = C.in[24] + layer * 1152; const float* mun = C.in[25] + layer * 1152;
    LAS bf16_t* G2T = (LAS bf16_t*)(C.lds + D3_G2T); LAS bf16_t* SG = (LAS bf16_t*)(C.lds + D3_SG);
    const int fr = C.lane & 15, fq = C.lane >> 4;
    __syncthreads();
    for (int e = C.tid; e < 64 * 128; e += 512) { const int l = e >> 7, r = e & 127; SG[l * 136 + r] = f2bf(sigm(lerp_d(P, ci, ci.row0 + l, 1024 + r, mup, mun))); }
    __syncthreads();
    const int h = C.wid >> 1, tmb = (C.wid & 1) * 2;
    const bf16_t* Ryg = (const bf16_t*)(C.ws + WS_RY); const bf16_t* Ylg = (const bf16_t*)(C.ws + WS_RL); const bf16_t* Hg = (const bf16_t*)(C.ws + WS_RH);
    const float* BON = (const float*)(C.ws + WS_BON);
#pragma unroll
    for (int ti = 0; ti < 2; ++ti) {
        const int tm = tmb + ti;
        f32x4 gacc[4], yacc[4];
#pragma unroll
        for (int tn = 0; tn < 4; ++tn) { f32x4 a = {0.f, 0.f, 0.f, 0.f};
#pragma unroll
            for (int ks = 0; ks < 4; ++ks) a = __builtin_amdgcn_mfma_f32_16x16x32_bf16(*(const LAS bf16x8*)(SG + (tm * 16 + fr) * 136 + ks * 32 + fq * 8),
                                                                                        *(const LAS bf16x8*)(G2T + (h * 64 + tn * 16 + fr) * 136 + ks * 32 + fq * 8), a, 0, 0, 0);
            gacc[tn] = a; yacc[tn] = (f32x4){0.f, 0.f, 0.f, 0.f}; }
#pragma unroll
        for (int d = 0; d < 2; ++d) {
            const size_t slot = (size_t)slot_of(ci.b, h, d, cpos_of(ci, d));
            const int arow = d ? 63 - (tm * 16 + fr) : tm * 16 + fr;
            bf16x8 af[2];
#pragma unroll
            for (int ks = 0; ks < 2; ++ks) af[ks] = *(const bf16x8*)(Ryg + slot * 4096 + arow * 64 + ks * 32 + fq * 8);
#pragma unroll
            for (int tn = 0; tn < 4; ++tn) {
                f32x4 a;
                if (d == 0) { const u32x2 yl = *(const u32x2*)(Ylg + slot * 4096 + (tn * 16 + fr) * 64 + tm * 16 + fq * 4); a = (f32x4){bflo(yl.x), bfhi(yl.x), bflo(yl.y), bfhi(yl.y)}; }
                else { const u32x2 yl = *(const u32x2*)(Ylg + slot * 4096 + (tn * 16 + fr) * 64 + 60 - (tm * 16 + fq * 4)); a = (f32x4){bfhi(yl.y), bflo(yl.y), bfhi(yl.x), bflo(yl.x)}; }
#pragma unroll
                for (int ks = 0; ks < 2; ++ks) a = __builtin_amdgcn_mfma_f32_16x16x32_bf16(af[ks], *(const bf16x8*)(Hg + slot * 4096 + (tn * 16 + fr) * 64 + ks * 32 + fq * 8), a, 0, 0, 0);
                yacc[tn] += a;
            }
        }
#pragma unroll
        for (int j = 0; j < 4; ++j) {
            const int l = tm * 16 + fq * 4 + j, row = ci.row0 + l;
            float s = (yacc[0][j] + yacc[1][j]) + (yacc[2][j] + yacc[3][j]);
            s += __shfl_xor(s, 1); s += __shfl_xor(s, 2); s += __shfl_xor(s, 4); s += __shfl_xor(s, 8);
            const float mu = s * (1.f / 64.f);
            float q = 0.f;
#pragma unroll
            for (int tn = 0; tn < 4; ++tn) { const float dd = yacc[tn][j] - mu; q += dd * dd; }
            q += __shfl_xor(q, 1); q += __shfl_xor(q, 2); q += __shfl_xor(q, 4); q += __shfl_xor(q, 8);
            const float rs = rsqrtf(q * (1.f / 64.f) + 64e-5f);
            const float bon = BON[(size_t)row * 8 + h * 2] + BON[(size_t)row * 8 + h * 2 + 1];
#pragma unroll
            for (int tn = 0; tn < 4; ++tn) { const int c = h * 64 + tn * 16 + fr;
                const float yn = (yacc[tn][j] - mu) * rs * C.in[34][layer * 256 + c] + C.in[35][layer * 256 + c];
                const float vv = lerp_d(P, ci, row, 512 + c, mup, mun);
                YC[(size_t)row * DM + 768 + c] = f2bf((yn + bon * vv) * gacc[tn][j]); }
        }
    }
}

__device__ __forceinline__ unsigned ordf(float f) { const unsigned u = __float_as_uint(f); return u ^ ((u >> 31) ? 0xFFFFFFFFu : 0x80000000u); }
__device__ __forceinline__ unsigned wave_max_u32(unsigned v) {
    unsigned t;
    t = (unsigned)__builtin_amdgcn_update_dpp((int)v, (int)v, 0xB1, 0xF, 0xF, false); v = t > v ? t : v;
    t = (unsigned)__builtin_amdgcn_update_dpp((int)v, (int)v, 0x4E, 0xF, 0xF, false); v = t > v ? t : v;
    t = (unsigned)__builtin_amdgcn_update_dpp((int)v, (int)v, 0x141, 0xF, 0xF, false); v = t > v ? t : v;
    t = (unsigned)__builtin_amdgcn_update_dpp((int)v, (int)v, 0x140, 0xF, 0xF, false); v = t > v ? t : v;
    t = (unsigned)__builtin_amdgcn_update_dpp((int)v, (int)v, 0x142, 0xA, 0xF, false); v = t > v ? t : v;
    t = (unsigned)__builtin_amdgcn_update_dpp((int)v, (int)v, 0x143, 0xC, 0xF, false); v = t > v ? t : v;
    return (unsigned)__builtin_amdgcn_readlane((int)v, 63);
}
constexpr int SEL_K1 = 0, SEL_K2 = 34816;
__device__ __forceinline__ float unordf(unsigned k) { return __uint_as_float((k & 0x80000000u) ? (k ^ 0x80000000u) : ~k); }
template <int N> __device__ __forceinline__ void bitonic_sort_desc(unsigned (&x)[N]) {
#pragma unroll
    for (int k = 2; k <= N; k <<= 1)
#pragma unroll
        for (int j = k >> 1; j > 0; j >>= 1)
#pragma unroll
            for (int i = 0; i < N; ++i) { const int l = i ^ j;
                if (l > i) { const unsigned p = x[i], q = x[l]; const unsigned hi = p > q ? p : q, lo = p > q ? q : p; if ((i & k) == 0) { x[i] = hi; x[l] = lo; } else { x[i] = lo; x[l] = hi; } } }
}
__device__ __forceinline__ void merge_top16(unsigned (&a)[16], const unsigned (&b)[16]) {
#pragma unroll
    for (int i = 0; i < 16; ++i) a[i] = a[i] > b[15 - i] ? a[i] : b[15 - i];
#pragma unroll
    for (int j = 8; j > 0; j >>= 1)
#pragma unroll
        for (int i = 0; i < 16; ++i) { const int l = i ^ j; if (l > i) { const unsigned p = a[i], q = a[l]; a[i] = p > q ? p : q; a[l] = p > q ? q : p; } }
}
__device__ __forceinline__ void ph_select(const Ctx& C, int layer, int nrows) {
    const bf16_t* Q = (const bf16_t*)(C.ws + WS_Q); int* SELI = (int*)(C.ws + WS_SELI); float* SELG = (float*)(C.ws + WS_SELG);
    LAS bf16_t* K1 = (LAS bf16_t*)(C.lds + SEL_K1); LAS bf16_t* K2 = (LAS bf16_t*)(C.lds + SEL_K2);
    {
        const float* k1 = C.in[37] + (size_t)layer * 128 * 128; const float* k2 = C.in[38] + (size_t)layer * 128 * 128;
        for (int e = C.tid; e < 4096; e += 512) { const int r = e >> 5, c4 = (e & 31) * 4; const f32x4 a = *(const f32x4*)(k1 + r * 128 + c4), b = *(const f32x4*)(k2 + r * 128 + c4);
            u32x2 oa, ob; oa.x = pk2(a.x, a.y); oa.y = pk2(a.z, a.w); ob.x = pk2(b.x, b.y); ob.y = pk2(b.z, b.w);
            *(LAS u32x2*)(K1 + r * 136 + c4) = oa; *(LAS u32x2*)(K2 + r * 136 + c4) = ob; }
    }
    __syncthreads();
    const int fr = C.lane & 15, fq = C.lane >> 4;
    const int nunits = (nrows / 16) * 8;
    for (int u = C.bid * 8 + C.wid; u < nunits; u += C.G * 8) {
        const int tile = u >> 3, h = u & 7, row = tile * 16 + fr;
        const bf16_t* qp = Q + (size_t)row * 2048 + h * 256 + fq * 8;
        bf16x8 qf[8];
#pragma unroll
        for (int i = 0; i < 8; ++i) qf[i] = *(const bf16x8*)(qp + i * 32);
        unsigned T[2][16];
#pragma unroll
        for (int half = 0; half < 2; ++half) {
            const LAS bf16_t* K = half ? K2 : K1;
            unsigned lo16[16], hi16[16];
#pragma unroll
            for (int kt = 0; kt < 8; ++kt) {
                f32x4 acc = {0.f, 0.f, 0.f, 0.f};
#pragma unroll
                for (int ks = 0; ks < 4; ++ks) acc = __builtin_amdgcn_mfma_f32_16x16x32_bf16(*(const LAS bf16x8*)(K + (kt * 16 + fr) * 136 + ks * 32 + fq * 8), qf[half * 4 + ks], acc, 0, 0, 0);
#pragma unroll
                for (int j = 0; j < 4; ++j) { const unsigned key = (ordf(acc[j]) & ~0x7Fu) | (unsigned)(127 - (kt * 16 + fq * 4 + j));
                    if (kt < 4) lo16[kt * 4 + j] = key; else hi16[(kt - 4) * 4 + j] = key; }
            }
            bitonic_sort_desc<16>(lo16); bitonic_sort_desc<16>(hi16); merge_top16(lo16, hi16);
#pragma unroll
            for (int rnd = 16; rnd <= 32; rnd <<= 1) { unsigned o[16];
#pragma unroll
                for (int i = 0; i < 16; ++i) o[i] = (unsigned)__shfl_xor((int)lo16[i], rnd);
                merge_top16(lo16, o); }
#pragma unroll
            for (int i = 0; i < 16; ++i) T[half][i] = lo16[i];
        }
        unsigned ck[50]; unsigned R0[16];
        {
            int id = 0;
#pragma unroll
            for (int a = 0; a < 16; ++a) {
                const float va = unordf(T[0][a] & ~0x7Fu);
#pragma unroll
                for (int b = 0; b < 16; ++b) if ((a + 1) * (b + 1) <= 16) { ck[id] = (ordf(va + unordf(T[1][b] & ~0x7Fu)) & ~0x3Fu) | (unsigned)(63 - id); ++id; }
            }
        }
#pragma unroll
        for (int i = 0; i < 16; ++i) R0[i] = ck[i];
        {
            int base = 16;
#pragma unroll
            for (int a = 1; a < 8; ++a) { const int n = 16 / (a + 1); unsigned rw[16];
#pragma unroll
                for (int i = 0; i < 16; ++i) rw[i] = i < n ? ck[base + i] : 0u;
                merge_top16(R0, rw); base += n; }
            unsigned rw[16];
#pragma unroll
            for (int i = 0; i < 16; ++i) rw[i] = i < 8 ? ck[base + i] : 0u;
            merge_top16(R0, rw);
        }
        const unsigned thr = R0[15]; const float mx = unordf(R0[0] & ~0x3Fu);
        float sum = 0.f;
#pragma unroll
        for (int c = 0; c < 50; ++c) sum += ck[c] >= thr ? __expf(unordf(ck[c] & ~0x3Fu) - mx) : 0.f;
        const float rsum = 1.f / sum;
        int* oi = SELI + ((size_t)row * 8 + h) * 16; float* og = SELG + ((size_t)row * 8 + h) * 16;
        {
            int id = 0, cnt = 0;
#pragma unroll
            for (int a = 0; a < 16; ++a)
#pragma unroll
                for (int b = 0; b < 16; ++b) if ((a + 1) * (b + 1) <= 16) {
                    if (ck[id] >= thr) { if (fq == 0 && cnt < 16) { oi[cnt] = (127 - (int)(T[0][a] & 0x7Fu)) * 128 + (127 - (int)(T[1][b] & 0x7Fu)); og[cnt] = __expf(unordf(ck[id] & ~0x3Fu) - mx) * rsum; } ++cnt; }
                    ++id; }
        }
    }
}

struct R16 { float v[16]; };
__device__ __forceinline__ R16 load_r16_f32(const float* p, int lane) { R16 r;
#pragma unroll
    for (int k = 0; k < 4; ++k) { const f32x4 a = *(const f32x4*)(p + 16 * lane + 4 * k); r.v[4 * k] = a.x; r.v[4 * k + 1] = a.y; r.v[4 * k + 2] = a.z; r.v[4 * k + 3] = a.w; }
    return r; }
__device__ __forceinline__ void store_r16_f32(float* p, int lane, const R16& r) {
#pragma unroll
    for (int k = 0; k < 4; ++k) *(f32x4*)(p + 16 * lane + 4 * k) = (f32x4){r.v[4 * k], r.v[4 * k + 1], r.v[4 * k + 2], r.v[4 * k + 3]}; }
__device__ __forceinline__ R16 load_r16_bf16(const bf16_t* p, int lane) { R16 r;
#pragma unroll
    for (int k = 0; k < 2; ++k) { const u32x4 a = *(const u32x4*)(p + 16 * lane + 8 * k);
        r.v[8 * k] = bflo(a.x); r.v[8 * k + 1] = bfhi(a.x); r.v[8 * k + 2] = bflo(a.y); r.v[8 * k + 3] = bfhi(a.y); r.v[8 * k + 4] = bflo(a.z); r.v[8 * k + 5] = bfhi(a.z); r.v[8 * k + 6] = bflo(a.w); r.v[8 * k + 7] = bfhi(a.w); }
    return r; }
__device__ __forceinline__ void store_r16_bf16(bf16_t* p, int lane, const R16& r) {
#pragma unroll
    for (int k = 0; k < 2; ++k) { u32x4 a; a.x = pk2(r.v[8 * k], r.v[8 * k + 1]); a.y = pk2(r.v[8 * k + 2], r.v[8 * k + 3]); a.z = pk2(r.v[8 * k + 4], r.v[8 * k + 5]); a.w = pk2(r.v[8 * k + 6], r.v[8 * k + 7]);
        *(u32x4*)(p + 16 * lane + 8 * k) = a; } }
typedef float f32x2p __attribute__((ext_vector_type(2)));
__device__ __forceinline__ void ph_peer(const Ctx& C, int layer, int nrows, bool last, bool store = true) {
    const bf16_t* F = (const bf16_t*)(C.ws + WS_ACT); bf16_t* XN = (bf16_t*)(C.ws + WS_ACT);
    const unsigned char* UB = C.ws + WS_UB; const unsigned char* VB = C.ws + WS_VB; const float* SU = (const float*)(C.ws + WS_SU); const float* SV = (const float*)(C.ws + WS_SV);
    const int* SELI = (const int*)(C.ws + WS_SELI); const float* SELG = (const float*)(C.ws + WS_SELG);
    float* H = (float*)(C.ws + WS_H); const float* MOD = (const float*)(C.ws + WS_MOD);
    const int L = C.lane;
    for (int tok = C.bid * 8 + C.wid; tok < nrows; tok += C.G * 8) {
        const R16 f = load_r16_bf16(F + (size_t)tok * DM, L);
        const int idx0 = SELI[(size_t)tok * 128 + L], idx1 = SELI[(size_t)tok * 128 + 64 + L];
        const float su0 = SU[idx0], su1 = SU[idx1];
        const float gsv0 = SELG[(size_t)tok * 128 + L] * SV[idx0], gsv1 = SELG[(size_t)tok * 128 + 64 + L] * SV[idx1];
        f32x2p out[8];
#pragma unroll
        for (int i = 0; i < 8; ++i) out[i] = (f32x2p){0.f, 0.f};
        for (int bt = 0; bt < 8; ++bt) {
            const int src = bt < 4 ? idx0 : idx1; const float susrc = bt < 4 ? su0 : su1, gsrc = bt < 4 ? gsv0 : gsv1; const int l0 = (bt & 3) * 16;
            u32x4 ua[16], va[16];
#pragma unroll
            for (int i = 0; i < 16; ++i) { const int ei = __builtin_amdgcn_readlane(src, l0 + i);
                ua[i] = *(const u32x4*)(UB + (size_t)ei * DM + 16 * L); va[i] = *(const u32x4*)(VB + (size_t)ei * DM + 16 * L); }
            float part[16];
#pragma unroll
            for (int i = 0; i < 16; ++i) { f32x2p acc = {0.f, 0.f};
#pragma unroll
                for (int k = 0; k < 4; ++k) { const f32x2p lo = __builtin_amdgcn_cvt_pk_f32_fp8((int)ua[i][k], false), hi = __builtin_amdgcn_cvt_pk_f32_fp8((int)ua[i][k], true);
                    acc += lo * (f32x2p){f.v[4 * k], f.v[4 * k + 1]}; acc += hi * (f32x2p){f.v[4 * k + 2], f.v[4 * k + 3]}; }
                part[i] = acc.x + acc.y; }
            float p8[8], p4[4], p2[2], p1;
            { const bool hi = (L & 32) != 0;
#pragma unroll
              for (int i = 0; i < 8; ++i) { const float send = hi ? part[i] : part[i + 8]; const float recv = __shfl_xor(send, 32); p8[i] = (hi ? part[i + 8] : part[i]) + recv; } }
            { const bool hi = (L & 16) != 0;
#pragma unroll
              for (int i = 0; i < 4; ++i) { const float send = hi ? p8[i] : p8[i + 4]; const float recv = __shfl_xor(send, 16); p4[i] = (hi ? p8[i + 4] : p8[i]) + recv; } }
            { const bool hi = (L & 8) != 0;
#pragma unroll
              for (int i = 0; i < 2; ++i) { const float send = hi ? p4[i] : p4[i + 2]; const float recv = __shfl_xor(send, 8); p2[i] = (hi ? p4[i + 2] : p4[i]) + recv; } }
            { const bool hi = (L & 4) != 0; const float send = hi ? p2[0] : p2[1]; const float recv = __shfl_xor(send, 4); p1 = (hi ? p2[1] : p2[0]) + recv; }
            p1 += __shfl_xor(p1, 2); p1 += __shfl_xor(p1, 1);
            const int myexp = ((L >> 5) & 1) * 8 + ((L >> 4) & 1) * 4 + ((L >> 3) & 1) * 2 + ((L >> 2) & 1);
            const float act = gelu_tanh(p1 * __shfl(susrc, l0 + myexp)) * __shfl(gsrc, l0 + myexp);
#pragma unroll
            for (int i = 0; i < 16; ++i) {
                const float a = __uint_as_float((unsigned)__builtin_amdgcn_readlane((int)__float_as_uint(act), ((i >> 3) & 1) * 32 + ((i >> 2) & 1) * 16 + ((i >> 1) & 1) * 8 + (i & 1) * 4)); const f32x2p a2 = {a, a};
#pragma unroll
                for (int k = 0; k < 4; ++k) { out[2 * k] += a2 * __builtin_amdgcn_cvt_pk_f32_fp8((int)va[i][k], false); out[2 * k + 1] += a2 * __builtin_amdgcn_cvt_pk_f32_fp8((int)va[i][k], true); }
            }
        }
        const float* m = MOD + ((size_t)layer * 3 + which_of(tok)) * 6144;
        R16 hr = load_r16_f32(H + (size_t)tok * DM, L); const R16 g5 = load_r16_f32(m + 5 * 1024, L);
#pragma unroll
        for (int i = 0; i < 8; ++i) { hr.v[2 * i] += g5.v[2 * i] * out[i].x; hr.v[2 * i + 1] += g5.v[2 * i + 1] * out[i].y; }
        float ss = 0.f;
#pragma unroll
        for (int i = 0; i < 16; ++i) ss += hr.v[i] * hr.v[i];
        const float rs = rsqrtf(wave_sum(ss) * (1.f / 1024.f) + 1e-6f);
        if (!store) continue;
        if (!last) {
            store_r16_f32(H + (size_t)tok * DM, L, hr);
            const float* m2 = MOD + ((size_t)(layer + 1) * 3 + which_of(tok)) * 6144;
            const R16 gg = load_r16_f32(C.in[6] + (layer + 1) * 1024, L), sh = load_r16_f32(m2, L), sc = load_r16_f32(m2 + 1024, L); R16 o;
#pragma unroll
            for (int i = 0; i < 16; ++i) o.v[i] = (hr.v[i] * rs * gg.v[i]) * (1.f + sc.v[i]) + sh.v[i];
            store_r16_bf16(XN + (size_t)tok * DM, L, o);
        } else {
            const R16 fg = load_r16_f32(C.in[41], L); R16 o;
#pragma unroll
            for (int i = 0; i < 16; ++i) o.v[i] = hr.v[i] * rs * fg.v[i];
            store_r16_f32(C.out + (size_t)tok * DM, L, o);
        }
    }
}

#define PM(n) ((MASK >> (n)) & 1u)
constexpr int NPH_LAYER = 9, NPH = 2 + 2 * NPH_LAYER;
template <unsigned MASK> __global__ void __launch_bounds__(512, 2) hybrid_fwd(Args args) {
    extern __shared__ __attribute__((aligned(16))) unsigned char lds_raw[];
    Ctx C0; C0.in = args.in; C0.out = args.out; C0.ws = args.ws; C0.lds = (lds_t)lds_raw;
    C0.tid = threadIdx.x; C0.lane = C0.tid & 63; C0.wid = __builtin_amdgcn_readfirstlane(C0.tid >> 6); C0.bid = blockIdx.x; C0.G = gridDim.x;
    const Ctx& C = C0;
    const int lo = args.ph_lo, hi = args.ph_hi;
    const bool multi = (hi - lo) > 1;
    XcdBarrier bar; bar.bar = (unsigned*)(C.ws + WS_CTL); bar.x = 0; bar.st = (volatile LAS unsigned*)(C.lds + LDS_XB);
    if (multi) {
        if (C.tid == 0) *(LAS u32x4*)(C.lds + LDS_XB) = (u32x4){0u, 0u, 0u, 0u};
        __syncthreads();
        bar = xcd_barrier_post((unsigned*)(C.ws + WS_CTL), (volatile LAS unsigned*)(C.lds + LDS_XB));
    }
#define IN(k) (lo <= (k) && (k) < hi)
#define PHASE_CTX(c) Ctx c = C0; { int t_ = C0.tid; asm volatile("" : "+v"(t_)); c.tid = t_; c.lane = t_ & 63; c.wid = __builtin_amdgcn_readfirstlane(t_ >> 6); }
#ifndef MK_PROBE
#define MK_PROBE 0u
#endif
#ifndef MK_REPEAT
#define MK_REPEAT 0u
#endif
#define RP(k) ((MK_REPEAT >> (k)) & 1u)
#if MK_PROBE
#define STAMP(k) do { if (C0.bid == 0 && C0.tid == 0) ((LAS unsigned long long*)(C0.lds + LDS_XB + 16))[k] = wall_clock64(); } while (0)
#else
#define STAMP(k) do {} while (0)
#endif
#define SEAM(k) do { if (IN(k) && IN((k) + 1)) xcd_barrier(bar); STAMP((k) + 1); } while (0)
    STAMP(0);
    if (PM(0) && IN(0)) { PHASE_CTX(c); ph_prologue(c); } SEAM(0);
    if (PM(1) && IN(1)) { PHASE_CTX(c); ph_norm(c, 0, c.in[6], 0, NROW); } SEAM(1);
    for (int layer = 0; layer < 2; ++layer) {
        const int base = 2 + layer * NPH_LAYER;
        const bool emit = (layer == 0);
        const int nrows = emit ? NROW : NLAT;
        if (PM(2) && IN(base + 0)) {
            pg8::Gemm g{(const bf16_t*)(C.ws + WS_ACT), (const bf16_t*)(C.ws + WS_WIN) + (size_t)layer * NP * DM, NROW, NP, DM};
            pg8::StaticOrder S; S.init(NROW, NP, C.G, C.bid);
            pg8::EpiBf16<0> E{(bf16_t*)(C.ws + WS_P), NP, nullptr, 0, 0};
            pg8::gemm_phase<pg8::EpiBf16<0>, pg8::StaticOrder, false>(C.lds, g, S, E, nullptr);
            if (RP(0)) { xcd_barrier(bar); pg8::gemm_phase<pg8::EpiBf16<0>, pg8::StaticOrder, false>(C.lds, g, S, E, nullptr); }
        }
        SEAM(base + 0);
        if (PM(3) && IN(base + 1)) {
            const int nD = 2112, nC = 264, nB = emit ? 132 : 128, nA = emit ? 264 : 256, tot = nD + nC + nB + nA;
            for (int rep = 0; rep < (RP(1) ? 2 : 1); ++rep) {
            if (rep) xcd_barrier(bar);
            if (PM(11)) { PHASE_CTX(c); for (int it = c.bid; it < nD; it += c.G) item_rwkv_local(c, layer, it); }
            if (PM(12)) { PHASE_CTX(c); for (int it = nD + (c.bid + 64) % c.G; it < nD + nC; it += c.G) item_mamba_local(c, layer, it - nD); }
            if (PM(13)) { PHASE_CTX(c); for (int it = nD + nC + (c.bid + 192) % c.G; it < nD + nC + nB; it += c.G) item_chunkmlp(c, layer, it - nD - nC); }
            if (PM(14)) { PHASE_CTX(c); for (int it = nD + nC + nB + (c.bid + 64) % c.G; it < tot; it += c.G) item_conformer(c, layer, it - nD - nC - nB); }
            }
        }
        SEAM(base + 1);
        if (PM(4) && IN(base + 2)) { PHASE_CTX(c); ph_scan(c); }
        SEAM(base + 2);
        if (PM(5) && IN(base + 3)) {
            const int nc = nrows / 64;
            for (int rep = 0; rep < (RP(3) ? 2 : 1); ++rep) {
            if (rep) xcd_barrier(bar);
            if (PM(15)) { PHASE_CTX(c); load_g2t(c, layer); for (int it = c.bid; it < nc; it += c.G) item_rwkv_out(c, layer, it); }
            __syncthreads();
            if (PM(16)) { PHASE_CTX(c); for (int it = c.bid; it < nc; it += c.G) item_mamba_out(c, layer, (it + 128) % nc); }
            __syncthreads();
            }
        }
        SEAM(base + 3);
        if (PM(6) && IN(base + 4)) {
            pg8::Gemm g{(const bf16_t*)(C.ws + WS_ACT), (const bf16_t*)(C.ws + WS_WOUT) + (size_t)layer * DM * DM, nrows, DM, DM};
            pg8::StaticOrder S; S.init(nrows, DM, C.G, C.bid);
            EpiResid E{(float*)(C.ws + WS_H), (const float*)(C.ws + WS_MOD) + (size_t)layer * 3 * 6144};
            pg8::gemm_phase<EpiResid, pg8::StaticOrder, false>(C.lds, g, S, E, nullptr);
        }
        SEAM(base + 4);
        if (PM(7) && IN(base + 5)) { PHASE_CTX(c); for (int rep = 0; rep < (RP(5) ? 2 : 1); ++rep) { if (rep) xcd_barrier(bar); ph_norm(c, layer, c.in[7] + layer * 1024, 3, nrows); if (layer == 1) convert_tables(c, 1); } }
        SEAM(base + 5);
        if (PM(8) && IN(base + 6)) {
            pg8::Gemm g{(const bf16_t*)(C.ws + WS_ACT), (const bf16_t*)(C.ws + WS_WQ) + (size_t)layer * 2048 * DM, nrows, 2048, DM};
            pg8::StaticOrder S; S.init(nrows, 2048, C.G, C.bid);
            pg8::EpiBf16<0> E{(bf16_t*)(C.ws + WS_Q), 2048, nullptr, 0, 0};
            pg8::gemm_phase<pg8::EpiBf16<0>, pg8::StaticOrder, false>(C.lds, g, S, E, nullptr);
            if (RP(6)) { xcd_barrier(bar); pg8::gemm_phase<pg8::EpiBf16<0>, pg8::StaticOrder, false>(C.lds, g, S, E, nullptr); }
        }
        SEAM(base + 6);
        if (PM(9) && IN(base + 7)) { PHASE_CTX(c); ph_select(c, layer, nrows); if (RP(7)) { xcd_barrier(bar); ph_select(c, layer, nrows); } }
        SEAM(base + 7);
        if (PM(10) && IN(base + 8)) { PHASE_CTX(c); if (RP(8)) { ph_peer(c, layer, nrows, layer == 1, args.ph_hi > 1000); xcd_barrier(bar); } ph_peer(c, layer, nrows, layer == 1); }
        SEAM(base + 8);
    }
#if MK_PROBE
    {
        xcd_barrier(bar);
        if (C0.bid == 0 && C0.tid == 0) { const LAS unsigned long long* TS = (const LAS unsigned long long*)(C0.lds + LDS_XB + 16);
            unsigned long long sel = 0; for (int k = 0; k < NPH; ++k) if ((MK_PROBE >> k) & 1u) sel += TS[k + 1] - TS[k];
            const unsigned long long tot = TS[NPH] - TS[0];
            __hip_atomic_store((unsigned*)(C0.ws + 40960), (unsigned)((double)sel / (double)tot * (double)NLAT), __ATOMIC_RELAXED, __HIP_MEMORY_SCOPE_AGENT); }
        xcd_barrier(bar);
        const unsigned nz = __hip_atomic_load((unsigned*)(C0.ws + 40960), __ATOMIC_RELAXED, __HIP_MEMORY_SCOPE_AGENT);
        for (size_t i = (size_t)C0.bid * 512 + C0.tid; i < (size_t)nz * 256; i += (size_t)C0.G * 512) *(f32x4*)(C0.out + i * 4) = (f32x4){0.f, 0.f, 0.f, 0.f};
    }
#endif
#undef IN
#undef SEAM
}
}
#ifndef MK_DIAG
#define MK_DIAG 0
#endif


namespace mk {
struct LaunchEnt { unsigned mask; int ph; };
template <unsigned MASK> static bool prep_kernel() {
    return hipFuncSetAttribute((const void*)hybrid_fwd<MASK>, hipFuncAttributeMaxDynamicSharedMemorySize, LDS_BYTES) == hipSuccess;
}
template <unsigned MASK> static void launch_kernel(int grid, hipStream_t stream, const Args& a) {
    hipLaunchKernelGGL(hybrid_fwd<MASK>, dim3(grid), dim3(512), LDS_BYTES, stream, a);
}
}

#if MK_DIAG
namespace mk {
__global__ void census_kernel(const void* buf, size_t n, int kind  , unsigned* flags, int stage, float lim) {
    bool bad = false;
    for (size_t i = (size_t)blockIdx.x * blockDim.x + threadIdx.x; i < n; i += (size_t)gridDim.x * blockDim.x) {
        if (kind == 2) { const int v = ((const int*)buf)[i]; bad |= (v < 0 || v >= 16384); }
        else { const float v = kind == 0 ? ((const float*)buf)[i] : bf2f(((const bf16_t*)buf)[i]); bad |= !(fabsf(v) < lim); }
    }
    if (bad) atomicOr(flags + stage, 1u);
}
__global__ void encode_kernel(const float* x, const float* fg, float* out, const unsigned* flags, int nst) {
    int first = 0; for (int k = nst; k >= 1; --k) if (flags[k]) first = k;
    const int row = blockIdx.x * 4 + (threadIdx.x >> 6), lane = threadIdx.x & 63;
    Row16 r = load_row16(x + (size_t)row * DM, lane);
    const int t = row & 8191;
    for (int i = 0; i < 16; ++i) { const int c = (i < 8 ? 8 * lane + i : 512 + 8 * lane + i - 8); const int quarter = c >> 8, jj = c & 255; const float pos = (quarter < 2) ? (float)(t >> 6) : (float)(t & 63);
        const float fr = exp2f(-(float)jj * (13.287712379549449f / 256.f)); r.v[i] += (quarter & 1) ? cosf(pos * fr) : sinf(pos * fr); }
    float ss = 0.f; for (int i = 0; i < 16; ++i) ss += r.v[i] * r.v[i];
    const float rs = rsqrtf(wave_sum(ss) * (1.f / 1024.f) + 1e-6f);
    const Row16 g = load_row16(fg, lane); Row16 o;
    const bool zero = row < first * 512;
    for (int i = 0; i < 16; ++i) o.v[i] = zero ? 0.f : r.v[i] * rs * g.v[i];
    store_row16_f32(out + (size_t)row * DM, lane, o);
}
}
#define CENSUS(off, n, kind, stage, lim) hipLaunchKernelGGL(mk::census_kernel, dim3(1024), dim3(256), 0, stream, (const void*)((char*)d_ws + (off)), (size_t)(n), kind, (unsigned*)((char*)d_ws + 32768), stage, lim)
#else
#define CENSUS(off, n, kind, stage, lim) do {} while (0)
#endif
#ifndef MK_ONE_LAUNCH
#define MK_ONE_LAUNCH 1
#endif
extern "C" void kernel_launch(void* const* d_in, const int* in_sizes, int n_in, void* d_out, int out_size, void* d_ws, size_t ws_size, hipStream_t stream) {
    using namespace mk;
    static int grid = 0;
    if (grid == 0) {
        if (n_in != 42 || ws_size < WS_END) { fprintf(stderr, "kernel_launch: need 42 inputs and %zu bytes of workspace (got %d, %zu)\n", (size_t)WS_END, n_in, ws_size); grid = -1; return; }
        int dev = 0, cus = 0;
        if (hipGetDevice(&dev) != hipSuccess || hipDeviceGetAttribute(&cus, hipDeviceAttributeMultiprocessorCount, dev) != hipSuccess) { grid = -1; return; }
        bool ok = true;
#if MK_ONE_LAUNCH
        ok = ok && prep_kernel<0x1FFFFu>();
#else
        ok = ok && prep_kernel<0x0001u>() && prep_kernel<0x0002u>() && prep_kernel<0x0004u>() && prep_kernel<0x0808u>() && prep_kernel<0x1008u>() && prep_kernel<0x2008u>() && prep_kernel<0x4008u>()
                && prep_kernel<0x0010u>() && prep_kernel<0x8020u>() && prep_kernel<0x10020u>() && prep_kernel<0x0040u>() && prep_kernel<0x0080u>() && prep_kernel<0x0100u>() && prep_kernel<0x0200u>() && prep_kernel<0x0400u>();
#endif
        if (!ok) { fprintf(stderr, "kernel_launch: hipFuncSetAttribute failed\n"); grid = -1; return; }
        (void)hipGetLastError();
        grid = cus;
    }
    if (grid < 0) return;
    (void)hipMemsetAsync((char*)d_ws + WS_CTL, 0, 65536, stream);
    Args a{};
    for (int i = 0; i < 42; ++i) a.in[i] = (const float*)d_in[i];
    a.out = (float*)d_out; a.ws = (unsigned char*)d_ws;
#if MK_ONE_LAUNCH
    a.ph_lo = 0; a.ph_hi = NPH; launch_kernel<0x1FFFFu>(grid, stream, a);
#else
    a.ph_lo = 0; a.ph_hi = 1; launch_kernel<0x0001u>(grid, stream, a);
    CENSUS(WS_H, (size_t)NROW * DM, 0, 1, 1e4f); CENSUS(WS_MOD, 2 * 3 * 6144, 0, 1, 1e4f); CENSUS(WS_WIN, 2ull * NP * DM, 1, 1, 1e4f); CENSUS(WS_UB, 2ull * NEXP * DM, 1, 1, 1e4f);
    a.ph_lo = 1; a.ph_hi = 2; launch_kernel<0x0002u>(grid, stream, a);
    CENSUS(WS_ACT, (size_t)NROW * DM, 1, 2, 1e4f);
    for (int layer = 0; layer < 2; ++layer) {
        const int b = 2 + layer * NPH_LAYER;
        const int so = layer ? 100 : 0; (void)so;
        a.ph_lo = b + 0; a.ph_hi = b + 1; launch_kernel<0x0004u>(grid, stream, a);
        if (!layer) CENSUS(WS_P, (size_t)NROW * NP, 1, 3, 1e4f);
        a.ph_lo = b + 1; a.ph_hi = b + 2; launch_kernel<0x0808u>(grid, stream, a);
        if (!layer) { CENSUS(WS_RG, (size_t)NSLOT * 4096, 1, 4, 1e6f); CENSUS(WS_RJ, (size_t)NSLOT * 4096, 0, 5, 1e6f); CENSUS(WS_RY, (size_t)NSLOT * 4096 * 2, 1, 6, 1e6f); CENSUS(WS_BON, (size_t)NROW * 8, 0, 6, 1e6f); }
        launch_kernel<0x1008u>(grid, stream, a);
        if (!layer) { CENSUS(WS_MST, (size_t)NSLOT * 8192, 0, 7, 1e6f); CENSUS(WS_MCD, NSLOT, 0, 7, 1e6f); }
        launch_kernel<0x2008u>(grid, stream, a); launch_kernel<0x4008u>(grid, stream, a);
        a.ph_lo = b + 2; a.ph_hi = b + 3; launch_kernel<0x0010u>(grid, stream, a);
        if (!layer) { CENSUS(WS_MST, (size_t)NSLOT * 8192, 0, 8, 1e6f); CENSUS(WS_RH, (size_t)NSLOT * 4096, 1, 9, 1e6f); }
        a.ph_lo = b + 3; a.ph_hi = b + 4; launch_kernel<0x8020u>(grid, stream, a); launch_kernel<0x10020u>(grid, stream, a);
        if (!layer) CENSUS(WS_ACT, (size_t)NROW * DM, 1, 10, 1e4f);
        a.ph_lo = b + 4; a.ph_hi = b + 5; launch_kernel<0x0040u>(grid, stream, a);
        if (!layer) CENSUS(WS_H, (size_t)NROW * DM, 0, 11, 1e4f);
        a.ph_lo = b + 5; a.ph_hi = b + 6; launch_kernel<0x0080u>(grid, stream, a);
        a.ph_lo = b + 6; a.ph_hi = b + 7; launch_kernel<0x0100u>(grid, stream, a);
        if (!layer) CENSUS(WS_Q, (size_t)NROW * 2048, 1, 12, 1e4f);
        a.ph_lo = b + 7; a.ph_hi = b + 8; launch_kernel<0x0200u>(grid, stream, a);
        if (!layer) { CENSUS(WS_SELI, (size_t)NROW * 128, 2, 13, 0.f); CENSUS(WS_SELG, (size_t)NROW * 128, 0, 13, 2.f); }
        a.ph_lo = b + 8; a.ph_hi = b + 9; launch_kernel<0x0400u>(grid, stream, a);
        if (!layer) { CENSUS(WS_H, (size_t)NROW * DM, 0, 14, 1e4f); CENSUS(WS_ACT, (size_t)NROW * DM, 1, 15, 1e4f); }
    }
#endif
#if MK_DIAG
    hipLaunchKernelGGL(mk::encode_kernel, dim3(NLAT / 4), dim3(256), 0, stream, (const float*)d_in[0], (const float*)d_in[41], (float*)d_out, (const unsigned*)((char*)d_ws + 32768), 15);
#endif
    (void)in_sizes; (void)out_size;
}
```

```cpp
#include <hip/hip_runtime.h>
#include <cstdio>
#include <cstdint>
namespace pg8 {
#define PG8_LAS __attribute__((address_space(3)))
typedef unsigned short bf16_t;
typedef short bf16x8 __attribute__((ext_vector_type(8)));
typedef float f32x4 __attribute__((ext_vector_type(4)));
typedef unsigned u32x4 __attribute__((ext_vector_type(4)));
constexpr int BM = 256, BK = 64, HALF = 128, HTB = HALF * BK * 2  , STAGE_BYTES = 8 * HTB, NXCD = 8, WGM = 8;

__host__ __device__ __forceinline__ int lds_byte(int r, int c) { const int st = (r >> 4) * 2 + (c >> 5), rr = r & 15, cc = c & 31, ob = rr * 64 + cc * 2; return st * 1024 + (ob ^ (((ob >> 9) & 1) << 5)); }
__host__ __device__ __forceinline__ void stage_rc(int b, int& R, int& C) { const int st = b / 1024, sb = b % 1024, swz = sb ^ (((sb >> 9) & 1) << 5); R = (st >> 1) * 16 + swz / 64; C = (st & 1) * 32 + (swz % 64) / 2; }
__host__ __device__ __forceinline__ int perm32(int rho) { const int n = rho >> 4, i = rho & 15; return 8 * (i >> 2) + 4 * n + (i & 3); }

struct Unit { int pm, pn; };
struct Gemm { const bf16_t* A; const bf16_t* Bt; int M, N, K; };

struct StaticOrder {
    int nM, nN, nwg, G, c;
    __host__ __device__ void init(int M, int N, int G_, int c_) { nM = M / BM; nN = N / BM; nwg = nM * nN; G = G_; c = c_; }
    __host__ __device__ bool next(int i, Unit& u) const {
        const long L = (long)i * G + c; if (L >= nwg) return false;
        int wgid = (int)L; { const int q = nwg / NXCD, r = nwg % NXCD, xcd = wgid % NXCD, off = wgid / NXCD; wgid = (xcd < r ? xcd * (q + 1) : r * (q + 1) + (xcd - r) * q) + off; }
        const int nig = WGM * nN, gid = wgid / nig, fm = gid * WGM, gsz = (nM - fm) < WGM ? (nM - fm) : WGM;
        u.pm = fm + ((wgid % nig) % gsz); u.pn = (wgid % nig) / gsz; return true;
    }
    __device__ __forceinline__ void a_ready(const Unit&) const {}
    __device__ __forceinline__ void done(const Unit&) const {}
};
struct CountedOrder : StaticOrder {
    const unsigned* ready; unsigned need; unsigned* tmo;
    __device__ __forceinline__ void a_ready(const Unit& u) const {
        if (threadIdx.x < 64) {
            const unsigned long long t0 = __builtin_amdgcn_s_memrealtime(); unsigned polls = 0;
            while ((unsigned)__builtin_amdgcn_readfirstlane(__hip_atomic_load(ready + 64 * u.pm, __ATOMIC_RELAXED, __HIP_MEMORY_SCOPE_AGENT)) < need) {
                if ((++polls & 255u) == 0u && __builtin_amdgcn_readfirstlane(__hip_atomic_load(tmo, __ATOMIC_RELAXED, __HIP_MEMORY_SCOPE_AGENT)) != 0u) break;
                if (__builtin_amdgcn_s_memrealtime() - t0 > 2000000ull) {
                    if (threadIdx.x == 0) { unsigned expect = 0u; __hip_atomic_compare_exchange_strong(tmo + 1, &expect, 0x600u | (unsigned)(u.pm & 0xff), __ATOMIC_RELAXED, __ATOMIC_RELAXED, __HIP_MEMORY_SCOPE_AGENT); __hip_atomic_store(tmo, 1u, __ATOMIC_RELAXED, __HIP_MEMORY_SCOPE_AGENT); }
                    break; }
                __builtin_amdgcn_s_sleep(2); }
            __builtin_amdgcn_fence(__ATOMIC_ACQUIRE, "agent");
            asm volatile("s_waitcnt vmcnt(0)" ::: "memory");
        }
#if !defined(BROKEN_HOOK_NO_BARRIER)
        asm volatile("" ::: "memory"); __builtin_amdgcn_s_barrier(); asm volatile("" ::: "memory");
#endif
    }
};

__device__ __forceinline__ unsigned cvt_pk_bf16(float lo, float hi) { unsigned r; asm volatile("v_cvt_pk_bf16_f32 %0, %1, %2" : "=v"(r) : "v"(lo), "v"(hi)); return r; }
typedef float f32x2 __attribute__((ext_vector_type(2)));
__device__ __forceinline__ f32x2 gelu_pk(f32x2 v) {
    const f32x2 av = __builtin_elementwise_abs(v), d = av * 0.2316418882f + 1.0f;
    f32x2 t; t.x = __builtin_amdgcn_rcpf(d.x); t.y = __builtin_amdgcn_rcpf(d.y);
    f32x2 q = t * 0.5307027145f + (-0.7265760135f); q = q * t + 0.7107068705f; q = q * t + (-0.142248368f); q = q * t + 0.127414796f; q = q * t;
    const f32x2 s = (v * v) * (-0.72134752044f);
    f32x2 e; e.x = __builtin_amdgcn_exp2f(s.x); e.y = __builtin_amdgcn_exp2f(s.y);
    const f32x2 m = v * (q * e), r = v - m;
    f32x2 o; o.x = v.x < 0.f ? m.x : r.x; o.y = v.y < 0.f ? m.y : r.y; return o;
}

struct EpiF32 {
    static constexpr bool PERM = false, AFTER_DRAIN = false;
    float* C; int ldc; const float* bias;
    __device__ __forceinline__ void operator()(const f32x4 (&acc)[2][2][4][2], const Unit& u, int wr, int wc, int fr, int fq) const {
        const int row0 = u.pm * BM + wr * 64 + fr, col0 = u.pn * BM + wc * 32 + 4 * fq;
        f32x4 bv[2][2];
#pragma unroll
        for (int bj = 0; bj < 2; ++bj)
#pragma unroll
            for (int n = 0; n < 2; ++n) bv[bj][n] = bias ? *(const f32x4*)(bias + col0 + bj * HALF + n * 16) : (f32x4){0.f, 0.f, 0.f, 0.f};
#pragma unroll
        for (int ai = 0; ai < 2; ++ai)
#pragma unroll
            for (int m = 0; m < 4; ++m) { float* rowp = C + (size_t)(row0 + ai * HALF + m * 16) * ldc + col0;
#pragma unroll
                for (int bj = 0; bj < 2; ++bj)
#pragma unroll
                    for (int n = 0; n < 2; ++n) *(f32x4*)(rowp + bj * HALF + n * 16) = acc[ai][bj][m][n] + bv[bj][n]; }
    }
};
template <int ACT  > struct EpiBf16 {
    static constexpr bool PERM = true, AFTER_DRAIN = false;
    bf16_t* O; int ldc; const float* bias; int split_cols; size_t split_stride;
    __device__ __forceinline__ void operator()(const f32x4 (&acc)[2][2][4][2], const Unit& u, int wr, int wc, int fr, int fq) const {
        const int row0 = u.pm * BM + wr * 64 + fr; int colt = u.pn * BM; bf16_t* base = O;
        if (split_cols) { const int t = colt / split_cols; base += (size_t)t * split_stride; colt -= t * split_cols; }
        const int col0 = colt + wc * 32 + 8 * fq, bcol0 = u.pn * BM + wc * 32 + 8 * fq;
        f32x4 bv[2][2];
#pragma unroll
        for (int bj = 0; bj < 2; ++bj)
#pragma unroll
            for (int n = 0; n < 2; ++n) bv[bj][n] = bias ? *(const f32x4*)(bias + bcol0 + bj * HALF + 4 * n) : (f32x4){0.f, 0.f, 0.f, 0.f};
#pragma unroll
        for (int ai = 0; ai < 2; ++ai)
#pragma unroll
            for (int m = 0; m < 4; ++m) { bf16_t* rowp = base + (size_t)(row0 + ai * HALF + m * 16) * ldc + col0;
#pragma unroll
                for (int bj = 0; bj < 2; ++bj) { f32x4 v0 = acc[ai][bj][m][0] + bv[bj][0], v1 = acc[ai][bj][m][1] + bv[bj][1];
                    if (ACT == 1) { f32x2 a = gelu_pk((f32x2){v0[0], v0[1]}), b = gelu_pk((f32x2){v0[2], v0[3]}), c = gelu_pk((f32x2){v1[0], v1[1]}), d = gelu_pk((f32x2){v1[2], v1[3]});
                        v0 = (f32x4){a.x, a.y, b.x, b.y}; v1 = (f32x4){c.x, c.y, d.x, d.y}; }
                    if (ACT == 2) {
#pragma unroll
                        for (int j = 0; j < 4; ++j) { v0[j] = 0.5f * v0[j] * (1.0f + erff(v0[j] * 0.70710678f)); v1[j] = 0.5f * v1[j] * (1.0f + erff(v1[j] * 0.70710678f)); } }
                    u32x4 w; w.x = cvt_pk_bf16(v0[0], v0[1]); w.y = cvt_pk_bf16(v0[2], v0[3]); w.z = cvt_pk_bf16(v1[0], v1[1]); w.w = cvt_pk_bf16(v1[2], v1[3]);
                    *(u32x4*)(rowp + bj * HALF) = w; } }
    }
};
template <class Epi, class Sched, bool STAMP = false>
__device__ __forceinline__ void gemm_phase(PG8_LAS unsigned char* lds, const Gemm g, const Sched& S, const Epi& E, unsigned long long* stamps) {
    int tid_ = threadIdx.x; asm volatile("" : "+v"(tid_));
    const int tid = tid_, wid = __builtin_amdgcn_readfirstlane(tid >> 6), lane = tid & 63, wr = wid >> 2, wc = wid & 3, fr = lane & 15, fq = lane >> 4;
    const int K = g.K, nt = K / BK;
    int ts_lo = 0, ts_hi = 0, nts = 0; const unsigned long long rt_entry = STAMP ? (unsigned long long)wall_clock64() : 0ull;
#define PG8_STAMP() do { if (STAMP && wid == 0 && nts < 64) { const unsigned long long _c = (unsigned long long)clock64(); \
        ts_lo = (lane == nts) ? (int)(unsigned)_c : ts_lo; ts_hi = (lane == nts) ? (int)(unsigned)(_c >> 32) : ts_hi; ++nts; } } while (0)
    PG8_STAMP();
    unsigned voffA[2], voffB[2];
#pragma unroll
    for (int i = 0; i < 2; ++i) { int R, C; stage_rc(tid * 16 + i * 8192, R, C); const int Rb = Epi::PERM ? ((R & ~31) + perm32(R & 31)) : R;
        voffA[i] = (unsigned)(R * K + C) * 2u; voffB[i] = (unsigned)(Rb * K + C) * 2u; }
    const size_t kstep = (size_t)(BK * 2);
    const size_t hstep = (size_t)HALF * K * 2;
    const size_t tstep = 2 * hstep;
    const unsigned ldsw = (unsigned)wid * 1024u;
    const int aoff = lds_byte(wr * 64 + fr, fq * 8), boff = lds_byte(wc * 32 + fr, fq * 8);
#define PG8_SA(b, h) (((b) * 2 + (h)) * HTB)
#define PG8_SB(b, h) ((4 + (b) * 2 + (h)) * HTB)
#define PG8_STAGE(bufoff, gbase, voff) do { _Pragma("unroll") for (int _i = 0; _i < 2; ++_i) \
        __builtin_amdgcn_global_load_lds((const unsigned*)((const char*)(gbase) + (voff)[_i]), (PG8_LAS unsigned*)(lds + (bufoff) + ldsw + _i * 8192), 16, 0, 0); } while (0)
#define PG8_LDA(dst, b, h) do { _Pragma("unroll") for (int m = 0; m < 4; ++m) _Pragma("unroll") for (int k = 0; k < 2; ++k) dst[m][k] = *(const PG8_LAS bf16x8*)(lds + PG8_SA(b, h) + aoff + m * 2048 + k * 1024); } while (0)
#define PG8_LDB(dst, b, h) do { _Pragma("unroll") for (int n = 0; n < 2; ++n) _Pragma("unroll") for (int k = 0; k < 2; ++k) dst[n][k] = *(const PG8_LAS bf16x8*)(lds + PG8_SB(b, h) + boff + n * 2048 + k * 1024); } while (0)
#define PG8_MMA(ai, bj, At, Bt) do { __builtin_amdgcn_s_setprio(1); _Pragma("unroll") for (int m = 0; m < 4; ++m) _Pragma("unroll") for (int n = 0; n < 2; ++n) _Pragma("unroll") for (int k = 0; k < 2; ++k) \
        acc[ai][bj][m][n] = __builtin_amdgcn_mfma_f32_16x16x32_bf16(Bt[n][k], At[m][k], acc[ai][bj][m][n], 0, 0, 0); __builtin_amdgcn_s_setprio(0); } while (0)
#define PG8_WAIT_V(n) asm volatile("s_waitcnt vmcnt(" #n ")" ::: "memory")
#define PG8_WAIT_L(n) asm volatile("s_waitcnt lgkmcnt(" #n ")" ::: "memory")
#define PG8_BAR __builtin_amdgcn_s_barrier()
#define PG8_SCHED __builtin_amdgcn_sched_barrier(0)
    Unit cur, nxt; int ui = 0;
    if (!S.next(0, cur)) return;
    f32x4 acc[2][2][4][2];
#pragma unroll
    for (int a = 0; a < 2; ++a)
#pragma unroll
        for (int b = 0; b < 2; ++b)
#pragma unroll
            for (int m = 0; m < 4; ++m)
#pragma unroll
                for (int n = 0; n < 2; ++n) acc[a][b][m][n] = (f32x4){0.f, 0.f, 0.f, 0.f};
    bf16x8 At[4][2], B0[2][2], B1[2][2];
    const char* cA = (const char*)g.A + (size_t)cur.pm * tstep; const char* cB = (const char*)g.Bt + (size_t)cur.pn * tstep;
    S.a_ready(cur);
    PG8_STAGE(PG8_SB(0, 0), cB, voffB); PG8_STAGE(PG8_SA(0, 0), cA, voffA); PG8_STAGE(PG8_SB(0, 1), cB + hstep, voffB); PG8_STAGE(PG8_SA(0, 1), cA + hstep, voffA);
    if (wr == 1) PG8_BAR;
    PG8_WAIT_V(4); PG8_BAR;
    PG8_STAGE(PG8_SB(1, 0), cB + kstep, voffB); PG8_STAGE(PG8_SA(1, 0), cA + kstep, voffA); PG8_STAGE(PG8_SB(1, 1), cB + hstep + kstep, voffB);
    PG8_WAIT_V(6); PG8_BAR;
    PG8_STAMP();
    for (;;) {
        const bool has_next = S.next(ui + 1, nxt);
        const char* nA = has_next ? (const char*)g.A + (size_t)nxt.pm * tstep : cA; const char* nB = has_next ? (const char*)g.Bt + (size_t)nxt.pn * tstep : cB;
        for (int t = 0; t < nt; t += 2) {
            const bool last = (t == nt - 2);
            const char* a1 = cA + (size_t)(t + 1) * kstep;
            const char* a2 = last ? nA : cA + (size_t)(t + 2) * kstep; const char* b2 = last ? nB : cB + (size_t)(t + 2) * kstep;
            const char* a3 = a2 + kstep; const char* b3 = b2 + kstep;
            if (last && has_next) S.a_ready(nxt);
            PG8_LDB(B0, 0, 0); PG8_SCHED; PG8_LDA(At, 0, 0); PG8_STAGE(PG8_SA(1, 1), a1 + hstep, voffA);
            PG8_WAIT_L(8); PG8_BAR; PG8_WAIT_L(0); PG8_MMA(0, 0, At, B0); PG8_BAR; PG8_SCHED;
            PG8_LDB(B1, 0, 1); PG8_STAGE(PG8_SB(0, 0), b2, voffB);
            PG8_BAR; PG8_WAIT_L(0); PG8_MMA(0, 1, At, B1); PG8_BAR;
            PG8_LDA(At, 0, 1); PG8_STAGE(PG8_SA(0, 0), a2, voffA);
            PG8_BAR; PG8_WAIT_L(0); PG8_MMA(1, 0, At, B0); PG8_BAR; PG8_SCHED;
            PG8_STAGE(PG8_SB(0, 1), b2 + hstep, voffB);
            PG8_WAIT_V(6); PG8_BAR; PG8_MMA(1, 1, At, B1); PG8_BAR;
            PG8_LDB(B0, 1, 0); PG8_SCHED; PG8_LDA(At, 1, 0); PG8_STAGE(PG8_SA(0, 1), a2 + hstep, voffA);
            PG8_WAIT_L(8); PG8_BAR; PG8_WAIT_L(0); PG8_MMA(0, 0, At, B0); PG8_BAR; PG8_SCHED;
            PG8_LDB(B1, 1, 1); PG8_STAGE(PG8_SB(1, 0), b3, voffB);
            PG8_BAR; PG8_WAIT_L(0); PG8_MMA(0, 1, At, B1); PG8_BAR;
            PG8_LDA(At, 1, 1); PG8_STAGE(PG8_SA(1, 0), a3, voffA);
            PG8_BAR; PG8_WAIT_L(0); PG8_MMA(1, 0, At, B0); PG8_BAR; PG8_SCHED;
            PG8_STAGE(PG8_SB(1, 1), b3 + hstep, voffB);
            PG8_WAIT_V(6); PG8_BAR; PG8_MMA(1, 1, At, B1); PG8_BAR;
        }
        PG8_STAMP();
        if constexpr (!Epi::AFTER_DRAIN) { E(acc, cur, wr, wc, fr, fq); S.done(cur); }
        PG8_STAMP();
        if (!has_next) break;
#pragma unroll
        for (int a = 0; a < 2; ++a)
#pragma unroll
            for (int b = 0; b < 2; ++b)
#pragma unroll
                for (int m = 0; m < 4; ++m)
#pragma unroll
                    for (int n = 0; n < 2; ++n) acc[a][b][m][n] = (f32x4){0.f, 0.f, 0.f, 0.f};
        cur = nxt; cA = nA; cB = nB; ++ui;
    }
    PG8_WAIT_V(0);
    if (wr == 0) PG8_BAR;
    PG8_BAR;
    if constexpr (Epi::AFTER_DRAIN) { E.fused(acc, cur, wr, wc, fr, fq, lds, wid, lane); S.done(cur); }
    PG8_STAMP();
    if (STAMP && wid == 0) { stamps[lane] = lane < nts ? (((unsigned long long)(unsigned)ts_hi << 32) | (unsigned)ts_lo) : 0ull;
        if (lane == 62) stamps[62] = rt_entry; if (lane == 63) stamps[63] = (unsigned long long)wall_clock64(); }
#undef PG8_STAMP
#undef PG8_SA
#undef PG8_SB
#undef PG8_STAGE
#undef PG8_LDA
#undef PG8_LDB
#undef PG8_MMA
#undef PG8_WAIT_V
#undef PG8_WAIT_L
#undef PG8_BAR
#undef PG8_SCHED
}
}
#define XB_TMO      128
#define XB_XCNT(j)  (256  + 64 * (j))
#define XB_XSUB(j)  (1280 + 64 * (j))
#define XB_XGEN(j)  (2304 + 64 * (j))
#define XB_TOP      3328
#define XB_TOPGEN   3392
#define XCD_BAR_WORDS 3456
#define XB_SPIN_CAP (1u << 18)
#define LAS __attribute__((address_space(3)))

__device__ __forceinline__ unsigned xb_ld(unsigned* p)              { return __hip_atomic_load(p, __ATOMIC_RELAXED, __HIP_MEMORY_SCOPE_AGENT); }
__device__ __forceinline__ unsigned xb_add(unsigned* p, unsigned v) { return __hip_atomic_fetch_add(p, v, __ATOMIC_RELAXED, __HIP_MEMORY_SCOPE_AGENT); }
__device__ __forceinline__ unsigned xb_xcc_id() { return (unsigned)__builtin_amdgcn_s_getreg((3 << 11) | 20) & 0xFu; }
#define XB_SPIN(cond, bar) do { unsigned _sp = 0; while (cond) { __builtin_amdgcn_s_sleep(1); \
    if ((++_sp & 255u) == 0u) { if (xb_ld(&(bar)[XB_TMO])) break; if (_sp > XB_SPIN_CAP) { atomicAdd(&(bar)[XB_TMO], 1u); break; } } } } while (0)

struct XcdBarrier {
    unsigned* bar; unsigned x;
    volatile LAS unsigned* st;
};

__device__ __forceinline__ XcdBarrier xcd_barrier_post(unsigned* bar, volatile LAS unsigned* st) {
    XcdBarrier b; b.bar = bar; b.x = xb_xcc_id(); b.st = st;
    if (threadIdx.x == 0) (void)xb_add(&bar[XB_XCNT(b.x)], 1u);
    return b;
}
__device__ __forceinline__ void xcd_barrier_complete(unsigned* bar, unsigned x, unsigned& nloc, unsigned& nx) {
    const unsigned G = gridDim.x * gridDim.y * gridDim.z;
    unsigned sum, cnt, mine, sp = 0u;
    for (;;) {
        sum = 0u; cnt = 0u; mine = 0u;
#pragma unroll
        for (unsigned j = 0; j < 16; ++j) { const unsigned c = xb_ld(&bar[XB_XCNT(j)]); sum += c; cnt += (c > 0u) ? 1u : 0u; mine = (j == x) ? c : mine; }
        if (sum == G) break;
        __builtin_amdgcn_s_sleep(1);
        if ((++sp & 255u) == 0u) { if (xb_ld(&bar[XB_TMO])) break; if (sp > XB_SPIN_CAP) { atomicAdd(&bar[XB_TMO], 1u); break; } }
    }
    nloc = mine > 0u ? mine : 1u; nx = cnt > 0u ? cnt : 1u;
}

__device__ __forceinline__ void xcd_barrier(const XcdBarrier& b) {
    asm volatile("s_waitcnt vmcnt(0)" ::: "memory");
    __syncthreads();
    if (threadIdx.x == 0) {
        unsigned* bar = b.bar;
        __builtin_amdgcn_s_waitcnt(0);
        unsigned nloc = b.st[0], nx = b.st[1];
        if (nloc == 0u) { xcd_barrier_complete(bar, b.x, nloc, nx); b.st[0] = nloc; b.st[1] = nx; }
        const unsigned old = xb_add(&bar[XB_XSUB(b.x)], 1u);
        const unsigned gen = old / nloc;
        if (old + 1u == (gen + 1u) * nloc) {
            __builtin_amdgcn_fence(__ATOMIC_RELEASE, "agent");
            asm volatile("s_waitcnt vmcnt(0)" ::: "memory");
            const unsigned og = xb_add(&bar[XB_TOP], 1u);
            const unsigned tg = og / nx;
            if (og + 1u == (tg + 1u) * nx) xb_add(&bar[XB_TOPGEN], 1u);
            else XB_SPIN(xb_ld(&bar[XB_TOPGEN]) == tg, bar);
            __builtin_amdgcn_fence(__ATOMIC_ACQUIRE, "agent");
            xb_add(&bar[XB_XGEN(b.x)], 1u);
            asm volatile("s_waitcnt vmcnt(0)" ::: "memory");
        } else {
            XB_SPIN(xb_ld(&bar[XB_XGEN(b.x)]) == gen, bar);
            __builtin_amdgcn_fence(__ATOMIC_ACQUIRE, "agent");
            asm volatile("s_waitcnt vmcnt(0)" ::: "memory");
        }
    }
    __syncthreads();
}

namespace mk {
using pg8::bf16_t; using pg8::bf16x8; using pg8::f32x4; using pg8::u32x4;
typedef unsigned u32x2 __attribute__((ext_vector_type(2)));
typedef __bf16 bf16x2_t __attribute__((ext_vector_type(2)));
typedef LAS unsigned char* lds_t;

constexpr int DM = 1024, NLAT = 16384, NROW = 16896;
constexpr int OFF_B = 512, OFF_C = 1024, OFF_D = 2056, INC = 3208, NP = 3328;
constexpr int NCH = 132, NSLOT = 16 * NCH;
constexpr int NEXP = 16384;

constexpr size_t WS_CTL  = 0;
constexpr size_t WS_MOD  = 65536;
constexpr size_t WS_WIN  = WS_MOD + 147456;
constexpr size_t WS_WOUT = WS_WIN + 2ull * NP * DM * 2;
constexpr size_t WS_WQ   = WS_WOUT + 2ull * DM * DM * 2;
constexpr size_t WS_H    = WS_WQ + 2ull * 2048 * DM * 2;
constexpr size_t WS_ACT  = WS_H + (size_t)NROW * DM * 4;
constexpr size_t WS_UB   = WS_ACT + (size_t)NROW * DM * 2;
constexpr size_t WS_VB   = WS_UB + (size_t)NEXP * DM * 2;
constexpr size_t WS_SU   = WS_UB + (size_t)NEXP * DM;
constexpr size_t WS_SV   = WS_VB + (size_t)NEXP * DM;
constexpr size_t WS_P    = WS_VB + (size_t)NEXP * DM * 2;
constexpr size_t WS_Q    = WS_P;
constexpr size_t WS_SELI = WS_Q + (size_t)NROW * 2048 * 2;
constexpr size_t WS_SELG = WS_SELI + (size_t)NROW * 128 * 4;
constexpr size_t WS_MST  = WS_P + (size_t)NROW * NP * 2;
constexpr size_t WS_MCD  = WS_MST + (size_t)NSLOT * 8192 * 4;
constexpr size_t WS_RG   = WS_MCD + 16384;
constexpr size_t WS_RJ   = WS_RG + (size_t)NSLOT * 8192;
constexpr size_t WS_RY   = WS_RJ + (size_t)NSLOT * 16384;
constexpr size_t WS_RL   = WS_RY + (size_t)NSLOT * 8192;
constexpr size_t WS_RH   = WS_RL + (size_t)NSLOT * 8192;
constexpr size_t WS_BON  = WS_RH + (size_t)NSLOT * 8192;
constexpr size_t WS_END  = WS_BON + (size_t)NROW * 8 * 4;
static_assert(WS_SELG + (size_t)NROW * 128 * 4 <= WS_MST, "Q + selections must fit in P's region");

constexpr int LDS_BYTES = 157440;
constexpr int LDS_XB = 157184;

struct Args { const float* in[42]; float* out; unsigned char* ws; int ph_lo, ph_hi; };

struct Ctx {
    const float* const* in; float* out; unsigned char* ws; lds_t lds;
    int tid, lane, wid, bid, G;
};

__device__ __forceinline__ float bf2f(unsigned short x) { return __uint_as_float(((unsigned)x) << 16); }
__device__ __forceinline__ float bflo(unsigned w) { return __uint_as_float(w << 16); }
__device__ __forceinline__ float bfhi(unsigned w) { return __uint_as_float(w & 0xffff0000u); }
typedef __bf16 bf16pair_t __attribute__((ext_vector_type(2)));
__device__ __forceinline__ unsigned pk2(float lo, float hi) { const bf16pair_t v = {(__bf16)lo, (__bf16)hi}; return __builtin_bit_cast(unsigned, v); }
__device__ __forceinline__ unsigned short f2bf(float f) { return (unsigned short)(pk2(f, 0.f) & 0xffffu); }
__device__ __forceinline__ float wave_sum(float v) {
#pragma unroll
    for (int o = 1; o < 64; o <<= 1) v += __shfl_xor(v, o);
    return v;
}
__device__ __forceinline__ float wave_incl_scan(float v, int lane) {
#pragma unroll
    for (int o = 1; o < 64; o <<= 1) { const float t = __shfl_up(v, o); v += (lane >= o) ? t : 0.f; }
    return v;
}
__device__ __forceinline__ float fexp(float x) { return __expf(x); }
__device__ __forceinline__ float frcp(float x) { return __builtin_amdgcn_rcpf(x); }
__device__ __forceinline__ float sigm(float x) { return frcp(1.f + __expf(-x)); }
__device__ __forceinline__ float silu(float x) { return x * frcp(1.f + __expf(-x)); }
__device__ __forceinline__ float softplus(float x) { return fmaxf(x, 0.f) + __logf(1.f + __expf(-fabsf(x))); }
__device__ __forceinline__ float ftanh(float x) { const float e = __expf(-2.f * fabsf(x)); const float t = (1.f - e) * frcp(1.f + e); return x < 0.f ? -t : t; }
__device__ __forceinline__ float gelu_tanh(float x) { const float u = 0.7978845608028654f * (x + 0.044715f * x * x * x); return 0.5f * x * (1.f + ftanh(u)); }
__device__ __forceinline__ float dot2bf(unsigned a, unsigned b, float acc) { return __builtin_amdgcn_fdot2_f32_bf16(__builtin_bit_cast(bf16x2_t, a), __builtin_bit_cast(bf16x2_t, b), acc, false); }

struct ChunkInfo { int row0, lo, hi, b, tc, isctx; };
__device__ __forceinline__ ChunkInfo chunk_info(int gc) {
    ChunkInfo c; c.row0 = gc * 64;
    if (gc < 256) { c.b = gc >> 7; c.tc = gc & 127; c.isctx = 0; c.lo = c.b * 8192; c.hi = c.lo + 8192; }
    else { const int q = gc - 256; c.b = q >> 2; c.tc = q & 3; c.isctx = 1; c.lo = NLAT + c.b * 256; c.hi = c.lo + 256; }
    return c;
}
__device__ __forceinline__ int cpos_of(const ChunkInfo& c, int d) { return c.isctx ? (d ? 3 - c.tc : c.tc) : (d ? 4 + 127 - c.tc : 4 + c.tc); }
__device__ __forceinline__ int slot_of(int b, int h, int d, int cpos) { return ((b * 4 + h) * 2 + d) * NCH + cpos; }

template <int MT, int NT, int KS, class Epi>
__device__ __forceinline__ void blk_mma(const LAS bf16_t* A, int lda, const LAS bf16_t* Bt, int ldb, int wid, int lane, Epi epi) {
    const int fr = lane & 15, fq = lane >> 4;
    for (int tt = wid; tt < MT * NT; tt += 8) {
        const int tm = tt / NT, tn = tt % NT;
        f32x4 acc = {0.f, 0.f, 0.f, 0.f};
#pragma unroll
        for (int ks = 0; ks < KS; ++ks) {
            const bf16x8 a = *(const LAS bf16x8*)(A + (tm * 16 + fr) * lda + ks * 32 + fq * 8);
            const bf16x8 b = *(const LAS bf16x8*)(Bt + (tn * 16 + fr) * ldb + ks * 32 + fq * 8);
            acc = __builtin_amdgcn_mfma_f32_16x16x32_bf16(a, b, acc, 0, 0, 0);
        }
        epi(tm * 16 + fq * 4, tn * 16 + fr, acc);
    }
}
template <int MT, int NT, int KS, class Epi>
__device__ __forceinline__ void blk_mma2(const LAS bf16_t* A1, const LAS bf16_t* B1, const LAS bf16_t* A2, const LAS bf16_t* B2, int ld, int wid, int lane, Epi epi) {
    const int fr = lane & 15, fq = lane >> 4;
    for (int tt = wid; tt < MT * NT; tt += 8) {
        const int tm = tt / NT, tn = tt % NT;
        f32x4 acc1 = {0.f, 0.f, 0.f, 0.f}, acc2 = {0.f, 0.f, 0.f, 0.f};
#pragma unroll
        for (int ks = 0; ks < KS; ++ks) {
            const bf16x8 a1 = *(const LAS bf16x8*)(A1 + (tm * 16 + fr) * ld + ks * 32 + fq * 8);
            const bf16x8 b1 = *(const LAS bf16x8*)(B1 + (tn * 16 + fr) * ld + ks * 32 + fq * 8);
            acc1 = __builtin_amdgcn_mfma_f32_16x16x32_bf16(a1, b1, acc1, 0, 0, 0);
            const bf16x8 a2 = *(const LAS bf16x8*)(A2 + (tm * 16 + fr) * ld + ks * 32 + fq * 8);
            const bf16x8 b2 = *(const LAS bf16x8*)(B2 + (tn * 16 + fr) * ld + ks * 32 + fq * 8);
            acc2 = __builtin_amdgcn_mfma_f32_16x16x32_bf16(a2, b2, acc2, 0, 0, 0);
        }
        epi(tm * 16 + fq * 4, tn * 16 + fr, acc1, acc2);
    }
}

__device__ __forceinline__ void transpose_item(const float* W, int K, int N, int nblk, bf16_t* WT, LAS float* scr, int item, int lane) {
    const int kb = item / nblk, nb = item % nblk, k0 = 64 * kb, n0 = 32 * nb;
    const int nn = n0 + (lane & 31);
#pragma unroll 8
    for (int i = 0; i < 32; ++i) { const int kk = 2 * i + (lane >> 5); scr[kk * 33 + (lane & 31)] = (nn < N) ? W[(size_t)(k0 + kk) * N + nn] : 0.f; }
    asm volatile("s_waitcnt lgkmcnt(0)" ::: "memory");
    const int c = lane & 7;
#pragma unroll
    for (int j = 0; j < 4; ++j) { const int n = (lane >> 3) + 8 * j; const LAS float* s = scr + (8 * c) * 33 + n;
        u32x4 o; o.x = pk2(s[0 * 33], s[1 * 33]); o.y = pk2(s[2 * 33], s[3 * 33]); o.z = pk2(s[4 * 33], s[5 * 33]); o.w = pk2(s[6 * 33], s[7 * 33]);
        *(u32x4*)(WT + (size_t)(n0 + n) * K + k0 + 8 * c) = o; }
    asm volatile("s_waitcnt lgkmcnt(0)" ::: "memory");
}
__device__ __forceinline__ float wave_maxf(float v) {
#pragma unroll
    for (int o = 1; o < 64; o <<= 1) v = fmaxf(v, __shfl_xor(v, o));
    return v;
}
__device__ __forceinline__ void convert_tables(const Ctx& C, int layer, int rank, int nrank) {
    const float* U = C.in[39] + (size_t)layer * NEXP * DM; const float* V = C.in[40] + (size_t)layer * NEXP * DM;
    unsigned char* UB = C.ws + WS_UB; unsigned char* VB = C.ws + WS_VB; float* SU = (float*)(C.ws + WS_SU); float* SV = (float*)(C.ws + WS_SV);
    for (int r4 = (rank * 8 + C.wid) * 4; r4 < 2 * NEXP; r4 += nrank * 8 * 4) {
        const bool isv = r4 >= NEXP; const int row0 = isv ? r4 - NEXP : r4;
        const float* src = (isv ? V : U) + (size_t)row0 * DM + 16 * C.lane;
        f32x4 x[4][4];
#pragma unroll
        for (int q = 0; q < 4; ++q)
#pragma unroll
            for (int k = 0; k < 4; ++k) x[q][k] = *(const f32x4*)(src + (size_t)q * DM + 4 * k);
#pragma unroll
        for (int q = 0; q < 4; ++q) {
            float m = 0.f;
#pragma unroll
            for (int k = 0; k < 4; ++k) m = fmaxf(fmaxf(m, fmaxf(fabsf(x[q][k].x), fabsf(x[q][k].y))), fmaxf(fabsf(x[q][k].z), fabsf(x[q][k].w)));
            m = wave_maxf(m);
            const float sc = m > 0.f ? 224.f / m : 1.f;
            u32x4 o;
#pragma unroll
            for (int k = 0; k < 4; ++k) { int w = __builtin_amdgcn_cvt_pk_fp8_f32(x[q][k].x * sc, x[q][k].y * sc, 0, false); w = __builtin_amdgcn_cvt_pk_fp8_f32(x[q][k].z * sc, x[q][k].w * sc, w, true); o[k] = (unsigned)w; }
            *(u32x4*)((isv ? VB : UB) + (size_t)(row0 + q) * DM + 16 * C.lane) = o;
            if (C.lane == 0) (isv ? SV : SU)[row0 + q] = m > 0.f ? m * (1.f / 224.f) : 1.f;
        }
    }
}
__device__ __forceinline__ void ph_prologue(const Ctx& C) {
    const int gw = C.bid * 8 + C.wid, NGW = C.G * 8;
    {
        LAS float* scr = (LAS float*)(C.lds + C.wid * 16384);
        bf16_t* WIN = (bf16_t*)(C.ws + WS_WIN); bf16_t* WOUT = (bf16_t*)(C.ws + WS_WOUT); bf16_t* WQ = (bf16_t*)(C.ws + WS_WQ);
        for (int it = gw; it < 6400; it += NGW) {
            const int layer = it / 3200; int r = it % 3200;
            if (r < 1664) { transpose_item(C.in[8] + (size_t)layer * DM * INC, DM, INC, 104, WIN + (size_t)layer * NP * DM, scr, r, C.lane); continue; } r -= 1664;
            if (r < 512) { transpose_item(C.in[9] + (size_t)layer * DM * DM, DM, DM, 32, WOUT + (size_t)layer * DM * DM, scr, r, C.lane); continue; } r -= 512;
            transpose_item(C.in[36] + (size_t)layer * DM * 2048, DM, 2048, 64, WQ + (size_t)layer * 2048 * DM, scr, r, C.lane);
        }
    }
    __syncthreads();
    {
        LAS float* sv = (LAS float*)C.lds;
        LAS float* red = (LAS float*)(C.lds + 12288);
        for (int i = C.tid; i < 3 * 1024; i += 512) { const int w = i >> 10, k = i & 1023; const float x = (w < 2) ? C.in[1][w * 1024 + k] : C.in[3][k]; sv[i] = silu(x); }
        __syncthreads();
        float* MOD = (float*)(C.ws + WS_MOD);
        for (int it = C.bid; it < 192; it += C.G) {
            const int layer = it / 96, col0 = (it % 96) * 64, col = C.tid & 63, kg = C.tid >> 6;
            const float* W = C.in[4] + (size_t)layer * DM * 6144 + col0 + col;
            float a0 = 0.f, a1 = 0.f, a2 = 0.f;
#pragma unroll 32
            for (int k = kg * 128; k < kg * 128 + 128; ++k) { const float w = W[(size_t)k * 6144]; a0 += sv[k] * w; a1 += sv[1024 + k] * w; a2 += sv[2048 + k] * w; }
            red[(kg * 3 + 0) * 64 + col] = a0; red[(kg * 3 + 1) * 64 + col] = a1; red[(kg * 3 + 2) * 64 + col] = a2;
            __syncthreads();
            if (C.tid < 192) { const int w = C.tid >> 6, c2 = C.tid & 63; float s = 0.f;
#pragma unroll
                for (int g = 0; g < 8; ++g) s += red[(g * 3 + w) * 64 + c2];
                MOD[((size_t)layer * 3 + w) * 6144 + col0 + c2] = s + C.in[5][layer * 6144 + col0 + c2]; }
            __syncthreads();
        }
    }
    {
        float* H = (float*)(C.ws + WS_H);
        const size_t n4 = (size_t)NROW * 256;
        for (size_t i = (size_t)C.bid * 512 + C.tid; i < n4; i += (size_t)C.G * 512) {
            const int row = (int)(i >> 8), c4 = (int)(i & 255) * 4;
            f32x4 v;
            if (row < NLAT) {
                v = *(const f32x4*)(C.in[0] + (size_t)row * DM + c4);
                const int t = row & 8191, quarter = c4 >> 8; const float pos = (quarter < 2) ? (float)(t >> 6) : (float)(t & 63);
                float e[4];
#pragma unroll
                for (int j = 0; j < 4; ++j) { const int jj = (c4 & 255) + j; const float fr = exp2f(-(float)jj * (13.287712379549449f / 256.f)); const float a = pos * fr; e[j] = (quarter & 1) ? cosf(a) : sinf(a); }
                v.x += e[0]; v.y += e[1]; v.z += e[2]; v.w += e[3];
            } else v = *(const f32x4*)(C.in[2] + (size_t)(row - NLAT) * DM + c4);
            *(f32x4*)(H + (size_t)row * DM + c4) = v;
        }
    }
}

struct Row16 { float v[16]; };
__device__ __forceinline__ Row16 load_row16(const float* p, int lane) {
    Row16 r; const f32x4 a = *(const f32x4*)(p + 8 * lane), b = *(const f32x4*)(p + 8 * lane + 4), c = *(const f32x4*)(p + 512 + 8 * lane), d = *(const f32x4*)(p + 512 + 8 * lane + 4);
    r.v[0] = a.x; r.v[1] = a.y; r.v[2] = a.z; r.v[3] = a.w; r.v[4] = b.x; r.v[5] = b.y; r.v[6] = b.z; r.v[7] = b.w;
    r.v[8] = c.x; r.v[9] = c.y; r.v[10] = c.z; r.v[11] = c.w; r.v[12] = d.x; r.v[13] = d.y; r.v[14] = d.z; r.v[15] = d.w; return r;
}
__device__ __forceinline__ void store_row16_f32(float* p, int lane, const Row16& r) {
    *(f32x4*)(p + 8 * lane) = (f32x4){r.v[0], r.v[1], r.v[2], r.v[3]}; *(f32x4*)(p + 8 * lane + 4) = (f32x4){r.v[4], r.v[5], r.v[6], r.v[7]};
    *(f32x4*)(p + 512 + 8 * lane) = (f32x4){r.v[8], r.v[9], r.v[10], r.v[11]}; *(f32x4*)(p + 512 + 8 * lane + 4) = (f32x4){r.v[12], r.v[13], r.v[14], r.v[15]};
}
__device__ __forceinline__ void store_row16_bf16(bf16_t* p, int lane, const Row16& r) {
    u32x4 a, b; a.x = pk2(r.v[0], r.v[1]); a.y = pk2(r.v[2], r.v[3]); a.z = pk2(r.v[4], r.v[5]); a.w = pk2(r.v[6], r.v[7]);
    b.x = pk2(r.v[8], r.v[9]); b.y = pk2(r.v[10], r.v[11]); b.z = pk2(r.v[12], r.v[13]); b.w = pk2(r.v[14], r.v[15]);
    *(u32x4*)(p + 8 * lane) = a; *(u32x4*)(p + 512 + 8 * lane) = b;
}
__device__ __forceinline__ Row16 norm_mod_row(const Row16& x, const float* g, const float* shift, const float* scale, int lane) {
    float ss = 0.f;
#pragma unroll
    for (int i = 0; i < 16; ++i) ss += x.v[i] * x.v[i];
    const float rs = rsqrtf(wave_sum(ss) * (1.f / 1024.f) + 1e-6f);
    const Row16 gg = load_row16(g, lane), sh = load_row16(shift, lane), sc = load_row16(scale, lane);
    Row16 o;
#pragma unroll
    for (int i = 0; i < 16; ++i) o.v[i] = (x.v[i] * rs * gg.v[i]) * (1.f + sc.v[i]) + sh.v[i];
    return o;
}
__device__ __forceinline__ int which_of(int row) { return row < 8192 ? 0 : (row < NLAT ? 1 : 2); }
__device__ __forceinline__ void ph_norm(const Ctx& C, int layer, const float* gain, int sidx, int nrows) {
    const float* H = (const float*)(C.ws + WS_H); bf16_t* ACT = (bf16_t*)(C.ws + WS_ACT); const float* MOD = (const float*)(C.ws + WS_MOD);
    for (int row = C.bid * 8 + C.wid; row < nrows; row += C.G * 8) {
        const float* m = MOD + ((size_t)layer * 3 + which_of(row)) * 6144;
        const Row16 x = load_row16(H + (size_t)row * DM, C.lane);
        const Row16 o = norm_mod_row(x, gain, m + sidx * 1024, m + (sidx + 1) * 1024, C.lane);
        store_row16_bf16(ACT + (size_t)row * DM, C.lane, o);
    }
}
struct EpiResid {
    static constexpr bool PERM = false, AFTER_DRAIN = false;
    float* H; const float* modl;
    __device__ __forceinline__ void operator()(const f32x4 (&acc)[2][2][4][2], const pg8::Unit& u, int wr, int wc, int fr, int fq) const {
        const int row0 = u.pm * 256 + wr * 64 + fr, col0 = u.pn * 256 + wc * 32 + 4 * fq;
        const int which = u.pm < 32 ? 0 : (u.pm < 64 ? 1 : 2);
        const float* gate = modl + ((size_t)which * 6 + 2) * 1024;
        f32x4 gv[2][2];
#pragma unroll
        for (int bj = 0; bj < 2; ++bj)
#pragma unroll
            for (int n = 0; n < 2; ++n) gv[bj][n] = *(const f32x4*)(gate + col0 + bj * 128 + n * 16);
#pragma unroll
        for (int ai = 0; ai < 2; ++ai)
#pragma unroll
            for (int m = 0; m < 4; ++m) { float* rowp = H + (size_t)(row0 + ai * 128 + m * 16) * DM + col0;
#pragma unroll
                for (int bj = 0; bj < 2; ++bj)
#pragma unroll
                    for (int n = 0; n < 2; ++n) { f32x4* p = (f32x4*)(rowp + bj * 128 + n * 16); *p = *p + gv[bj][n] * acc[ai][bj][m][n]; } }
    }
};

__device__ __forceinline__ void item_conformer(const Ctx& C, int layer, int gc) {
    const ChunkInfo ci = chunk_info(gc);
    const bf16_t* P = (const bf16_t*)(C.ws + WS_P); bf16_t* YC = (bf16_t*)(C.ws + WS_ACT);
    LAS bf16_t* HG = (LAS bf16_t*)C.lds;
    LAS float* CO = (LAS float*)(C.lds + 49152);
    for (int e = C.tid; e < 94 * 128; e += 512) {
        const int rr = e >> 7, cp = e & 127, grow = ci.row0 - 15 + rr;
        unsigned o = 0u;
        if (grow >= ci.lo && grow < ci.hi) {
            const unsigned v = *(const unsigned*)(P + (size_t)grow * NP + 2 * cp), g = *(const unsigned*)(P + (size_t)grow * NP + 256 + 2 * cp);
            o = pk2(bflo(v) * sigm(bflo(g)), bfhi(v) * sigm(bfhi(g)));
        }
        *(LAS unsigned*)(HG + rr * 256 + 2 * cp) = o;
    }
    __syncthreads();
    {
        const int c = C.tid & 255, half = C.tid >> 8;
        const float* cw = C.in[10] + (size_t)layer * 31 * 256 + c;
        float w[31];
#pragma unroll
        for (int j = 0; j < 31; ++j) w[j] = cw[j * 256];
        const float bias = C.in[11][layer * 256 + c];
        for (int tt = 0; tt < 32; ++tt) {
            const int t = half * 32 + tt; float acc = bias;
#pragma unroll
            for (int j = 0; j < 31; ++j) acc += w[j] * bf2f(HG[(t + j) * 256 + c]);
            CO[t * 256 + c] = acc;
        }
    }
    __syncthreads();
    {
        const float* lg = C.in[12] + layer * 256 + 4 * C.lane; const float* lb = C.in[13] + layer * 256 + 4 * C.lane;
        const f32x4 g4 = *(const f32x4*)lg, b4 = *(const f32x4*)lb;
        for (int i = 0; i < 8; ++i) {
            const int t = C.wid * 8 + i;
            const f32x4 x = *(const LAS f32x4*)(CO + t * 256 + 4 * C.lane);
            const float mean = wave_sum((x.x + x.y) + (x.z + x.w)) * (1.f / 256.f);
            const f32x4 d = x - mean;
            const float var = wave_sum((d.x * d.x + d.y * d.y) + (d.z * d.z + d.w * d.w)) * (1.f / 256.f);
            const float rs = rsqrtf(var + 1e-5f);
            const f32x4 y = d * rs * g4 + b4;
            u32x2 o; o.x = pk2(silu(y.x), silu(y.y)); o.y = pk2(silu(y.z), silu(y.w));
            *(u32x2*)(YC + (size_t)(ci.row0 + t) * DM + 4 * C.lane) = o;
        }
    }
    __syncthreads();
}

__device__ __forceinline__ void item_chunkmlp(const Ctx& C, int layer, int gb) {
    const int row0 = gb * 128;
    const bf16_t* P = (const bf16_t*)(C.ws + WS_P); bf16_t* YC = (bf16_t*)(C.ws + WS_ACT);
    LAS bf16_t* VNT = (LAS bf16_t*)C.lds;
    LAS bf16_t* WS = (LAS bf16_t*)(C.lds + 69632);
    {
        const f32x4 g4 = *(const f32x4*)(C.in[14] + layer * 256 + 4 * C.lane), b4 = *(const f32x4*)(C.in[15] + layer * 256 + 4 * C.lane);
        for (int i = 0; i < 16; ++i) {
            const int j = C.wid * 16 + i;
            const u32x2 raw = *(const u32x2*)(P + (size_t)(row0 + j) * NP + 768 + 4 * C.lane);
            const f32x4 x = {bflo(raw.x), bfhi(raw.x), bflo(raw.y), bfhi(raw.y)};
            const float mean = wave_sum((x.x + x.y) + (x.z + x.w)) * (1.f / 256.f);
            const f32x4 d = x - mean;
            const float var = wave_sum((d.x * d.x + d.y * d.y) + (d.z * d.z + d.w * d.w)) * (1.f / 256.f);
            const f32x4 y = d * rsqrtf(var + 1e-5f) * g4 + b4;
            VNT[(4 * C.lane + 0) * 136 + j] = f2bf(y.x); VNT[(4 * C.lane + 1) * 136 + j] = f2bf(y.y);
            VNT[(4 * C.lane + 2) * 136 + j] = f2bf(y.z); VNT[(4 * C.lane + 3) * 136 + j] = f2bf(y.w);
        }
    }
    for (int h = 0; h < 4; ++h) {
        const float* ws = C.in[16] + ((size_t)layer * 4 + h) * 128 * 128;
        for (int e = C.tid; e < 4096; e += 512) { const int i = e >> 5, j4 = (e & 31) * 4; const f32x4 w = *(const f32x4*)(ws + i * 128 + j4);
            u32x2 o; o.x = pk2(w.x, w.y); o.y = pk2(w.z, w.w); *(LAS u32x2*)(WS + i * 136 + j4) = o; }
        __syncthreads();
        const float* bs = C.in[17] + ((size_t)layer * 4 + h) * 128;
        blk_mma<8, 4, 4>(WS, 136, VNT + h * 64 * 136, 136, C.wid, C.lane, [=](int r0, int col, const f32x4& acc) {
#pragma unroll
            for (int jj = 0; jj < 4; ++jj) { const int i = r0 + jj; const size_t row = (size_t)(row0 + i);
                const float u = bf2f(P[row * NP + 512 + h * 64 + col]);
                YC[row * DM + 256 + h * 64 + col] = f2bf((acc[jj] + bs[i]) * u); }
        });
        __syncthreads();
    }
}

__device__ __forceinline__ void item_mamba_local(const Ctx& C, int layer, int gc) {
    const ChunkInfo ci = chunk_info(gc);
    const bf16_t* P = (const bf16_t*)(C.ws + WS_P);
    bf16_t* MSTb = (bf16_t*)(C.ws + WS_MST); float* MCD = (float*)(C.ws + WS_MCD);
    LAS float* DA = (LAS float*)C.lds;
    LAS float* DT = (LAS float*)(C.lds + 2048);
    LAS float* FAC = (LAS float*)(C.lds + 4096);
    LAS bf16_t* XDT = (LAS bf16_t*)(C.lds + 8192);
    LAS bf16_t* BTT = (LAS bf16_t*)(C.lds + 8192 + 73728);
    {
        const int s = C.lane, dh = C.wid, d = dh >> 2, h = dh & 3;
        const float raw = bf2f(P[(size_t)(ci.row0 + s) * NP + OFF_C + 1024 + dh]);
        const float dt = softplus(raw + C.in[20][layer * 8 + dh]);
        const float da = dt * (-expf(C.in[21][layer * 8 + dh]));
        const float incl = wave_incl_scan(da, s), total = __shfl(incl, 63);
        DT[dh * 64 + s] = dt; DA[dh * 64 + s] = da;
        FAC[dh * 64 + s] = d ? fexp(incl - da) : fexp(total - incl);
        if (s == 0) MCD[slot_of(ci.b, h, d, cpos_of(ci, d))] = expf(total);
    }
    __syncthreads();
    {
        const int cp = C.tid & 255, half = C.tid >> 8, c0 = 2 * cp;
        const float* cw = C.in[18] + (size_t)layer * 5 * 768 + c0; const float* cb = C.in[19] + layer * 768 + c0;
        float w0[5], w1[5];
#pragma unroll
        for (int j = 0; j < 5; ++j) { w0[j] = cw[j * 768]; w1[j] = cw[j * 768 + 1]; }
        const float b0 = cb[0], b1 = cb[1];
        const int s0 = half * 32;
        unsigned win[5];
#pragma unroll
        for (int j = 0; j < 4; ++j) { const int row = ci.row0 + s0 - 2 + j; win[j + 1] = (row >= ci.lo && row < ci.hi) ? *(const unsigned*)(P + (size_t)row * NP + OFF_C + 256 + c0) : 0u; }
        for (int tt = 0; tt < 32; ++tt) {
            const int s = s0 + tt;
#pragma unroll
            for (int j = 0; j < 4; ++j) win[j] = win[j + 1];
            { const int row = ci.row0 + s + 2; win[4] = (row >= ci.lo && row < ci.hi) ? *(const unsigned*)(P + (size_t)row * NP + OFF_C + 256 + c0) : 0u; }
            float a0 = b0, a1 = b1;
#pragma unroll
            for (int j = 0; j < 5; ++j) { a0 += w0[j] * bflo(win[j]); a1 += w1[j] * bfhi(win[j]); }
            a0 = silu(a0); a1 = silu(a1);
            if (c0 < 256) { const int h = c0 >> 6;
#pragma unroll
                for (int d = 0; d < 2; ++d) { const float f = DT[(d * 4 + h) * 64 + s] * FAC[(d * 4 + h) * 64 + s];
                    XDT[(d * 256 + c0) * 72 + s] = f2bf(a0 * f); XDT[(d * 256 + c0 + 1) * 72 + s] = f2bf(a1 * f); }
            } else { const int q = c0 - 256; BTT[q * 72 + s] = f2bf(a0); BTT[(q + 1) * 72 + s] = f2bf(a1); }
        }
    }
    __syncthreads();
    for (int hd = 0; hd < 8; ++hd) {
        const int d = hd >> 2, h = hd & 3;
        bf16_t* dst = MSTb + (size_t)slot_of(ci.b, h, d, cpos_of(ci, d)) * 8192;
        blk_mma<8, 4, 2>(BTT + (h >> 1) * 128 * 72, 72, XDT + (d * 256 + h * 64) * 72, 72, C.wid, C.lane, [=](int r0, int col, const f32x4& acc) {
            u32x2 o; o.x = pk2(acc[0], acc[1]); o.y = pk2(acc[2], acc[3]); *(u32x2*)(dst + col * 128 + r0) = o;
        });
    }
    __syncthreads();
}


#ifndef MK_DIAG2
#define MK_DIAG2 0
#endif
#if MK_DIAG2
#define DBGF(stage, cond) do { if (cond) atomicOr((unsigned*)(C.ws + 32768) + (stage), 1u); } while (0)
#define DBGL(stage, cond) do { if (cond) atomicOr(dbgflags + (stage), 1u); } while (0)
#else
#define DBGF(stage, cond) do {} while (0)
#define DBGL(stage, cond) do {} while (0)
#endif
__device__ __forceinline__ bool badv(float x, float lim) { return !(fabsf(x) < lim); }
__device__ __forceinline__ void tri_inverse(const LAS float* ABf, LAS float* Tf, LAS float* Rt, LAS bf16_t* TT, int tid, int wid, int lane) {
    if (wid == 0) {
        const int bi = lane >> 4, j = lane & 15; const LAS float* Ab = ABf + (16 * bi) * 68 + 16 * bi;
        float col[16];
#pragma unroll
        for (int r = 0; r < 16; ++r) { float acc = (r == j) ? 1.f : 0.f;
#pragma unroll
            for (int s = 0; s < r; ++s) acc -= Ab[r * 68 + s] * col[s];
            col[r] = acc; }
#pragma unroll
        for (int r = 0; r < 16; ++r) Tf[(16 * bi + r) * 68 + 16 * bi + j] = col[r];
    } else {
        for (int e = tid - 64; e < 64 * 64; e += 448) { const int t = e >> 6, s2 = e & 63; if ((s2 >> 4) > (t >> 4)) Tf[t * 68 + s2] = 0.f; }
    }
    __syncthreads();
    if (wid < 3) {
        const int tn = wid, fr = lane & 15, fq = lane >> 4;
        LAS float* Rw = Rt + wid * 320;
        for (int i = tn + 1; i < 4; ++i) {
            f32x4 acc = {0.f, 0.f, 0.f, 0.f};
            for (int k = 16 * tn; k < 16 * i; k += 4) acc = __builtin_amdgcn_mfma_f32_16x16x4f32(ABf[(16 * i + fr) * 68 + k + fq], Tf[(k + fq) * 68 + 16 * tn + fr], acc, 0, 0, 0);
#pragma unroll
            for (int j = 0; j < 4; ++j) Rw[(fq * 4 + j) * 20 + fr] = -acc[j];
            asm volatile("s_waitcnt lgkmcnt(0)" ::: "memory");
            f32x4 t = {0.f, 0.f, 0.f, 0.f};
#pragma unroll
            for (int k = 0; k < 16; k += 4) t = __builtin_amdgcn_mfma_f32_16x16x4f32(Tf[(16 * i + fr) * 68 + 16 * i + k + fq], Rw[(k + fq) * 20 + fr], t, 0, 0, 0);
#pragma unroll
            for (int j = 0; j < 4; ++j) Tf[(16 * i + fq * 4 + j) * 68 + 16 * tn + fr] = t[j];
            asm volatile("s_waitcnt lgkmcnt(0)" ::: "memory");
        }
    }
    __syncthreads();
    for (int e = tid; e < 4096; e += 512) { const int t = e >> 6, s2 = e & 63; TT[t * 72 + s2] = f2bf(Tf[t * 68 + s2]); }
}
constexpr int D1_LW = 0, D1_CS = 17408, D1_AA = 34816, D1_RB = 52224, D1_KB = 61440, D1_VB = 70656, D1_TW = 79872, D1_AD = 89088, D1_W2T = 98304, D1_A2T = 107520;
constexpr int D1_Y = 82944;
constexpr int D1_ABF = 0, D1_AK = 17408, D1_ARK = 26624, D1_ARB = 35840, D1_TT = 45056, D1_W1T = 54272, D1_AKVT = 63488, D1_W2TT = 72704;
constexpr int D1_GL = 156672;
__device__ __forceinline__ void item_rwkv_local(const Ctx& C0_, int layer, int it) {
    Ctx C = C0_; { int t_ = C0_.tid; asm volatile("" : "+v"(t_)); C.tid = t_; C.lane = t_ & 63; C.wid = __builtin_amdgcn_readfirstlane(t_ >> 6); }
#define D1_RELAUNDER() do { int t_ = C.tid; asm volatile("" : "+v"(t_)); C.tid = t_; C.lane = t_ & 63; C.wid = __builtin_amdgcn_readfirstlane(t_ >> 6); } while (0)
    const int gc = it >> 3, hd = it & 7, h = hd & 3, d = hd >> 2;
    const ChunkInfo ci = chunk_info(gc);
    const int slot = slot_of(ci.b, h, d, cpos_of(ci, d));
    const bf16_t* P = (const bf16_t*)(C.ws + WS_P);
    const float* mup = C.in[24] + layer * 1152; const float* mun = C.in[25] + layer * 1152;
    lds_t L = C.lds;
    LAS float* LW = (LAS float*)(L + D1_LW); LAS float* CS = (LAS float*)(L + D1_CS); LAS float* AA = (LAS float*)(L + D1_AA); LAS float* GL = (LAS float*)(L + D1_GL);
    LAS bf16_t* Rb = (LAS bf16_t*)(L + D1_RB); LAS bf16_t* Kb = (LAS bf16_t*)(L + D1_KB); LAS bf16_t* Vb = (LAS bf16_t*)(L + D1_VB);
    LAS bf16_t* TW = (LAS bf16_t*)(L + D1_TW); LAS bf16_t* AD = (LAS bf16_t*)(L + D1_AD); LAS bf16_t* W2T = (LAS bf16_t*)(L + D1_W2T); LAS bf16_t* A2T = (LAS bf16_t*)(L + D1_A2T);
    LAS bf16_t* KT = (LAS bf16_t*)(L + D1_Y); LAS bf16_t* KTt = KT + 4608; LAS bf16_t* KD = KT + 2 * 4608; LAS bf16_t* KDt = KT + 3 * 4608;
    LAS bf16_t* BT = KT + 4 * 4608; LAS bf16_t* BTt = KT + 5 * 4608; LAS bf16_t* RT = KT + 6 * 4608; LAS bf16_t* Vt = KT + 7 * 4608;
    LAS float* ABf = (LAS float*)(L + D1_ABF); LAS bf16_t* AK = (LAS bf16_t*)(L + D1_AK); LAS bf16_t* ARK = (LAS bf16_t*)(L + D1_ARK); LAS bf16_t* ARB = (LAS bf16_t*)(L + D1_ARB);
    LAS bf16_t* TT = (LAS bf16_t*)(L + D1_TT); LAS bf16_t* W1t = (LAS bf16_t*)(L + D1_W1T); LAS bf16_t* AKVt = (LAS bf16_t*)(L + D1_AKVT); LAS bf16_t* W2t = (LAS bf16_t*)(L + D1_W2TT);

#ifndef D1PROBE
#define D1PROBE 0
#endif
    for (int rep1 = 0; rep1 < (D1PROBE == 1 ? 2 : 1); ++rep1) {
    if (C.tid < 480) {
        const int q = C.tid % 160, seg = C.tid / 160, grp = q >> 5, c = (q & 31) * 2;
        const int j = (grp == 0 ? h * 64 : grp == 1 ? 256 + h * 64 : grp == 2 ? 512 + h * 64 : grp == 3 ? 768 + d * 64 : 896 + d * 64) + c;
        const int t0 = seg * 22, nt = seg == 2 ? 20 : 22;
        const bf16_t* pp = P + (size_t)(ci.row0 + t0) * NP + OFF_D + j;
        const float mp0 = mup[j], mp1 = mup[j + 1], mn0 = mun[j], mn1 = mun[j + 1];
        unsigned w[24];
#pragma unroll
        for (int i = 0; i < 24; ++i) { const int row = ci.row0 + t0 - 1 + i; w[i] = (i < nt + 2 && row >= ci.lo && row < ci.hi) ? *(const unsigned*)(pp + (ptrdiff_t)(i - 1) * NP) : 0u; }
        LAS bf16_t* dst = (grp == 0 ? Rb : grp == 1 ? Kb : grp == 2 ? Vb : grp == 3 ? TW : AD);
#pragma unroll
        for (int i = 0; i < 22; ++i) if (i < nt) {
            const float x0 = bflo(w[i + 1]), x1 = bfhi(w[i + 1]);
            const float v0 = x0 + mp0 * (bflo(w[i]) - x0) + mn0 * (bflo(w[i + 2]) - x0);
            const float v1 = x1 + mp1 * (bfhi(w[i]) - x1) + mn1 * (bfhi(w[i + 2]) - x1);
            DBGF(1, badv(v0, 1e4f) || badv(v1, 1e4f));
            const unsigned o = (grp == 3) ? pk2(ftanh(v0), ftanh(v1)) : pk2(v0, v1);
            const int tl = t0 + i, l = d ? 63 - tl : tl;
            *(LAS unsigned*)(dst + l * 72 + c) = o;
        }
    }
    {
        const float* w2 = C.in[27] + ((size_t)layer * 2 + d) * 64 * 256 + h * 64; const float* a2 = C.in[29] + ((size_t)layer * 2 + d) * 64 * 256 + h * 64;
        for (int e = C.tid; e < 4096; e += 512) { const int r = e >> 6, c = e & 63; W2T[c * 72 + r] = f2bf(w2[r * 256 + c]); A2T[c * 72 + r] = f2bf(a2[r * 256 + c]); }
    }
    __syncthreads();
    D1_RELAUNDER();
    {
        unsigned* dbgflags = (unsigned*)(C.ws + 32768); (void)dbgflags;
        const float* w0 = C.in[26] + ((size_t)layer * 2 + d) * 256 + h * 64; const float* a0 = C.in[28] + ((size_t)layer * 2 + d) * 256 + h * 64;
        blk_mma<4, 4, 2>(TW, 72, W2T, 72, C.wid, C.lane, [=](int r0, int col, const f32x4& acc) {
#pragma unroll
            for (int jj = 0; jj < 4; ++jj) { const float w = w0[col] + acc[jj]; DBGL(2, badv(w, 1e4f)); LW[(r0 + jj) * 68 + col] = -fexp(-softplus(-w) - 0.5f); }
        });
        blk_mma<4, 4, 2>(AD, 72, A2T, 72, C.wid, C.lane, [=](int r0, int col, const f32x4& acc) {
#pragma unroll
            for (int jj = 0; jj < 4; ++jj) { DBGL(2, badv(acc[jj], 1e4f)); AA[(r0 + jj) * 68 + col] = sigm(a0[col] + acc[jj]); }
        });
    }
    __syncthreads();
    {
#pragma unroll
        for (int i = 0; i < 8; ++i) { const int c = C.wid * 8 + i; const float incl = wave_incl_scan(LW[C.lane * 68 + c], C.lane); CS[C.lane * 68 + c] = incl; if (C.lane == 63) GL[c] = fexp(incl); }
    }
    __syncthreads();
    D1_RELAUNDER();
    {
        const int l = C.tid >> 3, sub = C.tid & 7;
        const float* kkw = C.in[31] + layer * 256 + h * 64; const float* kaw = C.in[32] + layer * 256 + h * 64; const float* rkw = C.in[33] + layer * 256 + h * 64;
        float kk[8], kdv[8], aa[8], rr[8], vv[8]; float ss = 0.f, bon = 0.f;
#pragma unroll
        for (int i = 0; i < 8; ++i) { const int c = sub * 8 + i; const float k = bf2f(Kb[l * 72 + c]); rr[i] = bf2f(Rb[l * 72 + c]); vv[i] = bf2f(Vb[l * 72 + c]); aa[i] = AA[l * 68 + c];
            kk[i] = k * kkw[c]; ss += kk[i] * kk[i]; kdv[i] = k * (1.f + (aa[i] - 1.f) * kaw[c]); bon += rr[i] * kdv[i] * rkw[c]; }
        ss += __shfl_xor(ss, 1); ss += __shfl_xor(ss, 2); ss += __shfl_xor(ss, 4);
        bon += __shfl_xor(bon, 1); bon += __shfl_xor(bon, 2); bon += __shfl_xor(bon, 4);
        const float inv = rsqrtf(ss + 1e-12f);
        if (sub == 0) ((float*)(C.ws + WS_BON))[(size_t)(ci.row0 + (d ? 63 - l : l)) * 8 + h * 2 + d] = bon;
        unsigned short kt[8], kd[8], bt[8], rt[8];
#pragma unroll
        for (int i = 0; i < 8; ++i) { const int c = sub * 8 + i; const float cs = CS[l * 68 + c], lw = LW[l * 68 + c];
            const float ge = fexp(cs - lw), gi = fexp(cs), gn = fexp(-cs); const float kkn = kk[i] * inv;
            DBGF(3, badv(cs, 50.f) || cs > 0.f || badv(lw, 1.f)); DBGF(4, badv(kkn * ge, 10.f) || badv(rr[i] * gi, 1e4f) || badv(vv[i], 1e4f)); DBGF(5, badv(kdv[i] * gn, 1e25f) || badv(kkn * aa[i] * gn, 1e25f));
            kt[i] = f2bf(kkn * ge); kd[i] = f2bf(kdv[i] * gn); bt[i] = f2bf(kkn * aa[i] * gn); rt[i] = f2bf(rr[i] * gi);
            KTt[c * 72 + l] = kt[i]; KDt[c * 72 + l] = kd[i]; BTt[c * 72 + l] = bt[i]; Vt[c * 72 + l] = f2bf(vv[i]); }
#define D1_PACK8(a) (u32x4){(unsigned)a[0] | ((unsigned)a[1] << 16), (unsigned)a[2] | ((unsigned)a[3] << 16), (unsigned)a[4] | ((unsigned)a[5] << 16), (unsigned)a[6] | ((unsigned)a[7] << 16)}
        *(LAS u32x4*)(KT + l * 72 + sub * 8) = D1_PACK8(kt); *(LAS u32x4*)(KD + l * 72 + sub * 8) = D1_PACK8(kd);
        *(LAS u32x4*)(BT + l * 72 + sub * 8) = D1_PACK8(bt); *(LAS u32x4*)(RT + l * 72 + sub * 8) = D1_PACK8(rt);
#undef D1_PACK8
    }
    __syncthreads();
    }
    for (int rep2 = 0; rep2 < (D1PROBE >= 2 ? 2 : 1); ++rep2) {
    D1_RELAUNDER();
    unsigned* dbgflags = (unsigned*)(C.ws + 32768); (void)dbgflags;
    blk_mma2<4, 4, 2>(BT, KT, KD, KT, 72, C.wid, C.lane, [=](int r0, int col, const f32x4& ab, const f32x4& ak) {
        f32x4 a; float k[4];
#pragma unroll
        for (int jj = 0; jj < 4; ++jj) { const bool lo = r0 + jj < col; DBGL(6, lo && (badv(ab[jj], 1e3f) || badv(ak[jj], 1e4f))); a[jj] = lo ? ab[jj] : 0.f; k[jj] = lo ? ak[jj] : 0.f; }
        *(LAS f32x4*)(ABf + col * 68 + r0) = a;
        u32x2 o; o.x = pk2(k[0], k[1]); o.y = pk2(k[2], k[3]); *(LAS u32x2*)(AK + col * 72 + r0) = o;
    });
    blk_mma2<4, 4, 2>(KD, RT, BT, RT, 72, C.wid, C.lane, [=](int r0, int col, const f32x4& rk, const f32x4& rb) {
        float a[4], b[4];
#pragma unroll
        for (int jj = 0; jj < 4; ++jj) { const bool le = r0 + jj <= col; DBGL(7, le && (badv(rk[jj], 1e5f) || badv(rb[jj], 1e5f))); a[jj] = le ? rk[jj] : 0.f; b[jj] = le ? rb[jj] : 0.f; }
        u32x2 oa, ob; oa.x = pk2(a[0], a[1]); oa.y = pk2(a[2], a[3]); ob.x = pk2(b[0], b[1]); ob.y = pk2(b[2], b[3]);
        *(LAS u32x2*)(ARK + col * 72 + r0) = oa; *(LAS u32x2*)(ARB + col * 72 + r0) = ob;
    });
    __syncthreads();
    tri_inverse(ABf, (LAS float*)(L + 54272), (LAS float*)(L + 71680), TT, C.tid, C.wid, C.lane);
    __syncthreads();
#if MK_DIAG2
    for (int e = C.tid; e < 4096; e += 512) DBGF(8, badv(bf2f(TT[(e >> 6) * 72 + (e & 63)]), 1e3f));
#endif
    D1_RELAUNDER();
    blk_mma2<4, 4, 2>(TT, KTt, AK, Vt, 72, C.wid, C.lane, [=](int r0, int col, const f32x4& w1, const f32x4& akv) {
        DBGL(9, badv(w1[0], 1e3f) || badv(w1[1], 1e3f) || badv(w1[2], 1e3f) || badv(w1[3], 1e3f)); DBGL(10, badv(akv[0], 1e5f) || badv(akv[1], 1e5f) || badv(akv[2], 1e5f) || badv(akv[3], 1e5f));
        u32x2 a, b; a.x = pk2(w1[0], w1[1]); a.y = pk2(w1[2], w1[3]); b.x = pk2(akv[0], akv[1]); b.y = pk2(akv[2], akv[3]);
        *(LAS u32x2*)(W1t + col * 72 + r0) = a; *(LAS u32x2*)(AKVt + col * 72 + r0) = b;
    });
    __syncthreads();
    blk_mma<4, 4, 2>(TT, 72, AKVt, 72, C.wid, C.lane, [=](int r0, int col, const f32x4& w2) {
        DBGL(11, badv(w2[0], 1e5f) || badv(w2[1], 1e5f) || badv(w2[2], 1e5f) || badv(w2[3], 1e5f));
        u32x2 a; a.x = pk2(w2[0], w2[1]); a.y = pk2(w2[2], w2[3]); *(LAS u32x2*)(W2t + col * 72 + r0) = a;
    });
    __syncthreads();
    D1_RELAUNDER();
    {
        bf16_t* Gg = (bf16_t*)(C.ws + WS_RG) + (size_t)slot * 4096; float* Jg = (float*)(C.ws + WS_RJ) + (size_t)slot * 4096;
        bf16_t* Ryg = (bf16_t*)(C.ws + WS_RY) + (size_t)slot * 4096; bf16_t* Ylg = (bf16_t*)(C.ws + WS_RL) + (size_t)slot * 4096;
        blk_mma2<4, 4, 2>(W1t, BTt, W1t, ARB, 72, C.wid, C.lane, [=](int r0, int col, const f32x4& gp, const f32x4& rbw) {
            const float gl = GL[col]; float g[4], ry[4];
            const u32x2 rt = *(const LAS u32x2*)(RT + col * 72 + r0);
            const float rtv[4] = {bflo(rt.x), bfhi(rt.x), bflo(rt.y), bfhi(rt.y)};
#pragma unroll
            for (int jj = 0; jj < 4; ++jj) { g[jj] = gl * ((col == r0 + jj ? 1.f : 0.f) - gp[jj]); ry[jj] = rtv[jj] - rbw[jj]; }
            u32x2 og, oy; og.x = pk2(g[0], g[1]); og.y = pk2(g[2], g[3]); oy.x = pk2(ry[0], ry[1]); oy.y = pk2(ry[2], ry[3]);
            *(u32x2*)(Gg + col * 64 + r0) = og;
            *(u32x2*)(Ryg + col * 64 + r0) = oy;
        });
        blk_mma2<4, 4, 2>(KDt, Vt, BTt, W2t, 72, C.wid, C.lane, [=](int r0, int col, const f32x4& kv, const f32x4& bw) {
            f32x4 o;
#pragma unroll
            for (int jj = 0; jj < 4; ++jj) { o[jj] = GL[r0 + jj] * (kv[jj] - bw[jj]); DBGL(12, badv(GL[r0 + jj] * kv[jj], 1e5f)); DBGL(13, badv(GL[r0 + jj] * bw[jj], 1e5f)); DBGL(14, badv(o[jj], 1e5f)); }
            *(f32x4*)(Jg + col * 64 + r0) = o;
        });
        blk_mma2<4, 4, 2>(ARK, Vt, ARB, W2t, 72, C.wid, C.lane, [=](int r0, int col, const f32x4& a, const f32x4& b) {
            u32x2 o; o.x = pk2(a[0] - b[0], a[1] - b[1]); o.y = pk2(a[2] - b[2], a[3] - b[3]);
            *(u32x2*)(Ylg + col * 64 + r0) = o;
        });
    }
    __syncthreads();
    }
}

typedef float f32x2p __attribute__((ext_vector_type(2)));
__device__ __forceinline__ void ph_scan(const Ctx& C, int nrep = 1) {
    if (C.bid < 16) {
      for (int rep = 0; rep < nrep; ++rep) {
        if (C.wid < 4) {
            const int chain = C.bid, fr = C.lane & 15, fq = C.lane >> 4, w = C.wid;
            LAS bf16_t* HT = (LAS bf16_t*)C.lds + w * 16 * 72;
            const bf16_t* Gg = (const bf16_t*)(C.ws + WS_RG) + (size_t)chain * NCH * 4096 + fr * 64 + fq * 8;
            const float* Jg = (const float*)(C.ws + WS_RJ) + (size_t)chain * NCH * 4096 + (w * 16 + fr) * 64 + fq * 4;
            bf16_t* Hg = (bf16_t*)(C.ws + WS_RH) + (size_t)chain * NCH * 4096 + (w * 16 + fr) * 64 + fq * 4;
            f32x4 acc[4];
#pragma unroll
            for (int tm = 0; tm < 4; ++tm) acc[tm] = (f32x4){0.f, 0.f, 0.f, 0.f};
            bf16x8 gn[4][2]; f32x4 jn[4];
#pragma unroll
            for (int tm = 0; tm < 4; ++tm) { gn[tm][0] = *(const bf16x8*)(Gg + tm * 1024); gn[tm][1] = *(const bf16x8*)(Gg + tm * 1024 + 32); jn[tm] = *(const f32x4*)(Jg + tm * 16); }
            for (int cpos = 0; cpos < NCH; ++cpos) {
                bf16x8 g[4][2]; f32x4 jv[4];
#pragma unroll
                for (int tm = 0; tm < 4; ++tm) { g[tm][0] = gn[tm][0]; g[tm][1] = gn[tm][1]; jv[tm] = jn[tm]; }
                if (cpos + 1 < NCH) { const bf16_t* gq = Gg + (size_t)(cpos + 1) * 4096; const float* jq = Jg + (size_t)(cpos + 1) * 4096;
#pragma unroll
                    for (int tm = 0; tm < 4; ++tm) { gn[tm][0] = *(const bf16x8*)(gq + tm * 1024); gn[tm][1] = *(const bf16x8*)(gq + tm * 1024 + 32); jn[tm] = *(const f32x4*)(jq + tm * 16); } }
#pragma unroll
                for (int tm = 0; tm < 4; ++tm) { u32x2 o; o.x = pk2(acc[tm][0], acc[tm][1]); o.y = pk2(acc[tm][2], acc[tm][3]);
                    *(LAS u32x2*)(HT + fr * 72 + tm * 16 + fq * 4) = o;
                    *(u32x2*)(Hg + (size_t)cpos * 4096 + tm * 16) = o; }
                asm volatile("s_waitcnt lgkmcnt(0)" ::: "memory");
                const bf16x8 b0 = *(const LAS bf16x8*)(HT + fr * 72 + fq * 8), b1 = *(const LAS bf16x8*)(HT + fr * 72 + 32 + fq * 8);
#pragma unroll
                for (int tm = 0; tm < 4; ++tm) { f32x4 a = jv[tm];
                    a = __builtin_amdgcn_mfma_f32_16x16x32_bf16(g[tm][0], b0, a, 0, 0, 0);
                    a = __builtin_amdgcn_mfma_f32_16x16x32_bf16(g[tm][1], b1, a, 0, 0, 0);
                    acc[tm] = a; }
                asm volatile("" ::: "memory");
            }
        }
      }
    } else {
        unsigned* MST = (unsigned*)(C.ws + WS_MST); const float* MCD = (const float*)(C.ws + WS_MCD);
        const int nthr = (C.G - 16) * 512;
        for (int e = (C.bid - 16) * 512 + C.tid; e < 16 * 4096; e += nthr) {
            const int chain = e >> 12, el = e & 4095; float r0 = 0.f, r1 = 0.f;
            unsigned* p = MST + (size_t)chain * NCH * 4096 + el; const float* cd = MCD + chain * NCH;
#pragma unroll 12
            for (int cpos = 0; cpos < NCH; ++cpos) { const unsigned tmp = p[(size_t)cpos * 4096]; p[(size_t)cpos * 4096] = pk2(r0, r1); const float c = cd[cpos]; r0 = r0 * c + bflo(tmp); r1 = r1 * c + bfhi(tmp); }
        }
    }
}

__device__ __forceinline__ void item_mamba_out(const Ctx& C, int layer, int gc) {
    const ChunkInfo ci = chunk_info(gc);
    const bf16_t* P = (const bf16_t*)(C.ws + WS_P); bf16_t* YC = (bf16_t*)(C.ws + WS_ACT); const bf16_t* MST = (const bf16_t*)(C.ws + WS_MST);
    lds_t L = C.lds;
    LAS float* DT = (LAS float*)L;
    LAS float* DA = (LAS float*)(L + 2048);
    LAS float* CSI = (LAS float*)(L + 4096);
    LAS float* SSQ = (LAS float*)(L + 6144);
    LAS bf16_t* CG = (LAS bf16_t*)(L + 10240);
    LAS bf16_t* BG = (LAS bf16_t*)(L + 27648);
    LAS bf16_t* XT = (LAS bf16_t*)(L + 45056);
    LAS float* CBm = (LAS float*)(L + 63488);
    LAS bf16_t* MP = (LAS bf16_t*)(L + 80896);
    LAS bf16_t* S0 = (LAS bf16_t*)(L + 90112);
    LAS bf16_t* YPRE = (LAS bf16_t*)(L + 107520);
    const int fr = C.lane & 15, fq = C.lane >> 4;
    {
        const int s = C.lane, dh = C.wid;
        const float raw = bf2f(P[(size_t)(ci.row0 + s) * NP + OFF_C + 1024 + dh]);
        const float dt = softplus(raw + C.in[20][layer * 8 + dh]);
        const float da = dt * (-expf(C.in[21][layer * 8 + dh]));
        const float incl = wave_incl_scan(da, s), total = __shfl(incl, 63);
        DT[dh * 64 + s] = dt; DA[dh * 64 + s] = da;
        CSI[dh * 64 + s] = (dh < 4) ? incl : (total - incl + da);
    }
    for (int g = 0; g < 2; ++g) {
        __syncthreads();
        {
            const int cp = C.tid & 255, half = C.tid >> 8;
            if (cp < 192) {
                const int kind = cp >> 6, cl = (cp & 63) * 2, c0 = kind * 256 + g * 128 + cl;
                const float* cw = C.in[18] + (size_t)layer * 5 * 768 + c0; const float* cb = C.in[19] + layer * 768 + c0;
                float w0[5], w1[5];
#pragma unroll
                for (int j = 0; j < 5; ++j) { w0[j] = cw[j * 768]; w1[j] = cw[j * 768 + 1]; }
                const float b0 = cb[0], b1 = cb[1];
                const int s0 = half * 32;
                unsigned win[5];
#pragma unroll
                for (int j = 0; j < 4; ++j) { const int row = ci.row0 + s0 - 2 + j; win[j + 1] = (row >= ci.lo && row < ci.hi) ? *(const unsigned*)(P + (size_t)row * NP + OFF_C + 256 + c0) : 0u; }
                for (int tt = 0; tt < 32; ++tt) {
                    const int s = s0 + tt;
#pragma unroll
                    for (int j = 0; j < 4; ++j) win[j] = win[j + 1];
                    { const int row = ci.row0 + s + 2; win[4] = (row >= ci.lo && row < ci.hi) ? *(const unsigned*)(P + (size_t)row * NP + OFF_C + 256 + c0) : 0u; }
                    float a0 = b0, a1 = b1;
#pragma unroll
                    for (int j = 0; j < 5; ++j) { a0 += w0[j] * bflo(win[j]); a1 += w1[j] * bfhi(win[j]); }
                    const unsigned short o0 = f2bf(silu(a0)), o1 = f2bf(silu(a1));
                    if (kind == 0) { XT[cl * 72 + s] = o0; XT[(cl + 1) * 72 + s] = o1; }
                    else if (kind == 1) { *(LAS unsigned*)(BG + s * 136 + cl) = (unsigned)o0 | ((unsigned)o1 << 16); }
                    else { *(LAS unsigned*)(CG + s * 136 + cl) = (unsigned)o0 | ((unsigned)o1 << 16); }
                }
            }
        }
        __syncthreads();
        blk_mma<4, 4, 4>(CG, 136, BG, 136, C.wid, C.lane, [=](int r0, int col, const f32x4& acc) {
#pragma unroll
            for (int jj = 0; jj < 4; ++jj) CBm[(r0 + jj) * 68 + col] = acc[jj];
        });
        u32x4 s0r[2];
        { const bf16_t* src = MST + (size_t)slot_of(ci.b, 2 * g, 0, cpos_of(ci, 0)) * 8192;
#pragma unroll
          for (int k = 0; k < 2; ++k) { const int e = C.tid + 512 * k; s0r[k] = *(const u32x4*)(src + (e >> 4) * 128 + (e & 15) * 8); } }
        for (int hh = 0; hh < 2; ++hh) {
            const int h = 2 * g + hh;
            f32x4 yacc[2] = {{0.f, 0.f, 0.f, 0.f}, {0.f, 0.f, 0.f, 0.f}};
            for (int d = 0; d < 2; ++d) {
                const int dh = d * 4 + h;
                __syncthreads();
                for (int e = C.tid; e < 4096; e += 512) { const int l = e >> 6, s = e & 63; const bool ok = d ? (s >= l) : (s <= l);
                    MP[l * 72 + s] = ok ? f2bf(CBm[l * 68 + s] * fexp(CSI[dh * 64 + l] - CSI[dh * 64 + s]) * DT[dh * 64 + s]) : (unsigned short)0; }
#pragma unroll
                for (int k = 0; k < 2; ++k) { const int e = C.tid + 512 * k; *(LAS u32x4*)(S0 + (e >> 4) * 136 + (e & 15) * 8) = s0r[k]; }
                if (!(hh == 1 && d == 1)) { const int nh = d ? h + 1 : h, nd = d ^ 1; const bf16_t* src = MST + (size_t)slot_of(ci.b, nh, nd, cpos_of(ci, nd)) * 8192;
#pragma unroll
                    for (int k = 0; k < 2; ++k) { const int e = C.tid + 512 * k; s0r[k] = *(const u32x4*)(src + (e >> 4) * 128 + (e & 15) * 8); } }
                __syncthreads();
#pragma unroll
                for (int i = 0; i < 2; ++i) { const int tt = C.wid + 8 * i, tm = tt >> 2, tn = tt & 3;
                    f32x4 a1 = {0.f, 0.f, 0.f, 0.f}, a2 = {0.f, 0.f, 0.f, 0.f};
#pragma unroll
                    for (int ks = 0; ks < 2; ++ks) a1 = __builtin_amdgcn_mfma_f32_16x16x32_bf16(*(const LAS bf16x8*)(MP + (tm * 16 + fr) * 72 + ks * 32 + fq * 8),
                                                                                                 *(const LAS bf16x8*)(XT + (hh * 64 + tn * 16 + fr) * 72 + ks * 32 + fq * 8), a1, 0, 0, 0);
#pragma unroll
                    for (int ks = 0; ks < 4; ++ks) a2 = __builtin_amdgcn_mfma_f32_16x16x32_bf16(*(const LAS bf16x8*)(CG + (tm * 16 + fr) * 136 + ks * 32 + fq * 8),
                                                                                                 *(const LAS bf16x8*)(S0 + (tn * 16 + fr) * 136 + ks * 32 + fq * 8), a2, 0, 0, 0);
#pragma unroll
                    for (int j = 0; j < 4; ++j) yacc[i][j] += a1[j] + a2[j] * fexp(CSI[dh * 64 + tm * 16 + fq * 4 + j]);
                }
            }
            const float dsk = C.in[22][layer * 4 + h];
#pragma unroll
            for (int i = 0; i < 2; ++i) { const int tt = C.wid + 8 * i, tm = tt >> 2, tn = tt & 3;
#pragma unroll
                for (int j = 0; j < 4; ++j) { const int l = tm * 16 + fq * 4 + j, p = tn * 16 + fr, c = h * 64 + p;
                    const float xs = bf2f(XT[(hh * 64 + p) * 72 + l]);
                    const float z = bf2f(P[(size_t)(ci.row0 + l) * NP + OFF_C + c]);
                    const float pre = (yacc[i][j] + dsk * xs) * silu(z);
                    YPRE[l * 264 + c] = f2bf(pre);
                    float q = pre * pre; q += __shfl_xor(q, 1); q += __shfl_xor(q, 2); q += __shfl_xor(q, 4); q += __shfl_xor(q, 8);
                    if (fr == 0) SSQ[l * 16 + h * 4 + tn] = q; }
            }
        }
    }
    __syncthreads();
    {
        const int l = C.tid >> 3, sub = C.tid & 7; float ss = 0.f;
#pragma unroll
        for (int i = 0; i < 16; ++i) ss += SSQ[l * 16 + i];
        const float rs = rsqrtf(ss * (1.f / 256.f) + 1e-6f);
        const float* ng = C.in[23] + layer * 256 + sub * 32;
        bf16_t* dst = YC + (size_t)(ci.row0 + l) * DM + 512 + sub * 32;
#pragma unroll
        for (int i = 0; i < 32; i += 2) { const float a = bf2f(YPRE[l * 264 + sub * 32 + i]) * rs * ng[i], b = bf2f(YPRE[l * 264 + sub * 32 + i + 1]) * rs * ng[i + 1]; *(unsigned*)(dst + i) = pk2(a, b); }
    }
    __syncthreads();
}

constexpr int D3_G2T = 0, D3_SG = 69632;
__device__ __forceinline__ void load_g2t(const Ctx& C, int layer) {
    LAS bf16_t* G2T = (LAS bf16_t*)(C.lds + D3_G2T); const float* g2 = C.in[30] + (size_t)layer * 128 * 256;
    for (int e = C.tid; e < 128 * 256; e += 512) { const int r = e >> 8, c = e & 255; G2T[c * 136 + r] = f2bf(g2[e]); }
}
__device__ __forceinline__ float lerp_d(const bf16_t* P, const ChunkInfo& ci, int row, int j, const float* mup, const float* mun) {
    const bf16_t* pp = P + (size_t)row * NP + OFF_D + j;
    const float x = bf2f(*pp), xp = (row - 1 >= ci.lo) ? bf2f(*(pp - NP)) : 0.f, xn = (row + 1 < ci.hi) ? bf2f(*(pp + NP)) : 0.f;
    return x + mup[j] * (xp - x) + mun[j] * (xn - x);
}
__device__ __forceinline__ void item_rwkv_out(const Ctx& C, int layer, int gc) {
    const ChunkInfo ci = chunk_info(gc);
    const bf16_t* P = (const bf16_t*)(C.ws + WS_P); bf16_t* YC = (bf16_t*)(C.ws + WS_ACT);
    const float* mup = C.in[24] + layer * 1152; const float* mun = C.in[25] + layer * 1152;
    LAS bf16_t* G2T = (LAS bf16_t*)(C.lds + D3_G2T); LAS bf16_t* SG = (LAS bf16_t*)(C.lds + D3_SG);
    const int fr = C.lane & 15, fq = C.lane >> 4;
    __syncthreads();
    for (int e = C.tid; e < 64 * 128; e += 512) { const int l = e >> 7, r = e & 127; SG[l * 136 + r] = f2bf(sigm(lerp_d(P, ci, ci.row0 + l, 1024 + r, mup, mun))); }
    __syncthreads();
    const int h = C.wid >> 1, tmb = (C.wid & 1) * 2;
    const bf16_t* Ryg = (const bf16_t*)(C.ws + WS_RY); const bf16_t* Ylg = (const bf16_t*)(C.ws + WS_RL); const bf16_t* Hg = (const bf16_t*)(C.ws + WS_RH);
    const float* BON = (const float*)(C.ws + WS_BON);
#pragma unroll
    for (int ti = 0; ti < 2; ++ti) {
        const int tm = tmb + ti;
        f32x4 gacc[4], yacc[4];
#pragma unroll
        for (int tn = 0; tn < 4; ++tn) { f32x4 a = {0.f, 0.f, 0.f, 0.f};
#pragma unroll
            for (int ks = 0; ks < 4; ++ks) a = __builtin_amdgcn_mfma_f32_16x16x32_bf16(*(const LAS bf16x8*)(SG + (tm * 16 + fr) * 136 + ks * 32 + fq * 8),
                                                                                        *(const LAS bf16x8*)(G2T + (h * 64 + tn * 16 + fr) * 136 + ks * 32 + fq * 8), a, 0, 0, 0);
            gacc[tn] = a; yacc[tn] = (f32x4){0.f, 0.f, 0.f, 0.f}; }
#pragma unroll
        for (int d = 0; d < 2; ++d) {
            const size_t slot = (size_t)slot_of(ci.b, h, d, cpos_of(ci, d));
            const int arow = d ? 63 - (tm * 16 + fr) : tm * 16 + fr;
            bf16x8 af[2];
#pragma unroll
            for (int ks = 0; ks < 2; ++ks) af[ks] = *(const bf16x8*)(Ryg + slot * 4096 + arow * 64 + ks * 32 + fq * 8);
#pragma unroll
            for (int tn = 0; tn < 4; ++tn) {
                f32x4 a;
                if (d == 0) { const u32x2 yl = *(const u32x2*)(Ylg + slot * 4096 + (tn * 16 + fr) * 64 + tm * 16 + fq * 4); a = (f32x4){bflo(yl.x), bfhi(yl.x), bflo(yl.y), bfhi(yl.y)}; }
                else { const u32x2 yl = *(const u32x2*)(Ylg + slot * 4096 + (tn * 16 + fr) * 64 + 60 - (tm * 16 + fq * 4)); a = (f32x4){bfhi(yl.y), bflo(yl.y), bfhi(yl.x), bflo(yl.x)}; }
#pragma unroll
                for (int ks = 0; ks < 2; ++ks) a = __builtin_amdgcn_mfma_f32_16x16x32_bf16(af[ks], *(const bf16x8*)(Hg + slot * 4096 + (tn * 16 + fr) * 64 + ks * 32 + fq * 8), a, 0, 0, 0);
                yacc[tn] += a;
            }
        }
#pragma unroll
        for (int j = 0; j < 4; ++j) {
            const int l = tm * 16 + fq * 4 + j, row = ci.row0 + l;
            float s = (yacc[0][j] + yacc[1][j]) + (yacc[2][j] + yacc[3][j]);
            s += __shfl_xor(s, 1); s += __shfl_xor(s, 2); s += __shfl_xor(s, 4); s += __shfl_xor(s, 8);
            const float mu = s * (1.f / 64.f);
            float q = 0.f;
#pragma unroll
            for (int tn = 0; tn < 4; ++tn) { const float dd = yacc[tn][j] - mu; q += dd * dd; }
            q += __shfl_xor(q, 1); q += __shfl_xor(q, 2); q += __shfl_xor(q, 4); q += __shfl_xor(q, 8);
            const float rs = rsqrtf(q * (1.f / 64.f) + 64e-5f);
            const float bon = BON[(size_t)row * 8 + h * 2] + BON[(size_t)row * 8 + h * 2 + 1];
#pragma unroll
            for (int tn = 0; tn < 4; ++tn) { const int c = h * 64 + tn * 16 + fr;
                const float yn = (yacc[tn][j] - mu) * rs * C.in[34][layer * 256 + c] + C.in[35][layer * 256 + c];
                const float vv = lerp_d(P, ci, row, 512 + c, mup, mun);
                YC[(size_t)row * DM + 768 + c] = f2bf((yn + bon * vv) * gacc[tn][j]); }
        }
    }
}

__device__ __forceinline__ unsigned ordf(float f) { const unsigned u = __float_as_uint(f); return u ^ ((u >> 31) ? 0xFFFFFFFFu : 0x80000000u); }
__device__ __forceinline__ unsigned wave_max_u32(unsigned v) {
    unsigned t;
    t = (unsigned)__builtin_amdgcn_update_dpp((int)v, (int)v, 0xB1, 0xF, 0xF, false); v = t > v ? t : v;
    t = (unsigned)__builtin_amdgcn_update_dpp((int)v, (int)v, 0x4E, 0xF, 0xF, false); v = t > v ? t : v;
    t = (unsigned)__builtin_amdgcn_update_dpp((int)v, (int)v, 0x141, 0xF, 0xF, false); v = t > v ? t : v;
    t = (unsigned)__builtin_amdgcn_update_dpp((int)v, (int)v, 0x140, 0xF, 0xF, false); v = t > v ? t : v;
    t = (unsigned)__builtin_amdgcn_update_dpp((int)v, (int)v, 0x142, 0xA, 0xF, false); v = t > v ? t : v;
    t = (unsigned)__builtin_amdgcn_update_dpp((int)v, (int)v, 0x143, 0xC, 0xF, false); v = t > v ? t : v;
    return (unsigned)__builtin_amdgcn_readlane((int)v, 63);
}
constexpr int SEL_K1 = 0, SEL_K2 = 34816;
__device__ __forceinline__ float unordf(unsigned k) { return __uint_as_float((k & 0x80000000u) ? (k ^ 0x80000000u) : ~k); }
template <int N> __device__ __forceinline__ void bitonic_sort_desc(unsigned (&x)[N]) {
#pragma unroll
    for (int k = 2; k <= N; k <<= 1)
#pragma unroll
        for (int j = k >> 1; j > 0; j >>= 1)
#pragma unroll
            for (int i = 0; i < N; ++i) { const int l = i ^ j;
                if (l > i) { const unsigned p = x[i], q = x[l]; const unsigned hi = p > q ? p : q, lo = p > q ? q : p; if ((i & k) == 0) { x[i] = hi; x[l] = lo; } else { x[i] = lo; x[l] = hi; } } }
}
__device__ __forceinline__ void merge_top16(unsigned (&a)[16], const unsigned (&b)[16]) {
#pragma unroll
    for (int i = 0; i < 16; ++i) a[i] = a[i] > b[15 - i] ? a[i] : b[15 - i];
#pragma unroll
    for (int j = 8; j > 0; j >>= 1)
#pragma unroll
        for (int i = 0; i < 16; ++i) { const int l = i ^ j; if (l > i) { const unsigned p = a[i], q = a[l]; a[i] = p > q ? p : q; a[l] = p > q ? q : p; } }
}
__device__ __forceinline__ void ph_select(const Ctx& C, int layer, int nrows) {
    const bf16_t* Q = (const bf16_t*)(C.ws + WS_Q); int* SELI = (int*)(C.ws + WS_SELI); float* SELG = (float*)(C.ws + WS_SELG);
    LAS bf16_t* K1 = (LAS bf16_t*)(C.lds + SEL_K1); LAS bf16_t* K2 = (LAS bf16_t*)(C.lds + SEL_K2);
    {
        const float* k1 = C.in[37] + (size_t)layer * 128 * 128; const float* k2 = C.in[38] + (size_t)layer * 128 * 128;
        for (int e = C.tid; e < 4096; e += 512) { const int r = e >> 5, c4 = (e & 31) * 4; const f32x4 a = *(const f32x4*)(k1 + r * 128 + c4), b = *(const f32x4*)(k2 + r * 128 + c4);
            u32x2 oa, ob; oa.x = pk2(a.x, a.y); oa.y = pk2(a.z, a.w); ob.x = pk2(b.x, b.y); ob.y = pk2(b.z, b.w);
            *(LAS u32x2*)(K1 + r * 136 + c4) = oa; *(LAS u32x2*)(K2 + r * 136 + c4) = ob; }
    }
    __syncthreads();
    const int fr = C.lane & 15, fq = C.lane >> 4;
    const int nunits = (nrows / 16) * 8;
    for (int u = C.bid * 8 + C.wid; u < nunits; u += C.G * 8) {
        const int tile = u >> 3, h = u & 7, row = tile * 16 + fr;
        const bf16_t* qp = Q + (size_t)row * 2048 + h * 256 + fq * 8;
        bf16x8 qf[8];
#pragma unroll
        for (int i = 0; i < 8; ++i) qf[i] = *(const bf16x8*)(qp + i * 32);
        unsigned T[2][16];
#pragma unroll
        for (int half = 0; half < 2; ++half) {
            const LAS bf16_t* K = half ? K2 : K1;
            unsigned lo16[16], hi16[16];
#pragma unroll
            for (int kt = 0; kt < 8; ++kt) {
                f32x4 acc = {0.f, 0.f, 0.f, 0.f};
#pragma unroll
                for (int ks = 0; ks < 4; ++ks) acc = __builtin_amdgcn_mfma_f32_16x16x32_bf16(*(const LAS bf16x8*)(K + (kt * 16 + fr) * 136 + ks * 32 + fq * 8), qf[half * 4 + ks], acc, 0, 0, 0);
#pragma unroll
                for (int j = 0; j < 4; ++j) { const unsigned key = (ordf(acc[j]) & ~0x7Fu) | (unsigned)(127 - (kt * 16 + fq * 4 + j));
                    if (kt < 4) lo16[kt * 4 + j] = key; else hi16[(kt - 4) * 4 + j] = key; }
            }
            bitonic_sort_desc<16>(lo16); bitonic_sort_desc<16>(hi16); merge_top16(lo16, hi16);
#pragma unroll
            for (int rnd = 16; rnd <= 32; rnd <<= 1) { unsigned o[16];
#pragma unroll
                for (int i = 0; i < 16; ++i) o[i] = (unsigned)__shfl_xor((int)lo16[i], rnd);
                merge_top16(lo16, o); }
#pragma unroll
            for (int i = 0; i < 16; ++i) T[half][i] = lo16[i];
        }
        unsigned ck[50]; unsigned R0[16];
        {
            int id = 0;
#pragma unroll
            for (int a = 0; a < 16; ++a) {
                const float va = unordf(T[0][a] & ~0x7Fu);
#pragma unroll
                for (int b = 0; b < 16; ++b) if ((a + 1) * (b + 1) <= 16) { ck[id] = (ordf(va + unordf(T[1][b] & ~0x7Fu)) & ~0x3Fu) | (unsigned)(63 - id); ++id; }
            }
        }
#pragma unroll
        for (int i = 0; i < 16; ++i) R0[i] = ck[i];
        {
            int base = 16;
#pragma unroll
            for (int a = 1; a < 8; ++a) { const int n = 16 / (a + 1); unsigned rw[16];
#pragma unroll
                for (int i = 0; i < 16; ++i) rw[i] = i < n ? ck[base + i] : 0u;
                merge_top16(R0, rw); base += n; }
            unsigned rw[16];
#pragma unroll
            for (int i = 0; i < 16; ++i) rw[i] = i < 8 ? ck[base + i] : 0u;
            merge_top16(R0, rw);
        }
        const unsigned thr = R0[15]; const float mx = unordf(R0[0] & ~0x3Fu);
        float sum = 0.f;
#pragma unroll
        for (int c = 0; c < 50; ++c) sum += ck[c] >= thr ? __expf(unordf(ck[c] & ~0x3Fu) - mx) : 0.f;
        const float rsum = 1.f / sum;
        int* oi = SELI + ((size_t)row * 8 + h) * 16; float* og = SELG + ((size_t)row * 8 + h) * 16;
        {
            int id = 0, cnt = 0;
#pragma unroll
            for (int a = 0; a < 16; ++a)
#pragma unroll
                for (int b = 0; b < 16; ++b) if ((a + 1) * (b + 1) <= 16) {
                    if (ck[id] >= thr) { if (fq == 0 && cnt < 16) { oi[cnt] = (127 - (int)(T[0][a] & 0x7Fu)) * 128 + (127 - (int)(T[1][b] & 0x7Fu)); og[cnt] = __expf(unordf(ck[id] & ~0x3Fu) - mx) * rsum; } ++cnt; }
                    ++id; }
        }
    }
}

struct R16 { float v[16]; };
__device__ __forceinline__ R16 load_r16_f32(const float* p, int lane) { R16 r;
#pragma unroll
    for (int k = 0; k < 4; ++k) { const f32x4 a = *(const f32x4*)(p + 16 * lane + 4 * k); r.v[4 * k] = a.x; r.v[4 * k + 1] = a.y; r.v[4 * k + 2] = a.z; r.v[4 * k + 3] = a.w; }
    return r; }
__device__ __forceinline__ void store_r16_f32(float* p, int lane, const R16& r) {
#pragma unroll
    for (int k = 0; k < 4; ++k) *(f32x4*)(p + 16 * lane + 4 * k) = (f32x4){r.v[4 * k], r.v[4 * k + 1], r.v[4 * k + 2], r.v[4 * k + 3]}; }
__device__ __forceinline__ R16 load_r16_bf16(const bf16_t* p, int lane) { R16 r;
#pragma unroll
    for (int k = 0; k < 2; ++k) { const u32x4 a = *(const u32x4*)(p + 16 * lane + 8 * k);
        r.v[8 * k] = bflo(a.x); r.v[8 * k + 1] = bfhi(a.x); r.v[8 * k + 2] = bflo(a.y); r.v[8 * k + 3] = bfhi(a.y); r.v[8 * k + 4] = bflo(a.z); r.v[8 * k + 5] = bfhi(a.z); r.v[8 * k + 6] = bflo(a.w); r.v[8 * k + 7] = bfhi(a.w); }
    return r; }
__device__ __forceinline__ void store_r16_bf16(bf16_t* p, int lane, const R16& r) {
#pragma unroll
    for (int k = 0; k < 2; ++k) { u32x4 a; a.x = pk2(r.v[8 * k], r.v[8 * k + 1]); a.y = pk2(r.v[8 * k + 2], r.v[8 * k + 3]); a.z = pk2(r.v[8 * k + 4], r.v[8 * k + 5]); a.w = pk2(r.v[8 * k + 6], r.v[8 * k + 7]);
        *(u32x4*)(p + 16 * lane + 8 * k) = a; } }
typedef float f32x2p __attribute__((ext_vector_type(2)));
struct PeerHdr { int idx0, idx1; float su0, su1, gsv0, gsv1; };
__device__ __forceinline__ void ph_peer(const Ctx& C, int layer, int nrows, bool last, bool store = true) {
    const bf16_t* F = (const bf16_t*)(C.ws + WS_ACT); bf16_t* XN = (bf16_t*)(C.ws + WS_ACT);
    const unsigned char* UB = C.ws + WS_UB; const unsigned char* VB = C.ws + WS_VB; const float* SU = (const float*)(C.ws + WS_SU); const float* SV = (const float*)(C.ws + WS_SV);
    const int* SELI = (const int*)(C.ws + WS_SELI); const float* SELG = (const float*)(C.ws + WS_SELG);
    float* H = (float*)(C.ws + WS_H); const float* MOD = (const float*)(C.ws + WS_MOD);
    const int L = C.lane, step = C.G * 8;
    const int myexp = ((L >> 5) & 1) * 4 + ((L >> 4) & 1) * 2 + ((L >> 3) & 1);
    auto load_hdr = [&](int tok) { PeerHdr h; h.idx0 = SELI[(size_t)tok * 128 + L]; h.idx1 = SELI[(size_t)tok * 128 + 64 + L];
        h.su0 = SU[h.idx0]; h.su1 = SU[h.idx1]; h.gsv0 = SELG[(size_t)tok * 128 + L] * SV[h.idx0]; h.gsv1 = SELG[(size_t)tok * 128 + 64 + L] * SV[h.idx1]; return h; };
    int tok = C.bid * 8 + C.wid;
    for (; tok < nrows; tok += step) {
        const PeerHdr hd = load_hdr(tok);
        const R16 f = load_r16_bf16(F + (size_t)tok * DM, L);
        f32x2p out[8];
#pragma unroll
        for (int i = 0; i < 8; ++i) out[i] = (f32x2p){0.f, 0.f};
        u32x4 ua[2][8], va[2][8];
#define PEER_LOAD(buf, bt) do { const int src_ = (bt) < 8 ? hd.idx0 : hd.idx1; const int l0_ = ((bt) & 7) * 8; _Pragma("unroll") for (int i = 0; i < 8; ++i) { const int ei = __builtin_amdgcn_readlane(src_, l0_ + i); \
            ua[buf][i] = *(const u32x4*)(UB + (size_t)ei * DM + 16 * L); va[buf][i] = *(const u32x4*)(VB + (size_t)ei * DM + 16 * L); } } while (0)
#define PEER_COMPUTE(buf, bt) do { const float susrc = (bt) < 8 ? hd.su0 : hd.su1, gsrc = (bt) < 8 ? hd.gsv0 : hd.gsv1; const int l0 = ((bt) & 7) * 8; float part[8]; \
            _Pragma("unroll") for (int i = 0; i < 8; ++i) { f32x2p acc = {0.f, 0.f}; _Pragma("unroll") for (int k = 0; k < 4; ++k) { \
                const f32x2p lo = __builtin_amdgcn_cvt_pk_f32_fp8((int)ua[buf][i][k], false), hi = __builtin_amdgcn_cvt_pk_f32_fp8((int)ua[buf][i][k], true); \
                acc += lo * (f32x2p){f.v[4 * k], f.v[4 * k + 1]}; acc += hi * (f32x2p){f.v[4 * k + 2], f.v[4 * k + 3]}; } part[i] = acc.x + acc.y; } \
            float p4[4], p2[2], p1; \
            { const bool hi = (L & 32) != 0; _Pragma("unroll") for (int i = 0; i < 4; ++i) { const float send = hi ? part[i] : part[i + 4]; const float recv = __shfl_xor(send, 32); p4[i] = (hi ? part[i + 4] : part[i]) + recv; } } \
            { const bool hi = (L & 16) != 0; _Pragma("unroll") for (int i = 0; i < 2; ++i) { const float send = hi ? p4[i] : p4[i + 2]; const float recv = __shfl_xor(send, 16); p2[i] = (hi ? p4[i + 2] : p4[i]) + recv; } } \
            { const bool hi = (L & 8) != 0; const float send = hi ? p2[0] : p2[1]; const float recv = __shfl_xor(send, 8); p1 = (hi ? p2[1] : p2[0]) + recv; } \
            p1 += __shfl_xor(p1, 4); p1 += __shfl_xor(p1, 2); p1 += __shfl_xor(p1, 1); \
            const float act = gelu_tanh(p1 * __shfl(susrc, l0 + myexp)) * __shfl(gsrc, l0 + myexp); \
            _Pragma("unroll") for (int i = 0; i < 8; ++i) { \
                const float a = __uint_as_float((unsigned)__builtin_amdgcn_readlane((int)__float_as_uint(act), ((i >> 2) & 1) * 32 + ((i >> 1) & 1) * 16 + (i & 1) * 8)); const f32x2p a2 = {a, a}; \
                _Pragma("unroll") for (int k = 0; k < 4; ++k) { out[2 * k] += a2 * __builtin_amdgcn_cvt_pk_f32_fp8((int)va[buf][i][k], false); out[2 * k + 1] += a2 * __builtin_amdgcn_cvt_pk_f32_fp8((int)va[buf][i][k], true); } } } while (0)
        PEER_LOAD(0, 0);
        for (int bt = 0; bt < 16; bt += 2) {
            PEER_LOAD(1, bt + 1);
            PEER_COMPUTE(0, bt);
            if (bt + 2 < 16) PEER_LOAD(0, bt + 2);
            PEER_COMPUTE(1, bt + 1);
        }
#undef PEER_LOAD
#undef PEER_COMPUTE
        const float* m = MOD + ((size_t)layer * 3 + which_of(tok)) * 6144;
        R16 hr = load_r16_f32(H + (size_t)tok * DM, L); const R16 g5 = load_r16_f32(m + 5 * 1024, L);
#pragma unroll
        for (int i = 0; i < 8; ++i) { hr.v[2 * i] += g5.v[2 * i] * out[i].x; hr.v[2 * i + 1] += g5.v[2 * i + 1] * out[i].y; }
        float ss = 0.f;
#pragma unroll
        for (int i = 0; i < 16; ++i) ss += hr.v[i] * hr.v[i];
        const float rs = rsqrtf(wave_sum(ss) * (1.f / 1024.f) + 1e-6f);
        if (!store) continue;
        if (!last) {
            store_r16_f32(H + (size_t)tok * DM, L, hr);
            const float* m2 = MOD + ((size_t)(layer + 1) * 3 + which_of(tok)) * 6144;
            const R16 gg = load_r16_f32(C.in[6] + (layer + 1) * 1024, L), sh = load_r16_f32(m2, L), sc = load_r16_f32(m2 + 1024, L); R16 o;
#pragma unroll
            for (int i = 0; i < 16; ++i) o.v[i] = (hr.v[i] * rs * gg.v[i]) * (1.f + sc.v[i]) + sh.v[i];
            store_r16_bf16(XN + (size_t)tok * DM, L, o);
        } else {
            const R16 fg = load_r16_f32(C.in[41], L); R16 o;
#pragma unroll
            for (int i = 0; i < 16; ++i) o.v[i] = hr.v[i] * rs * fg.v[i];
            store_r16_f32(C.out + (size_t)tok * DM, L, o);
        }
    }
}

#define PM(n) ((MASK >> (n)) & 1u)
constexpr int NPH_LAYER = 9, NPH = 2 + 2 * NPH_LAYER;
template <unsigned MASK> __global__ void __launch_bounds__(512, 2) hybrid_fwd(Args args) {
    extern __shared__ __attribute__((aligned(16))) unsigned char lds_raw[];
    Ctx C0; C0.in = args.in; C0.out = args.out; C0.ws = args.ws; C0.lds = (lds_t)lds_raw;
    C0.tid = threadIdx.x; C0.lane = C0.tid & 63; C0.wid = __builtin_amdgcn_readfirstlane(C0.tid >> 6); C0.bid = blockIdx.x; C0.G = gridDim.x;
    const Ctx& C = C0;
    const int lo = args.ph_lo, hi = args.ph_hi;
    const bool multi = (hi - lo) > 1;
    XcdBarrier bar; bar.bar = (unsigned*)(C.ws + WS_CTL); bar.x = 0; bar.st = (volatile LAS unsigned*)(C.lds + LDS_XB);
    if (multi) {
        if (C.tid == 0) *(LAS u32x4*)(C.lds + LDS_XB) = (u32x4){0u, 0u, 0u, 0u};
        __syncthreads();
        bar = xcd_barrier_post((unsigned*)(C.ws + WS_CTL), (volatile LAS unsigned*)(C.lds + LDS_XB));
    }
#define IN(k) (lo <= (k) && (k) < hi)
#define PHASE_CTX(c) Ctx c = C0; { int t_ = C0.tid; asm volatile("" : "+v"(t_)); c.tid = t_; c.lane = t_ & 63; c.wid = __builtin_amdgcn_readfirstlane(t_ >> 6); }
#ifndef MK_PROBE
#define MK_PROBE 0u
#endif
#ifndef MK_REPEAT
#define MK_REPEAT 0u
#endif
#define RP(k) ((MK_REPEAT >> (k)) & 1u)
#if MK_PROBE
#define STAMP(k) do { if (C0.bid == 0 && C0.tid == 0) ((LAS unsigned long long*)(C0.lds + LDS_XB + 16))[k] = wall_clock64(); } while (0)
#else
#define STAMP(k) do {} while (0)
#endif
#define SEAM(k) do { if (IN(k) && IN((k) + 1)) xcd_barrier(bar); STAMP((k) + 1); } while (0)
    STAMP(0);
    if (PM(0) && IN(0)) { PHASE_CTX(c); ph_prologue(c); if (RP(9)) { xcd_barrier(bar); ph_prologue(c); } } SEAM(0);
    if (PM(1) && IN(1)) { PHASE_CTX(c); ph_norm(c, 0, c.in[6], 0, NROW); } SEAM(1);
    for (int layer = 0; layer < 2; ++layer) {
        const int base = 2 + layer * NPH_LAYER;
        const bool emit = (layer == 0);
        const int nrows = emit ? NROW : NLAT;
        if (PM(2) && IN(base + 0)) {
            pg8::Gemm g{(const bf16_t*)(C.ws + WS_ACT), (const bf16_t*)(C.ws + WS_WIN) + (size_t)layer * NP * DM, NROW, NP, DM};
            pg8::StaticOrder S; S.init(NROW, NP, C.G, C.bid);
            pg8::EpiBf16<0> E{(bf16_t*)(C.ws + WS_P), NP, nullptr, 0, 0};
            pg8::gemm_phase<pg8::EpiBf16<0>, pg8::StaticOrder, false>(C.lds, g, S, E, nullptr);
            if (RP(0)) { xcd_barrier(bar); pg8::gemm_phase<pg8::EpiBf16<0>, pg8::StaticOrder, false>(C.lds, g, S, E, nullptr); }
            { const int nfull = (NROW / 256) * (NP / 256) - ((NROW / 256) * (NP / 256) / C.G) * C.G; PHASE_CTX(c); if (c.bid >= nfull) convert_tables(c, layer, c.bid - nfull, c.G - nfull); }
        }
        SEAM(base + 0);
        if (PM(3) && IN(base + 1)) {
            const int nD = 2112, nC = 264, nB = emit ? 132 : 128, nA = emit ? 264 : 256, tot = nD + nC + nB + nA;
            for (int rep = 0; rep < (RP(1) ? 2 : 1); ++rep) {
            if (rep) xcd_barrier(bar);
            if (PM(11)) { PHASE_CTX(c); for (int it = c.bid; it < nD; it += c.G) item_rwkv_local(c, layer, it); }
            if (PM(12)) { PHASE_CTX(c); for (int it = (c.bid + 52) % c.G; it < nC; it += c.G) item_mamba_local(c, layer, it); }
            if (PM(13)) { PHASE_CTX(c); for (int it = (c.bid + 192) % c.G; it < nB; it += c.G) item_chunkmlp(c, layer, it); }
            if (PM(14)) { PHASE_CTX(c); for (int it = (c.bid + 60) % c.G; it < nA; it += c.G) item_conformer(c, layer, it); }
            }
        }
        SEAM(base + 1);
        if (PM(4) && IN(base + 2)) { PHASE_CTX(c); ph_scan(c, RP(2) ? 2 : 1); }
        SEAM(base + 2);
        if (PM(5) && IN(base + 3)) {
            const int nc = nrows / 64;
            for (int rep = 0; rep < (RP(3) ? 2 : 1); ++rep) {
            if (rep) xcd_barrier(bar);
            if (PM(15)) { PHASE_CTX(c); load_g2t(c, layer); for (int it = c.bid; it < nc; it += c.G) item_rwkv_out(c, layer, it); }
            __syncthreads();
            if (PM(16)) { PHASE_CTX(c); for (int it = c.bid; it < nc; it += c.G) item_mamba_out(c, layer, (it + 128) % nc); }
            __syncthreads();
            }
        }
        SEAM(base + 3);
        if (PM(6) && IN(base + 4)) {
            pg8::Gemm g{(const bf16_t*)(C.ws + WS_ACT), (const bf16_t*)(C.ws + WS_WOUT) + (size_t)layer * DM * DM, nrows, DM, DM};
            pg8::StaticOrder S; S.init(nrows, DM, C.G, C.bid);
            EpiResid E{(float*)(C.ws + WS_H), (const float*)(C.ws + WS_MOD) + (size_t)layer * 3 * 6144};
            pg8::gemm_phase<EpiResid, pg8::StaticOrder, false>(C.lds, g, S, E, nullptr);
        }
        SEAM(base + 4);
        if (PM(7) && IN(base + 5)) { PHASE_CTX(c); for (int rep = 0; rep < (RP(5) ? 2 : 1); ++rep) { if (rep) xcd_barrier(bar); ph_norm(c, layer, c.in[7] + layer * 1024, 3, nrows); } }
        SEAM(base + 5);
        if (PM(8) && IN(base + 6)) {
            pg8::Gemm g{(const bf16_t*)(C.ws + WS_ACT), (const bf16_t*)(C.ws + WS_WQ) + (size_t)layer * 2048 * DM, nrows, 2048, DM};
            pg8::StaticOrder S; S.init(nrows, 2048, C.G, C.bid);
            pg8::EpiBf16<0> E{(bf16_t*)(C.ws + WS_Q), 2048, nullptr, 0, 0};
            pg8::gemm_phase<pg8::EpiBf16<0>, pg8::StaticOrder, false>(C.lds, g, S, E, nullptr);
            if (RP(6)) { xcd_barrier(bar); pg8::gemm_phase<pg8::EpiBf16<0>, pg8::StaticOrder, false>(C.lds, g, S, E, nullptr); }
        }
        SEAM(base + 6);
        if (PM(9) && IN(base + 7)) { PHASE_CTX(c); ph_select(c, layer, nrows); if (RP(7)) { xcd_barrier(bar); ph_select(c, layer, nrows); } }
        SEAM(base + 7);
        if (PM(10) && IN(base + 8)) { PHASE_CTX(c); if (RP(8)) { ph_peer(c, layer, nrows, layer == 1, args.ph_hi > 1000); xcd_barrier(bar); } ph_peer(c, layer, nrows, layer == 1); }
        SEAM(base + 8);
    }
#if MK_PROBE
    {
        xcd_barrier(bar);
        if (C0.bid == 0 && C0.tid == 0) { const LAS unsigned long long* TS = (const LAS unsigned long long*)(C0.lds + LDS_XB + 16);
            unsigned long long sel = 0; for (int k = 0; k < NPH; ++k) if ((MK_PROBE >> k) & 1u) sel += TS[k + 1] - TS[k];
            const unsigned long long tot = TS[NPH] - TS[0];
            __hip_atomic_store((unsigned*)(C0.ws + 40960), (unsigned)((double)sel / (double)tot * (double)NLAT), __ATOMIC_RELAXED, __HIP_MEMORY_SCOPE_AGENT); }
        xcd_barrier(bar);
        const unsigned nz = __hip_atomic_load((unsigned*)(C0.ws + 40960), __ATOMIC_RELAXED, __HIP_MEMORY_SCOPE_AGENT);
        for (size_t i = (size_t)C0.bid * 512 + C0.tid; i < (size_t)nz * 256; i += (size_t)C0.G * 512) *(f32x4*)(C0.out + i * 4) = (f32x4){0.f, 0.f, 0.f, 0.f};
    }
#endif
#undef IN
#undef SEAM
}
}
#ifndef MK_DIAG
#define MK_DIAG 0
#endif


namespace mk {
struct LaunchEnt { unsigned mask; int ph; };
template <unsigned MASK> static bool prep_kernel() {
    return hipFuncSetAttribute((const void*)hybrid_fwd<MASK>, hipFuncAttributeMaxDynamicSharedMemorySize, LDS_BYTES) == hipSuccess;
}
template <unsigned MASK> static void launch_kernel(int grid, hipStream_t stream, const Args& a) {
    hipLaunchKernelGGL(hybrid_fwd<MASK>, dim3(grid), dim3(512), LDS_BYTES, stream, a);
}
}

#if MK_DIAG
namespace mk {
__global__ void census_kernel(const void* buf, size_t n, int kind  , unsigned* flags, int stage, float lim) {
    bool bad = false;
    for (size_t i = (size_t)blockIdx.x * blockDim.x + threadIdx.x; i < n; i += (size_t)gridDim.x * blockDim.x) {
        if (kind == 2) { const int v = ((const int*)buf)[i]; bad |= (v < 0 || v >= 16384); }
        else { const float v = kind == 0 ? ((const float*)buf)[i] : bf2f(((const bf16_t*)buf)[i]); bad |= !(fabsf(v) < lim); }
    }
    if (bad) atomicOr(flags + stage, 1u);
}
__global__ void encode_kernel(const float* x, const float* fg, float* out, const unsigned* flags, int nst) {
    int first = 0; for (int k = nst; k >= 1; --k) if (flags[k]) first = k;
    const int row = blockIdx.x * 4 + (threadIdx.x >> 6), lane = threadIdx.x & 63;
    Row16 r = load_row16(x + (size_t)row * DM, lane);
    const int t = row & 8191;
    for (int i = 0; i < 16; ++i) { const int c = (i < 8 ? 8 * lane + i : 512 + 8 * lane + i - 8); const int quarter = c >> 8, jj = c & 255; const float pos = (quarter < 2) ? (float)(t >> 6) : (float)(t & 63);
        const float fr = exp2f(-(float)jj * (13.287712379549449f / 256.f)); r.v[i] += (quarter & 1) ? cosf(pos * fr) : sinf(pos * fr); }
    float ss = 0.f; for (int i = 0; i < 16; ++i) ss += r.v[i] * r.v[i];
    const float rs = rsqrtf(wave_sum(ss) * (1.f / 1024.f) + 1e-6f);
    const Row16 g = load_row16(fg, lane); Row16 o;
    const bool zero = row < first * 512;
    for (int i = 0; i < 16; ++i) o.v[i] = zero ? 0.f : r.v[i] * rs * g.v[i];
    store_row16_f32(out + (size_t)row * DM, lane, o);
}
}
#define CENSUS(off, n, kind, stage, lim) hipLaunchKernelGGL(mk::census_kernel, dim3(1024), dim3(256), 0, stream, (const void*)((char*)d_ws + (off)), (size_t)(n), kind, (unsigned*)((char*)d_ws + 32768), stage, lim)
#else
#define CENSUS(off, n, kind, stage, lim) do {} while (0)
#endif
#ifndef MK_ONE_LAUNCH
#define MK_ONE_LAUNCH 1
#endif
extern "C" void kernel_launch(void* const* d_in, const int* in_sizes, int n_in, void* d_out, int out_size, void* d_ws, size_t ws_size, hipStream_t stream) {
    using namespace mk;
    static int grid = 0;
    if (grid == 0) {
        if (n_in != 42 || ws_size < WS_END) { fprintf(stderr, "kernel_launch: need 42 inputs and %zu bytes of workspace (got %d, %zu)\n", (size_t)WS_END, n_in, ws_size); grid = -1; return; }
        int dev = 0, cus = 0;
        if (hipGetDevice(&dev) != hipSuccess || hipDeviceGetAttribute(&cus, hipDeviceAttributeMultiprocessorCount, dev) != hipSuccess) { grid = -1; return; }
        bool ok = true;
#if MK_ONE_LAUNCH
        ok = ok && prep_kernel<0x1FFFFu>();
#else
        ok = ok && prep_kernel<0x0001u>() && prep_kernel<0x0002u>() && prep_kernel<0x0004u>() && prep_kernel<0x0808u>() && prep_kernel<0x1008u>() && prep_kernel<0x2008u>() && prep_kernel<0x4008u>()
                && prep_kernel<0x0010u>() && prep_kernel<0x8020u>() && prep_kernel<0x10020u>() && prep_kernel<0x0040u>() && prep_kernel<0x0080u>() && prep_kernel<0x0100u>() && prep_kernel<0x0200u>() && prep_kernel<0x0400u>();
#endif
        if (!ok) { fprintf(stderr, "kernel_launch: hipFuncSetAttribute failed\n"); grid = -1; return; }
        (void)hipGetLastError();
        grid = cus;
    }
    if (grid < 0) return;
    (void)hipMemsetAsync((char*)d_ws + WS_CTL, 0, 65536, stream);
    Args a{};
    for (int i = 0; i < 42; ++i) a.in[i] = (const float*)d_in[i];
    a.out = (float*)d_out; a.ws = (unsigned char*)d_ws;
#if MK_ONE_LAUNCH
    a.ph_lo = 0; a.ph_hi = NPH; launch_kernel<0x1FFFFu>(grid, stream, a);
#else
    a.ph_lo = 0; a.ph_hi = 1; launch_kernel<0x0001u>(grid, stream, a);
    CENSUS(WS_H, (size_t)NROW * DM, 0, 1, 1e4f); CENSUS(WS_MOD, 2 * 3 * 6144, 0, 1, 1e4f); CENSUS(WS_WIN, 2ull * NP * DM, 1, 1, 1e4f); CENSUS(WS_UB, 2ull * NEXP * DM, 1, 1, 1e4f);
    a.ph_lo = 1; a.ph_hi = 2; launch_kernel<0x0002u>(grid, stream, a);
    CENSUS(WS_ACT, (size_t)NROW * DM, 1, 2, 1e4f);
    for (int layer = 0; layer < 2; ++layer) {
        const int b = 2 + layer * NPH_LAYER;
        const int so = layer ? 100 : 0; (void)so;
        a.ph_lo = b + 0; a.ph_hi = b + 1; launch_kernel<0x0004u>(grid, stream, a);
        if (!layer) CENSUS(WS_P, (size_t)NROW * NP, 1, 3, 1e4f);
        a.ph_lo = b + 1; a.ph_hi = b + 2; launch_kernel<0x0808u>(grid, stream, a);
        if (!layer) { CENSUS(WS_RG, (size_t)NSLOT * 4096, 1, 4, 1e6f); CENSUS(WS_RJ, (size_t)NSLOT * 4096, 0, 5, 1e6f); CENSUS(WS_RY, (size_t)NSLOT * 4096 * 2, 1, 6, 1e6f); CENSUS(WS_BON, (size_t)NROW * 8, 0, 6, 1e6f); }
        launch_kernel<0x1008u>(grid, stream, a);
        if (!layer) { CENSUS(WS_MST, (size_t)NSLOT * 8192, 0, 7, 1e6f); CENSUS(WS_MCD, NSLOT, 0, 7, 1e6f); }
        launch_kernel<0x2008u>(grid, stream, a); launch_kernel<0x4008u>(grid, stream, a);
        a.ph_lo = b + 2; a.ph_hi = b + 3; launch_kernel<0x0010u>(grid, stream, a);
        if (!layer) { CENSUS(WS_MST, (size_t)NSLOT * 8192, 0, 8, 1e6f); CENSUS(WS_RH, (size_t)NSLOT * 4096, 1, 9, 1e6f); }
        a.ph_lo = b + 3; a.ph_hi = b + 4; launch_kernel<0x8020u>(grid, stream, a); launch_kernel<0x10020u>(grid, stream, a);
        if (!layer) CENSUS(WS_ACT, (size_t)NROW * DM, 1, 10, 1e4f);
        a.ph_lo = b + 4; a.ph_hi = b + 5; launch_kernel<0x0040u>(grid, stream, a);
        if (!layer) CENSUS(WS_H, (size_t)NROW * DM, 0, 11, 1e4f);
        a.ph_lo = b + 5; a.ph_hi = b + 6; launch_kernel<0x0080u>(grid, stream, a);
        a.ph_lo = b + 6; a.ph_hi = b + 7; launch_kernel<0x0100u>(grid, stream, a);
        if (!layer) CENSUS(WS_Q, (size_t)NROW * 2048, 1, 12, 1e4f);
        a.ph_lo = b + 7; a.ph_hi = b + 8; launch_kernel<0x0200u>(grid, stream, a);
        if (!layer) { CENSUS(WS_SELI, (size_t)NROW * 128, 2, 13, 0.f); CENSUS(WS_SELG, (size_t)NROW * 128, 0, 13, 2.f); }
        a.ph_lo = b + 8; a.ph_hi = b + 9; launch_kernel<0x0400u>(grid, stream, a);
        if (!layer) { CENSUS(WS_H, (size_t)NROW * DM, 0, 14, 1e4f); CENSUS(WS_ACT, (size_t)NROW * DM, 1, 15, 1e4f); }
    }
#endif
#if MK_DIAG
    hipLaunchKernelGGL(mk::encode_kernel, dim3(NLAT / 4), dim3(256), 0, stream, (const float*)d_in[0], (const float*)d_in[41], (float*)d_out, (const unsigned*)((char*)d_ws + 32768), 15);
#endif
    (void)in_sizes; (void)out_size;
}
```

```cpp
#include <hip/hip_runtime.h>
#include <cstdio>
#include <cstdint>
namespace pg8 {
#define PG8_LAS __attribute__((address_space(3)))
typedef unsigned short bf16_t;
typedef short bf16x8 __attribute__((ext_vector_type(8)));
typedef float f32x4 __attribute__((ext_vector_type(4)));
typedef unsigned u32x4 __attribute__((ext_vector_type(4)));
constexpr int BM = 256, BK = 64, HALF = 128, HTB = HALF * BK * 2  , STAGE_BYTES = 8 * HTB, NXCD = 8, WGM = 8;

__host__ __device__ __forceinline__ int lds_byte(int r, int c) { const int st = (r >> 4) * 2 + (c >> 5), rr = r & 15, cc = c & 31, ob = rr * 64 + cc * 2; return st * 1024 + (ob ^ (((ob >> 9) & 1) << 5)); }
__host__ __device__ __forceinline__ void stage_rc(int b, int& R, int& C) { const int st = b / 1024, sb = b % 1024, swz = sb ^ (((sb >> 9) & 1) << 5); R = (st >> 1) * 16 + swz / 64; C = (st & 1) * 32 + (swz % 64) / 2; }
__host__ __device__ __forceinline__ int perm32(int rho) { const int n = rho >> 4, i = rho & 15; return 8 * (i >> 2) + 4 * n + (i & 3); }

struct Unit { int pm, pn; };
struct Gemm { const bf16_t* A; const bf16_t* Bt; int M, N, K; };

struct StaticOrder {
    int nM, nN, nwg, G, c;
    __host__ __device__ void init(int M, int N, int G_, int c_) { nM = M / BM; nN = N / BM; nwg = nM * nN; G = G_; c = c_; }
    __host__ __device__ bool next(int i, Unit& u) const {
        const long L = (long)i * G + c; if (L >= nwg) return false;
        int wgid = (int)L; { const int q = nwg / NXCD, r = nwg % NXCD, xcd = wgid % NXCD, off = wgid / NXCD; wgid = (xcd < r ? xcd * (q + 1) : r * (q + 1) + (xcd - r) * q) + off; }
        const int nig = WGM * nN, gid = wgid / nig, fm = gid * WGM, gsz = (nM - fm) < WGM ? (nM - fm) : WGM;
        u.pm = fm + ((wgid % nig) % gsz); u.pn = (wgid % nig) / gsz; return true;
    }
    __device__ __forceinline__ void a_ready(const Unit&) const {}
    __device__ __forceinline__ void done(const Unit&) const {}
};
struct CountedOrder : StaticOrder {
    const unsigned* ready; unsigned need; unsigned* tmo;
    __device__ __forceinline__ void a_ready(const Unit& u) const {
        if (threadIdx.x < 64) {
            const unsigned long long t0 = __builtin_amdgcn_s_memrealtime(); unsigned polls = 0;
            while ((unsigned)__builtin_amdgcn_readfirstlane(__hip_atomic_load(ready + 64 * u.pm, __ATOMIC_RELAXED, __HIP_MEMORY_SCOPE_AGENT)) < need) {
                if ((++polls & 255u) == 0u && __builtin_amdgcn_readfirstlane(__hip_atomic_load(tmo, __ATOMIC_RELAXED, __HIP_MEMORY_SCOPE_AGENT)) != 0u) break;
                if (__builtin_amdgcn_s_memrealtime() - t0 > 2000000ull) {
                    if (threadIdx.x == 0) { unsigned expect = 0u; __hip_atomic_compare_exchange_strong(tmo + 1, &expect, 0x600u | (unsigned)(u.pm & 0xff), __ATOMIC_RELAXED, __ATOMIC_RELAXED, __HIP_MEMORY_SCOPE_AGENT); __hip_atomic_store(tmo, 1u, __ATOMIC_RELAXED, __HIP_MEMORY_SCOPE_AGENT); }
                    break; }
                __builtin_amdgcn_s_sleep(2); }
            __builtin_amdgcn_fence(__ATOMIC_ACQUIRE, "agent");
            asm volatile("s_waitcnt vmcnt(0)" ::: "memory");
        }
#if !defined(BROKEN_HOOK_NO_BARRIER)
        asm volatile("" ::: "memory"); __builtin_amdgcn_s_barrier(); asm volatile("" ::: "memory");
#endif
    }
};

__device__ __forceinline__ unsigned cvt_pk_bf16(float lo, float hi) { unsigned r; asm volatile("v_cvt_pk_bf16_f32 %0, %1, %2" : "=v"(r) : "v"(lo), "v"(hi)); return r; }
typedef float f32x2 __attribute__((ext_vector_type(2)));
__device__ __forceinline__ f32x2 gelu_pk(f32x2 v) {
    const f32x2 av = __builtin_elementwise_abs(v), d = av * 0.2316418882f + 1.0f;
    f32x2 t; t.x = __builtin_amdgcn_rcpf(d.x); t.y = __builtin_amdgcn_rcpf(d.y);
    f32x2 q = t * 0.5307027145f + (-0.7265760135f); q = q * t + 0.7107068705f; q = q * t + (-0.142248368f); q = q * t + 0.127414796f; q = q * t;
    const f32x2 s = (v * v) * (-0.72134752044f);
    f32x2 e; e.x = __builtin_amdgcn_exp2f(s.x); e.y = __builtin_amdgcn_exp2f(s.y);
    const f32x2 m = v * (q * e), r = v - m;
    f32x2 o; o.x = v.x < 0.f ? m.x : r.x; o.y = v.y < 0.f ? m.y : r.y; return o;
}

struct EpiF32 {
    static constexpr bool PERM = false, AFTER_DRAIN = false;
    float* C; int ldc; const float* bias;
    __device__ __forceinline__ void operator()(const f32x4 (&acc)[2][2][4][2], const Unit& u, int wr, int wc, int fr, int fq) const {
        const int row0 = u.pm * BM + wr * 64 + fr, col0 = u.pn * BM + wc * 32 + 4 * fq;
        f32x4 bv[2][2];
#pragma unroll
        for (int bj = 0; bj < 2; ++bj)
#pragma unroll
            for (int n = 0; n < 2; ++n) bv[bj][n] = bias ? *(const f32x4*)(bias + col0 + bj * HALF + n * 16) : (f32x4){0.f, 0.f, 0.f, 0.f};
#pragma unroll
        for (int ai = 0; ai < 2; ++ai)
#pragma unroll
            for (int m = 0; m < 4; ++m) { float* rowp = C + (size_t)(row0 + ai * HALF + m * 16) * ldc + col0;
#pragma unroll
                for (int bj = 0; bj < 2; ++bj)
#pragma unroll
                    for (int n = 0; n < 2; ++n) *(f32x4*)(rowp + bj * HALF + n * 16) = acc[ai][bj][m][n] + bv[bj][n]; }
    }
};
template <int ACT  > struct EpiBf16 {
    static constexpr bool PERM = true, AFTER_DRAIN = false;
    bf16_t* O; int ldc; const float* bias; int split_cols; size_t split_stride;
    __device__ __forceinline__ void operator()(const f32x4 (&acc)[2][2][4][2], const Unit& u, int wr, int wc, int fr, int fq) const {
        const int row0 = u.pm * BM + wr * 64 + fr; int colt = u.pn * BM; bf16_t* base = O;
        if (split_cols) { const int t = colt / split_cols; base += (size_t)t * split_stride; colt -= t * split_cols; }
        const int col0 = colt + wc * 32 + 8 * fq, bcol0 = u.pn * BM + wc * 32 + 8 * fq;
        f32x4 bv[2][2];
#pragma unroll
        for (int bj = 0; bj < 2; ++bj)
#pragma unroll
            for (int n = 0; n < 2; ++n) bv[bj][n] = bias ? *(const f32x4*)(bias + bcol0 + bj * HALF + 4 * n) : (f32x4){0.f, 0.f, 0.f, 0.f};
#pragma unroll
        for (int ai = 0; ai < 2; ++ai)
#pragma unroll
            for (int m = 0; m < 4; ++m) { bf16_t* rowp = base + (size_t)(row0 + ai * HALF + m * 16) * ldc + col0;
#pragma unroll
                for (int bj = 0; bj < 2; ++bj) { f32x4 v0 = acc[ai][bj][m][0] + bv[bj][0], v1 = acc[ai][bj][m][1] + bv[bj][1];
                    if (ACT == 1) { f32x2 a = gelu_pk((f32x2){v0[0], v0[1]}), b = gelu_pk((f32x2){v0[2], v0[3]}), c = gelu_pk((f32x2){v1[0], v1[1]}), d = gelu_pk((f32x2){v1[2], v1[3]});
                        v0 = (f32x4){a.x, a.y, b.x, b.y}; v1 = (f32x4){c.x, c.y, d.x, d.y}; }
                    if (ACT == 2) {
#pragma unroll
                        for (int j = 0; j < 4; ++j) { v0[j] = 0.5f * v0[j] * (1.0f + erff(v0[j] * 0.70710678f)); v1[j] = 0.5f * v1[j] * (1.0f + erff(v1[j] * 0.70710678f)); } }
                    u32x4 w; w.x = cvt_pk_bf16(v0[0], v0[1]); w.y = cvt_pk_bf16(v0[2], v0[3]); w.z = cvt_pk_bf16(v1[0], v1[1]); w.w = cvt_pk_bf16(v1[2], v1[3]);
                    *(u32x4*)(rowp + bj * HALF) = w; } }
    }
};
template <class Epi, class Sched, bool STAMP = false>
__device__ __forceinline__ void gemm_phase(PG8_LAS unsigned char* lds, const Gemm g, const Sched& S, const Epi& E, unsigned long long* stamps) {
    int tid_ = threadIdx.x; asm volatile("" : "+v"(tid_));
    const int tid = tid_, wid = __builtin_amdgcn_readfirstlane(tid >> 6), lane = tid & 63, wr = wid >> 2, wc = wid & 3, fr = lane & 15, fq = lane >> 4;
    const int K = g.K, nt = K / BK;
    int ts_lo = 0, ts_hi = 0, nts = 0; const unsigned long long rt_entry = STAMP ? (unsigned long long)wall_clock64() : 0ull;
#define PG8_STAMP() do { if (STAMP && wid == 0 && nts < 64) { const unsigned long long _c = (unsigned long long)clock64(); \
        ts_lo = (lane == nts) ? (int)(unsigned)_c : ts_lo; ts_hi = (lane == nts) ? (int)(unsigned)(_c >> 32) : ts_hi; ++nts; } } while (0)
    PG8_STAMP();
    unsigned voffA[2], voffB[2];
#pragma unroll
    for (int i = 0; i < 2; ++i) { int R, C; stage_rc(tid * 16 + i * 8192, R, C); const int Rb = Epi::PERM ? ((R & ~31) + perm32(R & 31)) : R;
        voffA[i] = (unsigned)(R * K + C) * 2u; voffB[i] = (unsigned)(Rb * K + C) * 2u; }
    const size_t kstep = (size_t)(BK * 2);
    const size_t hstep = (size_t)HALF * K * 2;
    const size_t tstep = 2 * hstep;
    const unsigned ldsw = (unsigned)wid * 1024u;
    const int aoff = lds_byte(wr * 64 + fr, fq * 8), boff = lds_byte(wc * 32 + fr, fq * 8);
#define PG8_SA(b, h) (((b) * 2 + (h)) * HTB)
#define PG8_SB(b, h) ((4 + (b) * 2 + (h)) * HTB)
#define PG8_STAGE(bufoff, gbase, voff) do { _Pragma("unroll") for (int _i = 0; _i < 2; ++_i) \
        __builtin_amdgcn_global_load_lds((const unsigned*)((const char*)(gbase) + (voff)[_i]), (PG8_LAS unsigned*)(lds + (bufoff) + ldsw + _i * 8192), 16, 0, 0); } while (0)
#define PG8_LDA(dst, b, h) do { _Pragma("unroll") for (int m = 0; m < 4; ++m) _Pragma("unroll") for (int k = 0; k < 2; ++k) dst[m][k] = *(const PG8_LAS bf16x8*)(lds + PG8_SA(b, h) + aoff + m * 2048 + k * 1024); } while (0)
#define PG8_LDB(dst, b, h) do { _Pragma("unroll") for (int n = 0; n < 2; ++n) _Pragma("unroll") for (int k = 0; k < 2; ++k) dst[n][k] = *(const PG8_LAS bf16x8*)(lds + PG8_SB(b, h) + boff + n * 2048 + k * 1024); } while (0)
#define PG8_MMA(ai, bj, At, Bt) do { __builtin_amdgcn_s_setprio(1); _Pragma("unroll") for (int m = 0; m < 4; ++m) _Pragma("unroll") for (int n = 0; n < 2; ++n) _Pragma("unroll") for (int k = 0; k < 2; ++k) \
        acc[ai][bj][m][n] = __builtin_amdgcn_mfma_f32_16x16x32_bf16(Bt[n][k], At[m][k], acc[ai][bj][m][n], 0, 0, 0); __builtin_amdgcn_s_setprio(0); } while (0)
#define PG8_WAIT_V(n) asm volatile("s_waitcnt vmcnt(" #n ")" ::: "memory")
#define PG8_WAIT_L(n) asm volatile("s_waitcnt lgkmcnt(" #n ")" ::: "memory")
#define PG8_BAR __builtin_amdgcn_s_barrier()
#define PG8_SCHED __builtin_amdgcn_sched_barrier(0)
    Unit cur, nxt; int ui = 0;
    if (!S.next(0, cur)) return;
    f32x4 acc[2][2][4][2];
#pragma unroll
    for (int a = 0; a < 2; ++a)
#pragma unroll
        for (int b = 0; b < 2; ++b)
#pragma unroll
            for (int m = 0; m < 4; ++m)
#pragma unroll
                for (int n = 0; n < 2; ++n) acc[a][b][m][n] = (f32x4){0.f, 0.f, 0.f, 0.f};
    bf16x8 At[4][2], B0[2][2], B1[2][2];
    const char* cA = (const char*)g.A + (size_t)cur.pm * tstep; const char* cB = (const char*)g.Bt + (size_t)cur.pn * tstep;
    S.a_ready(cur);
    PG8_STAGE(PG8_SB(0, 0), cB, voffB); PG8_STAGE(PG8_SA(0, 0), cA, voffA); PG8_STAGE(PG8_SB(0, 1), cB + hstep, voffB); PG8_STAGE(PG8_SA(0, 1), cA + hstep, voffA);
    if (wr == 1) PG8_BAR;
    PG8_WAIT_V(4); PG8_BAR;
    PG8_STAGE(PG8_SB(1, 0), cB + kstep, voffB); PG8_STAGE(PG8_SA(1, 0), cA + kstep, voffA); PG8_STAGE(PG8_SB(1, 1), cB + hstep + kstep, voffB);
    PG8_WAIT_V(6); PG8_BAR;
    PG8_STAMP();
    for (;;) {
        const bool has_next = S.next(ui + 1, nxt);
        const char* nA = has_next ? (const char*)g.A + (size_t)nxt.pm * tstep : cA; const char* nB = has_next ? (const char*)g.Bt + (size_t)nxt.pn * tstep : cB;
        for (int t = 0; t < nt; t += 2) {
            const bool last = (t == nt - 2);
            const char* a1 = cA + (size_t)(t + 1) * kstep;
            const char* a2 = last ? nA : cA + (size_t)(t + 2) * kstep; const char* b2 = last ? nB : cB + (size_t)(t + 2) * kstep;
            const char* a3 = a2 + kstep; const char* b3 = b2 + kstep;
            if (last && has_next) S.a_ready(nxt);
            PG8_LDB(B0, 0, 0); PG8_SCHED; PG8_LDA(At, 0, 0); PG8_STAGE(PG8_SA(1, 1), a1 + hstep, voffA);
            PG8_WAIT_L(8); PG8_BAR; PG8_WAIT_L(0); PG8_MMA(0, 0, At, B0); PG8_BAR; PG8_SCHED;
            PG8_LDB(B1, 0, 1); PG8_STAGE(PG8_SB(0, 0), b2, voffB);
            PG8_BAR; PG8_WAIT_L(0); PG8_MMA(0, 1, At, B1); PG8_BAR;
            PG8_LDA(At, 0, 1); PG8_STAGE(PG8_SA(0, 0), a2, voffA);
            PG8_BAR; PG8_WAIT_L(0); PG8_MMA(1, 0, At, B0); PG8_BAR; PG8_SCHED;
            PG8_STAGE(PG8_SB(0, 1), b2 + hstep, voffB);
            PG8_WAIT_V(6); PG8_BAR; PG8_MMA(1, 1, At, B1); PG8_BAR;
            PG8_LDB(B0, 1, 0); PG8_SCHED; PG8_LDA(At, 1, 0); PG8_STAGE(PG8_SA(0, 1), a2 + hstep, voffA);
            PG8_WAIT_L(8); PG8_BAR; PG8_WAIT_L(0); PG8_MMA(0, 0, At, B0); PG8_BAR; PG8_SCHED;
            PG8_LDB(B1, 1, 1); PG8_STAGE(PG8_SB(1, 0), b3, voffB);
            PG8_BAR; PG8_WAIT_L(0); PG8_MMA(0, 1, At, B1); PG8_BAR;
            PG8_LDA(At, 1, 1); PG8_STAGE(PG8_SA(1, 0), a3, voffA);
            PG8_BAR; PG8_WAIT_L(0); PG8_MMA(1, 0, At, B0); PG8_BAR; PG8_SCHED;
            PG8_STAGE(PG8_SB(1, 1), b3 + hstep, voffB);
            PG8_WAIT_V(6); PG8_BAR; PG8_MMA(1, 1, At, B1); PG8_BAR;
        }
        PG8_STAMP();
        if constexpr (!Epi::AFTER_DRAIN) { E(acc, cur, wr, wc, fr, fq); S.done(cur); }
        PG8_STAMP();
        if (!has_next) break;
#pragma unroll
        for (int a = 0; a < 2; ++a)
#pragma unroll
            for (int b = 0; b < 2; ++b)
#pragma unroll
                for (int m = 0; m < 4; ++m)
#pragma unroll
                    for (int n = 0; n < 2; ++n) acc[a][b][m][n] = (f32x4){0.f, 0.f, 0.f, 0.f};
        cur = nxt; cA = nA; cB = nB; ++ui;
    }
    PG8_WAIT_V(0);
    if (wr == 0) PG8_BAR;
    PG8_BAR;
    if constexpr (Epi::AFTER_DRAIN) { E.fused(acc, cur, wr, wc, fr, fq, lds, wid, lane); S.done(cur); }
    PG8_STAMP();
    if (STAMP && wid == 0) { stamps[lane] = lane < nts ? (((unsigned long long)(unsigned)ts_hi << 32) | (unsigned)ts_lo) : 0ull;
        if (lane == 62) stamps[62] = rt_entry; if (lane == 63) stamps[63] = (unsigned long long)wall_clock64(); }
#undef PG8_STAMP
#undef PG8_SA
#undef PG8_SB
#undef PG8_STAGE
#undef PG8_LDA
#undef PG8_LDB
#undef PG8_MMA
#undef PG8_WAIT_V
#undef PG8_WAIT_L
#undef PG8_BAR
#undef PG8_SCHED
}
}
#define XB_TMO      128
#define XB_XCNT(j)  (256  + 64 * (j))
#define XB_XSUB(j)  (1280 + 64 * (j))
#define XB_XGEN(j)  (2304 + 64 * (j))
#define XB_TOP      3328
#define XB_TOPGEN   3392
#define XCD_BAR_WORDS 3456
#define XB_SPIN_CAP (1u << 18)
#define LAS __attribute__((address_space(3)))

__device__ __forceinline__ unsigned xb_ld(unsigned* p)              { return __hip_atomic_load(p, __ATOMIC_RELAXED, __HIP_MEMORY_SCOPE_AGENT); }
__device__ __forceinline__ unsigned xb_add(unsigned* p, unsigned v) { return __hip_atomic_fetch_add(p, v, __ATOMIC_RELAXED, __HIP_MEMORY_SCOPE_AGENT); }
__device__ __forceinline__ unsigned xb_xcc_id() { return (unsigned)__builtin_amdgcn_s_getreg((3 << 11) | 20) & 0xFu; }
#define XB_SPIN(cond, bar) do { unsigned _sp = 0; while (cond) { __builtin_amdgcn_s_sleep(1); \
    if ((++_sp & 255u) == 0u) { if (xb_ld(&(bar)[XB_TMO])) break; if (_sp > XB_SPIN_CAP) { atomicAdd(&(bar)[XB_TMO], 1u); break; } } } } while (0)

struct XcdBarrier {
    unsigned* bar; unsigned x;
    volatile LAS unsigned* st;
};

__device__ __forceinline__ XcdBarrier xcd_barrier_post(unsigned* bar, volatile LAS unsigned* st) {
    XcdBarrier b; b.bar = bar; b.x = xb_xcc_id(); b.st = st;
    if (threadIdx.x == 0) (void)xb_add(&bar[XB_XCNT(b.x)], 1u);
    return b;
}
__device__ __forceinline__ void xcd_barrier_complete(unsigned* bar, unsigned x, unsigned& nloc, unsigned& nx) {
    const unsigned G = gridDim.x * gridDim.y * gridDim.z;
    unsigned sum, cnt, mine, sp = 0u;
    for (;;) {
        sum = 0u; cnt = 0u; mine = 0u;
#pragma unroll
        for (unsigned j = 0; j < 16; ++j) { const unsigned c = xb_ld(&bar[XB_XCNT(j)]); sum += c; cnt += (c > 0u) ? 1u : 0u; mine = (j == x) ? c : mine; }
        if (sum == G) break;
        __builtin_amdgcn_s_sleep(1);
        if ((++sp & 255u) == 0u) { if (xb_ld(&bar[XB_TMO])) break; if (sp > XB_SPIN_CAP) { atomicAdd(&bar[XB_TMO], 1u); break; } }
    }
    nloc = mine > 0u ? mine : 1u; nx = cnt > 0u ? cnt : 1u;
}

__device__ __forceinline__ void xcd_barrier(const XcdBarrier& b) {
    asm volatile("s_waitcnt vmcnt(0)" ::: "memory");
    __syncthreads();
    if (threadIdx.x == 0) {
        unsigned* bar = b.bar;
        __builtin_amdgcn_s_waitcnt(0);
        unsigned nloc = b.st[0], nx = b.st[1];
        if (nloc == 0u) { xcd_barrier_complete(bar, b.x, nloc, nx); b.st[0] = nloc; b.st[1] = nx; }
        const unsigned old = xb_add(&bar[XB_XSUB(b.x)], 1u);
        const unsigned gen = old / nloc;
        if (old + 1u == (gen + 1u) * nloc) {
            __builtin_amdgcn_fence(__ATOMIC_RELEASE, "agent");
            asm volatile("s_waitcnt vmcnt(0)" ::: "memory");
            const unsigned og = xb_add(&bar[XB_TOP], 1u);
            const unsigned tg = og / nx;
            if (og + 1u == (tg + 1u) * nx) xb_add(&bar[XB_TOPGEN], 1u);
            else XB_SPIN(xb_ld(&bar[XB_TOPGEN]) == tg, bar);
            __builtin_amdgcn_fence(__ATOMIC_ACQUIRE, "agent");
            xb_add(&bar[XB_XGEN(b.x)], 1u);
            asm volatile("s_waitcnt vmcnt(0)" ::: "memory");
        } else {
            XB_SPIN(xb_ld(&bar[XB_XGEN(b.x)]) == gen, bar);
            __builtin_amdgcn_fence(__ATOMIC_ACQUIRE, "agent");
            asm volatile("s_waitcnt vmcnt(0)" ::: "memory");
        }
    }
    __syncthreads();
}

namespace mk {
using pg8::bf16_t; using pg8::bf16x8; using pg8::f32x4; using pg8::u32x4;
typedef unsigned u32x2 __attribute__((ext_vector_type(2)));
typedef __bf16 bf16x2_t __attribute__((ext_vector_type(2)));
typedef LAS unsigned char* lds_t;

constexpr int DM = 1024, NLAT = 16384, NROW = 16896;
constexpr int OFF_B = 512, OFF_C = 1024, OFF_D = 2056, INC = 3208, NP = 3328;
constexpr int NCH = 132, NSLOT = 16 * NCH;
constexpr int NEXP = 16384;

constexpr size_t WS_CTL  = 0;
constexpr size_t WS_MOD  = 65536;
constexpr size_t WS_WIN  = WS_MOD + 147456;
constexpr size_t WS_WOUT = WS_WIN + 2ull * NP * DM * 2;
constexpr size_t WS_WQ   = WS_WOUT + 2ull * DM * DM * 2;
constexpr size_t WS_H    = WS_WQ + 2ull * 2048 * DM * 2;
constexpr size_t WS_ACT  = WS_H + (size_t)NROW * DM * 4;
constexpr size_t WS_UB   = WS_ACT + (size_t)NROW * DM * 2;
constexpr size_t WS_VB   = WS_UB + (size_t)NEXP * DM * 2;
constexpr size_t WS_SU   = WS_UB + (size_t)NEXP * DM;
constexpr size_t WS_SV   = WS_VB + (size_t)NEXP * DM;
constexpr size_t WS_P    = WS_VB + (size_t)NEXP * DM * 2;
constexpr size_t WS_Q    = WS_P;
constexpr size_t WS_SELI = WS_Q + (size_t)NROW * 2048 * 2;
constexpr size_t WS_SELG = WS_SELI + (size_t)NROW * 128 * 4;
constexpr size_t WS_MST  = WS_P + (size_t)NROW * NP * 2;
constexpr size_t WS_MCD  = WS_MST + (size_t)NSLOT * 8192 * 4;
constexpr size_t WS_RG   = WS_MCD + 16384;
constexpr size_t WS_RJ   = WS_RG + (size_t)NSLOT * 8192;
constexpr size_t WS_RY   = WS_RJ + (size_t)NSLOT * 16384;
constexpr size_t WS_RL   = WS_RY + (size_t)NSLOT * 8192;
constexpr size_t WS_RH   = WS_RL + (size_t)NSLOT * 8192;
constexpr size_t WS_BON  = WS_RH + (size_t)NSLOT * 8192;
constexpr size_t WS_END  = WS_BON + (size_t)NROW * 8 * 4;
static_assert(WS_SELG + (size_t)NROW * 128 * 4 <= WS_MST, "Q + selections must fit in P's region");

constexpr int LDS_BYTES = 157440;
constexpr int LDS_XB = 157184;

struct Args { const float* in[42]; float* out; unsigned char* ws; int ph_lo, ph_hi; };

struct Ctx {
    const float* const* in; float* out; unsigned char* ws; lds_t lds;
    int tid, lane, wid, bid, G;
};

__device__ __forceinline__ float bf2f(unsigned short x) { return __uint_as_float(((unsigned)x) << 16); }
__device__ __forceinline__ float bflo(unsigned w) { return __uint_as_float(w << 16); }
__device__ __forceinline__ float bfhi(unsigned w) { return __uint_as_float(w & 0xffff0000u); }
typedef __bf16 bf16pair_t __attribute__((ext_vector_type(2)));
__device__ __forceinline__ unsigned pk2(float lo, float hi) { const bf16pair_t v = {(__bf16)lo, (__bf16)hi}; return __builtin_bit_cast(unsigned, v); }
__device__ __forceinline__ unsigned short f2bf(float f) { return (unsigned short)(pk2(f, 0.f) & 0xffffu); }
__device__ __forceinline__ float wave_sum(float v) {
#pragma unroll
    for (int o = 1; o < 64; o <<= 1) v += __shfl_xor(v, o);
    return v;
}
__device__ __forceinline__ float wave_incl_scan(float v, int lane) {
#pragma unroll
    for (int o = 1; o < 64; o <<= 1) { const float t = __shfl_up(v, o); v += (lane >= o) ? t : 0.f; }
    return v;
}
__device__ __forceinline__ float fexp(float x) { return __expf(x); }
__device__ __forceinline__ float frcp(float x) { return __builtin_amdgcn_rcpf(x); }
__device__ __forceinline__ float sigm(float x) { return frcp(1.f + __expf(-x)); }
__device__ __forceinline__ float silu(float x) { return x * frcp(1.f + __expf(-x)); }
__device__ __forceinline__ float softplus(float x) { return fmaxf(x, 0.f) + __logf(1.f + __expf(-fabsf(x))); }
__device__ __forceinline__ float ftanh(float x) { const float e = __expf(-2.f * fabsf(x)); const float t = (1.f - e) * frcp(1.f + e); return x < 0.f ? -t : t; }
__device__ __forceinline__ float gelu_tanh(float x) { const float u = 0.7978845608028654f * (x + 0.044715f * x * x * x); return 0.5f * x * (1.f + ftanh(u)); }
__device__ __forceinline__ float dot2bf(unsigned a, unsigned b, float acc) { return __builtin_amdgcn_fdot2_f32_bf16(__builtin_bit_cast(bf16x2_t, a), __builtin_bit_cast(bf16x2_t, b), acc, false); }

struct ChunkInfo { int row0, lo, hi, b, tc, isctx; };
__device__ __forceinline__ ChunkInfo chunk_info(int gc) {
    ChunkInfo c; c.row0 = gc * 64;
    if (gc < 256) { c.b = gc >> 7; c.tc = gc & 127; c.isctx = 0; c.lo = c.b * 8192; c.hi = c.lo + 8192; }
    else { const int q = gc - 256; c.b = q >> 2; c.tc = q & 3; c.isctx = 1; c.lo = NLAT + c.b * 256; c.hi = c.lo + 256; }
    return c;
}
__device__ __forceinline__ int cpos_of(const ChunkInfo& c, int d) { return c.isctx ? (d ? 3 - c.tc : c.tc) : (d ? 4 + 127 - c.tc : 4 + c.tc); }
__device__ __forceinline__ int slot_of(int b, int h, int d, int cpos) { return ((b * 4 + h) * 2 + d) * NCH + cpos; }

template <int MT, int NT, int KS, class Epi>
__device__ __forceinline__ void blk_mma(const LAS bf16_t* A, int lda, const LAS bf16_t* Bt, int ldb, int wid, int lane, Epi epi) {
    const int fr = lane & 15, fq = lane >> 4;
    for (int tt = wid; tt < MT * NT; tt += 8) {
        const int tm = tt / NT, tn = tt % NT;
        f32x4 acc = {0.f, 0.f, 0.f, 0.f};
#pragma unroll
        for (int ks = 0; ks < KS; ++ks) {
            const bf16x8 a = *(const LAS bf16x8*)(A + (tm * 16 + fr) * lda + ks * 32 + fq * 8);
            const bf16x8 b = *(const LAS bf16x8*)(Bt + (tn * 16 + fr) * ldb + ks * 32 + fq * 8);
            acc = __builtin_amdgcn_mfma_f32_16x16x32_bf16(a, b, acc, 0, 0, 0);
        }
        epi(tm * 16 + fq * 4, tn * 16 + fr, acc);
    }
}
template <int MT, int NT, int KS, class Epi>
__device__ __forceinline__ void blk_mma2(const LAS bf16_t* A1, const LAS bf16_t* B1, const LAS bf16_t* A2, const LAS bf16_t* B2, int ld, int wid, int lane, Epi epi) {
    const int fr = lane & 15, fq = lane >> 4;
    for (int tt = wid; tt < MT * NT; tt += 8) {
        const int tm = tt / NT, tn = tt % NT;
        f32x4 acc1 = {0.f, 0.f, 0.f, 0.f}, acc2 = {0.f, 0.f, 0.f, 0.f};
#pragma unroll
        for (int ks = 0; ks < KS; ++ks) {
            const bf16x8 a1 = *(const LAS bf16x8*)(A1 + (tm * 16 + fr) * ld + ks * 32 + fq * 8);
            const bf16x8 b1 = *(const LAS bf16x8*)(B1 + (tn * 16 + fr) * ld + ks * 32 + fq * 8);
            acc1 = __builtin_amdgcn_mfma_f32_16x16x32_bf16(a1, b1, acc1, 0, 0, 0);
            const bf16x8 a2 = *(const LAS bf16x8*)(A2 + (tm * 16 + fr) * ld + ks * 32 + fq * 8);
            const bf16x8 b2 = *(const LAS bf16x8*)(B2 + (tn * 16 + fr) * ld + ks * 32 + fq * 8);
            acc2 = __builtin_amdgcn_mfma_f32_16x16x32_bf16(a2, b2, acc2, 0, 0, 0);
        }
        epi(tm * 16 + fq * 4, tn * 16 + fr, acc1, acc2);
    }
}

__device__ __forceinline__ void transpose_item(const float* W, int K, int N, int nblk, bf16_t* WT, LAS float* scr, int item, int lane) {
    const int kb = item / nblk, nb = item % nblk, k0 = 64 * kb, n0 = 32 * nb;
    const int nn = n0 + (lane & 31);
#pragma unroll 8
    for (int i = 0; i < 32; ++i) { const int kk = 2 * i + (lane >> 5); scr[kk * 33 + (lane & 31)] = (nn < N) ? W[(size_t)(k0 + kk) * N + nn] : 0.f; }
    asm volatile("s_waitcnt lgkmcnt(0)" ::: "memory");
    const int c = lane & 7;
#pragma unroll
    for (int j = 0; j < 4; ++j) { const int n = (lane >> 3) + 8 * j; const LAS float* s = scr + (8 * c) * 33 + n;
        u32x4 o; o.x = pk2(s[0 * 33], s[1 * 33]); o.y = pk2(s[2 * 33], s[3 * 33]); o.z = pk2(s[4 * 33], s[5 * 33]); o.w = pk2(s[6 * 33], s[7 * 33]);
        *(u32x4*)(WT + (size_t)(n0 + n) * K + k0 + 8 * c) = o; }
    asm volatile("s_waitcnt lgkmcnt(0)" ::: "memory");
}
__device__ __forceinline__ float wave_maxf(float v) {
#pragma unroll
    for (int o = 1; o < 64; o <<= 1) v = fmaxf(v, __shfl_xor(v, o));
    return v;
}
__device__ __forceinline__ void convert_tables(const Ctx& C, int layer, int rank, int nrank) {
    const float* U = C.in[39] + (size_t)layer * NEXP * DM; const float* V = C.in[40] + (size_t)layer * NEXP * DM;
    unsigned char* UB = C.ws + WS_UB; unsigned char* VB = C.ws + WS_VB; float* SU = (float*)(C.ws + WS_SU); float* SV = (float*)(C.ws + WS_SV);
    for (int r4 = (rank * 8 + C.wid) * 4; r4 < 2 * NEXP; r4 += nrank * 8 * 4) {
        const bool isv = r4 >= NEXP; const int row0 = isv ? r4 - NEXP : r4;
        const float* src = (isv ? V : U) + (size_t)row0 * DM + 16 * C.lane;
        f32x4 x[4][4];
#pragma unroll
        for (int q = 0; q < 4; ++q)
#pragma unroll
            for (int k = 0; k < 4; ++k) x[q][k] = *(const f32x4*)(src + (size_t)q * DM + 4 * k);
#pragma unroll
        for (int q = 0; q < 4; ++q) {
            float m = 0.f;
#pragma unroll
            for (int k = 0; k < 4; ++k) m = fmaxf(fmaxf(m, fmaxf(fabsf(x[q][k].x), fabsf(x[q][k].y))), fmaxf(fabsf(x[q][k].z), fabsf(x[q][k].w)));
            m = wave_maxf(m);
            const float sc = m > 0.f ? 224.f / m : 1.f;
            u32x4 o;
#pragma unroll
            for (int k = 0; k < 4; ++k) { int w = __builtin_amdgcn_cvt_pk_fp8_f32(x[q][k].x * sc, x[q][k].y * sc, 0, false); w = __builtin_amdgcn_cvt_pk_fp8_f32(x[q][k].z * sc, x[q][k].w * sc, w, true); o[k] = (unsigned)w; }
            *(u32x4*)((isv ? VB : UB) + (size_t)(row0 + q) * DM + 16 * C.lane) = o;
            if (C.lane == 0) (isv ? SV : SU)[row0 + q] = m > 0.f ? m * (1.f / 224.f) : 1.f;
        }
    }
}
__device__ __forceinline__ void ph_prologue(const Ctx& C) {
    const int gw = C.bid * 8 + C.wid, NGW = C.G * 8;
    {
        LAS float* scr = (LAS float*)(C.lds + C.wid * 16384);
        bf16_t* WIN = (bf16_t*)(C.ws + WS_WIN); bf16_t* WOUT = (bf16_t*)(C.ws + WS_WOUT); bf16_t* WQ = (bf16_t*)(C.ws + WS_WQ);
        for (int it = gw; it < 6400; it += NGW) {
            const int layer = it / 3200; int r = it % 3200;
            if (r < 1664) { transpose_item(C.in[8] + (size_t)layer * DM * INC, DM, INC, 104, WIN + (size_t)layer * NP * DM, scr, r, C.lane); continue; } r -= 1664;
            if (r < 512) { transpose_item(C.in[9] + (size_t)layer * DM * DM, DM, DM, 32, WOUT + (size_t)layer * DM * DM, scr, r, C.lane); continue; } r -= 512;
            transpose_item(C.in[36] + (size_t)layer * DM * 2048, DM, 2048, 64, WQ + (size_t)layer * 2048 * DM, scr, r, C.lane);
        }
    }
    __syncthreads();
    {
        LAS float* sv = (LAS float*)C.lds;
        LAS float* red = (LAS float*)(C.lds + 12288);
        for (int i = C.tid; i < 3 * 1024; i += 512) { const int w = i >> 10, k = i & 1023; const float x = (w < 2) ? C.in[1][w * 1024 + k] : C.in[3][k]; sv[i] = silu(x); }
        __syncthreads();
        float* MOD = (float*)(C.ws + WS_MOD);
        for (int it = C.bid; it < 192; it += C.G) {
            const int layer = it / 96, col0 = (it % 96) * 64, col = C.tid & 63, kg = C.tid >> 6;
            const float* W = C.in[4] + (size_t)layer * DM * 6144 + col0 + col;
            float a0 = 0.f, a1 = 0.f, a2 = 0.f;
#pragma unroll 32
            for (int k = kg * 128; k < kg * 128 + 128; ++k) { const float w = W[(size_t)k * 6144]; a0 += sv[k] * w; a1 += sv[1024 + k] * w; a2 += sv[2048 + k] * w; }
            red[(kg * 3 + 0) * 64 + col] = a0; red[(kg * 3 + 1) * 64 + col] = a1; red[(kg * 3 + 2) * 64 + col] = a2;
            __syncthreads();
            if (C.tid < 192) { const int w = C.tid >> 6, c2 = C.tid & 63; float s = 0.f;
#pragma unroll
                for (int g = 0; g < 8; ++g) s += red[(g * 3 + w) * 64 + c2];
                MOD[((size_t)layer * 3 + w) * 6144 + col0 + c2] = s + C.in[5][layer * 6144 + col0 + c2]; }
            __syncthreads();
        }
    }
    {
        float* H = (float*)(C.ws + WS_H);
        const size_t n4 = (size_t)NROW * 256;
        for (size_t i = (size_t)C.bid * 512 + C.tid; i < n4; i += (size_t)C.G * 512) {
            const int row = (int)(i >> 8), c4 = (int)(i & 255) * 4;
            f32x4 v;
            if (row < NLAT) {
                v = *(const f32x4*)(C.in[0] + (size_t)row * DM + c4);
                const int t = row & 8191, quarter = c4 >> 8; const float pos = (quarter < 2) ? (float)(t >> 6) : (float)(t & 63);
                float e[4];
#pragma unroll
                for (int j = 0; j < 4; ++j) { const int jj = (c4 & 255) + j; const float fr = exp2f(-(float)jj * (13.287712379549449f / 256.f)); const float a = pos * fr; e[j] = (quarter & 1) ? cosf(a) : sinf(a); }
                v.x += e[0]; v.y += e[1]; v.z += e[2]; v.w += e[3];
            } else v = *(const f32x4*)(C.in[2] + (size_t)(row - NLAT) * DM + c4);
            *(f32x4*)(H + (size_t)row * DM + c4) = v;
        }
    }
}

struct Row16 { float v[16]; };
__device__ __forceinline__ Row16 load_row16(const float* p, int lane) {
    Row16 r; const f32x4 a = *(const f32x4*)(p + 8 * lane), b = *(const f32x4*)(p + 8 * lane + 4), c = *(const f32x4*)(p + 512 + 8 * lane), d = *(const f32x4*)(p + 512 + 8 * lane + 4);
    r.v[0] = a.x; r.v[1] = a.y; r.v[2] = a.z; r.v[3] = a.w; r.v[4] = b.x; r.v[5] = b.y; r.v[6] = b.z; r.v[7] = b.w;
    r.v[8] = c.x; r.v[9] = c.y; r.v[10] = c.z; r.v[11] = c.w; r.v[12] = d.x; r.v[13] = d.y; r.v[14] = d.z; r.v[15] = d.w; return r;
}
__device__ __forceinline__ void store_row16_f32(float* p, int lane, const Row16& r) {
    *(f32x4*)(p + 8 * lane) = (f32x4){r.v[0], r.v[1], r.v[2], r.v[3]}; *(f32x4*)(p + 8 * lane + 4) = (f32x4){r.v[4], r.v[5], r.v[6], r.v[7]};
    *(f32x4*)(p + 512 + 8 * lane) = (f32x4){r.v[8], r.v[9], r.v[10], r.v[11]}; *(f32x4*)(p + 512 + 8 * lane + 4) = (f32x4){r.v[12], r.v[13], r.v[14], r.v[15]};
}
__device__ __forceinline__ void store_row16_bf16(bf16_t* p, int lane, const Row16& r) {
    u32x4 a, b; a.x = pk2(r.v[0], r.v[1]); a.y = pk2(r.v[2], r.v[3]); a.z = pk2(r.v[4], r.v[5]); a.w = pk2(r.v[6], r.v[7]);
    b.x = pk2(r.v[8], r.v[9]); b.y = pk2(r.v[10], r.v[11]); b.z = pk2(r.v[12], r.v[13]); b.w = pk2(r.v[14], r.v[15]);
    *(u32x4*)(p + 8 * lane) = a; *(u32x4*)(p + 512 + 8 * lane) = b;
}
__device__ __forceinline__ Row16 norm_mod_row(const Row16& x, const float* g, const float* shift, const float* scale, int lane) {
    float ss = 0.f;
#pragma unroll
    for (int i = 0; i < 16; ++i) ss += x.v[i] * x.v[i];
    const float rs = rsqrtf(wave_sum(ss) * (1.f / 1024.f) + 1e-6f);
    const Row16 gg = load_row16(g, lane), sh = load_row16(shift, lane), sc = load_row16(scale, lane);
    Row16 o;
#pragma unroll
    for (int i = 0; i < 16; ++i) o.v[i] = (x.v[i] * rs * gg.v[i]) * (1.f + sc.v[i]) + sh.v[i];
    return o;
}
__device__ __forceinline__ int which_of(int row) { return row < 8192 ? 0 : (row < NLAT ? 1 : 2); }
__device__ __forceinline__ void ph_norm(const Ctx& C, int layer, const float* gain, int sidx, int nrows) {
    const float* H = (const float*)(C.ws + WS_H); bf16_t* ACT = (bf16_t*)(C.ws + WS_ACT); const float* MOD = (const float*)(C.ws + WS_MOD);
    for (int row = C.bid * 8 + C.wid; row < nrows; row += C.G * 8) {
        const float* m = MOD + ((size_t)layer * 3 + which_of(row)) * 6144;
        const Row16 x = load_row16(H + (size_t)row * DM, C.lane);
        const Row16 o = norm_mod_row(x, gain, m + sidx * 1024, m + (sidx + 1) * 1024, C.lane);
        store_row16_bf16(ACT + (size_t)row * DM, C.lane, o);
    }
}
struct EpiResid {
    static constexpr bool PERM = false, AFTER_DRAIN = false;
    float* H; const float* modl;
    __device__ __forceinline__ void operator()(const f32x4 (&acc)[2][2][4][2], const pg8::Unit& u, int wr, int wc, int fr, int fq) const {
        const int row0 = u.pm * 256 + wr * 64 + fr, col0 = u.pn * 256 + wc * 32 + 4 * fq;
        const int which = u.pm < 32 ? 0 : (u.pm < 64 ? 1 : 2);
        const float* gate = modl + ((size_t)which * 6 + 2) * 1024;
        f32x4 gv[2][2];
#pragma unroll
        for (int bj = 0; bj < 2; ++bj)
#pragma unroll
            for (int n = 0; n < 2; ++n) gv[bj][n] = *(const f32x4*)(gate + col0 + bj * 128 + n * 16);
#pragma unroll
        for (int ai = 0; ai < 2; ++ai)
#pragma unroll
            for (int m = 0; m < 4; ++m) { float* rowp = H + (size_t)(row0 + ai * 128 + m * 16) * DM + col0;
#pragma unroll
                for (int bj = 0; bj < 2; ++bj)
#pragma unroll
                    for (int n = 0; n < 2; ++n) { f32x4* p = (f32x4*)(rowp + bj * 128 + n * 16); *p = *p + gv[bj][n] * acc[ai][bj][m][n]; } }
    }
};

__device__ __forceinline__ void item_conformer(const Ctx& C, int layer, int gc) {
    const ChunkInfo ci = chunk_info(gc);
    const bf16_t* P = (const bf16_t*)(C.ws + WS_P); bf16_t* YC = (bf16_t*)(C.ws + WS_ACT);
    LAS bf16_t* HG = (LAS bf16_t*)C.lds;
    LAS float* CO = (LAS float*)(C.lds + 49152);
    for (int e = C.tid; e < 94 * 128; e += 512) {
        const int rr = e >> 7, cp = e & 127, grow = ci.row0 - 15 + rr;
        unsigned o = 0u;
        if (grow >= ci.lo && grow < ci.hi) {
            const unsigned v = *(const unsigned*)(P + (size_t)grow * NP + 2 * cp), g = *(const unsigned*)(P + (size_t)grow * NP + 256 + 2 * cp);
            o = pk2(bflo(v) * sigm(bflo(g)), bfhi(v) * sigm(bfhi(g)));
        }
        *(LAS unsigned*)(HG + rr * 256 + 2 * cp) = o;
    }
    __syncthreads();
    {
        const int c = C.tid & 255, half = C.tid >> 8;
        const float* cw = C.in[10] + (size_t)layer * 31 * 256 + c;
        float w[31];
#pragma unroll
        for (int j = 0; j < 31; ++j) w[j] = cw[j * 256];
        const float bias = C.in[11][layer * 256 + c];
        for (int tt = 0; tt < 32; ++tt) {
            const int t = half * 32 + tt; float acc = bias;
#pragma unroll
            for (int j = 0; j < 31; ++j) acc += w[j] * bf2f(HG[(t + j) * 256 + c]);
            CO[t * 256 + c] = acc;
        }
    }
    __syncthreads();
    {
        const float* lg = C.in[12] + layer * 256 + 4 * C.lane; const float* lb = C.in[13] + layer * 256 + 4 * C.lane;
        const f32x4 g4 = *(const f32x4*)lg, b4 = *(const f32x4*)lb;
        for (int i = 0; i < 8; ++i) {
            const int t = C.wid * 8 + i;
            const f32x4 x = *(const LAS f32x4*)(CO + t * 256 + 4 * C.lane);
            const float mean = wave_sum((x.x + x.y) + (x.z + x.w)) * (1.f / 256.f);
            const f32x4 d = x - mean;
            const float var = wave_sum((d.x * d.x + d.y * d.y) + (d.z * d.z + d.w * d.w)) * (1.f / 256.f);
            const float rs = rsqrtf(var + 1e-5f);
            const f32x4 y = d * rs * g4 + b4;
            u32x2 o; o.x = pk2(silu(y.x), silu(y.y)); o.y = pk2(silu(y.z), silu(y.w));
            *(u32x2*)(YC + (size_t)(ci.row0 + t) * DM + 4 * C.lane) = o;
        }
    }
    __syncthreads();
}

__device__ __forceinline__ void item_chunkmlp(const Ctx& C, int layer, int gb) {
    const int row0 = gb * 128;
    const bf16_t* P = (const bf16_t*)(C.ws + WS_P); bf16_t* YC = (bf16_t*)(C.ws + WS_ACT);
    LAS bf16_t* VNT = (LAS bf16_t*)C.lds;
    LAS bf16_t* WS = (LAS bf16_t*)(C.lds + 69632);
    {
        const f32x4 g4 = *(const f32x4*)(C.in[14] + layer * 256 + 4 * C.lane), b4 = *(const f32x4*)(C.in[15] + layer * 256 + 4 * C.lane);
        for (int i = 0; i < 16; ++i) {
            const int j = C.wid * 16 + i;
            const u32x2 raw = *(const u32x2*)(P + (size_t)(row0 + j) * NP + 768 + 4 * C.lane);
            const f32x4 x = {bflo(raw.x), bfhi(raw.x), bflo(raw.y), bfhi(raw.y)};
            const float mean = wave_sum((x.x + x.y) + (x.z + x.w)) * (1.f / 256.f);
            const f32x4 d = x - mean;
            const float var = wave_sum((d.x * d.x + d.y * d.y) + (d.z * d.z + d.w * d.w)) * (1.f / 256.f);
            const f32x4 y = d * rsqrtf(var + 1e-5f) * g4 + b4;
            VNT[(4 * C.lane + 0) * 136 + j] = f2bf(y.x); VNT[(4 * C.lane + 1) * 136 + j] = f2bf(y.y);
            VNT[(4 * C.lane + 2) * 136 + j] = f2bf(y.z); VNT[(4 * C.lane + 3) * 136 + j] = f2bf(y.w);
        }
    }
    for (int h = 0; h < 4; ++h) {
        const float* ws = C.in[16] + ((size_t)layer * 4 + h) * 128 * 128;
        for (int e = C.tid; e < 4096; e += 512) { const int i = e >> 5, j4 = (e & 31) * 4; const f32x4 w = *(const f32x4*)(ws + i * 128 + j4);
            u32x2 o; o.x = pk2(w.x, w.y); o.y = pk2(w.z, w.w); *(LAS u32x2*)(WS + i * 136 + j4) = o; }
        __syncthreads();
        const float* bs = C.in[17] + ((size_t)layer * 4 + h) * 128;
        blk_mma<8, 4, 4>(WS, 136, VNT + h * 64 * 136, 136, C.wid, C.lane, [=](int r0, int col, const f32x4& acc) {
#pragma unroll
            for (int jj = 0; jj < 4; ++jj) { const int i = r0 + jj; const size_t row = (size_t)(row0 + i);
                const float u = bf2f(P[row * NP + 512 + h * 64 + col]);
                YC[row * DM + 256 + h * 64 + col] = f2bf((acc[jj] + bs[i]) * u); }
        });
        __syncthreads();
    }
}

__device__ __forceinline__ void item_mamba_local(const Ctx& C, int layer, int gc) {
    const ChunkInfo ci = chunk_info(gc);
    const bf16_t* P = (const bf16_t*)(C.ws + WS_P);
    bf16_t* MSTb = (bf16_t*)(C.ws + WS_MST); float* MCD = (float*)(C.ws + WS_MCD);
    LAS float* DA = (LAS float*)C.lds;
    LAS float* DT = (LAS float*)(C.lds + 2048);
    LAS float* FAC = (LAS float*)(C.lds + 4096);
    LAS bf16_t* XDT = (LAS bf16_t*)(C.lds + 8192);
    LAS bf16_t* BTT = (LAS bf16_t*)(C.lds + 8192 + 73728);
    {
        const int s = C.lane, dh = C.wid, d = dh >> 2, h = dh & 3;
        const float raw = bf2f(P[(size_t)(ci.row0 + s) * NP + OFF_C + 1024 + dh]);
        const float dt = softplus(raw + C.in[20][layer * 8 + dh]);
        const float da = dt * (-expf(C.in[21][layer * 8 + dh]));
        const float incl = wave_incl_scan(da, s), total = __shfl(incl, 63);
        DT[dh * 64 + s] = dt; DA[dh * 64 + s] = da;
        FAC[dh * 64 + s] = d ? fexp(incl - da) : fexp(total - incl);
        if (s == 0) MCD[slot_of(ci.b, h, d, cpos_of(ci, d))] = expf(total);
    }
    __syncthreads();
    {
        const int cp = C.tid & 255, half = C.tid >> 8, c0 = 2 * cp;
        const float* cw = C.in[18] + (size_t)layer * 5 * 768 + c0; const float* cb = C.in[19] + layer * 768 + c0;
        float w0[5], w1[5];
#pragma unroll
        for (int j = 0; j < 5; ++j) { w0[j] = cw[j * 768]; w1[j] = cw[j * 768 + 1]; }
        const float b0 = cb[0], b1 = cb[1];
        const int s0 = half * 32;
        unsigned win[5];
#pragma unroll
        for (int j = 0; j < 4; ++j) { const int row = ci.row0 + s0 - 2 + j; win[j + 1] = (row >= ci.lo && row < ci.hi) ? *(const unsigned*)(P + (size_t)row * NP + OFF_C + 256 + c0) : 0u; }
        for (int tt = 0; tt < 32; ++tt) {
            const int s = s0 + tt;
#pragma unroll
            for (int j = 0; j < 4; ++j) win[j] = win[j + 1];
            { const int row = ci.row0 + s + 2; win[4] = (row >= ci.lo && row < ci.hi) ? *(const unsigned*)(P + (size_t)row * NP + OFF_C + 256 + c0) : 0u; }
            float a0 = b0, a1 = b1;
#pragma unroll
            for (int j = 0; j < 5; ++j) { a0 += w0[j] * bflo(win[j]); a1 += w1[j] * bfhi(win[j]); }
            a0 = silu(a0); a1 = silu(a1);
            if (c0 < 256) { const int h = c0 >> 6;
#pragma unroll
                for (int d = 0; d < 2; ++d) { const float f = DT[(d * 4 + h) * 64 + s] * FAC[(d * 4 + h) * 64 + s];
                    XDT[(d * 256 + c0) * 72 + s] = f2bf(a0 * f); XDT[(d * 256 + c0 + 1) * 72 + s] = f2bf(a1 * f); }
            } else { const int q = c0 - 256; BTT[q * 72 + s] = f2bf(a0); BTT[(q + 1) * 72 + s] = f2bf(a1); }
        }
    }
    __syncthreads();
    for (int hd = 0; hd < 8; ++hd) {
        const int d = hd >> 2, h = hd & 3;
        bf16_t* dst = MSTb + (size_t)slot_of(ci.b, h, d, cpos_of(ci, d)) * 8192;
        blk_mma<8, 4, 2>(BTT + (h >> 1) * 128 * 72, 72, XDT + (d * 256 + h * 64) * 72, 72, C.wid, C.lane, [=](int r0, int col, const f32x4& acc) {
            u32x2 o; o.x = pk2(acc[0], acc[1]); o.y = pk2(acc[2], acc[3]); *(u32x2*)(dst + col * 128 + r0) = o;
        });
    }
    __syncthreads();
}


#ifndef MK_DIAG2
#define MK_DIAG2 0
#endif
#if MK_DIAG2
#define DBGF(stage, cond) do { if (cond) atomicOr((unsigned*)(C.ws + 32768) + (stage), 1u); } while (0)
#define DBGL(stage, cond) do { if (cond) atomicOr(dbgflags + (stage), 1u); } while (0)
#else
#define DBGF(stage, cond) do {} while (0)
#define DBGL(stage, cond) do {} while (0)
#endif
__device__ __forceinline__ bool badv(float x, float lim) { return !(fabsf(x) < lim); }
__device__ __forceinline__ void tri_inverse(const LAS float* ABf, LAS float* Tf, LAS float* Rt, LAS bf16_t* TT, int tid, int wid, int lane) {
    if (wid == 0) {
        const int bi = lane >> 4, j = lane & 15; const LAS float* Ab = ABf + (16 * bi) * 68 + 16 * bi;
        float col[16];
#pragma unroll
        for (int r = 0; r < 16; ++r) { float acc = (r == j) ? 1.f : 0.f;
#pragma unroll
            for (int s = 0; s < r; ++s) acc -= Ab[r * 68 + s] * col[s];
            col[r] = acc; }
#pragma unroll
        for (int r = 0; r < 16; ++r) Tf[(16 * bi + r) * 68 + 16 * bi + j] = col[r];
    } else {
        for (int e = tid - 64; e < 64 * 64; e += 448) { const int t = e >> 6, s2 = e & 63; if ((s2 >> 4) > (t >> 4)) Tf[t * 68 + s2] = 0.f; }
    }
    __syncthreads();
    if (wid < 3) {
        const int tn = wid, fr = lane & 15, fq = lane >> 4;
        LAS float* Rw = Rt + wid * 320;
        for (int i = tn + 1; i < 4; ++i) {
            f32x4 acc = {0.f, 0.f, 0.f, 0.f};
            for (int k = 16 * tn; k < 16 * i; k += 4) acc = __builtin_amdgcn_mfma_f32_16x16x4f32(ABf[(16 * i + fr) * 68 + k + fq], Tf[(k + fq) * 68 + 16 * tn + fr], acc, 0, 0, 0);
#pragma unroll
            for (int j = 0; j < 4; ++j) Rw[(fq * 4 + j) * 20 + fr] = -acc[j];
            asm volatile("s_waitcnt lgkmcnt(0)" ::: "memory");
            f32x4 t = {0.f, 0.f, 0.f, 0.f};
#pragma unroll
            for (int k = 0; k < 16; k += 4) t = __builtin_amdgcn_mfma_f32_16x16x4f32(Tf[(16 * i + fr) * 68 + 16 * i + k + fq], Rw[(k + fq) * 20 + fr], t, 0, 0, 0);
#pragma unroll
            for (int j = 0; j < 4; ++j) Tf[(16 * i + fq * 4 + j) * 68 + 16 * tn + fr] = t[j];
            asm volatile("s_waitcnt lgkmcnt(0)" ::: "memory");
        }
    }
    __syncthreads();
    for (int e = tid; e < 4096; e += 512) { const int t = e >> 6, s2 = e & 63; TT[t * 72 + s2] = f2bf(Tf[t * 68 + s2]); }
}
constexpr int D1_LW = 0, D1_CS = 17408, D1_AA = 34816, D1_RB = 52224, D1_KB = 61440, D1_VB = 70656, D1_TW = 79872, D1_AD = 89088, D1_W2T = 98304, D1_A2T = 107520;
constexpr int D1_Y = 82944;
constexpr int D1_ABF = 0, D1_AK = 17408, D1_ARK = 26624, D1_ARB = 35840, D1_TT = 45056, D1_W1T = 54272, D1_AKVT = 63488, D1_W2TT = 72704;
constexpr int D1_GL = 156672;
__device__ __forceinline__ void item_rwkv_local(const Ctx& C0_, int layer, int it) {
    Ctx C = C0_; { int t_ = C0_.tid; asm volatile("" : "+v"(t_)); C.tid = t_; C.lane = t_ & 63; C.wid = __builtin_amdgcn_readfirstlane(t_ >> 6); }
#define D1_RELAUNDER() do { int t_ = C.tid; asm volatile("" : "+v"(t_)); C.tid = t_; C.lane = t_ & 63; C.wid = __builtin_amdgcn_readfirstlane(t_ >> 6); } while (0)
    const int gc = it >> 3, hd = it & 7, h = hd & 3, d = hd >> 2;
    const ChunkInfo ci = chunk_info(gc);
    const int slot = slot_of(ci.b, h, d, cpos_of(ci, d));
    const bf16_t* P = (const bf16_t*)(C.ws + WS_P);
    const float* mup = C.in[24] + layer * 1152; const float* mun = C.in[25] + layer * 1152;
    lds_t L = C.lds;
    LAS float* LW = (LAS float*)(L + D1_LW); LAS float* CS = (LAS float*)(L + D1_CS); LAS float* AA = (LAS float*)(L + D1_AA); LAS float* GL = (LAS float*)(L + D1_GL);
    LAS bf16_t* Rb = (LAS bf16_t*)(L + D1_RB); LAS bf16_t* Kb = (LAS bf16_t*)(L + D1_KB); LAS bf16_t* Vb = (LAS bf16_t*)(L + D1_VB);
    LAS bf16_t* TW = (LAS bf16_t*)(L + D1_TW); LAS bf16_t* AD = (LAS bf16_t*)(L + D1_AD); LAS bf16_t* W2T = (LAS bf16_t*)(L + D1_W2T); LAS bf16_t* A2T = (LAS bf16_t*)(L + D1_A2T);
    LAS bf16_t* KT = (LAS bf16_t*)(L + D1_Y); LAS bf16_t* KTt = KT + 4608; LAS bf16_t* KD = KT + 2 * 4608; LAS bf16_t* KDt = KT + 3 * 4608;
    LAS bf16_t* BT = KT + 4 * 4608; LAS bf16_t* BTt = KT + 5 * 4608; LAS bf16_t* RT = KT + 6 * 4608; LAS bf16_t* Vt = KT + 7 * 4608;
    LAS float* ABf = (LAS float*)(L + D1_ABF); LAS bf16_t* AK = (LAS bf16_t*)(L + D1_AK); LAS bf16_t* ARK = (LAS bf16_t*)(L + D1_ARK); LAS bf16_t* ARB = (LAS bf16_t*)(L + D1_ARB);
    LAS bf16_t* TT = (LAS bf16_t*)(L + D1_TT); LAS bf16_t* W1t = (LAS bf16_t*)(L + D1_W1T); LAS bf16_t* AKVt = (LAS bf16_t*)(L + D1_AKVT); LAS bf16_t* W2t = (LAS bf16_t*)(L + D1_W2TT);

    if (C.tid < 480) {
        const int q = C.tid % 160, seg = C.tid / 160, grp = q >> 5, c = (q & 31) * 2;
        const int j = (grp == 0 ? h * 64 : grp == 1 ? 256 + h * 64 : grp == 2 ? 512 + h * 64 : grp == 3 ? 768 + d * 64 : 896 + d * 64) + c;
        const int t0 = seg * 22, nt = seg == 2 ? 20 : 22;
        const bf16_t* pp = P + (size_t)(ci.row0 + t0) * NP + OFF_D + j;
        const float mp0 = mup[j], mp1 = mup[j + 1], mn0 = mun[j], mn1 = mun[j + 1];
        unsigned w[24];
#pragma unroll
        for (int i = 0; i < 24; ++i) { const int row = ci.row0 + t0 - 1 + i; w[i] = (i < nt + 2 && row >= ci.lo && row < ci.hi) ? *(const unsigned*)(pp + (ptrdiff_t)(i - 1) * NP) : 0u; }
        LAS bf16_t* dst = (grp == 0 ? Rb : grp == 1 ? Kb : grp == 2 ? Vb : grp == 3 ? TW : AD);
#pragma unroll
        for (int i = 0; i < 22; ++i) if (i < nt) {
            const float x0 = bflo(w[i + 1]), x1 = bfhi(w[i + 1]);
            const float v0 = x0 + mp0 * (bflo(w[i]) - x0) + mn0 * (bflo(w[i + 2]) - x0);
            const float v1 = x1 + mp1 * (bfhi(w[i]) - x1) + mn1 * (bfhi(w[i + 2]) - x1);
            DBGF(1, badv(v0, 1e4f) || badv(v1, 1e4f));
            const unsigned o = (grp == 3) ? pk2(ftanh(v0), ftanh(v1)) : pk2(v0, v1);
            const int tl = t0 + i, l = d ? 63 - tl : tl;
            *(LAS unsigned*)(dst + l * 72 + c) = o;
        }
    }
    {
        const float* w2 = C.in[27] + ((size_t)layer * 2 + d) * 64 * 256 + h * 64; const float* a2 = C.in[29] + ((size_t)layer * 2 + d) * 64 * 256 + h * 64;
        for (int e = C.tid; e < 4096; e += 512) { const int r = e >> 6, c = e & 63; W2T[c * 72 + r] = f2bf(w2[r * 256 + c]); A2T[c * 72 + r] = f2bf(a2[r * 256 + c]); }
    }
    __syncthreads();
    D1_RELAUNDER();
    {
        unsigned* dbgflags = (unsigned*)(C.ws + 32768); (void)dbgflags;
        const float* w0 = C.in[26] + ((size_t)layer * 2 + d) * 256 + h * 64; const float* a0 = C.in[28] + ((size_t)layer * 2 + d) * 256 + h * 64;
        blk_mma<4, 4, 2>(TW, 72, W2T, 72, C.wid, C.lane, [=](int r0, int col, const f32x4& acc) {
#pragma unroll
            for (int jj = 0; jj < 4; ++jj) { const float w = w0[col] + acc[jj]; DBGL(2, badv(w, 1e4f)); LW[(r0 + jj) * 68 + col] = -fexp(-softplus(-w) - 0.5f); }
        });
        blk_mma<4, 4, 2>(AD, 72, A2T, 72, C.wid, C.lane, [=](int r0, int col, const f32x4& acc) {
#pragma unroll
            for (int jj = 0; jj < 4; ++jj) { DBGL(2, badv(acc[jj], 1e4f)); AA[(r0 + jj) * 68 + col] = sigm(a0[col] + acc[jj]); }
        });
    }
    __syncthreads();
    {
#pragma unroll
        for (int i = 0; i < 8; ++i) { const int c = C.wid * 8 + i; const float incl = wave_incl_scan(LW[C.lane * 68 + c], C.lane); CS[C.lane * 68 + c] = incl; if (C.lane == 63) GL[c] = fexp(incl); }
    }
    __syncthreads();
    D1_RELAUNDER();
    {
        const int l = C.tid >> 3, sub = C.tid & 7;
        const float* kkw = C.in[31] + layer * 256 + h * 64; const float* kaw = C.in[32] + layer * 256 + h * 64; const float* rkw = C.in[33] + layer * 256 + h * 64;
        float kk[8], kdv[8], aa[8], rr[8], vv[8]; float ss = 0.f, bon = 0.f;
#pragma unroll
        for (int i = 0; i < 8; ++i) { const int c = sub * 8 + i; const float k = bf2f(Kb[l * 72 + c]); rr[i] = bf2f(Rb[l * 72 + c]); vv[i] = bf2f(Vb[l * 72 + c]); aa[i] = AA[l * 68 + c];
            kk[i] = k * kkw[c]; ss += kk[i] * kk[i]; kdv[i] = k * (1.f + (aa[i] - 1.f) * kaw[c]); bon += rr[i] * kdv[i] * rkw[c]; }
        ss += __shfl_xor(ss, 1); ss += __shfl_xor(ss, 2); ss += __shfl_xor(ss, 4);
        bon += __shfl_xor(bon, 1); bon += __shfl_xor(bon, 2); bon += __shfl_xor(bon, 4);
        const float inv = rsqrtf(ss + 1e-12f);
        if (sub == 0) ((float*)(C.ws + WS_BON))[(size_t)(ci.row0 + (d ? 63 - l : l)) * 8 + h * 2 + d] = bon;
        unsigned short kt[8], kd[8], bt[8], rt[8];
#pragma unroll
        for (int i = 0; i < 8; ++i) { const int c = sub * 8 + i; const float cs = CS[l * 68 + c], lw = LW[l * 68 + c];
            const float ge = fexp(cs - lw), gi = fexp(cs), gn = fexp(-cs); const float kkn = kk[i] * inv;
            DBGF(3, badv(cs, 50.f) || cs > 0.f || badv(lw, 1.f)); DBGF(4, badv(kkn * ge, 10.f) || badv(rr[i] * gi, 1e4f) || badv(vv[i], 1e4f)); DBGF(5, badv(kdv[i] * gn, 1e25f) || badv(kkn * aa[i] * gn, 1e25f));
            kt[i] = f2bf(kkn * ge); kd[i] = f2bf(kdv[i] * gn); bt[i] = f2bf(kkn * aa[i] * gn); rt[i] = f2bf(rr[i] * gi);
            KTt[c * 72 + l] = kt[i]; KDt[c * 72 + l] = kd[i]; BTt[c * 72 + l] = bt[i]; Vt[c * 72 + l] = f2bf(vv[i]); }
#define D1_PACK8(a) (u32x4){(unsigned)a[0] | ((unsigned)a[1] << 16), (unsigned)a[2] | ((unsigned)a[3] << 16), (unsigned)a[4] | ((unsigned)a[5] << 16), (unsigned)a[6] | ((unsigned)a[7] << 16)}
        *(LAS u32x4*)(KT + l * 72 + sub * 8) = D1_PACK8(kt); *(LAS u32x4*)(KD + l * 72 + sub * 8) = D1_PACK8(kd);
        *(LAS u32x4*)(BT + l * 72 + sub * 8) = D1_PACK8(bt); *(LAS u32x4*)(RT + l * 72 + sub * 8) = D1_PACK8(rt);
#undef D1_PACK8
    }
    __syncthreads();
    D1_RELAUNDER();
    unsigned* dbgflags = (unsigned*)(C.ws + 32768); (void)dbgflags;
    blk_mma2<4, 4, 2>(BT, KT, KD, KT, 72, C.wid, C.lane, [=](int r0, int col, const f32x4& ab, const f32x4& ak) {
        f32x4 a; float k[4];
#pragma unroll
        for (int jj = 0; jj < 4; ++jj) { const bool lo = r0 + jj < col; DBGL(6, lo && (badv(ab[jj], 1e3f) || badv(ak[jj], 1e4f))); a[jj] = lo ? ab[jj] : 0.f; k[jj] = lo ? ak[jj] : 0.f; }
        *(LAS f32x4*)(ABf + col * 68 + r0) = a;
        u32x2 o; o.x = pk2(k[0], k[1]); o.y = pk2(k[2], k[3]); *(LAS u32x2*)(AK + col * 72 + r0) = o;
    });
    blk_mma2<4, 4, 2>(KD, RT, BT, RT, 72, C.wid, C.lane, [=](int r0, int col, const f32x4& rk, const f32x4& rb) {
        float a[4], b[4];
#pragma unroll
        for (int jj = 0; jj < 4; ++jj) { const bool le = r0 + jj <= col; DBGL(7, le && (badv(rk[jj], 1e5f) || badv(rb[jj], 1e5f))); a[jj] = le ? rk[jj] : 0.f; b[jj] = le ? rb[jj] : 0.f; }
        u32x2 oa, ob; oa.x = pk2(a[0], a[1]); oa.y = pk2(a[2], a[3]); ob.x = pk2(b[0], b[1]); ob.y = pk2(b[2], b[3]);
        *(LAS u32x2*)(ARK + col * 72 + r0) = oa; *(LAS u32x2*)(ARB + col * 72 + r0) = ob;
    });
    __syncthreads();
    tri_inverse(ABf, (LAS float*)(L + 54272), (LAS float*)(L + 71680), TT, C.tid, C.wid, C.lane);
    __syncthreads();
#if MK_DIAG2
    for (int e = C.tid; e < 4096; e += 512) DBGF(8, badv(bf2f(TT[(e >> 6) * 72 + (e & 63)]), 1e3f));
#endif
    D1_RELAUNDER();
    blk_mma2<4, 4, 2>(TT, KTt, AK, Vt, 72, C.wid, C.lane, [=](int r0, int col, const f32x4& w1, const f32x4& akv) {
        DBGL(9, badv(w1[0], 1e3f) || badv(w1[1], 1e3f) || badv(w1[2], 1e3f) || badv(w1[3], 1e3f)); DBGL(10, badv(akv[0], 1e5f) || badv(akv[1], 1e5f) || badv(akv[2], 1e5f) || badv(akv[3], 1e5f));
        u32x2 a, b; a.x = pk2(w1[0], w1[1]); a.y = pk2(w1[2], w1[3]); b.x = pk2(akv[0], akv[1]); b.y = pk2(akv[2], akv[3]);
        *(LAS u32x2*)(W1t + col * 72 + r0) = a; *(LAS u32x2*)(AKVt + col * 72 + r0) = b;
    });
    __syncthreads();
    blk_mma<4, 4, 2>(TT, 72, AKVt, 72, C.wid, C.lane, [=](int r0, int col, const f32x4& w2) {
        DBGL(11, badv(w2[0], 1e5f) || badv(w2[1], 1e5f) || badv(w2[2], 1e5f) || badv(w2[3], 1e5f));
        u32x2 a; a.x = pk2(w2[0], w2[1]); a.y = pk2(w2[2], w2[3]); *(LAS u32x2*)(W2t + col * 72 + r0) = a;
    });
    __syncthreads();
    D1_RELAUNDER();
    {
        bf16_t* Gg = (bf16_t*)(C.ws + WS_RG) + (size_t)slot * 4096; float* Jg = (float*)(C.ws + WS_RJ) + (size_t)slot * 4096;
        bf16_t* Ryg = (bf16_t*)(C.ws + WS_RY) + (size_t)slot * 4096; bf16_t* Ylg = (bf16_t*)(C.ws + WS_RL) + (size_t)slot * 4096;
        blk_mma2<4, 4, 2>(W1t, BTt, W1t, ARB, 72, C.wid, C.lane, [=](int r0, int col, const f32x4& gp, const f32x4& rbw) {
            const float gl = GL[col]; float g[4], ry[4];
            const u32x2 rt = *(const LAS u32x2*)(RT + col * 72 + r0);
            const float rtv[4] = {bflo(rt.x), bfhi(rt.x), bflo(rt.y), bfhi(rt.y)};
#pragma unroll
            for (int jj = 0; jj < 4; ++jj) { g[jj] = gl * ((col == r0 + jj ? 1.f : 0.f) - gp[jj]); ry[jj] = rtv[jj] - rbw[jj]; }
            u32x2 og, oy; og.x = pk2(g[0], g[1]); og.y = pk2(g[2], g[3]); oy.x = pk2(ry[0], ry[1]); oy.y = pk2(ry[2], ry[3]);
            *(u32x2*)(Gg + col * 64 + r0) = og;
            *(u32x2*)(Ryg + col * 64 + r0) = oy;
        });
        blk_mma2<4, 4, 2>(KDt, Vt, BTt, W2t, 72, C.wid, C.lane, [=](int r0, int col, const f32x4& kv, const f32x4& bw) {
            f32x4 o;
#pragma unroll
            for (int jj = 0; jj < 4; ++jj) { o[jj] = GL[r0 + jj] * (kv[jj] - bw[jj]); DBGL(12, badv(GL[r0 + jj] * kv[jj], 1e5f)); DBGL(13, badv(GL[r0 + jj] * bw[jj], 1e5f)); DBGL(14, badv(o[jj], 1e5f)); }
            *(f32x4*)(Jg + col * 64 + r0) = o;
        });
        blk_mma2<4, 4, 2>(ARK, Vt, ARB, W2t, 72, C.wid, C.lane, [=](int r0, int col, const f32x4& a, const f32x4& b) {
            u32x2 o; o.x = pk2(a[0] - b[0], a[1] - b[1]); o.y = pk2(a[2] - b[2], a[3] - b[3]);
            *(u32x2*)(Ylg + col * 64 + r0) = o;
        });
    }
    __syncthreads();
}

typedef float f32x2p __attribute__((ext_vector_type(2)));
__device__ __forceinline__ void ph_scan(const Ctx& C, int nrep = 1) {
    if (C.bid < 16) {
      for (int rep = 0; rep < nrep; ++rep) {
        if (C.wid < 4) {
            const int chain = C.bid, fr = C.lane & 15, fq = C.lane >> 4, w = C.wid;
            LAS bf16_t* HT = (LAS bf16_t*)C.lds + w * 16 * 72;
            const bf16_t* Gg = (const bf16_t*)(C.ws + WS_RG) + (size_t)chain * NCH * 4096 + fr * 64 + fq * 8;
            const float* Jg = (const float*)(C.ws + WS_RJ) + (size_t)chain * NCH * 4096 + (w * 16 + fr) * 64 + fq * 4;
            bf16_t* Hg = (bf16_t*)(C.ws + WS_RH) + (size_t)chain * NCH * 4096 + (w * 16 + fr) * 64 + fq * 4;
            f32x4 acc[4];
#pragma unroll
            for (int tm = 0; tm < 4; ++tm) acc[tm] = (f32x4){0.f, 0.f, 0.f, 0.f};
            bf16x8 gn[4][2]; f32x4 jn[4];
#pragma unroll
            for (int tm = 0; tm < 4; ++tm) { gn[tm][0] = *(const bf16x8*)(Gg + tm * 1024); gn[tm][1] = *(const bf16x8*)(Gg + tm * 1024 + 32); jn[tm] = *(const f32x4*)(Jg + tm * 16); }
            for (int cpos = 0; cpos < NCH; ++cpos) {
                bf16x8 g[4][2]; f32x4 jv[4];
#pragma unroll
                for (int tm = 0; tm < 4; ++tm) { g[tm][0] = gn[tm][0]; g[tm][1] = gn[tm][1]; jv[tm] = jn[tm]; }
                if (cpos + 1 < NCH) { const bf16_t* gq = Gg + (size_t)(cpos + 1) * 4096; const float* jq = Jg + (size_t)(cpos + 1) * 4096;
#pragma unroll
                    for (int tm = 0; tm < 4; ++tm) { gn[tm][0] = *(const bf16x8*)(gq + tm * 1024); gn[tm][1] = *(const bf16x8*)(gq + tm * 1024 + 32); jn[tm] = *(const f32x4*)(jq + tm * 16); } }
#pragma unroll
                for (int tm = 0; tm < 4; ++tm) { u32x2 o; o.x = pk2(acc[tm][0], acc[tm][1]); o.y = pk2(acc[tm][2], acc[tm][3]);
                    *(LAS u32x2*)(HT + fr * 72 + tm * 16 + fq * 4) = o;
                    *(u32x2*)(Hg + (size_t)cpos * 4096 + tm * 16) = o; }
                asm volatile("s_waitcnt lgkmcnt(0)" ::: "memory");
                const bf16x8 b0 = *(const LAS bf16x8*)(HT + fr * 72 + fq * 8), b1 = *(const LAS bf16x8*)(HT + fr * 72 + 32 + fq * 8);
#pragma unroll
                for (int tm = 0; tm < 4; ++tm) { f32x4 a = jv[tm];
                    a = __builtin_amdgcn_mfma_f32_16x16x32_bf16(g[tm][0], b0, a, 0, 0, 0);
                    a = __builtin_amdgcn_mfma_f32_16x16x32_bf16(g[tm][1], b1, a, 0, 0, 0);
                    acc[tm] = a; }
                asm volatile("" ::: "memory");
            }
        }
      }
    } else {
        unsigned* MST = (unsigned*)(C.ws + WS_MST); const float* MCD = (const float*)(C.ws + WS_MCD);
        const int nthr = (C.G - 16) * 512;
        for (int e = (C.bid - 16) * 512 + C.tid; e < 16 * 4096; e += nthr) {
            const int chain = e >> 12, el = e & 4095; float r0 = 0.f, r1 = 0.f;
            unsigned* p = MST + (size_t)chain * NCH * 4096 + el; const float* cd = MCD + chain * NCH;
#pragma unroll 22
            for (int cpos = 0; cpos < NCH; ++cpos) { const unsigned tmp = p[(size_t)cpos * 4096]; p[(size_t)cpos * 4096] = pk2(r0, r1); const float c = cd[cpos]; r0 = r0 * c + bflo(tmp); r1 = r1 * c + bfhi(tmp); }
        }
    }
}

__device__ __forceinline__ void item_mamba_out(const Ctx& C, int layer, int gc) {
    const ChunkInfo ci = chunk_info(gc);
    const bf16_t* P = (const bf16_t*)(C.ws + WS_P); bf16_t* YC = (bf16_t*)(C.ws + WS_ACT); const bf16_t* MST = (const bf16_t*)(C.ws + WS_MST);
    lds_t L = C.lds;
    LAS float* DT = (LAS float*)L;
    LAS float* DA = (LAS float*)(L + 2048);
    LAS float* CSI = (LAS float*)(L + 4096);
    LAS float* SSQ = (LAS float*)(L + 6144);
    LAS bf16_t* CG = (LAS bf16_t*)(L + 10240);
    LAS bf16_t* BG = (LAS bf16_t*)(L + 27648);
    LAS bf16_t* XT = (LAS bf16_t*)(L + 45056);
    LAS float* CBm = (LAS float*)(L + 63488);
    LAS bf16_t* MP = (LAS bf16_t*)(L + 80896);
    LAS bf16_t* S0 = (LAS bf16_t*)(L + 90112);
    LAS bf16_t* YPRE = (LAS bf16_t*)(L + 107520);
    const int fr = C.lane & 15, fq = C.lane >> 4;
    {
        const int s = C.lane, dh = C.wid;
        const float raw = bf2f(P[(size_t)(ci.row0 + s) * NP + OFF_C + 1024 + dh]);
        const float dt = softplus(raw + C.in[20][layer * 8 + dh]);
        const float da = dt * (-expf(C.in[21][layer * 8 + dh]));
        const float incl = wave_incl_scan(da, s), total = __shfl(incl, 63);
        DT[dh * 64 + s] = dt; DA[dh * 64 + s] = da;
        CSI[dh * 64 + s] = (dh < 4) ? incl : (total - incl + da);
    }
    for (int g = 0; g < 2; ++g) {
        __syncthreads();
        {
            const int cp = C.tid & 255, half = C.tid >> 8;
            if (cp < 192) {
                const int kind = cp >> 6, cl = (cp & 63) * 2, c0 = kind * 256 + g * 128 + cl;
                const float* cw = C.in[18] + (size_t)layer * 5 * 768 + c0; const float* cb = C.in[19] + layer * 768 + c0;
                float w0[5], w1[5];
#pragma unroll
                for (int j = 0; j < 5; ++j) { w0[j] = cw[j * 768]; w1[j] = cw[j * 768 + 1]; }
                const float b0 = cb[0], b1 = cb[1];
                const int s0 = half * 32;
                unsigned win[5];
#pragma unroll
                for (int j = 0; j < 4; ++j) { const int row = ci.row0 + s0 - 2 + j; win[j + 1] = (row >= ci.lo && row < ci.hi) ? *(const unsigned*)(P + (size_t)row * NP + OFF_C + 256 + c0) : 0u; }
                for (int tt = 0; tt < 32; ++tt) {
                    const int s = s0 + tt;
#pragma unroll
                    for (int j = 0; j < 4; ++j) win[j] = win[j + 1];
                    { const int row = ci.row0 + s + 2; win[4] = (row >= ci.lo && row < ci.hi) ? *(const unsigned*)(P + (size_t)row * NP + OFF_C + 256 + c0) : 0u; }
                    float a0 = b0, a1 = b1;
#pragma unroll
                    for (int j = 0; j < 5; ++j) { a0 += w0[j] * bflo(win[j]); a1 += w1[j] * bfhi(win[j]); }
                    const unsigned short o0 = f2bf(silu(a0)), o1 = f2bf(silu(a1));
                    if (kind == 0) { XT[cl * 72 + s] = o0; XT[(cl + 1) * 72 + s] = o1; }
                    else if (kind == 1) { *(LAS unsigned*)(BG + s * 136 + cl) = (unsigned)o0 | ((unsigned)o1 << 16); }
                    else { *(LAS unsigned*)(CG + s * 136 + cl) = (unsigned)o0 | ((unsigned)o1 << 16); }
                }
            }
        }
        __syncthreads();
        blk_mma<4, 4, 4>(CG, 136, BG, 136, C.wid, C.lane, [=](int r0, int col, const f32x4& acc) {
#pragma unroll
            for (int jj = 0; jj < 4; ++jj) CBm[(r0 + jj) * 68 + col] = acc[jj];
        });
        u32x4 s0r[2];
        { const bf16_t* src = MST + (size_t)slot_of(ci.b, 2 * g, 0, cpos_of(ci, 0)) * 8192;
#pragma unroll
          for (int k = 0; k < 2; ++k) { const int e = C.tid + 512 * k; s0r[k] = *(const u32x4*)(src + (e >> 4) * 128 + (e & 15) * 8); } }
        for (int hh = 0; hh < 2; ++hh) {
            const int h = 2 * g + hh;
            f32x4 yacc[2] = {{0.f, 0.f, 0.f, 0.f}, {0.f, 0.f, 0.f, 0.f}};
            for (int d = 0; d < 2; ++d) {
                const int dh = d * 4 + h;
                __syncthreads();
                for (int e = C.tid; e < 4096; e += 512) { const int l = e >> 6, s = e & 63; const bool ok = d ? (s >= l) : (s <= l);
                    MP[l * 72 + s] = ok ? f2bf(CBm[l * 68 + s] * fexp(CSI[dh * 64 + l] - CSI[dh * 64 + s]) * DT[dh * 64 + s]) : (unsigned short)0; }
#pragma unroll
                for (int k = 0; k < 2; ++k) { const int e = C.tid + 512 * k; *(LAS u32x4*)(S0 + (e >> 4) * 136 + (e & 15) * 8) = s0r[k]; }
                if (!(hh == 1 && d == 1)) { const int nh = d ? h + 1 : h, nd = d ^ 1; const bf16_t* src = MST + (size_t)slot_of(ci.b, nh, nd, cpos_of(ci, nd)) * 8192;
#pragma unroll
                    for (int k = 0; k < 2; ++k) { const int e = C.tid + 512 * k; s0r[k] = *(const u32x4*)(src + (e >> 4) * 128 + (e & 15) * 8); } }
                __syncthreads();
#pragma unroll
                for (int i = 0; i < 2; ++i) { const int tt = C.wid + 8 * i, tm = tt >> 2, tn = tt & 3;
                    f32x4 a1 = {0.f, 0.f, 0.f, 0.f}, a2 = {0.f, 0.f, 0.f, 0.f};
#pragma unroll
                    for (int ks = 0; ks < 2; ++ks) a1 = __builtin_amdgcn_mfma_f32_16x16x32_bf16(*(const LAS bf16x8*)(MP + (tm * 16 + fr) * 72 + ks * 32 + fq * 8),
                                                                                                 *(const LAS bf16x8*)(XT + (hh * 64 + tn * 16 + fr) * 72 + ks * 32 + fq * 8), a1, 0, 0, 0);
#pragma unroll
                    for (int ks = 0; ks < 4; ++ks) a2 = __builtin_amdgcn_mfma_f32_16x16x32_bf16(*(const LAS bf16x8*)(CG + (tm * 16 + fr) * 136 + ks * 32 + fq * 8),
                                                                                                 *(const LAS bf16x8*)(S0 + (tn * 16 + fr) * 136 + ks * 32 + fq * 8), a2, 0, 0, 0);
#pragma unroll
                    for (int j = 0; j < 4; ++j) yacc[i][j] += a1[j] + a2[j] * fexp(CSI[dh * 64 + tm * 16 + fq * 4 + j]);
                }
            }
            const float dsk = C.in[22][layer * 4 + h];
#pragma unroll
            for (int i = 0; i < 2; ++i) { const int tt = C.wid + 8 * i, tm = tt >> 2, tn = tt & 3;
#pragma unroll
                for (int j = 0; j < 4; ++j) { const int l = tm * 16 + fq * 4 + j, p = tn * 16 + fr, c = h * 64 + p;
                    const float xs = bf2f(XT[(hh * 64 + p) * 72 + l]);
                    const float z = bf2f(P[(size_t)(ci.row0 + l) * NP + OFF_C + c]);
                    const float pre = (yacc[i][j] + dsk * xs) * silu(z);
                    YPRE[l * 264 + c] = f2bf(pre);
                    float q = pre * pre; q += __shfl_xor(q, 1); q += __shfl_xor(q, 2); q += __shfl_xor(q, 4); q += __shfl_xor(q, 8);
                    if (fr == 0) SSQ[l * 16 + h * 4 + tn] = q; }
            }
        }
    }
    __syncthreads();
    {
        const int l = C.tid >> 3, sub = C.tid & 7; float ss = 0.f;
#pragma unroll
        for (int i = 0; i < 16; ++i) ss += SSQ[l * 16 + i];
        const float rs = rsqrtf(ss * (1.f / 256.f) + 1e-6f);
        const float* ng = C.in[23] + layer * 256 + sub * 32;
        bf16_t* dst = YC + (size_t)(ci.row0 + l) * DM + 512 + sub * 32;
#pragma unroll
        for (int i = 0; i < 32; i += 2) { const float a = bf2f(YPRE[l * 264 + sub * 32 + i]) * rs * ng[i], b = bf2f(YPRE[l * 264 + sub * 32 + i + 1]) * rs * ng[i + 1]; *(unsigned*)(dst + i) = pk2(a, b); }
    }
    __syncthreads();
}

constexpr int D3_G2T = 0, D3_SG = 69632;
__device__ __forceinline__ void load_g2t(const Ctx& C, int layer) {
    LAS bf16_t* G2T = (LAS bf16_t*)(C.lds + D3_G2T); const float* g2 = C.in[30] + (size_t)layer * 128 * 256;
    for (int e = C.tid; e < 128 * 256; e += 512) { const int r = e >> 8, c = e & 255; G2T[c * 136 + r] = f2bf(g2[e]); }
}
__device__ __forceinline__ float lerp_d(const bf16_t* P, const ChunkInfo& ci, int row, int j, const float* mup, const float* mun) {
    const bf16_t* pp = P + (size_t)row * NP + OFF_D + j;
    const float x = bf2f(*pp), xp = (row - 1 >= ci.lo) ? bf2f(*(pp - NP)) : 0.f, xn = (row + 1 < ci.hi) ? bf2f(*(pp + NP)) : 0.f;
    return x + mup[j] * (xp - x) + mun[j] * (xn - x);
}
__device__ __forceinline__ void item_rwkv_out(const Ctx& C, int layer, int gc) {
    const ChunkInfo ci = chunk_info(gc);
    const bf16_t* P = (const bf16_t*)(C.ws + WS_P); bf16_t* YC = (bf16_t*)(C.ws + WS_ACT);
    const float* mup = C.in[24] + layer * 1152; const float* mun = C.in[25] + layer * 1152;
    LAS bf16_t* G2T = (LAS bf16_t*)(C.lds + D3_G2T); LAS bf16_t* SG = (LAS bf16_t*)(C.lds + D3_SG);
    const int fr = C.lane & 15, fq = C.lane >> 4;
    __syncthreads();
    for (int e = C.tid; e < 64 * 128; e += 512) { const int l = e >> 7, r = e & 127; SG[l * 136 + r] = f2bf(sigm(lerp_d(P, ci, ci.row0 + l, 1024 + r, mup, mun))); }
    __syncthreads();
    const int h = C.wid >> 1, tmb = (C.wid & 1) * 2;
    const bf16_t* Ryg = (const bf16_t*)(C.ws + WS_RY); const bf16_t* Ylg = (const bf16_t*)(C.ws + WS_RL); const bf16_t* Hg = (const bf16_t*)(C.ws + WS_RH);
    const float* BON = (const float*)(C.ws + WS_BON);
#pragma unroll
    for (int ti = 0; ti < 2; ++ti) {
        const int tm = tmb + ti;
        f32x4 gacc[4], yacc[4];
#pragma unroll
        for (int tn = 0; tn < 4; ++tn) { f32x4 a = {0.f, 0.f, 0.f, 0.f};
#pragma unroll
            for (int ks = 0; ks < 4; ++ks) a = __builtin_amdgcn_mfma_f32_16x16x32_bf16(*(const LAS bf16x8*)(SG + (tm * 16 + fr) * 136 + ks * 32 + fq * 8),
                                                                                        *(const LAS bf16x8*)(G2T + (h * 64 + tn * 16 + fr) * 136 + ks * 32 + fq * 8), a, 0, 0, 0);
            gacc[tn] = a; yacc[tn] = (f32x4){0.f, 0.f, 0.f, 0.f}; }
#pragma unroll
        for (int d = 0; d < 2; ++d) {
            const size_t slot = (size_t)slot_of(ci.b, h, d, cpos_of(ci, d));
            const int arow = d ? 63 - (tm * 16 + fr) : tm * 16 + fr;
            bf16x8 af[2];
#pragma unroll
            for (int ks = 0; ks < 2; ++ks) af[ks] = *(const bf16x8*)(Ryg + slot * 4096 + arow * 64 + ks * 32 + fq * 8);
#pragma unroll
            for (int tn = 0; tn < 4; ++tn) {
                f32x4 a;
                if (d == 0) { const u32x2 yl = *(const u32x2*)(Ylg + slot * 4096 + (tn * 16 + fr) * 64 + tm * 16 + fq * 4); a = (f32x4){bflo(yl.x), bfhi(yl.x), bflo(yl.y), bfhi(yl.y)}; }
                else { const u32x2 yl = *(const u32x2*)(Ylg + slot * 4096 + (tn * 16 + fr) * 64 + 60 - (tm * 16 + fq * 4)); a = (f32x4){bfhi(yl.y), bflo(yl.y), bfhi(yl.x), bflo(yl.x)}; }
#pragma unroll
                for (int ks = 0; ks < 2; ++ks) a = __builtin_amdgcn_mfma_f32_16x16x32_bf16(af[ks], *(const bf16x8*)(Hg + slot * 4096 + (tn * 16 + fr) * 64 + ks * 32 + fq * 8), a, 0, 0, 0);
                yacc[tn] += a;
            }
        }
#pragma unroll
        for (int j = 0; j < 4; ++j) {
            const int l = tm * 16 + fq * 4 + j, row = ci.row0 + l;
            float s = (yacc[0][j] + yacc[1][j]) + (yacc[2][j] + yacc[3][j]);
            s += __shfl_xor(s, 1); s += __shfl_xor(s, 2); s += __shfl_xor(s, 4); s += __shfl_xor(s, 8);
            const float mu = s * (1.f / 64.f);
            float q = 0.f;
#pragma unroll
            for (int tn = 0; tn < 4; ++tn) { const float dd = yacc[tn][j] - mu; q += dd * dd; }
            q += __shfl_xor(q, 1); q += __shfl_xor(q, 2); q += __shfl_xor(q, 4); q += __shfl_xor(q, 8);
            const float rs = rsqrtf(q * (1.f / 64.f) + 64e-5f);
            const float bon = BON[(size_t)row * 8 + h * 2] + BON[(size_t)row * 8 + h * 2 + 1];
#pragma unroll
            for (int tn = 0; tn < 4; ++tn) { const int c = h * 64 + tn * 16 + fr;
                const float yn = (yacc[tn][j] - mu) * rs * C.in[34][layer * 256 + c] + C.in[35][layer * 256 + c];
                const float vv = lerp_d(P, ci, row, 512 + c, mup, mun);
                YC[(size_t)row * DM + 768 + c] = f2bf((yn + bon * vv) * gacc[tn][j]); }
        }
    }
}

__device__ __forceinline__ unsigned ordf(float f) { const unsigned u = __float_as_uint(f); return u ^ ((u >> 31) ? 0xFFFFFFFFu : 0x80000000u); }
__device__ __forceinline__ unsigned wave_max_u32(unsigned v) {
    unsigned t;
    t = (unsigned)__builtin_amdgcn_update_dpp((int)v, (int)v, 0xB1, 0xF, 0xF, false); v = t > v ? t : v;
    t = (unsigned)__builtin_amdgcn_update_dpp((int)v, (int)v, 0x4E, 0xF, 0xF, false); v = t > v ? t : v;
    t = (unsigned)__builtin_amdgcn_update_dpp((int)v, (int)v, 0x141, 0xF, 0xF, false); v = t > v ? t : v;
    t = (unsigned)__builtin_amdgcn_update_dpp((int)v, (int)v, 0x140, 0xF, 0xF, false); v = t > v ? t : v;
    t = (unsigned)__builtin_amdgcn_update_dpp((int)v, (int)v, 0x142, 0xA, 0xF, false); v = t > v ? t : v;
    t = (unsigned)__builtin_amdgcn_update_dpp((int)v, (int)v, 0x143, 0xC, 0xF, false); v = t > v ? t : v;
    return (unsigned)__builtin_amdgcn_readlane((int)v, 63);
}
constexpr int SEL_K1 = 0, SEL_K2 = 34816;
__device__ __forceinline__ float unordf(unsigned k) { return __uint_as_float((k & 0x80000000u) ? (k ^ 0x80000000u) : ~k); }
template <int N> __device__ __forceinline__ void bitonic_sort_desc(unsigned (&x)[N]) {
#pragma unroll
    for (int k = 2; k <= N; k <<= 1)
#pragma unroll
        for (int j = k >> 1; j > 0; j >>= 1)
#pragma unroll
            for (int i = 0; i < N; ++i) { const int l = i ^ j;
                if (l > i) { const unsigned p = x[i], q = x[l]; const unsigned hi = p > q ? p : q, lo = p > q ? q : p; if ((i & k) == 0) { x[i] = hi; x[l] = lo; } else { x[i] = lo; x[l] = hi; } } }
}
__device__ __forceinline__ void merge_top16(unsigned (&a)[16], const unsigned (&b)[16]) {
#pragma unroll
    for (int i = 0; i < 16; ++i) a[i] = a[i] > b[15 - i] ? a[i] : b[15 - i];
#pragma unroll
    for (int j = 8; j > 0; j >>= 1)
#pragma unroll
        for (int i = 0; i < 16; ++i) { const int l = i ^ j; if (l > i) { const unsigned p = a[i], q = a[l]; a[i] = p > q ? p : q; a[l] = p > q ? q : p; } }
}
__device__ __forceinline__ void ph_select(const Ctx& C, int layer, int nrows) {
    const bf16_t* Q = (const bf16_t*)(C.ws + WS_Q); int* SELI = (int*)(C.ws + WS_SELI); float* SELG = (float*)(C.ws + WS_SELG);
    LAS bf16_t* K1 = (LAS bf16_t*)(C.lds + SEL_K1); LAS bf16_t* K2 = (LAS bf16_t*)(C.lds + SEL_K2);
    {
        const float* k1 = C.in[37] + (size_t)layer * 128 * 128; const float* k2 = C.in[38] + (size_t)layer * 128 * 128;
        for (int e = C.tid; e < 4096; e += 512) { const int r = e >> 5, c4 = (e & 31) * 4; const f32x4 a = *(const f32x4*)(k1 + r * 128 + c4), b = *(const f32x4*)(k2 + r * 128 + c4);
            u32x2 oa, ob; oa.x = pk2(a.x, a.y); oa.y = pk2(a.z, a.w); ob.x = pk2(b.x, b.y); ob.y = pk2(b.z, b.w);
            *(LAS u32x2*)(K1 + r * 136 + c4) = oa; *(LAS u32x2*)(K2 + r * 136 + c4) = ob; }
    }
    __syncthreads();
    const int fr = C.lane & 15, fq = C.lane >> 4;
    const int nunits = (nrows / 16) * 8;
    for (int u = C.bid * 8 + C.wid; u < nunits; u += C.G * 8) {
        const int tile = u >> 3, h = u & 7, row = tile * 16 + fr;
        const bf16_t* qp = Q + (size_t)row * 2048 + h * 256 + fq * 8;
        bf16x8 qf[8];
#pragma unroll
        for (int i = 0; i < 8; ++i) qf[i] = *(const bf16x8*)(qp + i * 32);
        unsigned T[2][16];
#pragma unroll
        for (int half = 0; half < 2; ++half) {
            const LAS bf16_t* K = half ? K2 : K1;
            unsigned lo16[16], hi16[16];
#pragma unroll
            for (int kt = 0; kt < 8; ++kt) {
                f32x4 acc = {0.f, 0.f, 0.f, 0.f};
#pragma unroll
                for (int ks = 0; ks < 4; ++ks) acc = __builtin_amdgcn_mfma_f32_16x16x32_bf16(*(const LAS bf16x8*)(K + (kt * 16 + fr) * 136 + ks * 32 + fq * 8), qf[half * 4 + ks], acc, 0, 0, 0);
#pragma unroll
                for (int j = 0; j < 4; ++j) { const unsigned key = (ordf(acc[j]) & ~0x7Fu) | (unsigned)(127 - (kt * 16 + fq * 4 + j));
                    if (kt < 4) lo16[kt * 4 + j] = key; else hi16[(kt - 4) * 4 + j] = key; }
            }
            bitonic_sort_desc<16>(lo16); bitonic_sort_desc<16>(hi16); merge_top16(lo16, hi16);
#pragma unroll
            for (int rnd = 16; rnd <= 32; rnd <<= 1) { unsigned o[16];
#pragma unroll
                for (int i = 0; i < 16; ++i) o[i] = (unsigned)__shfl_xor((int)lo16[i], rnd);
                merge_top16(lo16, o); }
#pragma unroll
            for (int i = 0; i < 16; ++i) T[half][i] = lo16[i];
        }
        unsigned ck[50]; unsigned R0[16];
        {
            int id = 0;
#pragma unroll
            for (int a = 0; a < 16; ++a) {
                const float va = unordf(T[0][a] & ~0x7Fu);
#pragma unroll
                for (int b = 0; b < 16; ++b) if ((a + 1) * (b + 1) <= 16) { ck[id] = (ordf(va + unordf(T[1][b] & ~0x7Fu)) & ~0x3Fu) | (unsigned)(63 - id); ++id; }
            }
        }
#pragma unroll
        for (int i = 0; i < 16; ++i) R0[i] = ck[i];
        {
            int base = 16;
#pragma unroll
            for (int a = 1; a < 8; ++a) { const int n = 16 / (a + 1); unsigned rw[16];
#pragma unroll
                for (int i = 0; i < 16; ++i) rw[i] = i < n ? ck[base + i] : 0u;
                merge_top16(R0, rw); base += n; }
            unsigned rw[16];
#pragma unroll
            for (int i = 0; i < 16; ++i) rw[i] = i < 8 ? ck[base + i] : 0u;
            merge_top16(R0, rw);
        }
        const unsigned thr = R0[15]; const float mx = unordf(R0[0] & ~0x3Fu);
        float sum = 0.f;
#pragma unroll
        for (int c = 0; c < 50; ++c) sum += ck[c] >= thr ? __expf(unordf(ck[c] & ~0x3Fu) - mx) : 0.f;
        const float rsum = 1.f / sum;
        int* oi = SELI + ((size_t)row * 8 + h) * 16; float* og = SELG + ((size_t)row * 8 + h) * 16;
        {
            int id = 0, cnt = 0;
#pragma unroll
            for (int a = 0; a < 16; ++a)
#pragma unroll
                for (int b = 0; b < 16; ++b) if ((a + 1) * (b + 1) <= 16) {
                    if (ck[id] >= thr) { if (fq == 0 && cnt < 16) { oi[cnt] = (127 - (int)(T[0][a] & 0x7Fu)) * 128 + (127 - (int)(T[1][b] & 0x7Fu)); og[cnt] = __expf(unordf(ck[id] & ~0x3Fu) - mx) * rsum; } ++cnt; }
                    ++id; }
        }
    }
}

struct R16 { float v[16]; };
__device__ __forceinline__ R16 load_r16_f32(const float* p, int lane) { R16 r;
#pragma unroll
    for (int k = 0; k < 4; ++k) { const f32x4 a = *(const f32x4*)(p + 16 * lane + 4 * k); r.v[4 * k] = a.x; r.v[4 * k + 1] = a.y; r.v[4 * k + 2] = a.z; r.v[4 * k + 3] = a.w; }
    return r; }
__device__ __forceinline__ void store_r16_f32(float* p, int lane, const R16& r) {
#pragma unroll
    for (int k = 0; k < 4; ++k) *(f32x4*)(p + 16 * lane + 4 * k) = (f32x4){r.v[4 * k], r.v[4 * k + 1], r.v[4 * k + 2], r.v[4 * k + 3]}; }
__device__ __forceinline__ R16 load_r16_bf16(const bf16_t* p, int lane) { R16 r;
#pragma unroll
    for (int k = 0; k < 2; ++k) { const u32x4 a = *(const u32x4*)(p + 16 * lane + 8 * k);
        r.v[8 * k] = bflo(a.x); r.v[8 * k + 1] = bfhi(a.x); r.v[8 * k + 2] = bflo(a.y); r.v[8 * k + 3] = bfhi(a.y); r.v[8 * k + 4] = bflo(a.z); r.v[8 * k + 5] = bfhi(a.z); r.v[8 * k + 6] = bflo(a.w); r.v[8 * k + 7] = bfhi(a.w); }
    return r; }
__device__ __forceinline__ void store_r16_bf16(bf16_t* p, int lane, const R16& r) {
#pragma unroll
    for (int k = 0; k < 2; ++k) { u32x4 a; a.x = pk2(r.v[8 * k], r.v[8 * k + 1]); a.y = pk2(r.v[8 * k + 2], r.v[8 * k + 3]); a.z = pk2(r.v[8 * k + 4], r.v[8 * k + 5]); a.w = pk2(r.v[8 * k + 6], r.v[8 * k + 7]);
        *(u32x4*)(p + 16 * lane + 8 * k) = a; } }
typedef float f32x2p __attribute__((ext_vector_type(2)));
struct PeerHdr { int idx0, idx1; float su0, su1, gsv0, gsv1; };
__device__ __forceinline__ void ph_peer(const Ctx& C, int layer, int nrows, bool last, bool store = true) {
    const bf16_t* F = (const bf16_t*)(C.ws + WS_ACT); bf16_t* XN = (bf16_t*)(C.ws + WS_ACT);
    const unsigned char* UB = C.ws + WS_UB; const unsigned char* VB = C.ws + WS_VB; const float* SU = (const float*)(C.ws + WS_SU); const float* SV = (const float*)(C.ws + WS_SV);
    const int* SELI = (const int*)(C.ws + WS_SELI); const float* SELG = (const float*)(C.ws + WS_SELG);
    float* H = (float*)(C.ws + WS_H); const float* MOD = (const float*)(C.ws + WS_MOD);
    const int L = C.lane, step = C.G * 8;
    const int myexp = ((L >> 5) & 1) * 4 + ((L >> 4) & 1) * 2 + ((L >> 3) & 1);
    auto load_hdr = [&](int tok) { PeerHdr h; h.idx0 = SELI[(size_t)tok * 128 + L]; h.idx1 = SELI[(size_t)tok * 128 + 64 + L];
        h.su0 = SU[h.idx0]; h.su1 = SU[h.idx1]; h.gsv0 = SELG[(size_t)tok * 128 + L] * SV[h.idx0]; h.gsv1 = SELG[(size_t)tok * 128 + 64 + L] * SV[h.idx1]; return h; };
    int tok = C.bid * 8 + C.wid;
    for (; tok < nrows; tok += step) {
        const PeerHdr hd = load_hdr(tok);
        const R16 f = load_r16_bf16(F + (size_t)tok * DM, L);
        f32x2p out[8];
#pragma unroll
        for (int i = 0; i < 8; ++i) out[i] = (f32x2p){0.f, 0.f};
        u32x4 ua[2][8], va[2][8];
#define PEER_LOAD(buf, bt) do { const int src_ = (bt) < 8 ? hd.idx0 : hd.idx1; const int l0_ = ((bt) & 7) * 8; _Pragma("unroll") for (int i = 0; i < 8; ++i) { const int ei = __builtin_amdgcn_readlane(src_, l0_ + i); \
            ua[buf][i] = *(const u32x4*)(UB + (size_t)ei * DM + 16 * L); va[buf][i] = *(const u32x4*)(VB + (size_t)ei * DM + 16 * L); } } while (0)
#define PEER_COMPUTE(buf, bt) do { const float susrc = (bt) < 8 ? hd.su0 : hd.su1, gsrc = (bt) < 8 ? hd.gsv0 : hd.gsv1; const int l0 = ((bt) & 7) * 8; float part[8]; \
            _Pragma("unroll") for (int i = 0; i < 8; ++i) { f32x2p acc = {0.f, 0.f}; _Pragma("unroll") for (int k = 0; k < 4; ++k) { \
                const f32x2p lo = __builtin_amdgcn_cvt_pk_f32_fp8((int)ua[buf][i][k], false), hi = __builtin_amdgcn_cvt_pk_f32_fp8((int)ua[buf][i][k], true); \
                acc += lo * (f32x2p){f.v[4 * k], f.v[4 * k + 1]}; acc += hi * (f32x2p){f.v[4 * k + 2], f.v[4 * k + 3]}; } part[i] = acc.x + acc.y; } \
            float p4[4], p2[2], p1; \
            { const bool hi = (L & 32) != 0; _Pragma("unroll") for (int i = 0; i < 4; ++i) { const float send = hi ? part[i] : part[i + 4]; const float recv = __shfl_xor(send, 32); p4[i] = (hi ? part[i + 4] : part[i]) + recv; } } \
            { const bool hi = (L & 16) != 0; _Pragma("unroll") for (int i = 0; i < 2; ++i) { const float send = hi ? p4[i] : p4[i + 2]; const float recv = __shfl_xor(send, 16); p2[i] = (hi ? p4[i + 2] : p4[i]) + recv; } } \
            { const bool hi = (L & 8) != 0; const float send = hi ? p2[0] : p2[1]; const float recv = __shfl_xor(send, 8); p1 = (hi ? p2[1] : p2[0]) + recv; } \
            p1 += __shfl_xor(p1, 4); p1 += __shfl_xor(p1, 2); p1 += __shfl_xor(p1, 1); \
            const float act = gelu_tanh(p1 * __shfl(susrc, l0 + myexp)) * __shfl(gsrc, l0 + myexp); \
            _Pragma("unroll") for (int i = 0; i < 8; ++i) { \
                const float a = __uint_as_float((unsigned)__builtin_amdgcn_readlane((int)__float_as_uint(act), ((i >> 2) & 1) * 32 + ((i >> 1) & 1) * 16 + (i & 1) * 8)); const f32x2p a2 = {a, a}; \
                _Pragma("unroll") for (int k = 0; k < 4; ++k) { out[2 * k] += a2 * __builtin_amdgcn_cvt_pk_f32_fp8((int)va[buf][i][k], false); out[2 * k + 1] += a2 * __builtin_amdgcn_cvt_pk_f32_fp8((int)va[buf][i][k], true); } } } while (0)
        PEER_LOAD(0, 0);
        for (int bt = 0; bt < 16; bt += 2) {
            PEER_LOAD(1, bt + 1);
            PEER_COMPUTE(0, bt);
            if (bt + 2 < 16) PEER_LOAD(0, bt + 2);
            PEER_COMPUTE(1, bt + 1);
        }
#undef PEER_LOAD
#undef PEER_COMPUTE
        const float* m = MOD + ((size_t)layer * 3 + which_of(tok)) * 6144;
        R16 hr = load_r16_f32(H + (size_t)tok * DM, L); const R16 g5 = load_r16_f32(m + 5 * 1024, L);
#pragma unroll
        for (int i = 0; i < 8; ++i) { hr.v[2 * i] += g5.v[2 * i] * out[i].x; hr.v[2 * i + 1] += g5.v[2 * i + 1] * out[i].y; }
        float ss = 0.f;
#pragma unroll
        for (int i = 0; i < 16; ++i) ss += hr.v[i] * hr.v[i];
        const float rs = rsqrtf(wave_sum(ss) * (1.f / 1024.f) + 1e-6f);
        if (!store) continue;
        if (!last) {
            store_r16_f32(H + (size_t)tok * DM, L, hr);
            const float* m2 = MOD + ((size_t)(layer + 1) * 3 + which_of(tok)) * 6144;
            const R16 gg = load_r16_f32(C.in[6] + (layer + 1) * 1024, L), sh = load_r16_f32(m2, L), sc = load_r16_f32(m2 + 1024, L); R16 o;
#pragma unroll
            for (int i = 0; i < 16; ++i) o.v[i] = (hr.v[i] * rs * gg.v[i]) * (1.f + sc.v[i]) + sh.v[i];
            store_r16_bf16(XN + (size_t)tok * DM, L, o);
        } else {
            const R16 fg = load_r16_f32(C.in[41], L); R16 o;
#pragma unroll
            for (int i = 0; i < 16; ++i) o.v[i] = hr.v[i] * rs * fg.v[i];
            store_r16_f32(C.out + (size_t)tok * DM, L, o);
        }
    }
}

#define PM(n) ((MASK >> (n)) & 1u)
constexpr int NPH_LAYER = 9, NPH = 2 + 2 * NPH_LAYER;
template <unsigned MASK> __global__ void __launch_bounds__(512, 2) hybrid_fwd(Args args) {
    extern __shared__ __attribute__((aligned(16))) unsigned char lds_raw[];
    Ctx C0; C0.in = args.in; C0.out = args.out; C0.ws = args.ws; C0.lds = (lds_t)lds_raw;
    C0.tid = threadIdx.x; C0.lane = C0.tid & 63; C0.wid = __builtin_amdgcn_readfirstlane(C0.tid >> 6); C0.bid = blockIdx.x; C0.G = gridDim.x;
    const Ctx& C = C0;
    const int lo = args.ph_lo, hi = args.ph_hi;
    const bool multi = (hi - lo) > 1;
    XcdBarrier bar; bar.bar = (unsigned*)(C.ws + WS_CTL); bar.x = 0; bar.st = (volatile LAS unsigned*)(C.lds + LDS_XB);
    if (multi) {
        if (C.tid == 0) *(LAS u32x4*)(C.lds + LDS_XB) = (u32x4){0u, 0u, 0u, 0u};
        __syncthreads();
        bar = xcd_barrier_post((unsigned*)(C.ws + WS_CTL), (volatile LAS unsigned*)(C.lds + LDS_XB));
    }
#define IN(k) (lo <= (k) && (k) < hi)
#define PHASE_CTX(c) Ctx c = C0; { int t_ = C0.tid; asm volatile("" : "+v"(t_)); c.tid = t_; c.lane = t_ & 63; c.wid = __builtin_amdgcn_readfirstlane(t_ >> 6); }
#ifndef MK_REPEAT
#define MK_REPEAT 0u
#endif
#define RP(k) ((MK_REPEAT >> (k)) & 1u)
#define STAMP(k) do {} while (0)
#define SEAM(k) do { if (IN(k) && IN((k) + 1)) xcd_barrier(bar); STAMP((k) + 1); } while (0)
    STAMP(0);
    if (PM(0) && IN(0)) { PHASE_CTX(c); ph_prologue(c); if (RP(9)) { xcd_barrier(bar); ph_prologue(c); } } SEAM(0);
    if (PM(1) && IN(1)) { PHASE_CTX(c); ph_norm(c, 0, c.in[6], 0, NROW); } SEAM(1);
    for (int layer = 0; layer < 2; ++layer) {
        const int base = 2 + layer * NPH_LAYER;
        const bool emit = (layer == 0);
        const int nrows = emit ? NROW : NLAT;
        if (PM(2) && IN(base + 0)) {
            pg8::Gemm g{(const bf16_t*)(C.ws + WS_ACT), (const bf16_t*)(C.ws + WS_WIN) + (size_t)layer * NP * DM, NROW, NP, DM};
            pg8::StaticOrder S; S.init(NROW, NP, C.G, C.bid);
            pg8::EpiBf16<0> E{(bf16_t*)(C.ws + WS_P), NP, nullptr, 0, 0};
            pg8::gemm_phase<pg8::EpiBf16<0>, pg8::StaticOrder, false>(C.lds, g, S, E, nullptr);
            if (RP(0)) { xcd_barrier(bar); pg8::gemm_phase<pg8::EpiBf16<0>, pg8::StaticOrder, false>(C.lds, g, S, E, nullptr); }
            { const int nfull = (NROW / 256) * (NP / 256) - ((NROW / 256) * (NP / 256) / C.G) * C.G; PHASE_CTX(c); if (c.bid >= nfull) convert_tables(c, layer, c.bid - nfull, c.G - nfull); }
        }
        SEAM(base + 0);
        if (PM(3) && IN(base + 1)) {
            const int nD = 2112, nC = 264, nB = emit ? 132 : 128, nA = emit ? 264 : 256, tot = nD + nC + nB + nA;
            for (int rep = 0; rep < (RP(1) ? 2 : 1); ++rep) {
            if (rep) xcd_barrier(bar);
            if (PM(11)) { PHASE_CTX(c); for (int it = c.bid; it < nD; it += c.G) item_rwkv_local(c, layer, it); }
            if (PM(12)) { PHASE_CTX(c); for (int it = (c.bid + 52) % c.G; it < nC; it += c.G) item_mamba_local(c, layer, it); }
            if (PM(13)) { PHASE_CTX(c); for (int it = (c.bid + 192) % c.G; it < nB; it += c.G) item_chunkmlp(c, layer, it); }
            if (PM(14)) { PHASE_CTX(c); for (int it = (c.bid + 60) % c.G; it < nA; it += c.G) item_conformer(c, layer, it); }
            }
        }
        SEAM(base + 1);
        if (PM(4) && IN(base + 2)) { PHASE_CTX(c); ph_scan(c, RP(2) ? 2 : 1); }
        SEAM(base + 2);
        if (PM(5) && IN(base + 3)) {
            const int nc = nrows / 64;
            for (int rep = 0; rep < (RP(3) ? 2 : 1); ++rep) {
            if (rep) xcd_barrier(bar);
            if (PM(15)) { PHASE_CTX(c); load_g2t(c, layer); for (int it = c.bid; it < nc; it += c.G) item_rwkv_out(c, layer, it); }
            __syncthreads();
            if (PM(16)) { PHASE_CTX(c); for (int it = (c.bid + 128) % c.G; it < nc; it += c.G) item_mamba_out(c, layer, it); }
            __syncthreads();
            }
        }
        SEAM(base + 3);
        if (PM(6) && IN(base + 4)) {
            pg8::Gemm g{(const bf16_t*)(C.ws + WS_ACT), (const bf16_t*)(C.ws + WS_WOUT) + (size_t)layer * DM * DM, nrows, DM, DM};
            pg8::StaticOrder S; S.init(nrows, DM, C.G, C.bid);
            EpiResid E{(float*)(C.ws + WS_H), (const float*)(C.ws + WS_MOD) + (size_t)layer * 3 * 6144};
            pg8::gemm_phase<EpiResid, pg8::StaticOrder, false>(C.lds, g, S, E, nullptr);
        }
        SEAM(base + 4);
        if (PM(7) && IN(base + 5)) { PHASE_CTX(c); for (int rep = 0; rep < (RP(5) ? 2 : 1); ++rep) { if (rep) xcd_barrier(bar); ph_norm(c, layer, c.in[7] + layer * 1024, 3, nrows); } }
        SEAM(base + 5);
        if (PM(8) && IN(base + 6)) {
            pg8::Gemm g{(const bf16_t*)(C.ws + WS_ACT), (const bf16_t*)(C.ws + WS_WQ) + (size_t)layer * 2048 * DM, nrows, 2048, DM};
            pg8::StaticOrder S; S.init(nrows, 2048, C.G, C.bid);
            pg8::EpiBf16<0> E{(bf16_t*)(C.ws + WS_Q), 2048, nullptr, 0, 0};
            pg8::gemm_phase<pg8::EpiBf16<0>, pg8::StaticOrder, false>(C.lds, g, S, E, nullptr);
            if (RP(6)) { xcd_barrier(bar); pg8::gemm_phase<pg8::EpiBf16<0>, pg8::StaticOrder, false>(C.lds, g, S, E, nullptr); }
        }
        SEAM(base + 6);
        if (PM(9) && IN(base + 7)) { PHASE_CTX(c); ph_select(c, layer, nrows); if (RP(7)) { xcd_barrier(bar); ph_select(c, layer, nrows); } }
        SEAM(base + 7);
        if (PM(10) && IN(base + 8)) { PHASE_CTX(c); if (RP(8)) { ph_peer(c, layer, nrows, layer == 1, args.ph_hi > 1000); xcd_barrier(bar); } ph_peer(c, layer, nrows, layer == 1); }
        SEAM(base + 8);
    }
#undef IN
#undef SEAM
}
}


namespace mk {
struct LaunchEnt { unsigned mask; int ph; };
template <unsigned MASK> static bool prep_kernel() {
    return hipFuncSetAttribute((const void*)hybrid_fwd<MASK>, hipFuncAttributeMaxDynamicSharedMemorySize, LDS_BYTES) == hipSuccess;
}
template <unsigned MASK> static void launch_kernel(int grid, hipStream_t stream, const Args& a) {
    hipLaunchKernelGGL(hybrid_fwd<MASK>, dim3(grid), dim3(512), LDS_BYTES, stream, a);
}
}

#define CENSUS(off, n, kind, stage, lim) do {} while (0)
#ifndef MK_ONE_LAUNCH
#define MK_ONE_LAUNCH 1
#endif
extern "C" void kernel_launch(void* const* d_in, const int* in_sizes, int n_in, void* d_out, int out_size, void* d_ws, size_t ws_size, hipStream_t stream) {
    using namespace mk;
    static int grid = 0;
    if (grid == 0) {
        if (n_in != 42 || ws_size < WS_END) { fprintf(stderr, "kernel_launch: need 42 inputs and %zu bytes of workspace (got %d, %zu)\n", (size_t)WS_END, n_in, ws_size); grid = -1; return; }
        int dev = 0, cus = 0;
        if (hipGetDevice(&dev) != hipSuccess || hipDeviceGetAttribute(&cus, hipDeviceAttributeMultiprocessorCount, dev) != hipSuccess) { grid = -1; return; }
        bool ok = true;
#if MK_ONE_LAUNCH
        ok = ok && prep_kernel<0x1FFFFu>();
#else
        ok = ok && prep_kernel<0x0001u>() && prep_kernel<0x0002u>() && prep_kernel<0x0004u>() && prep_kernel<0x0808u>() && prep_kernel<0x1008u>() && prep_kernel<0x2008u>() && prep_kernel<0x4008u>()
                && prep_kernel<0x0010u>() && prep_kernel<0x8020u>() && prep_kernel<0x10020u>() && prep_kernel<0x0040u>() && prep_kernel<0x0080u>() && prep_kernel<0x0100u>() && prep_kernel<0x0200u>() && prep_kernel<0x0400u>();
#endif
        if (!ok) { fprintf(stderr, "kernel_launch: hipFuncSetAttribute failed\n"); grid = -1; return; }
        (void)hipGetLastError();
        grid = cus;
    }
    if (grid < 0) return;
    (void)hipMemsetAsync((char*)d_ws + WS_CTL, 0, 65536, stream);
    Args a{};
    for (int i = 0; i < 42; ++i) a.in[i] = (const float*)d_in[i];
    a.out = (float*)d_out; a.ws = (unsigned char*)d_ws;
#if MK_ONE_LAUNCH
    a.ph_lo = 0; a.ph_hi = NPH; launch_kernel<0x1FFFFu>(grid, stream, a);
#else
    a.ph_lo = 0; a.ph_hi = 1; launch_kernel<0x0001u>(grid, stream, a);
    CENSUS(WS_H, (size_t)NROW * DM, 0, 1, 1e4f); CENSUS(WS_MOD, 2 * 3 * 6144, 0, 1, 1e4f); CENSUS(WS_WIN, 2ull * NP * DM, 1, 1, 1e4f); CENSUS(WS_UB, 2ull * NEXP * DM, 1, 1, 1e4f);
    a.ph_lo = 1; a.ph_hi = 2; launch_kernel<0x0002u>(grid, stream, a);
    CENSUS(WS_ACT, (size_t)NROW * DM, 1, 2, 1e4f);
    for (int layer = 0; layer < 2; ++layer) {
        const int b = 2 + layer * NPH_LAYER;
        const int so = layer ? 100 : 0; (void)so;
        a.ph_lo = b + 0; a.ph_hi = b + 1; launch_kernel<0x0004u>(grid, stream, a);
        if (!layer) CENSUS(WS_P, (size_t)NROW * NP, 1, 3, 1e4f);
        a.ph_lo = b + 1; a.ph_hi = b + 2; launch_kernel<0x0808u>(grid, stream, a);
        if (!layer) { CENSUS(WS_RG, (size_t)NSLOT * 4096, 1, 4, 1e6f); CENSUS(WS_RJ, (size_t)NSLOT * 4096, 0, 5, 1e6f); CENSUS(WS_RY, (size_t)NSLOT * 4096 * 2, 1, 6, 1e6f); CENSUS(WS_BON, (size_t)NROW * 8, 0, 6, 1e6f); }
        launch_kernel<0x1008u>(grid, stream, a);
        if (!layer) { CENSUS(WS_MST, (size_t)NSLOT * 8192, 0, 7, 1e6f); CENSUS(WS_MCD, NSLOT, 0, 7, 1e6f); }
        launch_kernel<0x2008u>(grid, stream, a); launch_kernel<0x4008u>(grid, stream, a);
        a.ph_lo = b + 2; a.ph_hi = b + 3; launch_kernel<0x0010u>(grid, stream, a);
        if (!layer) { CENSUS(WS_MST, (size_t)NSLOT * 8192, 0, 8, 1e6f); CENSUS(WS_RH, (size_t)NSLOT * 4096, 1, 9, 1e6f); }
        a.ph_lo = b + 3; a.ph_hi = b + 4; launch_kernel<0x8020u>(grid, stream, a); launch_kernel<0x10020u>(grid, stream, a);
        if (!layer) CENSUS(WS_ACT, (size_t)NROW * DM, 1, 10, 1e4f);
        a.ph_lo = b + 4; a.ph_hi = b + 5; launch_kernel<0x0040u>(grid, stream, a);
        if (!layer) CENSUS(WS_H, (size_t)NROW * DM, 0, 11, 1e4f);
        a.ph_lo = b + 5; a.ph_hi = b + 6; launch_kernel<0x0080u>(grid, stream, a);
        a.ph_lo = b + 6; a.ph_hi = b + 7; launch_kernel<0x0100u>(grid, stream, a);
        if (!layer) CENSUS(WS_Q, (size_t)NROW * 2048, 1, 12, 1e4f);
        a.ph_lo = b + 7; a.ph_hi = b + 8; launch_kernel<0x0200u>(grid, stream, a);
        if (!layer) { CENSUS(WS_SELI, (size_t)NROW * 128, 2, 13, 0.f); CENSUS(WS_SELG, (size_t)NROW * 128, 0, 13, 2.f); }
        a.ph_lo = b + 8; a.ph_hi = b + 9; launch_kernel<0x0400u>(grid, stream, a);
        if (!layer) { CENSUS(WS_H, (size_t)NROW * DM, 0, 14, 1e4f); CENSUS(WS_ACT, (size_t)NROW * DM, 1, 15, 1e4f); }
    }
#endif
    (void)in_sizes; (void)out_size;
}
```

```cpp
#include <hip/hip_runtime.h>
#include <cstdio>
#include <cstdint>
namespace pg8 {
#define PG8_LAS __attribute__((address_space(3)))
typedef unsigned short bf16_t;
typedef short bf16x8 __attribute__((ext_vector_type(8)));
typedef float f32x4 __attribute__((ext_vector_type(4)));
typedef unsigned u32x4 __attribute__((ext_vector_type(4)));
constexpr int BM = 256, BK = 64, HALF = 128, HTB = HALF * BK * 2  , STAGE_BYTES = 8 * HTB, NXCD = 8, WGM = 8;

__host__ __device__ __forceinline__ int lds_byte(int r, int c) { const int st = (r >> 4) * 2 + (c >> 5), rr = r & 15, cc = c & 31, ob = rr * 64 + cc * 2; return st * 1024 + (ob ^ (((ob >> 9) & 1) << 5)); }
__host__ __device__ __forceinline__ void stage_rc(int b, int& R, int& C) { const int st = b / 1024, sb = b % 1024, swz = sb ^ (((sb >> 9) & 1) << 5); R = (st >> 1) * 16 + swz / 64; C = (st & 1) * 32 + (swz % 64) / 2; }
__host__ __device__ __forceinline__ int perm32(int rho) { const int n = rho >> 4, i = rho & 15; return 8 * (i >> 2) + 4 * n + (i & 3); }

struct Unit { int pm, pn; };
struct Gemm { const bf16_t* A; const bf16_t* Bt; int M, N, K; };

struct StaticOrder {
    int nM, nN, nwg, G, c;
    __host__ __device__ void init(int M, int N, int G_, int c_) { nM = M / BM; nN = N / BM; nwg = nM * nN; G = G_; c = c_; }
    __host__ __device__ bool next(int i, Unit& u) const {
        const long L = (long)i * G + c; if (L >= nwg) return false;
        int wgid = (int)L; { const int q = nwg / NXCD, r = nwg % NXCD, xcd = wgid % NXCD, off = wgid / NXCD; wgid = (xcd < r ? xcd * (q + 1) : r * (q + 1) + (xcd - r) * q) + off; }
        const int nig = WGM * nN, gid = wgid / nig, fm = gid * WGM, gsz = (nM - fm) < WGM ? (nM - fm) : WGM;
        u.pm = fm + ((wgid % nig) % gsz); u.pn = (wgid % nig) / gsz; return true;
    }
    __device__ __forceinline__ void a_ready(const Unit&) const {}
    __device__ __forceinline__ void done(const Unit&) const {}
};
struct CountedOrder : StaticOrder {
    const unsigned* ready; unsigned need; unsigned* tmo;
    __device__ __forceinline__ void a_ready(const Unit& u) const {
        if (threadIdx.x < 64) {
            const unsigned long long t0 = __builtin_amdgcn_s_memrealtime(); unsigned polls = 0;
            while ((unsigned)__builtin_amdgcn_readfirstlane(__hip_atomic_load(ready + 64 * u.pm, __ATOMIC_RELAXED, __HIP_MEMORY_SCOPE_AGENT)) < need) {
                if ((++polls & 255u) == 0u && __builtin_amdgcn_readfirstlane(__hip_atomic_load(tmo, __ATOMIC_RELAXED, __HIP_MEMORY_SCOPE_AGENT)) != 0u) break;
                if (__builtin_amdgcn_s_memrealtime() - t0 > 2000000ull) {
                    if (threadIdx.x == 0) { unsigned expect = 0u; __hip_atomic_compare_exchange_strong(tmo + 1, &expect, 0x600u | (unsigned)(u.pm & 0xff), __ATOMIC_RELAXED, __ATOMIC_RELAXED, __HIP_MEMORY_SCOPE_AGENT); __hip_atomic_store(tmo, 1u, __ATOMIC_RELAXED, __HIP_MEMORY_SCOPE_AGENT); }
                    break; }
                __builtin_amdgcn_s_sleep(2); }
            __builtin_amdgcn_fence(__ATOMIC_ACQUIRE, "agent");
            asm volatile("s_waitcnt vmcnt(0)" ::: "memory");
        }
#if !defined(BROKEN_HOOK_NO_BARRIER)
        asm volatile("" ::: "memory"); __builtin_amdgcn_s_barrier(); asm volatile("" ::: "memory");
#endif
    }
};

__device__ __forceinline__ unsigned cvt_pk_bf16(float lo, float hi) { unsigned r; asm volatile("v_cvt_pk_bf16_f32 %0, %1, %2" : "=v"(r) : "v"(lo), "v"(hi)); return r; }
typedef float f32x2 __attribute__((ext_vector_type(2)));
__device__ __forceinline__ f32x2 gelu_pk(f32x2 v) {
    const f32x2 av = __builtin_elementwise_abs(v), d = av * 0.2316418882f + 1.0f;
    f32x2 t; t.x = __builtin_amdgcn_rcpf(d.x); t.y = __builtin_amdgcn_rcpf(d.y);
    f32x2 q = t * 0.5307027145f + (-0.7265760135f); q = q * t + 0.7107068705f; q = q * t + (-0.142248368f); q = q * t + 0.127414796f; q = q * t;
    const f32x2 s = (v * v) * (-0.72134752044f);
    f32x2 e; e.x = __builtin_amdgcn_exp2f(s.x); e.y = __builtin_amdgcn_exp2f(s.y);
    const f32x2 m = v * (q * e), r = v - m;
    f32x2 o; o.x = v.x < 0.f ? m.x : r.x; o.y = v.y < 0.f ? m.y : r.y; return o;
}

struct EpiF32 {
    static constexpr bool PERM = false, AFTER_DRAIN = false;
    float* C; int ldc; const float* bias;
    __device__ __forceinline__ void operator()(const f32x4 (&acc)[2][2][4][2], const Unit& u, int wr, int wc, int fr, int fq) const {
        const int row0 = u.pm * BM + wr * 64 + fr, col0 = u.pn * BM + wc * 32 + 4 * fq;
        f32x4 bv[2][2];
#pragma unroll
        for (int bj = 0; bj < 2; ++bj)
#pragma unroll
            for (int n = 0; n < 2; ++n) bv[bj][n] = bias ? *(const f32x4*)(bias + col0 + bj * HALF + n * 16) : (f32x4){0.f, 0.f, 0.f, 0.f};
#pragma unroll
        for (int ai = 0; ai < 2; ++ai)
#pragma unroll
            for (int m = 0; m < 4; ++m) { float* rowp = C + (size_t)(row0 + ai * HALF + m * 16) * ldc + col0;
#pragma unroll
                for (int bj = 0; bj < 2; ++bj)
#pragma unroll
                    for (int n = 0; n < 2; ++n) *(f32x4*)(rowp + bj * HALF + n * 16) = acc[ai][bj][m][n] + bv[bj][n]; }
    }
};
template <int ACT  > struct EpiBf16 {
    static constexpr bool PERM = true, AFTER_DRAIN = false;
    bf16_t* O; int ldc; const float* bias; int split_cols; size_t split_stride;
    __device__ __forceinline__ void operator()(const f32x4 (&acc)[2][2][4][2], const Unit& u, int wr, int wc, int fr, int fq) const {
        const int row0 = u.pm * BM + wr * 64 + fr; int colt = u.pn * BM; bf16_t* base = O;
        if (split_cols) { const int t = colt / split_cols; base += (size_t)t * split_stride; colt -= t * split_cols; }
        const int col0 = colt + wc * 32 + 8 * fq, bcol0 = u.pn * BM + wc * 32 + 8 * fq;
        f32x4 bv[2][2];
#pragma unroll
        for (int bj = 0; bj < 2; ++bj)
#pragma unroll
            for (int n = 0; n < 2; ++n) bv[bj][n] = bias ? *(const f32x4*)(bias + bcol0 + bj * HALF + 4 * n) : (f32x4){0.f, 0.f, 0.f, 0.f};
#pragma unroll
        for (int ai = 0; ai < 2; ++ai)
#pragma unroll
            for (int m = 0; m < 4; ++m) { bf16_t* rowp = base + (size_t)(row0 + ai * HALF + m * 16) * ldc + col0;
#pragma unroll
                for (int bj = 0; bj < 2; ++bj) { f32x4 v0 = acc[ai][bj][m][0] + bv[bj][0], v1 = acc[ai][bj][m][1] + bv[bj][1];
                    if (ACT == 1) { f32x2 a = gelu_pk((f32x2){v0[0], v0[1]}), b = gelu_pk((f32x2){v0[2], v0[3]}), c = gelu_pk((f32x2){v1[0], v1[1]}), d = gelu_pk((f32x2){v1[2], v1[3]});
                        v0 = (f32x4){a.x, a.y, b.x, b.y}; v1 = (f32x4){c.x, c.y, d.x, d.y}; }
                    if (ACT == 2) {
#pragma unroll
                        for (int j = 0; j < 4; ++j) { v0[j] = 0.5f * v0[j] * (1.0f + erff(v0[j] * 0.70710678f)); v1[j] = 0.5f * v1[j] * (1.0f + erff(v1[j] * 0.70710678f)); } }
                    u32x4 w; w.x = cvt_pk_bf16(v0[0], v0[1]); w.y = cvt_pk_bf16(v0[2], v0[3]); w.z = cvt_pk_bf16(v1[0], v1[1]); w.w = cvt_pk_bf16(v1[2], v1[3]);
                    *(u32x4*)(rowp + bj * HALF) = w; } }
    }
};
template <class Epi, class Sched, bool STAMP = false>
__device__ __forceinline__ void gemm_phase(PG8_LAS unsigned char* lds, const Gemm g, const Sched& S, const Epi& E, unsigned long long* stamps) {
    int tid_ = threadIdx.x; asm volatile("" : "+v"(tid_));
    const int tid = tid_, wid = __builtin_amdgcn_readfirstlane(tid >> 6), lane = tid & 63, wr = wid >> 2, wc = wid & 3, fr = lane & 15, fq = lane >> 4;
    const int K = g.K, nt = K / BK;
    int ts_lo = 0, ts_hi = 0, nts = 0; const unsigned long long rt_entry = STAMP ? (unsigned long long)wall_clock64() : 0ull;
#define PG8_STAMP() do { if (STAMP && wid == 0 && nts < 64) { const unsigned long long _c = (unsigned long long)clock64(); \
        ts_lo = (lane == nts) ? (int)(unsigned)_c : ts_lo; ts_hi = (lane == nts) ? (int)(unsigned)(_c >> 32) : ts_hi; ++nts; } } while (0)
    PG8_STAMP();
    unsigned voffA[2], voffB[2];
#pragma unroll
    for (int i = 0; i < 2; ++i) { int R, C; stage_rc(tid * 16 + i * 8192, R, C); const int Rb = Epi::PERM ? ((R & ~31) + perm32(R & 31)) : R;
        voffA[i] = (unsigned)(R * K + C) * 2u; voffB[i] = (unsigned)(Rb * K + C) * 2u; }
    const size_t kstep = (size_t)(BK * 2);
    const size_t hstep = (size_t)HALF * K * 2;
    const size_t tstep = 2 * hstep;
    const unsigned ldsw = (unsigned)wid * 1024u;
    const int aoff = lds_byte(wr * 64 + fr, fq * 8), boff = lds_byte(wc * 32 + fr, fq * 8);
#define PG8_SA(b, h) (((b) * 2 + (h)) * HTB)
#define PG8_SB(b, h) ((4 + (b) * 2 + (h)) * HTB)
#define PG8_STAGE(bufoff, gbase, voff) do { _Pragma("unroll") for (int _i = 0; _i < 2; ++_i) \
        __builtin_amdgcn_global_load_lds((const unsigned*)((const char*)(gbase) + (voff)[_i]), (PG8_LAS unsigned*)(lds + (bufoff) + ldsw + _i * 8192), 16, 0, 0); } while (0)
#define PG8_LDA(dst, b, h) do { _Pragma("unroll") for (int m = 0; m < 4; ++m) _Pragma("unroll") for (int k = 0; k < 2; ++k) dst[m][k] = *(const PG8_LAS bf16x8*)(lds + PG8_SA(b, h) + aoff + m * 2048 + k * 1024); } while (0)
#define PG8_LDB(dst, b, h) do { _Pragma("unroll") for (int n = 0; n < 2; ++n) _Pragma("unroll") for (int k = 0; k < 2; ++k) dst[n][k] = *(const PG8_LAS bf16x8*)(lds + PG8_SB(b, h) + boff + n * 2048 + k * 1024); } while (0)
#define PG8_MMA(ai, bj, At, Bt) do { __builtin_amdgcn_s_setprio(1); _Pragma("unroll") for (int m = 0; m < 4; ++m) _Pragma("unroll") for (int n = 0; n < 2; ++n) _Pragma("unroll") for (int k = 0; k < 2; ++k) \
        acc[ai][bj][m][n] = __builtin_amdgcn_mfma_f32_16x16x32_bf16(Bt[n][k], At[m][k], acc[ai][bj][m][n], 0, 0, 0); __builtin_amdgcn_s_setprio(0); } while (0)
#define PG8_WAIT_V(n) asm volatile("s_waitcnt vmcnt(" #n ")" ::: "memory")
#define PG8_WAIT_L(n) asm volatile("s_waitcnt lgkmcnt(" #n ")" ::: "memory")
#define PG8_BAR __builtin_amdgcn_s_barrier()
#define PG8_SCHED __builtin_amdgcn_sched_barrier(0)
    Unit cur, nxt; int ui = 0;
    if (!S.next(0, cur)) return;
    f32x4 acc[2][2][4][2];
#pragma unroll
    for (int a = 0; a < 2; ++a)
#pragma unroll
        for (int b = 0; b < 2; ++b)
#pragma unroll
            for (int m = 0; m < 4; ++m)
#pragma unroll
                for (int n = 0; n < 2; ++n) acc[a][b][m][n] = (f32x4){0.f, 0.f, 0.f, 0.f};
    bf16x8 At[4][2], B0[2][2], B1[2][2];
    const char* cA = (const char*)g.A + (size_t)cur.pm * tstep; const char* cB = (const char*)g.Bt + (size_t)cur.pn * tstep;
    S.a_ready(cur);
    PG8_STAGE(PG8_SB(0, 0), cB, voffB); PG8_STAGE(PG8_SA(0, 0), cA, voffA); PG8_STAGE(PG8_SB(0, 1), cB + hstep, voffB); PG8_STAGE(PG8_SA(0, 1), cA + hstep, voffA);
    if (wr == 1) PG8_BAR;
    PG8_WAIT_V(4); PG8_BAR;
    PG8_STAGE(PG8_SB(1, 0), cB + kstep, voffB); PG8_STAGE(PG8_SA(1, 0), cA + kstep, voffA); PG8_STAGE(PG8_SB(1, 1), cB + hstep + kstep, voffB);
    PG8_WAIT_V(6); PG8_BAR;
    PG8_STAMP();
    for (;;) {
        const bool has_next = S.next(ui + 1, nxt);
        const char* nA = has_next ? (const char*)g.A + (size_t)nxt.pm * tstep : cA; const char* nB = has_next ? (const char*)g.Bt + (size_t)nxt.pn * tstep : cB;
        for (int t = 0; t < nt; t += 2) {
            const bool last = (t == nt - 2);
            const char* a1 = cA + (size_t)(t + 1) * kstep;
            const char* a2 = last ? nA : cA + (size_t)(t + 2) * kstep; const char* b2 = last ? nB : cB + (size_t)(t + 2) * kstep;
            const char* a3 = a2 + kstep; const char* b3 = b2 + kstep;
            if (last && has_next) S.a_ready(nxt);
            PG8_LDB(B0, 0, 0); PG8_SCHED; PG8_LDA(At, 0, 0); PG8_STAGE(PG8_SA(1, 1), a1 + hstep, voffA);
            PG8_WAIT_L(8); PG8_BAR; PG8_WAIT_L(0); PG8_MMA(0, 0, At, B0); PG8_BAR; PG8_SCHED;
            PG8_LDB(B1, 0, 1); PG8_STAGE(PG8_SB(0, 0), b2, voffB);
            PG8_BAR; PG8_WAIT_L(0); PG8_MMA(0, 1, At, B1); PG8_BAR;
            PG8_LDA(At, 0, 1); PG8_STAGE(PG8_SA(0, 0), a2, voffA);
            PG8_BAR; PG8_WAIT_L(0); PG8_MMA(1, 0, At, B0); PG8_BAR; PG8_SCHED;
            PG8_STAGE(PG8_SB(0, 1), b2 + hstep, voffB);
            PG8_WAIT_V(6); PG8_BAR; PG8_MMA(1, 1, At, B1); PG8_BAR;
            PG8_LDB(B0, 1, 0); PG8_SCHED; PG8_LDA(At, 1, 0); PG8_STAGE(PG8_SA(0, 1), a2 + hstep, voffA);
            PG8_WAIT_L(8); PG8_BAR; PG8_WAIT_L(0); PG8_MMA(0, 0, At, B0); PG8_BAR; PG8_SCHED;
            PG8_LDB(B1, 1, 1); PG8_STAGE(PG8_SB(1, 0), b3, voffB);
            PG8_BAR; PG8_WAIT_L(0); PG8_MMA(0, 1, At, B1); PG8_BAR;
            PG8_LDA(At, 1, 1); PG8_STAGE(PG8_SA(1, 0), a3, voffA);
            PG8_BAR; PG8_WAIT_L(0); PG8_MMA(1, 0, At, B0); PG8_BAR; PG8_SCHED;
            PG8_STAGE(PG8_SB(1, 1), b3 + hstep, voffB);
            PG8_WAIT_V(6); PG8_BAR; PG8_MMA(1, 1, At, B1); PG8_BAR;
        }
        PG8_STAMP();
        if constexpr (!Epi::AFTER_DRAIN) { E(acc, cur, wr, wc, fr, fq); S.done(cur); }
        PG8_STAMP();
        if (!has_next) break;
#pragma unroll
        for (int a = 0; a < 2; ++a)
#pragma unroll
            for (int b = 0; b < 2; ++b)
#pragma unroll
                for (int m = 0; m < 4; ++m)
#pragma unroll
                    for (int n = 0; n < 2; ++n) acc[a][b][m][n] = (f32x4){0.f, 0.f, 0.f, 0.f};
        cur = nxt; cA = nA; cB = nB; ++ui;
    }
    PG8_WAIT_V(0);
    if (wr == 0) PG8_BAR;
    PG8_BAR;
    if constexpr (Epi::AFTER_DRAIN) { E.fused(acc, cur, wr, wc, fr, fq, lds, wid, lane); S.done(cur); }
    PG8_STAMP();
    if (STAMP && wid == 0) { stamps[lane] = lane < nts ? (((unsigned long long)(unsigned)ts_hi << 32) | (unsigned)ts_lo) : 0ull;
        if (lane == 62) stamps[62] = rt_entry; if (lane == 63) stamps[63] = (unsigned long long)wall_clock64(); }
#undef PG8_STAMP
#undef PG8_SA
#undef PG8_SB
#undef PG8_STAGE
#undef PG8_LDA
#undef PG8_LDB
#undef PG8_MMA
#undef PG8_WAIT_V
#undef PG8_WAIT_L
#undef PG8_BAR
#undef PG8_SCHED
}
}
#define XB_TMO      128
#define XB_XCNT(j)  (256  + 64 * (j))
#define XB_XSUB(j)  (1280 + 64 * (j))
#define XB_XGEN(j)  (2304 + 64 * (j))
#define XB_TOP      3328
#define XB_TOPGEN   3392
#define XCD_BAR_WORDS 3456
#define XB_SPIN_CAP (1u << 18)
#define LAS __attribute__((address_space(3)))

__device__ __forceinline__ unsigned xb_ld(unsigned* p)              { return __hip_atomic_load(p, __ATOMIC_RELAXED, __HIP_MEMORY_SCOPE_AGENT); }
__device__ __forceinline__ unsigned xb_add(unsigned* p, unsigned v) { return __hip_atomic_fetch_add(p, v, __ATOMIC_RELAXED, __HIP_MEMORY_SCOPE_AGENT); }
__device__ __forceinline__ unsigned xb_xcc_id() { return (unsigned)__builtin_amdgcn_s_getreg((3 << 11) | 20) & 0xFu; }
#define XB_SPIN(cond, bar) do { unsigned _sp = 0; while (cond) { __builtin_amdgcn_s_sleep(1); \
    if ((++_sp & 255u) == 0u) { if (xb_ld(&(bar)[XB_TMO])) break; if (_sp > XB_SPIN_CAP) { atomicAdd(&(bar)[XB_TMO], 1u); break; } } } } while (0)

struct XcdBarrier {
    unsigned* bar; unsigned x;
    volatile LAS unsigned* st;
};

__device__ __forceinline__ XcdBarrier xcd_barrier_post(unsigned* bar, volatile LAS unsigned* st) {
    XcdBarrier b; b.bar = bar; b.x = xb_xcc_id(); b.st = st;
    if (threadIdx.x == 0) (void)xb_add(&bar[XB_XCNT(b.x)], 1u);
    return b;
}
__device__ __forceinline__ void xcd_barrier_complete(unsigned* bar, unsigned x, unsigned& nloc, unsigned& nx) {
    const unsigned G = gridDim.x * gridDim.y * gridDim.z;
    unsigned sum, cnt, mine, sp = 0u;
    for (;;) {
        sum = 0u; cnt = 0u; mine = 0u;
#pragma unroll
        for (unsigned j = 0; j < 16; ++j) { const unsigned c = xb_ld(&bar[XB_XCNT(j)]); sum += c; cnt += (c > 0u) ? 1u : 0u; mine = (j == x) ? c : mine; }
        if (sum == G) break;
        __builtin_amdgcn_s_sleep(1);
        if ((++sp & 255u) == 0u) { if (xb_ld(&bar[XB_TMO])) break; if (sp > XB_SPIN_CAP) { atomicAdd(&bar[XB_TMO], 1u); break; } }
    }
    nloc = mine > 0u ? mine : 1u; nx = cnt > 0u ? cnt : 1u;
}

__device__ __forceinline__ void xcd_barrier(const XcdBarrier& b) {
    asm volatile("s_waitcnt vmcnt(0)" ::: "memory");
    __syncthreads();
    if (threadIdx.x == 0) {
        unsigned* bar = b.bar;
        __builtin_amdgcn_s_waitcnt(0);
        unsigned nloc = b.st[0], nx = b.st[1];
        if (nloc == 0u) { xcd_barrier_complete(bar, b.x, nloc, nx); b.st[0] = nloc; b.st[1] = nx; }
        const unsigned old = xb_add(&bar[XB_XSUB(b.x)], 1u);
        const unsigned gen = old / nloc;
        if (old + 1u == (gen + 1u) * nloc) {
            __builtin_amdgcn_fence(__ATOMIC_RELEASE, "agent");
            asm volatile("s_waitcnt vmcnt(0)" ::: "memory");
            const unsigned og = xb_add(&bar[XB_TOP], 1u);
            const unsigned tg = og / nx;
            if (og + 1u == (tg + 1u) * nx) xb_add(&bar[XB_TOPGEN], 1u);
            else XB_SPIN(xb_ld(&bar[XB_TOPGEN]) == tg, bar);
            __builtin_amdgcn_fence(__ATOMIC_ACQUIRE, "agent");
            xb_add(&bar[XB_XGEN(b.x)], 1u);
            asm volatile("s_waitcnt vmcnt(0)" ::: "memory");
        } else {
            XB_SPIN(xb_ld(&bar[XB_XGEN(b.x)]) == gen, bar);
            __builtin_amdgcn_fence(__ATOMIC_ACQUIRE, "agent");
            asm volatile("s_waitcnt vmcnt(0)" ::: "memory");
        }
    }
    __syncthreads();
}

namespace mk {
using pg8::bf16_t; using pg8::bf16x8; using pg8::f32x4; using pg8::u32x4;
typedef unsigned u32x2 __attribute__((ext_vector_type(2)));
typedef __bf16 bf16x2_t __attribute__((ext_vector_type(2)));
typedef LAS unsigned char* lds_t;

constexpr int DM = 1024, NLAT = 16384, NROW = 16896;
constexpr int OFF_B = 512, OFF_C = 1024, OFF_D = 2056, INC = 3208, NP = 3328;
constexpr int NCH = 132, NSLOT = 16 * NCH;
constexpr int NEXP = 16384;

constexpr size_t WS_CTL  = 0;
constexpr size_t WS_MOD  = 65536;
constexpr size_t WS_WIN  = WS_MOD + 147456;
constexpr size_t WS_WOUT = WS_WIN + 2ull * NP * DM * 2;
constexpr size_t WS_WQ   = WS_WOUT + 2ull * DM * DM * 2;
constexpr size_t WS_H    = WS_WQ + 2ull * 2048 * DM * 2;
constexpr size_t WS_ACT  = WS_H + (size_t)NROW * DM * 4;
constexpr size_t WS_UB   = WS_ACT + (size_t)NROW * DM * 2;
constexpr size_t WS_VB   = WS_UB + (size_t)NEXP * DM * 2;
constexpr size_t WS_SU   = WS_UB + (size_t)NEXP * DM;
constexpr size_t WS_SV   = WS_VB + (size_t)NEXP * DM;
constexpr size_t WS_P    = WS_VB + (size_t)NEXP * DM * 2;
constexpr size_t WS_Q    = WS_P;
constexpr size_t WS_SELI = WS_Q + (size_t)NROW * 2048 * 2;
constexpr size_t WS_SELG = WS_SELI + (size_t)NROW * 128 * 4;
constexpr size_t WS_MST  = WS_P + (size_t)NROW * NP * 2;
constexpr size_t WS_MCD  = WS_MST + (size_t)NSLOT * 8192 * 4;
constexpr size_t WS_RG   = WS_MCD + 16384;
constexpr size_t WS_RJ   = WS_RG + (size_t)NSLOT * 8192;
constexpr size_t WS_RY   = WS_RJ + (size_t)NSLOT * 16384;
constexpr size_t WS_RL   = WS_RY + (size_t)NSLOT * 8192;
constexpr size_t WS_RH   = WS_RL + (size_t)NSLOT * 8192;
constexpr size_t WS_BON  = WS_RH + (size_t)NSLOT * 8192;
constexpr size_t WS_END  = WS_BON + (size_t)NROW * 8 * 4;
static_assert(WS_SELG + (size_t)NROW * 128 * 4 <= WS_MST, "Q + selections must fit in P's region");

constexpr int LDS_BYTES = 157440;
constexpr int LDS_XB = 157184;

struct Args { const float* in[42]; float* out; unsigned char* ws; int ph_lo, ph_hi; };

struct Ctx {
    const float* const* in; float* out; unsigned char* ws; lds_t lds;
    int tid, lane, wid, bid, G;
};

__device__ __forceinline__ float bf2f(unsigned short x) { return __uint_as_float(((unsigned)x) << 16); }
__device__ __forceinline__ float bflo(unsigned w) { return __uint_as_float(w << 16); }
__device__ __forceinline__ float bfhi(unsigned w) { return __uint_as_float(w & 0xffff0000u); }
typedef __bf16 bf16pair_t __attribute__((ext_vector_type(2)));
__device__ __forceinline__ unsigned pk2(float lo, float hi) { const bf16pair_t v = {(__bf16)lo, (__bf16)hi}; return __builtin_bit_cast(unsigned, v); }
__device__ __forceinline__ unsigned short f2bf(float f) { return (unsigned short)(pk2(f, 0.f) & 0xffffu); }
__device__ __forceinline__ float wave_sum(float v) {
#pragma unroll
    for (int o = 1; o < 64; o <<= 1) v += __shfl_xor(v, o);
    return v;
}
#define dpp_f(old, src, ctrl, row_mask, bank_mask) __uint_as_float((unsigned)__builtin_amdgcn_update_dpp((int)__float_as_uint(old), (int)__float_as_uint(src), ctrl, row_mask, bank_mask, true))
__device__ __forceinline__ float wave_incl_scan(float v, int lane) {
    (void)lane;
    float s = v + dpp_f(0.f, v, 0x111, 0xF, 0xF);
    s += dpp_f(0.f, v, 0x112, 0xF, 0xF);
    s += dpp_f(0.f, v, 0x113, 0xF, 0xF);
    s += dpp_f(0.f, s, 0x114, 0xF, 0xE);
    s += dpp_f(0.f, s, 0x118, 0xF, 0xC);
    s += dpp_f(0.f, s, 0x142, 0xA, 0xF);
    s += dpp_f(0.f, s, 0x143, 0xC, 0xF);
    return s;
}
__device__ __forceinline__ float fexp(float x) { return __expf(x); }
__device__ __forceinline__ float frcp(float x) { return __builtin_amdgcn_rcpf(x); }
__device__ __forceinline__ float sigm(float x) { return frcp(1.f + __expf(-x)); }
__device__ __forceinline__ float silu(float x) { return x * frcp(1.f + __expf(-x)); }
__device__ __forceinline__ float softplus(float x) { return fmaxf(x, 0.f) + __logf(1.f + __expf(-fabsf(x))); }
__device__ __forceinline__ float ftanh(float x) { const float e = __expf(-2.f * fabsf(x)); const float t = (1.f - e) * frcp(1.f + e); return x < 0.f ? -t : t; }
__device__ __forceinline__ float gelu_tanh(float x) { const float u = 0.7978845608028654f * (x + 0.044715f * x * x * x); return 0.5f * x * (1.f + ftanh(u)); }
__device__ __forceinline__ float dot2bf(unsigned a, unsigned b, float acc) { return __builtin_amdgcn_fdot2_f32_bf16(__builtin_bit_cast(bf16x2_t, a), __builtin_bit_cast(bf16x2_t, b), acc, false); }

struct ChunkInfo { int row0, lo, hi, b, tc, isctx; };
__device__ __forceinline__ ChunkInfo chunk_info(int gc) {
    ChunkInfo c; c.row0 = gc * 64;
    if (gc < 256) { c.b = gc >> 7; c.tc = gc & 127; c.isctx = 0; c.lo = c.b * 8192; c.hi = c.lo + 8192; }
    else { const int q = gc - 256; c.b = q >> 2; c.tc = q & 3; c.isctx = 1; c.lo = NLAT + c.b * 256; c.hi = c.lo + 256; }
    return c;
}
__device__ __forceinline__ int cpos_of(const ChunkInfo& c, int d) { return c.isctx ? (d ? 3 - c.tc : c.tc) : (d ? 4 + 127 - c.tc : 4 + c.tc); }
__device__ __forceinline__ int slot_of(int b, int h, int d, int cpos) { return ((b * 4 + h) * 2 + d) * NCH + cpos; }

template <int MT, int NT, int KS, class Epi>
__device__ __forceinline__ void blk_mma(const LAS bf16_t* A, int lda, const LAS bf16_t* Bt, int ldb, int wid, int lane, Epi epi) {
    const int fr = lane & 15, fq = lane >> 4;
    for (int tt = wid; tt < MT * NT; tt += 8) {
        const int tm = tt / NT, tn = tt % NT;
        f32x4 acc = {0.f, 0.f, 0.f, 0.f};
#pragma unroll
        for (int ks = 0; ks < KS; ++ks) {
            const bf16x8 a = *(const LAS bf16x8*)(A + (tm * 16 + fr) * lda + ks * 32 + fq * 8);
            const bf16x8 b = *(const LAS bf16x8*)(Bt + (tn * 16 + fr) * ldb + ks * 32 + fq * 8);
            acc = __builtin_amdgcn_mfma_f32_16x16x32_bf16(a, b, acc, 0, 0, 0);
        }
        epi(tm * 16 + fq * 4, tn * 16 + fr, acc);
    }
}
template <int MT, int NT, int KS, class Epi>
__device__ __forceinline__ void blk_mma2(const LAS bf16_t* A1, const LAS bf16_t* B1, const LAS bf16_t* A2, const LAS bf16_t* B2, int ld, int wid, int lane, Epi epi) {
    const int fr = lane & 15, fq = lane >> 4;
    for (int tt = wid; tt < MT * NT; tt += 8) {
        const int tm = tt / NT, tn = tt % NT;
        f32x4 acc1 = {0.f, 0.f, 0.f, 0.f}, acc2 = {0.f, 0.f, 0.f, 0.f};
#pragma unroll
        for (int ks = 0; ks < KS; ++ks) {
            const bf16x8 a1 = *(const LAS bf16x8*)(A1 + (tm * 16 + fr) * ld + ks * 32 + fq * 8);
            const bf16x8 b1 = *(const LAS bf16x8*)(B1 + (tn * 16 + fr) * ld + ks * 32 + fq * 8);
            acc1 = __builtin_amdgcn_mfma_f32_16x16x32_bf16(a1, b1, acc1, 0, 0, 0);
            const bf16x8 a2 = *(const LAS bf16x8*)(A2 + (tm * 16 + fr) * ld + ks * 32 + fq * 8);
            const bf16x8 b2 = *(const LAS bf16x8*)(B2 + (tn * 16 + fr) * ld + ks * 32 + fq * 8);
            acc2 = __builtin_amdgcn_mfma_f32_16x16x32_bf16(a2, b2, acc2, 0, 0, 0);
        }
        epi(tm * 16 + fq * 4, tn * 16 + fr, acc1, acc2);
    }
}


template <int MT, int NT, class Epi>
__device__ __forceinline__ void small_gemm_tile(const Ctx& C, const bf16_t* A, const bf16_t* Bt, int K, Epi epi) {
    constexpr int AR = MT * 16, BR = NT * 16, PITCH = 264, NA = AR * 32 / 512, NB = BR * 32 / 512;
    LAS bf16_t* As = (LAS bf16_t*)C.lds; LAS bf16_t* Bs = As + AR * PITCH;
    u32x4 ra[NA], rb[NB];
    auto fetch = [&](int k0) {
#pragma unroll
        for (int i = 0; i < NA; ++i) { const int e = C.tid + 512 * i; ra[i] = *(const u32x4*)(A + (size_t)(e >> 5) * K + k0 + (e & 31) * 8); }
#pragma unroll
        for (int i = 0; i < NB; ++i) { const int e = C.tid + 512 * i; rb[i] = *(const u32x4*)(Bt + (size_t)(e >> 5) * K + k0 + (e & 31) * 8); } };
    const int fr = C.lane & 15, fq = C.lane >> 4;
    constexpr int TPW = (MT * NT + 7) / 8;
    f32x4 acc[TPW];
#pragma unroll
    for (int i = 0; i < TPW; ++i) acc[i] = (f32x4){0.f, 0.f, 0.f, 0.f};
    fetch(0);
    for (int k0 = 0; k0 < K; k0 += 256) {
        __syncthreads();
#pragma unroll
        for (int i = 0; i < NA; ++i) { const int e = C.tid + 512 * i; *(LAS u32x4*)(As + (e >> 5) * PITCH + (e & 31) * 8) = ra[i]; }
#pragma unroll
        for (int i = 0; i < NB; ++i) { const int e = C.tid + 512 * i; *(LAS u32x4*)(Bs + (e >> 5) * PITCH + (e & 31) * 8) = rb[i]; }
        if (k0 + 256 < K) fetch(k0 + 256);
        __syncthreads();
#pragma unroll
        for (int i = 0; i < TPW; ++i) { const int tt = C.wid + 8 * i; if (tt < MT * NT) { const int tm = tt / NT, tn = tt % NT;
#pragma unroll
            for (int ks = 0; ks < 8; ++ks) acc[i] = __builtin_amdgcn_mfma_f32_16x16x32_bf16(*(const LAS bf16x8*)(As + (tm * 16 + fr) * PITCH + ks * 32 + fq * 8),
                                                                                           *(const LAS bf16x8*)(Bs + (tn * 16 + fr) * PITCH + ks * 32 + fq * 8), acc[i], 0, 0, 0); } }
    }
#pragma unroll
    for (int i = 0; i < TPW; ++i) { const int tt = C.wid + 8 * i; if (tt < MT * NT) epi((tt / NT) * 16 + fq * 4, (tt % NT) * 16 + fr, acc[i]); }
    __syncthreads();
}

__device__ __forceinline__ void transpose_item(const float* W, int K, int N, int nblk, bf16_t* WT, LAS float* scr, int item, int lane) {
    const int kb = item / nblk, nb = item % nblk, k0 = 64 * kb, n0 = 32 * nb;
    const int nn = n0 + (lane & 31);
#pragma unroll 8
    for (int i = 0; i < 32; ++i) { const int kk = 2 * i + (lane >> 5); scr[kk * 33 + (lane & 31)] = (nn < N) ? W[(size_t)(k0 + kk) * N + nn] : 0.f; }
    asm volatile("s_waitcnt lgkmcnt(0)" ::: "memory");
    const int c = lane & 7;
#pragma unroll
    for (int j = 0; j < 4; ++j) { const int n = (lane >> 3) + 8 * j; const LAS float* s = scr + (8 * c) * 33 + n;
        u32x4 o; o.x = pk2(s[0 * 33], s[1 * 33]); o.y = pk2(s[2 * 33], s[3 * 33]); o.z = pk2(s[4 * 33], s[5 * 33]); o.w = pk2(s[6 * 33], s[7 * 33]);
        *(u32x4*)(WT + (size_t)(n0 + n) * K + k0 + 8 * c) = o; }
    asm volatile("s_waitcnt lgkmcnt(0)" ::: "memory");
}
__device__ __forceinline__ float wave_maxf(float v) {
#pragma unroll
    for (int o = 1; o < 64; o <<= 1) v = fmaxf(v, __shfl_xor(v, o));
    return v;
}
__device__ __forceinline__ void convert_tables(const Ctx& C, int layer, int rank, int nrank) {
    const float* U = C.in[39] + (size_t)layer * NEXP * DM; const float* V = C.in[40] + (size_t)layer * NEXP * DM;
    unsigned char* UB = C.ws + WS_UB; unsigned char* VB = C.ws + WS_VB; float* SU = (float*)(C.ws + WS_SU); float* SV = (float*)(C.ws + WS_SV);
    for (int r4 = (rank * 8 + C.wid) * 2; r4 < 2 * NEXP; r4 += nrank * 8 * 2) {
        const bool isv = r4 >= NEXP; const int row0 = isv ? r4 - NEXP : r4;
        const float* src = (isv ? V : U) + (size_t)row0 * DM + 16 * C.lane;
        f32x4 x[2][4];
#pragma unroll
        for (int q = 0; q < 2; ++q)
#pragma unroll
            for (int k = 0; k < 4; ++k) x[q][k] = *(const f32x4*)(src + (size_t)q * DM + 4 * k);
#pragma unroll
        for (int q = 0; q < 2; ++q) {
            float m = 0.f;
#pragma unroll
            for (int k = 0; k < 4; ++k) m = fmaxf(fmaxf(m, fmaxf(fabsf(x[q][k].x), fabsf(x[q][k].y))), fmaxf(fabsf(x[q][k].z), fabsf(x[q][k].w)));
            m = wave_maxf(m);
            const float sc = m > 0.f ? 224.f / m : 1.f;
            u32x4 o;
#pragma unroll
            for (int k = 0; k < 4; ++k) { int w = __builtin_amdgcn_cvt_pk_fp8_f32(x[q][k].x * sc, x[q][k].y * sc, 0, false); w = __builtin_amdgcn_cvt_pk_fp8_f32(x[q][k].z * sc, x[q][k].w * sc, w, true); o[k] = (unsigned)w; }
            *(u32x4*)((isv ? VB : UB) + (size_t)(row0 + q) * DM + 16 * C.lane) = o;
            if (C.lane == 0) (isv ? SV : SU)[row0 + q] = m > 0.f ? m * (1.f / 224.f) : 1.f;
        }
    }
}
__device__ __forceinline__ void ph_prologue(const Ctx& C) {
    const int gw = C.bid * 8 + C.wid, NGW = C.G * 8;
    {
        LAS float* scr = (LAS float*)(C.lds + C.wid * 16384);
        bf16_t* WIN = (bf16_t*)(C.ws + WS_WIN); bf16_t* WOUT = (bf16_t*)(C.ws + WS_WOUT); bf16_t* WQ = (bf16_t*)(C.ws + WS_WQ);
        for (int it = gw; it < 6400; it += NGW) {
            const int layer = it / 3200; int r = it % 3200;
            if (r < 1664) { transpose_item(C.in[8] + (size_t)layer * DM * INC, DM, INC, 104, WIN + (size_t)layer * NP * DM, scr, r, C.lane); continue; } r -= 1664;
            if (r < 512) { transpose_item(C.in[9] + (size_t)layer * DM * DM, DM, DM, 32, WOUT + (size_t)layer * DM * DM, scr, r, C.lane); continue; } r -= 512;
            transpose_item(C.in[36] + (size_t)layer * DM * 2048, DM, 2048, 64, WQ + (size_t)layer * 2048 * DM, scr, r, C.lane);
        }
    }
    __syncthreads();
    {
        LAS float* sv = (LAS float*)C.lds;
        LAS float* red = (LAS float*)(C.lds + 12288);
        for (int i = C.tid; i < 3 * 1024; i += 512) { const int w = i >> 10, k = i & 1023; const float x = (w < 2) ? C.in[1][w * 1024 + k] : C.in[3][k]; sv[i] = silu(x); }
        __syncthreads();
        float* MOD = (float*)(C.ws + WS_MOD);
        for (int it = C.bid; it < 192; it += C.G) {
            const int layer = it / 96, col0 = (it % 96) * 64, col = C.tid & 63, kg = C.tid >> 6;
            const float* W = C.in[4] + (size_t)layer * DM * 6144 + col0 + col;
            float a0 = 0.f, a1 = 0.f, a2 = 0.f;
#pragma unroll 32
            for (int k = kg * 128; k < kg * 128 + 128; ++k) { const float w = W[(size_t)k * 6144]; a0 += sv[k] * w; a1 += sv[1024 + k] * w; a2 += sv[2048 + k] * w; }
            red[(kg * 3 + 0) * 64 + col] = a0; red[(kg * 3 + 1) * 64 + col] = a1; red[(kg * 3 + 2) * 64 + col] = a2;
            __syncthreads();
            if (C.tid < 192) { const int w = C.tid >> 6, c2 = C.tid & 63; float s = 0.f;
#pragma unroll
                for (int g = 0; g < 8; ++g) s += red[(g * 3 + w) * 64 + c2];
                MOD[((size_t)layer * 3 + w) * 6144 + col0 + c2] = s + C.in[5][layer * 6144 + col0 + c2]; }
            __syncthreads();
        }
    }
    {
        float* H = (float*)(C.ws + WS_H);
        const size_t n4 = (size_t)NROW * 256;
        for (size_t i = (size_t)C.bid * 512 + C.tid; i < n4; i += (size_t)C.G * 512) {
            const int row = (int)(i >> 8), c4 = (int)(i & 255) * 4;
            f32x4 v;
            if (row < NLAT) {
                v = *(const f32x4*)(C.in[0] + (size_t)row * DM + c4);
                const int t = row & 8191, quarter = c4 >> 8; const float pos = (quarter < 2) ? (float)(t >> 6) : (float)(t & 63);
                float e[4];
#pragma unroll
                for (int j = 0; j < 4; ++j) { const int jj = (c4 & 255) + j; const float fr = exp2f(-(float)jj * (13.287712379549449f / 256.f)); const float a = pos * fr; e[j] = (quarter & 1) ? cosf(a) : sinf(a); }
                v.x += e[0]; v.y += e[1]; v.z += e[2]; v.w += e[3];
            } else v = *(const f32x4*)(C.in[2] + (size_t)(row - NLAT) * DM + c4);
            *(f32x4*)(H + (size_t)row * DM + c4) = v;
        }
    }
}

struct Row16 { float v[16]; };
__device__ __forceinline__ Row16 load_row16(const float* p, int lane) {
    Row16 r; const f32x4 a = *(const f32x4*)(p + 8 * lane), b = *(const f32x4*)(p + 8 * lane + 4), c = *(const f32x4*)(p + 512 + 8 * lane), d = *(const f32x4*)(p + 512 + 8 * lane + 4);
    r.v[0] = a.x; r.v[1] = a.y; r.v[2] = a.z; r.v[3] = a.w; r.v[4] = b.x; r.v[5] = b.y; r.v[6] = b.z; r.v[7] = b.w;
    r.v[8] = c.x; r.v[9] = c.y; r.v[10] = c.z; r.v[11] = c.w; r.v[12] = d.x; r.v[13] = d.y; r.v[14] = d.z; r.v[15] = d.w; return r;
}
__device__ __forceinline__ void store_row16_f32(float* p, int lane, const Row16& r) {
    *(f32x4*)(p + 8 * lane) = (f32x4){r.v[0], r.v[1], r.v[2], r.v[3]}; *(f32x4*)(p + 8 * lane + 4) = (f32x4){r.v[4], r.v[5], r.v[6], r.v[7]};
    *(f32x4*)(p + 512 + 8 * lane) = (f32x4){r.v[8], r.v[9], r.v[10], r.v[11]}; *(f32x4*)(p + 512 + 8 * lane + 4) = (f32x4){r.v[12], r.v[13], r.v[14], r.v[15]};
}
__device__ __forceinline__ void store_row16_bf16(bf16_t* p, int lane, const Row16& r) {
    u32x4 a, b; a.x = pk2(r.v[0], r.v[1]); a.y = pk2(r.v[2], r.v[3]); a.z = pk2(r.v[4], r.v[5]); a.w = pk2(r.v[6], r.v[7]);
    b.x = pk2(r.v[8], r.v[9]); b.y = pk2(r.v[10], r.v[11]); b.z = pk2(r.v[12], r.v[13]); b.w = pk2(r.v[14], r.v[15]);
    *(u32x4*)(p + 8 * lane) = a; *(u32x4*)(p + 512 + 8 * lane) = b;
}
__device__ __forceinline__ Row16 norm_mod_row(const Row16& x, const float* g, const float* shift, const float* scale, int lane) {
    float ss = 0.f;
#pragma unroll
    for (int i = 0; i < 16; ++i) ss += x.v[i] * x.v[i];
    const float rs = rsqrtf(wave_sum(ss) * (1.f / 1024.f) + 1e-6f);
    const Row16 gg = load_row16(g, lane), sh = load_row16(shift, lane), sc = load_row16(scale, lane);
    Row16 o;
#pragma unroll
    for (int i = 0; i < 16; ++i) o.v[i] = (x.v[i] * rs * gg.v[i]) * (1.f + sc.v[i]) + sh.v[i];
    return o;
}
__device__ __forceinline__ int which_of(int row) { return row < 8192 ? 0 : (row < NLAT ? 1 : 2); }
__device__ __forceinline__ void ph_norm(const Ctx& C, int layer, const float* gain, int sidx, int nrows) {
    const float* H = (const float*)(C.ws + WS_H); bf16_t* ACT = (bf16_t*)(C.ws + WS_ACT); const float* MOD = (const float*)(C.ws + WS_MOD);
    for (int row = C.bid * 8 + C.wid; row < nrows; row += C.G * 8) {
        const float* m = MOD + ((size_t)layer * 3 + which_of(row)) * 6144;
        const Row16 x = load_row16(H + (size_t)row * DM, C.lane);
        const Row16 o = norm_mod_row(x, gain, m + sidx * 1024, m + (sidx + 1) * 1024, C.lane);
        store_row16_bf16(ACT + (size_t)row * DM, C.lane, o);
    }
}
struct EpiResid {
    static constexpr bool PERM = false, AFTER_DRAIN = false;
    float* H; const float* modl;
    __device__ __forceinline__ void operator()(const f32x4 (&acc)[2][2][4][2], const pg8::Unit& u, int wr, int wc, int fr, int fq) const {
        const int row0 = u.pm * 256 + wr * 64 + fr, col0 = u.pn * 256 + wc * 32 + 4 * fq;
        const int which = u.pm < 32 ? 0 : (u.pm < 64 ? 1 : 2);
        const float* gate = modl + ((size_t)which * 6 + 2) * 1024;
        f32x4 gv[2][2];
#pragma unroll
        for (int bj = 0; bj < 2; ++bj)
#pragma unroll
            for (int n = 0; n < 2; ++n) gv[bj][n] = *(const f32x4*)(gate + col0 + bj * 128 + n * 16);
#pragma unroll
        for (int ai = 0; ai < 2; ++ai)
#pragma unroll
            for (int m = 0; m < 4; ++m) { float* rowp = H + (size_t)(row0 + ai * 128 + m * 16) * DM + col0;
#pragma unroll
                for (int bj = 0; bj < 2; ++bj)
#pragma unroll
                    for (int n = 0; n < 2; ++n) { f32x4* p = (f32x4*)(rowp + bj * 128 + n * 16); *p = *p + gv[bj][n] * acc[ai][bj][m][n]; } }
    }
};

__device__ __forceinline__ void item_conformer(const Ctx& C, int layer, int gc) {
    const ChunkInfo ci = chunk_info(gc);
    const bf16_t* P = (const bf16_t*)(C.ws + WS_P); bf16_t* YC = (bf16_t*)(C.ws + WS_ACT);
    LAS bf16_t* HG = (LAS bf16_t*)C.lds;
    LAS float* CO = (LAS float*)(C.lds + 49152);
    for (int e = C.tid; e < 94 * 128; e += 512) {
        const int rr = e >> 7, cp = e & 127, grow = ci.row0 - 15 + rr;
        const bool ok = grow >= ci.lo && grow < ci.hi; const int gr = ok ? grow : ci.row0;
        const unsigned v = *(const unsigned*)(P + (size_t)gr * NP + 2 * cp), g = *(const unsigned*)(P + (size_t)gr * NP + 256 + 2 * cp);
        const unsigned o = pk2(bflo(v) * sigm(bflo(g)), bfhi(v) * sigm(bfhi(g)));
        *(LAS unsigned*)(HG + rr * 256 + 2 * cp) = ok ? o : 0u;
    }
    __syncthreads();
    {
        const int c = C.tid & 255, half = C.tid >> 8;
        const float* cw = C.in[10] + (size_t)layer * 31 * 256 + c;
        float w[31];
#pragma unroll
        for (int j = 0; j < 31; ++j) w[j] = cw[j * 256];
        const float bias = C.in[11][layer * 256 + c];
        for (int tt = 0; tt < 32; ++tt) {
            const int t = half * 32 + tt; float acc = bias;
#pragma unroll
            for (int j = 0; j < 31; ++j) acc += w[j] * bf2f(HG[(t + j) * 256 + c]);
            CO[t * 256 + c] = acc;
        }
    }
    __syncthreads();
    {
        const float* lg = C.in[12] + layer * 256 + 4 * C.lane; const float* lb = C.in[13] + layer * 256 + 4 * C.lane;
        const f32x4 g4 = *(const f32x4*)lg, b4 = *(const f32x4*)lb;
        for (int i = 0; i < 8; ++i) {
            const int t = C.wid * 8 + i;
            const f32x4 x = *(const LAS f32x4*)(CO + t * 256 + 4 * C.lane);
            const float mean = wave_sum((x.x + x.y) + (x.z + x.w)) * (1.f / 256.f);
            const f32x4 d = x - mean;
            const float var = wave_sum((d.x * d.x + d.y * d.y) + (d.z * d.z + d.w * d.w)) * (1.f / 256.f);
            const float rs = rsqrtf(var + 1e-5f);
            const f32x4 y = d * rs * g4 + b4;
            u32x2 o; o.x = pk2(silu(y.x), silu(y.y)); o.y = pk2(silu(y.z), silu(y.w));
            *(u32x2*)(YC + (size_t)(ci.row0 + t) * DM + 4 * C.lane) = o;
        }
    }
    __syncthreads();
}

__device__ __forceinline__ void item_chunkmlp(const Ctx& C, int layer, int gb) {
    const int row0 = gb * 128;
    const bf16_t* P = (const bf16_t*)(C.ws + WS_P); bf16_t* YC = (bf16_t*)(C.ws + WS_ACT);
    LAS bf16_t* VNT = (LAS bf16_t*)C.lds;
    LAS bf16_t* WS = (LAS bf16_t*)(C.lds + 69632);
    {
        const f32x4 g4 = *(const f32x4*)(C.in[14] + layer * 256 + 4 * C.lane), b4 = *(const f32x4*)(C.in[15] + layer * 256 + 4 * C.lane);
        for (int i = 0; i < 16; ++i) {
            const int j = C.wid * 16 + i;
            const u32x2 raw = *(const u32x2*)(P + (size_t)(row0 + j) * NP + 768 + 4 * C.lane);
            const f32x4 x = {bflo(raw.x), bfhi(raw.x), bflo(raw.y), bfhi(raw.y)};
            const float mean = wave_sum((x.x + x.y) + (x.z + x.w)) * (1.f / 256.f);
            const f32x4 d = x - mean;
            const float var = wave_sum((d.x * d.x + d.y * d.y) + (d.z * d.z + d.w * d.w)) * (1.f / 256.f);
            const f32x4 y = d * rsqrtf(var + 1e-5f) * g4 + b4;
            VNT[(4 * C.lane + 0) * 136 + j] = f2bf(y.x); VNT[(4 * C.lane + 1) * 136 + j] = f2bf(y.y);
            VNT[(4 * C.lane + 2) * 136 + j] = f2bf(y.z); VNT[(4 * C.lane + 3) * 136 + j] = f2bf(y.w);
        }
    }
    for (int h = 0; h < 4; ++h) {
        const float* ws = C.in[16] + ((size_t)layer * 4 + h) * 128 * 128;
        for (int e = C.tid; e < 4096; e += 512) { const int i = e >> 5, j4 = (e & 31) * 4; const f32x4 w = *(const f32x4*)(ws + i * 128 + j4);
            u32x2 o; o.x = pk2(w.x, w.y); o.y = pk2(w.z, w.w); *(LAS u32x2*)(WS + i * 136 + j4) = o; }
        __syncthreads();
        const float* bs = C.in[17] + ((size_t)layer * 4 + h) * 128;
        blk_mma<8, 4, 4>(WS, 136, VNT + h * 64 * 136, 136, C.wid, C.lane, [=](int r0, int col, const f32x4& acc) {
#pragma unroll
            for (int jj = 0; jj < 4; ++jj) { const int i = r0 + jj; const size_t row = (size_t)(row0 + i);
                const float u = bf2f(P[row * NP + 512 + h * 64 + col]);
                YC[row * DM + 256 + h * 64 + col] = f2bf((acc[jj] + bs[i]) * u); }
        });
        __syncthreads();
    }
}

__device__ __forceinline__ void item_mamba_local(const Ctx& C, int layer, int gc) {
    const ChunkInfo ci = chunk_info(gc);
    const bf16_t* P = (const bf16_t*)(C.ws + WS_P);
    bf16_t* MSTb = (bf16_t*)(C.ws + WS_MST); float* MCD = (float*)(C.ws + WS_MCD);
    LAS float* DA = (LAS float*)C.lds;
    LAS float* DT = (LAS float*)(C.lds + 2048);
    LAS float* FAC = (LAS float*)(C.lds + 4096);
    LAS bf16_t* XDT = (LAS bf16_t*)(C.lds + 8192);
    LAS bf16_t* BTT = (LAS bf16_t*)(C.lds + 8192 + 73728);
    {
        const int s = C.lane, dh = C.wid, d = dh >> 2, h = dh & 3;
        const float raw = bf2f(P[(size_t)(ci.row0 + s) * NP + OFF_C + 1024 + dh]);
        const float dt = softplus(raw + C.in[20][layer * 8 + dh]);
        const float da = dt * (-expf(C.in[21][layer * 8 + dh]));
        const float incl = wave_incl_scan(da, s), total = __shfl(incl, 63);
        DT[dh * 64 + s] = dt; DA[dh * 64 + s] = da;
        FAC[dh * 64 + s] = d ? fexp(incl - da) : fexp(total - incl);
        if (s == 0) MCD[slot_of(ci.b, h, d, cpos_of(ci, d))] = expf(total);
    }
    __syncthreads();
    {
        const int cp = C.tid & 255, half = C.tid >> 8, c0 = 2 * cp;
        const float* cw = C.in[18] + (size_t)layer * 5 * 768 + c0; const float* cb = C.in[19] + layer * 768 + c0;
        float w0[5], w1[5];
#pragma unroll
        for (int j = 0; j < 5; ++j) { w0[j] = cw[j * 768]; w1[j] = cw[j * 768 + 1]; }
        const float b0 = cb[0], b1 = cb[1];
        const int s0 = half * 32;
        unsigned win[5];
#pragma unroll
        for (int j = 0; j < 4; ++j) { const int row = ci.row0 + s0 - 2 + j; const bool ok = row >= ci.lo && row < ci.hi; const unsigned v = *(const unsigned*)(P + (size_t)(ok ? row : ci.row0) * NP + OFF_C + 256 + c0); win[j + 1] = ok ? v : 0u; }
        for (int tt = 0; tt < 32; ++tt) {
            const int s = s0 + tt;
#pragma unroll
            for (int j = 0; j < 4; ++j) win[j] = win[j + 1];
            { const int row = ci.row0 + s + 2; const bool ok = row >= ci.lo && row < ci.hi; const unsigned v = *(const unsigned*)(P + (size_t)(ok ? row : ci.row0) * NP + OFF_C + 256 + c0); win[4] = ok ? v : 0u; }
            float a0 = b0, a1 = b1;
#pragma unroll
            for (int j = 0; j < 5; ++j) { a0 += w0[j] * bflo(win[j]); a1 += w1[j] * bfhi(win[j]); }
            a0 = silu(a0); a1 = silu(a1);
            if (c0 < 256) { const int h = c0 >> 6;
#pragma unroll
                for (int d = 0; d < 2; ++d) { const float f = DT[(d * 4 + h) * 64 + s] * FAC[(d * 4 + h) * 64 + s];
                    XDT[(d * 256 + c0) * 72 + s] = f2bf(a0 * f); XDT[(d * 256 + c0 + 1) * 72 + s] = f2bf(a1 * f); }
            } else { const int q = c0 - 256; BTT[q * 72 + s] = f2bf(a0); BTT[(q + 1) * 72 + s] = f2bf(a1); }
        }
    }
    __syncthreads();
    for (int hd = 0; hd < 8; ++hd) {
        const int d = hd >> 2, h = hd & 3;
        bf16_t* dst = MSTb + (size_t)slot_of(ci.b, h, d, cpos_of(ci, d)) * 8192;
        blk_mma<8, 4, 2>(BTT + (h >> 1) * 128 * 72, 72, XDT + (d * 256 + h * 64) * 72, 72, C.wid, C.lane, [=](int r0, int col, const f32x4& acc) {
            u32x2 o; o.x = pk2(acc[0], acc[1]); o.y = pk2(acc[2], acc[3]); *(u32x2*)(dst + col * 128 + r0) = o;
        });
    }
    __syncthreads();
}


#ifndef MK_DIAG2
#define MK_DIAG2 0
#endif
#if MK_DIAG2
#define DBGF(stage, cond) do { if (cond) atomicOr((unsigned*)(C.ws + 32768) + (stage), 1u); } while (0)
#define DBGL(stage, cond) do { if (cond) atomicOr(dbgflags + (stage), 1u); } while (0)
#else
#define DBGF(stage, cond) do {} while (0)
#define DBGL(stage, cond) do {} while (0)
#endif
__device__ __forceinline__ bool badv(float x, float lim) { return !(fabsf(x) < lim); }
__device__ __forceinline__ void tri_inverse(const LAS float* ABf, LAS float* Tf, LAS float* Rt, LAS bf16_t* TT, int tid, int wid, int lane) {
    if (wid == 0) {
        const int bi = lane >> 4, j = lane & 15; const LAS float* Ab = ABf + (16 * bi) * 68 + 16 * bi;
        float col[16];
#pragma unroll
        for (int r = 0; r < 16; ++r) { float acc = (r == j) ? 1.f : 0.f;
#pragma unroll
            for (int s = 0; s < r; ++s) acc -= Ab[r * 68 + s] * col[s];
            col[r] = acc; }
#pragma unroll
        for (int r = 0; r < 16; ++r) Tf[(16 * bi + r) * 68 + 16 * bi + j] = col[r];
    } else {
        for (int e = tid - 64; e < 64 * 64; e += 448) { const int t = e >> 6, s2 = e & 63; if ((s2 >> 4) > (t >> 4)) Tf[t * 68 + s2] = 0.f; }
    }
    __syncthreads();
    if (wid < 3) {
        const int tn = wid, fr = lane & 15, fq = lane >> 4;
        LAS float* Rw = Rt + wid * 320;
        for (int i = tn + 1; i < 4; ++i) {
            f32x4 acc = {0.f, 0.f, 0.f, 0.f};
            for (int k = 16 * tn; k < 16 * i; k += 4) acc = __builtin_amdgcn_mfma_f32_16x16x4f32(ABf[(16 * i + fr) * 68 + k + fq], Tf[(k + fq) * 68 + 16 * tn + fr], acc, 0, 0, 0);
#pragma unroll
            for (int j = 0; j < 4; ++j) Rw[(fq * 4 + j) * 20 + fr] = -acc[j];
            asm volatile("s_waitcnt lgkmcnt(0)" ::: "memory");
            f32x4 t = {0.f, 0.f, 0.f, 0.f};
#pragma unroll
            for (int k = 0; k < 16; k += 4) t = __builtin_amdgcn_mfma_f32_16x16x4f32(Tf[(16 * i + fr) * 68 + 16 * i + k + fq], Rw[(k + fq) * 20 + fr], t, 0, 0, 0);
#pragma unroll
            for (int j = 0; j < 4; ++j) Tf[(16 * i + fq * 4 + j) * 68 + 16 * tn + fr] = t[j];
            asm volatile("s_waitcnt lgkmcnt(0)" ::: "memory");
        }
    }
    __syncthreads();
    for (int e = tid; e < 4096; e += 512) { const int t = e >> 6, s2 = e & 63; TT[t * 72 + s2] = f2bf(Tf[t * 68 + s2]); }
}
struct D1Pre { unsigned w[24]; unsigned lw[8]; int hd; };
__device__ __forceinline__ void d1_load_rows(const Ctx& C, int it, unsigned (&w)[24]) {
    const int gc = it >> 3, hd = it & 7, h = hd & 3, d = hd >> 2;
    const ChunkInfo ci = chunk_info(gc);
    const bf16_t* P = (const bf16_t*)(C.ws + WS_P);
    if (C.tid < 480) {
        const int q = C.tid % 160, seg = C.tid / 160, grp = q >> 5, c = (q & 31) * 2;
        const int j = (grp == 0 ? h * 64 : grp == 1 ? 256 + h * 64 : grp == 2 ? 512 + h * 64 : grp == 3 ? 768 + d * 64 : 896 + d * 64) + c;
        const int t0 = seg * 22, nt = seg == 2 ? 20 : 22;
        const bf16_t* pp = P + (size_t)(ci.row0 + t0) * NP + OFF_D + j;
#pragma unroll
        for (int i = 0; i < 24; ++i) { const int row = ci.row0 + t0 - 1 + i; const bool ok = row >= ci.lo && row < ci.hi; const int rc = ok ? row : ci.row0;
            const unsigned v = (i < nt + 2) ? *(const unsigned*)(pp + (ptrdiff_t)(rc - (ci.row0 + t0)) * NP) : 0u; w[i] = ok ? v : 0u; }
    }
}
constexpr int D1_LW = 0, D1_CS = 17408, D1_AA = 34816, D1_RB = 52224, D1_KB = 61440, D1_VB = 70656, D1_TW = 79872, D1_AD = 89088, D1_W2T = 98304, D1_A2T = 107520;
constexpr int D1_Y = 82944;
constexpr int D1_ABF = 0, D1_AK = 17408, D1_ARK = 26624, D1_ARB = 35840, D1_TT = 45056, D1_W1T = 54272, D1_AKVT = 63488, D1_W2TT = 72704;
constexpr int D1_GL = 156672;
__device__ __forceinline__ void item_rwkv_local(const Ctx& C0_, int layer, int it, D1Pre& pre, int it_next) {
    Ctx C = C0_; { int t_ = C0_.tid; asm volatile("" : "+v"(t_)); C.tid = t_; C.lane = t_ & 63; C.wid = __builtin_amdgcn_readfirstlane(t_ >> 6); }
#define D1_RELAUNDER() do { int t_ = C.tid; asm volatile("" : "+v"(t_)); C.tid = t_; C.lane = t_ & 63; C.wid = __builtin_amdgcn_readfirstlane(t_ >> 6); } while (0)
    const int gc = it >> 3, hd = it & 7, h = hd & 3, d = hd >> 2;
    const ChunkInfo ci = chunk_info(gc);
    const int slot = slot_of(ci.b, h, d, cpos_of(ci, d));
    const bf16_t* P = (const bf16_t*)(C.ws + WS_P);
    const float* mup = C.in[24] + layer * 1152; const float* mun = C.in[25] + layer * 1152;
    lds_t L = C.lds;
    LAS float* LW = (LAS float*)(L + D1_LW); LAS float* CS = (LAS float*)(L + D1_CS); LAS float* AA = (LAS float*)(L + D1_AA); LAS float* GL = (LAS float*)(L + D1_GL);
    LAS bf16_t* Rb = (LAS bf16_t*)(L + D1_RB); LAS bf16_t* Kb = (LAS bf16_t*)(L + D1_KB); LAS bf16_t* Vb = (LAS bf16_t*)(L + D1_VB);
    LAS bf16_t* TW = (LAS bf16_t*)(L + D1_TW); LAS bf16_t* AD = (LAS bf16_t*)(L + D1_AD); LAS bf16_t* W2T = (LAS bf16_t*)(L + D1_W2T); LAS bf16_t* A2T = (LAS bf16_t*)(L + D1_A2T);
    LAS bf16_t* KT = (LAS bf16_t*)(L + D1_Y); LAS bf16_t* KTt = KT + 4608; LAS bf16_t* KD = KT + 2 * 4608; LAS bf16_t* KDt = KT + 3 * 4608;
    LAS bf16_t* BT = KT + 4 * 4608; LAS bf16_t* BTt = KT + 5 * 4608; LAS bf16_t* RT = KT + 6 * 4608; LAS bf16_t* Vt = KT + 7 * 4608;
    LAS float* ABf = (LAS float*)(L + D1_ABF); LAS bf16_t* AK = (LAS bf16_t*)(L + D1_AK); LAS bf16_t* ARK = (LAS bf16_t*)(L + D1_ARK); LAS bf16_t* ARB = (LAS bf16_t*)(L + D1_ARB);
    LAS bf16_t* TT = (LAS bf16_t*)(L + D1_TT); LAS bf16_t* W1t = (LAS bf16_t*)(L + D1_W1T); LAS bf16_t* AKVt = (LAS bf16_t*)(L + D1_AKVT); LAS bf16_t* W2t = (LAS bf16_t*)(L + D1_W2TT);

    if (C.tid < 480) {
        const int q = C.tid % 160, seg = C.tid / 160, grp = q >> 5, c = (q & 31) * 2;
        const int j = (grp == 0 ? h * 64 : grp == 1 ? 256 + h * 64 : grp == 2 ? 512 + h * 64 : grp == 3 ? 768 + d * 64 : 896 + d * 64) + c;
        const int t0 = seg * 22, nt = seg == 2 ? 20 : 22;
        const float mp0 = mup[j], mp1 = mup[j + 1], mn0 = mun[j], mn1 = mun[j + 1];
        unsigned w[24]; { const bf16_t* pp = P + (size_t)(ci.row0 + t0) * NP + OFF_D + j;
#pragma unroll
        for (int i = 0; i < 24; ++i) { const int row = ci.row0 + t0 - 1 + i; const bool ok = row >= ci.lo && row < ci.hi; const int rc = ok ? row : ci.row0;
            const unsigned v = (i < nt + 2) ? *(const unsigned*)(pp + (ptrdiff_t)(rc - (ci.row0 + t0)) * NP) : 0u; w[i] = ok ? v : 0u; } }
        LAS bf16_t* dst = (grp == 0 ? Rb : grp == 1 ? Kb : grp == 2 ? Vb : grp == 3 ? TW : AD);
#pragma unroll
        for (int i = 0; i < 22; ++i) if (i < nt) {
            const float x0 = bflo(w[i + 1]), x1 = bfhi(w[i + 1]);
            const float v0 = x0 + mp0 * (bflo(w[i]) - x0) + mn0 * (bflo(w[i + 2]) - x0);
            const float v1 = x1 + mp1 * (bfhi(w[i]) - x1) + mn1 * (bfhi(w[i + 2]) - x1);
            DBGF(1, badv(v0, 1e4f) || badv(v1, 1e4f));
            const unsigned o = (grp == 3) ? pk2(ftanh(v0), ftanh(v1)) : pk2(v0, v1);
            const int tl = t0 + i, l = d ? 63 - tl : tl;
            *(LAS unsigned*)(dst + l * 72 + c) = o;
        }
    }
    {
        if (pre.hd != hd) {
            const float* w2 = C.in[27] + ((size_t)layer * 2 + d) * 64 * 256 + h * 64; const float* a2 = C.in[29] + ((size_t)layer * 2 + d) * 64 * 256 + h * 64;
#pragma unroll
            for (int k = 0; k < 8; ++k) { const int e = C.tid + 512 * k, r = e >> 6, c = e & 63; pre.lw[k] = pk2(w2[r * 256 + c], a2[r * 256 + c]); }
            pre.hd = hd;
        }
#pragma unroll
        for (int k = 0; k < 8; ++k) { const int e = C.tid + 512 * k, r = e >> 6, c = e & 63; W2T[c * 72 + r] = (unsigned short)(pre.lw[k] & 0xffffu); A2T[c * 72 + r] = (unsigned short)(pre.lw[k] >> 16); }
    }
    __syncthreads();
    D1_RELAUNDER();
    {
        unsigned* dbgflags = (unsigned*)(C.ws + 32768); (void)dbgflags;
        const float* w0 = C.in[26] + ((size_t)layer * 2 + d) * 256 + h * 64; const float* a0 = C.in[28] + ((size_t)layer * 2 + d) * 256 + h * 64;
        blk_mma<4, 4, 2>(TW, 72, W2T, 72, C.wid, C.lane, [=](int r0, int col, const f32x4& acc) {
#pragma unroll
            for (int jj = 0; jj < 4; ++jj) { const float w = w0[col] + acc[jj]; DBGL(2, badv(w, 1e4f)); LW[(r0 + jj) * 68 + col] = -fexp(-softplus(-w) - 0.5f); }
        });
        blk_mma<4, 4, 2>(AD, 72, A2T, 72, C.wid, C.lane, [=](int r0, int col, const f32x4& acc) {
#pragma unroll
            for (int jj = 0; jj < 4; ++jj) { DBGL(2, badv(acc[jj], 1e4f)); AA[(r0 + jj) * 68 + col] = sigm(a0[col] + acc[jj]); }
        });
    }
    __syncthreads();
    {
#pragma unroll
        for (int i = 0; i < 8; ++i) { const int c = C.wid * 8 + i; const float incl = wave_incl_scan(LW[C.lane * 68 + c], C.lane); CS[C.lane * 68 + c] = incl; if (C.lane == 63) GL[c] = fexp(incl); }
    }
    __syncthreads();
    D1_RELAUNDER();
    {
        const int l = C.tid >> 3, sub = C.tid & 7;
        const float* kkw = C.in[31] + layer * 256 + h * 64; const float* kaw = C.in[32] + layer * 256 + h * 64; const float* rkw = C.in[33] + layer * 256 + h * 64;
        float kk[8], kdv[8], aa[8], rr[8], vv[8]; float ss = 0.f, bon = 0.f;
#pragma unroll
        for (int i = 0; i < 8; ++i) { const int c = sub * 8 + i; const float k = bf2f(Kb[l * 72 + c]); rr[i] = bf2f(Rb[l * 72 + c]); vv[i] = bf2f(Vb[l * 72 + c]); aa[i] = AA[l * 68 + c];
            kk[i] = k * kkw[c]; ss += kk[i] * kk[i]; kdv[i] = k * (1.f + (aa[i] - 1.f) * kaw[c]); bon += rr[i] * kdv[i] * rkw[c]; }
        ss += __shfl_xor(ss, 1); ss += __shfl_xor(ss, 2); ss += __shfl_xor(ss, 4);
        bon += __shfl_xor(bon, 1); bon += __shfl_xor(bon, 2); bon += __shfl_xor(bon, 4);
        const float inv = rsqrtf(ss + 1e-12f);
        if (sub == 0) ((float*)(C.ws + WS_BON))[(size_t)(ci.row0 + (d ? 63 - l : l)) * 8 + h * 2 + d] = bon;
        unsigned short kt[8], kd[8], bt[8], rt[8];
#pragma unroll
        for (int i = 0; i < 8; ++i) { const int c = sub * 8 + i; const float cs = CS[l * 68 + c], lw = LW[l * 68 + c];
            const float ge = fexp(cs - lw), gi = fexp(cs), gn = fexp(-cs); const float kkn = kk[i] * inv;
            DBGF(3, badv(cs, 50.f) || cs > 0.f || badv(lw, 1.f)); DBGF(4, badv(kkn * ge, 10.f) || badv(rr[i] * gi, 1e4f) || badv(vv[i], 1e4f)); DBGF(5, badv(kdv[i] * gn, 1e25f) || badv(kkn * aa[i] * gn, 1e25f));
            kt[i] = f2bf(kkn * ge); kd[i] = f2bf(kdv[i] * gn); bt[i] = f2bf(kkn * aa[i] * gn); rt[i] = f2bf(rr[i] * gi);
            KTt[c * 72 + l] = kt[i]; KDt[c * 72 + l] = kd[i]; BTt[c * 72 + l] = bt[i]; Vt[c * 72 + l] = f2bf(vv[i]); }
#define D1_PACK8(a) (u32x4){(unsigned)a[0] | ((unsigned)a[1] << 16), (unsigned)a[2] | ((unsigned)a[3] << 16), (unsigned)a[4] | ((unsigned)a[5] << 16), (unsigned)a[6] | ((unsigned)a[7] << 16)}
        *(LAS u32x4*)(KT + l * 72 + sub * 8) = D1_PACK8(kt); *(LAS u32x4*)(KD + l * 72 + sub * 8) = D1_PACK8(kd);
        *(LAS u32x4*)(BT + l * 72 + sub * 8) = D1_PACK8(bt); *(LAS u32x4*)(RT + l * 72 + sub * 8) = D1_PACK8(rt);
#undef D1_PACK8
    }
    __syncthreads();
    D1_RELAUNDER();
    unsigned* dbgflags = (unsigned*)(C.ws + 32768); (void)dbgflags;
    blk_mma2<4, 4, 2>(BT, KT, KD, KT, 72, C.wid, C.lane, [=](int r0, int col, const f32x4& ab, const f32x4& ak) {
        f32x4 a; float k[4];
#pragma unroll
        for (int jj = 0; jj < 4; ++jj) { const bool lo = r0 + jj < col; DBGL(6, lo && (badv(ab[jj], 1e3f) || badv(ak[jj], 1e4f))); a[jj] = lo ? ab[jj] : 0.f; k[jj] = lo ? ak[jj] : 0.f; }
        *(LAS f32x4*)(ABf + col * 68 + r0) = a;
        u32x2 o; o.x = pk2(k[0], k[1]); o.y = pk2(k[2], k[3]); *(LAS u32x2*)(AK + col * 72 + r0) = o;
    });
    blk_mma2<4, 4, 2>(KD, RT, BT, RT, 72, C.wid, C.lane, [=](int r0, int col, const f32x4& rk, const f32x4& rb) {
        float a[4], b[4];
#pragma unroll
        for (int jj = 0; jj < 4; ++jj) { const bool le = r0 + jj <= col; DBGL(7, le && (badv(rk[jj], 1e5f) || badv(rb[jj], 1e5f))); a[jj] = le ? rk[jj] : 0.f; b[jj] = le ? rb[jj] : 0.f; }
        u32x2 oa, ob; oa.x = pk2(a[0], a[1]); oa.y = pk2(a[2], a[3]); ob.x = pk2(b[0], b[1]); ob.y = pk2(b[2], b[3]);
        *(LAS u32x2*)(ARK + col * 72 + r0) = oa; *(LAS u32x2*)(ARB + col * 72 + r0) = ob;
    });
    __syncthreads();
    tri_inverse(ABf, (LAS float*)(L + 54272), (LAS float*)(L + 71680), TT, C.tid, C.wid, C.lane);
    __syncthreads();
#if MK_DIAG2
    for (int e = C.tid; e < 4096; e += 512) DBGF(8, badv(bf2f(TT[(e >> 6) * 72 + (e & 63)]), 1e3f));
#endif
    D1_RELAUNDER();
    blk_mma2<4, 4, 2>(TT, KTt, AK, Vt, 72, C.wid, C.lane, [=](int r0, int col, const f32x4& w1, const f32x4& akv) {
        DBGL(9, badv(w1[0], 1e3f) || badv(w1[1], 1e3f) || badv(w1[2], 1e3f) || badv(w1[3], 1e3f)); DBGL(10, badv(akv[0], 1e5f) || badv(akv[1], 1e5f) || badv(akv[2], 1e5f) || badv(akv[3], 1e5f));
        u32x2 a, b; a.x = pk2(w1[0], w1[1]); a.y = pk2(w1[2], w1[3]); b.x = pk2(akv[0], akv[1]); b.y = pk2(akv[2], akv[3]);
        *(LAS u32x2*)(W1t + col * 72 + r0) = a; *(LAS u32x2*)(AKVt + col * 72 + r0) = b;
    });
    __syncthreads();
    blk_mma<4, 4, 2>(TT, 72, AKVt, 72, C.wid, C.lane, [=](int r0, int col, const f32x4& w2) {
        DBGL(11, badv(w2[0], 1e5f) || badv(w2[1], 1e5f) || badv(w2[2], 1e5f) || badv(w2[3], 1e5f));
        u32x2 a; a.x = pk2(w2[0], w2[1]); a.y = pk2(w2[2], w2[3]); *(LAS u32x2*)(W2t + col * 72 + r0) = a;
    });
    __syncthreads();
    D1_RELAUNDER();
    {
        bf16_t* Gg = (bf16_t*)(C.ws + WS_RG) + (size_t)slot * 4096; bf16_t* Jg = (bf16_t*)(C.ws + WS_RJ) + (size_t)slot * 4096;
        bf16_t* Ryg = (bf16_t*)(C.ws + WS_RY) + (size_t)slot * 4096; bf16_t* Ylg = (bf16_t*)(C.ws + WS_RL) + (size_t)slot * 4096;
        blk_mma2<4, 4, 2>(W1t, BTt, W1t, ARB, 72, C.wid, C.lane, [=](int r0, int col, const f32x4& gp, const f32x4& rbw) {
            const float gl = GL[col]; float g[4], ry[4];
            const u32x2 rt = *(const LAS u32x2*)(RT + col * 72 + r0);
            const float rtv[4] = {bflo(rt.x), bfhi(rt.x), bflo(rt.y), bfhi(rt.y)};
#pragma unroll
            for (int jj = 0; jj < 4; ++jj) { g[jj] = gl * ((col == r0 + jj ? 1.f : 0.f) - gp[jj]); ry[jj] = rtv[jj] - rbw[jj]; }
            u32x2 og, oy; og.x = pk2(g[0], g[1]); og.y = pk2(g[2], g[3]); oy.x = pk2(ry[0], ry[1]); oy.y = pk2(ry[2], ry[3]);
            *(u32x2*)(Gg + col * 64 + r0) = og;
            *(u32x2*)(Ryg + col * 64 + r0) = oy;
        });
        blk_mma2<4, 4, 2>(KDt, Vt, BTt, W2t, 72, C.wid, C.lane, [=](int r0, int col, const f32x4& kv, const f32x4& bw) {
            f32x4 o;
#pragma unroll
            for (int jj = 0; jj < 4; ++jj) { o[jj] = GL[r0 + jj] * (kv[jj] - bw[jj]); DBGL(12, badv(GL[r0 + jj] * kv[jj], 1e5f)); DBGL(13, badv(GL[r0 + jj] * bw[jj], 1e5f)); DBGL(14, badv(o[jj], 1e5f)); }
            u32x2 oj; oj.x = pk2(o[0], o[1]); oj.y = pk2(o[2], o[3]); *(u32x2*)(Jg + col * 64 + r0) = oj;
        });
        blk_mma2<4, 4, 2>(ARK, Vt, ARB, W2t, 72, C.wid, C.lane, [=](int r0, int col, const f32x4& a, const f32x4& b) {
            u32x2 o; o.x = pk2(a[0] - b[0], a[1] - b[1]); o.y = pk2(a[2] - b[2], a[3] - b[3]);
            *(u32x2*)(Ylg + col * 64 + r0) = o;
        });
    }
    __syncthreads();
}

typedef float f32x2p __attribute__((ext_vector_type(2)));
__device__ __forceinline__ void ph_scan(const Ctx& C, int nrep = 1) {
    if (C.bid < 16) {
      for (int rep = 0; rep < nrep; ++rep) {
        const int chain = C.bid, fr = C.lane & 15, fq = C.lane >> 4, w = C.wid;
        LAS bf16_t* Gs = (LAS bf16_t*)C.lds;
        LAS bf16_t* Js = Gs + 8 * 4608;
        LAS bf16_t* HT = Js + 8 * 4608 + (w & 3) * 16 * 72;
        const bf16_t* Gg = (const bf16_t*)(C.ws + WS_RG) + (size_t)chain * NCH * 4096;
        const bf16_t* Jg = (const bf16_t*)(C.ws + WS_RJ) + (size_t)chain * NCH * 4096;
        bf16_t* Hg = (bf16_t*)(C.ws + WS_RH) + (size_t)chain * NCH * 4096 + ((w & 3) * 16 + fr) * 64 + fq * 4;
        u32x4 pf[16];
        const int lt = C.tid;
        auto issue = [&](int b0) {
#pragma unroll
            for (int i = 0; i < 16; ++i) { const int e = lt + 512 * i, st = e >> 10, m = (e >> 9) & 1, p = e & 511; const int cp = b0 + st < NCH ? b0 + st : NCH - 1;
                pf[i] = *(const u32x4*)((m ? Jg : Gg) + (size_t)cp * 4096 + p * 8); } };
        f32x4 acc[4];
#pragma unroll
        for (int tm = 0; tm < 4; ++tm) acc[tm] = (f32x4){0.f, 0.f, 0.f, 0.f};
        issue(0);
        for (int b0 = 0; b0 < NCH; b0 += 8) {
            __syncthreads();
#pragma unroll
            for (int i = 0; i < 16; ++i) { const int e = lt + 512 * i, st = e >> 10, m = (e >> 9) & 1, p = e & 511; *(LAS u32x4*)((m ? Js : Gs) + st * 4608 + (p >> 3) * 72 + (p & 7) * 8) = pf[i]; }
            __syncthreads();
            if (b0 + 8 < NCH) issue(b0 + 8);
            if (w < 4) {
                const int nb = NCH - b0 < 8 ? NCH - b0 : 8;
                for (int st = 0; st < nb; ++st) {
                    const int cpos = b0 + st;
#pragma unroll
                    for (int tm = 0; tm < 4; ++tm) { u32x2 o; o.x = pk2(acc[tm][0], acc[tm][1]); o.y = pk2(acc[tm][2], acc[tm][3]);
                        *(LAS u32x2*)(HT + fr * 72 + tm * 16 + fq * 4) = o;
                        *(u32x2*)(Hg + (size_t)cpos * 4096 + tm * 16) = o; }
                    const bf16x8 b0v = *(const LAS bf16x8*)(HT + fr * 72 + fq * 8), b1v = *(const LAS bf16x8*)(HT + fr * 72 + 32 + fq * 8);
#pragma unroll
                    for (int tm = 0; tm < 4; ++tm) {
                        const u32x2 jr = *(const LAS u32x2*)(Js + st * 4608 + (w * 16 + fr) * 72 + tm * 16 + fq * 4);
                        f32x4 a = {bflo(jr.x), bfhi(jr.x), bflo(jr.y), bfhi(jr.y)};
                        a = __builtin_amdgcn_mfma_f32_16x16x32_bf16(*(const LAS bf16x8*)(Gs + st * 4608 + (tm * 16 + fr) * 72 + fq * 8), b0v, a, 0, 0, 0);
                        a = __builtin_amdgcn_mfma_f32_16x16x32_bf16(*(const LAS bf16x8*)(Gs + st * 4608 + (tm * 16 + fr) * 72 + 32 + fq * 8), b1v, a, 0, 0, 0);
                        acc[tm] = a; }
                }
            }
        }
        __syncthreads();
      }
    } else {
        unsigned* MST = (unsigned*)(C.ws + WS_MST); const float* MCD = (const float*)(C.ws + WS_MCD);
        const int nthr = (C.G - 16) * 512;
        for (int e = (C.bid - 16) * 512 + C.tid; e < 16 * 4096; e += nthr) {
            const int chain = e >> 12, el = e & 4095; float r0 = 0.f, r1 = 0.f;
            unsigned* p = MST + (size_t)chain * NCH * 4096 + el; const float* cd = MCD + chain * NCH;
#pragma unroll 22
            for (int cpos = 0; cpos < NCH; ++cpos) { const unsigned tmp = p[(size_t)cpos * 4096]; p[(size_t)cpos * 4096] = pk2(r0, r1); const float c = cd[cpos]; r0 = r0 * c + bflo(tmp); r1 = r1 * c + bfhi(tmp); }
        }
    }
}

__device__ __forceinline__ void item_mamba_out(const Ctx& C, int layer, int gc) {
    const ChunkInfo ci = chunk_info(gc);
    const bf16_t* P = (const bf16_t*)(C.ws + WS_P); bf16_t* YC = (bf16_t*)(C.ws + WS_ACT); const bf16_t* MST = (const bf16_t*)(C.ws + WS_MST);
    lds_t L = C.lds;
    LAS float* DT = (LAS float*)L;
    LAS float* DA = (LAS float*)(L + 2048);
    LAS float* CSI = (LAS float*)(L + 4096);
    LAS float* SSQ = (LAS float*)(L + 6144);
    LAS bf16_t* CG = (LAS bf16_t*)(L + 10240);
    LAS bf16_t* BG = (LAS bf16_t*)(L + 27648);
    LAS bf16_t* XT = (LAS bf16_t*)(L + 45056);
    LAS float* CBm = (LAS float*)(L + 63488);
    LAS bf16_t* MP = (LAS bf16_t*)(L + 80896);
    LAS bf16_t* S0 = (LAS bf16_t*)(L + 90112);
    LAS bf16_t* YPRE = (LAS bf16_t*)(L + 107520);
    const int fr = C.lane & 15, fq = C.lane >> 4;
    {
        const int s = C.lane, dh = C.wid;
        const float raw = bf2f(P[(size_t)(ci.row0 + s) * NP + OFF_C + 1024 + dh]);
        const float dt = softplus(raw + C.in[20][layer * 8 + dh]);
        const float da = dt * (-expf(C.in[21][layer * 8 + dh]));
        const float incl = wave_incl_scan(da, s), total = __shfl(incl, 63);
        DT[dh * 64 + s] = dt; DA[dh * 64 + s] = da;
        CSI[dh * 64 + s] = (dh < 4) ? incl : (total - incl + da);
    }
    for (int g = 0; g < 2; ++g) {
        __syncthreads();
        {
            const int cp = C.tid & 255, half = C.tid >> 8;
            if (cp < 192) {
                const int kind = cp >> 6, cl = (cp & 63) * 2, c0 = kind * 256 + g * 128 + cl;
                const float* cw = C.in[18] + (size_t)layer * 5 * 768 + c0; const float* cb = C.in[19] + layer * 768 + c0;
                float w0[5], w1[5];
#pragma unroll
                for (int j = 0; j < 5; ++j) { w0[j] = cw[j * 768]; w1[j] = cw[j * 768 + 1]; }
                const float b0 = cb[0], b1 = cb[1];
                const int s0 = half * 32;
                unsigned win[5];
#pragma unroll
                for (int j = 0; j < 4; ++j) { const int row = ci.row0 + s0 - 2 + j; const bool ok = row >= ci.lo && row < ci.hi; const unsigned v = *(const unsigned*)(P + (size_t)(ok ? row : ci.row0) * NP + OFF_C + 256 + c0); win[j + 1] = ok ? v : 0u; }
                for (int tt = 0; tt < 32; ++tt) {
                    const int s = s0 + tt;
#pragma unroll
                    for (int j = 0; j < 4; ++j) win[j] = win[j + 1];
                    { const int row = ci.row0 + s + 2; const bool ok = row >= ci.lo && row < ci.hi; const unsigned v = *(const unsigned*)(P + (size_t)(ok ? row : ci.row0) * NP + OFF_C + 256 + c0); win[4] = ok ? v : 0u; }
                    float a0 = b0, a1 = b1;
#pragma unroll
                    for (int j = 0; j < 5; ++j) { a0 += w0[j] * bflo(win[j]); a1 += w1[j] * bfhi(win[j]); }
                    const unsigned short o0 = f2bf(silu(a0)), o1 = f2bf(silu(a1));
                    if (kind == 0) { XT[cl * 72 + s] = o0; XT[(cl + 1) * 72 + s] = o1; }
                    else if (kind == 1) { *(LAS unsigned*)(BG + s * 136 + cl) = (unsigned)o0 | ((unsigned)o1 << 16); }
                    else { *(LAS unsigned*)(CG + s * 136 + cl) = (unsigned)o0 | ((unsigned)o1 << 16); }
                }
            }
        }
        __syncthreads();
        blk_mma<4, 4, 4>(CG, 136, BG, 136, C.wid, C.lane, [=](int r0, int col, const f32x4& acc) {
#pragma unroll
            for (int jj = 0; jj < 4; ++jj) CBm[(r0 + jj) * 68 + col] = acc[jj];
        });
        u32x4 s0r[2];
        { const bf16_t* src = MST + (size_t)slot_of(ci.b, 2 * g, 0, cpos_of(ci, 0)) * 8192;
#pragma unroll
          for (int k = 0; k < 2; ++k) { const int e = C.tid + 512 * k; s0r[k] = *(const u32x4*)(src + (e >> 4) * 128 + (e & 15) * 8); } }
        for (int hh = 0; hh < 2; ++hh) {
            const int h = 2 * g + hh;
            f32x4 yacc[2] = {{0.f, 0.f, 0.f, 0.f}, {0.f, 0.f, 0.f, 0.f}};
            for (int d = 0; d < 2; ++d) {
                const int dh = d * 4 + h;
                __syncthreads();
                for (int e = C.tid; e < 4096; e += 512) { const int l = e >> 6, s = e & 63; const bool ok = d ? (s >= l) : (s <= l);
                    MP[l * 72 + s] = ok ? f2bf(CBm[l * 68 + s] * fexp(CSI[dh * 64 + l] - CSI[dh * 64 + s]) * DT[dh * 64 + s]) : (unsigned short)0; }
#pragma unroll
                for (int k = 0; k < 2; ++k) { const int e = C.tid + 512 * k; *(LAS u32x4*)(S0 + (e >> 4) * 136 + (e & 15) * 8) = s0r[k]; }
                if (!(hh == 1 && d == 1)) { const int nh = d ? h + 1 : h, nd = d ^ 1; const bf16_t* src = MST + (size_t)slot_of(ci.b, nh, nd, cpos_of(ci, nd)) * 8192;
#pragma unroll
                    for (int k = 0; k < 2; ++k) { const int e = C.tid + 512 * k; s0r[k] = *(const u32x4*)(src + (e >> 4) * 128 + (e & 15) * 8); } }
                __syncthreads();
#pragma unroll
                for (int i = 0; i < 2; ++i) { const int tt = C.wid + 8 * i, tm = tt >> 2, tn = tt & 3;
                    f32x4 a1 = {0.f, 0.f, 0.f, 0.f}, a2 = {0.f, 0.f, 0.f, 0.f};
#pragma unroll
                    for (int ks = 0; ks < 2; ++ks) a1 = __builtin_amdgcn_mfma_f32_16x16x32_bf16(*(const LAS bf16x8*)(MP + (tm * 16 + fr) * 72 + ks * 32 + fq * 8),
                                                                                                 *(const LAS bf16x8*)(XT + (hh * 64 + tn * 16 + fr) * 72 + ks * 32 + fq * 8), a1, 0, 0, 0);
#pragma unroll
                    for (int ks = 0; ks < 4; ++ks) a2 = __builtin_amdgcn_mfma_f32_16x16x32_bf16(*(const LAS bf16x8*)(CG + (tm * 16 + fr) * 136 + ks * 32 + fq * 8),
                                                                                                 *(const LAS bf16x8*)(S0 + (tn * 16 + fr) * 136 + ks * 32 + fq * 8), a2, 0, 0, 0);
#pragma unroll
                    for (int j = 0; j < 4; ++j) yacc[i][j] += a1[j] + a2[j] * fexp(CSI[dh * 64 + tm * 16 + fq * 4 + j]);
                }
            }
            const float dsk = C.in[22][layer * 4 + h];
#pragma unroll
            for (int i = 0; i < 2; ++i) { const int tt = C.wid + 8 * i, tm = tt >> 2, tn = tt & 3;
#pragma unroll
                for (int j = 0; j < 4; ++j) { const int l = tm * 16 + fq * 4 + j, p = tn * 16 + fr, c = h * 64 + p;
                    const float xs = bf2f(XT[(hh * 64 + p) * 72 + l]);
                    const float z = bf2f(P[(size_t)(ci.row0 + l) * NP + OFF_C + c]);
                    const float pre = (yacc[i][j] + dsk * xs) * silu(z);
                    YPRE[l * 264 + c] = f2bf(pre);
                    float q = pre * pre; q += __shfl_xor(q, 1); q += __shfl_xor(q, 2); q += __shfl_xor(q, 4); q += __shfl_xor(q, 8);
                    if (fr == 0) SSQ[l * 16 + h * 4 + tn] = q; }
            }
        }
    }
    __syncthreads();
    {
        const int l = C.tid >> 3, sub = C.tid & 7; float ss = 0.f;
#pragma unroll
        for (int i = 0; i < 16; ++i) ss += SSQ[l * 16 + i];
        const float rs = rsqrtf(ss * (1.f / 256.f) + 1e-6f);
        const float* ng = C.in[23] + layer * 256 + sub * 32;
        bf16_t* dst = YC + (size_t)(ci.row0 + l) * DM + 512 + sub * 32;
#pragma unroll
        for (int i = 0; i < 32; i += 2) { const float a = bf2f(YPRE[l * 264 + sub * 32 + i]) * rs * ng[i], b = bf2f(YPRE[l * 264 + sub * 32 + i + 1]) * rs * ng[i + 1]; *(unsigned*)(dst + i) = pk2(a, b); }
    }
    __syncthreads();
}

constexpr int D3_G2T = 0, D3_SG = 69632;
__device__ __forceinline__ void load_g2t(const Ctx& C, int layer) {
    LAS bf16_t* G2T = (LAS bf16_t*)(C.lds + D3_G2T); const float* g2 = C.in[30] + (size_t)layer * 128 * 256;
    for (int e = C.tid; e < 128 * 256; e += 512) { const int r = e >> 8, c = e & 255; G2T[c * 136 + r] = f2bf(g2[e]); }
}
__device__ __forceinline__ float lerp_d(const bf16_t* P, const ChunkInfo& ci, int row, int j, const float* mup, const float* mun) {
    const bf16_t* pp = P + (size_t)row * NP + OFF_D + j;
    const bool okp = row - 1 >= ci.lo, okn = row + 1 < ci.hi;
    const float x = bf2f(*pp), xpv = bf2f(*(okp ? pp - NP : pp)), xnv = bf2f(*(okn ? pp + NP : pp)); const float xp = okp ? xpv : 0.f, xn = okn ? xnv : 0.f;
    return x + mup[j] * (xp - x) + mun[j] * (xn - x);
}
__device__ __forceinline__ void item_rwkv_out(const Ctx& C, int layer, int gc) {
    const ChunkInfo ci = chunk_info(gc);
    const bf16_t* P = (const bf16_t*)(C.ws + WS_P); bf16_t* YC = (bf16_t*)(C.ws + WS_ACT);
    const float* mup = C.in[24] + layer * 1152; const float* mun = C.in[25] + layer * 1152;
    LAS bf16_t* G2T = (LAS bf16_t*)(C.lds + D3_G2T); LAS bf16_t* SG = (LAS bf16_t*)(C.lds + D3_SG);
    const int fr = C.lane & 15, fq = C.lane >> 4;
    __syncthreads();
    for (int e = C.tid; e < 64 * 128; e += 512) { const int l = e >> 7, r = e & 127; SG[l * 136 + r] = f2bf(sigm(lerp_d(P, ci, ci.row0 + l, 1024 + r, mup, mun))); }
    __syncthreads();
    const int h = C.wid >> 1, tmb = (C.wid & 1) * 2;
    const bf16_t* Ryg = (const bf16_t*)(C.ws + WS_RY); const bf16_t* Ylg = (const bf16_t*)(C.ws + WS_RL); const bf16_t* Hg = (const bf16_t*)(C.ws + WS_RH);
    const float* BON = (const float*)(C.ws + WS_BON);
#pragma unroll
    for (int ti = 0; ti < 2; ++ti) {
        const int tm = tmb + ti;
        f32x4 gacc[4], yacc[4];
#pragma unroll
        for (int tn = 0; tn < 4; ++tn) { f32x4 a = {0.f, 0.f, 0.f, 0.f};
#pragma unroll
            for (int ks = 0; ks < 4; ++ks) a = __builtin_amdgcn_mfma_f32_16x16x32_bf16(*(const LAS bf16x8*)(SG + (tm * 16 + fr) * 136 + ks * 32 + fq * 8),
                                                                                        *(const LAS bf16x8*)(G2T + (h * 64 + tn * 16 + fr) * 136 + ks * 32 + fq * 8), a, 0, 0, 0);
            gacc[tn] = a; yacc[tn] = (f32x4){0.f, 0.f, 0.f, 0.f}; }
#pragma unroll
        for (int d = 0; d < 2; ++d) {
            const size_t slot = (size_t)slot_of(ci.b, h, d, cpos_of(ci, d));
            const int arow = d ? 63 - (tm * 16 + fr) : tm * 16 + fr;
            bf16x8 af[2];
#pragma unroll
            for (int ks = 0; ks < 2; ++ks) af[ks] = *(const bf16x8*)(Ryg + slot * 4096 + arow * 64 + ks * 32 + fq * 8);
#pragma unroll
            for (int tn = 0; tn < 4; ++tn) {
                f32x4 a;
                if (d == 0) { const u32x2 yl = *(const u32x2*)(Ylg + slot * 4096 + (tn * 16 + fr) * 64 + tm * 16 + fq * 4); a = (f32x4){bflo(yl.x), bfhi(yl.x), bflo(yl.y), bfhi(yl.y)}; }
                else { const u32x2 yl = *(const u32x2*)(Ylg + slot * 4096 + (tn * 16 + fr) * 64 + 60 - (tm * 16 + fq * 4)); a = (f32x4){bfhi(yl.y), bflo(yl.y), bfhi(yl.x), bflo(yl.x)}; }
#pragma unroll
                for (int ks = 0; ks < 2; ++ks) a = __builtin_amdgcn_mfma_f32_16x16x32_bf16(af[ks], *(const bf16x8*)(Hg + slot * 4096 + (tn * 16 + fr) * 64 + ks * 32 + fq * 8), a, 0, 0, 0);
                yacc[tn] += a;
            }
        }
#pragma unroll
        for (int j = 0; j < 4; ++j) {
            const int l = tm * 16 + fq * 4 + j, row = ci.row0 + l;
            float s = (yacc[0][j] + yacc[1][j]) + (yacc[2][j] + yacc[3][j]);
            s += __shfl_xor(s, 1); s += __shfl_xor(s, 2); s += __shfl_xor(s, 4); s += __shfl_xor(s, 8);
            const float mu = s * (1.f / 64.f);
            float q = 0.f;
#pragma unroll
            for (int tn = 0; tn < 4; ++tn) { const float dd = yacc[tn][j] - mu; q += dd * dd; }
            q += __shfl_xor(q, 1); q += __shfl_xor(q, 2); q += __shfl_xor(q, 4); q += __shfl_xor(q, 8);
            const float rs = rsqrtf(q * (1.f / 64.f) + 64e-5f);
            const float bon = BON[(size_t)row * 8 + h * 2] + BON[(size_t)row * 8 + h * 2 + 1];
#pragma unroll
            for (int tn = 0; tn < 4; ++tn) { const int c = h * 64 + tn * 16 + fr;
                const float yn = (yacc[tn][j] - mu) * rs * C.in[34][layer * 256 + c] + C.in[35][layer * 256 + c];
                const float vv = lerp_d(P, ci, row, 512 + c, mup, mun);
                YC[(size_t)row * DM + 768 + c] = f2bf((yn + bon * vv) * gacc[tn][j]); }
        }
    }
}

__device__ __forceinline__ unsigned ordf(float f) { const unsigned u = __float_as_uint(f); return u ^ ((u >> 31) ? 0xFFFFFFFFu : 0x80000000u); }
__device__ __forceinline__ unsigned wave_max_u32(unsigned v) {
    unsigned t;
    t = (unsigned)__builtin_amdgcn_update_dpp((int)v, (int)v, 0xB1, 0xF, 0xF, false); v = t > v ? t : v;
    t = (unsigned)__builtin_amdgcn_update_dpp((int)v, (int)v, 0x4E, 0xF, 0xF, false); v = t > v ? t : v;
    t = (unsigned)__builtin_amdgcn_update_dpp((int)v, (int)v, 0x141, 0xF, 0xF, false); v = t > v ? t : v;
    t = (unsigned)__builtin_amdgcn_update_dpp((int)v, (int)v, 0x140, 0xF, 0xF, false); v = t > v ? t : v;
    t = (unsigned)__builtin_amdgcn_update_dpp((int)v, (int)v, 0x142, 0xA, 0xF, false); v = t > v ? t : v;
    t = (unsigned)__builtin_amdgcn_update_dpp((int)v, (int)v, 0x143, 0xC, 0xF, false); v = t > v ? t : v;
    return (unsigned)__builtin_amdgcn_readlane((int)v, 63);
}
constexpr int SEL_K1 = 0, SEL_K2 = 34816;
__device__ __forceinline__ float unordf(unsigned k) { return __uint_as_float((k & 0x80000000u) ? (k ^ 0x80000000u) : ~k); }
template <int N> __device__ __forceinline__ void bitonic_sort_desc(unsigned (&x)[N]) {
#pragma unroll
    for (int k = 2; k <= N; k <<= 1)
#pragma unroll
        for (int j = k >> 1; j > 0; j >>= 1)
#pragma unroll
            for (int i = 0; i < N; ++i) { const int l = i ^ j;
                if (l > i) { const unsigned p = x[i], q = x[l]; const unsigned hi = p > q ? p : q, lo = p > q ? q : p; if ((i & k) == 0) { x[i] = hi; x[l] = lo; } else { x[i] = lo; x[l] = hi; } } }
}
__device__ __forceinline__ void merge_top16(unsigned (&a)[16], const unsigned (&b)[16]) {
#pragma unroll
    for (int i = 0; i < 16; ++i) a[i] = a[i] > b[15 - i] ? a[i] : b[15 - i];
#pragma unroll
    for (int j = 8; j > 0; j >>= 1)
#pragma unroll
        for (int i = 0; i < 16; ++i) { const int l = i ^ j; if (l > i) { const unsigned p = a[i], q = a[l]; a[i] = p > q ? p : q; a[l] = p > q ? q : p; } }
}
__device__ __forceinline__ void ph_select(const Ctx& C, int layer, int nrows) {
    const bf16_t* Q = (const bf16_t*)(C.ws + WS_Q); int* SELI = (int*)(C.ws + WS_SELI); float* SELG = (float*)(C.ws + WS_SELG);
    LAS bf16_t* K1 = (LAS bf16_t*)(C.lds + SEL_K1); LAS bf16_t* K2 = (LAS bf16_t*)(C.lds + SEL_K2);
    {
        const float* k1 = C.in[37] + (size_t)layer * 128 * 128; const float* k2 = C.in[38] + (size_t)layer * 128 * 128;
        for (int e = C.tid; e < 4096; e += 512) { const int r = e >> 5, c4 = (e & 31) * 4; const f32x4 a = *(const f32x4*)(k1 + r * 128 + c4), b = *(const f32x4*)(k2 + r * 128 + c4);
            u32x2 oa, ob; oa.x = pk2(a.x, a.y); oa.y = pk2(a.z, a.w); ob.x = pk2(b.x, b.y); ob.y = pk2(b.z, b.w);
            *(LAS u32x2*)(K1 + r * 136 + c4) = oa; *(LAS u32x2*)(K2 + r * 136 + c4) = ob; }
    }
    __syncthreads();
    const int nunits = (nrows / 16) * 8;
    for (int u = C.bid * 8 + C.wid; u < nunits; u += C.G * 8) {
        int ln_ = C.lane; asm volatile("" : "+v"(ln_));
        const int fr = ln_ & 15, fq = ln_ >> 4;
        const int tile = u >> 3, h = u & 7, row = tile * 16 + fr;
        const bf16_t* qp = Q + (size_t)row * 2048 + h * 256 + fq * 8;
        bf16x8 qf[8];
#pragma unroll
        for (int i = 0; i < 8; ++i) qf[i] = *(const bf16x8*)(qp + i * 32);
        unsigned T[2][16];
#pragma unroll
        for (int half = 0; half < 2; ++half) {
            const LAS bf16_t* K = half ? K2 : K1;
            unsigned lo16[16], hi16[16];
#pragma unroll
            for (int kt = 0; kt < 8; ++kt) {
                f32x4 acc = {0.f, 0.f, 0.f, 0.f};
#pragma unroll
                for (int ks = 0; ks < 4; ++ks) acc = __builtin_amdgcn_mfma_f32_16x16x32_bf16(*(const LAS bf16x8*)(K + (kt * 16 + fr) * 136 + ks * 32 + fq * 8), qf[half * 4 + ks], acc, 0, 0, 0);
#pragma unroll
                for (int j = 0; j < 4; ++j) { const unsigned key = (ordf(acc[j]) & ~0x7Fu) | (unsigned)(127 - (kt * 16 + fq * 4 + j));
                    if (kt < 4) lo16[kt * 4 + j] = key; else hi16[(kt - 4) * 4 + j] = key; }
            }
            bitonic_sort_desc<16>(lo16); bitonic_sort_desc<16>(hi16); merge_top16(lo16, hi16);
#pragma unroll
            for (int rnd = 16; rnd <= 32; rnd <<= 1) { unsigned o[16];
#pragma unroll
                for (int i = 0; i < 16; ++i) o[i] = (unsigned)__shfl_xor((int)lo16[i], rnd);
                merge_top16(lo16, o); }
#pragma unroll
            for (int i = 0; i < 16; ++i) T[half][i] = lo16[i];
        }
        unsigned ck[50]; unsigned R0[16];
        {
            int id = 0;
#pragma unroll
            for (int a = 0; a < 16; ++a) {
                const float va = unordf(T[0][a] & ~0x7Fu);
#pragma unroll
                for (int b = 0; b < 16; ++b) if ((a + 1) * (b + 1) <= 16) { ck[id] = (ordf(va + unordf(T[1][b] & ~0x7Fu)) & ~0x3Fu) | (unsigned)(63 - id); ++id; }
            }
        }
#pragma unroll
        for (int i = 0; i < 16; ++i) R0[i] = ck[i];
        {
            int base = 16;
#pragma unroll
            for (int a = 1; a < 8; ++a) { const int n = 16 / (a + 1); unsigned rw[16];
#pragma unroll
                for (int i = 0; i < 16; ++i) rw[i] = i < n ? ck[base + i] : 0u;
                merge_top16(R0, rw); base += n; }
            unsigned rw[16];
#pragma unroll
            for (int i = 0; i < 16; ++i) rw[i] = i < 8 ? ck[base + i] : 0u;
            merge_top16(R0, rw);
        }
        const unsigned thr = R0[15]; const float mx = unordf(R0[0] & ~0x3Fu);
        float sum = 0.f;
#pragma unroll
        for (int c = 0; c < 50; ++c) sum += ck[c] >= thr ? __expf(unordf(ck[c] & ~0x3Fu) - mx) : 0.f;
        const float rsum = 1.f / sum;
        int* oi = SELI + ((size_t)row * 8 + h) * 16; float* og = SELG + ((size_t)row * 8 + h) * 16;
        {
            int id = 0, cnt = 0;
#pragma unroll
            for (int a = 0; a < 16; ++a)
#pragma unroll
                for (int b = 0; b < 16; ++b) if ((a + 1) * (b + 1) <= 16) {
                    if (ck[id] >= thr) { if (fq == 0 && cnt < 16) { oi[cnt] = (127 - (int)(T[0][a] & 0x7Fu)) * 128 + (127 - (int)(T[1][b] & 0x7Fu)); og[cnt] = __expf(unordf(ck[id] & ~0x3Fu) - mx) * rsum; } ++cnt; }
                    ++id; }
        }
    }
}

struct R16 { float v[16]; };
__device__ __forceinline__ R16 load_r16_f32(const float* p, int lane) { R16 r;
#pragma unroll
    for (int k = 0; k < 4; ++k) { const f32x4 a = *(const f32x4*)(p + 16 * lane + 4 * k); r.v[4 * k] = a.x; r.v[4 * k + 1] = a.y; r.v[4 * k + 2] = a.z; r.v[4 * k + 3] = a.w; }
    return r; }
__device__ __forceinline__ void store_r16_f32(float* p, int lane, const R16& r) {
#pragma unroll
    for (int k = 0; k < 4; ++k) *(f32x4*)(p + 16 * lane + 4 * k) = (f32x4){r.v[4 * k], r.v[4 * k + 1], r.v[4 * k + 2], r.v[4 * k + 3]}; }
__device__ __forceinline__ R16 load_r16_bf16(const bf16_t* p, int lane) { R16 r;
#pragma unroll
    for (int k = 0; k < 2; ++k) { const u32x4 a = *(const u32x4*)(p + 16 * lane + 8 * k);
        r.v[8 * k] = bflo(a.x); r.v[8 * k + 1] = bfhi(a.x); r.v[8 * k + 2] = bflo(a.y); r.v[8 * k + 3] = bfhi(a.y); r.v[8 * k + 4] = bflo(a.z); r.v[8 * k + 5] = bfhi(a.z); r.v[8 * k + 6] = bflo(a.w); r.v[8 * k + 7] = bfhi(a.w); }
    return r; }
__device__ __forceinline__ void store_r16_bf16(bf16_t* p, int lane, const R16& r) {
#pragma unroll
    for (int k = 0; k < 2; ++k) { u32x4 a; a.x = pk2(r.v[8 * k], r.v[8 * k + 1]); a.y = pk2(r.v[8 * k + 2], r.v[8 * k + 3]); a.z = pk2(r.v[8 * k + 4], r.v[8 * k + 5]); a.w = pk2(r.v[8 * k + 6], r.v[8 * k + 7]);
        *(u32x4*)(p + 16 * lane + 8 * k) = a; } }
typedef float f32x2p __attribute__((ext_vector_type(2)));
struct PeerHdr { int idx0, idx1; float su0, su1, gsv0, gsv1; };
__device__ __forceinline__ void ph_peer(const Ctx& C, int layer, int nrows, bool last, bool store = true, int idmask = 0x3FFF) {
    const bf16_t* F = (const bf16_t*)(C.ws + WS_ACT); bf16_t* XN = (bf16_t*)(C.ws + WS_ACT);
    const unsigned char* UB = C.ws + WS_UB; const unsigned char* VB = C.ws + WS_VB; const float* SU = (const float*)(C.ws + WS_SU); const float* SV = (const float*)(C.ws + WS_SV);
    const int* SELI = (const int*)(C.ws + WS_SELI); const float* SELG = (const float*)(C.ws + WS_SELG);
    float* H = (float*)(C.ws + WS_H); const float* MOD = (const float*)(C.ws + WS_MOD);
    const int step = C.G * 8;
    auto load_hdr = [&](int tok, int L) { PeerHdr h; h.idx0 = SELI[(size_t)tok * 128 + L] & idmask; h.idx1 = SELI[(size_t)tok * 128 + 64 + L] & idmask;
        h.su0 = SU[h.idx0]; h.su1 = SU[h.idx1]; h.gsv0 = SELG[(size_t)tok * 128 + L] * SV[h.idx0]; h.gsv1 = SELG[(size_t)tok * 128 + 64 + L] * SV[h.idx1]; return h; };
    int tok = C.bid * 8 + C.wid;
    for (; tok < nrows; tok += step) {
        int L = C.lane; asm volatile("" : "+v"(L));
        const int myexp = ((L >> 5) & 1) * 4 + ((L >> 4) & 1) * 2 + ((L >> 3) & 1);
        const PeerHdr hd = load_hdr(tok, L);
        const u32x4 fpa = *(const u32x4*)(F + (size_t)tok * DM + 16 * L), fpb = *(const u32x4*)(F + (size_t)tok * DM + 16 * L + 8);
        f32x2p out[8];
#pragma unroll
        for (int i = 0; i < 8; ++i) out[i] = (f32x2p){0.f, 0.f};
        u32x4 ua[2][8], va[2][8];
#define PEER_LOAD(buf, bt) do { const int src_ = (bt) < 8 ? hd.idx0 : hd.idx1; const int l0_ = ((bt) & 7) * 8; _Pragma("unroll") for (int i = 0; i < 8; ++i) { const int ei = __builtin_amdgcn_readlane(src_, l0_ + i); \
            ua[buf][i] = *(const u32x4*)(UB + (size_t)ei * DM + 16 * L); va[buf][i] = *(const u32x4*)(VB + (size_t)ei * DM + 16 * L); } } while (0)
#define PEER_COMPUTE(buf, bt) do { const float susrc = (bt) < 8 ? hd.su0 : hd.su1, gsrc = (bt) < 8 ? hd.gsv0 : hd.gsv1; const int l0 = ((bt) & 7) * 8; float part[8]; \
            _Pragma("unroll") for (int i = 0; i < 8; ++i) { f32x2p acc = {0.f, 0.f}; _Pragma("unroll") for (int k = 0; k < 4; ++k) { \
                const f32x2p lo = __builtin_amdgcn_cvt_pk_f32_fp8((int)ua[buf][i][k], false), hi = __builtin_amdgcn_cvt_pk_f32_fp8((int)ua[buf][i][k], true); \
                const unsigned fw0 = (k < 2 ? fpa : fpb)[(2 * k) & 3], fw1 = (k < 2 ? fpa : fpb)[(2 * k + 1) & 3]; \
                acc += lo * (f32x2p){bflo(fw0), bfhi(fw0)}; acc += hi * (f32x2p){bflo(fw1), bfhi(fw1)}; } part[i] = acc.x + acc.y; } \
            float p4[4], p2[2], p1; \
            { const bool hi = (L & 32) != 0; _Pragma("unroll") for (int i = 0; i < 4; ++i) { const float send = hi ? part[i] : part[i + 4]; const float recv = __shfl_xor(send, 32); p4[i] = (hi ? part[i + 4] : part[i]) + recv; } } \
            { const bool hi = (L & 16) != 0; _Pragma("unroll") for (int i = 0; i < 2; ++i) { const float send = hi ? p4[i] : p4[i + 2]; const float recv = __shfl_xor(send, 16); p2[i] = (hi ? p4[i + 2] : p4[i]) + recv; } } \
            { const bool hi = (L & 8) != 0; const float send = hi ? p2[0] : p2[1]; const float recv = __shfl_xor(send, 8); p1 = (hi ? p2[1] : p2[0]) + recv; } \
            p1 += __shfl_xor(p1, 4); p1 += __shfl_xor(p1, 2); p1 += __shfl_xor(p1, 1); \
            const float act = gelu_tanh(p1 * __shfl(susrc, l0 + myexp)) * __shfl(gsrc, l0 + myexp); \
            _Pragma("unroll") for (int i = 0; i < 8; ++i) { \
                const float a = __uint_as_float((unsigned)__builtin_amdgcn_readlane((int)__float_as_uint(act), ((i >> 2) & 1) * 32 + ((i >> 1) & 1) * 16 + (i & 1) * 8)); const f32x2p a2 = {a, a}; \
                _Pragma("unroll") for (int k = 0; k < 4; ++k) { out[2 * k] += a2 * __builtin_amdgcn_cvt_pk_f32_fp8((int)va[buf][i][k], false); out[2 * k + 1] += a2 * __builtin_amdgcn_cvt_pk_f32_fp8((int)va[buf][i][k], true); } } } while (0)
        PEER_LOAD(0, 0);
        for (int bt = 0; bt < 16; bt += 2) {
            PEER_LOAD(1, bt + 1);
            PEER_COMPUTE(0, bt);
            if (bt + 2 < 16) PEER_LOAD(0, bt + 2);
            PEER_COMPUTE(1, bt + 1);
        }
#undef PEER_LOAD
#undef PEER_COMPUTE
        const float* m = MOD + ((size_t)layer * 3 + which_of(tok)) * 6144;
        R16 hr = load_r16_f32(H + (size_t)tok * DM, L); const R16 g5 = load_r16_f32(m + 5 * 1024, L);
#pragma unroll
        for (int i = 0; i < 8; ++i) { hr.v[2 * i] += g5.v[2 * i] * out[i].x; hr.v[2 * i + 1] += g5.v[2 * i + 1] * out[i].y; }
        float ss = 0.f;
#pragma unroll
        for (int i = 0; i < 16; ++i) ss += hr.v[i] * hr.v[i];
        const float rs = rsqrtf(wave_sum(ss) * (1.f / 1024.f) + 1e-6f);
        if (!store) continue;
        if (!last) {
            store_r16_f32(H + (size_t)tok * DM, L, hr);
            const float* m2 = MOD + ((size_t)(layer + 1) * 3 + which_of(tok)) * 6144;
            const R16 gg = load_r16_f32(C.in[6] + (layer + 1) * 1024, L), sh = load_r16_f32(m2, L), sc = load_r16_f32(m2 + 1024, L); R16 o;
#pragma unroll
            for (int i = 0; i < 16; ++i) o.v[i] = (hr.v[i] * rs * gg.v[i]) * (1.f + sc.v[i]) + sh.v[i];
            store_r16_bf16(XN + (size_t)tok * DM, L, o);
        } else {
            const R16 fg = load_r16_f32(C.in[41], L); R16 o;
#pragma unroll
            for (int i = 0; i < 16; ++i) o.v[i] = hr.v[i] * rs * fg.v[i];
            store_r16_f32(C.out + (size_t)tok * DM, L, o);
        }
    }
}

#define PM(n) ((MASK >> (n)) & 1u)
constexpr int NPH_LAYER = 9, NPH = 2 + 2 * NPH_LAYER;
template <unsigned MASK> __global__ void __launch_bounds__(512, 2) hybrid_fwd(Args args) {
    extern __shared__ __attribute__((aligned(16))) unsigned char lds_raw[];
    Ctx C0; C0.in = args.in; C0.out = args.out; C0.ws = args.ws; C0.lds = (lds_t)lds_raw;
    C0.tid = threadIdx.x; C0.lane = C0.tid & 63; C0.wid = __builtin_amdgcn_readfirstlane(C0.tid >> 6); C0.bid = blockIdx.x; C0.G = gridDim.x;
    const Ctx& C = C0;
    const int lo = args.ph_lo, hi = args.ph_hi;
    const bool multi = (hi - lo) > 1;
    XcdBarrier bar; bar.bar = (unsigned*)(C.ws + WS_CTL); bar.x = 0; bar.st = (volatile LAS unsigned*)(C.lds + LDS_XB);
    if (multi) {
        if (C.tid == 0) *(LAS u32x4*)(C.lds + LDS_XB) = (u32x4){0u, 0u, 0u, 0u};
        __syncthreads();
        bar = xcd_barrier_post((unsigned*)(C.ws + WS_CTL), (volatile LAS unsigned*)(C.lds + LDS_XB));
    }
#define IN(k) (lo <= (k) && (k) < hi)
#define PHASE_CTX(c) Ctx c = C0; { int t_ = C0.tid; asm volatile("" : "+v"(t_)); c.tid = t_; c.lane = t_ & 63; c.wid = __builtin_amdgcn_readfirstlane(t_ >> 6); }
#ifndef MK_REPEAT
#define MK_REPEAT 0u
#endif
#define RP(k) ((MK_REPEAT >> (k)) & 1u)
#define STAMP(k) do {} while (0)
#define SEAM(k) do { if (IN(k) && IN((k) + 1)) xcd_barrier(bar); STAMP((k) + 1); } while (0)
    STAMP(0);
    if (RP(10)) { for (int i = 0; i < 20; ++i) xcd_barrier(bar); }
    if (PM(0) && IN(0)) { PHASE_CTX(c); ph_prologue(c); if (RP(9)) { xcd_barrier(bar); ph_prologue(c); } } SEAM(0);
    if (PM(1) && IN(1)) { PHASE_CTX(c); ph_norm(c, 0, c.in[6], 0, NROW); } SEAM(1);
    for (int layer = 0; layer < 2; ++layer) {
        const int base = 2 + layer * NPH_LAYER;
        const bool emit = (layer == 0);
        const int nrows = emit ? NROW : NLAT;
        if (PM(2) && IN(base + 0)) {
            pg8::Gemm g{(const bf16_t*)(C.ws + WS_ACT), (const bf16_t*)(C.ws + WS_WIN) + (size_t)layer * NP * DM, NROW, NP, DM};
            pg8::StaticOrder S; S.init(NROW, NP, C.G, C.bid);
            pg8::EpiBf16<0> E{(bf16_t*)(C.ws + WS_P), NP, nullptr, 0, 0};
            pg8::gemm_phase<pg8::EpiBf16<0>, pg8::StaticOrder, false>(C.lds, g, S, E, nullptr);
            if (RP(0)) { xcd_barrier(bar); pg8::gemm_phase<pg8::EpiBf16<0>, pg8::StaticOrder, false>(C.lds, g, S, E, nullptr); }
            { const int nfull = (NROW / 256) * (NP / 256) - ((NROW / 256) * (NP / 256) / C.G) * C.G; PHASE_CTX(c); if (c.bid >= nfull) convert_tables(c, layer, c.bid - nfull, c.G - nfull); }
        }
        SEAM(base + 0);
        if (PM(3) && IN(base + 1)) {
            const int nD = 2112, nC = 264, nB = emit ? 132 : 128, nA = emit ? 264 : 256, tot = nD + nC + nB + nA;
            for (int rep = 0; rep < (RP(1) ? 2 : 1); ++rep) {
            if (rep) xcd_barrier(bar);
            if (PM(11)) { PHASE_CTX(c); D1Pre pre; pre.hd = -1; for (int it = c.bid; it < nD; it += c.G) item_rwkv_local(c, layer, it, pre, it + c.G < nD ? it + c.G : -1); }
            if (PM(12)) { PHASE_CTX(c); for (int it = (c.bid + 52) % c.G; it < nC; it += c.G) item_mamba_local(c, layer, it); }
            if (PM(13)) { PHASE_CTX(c); for (int it = (c.bid + 192) % c.G; it < nB; it += c.G) item_chunkmlp(c, layer, it); }
            if (PM(14)) { PHASE_CTX(c); for (int it = (c.bid + 60) % c.G; it < nA; it += c.G) item_conformer(c, layer, it); }
            }
        }
        SEAM(base + 1);
        if (PM(4) && IN(base + 2)) { PHASE_CTX(c); ph_scan(c, RP(2) ? 2 : 1); }
        SEAM(base + 2);
        if (PM(5) && IN(base + 3)) {
            const int nc = nrows / 64;
            for (int rep = 0; rep < (RP(3) ? 2 : 1); ++rep) {
            if (rep) xcd_barrier(bar);
            if (PM(15)) { PHASE_CTX(c); load_g2t(c, layer); for (int it = c.bid; it < nc; it += c.G) item_rwkv_out(c, layer, it); }
            __syncthreads();
            if (PM(16)) { PHASE_CTX(c); for (int it = (c.bid + 128) % c.G; it < nc; it += c.G) item_mamba_out(c, layer, it); }
            __syncthreads();
            }
        }
        SEAM(base + 3);
        if (PM(6) && IN(base + 4)) {
            pg8::Gemm g{(const bf16_t*)(C.ws + WS_ACT), (const bf16_t*)(C.ws + WS_WOUT) + (size_t)layer * DM * DM, NLAT, DM, DM};
            pg8::StaticOrder S; S.init(NLAT, DM, C.G, C.bid);
            EpiResid E{(float*)(C.ws + WS_H), (const float*)(C.ws + WS_MOD) + (size_t)layer * 3 * 6144};
            pg8::gemm_phase<EpiResid, pg8::StaticOrder, false>(C.lds, g, S, E, nullptr);
            if (emit) {
                PHASE_CTX(c);
                for (int u = c.bid; u < 256; u += c.G) { const int tr = u >> 4, tc = u & 15;
                    float* Hc = (float*)(c.ws + WS_H) + (size_t)(NLAT + tr * 32) * DM + tc * 64;
                    const float* gate = (const float*)(c.ws + WS_MOD) + ((size_t)layer * 3 + 2) * 6144 + 2 * 1024 + tc * 64;
                    small_gemm_tile<2, 4>(c, (const bf16_t*)(c.ws + WS_ACT) + (size_t)(NLAT + tr * 32) * DM, (const bf16_t*)(c.ws + WS_WOUT) + (size_t)layer * DM * DM + (size_t)(tc * 64) * DM, DM,
                        [=](int r, int cc, const f32x4& acc) {
#pragma unroll
                            for (int j = 0; j < 4; ++j) Hc[(size_t)(r + j) * DM + cc] += gate[cc] * acc[j]; });
                }
            }
        }
        SEAM(base + 4);
        if (PM(7) && IN(base + 5)) { PHASE_CTX(c); for (int rep = 0; rep < (RP(5) ? 2 : 1); ++rep) { if (rep) xcd_barrier(bar); ph_norm(c, layer, c.in[7] + layer * 1024, 3, nrows); } }
        SEAM(base + 5);
        if (PM(8) && IN(base + 6)) {
            pg8::Gemm g{(const bf16_t*)(C.ws + WS_ACT), (const bf16_t*)(C.ws + WS_WQ) + (size_t)layer * 2048 * DM, NLAT, 2048, DM};
            pg8::StaticOrder S; S.init(NLAT, 2048, C.G, C.bid);
            pg8::EpiBf16<0> E{(bf16_t*)(C.ws + WS_Q), 2048, nullptr, 0, 0};
            pg8::gemm_phase<pg8::EpiBf16<0>, pg8::StaticOrder, false>(C.lds, g, S, E, nullptr);
            if (RP(6)) { xcd_barrier(bar); pg8::gemm_phase<pg8::EpiBf16<0>, pg8::StaticOrder, false>(C.lds, g, S, E, nullptr); }
            if (emit) {
                PHASE_CTX(c);
                for (int u = c.bid; u < 256; u += c.G) { const int tr = u >> 5, tc = u & 31;
                    bf16_t* Qc = (bf16_t*)(c.ws + WS_Q) + (size_t)(NLAT + tr * 64) * 2048 + tc * 64;
                    small_gemm_tile<4, 4>(c, (const bf16_t*)(c.ws + WS_ACT) + (size_t)(NLAT + tr * 64) * DM, (const bf16_t*)(c.ws + WS_WQ) + (size_t)layer * 2048 * DM + (size_t)(tc * 64) * DM, DM,
                        [=](int r, int cc, const f32x4& acc) {
#pragma unroll
                            for (int j = 0; j < 4; ++j) Qc[(size_t)(r + j) * 2048 + cc] = f2bf(acc[j]); });
                }
            }
        }
        SEAM(base + 6);
        if (PM(9) && IN(base + 7)) { PHASE_CTX(c); ph_select(c, layer, nrows); if (RP(7)) { xcd_barrier(bar); ph_select(c, layer, nrows); } }
        SEAM(base + 7);
        if (PM(10) && IN(base + 8)) { PHASE_CTX(c); if (RP(8)) { ph_peer(c, layer, nrows, layer == 1, args.ph_hi > 1000); xcd_barrier(bar); } if (RP(11)) { ph_peer(c, layer, nrows, layer == 1, args.ph_hi > 1000, 1023); xcd_barrier(bar); } ph_peer(c, layer, nrows, layer == 1); }
        SEAM(base + 8);
    }
#undef IN
#undef SEAM
}
}


namespace mk {
struct LaunchEnt { unsigned mask; int ph; };
template <unsigned MASK> static bool prep_kernel() {
    return hipFuncSetAttribute((const void*)hybrid_fwd<MASK>, hipFuncAttributeMaxDynamicSharedMemorySize, LDS_BYTES) == hipSuccess;
}
template <unsigned MASK> static void launch_kernel(int grid, hipStream_t stream, const Args& a) {
    hipLaunchKernelGGL(hybrid_fwd<MASK>, dim3(grid), dim3(512), LDS_BYTES, stream, a);
}
}

#define CENSUS(off, n, kind, stage, lim) do {} while (0)
#ifndef MK_ONE_LAUNCH
#define MK_ONE_LAUNCH 1
#endif
extern "C" void kernel_launch(void* const* d_in, const int* in_sizes, int n_in, void* d_out, int out_size, void* d_ws, size_t ws_size, hipStream_t stream) {
    using namespace mk;
    static int grid = 0;
    if (grid == 0) {
        if (n_in != 42 || ws_size < WS_END) { fprintf(stderr, "kernel_launch: need 42 inputs and %zu bytes of workspace (got %d, %zu)\n", (size_t)WS_END, n_in, ws_size); grid = -1; return; }
        int dev = 0, cus = 0;
        if (hipGetDevice(&dev) != hipSuccess || hipDeviceGetAttribute(&cus, hipDeviceAttributeMultiprocessorCount, dev) != hipSuccess) { grid = -1; return; }
        bool ok = true;
#if MK_ONE_LAUNCH
        ok = ok && prep_kernel<0x1FFFFu>();
#else
        ok = ok && prep_kernel<0x0001u>() && prep_kernel<0x0002u>() && prep_kernel<0x0004u>() && prep_kernel<0x0808u>() && prep_kernel<0x1008u>() && prep_kernel<0x2008u>() && prep_kernel<0x4008u>()
                && prep_kernel<0x0010u>() && prep_kernel<0x8020u>() && prep_kernel<0x10020u>() && prep_kernel<0x0040u>() && prep_kernel<0x0080u>() && prep_kernel<0x0100u>() && prep_kernel<0x0200u>() && prep_kernel<0x0400u>();
#endif
        if (!ok) { fprintf(stderr, "kernel_launch: hipFuncSetAttribute failed\n"); grid = -1; return; }
        (void)hipGetLastError();
        grid = cus;
    }
    if (grid < 0) return;
    (void)hipMemsetAsync((char*)d_ws + WS_CTL, 0, 65536, stream);
    Args a{};
    for (int i = 0; i < 42; ++i) a.in[i] = (const float*)d_in[i];
    a.out = (float*)d_out; a.ws = (unsigned char*)d_ws;
#if MK_ONE_LAUNCH
    a.ph_lo = 0; a.ph_hi = NPH; launch_kernel<0x1FFFFu>(grid, stream, a);
#else
    a.ph_lo = 0; a.ph_hi = 1; launch_kernel<0x0001u>(grid, stream, a);
    CENSUS(WS_H, (size_t)NROW * DM, 0, 1, 1e4f); CENSUS(WS_MOD, 2 * 3 * 6144, 0, 1, 1e4f); CENSUS(WS_WIN, 2ull * NP * DM, 1, 1, 1e4f); CENSUS(WS_UB, 2ull * NEXP * DM, 1, 1, 1e4f);
    a.ph_lo = 1; a.ph_hi = 2; launch_kernel<0x0002u>(grid, stream, a);
    CENSUS(WS_ACT, (size_t)NROW * DM, 1, 2, 1e4f);
    for (int layer = 0; layer < 2; ++layer) {
        const int b = 2 + layer * NPH_LAYER;
        const int so = layer ? 100 : 0; (void)so;
        a.ph_lo = b + 0; a.ph_hi = b + 1; launch_kernel<0x0004u>(grid, stream, a);
        if (!layer) CENSUS(WS_P, (size_t)NROW * NP, 1, 3, 1e4f);
        a.ph_lo = b + 1; a.ph_hi = b + 2; launch_kernel<0x0808u>(grid, stream, a);
        if (!layer) { CENSUS(WS_RG, (size_t)NSLOT * 4096, 1, 4, 1e6f); CENSUS(WS_RJ, (size_t)NSLOT * 4096, 0, 5, 1e6f); CENSUS(WS_RY, (size_t)NSLOT * 4096 * 2, 1, 6, 1e6f); CENSUS(WS_BON, (size_t)NROW * 8, 0, 6, 1e6f); }
        launch_kernel<0x1008u>(grid, stream, a);
        if (!layer) { CENSUS(WS_MST, (size_t)NSLOT * 8192, 0, 7, 1e6f); CENSUS(WS_MCD, NSLOT, 0, 7, 1e6f); }
        launch_kernel<0x2008u>(grid, stream, a); launch_kernel<0x4008u>(grid, stream, a);
        a.ph_lo = b + 2; a.ph_hi = b + 3; launch_kernel<0x0010u>(grid, stream, a);
        if (!layer) { CENSUS(WS_MST, (size_t)NSLOT * 8192, 0, 8, 1e6f); CENSUS(WS_RH, (size_t)NSLOT * 4096, 1, 9, 1e6f); }
        a.ph_lo = b + 3; a.ph_hi = b + 4; launch_kernel<0x8020u>(grid, stream, a); launch_kernel<0x10020u>(grid, stream, a);
        if (!layer) CENSUS(WS_ACT, (size_t)NROW * DM, 1, 10, 1e4f);
        a.ph_lo = b + 4; a.ph_hi = b + 5; launch_kernel<0x0040u>(grid, stream, a);
        if (!layer) CENSUS(WS_H, (size_t)NROW * DM, 0, 11, 1e4f);
        a.ph_lo = b + 5; a.ph_hi = b + 6; launch_kernel<0x0080u>(grid, stream, a);
        a.ph_lo = b + 6; a.ph_hi = b + 7; launch_kernel<0x0100u>(grid, stream, a);
        if (!layer) CENSUS(WS_Q, (size_t)NROW * 2048, 1, 12, 1e4f);
        a.ph_lo = b + 7; a.ph_hi = b + 8; launch_kernel<0x0200u>(grid, stream, a);
        if (!layer) { CENSUS(WS_SELI, (size_t)NROW * 128, 2, 13, 0.f); CENSUS(WS_SELG, (size_t)NROW * 128, 0, 13, 2.f); }
        a.ph_lo = b + 8; a.ph_hi = b + 9; launch_kernel<0x0400u>(grid, stream, a);
        if (!layer) { CENSUS(WS_H, (size_t)NROW * DM, 0, 14, 1e4f); CENSUS(WS_ACT, (size_t)NROW * DM, 1, 15, 1e4f); }
    }
#endif
    (void)in_sizes; (void)out_size;
}
```

```cpp
#include <hip/hip_runtime.h>
#include <cstdio>
#include <cstdint>
namespace pg8 {
#define PG8_LAS __attribute__((address_space(3)))
typedef unsigned short bf16_t;
typedef short bf16x8 __attribute__((ext_vector_type(8)));
typedef float f32x4 __attribute__((ext_vector_type(4)));
typedef unsigned u32x4 __attribute__((ext_vector_type(4)));
constexpr int BM = 256, BK = 64, HALF = 128, HTB = HALF * BK * 2  , STAGE_BYTES = 8 * HTB, NXCD = 8, WGM = 8;

__host__ __device__ __forceinline__ int lds_byte(int r, int c) { const int st = (r >> 4) * 2 + (c >> 5), rr = r & 15, cc = c & 31, ob = rr * 64 + cc * 2; return st * 1024 + (ob ^ (((ob >> 9) & 1) << 5)); }
__host__ __device__ __forceinline__ void stage_rc(int b, int& R, int& C) { const int st = b / 1024, sb = b % 1024, swz = sb ^ (((sb >> 9) & 1) << 5); R = (st >> 1) * 16 + swz / 64; C = (st & 1) * 32 + (swz % 64) / 2; }
__host__ __device__ __forceinline__ int perm32(int rho) { const int n = rho >> 4, i = rho & 15; return 8 * (i >> 2) + 4 * n + (i & 3); }

struct Unit { int pm, pn; };
struct Gemm { const bf16_t* A; const bf16_t* Bt; int M, N, K; };

struct StaticOrder {
    int nM, nN, nwg, G, c;
    __host__ __device__ void init(int M, int N, int G_, int c_) { nM = M / BM; nN = N / BM; nwg = nM * nN; G = G_; c = c_; }
    __host__ __device__ bool next(int i, Unit& u) const {
        const long L = (long)i * G + c; if (L >= nwg) return false;
        int wgid = (int)L; { const int q = nwg / NXCD, r = nwg % NXCD, xcd = wgid % NXCD, off = wgid / NXCD; wgid = (xcd < r ? xcd * (q + 1) : r * (q + 1) + (xcd - r) * q) + off; }
        const int nig = WGM * nN, gid = wgid / nig, fm = gid * WGM, gsz = (nM - fm) < WGM ? (nM - fm) : WGM;
        u.pm = fm + ((wgid % nig) % gsz); u.pn = (wgid % nig) / gsz; return true;
    }
    __device__ __forceinline__ void a_ready(const Unit&) const {}
    __device__ __forceinline__ void done(const Unit&) const {}
};
struct CountedOrder : StaticOrder {
    const unsigned* ready; unsigned need; unsigned* tmo;
    __device__ __forceinline__ void a_ready(const Unit& u) const {
        if (threadIdx.x < 64) {
            const unsigned long long t0 = __builtin_amdgcn_s_memrealtime(); unsigned polls = 0;
            while ((unsigned)__builtin_amdgcn_readfirstlane(__hip_atomic_load(ready + 64 * u.pm, __ATOMIC_RELAXED, __HIP_MEMORY_SCOPE_AGENT)) < need) {
                if ((++polls & 255u) == 0u && __builtin_amdgcn_readfirstlane(__hip_atomic_load(tmo, __ATOMIC_RELAXED, __HIP_MEMORY_SCOPE_AGENT)) != 0u) break;
                if (__builtin_amdgcn_s_memrealtime() - t0 > 2000000ull) {
                    if (threadIdx.x == 0) { unsigned expect = 0u; __hip_atomic_compare_exchange_strong(tmo + 1, &expect, 0x600u | (unsigned)(u.pm & 0xff), __ATOMIC_RELAXED, __ATOMIC_RELAXED, __HIP_MEMORY_SCOPE_AGENT); __hip_atomic_store(tmo, 1u, __ATOMIC_RELAXED, __HIP_MEMORY_SCOPE_AGENT); }
                    break; }
                __builtin_amdgcn_s_sleep(2); }
            __builtin_amdgcn_fence(__ATOMIC_ACQUIRE, "agent");
            asm volatile("s_waitcnt vmcnt(0)" ::: "memory");
        }
#if !defined(BROKEN_HOOK_NO_BARRIER)
        asm volatile("" ::: "memory"); __builtin_amdgcn_s_barrier(); asm volatile("" ::: "memory");
#endif
    }
};

__device__ __forceinline__ unsigned cvt_pk_bf16(float lo, float hi) { unsigned r; asm volatile("v_cvt_pk_bf16_f32 %0, %1, %2" : "=v"(r) : "v"(lo), "v"(hi)); return r; }
typedef float f32x2 __attribute__((ext_vector_type(2)));
__device__ __forceinline__ f32x2 gelu_pk(f32x2 v) {
    const f32x2 av = __builtin_elementwise_abs(v), d = av * 0.2316418882f + 1.0f;
    f32x2 t; t.x = __builtin_amdgcn_rcpf(d.x); t.y = __builtin_amdgcn_rcpf(d.y);
    f32x2 q = t * 0.5307027145f + (-0.7265760135f); q = q * t + 0.7107068705f; q = q * t + (-0.142248368f); q = q * t + 0.127414796f; q = q * t;
    const f32x2 s = (v * v) * (-0.72134752044f);
    f32x2 e; e.x = __builtin_amdgcn_exp2f(s.x); e.y = __builtin_amdgcn_exp2f(s.y);
    const f32x2 m = v * (q * e), r = v - m;
    f32x2 o; o.x = v.x < 0.f ? m.x : r.x; o.y = v.y < 0.f ? m.y : r.y; return o;
}

struct EpiF32 {
    static constexpr bool PERM = false, AFTER_DRAIN = false;
    float* C; int ldc; const float* bias;
    __device__ __forceinline__ void operator()(const f32x4 (&acc)[2][2][4][2], const Unit& u, int wr, int wc, int fr, int fq) const {
        const int row0 = u.pm * BM + wr * 64 + fr, col0 = u.pn * BM + wc * 32 + 4 * fq;
        f32x4 bv[2][2];
#pragma unroll
        for (int bj = 0; bj < 2; ++bj)
#pragma unroll
            for (int n = 0; n < 2; ++n) bv[bj][n] = bias ? *(const f32x4*)(bias + col0 + bj * HALF + n * 16) : (f32x4){0.f, 0.f, 0.f, 0.f};
#pragma unroll
        for (int ai = 0; ai < 2; ++ai)
#pragma unroll
            for (int m = 0; m < 4; ++m) { float* rowp = C + (size_t)(row0 + ai * HALF + m * 16) * ldc + col0;
#pragma unroll
                for (int bj = 0; bj < 2; ++bj)
#pragma unroll
                    for (int n = 0; n < 2; ++n) *(f32x4*)(rowp + bj * HALF + n * 16) = acc[ai][bj][m][n] + bv[bj][n]; }
    }
};
template <int ACT  > struct EpiBf16 {
    static constexpr bool PERM = true, AFTER_DRAIN = false;
    bf16_t* O; int ldc; const float* bias; int split_cols; size_t split_stride;
    __device__ __forceinline__ void operator()(const f32x4 (&acc)[2][2][4][2], const Unit& u, int wr, int wc, int fr, int fq) const {
        const int row0 = u.pm * BM + wr * 64 + fr; int colt = u.pn * BM; bf16_t* base = O;
        if (split_cols) { const int t = colt / split_cols; base += (size_t)t * split_stride; colt -= t * split_cols; }
        const int col0 = colt + wc * 32 + 8 * fq, bcol0 = u.pn * BM + wc * 32 + 8 * fq;
        f32x4 bv[2][2];
#pragma unroll
        for (int bj = 0; bj < 2; ++bj)
#pragma unroll
            for (int n = 0; n < 2; ++n) bv[bj][n] = bias ? *(const f32x4*)(bias + bcol0 + bj * HALF + 4 * n) : (f32x4){0.f, 0.f, 0.f, 0.f};
#pragma unroll
        for (int ai = 0; ai < 2; ++ai)
#pragma unroll
            for (int m = 0; m < 4; ++m) { bf16_t* rowp = base + (size_t)(row0 + ai * HALF + m * 16) * ldc + col0;
#pragma unroll
                for (int bj = 0; bj < 2; ++bj) { f32x4 v0 = acc[ai][bj][m][0] + bv[bj][0], v1 = acc[ai][bj][m][1] + bv[bj][1];
                    if (ACT == 1) { f32x2 a = gelu_pk((f32x2){v0[0], v0[1]}), b = gelu_pk((f32x2){v0[2], v0[3]}), c = gelu_pk((f32x2){v1[0], v1[1]}), d = gelu_pk((f32x2){v1[2], v1[3]});
                        v0 = (f32x4){a.x, a.y, b.x, b.y}; v1 = (f32x4){c.x, c.y, d.x, d.y}; }
                    if (ACT == 2) {
#pragma unroll
                        for (int j = 0; j < 4; ++j) { v0[j] = 0.5f * v0[j] * (1.0f + erff(v0[j] * 0.70710678f)); v1[j] = 0.5f * v1[j] * (1.0f + erff(v1[j] * 0.70710678f)); } }
                    u32x4 w; w.x = cvt_pk_bf16(v0[0], v0[1]); w.y = cvt_pk_bf16(v0[2], v0[3]); w.z = cvt_pk_bf16(v1[0], v1[1]); w.w = cvt_pk_bf16(v1[2], v1[3]);
                    *(u32x4*)(rowp + bj * HALF) = w; } }
    }
};
template <class Epi, class Sched, bool STAMP = false>
__device__ __forceinline__ void gemm_phase(PG8_LAS unsigned char* lds, const Gemm g, const Sched& S, const Epi& E, unsigned long long* stamps) {
    int tid_ = threadIdx.x; asm volatile("" : "+v"(tid_));
    const int tid = tid_, wid = __builtin_amdgcn_readfirstlane(tid >> 6), lane = tid & 63, wr = wid >> 2, wc = wid & 3, fr = lane & 15, fq = lane >> 4;
    const int K = g.K, nt = K / BK;
    int ts_lo = 0, ts_hi = 0, nts = 0; const unsigned long long rt_entry = STAMP ? (unsigned long long)wall_clock64() : 0ull;
#define PG8_STAMP() do { if (STAMP && wid == 0 && nts < 64) { const unsigned long long _c = (unsigned long long)clock64(); \
        ts_lo = (lane == nts) ? (int)(unsigned)_c : ts_lo; ts_hi = (lane == nts) ? (int)(unsigned)(_c >> 32) : ts_hi; ++nts; } } while (0)
    PG8_STAMP();
    unsigned voffA[2], voffB[2];
#pragma unroll
    for (int i = 0; i < 2; ++i) { int R, C; stage_rc(tid * 16 + i * 8192, R, C); const int Rb = Epi::PERM ? ((R & ~31) + perm32(R & 31)) : R;
        voffA[i] = (unsigned)(R * K + C) * 2u; voffB[i] = (unsigned)(Rb * K + C) * 2u; }
    const size_t kstep = (size_t)(BK * 2);
    const size_t hstep = (size_t)HALF * K * 2;
    const size_t tstep = 2 * hstep;
    const unsigned ldsw = (unsigned)wid * 1024u;
    const int aoff = lds_byte(wr * 64 + fr, fq * 8), boff = lds_byte(wc * 32 + fr, fq * 8);
#define PG8_SA(b, h) (((b) * 2 + (h)) * HTB)
#define PG8_SB(b, h) ((4 + (b) * 2 + (h)) * HTB)
#define PG8_STAGE(bufoff, gbase, voff) do { _Pragma("unroll") for (int _i = 0; _i < 2; ++_i) \
        __builtin_amdgcn_global_load_lds((const unsigned*)((const char*)(gbase) + (voff)[_i]), (PG8_LAS unsigned*)(lds + (bufoff) + ldsw + _i * 8192), 16, 0, 0); } while (0)
#define PG8_LDA(dst, b, h) do { _Pragma("unroll") for (int m = 0; m < 4; ++m) _Pragma("unroll") for (int k = 0; k < 2; ++k) dst[m][k] = *(const PG8_LAS bf16x8*)(lds + PG8_SA(b, h) + aoff + m * 2048 + k * 1024); } while (0)
#define PG8_LDB(dst, b, h) do { _Pragma("unroll") for (int n = 0; n < 2; ++n) _Pragma("unroll") for (int k = 0; k < 2; ++k) dst[n][k] = *(const PG8_LAS bf16x8*)(lds + PG8_SB(b, h) + boff + n * 2048 + k * 1024); } while (0)
#define PG8_MMA(ai, bj, At, Bt) do { __builtin_amdgcn_s_setprio(1); _Pragma("unroll") for (int m = 0; m < 4; ++m) _Pragma("unroll") for (int n = 0; n < 2; ++n) _Pragma("unroll") for (int k = 0; k < 2; ++k) \
        acc[ai][bj][m][n] = __builtin_amdgcn_mfma_f32_16x16x32_bf16(Bt[n][k], At[m][k], acc[ai][bj][m][n], 0, 0, 0); __builtin_amdgcn_s_setprio(0); } while (0)
#define PG8_WAIT_V(n) asm volatile("s_waitcnt vmcnt(" #n ")" ::: "memory")
#define PG8_WAIT_L(n) asm volatile("s_waitcnt lgkmcnt(" #n ")" ::: "memory")
#define PG8_BAR __builtin_amdgcn_s_barrier()
#define PG8_SCHED __builtin_amdgcn_sched_barrier(0)
    Unit cur, nxt; int ui = 0;
    if (!S.next(0, cur)) return;
    f32x4 acc[2][2][4][2];
#pragma unroll
    for (int a = 0; a < 2; ++a)
#pragma unroll
        for (int b = 0; b < 2; ++b)
#pragma unroll
            for (int m = 0; m < 4; ++m)
#pragma unroll
                for (int n = 0; n < 2; ++n) acc[a][b][m][n] = (f32x4){0.f, 0.f, 0.f, 0.f};
    bf16x8 At[4][2], B0[2][2], B1[2][2];
    const char* cA = (const char*)g.A + (size_t)cur.pm * tstep; const char* cB = (const char*)g.Bt + (size_t)cur.pn * tstep;
    S.a_ready(cur);
    PG8_STAGE(PG8_SB(0, 0), cB, voffB); PG8_STAGE(PG8_SA(0, 0), cA, voffA); PG8_STAGE(PG8_SB(0, 1), cB + hstep, voffB); PG8_STAGE(PG8_SA(0, 1), cA + hstep, voffA);
    if (wr == 1) PG8_BAR;
    PG8_WAIT_V(4); PG8_BAR;
    PG8_STAGE(PG8_SB(1, 0), cB + kstep, voffB); PG8_STAGE(PG8_SA(1, 0), cA + kstep, voffA); PG8_STAGE(PG8_SB(1, 1), cB + hstep + kstep, voffB);
    PG8_WAIT_V(6); PG8_BAR;
    PG8_STAMP();
    for (;;) {
        const bool has_next = S.next(ui + 1, nxt);
        const char* nA = has_next ? (const char*)g.A + (size_t)nxt.pm * tstep : cA; const char* nB = has_next ? (const char*)g.Bt + (size_t)nxt.pn * tstep : cB;
        for (int t = 0; t < nt; t += 2) {
            const bool last = (t == nt - 2);
            const char* a1 = cA + (size_t)(t + 1) * kstep;
            const char* a2 = last ? nA : cA + (size_t)(t + 2) * kstep; const char* b2 = last ? nB : cB + (size_t)(t + 2) * kstep;
            const char* a3 = a2 + kstep; const char* b3 = b2 + kstep;
            if (last && has_next) S.a_ready(nxt);
            PG8_LDB(B0, 0, 0); PG8_SCHED; PG8_LDA(At, 0, 0); PG8_STAGE(PG8_SA(1, 1), a1 + hstep, voffA);
            PG8_WAIT_L(8); PG8_BAR; PG8_WAIT_L(0); PG8_MMA(0, 0, At, B0); PG8_BAR; PG8_SCHED;
            PG8_LDB(B1, 0, 1); PG8_STAGE(PG8_SB(0, 0), b2, voffB);
            PG8_BAR; PG8_WAIT_L(0); PG8_MMA(0, 1, At, B1); PG8_BAR;
            PG8_LDA(At, 0, 1); PG8_STAGE(PG8_SA(0, 0), a2, voffA);
            PG8_BAR; PG8_WAIT_L(0); PG8_MMA(1, 0, At, B0); PG8_BAR; PG8_SCHED;
            PG8_STAGE(PG8_SB(0, 1), b2 + hstep, voffB);
            PG8_WAIT_V(6); PG8_BAR; PG8_MMA(1, 1, At, B1); PG8_BAR;
            PG8_LDB(B0, 1, 0); PG8_SCHED; PG8_LDA(At, 1, 0); PG8_STAGE(PG8_SA(0, 1), a2 + hstep, voffA);
            PG8_WAIT_L(8); PG8_BAR; PG8_WAIT_L(0); PG8_MMA(0, 0, At, B0); PG8_BAR; PG8_SCHED;
            PG8_LDB(B1, 1, 1); PG8_STAGE(PG8_SB(1, 0), b3, voffB);
            PG8_BAR; PG8_WAIT_L(0); PG8_MMA(0, 1, At, B1); PG8_BAR;
            PG8_LDA(At, 1, 1); PG8_STAGE(PG8_SA(1, 0), a3, voffA);
            PG8_BAR; PG8_WAIT_L(0); PG8_MMA(1, 0, At, B0); PG8_BAR; PG8_SCHED;
            PG8_STAGE(PG8_SB(1, 1), b3 + hstep, voffB);
            PG8_WAIT_V(6); PG8_BAR; PG8_MMA(1, 1, At, B1); PG8_BAR;
        }
        PG8_STAMP();
        if constexpr (!Epi::AFTER_DRAIN) { E(acc, cur, wr, wc, fr, fq); S.done(cur); }
        PG8_STAMP();
        if (!has_next) break;
#pragma unroll
        for (int a = 0; a < 2; ++a)
#pragma unroll
            for (int b = 0; b < 2; ++b)
#pragma unroll
                for (int m = 0; m < 4; ++m)
#pragma unroll
                    for (int n = 0; n < 2; ++n) acc[a][b][m][n] = (f32x4){0.f, 0.f, 0.f, 0.f};
        cur = nxt; cA = nA; cB = nB; ++ui;
    }
    PG8_WAIT_V(0);
    if (wr == 0) PG8_BAR;
    PG8_BAR;
    if constexpr (Epi::AFTER_DRAIN) { E.fused(acc, cur, wr, wc, fr, fq, lds, wid, lane); S.done(cur); }
    PG8_STAMP();
    if (STAMP && wid == 0) { stamps[lane] = lane < nts ? (((unsigned long long)(unsigned)ts_hi << 32) | (unsigned)ts_lo) : 0ull;
        if (lane == 62) stamps[62] = rt_entry; if (lane == 63) stamps[63] = (unsigned long long)wall_clock64(); }
#undef PG8_STAMP
#undef PG8_SA
#undef PG8_SB
#undef PG8_STAGE
#undef PG8_LDA
#undef PG8_LDB
#undef PG8_MMA
#undef PG8_WAIT_V
#undef PG8_WAIT_L
#undef PG8_BAR
#undef PG8_SCHED
}
}
#define XB_TMO      128
#define XB_XCNT(j)  (256  + 64 * (j))
#define XB_XSUB(j)  (1280 + 64 * (j))
#define XB_XGEN(j)  (2304 + 64 * (j))
#define XB_TOP      3328
#define XB_TOPGEN   3392
#define XCD_BAR_WORDS 3456
#define XB_SPIN_CAP (1u << 18)
#define LAS __attribute__((address_space(3)))

__device__ __forceinline__ unsigned xb_ld(unsigned* p)              { return __hip_atomic_load(p, __ATOMIC_RELAXED, __HIP_MEMORY_SCOPE_AGENT); }
__device__ __forceinline__ unsigned xb_add(unsigned* p, unsigned v) { return __hip_atomic_fetch_add(p, v, __ATOMIC_RELAXED, __HIP_MEMORY_SCOPE_AGENT); }
__device__ __forceinline__ unsigned xb_xcc_id() { return (unsigned)__builtin_amdgcn_s_getreg((3 << 11) | 20) & 0xFu; }
#define XB_SPIN(cond, bar) do { unsigned _sp = 0; while (cond) { __builtin_amdgcn_s_sleep(1); \
    if ((++_sp & 255u) == 0u) { if (xb_ld(&(bar)[XB_TMO])) break; if (_sp > XB_SPIN_CAP) { atomicAdd(&(bar)[XB_TMO], 1u); break; } } } } while (0)

struct XcdBarrier {
    unsigned* bar; unsigned x;
    volatile LAS unsigned* st;
};

__device__ __forceinline__ XcdBarrier xcd_barrier_post(unsigned* bar, volatile LAS unsigned* st) {
    XcdBarrier b; b.bar = bar; b.x = xb_xcc_id(); b.st = st;
    if (threadIdx.x == 0) (void)xb_add(&bar[XB_XCNT(b.x)], 1u);
    return b;
}
__device__ __forceinline__ void xcd_barrier_complete(unsigned* bar, unsigned x, unsigned& nloc, unsigned& nx) {
    const unsigned G = gridDim.x * gridDim.y * gridDim.z;
    unsigned sum, cnt, mine, sp = 0u;
    for (;;) {
        sum = 0u; cnt = 0u; mine = 0u;
#pragma unroll
        for (unsigned j = 0; j < 16; ++j) { const unsigned c = xb_ld(&bar[XB_XCNT(j)]); sum += c; cnt += (c > 0u) ? 1u : 0u; mine = (j == x) ? c : mine; }
        if (sum == G) break;
        __builtin_amdgcn_s_sleep(1);
        if ((++sp & 255u) == 0u) { if (xb_ld(&bar[XB_TMO])) break; if (sp > XB_SPIN_CAP) { atomicAdd(&bar[XB_TMO], 1u); break; } }
    }
    nloc = mine > 0u ? mine : 1u; nx = cnt > 0u ? cnt : 1u;
}

__device__ __forceinline__ void xcd_barrier(const XcdBarrier& b) {
    asm volatile("s_waitcnt vmcnt(0)" ::: "memory");
    __syncthreads();
    if (threadIdx.x == 0) {
        unsigned* bar = b.bar;
        __builtin_amdgcn_s_waitcnt(0);
        unsigned nloc = b.st[0], nx = b.st[1];
        if (nloc == 0u) { xcd_barrier_complete(bar, b.x, nloc, nx); b.st[0] = nloc; b.st[1] = nx; }
        const unsigned old = xb_add(&bar[XB_XSUB(b.x)], 1u);
        const unsigned gen = old / nloc;
        if (old + 1u == (gen + 1u) * nloc) {
            __builtin_amdgcn_fence(__ATOMIC_RELEASE, "agent");
            asm volatile("s_waitcnt vmcnt(0)" ::: "memory");
            const unsigned og = xb_add(&bar[XB_TOP], 1u);
            const unsigned tg = og / nx;
            if (og + 1u == (tg + 1u) * nx) xb_add(&bar[XB_TOPGEN], 1u);
            else XB_SPIN(xb_ld(&bar[XB_TOPGEN]) == tg, bar);
            __builtin_amdgcn_fence(__ATOMIC_ACQUIRE, "agent");
            xb_add(&bar[XB_XGEN(b.x)], 1u);
            asm volatile("s_waitcnt vmcnt(0)" ::: "memory");
        } else {
            XB_SPIN(xb_ld(&bar[XB_XGEN(b.x)]) == gen, bar);
            __builtin_amdgcn_fence(__ATOMIC_ACQUIRE, "agent");
            asm volatile("s_waitcnt vmcnt(0)" ::: "memory");
        }
    }
    __syncthreads();
}

namespace mk {
using pg8::bf16_t; using pg8::bf16x8; using pg8::f32x4; using pg8::u32x4;
typedef unsigned u32x2 __attribute__((ext_vector_type(2)));
typedef __bf16 bf16x2_t __attribute__((ext_vector_type(2)));
typedef LAS unsigned char* lds_t;

constexpr int DM = 1024, NLAT = 16384, NROW = 16896;
constexpr int OFF_B = 512, OFF_C = 1024, OFF_D = 2056, INC = 3208, NP = 3328;
constexpr int NCH = 132, NSLOT = 16 * NCH;
constexpr int NEXP = 16384;

constexpr size_t WS_CTL  = 0;
constexpr size_t WS_MOD  = 65536;
constexpr size_t WS_WIN  = WS_MOD + 147456;
constexpr size_t WS_WOUT = WS_WIN + 2ull * NP * DM * 2;
constexpr size_t WS_WQ   = WS_WOUT + 2ull * DM * DM * 2;
constexpr size_t WS_H    = WS_WQ + 2ull * 2048 * DM * 2;
constexpr size_t WS_ACT  = WS_H + (size_t)NROW * DM * 4;
constexpr size_t WS_UB   = WS_ACT + (size_t)NROW * DM * 2;
constexpr size_t WS_VB   = WS_UB + (size_t)NEXP * DM * 2;
constexpr size_t WS_SU   = WS_UB + (size_t)NEXP * DM;
constexpr size_t WS_SV   = WS_VB + (size_t)NEXP * DM;
constexpr size_t WS_P    = WS_VB + (size_t)NEXP * DM * 2;
constexpr size_t WS_Q    = WS_P;
constexpr size_t WS_SELI = WS_Q + (size_t)NROW * 2048 * 2;
constexpr size_t WS_SELG = WS_SELI + (size_t)NROW * 128 * 4;
constexpr size_t WS_MST  = WS_P + (size_t)NROW * NP * 2;
constexpr size_t WS_MCD  = WS_MST + (size_t)NSLOT * 8192 * 4;
constexpr size_t WS_RG   = WS_MCD + 16384;
constexpr size_t WS_RJ   = WS_RG + (size_t)NSLOT * 8192;
constexpr size_t WS_RY   = WS_RJ + (size_t)NSLOT * 16384;
constexpr size_t WS_RL   = WS_RY + (size_t)NSLOT * 8192;
constexpr size_t WS_RH   = WS_RL + (size_t)NSLOT * 8192;
constexpr size_t WS_BON  = WS_RH + (size_t)NSLOT * 8192;
constexpr size_t WS_END  = WS_BON + (size_t)NROW * 8 * 4;
static_assert(WS_SELG + (size_t)NROW * 128 * 4 <= WS_MST, "Q + selections must fit in P's region");

constexpr int LDS_BYTES = 157440;
constexpr int LDS_XB = 157184;

struct Args { const float* in[42]; float* out; unsigned char* ws; int ph_lo, ph_hi; };

struct Ctx {
    const float* const* in; float* out; unsigned char* ws; lds_t lds;
    int tid, lane, wid, bid, G;
};

__device__ __forceinline__ float bf2f(unsigned short x) { return __uint_as_float(((unsigned)x) << 16); }
__device__ __forceinline__ float bflo(unsigned w) { return __uint_as_float(w << 16); }
__device__ __forceinline__ float bfhi(unsigned w) { return __uint_as_float(w & 0xffff0000u); }
typedef __bf16 bf16pair_t __attribute__((ext_vector_type(2)));
__device__ __forceinline__ unsigned pk2(float lo, float hi) { const bf16pair_t v = {(__bf16)lo, (__bf16)hi}; return __builtin_bit_cast(unsigned, v); }
__device__ __forceinline__ unsigned short f2bf(float f) { return (unsigned short)(pk2(f, 0.f) & 0xffffu); }
__device__ __forceinline__ float wave_sum(float v) {
#pragma unroll
    for (int o = 1; o < 64; o <<= 1) v += __shfl_xor(v, o);
    return v;
}
#define dpp_f(old, src, ctrl, row_mask, bank_mask) __uint_as_float((unsigned)__builtin_amdgcn_update_dpp((int)__float_as_uint(old), (int)__float_as_uint(src), ctrl, row_mask, bank_mask, true))
__device__ __forceinline__ float wave_incl_scan(float v, int lane) {
    (void)lane;
    float s = v + dpp_f(0.f, v, 0x111, 0xF, 0xF);
    s += dpp_f(0.f, v, 0x112, 0xF, 0xF);
    s += dpp_f(0.f, v, 0x113, 0xF, 0xF);
    s += dpp_f(0.f, s, 0x114, 0xF, 0xE);
    s += dpp_f(0.f, s, 0x118, 0xF, 0xC);
    s += dpp_f(0.f, s, 0x142, 0xA, 0xF);
    s += dpp_f(0.f, s, 0x143, 0xC, 0xF);
    return s;
}
__device__ __forceinline__ float fexp(float x) { return __expf(x); }
__device__ __forceinline__ float frcp(float x) { return __builtin_amdgcn_rcpf(x); }
__device__ __forceinline__ float sigm(float x) { return frcp(1.f + __expf(-x)); }
__device__ __forceinline__ float silu(float x) { return x * frcp(1.f + __expf(-x)); }
__device__ __forceinline__ float softplus(float x) { return fmaxf(x, 0.f) + __logf(1.f + __expf(-fabsf(x))); }
__device__ __forceinline__ float ftanh(float x) { const float e = __expf(-2.f * fabsf(x)); const float t = (1.f - e) * frcp(1.f + e); return x < 0.f ? -t : t; }
__device__ __forceinline__ float gelu_tanh(float x) { const float u = 0.7978845608028654f * (x + 0.044715f * x * x * x); return 0.5f * x * (1.f + ftanh(u)); }
__device__ __forceinline__ float dot2bf(unsigned a, unsigned b, float acc) { return __builtin_amdgcn_fdot2_f32_bf16(__builtin_bit_cast(bf16x2_t, a), __builtin_bit_cast(bf16x2_t, b), acc, false); }

struct ChunkInfo { int row0, lo, hi, b, tc, isctx; };
__device__ __forceinline__ ChunkInfo chunk_info(int gc) {
    ChunkInfo c; c.row0 = gc * 64;
    if (gc < 256) { c.b = gc >> 7; c.tc = gc & 127; c.isctx = 0; c.lo = c.b * 8192; c.hi = c.lo + 8192; }
    else { const int q = gc - 256; c.b = q >> 2; c.tc = q & 3; c.isctx = 1; c.lo = NLAT + c.b * 256; c.hi = c.lo + 256; }
    return c;
}
__device__ __forceinline__ int cpos_of(const ChunkInfo& c, int d) { return c.isctx ? (d ? 3 - c.tc : c.tc) : (d ? 4 + 127 - c.tc : 4 + c.tc); }
__device__ __forceinline__ int slot_of(int b, int h, int d, int cpos) { return ((b * 4 + h) * 2 + d) * NCH + cpos; }

template <int MT, int NT, int KS, class Epi>
__device__ __forceinline__ void blk_mma(const LAS bf16_t* A, int lda, const LAS bf16_t* Bt, int ldb, int wid, int lane, Epi epi) {
    const int fr = lane & 15, fq = lane >> 4;
    for (int tt = wid; tt < MT * NT; tt += 8) {
        const int tm = tt / NT, tn = tt % NT;
        f32x4 acc = {0.f, 0.f, 0.f, 0.f};
#pragma unroll
        for (int ks = 0; ks < KS; ++ks) {
            const bf16x8 a = *(const LAS bf16x8*)(A + (tm * 16 + fr) * lda + ks * 32 + fq * 8);
            const bf16x8 b = *(const LAS bf16x8*)(Bt + (tn * 16 + fr) * ldb + ks * 32 + fq * 8);
            acc = __builtin_amdgcn_mfma_f32_16x16x32_bf16(a, b, acc, 0, 0, 0);
        }
        epi(tm * 16 + fq * 4, tn * 16 + fr, acc);
    }
}
template <int MT, int NT, int KS, class Epi>
__device__ __forceinline__ void blk_mma2(const LAS bf16_t* A1, const LAS bf16_t* B1, const LAS bf16_t* A2, const LAS bf16_t* B2, int ld, int wid, int lane, Epi epi) {
    const int fr = lane & 15, fq = lane >> 4;
    for (int tt = wid; tt < MT * NT; tt += 8) {
        const int tm = tt / NT, tn = tt % NT;
        f32x4 acc1 = {0.f, 0.f, 0.f, 0.f}, acc2 = {0.f, 0.f, 0.f, 0.f};
#pragma unroll
        for (int ks = 0; ks < KS; ++ks) {
            const bf16x8 a1 = *(const LAS bf16x8*)(A1 + (tm * 16 + fr) * ld + ks * 32 + fq * 8);
            const bf16x8 b1 = *(const LAS bf16x8*)(B1 + (tn * 16 + fr) * ld + ks * 32 + fq * 8);
            acc1 = __builtin_amdgcn_mfma_f32_16x16x32_bf16(a1, b1, acc1, 0, 0, 0);
            const bf16x8 a2 = *(const LAS bf16x8*)(A2 + (tm * 16 + fr) * ld + ks * 32 + fq * 8);
            const bf16x8 b2 = *(const LAS bf16x8*)(B2 + (tn * 16 + fr) * ld + ks * 32 + fq * 8);
            acc2 = __builtin_amdgcn_mfma_f32_16x16x32_bf16(a2, b2, acc2, 0, 0, 0);
        }
        epi(tm * 16 + fq * 4, tn * 16 + fr, acc1, acc2);
    }
}


template <int MT, int NT, class Epi>
__device__ __forceinline__ void small_gemm_tile(const Ctx& C, const bf16_t* A, const bf16_t* Bt, int K, Epi epi) {
    constexpr int AR = MT * 16, BR = NT * 16, PITCH = 264, NA = AR * 32 / 512, NB = BR * 32 / 512;
    LAS bf16_t* As = (LAS bf16_t*)C.lds; LAS bf16_t* Bs = As + AR * PITCH;
    u32x4 ra[NA], rb[NB];
    auto fetch = [&](int k0) {
#pragma unroll
        for (int i = 0; i < NA; ++i) { const int e = C.tid + 512 * i; ra[i] = *(const u32x4*)(A + (size_t)(e >> 5) * K + k0 + (e & 31) * 8); }
#pragma unroll
        for (int i = 0; i < NB; ++i) { const int e = C.tid + 512 * i; rb[i] = *(const u32x4*)(Bt + (size_t)(e >> 5) * K + k0 + (e & 31) * 8); } };
    const int fr = C.lane & 15, fq = C.lane >> 4;
    constexpr int TPW = (MT * NT + 7) / 8;
    f32x4 acc[TPW];
#pragma unroll
    for (int i = 0; i < TPW; ++i) acc[i] = (f32x4){0.f, 0.f, 0.f, 0.f};
    fetch(0);
    for (int k0 = 0; k0 < K; k0 += 256) {
        __syncthreads();
#pragma unroll
        for (int i = 0; i < NA; ++i) { const int e = C.tid + 512 * i; *(LAS u32x4*)(As + (e >> 5) * PITCH + (e & 31) * 8) = ra[i]; }
#pragma unroll
        for (int i = 0; i < NB; ++i) { const int e = C.tid + 512 * i; *(LAS u32x4*)(Bs + (e >> 5) * PITCH + (e & 31) * 8) = rb[i]; }
        if (k0 + 256 < K) fetch(k0 + 256);
        __syncthreads();
#pragma unroll
        for (int i = 0; i < TPW; ++i) { const int tt = C.wid + 8 * i; if (tt < MT * NT) { const int tm = tt / NT, tn = tt % NT;
#pragma unroll
            for (int ks = 0; ks < 8; ++ks) acc[i] = __builtin_amdgcn_mfma_f32_16x16x32_bf16(*(const LAS bf16x8*)(As + (tm * 16 + fr) * PITCH + ks * 32 + fq * 8),
                                                                                           *(const LAS bf16x8*)(Bs + (tn * 16 + fr) * PITCH + ks * 32 + fq * 8), acc[i], 0, 0, 0); } }
    }
#pragma unroll
    for (int i = 0; i < TPW; ++i) { const int tt = C.wid + 8 * i; if (tt < MT * NT) epi((tt / NT) * 16 + fq * 4, (tt % NT) * 16 + fr, acc[i]); }
    __syncthreads();
}

__device__ __forceinline__ void transpose_item(const float* W, int K, int N, int nblk, bf16_t* WT, LAS float* scr, int item, int lane) {
    const int kb = item / nblk, nb = item % nblk, k0 = 64 * kb, n0 = 32 * nb;
    const int nn = n0 + (lane & 31);
#pragma unroll 8
    for (int i = 0; i < 32; ++i) { const int kk = 2 * i + (lane >> 5); scr[kk * 33 + (lane & 31)] = (nn < N) ? W[(size_t)(k0 + kk) * N + nn] : 0.f; }
    asm volatile("s_waitcnt lgkmcnt(0)" ::: "memory");
    const int c = lane & 7;
#pragma unroll
    for (int j = 0; j < 4; ++j) { const int n = (lane >> 3) + 8 * j; const LAS float* s = scr + (8 * c) * 33 + n;
        u32x4 o; o.x = pk2(s[0 * 33], s[1 * 33]); o.y = pk2(s[2 * 33], s[3 * 33]); o.z = pk2(s[4 * 33], s[5 * 33]); o.w = pk2(s[6 * 33], s[7 * 33]);
        *(u32x4*)(WT + (size_t)(n0 + n) * K + k0 + 8 * c) = o; }
    asm volatile("s_waitcnt lgkmcnt(0)" ::: "memory");
}
__device__ __forceinline__ float wave_maxf(float v) {
#pragma unroll
    for (int o = 1; o < 64; o <<= 1) v = fmaxf(v, __shfl_xor(v, o));
    return v;
}
__device__ __forceinline__ void convert_tables(const Ctx& C, int layer, int rank, int nrank) {
    const float* U = C.in[39] + (size_t)layer * NEXP * DM; const float* V = C.in[40] + (size_t)layer * NEXP * DM;
    unsigned char* UB = C.ws + WS_UB; unsigned char* VB = C.ws + WS_VB; float* SU = (float*)(C.ws + WS_SU); float* SV = (float*)(C.ws + WS_SV);
    for (int r4 = (rank * 8 + C.wid) * 2; r4 < 2 * NEXP; r4 += nrank * 8 * 2) {
        const bool isv = r4 >= NEXP; const int row0 = isv ? r4 - NEXP : r4;
        const float* src = (isv ? V : U) + (size_t)row0 * DM + 16 * C.lane;
        f32x4 x[2][4];
#pragma unroll
        for (int q = 0; q < 2; ++q)
#pragma unroll
            for (int k = 0; k < 4; ++k) x[q][k] = *(const f32x4*)(src + (size_t)q * DM + 4 * k);
#pragma unroll
        for (int q = 0; q < 2; ++q) {
            float m = 0.f;
#pragma unroll
            for (int k = 0; k < 4; ++k) m = fmaxf(fmaxf(m, fmaxf(fabsf(x[q][k].x), fabsf(x[q][k].y))), fmaxf(fabsf(x[q][k].z), fabsf(x[q][k].w)));
            m = wave_maxf(m);
            const float sc = m > 0.f ? 224.f / m : 1.f;
            u32x4 o;
#pragma unroll
            for (int k = 0; k < 4; ++k) { int w = __builtin_amdgcn_cvt_pk_fp8_f32(x[q][k].x * sc, x[q][k].y * sc, 0, false); w = __builtin_amdgcn_cvt_pk_fp8_f32(x[q][k].z * sc, x[q][k].w * sc, w, true); o[k] = (unsigned)w; }
            *(u32x4*)((isv ? VB : UB) + (size_t)(row0 + q) * DM + 16 * C.lane) = o;
            if (C.lane == 0) (isv ? SV : SU)[row0 + q] = m > 0.f ? m * (1.f / 224.f) : 1.f;
        }
    }
}
__device__ __forceinline__ void ph_prologue(const Ctx& C) {
    const int gw = C.bid * 8 + C.wid, NGW = C.G * 8;
    {
        LAS float* scr = (LAS float*)(C.lds + C.wid * 16384);
        bf16_t* WIN = (bf16_t*)(C.ws + WS_WIN); bf16_t* WOUT = (bf16_t*)(C.ws + WS_WOUT); bf16_t* WQ = (bf16_t*)(C.ws + WS_WQ);
        for (int it = gw; it < 6400; it += NGW) {
            const int layer = it / 3200; int r = it % 3200;
            if (r < 1664) { transpose_item(C.in[8] + (size_t)layer * DM * INC, DM, INC, 104, WIN + (size_t)layer * NP * DM, scr, r, C.lane); continue; } r -= 1664;
            if (r < 512) { transpose_item(C.in[9] + (size_t)layer * DM * DM, DM, DM, 32, WOUT + (size_t)layer * DM * DM, scr, r, C.lane); continue; } r -= 512;
            transpose_item(C.in[36] + (size_t)layer * DM * 2048, DM, 2048, 64, WQ + (size_t)layer * 2048 * DM, scr, r, C.lane);
        }
    }
    __syncthreads();
    {
        LAS float* sv = (LAS float*)C.lds;
        LAS float* red = (LAS float*)(C.lds + 12288);
        for (int i = C.tid; i < 3 * 1024; i += 512) { const int w = i >> 10, k = i & 1023; const float x = (w < 2) ? C.in[1][w * 1024 + k] : C.in[3][k]; sv[i] = silu(x); }
        __syncthreads();
        float* MOD = (float*)(C.ws + WS_MOD);
        for (int it = C.bid; it < 192; it += C.G) {
            const int layer = it / 96, col0 = (it % 96) * 64, col = C.tid & 63, kg = C.tid >> 6;
            const float* W = C.in[4] + (size_t)layer * DM * 6144 + col0 + col;
            float a0 = 0.f, a1 = 0.f, a2 = 0.f;
#pragma unroll 32
            for (int k = kg * 128; k < kg * 128 + 128; ++k) { const float w = W[(size_t)k * 6144]; a0 += sv[k] * w; a1 += sv[1024 + k] * w; a2 += sv[2048 + k] * w; }
            red[(kg * 3 + 0) * 64 + col] = a0; red[(kg * 3 + 1) * 64 + col] = a1; red[(kg * 3 + 2) * 64 + col] = a2;
            __syncthreads();
            if (C.tid < 192) { const int w = C.tid >> 6, c2 = C.tid & 63; float s = 0.f;
#pragma unroll
                for (int g = 0; g < 8; ++g) s += red[(g * 3 + w) * 64 + c2];
                MOD[((size_t)layer * 3 + w) * 6144 + col0 + c2] = s + C.in[5][layer * 6144 + col0 + c2]; }
            __syncthreads();
        }
    }
    {
        float* H = (float*)(C.ws + WS_H);
        const size_t n4 = (size_t)NROW * 256;
        for (size_t i = (size_t)C.bid * 512 + C.tid; i < n4; i += (size_t)C.G * 512) {
            const int row = (int)(i >> 8), c4 = (int)(i & 255) * 4;
            f32x4 v;
            if (row < NLAT) {
                v = *(const f32x4*)(C.in[0] + (size_t)row * DM + c4);
                const int t = row & 8191, quarter = c4 >> 8; const float pos = (quarter < 2) ? (float)(t >> 6) : (float)(t & 63);
                float e[4];
#pragma unroll
                for (int j = 0; j < 4; ++j) { const int jj = (c4 & 255) + j; const float fr = exp2f(-(float)jj * (13.287712379549449f / 256.f)); const float a = pos * fr; e[j] = (quarter & 1) ? cosf(a) : sinf(a); }
                v.x += e[0]; v.y += e[1]; v.z += e[2]; v.w += e[3];
            } else v = *(const f32x4*)(C.in[2] + (size_t)(row - NLAT) * DM + c4);
            *(f32x4*)(H + (size_t)row * DM + c4) = v;
        }
    }
}

struct Row16 { float v[16]; };
__device__ __forceinline__ Row16 load_row16(const float* p, int lane) {
    Row16 r; const f32x4 a = *(const f32x4*)(p + 8 * lane), b = *(const f32x4*)(p + 8 * lane + 4), c = *(const f32x4*)(p + 512 + 8 * lane), d = *(const f32x4*)(p + 512 + 8 * lane + 4);
    r.v[0] = a.x; r.v[1] = a.y; r.v[2] = a.z; r.v[3] = a.w; r.v[4] = b.x; r.v[5] = b.y; r.v[6] = b.z; r.v[7] = b.w;
    r.v[8] = c.x; r.v[9] = c.y; r.v[10] = c.z; r.v[11] = c.w; r.v[12] = d.x; r.v[13] = d.y; r.v[14] = d.z; r.v[15] = d.w; return r;
}
__device__ __forceinline__ void store_row16_f32(float* p, int lane, const Row16& r) {
    *(f32x4*)(p + 8 * lane) = (f32x4){r.v[0], r.v[1], r.v[2], r.v[3]}; *(f32x4*)(p + 8 * lane + 4) = (f32x4){r.v[4], r.v[5], r.v[6], r.v[7]};
    *(f32x4*)(p + 512 + 8 * lane) = (f32x4){r.v[8], r.v[9], r.v[10], r.v[11]}; *(f32x4*)(p + 512 + 8 * lane + 4) = (f32x4){r.v[12], r.v[13], r.v[14], r.v[15]};
}
__device__ __forceinline__ void store_row16_bf16(bf16_t* p, int lane, const Row16& r) {
    u32x4 a, b; a.x = pk2(r.v[0], r.v[1]); a.y = pk2(r.v[2], r.v[3]); a.z = pk2(r.v[4], r.v[5]); a.w = pk2(r.v[6], r.v[7]);
    b.x = pk2(r.v[8], r.v[9]); b.y = pk2(r.v[10], r.v[11]); b.z = pk2(r.v[12], r.v[13]); b.w = pk2(r.v[14], r.v[15]);
    *(u32x4*)(p + 8 * lane) = a; *(u32x4*)(p + 512 + 8 * lane) = b;
}
__device__ __forceinline__ Row16 norm_mod_row(const Row16& x, const float* g, const float* shift, const float* scale, int lane) {
    float ss = 0.f;
#pragma unroll
    for (int i = 0; i < 16; ++i) ss += x.v[i] * x.v[i];
    const float rs = rsqrtf(wave_sum(ss) * (1.f / 1024.f) + 1e-6f);
    const Row16 gg = load_row16(g, lane), sh = load_row16(shift, lane), sc = load_row16(scale, lane);
    Row16 o;
#pragma unroll
    for (int i = 0; i < 16; ++i) o.v[i] = (x.v[i] * rs * gg.v[i]) * (1.f + sc.v[i]) + sh.v[i];
    return o;
}
__device__ __forceinline__ int which_of(int row) { return row < 8192 ? 0 : (row < NLAT ? 1 : 2); }
__device__ __forceinline__ void ph_norm(const Ctx& C, int layer, const float* gain, int sidx, int nrows) {
    const float* H = (const float*)(C.ws + WS_H); bf16_t* ACT = (bf16_t*)(C.ws + WS_ACT); const float* MOD = (const float*)(C.ws + WS_MOD);
    for (int row = C.bid * 8 + C.wid; row < nrows; row += C.G * 8) {
        const float* m = MOD + ((size_t)layer * 3 + which_of(row)) * 6144;
        const Row16 x = load_row16(H + (size_t)row * DM, C.lane);
        const Row16 o = norm_mod_row(x, gain, m + sidx * 1024, m + (sidx + 1) * 1024, C.lane);
        store_row16_bf16(ACT + (size_t)row * DM, C.lane, o);
    }
}
struct EpiResid {
    static constexpr bool PERM = false, AFTER_DRAIN = false;
    float* H; const float* modl;
    __device__ __forceinline__ void operator()(const f32x4 (&acc)[2][2][4][2], const pg8::Unit& u, int wr, int wc, int fr, int fq) const {
        const int row0 = u.pm * 256 + wr * 64 + fr, col0 = u.pn * 256 + wc * 32 + 4 * fq;
        const int which = u.pm < 32 ? 0 : (u.pm < 64 ? 1 : 2);
        const float* gate = modl + ((size_t)which * 6 + 2) * 1024;
        f32x4 gv[2][2];
#pragma unroll
        for (int bj = 0; bj < 2; ++bj)
#pragma unroll
            for (int n = 0; n < 2; ++n) gv[bj][n] = *(const f32x4*)(gate + col0 + bj * 128 + n * 16);
#pragma unroll
        for (int ai = 0; ai < 2; ++ai)
#pragma unroll
            for (int m = 0; m < 4; ++m) { float* rowp = H + (size_t)(row0 + ai * 128 + m * 16) * DM + col0;
#pragma unroll
                for (int bj = 0; bj < 2; ++bj)
#pragma unroll
                    for (int n = 0; n < 2; ++n) { f32x4* p = (f32x4*)(rowp + bj * 128 + n * 16); *p = *p + gv[bj][n] * acc[ai][bj][m][n]; } }
    }
};

__device__ __forceinline__ void item_conformer(const Ctx& C, int layer, int gc) {
    const ChunkInfo ci = chunk_info(gc);
    const bf16_t* P = (const bf16_t*)(C.ws + WS_P); bf16_t* YC = (bf16_t*)(C.ws + WS_ACT);
    LAS bf16_t* HG = (LAS bf16_t*)C.lds;
    LAS float* CO = (LAS float*)(C.lds + 49152);
    for (int e = C.tid; e < 94 * 128; e += 512) {
        const int rr = e >> 7, cp = e & 127, grow = ci.row0 - 15 + rr;
        const bool ok = grow >= ci.lo && grow < ci.hi; const int gr = ok ? grow : ci.row0;
        const unsigned v = *(const unsigned*)(P + (size_t)gr * NP + 2 * cp), g = *(const unsigned*)(P + (size_t)gr * NP + 256 + 2 * cp);
        const unsigned o = pk2(bflo(v) * sigm(bflo(g)), bfhi(v) * sigm(bfhi(g)));
        *(LAS unsigned*)(HG + rr * 256 + 2 * cp) = ok ? o : 0u;
    }
    __syncthreads();
    {
        const int c = C.tid & 255, half = C.tid >> 8;
        const float* cw = C.in[10] + (size_t)layer * 31 * 256 + c;
        float w[31];
#pragma unroll
        for (int j = 0; j < 31; ++j) w[j] = cw[j * 256];
        const float bias = C.in[11][layer * 256 + c];
        for (int tt = 0; tt < 32; ++tt) {
            const int t = half * 32 + tt; float acc = bias;
#pragma unroll
            for (int j = 0; j < 31; ++j) acc += w[j] * bf2f(HG[(t + j) * 256 + c]);
            CO[t * 256 + c] = acc;
        }
    }
    __syncthreads();
    {
        const float* lg = C.in[12] + layer * 256 + 4 * C.lane; const float* lb = C.in[13] + layer * 256 + 4 * C.lane;
        const f32x4 g4 = *(const f32x4*)lg, b4 = *(const f32x4*)lb;
        for (int i = 0; i < 8; ++i) {
            const int t = C.wid * 8 + i;
            const f32x4 x = *(const LAS f32x4*)(CO + t * 256 + 4 * C.lane);
            const float mean = wave_sum((x.x + x.y) + (x.z + x.w)) * (1.f / 256.f);
            const f32x4 d = x - mean;
            const float var = wave_sum((d.x * d.x + d.y * d.y) + (d.z * d.z + d.w * d.w)) * (1.f / 256.f);
            const float rs = rsqrtf(var + 1e-5f);
            const f32x4 y = d * rs * g4 + b4;
            u32x2 o; o.x = pk2(silu(y.x), silu(y.y)); o.y = pk2(silu(y.z), silu(y.w));
            *(u32x2*)(YC + (size_t)(ci.row0 + t) * DM + 4 * C.lane) = o;
        }
    }
    __syncthreads();
}

__device__ __forceinline__ void item_chunkmlp(const Ctx& C, int layer, int gb) {
    const int row0 = gb * 128;
    const bf16_t* P = (const bf16_t*)(C.ws + WS_P); bf16_t* YC = (bf16_t*)(C.ws + WS_ACT);
    LAS bf16_t* VNT = (LAS bf16_t*)C.lds;
    LAS bf16_t* WS = (LAS bf16_t*)(C.lds + 69632);
    {
        const f32x4 g4 = *(const f32x4*)(C.in[14] + layer * 256 + 4 * C.lane), b4 = *(const f32x4*)(C.in[15] + layer * 256 + 4 * C.lane);
        for (int i = 0; i < 16; ++i) {
            const int j = C.wid * 16 + i;
            const u32x2 raw = *(const u32x2*)(P + (size_t)(row0 + j) * NP + 768 + 4 * C.lane);
            const f32x4 x = {bflo(raw.x), bfhi(raw.x), bflo(raw.y), bfhi(raw.y)};
            const float mean = wave_sum((x.x + x.y) + (x.z + x.w)) * (1.f / 256.f);
            const f32x4 d = x - mean;
            const float var = wave_sum((d.x * d.x + d.y * d.y) + (d.z * d.z + d.w * d.w)) * (1.f / 256.f);
            const f32x4 y = d * rsqrtf(var + 1e-5f) * g4 + b4;
            VNT[(4 * C.lane + 0) * 136 + j] = f2bf(y.x); VNT[(4 * C.lane + 1) * 136 + j] = f2bf(y.y);
            VNT[(4 * C.lane + 2) * 136 + j] = f2bf(y.z); VNT[(4 * C.lane + 3) * 136 + j] = f2bf(y.w);
        }
    }
    for (int h = 0; h < 4; ++h) {
        const float* ws = C.in[16] + ((size_t)layer * 4 + h) * 128 * 128;
        for (int e = C.tid; e < 4096; e += 512) { const int i = e >> 5, j4 = (e & 31) * 4; const f32x4 w = *(const f32x4*)(ws + i * 128 + j4);
            u32x2 o; o.x = pk2(w.x, w.y); o.y = pk2(w.z, w.w); *(LAS u32x2*)(WS + i * 136 + j4) = o; }
        __syncthreads();
        const float* bs = C.in[17] + ((size_t)layer * 4 + h) * 128;
        blk_mma<8, 4, 4>(WS, 136, VNT + h * 64 * 136, 136, C.wid, C.lane, [=](int r0, int col, const f32x4& acc) {
#pragma unroll
            for (int jj = 0; jj < 4; ++jj) { const int i = r0 + jj; const size_t row = (size_t)(row0 + i);
                const float u = bf2f(P[row * NP + 512 + h * 64 + col]);
                YC[row * DM + 256 + h * 64 + col] = f2bf((acc[jj] + bs[i]) * u); }
        });
        __syncthreads();
    }
}

__device__ __forceinline__ void item_mamba_local(const Ctx& C, int layer, int gc) {
    const ChunkInfo ci = chunk_info(gc);
    const bf16_t* P = (const bf16_t*)(C.ws + WS_P);
    bf16_t* MSTb = (bf16_t*)(C.ws + WS_MST); float* MCD = (float*)(C.ws + WS_MCD);
    LAS float* DA = (LAS float*)C.lds;
    LAS float* DT = (LAS float*)(C.lds + 2048);
    LAS float* FAC = (LAS float*)(C.lds + 4096);
    LAS bf16_t* XDT = (LAS bf16_t*)(C.lds + 8192);
    LAS bf16_t* BTT = (LAS bf16_t*)(C.lds + 8192 + 73728);
    {
        const int s = C.lane, dh = C.wid, d = dh >> 2, h = dh & 3;
        const float raw = bf2f(P[(size_t)(ci.row0 + s) * NP + OFF_C + 1024 + dh]);
        const float dt = softplus(raw + C.in[20][layer * 8 + dh]);
        const float da = dt * (-expf(C.in[21][layer * 8 + dh]));
        const float incl = wave_incl_scan(da, s), total = __shfl(incl, 63);
        DT[dh * 64 + s] = dt; DA[dh * 64 + s] = da;
        FAC[dh * 64 + s] = d ? fexp(incl - da) : fexp(total - incl);
        if (s == 0) MCD[slot_of(ci.b, h, d, cpos_of(ci, d))] = expf(total);
    }
    __syncthreads();
    {
        const int cp = C.tid & 255, half = C.tid >> 8, c0 = 2 * cp;
        const float* cw = C.in[18] + (size_t)layer * 5 * 768 + c0; const float* cb = C.in[19] + layer * 768 + c0;
        float w0[5], w1[5];
#pragma unroll
        for (int j = 0; j < 5; ++j) { w0[j] = cw[j * 768]; w1[j] = cw[j * 768 + 1]; }
        const float b0 = cb[0], b1 = cb[1];
        const int s0 = half * 32;
        unsigned win[5];
#pragma unroll
        for (int j = 0; j < 4; ++j) { const int row = ci.row0 + s0 - 2 + j; const bool ok = row >= ci.lo && row < ci.hi; const unsigned v = *(const unsigned*)(P + (size_t)(ok ? row : ci.row0) * NP + OFF_C + 256 + c0); win[j + 1] = ok ? v : 0u; }
        for (int tt = 0; tt < 32; ++tt) {
            const int s = s0 + tt;
#pragma unroll
            for (int j = 0; j < 4; ++j) win[j] = win[j + 1];
            { const int row = ci.row0 + s + 2; const bool ok = row >= ci.lo && row < ci.hi; const unsigned v = *(const unsigned*)(P + (size_t)(ok ? row : ci.row0) * NP + OFF_C + 256 + c0); win[4] = ok ? v : 0u; }
            float a0 = b0, a1 = b1;
#pragma unroll
            for (int j = 0; j < 5; ++j) { a0 += w0[j] * bflo(win[j]); a1 += w1[j] * bfhi(win[j]); }
            a0 = silu(a0); a1 = silu(a1);
            if (c0 < 256) { const int h = c0 >> 6;
#pragma unroll
                for (int d = 0; d < 2; ++d) { const float f = DT[(d * 4 + h) * 64 + s] * FAC[(d * 4 + h) * 64 + s];
                    XDT[(d * 256 + c0) * 72 + s] = f2bf(a0 * f); XDT[(d * 256 + c0 + 1) * 72 + s] = f2bf(a1 * f); }
            } else { const int q = c0 - 256; BTT[q * 72 + s] = f2bf(a0); BTT[(q + 1) * 72 + s] = f2bf(a1); }
        }
    }
    __syncthreads();
    for (int hd = 0; hd < 8; ++hd) {
        const int d = hd >> 2, h = hd & 3;
        bf16_t* dst = MSTb + (size_t)slot_of(ci.b, h, d, cpos_of(ci, d)) * 8192;
        blk_mma<8, 4, 2>(BTT + (h >> 1) * 128 * 72, 72, XDT + (d * 256 + h * 64) * 72, 72, C.wid, C.lane, [=](int r0, int col, const f32x4& acc) {
            u32x2 o; o.x = pk2(acc[0], acc[1]); o.y = pk2(acc[2], acc[3]); *(u32x2*)(dst + col * 128 + r0) = o;
        });
    }
    __syncthreads();
}


#ifndef MK_DIAG2
#define MK_DIAG2 0
#endif
#if MK_DIAG2
#define DBGF(stage, cond) do { if (cond) atomicOr((unsigned*)(C.ws + 32768) + (stage), 1u); } while (0)
#define DBGL(stage, cond) do { if (cond) atomicOr(dbgflags + (stage), 1u); } while (0)
#else
#define DBGF(stage, cond) do {} while (0)
#define DBGL(stage, cond) do {} while (0)
#endif
__device__ __forceinline__ bool badv(float x, float lim) { return !(fabsf(x) < lim); }
__device__ __forceinline__ void tri_inverse(const LAS float* ABf, LAS float* Tf, LAS float* Rt, LAS bf16_t* TT, int tid, int wid, int lane) {
    if (wid == 0) {
        const int bi = lane >> 4, j = lane & 15; const LAS float* Ab = ABf + (16 * bi) * 68 + 16 * bi;
        float col[16];
#pragma unroll
        for (int r = 0; r < 16; ++r) { float acc = (r == j) ? 1.f : 0.f;
#pragma unroll
            for (int s = 0; s < r; ++s) acc -= Ab[r * 68 + s] * col[s];
            col[r] = acc; }
#pragma unroll
        for (int r = 0; r < 16; ++r) Tf[(16 * bi + r) * 68 + 16 * bi + j] = col[r];
    } else {
        for (int e = tid - 64; e < 64 * 64; e += 448) { const int t = e >> 6, s2 = e & 63; if ((s2 >> 4) > (t >> 4)) Tf[t * 68 + s2] = 0.f; }
    }
    __syncthreads();
    if (wid < 3) {
        const int tn = wid, fr = lane & 15, fq = lane >> 4;
        LAS float* Rw = Rt + wid * 320;
        for (int i = tn + 1; i < 4; ++i) {
            f32x4 acc = {0.f, 0.f, 0.f, 0.f};
            for (int k = 16 * tn; k < 16 * i; k += 4) acc = __builtin_amdgcn_mfma_f32_16x16x4f32(ABf[(16 * i + fr) * 68 + k + fq], Tf[(k + fq) * 68 + 16 * tn + fr], acc, 0, 0, 0);
#pragma unroll
            for (int j = 0; j < 4; ++j) Rw[(fq * 4 + j) * 20 + fr] = -acc[j];
            asm volatile("s_waitcnt lgkmcnt(0)" ::: "memory");
            f32x4 t = {0.f, 0.f, 0.f, 0.f};
#pragma unroll
            for (int k = 0; k < 16; k += 4) t = __builtin_amdgcn_mfma_f32_16x16x4f32(Tf[(16 * i + fr) * 68 + 16 * i + k + fq], Rw[(k + fq) * 20 + fr], t, 0, 0, 0);
#pragma unroll
            for (int j = 0; j < 4; ++j) Tf[(16 * i + fq * 4 + j) * 68 + 16 * tn + fr] = t[j];
            asm volatile("s_waitcnt lgkmcnt(0)" ::: "memory");
        }
    }
    __syncthreads();
    for (int e = tid; e < 4096; e += 512) { const int t = e >> 6, s2 = e & 63; TT[t * 72 + s2] = f2bf(Tf[t * 68 + s2]); }
}
struct D1Pre { unsigned w[24]; unsigned lw[8]; int hd; };
__device__ __forceinline__ void d1_load_rows(const Ctx& C, int it, unsigned (&w)[24]) {
    const int gc = it >> 3, hd = it & 7, h = hd & 3, d = hd >> 2;
    const ChunkInfo ci = chunk_info(gc);
    const bf16_t* P = (const bf16_t*)(C.ws + WS_P);
    if (C.tid < 480) {
        const int q = C.tid % 160, seg = C.tid / 160, grp = q >> 5, c = (q & 31) * 2;
        const int j = (grp == 0 ? h * 64 : grp == 1 ? 256 + h * 64 : grp == 2 ? 512 + h * 64 : grp == 3 ? 768 + d * 64 : 896 + d * 64) + c;
        const int t0 = seg * 22, nt = seg == 2 ? 20 : 22;
        const bf16_t* pp = P + (size_t)(ci.row0 + t0) * NP + OFF_D + j;
#pragma unroll
        for (int i = 0; i < 24; ++i) { const int row = ci.row0 + t0 - 1 + i; const bool ok = row >= ci.lo && row < ci.hi; const int rc = ok ? row : ci.row0;
            const unsigned v = (i < nt + 2) ? *(const unsigned*)(pp + (ptrdiff_t)(rc - (ci.row0 + t0)) * NP) : 0u; w[i] = ok ? v : 0u; }
    }
}
constexpr int D1_LW = 0, D1_CS = 17408, D1_AA = 34816, D1_RB = 52224, D1_KB = 61440, D1_VB = 70656, D1_TW = 79872, D1_AD = 89088, D1_W2T = 98304, D1_A2T = 107520;
constexpr int D1_Y = 82944;
constexpr int D1_ABF = 0, D1_AK = 17408, D1_ARK = 26624, D1_ARB = 35840, D1_TT = 45056, D1_W1T = 54272, D1_AKVT = 63488, D1_W2TT = 72704;
constexpr int D1_GL = 156672;
__device__ __forceinline__ void item_rwkv_local(const Ctx& C0_, int layer, int it, D1Pre& pre, int it_next) {
    Ctx C = C0_; { int t_ = C0_.tid; asm volatile("" : "+v"(t_)); C.tid = t_; C.lane = t_ & 63; C.wid = __builtin_amdgcn_readfirstlane(t_ >> 6); }
#define D1_RELAUNDER() do { int t_ = C.tid; asm volatile("" : "+v"(t_)); C.tid = t_; C.lane = t_ & 63; C.wid = __builtin_amdgcn_readfirstlane(t_ >> 6); } while (0)
    const int gc = it >> 3, hd = it & 7, h = hd & 3, d = hd >> 2;
    const ChunkInfo ci = chunk_info(gc);
    const int slot = slot_of(ci.b, h, d, cpos_of(ci, d));
    const bf16_t* P = (const bf16_t*)(C.ws + WS_P);
    const float* mup = C.in[24] + layer * 1152; const float* mun = C.in[25] + layer * 1152;
    lds_t L = C.lds;
    LAS float* LW = (LAS float*)(L + D1_LW); LAS float* CS = (LAS float*)(L + D1_CS); LAS float* AA = (LAS float*)(L + D1_AA); LAS float* GL = (LAS float*)(L + D1_GL);
    LAS bf16_t* Rb = (LAS bf16_t*)(L + D1_RB); LAS bf16_t* Kb = (LAS bf16_t*)(L + D1_KB); LAS bf16_t* Vb = (LAS bf16_t*)(L + D1_VB);
    LAS bf16_t* TW = (LAS bf16_t*)(L + D1_TW); LAS bf16_t* AD = (LAS bf16_t*)(L + D1_AD); LAS bf16_t* W2T = (LAS bf16_t*)(L + D1_W2T); LAS bf16_t* A2T = (LAS bf16_t*)(L + D1_A2T);
    LAS bf16_t* KT = (LAS bf16_t*)(L + D1_Y); LAS bf16_t* KTt = KT + 4608; LAS bf16_t* KD = KT + 2 * 4608; LAS bf16_t* KDt = KT + 3 * 4608;
    LAS bf16_t* BT = KT + 4 * 4608; LAS bf16_t* BTt = KT + 5 * 4608; LAS bf16_t* RT = KT + 6 * 4608; LAS bf16_t* Vt = KT + 7 * 4608;
    LAS float* ABf = (LAS float*)(L + D1_ABF); LAS bf16_t* AK = (LAS bf16_t*)(L + D1_AK); LAS bf16_t* ARK = (LAS bf16_t*)(L + D1_ARK); LAS bf16_t* ARB = (LAS bf16_t*)(L + D1_ARB);
    LAS bf16_t* TT = (LAS bf16_t*)(L + D1_TT); LAS bf16_t* W1t = (LAS bf16_t*)(L + D1_W1T); LAS bf16_t* AKVt = (LAS bf16_t*)(L + D1_AKVT); LAS bf16_t* W2t = (LAS bf16_t*)(L + D1_W2TT);

    if (C.tid < 480) {
        const int q = C.tid % 160, seg = C.tid / 160, grp = q >> 5, c = (q & 31) * 2;
        const int j = (grp == 0 ? h * 64 : grp == 1 ? 256 + h * 64 : grp == 2 ? 512 + h * 64 : grp == 3 ? 768 + d * 64 : 896 + d * 64) + c;
        const int t0 = seg * 22, nt = seg == 2 ? 20 : 22;
        const float mp0 = mup[j], mp1 = mup[j + 1], mn0 = mun[j], mn1 = mun[j + 1];
        unsigned w[24]; { const bf16_t* pp = P + (size_t)(ci.row0 + t0) * NP + OFF_D + j;
#pragma unroll
        for (int i = 0; i < 24; ++i) { const int row = ci.row0 + t0 - 1 + i; const bool ok = row >= ci.lo && row < ci.hi; const int rc = ok ? row : ci.row0;
            const unsigned v = (i < nt + 2) ? *(const unsigned*)(pp + (ptrdiff_t)(rc - (ci.row0 + t0)) * NP) : 0u; w[i] = ok ? v : 0u; } }
        LAS bf16_t* dst = (grp == 0 ? Rb : grp == 1 ? Kb : grp == 2 ? Vb : grp == 3 ? TW : AD);
#pragma unroll
        for (int i = 0; i < 22; ++i) if (i < nt) {
            const float x0 = bflo(w[i + 1]), x1 = bfhi(w[i + 1]);
            const float v0 = x0 + mp0 * (bflo(w[i]) - x0) + mn0 * (bflo(w[i + 2]) - x0);
            const float v1 = x1 + mp1 * (bfhi(w[i]) - x1) + mn1 * (bfhi(w[i + 2]) - x1);
            DBGF(1, badv(v0, 1e4f) || badv(v1, 1e4f));
            const unsigned o = (grp == 3) ? pk2(ftanh(v0), ftanh(v1)) : pk2(v0, v1);
            const int tl = t0 + i, l = d ? 63 - tl : tl;
            *(LAS unsigned*)(dst + l * 72 + c) = o;
        }
    }
    {
        if (pre.hd != hd) {
            const float* w2 = C.in[27] + ((size_t)layer * 2 + d) * 64 * 256 + h * 64; const float* a2 = C.in[29] + ((size_t)layer * 2 + d) * 64 * 256 + h * 64;
#pragma unroll
            for (int k = 0; k < 8; ++k) { const int e = C.tid + 512 * k, r = e >> 6, c = e & 63; pre.lw[k] = pk2(w2[r * 256 + c], a2[r * 256 + c]); }
            pre.hd = hd;
        }
#pragma unroll
        for (int k = 0; k < 8; ++k) { const int e = C.tid + 512 * k, r = e >> 6, c = e & 63; W2T[c * 72 + r] = (unsigned short)(pre.lw[k] & 0xffffu); A2T[c * 72 + r] = (unsigned short)(pre.lw[k] >> 16); }
    }
    __syncthreads();
    D1_RELAUNDER();
    {
        unsigned* dbgflags = (unsigned*)(C.ws + 32768); (void)dbgflags;
        const float* w0 = C.in[26] + ((size_t)layer * 2 + d) * 256 + h * 64; const float* a0 = C.in[28] + ((size_t)layer * 2 + d) * 256 + h * 64;
        blk_mma<4, 4, 2>(TW, 72, W2T, 72, C.wid, C.lane, [=](int r0, int col, const f32x4& acc) {
#pragma unroll
            for (int jj = 0; jj < 4; ++jj) { const float w = w0[col] + acc[jj]; DBGL(2, badv(w, 1e4f)); LW[(r0 + jj) * 68 + col] = -fexp(-softplus(-w) - 0.5f); }
        });
        blk_mma<4, 4, 2>(AD, 72, A2T, 72, C.wid, C.lane, [=](int r0, int col, const f32x4& acc) {
#pragma unroll
            for (int jj = 0; jj < 4; ++jj) { DBGL(2, badv(acc[jj], 1e4f)); AA[(r0 + jj) * 68 + col] = sigm(a0[col] + acc[jj]); }
        });
    }
    __syncthreads();
    {
#pragma unroll
        for (int i = 0; i < 8; ++i) { const int c = C.wid * 8 + i; const float incl = wave_incl_scan(LW[C.lane * 68 + c], C.lane); CS[C.lane * 68 + c] = incl; if (C.lane == 63) GL[c] = fexp(incl); }
    }
    __syncthreads();
    D1_RELAUNDER();
    {
        const int l = C.tid >> 3, sub = C.tid & 7;
        const float* kkw = C.in[31] + layer * 256 + h * 64; const float* kaw = C.in[32] + layer * 256 + h * 64; const float* rkw = C.in[33] + layer * 256 + h * 64;
        float kk[8], kdv[8], aa[8], rr[8], vv[8]; float ss = 0.f, bon = 0.f;
#pragma unroll
        for (int i = 0; i < 8; ++i) { const int c = sub * 8 + i; const float k = bf2f(Kb[l * 72 + c]); rr[i] = bf2f(Rb[l * 72 + c]); vv[i] = bf2f(Vb[l * 72 + c]); aa[i] = AA[l * 68 + c];
            kk[i] = k * kkw[c]; ss += kk[i] * kk[i]; kdv[i] = k * (1.f + (aa[i] - 1.f) * kaw[c]); bon += rr[i] * kdv[i] * rkw[c]; }
        ss += __shfl_xor(ss, 1); ss += __shfl_xor(ss, 2); ss += __shfl_xor(ss, 4);
        bon += __shfl_xor(bon, 1); bon += __shfl_xor(bon, 2); bon += __shfl_xor(bon, 4);
        const float inv = rsqrtf(ss + 1e-12f);
        if (sub == 0) ((float*)(C.ws + WS_BON))[(size_t)(ci.row0 + (d ? 63 - l : l)) * 8 + h * 2 + d] = bon;
        unsigned short kt[8], kd[8], bt[8], rt[8];
#pragma unroll
        for (int i = 0; i < 8; ++i) { const int c = sub * 8 + i; const float cs = CS[l * 68 + c], lw = LW[l * 68 + c];
            const float ge = fexp(cs - lw), gi = fexp(cs), gn = fexp(-cs); const float kkn = kk[i] * inv;
            DBGF(3, badv(cs, 50.f) || cs > 0.f || badv(lw, 1.f)); DBGF(4, badv(kkn * ge, 10.f) || badv(rr[i] * gi, 1e4f) || badv(vv[i], 1e4f)); DBGF(5, badv(kdv[i] * gn, 1e25f) || badv(kkn * aa[i] * gn, 1e25f));
            kt[i] = f2bf(kkn * ge); kd[i] = f2bf(kdv[i] * gn); bt[i] = f2bf(kkn * aa[i] * gn); rt[i] = f2bf(rr[i] * gi);
            KTt[c * 72 + l] = kt[i]; KDt[c * 72 + l] = kd[i]; BTt[c * 72 + l] = bt[i]; Vt[c * 72 + l] = f2bf(vv[i]); }
#define D1_PACK8(a) (u32x4){(unsigned)a[0] | ((unsigned)a[1] << 16), (unsigned)a[2] | ((unsigned)a[3] << 16), (unsigned)a[4] | ((unsigned)a[5] << 16), (unsigned)a[6] | ((unsigned)a[7] << 16)}
        *(LAS u32x4*)(KT + l * 72 + sub * 8) = D1_PACK8(kt); *(LAS u32x4*)(KD + l * 72 + sub * 8) = D1_PACK8(kd);
        *(LAS u32x4*)(BT + l * 72 + sub * 8) = D1_PACK8(bt); *(LAS u32x4*)(RT + l * 72 + sub * 8) = D1_PACK8(rt);
#undef D1_PACK8
    }
    __syncthreads();
    D1_RELAUNDER();
    unsigned* dbgflags = (unsigned*)(C.ws + 32768); (void)dbgflags;
    blk_mma2<4, 4, 2>(BT, KT, KD, KT, 72, C.wid, C.lane, [=](int r0, int col, const f32x4& ab, const f32x4& ak) {
        f32x4 a; float k[4];
#pragma unroll
        for (int jj = 0; jj < 4; ++jj) { const bool lo = r0 + jj < col; DBGL(6, lo && (badv(ab[jj], 1e3f) || badv(ak[jj], 1e4f))); a[jj] = lo ? ab[jj] : 0.f; k[jj] = lo ? ak[jj] : 0.f; }
        *(LAS f32x4*)(ABf + col * 68 + r0) = a;
        u32x2 o; o.x = pk2(k[0], k[1]); o.y = pk2(k[2], k[3]); *(LAS u32x2*)(AK + col * 72 + r0) = o;
    });
    blk_mma2<4, 4, 2>(KD, RT, BT, RT, 72, C.wid, C.lane, [=](int r0, int col, const f32x4& rk, const f32x4& rb) {
        float a[4], b[4];
#pragma unroll
        for (int jj = 0; jj < 4; ++jj) { const bool le = r0 + jj <= col; DBGL(7, le && (badv(rk[jj], 1e5f) || badv(rb[jj], 1e5f))); a[jj] = le ? rk[jj] : 0.f; b[jj] = le ? rb[jj] : 0.f; }
        u32x2 oa, ob; oa.x = pk2(a[0], a[1]); oa.y = pk2(a[2], a[3]); ob.x = pk2(b[0], b[1]); ob.y = pk2(b[2], b[3]);
        *(LAS u32x2*)(ARK + col * 72 + r0) = oa; *(LAS u32x2*)(ARB + col * 72 + r0) = ob;
    });
    __syncthreads();
    tri_inverse(ABf, (LAS float*)(L + 54272), (LAS float*)(L + 71680), TT, C.tid, C.wid, C.lane);
    __syncthreads();
#if MK_DIAG2
    for (int e = C.tid; e < 4096; e += 512) DBGF(8, badv(bf2f(TT[(e >> 6) * 72 + (e & 63)]), 1e3f));
#endif
    D1_RELAUNDER();
    blk_mma2<4, 4, 2>(TT, KTt, AK, Vt, 72, C.wid, C.lane, [=](int r0, int col, const f32x4& w1, const f32x4& akv) {
        DBGL(9, badv(w1[0], 1e3f) || badv(w1[1], 1e3f) || badv(w1[2], 1e3f) || badv(w1[3], 1e3f)); DBGL(10, badv(akv[0], 1e5f) || badv(akv[1], 1e5f) || badv(akv[2], 1e5f) || badv(akv[3], 1e5f));
        u32x2 a, b; a.x = pk2(w1[0], w1[1]); a.y = pk2(w1[2], w1[3]); b.x = pk2(akv[0], akv[1]); b.y = pk2(akv[2], akv[3]);
        *(LAS u32x2*)(W1t + col * 72 + r0) = a; *(LAS u32x2*)(AKVt + col * 72 + r0) = b;
    });
    __syncthreads();
    blk_mma<4, 4, 2>(TT, 72, AKVt, 72, C.wid, C.lane, [=](int r0, int col, const f32x4& w2) {
        DBGL(11, badv(w2[0], 1e5f) || badv(w2[1], 1e5f) || badv(w2[2], 1e5f) || badv(w2[3], 1e5f));
        u32x2 a; a.x = pk2(w2[0], w2[1]); a.y = pk2(w2[2], w2[3]); *(LAS u32x2*)(W2t + col * 72 + r0) = a;
    });
    __syncthreads();
    D1_RELAUNDER();
    {
        bf16_t* Gg = (bf16_t*)(C.ws + WS_RG) + (size_t)slot * 4096; bf16_t* Jg = (bf16_t*)(C.ws + WS_RJ) + (size_t)slot * 4096;
        bf16_t* Ryg = (bf16_t*)(C.ws + WS_RY) + (size_t)slot * 4096; bf16_t* Ylg = (bf16_t*)(C.ws + WS_RL) + (size_t)slot * 4096;
        blk_mma2<4, 4, 2>(W1t, BTt, W1t, ARB, 72, C.wid, C.lane, [=](int r0, int col, const f32x4& gp, const f32x4& rbw) {
            const float gl = GL[col]; float g[4], ry[4];
            const u32x2 rt = *(const LAS u32x2*)(RT + col * 72 + r0);
            const float rtv[4] = {bflo(rt.x), bfhi(rt.x), bflo(rt.y), bfhi(rt.y)};
#pragma unroll
            for (int jj = 0; jj < 4; ++jj) { g[jj] = gl * ((col == r0 + jj ? 1.f : 0.f) - gp[jj]); ry[jj] = rtv[jj] - rbw[jj]; }
            u32x2 og, oy; og.x = pk2(g[0], g[1]); og.y = pk2(g[2], g[3]); oy.x = pk2(ry[0], ry[1]); oy.y = pk2(ry[2], ry[3]);
            *(u32x2*)(Gg + col * 64 + r0) = og;
            *(u32x2*)(Ryg + col * 64 + r0) = oy;
        });
        blk_mma2<4, 4, 2>(KDt, Vt, BTt, W2t, 72, C.wid, C.lane, [=](int r0, int col, const f32x4& kv, const f32x4& bw) {
            f32x4 o;
#pragma unroll
            for (int jj = 0; jj < 4; ++jj) { o[jj] = GL[r0 + jj] * (kv[jj] - bw[jj]); DBGL(12, badv(GL[r0 + jj] * kv[jj], 1e5f)); DBGL(13, badv(GL[r0 + jj] * bw[jj], 1e5f)); DBGL(14, badv(o[jj], 1e5f)); }
            u32x2 oj; oj.x = pk2(o[0], o[1]); oj.y = pk2(o[2], o[3]); *(u32x2*)(Jg + col * 64 + r0) = oj;
        });
        blk_mma2<4, 4, 2>(ARK, Vt, ARB, W2t, 72, C.wid, C.lane, [=](int r0, int col, const f32x4& a, const f32x4& b) {
            u32x2 o; o.x = pk2(a[0] - b[0], a[1] - b[1]); o.y = pk2(a[2] - b[2], a[3] - b[3]);
            *(u32x2*)(Ylg + col * 64 + r0) = o;
        });
    }
    __syncthreads();
}

typedef float f32x2p __attribute__((ext_vector_type(2)));
__device__ __forceinline__ void ph_scan(const Ctx& C, int nrep = 1, bool mstore = true, bool chain = true) {
    if (C.bid < 64) {
      if (chain)
      for (int rep = 0; rep < nrep; ++rep) {
        constexpr int NB = 8;
        const int chain_id = C.bid >> 2, w4 = C.bid & 3, fr = C.lane & 15, fq = C.lane >> 4;
        LAS bf16_t* Gs = (LAS bf16_t*)C.lds;
        LAS bf16_t* Js = Gs + NB * 4608;
        LAS bf16_t* HT = Js + NB * 1152;
        const bf16_t* Gg = (const bf16_t*)(C.ws + WS_RG) + (size_t)chain_id * NCH * 4096;
        const bf16_t* Jg = (const bf16_t*)(C.ws + WS_RJ) + (size_t)chain_id * NCH * 4096 + (size_t)(16 * w4) * 64;
        bf16_t* Hg = (bf16_t*)(C.ws + WS_RH) + (size_t)chain_id * NCH * 4096 + (16 * w4 + fr) * 64 + fq * 4;
        u32x4 pf[10];
#define CHAIN_ISSUE(b0_) do { _Pragma("unroll") for (int i = 0; i < 10; ++i) { const int e = C.tid + 512 * i, st = e / 640, q = e % 640; const size_t cp = (size_t)((b0_) + st < NCH ? (b0_) + st : NCH - 1) * 4096; \
            pf[i] = *(const u32x4*)(q < 512 ? Gg + cp + q * 8 : Jg + cp + (q - 512) * 8); } } while (0)
#define CHAIN_STAGE() do { _Pragma("unroll") for (int i = 0; i < 10; ++i) { const int e = C.tid + 512 * i, st = e / 640, q = e % 640; \
            if (q < 512) *(LAS u32x4*)(Gs + st * 4608 + (q >> 3) * 72 + (q & 7) * 8) = pf[i]; else *(LAS u32x4*)(Js + st * 1152 + ((q - 512) >> 3) * 72 + (q & 7) * 8) = pf[i]; } } while (0)
        f32x4 acc[4];
#pragma unroll
        for (int tm = 0; tm < 4; ++tm) acc[tm] = (f32x4){0.f, 0.f, 0.f, 0.f};
        CHAIN_ISSUE(0);
        for (int b0 = 0; b0 < NCH; b0 += NB) {
            __syncthreads();
            CHAIN_STAGE();
            __syncthreads();
            if (b0 + NB < NCH) CHAIN_ISSUE(b0 + NB);
            if (C.wid == 0) {
                const int nb = NCH - b0 < NB ? NCH - b0 : NB;
                for (int st = 0; st < nb; ++st) {
                    const int cpos = b0 + st;
#pragma unroll
                    for (int tm = 0; tm < 4; ++tm) { u32x2 o; o.x = pk2(acc[tm][0], acc[tm][1]); o.y = pk2(acc[tm][2], acc[tm][3]);
                        *(LAS u32x2*)(HT + fr * 72 + tm * 16 + fq * 4) = o;
                        *(u32x2*)(Hg + (size_t)cpos * 4096 + tm * 16) = o; }
                    const bf16x8 b0v = *(const LAS bf16x8*)(HT + fr * 72 + fq * 8), b1v = *(const LAS bf16x8*)(HT + fr * 72 + 32 + fq * 8);
#pragma unroll
                    for (int tm = 0; tm < 4; ++tm) {
                        const u32x2 jr = *(const LAS u32x2*)(Js + st * 1152 + fr * 72 + tm * 16 + fq * 4);
                        f32x4 a = {bflo(jr.x), bfhi(jr.x), bflo(jr.y), bfhi(jr.y)};
                        a = __builtin_amdgcn_mfma_f32_16x16x32_bf16(*(const LAS bf16x8*)(Gs + st * 4608 + (tm * 16 + fr) * 72 + fq * 8), b0v, a, 0, 0, 0);
                        a = __builtin_amdgcn_mfma_f32_16x16x32_bf16(*(const LAS bf16x8*)(Gs + st * 4608 + (tm * 16 + fr) * 72 + 32 + fq * 8), b1v, a, 0, 0, 0);
                        acc[tm] = a; }
                }
            }
        }
#undef CHAIN_ISSUE
#undef CHAIN_STAGE
        __syncthreads();
      }
    } else {
        unsigned* MST = (unsigned*)(C.ws + WS_MST); const float* MCD = (const float*)(C.ws + WS_MCD);
        const int nthr = (C.G - 64) * 512;
        for (int e = (C.bid - 64) * 512 + C.tid; e < 16 * 4096; e += nthr) {
            const int chain = e >> 12, el = e & 4095; float r0 = 0.f, r1 = 0.f;
            unsigned* p = MST + (size_t)chain * NCH * 4096 + el; const float* cd = MCD + chain * NCH;
#pragma unroll 22
            for (int cpos = 0; cpos < NCH; ++cpos) { const unsigned tmp = p[(size_t)cpos * 4096]; if (mstore) p[(size_t)cpos * 4096] = pk2(r0, r1); const float c = cd[cpos]; r0 = r0 * c + bflo(tmp); r1 = r1 * c + bfhi(tmp); }
            if (!mstore && r0 == 12345.678f) p[0] = 0u;
        }
    }
}

__device__ __forceinline__ void item_mamba_out(const Ctx& C, int layer, int gc) {
    const ChunkInfo ci = chunk_info(gc);
    const bf16_t* P = (const bf16_t*)(C.ws + WS_P); bf16_t* YC = (bf16_t*)(C.ws + WS_ACT); const bf16_t* MST = (const bf16_t*)(C.ws + WS_MST);
    lds_t L = C.lds;
    LAS float* DT = (LAS float*)L;
    LAS float* DA = (LAS float*)(L + 2048);
    LAS float* CSI = (LAS float*)(L + 4096);
    LAS float* SSQ = (LAS float*)(L + 6144);
    LAS bf16_t* CG = (LAS bf16_t*)(L + 10240);
    LAS bf16_t* BG = (LAS bf16_t*)(L + 27648);
    LAS bf16_t* XT = (LAS bf16_t*)(L + 45056);
    LAS float* CBm = (LAS float*)(L + 63488);
    LAS bf16_t* MP = (LAS bf16_t*)(L + 80896);
    LAS bf16_t* S0 = (LAS bf16_t*)(L + 90112);
    LAS bf16_t* YPRE = (LAS bf16_t*)(L + 107520);
    const int fr = C.lane & 15, fq = C.lane >> 4;
    {
        const int s = C.lane, dh = C.wid;
        const float raw = bf2f(P[(size_t)(ci.row0 + s) * NP + OFF_C + 1024 + dh]);
        const float dt = softplus(raw + C.in[20][layer * 8 + dh]);
        const float da = dt * (-expf(C.in[21][layer * 8 + dh]));
        const float incl = wave_incl_scan(da, s), total = __shfl(incl, 63);
        DT[dh * 64 + s] = dt; DA[dh * 64 + s] = da;
        CSI[dh * 64 + s] = (dh < 4) ? incl : (total - incl + da);
    }
    for (int g = 0; g < 2; ++g) {
        __syncthreads();
        {
            const int cp = C.tid & 255, half = C.tid >> 8;
            if (cp < 192) {
                const int kind = cp >> 6, cl = (cp & 63) * 2, c0 = kind * 256 + g * 128 + cl;
                const float* cw = C.in[18] + (size_t)layer * 5 * 768 + c0; const float* cb = C.in[19] + layer * 768 + c0;
                float w0[5], w1[5];
#pragma unroll
                for (int j = 0; j < 5; ++j) { w0[j] = cw[j * 768]; w1[j] = cw[j * 768 + 1]; }
                const float b0 = cb[0], b1 = cb[1];
                const int s0 = half * 32;
                unsigned win[5];
#pragma unroll
                for (int j = 0; j < 4; ++j) { const int row = ci.row0 + s0 - 2 + j; const bool ok = row >= ci.lo && row < ci.hi; const unsigned v = *(const unsigned*)(P + (size_t)(ok ? row : ci.row0) * NP + OFF_C + 256 + c0); win[j + 1] = ok ? v : 0u; }
                for (int tt = 0; tt < 32; ++tt) {
                    const int s = s0 + tt;
#pragma unroll
                    for (int j = 0; j < 4; ++j) win[j] = win[j + 1];
                    { const int row = ci.row0 + s + 2; const bool ok = row >= ci.lo && row < ci.hi; const unsigned v = *(const unsigned*)(P + (size_t)(ok ? row : ci.row0) * NP + OFF_C + 256 + c0); win[4] = ok ? v : 0u; }
                    float a0 = b0, a1 = b1;
#pragma unroll
                    for (int j = 0; j < 5; ++j) { a0 += w0[j] * bflo(win[j]); a1 += w1[j] * bfhi(win[j]); }
                    const unsigned short o0 = f2bf(silu(a0)), o1 = f2bf(silu(a1));
                    if (kind == 0) { XT[cl * 72 + s] = o0; XT[(cl + 1) * 72 + s] = o1; }
                    else if (kind == 1) { *(LAS unsigned*)(BG + s * 136 + cl) = (unsigned)o0 | ((unsigned)o1 << 16); }
                    else { *(LAS unsigned*)(CG + s * 136 + cl) = (unsigned)o0 | ((unsigned)o1 << 16); }
                }
            }
        }
        __syncthreads();
        blk_mma<4, 4, 4>(CG, 136, BG, 136, C.wid, C.lane, [=](int r0, int col, const f32x4& acc) {
#pragma unroll
            for (int jj = 0; jj < 4; ++jj) CBm[(r0 + jj) * 68 + col] = acc[jj];
        });
        u32x4 s0r[2];
        { const bf16_t* src = MST + (size_t)slot_of(ci.b, 2 * g, 0, cpos_of(ci, 0)) * 8192;
#pragma unroll
          for (int k = 0; k < 2; ++k) { const int e = C.tid + 512 * k; s0r[k] = *(const u32x4*)(src + (e >> 4) * 128 + (e & 15) * 8); } }
        for (int hh = 0; hh < 2; ++hh) {
            const int h = 2 * g + hh;
            f32x4 yacc[2] = {{0.f, 0.f, 0.f, 0.f}, {0.f, 0.f, 0.f, 0.f}};
            for (int d = 0; d < 2; ++d) {
                const int dh = d * 4 + h;
                __syncthreads();
                for (int e = C.tid; e < 4096; e += 512) { const int l = e >> 6, s = e & 63; const bool ok = d ? (s >= l) : (s <= l);
                    MP[l * 72 + s] = ok ? f2bf(CBm[l * 68 + s] * fexp(CSI[dh * 64 + l] - CSI[dh * 64 + s]) * DT[dh * 64 + s]) : (unsigned short)0; }
#pragma unroll
                for (int k = 0; k < 2; ++k) { const int e = C.tid + 512 * k; *(LAS u32x4*)(S0 + (e >> 4) * 136 + (e & 15) * 8) = s0r[k]; }
                if (!(hh == 1 && d == 1)) { const int nh = d ? h + 1 : h, nd = d ^ 1; const bf16_t* src = MST + (size_t)slot_of(ci.b, nh, nd, cpos_of(ci, nd)) * 8192;
#pragma unroll
                    for (int k = 0; k < 2; ++k) { const int e = C.tid + 512 * k; s0r[k] = *(const u32x4*)(src + (e >> 4) * 128 + (e & 15) * 8); } }
                __syncthreads();
#pragma unroll
                for (int i = 0; i < 2; ++i) { const int tt = C.wid + 8 * i, tm = tt >> 2, tn = tt & 3;
                    f32x4 a1 = {0.f, 0.f, 0.f, 0.f}, a2 = {0.f, 0.f, 0.f, 0.f};
#pragma unroll
                    for (int ks = 0; ks < 2; ++ks) a1 = __builtin_amdgcn_mfma_f32_16x16x32_bf16(*(const LAS bf16x8*)(MP + (tm * 16 + fr) * 72 + ks * 32 + fq * 8),
                                                                                                 *(const LAS bf16x8*)(XT + (hh * 64 + tn * 16 + fr) * 72 + ks * 32 + fq * 8), a1, 0, 0, 0);
#pragma unroll
                    for (int ks = 0; ks < 4; ++ks) a2 = __builtin_amdgcn_mfma_f32_16x16x32_bf16(*(const LAS bf16x8*)(CG + (tm * 16 + fr) * 136 + ks * 32 + fq * 8),
                                                                                                 *(const LAS bf16x8*)(S0 + (tn * 16 + fr) * 136 + ks * 32 + fq * 8), a2, 0, 0, 0);
#pragma unroll
                    for (int j = 0; j < 4; ++j) yacc[i][j] += a1[j] + a2[j] * fexp(CSI[dh * 64 + tm * 16 + fq * 4 + j]);
                }
            }
            const float dsk = C.in[22][layer * 4 + h];
#pragma unroll
            for (int i = 0; i < 2; ++i) { const int tt = C.wid + 8 * i, tm = tt >> 2, tn = tt & 3;
#pragma unroll
                for (int j = 0; j < 4; ++j) { const int l = tm * 16 + fq * 4 + j, p = tn * 16 + fr, c = h * 64 + p;
                    const float xs = bf2f(XT[(hh * 64 + p) * 72 + l]);
                    const float z = bf2f(P[(size_t)(ci.row0 + l) * NP + OFF_C + c]);
                    const float pre = (yacc[i][j] + dsk * xs) * silu(z);
                    YPRE[l * 264 + c] = f2bf(pre);
                    float q = pre * pre; q += __shfl_xor(q, 1); q += __shfl_xor(q, 2); q += __shfl_xor(q, 4); q += __shfl_xor(q, 8);
                    if (fr == 0) SSQ[l * 16 + h * 4 + tn] = q; }
            }
        }
    }
    __syncthreads();
    {
        const int l = C.tid >> 3, sub = C.tid & 7; float ss = 0.f;
#pragma unroll
        for (int i = 0; i < 16; ++i) ss += SSQ[l * 16 + i];
        const float rs = rsqrtf(ss * (1.f / 256.f) + 1e-6f);
        const float* ng = C.in[23] + layer * 256 + sub * 32;
        bf16_t* dst = YC + (size_t)(ci.row0 + l) * DM + 512 + sub * 32;
#pragma unroll
        for (int i = 0; i < 32; i += 2) { const float a = bf2f(YPRE[l * 264 + sub * 32 + i]) * rs * ng[i], b = bf2f(YPRE[l * 264 + sub * 32 + i + 1]) * rs * ng[i + 1]; *(unsigned*)(dst + i) = pk2(a, b); }
    }
    __syncthreads();
}

constexpr int D3_G2T = 0, D3_SG = 69632;
__device__ __forceinline__ void load_g2t(const Ctx& C, int layer) {
    LAS bf16_t* G2T = (LAS bf16_t*)(C.lds + D3_G2T); const float* g2 = C.in[30] + (size_t)layer * 128 * 256;
    for (int e = C.tid; e < 128 * 256; e += 512) { const int r = e >> 8, c = e & 255; G2T[c * 136 + r] = f2bf(g2[e]); }
}
__device__ __forceinline__ float lerp_d(const bf16_t* P, const ChunkInfo& ci, int row, int j, const float* mup, const float* mun) {
    const bf16_t* pp = P + (size_t)row * NP + OFF_D + j;
    const bool okp = row - 1 >= ci.lo, okn = row + 1 < ci.hi;
    const float x = bf2f(*pp), xpv = bf2f(*(okp ? pp - NP : pp)), xnv = bf2f(*(okn ? pp + NP : pp)); const float xp = okp ? xpv : 0.f, xn = okn ? xnv : 0.f;
    return x + mup[j] * (xp - x) + mun[j] * (xn - x);
}
__device__ __forceinline__ void item_rwkv_out(const Ctx& C, int layer, int gc) {
    const ChunkInfo ci = chunk_info(gc);
    const bf16_t* P = (const bf16_t*)(C.ws + WS_P); bf16_t* YC = (bf16_t*)(C.ws + WS_ACT);
    const float* mup = C.in[24] + layer * 1152; const float* mun = C.in[25] + layer * 1152;
    LAS bf16_t* G2T = (LAS bf16_t*)(C.lds + D3_G2T); LAS bf16_t* SG = (LAS bf16_t*)(C.lds + D3_SG);
    const int fr = C.lane & 15, fq = C.lane >> 4;
    __syncthreads();
    for (int e = C.tid; e < 64 * 128; e += 512) { const int l = e >> 7, r = e & 127; SG[l * 136 + r] = f2bf(sigm(lerp_d(P, ci, ci.row0 + l, 1024 + r, mup, mun))); }
    __syncthreads();
    const int h = C.wid >> 1, tmb = (C.wid & 1) * 2;
    const bf16_t* Ryg = (const bf16_t*)(C.ws + WS_RY); const bf16_t* Ylg = (const bf16_t*)(C.ws + WS_RL); const bf16_t* Hg = (const bf16_t*)(C.ws + WS_RH);
    const float* BON = (const float*)(C.ws + WS_BON);
#pragma unroll
    for (int ti = 0; ti < 2; ++ti) {
        const int tm = tmb + ti;
        f32x4 gacc[4], yacc[4];
#pragma unroll
        for (int tn = 0; tn < 4; ++tn) { f32x4 a = {0.f, 0.f, 0.f, 0.f};
#pragma unroll
            for (int ks = 0; ks < 4; ++ks) a = __builtin_amdgcn_mfma_f32_16x16x32_bf16(*(const LAS bf16x8*)(SG + (tm * 16 + fr) * 136 + ks * 32 + fq * 8),
                                                                                        *(const LAS bf16x8*)(G2T + (h * 64 + tn * 16 + fr) * 136 + ks * 32 + fq * 8), a, 0, 0, 0);
            gacc[tn] = a; yacc[tn] = (f32x4){0.f, 0.f, 0.f, 0.f}; }
#pragma unroll
        for (int d = 0; d < 2; ++d) {
            const size_t slot = (size_t)slot_of(ci.b, h, d, cpos_of(ci, d));
            const int arow = d ? 63 - (tm * 16 + fr) : tm * 16 + fr;
            bf16x8 af[2];
#pragma unroll
            for (int ks = 0; ks < 2; ++ks) af[ks] = *(const bf16x8*)(Ryg + slot * 4096 + arow * 64 + ks * 32 + fq * 8);
#pragma unroll
            for (int tn = 0; tn < 4; ++tn) {
                f32x4 a;
                if (d == 0) { const u32x2 yl = *(const u32x2*)(Ylg + slot * 4096 + (tn * 16 + fr) * 64 + tm * 16 + fq * 4); a = (f32x4){bflo(yl.x), bfhi(yl.x), bflo(yl.y), bfhi(yl.y)}; }
                else { const u32x2 yl = *(const u32x2*)(Ylg + slot * 4096 + (tn * 16 + fr) * 64 + 60 - (tm * 16 + fq * 4)); a = (f32x4){bfhi(yl.y), bflo(yl.y), bfhi(yl.x), bflo(yl.x)}; }
#pragma unroll
                for (int ks = 0; ks < 2; ++ks) a = __builtin_amdgcn_mfma_f32_16x16x32_bf16(af[ks], *(const bf16x8*)(Hg + slot * 4096 + (tn * 16 + fr) * 64 + ks * 32 + fq * 8), a, 0, 0, 0);
                yacc[tn] += a;
            }
        }
#pragma unroll
        for (int j = 0; j < 4; ++j) {
            const int l = tm * 16 + fq * 4 + j, row = ci.row0 + l;
            float s = (yacc[0][j] + yacc[1][j]) + (yacc[2][j] + yacc[3][j]);
            s += __shfl_xor(s, 1); s += __shfl_xor(s, 2); s += __shfl_xor(s, 4); s += __shfl_xor(s, 8);
            const float mu = s * (1.f / 64.f);
            float q = 0.f;
#pragma unroll
            for (int tn = 0; tn < 4; ++tn) { const float dd = yacc[tn][j] - mu; q += dd * dd; }
            q += __shfl_xor(q, 1); q += __shfl_xor(q, 2); q += __shfl_xor(q, 4); q += __shfl_xor(q, 8);
            const float rs = rsqrtf(q * (1.f / 64.f) + 64e-5f);
            const float bon = BON[(size_t)row * 8 + h * 2] + BON[(size_t)row * 8 + h * 2 + 1];
#pragma unroll
            for (int tn = 0; tn < 4; ++tn) { const int c = h * 64 + tn * 16 + fr;
                const float yn = (yacc[tn][j] - mu) * rs * C.in[34][layer * 256 + c] + C.in[35][layer * 256 + c];
                const float vv = lerp_d(P, ci, row, 512 + c, mup, mun);
                YC[(size_t)row * DM + 768 + c] = f2bf((yn + bon * vv) * gacc[tn][j]); }
        }
    }
}

__device__ __forceinline__ unsigned ordf(float f) { const unsigned u = __float_as_uint(f); return u ^ ((u >> 31) ? 0xFFFFFFFFu : 0x80000000u); }
__device__ __forceinline__ unsigned wave_max_u32(unsigned v) {
    unsigned t;
    t = (unsigned)__builtin_amdgcn_update_dpp((int)v, (int)v, 0xB1, 0xF, 0xF, false); v = t > v ? t : v;
    t = (unsigned)__builtin_amdgcn_update_dpp((int)v, (int)v, 0x4E, 0xF, 0xF, false); v = t > v ? t : v;
    t = (unsigned)__builtin_amdgcn_update_dpp((int)v, (int)v, 0x141, 0xF, 0xF, false); v = t > v ? t : v;
    t = (unsigned)__builtin_amdgcn_update_dpp((int)v, (int)v, 0x140, 0xF, 0xF, false); v = t > v ? t : v;
    t = (unsigned)__builtin_amdgcn_update_dpp((int)v, (int)v, 0x142, 0xA, 0xF, false); v = t > v ? t : v;
    t = (unsigned)__builtin_amdgcn_update_dpp((int)v, (int)v, 0x143, 0xC, 0xF, false); v = t > v ? t : v;
    return (unsigned)__builtin_amdgcn_readlane((int)v, 63);
}
constexpr int SEL_K1 = 0, SEL_K2 = 34816;
__device__ __forceinline__ float unordf(unsigned k) { return __uint_as_float((k & 0x80000000u) ? (k ^ 0x80000000u) : ~k); }
template <int N> __device__ __forceinline__ void bitonic_sort_desc(unsigned (&x)[N]) {
#pragma unroll
    for (int k = 2; k <= N; k <<= 1)
#pragma unroll
        for (int j = k >> 1; j > 0; j >>= 1)
#pragma unroll
            for (int i = 0; i < N; ++i) { const int l = i ^ j;
                if (l > i) { const unsigned p = x[i], q = x[l]; const unsigned hi = p > q ? p : q, lo = p > q ? q : p; if ((i & k) == 0) { x[i] = hi; x[l] = lo; } else { x[i] = lo; x[l] = hi; } } }
}
__device__ __forceinline__ void merge_top16(unsigned (&a)[16], const unsigned (&b)[16]) {
#pragma unroll
    for (int i = 0; i < 16; ++i) a[i] = a[i] > b[15 - i] ? a[i] : b[15 - i];
#pragma unroll
    for (int j = 8; j > 0; j >>= 1)
#pragma unroll
        for (int i = 0; i < 16; ++i) { const int l = i ^ j; if (l > i) { const unsigned p = a[i], q = a[l]; a[i] = p > q ? p : q; a[l] = p > q ? q : p; } }
}
__device__ __forceinline__ void ph_select(const Ctx& C, int layer, int nrows) {
    const bf16_t* Q = (const bf16_t*)(C.ws + WS_Q); int* SELI = (int*)(C.ws + WS_SELI); float* SELG = (float*)(C.ws + WS_SELG);
    LAS bf16_t* K1 = (LAS bf16_t*)(C.lds + SEL_K1); LAS bf16_t* K2 = (LAS bf16_t*)(C.lds + SEL_K2);
    {
        const float* k1 = C.in[37] + (size_t)layer * 128 * 128; const float* k2 = C.in[38] + (size_t)layer * 128 * 128;
        for (int e = C.tid; e < 4096; e += 512) { const int r = e >> 5, c4 = (e & 31) * 4; const f32x4 a = *(const f32x4*)(k1 + r * 128 + c4), b = *(const f32x4*)(k2 + r * 128 + c4);
            u32x2 oa, ob; oa.x = pk2(a.x, a.y); oa.y = pk2(a.z, a.w); ob.x = pk2(b.x, b.y); ob.y = pk2(b.z, b.w);
            *(LAS u32x2*)(K1 + r * 136 + c4) = oa; *(LAS u32x2*)(K2 + r * 136 + c4) = ob; }
    }
    __syncthreads();
    const int nunits = (nrows / 16) * 8;
    for (int u = C.bid * 8 + C.wid; u < nunits; u += C.G * 8) {
        int ln_ = C.lane; asm volatile("" : "+v"(ln_));
        const int fr = ln_ & 15, fq = ln_ >> 4;
        const int tile = u >> 3, h = u & 7, row = tile * 16 + fr;
        const bf16_t* qp = Q + (size_t)row * 2048 + h * 256 + fq * 8;
        bf16x8 qf[8];
#pragma unroll
        for (int i = 0; i < 8; ++i) qf[i] = *(const bf16x8*)(qp + i * 32);
        unsigned T[2][16];
#pragma unroll
        for (int half = 0; half < 2; ++half) {
            const LAS bf16_t* K = half ? K2 : K1;
            unsigned lo16[16], hi16[16];
#pragma unroll
            for (int kt = 0; kt < 8; ++kt) {
                f32x4 acc = {0.f, 0.f, 0.f, 0.f};
#pragma unroll
                for (int ks = 0; ks < 4; ++ks) acc = __builtin_amdgcn_mfma_f32_16x16x32_bf16(*(const LAS bf16x8*)(K + (kt * 16 + fr) * 136 + ks * 32 + fq * 8), qf[half * 4 + ks], acc, 0, 0, 0);
#pragma unroll
                for (int j = 0; j < 4; ++j) { const unsigned key = (ordf(acc[j]) & ~0x7Fu) | (unsigned)(127 - (kt * 16 + fq * 4 + j));
                    if (kt < 4) lo16[kt * 4 + j] = key; else hi16[(kt - 4) * 4 + j] = key; }
            }
            bitonic_sort_desc<16>(lo16); bitonic_sort_desc<16>(hi16); merge_top16(lo16, hi16);
#pragma unroll
            for (int rnd = 16; rnd <= 32; rnd <<= 1) { unsigned o[16];
#pragma unroll
                for (int i = 0; i < 16; ++i) o[i] = (unsigned)__shfl_xor((int)lo16[i], rnd);
                merge_top16(lo16, o); }
#pragma unroll
            for (int i = 0; i < 16; ++i) T[half][i] = lo16[i];
        }
        unsigned ck[50]; unsigned R0[16];
        {
            int id = 0;
#pragma unroll
            for (int a = 0; a < 16; ++a) {
                const float va = unordf(T[0][a] & ~0x7Fu);
#pragma unroll
                for (int b = 0; b < 16; ++b) if ((a + 1) * (b + 1) <= 16) { ck[id] = (ordf(va + unordf(T[1][b] & ~0x7Fu)) & ~0x3Fu) | (unsigned)(63 - id); ++id; }
            }
        }
#pragma unroll
        for (int i = 0; i < 16; ++i) R0[i] = ck[i];
        {
            int base = 16;
#pragma unroll
            for (int a = 1; a < 8; ++a) { const int n = 16 / (a + 1); unsigned rw[16];
#pragma unroll
                for (int i = 0; i < 16; ++i) rw[i] = i < n ? ck[base + i] : 0u;
                merge_top16(R0, rw); base += n; }
            unsigned rw[16];
#pragma unroll
            for (int i = 0; i < 16; ++i) rw[i] = i < 8 ? ck[base + i] : 0u;
            merge_top16(R0, rw);
        }
        const unsigned thr = R0[15]; const float mx = unordf(R0[0] & ~0x3Fu);
        float sum = 0.f;
#pragma unroll
        for (int c = 0; c < 50; ++c) sum += ck[c] >= thr ? __expf(unordf(ck[c] & ~0x3Fu) - mx) : 0.f;
        const float rsum = 1.f / sum;
        int* oi = SELI + ((size_t)row * 8 + h) * 16; float* og = SELG + ((size_t)row * 8 + h) * 16;
        {
            int id = 0, cnt = 0;
#pragma unroll
            for (int a = 0; a < 16; ++a)
#pragma unroll
                for (int b = 0; b < 16; ++b) if ((a + 1) * (b + 1) <= 16) {
                    if (ck[id] >= thr) { if (fq == 0 && cnt < 16) { oi[cnt] = (127 - (int)(T[0][a] & 0x7Fu)) * 128 + (127 - (int)(T[1][b] & 0x7Fu)); og[cnt] = __expf(unordf(ck[id] & ~0x3Fu) - mx) * rsum; } ++cnt; }
                    ++id; }
        }
    }
}

struct R16 { float v[16]; };
__device__ __forceinline__ R16 load_r16_f32(const float* p, int lane) { R16 r;
#pragma unroll
    for (int k = 0; k < 4; ++k) { const f32x4 a = *(const f32x4*)(p + 16 * lane + 4 * k); r.v[4 * k] = a.x; r.v[4 * k + 1] = a.y; r.v[4 * k + 2] = a.z; r.v[4 * k + 3] = a.w; }
    return r; }
__device__ __forceinline__ void store_r16_f32(float* p, int lane, const R16& r) {
#pragma unroll
    for (int k = 0; k < 4; ++k) *(f32x4*)(p + 16 * lane + 4 * k) = (f32x4){r.v[4 * k], r.v[4 * k + 1], r.v[4 * k + 2], r.v[4 * k + 3]}; }
__device__ __forceinline__ R16 load_r16_bf16(const bf16_t* p, int lane) { R16 r;
#pragma unroll
    for (int k = 0; k < 2; ++k) { const u32x4 a = *(const u32x4*)(p + 16 * lane + 8 * k);
        r.v[8 * k] = bflo(a.x); r.v[8 * k + 1] = bfhi(a.x); r.v[8 * k + 2] = bflo(a.y); r.v[8 * k + 3] = bfhi(a.y); r.v[8 * k + 4] = bflo(a.z); r.v[8 * k + 5] = bfhi(a.z); r.v[8 * k + 6] = bflo(a.w); r.v[8 * k + 7] = bfhi(a.w); }
    return r; }
__device__ __forceinline__ void store_r16_bf16(bf16_t* p, int lane, const R16& r) {
#pragma unroll
    for (int k = 0; k < 2; ++k) { u32x4 a; a.x = pk2(r.v[8 * k], r.v[8 * k + 1]); a.y = pk2(r.v[8 * k + 2], r.v[8 * k + 3]); a.z = pk2(r.v[8 * k + 4], r.v[8 * k + 5]); a.w = pk2(r.v[8 * k + 6], r.v[8 * k + 7]);
        *(u32x4*)(p + 16 * lane + 8 * k) = a; } }
typedef float f32x2p __attribute__((ext_vector_type(2)));
struct PeerHdr { int idx0, idx1; float su0, su1, gsv0, gsv1; };
__device__ __forceinline__ void ph_peer(const Ctx& C, int layer, int nrows, bool last, bool store = true, int idmask = 0x3FFF) {
    const bf16_t* F = (const bf16_t*)(C.ws + WS_ACT); bf16_t* XN = (bf16_t*)(C.ws + WS_ACT);
    const unsigned char* UB = C.ws + WS_UB; const unsigned char* VB = C.ws + WS_VB; const float* SU = (const float*)(C.ws + WS_SU); const float* SV = (const float*)(C.ws + WS_SV);
    const int* SELI = (const int*)(C.ws + WS_SELI); const float* SELG = (const float*)(C.ws + WS_SELG);
    float* H = (float*)(C.ws + WS_H); const float* MOD = (const float*)(C.ws + WS_MOD);
    const int step = C.G * 8;
    auto load_hdr = [&](int tok, int L) { PeerHdr h; h.idx0 = SELI[(size_t)tok * 128 + L] & idmask; h.idx1 = SELI[(size_t)tok * 128 + 64 + L] & idmask;
        h.su0 = SU[h.idx0]; h.su1 = SU[h.idx1]; h.gsv0 = SELG[(size_t)tok * 128 + L] * SV[h.idx0]; h.gsv1 = SELG[(size_t)tok * 128 + 64 + L] * SV[h.idx1]; return h; };
    int tok = C.bid * 8 + C.wid;
    for (; tok < nrows; tok += step) {
        int L = C.lane; asm volatile("" : "+v"(L));
        const int myexp = ((L >> 5) & 1) * 4 + ((L >> 4) & 1) * 2 + ((L >> 3) & 1);
        const PeerHdr hd = load_hdr(tok, L);
        const u32x4 fpa = *(const u32x4*)(F + (size_t)tok * DM + 16 * L), fpb = *(const u32x4*)(F + (size_t)tok * DM + 16 * L + 8);
        f32x2p out[8];
#pragma unroll
        for (int i = 0; i < 8; ++i) out[i] = (f32x2p){0.f, 0.f};
        u32x4 ua[2][8], va[2][8];
#define PEER_LOAD(buf, bt) do { const int src_ = (bt) < 8 ? hd.idx0 : hd.idx1; const int l0_ = ((bt) & 7) * 8; _Pragma("unroll") for (int i = 0; i < 8; ++i) { const int ei = __builtin_amdgcn_readlane(src_, l0_ + i); \
            ua[buf][i] = *(const u32x4*)(UB + (size_t)ei * DM + 16 * L); va[buf][i] = *(const u32x4*)(VB + (size_t)ei * DM + 16 * L); } } while (0)
#define PEER_COMPUTE(buf, bt) do { const float susrc = (bt) < 8 ? hd.su0 : hd.su1, gsrc = (bt) < 8 ? hd.gsv0 : hd.gsv1; const int l0 = ((bt) & 7) * 8; float part[8]; \
            _Pragma("unroll") for (int i = 0; i < 8; ++i) { f32x2p acc = {0.f, 0.f}; _Pragma("unroll") for (int k = 0; k < 4; ++k) { \
                const f32x2p lo = __builtin_amdgcn_cvt_pk_f32_fp8((int)ua[buf][i][k], false), hi = __builtin_amdgcn_cvt_pk_f32_fp8((int)ua[buf][i][k], true); \
                const unsigned fw0 = (k < 2 ? fpa : fpb)[(2 * k) & 3], fw1 = (k < 2 ? fpa : fpb)[(2 * k + 1) & 3]; \
                acc += lo * (f32x2p){bflo(fw0), bfhi(fw0)}; acc += hi * (f32x2p){bflo(fw1), bfhi(fw1)}; } part[i] = acc.x + acc.y; } \
            float p4[4], p2[2], p1; \
            { const bool hi = (L & 32) != 0; _Pragma("unroll") for (int i = 0; i < 4; ++i) { const float send = hi ? part[i] : part[i + 4]; const float recv = __shfl_xor(send, 32); p4[i] = (hi ? part[i + 4] : part[i]) + recv; } } \
            { const bool hi = (L & 16) != 0; _Pragma("unroll") for (int i = 0; i < 2; ++i) { const float send = hi ? p4[i] : p4[i + 2]; const float recv = __shfl_xor(send, 16); p2[i] = (hi ? p4[i + 2] : p4[i]) + recv; } } \
            { const bool hi = (L & 8) != 0; const float send = hi ? p2[0] : p2[1]; const float recv = __shfl_xor(send, 8); p1 = (hi ? p2[1] : p2[0]) + recv; } \
            p1 += __shfl_xor(p1, 4); p1 += __shfl_xor(p1, 2); p1 += __shfl_xor(p1, 1); \
            const float act = gelu_tanh(p1 * __shfl(susrc, l0 + myexp)) * __shfl(gsrc, l0 + myexp); \
            _Pragma("unroll") for (int i = 0; i < 8; ++i) { \
                const float a = __uint_as_float((unsigned)__builtin_amdgcn_readlane((int)__float_as_uint(act), ((i >> 2) & 1) * 32 + ((i >> 1) & 1) * 16 + (i & 1) * 8)); const f32x2p a2 = {a, a}; \
                _Pragma("unroll") for (int k = 0; k < 4; ++k) { out[2 * k] += a2 * __builtin_amdgcn_cvt_pk_f32_fp8((int)va[buf][i][k], false); out[2 * k + 1] += a2 * __builtin_amdgcn_cvt_pk_f32_fp8((int)va[buf][i][k], true); } } } while (0)
        PEER_LOAD(0, 0);
        for (int bt = 0; bt < 16; bt += 2) {
            PEER_LOAD(1, bt + 1);
            PEER_COMPUTE(0, bt);
            if (bt + 2 < 16) PEER_LOAD(0, bt + 2);
            PEER_COMPUTE(1, bt + 1);
        }
#undef PEER_LOAD
#undef PEER_COMPUTE
        const float* m = MOD + ((size_t)layer * 3 + which_of(tok)) * 6144;
        R16 hr = load_r16_f32(H + (size_t)tok * DM, L); const R16 g5 = load_r16_f32(m + 5 * 1024, L);
#pragma unroll
        for (int i = 0; i < 8; ++i) { hr.v[2 * i] += g5.v[2 * i] * out[i].x; hr.v[2 * i + 1] += g5.v[2 * i + 1] * out[i].y; }
        float ss = 0.f;
#pragma unroll
        for (int i = 0; i < 16; ++i) ss += hr.v[i] * hr.v[i];
        const float rs = rsqrtf(wave_sum(ss) * (1.f / 1024.f) + 1e-6f);
        if (!store) continue;
        if (!last) {
            store_r16_f32(H + (size_t)tok * DM, L, hr);
            const float* m2 = MOD + ((size_t)(layer + 1) * 3 + which_of(tok)) * 6144;
            const R16 gg = load_r16_f32(C.in[6] + (layer + 1) * 1024, L), sh = load_r16_f32(m2, L), sc = load_r16_f32(m2 + 1024, L); R16 o;
#pragma unroll
            for (int i = 0; i < 16; ++i) o.v[i] = (hr.v[i] * rs * gg.v[i]) * (1.f + sc.v[i]) + sh.v[i];
            store_r16_bf16(XN + (size_t)tok * DM, L, o);
        } else {
            const R16 fg = load_r16_f32(C.in[41], L); R16 o;
#pragma unroll
            for (int i = 0; i < 16; ++i) o.v[i] = hr.v[i] * rs * fg.v[i];
            store_r16_f32(C.out + (size_t)tok * DM, L, o);
        }
    }
}

#define PM(n) ((MASK >> (n)) & 1u)
constexpr int NPH_LAYER = 9, NPH = 2 + 2 * NPH_LAYER;
template <unsigned MASK> __global__ void __launch_bounds__(512, 2) hybrid_fwd(Args args) {
    extern __shared__ __attribute__((aligned(16))) unsigned char lds_raw[];
    Ctx C0; C0.in = args.in; C0.out = args.out; C0.ws = args.ws; C0.lds = (lds_t)lds_raw;
    C0.tid = threadIdx.x; C0.lane = C0.tid & 63; C0.wid = __builtin_amdgcn_readfirstlane(C0.tid >> 6); C0.bid = blockIdx.x; C0.G = gridDim.x;
    const Ctx& C = C0;
    const int lo = args.ph_lo, hi = args.ph_hi;
    const bool multi = (hi - lo) > 1;
    XcdBarrier bar; bar.bar = (unsigned*)(C.ws + WS_CTL); bar.x = 0; bar.st = (volatile LAS unsigned*)(C.lds + LDS_XB);
    if (multi) {
        if (C.tid == 0) *(LAS u32x4*)(C.lds + LDS_XB) = (u32x4){0u, 0u, 0u, 0u};
        __syncthreads();
        bar = xcd_barrier_post((unsigned*)(C.ws + WS_CTL), (volatile LAS unsigned*)(C.lds + LDS_XB));
    }
#define IN(k) (lo <= (k) && (k) < hi)
#define PHASE_CTX(c) Ctx c = C0; { int t_ = C0.tid; asm volatile("" : "+v"(t_)); c.tid = t_; c.lane = t_ & 63; c.wid = __builtin_amdgcn_readfirstlane(t_ >> 6); }
#ifndef MK_REPEAT
#define MK_REPEAT 0u
#endif
#define RP(k) ((MK_REPEAT >> (k)) & 1u)
#define STAMP(k) do {} while (0)
#define SEAM(k) do { if (IN(k) && IN((k) + 1)) xcd_barrier(bar); STAMP((k) + 1); } while (0)
    STAMP(0);
    if (RP(10)) { for (int i = 0; i < 20; ++i) xcd_barrier(bar); }
    if (PM(0) && IN(0)) { PHASE_CTX(c); ph_prologue(c); if (RP(9)) { xcd_barrier(bar); ph_prologue(c); } } SEAM(0);
    if (PM(1) && IN(1)) { PHASE_CTX(c); ph_norm(c, 0, c.in[6], 0, NROW); } SEAM(1);
    for (int layer = 0; layer < 2; ++layer) {
        const int base = 2 + layer * NPH_LAYER;
        const bool emit = (layer == 0);
        const int nrows = emit ? NROW : NLAT;
        if (PM(2) && IN(base + 0)) {
            pg8::Gemm g{(const bf16_t*)(C.ws + WS_ACT), (const bf16_t*)(C.ws + WS_WIN) + (size_t)layer * NP * DM, NROW, NP, DM};
            pg8::StaticOrder S; S.init(NROW, NP, C.G, C.bid);
            pg8::EpiBf16<0> E{(bf16_t*)(C.ws + WS_P), NP, nullptr, 0, 0};
            pg8::gemm_phase<pg8::EpiBf16<0>, pg8::StaticOrder, false>(C.lds, g, S, E, nullptr);
            if (RP(0)) { xcd_barrier(bar); pg8::gemm_phase<pg8::EpiBf16<0>, pg8::StaticOrder, false>(C.lds, g, S, E, nullptr); }
            { const int nfull = (NROW / 256) * (NP / 256) - ((NROW / 256) * (NP / 256) / C.G) * C.G; PHASE_CTX(c); if (c.bid >= nfull) convert_tables(c, layer, c.bid - nfull, c.G - nfull); }
        }
        SEAM(base + 0);
        if (PM(3) && IN(base + 1)) {
            const int nD = 2112, nC = 264, nB = emit ? 132 : 128, nA = emit ? 264 : 256, tot = nD + nC + nB + nA;
            for (int rep = 0; rep < (RP(1) ? 2 : 1); ++rep) {
            if (rep) xcd_barrier(bar);
            if (PM(11)) { PHASE_CTX(c); D1Pre pre; pre.hd = -1; for (int it = c.bid; it < nD; it += c.G) item_rwkv_local(c, layer, it, pre, it + c.G < nD ? it + c.G : -1); }
            if (PM(12)) { PHASE_CTX(c); for (int it = (c.bid + 52) % c.G; it < nC; it += c.G) item_mamba_local(c, layer, it); }
            if (PM(13)) { PHASE_CTX(c); for (int it = (c.bid + 192) % c.G; it < nB; it += c.G) item_chunkmlp(c, layer, it); }
            if (PM(14)) { PHASE_CTX(c); for (int it = (c.bid + 60) % c.G; it < nA; it += c.G) item_conformer(c, layer, it); }
            }
        }
        SEAM(base + 1);
        if (PM(4) && IN(base + 2)) { PHASE_CTX(c); if (RP(12)) { ph_scan(c, 1, args.ph_hi > 1000, false); xcd_barrier(bar); } ph_scan(c, RP(2) ? 2 : 1); }
        SEAM(base + 2);
        if (PM(5) && IN(base + 3)) {
            const int nc = nrows / 64;
            for (int rep = 0; rep < (RP(3) ? 2 : 1); ++rep) {
            if (rep) xcd_barrier(bar);
            if (PM(15)) { PHASE_CTX(c); load_g2t(c, layer); for (int it = c.bid; it < nc; it += c.G) item_rwkv_out(c, layer, it); }
            __syncthreads();
            if (PM(16)) { PHASE_CTX(c); for (int it = (c.bid + 128) % c.G; it < nc; it += c.G) item_mamba_out(c, layer, it); }
            __syncthreads();
            }
        }
        SEAM(base + 3);
        if (PM(6) && IN(base + 4)) {
            pg8::Gemm g{(const bf16_t*)(C.ws + WS_ACT), (const bf16_t*)(C.ws + WS_WOUT) + (size_t)layer * DM * DM, NLAT, DM, DM};
            pg8::StaticOrder S; S.init(NLAT, DM, C.G, C.bid);
            EpiResid E{(float*)(C.ws + WS_H), (const float*)(C.ws + WS_MOD) + (size_t)layer * 3 * 6144};
            pg8::gemm_phase<EpiResid, pg8::StaticOrder, false>(C.lds, g, S, E, nullptr);
            if (emit) {
                PHASE_CTX(c);
                for (int u = c.bid; u < 256; u += c.G) { const int tr = u >> 4, tc = u & 15;
                    float* Hc = (float*)(c.ws + WS_H) + (size_t)(NLAT + tr * 32) * DM + tc * 64;
                    const float* gate = (const float*)(c.ws + WS_MOD) + ((size_t)layer * 3 + 2) * 6144 + 2 * 1024 + tc * 64;
                    small_gemm_tile<2, 4>(c, (const bf16_t*)(c.ws + WS_ACT) + (size_t)(NLAT + tr * 32) * DM, (const bf16_t*)(c.ws + WS_WOUT) + (size_t)layer * DM * DM + (size_t)(tc * 64) * DM, DM,
                        [=](int r, int cc, const f32x4& acc) {
#pragma unroll
                            for (int j = 0; j < 4; ++j) Hc[(size_t)(r + j) * DM + cc] += gate[cc] * acc[j]; });
                }
            }
        }
        SEAM(base + 4);
        if (PM(7) && IN(base + 5)) { PHASE_CTX(c); for (int rep = 0; rep < (RP(5) ? 2 : 1); ++rep) { if (rep) xcd_barrier(bar); ph_norm(c, layer, c.in[7] + layer * 1024, 3, nrows); } }
        SEAM(base + 5);
        if (PM(8) && IN(base + 6)) {
            pg8::Gemm g{(const bf16_t*)(C.ws + WS_ACT), (const bf16_t*)(C.ws + WS_WQ) + (size_t)layer * 2048 * DM, NLAT, 2048, DM};
            pg8::StaticOrder S; S.init(NLAT, 2048, C.G, C.bid);
            pg8::EpiBf16<0> E{(bf16_t*)(C.ws + WS_Q), 2048, nullptr, 0, 0};
            pg8::gemm_phase<pg8::EpiBf16<0>, pg8::StaticOrder, false>(C.lds, g, S, E, nullptr);
            if (RP(6)) { xcd_barrier(bar); pg8::gemm_phase<pg8::EpiBf16<0>, pg8::StaticOrder, false>(C.lds, g, S, E, nullptr); }
            if (emit) {
                PHASE_CTX(c);
                for (int u = c.bid; u < 256; u += c.G) { const int tr = u >> 5, tc = u & 31;
                    bf16_t* Qc = (bf16_t*)(c.ws + WS_Q) + (size_t)(NLAT + tr * 64) * 2048 + tc * 64;
                    small_gemm_tile<4, 4>(c, (const bf16_t*)(c.ws + WS_ACT) + (size_t)(NLAT + tr * 64) * DM, (const bf16_t*)(c.ws + WS_WQ) + (size_t)layer * 2048 * DM + (size_t)(tc * 64) * DM, DM,
                        [=](int r, int cc, const f32x4& acc) {
#pragma unroll
                            for (int j = 0; j < 4; ++j) Qc[(size_t)(r + j) * 2048 + cc] = f2bf(acc[j]); });
                }
            }
        }
        SEAM(base + 6);
        if (PM(9) && IN(base + 7)) { PHASE_CTX(c); ph_select(c, layer, nrows); if (RP(7)) { xcd_barrier(bar); ph_select(c, layer, nrows); } }
        SEAM(base + 7);
        if (PM(10) && IN(base + 8)) { PHASE_CTX(c); if (RP(8)) { ph_peer(c, layer, nrows, layer == 1, args.ph_hi > 1000); xcd_barrier(bar); } if (RP(11)) { ph_peer(c, layer, nrows, layer == 1, args.ph_hi > 1000, 1023); xcd_barrier(bar); } ph_peer(c, layer, nrows, layer == 1); }
        SEAM(base + 8);
    }
#undef IN
#undef SEAM
}
}


namespace mk {
struct LaunchEnt { unsigned mask; int ph; };
template <unsigned MASK> static bool prep_kernel() {
    return hipFuncSetAttribute((const void*)hybrid_fwd<MASK>, hipFuncAttributeMaxDynamicSharedMemorySize, LDS_BYTES) == hipSuccess;
}
template <unsigned MASK> static void launch_kernel(int grid, hipStream_t stream, const Args& a) {
    hipLaunchKernelGGL(hybrid_fwd<MASK>, dim3(grid), dim3(512), LDS_BYTES, stream, a);
}
}

#define CENSUS(off, n, kind, stage, lim) do {} while (0)
#ifndef MK_ONE_LAUNCH
#define MK_ONE_LAUNCH 1
#endif
extern "C" void kernel_launch(void* const* d_in, const int* in_sizes, int n_in, void* d_out, int out_size, void* d_ws, size_t ws_size, hipStream_t stream) {
    using namespace mk;
    static int grid = 0;
    if (grid == 0) {
        if (n_in != 42 || ws_size < WS_END) { fprintf(stderr, "kernel_launch: need 42 inputs and %zu bytes of workspace (got %d, %zu)\n", (size_t)WS_END, n_in, ws_size); grid = -1; return; }
        int dev = 0, cus = 0;
        if (hipGetDevice(&dev) != hipSuccess || hipDeviceGetAttribute(&cus, hipDeviceAttributeMultiprocessorCount, dev) != hipSuccess) { grid = -1; return; }
        bool ok = true;
#if MK_ONE_LAUNCH
        ok = ok && prep_kernel<0x1FFFFu>();
#else
        ok = ok && prep_kernel<0x0001u>() && prep_kernel<0x0002u>() && prep_kernel<0x0004u>() && prep_kernel<0x0808u>() && prep_kernel<0x1008u>() && prep_kernel<0x2008u>() && prep_kernel<0x4008u>()
                && prep_kernel<0x0010u>() && prep_kernel<0x8020u>() && prep_kernel<0x10020u>() && prep_kernel<0x0040u>() && prep_kernel<0x0080u>() && prep_kernel<0x0100u>() && prep_kernel<0x0200u>() && prep_kernel<0x0400u>();
#endif
        if (!ok) { fprintf(stderr, "kernel_launch: hipFuncSetAttribute failed\n"); grid = -1; return; }
        (void)hipGetLastError();
        grid = cus;
    }
    if (grid < 0) return;
    (void)hipMemsetAsync((char*)d_ws + WS_CTL, 0, 65536, stream);
    Args a{};
    for (int i = 0; i < 42; ++i) a.in[i] = (const float*)d_in[i];
    a.out = (float*)d_out; a.ws = (unsigned char*)d_ws;
#if MK_ONE_LAUNCH
    a.ph_lo = 0; a.ph_hi = NPH; launch_kernel<0x1FFFFu>(grid, stream, a);
#else
    a.ph_lo = 0; a.ph_hi = 1; launch_kernel<0x0001u>(grid, stream, a);
    CENSUS(WS_H, (size_t)NROW * DM, 0, 1, 1e4f); CENSUS(WS_MOD, 2 * 3 * 6144, 0, 1, 1e4f); CENSUS(WS_WIN, 2ull * NP * DM, 1, 1, 1e4f); CENSUS(WS_UB, 2ull * NEXP * DM, 1, 1, 1e4f);
    a.ph_lo = 1; a.ph_hi = 2; launch_kernel<0x0002u>(grid, stream, a);
    CENSUS(WS_ACT, (size_t)NROW * DM, 1, 2, 1e4f);
    for (int layer = 0; layer < 2; ++layer) {
        const int b = 2 + layer * NPH_LAYER;
        const int so = layer ? 100 : 0; (void)so;
        a.ph_lo = b + 0; a.ph_hi = b + 1; launch_kernel<0x0004u>(grid, stream, a);
        if (!layer) CENSUS(WS_P, (size_t)NROW * NP, 1, 3, 1e4f);
        a.ph_lo = b + 1; a.ph_hi = b + 2; launch_kernel<0x0808u>(grid, stream, a);
        if (!layer) { CENSUS(WS_RG, (size_t)NSLOT * 4096, 1, 4, 1e6f); CENSUS(WS_RJ, (size_t)NSLOT * 4096, 0, 5, 1e6f); CENSUS(WS_RY, (size_t)NSLOT * 4096 * 2, 1, 6, 1e6f); CENSUS(WS_BON, (size_t)NROW * 8, 0, 6, 1e6f); }
        launch_kernel<0x1008u>(grid, stream, a);
        if (!layer) { CENSUS(WS_MST, (size_t)NSLOT * 8192, 0, 7, 1e6f); CENSUS(WS_MCD, NSLOT, 0, 7, 1e6f); }
        launch_kernel<0x2008u>(grid, stream, a); launch_kernel<0x4008u>(grid, stream, a);
        a.ph_lo = b + 2; a.ph_hi = b + 3; launch_kernel<0x0010u>(grid, stream, a);
        if (!layer) { CENSUS(WS_MST, (size_t)NSLOT * 8192, 0, 8, 1e6f); CENSUS(WS_RH, (size_t)NSLOT * 4096, 1, 9, 1e6f); }
        a.ph_lo = b + 3; a.ph_hi = b + 4; launch_kernel<0x8020u>(grid, stream, a); launch_kernel<0x10020u>(grid, stream, a);
        if (!layer) CENSUS(WS_ACT, (size_t)NROW * DM, 1, 10, 1e4f);
        a.ph_lo = b + 4; a.ph_hi = b + 5; launch_kernel<0x0040u>(grid, stream, a);
        if (!layer) CENSUS(WS_H, (size_t)NROW * DM, 0, 11, 1e4f);
        a.ph_lo = b + 5; a.ph_hi = b + 6; launch_kernel<0x0080u>(grid, stream, a);
        a.ph_lo = b + 6; a.ph_hi = b + 7; launch_kernel<0x0100u>(grid, stream, a);
        if (!layer) CENSUS(WS_Q, (size_t)NROW * 2048, 1, 12, 1e4f);
        a.ph_lo = b + 7; a.ph_hi = b + 8; launch_kernel<0x0200u>(grid, stream, a);
        if (!layer) { CENSUS(WS_SELI, (size_t)NROW * 128, 2, 13, 0.f); CENSUS(WS_SELG, (size_t)NROW * 128, 0, 13, 2.f); }
        a.ph_lo = b + 8; a.ph_hi = b + 9; launch_kernel<0x0400u>(grid, stream, a);
        if (!layer) { CENSUS(WS_H, (size_t)NROW * DM, 0, 14, 1e4f); CENSUS(WS_ACT, (size_t)NROW * DM, 1, 15, 1e4f); }
    }
#endif
    (void)in_sizes; (void)out_size;
}
```

```cpp
#include <hip/hip_runtime.h>
#include <cstdio>
#include <cstdint>
namespace pg8 {
#define PG8_LAS __attribute__((address_space(3)))
typedef unsigned short bf16_t;
typedef short bf16x8 __attribute__((ext_vector_type(8)));
typedef float f32x4 __attribute__((ext_vector_type(4)));
typedef unsigned u32x4 __attribute__((ext_vector_type(4)));
constexpr int BM = 256, BK = 64, HALF = 128, HTB = HALF * BK * 2  , STAGE_BYTES = 8 * HTB, NXCD = 8, WGM = 8;

__host__ __device__ __forceinline__ int lds_byte(int r, int c) { const int st = (r >> 4) * 2 + (c >> 5), rr = r & 15, cc = c & 31, ob = rr * 64 + cc * 2; return st * 1024 + (ob ^ (((ob >> 9) & 1) << 5)); }
__host__ __device__ __forceinline__ void stage_rc(int b, int& R, int& C) { const int st = b / 1024, sb = b % 1024, swz = sb ^ (((sb >> 9) & 1) << 5); R = (st >> 1) * 16 + swz / 64; C = (st & 1) * 32 + (swz % 64) / 2; }
__host__ __device__ __forceinline__ int perm32(int rho) { const int n = rho >> 4, i = rho & 15; return 8 * (i >> 2) + 4 * n + (i & 3); }

struct Unit { int pm, pn; };
struct Gemm { const bf16_t* A; const bf16_t* Bt; int M, N, K; };

struct StaticOrder {
    int nM, nN, nwg, G, c;
    __host__ __device__ void init(int M, int N, int G_, int c_) { nM = M / BM; nN = N / BM; nwg = nM * nN; G = G_; c = c_; }
    __host__ __device__ bool next(int i, Unit& u) const {
        const long L = (long)i * G + c; if (L >= nwg) return false;
        int wgid = (int)L; { const int q = nwg / NXCD, r = nwg % NXCD, xcd = wgid % NXCD, off = wgid / NXCD; wgid = (xcd < r ? xcd * (q + 1) : r * (q + 1) + (xcd - r) * q) + off; }
        const int nig = WGM * nN, gid = wgid / nig, fm = gid * WGM, gsz = (nM - fm) < WGM ? (nM - fm) : WGM;
        u.pm = fm + ((wgid % nig) % gsz); u.pn = (wgid % nig) / gsz; return true;
    }
    __device__ __forceinline__ void a_ready(const Unit&) const {}
    __device__ __forceinline__ void done(const Unit&) const {}
};
struct CountedOrder : StaticOrder {
    const unsigned* ready; unsigned need; unsigned* tmo;
    __device__ __forceinline__ void a_ready(const Unit& u) const {
        if (threadIdx.x < 64) {
            const unsigned long long t0 = __builtin_amdgcn_s_memrealtime(); unsigned polls = 0;
            while ((unsigned)__builtin_amdgcn_readfirstlane(__hip_atomic_load(ready + 64 * u.pm, __ATOMIC_RELAXED, __HIP_MEMORY_SCOPE_AGENT)) < need) {
                if ((++polls & 255u) == 0u && __builtin_amdgcn_readfirstlane(__hip_atomic_load(tmo, __ATOMIC_RELAXED, __HIP_MEMORY_SCOPE_AGENT)) != 0u) break;
                if (__builtin_amdgcn_s_memrealtime() - t0 > 2000000ull) {
                    if (threadIdx.x == 0) { unsigned expect = 0u; __hip_atomic_compare_exchange_strong(tmo + 1, &expect, 0x600u | (unsigned)(u.pm & 0xff), __ATOMIC_RELAXED, __ATOMIC_RELAXED, __HIP_MEMORY_SCOPE_AGENT); __hip_atomic_store(tmo, 1u, __ATOMIC_RELAXED, __HIP_MEMORY_SCOPE_AGENT); }
                    break; }
                __builtin_amdgcn_s_sleep(2); }
            __builtin_amdgcn_fence(__ATOMIC_ACQUIRE, "agent");
            asm volatile("s_waitcnt vmcnt(0)" ::: "memory");
        }
#if !defined(BROKEN_HOOK_NO_BARRIER)
        asm volatile("" ::: "memory"); __builtin_amdgcn_s_barrier(); asm volatile("" ::: "memory");
#endif
    }
};

__device__ __forceinline__ unsigned cvt_pk_bf16(float lo, float hi) { unsigned r; asm volatile("v_cvt_pk_bf16_f32 %0, %1, %2" : "=v"(r) : "v"(lo), "v"(hi)); return r; }
typedef float f32x2 __attribute__((ext_vector_type(2)));
__device__ __forceinline__ f32x2 gelu_pk(f32x2 v) {
    const f32x2 av = __builtin_elementwise_abs(v), d = av * 0.2316418882f + 1.0f;
    f32x2 t; t.x = __builtin_amdgcn_rcpf(d.x); t.y = __builtin_amdgcn_rcpf(d.y);
    f32x2 q = t * 0.5307027145f + (-0.7265760135f); q = q * t + 0.7107068705f; q = q * t + (-0.142248368f); q = q * t + 0.127414796f; q = q * t;
    const f32x2 s = (v * v) * (-0.72134752044f);
    f32x2 e; e.x = __builtin_amdgcn_exp2f(s.x); e.y = __builtin_amdgcn_exp2f(s.y);
    const f32x2 m = v * (q * e), r = v - m;
    f32x2 o; o.x = v.x < 0.f ? m.x : r.x; o.y = v.y < 0.f ? m.y : r.y; return o;
}

struct EpiF32 {
    static constexpr bool PERM = false, AFTER_DRAIN = false;
    float* C; int ldc; const float* bias;
    __device__ __forceinline__ void operator()(const f32x4 (&acc)[2][2][4][2], const Unit& u, int wr, int wc, int fr, int fq) const {
        const int row0 = u.pm * BM + wr * 64 + fr, col0 = u.pn * BM + wc * 32 + 4 * fq;
        f32x4 bv[2][2];
#pragma unroll
        for (int bj = 0; bj < 2; ++bj)
#pragma unroll
            for (int n = 0; n < 2; ++n) bv[bj][n] = bias ? *(const f32x4*)(bias + col0 + bj * HALF + n * 16) : (f32x4){0.f, 0.f, 0.f, 0.f};
#pragma unroll
        for (int ai = 0; ai < 2; ++ai)
#pragma unroll
            for (int m = 0; m < 4; ++m) { float* rowp = C + (size_t)(row0 + ai * HALF + m * 16) * ldc + col0;
#pragma unroll
                for (int bj = 0; bj < 2; ++bj)
#pragma unroll
                    for (int n = 0; n < 2; ++n) *(f32x4*)(rowp + bj * HALF + n * 16) = acc[ai][bj][m][n] + bv[bj][n]; }
    }
};
template <int ACT  > struct EpiBf16 {
    static constexpr bool PERM = true, AFTER_DRAIN = false;
    bf16_t* O; int ldc; const float* bias; int split_cols; size_t split_stride;
    __device__ __forceinline__ void operator()(const f32x4 (&acc)[2][2][4][2], const Unit& u, int wr, int wc, int fr, int fq) const {
        const int row0 = u.pm * BM + wr * 64 + fr; int colt = u.pn * BM; bf16_t* base = O;
        if (split_cols) { const int t = colt / split_cols; base += (size_t)t * split_stride; colt -= t * split_cols; }
        const int col0 = colt + wc * 32 + 8 * fq, bcol0 = u.pn * BM + wc * 32 + 8 * fq;
        f32x4 bv[2][2];
#pragma unroll
        for (int bj = 0; bj < 2; ++bj)
#pragma unroll
            for (int n = 0; n < 2; ++n) bv[bj][n] = bias ? *(const f32x4*)(bias + bcol0 + bj * HALF + 4 * n) : (f32x4){0.f, 0.f, 0.f, 0.f};
#pragma unroll
        for (int ai = 0; ai < 2; ++ai)
#pragma unroll
            for (int m = 0; m < 4; ++m) { bf16_t* rowp = base + (size_t)(row0 + ai * HALF + m * 16) * ldc + col0;
#pragma unroll
                for (int bj = 0; bj < 2; ++bj) { f32x4 v0 = acc[ai][bj][m][0] + bv[bj][0], v1 = acc[ai][bj][m][1] + bv[bj][1];
                    if (ACT == 1) { f32x2 a = gelu_pk((f32x2){v0[0], v0[1]}), b = gelu_pk((f32x2){v0[2], v0[3]}), c = gelu_pk((f32x2){v1[0], v1[1]}), d = gelu_pk((f32x2){v1[2], v1[3]});
                        v0 = (f32x4){a.x, a.y, b.x, b.y}; v1 = (f32x4){c.x, c.y, d.x, d.y}; }
                    if (ACT == 2) {
#pragma unroll
                        for (int j = 0; j < 4; ++j) { v0[j] = 0.5f * v0[j] * (1.0f + erff(v0[j] * 0.70710678f)); v1[j] = 0.5f * v1[j] * (1.0f + erff(v1[j] * 0.70710678f)); } }
                    u32x4 w; w.x = cvt_pk_bf16(v0[0], v0[1]); w.y = cvt_pk_bf16(v0[2], v0[3]); w.z = cvt_pk_bf16(v1[0], v1[1]); w.w = cvt_pk_bf16(v1[2], v1[3]);
                    *(u32x4*)(rowp + bj * HALF) = w; } }
    }
};
template <class Epi, class Sched, bool STAMP = false>
__device__ __forceinline__ void gemm_phase(PG8_LAS unsigned char* lds, const Gemm g, const Sched& S, const Epi& E, unsigned long long* stamps, int tid_in) {
    int tid_ = tid_in; asm volatile("" : "+v"(tid_));
    const int tid = tid_, wid = __builtin_amdgcn_readfirstlane(tid >> 6), lane = tid & 63, wr = wid >> 2, wc = wid & 3, fr = lane & 15, fq = lane >> 4;
    const int K = g.K, nt = K / BK;
    int ts_lo = 0, ts_hi = 0, nts = 0; const unsigned long long rt_entry = STAMP ? (unsigned long long)wall_clock64() : 0ull;
#define PG8_STAMP() do { if (STAMP && wid == 0 && nts < 64) { const unsigned long long _c = (unsigned long long)clock64(); \
        ts_lo = (lane == nts) ? (int)(unsigned)_c : ts_lo; ts_hi = (lane == nts) ? (int)(unsigned)(_c >> 32) : ts_hi; ++nts; } } while (0)
    PG8_STAMP();
    unsigned voffA[2], voffB[2];
#pragma unroll
    for (int i = 0; i < 2; ++i) { int R, C; stage_rc(tid * 16 + i * 8192, R, C); const int Rb = Epi::PERM ? ((R & ~31) + perm32(R & 31)) : R;
        voffA[i] = (unsigned)(R * K + C) * 2u; voffB[i] = (unsigned)(Rb * K + C) * 2u; }
    const size_t kstep = (size_t)(BK * 2);
    const size_t hstep = (size_t)HALF * K * 2;
    const size_t tstep = 2 * hstep;
    const unsigned ldsw = (unsigned)wid * 1024u;
    const int aoff = lds_byte(wr * 64 + fr, fq * 8), boff = lds_byte(wc * 32 + fr, fq * 8);
#define PG8_SA(b, h) (((b) * 2 + (h)) * HTB)
#define PG8_SB(b, h) ((4 + (b) * 2 + (h)) * HTB)
#define PG8_STAGE(bufoff, gbase, voff) do { _Pragma("unroll") for (int _i = 0; _i < 2; ++_i) \
        __builtin_amdgcn_global_load_lds((const unsigned*)((const char*)(gbase) + (voff)[_i]), (PG8_LAS unsigned*)(lds + (bufoff) + ldsw + _i * 8192), 16, 0, 0); } while (0)
#define PG8_LDA(dst, b, h) do { _Pragma("unroll") for (int m = 0; m < 4; ++m) _Pragma("unroll") for (int k = 0; k < 2; ++k) dst[m][k] = *(const PG8_LAS bf16x8*)(lds + PG8_SA(b, h) + aoff + m * 2048 + k * 1024); } while (0)
#define PG8_LDB(dst, b, h) do { _Pragma("unroll") for (int n = 0; n < 2; ++n) _Pragma("unroll") for (int k = 0; k < 2; ++k) dst[n][k] = *(const PG8_LAS bf16x8*)(lds + PG8_SB(b, h) + boff + n * 2048 + k * 1024); } while (0)
#define PG8_MMA(ai, bj, At, Bt) do { __builtin_amdgcn_s_setprio(1); _Pragma("unroll") for (int m = 0; m < 4; ++m) _Pragma("unroll") for (int n = 0; n < 2; ++n) _Pragma("unroll") for (int k = 0; k < 2; ++k) \
        acc[ai][bj][m][n] = __builtin_amdgcn_mfma_f32_16x16x32_bf16(Bt[n][k], At[m][k], acc[ai][bj][m][n], 0, 0, 0); __builtin_amdgcn_s_setprio(0); } while (0)
#define PG8_WAIT_V(n) asm volatile("s_waitcnt vmcnt(" #n ")" ::: "memory")
#define PG8_WAIT_L(n) asm volatile("s_waitcnt lgkmcnt(" #n ")" ::: "memory")
#define PG8_BAR __builtin_amdgcn_s_barrier()
#define PG8_SCHED __builtin_amdgcn_sched_barrier(0)
    Unit cur, nxt; int ui = 0;
    if (!S.next(0, cur)) return;
    f32x4 acc[2][2][4][2];
#pragma unroll
    for (int a = 0; a < 2; ++a)
#pragma unroll
        for (int b = 0; b < 2; ++b)
#pragma unroll
            for (int m = 0; m < 4; ++m)
#pragma unroll
                for (int n = 0; n < 2; ++n) acc[a][b][m][n] = (f32x4){0.f, 0.f, 0.f, 0.f};
    bf16x8 At[4][2], B0[2][2], B1[2][2];
    const char* cA = (const char*)g.A + (size_t)cur.pm * tstep; const char* cB = (const char*)g.Bt + (size_t)cur.pn * tstep;
    S.a_ready(cur);
    PG8_STAGE(PG8_SB(0, 0), cB, voffB); PG8_STAGE(PG8_SA(0, 0), cA, voffA); PG8_STAGE(PG8_SB(0, 1), cB + hstep, voffB); PG8_STAGE(PG8_SA(0, 1), cA + hstep, voffA);
    if (wr == 1) PG8_BAR;
    PG8_WAIT_V(4); PG8_BAR;
    PG8_STAGE(PG8_SB(1, 0), cB + kstep, voffB); PG8_STAGE(PG8_SA(1, 0), cA + kstep, voffA); PG8_STAGE(PG8_SB(1, 1), cB + hstep + kstep, voffB);
    PG8_WAIT_V(6); PG8_BAR;
    PG8_STAMP();
    for (;;) {
        const bool has_next = S.next(ui + 1, nxt);
        const char* nA = has_next ? (const char*)g.A + (size_t)nxt.pm * tstep : cA; const char* nB = has_next ? (const char*)g.Bt + (size_t)nxt.pn * tstep : cB;
        for (int t = 0; t < nt; t += 2) {
            const bool last = (t == nt - 2);
            const char* a1 = cA + (size_t)(t + 1) * kstep;
            const char* a2 = last ? nA : cA + (size_t)(t + 2) * kstep; const char* b2 = last ? nB : cB + (size_t)(t + 2) * kstep;
            const char* a3 = a2 + kstep; const char* b3 = b2 + kstep;
            if (last && has_next) S.a_ready(nxt);
            PG8_LDB(B0, 0, 0); PG8_SCHED; PG8_LDA(At, 0, 0); PG8_STAGE(PG8_SA(1, 1), a1 + hstep, voffA);
            PG8_WAIT_L(8); PG8_BAR; PG8_WAIT_L(0); PG8_MMA(0, 0, At, B0); PG8_BAR; PG8_SCHED;
            PG8_LDB(B1, 0, 1); PG8_STAGE(PG8_SB(0, 0), b2, voffB);
            PG8_BAR; PG8_WAIT_L(0); PG8_MMA(0, 1, At, B1); PG8_BAR;
            PG8_LDA(At, 0, 1); PG8_STAGE(PG8_SA(0, 0), a2, voffA);
            PG8_BAR; PG8_WAIT_L(0); PG8_MMA(1, 0, At, B0); PG8_BAR; PG8_SCHED;
            PG8_STAGE(PG8_SB(0, 1), b2 + hstep, voffB);
            PG8_WAIT_V(6); PG8_BAR; PG8_MMA(1, 1, At, B1); PG8_BAR;
            PG8_LDB(B0, 1, 0); PG8_SCHED; PG8_LDA(At, 1, 0); PG8_STAGE(PG8_SA(0, 1), a2 + hstep, voffA);
            PG8_WAIT_L(8); PG8_BAR; PG8_WAIT_L(0); PG8_MMA(0, 0, At, B0); PG8_BAR; PG8_SCHED;
            PG8_LDB(B1, 1, 1); PG8_STAGE(PG8_SB(1, 0), b3, voffB);
            PG8_BAR; PG8_WAIT_L(0); PG8_MMA(0, 1, At, B1); PG8_BAR;
            PG8_LDA(At, 1, 1); PG8_STAGE(PG8_SA(1, 0), a3, voffA);
            PG8_BAR; PG8_WAIT_L(0); PG8_MMA(1, 0, At, B0); PG8_BAR; PG8_SCHED;
            PG8_STAGE(PG8_SB(1, 1), b3 + hstep, voffB);
            PG8_WAIT_V(6); PG8_BAR; PG8_MMA(1, 1, At, B1); PG8_BAR;
        }
        PG8_STAMP();
        if constexpr (!Epi::AFTER_DRAIN) { E(acc, cur, wr, wc, fr, fq); S.done(cur); }
        PG8_STAMP();
        if (!has_next) break;
#pragma unroll
        for (int a = 0; a < 2; ++a)
#pragma unroll
            for (int b = 0; b < 2; ++b)
#pragma unroll
                for (int m = 0; m < 4; ++m)
#pragma unroll
                    for (int n = 0; n < 2; ++n) acc[a][b][m][n] = (f32x4){0.f, 0.f, 0.f, 0.f};
        cur = nxt; cA = nA; cB = nB; ++ui;
    }
    PG8_WAIT_V(0);
    if (wr == 0) PG8_BAR;
    PG8_BAR;
    if constexpr (Epi::AFTER_DRAIN) { E.fused(acc, cur, wr, wc, fr, fq, lds, wid, lane); S.done(cur); }
    PG8_STAMP();
    if (STAMP && wid == 0) { stamps[lane] = lane < nts ? (((unsigned long long)(unsigned)ts_hi << 32) | (unsigned)ts_lo) : 0ull;
        if (lane == 62) stamps[62] = rt_entry; if (lane == 63) stamps[63] = (unsigned long long)wall_clock64(); }
#undef PG8_STAMP
#undef PG8_SA
#undef PG8_SB
#undef PG8_STAGE
#undef PG8_LDA
#undef PG8_LDB
#undef PG8_MMA
#undef PG8_WAIT_V
#undef PG8_WAIT_L
#undef PG8_BAR
#undef PG8_SCHED
}
}
#define XB_TMO      128
#define XB_XCNT(j)  (256  + 64 * (j))
#define XB_XSUB(j)  (1280 + 64 * (j))
#define XB_XGEN(j)  (2304 + 64 * (j))
#define XB_TOP      3328
#define XB_TOPGEN   3392
#define XCD_BAR_WORDS 3456
#define XB_SPIN_CAP (1u << 18)
#define LAS __attribute__((address_space(3)))

__device__ __forceinline__ unsigned xb_ld(unsigned* p)              { return __hip_atomic_load(p, __ATOMIC_RELAXED, __HIP_MEMORY_SCOPE_AGENT); }
__device__ __forceinline__ unsigned xb_add(unsigned* p, unsigned v) { return __hip_atomic_fetch_add(p, v, __ATOMIC_RELAXED, __HIP_MEMORY_SCOPE_AGENT); }
__device__ __forceinline__ unsigned xb_xcc_id() { return (unsigned)__builtin_amdgcn_s_getreg((3 << 11) | 20) & 0xFu; }
#define XB_SPIN(cond, bar) do { unsigned _sp = 0; while (cond) { __builtin_amdgcn_s_sleep(1); \
    if ((++_sp & 255u) == 0u) { if (xb_ld(&(bar)[XB_TMO])) break; if (_sp > XB_SPIN_CAP) { atomicAdd(&(bar)[XB_TMO], 1u); break; } } } } while (0)

#define XB_LANE0() (__builtin_amdgcn_mbcnt_hi(~0u, __builtin_amdgcn_mbcnt_lo(~0u, 0u)) == 0u)
struct XcdBarrier {
    unsigned w0;
    unsigned* bar; unsigned x;
    volatile LAS unsigned* st;
};

__device__ __forceinline__ XcdBarrier xcd_barrier_post(unsigned* bar, volatile LAS unsigned* st, unsigned w0) {
    XcdBarrier b; b.w0 = w0; b.bar = bar; b.x = xb_xcc_id(); b.st = st;
    if (w0 == 0u && XB_LANE0()) (void)xb_add(&bar[XB_XCNT(b.x)], 1u);
    return b;
}
__device__ __forceinline__ void xcd_barrier_complete(unsigned* bar, unsigned x, unsigned& nloc, unsigned& nx) {
    const unsigned G = gridDim.x * gridDim.y * gridDim.z;
    unsigned sum, cnt, mine, sp = 0u;
    for (;;) {
        sum = 0u; cnt = 0u; mine = 0u;
#pragma unroll
        for (unsigned j = 0; j < 16; ++j) { const unsigned c = xb_ld(&bar[XB_XCNT(j)]); sum += c; cnt += (c > 0u) ? 1u : 0u; mine = (j == x) ? c : mine; }
        if (sum == G) break;
        __builtin_amdgcn_s_sleep(1);
        if ((++sp & 255u) == 0u) { if (xb_ld(&bar[XB_TMO])) break; if (sp > XB_SPIN_CAP) { atomicAdd(&bar[XB_TMO], 1u); break; } }
    }
    nloc = mine > 0u ? mine : 1u; nx = cnt > 0u ? cnt : 1u;
}

__device__ __forceinline__ void xcd_barrier(const XcdBarrier& b) {
    asm volatile("s_waitcnt vmcnt(0)" ::: "memory");
    __syncthreads();
    if (b.w0 == 0u && XB_LANE0()) {
        unsigned* bar = b.bar;
        __builtin_amdgcn_s_waitcnt(0);
        unsigned nloc = b.st[0], nx = b.st[1];
        if (nloc == 0u) { xcd_barrier_complete(bar, b.x, nloc, nx); b.st[0] = nloc; b.st[1] = nx; }
        const unsigned old = xb_add(&bar[XB_XSUB(b.x)], 1u);
        const unsigned gen = old / nloc;
        if (old + 1u == (gen + 1u) * nloc) {
            __builtin_amdgcn_fence(__ATOMIC_RELEASE, "agent");
            asm volatile("s_waitcnt vmcnt(0)" ::: "memory");
            const unsigned og = xb_add(&bar[XB_TOP], 1u);
            const unsigned tg = og / nx;
            if (og + 1u == (tg + 1u) * nx) xb_add(&bar[XB_TOPGEN], 1u);
            else XB_SPIN(xb_ld(&bar[XB_TOPGEN]) == tg, bar);
            __builtin_amdgcn_fence(__ATOMIC_ACQUIRE, "agent");
            xb_add(&bar[XB_XGEN(b.x)], 1u);
            asm volatile("s_waitcnt vmcnt(0)" ::: "memory");
        } else {
            XB_SPIN(xb_ld(&bar[XB_XGEN(b.x)]) == gen, bar);
            __builtin_amdgcn_fence(__ATOMIC_ACQUIRE, "agent");
            asm volatile("s_waitcnt vmcnt(0)" ::: "memory");
        }
    }
    __syncthreads();
}

namespace mk {
using pg8::bf16_t; using pg8::bf16x8; using pg8::f32x4; using pg8::u32x4;
typedef unsigned u32x2 __attribute__((ext_vector_type(2)));
typedef __bf16 bf16x2_t __attribute__((ext_vector_type(2)));
typedef LAS unsigned char* lds_t;

constexpr int DM = 1024, NLAT = 16384, NROW = 16896;
constexpr int OFF_B = 512, OFF_C = 1024, OFF_D = 2056, INC = 3208, NP = 3328;
constexpr int NCH = 132, NSLOT = 16 * NCH;
constexpr int NEXP = 16384;

constexpr size_t WS_CTL  = 0;
constexpr size_t WS_MOD  = 65536;
constexpr size_t WS_WIN  = WS_MOD + 147456;
constexpr size_t WS_WOUT = WS_WIN + 2ull * NP * DM * 2;
constexpr size_t WS_WQ   = WS_WOUT + 2ull * DM * DM * 2;
constexpr size_t WS_H    = WS_WQ + 2ull * 2048 * DM * 2;
constexpr size_t WS_ACT  = WS_H + (size_t)NROW * DM * 4;
constexpr size_t WS_UB   = WS_ACT + (size_t)NROW * DM * 2;
constexpr size_t WS_VB   = WS_UB + (size_t)NEXP * DM * 2;
constexpr size_t WS_SU   = WS_UB + (size_t)NEXP * DM;
constexpr size_t WS_SV   = WS_VB + (size_t)NEXP * DM;
constexpr size_t WS_P    = WS_VB + (size_t)NEXP * DM * 2;
constexpr size_t WS_Q    = WS_P;
constexpr size_t WS_SELI = WS_Q + (size_t)NROW * 2048 * 2;
constexpr size_t WS_SELG = WS_SELI + (size_t)NROW * 128 * 4;
constexpr size_t WS_MST  = WS_P + (size_t)NROW * NP * 2;
constexpr size_t WS_MCD  = WS_MST + (size_t)NSLOT * 8192 * 4;
constexpr size_t WS_RG   = WS_MCD + 16384;
constexpr size_t WS_RJ   = WS_RG + (size_t)NSLOT * 8192;
constexpr size_t WS_RY   = WS_RJ + (size_t)NSLOT * 16384;
constexpr size_t WS_RL   = WS_RY + (size_t)NSLOT * 8192;
constexpr size_t WS_RH   = WS_RL + (size_t)NSLOT * 8192;
constexpr size_t WS_BON  = WS_RH + (size_t)NSLOT * 8192;
constexpr size_t WS_END  = WS_BON + (size_t)NROW * 8 * 4;
static_assert(WS_SELG + (size_t)NROW * 128 * 4 <= WS_MST, "Q + selections must fit in P's region");

constexpr int LDS_BYTES = 157440;
constexpr int LDS_XB = 157184;

struct Args { const float* in[42]; float* out; unsigned char* ws; int ph_lo, ph_hi; };

struct Ctx {
    const float* const* in; float* out; unsigned char* ws; lds_t lds;
    int tid, lane, wid, bid, G;
};

__device__ __forceinline__ float bf2f(unsigned short x) { return __uint_as_float(((unsigned)x) << 16); }
__device__ __forceinline__ float bflo(unsigned w) { return __uint_as_float(w << 16); }
__device__ __forceinline__ float bfhi(unsigned w) { return __uint_as_float(w & 0xffff0000u); }
typedef __bf16 bf16pair_t __attribute__((ext_vector_type(2)));
__device__ __forceinline__ unsigned pk2(float lo, float hi) { const bf16pair_t v = {(__bf16)lo, (__bf16)hi}; return __builtin_bit_cast(unsigned, v); }
__device__ __forceinline__ unsigned short f2bf(float f) { return (unsigned short)(pk2(f, 0.f) & 0xffffu); }
#define dpp_f(old, src, ctrl, row_mask, bank_mask) __uint_as_float((unsigned)__builtin_amdgcn_update_dpp((int)__float_as_uint(old), (int)__float_as_uint(src), ctrl, row_mask, bank_mask, true))
__device__ __forceinline__ float wave_sum(float v) {
    v += dpp_f(0.f, v, 0xB1, 0xF, 0xF);
    v += dpp_f(0.f, v, 0x4E, 0xF, 0xF);
    v += dpp_f(0.f, v, 0x141, 0xF, 0xF);
    v += dpp_f(0.f, v, 0x140, 0xF, 0xF);
    v += dpp_f(0.f, v, 0x142, 0xA, 0xF);
    v += dpp_f(0.f, v, 0x143, 0xC, 0xF);
    return __uint_as_float((unsigned)__builtin_amdgcn_readlane((int)__float_as_uint(v), 63));
}
__device__ __forceinline__ float wave_incl_scan(float v, int lane) {
    (void)lane;
    float s = v + dpp_f(0.f, v, 0x111, 0xF, 0xF);
    s += dpp_f(0.f, v, 0x112, 0xF, 0xF);
    s += dpp_f(0.f, v, 0x113, 0xF, 0xF);
    s += dpp_f(0.f, s, 0x114, 0xF, 0xE);
    s += dpp_f(0.f, s, 0x118, 0xF, 0xC);
    s += dpp_f(0.f, s, 0x142, 0xA, 0xF);
    s += dpp_f(0.f, s, 0x143, 0xC, 0xF);
    return s;
}
__device__ __forceinline__ float fexp(float x) { return __expf(x); }
__device__ __forceinline__ float frcp(float x) { return __builtin_amdgcn_rcpf(x); }
__device__ __forceinline__ float sigm(float x) { return frcp(1.f + __expf(-x)); }
__device__ __forceinline__ float silu(float x) { return x * frcp(1.f + __expf(-x)); }
__device__ __forceinline__ float softplus(float x) { return fmaxf(x, 0.f) + __logf(1.f + __expf(-fabsf(x))); }
__device__ __forceinline__ float ftanh(float x) { const float e = __expf(-2.f * fabsf(x)); const float t = (1.f - e) * frcp(1.f + e); return x < 0.f ? -t : t; }
__device__ __forceinline__ float gelu_tanh(float x) { const float u = 0.7978845608028654f * (x + 0.044715f * x * x * x); return 0.5f * x * (1.f + ftanh(u)); }
__device__ __forceinline__ float dot2bf(unsigned a, unsigned b, float acc) { return __builtin_amdgcn_fdot2_f32_bf16(__builtin_bit_cast(bf16x2_t, a), __builtin_bit_cast(bf16x2_t, b), acc, false); }

struct ChunkInfo { int row0, lo, hi, b, tc, isctx; };
__device__ __forceinline__ ChunkInfo chunk_info(int gc) {
    ChunkInfo c; c.row0 = gc * 64;
    if (gc < 256) { c.b = gc >> 7; c.tc = gc & 127; c.isctx = 0; c.lo = c.b * 8192; c.hi = c.lo + 8192; }
    else { const int q = gc - 256; c.b = q >> 2; c.tc = q & 3; c.isctx = 1; c.lo = NLAT + c.b * 256; c.hi = c.lo + 256; }
    return c;
}
__device__ __forceinline__ int cpos_of(const ChunkInfo& c, int d) { return c.isctx ? (d ? 3 - c.tc : c.tc) : (d ? 4 + 127 - c.tc : 4 + c.tc); }
__device__ __forceinline__ int slot_of(int b, int h, int d, int cpos) { return ((b * 4 + h) * 2 + d) * NCH + cpos; }

template <int MT, int NT, int KS, class Epi>
__device__ __forceinline__ void blk_mma(const LAS bf16_t* A, int lda, const LAS bf16_t* Bt, int ldb, int wid, int lane, Epi epi) {
    const int fr = lane & 15, fq = lane >> 4;
    for (int tt = wid; tt < MT * NT; tt += 8) {
        const int tm = tt / NT, tn = tt % NT;
        f32x4 acc = {0.f, 0.f, 0.f, 0.f};
#pragma unroll
        for (int ks = 0; ks < KS; ++ks) {
            const bf16x8 a = *(const LAS bf16x8*)(A + (tm * 16 + fr) * lda + ks * 32 + fq * 8);
            const bf16x8 b = *(const LAS bf16x8*)(Bt + (tn * 16 + fr) * ldb + ks * 32 + fq * 8);
            acc = __builtin_amdgcn_mfma_f32_16x16x32_bf16(a, b, acc, 0, 0, 0);
        }
        epi(tm * 16 + fq * 4, tn * 16 + fr, acc);
    }
}
template <int MT, int NT, int KS, class Epi>
__device__ __forceinline__ void blk_mma2(const LAS bf16_t* A1, const LAS bf16_t* B1, const LAS bf16_t* A2, const LAS bf16_t* B2, int ld, int wid, int lane, Epi epi) {
    const int fr = lane & 15, fq = lane >> 4;
    for (int tt = wid; tt < MT * NT; tt += 8) {
        const int tm = tt / NT, tn = tt % NT;
        f32x4 acc1 = {0.f, 0.f, 0.f, 0.f}, acc2 = {0.f, 0.f, 0.f, 0.f};
#pragma unroll
        for (int ks = 0; ks < KS; ++ks) {
            const bf16x8 a1 = *(const LAS bf16x8*)(A1 + (tm * 16 + fr) * ld + ks * 32 + fq * 8);
            const bf16x8 b1 = *(const LAS bf16x8*)(B1 + (tn * 16 + fr) * ld + ks * 32 + fq * 8);
            acc1 = __builtin_amdgcn_mfma_f32_16x16x32_bf16(a1, b1, acc1, 0, 0, 0);
            const bf16x8 a2 = *(const LAS bf16x8*)(A2 + (tm * 16 + fr) * ld + ks * 32 + fq * 8);
            const bf16x8 b2 = *(const LAS bf16x8*)(B2 + (tn * 16 + fr) * ld + ks * 32 + fq * 8);
            acc2 = __builtin_amdgcn_mfma_f32_16x16x32_bf16(a2, b2, acc2, 0, 0, 0);
        }
        epi(tm * 16 + fq * 4, tn * 16 + fr, acc1, acc2);
    }
}


template <int MT, int NT, class Epi>
__device__ __forceinline__ void small_gemm_tile(const Ctx& C, const bf16_t* A, const bf16_t* Bt, int K, Epi epi) {
    constexpr int AR = MT * 16, BR = NT * 16, PITCH = 264, NA = AR * 32 / 512, NB = BR * 32 / 512;
    LAS bf16_t* As = (LAS bf16_t*)C.lds; LAS bf16_t* Bs = As + AR * PITCH;
    u32x4 ra[NA], rb[NB];
    auto fetch = [&](int k0) {
#pragma unroll
        for (int i = 0; i < NA; ++i) { const int e = C.tid + 512 * i; ra[i] = *(const u32x4*)(A + (size_t)(e >> 5) * K + k0 + (e & 31) * 8); }
#pragma unroll
        for (int i = 0; i < NB; ++i) { const int e = C.tid + 512 * i; rb[i] = *(const u32x4*)(Bt + (size_t)(e >> 5) * K + k0 + (e & 31) * 8); } };
    const int fr = C.lane & 15, fq = C.lane >> 4;
    constexpr int TPW = (MT * NT + 7) / 8;
    f32x4 acc[TPW];
#pragma unroll
    for (int i = 0; i < TPW; ++i) acc[i] = (f32x4){0.f, 0.f, 0.f, 0.f};
    fetch(0);
    for (int k0 = 0; k0 < K; k0 += 256) {
        __syncthreads();
#pragma unroll
        for (int i = 0; i < NA; ++i) { const int e = C.tid + 512 * i; *(LAS u32x4*)(As + (e >> 5) * PITCH + (e & 31) * 8) = ra[i]; }
#pragma unroll
        for (int i = 0; i < NB; ++i) { const int e = C.tid + 512 * i; *(LAS u32x4*)(Bs + (e >> 5) * PITCH + (e & 31) * 8) = rb[i]; }
        if (k0 + 256 < K) fetch(k0 + 256);
        __syncthreads();
#pragma unroll
        for (int i = 0; i < TPW; ++i) { const int tt = C.wid + 8 * i; if (tt < MT * NT) { const int tm = tt / NT, tn = tt % NT;
#pragma unroll
            for (int ks = 0; ks < 8; ++ks) acc[i] = __builtin_amdgcn_mfma_f32_16x16x32_bf16(*(const LAS bf16x8*)(As + (tm * 16 + fr) * PITCH + ks * 32 + fq * 8),
                                                                                           *(const LAS bf16x8*)(Bs + (tn * 16 + fr) * PITCH + ks * 32 + fq * 8), acc[i], 0, 0, 0); } }
    }
#pragma unroll
    for (int i = 0; i < TPW; ++i) { const int tt = C.wid + 8 * i; if (tt < MT * NT) epi((tt / NT) * 16 + fq * 4, (tt % NT) * 16 + fr, acc[i]); }
    __syncthreads();
}

__device__ __forceinline__ void transpose_item(const float* W, int K, int N, int nblk, bf16_t* WT, LAS float* scr, int item, int lane) {
    const int kb = item / nblk, nb = item % nblk, k0 = 64 * kb, n0 = 32 * nb;
    const int nn = n0 + (lane & 31);
#pragma unroll 8
    for (int i = 0; i < 32; ++i) { const int kk = 2 * i + (lane >> 5); scr[kk * 33 + (lane & 31)] = (nn < N) ? W[(size_t)(k0 + kk) * N + nn] : 0.f; }
    asm volatile("s_waitcnt lgkmcnt(0)" ::: "memory");
    const int c = lane & 7;
#pragma unroll
    for (int j = 0; j < 4; ++j) { const int n = (lane >> 3) + 8 * j; const LAS float* s = scr + (8 * c) * 33 + n;
        u32x4 o; o.x = pk2(s[0 * 33], s[1 * 33]); o.y = pk2(s[2 * 33], s[3 * 33]); o.z = pk2(s[4 * 33], s[5 * 33]); o.w = pk2(s[6 * 33], s[7 * 33]);
        *(u32x4*)(WT + (size_t)(n0 + n) * K + k0 + 8 * c) = o; }
    asm volatile("s_waitcnt lgkmcnt(0)" ::: "memory");
}
__device__ __forceinline__ float wave_maxf(float v) {
#pragma unroll
    for (int o = 1; o < 64; o <<= 1) v = fmaxf(v, __shfl_xor(v, o));
    return v;
}
__device__ __forceinline__ void convert_tables(const Ctx& C, int layer, int rank, int nrank) {
    const float* U = C.in[39] + (size_t)layer * NEXP * DM; const float* V = C.in[40] + (size_t)layer * NEXP * DM;
    unsigned char* UB = C.ws + WS_UB; unsigned char* VB = C.ws + WS_VB; float* SU = (float*)(C.ws + WS_SU); float* SV = (float*)(C.ws + WS_SV);
    for (int r4 = (rank * 8 + C.wid) * 2; r4 < 2 * NEXP; r4 += nrank * 8 * 2) {
        const bool isv = r4 >= NEXP; const int row0 = isv ? r4 - NEXP : r4;
        const float* src = (isv ? V : U) + (size_t)row0 * DM + 16 * C.lane;
        f32x4 x[2][4];
#pragma unroll
        for (int q = 0; q < 2; ++q)
#pragma unroll
            for (int k = 0; k < 4; ++k) x[q][k] = *(const f32x4*)(src + (size_t)q * DM + 4 * k);
#pragma unroll
        for (int q = 0; q < 2; ++q) {
            float m = 0.f;
#pragma unroll
            for (int k = 0; k < 4; ++k) m = fmaxf(fmaxf(m, fmaxf(fabsf(x[q][k].x), fabsf(x[q][k].y))), fmaxf(fabsf(x[q][k].z), fabsf(x[q][k].w)));
            m = wave_maxf(m);
            const float sc = m > 0.f ? 224.f / m : 1.f;
            u32x4 o;
#pragma unroll
            for (int k = 0; k < 4; ++k) { int w = __builtin_amdgcn_cvt_pk_fp8_f32(x[q][k].x * sc, x[q][k].y * sc, 0, false); w = __builtin_amdgcn_cvt_pk_fp8_f32(x[q][k].z * sc, x[q][k].w * sc, w, true); o[k] = (unsigned)w; }
            *(u32x4*)((isv ? VB : UB) + (size_t)(row0 + q) * DM + 16 * C.lane) = o;
            if (C.lane == 0) (isv ? SV : SU)[row0 + q] = m > 0.f ? m * (1.f / 224.f) : 1.f;
        }
    }
}
__device__ __forceinline__ void ph_prologue(const Ctx& C) {
    const int gw = C.bid * 8 + C.wid, NGW = C.G * 8;
    {
        LAS float* scr = (LAS float*)(C.lds + C.wid * 16384);
        bf16_t* WIN = (bf16_t*)(C.ws + WS_WIN); bf16_t* WOUT = (bf16_t*)(C.ws + WS_WOUT); bf16_t* WQ = (bf16_t*)(C.ws + WS_WQ);
        for (int it = gw; it < 6400; it += NGW) {
            const int layer = it / 3200; int r = it % 3200;
            if (r < 1664) { transpose_item(C.in[8] + (size_t)layer * DM * INC, DM, INC, 104, WIN + (size_t)layer * NP * DM, scr, r, C.lane); continue; } r -= 1664;
            if (r < 512) { transpose_item(C.in[9] + (size_t)layer * DM * DM, DM, DM, 32, WOUT + (size_t)layer * DM * DM, scr, r, C.lane); continue; } r -= 512;
            transpose_item(C.in[36] + (size_t)layer * DM * 2048, DM, 2048, 64, WQ + (size_t)layer * 2048 * DM, scr, r, C.lane);
        }
    }
    __syncthreads();
    {
        LAS float* sv = (LAS float*)C.lds;
        LAS float* red = (LAS float*)(C.lds + 12288);
        for (int i = C.tid; i < 3 * 1024; i += 512) { const int w = i >> 10, k = i & 1023; const float x = (w < 2) ? C.in[1][w * 1024 + k] : C.in[3][k]; sv[i] = silu(x); }
        __syncthreads();
        float* MOD = (float*)(C.ws + WS_MOD);
        for (int it = C.bid; it < 192; it += C.G) {
            const int layer = it / 96, col0 = (it % 96) * 64, col = C.tid & 63, kg = C.tid >> 6;
            const float* W = C.in[4] + (size_t)layer * DM * 6144 + col0 + col;
            float a0 = 0.f, a1 = 0.f, a2 = 0.f;
#pragma unroll 32
            for (int k = kg * 128; k < kg * 128 + 128; ++k) { const float w = W[(size_t)k * 6144]; a0 += sv[k] * w; a1 += sv[1024 + k] * w; a2 += sv[2048 + k] * w; }
            red[(kg * 3 + 0) * 64 + col] = a0; red[(kg * 3 + 1) * 64 + col] = a1; red[(kg * 3 + 2) * 64 + col] = a2;
            __syncthreads();
            if (C.tid < 192) { const int w = C.tid >> 6, c2 = C.tid & 63; float s = 0.f;
#pragma unroll
                for (int g = 0; g < 8; ++g) s += red[(g * 3 + w) * 64 + c2];
                MOD[((size_t)layer * 3 + w) * 6144 + col0 + c2] = s + C.in[5][layer * 6144 + col0 + c2]; }
            __syncthreads();
        }
    }
    {
        float* H = (float*)(C.ws + WS_H);
        const size_t n4 = (size_t)NROW * 256;
        for (size_t i = (size_t)C.bid * 512 + C.tid; i < n4; i += (size_t)C.G * 512) {
            const int row = (int)(i >> 8), c4 = (int)(i & 255) * 4;
            f32x4 v;
            if (row < NLAT) {
                v = *(const f32x4*)(C.in[0] + (size_t)row * DM + c4);
                const int t = row & 8191, quarter = c4 >> 8; const float pos = (quarter < 2) ? (float)(t >> 6) : (float)(t & 63);
                float e[4];
#pragma unroll
                for (int j = 0; j < 4; ++j) { const int jj = (c4 & 255) + j; const float fr = exp2f(-(float)jj * (13.287712379549449f / 256.f)); const float a = pos * fr; e[j] = (quarter & 1) ? cosf(a) : sinf(a); }
                v.x += e[0]; v.y += e[1]; v.z += e[2]; v.w += e[3];
            } else v = *(const f32x4*)(C.in[2] + (size_t)(row - NLAT) * DM + c4);
            *(f32x4*)(H + (size_t)row * DM + c4) = v;
        }
    }
}

struct Row16 { float v[16]; };
__device__ __forceinline__ Row16 load_row16(const float* p, int lane) {
    Row16 r; const f32x4 a = *(const f32x4*)(p + 8 * lane), b = *(const f32x4*)(p + 8 * lane + 4), c = *(const f32x4*)(p + 512 + 8 * lane), d = *(const f32x4*)(p + 512 + 8 * lane + 4);
    r.v[0] = a.x; r.v[1] = a.y; r.v[2] = a.z; r.v[3] = a.w; r.v[4] = b.x; r.v[5] = b.y; r.v[6] = b.z; r.v[7] = b.w;
    r.v[8] = c.x; r.v[9] = c.y; r.v[10] = c.z; r.v[11] = c.w; r.v[12] = d.x; r.v[13] = d.y; r.v[14] = d.z; r.v[15] = d.w; return r;
}
__device__ __forceinline__ void store_row16_f32(float* p, int lane, const Row16& r) {
    *(f32x4*)(p + 8 * lane) = (f32x4){r.v[0], r.v[1], r.v[2], r.v[3]}; *(f32x4*)(p + 8 * lane + 4) = (f32x4){r.v[4], r.v[5], r.v[6], r.v[7]};
    *(f32x4*)(p + 512 + 8 * lane) = (f32x4){r.v[8], r.v[9], r.v[10], r.v[11]}; *(f32x4*)(p + 512 + 8 * lane + 4) = (f32x4){r.v[12], r.v[13], r.v[14], r.v[15]};
}
__device__ __forceinline__ void store_row16_bf16(bf16_t* p, int lane, const Row16& r) {
    u32x4 a, b; a.x = pk2(r.v[0], r.v[1]); a.y = pk2(r.v[2], r.v[3]); a.z = pk2(r.v[4], r.v[5]); a.w = pk2(r.v[6], r.v[7]);
    b.x = pk2(r.v[8], r.v[9]); b.y = pk2(r.v[10], r.v[11]); b.z = pk2(r.v[12], r.v[13]); b.w = pk2(r.v[14], r.v[15]);
    *(u32x4*)(p + 8 * lane) = a; *(u32x4*)(p + 512 + 8 * lane) = b;
}
__device__ __forceinline__ Row16 norm_mod_row(const Row16& x, const float* g, const float* shift, const float* scale, int lane) {
    float ss = 0.f;
#pragma unroll
    for (int i = 0; i < 16; ++i) ss += x.v[i] * x.v[i];
    const float rs = rsqrtf(wave_sum(ss) * (1.f / 1024.f) + 1e-6f);
    const Row16 gg = load_row16(g, lane), sh = load_row16(shift, lane), sc = load_row16(scale, lane);
    Row16 o;
#pragma unroll
    for (int i = 0; i < 16; ++i) o.v[i] = (x.v[i] * rs * gg.v[i]) * (1.f + sc.v[i]) + sh.v[i];
    return o;
}
__device__ __forceinline__ int which_of(int row) { return row < 8192 ? 0 : (row < NLAT ? 1 : 2); }
__device__ __forceinline__ void ph_norm(const Ctx& C, int layer, const float* gain, int sidx, int nrows) {
    const float* H = (const float*)(C.ws + WS_H); bf16_t* ACT = (bf16_t*)(C.ws + WS_ACT); const float* MOD = (const float*)(C.ws + WS_MOD);
    for (int row = C.bid * 8 + C.wid; row < nrows; row += C.G * 8) {
        const float* m = MOD + ((size_t)layer * 3 + which_of(row)) * 6144;
        const Row16 x = load_row16(H + (size_t)row * DM, C.lane);
        const Row16 o = norm_mod_row(x, gain, m + sidx * 1024, m + (sidx + 1) * 1024, C.lane);
        store_row16_bf16(ACT + (size_t)row * DM, C.lane, o);
    }
}
struct EpiResid {
    static constexpr bool PERM = false, AFTER_DRAIN = false;
    float* H; const float* modl;
    __device__ __forceinline__ void operator()(const f32x4 (&acc)[2][2][4][2], const pg8::Unit& u, int wr, int wc, int fr, int fq) const {
        const int row0 = u.pm * 256 + wr * 64 + fr, col0 = u.pn * 256 + wc * 32 + 4 * fq;
        const int which = u.pm < 32 ? 0 : (u.pm < 64 ? 1 : 2);
        const float* gate = modl + ((size_t)which * 6 + 2) * 1024;
        f32x4 gv[2][2];
#pragma unroll
        for (int bj = 0; bj < 2; ++bj)
#pragma unroll
            for (int n = 0; n < 2; ++n) gv[bj][n] = *(const f32x4*)(gate + col0 + bj * 128 + n * 16);
#pragma unroll
        for (int ai = 0; ai < 2; ++ai)
#pragma unroll
            for (int m = 0; m < 4; ++m) { float* rowp = H + (size_t)(row0 + ai * 128 + m * 16) * DM + col0;
#pragma unroll
                for (int bj = 0; bj < 2; ++bj)
#pragma unroll
                    for (int n = 0; n < 2; ++n) { f32x4* p = (f32x4*)(rowp + bj * 128 + n * 16); *p = *p + gv[bj][n] * acc[ai][bj][m][n]; } }
    }
};

__device__ __forceinline__ void item_conformer(const Ctx& C, int layer, int gc) {
    const ChunkInfo ci = chunk_info(gc);
    const bf16_t* P = (const bf16_t*)(C.ws + WS_P); bf16_t* YC = (bf16_t*)(C.ws + WS_ACT);
    LAS bf16_t* HG = (LAS bf16_t*)C.lds;
    LAS float* CO = (LAS float*)(C.lds + 49152);
    for (int e = C.tid; e < 94 * 128; e += 512) {
        const int rr = e >> 7, cp = e & 127, grow = ci.row0 - 15 + rr;
        const bool ok = grow >= ci.lo && grow < ci.hi; const int gr = ok ? grow : ci.row0;
        const unsigned v = *(const unsigned*)(P + (size_t)gr * NP + 2 * cp), g = *(const unsigned*)(P + (size_t)gr * NP + 256 + 2 * cp);
        const unsigned o = pk2(bflo(v) * sigm(bflo(g)), bfhi(v) * sigm(bfhi(g)));
        *(LAS unsigned*)(HG + rr * 256 + 2 * cp) = ok ? o : 0u;
    }
    __syncthreads();
    {
        const int c = C.tid & 255, half = C.tid >> 8;
        const float* cw = C.in[10] + (size_t)layer * 31 * 256 + c;
        float w[31];
#pragma unroll
        for (int j = 0; j < 31; ++j) w[j] = cw[j * 256];
        const float bias = C.in[11][layer * 256 + c];
        float hv[62];
#pragma unroll
        for (int i = 0; i < 62; ++i) hv[i] = bf2f(HG[(half * 32 + i) * 256 + c]);
#pragma unroll
        for (int tt = 0; tt < 32; ++tt) { float acc = bias;
#pragma unroll
            for (int j = 0; j < 31; ++j) acc += w[j] * hv[tt + j];
            CO[(half * 32 + tt) * 256 + c] = acc; }
    }
    __syncthreads();
    {
        const float* lg = C.in[12] + layer * 256 + 4 * C.lane; const float* lb = C.in[13] + layer * 256 + 4 * C.lane;
        const f32x4 g4 = *(const f32x4*)lg, b4 = *(const f32x4*)lb;
        for (int i = 0; i < 8; ++i) {
            const int t = C.wid * 8 + i;
            const f32x4 x = *(const LAS f32x4*)(CO + t * 256 + 4 * C.lane);
            const float mean = wave_sum((x.x + x.y) + (x.z + x.w)) * (1.f / 256.f);
            const f32x4 d = x - mean;
            const float var = wave_sum((d.x * d.x + d.y * d.y) + (d.z * d.z + d.w * d.w)) * (1.f / 256.f);
            const float rs = rsqrtf(var + 1e-5f);
            const f32x4 y = d * rs * g4 + b4;
            u32x2 o; o.x = pk2(silu(y.x), silu(y.y)); o.y = pk2(silu(y.z), silu(y.w));
            *(u32x2*)(YC + (size_t)(ci.row0 + t) * DM + 4 * C.lane) = o;
        }
    }
    __syncthreads();
}

__device__ __forceinline__ void item_chunkmlp(const Ctx& C, int layer, int gb) {
    const int row0 = gb * 128;
    const bf16_t* P = (const bf16_t*)(C.ws + WS_P); bf16_t* YC = (bf16_t*)(C.ws + WS_ACT);
    LAS bf16_t* VNT = (LAS bf16_t*)C.lds;
    LAS bf16_t* WS = (LAS bf16_t*)(C.lds + 69632);
    {
        const f32x4 g4 = *(const f32x4*)(C.in[14] + layer * 256 + 4 * C.lane), b4 = *(const f32x4*)(C.in[15] + layer * 256 + 4 * C.lane);
        for (int i = 0; i < 16; ++i) {
            const int j = C.wid * 16 + i;
            const u32x2 raw = *(const u32x2*)(P + (size_t)(row0 + j) * NP + 768 + 4 * C.lane);
            const f32x4 x = {bflo(raw.x), bfhi(raw.x), bflo(raw.y), bfhi(raw.y)};
            const float mean = wave_sum((x.x + x.y) + (x.z + x.w)) * (1.f / 256.f);
            const f32x4 d = x - mean;
            const float var = wave_sum((d.x * d.x + d.y * d.y) + (d.z * d.z + d.w * d.w)) * (1.f / 256.f);
            const f32x4 y = d * rsqrtf(var + 1e-5f) * g4 + b4;
            VNT[(4 * C.lane + 0) * 136 + j] = f2bf(y.x); VNT[(4 * C.lane + 1) * 136 + j] = f2bf(y.y);
            VNT[(4 * C.lane + 2) * 136 + j] = f2bf(y.z); VNT[(4 * C.lane + 3) * 136 + j] = f2bf(y.w);
        }
    }
    for (int h = 0; h < 4; ++h) {
        const float* ws = C.in[16] + ((size_t)layer * 4 + h) * 128 * 128;
        for (int e = C.tid; e < 4096; e += 512) { const int i = e >> 5, j4 = (e & 31) * 4; const f32x4 w = *(const f32x4*)(ws + i * 128 + j4);
            u32x2 o; o.x = pk2(w.x, w.y); o.y = pk2(w.z, w.w); *(LAS u32x2*)(WS + i * 136 + j4) = o; }
        __syncthreads();
        const float* bs = C.in[17] + ((size_t)layer * 4 + h) * 128;
        {
            const int fr = C.lane & 15, fq = C.lane >> 4;
            unsigned short ur[4][4];
#pragma unroll
            for (int i = 0; i < 4; ++i) { const int tt = C.wid + 8 * i, tm = tt >> 2, tn = tt & 3;
#pragma unroll
                for (int jj = 0; jj < 4; ++jj) ur[i][jj] = P[(size_t)(row0 + tm * 16 + fq * 4 + jj) * NP + 512 + h * 64 + tn * 16 + fr]; }
#pragma unroll
            for (int i = 0; i < 4; ++i) { const int tt = C.wid + 8 * i, tm = tt >> 2, tn = tt & 3;
                f32x4 acc = {0.f, 0.f, 0.f, 0.f};
#pragma unroll
                for (int ks = 0; ks < 4; ++ks) acc = __builtin_amdgcn_mfma_f32_16x16x32_bf16(*(const LAS bf16x8*)(WS + (tm * 16 + fr) * 136 + ks * 32 + fq * 8),
                                                                                             *(const LAS bf16x8*)(VNT + (h * 64 + tn * 16 + fr) * 136 + ks * 32 + fq * 8), acc, 0, 0, 0);
#pragma unroll
                for (int jj = 0; jj < 4; ++jj) { const int ii = tm * 16 + fq * 4 + jj;
                    YC[(size_t)(row0 + ii) * DM + 256 + h * 64 + tn * 16 + fr] = f2bf((acc[jj] + bs[ii]) * bf2f(ur[i][jj])); }
            }
        }
        __syncthreads();
    }
}

__device__ __forceinline__ void item_mamba_local(const Ctx& C, int layer, int gc) {
    const ChunkInfo ci = chunk_info(gc);
    const bf16_t* P = (const bf16_t*)(C.ws + WS_P);
    bf16_t* MSTb = (bf16_t*)(C.ws + WS_MST); float* MCD = (float*)(C.ws + WS_MCD);
    LAS float* DA = (LAS float*)C.lds;
    LAS float* DT = (LAS float*)(C.lds + 2048);
    LAS float* FAC = (LAS float*)(C.lds + 4096);
    LAS bf16_t* XDT = (LAS bf16_t*)(C.lds + 8192);
    LAS bf16_t* BTT = (LAS bf16_t*)(C.lds + 8192 + 73728);
    {
        const int s = C.lane, dh = C.wid, d = dh >> 2, h = dh & 3;
        const float raw = bf2f(P[(size_t)(ci.row0 + s) * NP + OFF_C + 1024 + dh]);
        const float dt = softplus(raw + C.in[20][layer * 8 + dh]);
        const float da = dt * (-expf(C.in[21][layer * 8 + dh]));
        const float incl = wave_incl_scan(da, s), total = __shfl(incl, 63);
        DT[dh * 64 + s] = dt; DA[dh * 64 + s] = da;
        FAC[dh * 64 + s] = d ? fexp(incl - da) : fexp(total - incl);
        if (s == 0) MCD[slot_of(ci.b, h, d, cpos_of(ci, d))] = expf(total);
    }
    __syncthreads();
    {
        const int cp = C.tid & 255, half = C.tid >> 8, c0 = 2 * cp;
        const float* cw = C.in[18] + (size_t)layer * 5 * 768 + c0; const float* cb = C.in[19] + layer * 768 + c0;
        float w0[5], w1[5];
#pragma unroll
        for (int j = 0; j < 5; ++j) { w0[j] = cw[j * 768]; w1[j] = cw[j * 768 + 1]; }
        const float b0 = cb[0], b1 = cb[1];
        const int s0 = half * 32;
        unsigned wr[36];
#pragma unroll
        for (int j = 0; j < 36; ++j) { const int row = ci.row0 + s0 - 2 + j; const bool ok = row >= ci.lo && row < ci.hi; const unsigned v = *(const unsigned*)(P + (size_t)(ok ? row : ci.row0) * NP + OFF_C + 256 + c0); wr[j] = ok ? v : 0u; }
#pragma unroll
        for (int tt = 0; tt < 32; ++tt) {
            const int s = s0 + tt;
            const unsigned* win = wr + tt;
            float a0 = b0, a1 = b1;
#pragma unroll
            for (int j = 0; j < 5; ++j) { a0 += w0[j] * bflo(win[j]); a1 += w1[j] * bfhi(win[j]); }
            a0 = silu(a0); a1 = silu(a1);
            if (c0 < 256) { const int h = c0 >> 6;
#pragma unroll
                for (int d = 0; d < 2; ++d) { const float f = DT[(d * 4 + h) * 64 + s] * FAC[(d * 4 + h) * 64 + s];
                    XDT[(d * 256 + c0) * 72 + s] = f2bf(a0 * f); XDT[(d * 256 + c0 + 1) * 72 + s] = f2bf(a1 * f); }
            } else { const int q = c0 - 256; BTT[q * 72 + s] = f2bf(a0); BTT[(q + 1) * 72 + s] = f2bf(a1); }
        }
    }
    __syncthreads();
    for (int hd = 0; hd < 8; ++hd) {
        const int d = hd >> 2, h = hd & 3;
        bf16_t* dst = MSTb + (size_t)slot_of(ci.b, h, d, cpos_of(ci, d)) * 8192;
        blk_mma<8, 4, 2>(BTT + (h >> 1) * 128 * 72, 72, XDT + (d * 256 + h * 64) * 72, 72, C.wid, C.lane, [=](int r0, int col, const f32x4& acc) {
            u32x2 o; o.x = pk2(acc[0], acc[1]); o.y = pk2(acc[2], acc[3]); *(u32x2*)(dst + col * 128 + r0) = o;
        });
    }
    __syncthreads();
}


#ifndef MK_DIAG2
#define MK_DIAG2 0
#endif
#if MK_DIAG2
#define DBGF(stage, cond) do { if (cond) atomicOr((unsigned*)(C.ws + 32768) + (stage), 1u); } while (0)
#define DBGL(stage, cond) do { if (cond) atomicOr(dbgflags + (stage), 1u); } while (0)
#else
#define DBGF(stage, cond) do {} while (0)
#define DBGL(stage, cond) do {} while (0)
#endif
__device__ __forceinline__ bool badv(float x, float lim) { return !(fabsf(x) < lim); }
__device__ __forceinline__ void tri_inverse(const LAS float* ABf, LAS float* Tf, LAS float* Rt, LAS bf16_t* TT, int tid, int wid, int lane) {
    if (wid == 0) {
        const int bi = lane >> 4, j = lane & 15; const LAS float* Ab = ABf + (16 * bi) * 68 + 16 * bi;
        float col[16];
#pragma unroll
        for (int r = 0; r < 16; ++r) { float acc = (r == j) ? 1.f : 0.f;
#pragma unroll
            for (int s = 0; s < r; ++s) acc -= Ab[r * 68 + s] * col[s];
            col[r] = acc; }
#pragma unroll
        for (int r = 0; r < 16; ++r) Tf[(16 * bi + r) * 68 + 16 * bi + j] = col[r];
    } else {
        for (int e = tid - 64; e < 64 * 64; e += 448) { const int t = e >> 6, s2 = e & 63; if ((s2 >> 4) > (t >> 4)) Tf[t * 68 + s2] = 0.f; }
    }
    __syncthreads();
    if (wid < 3) {
        const int tn = wid, fr = lane & 15, fq = lane >> 4;
        LAS float* Rw = Rt + wid * 320;
        for (int i = tn + 1; i < 4; ++i) {
            f32x4 acc = {0.f, 0.f, 0.f, 0.f};
            for (int k = 16 * tn; k < 16 * i; k += 4) acc = __builtin_amdgcn_mfma_f32_16x16x4f32(ABf[(16 * i + fr) * 68 + k + fq], Tf[(k + fq) * 68 + 16 * tn + fr], acc, 0, 0, 0);
#pragma unroll
            for (int j = 0; j < 4; ++j) Rw[(fq * 4 + j) * 20 + fr] = -acc[j];
            asm volatile("s_waitcnt lgkmcnt(0)" ::: "memory");
            f32x4 t = {0.f, 0.f, 0.f, 0.f};
#pragma unroll
            for (int k = 0; k < 16; k += 4) t = __builtin_amdgcn_mfma_f32_16x16x4f32(Tf[(16 * i + fr) * 68 + 16 * i + k + fq], Rw[(k + fq) * 20 + fr], t, 0, 0, 0);
#pragma unroll
            for (int j = 0; j < 4; ++j) Tf[(16 * i + fq * 4 + j) * 68 + 16 * tn + fr] = t[j];
            asm volatile("s_waitcnt lgkmcnt(0)" ::: "memory");
        }
    }
    __syncthreads();
    for (int e = tid; e < 4096; e += 512) { const int t = e >> 6, s2 = e & 63; TT[t * 72 + s2] = f2bf(Tf[t * 68 + s2]); }
}
struct D1Pre { unsigned w[24]; unsigned lw[8]; int hd; };
__device__ __forceinline__ void d1_load_rows(const Ctx& C, int it, unsigned (&w)[24]) {
    const int gc = it >> 3, hd = it & 7, h = hd & 3, d = hd >> 2;
    const ChunkInfo ci = chunk_info(gc);
    const bf16_t* P = (const bf16_t*)(C.ws + WS_P);
    if (C.tid < 480) {
        const int q = C.tid % 160, seg = C.tid / 160, grp = q >> 5, c = (q & 31) * 2;
        const int j = (grp == 0 ? h * 64 : grp == 1 ? 256 + h * 64 : grp == 2 ? 512 + h * 64 : grp == 3 ? 768 + d * 64 : 896 + d * 64) + c;
        const int t0 = seg * 22, nt = seg == 2 ? 20 : 22;
        const bf16_t* pp = P + (size_t)(ci.row0 + t0) * NP + OFF_D + j;
#pragma unroll
        for (int i = 0; i < 24; ++i) { const int row = ci.row0 + t0 - 1 + i; const bool ok = row >= ci.lo && row < ci.hi; const int rc = ok ? row : ci.row0;
            const unsigned v = (i < nt + 2) ? *(const unsigned*)(pp + (ptrdiff_t)(rc - (ci.row0 + t0)) * NP) : 0u; w[i] = ok ? v : 0u; }
    }
}
constexpr int D1_LW = 0, D1_CS = 17408, D1_AA = 34816, D1_RB = 52224, D1_KB = 61440, D1_VB = 70656, D1_TW = 79872, D1_AD = 89088, D1_W2T = 98304, D1_A2T = 107520;
constexpr int D1_Y = 82944;
constexpr int D1_ABF = 0, D1_AK = 17408, D1_ARK = 26624, D1_ARB = 35840, D1_TT = 45056, D1_W1T = 54272, D1_AKVT = 63488, D1_W2TT = 72704;
constexpr int D1_GL = 156672;
__device__ __forceinline__ void item_rwkv_local(const Ctx& C0_, int layer, int it, D1Pre& pre, int it_next) {
    Ctx C = C0_; { int t_ = C0_.tid; asm volatile("" : "+v"(t_)); C.tid = t_; C.lane = t_ & 63; C.wid = __builtin_amdgcn_readfirstlane(t_ >> 6); }
#define D1_RELAUNDER() do { int t_ = C.tid; asm volatile("" : "+v"(t_)); C.tid = t_; C.lane = t_ & 63; C.wid = __builtin_amdgcn_readfirstlane(t_ >> 6); } while (0)
    const int gc = it >> 3, hd = it & 7, h = hd & 3, d = hd >> 2;
    const ChunkInfo ci = chunk_info(gc);
    const int slot = slot_of(ci.b, h, d, cpos_of(ci, d));
    const bf16_t* P = (const bf16_t*)(C.ws + WS_P);
    const float* mup = C.in[24] + layer * 1152; const float* mun = C.in[25] + layer * 1152;
    lds_t L = C.lds;
    LAS float* LW = (LAS float*)(L + D1_LW); LAS float* CS = (LAS float*)(L + D1_CS); LAS float* AA = (LAS float*)(L + D1_AA); LAS float* GL = (LAS float*)(L + D1_GL);
    LAS bf16_t* Rb = (LAS bf16_t*)(L + D1_RB); LAS bf16_t* Kb = (LAS bf16_t*)(L + D1_KB); LAS bf16_t* Vb = (LAS bf16_t*)(L + D1_VB);
    LAS bf16_t* TW = (LAS bf16_t*)(L + D1_TW); LAS bf16_t* AD = (LAS bf16_t*)(L + D1_AD); LAS bf16_t* W2T = (LAS bf16_t*)(L + D1_W2T); LAS bf16_t* A2T = (LAS bf16_t*)(L + D1_A2T);
    LAS bf16_t* KT = (LAS bf16_t*)(L + D1_Y); LAS bf16_t* KTt = KT + 4608; LAS bf16_t* KD = KT + 2 * 4608; LAS bf16_t* KDt = KT + 3 * 4608;
    LAS bf16_t* BT = KT + 4 * 4608; LAS bf16_t* BTt = KT + 5 * 4608; LAS bf16_t* RT = KT + 6 * 4608; LAS bf16_t* Vt = KT + 7 * 4608;
    LAS float* ABf = (LAS float*)(L + D1_ABF); LAS bf16_t* AK = (LAS bf16_t*)(L + D1_AK); LAS bf16_t* ARK = (LAS bf16_t*)(L + D1_ARK); LAS bf16_t* ARB = (LAS bf16_t*)(L + D1_ARB);
    LAS bf16_t* TT = (LAS bf16_t*)(L + D1_TT); LAS bf16_t* W1t = (LAS bf16_t*)(L + D1_W1T); LAS bf16_t* AKVt = (LAS bf16_t*)(L + D1_AKVT); LAS bf16_t* W2t = (LAS bf16_t*)(L + D1_W2TT);

    if (C.tid < 480) {
        const int q = C.tid % 160, seg = C.tid / 160, grp = q >> 5, c = (q & 31) * 2;
        const int j = (grp == 0 ? h * 64 : grp == 1 ? 256 + h * 64 : grp == 2 ? 512 + h * 64 : grp == 3 ? 768 + d * 64 : 896 + d * 64) + c;
        const int t0 = seg * 22, nt = seg == 2 ? 20 : 22;
        const float mp0 = mup[j], mp1 = mup[j + 1], mn0 = mun[j], mn1 = mun[j + 1];
        unsigned w[24]; { const bf16_t* pp = P + (size_t)(ci.row0 + t0) * NP + OFF_D + j;
#pragma unroll
        for (int i = 0; i < 24; ++i) { const int row = ci.row0 + t0 - 1 + i; const bool ok = row >= ci.lo && row < ci.hi; const int rc = ok ? row : ci.row0;
            const unsigned v = (i < nt + 2) ? *(const unsigned*)(pp + (ptrdiff_t)(rc - (ci.row0 + t0)) * NP) : 0u; w[i] = ok ? v : 0u; } }
        LAS bf16_t* dst = (grp == 0 ? Rb : grp == 1 ? Kb : grp == 2 ? Vb : grp == 3 ? TW : AD);
#pragma unroll
        for (int i = 0; i < 22; ++i) if (i < nt) {
            const float x0 = bflo(w[i + 1]), x1 = bfhi(w[i + 1]);
            const float v0 = x0 + mp0 * (bflo(w[i]) - x0) + mn0 * (bflo(w[i + 2]) - x0);
            const float v1 = x1 + mp1 * (bfhi(w[i]) - x1) + mn1 * (bfhi(w[i + 2]) - x1);
            DBGF(1, badv(v0, 1e4f) || badv(v1, 1e4f));
            const unsigned o = (grp == 3) ? pk2(ftanh(v0), ftanh(v1)) : pk2(v0, v1);
            const int tl = t0 + i, l = d ? 63 - tl : tl;
            *(LAS unsigned*)(dst + l * 72 + c) = o;
        }
    }
    {
        if (pre.hd != hd) {
            const float* w2 = C.in[27] + ((size_t)layer * 2 + d) * 64 * 256 + h * 64; const float* a2 = C.in[29] + ((size_t)layer * 2 + d) * 64 * 256 + h * 64;
#pragma unroll
            for (int k = 0; k < 8; ++k) { const int e = C.tid + 512 * k, r = e >> 6, c = e & 63; pre.lw[k] = pk2(w2[r * 256 + c], a2[r * 256 + c]); }
            pre.hd = hd;
        }
#pragma unroll
        for (int k = 0; k < 8; ++k) { const int e = C.tid + 512 * k, r = e >> 6, c = e & 63; W2T[c * 72 + r] = (unsigned short)(pre.lw[k] & 0xffffu); A2T[c * 72 + r] = (unsigned short)(pre.lw[k] >> 16); }
    }
    __syncthreads();
    D1_RELAUNDER();
    {
        unsigned* dbgflags = (unsigned*)(C.ws + 32768); (void)dbgflags;
        const float* w0 = C.in[26] + ((size_t)layer * 2 + d) * 256 + h * 64; const float* a0 = C.in[28] + ((size_t)layer * 2 + d) * 256 + h * 64;
        blk_mma<4, 4, 2>(TW, 72, W2T, 72, C.wid, C.lane, [=](int r0, int col, const f32x4& acc) {
#pragma unroll
            for (int jj = 0; jj < 4; ++jj) { const float w = w0[col] + acc[jj]; DBGL(2, badv(w, 1e4f)); LW[(r0 + jj) * 68 + col] = -fexp(-softplus(-w) - 0.5f); }
        });
        blk_mma<4, 4, 2>(AD, 72, A2T, 72, C.wid, C.lane, [=](int r0, int col, const f32x4& acc) {
#pragma unroll
            for (int jj = 0; jj < 4; ++jj) { DBGL(2, badv(acc[jj], 1e4f)); AA[(r0 + jj) * 68 + col] = sigm(a0[col] + acc[jj]); }
        });
    }
    __syncthreads();
    {
#pragma unroll
        for (int i = 0; i < 8; ++i) { const int c = C.wid * 8 + i; const float incl = wave_incl_scan(LW[C.lane * 68 + c], C.lane); CS[C.lane * 68 + c] = incl; if (C.lane == 63) GL[c] = fexp(incl); }
    }
    __syncthreads();
    D1_RELAUNDER();
    {
        const int l = C.tid >> 3, sub = C.tid & 7;
        const float* kkw = C.in[31] + layer * 256 + h * 64; const float* kaw = C.in[32] + layer * 256 + h * 64; const float* rkw = C.in[33] + layer * 256 + h * 64;
        float kk[8], kdv[8], aa[8], rr[8], vv[8]; float ss = 0.f, bon = 0.f;
#pragma unroll
        for (int i = 0; i < 8; ++i) { const int c = sub * 8 + i; const float k = bf2f(Kb[l * 72 + c]); rr[i] = bf2f(Rb[l * 72 + c]); vv[i] = bf2f(Vb[l * 72 + c]); aa[i] = AA[l * 68 + c];
            kk[i] = k * kkw[c]; ss += kk[i] * kk[i]; kdv[i] = k * (1.f + (aa[i] - 1.f) * kaw[c]); bon += rr[i] * kdv[i] * rkw[c]; }
        ss += __shfl_xor(ss, 1); ss += __shfl_xor(ss, 2); ss += __shfl_xor(ss, 4);
        bon += __shfl_xor(bon, 1); bon += __shfl_xor(bon, 2); bon += __shfl_xor(bon, 4);
        const float inv = rsqrtf(ss + 1e-12f);
        if (sub == 0) ((float*)(C.ws + WS_BON))[(size_t)(ci.row0 + (d ? 63 - l : l)) * 8 + h * 2 + d] = bon;
        unsigned short kt[8], kd[8], bt[8], rt[8];
#pragma unroll
        for (int i = 0; i < 8; ++i) { const int c = sub * 8 + i; const float cs = CS[l * 68 + c], lw = LW[l * 68 + c];
            const float ge = fexp(cs - lw), gi = fexp(cs), gn = fexp(-cs); const float kkn = kk[i] * inv;
            DBGF(3, badv(cs, 50.f) || cs > 0.f || badv(lw, 1.f)); DBGF(4, badv(kkn * ge, 10.f) || badv(rr[i] * gi, 1e4f) || badv(vv[i], 1e4f)); DBGF(5, badv(kdv[i] * gn, 1e25f) || badv(kkn * aa[i] * gn, 1e25f));
            kt[i] = f2bf(kkn * ge); kd[i] = f2bf(kdv[i] * gn); bt[i] = f2bf(kkn * aa[i] * gn); rt[i] = f2bf(rr[i] * gi);
            KTt[c * 72 + l] = kt[i]; KDt[c * 72 + l] = kd[i]; BTt[c * 72 + l] = bt[i]; Vt[c * 72 + l] = f2bf(vv[i]); }
#define D1_PACK8(a) (u32x4){(unsigned)a[0] | ((unsigned)a[1] << 16), (unsigned)a[2] | ((unsigned)a[3] << 16), (unsigned)a[4] | ((unsigned)a[5] << 16), (unsigned)a[6] | ((unsigned)a[7] << 16)}
        *(LAS u32x4*)(KT + l * 72 + sub * 8) = D1_PACK8(kt); *(LAS u32x4*)(KD + l * 72 + sub * 8) = D1_PACK8(kd);
        *(LAS u32x4*)(BT + l * 72 + sub * 8) = D1_PACK8(bt); *(LAS u32x4*)(RT + l * 72 + sub * 8) = D1_PACK8(rt);
#undef D1_PACK8
    }
    __syncthreads();
    D1_RELAUNDER();
    unsigned* dbgflags = (unsigned*)(C.ws + 32768); (void)dbgflags;
    blk_mma2<4, 4, 2>(BT, KT, KD, KT, 72, C.wid, C.lane, [=](int r0, int col, const f32x4& ab, const f32x4& ak) {
        f32x4 a; float k[4];
#pragma unroll
        for (int jj = 0; jj < 4; ++jj) { const bool lo = r0 + jj < col; DBGL(6, lo && (badv(ab[jj], 1e3f) || badv(ak[jj], 1e4f))); a[jj] = lo ? ab[jj] : 0.f; k[jj] = lo ? ak[jj] : 0.f; }
        *(LAS f32x4*)(ABf + col * 68 + r0) = a;
        u32x2 o; o.x = pk2(k[0], k[1]); o.y = pk2(k[2], k[3]); *(LAS u32x2*)(AK + col * 72 + r0) = o;
    });
    blk_mma2<4, 4, 2>(KD, RT, BT, RT, 72, C.wid, C.lane, [=](int r0, int col, const f32x4& rk, const f32x4& rb) {
        float a[4], b[4];
#pragma unroll
        for (int jj = 0; jj < 4; ++jj) { const bool le = r0 + jj <= col; DBGL(7, le && (badv(rk[jj], 1e5f) || badv(rb[jj], 1e5f))); a[jj] = le ? rk[jj] : 0.f; b[jj] = le ? rb[jj] : 0.f; }
        u32x2 oa, ob; oa.x = pk2(a[0], a[1]); oa.y = pk2(a[2], a[3]); ob.x = pk2(b[0], b[1]); ob.y = pk2(b[2], b[3]);
        *(LAS u32x2*)(ARK + col * 72 + r0) = oa; *(LAS u32x2*)(ARB + col * 72 + r0) = ob;
    });
    __syncthreads();
    tri_inverse(ABf, (LAS float*)(L + 54272), (LAS float*)(L + 71680), TT, C.tid, C.wid, C.lane);
    __syncthreads();
#if MK_DIAG2
    for (int e = C.tid; e < 4096; e += 512) DBGF(8, badv(bf2f(TT[(e >> 6) * 72 + (e & 63)]), 1e3f));
#endif
    D1_RELAUNDER();
    blk_mma2<4, 4, 2>(TT, KTt, AK, Vt, 72, C.wid, C.lane, [=](int r0, int col, const f32x4& w1, const f32x4& akv) {
        DBGL(9, badv(w1[0], 1e3f) || badv(w1[1], 1e3f) || badv(w1[2], 1e3f) || badv(w1[3], 1e3f)); DBGL(10, badv(akv[0], 1e5f) || badv(akv[1], 1e5f) || badv(akv[2], 1e5f) || badv(akv[3], 1e5f));
        u32x2 a, b; a.x = pk2(w1[0], w1[1]); a.y = pk2(w1[2], w1[3]); b.x = pk2(akv[0], akv[1]); b.y = pk2(akv[2], akv[3]);
        *(LAS u32x2*)(W1t + col * 72 + r0) = a; *(LAS u32x2*)(AKVt + col * 72 + r0) = b;
    });
    __syncthreads();
    blk_mma<4, 4, 2>(TT, 72, AKVt, 72, C.wid, C.lane, [=](int r0, int col, const f32x4& w2) {
        DBGL(11, badv(w2[0], 1e5f) || badv(w2[1], 1e5f) || badv(w2[2], 1e5f) || badv(w2[3], 1e5f));
        u32x2 a; a.x = pk2(w2[0], w2[1]); a.y = pk2(w2[2], w2[3]); *(LAS u32x2*)(W2t + col * 72 + r0) = a;
    });
    __syncthreads();
    D1_RELAUNDER();
    {
        bf16_t* Gg = (bf16_t*)(C.ws + WS_RG) + (size_t)slot * 4096; bf16_t* Jg = (bf16_t*)(C.ws + WS_RJ) + (size_t)slot * 4096;
        bf16_t* Ryg = (bf16_t*)(C.ws + WS_RY) + (size_t)slot * 4096; bf16_t* Ylg = (bf16_t*)(C.ws + WS_RL) + (size_t)slot * 4096;
        blk_mma2<4, 4, 2>(W1t, BTt, W1t, ARB, 72, C.wid, C.lane, [=](int r0, int col, const f32x4& gp, const f32x4& rbw) {
            const float gl = GL[col]; float g[4], ry[4];
            const u32x2 rt = *(const LAS u32x2*)(RT + col * 72 + r0);
            const float rtv[4] = {bflo(rt.x), bfhi(rt.x), bflo(rt.y), bfhi(rt.y)};
#pragma unroll
            for (int jj = 0; jj < 4; ++jj) { g[jj] = gl * ((col == r0 + jj ? 1.f : 0.f) - gp[jj]); ry[jj] = rtv[jj] - rbw[jj]; }
            u32x2 og, oy; og.x = pk2(g[0], g[1]); og.y = pk2(g[2], g[3]); oy.x = pk2(ry[0], ry[1]); oy.y = pk2(ry[2], ry[3]);
            *(u32x2*)(Gg + col * 64 + r0) = og;
            *(u32x2*)(Ryg + col * 64 + r0) = oy;
        });
        blk_mma2<4, 4, 2>(KDt, Vt, BTt, W2t, 72, C.wid, C.lane, [=](int r0, int col, const f32x4& kv, const f32x4& bw) {
            f32x4 o;
#pragma unroll
            for (int jj = 0; jj < 4; ++jj) { o[jj] = GL[r0 + jj] * (kv[jj] - bw[jj]); DBGL(12, badv(GL[r0 + jj] * kv[jj], 1e5f)); DBGL(13, badv(GL[r0 + jj] * bw[jj], 1e5f)); DBGL(14, badv(o[jj], 1e5f)); }
            u32x2 oj; oj.x = pk2(o[0], o[1]); oj.y = pk2(o[2], o[3]); *(u32x2*)(Jg + col * 64 + r0) = oj;
        });
        blk_mma2<4, 4, 2>(ARK, Vt, ARB, W2t, 72, C.wid, C.lane, [=](int r0, int col, const f32x4& a, const f32x4& b) {
            u32x2 o; o.x = pk2(a[0] - b[0], a[1] - b[1]); o.y = pk2(a[2] - b[2], a[3] - b[3]);
            *(u32x2*)(Ylg + col * 64 + r0) = o;
        });
    }
    __syncthreads();
}

typedef float f32x2p __attribute__((ext_vector_type(2)));
__device__ __forceinline__ void ph_scan(const Ctx& C, int nrep = 1, bool mstore = true, bool chain = true) {
    if (C.bid < 64) {
      if (chain)
      for (int rep = 0; rep < nrep; ++rep) {
        constexpr int NB = 8;
        const int chain_id = C.bid >> 2, w4 = C.bid & 3, fr = C.lane & 15, fq = C.lane >> 4;
        LAS bf16_t* Gs = (LAS bf16_t*)C.lds;
        LAS bf16_t* Js = Gs + NB * 4608;
        LAS bf16_t* HT = Js + NB * 1152;
        const bf16_t* Gg = (const bf16_t*)(C.ws + WS_RG) + (size_t)chain_id * NCH * 4096;
        const bf16_t* Jg = (const bf16_t*)(C.ws + WS_RJ) + (size_t)chain_id * NCH * 4096 + (size_t)(16 * w4) * 64;
        bf16_t* Hg = (bf16_t*)(C.ws + WS_RH) + (size_t)chain_id * NCH * 4096 + (16 * w4 + fr) * 64 + fq * 4;
        u32x4 pf[10];
#define CHAIN_ISSUE(b0_) do { _Pragma("unroll") for (int i = 0; i < 10; ++i) { const int e = C.tid + 512 * i, st = e / 640, q = e % 640; const size_t cp = (size_t)((b0_) + st < NCH ? (b0_) + st : NCH - 1) * 4096; \
            pf[i] = *(const u32x4*)(q < 512 ? Gg + cp + q * 8 : Jg + cp + (q - 512) * 8); } } while (0)
#define CHAIN_STAGE() do { _Pragma("unroll") for (int i = 0; i < 10; ++i) { const int e = C.tid + 512 * i, st = e / 640, q = e % 640; \
            if (q < 512) *(LAS u32x4*)(Gs + st * 4608 + (q >> 3) * 72 + (q & 7) * 8) = pf[i]; else *(LAS u32x4*)(Js + st * 1152 + ((q - 512) >> 3) * 72 + (q & 7) * 8) = pf[i]; } } while (0)
        f32x4 acc[4];
#pragma unroll
        for (int tm = 0; tm < 4; ++tm) acc[tm] = (f32x4){0.f, 0.f, 0.f, 0.f};
        CHAIN_ISSUE(0);
        for (int b0 = 0; b0 < NCH; b0 += NB) {
            __syncthreads();
            CHAIN_STAGE();
            __syncthreads();
            if (b0 + NB < NCH) CHAIN_ISSUE(b0 + NB);
            if (C.wid == 0) {
                const int nb = NCH - b0 < NB ? NCH - b0 : NB;
                for (int st = 0; st < nb; ++st) {
                    const int cpos = b0 + st;
#pragma unroll
                    for (int tm = 0; tm < 4; ++tm) { u32x2 o; o.x = pk2(acc[tm][0], acc[tm][1]); o.y = pk2(acc[tm][2], acc[tm][3]);
                        *(LAS u32x2*)(HT + fr * 72 + tm * 16 + fq * 4) = o;
                        *(u32x2*)(Hg + (size_t)cpos * 4096 + tm * 16) = o; }
                    const bf16x8 b0v = *(const LAS bf16x8*)(HT + fr * 72 + fq * 8), b1v = *(const LAS bf16x8*)(HT + fr * 72 + 32 + fq * 8);
#pragma unroll
                    for (int tm = 0; tm < 4; ++tm) {
                        const u32x2 jr = *(const LAS u32x2*)(Js + st * 1152 + fr * 72 + tm * 16 + fq * 4);
                        f32x4 a = {bflo(jr.x), bfhi(jr.x), bflo(jr.y), bfhi(jr.y)};
                        a = __builtin_amdgcn_mfma_f32_16x16x32_bf16(*(const LAS bf16x8*)(Gs + st * 4608 + (tm * 16 + fr) * 72 + fq * 8), b0v, a, 0, 0, 0);
                        a = __builtin_amdgcn_mfma_f32_16x16x32_bf16(*(const LAS bf16x8*)(Gs + st * 4608 + (tm * 16 + fr) * 72 + 32 + fq * 8), b1v, a, 0, 0, 0);
                        acc[tm] = a; }
                }
            }
        }
#undef CHAIN_ISSUE
#undef CHAIN_STAGE
        __syncthreads();
      }
    } else {
        unsigned* MST = (unsigned*)(C.ws + WS_MST); const float* MCD = (const float*)(C.ws + WS_MCD);
        const int nthr = (C.G - 64) * 512;
        for (int e = (C.bid - 64) * 512 + C.tid; e < 16 * 4096; e += nthr) {
            const int chain = e >> 12, el = e & 4095; float r0 = 0.f, r1 = 0.f;
            unsigned* p = MST + (size_t)chain * NCH * 4096 + el; const float* cd = MCD + chain * NCH;
#pragma unroll 22
            for (int cpos = 0; cpos < NCH; ++cpos) { const unsigned tmp = p[(size_t)cpos * 4096]; if (mstore) p[(size_t)cpos * 4096] = pk2(r0, r1); const float c = cd[cpos]; r0 = r0 * c + bflo(tmp); r1 = r1 * c + bfhi(tmp); }
            if (!mstore && r0 == 12345.678f) p[0] = 0u;
        }
    }
}

__device__ __forceinline__ void item_mamba_out(const Ctx& C0_, int layer, int gc) {
    Ctx C = C0_;
#define MO_RELAUNDER() do { int t_ = C.tid; asm volatile("" : "+v"(t_)); C.tid = t_; C.lane = t_ & 63; C.wid = __builtin_amdgcn_readfirstlane(t_ >> 6); } while (0)
    MO_RELAUNDER();
    const ChunkInfo ci = chunk_info(gc);
    const bf16_t* P = (const bf16_t*)(C.ws + WS_P); bf16_t* YC = (bf16_t*)(C.ws + WS_ACT); const bf16_t* MST = (const bf16_t*)(C.ws + WS_MST);
    lds_t L = C.lds;
    LAS float* DT = (LAS float*)L;
    LAS float* DA = (LAS float*)(L + 2048);
    LAS float* CSI = (LAS float*)(L + 4096);
    LAS float* SSQ = (LAS float*)(L + 6144);
    LAS bf16_t* CG = (LAS bf16_t*)(L + 10240);
    LAS bf16_t* BG = (LAS bf16_t*)(L + 27648);
    LAS bf16_t* XT = (LAS bf16_t*)(L + 45056);
    LAS float* CBm = (LAS float*)(L + 63488);
    LAS bf16_t* MP = (LAS bf16_t*)(L + 80896);
    LAS bf16_t* S0 = (LAS bf16_t*)(L + 90112);
    LAS bf16_t* YPRE = (LAS bf16_t*)(L + 107520);
    int fr = C.lane & 15, fq = C.lane >> 4;
    {
        const int s = C.lane, dh = C.wid;
        const float raw = bf2f(P[(size_t)(ci.row0 + s) * NP + OFF_C + 1024 + dh]);
        const float dt = softplus(raw + C.in[20][layer * 8 + dh]);
        const float da = dt * (-expf(C.in[21][layer * 8 + dh]));
        const float incl = wave_incl_scan(da, s), total = __shfl(incl, 63);
        DT[dh * 64 + s] = dt; DA[dh * 64 + s] = da;
        CSI[dh * 64 + s] = (dh < 4) ? incl : (total - incl + da);
    }
    for (int g = 0; g < 2; ++g) {
        __syncthreads();
        MO_RELAUNDER(); fr = C.lane & 15; fq = C.lane >> 4;
        {
            const int cp = C.tid & 255, half = C.tid >> 8;
            if (cp < 192) {
                const int kind = cp >> 6, cl = (cp & 63) * 2, c0 = kind * 256 + g * 128 + cl;
                const float* cw = C.in[18] + (size_t)layer * 5 * 768 + c0; const float* cb = C.in[19] + layer * 768 + c0;
                float w0[5], w1[5];
#pragma unroll
                for (int j = 0; j < 5; ++j) { w0[j] = cw[j * 768]; w1[j] = cw[j * 768 + 1]; }
                const float b0 = cb[0], b1 = cb[1];
                const int s0 = half * 32;
                unsigned wr[36];
#pragma unroll
                for (int j = 0; j < 36; ++j) { const int row = ci.row0 + s0 - 2 + j; const bool ok = row >= ci.lo && row < ci.hi; const unsigned v = *(const unsigned*)(P + (size_t)(ok ? row : ci.row0) * NP + OFF_C + 256 + c0); wr[j] = ok ? v : 0u; }
#pragma unroll
                for (int tt = 0; tt < 32; ++tt) {
                    const int s = s0 + tt;
                    const unsigned* win = wr + tt;
                    float a0 = b0, a1 = b1;
#pragma unroll
                    for (int j = 0; j < 5; ++j) { a0 += w0[j] * bflo(win[j]); a1 += w1[j] * bfhi(win[j]); }
                    const unsigned short o0 = f2bf(silu(a0)), o1 = f2bf(silu(a1));
                    if (kind == 0) { XT[cl * 72 + s] = o0; XT[(cl + 1) * 72 + s] = o1; }
                    else if (kind == 1) { *(LAS unsigned*)(BG + s * 136 + cl) = (unsigned)o0 | ((unsigned)o1 << 16); }
                    else { *(LAS unsigned*)(CG + s * 136 + cl) = (unsigned)o0 | ((unsigned)o1 << 16); }
                }
            }
        }
        __syncthreads();
        blk_mma<4, 4, 4>(CG, 136, BG, 136, C.wid, C.lane, [=](int r0, int col, const f32x4& acc) {
#pragma unroll
            for (int jj = 0; jj < 4; ++jj) CBm[(r0 + jj) * 68 + col] = acc[jj];
        });
        u32x4 s0r[2];
        { const bf16_t* src = MST + (size_t)slot_of(ci.b, 2 * g, 0, cpos_of(ci, 0)) * 8192;
#pragma unroll
          for (int k = 0; k < 2; ++k) { const int e = C.tid + 512 * k; s0r[k] = *(const u32x4*)(src + (e >> 4) * 128 + (e & 15) * 8); } }
        for (int hh = 0; hh < 2; ++hh) {
            MO_RELAUNDER(); fr = C.lane & 15; fq = C.lane >> 4;
            const int h = 2 * g + hh;
            f32x4 yacc[2] = {{0.f, 0.f, 0.f, 0.f}, {0.f, 0.f, 0.f, 0.f}};
            unsigned short zr[2][4];
#pragma unroll
            for (int i = 0; i < 2; ++i) { const int tt = C.wid + 8 * i, tm = tt >> 2, tn = tt & 3;
#pragma unroll
                for (int j = 0; j < 4; ++j) zr[i][j] = P[(size_t)(ci.row0 + tm * 16 + fq * 4 + j) * NP + OFF_C + h * 64 + tn * 16 + fr]; }
            for (int d = 0; d < 2; ++d) {
                const int dh = d * 4 + h;
                __syncthreads();
                for (int e = C.tid; e < 4096; e += 512) { const int l = e >> 6, s = e & 63; const bool ok = d ? (s >= l) : (s <= l);
                    MP[l * 72 + s] = ok ? f2bf(CBm[l * 68 + s] * fexp(CSI[dh * 64 + l] - CSI[dh * 64 + s]) * DT[dh * 64 + s]) : (unsigned short)0; }
#pragma unroll
                for (int k = 0; k < 2; ++k) { const int e = C.tid + 512 * k; *(LAS u32x4*)(S0 + (e >> 4) * 136 + (e & 15) * 8) = s0r[k]; }
                if (!(hh == 1 && d == 1)) { const int nh = d ? h + 1 : h, nd = d ^ 1; const bf16_t* src = MST + (size_t)slot_of(ci.b, nh, nd, cpos_of(ci, nd)) * 8192;
#pragma unroll
                    for (int k = 0; k < 2; ++k) { const int e = C.tid + 512 * k; s0r[k] = *(const u32x4*)(src + (e >> 4) * 128 + (e & 15) * 8); } }
                __syncthreads();
#pragma unroll
                for (int i = 0; i < 2; ++i) { const int tt = C.wid + 8 * i, tm = tt >> 2, tn = tt & 3;
                    f32x4 a1 = {0.f, 0.f, 0.f, 0.f}, a2 = {0.f, 0.f, 0.f, 0.f};
#pragma unroll
                    for (int ks = 0; ks < 2; ++ks) a1 = __builtin_amdgcn_mfma_f32_16x16x32_bf16(*(const LAS bf16x8*)(MP + (tm * 16 + fr) * 72 + ks * 32 + fq * 8),
                                                                                                 *(const LAS bf16x8*)(XT + (hh * 64 + tn * 16 + fr) * 72 + ks * 32 + fq * 8), a1, 0, 0, 0);
#pragma unroll
                    for (int ks = 0; ks < 4; ++ks) a2 = __builtin_amdgcn_mfma_f32_16x16x32_bf16(*(const LAS bf16x8*)(CG + (tm * 16 + fr) * 136 + ks * 32 + fq * 8),
                                                                                                 *(const LAS bf16x8*)(S0 + (tn * 16 + fr) * 136 + ks * 32 + fq * 8), a2, 0, 0, 0);
#pragma unroll
                    for (int j = 0; j < 4; ++j) yacc[i][j] += a1[j] + a2[j] * fexp(CSI[dh * 64 + tm * 16 + fq * 4 + j]);
                }
            }
            const float dsk = C.in[22][layer * 4 + h];
#pragma unroll
            for (int i = 0; i < 2; ++i) { const int tt = C.wid + 8 * i, tm = tt >> 2, tn = tt & 3;
#pragma unroll
                for (int j = 0; j < 4; ++j) { const int l = tm * 16 + fq * 4 + j, p = tn * 16 + fr, c = h * 64 + p;
                    const float xs = bf2f(XT[(hh * 64 + p) * 72 + l]);
                    const float z = bf2f(zr[i][j]);
                    const float pre = (yacc[i][j] + dsk * xs) * silu(z);
                    YPRE[l * 264 + c] = f2bf(pre);
                    float q = pre * pre; q += __shfl_xor(q, 1); q += __shfl_xor(q, 2); q += __shfl_xor(q, 4); q += __shfl_xor(q, 8);
                    if (fr == 0) SSQ[l * 16 + h * 4 + tn] = q; }
            }
        }
    }
    __syncthreads();
    {
        const int l = C.tid >> 3, sub = C.tid & 7; float ss = 0.f;
#pragma unroll
        for (int i = 0; i < 16; ++i) ss += SSQ[l * 16 + i];
        const float rs = rsqrtf(ss * (1.f / 256.f) + 1e-6f);
        const float* ng = C.in[23] + layer * 256 + sub * 32;
        bf16_t* dst = YC + (size_t)(ci.row0 + l) * DM + 512 + sub * 32;
#pragma unroll
        for (int i = 0; i < 32; i += 2) { const float a = bf2f(YPRE[l * 264 + sub * 32 + i]) * rs * ng[i], b = bf2f(YPRE[l * 264 + sub * 32 + i + 1]) * rs * ng[i + 1]; *(unsigned*)(dst + i) = pk2(a, b); }
    }
    __syncthreads();
}

constexpr int D3_G2T = 0, D3_SG = 69632;
__device__ __forceinline__ void load_g2t(const Ctx& C, int layer) {
    LAS bf16_t* G2T = (LAS bf16_t*)(C.lds + D3_G2T); const float* g2 = C.in[30] + (size_t)layer * 128 * 256;
    for (int e = C.tid; e < 128 * 256; e += 512) { const int r = e >> 8, c = e & 255; G2T[c * 136 + r] = f2bf(g2[e]); }
}
__device__ __forceinline__ float lerp_d(const bf16_t* P, const ChunkInfo& ci, int row, int j, const float* mup, const float* mun) {
    const bf16_t* pp = P + (size_t)row * NP + OFF_D + j;
    const bool okp = row - 1 >= ci.lo, okn = row + 1 < ci.hi;
    const float x = bf2f(*pp), xpv = bf2f(*(okp ? pp - NP : pp)), xnv = bf2f(*(okn ? pp + NP : pp)); const float xp = okp ? xpv : 0.f, xn = okn ? xnv : 0.f;
    return x + mup[j] * (xp - x) + mun[j] * (xn - x);
}
__device__ __forceinline__ void item_rwkv_out(const Ctx& C, int layer, int gc) {
    const ChunkInfo ci = chunk_info(gc);
    const bf16_t* P = (const bf16_t*)(C.ws + WS_P); bf16_t* YC = (bf16_t*)(C.ws + WS_ACT);
    const float* mup = C.in[24] + layer * 1152; const float* mun = C.in[25] + layer * 1152;
    LAS bf16_t* G2T = (LAS bf16_t*)(C.lds + D3_G2T); LAS bf16_t* SG = (LAS bf16_t*)(C.lds + D3_SG);
    int ln_ = C.lane; asm volatile("" : "+v"(ln_));
    const int fr = ln_ & 15, fq = ln_ >> 4;
    __syncthreads();
    for (int e = C.tid; e < 64 * 128; e += 512) { const int l = e >> 7, r = e & 127; SG[l * 136 + r] = f2bf(sigm(lerp_d(P, ci, ci.row0 + l, 1024 + r, mup, mun))); }
    __syncthreads();
    const int h = C.wid >> 1, tmb = (C.wid & 1) * 2;
    const bf16_t* Ryg = (const bf16_t*)(C.ws + WS_RY); const bf16_t* Ylg = (const bf16_t*)(C.ws + WS_RL); const bf16_t* Hg = (const bf16_t*)(C.ws + WS_RH);
    const float* BON = (const float*)(C.ws + WS_BON);
#pragma unroll
    for (int ti = 0; ti < 2; ++ti) {
        const int tm = tmb + ti;
        f32x4 gacc[4], yacc[4];
#pragma unroll
        for (int tn = 0; tn < 4; ++tn) { f32x4 a = {0.f, 0.f, 0.f, 0.f};
#pragma unroll
            for (int ks = 0; ks < 4; ++ks) a = __builtin_amdgcn_mfma_f32_16x16x32_bf16(*(const LAS bf16x8*)(SG + (tm * 16 + fr) * 136 + ks * 32 + fq * 8),
                                                                                        *(const LAS bf16x8*)(G2T + (h * 64 + tn * 16 + fr) * 136 + ks * 32 + fq * 8), a, 0, 0, 0);
            gacc[tn] = a; yacc[tn] = (f32x4){0.f, 0.f, 0.f, 0.f}; }
#pragma unroll
        for (int d = 0; d < 2; ++d) {
            const size_t slot = (size_t)slot_of(ci.b, h, d, cpos_of(ci, d));
            const int arow = d ? 63 - (tm * 16 + fr) : tm * 16 + fr;
            bf16x8 af[2];
#pragma unroll
            for (int ks = 0; ks < 2; ++ks) af[ks] = *(const bf16x8*)(Ryg + slot * 4096 + arow * 64 + ks * 32 + fq * 8);
#pragma unroll
            for (int tn = 0; tn < 4; ++tn) {
                f32x4 a;
                if (d == 0) { const u32x2 yl = *(const u32x2*)(Ylg + slot * 4096 + (tn * 16 + fr) * 64 + tm * 16 + fq * 4); a = (f32x4){bflo(yl.x), bfhi(yl.x), bflo(yl.y), bfhi(yl.y)}; }
                else { const u32x2 yl = *(const u32x2*)(Ylg + slot * 4096 + (tn * 16 + fr) * 64 + 60 - (tm * 16 + fq * 4)); a = (f32x4){bfhi(yl.y), bflo(yl.y), bfhi(yl.x), bflo(yl.x)}; }
#pragma unroll
                for (int ks = 0; ks < 2; ++ks) a = __builtin_amdgcn_mfma_f32_16x16x32_bf16(af[ks], *(const bf16x8*)(Hg + slot * 4096 + (tn * 16 + fr) * 64 + ks * 32 + fq * 8), a, 0, 0, 0);
                yacc[tn] += a;
            }
        }
#pragma unroll
        for (int j = 0; j < 4; ++j) {
            const int l = tm * 16 + fq * 4 + j, row = ci.row0 + l;
            float s = (yacc[0][j] + yacc[1][j]) + (yacc[2][j] + yacc[3][j]);
            s += __shfl_xor(s, 1); s += __shfl_xor(s, 2); s += __shfl_xor(s, 4); s += __shfl_xor(s, 8);
            const float mu = s * (1.f / 64.f);
            float q = 0.f;
#pragma unroll
            for (int tn = 0; tn < 4; ++tn) { const float dd = yacc[tn][j] - mu; q += dd * dd; }
            q += __shfl_xor(q, 1); q += __shfl_xor(q, 2); q += __shfl_xor(q, 4); q += __shfl_xor(q, 8);
            const float rs = rsqrtf(q * (1.f / 64.f) + 64e-5f);
            const float bon = BON[(size_t)row * 8 + h * 2] + BON[(size_t)row * 8 + h * 2 + 1];
#pragma unroll
            for (int tn = 0; tn < 4; ++tn) { const int c = h * 64 + tn * 16 + fr;
                const float yn = (yacc[tn][j] - mu) * rs * C.in[34][layer * 256 + c] + C.in[35][layer * 256 + c];
                const float vv = lerp_d(P, ci, row, 512 + c, mup, mun);
                YC[(size_t)row * DM + 768 + c] = f2bf((yn + bon * vv) * gacc[tn][j]); }
        }
    }
}

__device__ __forceinline__ unsigned ordf(float f) { const unsigned u = __float_as_uint(f); return u ^ ((u >> 31) ? 0xFFFFFFFFu : 0x80000000u); }
__device__ __forceinline__ unsigned wave_max_u32(unsigned v) {
    unsigned t;
    t = (unsigned)__builtin_amdgcn_update_dpp((int)v, (int)v, 0xB1, 0xF, 0xF, false); v = t > v ? t : v;
    t = (unsigned)__builtin_amdgcn_update_dpp((int)v, (int)v, 0x4E, 0xF, 0xF, false); v = t > v ? t : v;
    t = (unsigned)__builtin_amdgcn_update_dpp((int)v, (int)v, 0x141, 0xF, 0xF, false); v = t > v ? t : v;
    t = (unsigned)__builtin_amdgcn_update_dpp((int)v, (int)v, 0x140, 0xF, 0xF, false); v = t > v ? t : v;
    t = (unsigned)__builtin_amdgcn_update_dpp((int)v, (int)v, 0x142, 0xA, 0xF, false); v = t > v ? t : v;
    t = (unsigned)__builtin_amdgcn_update_dpp((int)v, (int)v, 0x143, 0xC, 0xF, false); v = t > v ? t : v;
    return (unsigned)__builtin_amdgcn_readlane((int)v, 63);
}
constexpr int SEL_K1 = 0, SEL_K2 = 34816;
__device__ __forceinline__ float unordf(unsigned k) { return __uint_as_float((k & 0x80000000u) ? (k ^ 0x80000000u) : ~k); }
template <int N> __device__ __forceinline__ void bitonic_sort_desc(unsigned (&x)[N]) {
#pragma unroll
    for (int k = 2; k <= N; k <<= 1)
#pragma unroll
        for (int j = k >> 1; j > 0; j >>= 1)
#pragma unroll
            for (int i = 0; i < N; ++i) { const int l = i ^ j;
                if (l > i) { const unsigned p = x[i], q = x[l]; const unsigned hi = p > q ? p : q, lo = p > q ? q : p; if ((i & k) == 0) { x[i] = hi; x[l] = lo; } else { x[i] = lo; x[l] = hi; } } }
}
__device__ __forceinline__ void merge_top16(unsigned (&a)[16], const unsigned (&b)[16]) {
#pragma unroll
    for (int i = 0; i < 16; ++i) a[i] = a[i] > b[15 - i] ? a[i] : b[15 - i];
#pragma unroll
    for (int j = 8; j > 0; j >>= 1)
#pragma unroll
        for (int i = 0; i < 16; ++i) { const int l = i ^ j; if (l > i) { const unsigned p = a[i], q = a[l]; a[i] = p > q ? p : q; a[l] = p > q ? q : p; } }
}
__device__ __forceinline__ void ph_select(const Ctx& C, int layer, int nrows) {
    const bf16_t* Q = (const bf16_t*)(C.ws + WS_Q); int* SELI = (int*)(C.ws + WS_SELI); float* SELG = (float*)(C.ws + WS_SELG);
    LAS bf16_t* K1 = (LAS bf16_t*)(C.lds + SEL_K1); LAS bf16_t* K2 = (LAS bf16_t*)(C.lds + SEL_K2);
    {
        const float* k1 = C.in[37] + (size_t)layer * 128 * 128; const float* k2 = C.in[38] + (size_t)layer * 128 * 128;
        for (int e = C.tid; e < 4096; e += 512) { const int r = e >> 5, c4 = (e & 31) * 4; const f32x4 a = *(const f32x4*)(k1 + r * 128 + c4), b = *(const f32x4*)(k2 + r * 128 + c4);
            u32x2 oa, ob; oa.x = pk2(a.x, a.y); oa.y = pk2(a.z, a.w); ob.x = pk2(b.x, b.y); ob.y = pk2(b.z, b.w);
            *(LAS u32x2*)(K1 + r * 136 + c4) = oa; *(LAS u32x2*)(K2 + r * 136 + c4) = ob; }
    }
    __syncthreads();
    const int nunits = (nrows / 16) * 8;
    for (int u = C.bid * 8 + C.wid; u < nunits; u += C.G * 8) {
        int ln_ = C.lane; asm volatile("" : "+v"(ln_));
        const int fr = ln_ & 15, fq = ln_ >> 4;
        const int tile = u >> 3, h = u & 7, row = tile * 16 + fr;
        const bf16_t* qp = Q + (size_t)row * 2048 + h * 256 + fq * 8;
        bf16x8 qf[8];
#pragma unroll
        for (int i = 0; i < 8; ++i) qf[i] = *(const bf16x8*)(qp + i * 32);
        unsigned T[2][16];
#pragma unroll
        for (int half = 0; half < 2; ++half) {
            const LAS bf16_t* K = half ? K2 : K1;
            unsigned lo16[16], hi16[16];
#pragma unroll
            for (int kt = 0; kt < 8; ++kt) {
                f32x4 acc = {0.f, 0.f, 0.f, 0.f};
#pragma unroll
                for (int ks = 0; ks < 4; ++ks) acc = __builtin_amdgcn_mfma_f32_16x16x32_bf16(*(const LAS bf16x8*)(K + (kt * 16 + fr) * 136 + ks * 32 + fq * 8), qf[half * 4 + ks], acc, 0, 0, 0);
#pragma unroll
                for (int j = 0; j < 4; ++j) { const unsigned key = (ordf(acc[j]) & ~0x7Fu) | (unsigned)(127 - (kt * 16 + fq * 4 + j));
                    if (kt < 4) lo16[kt * 4 + j] = key; else hi16[(kt - 4) * 4 + j] = key; }
            }
            bitonic_sort_desc<16>(lo16); bitonic_sort_desc<16>(hi16); merge_top16(lo16, hi16);
#pragma unroll
            for (int rnd = 16; rnd <= 32; rnd <<= 1) { unsigned o[16];
#pragma unroll
                for (int i = 0; i < 16; ++i) o[i] = (unsigned)__shfl_xor((int)lo16[i], rnd);
                merge_top16(lo16, o); }
#pragma unroll
            for (int i = 0; i < 16; ++i) T[half][i] = lo16[i];
        }
        unsigned ck[50]; unsigned R0[16];
        {
            int id = 0;
#pragma unroll
            for (int a = 0; a < 16; ++a) {
                const float va = unordf(T[0][a] & ~0x7Fu);
#pragma unroll
                for (int b = 0; b < 16; ++b) if ((a + 1) * (b + 1) <= 16) { ck[id] = (ordf(va + unordf(T[1][b] & ~0x7Fu)) & ~0x3Fu) | (unsigned)(63 - id); ++id; }
            }
        }
#pragma unroll
        for (int i = 0; i < 16; ++i) R0[i] = ck[i];
        {
            int base = 16;
#pragma unroll
            for (int a = 1; a < 8; ++a) { const int n = 16 / (a + 1); unsigned rw[16];
#pragma unroll
                for (int i = 0; i < 16; ++i) rw[i] = i < n ? ck[base + i] : 0u;
                merge_top16(R0, rw); base += n; }
            unsigned rw[16];
#pragma unroll
            for (int i = 0; i < 16; ++i) rw[i] = i < 8 ? ck[base + i] : 0u;
            merge_top16(R0, rw);
        }
        const unsigned thr = R0[15]; const float mx = unordf(R0[0] & ~0x3Fu);
        float sum = 0.f;
#pragma unroll
        for (int c = 0; c < 50; ++c) sum += ck[c] >= thr ? __expf(unordf(ck[c] & ~0x3Fu) - mx) : 0.f;
        const float rsum = 1.f / sum;
        int* oi = SELI + ((size_t)row * 8 + h) * 16; float* og = SELG + ((size_t)row * 8 + h) * 16;
        {
            int id = 0, cnt = 0;
#pragma unroll
            for (int a = 0; a < 16; ++a)
#pragma unroll
                for (int b = 0; b < 16; ++b) if ((a + 1) * (b + 1) <= 16) {
                    if (ck[id] >= thr) { if (fq == 0 && cnt < 16) { oi[cnt] = (127 - (int)(T[0][a] & 0x7Fu)) * 128 + (127 - (int)(T[1][b] & 0x7Fu)); og[cnt] = __expf(unordf(ck[id] & ~0x3Fu) - mx) * rsum; } ++cnt; }
                    ++id; }
        }
    }
}

struct R16 { float v[16]; };
__device__ __forceinline__ R16 load_r16_f32(const float* p, int lane) { R16 r;
#pragma unroll
    for (int k = 0; k < 4; ++k) { const f32x4 a = *(const f32x4*)(p + 16 * lane + 4 * k); r.v[4 * k] = a.x; r.v[4 * k + 1] = a.y; r.v[4 * k + 2] = a.z; r.v[4 * k + 3] = a.w; }
    return r; }
__device__ __forceinline__ void store_r16_f32(float* p, int lane, const R16& r) {
#pragma unroll
    for (int k = 0; k < 4; ++k) *(f32x4*)(p + 16 * lane + 4 * k) = (f32x4){r.v[4 * k], r.v[4 * k + 1], r.v[4 * k + 2], r.v[4 * k + 3]}; }
__device__ __forceinline__ R16 load_r16_bf16(const bf16_t* p, int lane) { R16 r;
#pragma unroll
    for (int k = 0; k < 2; ++k) { const u32x4 a = *(const u32x4*)(p + 16 * lane + 8 * k);
        r.v[8 * k] = bflo(a.x); r.v[8 * k + 1] = bfhi(a.x); r.v[8 * k + 2] = bflo(a.y); r.v[8 * k + 3] = bfhi(a.y); r.v[8 * k + 4] = bflo(a.z); r.v[8 * k + 5] = bfhi(a.z); r.v[8 * k + 6] = bflo(a.w); r.v[8 * k + 7] = bfhi(a.w); }
    return r; }
__device__ __forceinline__ void store_r16_bf16(bf16_t* p, int lane, const R16& r) {
#pragma unroll
    for (int k = 0; k < 2; ++k) { u32x4 a; a.x = pk2(r.v[8 * k], r.v[8 * k + 1]); a.y = pk2(r.v[8 * k + 2], r.v[8 * k + 3]); a.z = pk2(r.v[8 * k + 4], r.v[8 * k + 5]); a.w = pk2(r.v[8 * k + 6], r.v[8 * k + 7]);
        *(u32x4*)(p + 16 * lane + 8 * k) = a; } }
typedef float f32x2p __attribute__((ext_vector_type(2)));
struct PeerHdr { int idx0, idx1; float su0, su1, gsv0, gsv1; };
__device__ __forceinline__ void ph_peer(const Ctx& C, int layer, int nrows, bool last, bool store = true, int idmask = 0x3FFF) {
    const bf16_t* F = (const bf16_t*)(C.ws + WS_ACT); bf16_t* XN = (bf16_t*)(C.ws + WS_ACT);
    const unsigned char* UB = C.ws + WS_UB; const unsigned char* VB = C.ws + WS_VB; const float* SU = (const float*)(C.ws + WS_SU); const float* SV = (const float*)(C.ws + WS_SV);
    const int* SELI = (const int*)(C.ws + WS_SELI); const float* SELG = (const float*)(C.ws + WS_SELG);
    float* H = (float*)(C.ws + WS_H); const float* MOD = (const float*)(C.ws + WS_MOD);
    const int step = C.G * 8;
    auto load_hdr = [&](int tok, int L) { PeerHdr h; h.idx0 = SELI[(size_t)tok * 128 + L] & idmask; h.idx1 = SELI[(size_t)tok * 128 + 64 + L] & idmask;
        h.su0 = SU[h.idx0]; h.su1 = SU[h.idx1]; h.gsv0 = SELG[(size_t)tok * 128 + L] * SV[h.idx0]; h.gsv1 = SELG[(size_t)tok * 128 + 64 + L] * SV[h.idx1]; return h; };
    int tok = C.bid * 8 + C.wid;
    for (; tok < nrows; tok += step) {
        int L = C.lane; asm volatile("" : "+v"(L));
        const int myexp = ((L >> 5) & 1) * 4 + ((L >> 4) & 1) * 2 + ((L >> 3) & 1);
        const PeerHdr hd = load_hdr(tok, L);
        const u32x4 fpa = *(const u32x4*)(F + (size_t)tok * DM + 16 * L), fpb = *(const u32x4*)(F + (size_t)tok * DM + 16 * L + 8);
        f32x2p out[8];
#pragma unroll
        for (int i = 0; i < 8; ++i) out[i] = (f32x2p){0.f, 0.f};
        u32x4 ua[2][8], va[2][8];
#define PEER_LOAD(buf, bt) do { const int src_ = (bt) < 8 ? hd.idx0 : hd.idx1; const int l0_ = ((bt) & 7) * 8; _Pragma("unroll") for (int i = 0; i < 8; ++i) { const int ei = __builtin_amdgcn_readlane(src_, l0_ + i); \
            ua[buf][i] = *(const u32x4*)(UB + (size_t)ei * DM + 16 * L); va[buf][i] = *(const u32x4*)(VB + (size_t)ei * DM + 16 * L); } } while (0)
#define PEER_COMPUTE(buf, bt) do { const float susrc = (bt) < 8 ? hd.su0 : hd.su1, gsrc = (bt) < 8 ? hd.gsv0 : hd.gsv1; const int l0 = ((bt) & 7) * 8; float part[8]; \
            _Pragma("unroll") for (int i = 0; i < 8; ++i) { f32x2p acc = {0.f, 0.f}; _Pragma("unroll") for (int k = 0; k < 4; ++k) { \
                const f32x2p lo = __builtin_amdgcn_cvt_pk_f32_fp8((int)ua[buf][i][k], false), hi = __builtin_amdgcn_cvt_pk_f32_fp8((int)ua[buf][i][k], true); \
                const unsigned fw0 = (k < 2 ? fpa : fpb)[(2 * k) & 3], fw1 = (k < 2 ? fpa : fpb)[(2 * k + 1) & 3]; \
                acc += lo * (f32x2p){bflo(fw0), bfhi(fw0)}; acc += hi * (f32x2p){bflo(fw1), bfhi(fw1)}; } part[i] = acc.x + acc.y; } \
            float p4[4], p2[2], p1; \
            { const bool hi = (L & 32) != 0; _Pragma("unroll") for (int i = 0; i < 4; ++i) { const float send = hi ? part[i] : part[i + 4]; const float recv = __shfl_xor(send, 32); p4[i] = (hi ? part[i + 4] : part[i]) + recv; } } \
            { const bool hi = (L & 16) != 0; _Pragma("unroll") for (int i = 0; i < 2; ++i) { const float send = hi ? p4[i] : p4[i + 2]; const float recv = __shfl_xor(send, 16); p2[i] = (hi ? p4[i + 2] : p4[i]) + recv; } } \
            { const bool hi = (L & 8) != 0; const float send = hi ? p2[0] : p2[1]; const float recv = __shfl_xor(send, 8); p1 = (hi ? p2[1] : p2[0]) + recv; } \
            p1 += __shfl_xor(p1, 4); p1 += __shfl_xor(p1, 2); p1 += __shfl_xor(p1, 1); \
            const float act = gelu_tanh(p1 * __shfl(susrc, l0 + myexp)) * __shfl(gsrc, l0 + myexp); \
            _Pragma("unroll") for (int i = 0; i < 8; ++i) { \
                const float a = __uint_as_float((unsigned)__builtin_amdgcn_readlane((int)__float_as_uint(act), ((i >> 2) & 1) * 32 + ((i >> 1) & 1) * 16 + (i & 1) * 8)); const f32x2p a2 = {a, a}; \
                _Pragma("unroll") for (int k = 0; k < 4; ++k) { out[2 * k] += a2 * __builtin_amdgcn_cvt_pk_f32_fp8((int)va[buf][i][k], false); out[2 * k + 1] += a2 * __builtin_amdgcn_cvt_pk_f32_fp8((int)va[buf][i][k], true); } } } while (0)
        PEER_LOAD(0, 0);
        for (int bt = 0; bt < 16; bt += 2) {
            PEER_LOAD(1, bt + 1);
            PEER_COMPUTE(0, bt);
            if (bt + 2 < 16) PEER_LOAD(0, bt + 2);
            PEER_COMPUTE(1, bt + 1);
        }
#undef PEER_LOAD
#undef PEER_COMPUTE
        const float* m = MOD + ((size_t)layer * 3 + which_of(tok)) * 6144;
        R16 hr = load_r16_f32(H + (size_t)tok * DM, L); const R16 g5 = load_r16_f32(m + 5 * 1024, L);
#pragma unroll
        for (int i = 0; i < 8; ++i) { hr.v[2 * i] += g5.v[2 * i] * out[i].x; hr.v[2 * i + 1] += g5.v[2 * i + 1] * out[i].y; }
        float ss = 0.f;
#pragma unroll
        for (int i = 0; i < 16; ++i) ss += hr.v[i] * hr.v[i];
        const float rs = rsqrtf(wave_sum(ss) * (1.f / 1024.f) + 1e-6f);
        if (!store) continue;
        if (!last) {
            store_r16_f32(H + (size_t)tok * DM, L, hr);
            const float* m2 = MOD + ((size_t)(layer + 1) * 3 + which_of(tok)) * 6144;
            const R16 gg = load_r16_f32(C.in[6] + (layer + 1) * 1024, L), sh = load_r16_f32(m2, L), sc = load_r16_f32(m2 + 1024, L); R16 o;
#pragma unroll
            for (int i = 0; i < 16; ++i) o.v[i] = (hr.v[i] * rs * gg.v[i]) * (1.f + sc.v[i]) + sh.v[i];
            store_r16_bf16(XN + (size_t)tok * DM, L, o);
        } else {
            const R16 fg = load_r16_f32(C.in[41], L); R16 o;
#pragma unroll
            for (int i = 0; i < 16; ++i) o.v[i] = hr.v[i] * rs * fg.v[i];
            store_r16_f32(C.out + (size_t)tok * DM, L, o);
        }
    }
}

#define PM(n) ((MASK >> (n)) & 1u)
constexpr int NPH_LAYER = 9, NPH = 2 + 2 * NPH_LAYER;
template <unsigned MASK> __global__ void __launch_bounds__(512, 2) hybrid_fwd(Args args) {
    extern __shared__ __attribute__((aligned(16))) unsigned char lds_raw[];
    Ctx C0; C0.in = args.in; C0.out = args.out; C0.ws = args.ws; C0.lds = (lds_t)lds_raw;
    C0.wid = __builtin_amdgcn_readfirstlane((int)threadIdx.x >> 6); C0.tid = 0; C0.lane = 0; C0.bid = blockIdx.x; C0.G = gridDim.x;
#define MK_LANE() ((int)__builtin_amdgcn_mbcnt_hi(~0u, __builtin_amdgcn_mbcnt_lo(~0u, 0u)))
#define MK_TID() (C0.wid * 64 + MK_LANE())
    const Ctx& C = C0;
    const int lo = args.ph_lo, hi = args.ph_hi;
    const bool multi = (hi - lo) > 1;
    XcdBarrier bar; bar.w0 = (unsigned)C0.wid; bar.bar = (unsigned*)(C.ws + WS_CTL); bar.x = 0; bar.st = (volatile LAS unsigned*)(C.lds + LDS_XB);
    if (multi) {
        if (C0.wid == 0 && MK_LANE() == 0) *(LAS u32x4*)(C.lds + LDS_XB) = (u32x4){0u, 0u, 0u, 0u};
        __syncthreads();
        bar = xcd_barrier_post((unsigned*)(C.ws + WS_CTL), (volatile LAS unsigned*)(C.lds + LDS_XB), (unsigned)C0.wid);
    }
#define IN(k) (lo <= (k) && (k) < hi)
#define PHASE_CTX(c) Ctx c = C0; { int t_ = MK_TID(); asm volatile("" : "+v"(t_)); c.tid = t_; c.lane = t_ & 63; c.wid = __builtin_amdgcn_readfirstlane(t_ >> 6); }
#ifndef MK_REPEAT
#define MK_REPEAT 0u
#endif
#define RP(k) ((MK_REPEAT >> (k)) & 1u)
#define STAMP(k) do {} while (0)
#define SEAM(k) do { if (IN(k) && IN((k) + 1)) xcd_barrier(bar); STAMP((k) + 1); } while (0)
    STAMP(0);
    if (RP(10)) { for (int i = 0; i < 20; ++i) xcd_barrier(bar); }
    if (PM(0) && IN(0)) { PHASE_CTX(c); ph_prologue(c); if (RP(9)) { xcd_barrier(bar); ph_prologue(c); } } SEAM(0);
    if (PM(1) && IN(1)) { PHASE_CTX(c); ph_norm(c, 0, c.in[6], 0, NROW); } SEAM(1);
    for (int layer = 0; layer < 2; ++layer) {
        const int base = 2 + layer * NPH_LAYER;
        const bool emit = (layer == 0);
        const int nrows = emit ? NROW : NLAT;
        if (PM(2) && IN(base + 0)) {
            pg8::Gemm g{(const bf16_t*)(C.ws + WS_ACT), (const bf16_t*)(C.ws + WS_WIN) + (size_t)layer * NP * DM, NROW, NP, DM};
            pg8::StaticOrder S; S.init(NROW, NP, C.G, C.bid);
            pg8::EpiBf16<0> E{(bf16_t*)(C.ws + WS_P), NP, nullptr, 0, 0};
            pg8::gemm_phase<pg8::EpiBf16<0>, pg8::StaticOrder, false>(C.lds, g, S, E, nullptr, MK_TID());
            if (RP(0)) { xcd_barrier(bar); pg8::gemm_phase<pg8::EpiBf16<0>, pg8::StaticOrder, false>(C.lds, g, S, E, nullptr, MK_TID()); }
            { const int nfull = (NROW / 256) * (NP / 256) - ((NROW / 256) * (NP / 256) / C.G) * C.G; PHASE_CTX(c); if (c.bid >= nfull) convert_tables(c, layer, c.bid - nfull, c.G - nfull); }
        }
        SEAM(base + 0);
        if (PM(3) && IN(base + 1)) {
            const int nD = 2112, nC = 264, nB = emit ? 132 : 128, nA = emit ? 264 : 256, tot = nD + nC + nB + nA;
            for (int rep = 0; rep < (RP(1) ? 2 : 1); ++rep) {
            if (rep) xcd_barrier(bar);
            if (PM(11)) { PHASE_CTX(c); D1Pre pre; pre.hd = -1; for (int it = c.bid; it < nD; it += c.G) item_rwkv_local(c, layer, it, pre, it + c.G < nD ? it + c.G : -1); }
            if (PM(12)) { PHASE_CTX(c); for (int it = (c.bid + 52) % c.G; it < nC; it += c.G) { item_mamba_local(c, layer, it); if (RP(13)) item_mamba_local(c, layer, it); } }
            if (PM(13)) { PHASE_CTX(c); for (int it = (c.bid + 192) % c.G; it < nB; it += c.G) { item_chunkmlp(c, layer, it); if (RP(14)) item_chunkmlp(c, layer, it); } }
            if (PM(14)) { PHASE_CTX(c); for (int it = (c.bid + 60) % c.G; it < nA; it += c.G) { item_conformer(c, layer, it); if (RP(15)) item_conformer(c, layer, it); } }
            }
        }
        SEAM(base + 1);
        if (PM(4) && IN(base + 2)) { PHASE_CTX(c); if (RP(12)) { ph_scan(c, 1, args.ph_hi > 1000, false); xcd_barrier(bar); } ph_scan(c, RP(2) ? 2 : 1); }
        SEAM(base + 2);
        if (PM(5) && IN(base + 3)) {
            const int nc = nrows / 64;
            for (int rep = 0; rep < (RP(3) ? 2 : 1); ++rep) {
            if (rep) xcd_barrier(bar);
            if (PM(15)) { PHASE_CTX(c); load_g2t(c, layer); for (int it = c.bid; it < nc; it += c.G) item_rwkv_out(c, layer, it); }
            __syncthreads();
            if (PM(16)) { PHASE_CTX(c); for (int it = (c.bid + 128) % c.G; it < nc; it += c.G) item_mamba_out(c, layer, it); }
            __syncthreads();
            }
        }
        SEAM(base + 3);
        if (PM(6) && IN(base + 4)) {
            pg8::Gemm g{(const bf16_t*)(C.ws + WS_ACT), (const bf16_t*)(C.ws + WS_WOUT) + (size_t)layer * DM * DM, NLAT, DM, DM};
            pg8::StaticOrder S; S.init(NLAT, DM, C.G, C.bid);
            EpiResid E{(float*)(C.ws + WS_H), (const float*)(C.ws + WS_MOD) + (size_t)layer * 3 * 6144};
            pg8::gemm_phase<EpiResid, pg8::StaticOrder, false>(C.lds, g, S, E, nullptr, MK_TID());
            if (emit) {
                PHASE_CTX(c);
                for (int u = c.bid; u < 256; u += c.G) { const int tr = u >> 4, tc = u & 15;
                    float* Hc = (float*)(c.ws + WS_H) + (size_t)(NLAT + tr * 32) * DM + tc * 64;
                    const float* gate = (const float*)(c.ws + WS_MOD) + ((size_t)layer * 3 + 2) * 6144 + 2 * 1024 + tc * 64;
                    small_gemm_tile<2, 4>(c, (const bf16_t*)(c.ws + WS_ACT) + (size_t)(NLAT + tr * 32) * DM, (const bf16_t*)(c.ws + WS_WOUT) + (size_t)layer * DM * DM + (size_t)(tc * 64) * DM, DM,
                        [=](int r, int cc, const f32x4& acc) {
#pragma unroll
                            for (int j = 0; j < 4; ++j) Hc[(size_t)(r + j) * DM + cc] += gate[cc] * acc[j]; });
                }
            }
        }
        SEAM(base + 4);
        if (PM(7) && IN(base + 5)) { PHASE_CTX(c); for (int rep = 0; rep < (RP(5) ? 2 : 1); ++rep) { if (rep) xcd_barrier(bar); ph_norm(c, layer, c.in[7] + layer * 1024, 3, nrows); } }
        SEAM(base + 5);
        if (PM(8) && IN(base + 6)) {
            pg8::Gemm g{(const bf16_t*)(C.ws + WS_ACT), (const bf16_t*)(C.ws + WS_WQ) + (size_t)layer * 2048 * DM, NLAT, 2048, DM};
            pg8::StaticOrder S; S.init(NLAT, 2048, C.G, C.bid);
            pg8::EpiBf16<0> E{(bf16_t*)(C.ws + WS_Q), 2048, nullptr, 0, 0};
            pg8::gemm_phase<pg8::EpiBf16<0>, pg8::StaticOrder, false>(C.lds, g, S, E, nullptr, MK_TID());
            if (RP(6)) { xcd_barrier(bar); pg8::gemm_phase<pg8::EpiBf16<0>, pg8::StaticOrder, false>(C.lds, g, S, E, nullptr, MK_TID()); }
            if (emit) {
                PHASE_CTX(c);
                for (int u = c.bid; u < 256; u += c.G) { const int tr = u >> 5, tc = u & 31;
                    bf16_t* Qc = (bf16_t*)(c.ws + WS_Q) + (size_t)(NLAT + tr * 64) * 2048 + tc * 64;
                    small_gemm_tile<4, 4>(c, (const bf16_t*)(c.ws + WS_ACT) + (size_t)(NLAT + tr * 64) * DM, (const bf16_t*)(c.ws + WS_WQ) + (size_t)layer * 2048 * DM + (size_t)(tc * 64) * DM, DM,
                        [=](int r, int cc, const f32x4& acc) {
#pragma unroll
                            for (int j = 0; j < 4; ++j) Qc[(size_t)(r + j) * 2048 + cc] = f2bf(acc[j]); });
                }
            }
        }
        SEAM(base + 6);
        if (PM(9) && IN(base + 7)) { PHASE_CTX(c); ph_select(c, layer, nrows); if (RP(7)) { xcd_barrier(bar); ph_select(c, layer, nrows); } }
        SEAM(base + 7);
        if (PM(10) && IN(base + 8)) { PHASE_CTX(c); if (RP(8)) { ph_peer(c, layer, nrows, layer == 1, args.ph_hi > 1000); xcd_barrier(bar); } if (RP(11)) { ph_peer(c, layer, nrows, layer == 1, args.ph_hi > 1000, 1023); xcd_barrier(bar); } ph_peer(c, layer, nrows, layer == 1); }
        SEAM(base + 8);
    }
#undef IN
#undef SEAM
}
}


namespace mk {
struct LaunchEnt { unsigned mask; int ph; };
template <unsigned MASK> static bool prep_kernel() {
    return hipFuncSetAttribute((const void*)hybrid_fwd<MASK>, hipFuncAttributeMaxDynamicSharedMemorySize, LDS_BYTES) == hipSuccess;
}
template <unsigned MASK> static void launch_kernel(int grid, hipStream_t stream, const Args& a) {
    hipLaunchKernelGGL(hybrid_fwd<MASK>, dim3(grid), dim3(512), LDS_BYTES, stream, a);
}
}

#define CENSUS(off, n, kind, stage, lim) do {} while (0)
#ifndef MK_ONE_LAUNCH
#define MK_ONE_LAUNCH 1
#endif
extern "C" void kernel_launch(void* const* d_in, const int* in_sizes, int n_in, void* d_out, int out_size, void* d_ws, size_t ws_size, hipStream_t stream) {
    using namespace mk;
    static int grid = 0;
    if (grid == 0) {
        if (n_in != 42 || ws_size < WS_END) { fprintf(stderr, "kernel_launch: need 42 inputs and %zu bytes of workspace (got %d, %zu)\n", (size_t)WS_END, n_in, ws_size); grid = -1; return; }
        int dev = 0, cus = 0;
        if (hipGetDevice(&dev) != hipSuccess || hipDeviceGetAttribute(&cus, hipDeviceAttributeMultiprocessorCount, dev) != hipSuccess) { grid = -1; return; }
        bool ok = true;
#if MK_ONE_LAUNCH
        ok = ok && prep_kernel<0x1FFFFu>();
#else
        ok = ok && prep_kernel<0x0001u>() && prep_kernel<0x0002u>() && prep_kernel<0x0004u>() && prep_kernel<0x0808u>() && prep_kernel<0x1008u>() && prep_kernel<0x2008u>() && prep_kernel<0x4008u>()
                && prep_kernel<0x0010u>() && prep_kernel<0x8020u>() && prep_kernel<0x10020u>() && prep_kernel<0x0040u>() && prep_kernel<0x0080u>() && prep_kernel<0x0100u>() && prep_kernel<0x0200u>() && prep_kernel<0x0400u>();
#endif
        if (!ok) { fprintf(stderr, "kernel_launch: hipFuncSetAttribute failed\n"); grid = -1; return; }
        (void)hipGetLastError();
        grid = cus;
    }
    if (grid < 0) return;
    (void)hipMemsetAsync((char*)d_ws + WS_CTL, 0, 65536, stream);
    Args a{};
    for (int i = 0; i < 42; ++i) a.in[i] = (const float*)d_in[i];
    a.out = (float*)d_out; a.ws = (unsigned char*)d_ws;
#if MK_ONE_LAUNCH
    a.ph_lo = 0; a.ph_hi = NPH; launch_kernel<0x1FFFFu>(grid, stream, a);
#else
    a.ph_lo = 0; a.ph_hi = 1; launch_kernel<0x0001u>(grid, stream, a);
    CENSUS(WS_H, (size_t)NROW * DM, 0, 1, 1e4f); CENSUS(WS_MOD, 2 * 3 * 6144, 0, 1, 1e4f); CENSUS(WS_WIN, 2ull * NP * DM, 1, 1, 1e4f); CENSUS(WS_UB, 2ull * NEXP * DM, 1, 1, 1e4f);
    a.ph_lo = 1; a.ph_hi = 2; launch_kernel<0x0002u>(grid, stream, a);
    CENSUS(WS_ACT, (size_t)NROW * DM, 1, 2, 1e4f);
    for (int layer = 0; layer < 2; ++layer) {
        const int b = 2 + layer * NPH_LAYER;
        const int so = layer ? 100 : 0; (void)so;
        a.ph_lo = b + 0; a.ph_hi = b + 1; launch_kernel<0x0004u>(grid, stream, a);
        if (!layer) CENSUS(WS_P, (size_t)NROW * NP, 1, 3, 1e4f);
        a.ph_lo = b + 1; a.ph_hi = b + 2; launch_kernel<0x0808u>(grid, stream, a);
        if (!layer) { CENSUS(WS_RG, (size_t)NSLOT * 4096, 1, 4, 1e6f); CENSUS(WS_RJ, (size_t)NSLOT * 4096, 0, 5, 1e6f); CENSUS(WS_RY, (size_t)NSLOT * 4096 * 2, 1, 6, 1e6f); CENSUS(WS_BON, (size_t)NROW * 8, 0, 6, 1e6f); }
        launch_kernel<0x1008u>(grid, stream, a);
        if (!layer) { CENSUS(WS_MST, (size_t)NSLOT * 8192, 0, 7, 1e6f); CENSUS(WS_MCD, NSLOT, 0, 7, 1e6f); }
        launch_kernel<0x2008u>(grid, stream, a); launch_kernel<0x4008u>(grid, stream, a);
        a.ph_lo = b + 2; a.ph_hi = b + 3; launch_kernel<0x0010u>(grid, stream, a);
        if (!layer) { CENSUS(WS_MST, (size_t)NSLOT * 8192, 0, 8, 1e6f); CENSUS(WS_RH, (size_t)NSLOT * 4096, 1, 9, 1e6f); }
        a.ph_lo = b + 3; a.ph_hi = b + 4; launch_kernel<0x8020u>(grid, stream, a); launch_kernel<0x10020u>(grid, stream, a);
        if (!layer) CENSUS(WS_ACT, (size_t)NROW * DM, 1, 10, 1e4f);
        a.ph_lo = b + 4; a.ph_hi = b + 5; launch_kernel<0x0040u>(grid, stream, a);
        if (!layer) CENSUS(WS_H, (size_t)NROW * DM, 0, 11, 1e4f);
        a.ph_lo = b + 5; a.ph_hi = b + 6; launch_kernel<0x0080u>(grid, stream, a);
        a.ph_lo = b + 6; a.ph_hi = b + 7; launch_kernel<0x0100u>(grid, stream, a);
        if (!layer) CENSUS(WS_Q, (size_t)NROW * 2048, 1, 12, 1e4f);
        a.ph_lo = b + 7; a.ph_hi = b + 8; launch_kernel<0x0200u>(grid, stream, a);
        if (!layer) { CENSUS(WS_SELI, (size_t)NROW * 128, 2, 13, 0.f); CENSUS(WS_SELG, (size_t)NROW * 128, 0, 13, 2.f); }
        a.ph_lo = b + 8; a.ph_hi = b + 9; launch_kernel<0x0400u>(grid, stream, a);
        if (!layer) { CENSUS(WS_H, (size_t)NROW * DM, 0, 14, 1e4f); CENSUS(WS_ACT, (size_t)NROW * DM, 1, 15, 1e4f); }
    }
#endif
    (void)in_sizes; (void)out_size;
}
```

```cpp
#include <hip/hip_runtime.h>
#include <cstdio>
#include <cstdint>
namespace pg8 {
#define PG8_LAS __attribute__((address_space(3)))
typedef unsigned short bf16_t;
typedef short bf16x8 __attribute__((ext_vector_type(8)));
typedef float f32x4 __attribute__((ext_vector_type(4)));
typedef unsigned u32x4 __attribute__((ext_vector_type(4)));
constexpr int BM = 256, BK = 64, HALF = 128, HTB = HALF * BK * 2  , STAGE_BYTES = 8 * HTB, NXCD = 8, WGM = 8;

__host__ __device__ __forceinline__ int lds_byte(int r, int c) { const int st = (r >> 4) * 2 + (c >> 5), rr = r & 15, cc = c & 31, ob = rr * 64 + cc * 2; return st * 1024 + (ob ^ (((ob >> 9) & 1) << 5)); }
__host__ __device__ __forceinline__ void stage_rc(int b, int& R, int& C) { const int st = b / 1024, sb = b % 1024, swz = sb ^ (((sb >> 9) & 1) << 5); R = (st >> 1) * 16 + swz / 64; C = (st & 1) * 32 + (swz % 64) / 2; }
__host__ __device__ __forceinline__ int perm32(int rho) { const int n = rho >> 4, i = rho & 15; return 8 * (i >> 2) + 4 * n + (i & 3); }

struct Unit { int pm, pn; };
struct Gemm { const bf16_t* A; const bf16_t* Bt; int M, N, K; };

struct StaticOrder {
    int nM, nN, nwg, G, c;
    __host__ __device__ void init(int M, int N, int G_, int c_) { nM = M / BM; nN = N / BM; nwg = nM * nN; G = G_; c = c_; }
    __host__ __device__ bool next(int i, Unit& u) const {
        const long L = (long)i * G + c; if (L >= nwg) return false;
        int wgid = (int)L; { const int q = nwg / NXCD, r = nwg % NXCD, xcd = wgid % NXCD, off = wgid / NXCD; wgid = (xcd < r ? xcd * (q + 1) : r * (q + 1) + (xcd - r) * q) + off; }
        const int nig = WGM * nN, gid = wgid / nig, fm = gid * WGM, gsz = (nM - fm) < WGM ? (nM - fm) : WGM;
        u.pm = fm + ((wgid % nig) % gsz); u.pn = (wgid % nig) / gsz; return true;
    }
    __device__ __forceinline__ void a_ready(const Unit&) const {}
    __device__ __forceinline__ void done(const Unit&) const {}
};
struct CountedOrder : StaticOrder {
    const unsigned* ready; unsigned need; unsigned* tmo;
    __device__ __forceinline__ void a_ready(const Unit& u) const {
        if (threadIdx.x < 64) {
            const unsigned long long t0 = __builtin_amdgcn_s_memrealtime(); unsigned polls = 0;
            while ((unsigned)__builtin_amdgcn_readfirstlane(__hip_atomic_load(ready + 64 * u.pm, __ATOMIC_RELAXED, __HIP_MEMORY_SCOPE_AGENT)) < need) {
                if ((++polls & 255u) == 0u && __builtin_amdgcn_readfirstlane(__hip_atomic_load(tmo, __ATOMIC_RELAXED, __HIP_MEMORY_SCOPE_AGENT)) != 0u) break;
                if (__builtin_amdgcn_s_memrealtime() - t0 > 2000000ull) {
                    if (threadIdx.x == 0) { unsigned expect = 0u; __hip_atomic_compare_exchange_strong(tmo + 1, &expect, 0x600u | (unsigned)(u.pm & 0xff), __ATOMIC_RELAXED, __ATOMIC_RELAXED, __HIP_MEMORY_SCOPE_AGENT); __hip_atomic_store(tmo, 1u, __ATOMIC_RELAXED, __HIP_MEMORY_SCOPE_AGENT); }
                    break; }
                __builtin_amdgcn_s_sleep(2); }
            __builtin_amdgcn_fence(__ATOMIC_ACQUIRE, "agent");
            asm volatile("s_waitcnt vmcnt(0)" ::: "memory");
        }
#if !defined(BROKEN_HOOK_NO_BARRIER)
        asm volatile("" ::: "memory"); __builtin_amdgcn_s_barrier(); asm volatile("" ::: "memory");
#endif
    }
};

__device__ __forceinline__ unsigned cvt_pk_bf16(float lo, float hi) { unsigned r; asm volatile("v_cvt_pk_bf16_f32 %0, %1, %2" : "=v"(r) : "v"(lo), "v"(hi)); return r; }
typedef float f32x2 __attribute__((ext_vector_type(2)));
__device__ __forceinline__ f32x2 gelu_pk(f32x2 v) {
    const f32x2 av = __builtin_elementwise_abs(v), d = av * 0.2316418882f + 1.0f;
    f32x2 t; t.x = __builtin_amdgcn_rcpf(d.x); t.y = __builtin_amdgcn_rcpf(d.y);
    f32x2 q = t * 0.5307027145f + (-0.7265760135f); q = q * t + 0.7107068705f; q = q * t + (-0.142248368f); q = q * t + 0.127414796f; q = q * t;
    const f32x2 s = (v * v) * (-0.72134752044f);
    f32x2 e; e.x = __builtin_amdgcn_exp2f(s.x); e.y = __builtin_amdgcn_exp2f(s.y);
    const f32x2 m = v * (q * e), r = v - m;
    f32x2 o; o.x = v.x < 0.f ? m.x : r.x; o.y = v.y < 0.f ? m.y : r.y; return o;
}

struct EpiF32 {
    static constexpr bool PERM = false, AFTER_DRAIN = false;
    float* C; int ldc; const float* bias;
    __device__ __forceinline__ void operator()(const f32x4 (&acc)[2][2][4][2], const Unit& u, int wr, int wc, int fr, int fq) const {
        const int row0 = u.pm * BM + wr * 64 + fr, col0 = u.pn * BM + wc * 32 + 4 * fq;
        f32x4 bv[2][2];
#pragma unroll
        for (int bj = 0; bj < 2; ++bj)
#pragma unroll
            for (int n = 0; n < 2; ++n) bv[bj][n] = bias ? *(const f32x4*)(bias + col0 + bj * HALF + n * 16) : (f32x4){0.f, 0.f, 0.f, 0.f};
#pragma unroll
        for (int ai = 0; ai < 2; ++ai)
#pragma unroll
            for (int m = 0; m < 4; ++m) { float* rowp = C + (size_t)(row0 + ai * HALF + m * 16) * ldc + col0;
#pragma unroll
                for (int bj = 0; bj < 2; ++bj)
#pragma unroll
                    for (int n = 0; n < 2; ++n) *(f32x4*)(rowp + bj * HALF + n * 16) = acc[ai][bj][m][n] + bv[bj][n]; }
    }
};
template <int ACT  > struct EpiBf16 {
    static constexpr bool PERM = true, AFTER_DRAIN = false;
    bf16_t* O; int ldc; const float* bias; int split_cols; size_t split_stride;
    __device__ __forceinline__ void operator()(const f32x4 (&acc)[2][2][4][2], const Unit& u, int wr, int wc, int fr, int fq) const {
        const int row0 = u.pm * BM + wr * 64 + fr; int colt = u.pn * BM; bf16_t* base = O;
        if (split_cols) { const int t = colt / split_cols; base += (size_t)t * split_stride; colt -= t * split_cols; }
        const int col0 = colt + wc * 32 + 8 * fq, bcol0 = u.pn * BM + wc * 32 + 8 * fq;
        f32x4 bv[2][2];
#pragma unroll
        for (int bj = 0; bj < 2; ++bj)
#pragma unroll
            for (int n = 0; n < 2; ++n) bv[bj][n] = bias ? *(const f32x4*)(bias + bcol0 + bj * HALF + 4 * n) : (f32x4){0.f, 0.f, 0.f, 0.f};
#pragma unroll
        for (int ai = 0; ai < 2; ++ai)
#pragma unroll
            for (int m = 0; m < 4; ++m) { bf16_t* rowp = base + (size_t)(row0 + ai * HALF + m * 16) * ldc + col0;
#pragma unroll
                for (int bj = 0; bj < 2; ++bj) { f32x4 v0 = acc[ai][bj][m][0] + bv[bj][0], v1 = acc[ai][bj][m][1] + bv[bj][1];
                    if (ACT == 1) { f32x2 a = gelu_pk((f32x2){v0[0], v0[1]}), b = gelu_pk((f32x2){v0[2], v0[3]}), c = gelu_pk((f32x2){v1[0], v1[1]}), d = gelu_pk((f32x2){v1[2], v1[3]});
                        v0 = (f32x4){a.x, a.y, b.x, b.y}; v1 = (f32x4){c.x, c.y, d.x, d.y}; }
                    if (ACT == 2) {
#pragma unroll
                        for (int j = 0; j < 4; ++j) { v0[j] = 0.5f * v0[j] * (1.0f + erff(v0[j] * 0.70710678f)); v1[j] = 0.5f * v1[j] * (1.0f + erff(v1[j] * 0.70710678f)); } }
                    u32x4 w; w.x = cvt_pk_bf16(v0[0], v0[1]); w.y = cvt_pk_bf16(v0[2], v0[3]); w.z = cvt_pk_bf16(v1[0], v1[1]); w.w = cvt_pk_bf16(v1[2], v1[3]);
                    *(u32x4*)(rowp + bj * HALF) = w; } }
    }
};
template <class Epi, class Sched, bool STAMP = false>
__device__ __forceinline__ void gemm_phase(PG8_LAS unsigned char* lds, const Gemm g, const Sched& S, const Epi& E, unsigned long long* stamps, int tid_in) {
    int tid_ = tid_in; asm volatile("" : "+v"(tid_));
    const int tid = tid_, wid = __builtin_amdgcn_readfirstlane(tid >> 6), lane = tid & 63, wr = wid >> 2, wc = wid & 3, fr = lane & 15, fq = lane >> 4;
    const int K = g.K, nt = K / BK;
    int ts_lo = 0, ts_hi = 0, nts = 0; const unsigned long long rt_entry = STAMP ? (unsigned long long)wall_clock64() : 0ull;
#define PG8_STAMP() do { if (STAMP && wid == 0 && nts < 64) { const unsigned long long _c = (unsigned long long)clock64(); \
        ts_lo = (lane == nts) ? (int)(unsigned)_c : ts_lo; ts_hi = (lane == nts) ? (int)(unsigned)(_c >> 32) : ts_hi; ++nts; } } while (0)
    PG8_STAMP();
    unsigned voffA[2], voffB[2];
#pragma unroll
    for (int i = 0; i < 2; ++i) { int R, C; stage_rc(tid * 16 + i * 8192, R, C); const int Rb = Epi::PERM ? ((R & ~31) + perm32(R & 31)) : R;
        voffA[i] = (unsigned)(R * K + C) * 2u; voffB[i] = (unsigned)(Rb * K + C) * 2u; }
    const size_t kstep = (size_t)(BK * 2);
    const size_t hstep = (size_t)HALF * K * 2;
    const size_t tstep = 2 * hstep;
    const unsigned ldsw = (unsigned)wid * 1024u;
    const int aoff = lds_byte(wr * 64 + fr, fq * 8), boff = lds_byte(wc * 32 + fr, fq * 8);
#define PG8_SA(b, h) (((b) * 2 + (h)) * HTB)
#define PG8_SB(b, h) ((4 + (b) * 2 + (h)) * HTB)
#define PG8_STAGE(bufoff, gbase, voff) do { _Pragma("unroll") for (int _i = 0; _i < 2; ++_i) \
        __builtin_amdgcn_global_load_lds((const unsigned*)((const char*)(gbase) + (voff)[_i]), (PG8_LAS unsigned*)(lds + (bufoff) + ldsw + _i * 8192), 16, 0, 0); } while (0)
#define PG8_LDA(dst, b, h) do { _Pragma("unroll") for (int m = 0; m < 4; ++m) _Pragma("unroll") for (int k = 0; k < 2; ++k) dst[m][k] = *(const PG8_LAS bf16x8*)(lds + PG8_SA(b, h) + aoff + m * 2048 + k * 1024); } while (0)
#define PG8_LDB(dst, b, h) do { _Pragma("unroll") for (int n = 0; n < 2; ++n) _Pragma("unroll") for (int k = 0; k < 2; ++k) dst[n][k] = *(const PG8_LAS bf16x8*)(lds + PG8_SB(b, h) + boff + n * 2048 + k * 1024); } while (0)
#define PG8_MMA(ai, bj, At, Bt) do { __builtin_amdgcn_s_setprio(1); _Pragma("unroll") for (int m = 0; m < 4; ++m) _Pragma("unroll") for (int n = 0; n < 2; ++n) _Pragma("unroll") for (int k = 0; k < 2; ++k) \
        acc[ai][bj][m][n] = __builtin_amdgcn_mfma_f32_16x16x32_bf16(Bt[n][k], At[m][k], acc[ai][bj][m][n], 0, 0, 0); __builtin_amdgcn_s_setprio(0); } while (0)
#define PG8_WAIT_V(n) asm volatile("s_waitcnt vmcnt(" #n ")" ::: "memory")
#define PG8_WAIT_L(n) asm volatile("s_waitcnt lgkmcnt(" #n ")" ::: "memory")
#define PG8_BAR __builtin_amdgcn_s_barrier()
#define PG8_SCHED __builtin_amdgcn_sched_barrier(0)
    Unit cur, nxt; int ui = 0;
    if (!S.next(0, cur)) return;
    f32x4 acc[2][2][4][2];
#pragma unroll
    for (int a = 0; a < 2; ++a)
#pragma unroll
        for (int b = 0; b < 2; ++b)
#pragma unroll
            for (int m = 0; m < 4; ++m)
#pragma unroll
                for (int n = 0; n < 2; ++n) acc[a][b][m][n] = (f32x4){0.f, 0.f, 0.f, 0.f};
    bf16x8 At[4][2], B0[2][2], B1[2][2];
    const char* cA = (const char*)g.A + (size_t)cur.pm * tstep; const char* cB = (const char*)g.Bt + (size_t)cur.pn * tstep;
    S.a_ready(cur);
    PG8_STAGE(PG8_SB(0, 0), cB, voffB); PG8_STAGE(PG8_SA(0, 0), cA, voffA); PG8_STAGE(PG8_SB(0, 1), cB + hstep, voffB); PG8_STAGE(PG8_SA(0, 1), cA + hstep, voffA);
    if (wr == 1) PG8_BAR;
    PG8_WAIT_V(4); PG8_BAR;
    PG8_STAGE(PG8_SB(1, 0), cB + kstep, voffB); PG8_STAGE(PG8_SA(1, 0), cA + kstep, voffA); PG8_STAGE(PG8_SB(1, 1), cB + hstep + kstep, voffB);
    PG8_WAIT_V(6); PG8_BAR;
    PG8_STAMP();
    for (;;) {
        const bool has_next = S.next(ui + 1, nxt);
        const char* nA = has_next ? (const char*)g.A + (size_t)nxt.pm * tstep : cA; const char* nB = has_next ? (const char*)g.Bt + (size_t)nxt.pn * tstep : cB;
        for (int t = 0; t < nt; t += 2) {
            const bool last = (t == nt - 2);
            const char* a1 = cA + (size_t)(t + 1) * kstep;
            const char* a2 = last ? nA : cA + (size_t)(t + 2) * kstep; const char* b2 = last ? nB : cB + (size_t)(t + 2) * kstep;
            const char* a3 = a2 + kstep; const char* b3 = b2 + kstep;
            if (last && has_next) S.a_ready(nxt);
            PG8_LDB(B0, 0, 0); PG8_SCHED; PG8_LDA(At, 0, 0); PG8_STAGE(PG8_SA(1, 1), a1 + hstep, voffA);
            PG8_WAIT_L(8); PG8_BAR; PG8_WAIT_L(0); PG8_MMA(0, 0, At, B0); PG8_BAR; PG8_SCHED;
            PG8_LDB(B1, 0, 1); PG8_STAGE(PG8_SB(0, 0), b2, voffB);
            PG8_BAR; PG8_WAIT_L(0); PG8_MMA(0, 1, At, B1); PG8_BAR;
            PG8_LDA(At, 0, 1); PG8_STAGE(PG8_SA(0, 0), a2, voffA);
            PG8_BAR; PG8_WAIT_L(0); PG8_MMA(1, 0, At, B0); PG8_BAR; PG8_SCHED;
            PG8_STAGE(PG8_SB(0, 1), b2 + hstep, voffB);
            PG8_WAIT_V(6); PG8_BAR; PG8_MMA(1, 1, At, B1); PG8_BAR;
            PG8_LDB(B0, 1, 0); PG8_SCHED; PG8_LDA(At, 1, 0); PG8_STAGE(PG8_SA(0, 1), a2 + hstep, voffA);
            PG8_WAIT_L(8); PG8_BAR; PG8_WAIT_L(0); PG8_MMA(0, 0, At, B0); PG8_BAR; PG8_SCHED;
            PG8_LDB(B1, 1, 1); PG8_STAGE(PG8_SB(1, 0), b3, voffB);
            PG8_BAR; PG8_WAIT_L(0); PG8_MMA(0, 1, At, B1); PG8_BAR;
            PG8_LDA(At, 1, 1); PG8_STAGE(PG8_SA(1, 0), a3, voffA);
            PG8_BAR; PG8_WAIT_L(0); PG8_MMA(1, 0, At, B0); PG8_BAR; PG8_SCHED;
            PG8_STAGE(PG8_SB(1, 1), b3 + hstep, voffB);
            PG8_WAIT_V(6); PG8_BAR; PG8_MMA(1, 1, At, B1); PG8_BAR;
        }
        PG8_STAMP();
        if constexpr (!Epi::AFTER_DRAIN) { E(acc, cur, wr, wc, fr, fq); S.done(cur); }
        PG8_STAMP();
        if (!has_next) break;
#pragma unroll
        for (int a = 0; a < 2; ++a)
#pragma unroll
            for (int b = 0; b < 2; ++b)
#pragma unroll
                for (int m = 0; m < 4; ++m)
#pragma unroll
                    for (int n = 0; n < 2; ++n) acc[a][b][m][n] = (f32x4){0.f, 0.f, 0.f, 0.f};
        cur = nxt; cA = nA; cB = nB; ++ui;
    }
    PG8_WAIT_V(0);
    if (wr == 0) PG8_BAR;
    PG8_BAR;
    if constexpr (Epi::AFTER_DRAIN) { E.fused(acc, cur, wr, wc, fr, fq, lds, wid, lane); S.done(cur); }
    PG8_STAMP();
    if (STAMP && wid == 0) { stamps[lane] = lane < nts ? (((unsigned long long)(unsigned)ts_hi << 32) | (unsigned)ts_lo) : 0ull;
        if (lane == 62) stamps[62] = rt_entry; if (lane == 63) stamps[63] = (unsigned long long)wall_clock64(); }
#undef PG8_STAMP
#undef PG8_SA
#undef PG8_SB
#undef PG8_STAGE
#undef PG8_LDA
#undef PG8_LDB
#undef PG8_MMA
#undef PG8_WAIT_V
#undef PG8_WAIT_L
#undef PG8_BAR
#undef PG8_SCHED
}
}
#define XB_TMO      128
#define XB_XCNT(j)  (256  + 64 * (j))
#define XB_XSUB(j)  (1280 + 64 * (j))
#define XB_XGEN(j)  (2304 + 64 * (j))
#define XB_TOP      3328
#define XB_TOPGEN   3392
#define XCD_BAR_WORDS 3456
#define XB_SPIN_CAP (1u << 18)
#define LAS __attribute__((address_space(3)))

__device__ __forceinline__ unsigned xb_ld(unsigned* p)              { return __hip_atomic_load(p, __ATOMIC_RELAXED, __HIP_MEMORY_SCOPE_AGENT); }
__device__ __forceinline__ unsigned xb_add(unsigned* p, unsigned v) { return __hip_atomic_fetch_add(p, v, __ATOMIC_RELAXED, __HIP_MEMORY_SCOPE_AGENT); }
__device__ __forceinline__ unsigned xb_xcc_id() { return (unsigned)__builtin_amdgcn_s_getreg((3 << 11) | 20) & 0xFu; }
#define XB_SPIN(cond, bar) do { unsigned _sp = 0; while (cond) { __builtin_amdgcn_s_sleep(1); \
    if ((++_sp & 255u) == 0u) { if (xb_ld(&(bar)[XB_TMO])) break; if (_sp > XB_SPIN_CAP) { atomicAdd(&(bar)[XB_TMO], 1u); break; } } } } while (0)

#define XB_LANE0() (__builtin_amdgcn_mbcnt_hi(~0u, __builtin_amdgcn_mbcnt_lo(~0u, 0u)) == 0u)
struct XcdBarrier {
    unsigned w0;
    unsigned* bar; unsigned x;
    volatile LAS unsigned* st;
};

__device__ __forceinline__ XcdBarrier xcd_barrier_post(unsigned* bar, volatile LAS unsigned* st, unsigned w0) {
    XcdBarrier b; b.w0 = w0; b.bar = bar; b.x = xb_xcc_id(); b.st = st;
    if (w0 == 0u && XB_LANE0()) (void)xb_add(&bar[XB_XCNT(b.x)], 1u);
    return b;
}
__device__ __forceinline__ void xcd_barrier_complete(unsigned* bar, unsigned x, unsigned& nloc, unsigned& nx) {
    const unsigned G = gridDim.x * gridDim.y * gridDim.z;
    unsigned sum, cnt, mine, sp = 0u;
    for (;;) {
        sum = 0u; cnt = 0u; mine = 0u;
#pragma unroll
        for (unsigned j = 0; j < 16; ++j) { const unsigned c = xb_ld(&bar[XB_XCNT(j)]); sum += c; cnt += (c > 0u) ? 1u : 0u; mine = (j == x) ? c : mine; }
        if (sum == G) break;
        __builtin_amdgcn_s_sleep(1);
        if ((++sp & 255u) == 0u) { if (xb_ld(&bar[XB_TMO])) break; if (sp > XB_SPIN_CAP) { atomicAdd(&bar[XB_TMO], 1u); break; } }
    }
    nloc = mine > 0u ? mine : 1u; nx = cnt > 0u ? cnt : 1u;
}

__device__ __forceinline__ void xcd_barrier(const XcdBarrier& b) {
    asm volatile("s_waitcnt vmcnt(0)" ::: "memory");
    __syncthreads();
    if (b.w0 == 0u && XB_LANE0()) {
        unsigned* bar = b.bar;
        __builtin_amdgcn_s_waitcnt(0);
        unsigned nloc = b.st[0], nx = b.st[1];
        if (nloc == 0u) { xcd_barrier_complete(bar, b.x, nloc, nx); b.st[0] = nloc; b.st[1] = nx; }
        const unsigned old = xb_add(&bar[XB_XSUB(b.x)], 1u);
        const unsigned gen = old / nloc;
        if (old + 1u == (gen + 1u) * nloc) {
            __builtin_amdgcn_fence(__ATOMIC_RELEASE, "agent");
            asm volatile("s_waitcnt vmcnt(0)" ::: "memory");
            const unsigned og = xb_add(&bar[XB_TOP], 1u);
            const unsigned tg = og / nx;
            if (og + 1u == (tg + 1u) * nx) xb_add(&bar[XB_TOPGEN], 1u);
            else XB_SPIN(xb_ld(&bar[XB_TOPGEN]) == tg, bar);
            __builtin_amdgcn_fence(__ATOMIC_ACQUIRE, "agent");
            xb_add(&bar[XB_XGEN(b.x)], 1u);
            asm volatile("s_waitcnt vmcnt(0)" ::: "memory");
        } else {
            XB_SPIN(xb_ld(&bar[XB_XGEN(b.x)]) == gen, bar);
            __builtin_amdgcn_fence(__ATOMIC_ACQUIRE, "agent");
            asm volatile("s_waitcnt vmcnt(0)" ::: "memory");
        }
    }
    __syncthreads();
}

namespace mk {
using pg8::bf16_t; using pg8::bf16x8; using pg8::f32x4; using pg8::u32x4;
typedef unsigned u32x2 __attribute__((ext_vector_type(2)));
typedef __bf16 bf16x2_t __attribute__((ext_vector_type(2)));
typedef LAS unsigned char* lds_t;

constexpr int DM = 1024, NLAT = 16384, NROW = 16896;
constexpr int OFF_B = 512, OFF_C = 1024, OFF_D = 2056, INC = 3208, NP = 3328;
constexpr int NCH = 132, NSLOT = 16 * NCH;
constexpr int NEXP = 16384;

constexpr size_t WS_CTL  = 0;
constexpr size_t WS_MOD  = 65536;
constexpr size_t WS_WIN  = WS_MOD + 147456;
constexpr size_t WS_WOUT = WS_WIN + 2ull * NP * DM * 2;
constexpr size_t WS_WQ   = WS_WOUT + 2ull * DM * DM * 2;
constexpr size_t WS_H    = WS_WQ + 2ull * 2048 * DM * 2;
constexpr size_t WS_ACT  = WS_H + (size_t)NROW * DM * 4;
constexpr size_t WS_UB   = WS_ACT + (size_t)NROW * DM * 2;
constexpr size_t WS_VB   = WS_UB + (size_t)NEXP * DM * 2;
constexpr size_t WS_SU   = WS_UB + (size_t)NEXP * DM;
constexpr size_t WS_SV   = WS_VB + (size_t)NEXP * DM;
constexpr size_t WS_P    = WS_VB + (size_t)NEXP * DM * 2;
constexpr size_t WS_Q    = WS_P;
constexpr size_t WS_SELI = WS_Q + (size_t)NROW * 2048 * 2;
constexpr size_t WS_SELG = WS_SELI + (size_t)NROW * 128 * 4;
constexpr size_t WS_MST  = WS_P + (size_t)NROW * NP * 2;
constexpr size_t WS_MCD  = WS_MST + (size_t)NSLOT * 8192 * 4;
constexpr size_t WS_RG   = WS_MCD + 16384;
constexpr size_t WS_RJ   = WS_RG + (size_t)NSLOT * 8192;
constexpr size_t WS_RY   = WS_RJ + (size_t)NSLOT * 16384;
constexpr size_t WS_RL   = WS_RY + (size_t)NSLOT * 8192;
constexpr size_t WS_RH   = WS_RL + (size_t)NSLOT * 8192;
constexpr size_t WS_BON  = WS_RH + (size_t)NSLOT * 8192;
constexpr size_t WS_END  = WS_BON + (size_t)NROW * 8 * 4;
static_assert(WS_SELG + (size_t)NROW * 128 * 4 <= WS_MST, "Q + selections must fit in P's region");

constexpr int LDS_BYTES = 157440;
constexpr int LDS_XB = 157184;

struct Args { const float* in[42]; float* out; unsigned char* ws; int ph_lo, ph_hi; };

struct Ctx {
    const float* const* in; float* out; unsigned char* ws; lds_t lds;
    int tid, lane, wid, bid, G;
};

__device__ __forceinline__ float bf2f(unsigned short x) { return __uint_as_float(((unsigned)x) << 16); }
__device__ __forceinline__ float bflo(unsigned w) { return __uint_as_float(w << 16); }
__device__ __forceinline__ float bfhi(unsigned w) { return __uint_as_float(w & 0xffff0000u); }
typedef __bf16 bf16pair_t __attribute__((ext_vector_type(2)));
__device__ __forceinline__ unsigned pk2(float lo, float hi) { const bf16pair_t v = {(__bf16)lo, (__bf16)hi}; return __builtin_bit_cast(unsigned, v); }
__device__ __forceinline__ unsigned short f2bf(float f) { return (unsigned short)(pk2(f, 0.f) & 0xffffu); }
#define dpp_f(old, src, ctrl, row_mask, bank_mask) __uint_as_float((unsigned)__builtin_amdgcn_update_dpp((int)__float_as_uint(old), (int)__float_as_uint(src), ctrl, row_mask, bank_mask, true))
__device__ __forceinline__ float wave_sum(float v) {
    v += dpp_f(0.f, v, 0xB1, 0xF, 0xF);
    v += dpp_f(0.f, v, 0x4E, 0xF, 0xF);
    v += dpp_f(0.f, v, 0x141, 0xF, 0xF);
    v += dpp_f(0.f, v, 0x140, 0xF, 0xF);
    v += dpp_f(0.f, v, 0x142, 0xA, 0xF);
    v += dpp_f(0.f, v, 0x143, 0xC, 0xF);
    return __uint_as_float((unsigned)__builtin_amdgcn_readlane((int)__float_as_uint(v), 63));
}
__device__ __forceinline__ float wave_incl_scan(float v, int lane) {
    (void)lane;
    float s = v + dpp_f(0.f, v, 0x111, 0xF, 0xF);
    s += dpp_f(0.f, v, 0x112, 0xF, 0xF);
    s += dpp_f(0.f, v, 0x113, 0xF, 0xF);
    s += dpp_f(0.f, s, 0x114, 0xF, 0xE);
    s += dpp_f(0.f, s, 0x118, 0xF, 0xC);
    s += dpp_f(0.f, s, 0x142, 0xA, 0xF);
    s += dpp_f(0.f, s, 0x143, 0xC, 0xF);
    return s;
}
__device__ __forceinline__ float fexp(float x) { return __expf(x); }
__device__ __forceinline__ float frcp(float x) { return __builtin_amdgcn_rcpf(x); }
__device__ __forceinline__ float sigm(float x) { return frcp(1.f + __expf(-x)); }
__device__ __forceinline__ float silu(float x) { return x * frcp(1.f + __expf(-x)); }
__device__ __forceinline__ float softplus(float x) { return fmaxf(x, 0.f) + __logf(1.f + __expf(-fabsf(x))); }
__device__ __forceinline__ float ftanh(float x) { const float e = __expf(-2.f * fabsf(x)); const float t = (1.f - e) * frcp(1.f + e); return x < 0.f ? -t : t; }
__device__ __forceinline__ float gelu_tanh(float x) { const float u = 0.7978845608028654f * (x + 0.044715f * x * x * x); return 0.5f * x * (1.f + ftanh(u)); }
__device__ __forceinline__ float dot2bf(unsigned a, unsigned b, float acc) { return __builtin_amdgcn_fdot2_f32_bf16(__builtin_bit_cast(bf16x2_t, a), __builtin_bit_cast(bf16x2_t, b), acc, false); }

struct ChunkInfo { int row0, lo, hi, b, tc, isctx; };
__device__ __forceinline__ ChunkInfo chunk_info(int gc) {
    ChunkInfo c; c.row0 = gc * 64;
    if (gc < 256) { c.b = gc >> 7; c.tc = gc & 127; c.isctx = 0; c.lo = c.b * 8192; c.hi = c.lo + 8192; }
    else { const int q = gc - 256; c.b = q >> 2; c.tc = q & 3; c.isctx = 1; c.lo = NLAT + c.b * 256; c.hi = c.lo + 256; }
    return c;
}
__device__ __forceinline__ int cpos_of(const ChunkInfo& c, int d) { return c.isctx ? (d ? 3 - c.tc : c.tc) : (d ? 4 + 127 - c.tc : 4 + c.tc); }
__device__ __forceinline__ int slot_of(int b, int h, int d, int cpos) { return ((b * 4 + h) * 2 + d) * NCH + cpos; }

template <int MT, int NT, int KS, class Epi>
__device__ __forceinline__ void blk_mma(const LAS bf16_t* A, int lda, const LAS bf16_t* Bt, int ldb, int wid, int lane, Epi epi) {
    const int fr = lane & 15, fq = lane >> 4;
    for (int tt = wid; tt < MT * NT; tt += 8) {
        const int tm = tt / NT, tn = tt % NT;
        f32x4 acc = {0.f, 0.f, 0.f, 0.f};
#pragma unroll
        for (int ks = 0; ks < KS; ++ks) {
            const bf16x8 a = *(const LAS bf16x8*)(A + (tm * 16 + fr) * lda + ks * 32 + fq * 8);
            const bf16x8 b = *(const LAS bf16x8*)(Bt + (tn * 16 + fr) * ldb + ks * 32 + fq * 8);
            acc = __builtin_amdgcn_mfma_f32_16x16x32_bf16(a, b, acc, 0, 0, 0);
        }
        epi(tm * 16 + fq * 4, tn * 16 + fr, acc);
    }
}
template <int MT, int NT, int KS, class Epi>
__device__ __forceinline__ void blk_mma2(const LAS bf16_t* A1, const LAS bf16_t* B1, const LAS bf16_t* A2, const LAS bf16_t* B2, int ld, int wid, int lane, Epi epi) {
    const int fr = lane & 15, fq = lane >> 4;
    for (int tt = wid; tt < MT * NT; tt += 8) {
        const int tm = tt / NT, tn = tt % NT;
        f32x4 acc1 = {0.f, 0.f, 0.f, 0.f}, acc2 = {0.f, 0.f, 0.f, 0.f};
#pragma unroll
        for (int ks = 0; ks < KS; ++ks) {
            const bf16x8 a1 = *(const LAS bf16x8*)(A1 + (tm * 16 + fr) * ld + ks * 32 + fq * 8);
            const bf16x8 b1 = *(const LAS bf16x8*)(B1 + (tn * 16 + fr) * ld + ks * 32 + fq * 8);
            acc1 = __builtin_amdgcn_mfma_f32_16x16x32_bf16(a1, b1, acc1, 0, 0, 0);
            const bf16x8 a2 = *(const LAS bf16x8*)(A2 + (tm * 16 + fr) * ld + ks * 32 + fq * 8);
            const bf16x8 b2 = *(const LAS bf16x8*)(B2 + (tn * 16 + fr) * ld + ks * 32 + fq * 8);
            acc2 = __builtin_amdgcn_mfma_f32_16x16x32_bf16(a2, b2, acc2, 0, 0, 0);
        }
        epi(tm * 16 + fq * 4, tn * 16 + fr, acc1, acc2);
    }
}


template <int MT, int NT, class Epi>
__device__ __forceinline__ void small_gemm_tile(const Ctx& C, const bf16_t* A, const bf16_t* Bt, int K, Epi epi) {
    constexpr int AR = MT * 16, BR = NT * 16, PITCH = 264, NA = AR * 32 / 512, NB = BR * 32 / 512;
    LAS bf16_t* As = (LAS bf16_t*)C.lds; LAS bf16_t* Bs = As + AR * PITCH;
    u32x4 ra[NA], rb[NB];
    auto fetch = [&](int k0) {
#pragma unroll
        for (int i = 0; i < NA; ++i) { const int e = C.tid + 512 * i; ra[i] = *(const u32x4*)(A + (size_t)(e >> 5) * K + k0 + (e & 31) * 8); }
#pragma unroll
        for (int i = 0; i < NB; ++i) { const int e = C.tid + 512 * i; rb[i] = *(const u32x4*)(Bt + (size_t)(e >> 5) * K + k0 + (e & 31) * 8); } };
    const int fr = C.lane & 15, fq = C.lane >> 4;
    constexpr int TPW = (MT * NT + 7) / 8;
    f32x4 acc[TPW];
#pragma unroll
    for (int i = 0; i < TPW; ++i) acc[i] = (f32x4){0.f, 0.f, 0.f, 0.f};
    fetch(0);
    for (int k0 = 0; k0 < K; k0 += 256) {
        __syncthreads();
#pragma unroll
        for (int i = 0; i < NA; ++i) { const int e = C.tid + 512 * i; *(LAS u32x4*)(As + (e >> 5) * PITCH + (e & 31) * 8) = ra[i]; }
#pragma unroll
        for (int i = 0; i < NB; ++i) { const int e = C.tid + 512 * i; *(LAS u32x4*)(Bs + (e >> 5) * PITCH + (e & 31) * 8) = rb[i]; }
        if (k0 + 256 < K) fetch(k0 + 256);
        __syncthreads();
#pragma unroll
        for (int i = 0; i < TPW; ++i) { const int tt = C.wid + 8 * i; if (tt < MT * NT) { const int tm = tt / NT, tn = tt % NT;
#pragma unroll
            for (int ks = 0; ks < 8; ++ks) acc[i] = __builtin_amdgcn_mfma_f32_16x16x32_bf16(*(const LAS bf16x8*)(As + (tm * 16 + fr) * PITCH + ks * 32 + fq * 8),
                                                                                           *(const LAS bf16x8*)(Bs + (tn * 16 + fr) * PITCH + ks * 32 + fq * 8), acc[i], 0, 0, 0); } }
    }
#pragma unroll
    for (int i = 0; i < TPW; ++i) { const int tt = C.wid + 8 * i; if (tt < MT * NT) epi((tt / NT) * 16 + fq * 4, (tt % NT) * 16 + fr, acc[i]); }
    __syncthreads();
}

__device__ __forceinline__ void transpose_item(const float* W, int K, int N, int nblk, bf16_t* WT, LAS float* scr, int item, int lane) {
    const int kb = item / nblk, nb = item % nblk, k0 = 64 * kb, n0 = 32 * nb;
    const int nn = n0 + (lane & 31);
#pragma unroll 8
    for (int i = 0; i < 32; ++i) { const int kk = 2 * i + (lane >> 5); scr[kk * 33 + (lane & 31)] = (nn < N) ? W[(size_t)(k0 + kk) * N + nn] : 0.f; }
    asm volatile("s_waitcnt lgkmcnt(0)" ::: "memory");
    const int c = lane & 7;
#pragma unroll
    for (int j = 0; j < 4; ++j) { const int n = (lane >> 3) + 8 * j; const LAS float* s = scr + (8 * c) * 33 + n;
        u32x4 o; o.x = pk2(s[0 * 33], s[1 * 33]); o.y = pk2(s[2 * 33], s[3 * 33]); o.z = pk2(s[4 * 33], s[5 * 33]); o.w = pk2(s[6 * 33], s[7 * 33]);
        *(u32x4*)(WT + (size_t)(n0 + n) * K + k0 + 8 * c) = o; }
    asm volatile("s_waitcnt lgkmcnt(0)" ::: "memory");
}
__device__ __forceinline__ float wave_maxf(float v) {
#pragma unroll
    for (int o = 1; o < 64; o <<= 1) v = fmaxf(v, __shfl_xor(v, o));
    return v;
}
__device__ __forceinline__ void convert_tables(const Ctx& C, int layer, int rank, int nrank) {
    const float* U = C.in[39] + (size_t)layer * NEXP * DM; const float* V = C.in[40] + (size_t)layer * NEXP * DM;
    unsigned char* UB = C.ws + WS_UB; unsigned char* VB = C.ws + WS_VB; float* SU = (float*)(C.ws + WS_SU); float* SV = (float*)(C.ws + WS_SV);
    for (int r4 = (rank * 8 + C.wid) * 2; r4 < 2 * NEXP; r4 += nrank * 8 * 2) {
        const bool isv = r4 >= NEXP; const int row0 = isv ? r4 - NEXP : r4;
        const float* src = (isv ? V : U) + (size_t)row0 * DM + 16 * C.lane;
        f32x4 x[2][4];
#pragma unroll
        for (int q = 0; q < 2; ++q)
#pragma unroll
            for (int k = 0; k < 4; ++k) x[q][k] = *(const f32x4*)(src + (size_t)q * DM + 4 * k);
#pragma unroll
        for (int q = 0; q < 2; ++q) {
            float m = 0.f;
#pragma unroll
            for (int k = 0; k < 4; ++k) m = fmaxf(fmaxf(m, fmaxf(fabsf(x[q][k].x), fabsf(x[q][k].y))), fmaxf(fabsf(x[q][k].z), fabsf(x[q][k].w)));
            m = wave_maxf(m);
            const float sc = m > 0.f ? 224.f / m : 1.f;
            u32x4 o;
#pragma unroll
            for (int k = 0; k < 4; ++k) { int w = __builtin_amdgcn_cvt_pk_fp8_f32(x[q][k].x * sc, x[q][k].y * sc, 0, false); w = __builtin_amdgcn_cvt_pk_fp8_f32(x[q][k].z * sc, x[q][k].w * sc, w, true); o[k] = (unsigned)w; }
            *(u32x4*)((isv ? VB : UB) + (size_t)(row0 + q) * DM + 16 * C.lane) = o;
            if (C.lane == 0) (isv ? SV : SU)[row0 + q] = m > 0.f ? m * (1.f / 224.f) : 1.f;
        }
    }
}
__device__ __forceinline__ void ph_prologue(const Ctx& C) {
    const int gw = C.bid * 8 + C.wid, NGW = C.G * 8;
    {
        LAS float* scr = (LAS float*)(C.lds + C.wid * 16384);
        bf16_t* WIN = (bf16_t*)(C.ws + WS_WIN); bf16_t* WOUT = (bf16_t*)(C.ws + WS_WOUT); bf16_t* WQ = (bf16_t*)(C.ws + WS_WQ);
        for (int it = gw; it < 6400; it += NGW) {
            const int layer = it / 3200; int r = it % 3200;
            if (r < 1664) { transpose_item(C.in[8] + (size_t)layer * DM * INC, DM, INC, 104, WIN + (size_t)layer * NP * DM, scr, r, C.lane); continue; } r -= 1664;
            if (r < 512) { transpose_item(C.in[9] + (size_t)layer * DM * DM, DM, DM, 32, WOUT + (size_t)layer * DM * DM, scr, r, C.lane); continue; } r -= 512;
            transpose_item(C.in[36] + (size_t)layer * DM * 2048, DM, 2048, 64, WQ + (size_t)layer * 2048 * DM, scr, r, C.lane);
        }
    }
    __syncthreads();
    {
        LAS float* sv = (LAS float*)C.lds;
        LAS float* red = (LAS float*)(C.lds + 12288);
        for (int i = C.tid; i < 3 * 1024; i += 512) { const int w = i >> 10, k = i & 1023; const float x = (w < 2) ? C.in[1][w * 1024 + k] : C.in[3][k]; sv[i] = silu(x); }
        __syncthreads();
        float* MOD = (float*)(C.ws + WS_MOD);
        for (int it = C.bid; it < 192; it += C.G) {
            const int layer = it / 96, col0 = (it % 96) * 64, col = C.tid & 63, kg = C.tid >> 6;
            const float* W = C.in[4] + (size_t)layer * DM * 6144 + col0 + col;
            float a0 = 0.f, a1 = 0.f, a2 = 0.f;
#pragma unroll 32
            for (int k = kg * 128; k < kg * 128 + 128; ++k) { const float w = W[(size_t)k * 6144]; a0 += sv[k] * w; a1 += sv[1024 + k] * w; a2 += sv[2048 + k] * w; }
            red[(kg * 3 + 0) * 64 + col] = a0; red[(kg * 3 + 1) * 64 + col] = a1; red[(kg * 3 + 2) * 64 + col] = a2;
            __syncthreads();
            if (C.tid < 192) { const int w = C.tid >> 6, c2 = C.tid & 63; float s = 0.f;
#pragma unroll
                for (int g = 0; g < 8; ++g) s += red[(g * 3 + w) * 64 + c2];
                MOD[((size_t)layer * 3 + w) * 6144 + col0 + c2] = s + C.in[5][layer * 6144 + col0 + c2]; }
            __syncthreads();
        }
    }
    {
        float* H = (float*)(C.ws + WS_H);
        const size_t n4 = (size_t)NROW * 256;
        for (size_t i = (size_t)C.bid * 512 + C.tid; i < n4; i += (size_t)C.G * 512) {
            const int row = (int)(i >> 8), c4 = (int)(i & 255) * 4;
            f32x4 v;
            if (row < NLAT) {
                v = *(const f32x4*)(C.in[0] + (size_t)row * DM + c4);
                const int t = row & 8191, quarter = c4 >> 8; const float pos = (quarter < 2) ? (float)(t >> 6) : (float)(t & 63);
                float e[4];
#pragma unroll
                for (int j = 0; j < 4; ++j) { const int jj = (c4 & 255) + j; const float fr = exp2f(-(float)jj * (13.287712379549449f / 256.f)); const float a = pos * fr; e[j] = (quarter & 1) ? cosf(a) : sinf(a); }
                v.x += e[0]; v.y += e[1]; v.z += e[2]; v.w += e[3];
            } else v = *(const f32x4*)(C.in[2] + (size_t)(row - NLAT) * DM + c4);
            *(f32x4*)(H + (size_t)row * DM + c4) = v;
        }
    }
}

struct Row16 { float v[16]; };
__device__ __forceinline__ Row16 load_row16(const float* p, int lane) {
    Row16 r; const f32x4 a = *(const f32x4*)(p + 8 * lane), b = *(const f32x4*)(p + 8 * lane + 4), c = *(const f32x4*)(p + 512 + 8 * lane), d = *(const f32x4*)(p + 512 + 8 * lane + 4);
    r.v[0] = a.x; r.v[1] = a.y; r.v[2] = a.z; r.v[3] = a.w; r.v[4] = b.x; r.v[5] = b.y; r.v[6] = b.z; r.v[7] = b.w;
    r.v[8] = c.x; r.v[9] = c.y; r.v[10] = c.z; r.v[11] = c.w; r.v[12] = d.x; r.v[13] = d.y; r.v[14] = d.z; r.v[15] = d.w; return r;
}
__device__ __forceinline__ void store_row16_f32(float* p, int lane, const Row16& r) {
    *(f32x4*)(p + 8 * lane) = (f32x4){r.v[0], r.v[1], r.v[2], r.v[3]}; *(f32x4*)(p + 8 * lane + 4) = (f32x4){r.v[4], r.v[5], r.v[6], r.v[7]};
    *(f32x4*)(p + 512 + 8 * lane) = (f32x4){r.v[8], r.v[9], r.v[10], r.v[11]}; *(f32x4*)(p + 512 + 8 * lane + 4) = (f32x4){r.v[12], r.v[13], r.v[14], r.v[15]};
}
__device__ __forceinline__ void store_row16_bf16(bf16_t* p, int lane, const Row16& r) {
    u32x4 a, b; a.x = pk2(r.v[0], r.v[1]); a.y = pk2(r.v[2], r.v[3]); a.z = pk2(r.v[4], r.v[5]); a.w = pk2(r.v[6], r.v[7]);
    b.x = pk2(r.v[8], r.v[9]); b.y = pk2(r.v[10], r.v[11]); b.z = pk2(r.v[12], r.v[13]); b.w = pk2(r.v[14], r.v[15]);
    *(u32x4*)(p + 8 * lane) = a; *(u32x4*)(p + 512 + 8 * lane) = b;
}
__device__ __forceinline__ Row16 norm_mod_row(const Row16& x, const float* g, const float* shift, const float* scale, int lane) {
    float ss = 0.f;
#pragma unroll
    for (int i = 0; i < 16; ++i) ss += x.v[i] * x.v[i];
    const float rs = rsqrtf(wave_sum(ss) * (1.f / 1024.f) + 1e-6f);
    const Row16 gg = load_row16(g, lane), sh = load_row16(shift, lane), sc = load_row16(scale, lane);
    Row16 o;
#pragma unroll
    for (int i = 0; i < 16; ++i) o.v[i] = (x.v[i] * rs * gg.v[i]) * (1.f + sc.v[i]) + sh.v[i];
    return o;
}
__device__ __forceinline__ int which_of(int row) { return row < 8192 ? 0 : (row < NLAT ? 1 : 2); }
__device__ __forceinline__ void ph_norm(const Ctx& C, int layer, const float* gain, int sidx, int nrows) {
    const float* H = (const float*)(C.ws + WS_H); bf16_t* ACT = (bf16_t*)(C.ws + WS_ACT); const float* MOD = (const float*)(C.ws + WS_MOD);
    for (int row = C.bid * 8 + C.wid; row < nrows; row += C.G * 8) {
        const float* m = MOD + ((size_t)layer * 3 + which_of(row)) * 6144;
        const Row16 x = load_row16(H + (size_t)row * DM, C.lane);
        const Row16 o = norm_mod_row(x, gain, m + sidx * 1024, m + (sidx + 1) * 1024, C.lane);
        store_row16_bf16(ACT + (size_t)row * DM, C.lane, o);
    }
}
struct EpiResid {
    static constexpr bool PERM = false, AFTER_DRAIN = false;
    float* H; const float* modl;
    __device__ __forceinline__ void operator()(const f32x4 (&acc)[2][2][4][2], const pg8::Unit& u, int wr, int wc, int fr, int fq) const {
        const int row0 = u.pm * 256 + wr * 64 + fr, col0 = u.pn * 256 + wc * 32 + 4 * fq;
        const int which = u.pm < 32 ? 0 : (u.pm < 64 ? 1 : 2);
        const float* gate = modl + ((size_t)which * 6 + 2) * 1024;
        f32x4 gv[2][2];
#pragma unroll
        for (int bj = 0; bj < 2; ++bj)
#pragma unroll
            for (int n = 0; n < 2; ++n) gv[bj][n] = *(const f32x4*)(gate + col0 + bj * 128 + n * 16);
#pragma unroll
        for (int ai = 0; ai < 2; ++ai)
#pragma unroll
            for (int m = 0; m < 4; ++m) { float* rowp = H + (size_t)(row0 + ai * 128 + m * 16) * DM + col0;
#pragma unroll
                for (int bj = 0; bj < 2; ++bj)
#pragma unroll
                    for (int n = 0; n < 2; ++n) { f32x4* p = (f32x4*)(rowp + bj * 128 + n * 16); *p = *p + gv[bj][n] * acc[ai][bj][m][n]; } }
    }
};

__device__ __forceinline__ void item_conformer(const Ctx& C, int layer, int gc) {
    const ChunkInfo ci = chunk_info(gc);
    const bf16_t* P = (const bf16_t*)(C.ws + WS_P); bf16_t* YC = (bf16_t*)(C.ws + WS_ACT);
    LAS bf16_t* HG = (LAS bf16_t*)C.lds;
    LAS float* CO = (LAS float*)(C.lds + 49152);
    for (int e = C.tid; e < 94 * 128; e += 512) {
        const int rr = e >> 7, cp = e & 127, grow = ci.row0 - 15 + rr;
        const bool ok = grow >= ci.lo && grow < ci.hi; const int gr = ok ? grow : ci.row0;
        const unsigned v = *(const unsigned*)(P + (size_t)gr * NP + 2 * cp), g = *(const unsigned*)(P + (size_t)gr * NP + 256 + 2 * cp);
        const unsigned o = pk2(bflo(v) * sigm(bflo(g)), bfhi(v) * sigm(bfhi(g)));
        *(LAS unsigned*)(HG + rr * 256 + 2 * cp) = ok ? o : 0u;
    }
    __syncthreads();
    {
        const int c = C.tid & 255, half = C.tid >> 8;
        const float* cw = C.in[10] + (size_t)layer * 31 * 256 + c;
        float w[31];
#pragma unroll
        for (int j = 0; j < 31; ++j) w[j] = cw[j * 256];
        const float bias = C.in[11][layer * 256 + c];
        float hv[62];
#pragma unroll
        for (int i = 0; i < 62; ++i) hv[i] = bf2f(HG[(half * 32 + i) * 256 + c]);
#pragma unroll
        for (int tt = 0; tt < 32; ++tt) { float acc = bias;
#pragma unroll
            for (int j = 0; j < 31; ++j) acc += w[j] * hv[tt + j];
            CO[(half * 32 + tt) * 256 + c] = acc; }
    }
    __syncthreads();
    {
        const float* lg = C.in[12] + layer * 256 + 4 * C.lane; const float* lb = C.in[13] + layer * 256 + 4 * C.lane;
        const f32x4 g4 = *(const f32x4*)lg, b4 = *(const f32x4*)lb;
        for (int i = 0; i < 8; ++i) {
            const int t = C.wid * 8 + i;
            const f32x4 x = *(const LAS f32x4*)(CO + t * 256 + 4 * C.lane);
            const float mean = wave_sum((x.x + x.y) + (x.z + x.w)) * (1.f / 256.f);
            const f32x4 d = x - mean;
            const float var = wave_sum((d.x * d.x + d.y * d.y) + (d.z * d.z + d.w * d.w)) * (1.f / 256.f);
            const float rs = rsqrtf(var + 1e-5f);
            const f32x4 y = d * rs * g4 + b4;
            u32x2 o; o.x = pk2(silu(y.x), silu(y.y)); o.y = pk2(silu(y.z), silu(y.w));
            *(u32x2*)(YC + (size_t)(ci.row0 + t) * DM + 4 * C.lane) = o;
        }
    }
    __syncthreads();
}

__device__ __forceinline__ void item_chunkmlp(const Ctx& C, int layer, int gb) {
    const int row0 = gb * 128;
    const bf16_t* P = (const bf16_t*)(C.ws + WS_P); bf16_t* YC = (bf16_t*)(C.ws + WS_ACT);
    LAS bf16_t* VNT = (LAS bf16_t*)C.lds;
    LAS bf16_t* WS = (LAS bf16_t*)(C.lds + 69632);
    {
        const f32x4 g4 = *(const f32x4*)(C.in[14] + layer * 256 + 4 * C.lane), b4 = *(const f32x4*)(C.in[15] + layer * 256 + 4 * C.lane);
        for (int i = 0; i < 16; ++i) {
            const int j = C.wid * 16 + i;
            const u32x2 raw = *(const u32x2*)(P + (size_t)(row0 + j) * NP + 768 + 4 * C.lane);
            const f32x4 x = {bflo(raw.x), bfhi(raw.x), bflo(raw.y), bfhi(raw.y)};
            const float mean = wave_sum((x.x + x.y) + (x.z + x.w)) * (1.f / 256.f);
            const f32x4 d = x - mean;
            const float var = wave_sum((d.x * d.x + d.y * d.y) + (d.z * d.z + d.w * d.w)) * (1.f / 256.f);
            const f32x4 y = d * rsqrtf(var + 1e-5f) * g4 + b4;
            VNT[(4 * C.lane + 0) * 136 + j] = f2bf(y.x); VNT[(4 * C.lane + 1) * 136 + j] = f2bf(y.y);
            VNT[(4 * C.lane + 2) * 136 + j] = f2bf(y.z); VNT[(4 * C.lane + 3) * 136 + j] = f2bf(y.w);
        }
    }
    for (int h = 0; h < 4; ++h) {
        const float* ws = C.in[16] + ((size_t)layer * 4 + h) * 128 * 128;
        for (int e = C.tid; e < 4096; e += 512) { const int i = e >> 5, j4 = (e & 31) * 4; const f32x4 w = *(const f32x4*)(ws + i * 128 + j4);
            u32x2 o; o.x = pk2(w.x, w.y); o.y = pk2(w.z, w.w); *(LAS u32x2*)(WS + i * 136 + j4) = o; }
        __syncthreads();
        const float* bs = C.in[17] + ((size_t)layer * 4 + h) * 128;
        {
            const int fr = C.lane & 15, fq = C.lane >> 4;
            unsigned short ur[4][4];
#pragma unroll
            for (int i = 0; i < 4; ++i) { const int tt = C.wid + 8 * i, tm = tt >> 2, tn = tt & 3;
#pragma unroll
                for (int jj = 0; jj < 4; ++jj) ur[i][jj] = P[(size_t)(row0 + tm * 16 + fq * 4 + jj) * NP + 512 + h * 64 + tn * 16 + fr]; }
#pragma unroll
            for (int i = 0; i < 4; ++i) { const int tt = C.wid + 8 * i, tm = tt >> 2, tn = tt & 3;
                f32x4 acc = {0.f, 0.f, 0.f, 0.f};
#pragma unroll
                for (int ks = 0; ks < 4; ++ks) acc = __builtin_amdgcn_mfma_f32_16x16x32_bf16(*(const LAS bf16x8*)(WS + (tm * 16 + fr) * 136 + ks * 32 + fq * 8),
                                                                                             *(const LAS bf16x8*)(VNT + (h * 64 + tn * 16 + fr) * 136 + ks * 32 + fq * 8), acc, 0, 0, 0);
#pragma unroll
                for (int jj = 0; jj < 4; ++jj) { const int ii = tm * 16 + fq * 4 + jj;
                    YC[(size_t)(row0 + ii) * DM + 256 + h * 64 + tn * 16 + fr] = f2bf((acc[jj] + bs[ii]) * bf2f(ur[i][jj])); }
            }
        }
        __syncthreads();
    }
}

__device__ __forceinline__ void item_mamba_local(const Ctx& C, int layer, int gc) {
    const ChunkInfo ci = chunk_info(gc);
    const bf16_t* P = (const bf16_t*)(C.ws + WS_P);
    bf16_t* MSTb = (bf16_t*)(C.ws + WS_MST); float* MCD = (float*)(C.ws + WS_MCD);
    LAS float* DA = (LAS float*)C.lds;
    LAS float* DT = (LAS float*)(C.lds + 2048);
    LAS float* FAC = (LAS float*)(C.lds + 4096);
    LAS bf16_t* XDT = (LAS bf16_t*)(C.lds + 8192);
    LAS bf16_t* BTT = (LAS bf16_t*)(C.lds + 8192 + 73728);
    {
        const int s = C.lane, dh = C.wid, d = dh >> 2, h = dh & 3;
        const float raw = bf2f(P[(size_t)(ci.row0 + s) * NP + OFF_C + 1024 + dh]);
        const float dt = softplus(raw + C.in[20][layer * 8 + dh]);
        const float da = dt * (-expf(C.in[21][layer * 8 + dh]));
        const float incl = wave_incl_scan(da, s), total = __shfl(incl, 63);
        DT[dh * 64 + s] = dt; DA[dh * 64 + s] = da;
        FAC[dh * 64 + s] = d ? fexp(incl - da) : fexp(total - incl);
        if (s == 0) MCD[slot_of(ci.b, h, d, cpos_of(ci, d))] = expf(total);
    }
    __syncthreads();
    {
        const int cp = C.tid & 255, half = C.tid >> 8, c0 = 2 * cp;
        const float* cw = C.in[18] + (size_t)layer * 5 * 768 + c0; const float* cb = C.in[19] + layer * 768 + c0;
        float w0[5], w1[5];
#pragma unroll
        for (int j = 0; j < 5; ++j) { w0[j] = cw[j * 768]; w1[j] = cw[j * 768 + 1]; }
        const float b0 = cb[0], b1 = cb[1];
        const int s0 = half * 32;
        unsigned wr[36];
        unsigned short ob[4][8];
#pragma unroll
        for (int j = 0; j < 36; ++j) { const int row = ci.row0 + s0 - 2 + j; const bool ok = row >= ci.lo && row < ci.hi; const unsigned v = *(const unsigned*)(P + (size_t)(ok ? row : ci.row0) * NP + OFF_C + 256 + c0); wr[j] = ok ? v : 0u; }
#pragma unroll
        for (int tt = 0; tt < 32; ++tt) {
            const int s = s0 + tt;
            const unsigned* win = wr + tt;
            float a0 = b0, a1 = b1;
#pragma unroll
            for (int j = 0; j < 5; ++j) { a0 += w0[j] * bflo(win[j]); a1 += w1[j] * bfhi(win[j]); }
            a0 = silu(a0); a1 = silu(a1);
            if (c0 < 256) { const int h = c0 >> 6;
#pragma unroll
                for (int d = 0; d < 2; ++d) { const float f = DT[(d * 4 + h) * 64 + s] * FAC[(d * 4 + h) * 64 + s]; ob[d * 2][tt & 7] = f2bf(a0 * f); ob[d * 2 + 1][tt & 7] = f2bf(a1 * f); }
            } else { ob[0][tt & 7] = f2bf(a0); ob[1][tt & 7] = f2bf(a1); }
            if ((tt & 7) == 7) { const int sb = s - 7;
#define C1_PACK8(a) (u32x4){(unsigned)a[0] | ((unsigned)a[1] << 16), (unsigned)a[2] | ((unsigned)a[3] << 16), (unsigned)a[4] | ((unsigned)a[5] << 16), (unsigned)a[6] | ((unsigned)a[7] << 16)}
                if (c0 < 256) {
#pragma unroll
                    for (int d = 0; d < 2; ++d) { *(LAS u32x4*)(XDT + (d * 256 + c0) * 72 + sb) = C1_PACK8(ob[d * 2]); *(LAS u32x4*)(XDT + (d * 256 + c0 + 1) * 72 + sb) = C1_PACK8(ob[d * 2 + 1]); }
                } else { const int q = c0 - 256; *(LAS u32x4*)(BTT + q * 72 + sb) = C1_PACK8(ob[0]); *(LAS u32x4*)(BTT + (q + 1) * 72 + sb) = C1_PACK8(ob[1]); }
#undef C1_PACK8
            }
        }
    }
    __syncthreads();
    for (int hd = 0; hd < 8; ++hd) {
        const int d = hd >> 2, h = hd & 3;
        bf16_t* dst = MSTb + (size_t)slot_of(ci.b, h, d, cpos_of(ci, d)) * 8192;
        blk_mma<8, 4, 2>(BTT + (h >> 1) * 128 * 72, 72, XDT + (d * 256 + h * 64) * 72, 72, C.wid, C.lane, [=](int r0, int col, const f32x4& acc) {
            u32x2 o; o.x = pk2(acc[0], acc[1]); o.y = pk2(acc[2], acc[3]); *(u32x2*)(dst + col * 128 + r0) = o;
        });
    }
    __syncthreads();
}


#ifndef MK_DIAG2
#define MK_DIAG2 0
#endif
#if MK_DIAG2
#define DBGF(stage, cond) do { if (cond) atomicOr((unsigned*)(C.ws + 32768) + (stage), 1u); } while (0)
#define DBGL(stage, cond) do { if (cond) atomicOr(dbgflags + (stage), 1u); } while (0)
#else
#define DBGF(stage, cond) do {} while (0)
#define DBGL(stage, cond) do {} while (0)
#endif
__device__ __forceinline__ bool badv(float x, float lim) { return !(fabsf(x) < lim); }
__device__ __forceinline__ void tri_inverse(const LAS float* ABf, LAS float* Tf, LAS float* Rt, LAS bf16_t* TT, int tid, int wid, int lane) {
    if (wid == 0) {
        const int bi = lane >> 4, j = lane & 15; const LAS float* Ab = ABf + (16 * bi) * 68 + 16 * bi;
        float col[16];
#pragma unroll
        for (int r = 0; r < 16; ++r) { float acc = (r == j) ? 1.f : 0.f;
#pragma unroll
            for (int s = 0; s < r; ++s) acc -= Ab[r * 68 + s] * col[s];
            col[r] = acc; }
#pragma unroll
        for (int r = 0; r < 16; ++r) Tf[(16 * bi + r) * 68 + 16 * bi + j] = col[r];
    } else {
        for (int e = tid - 64; e < 64 * 64; e += 448) { const int t = e >> 6, s2 = e & 63; if ((s2 >> 4) > (t >> 4)) Tf[t * 68 + s2] = 0.f; }
    }
    __syncthreads();
    if (wid < 3) {
        const int tn = wid, fr = lane & 15, fq = lane >> 4;
        LAS float* Rw = Rt + wid * 320;
        for (int i = tn + 1; i < 4; ++i) {
            f32x4 acc = {0.f, 0.f, 0.f, 0.f};
            for (int k = 16 * tn; k < 16 * i; k += 4) acc = __builtin_amdgcn_mfma_f32_16x16x4f32(ABf[(16 * i + fr) * 68 + k + fq], Tf[(k + fq) * 68 + 16 * tn + fr], acc, 0, 0, 0);
#pragma unroll
            for (int j = 0; j < 4; ++j) Rw[(fq * 4 + j) * 20 + fr] = -acc[j];
            asm volatile("s_waitcnt lgkmcnt(0)" ::: "memory");
            f32x4 t = {0.f, 0.f, 0.f, 0.f};
#pragma unroll
            for (int k = 0; k < 16; k += 4) t = __builtin_amdgcn_mfma_f32_16x16x4f32(Tf[(16 * i + fr) * 68 + 16 * i + k + fq], Rw[(k + fq) * 20 + fr], t, 0, 0, 0);
#pragma unroll
            for (int j = 0; j < 4; ++j) Tf[(16 * i + fq * 4 + j) * 68 + 16 * tn + fr] = t[j];
            asm volatile("s_waitcnt lgkmcnt(0)" ::: "memory");
        }
    }
    __syncthreads();
    for (int e = tid; e < 4096; e += 512) { const int t = e >> 6, s2 = e & 63; TT[t * 72 + s2] = f2bf(Tf[t * 68 + s2]); }
}
struct D1Pre { unsigned w[24]; unsigned lw[8]; int hd; };
__device__ __forceinline__ void d1_load_rows(const Ctx& C, int it, unsigned (&w)[24]) {
    const int gc = it >> 3, hd = it & 7, h = hd & 3, d = hd >> 2;
    const ChunkInfo ci = chunk_info(gc);
    const bf16_t* P = (const bf16_t*)(C.ws + WS_P);
    if (C.tid < 480) {
        const int q = C.tid % 160, seg = C.tid / 160, grp = q >> 5, c = (q & 31) * 2;
        const int j = (grp == 0 ? h * 64 : grp == 1 ? 256 + h * 64 : grp == 2 ? 512 + h * 64 : grp == 3 ? 768 + d * 64 : 896 + d * 64) + c;
        const int t0 = seg * 22, nt = seg == 2 ? 20 : 22;
        const bf16_t* pp = P + (size_t)(ci.row0 + t0) * NP + OFF_D + j;
#pragma unroll
        for (int i = 0; i < 24; ++i) { const int row = ci.row0 + t0 - 1 + i; const bool ok = row >= ci.lo && row < ci.hi; const int rc = ok ? row : ci.row0;
            const unsigned v = (i < nt + 2) ? *(const unsigned*)(pp + (ptrdiff_t)(rc - (ci.row0 + t0)) * NP) : 0u; w[i] = ok ? v : 0u; }
    }
}
constexpr int D1_LW = 0, D1_CS = 17408, D1_AA = 34816, D1_RB = 52224, D1_KB = 61440, D1_VB = 70656, D1_TW = 79872, D1_AD = 89088, D1_W2T = 98304, D1_A2T = 107520;
constexpr int D1_Y = 82944;
constexpr int D1_ABF = 0, D1_AK = 17408, D1_ARK = 26624, D1_ARB = 35840, D1_TT = 45056, D1_W1T = 54272, D1_AKVT = 63488, D1_W2TT = 72704;
constexpr int D1_GL = 156672;
__device__ __forceinline__ void item_rwkv_local(const Ctx& C0_, int layer, int it, D1Pre& pre, int it_next) {
    Ctx C = C0_; { int t_ = C0_.tid; asm volatile("" : "+v"(t_)); C.tid = t_; C.lane = t_ & 63; C.wid = __builtin_amdgcn_readfirstlane(t_ >> 6); }
#define D1_RELAUNDER() do { int t_ = C.tid; asm volatile("" : "+v"(t_)); C.tid = t_; C.lane = t_ & 63; C.wid = __builtin_amdgcn_readfirstlane(t_ >> 6); } while (0)
    const int gc = it >> 3, hd = it & 7, h = hd & 3, d = hd >> 2;
    const ChunkInfo ci = chunk_info(gc);
    const int slot = slot_of(ci.b, h, d, cpos_of(ci, d));
    const bf16_t* P = (const bf16_t*)(C.ws + WS_P);
    const float* mup = C.in[24] + layer * 1152; const float* mun = C.in[25] + layer * 1152;
    lds_t L = C.lds;
    LAS float* LW = (LAS float*)(L + D1_LW); LAS float* CS = (LAS float*)(L + D1_CS); LAS float* AA = (LAS float*)(L + D1_AA); LAS float* GL = (LAS float*)(L + D1_GL);
    LAS bf16_t* Rb = (LAS bf16_t*)(L + D1_RB); LAS bf16_t* Kb = (LAS bf16_t*)(L + D1_KB); LAS bf16_t* Vb = (LAS bf16_t*)(L + D1_VB);
    LAS bf16_t* TW = (LAS bf16_t*)(L + D1_TW); LAS bf16_t* AD = (LAS bf16_t*)(L + D1_AD); LAS bf16_t* W2T = (LAS bf16_t*)(L + D1_W2T); LAS bf16_t* A2T = (LAS bf16_t*)(L + D1_A2T);
    LAS bf16_t* KT = (LAS bf16_t*)(L + D1_Y); LAS bf16_t* KTt = KT + 4608; LAS bf16_t* KD = KT + 2 * 4608; LAS bf16_t* KDt = KT + 3 * 4608;
    LAS bf16_t* BT = KT + 4 * 4608; LAS bf16_t* BTt = KT + 5 * 4608; LAS bf16_t* RT = KT + 6 * 4608; LAS bf16_t* Vt = KT + 7 * 4608;
    LAS float* ABf = (LAS float*)(L + D1_ABF); LAS bf16_t* AK = (LAS bf16_t*)(L + D1_AK); LAS bf16_t* ARK = (LAS bf16_t*)(L + D1_ARK); LAS bf16_t* ARB = (LAS bf16_t*)(L + D1_ARB);
    LAS bf16_t* TT = (LAS bf16_t*)(L + D1_TT); LAS bf16_t* W1t = (LAS bf16_t*)(L + D1_W1T); LAS bf16_t* AKVt = (LAS bf16_t*)(L + D1_AKVT); LAS bf16_t* W2t = (LAS bf16_t*)(L + D1_W2TT);

    if (C.tid < 480) {
        const int q = C.tid % 160, seg = C.tid / 160, grp = q >> 5, c = (q & 31) * 2;
        const int j = (grp == 0 ? h * 64 : grp == 1 ? 256 + h * 64 : grp == 2 ? 512 + h * 64 : grp == 3 ? 768 + d * 64 : 896 + d * 64) + c;
        const int t0 = seg * 22, nt = seg == 2 ? 20 : 22;
        const float mp0 = mup[j], mp1 = mup[j + 1], mn0 = mun[j], mn1 = mun[j + 1];
        unsigned w[24]; { const bf16_t* pp = P + (size_t)(ci.row0 + t0) * NP + OFF_D + j;
#pragma unroll
        for (int i = 0; i < 24; ++i) { const int row = ci.row0 + t0 - 1 + i; const bool ok = row >= ci.lo && row < ci.hi; const int rc = ok ? row : ci.row0;
            const unsigned v = (i < nt + 2) ? *(const unsigned*)(pp + (ptrdiff_t)(rc - (ci.row0 + t0)) * NP) : 0u; w[i] = ok ? v : 0u; } }
        LAS bf16_t* dst = (grp == 0 ? Rb : grp == 1 ? Kb : grp == 2 ? Vb : grp == 3 ? TW : AD);
#pragma unroll
        for (int i = 0; i < 22; ++i) if (i < nt) {
            const float x0 = bflo(w[i + 1]), x1 = bfhi(w[i + 1]);
            const float v0 = x0 + mp0 * (bflo(w[i]) - x0) + mn0 * (bflo(w[i + 2]) - x0);
            const float v1 = x1 + mp1 * (bfhi(w[i]) - x1) + mn1 * (bfhi(w[i + 2]) - x1);
            DBGF(1, badv(v0, 1e4f) || badv(v1, 1e4f));
            const unsigned o = (grp == 3) ? pk2(ftanh(v0), ftanh(v1)) : pk2(v0, v1);
            const int tl = t0 + i, l = d ? 63 - tl : tl;
            *(LAS unsigned*)(dst + l * 72 + c) = o;
        }
    }
    {
        if (pre.hd != hd) {
            const float* w2 = C.in[27] + ((size_t)layer * 2 + d) * 64 * 256 + h * 64; const float* a2 = C.in[29] + ((size_t)layer * 2 + d) * 64 * 256 + h * 64;
#pragma unroll
            for (int k = 0; k < 8; ++k) { const int e = C.tid + 512 * k, r = e >> 6, c = e & 63; pre.lw[k] = pk2(w2[r * 256 + c], a2[r * 256 + c]); }
            pre.hd = hd;
        }
#pragma unroll
        for (int k = 0; k < 8; ++k) { const int e = C.tid + 512 * k, r = e >> 6, c = e & 63; W2T[c * 72 + r] = (unsigned short)(pre.lw[k] & 0xffffu); A2T[c * 72 + r] = (unsigned short)(pre.lw[k] >> 16); }
    }
    __syncthreads();
    D1_RELAUNDER();
    {
        unsigned* dbgflags = (unsigned*)(C.ws + 32768); (void)dbgflags;
        const float* w0 = C.in[26] + ((size_t)layer * 2 + d) * 256 + h * 64; const float* a0 = C.in[28] + ((size_t)layer * 2 + d) * 256 + h * 64;
        blk_mma<4, 4, 2>(TW, 72, W2T, 72, C.wid, C.lane, [=](int r0, int col, const f32x4& acc) {
#pragma unroll
            for (int jj = 0; jj < 4; ++jj) { const float w = w0[col] + acc[jj]; DBGL(2, badv(w, 1e4f)); LW[(r0 + jj) * 68 + col] = -fexp(-softplus(-w) - 0.5f); }
        });
        blk_mma<4, 4, 2>(AD, 72, A2T, 72, C.wid, C.lane, [=](int r0, int col, const f32x4& acc) {
#pragma unroll
            for (int jj = 0; jj < 4; ++jj) { DBGL(2, badv(acc[jj], 1e4f)); AA[(r0 + jj) * 68 + col] = sigm(a0[col] + acc[jj]); }
        });
    }
    __syncthreads();
    {
#pragma unroll
        for (int i = 0; i < 8; ++i) { const int c = C.wid * 8 + i; const float incl = wave_incl_scan(LW[C.lane * 68 + c], C.lane); CS[C.lane * 68 + c] = incl; if (C.lane == 63) GL[c] = fexp(incl); }
    }
    __syncthreads();
    D1_RELAUNDER();
    {
        const int c = C.lane, l0 = C.wid * 8;
        const float kkw = C.in[31][layer * 256 + h * 64 + c], kaw = C.in[32][layer * 256 + h * 64 + c], rkw = C.in[33][layer * 256 + h * 64 + c];
        unsigned short kt[8], kd[8], bt[8], vt[8];
#pragma unroll
        for (int i = 0; i < 8; ++i) { const int l = l0 + i;
            const float k = bf2f(Kb[l * 72 + c]), r = bf2f(Rb[l * 72 + c]), v = bf2f(Vb[l * 72 + c]), aa = AA[l * 68 + c];
            const float kkr = k * kkw, kdv = k * (1.f + (aa - 1.f) * kaw);
            const float ss = wave_sum(kkr * kkr), bon = wave_sum(r * kdv * rkw);
            const float kkn = kkr * rsqrtf(ss + 1e-12f);
            if (c == 0) ((float*)(C.ws + WS_BON))[(size_t)(ci.row0 + (d ? 63 - l : l)) * 8 + h * 2 + d] = bon;
            const float cs = CS[l * 68 + c], lw = LW[l * 68 + c];
            const float ge = fexp(cs - lw), gi = fexp(cs), gn = fexp(-cs);
            DBGF(3, badv(cs, 50.f) || cs > 0.f || badv(lw, 1.f)); DBGF(4, badv(kkn * ge, 10.f) || badv(r * gi, 1e4f) || badv(v, 1e4f)); DBGF(5, badv(kdv * gn, 1e25f) || badv(kkn * aa * gn, 1e25f));
            kt[i] = f2bf(kkn * ge); kd[i] = f2bf(kdv * gn); bt[i] = f2bf(kkn * aa * gn); vt[i] = f2bf(v);
            KT[l * 72 + c] = kt[i]; KD[l * 72 + c] = kd[i]; BT[l * 72 + c] = bt[i]; RT[l * 72 + c] = f2bf(r * gi); }
#define D1_PACK8(a) (u32x4){(unsigned)a[0] | ((unsigned)a[1] << 16), (unsigned)a[2] | ((unsigned)a[3] << 16), (unsigned)a[4] | ((unsigned)a[5] << 16), (unsigned)a[6] | ((unsigned)a[7] << 16)}
        *(LAS u32x4*)(KTt + c * 72 + l0) = D1_PACK8(kt); *(LAS u32x4*)(KDt + c * 72 + l0) = D1_PACK8(kd);
        *(LAS u32x4*)(BTt + c * 72 + l0) = D1_PACK8(bt); *(LAS u32x4*)(Vt + c * 72 + l0) = D1_PACK8(vt);
#undef D1_PACK8
    }
    __syncthreads();
    D1_RELAUNDER();
    unsigned* dbgflags = (unsigned*)(C.ws + 32768); (void)dbgflags;
    blk_mma2<4, 4, 2>(BT, KT, KD, KT, 72, C.wid, C.lane, [=](int r0, int col, const f32x4& ab, const f32x4& ak) {
        f32x4 a; float k[4];
#pragma unroll
        for (int jj = 0; jj < 4; ++jj) { const bool lo = r0 + jj < col; DBGL(6, lo && (badv(ab[jj], 1e3f) || badv(ak[jj], 1e4f))); a[jj] = lo ? ab[jj] : 0.f; k[jj] = lo ? ak[jj] : 0.f; }
        *(LAS f32x4*)(ABf + col * 68 + r0) = a;
        u32x2 o; o.x = pk2(k[0], k[1]); o.y = pk2(k[2], k[3]); *(LAS u32x2*)(AK + col * 72 + r0) = o;
    });
    blk_mma2<4, 4, 2>(KD, RT, BT, RT, 72, C.wid, C.lane, [=](int r0, int col, const f32x4& rk, const f32x4& rb) {
        float a[4], b[4];
#pragma unroll
        for (int jj = 0; jj < 4; ++jj) { const bool le = r0 + jj <= col; DBGL(7, le && (badv(rk[jj], 1e5f) || badv(rb[jj], 1e5f))); a[jj] = le ? rk[jj] : 0.f; b[jj] = le ? rb[jj] : 0.f; }
        u32x2 oa, ob; oa.x = pk2(a[0], a[1]); oa.y = pk2(a[2], a[3]); ob.x = pk2(b[0], b[1]); ob.y = pk2(b[2], b[3]);
        *(LAS u32x2*)(ARK + col * 72 + r0) = oa; *(LAS u32x2*)(ARB + col * 72 + r0) = ob;
    });
    __syncthreads();
    tri_inverse(ABf, (LAS float*)(L + 54272), (LAS float*)(L + 71680), TT, C.tid, C.wid, C.lane);
    __syncthreads();
#if MK_DIAG2
    for (int e = C.tid; e < 4096; e += 512) DBGF(8, badv(bf2f(TT[(e >> 6) * 72 + (e & 63)]), 1e3f));
#endif
    D1_RELAUNDER();
    blk_mma2<4, 4, 2>(TT, KTt, AK, Vt, 72, C.wid, C.lane, [=](int r0, int col, const f32x4& w1, const f32x4& akv) {
        DBGL(9, badv(w1[0], 1e3f) || badv(w1[1], 1e3f) || badv(w1[2], 1e3f) || badv(w1[3], 1e3f)); DBGL(10, badv(akv[0], 1e5f) || badv(akv[1], 1e5f) || badv(akv[2], 1e5f) || badv(akv[3], 1e5f));
        u32x2 a, b; a.x = pk2(w1[0], w1[1]); a.y = pk2(w1[2], w1[3]); b.x = pk2(akv[0], akv[1]); b.y = pk2(akv[2], akv[3]);
        *(LAS u32x2*)(W1t + col * 72 + r0) = a; *(LAS u32x2*)(AKVt + col * 72 + r0) = b;
    });
    __syncthreads();
    blk_mma<4, 4, 2>(TT, 72, AKVt, 72, C.wid, C.lane, [=](int r0, int col, const f32x4& w2) {
        DBGL(11, badv(w2[0], 1e5f) || badv(w2[1], 1e5f) || badv(w2[2], 1e5f) || badv(w2[3], 1e5f));
        u32x2 a; a.x = pk2(w2[0], w2[1]); a.y = pk2(w2[2], w2[3]); *(LAS u32x2*)(W2t + col * 72 + r0) = a;
    });
    __syncthreads();
    D1_RELAUNDER();
    {
        bf16_t* Gg = (bf16_t*)(C.ws + WS_RG) + (size_t)slot * 4096; bf16_t* Jg = (bf16_t*)(C.ws + WS_RJ) + (size_t)slot * 4096;
        bf16_t* Ryg = (bf16_t*)(C.ws + WS_RY) + (size_t)slot * 4096; bf16_t* Ylg = (bf16_t*)(C.ws + WS_RL) + (size_t)slot * 4096;
        blk_mma2<4, 4, 2>(W1t, BTt, W1t, ARB, 72, C.wid, C.lane, [=](int r0, int col, const f32x4& gp, const f32x4& rbw) {
            const float gl = GL[col]; float g[4], ry[4];
            const u32x2 rt = *(const LAS u32x2*)(RT + col * 72 + r0);
            const float rtv[4] = {bflo(rt.x), bfhi(rt.x), bflo(rt.y), bfhi(rt.y)};
#pragma unroll
            for (int jj = 0; jj < 4; ++jj) { g[jj] = gl * ((col == r0 + jj ? 1.f : 0.f) - gp[jj]); ry[jj] = rtv[jj] - rbw[jj]; }
            u32x2 og, oy; og.x = pk2(g[0], g[1]); og.y = pk2(g[2], g[3]); oy.x = pk2(ry[0], ry[1]); oy.y = pk2(ry[2], ry[3]);
            *(u32x2*)(Gg + col * 64 + r0) = og;
            *(u32x2*)(Ryg + col * 64 + r0) = oy;
        });
        blk_mma2<4, 4, 2>(KDt, Vt, BTt, W2t, 72, C.wid, C.lane, [=](int r0, int col, const f32x4& kv, const f32x4& bw) {
            f32x4 o;
#pragma unroll
            for (int jj = 0; jj < 4; ++jj) { o[jj] = GL[r0 + jj] * (kv[jj] - bw[jj]); DBGL(12, badv(GL[r0 + jj] * kv[jj], 1e5f)); DBGL(13, badv(GL[r0 + jj] * bw[jj], 1e5f)); DBGL(14, badv(o[jj], 1e5f)); }
            u32x2 oj; oj.x = pk2(o[0], o[1]); oj.y = pk2(o[2], o[3]); *(u32x2*)(Jg + col * 64 + r0) = oj;
        });
        blk_mma2<4, 4, 2>(ARK, Vt, ARB, W2t, 72, C.wid, C.lane, [=](int r0, int col, const f32x4& a, const f32x4& b) {
            u32x2 o; o.x = pk2(a[0] - b[0], a[1] - b[1]); o.y = pk2(a[2] - b[2], a[3] - b[3]);
            *(u32x2*)(Ylg + col * 64 + r0) = o;
        });
    }
    __syncthreads();
}

typedef float f32x2p __attribute__((ext_vector_type(2)));
__device__ __forceinline__ void ph_scan(const Ctx& C, int nrep = 1, bool mstore = true, bool chain = true) {
    if (C.bid < 64) {
      if (chain)
      for (int rep = 0; rep < nrep; ++rep) {
        constexpr int NB = 8;
        const int chain_id = C.bid >> 2, w4 = C.bid & 3, fr = C.lane & 15, fq = C.lane >> 4;
        LAS bf16_t* Gs = (LAS bf16_t*)C.lds;
        LAS bf16_t* Js = Gs + NB * 4608;
        LAS bf16_t* HT = Js + NB * 1152;
        const bf16_t* Gg = (const bf16_t*)(C.ws + WS_RG) + (size_t)chain_id * NCH * 4096;
        const bf16_t* Jg = (const bf16_t*)(C.ws + WS_RJ) + (size_t)chain_id * NCH * 4096 + (size_t)(16 * w4) * 64;
        bf16_t* Hg = (bf16_t*)(C.ws + WS_RH) + (size_t)chain_id * NCH * 4096 + (16 * w4 + fr) * 64 + fq * 4;
        u32x4 pf[10];
#define CHAIN_ISSUE(b0_) do { _Pragma("unroll") for (int i = 0; i < 10; ++i) { const int e = C.tid + 512 * i, st = e / 640, q = e % 640; const size_t cp = (size_t)((b0_) + st < NCH ? (b0_) + st : NCH - 1) * 4096; \
            pf[i] = *(const u32x4*)(q < 512 ? Gg + cp + q * 8 : Jg + cp + (q - 512) * 8); } } while (0)
#define CHAIN_STAGE() do { _Pragma("unroll") for (int i = 0; i < 10; ++i) { const int e = C.tid + 512 * i, st = e / 640, q = e % 640; \
            if (q < 512) *(LAS u32x4*)(Gs + st * 4608 + (q >> 3) * 72 + (q & 7) * 8) = pf[i]; else *(LAS u32x4*)(Js + st * 1152 + ((q - 512) >> 3) * 72 + (q & 7) * 8) = pf[i]; } } while (0)
        f32x4 acc[4];
#pragma unroll
        for (int tm = 0; tm < 4; ++tm) acc[tm] = (f32x4){0.f, 0.f, 0.f, 0.f};
        CHAIN_ISSUE(0);
        for (int b0 = 0; b0 < NCH; b0 += NB) {
            __syncthreads();
            CHAIN_STAGE();
            __syncthreads();
            if (b0 + NB < NCH) CHAIN_ISSUE(b0 + NB);
            if (C.wid == 0) {
                const int nb = NCH - b0 < NB ? NCH - b0 : NB;
                for (int st = 0; st < nb; ++st) {
                    const int cpos = b0 + st;
#pragma unroll
                    for (int tm = 0; tm < 4; ++tm) { u32x2 o; o.x = pk2(acc[tm][0], acc[tm][1]); o.y = pk2(acc[tm][2], acc[tm][3]);
                        *(LAS u32x2*)(HT + fr * 72 + tm * 16 + fq * 4) = o;
                        *(u32x2*)(Hg + (size_t)cpos * 4096 + tm * 16) = o; }
                    const bf16x8 b0v = *(const LAS bf16x8*)(HT + fr * 72 + fq * 8), b1v = *(const LAS bf16x8*)(HT + fr * 72 + 32 + fq * 8);
#pragma unroll
                    for (int tm = 0; tm < 4; ++tm) {
                        const u32x2 jr = *(const LAS u32x2*)(Js + st * 1152 + fr * 72 + tm * 16 + fq * 4);
                        f32x4 a = {bflo(jr.x), bfhi(jr.x), bflo(jr.y), bfhi(jr.y)};
                        a = __builtin_amdgcn_mfma_f32_16x16x32_bf16(*(const LAS bf16x8*)(Gs + st * 4608 + (tm * 16 + fr) * 72 + fq * 8), b0v, a, 0, 0, 0);
                        a = __builtin_amdgcn_mfma_f32_16x16x32_bf16(*(const LAS bf16x8*)(Gs + st * 4608 + (tm * 16 + fr) * 72 + 32 + fq * 8), b1v, a, 0, 0, 0);
                        acc[tm] = a; }
                }
            }
        }
#undef CHAIN_ISSUE
#undef CHAIN_STAGE
        __syncthreads();
      }
    } else {
        unsigned* MST = (unsigned*)(C.ws + WS_MST); const float* MCD = (const float*)(C.ws + WS_MCD);
        const int nthr = (C.G - 64) * 512;
        for (int e = (C.bid - 64) * 512 + C.tid; e < 16 * 4096; e += nthr) {
            const int chain = e >> 12, el = e & 4095; float r0 = 0.f, r1 = 0.f;
            unsigned* p = MST + (size_t)chain * NCH * 4096 + el; const float* cd = MCD + chain * NCH;
#pragma unroll 22
            for (int cpos = 0; cpos < NCH; ++cpos) { const unsigned tmp = p[(size_t)cpos * 4096]; if (mstore) p[(size_t)cpos * 4096] = pk2(r0, r1); const float c = cd[cpos]; r0 = r0 * c + bflo(tmp); r1 = r1 * c + bfhi(tmp); }
            if (!mstore && r0 == 12345.678f) p[0] = 0u;
        }
    }
}

__device__ __forceinline__ void item_mamba_out(const Ctx& C0_, int layer, int gc) {
    Ctx C = C0_;
#define MO_RELAUNDER() do { int t_ = C.tid; asm volatile("" : "+v"(t_)); C.tid = t_; C.lane = t_ & 63; C.wid = __builtin_amdgcn_readfirstlane(t_ >> 6); } while (0)
    MO_RELAUNDER();
    const ChunkInfo ci = chunk_info(gc);
    const bf16_t* P = (const bf16_t*)(C.ws + WS_P); bf16_t* YC = (bf16_t*)(C.ws + WS_ACT); const bf16_t* MST = (const bf16_t*)(C.ws + WS_MST);
    lds_t L = C.lds;
    LAS float* DT = (LAS float*)L;
    LAS float* DA = (LAS float*)(L + 2048);
    LAS float* CSI = (LAS float*)(L + 4096);
    LAS float* SSQ = (LAS float*)(L + 6144);
    LAS bf16_t* CG = (LAS bf16_t*)(L + 10240);
    LAS bf16_t* BG = (LAS bf16_t*)(L + 27648);
    LAS bf16_t* XT = (LAS bf16_t*)(L + 45056);
    LAS float* CBm = (LAS float*)(L + 63488);
    LAS bf16_t* MP = (LAS bf16_t*)(L + 80896);
    LAS bf16_t* S0 = (LAS bf16_t*)(L + 90112);
    LAS bf16_t* YPRE = (LAS bf16_t*)(L + 107520);
    int fr = C.lane & 15, fq = C.lane >> 4;
    {
        const int s = C.lane, dh = C.wid;
        const float raw = bf2f(P[(size_t)(ci.row0 + s) * NP + OFF_C + 1024 + dh]);
        const float dt = softplus(raw + C.in[20][layer * 8 + dh]);
        const float da = dt * (-expf(C.in[21][layer * 8 + dh]));
        const float incl = wave_incl_scan(da, s), total = __shfl(incl, 63);
        DT[dh * 64 + s] = dt; DA[dh * 64 + s] = da;
        CSI[dh * 64 + s] = (dh < 4) ? incl : (total - incl + da);
    }
    for (int g = 0; g < 2; ++g) {
        __syncthreads();
        MO_RELAUNDER(); fr = C.lane & 15; fq = C.lane >> 4;
        {
            const int cp = C.tid & 255, half = C.tid >> 8;
            if (cp < 192) {
                const int kind = cp >> 6, cl = (cp & 63) * 2, c0 = kind * 256 + g * 128 + cl;
                const float* cw = C.in[18] + (size_t)layer * 5 * 768 + c0; const float* cb = C.in[19] + layer * 768 + c0;
                float w0[5], w1[5];
#pragma unroll
                for (int j = 0; j < 5; ++j) { w0[j] = cw[j * 768]; w1[j] = cw[j * 768 + 1]; }
                const float b0 = cb[0], b1 = cb[1];
                const int s0 = half * 32;
                unsigned wr[36];
                unsigned short xb0[8], xb1[8];
#pragma unroll
                for (int j = 0; j < 36; ++j) { const int row = ci.row0 + s0 - 2 + j; const bool ok = row >= ci.lo && row < ci.hi; const unsigned v = *(const unsigned*)(P + (size_t)(ok ? row : ci.row0) * NP + OFF_C + 256 + c0); wr[j] = ok ? v : 0u; }
#pragma unroll
                for (int tt = 0; tt < 32; ++tt) {
                    const int s = s0 + tt;
                    const unsigned* win = wr + tt;
                    float a0 = b0, a1 = b1;
#pragma unroll
                    for (int j = 0; j < 5; ++j) { a0 += w0[j] * bflo(win[j]); a1 += w1[j] * bfhi(win[j]); }
                    const unsigned short o0 = f2bf(silu(a0)), o1 = f2bf(silu(a1));
                    if (kind == 0) { xb0[tt & 7] = o0; xb1[tt & 7] = o1;
                        if ((tt & 7) == 7) { const int sb = s - 7;
                            *(LAS u32x4*)(XT + cl * 72 + sb) = (u32x4){(unsigned)xb0[0] | ((unsigned)xb0[1] << 16), (unsigned)xb0[2] | ((unsigned)xb0[3] << 16), (unsigned)xb0[4] | ((unsigned)xb0[5] << 16), (unsigned)xb0[6] | ((unsigned)xb0[7] << 16)};
                            *(LAS u32x4*)(XT + (cl + 1) * 72 + sb) = (u32x4){(unsigned)xb1[0] | ((unsigned)xb1[1] << 16), (unsigned)xb1[2] | ((unsigned)xb1[3] << 16), (unsigned)xb1[4] | ((unsigned)xb1[5] << 16), (unsigned)xb1[6] | ((unsigned)xb1[7] << 16)}; } }
                    else if (kind == 1) { *(LAS unsigned*)(BG + s * 136 + cl) = (unsigned)o0 | ((unsigned)o1 << 16); }
                    else { *(LAS unsigned*)(CG + s * 136 + cl) = (unsigned)o0 | ((unsigned)o1 << 16); }
                }
            }
        }
        __syncthreads();
        blk_mma<4, 4, 4>(CG, 136, BG, 136, C.wid, C.lane, [=](int r0, int col, const f32x4& acc) {
#pragma unroll
            for (int jj = 0; jj < 4; ++jj) CBm[(r0 + jj) * 68 + col] = acc[jj];
        });
        u32x4 s0r[2];
        { const bf16_t* src = MST + (size_t)slot_of(ci.b, 2 * g, 0, cpos_of(ci, 0)) * 8192;
#pragma unroll
          for (int k = 0; k < 2; ++k) { const int e = C.tid + 512 * k; s0r[k] = *(const u32x4*)(src + (e >> 4) * 128 + (e & 15) * 8); } }
        for (int hh = 0; hh < 2; ++hh) {
            MO_RELAUNDER(); fr = C.lane & 15; fq = C.lane >> 4;
            const int h = 2 * g + hh;
            f32x4 yacc[2] = {{0.f, 0.f, 0.f, 0.f}, {0.f, 0.f, 0.f, 0.f}};
            unsigned short zr[2][4];
#pragma unroll
            for (int i = 0; i < 2; ++i) { const int tt = C.wid + 8 * i, tm = tt >> 2, tn = tt & 3;
#pragma unroll
                for (int j = 0; j < 4; ++j) zr[i][j] = P[(size_t)(ci.row0 + tm * 16 + fq * 4 + j) * NP + OFF_C + h * 64 + tn * 16 + fr]; }
            for (int d = 0; d < 2; ++d) {
                const int dh = d * 4 + h;
                __syncthreads();
                for (int e = C.tid; e < 4096; e += 512) { const int l = e >> 6, s = e & 63; const bool ok = d ? (s >= l) : (s <= l);
                    MP[l * 72 + s] = ok ? f2bf(CBm[l * 68 + s] * fexp(CSI[dh * 64 + l] - CSI[dh * 64 + s]) * DT[dh * 64 + s]) : (unsigned short)0; }
#pragma unroll
                for (int k = 0; k < 2; ++k) { const int e = C.tid + 512 * k; *(LAS u32x4*)(S0 + (e >> 4) * 136 + (e & 15) * 8) = s0r[k]; }
                if (!(hh == 1 && d == 1)) { const int nh = d ? h + 1 : h, nd = d ^ 1; const bf16_t* src = MST + (size_t)slot_of(ci.b, nh, nd, cpos_of(ci, nd)) * 8192;
#pragma unroll
                    for (int k = 0; k < 2; ++k) { const int e = C.tid + 512 * k; s0r[k] = *(const u32x4*)(src + (e >> 4) * 128 + (e & 15) * 8); } }
                __syncthreads();
#pragma unroll
                for (int i = 0; i < 2; ++i) { const int tt = C.wid + 8 * i, tm = tt >> 2, tn = tt & 3;
                    f32x4 a1 = {0.f, 0.f, 0.f, 0.f}, a2 = {0.f, 0.f, 0.f, 0.f};
#pragma unroll
                    for (int ks = 0; ks < 2; ++ks) a1 = __builtin_amdgcn_mfma_f32_16x16x32_bf16(*(const LAS bf16x8*)(MP + (tm * 16 + fr) * 72 + ks * 32 + fq * 8),
                                                                                                 *(const LAS bf16x8*)(XT + (hh * 64 + tn * 16 + fr) * 72 + ks * 32 + fq * 8), a1, 0, 0, 0);
#pragma unroll
                    for (int ks = 0; ks < 4; ++ks) a2 = __builtin_amdgcn_mfma_f32_16x16x32_bf16(*(const LAS bf16x8*)(CG + (tm * 16 + fr) * 136 + ks * 32 + fq * 8),
                                                                                                 *(const LAS bf16x8*)(S0 + (tn * 16 + fr) * 136 + ks * 32 + fq * 8), a2, 0, 0, 0);
#pragma unroll
                    for (int j = 0; j < 4; ++j) yacc[i][j] += a1[j] + a2[j] * fexp(CSI[dh * 64 + tm * 16 + fq * 4 + j]);
                }
            }
            const float dsk = C.in[22][layer * 4 + h];
#pragma unroll
            for (int i = 0; i < 2; ++i) { const int tt = C.wid + 8 * i, tm = tt >> 2, tn = tt & 3;
#pragma unroll
                for (int j = 0; j < 4; ++j) { const int l = tm * 16 + fq * 4 + j, p = tn * 16 + fr, c = h * 64 + p;
                    const float xs = bf2f(XT[(hh * 64 + p) * 72 + l]);
                    const float z = bf2f(zr[i][j]);
                    const float pre = (yacc[i][j] + dsk * xs) * silu(z);
                    YPRE[l * 264 + c] = f2bf(pre);
                    float q = pre * pre; q += __shfl_xor(q, 1); q += __shfl_xor(q, 2); q += __shfl_xor(q, 4); q += __shfl_xor(q, 8);
                    if (fr == 0) SSQ[l * 16 + h * 4 + tn] = q; }
            }
        }
    }
    __syncthreads();
    {
        const int l = C.tid >> 3, sub = C.tid & 7; float ss = 0.f;
#pragma unroll
        for (int i = 0; i < 16; ++i) ss += SSQ[l * 16 + i];
        const float rs = rsqrtf(ss * (1.f / 256.f) + 1e-6f);
        const float* ng = C.in[23] + layer * 256 + sub * 32;
        bf16_t* dst = YC + (size_t)(ci.row0 + l) * DM + 512 + sub * 32;
#pragma unroll
        for (int i = 0; i < 32; i += 2) { const float a = bf2f(YPRE[l * 264 + sub * 32 + i]) * rs * ng[i], b = bf2f(YPRE[l * 264 + sub * 32 + i + 1]) * rs * ng[i + 1]; *(unsigned*)(dst + i) = pk2(a, b); }
    }
    __syncthreads();
}

constexpr int D3_G2T = 0, D3_SG = 69632;
__device__ __forceinline__ void load_g2t(const Ctx& C, int layer) {
    LAS bf16_t* G2T = (LAS bf16_t*)(C.lds + D3_G2T); const float* g2 = C.in[30] + (size_t)layer * 128 * 256;
    for (int e = C.tid; e < 128 * 256; e += 512) { const int r = e >> 8, c = e & 255; G2T[c * 136 + r] = f2bf(g2[e]); }
}
__device__ __forceinline__ float lerp_d(const bf16_t* P, const ChunkInfo& ci, int row, int j, const float* mup, const float* mun) {
    const bf16_t* pp = P + (size_t)row * NP + OFF_D + j;
    const bool okp = row - 1 >= ci.lo, okn = row + 1 < ci.hi;
    const float x = bf2f(*pp), xpv = bf2f(*(okp ? pp - NP : pp)), xnv = bf2f(*(okn ? pp + NP : pp)); const float xp = okp ? xpv : 0.f, xn = okn ? xnv : 0.f;
    return x + mup[j] * (xp - x) + mun[j] * (xn - x);
}
__device__ __forceinline__ void item_rwkv_out(const Ctx& C, int layer, int gc) {
    const ChunkInfo ci = chunk_info(gc);
    const bf16_t* P = (const bf16_t*)(C.ws + WS_P); bf16_t* YC = (bf16_t*)(C.ws + WS_ACT);
    const float* mup = C.in[24] + layer * 1152; const float* mun = C.in[25] + layer * 1152;
    LAS bf16_t* G2T = (LAS bf16_t*)(C.lds + D3_G2T); LAS bf16_t* SG = (LAS bf16_t*)(C.lds + D3_SG);
    int ln_ = C.lane; asm volatile("" : "+v"(ln_));
    const int fr = ln_ & 15, fq = ln_ >> 4;
    __syncthreads();
    for (int e = C.tid; e < 64 * 128; e += 512) { const int l = e >> 7, r = e & 127; SG[l * 136 + r] = f2bf(sigm(lerp_d(P, ci, ci.row0 + l, 1024 + r, mup, mun))); }
    __syncthreads();
    const int h = C.wid >> 1, tmb = (C.wid & 1) * 2;
    const bf16_t* Ryg = (const bf16_t*)(C.ws + WS_RY); const bf16_t* Ylg = (const bf16_t*)(C.ws + WS_RL); const bf16_t* Hg = (const bf16_t*)(C.ws + WS_RH);
    const float* BON = (const float*)(C.ws + WS_BON);
#pragma unroll
    for (int ti = 0; ti < 2; ++ti) {
        const int tm = tmb + ti;
        f32x4 gacc[4], yacc[4];
#pragma unroll
        for (int tn = 0; tn < 4; ++tn) { f32x4 a = {0.f, 0.f, 0.f, 0.f};
#pragma unroll
            for (int ks = 0; ks < 4; ++ks) a = __builtin_amdgcn_mfma_f32_16x16x32_bf16(*(const LAS bf16x8*)(SG + (tm * 16 + fr) * 136 + ks * 32 + fq * 8),
                                                                                        *(const LAS bf16x8*)(G2T + (h * 64 + tn * 16 + fr) * 136 + ks * 32 + fq * 8), a, 0, 0, 0);
            gacc[tn] = a; yacc[tn] = (f32x4){0.f, 0.f, 0.f, 0.f}; }
#pragma unroll
        for (int d = 0; d < 2; ++d) {
            const size_t slot = (size_t)slot_of(ci.b, h, d, cpos_of(ci, d));
            const int arow = d ? 63 - (tm * 16 + fr) : tm * 16 + fr;
            bf16x8 af[2];
#pragma unroll
            for (int ks = 0; ks < 2; ++ks) af[ks] = *(const bf16x8*)(Ryg + slot * 4096 + arow * 64 + ks * 32 + fq * 8);
#pragma unroll
            for (int tn = 0; tn < 4; ++tn) {
                f32x4 a;
                if (d == 0) { const u32x2 yl = *(const u32x2*)(Ylg + slot * 4096 + (tn * 16 + fr) * 64 + tm * 16 + fq * 4); a = (f32x4){bflo(yl.x), bfhi(yl.x), bflo(yl.y), bfhi(yl.y)}; }
                else { const u32x2 yl = *(const u32x2*)(Ylg + slot * 4096 + (tn * 16 + fr) * 64 + 60 - (tm * 16 + fq * 4)); a = (f32x4){bfhi(yl.y), bflo(yl.y), bfhi(yl.x), bflo(yl.x)}; }
#pragma unroll
                for (int ks = 0; ks < 2; ++ks) a = __builtin_amdgcn_mfma_f32_16x16x32_bf16(af[ks], *(const bf16x8*)(Hg + slot * 4096 + (tn * 16 + fr) * 64 + ks * 32 + fq * 8), a, 0, 0, 0);
                yacc[tn] += a;
            }
        }
#pragma unroll
        for (int j = 0; j < 4; ++j) {
            const int l = tm * 16 + fq * 4 + j, row = ci.row0 + l;
            float s = (yacc[0][j] + yacc[1][j]) + (yacc[2][j] + yacc[3][j]);
            s += __shfl_xor(s, 1); s += __shfl_xor(s, 2); s += __shfl_xor(s, 4); s += __shfl_xor(s, 8);
            const float mu = s * (1.f / 64.f);
            float q = 0.f;
#pragma unroll
            for (int tn = 0; tn < 4; ++tn) { const float dd = yacc[tn][j] - mu; q += dd * dd; }
            q += __shfl_xor(q, 1); q += __shfl_xor(q, 2); q += __shfl_xor(q, 4); q += __shfl_xor(q, 8);
            const float rs = rsqrtf(q * (1.f / 64.f) + 64e-5f);
            const float bon = BON[(size_t)row * 8 + h * 2] + BON[(size_t)row * 8 + h * 2 + 1];
#pragma unroll
            for (int tn = 0; tn < 4; ++tn) { const int c = h * 64 + tn * 16 + fr;
                const float yn = (yacc[tn][j] - mu) * rs * C.in[34][layer * 256 + c] + C.in[35][layer * 256 + c];
                const float vv = lerp_d(P, ci, row, 512 + c, mup, mun);
                YC[(size_t)row * DM + 768 + c] = f2bf((yn + bon * vv) * gacc[tn][j]); }
        }
    }
}

__device__ __forceinline__ unsigned ordf(float f) { const unsigned u = __float_as_uint(f); return u ^ ((u >> 31) ? 0xFFFFFFFFu : 0x80000000u); }
__device__ __forceinline__ unsigned wave_max_u32(unsigned v) {
    unsigned t;
    t = (unsigned)__builtin_amdgcn_update_dpp((int)v, (int)v, 0xB1, 0xF, 0xF, false); v = t > v ? t : v;
    t = (unsigned)__builtin_amdgcn_update_dpp((int)v, (int)v, 0x4E, 0xF, 0xF, false); v = t > v ? t : v;
    t = (unsigned)__builtin_amdgcn_update_dpp((int)v, (int)v, 0x141, 0xF, 0xF, false); v = t > v ? t : v;
    t = (unsigned)__builtin_amdgcn_update_dpp((int)v, (int)v, 0x140, 0xF, 0xF, false); v = t > v ? t : v;
    t = (unsigned)__builtin_amdgcn_update_dpp((int)v, (int)v, 0x142, 0xA, 0xF, false); v = t > v ? t : v;
    t = (unsigned)__builtin_amdgcn_update_dpp((int)v, (int)v, 0x143, 0xC, 0xF, false); v = t > v ? t : v;
    return (unsigned)__builtin_amdgcn_readlane((int)v, 63);
}
constexpr int SEL_K1 = 0, SEL_K2 = 34816;
__device__ __forceinline__ float unordf(unsigned k) { return __uint_as_float((k & 0x80000000u) ? (k ^ 0x80000000u) : ~k); }
template <int N> __device__ __forceinline__ void bitonic_sort_desc(unsigned (&x)[N]) {
#pragma unroll
    for (int k = 2; k <= N; k <<= 1)
#pragma unroll
        for (int j = k >> 1; j > 0; j >>= 1)
#pragma unroll
            for (int i = 0; i < N; ++i) { const int l = i ^ j;
                if (l > i) { const unsigned p = x[i], q = x[l]; const unsigned hi = p > q ? p : q, lo = p > q ? q : p; if ((i & k) == 0) { x[i] = hi; x[l] = lo; } else { x[i] = lo; x[l] = hi; } } }
}
__device__ __forceinline__ void merge_top16(unsigned (&a)[16], const unsigned (&b)[16]) {
#pragma unroll
    for (int i = 0; i < 16; ++i) a[i] = a[i] > b[15 - i] ? a[i] : b[15 - i];
#pragma unroll
    for (int j = 8; j > 0; j >>= 1)
#pragma unroll
        for (int i = 0; i < 16; ++i) { const int l = i ^ j; if (l > i) { const unsigned p = a[i], q = a[l]; a[i] = p > q ? p : q; a[l] = p > q ? q : p; } }
}
__device__ __forceinline__ void ph_select(const Ctx& C, int layer, int nrows) {
    const bf16_t* Q = (const bf16_t*)(C.ws + WS_Q); int* SELI = (int*)(C.ws + WS_SELI); float* SELG = (float*)(C.ws + WS_SELG);
    LAS bf16_t* K1 = (LAS bf16_t*)(C.lds + SEL_K1); LAS bf16_t* K2 = (LAS bf16_t*)(C.lds + SEL_K2);
    {
        const float* k1 = C.in[37] + (size_t)layer * 128 * 128; const float* k2 = C.in[38] + (size_t)layer * 128 * 128;
        for (int e = C.tid; e < 4096; e += 512) { const int r = e >> 5, c4 = (e & 31) * 4; const f32x4 a = *(const f32x4*)(k1 + r * 128 + c4), b = *(const f32x4*)(k2 + r * 128 + c4);
            u32x2 oa, ob; oa.x = pk2(a.x, a.y); oa.y = pk2(a.z, a.w); ob.x = pk2(b.x, b.y); ob.y = pk2(b.z, b.w);
            *(LAS u32x2*)(K1 + r * 136 + c4) = oa; *(LAS u32x2*)(K2 + r * 136 + c4) = ob; }
    }
    __syncthreads();
    const int nunits = (nrows / 16) * 8;
    for (int u = C.bid * 8 + C.wid; u < nunits; u += C.G * 8) {
        int ln_ = C.lane; asm volatile("" : "+v"(ln_));
        const int fr = ln_ & 15, fq = ln_ >> 4;
        const int tile = u >> 3, h = u & 7, row = tile * 16 + fr;
        const bf16_t* qp = Q + (size_t)row * 2048 + h * 256 + fq * 8;
        bf16x8 qf[8];
#pragma unroll
        for (int i = 0; i < 8; ++i) qf[i] = *(const bf16x8*)(qp + i * 32);
        unsigned T[2][16];
#pragma unroll
        for (int half = 0; half < 2; ++half) {
            const LAS bf16_t* K = half ? K2 : K1;
            unsigned lo16[16], hi16[16];
#pragma unroll
            for (int kt = 0; kt < 8; ++kt) {
                f32x4 acc = {0.f, 0.f, 0.f, 0.f};
#pragma unroll
                for (int ks = 0; ks < 4; ++ks) acc = __builtin_amdgcn_mfma_f32_16x16x32_bf16(*(const LAS bf16x8*)(K + (kt * 16 + fr) * 136 + ks * 32 + fq * 8), qf[half * 4 + ks], acc, 0, 0, 0);
#pragma unroll
                for (int j = 0; j < 4; ++j) { const unsigned key = (ordf(acc[j]) & ~0x7Fu) | (unsigned)(127 - (kt * 16 + fq * 4 + j));
                    if (kt < 4) lo16[kt * 4 + j] = key; else hi16[(kt - 4) * 4 + j] = key; }
            }
            bitonic_sort_desc<16>(lo16); bitonic_sort_desc<16>(hi16); merge_top16(lo16, hi16);
#pragma unroll
            for (int rnd = 16; rnd <= 32; rnd <<= 1) { unsigned o[16];
#pragma unroll
                for (int i = 0; i < 16; ++i) o[i] = (unsigned)__shfl_xor((int)lo16[i], rnd);
                merge_top16(lo16, o); }
#pragma unroll
            for (int i = 0; i < 16; ++i) T[half][i] = lo16[i];
        }
        unsigned ck[50]; unsigned R0[16];
        {
            int id = 0;
#pragma unroll
            for (int a = 0; a < 16; ++a) {
                const float va = unordf(T[0][a] & ~0x7Fu);
#pragma unroll
                for (int b = 0; b < 16; ++b) if ((a + 1) * (b + 1) <= 16) { ck[id] = (ordf(va + unordf(T[1][b] & ~0x7Fu)) & ~0x3Fu) | (unsigned)(63 - id); ++id; }
            }
        }
#pragma unroll
        for (int i = 0; i < 16; ++i) R0[i] = ck[i];
        {
            int base = 16;
#pragma unroll
            for (int a = 1; a < 8; ++a) { const int n = 16 / (a + 1); unsigned rw[16];
#pragma unroll
                for (int i = 0; i < 16; ++i) rw[i] = i < n ? ck[base + i] : 0u;
                merge_top16(R0, rw); base += n; }
            unsigned rw[16];
#pragma unroll
            for (int i = 0; i < 16; ++i) rw[i] = i < 8 ? ck[base + i] : 0u;
            merge_top16(R0, rw);
        }
        const unsigned thr = R0[15]; const float mx = unordf(R0[0] & ~0x3Fu);
        float sum = 0.f;
#pragma unroll
        for (int c = 0; c < 50; ++c) sum += ck[c] >= thr ? __expf(unordf(ck[c] & ~0x3Fu) - mx) : 0.f;
        const float rsum = 1.f / sum;
        int* oi = SELI + ((size_t)row * 8 + h) * 16; float* og = SELG + ((size_t)row * 8 + h) * 16;
        {
            int id = 0, cnt = 0;
#pragma unroll
            for (int a = 0; a < 16; ++a)
#pragma unroll
                for (int b = 0; b < 16; ++b) if ((a + 1) * (b + 1) <= 16) {
                    if (ck[id] >= thr) { if (fq == 0 && cnt < 16) { oi[cnt] = (127 - (int)(T[0][a] & 0x7Fu)) * 128 + (127 - (int)(T[1][b] & 0x7Fu)); og[cnt] = __expf(unordf(ck[id] & ~0x3Fu) - mx) * rsum; } ++cnt; }
                    ++id; }
        }
    }
}

struct R16 { float v[16]; };
__device__ __forceinline__ R16 load_r16_f32(const float* p, int lane) { R16 r;
#pragma unroll
    for (int k = 0; k < 4; ++k) { const f32x4 a = *(const f32x4*)(p + 16 * lane + 4 * k); r.v[4 * k] = a.x; r.v[4 * k + 1] = a.y; r.v[4 * k + 2] = a.z; r.v[4 * k + 3] = a.w; }
    return r; }
__device__ __forceinline__ void store_r16_f32(float* p, int lane, const R16& r) {
#pragma unroll
    for (int k = 0; k < 4; ++k) *(f32x4*)(p + 16 * lane + 4 * k) = (f32x4){r.v[4 * k], r.v[4 * k + 1], r.v[4 * k + 2], r.v[4 * k + 3]}; }
__device__ __forceinline__ R16 load_r16_bf16(const bf16_t* p, int lane) { R16 r;
#pragma unroll
    for (int k = 0; k < 2; ++k) { const u32x4 a = *(const u32x4*)(p + 16 * lane + 8 * k);
        r.v[8 * k] = bflo(a.x); r.v[8 * k + 1] = bfhi(a.x); r.v[8 * k + 2] = bflo(a.y); r.v[8 * k + 3] = bfhi(a.y); r.v[8 * k + 4] = bflo(a.z); r.v[8 * k + 5] = bfhi(a.z); r.v[8 * k + 6] = bflo(a.w); r.v[8 * k + 7] = bfhi(a.w); }
    return r; }
__device__ __forceinline__ void store_r16_bf16(bf16_t* p, int lane, const R16& r) {
#pragma unroll
    for (int k = 0; k < 2; ++k) { u32x4 a; a.x = pk2(r.v[8 * k], r.v[8 * k + 1]); a.y = pk2(r.v[8 * k + 2], r.v[8 * k + 3]); a.z = pk2(r.v[8 * k + 4], r.v[8 * k + 5]); a.w = pk2(r.v[8 * k + 6], r.v[8 * k + 7]);
        *(u32x4*)(p + 16 * lane + 8 * k) = a; } }
typedef float f32x2p __attribute__((ext_vector_type(2)));
struct PeerHdr { int idx0, idx1; float su0, su1, gsv0, gsv1; };
__device__ __forceinline__ void ph_peer(const Ctx& C, int layer, int nrows, bool last, bool store = true, int idmask = 0x3FFF) {
    const bf16_t* F = (const bf16_t*)(C.ws + WS_ACT); bf16_t* XN = (bf16_t*)(C.ws + WS_ACT);
    const unsigned char* UB = C.ws + WS_UB; const unsigned char* VB = C.ws + WS_VB; const float* SU = (const float*)(C.ws + WS_SU); const float* SV = (const float*)(C.ws + WS_SV);
    const int* SELI = (const int*)(C.ws + WS_SELI); const float* SELG = (const float*)(C.ws + WS_SELG);
    float* H = (float*)(C.ws + WS_H); const float* MOD = (const float*)(C.ws + WS_MOD);
    const int step = C.G * 8;
    auto load_hdr = [&](int tok, int L) { PeerHdr h; h.idx0 = SELI[(size_t)tok * 128 + L] & idmask; h.idx1 = SELI[(size_t)tok * 128 + 64 + L] & idmask;
        h.su0 = SU[h.idx0]; h.su1 = SU[h.idx1]; h.gsv0 = SELG[(size_t)tok * 128 + L] * SV[h.idx0]; h.gsv1 = SELG[(size_t)tok * 128 + 64 + L] * SV[h.idx1]; return h; };
    int tok = C.bid * 8 + C.wid;
    for (; tok < nrows; tok += step) {
        int L = C.lane; asm volatile("" : "+v"(L));
        const int myexp = ((L >> 5) & 1) * 4 + ((L >> 4) & 1) * 2 + ((L >> 3) & 1);
        const PeerHdr hd = load_hdr(tok, L);
        const u32x4 fpa = *(const u32x4*)(F + (size_t)tok * DM + 16 * L), fpb = *(const u32x4*)(F + (size_t)tok * DM + 16 * L + 8);
        f32x2p out[8];
#pragma unroll
        for (int i = 0; i < 8; ++i) out[i] = (f32x2p){0.f, 0.f};
        u32x4 ua[2][8], va[2][8];
#define PEER_LOAD(buf, bt) do { const int src_ = (bt) < 8 ? hd.idx0 : hd.idx1; const int l0_ = ((bt) & 7) * 8; _Pragma("unroll") for (int i = 0; i < 8; ++i) { const int ei = __builtin_amdgcn_readlane(src_, l0_ + i); \
            ua[buf][i] = *(const u32x4*)(UB + (size_t)ei * DM + 16 * L); va[buf][i] = *(const u32x4*)(VB + (size_t)ei * DM + 16 * L); } } while (0)
#define PEER_COMPUTE(buf, bt) do { const float susrc = (bt) < 8 ? hd.su0 : hd.su1, gsrc = (bt) < 8 ? hd.gsv0 : hd.gsv1; const int l0 = ((bt) & 7) * 8; float part[8]; \
            _Pragma("unroll") for (int i = 0; i < 8; ++i) { f32x2p acc = {0.f, 0.f}; _Pragma("unroll") for (int k = 0; k < 4; ++k) { \
                const f32x2p lo = __builtin_amdgcn_cvt_pk_f32_fp8((int)ua[buf][i][k], false), hi = __builtin_amdgcn_cvt_pk_f32_fp8((int)ua[buf][i][k], true); \
                const unsigned fw0 = (k < 2 ? fpa : fpb)[(2 * k) & 3], fw1 = (k < 2 ? fpa : fpb)[(2 * k + 1) & 3]; \
                acc += lo * (f32x2p){bflo(fw0), bfhi(fw0)}; acc += hi * (f32x2p){bflo(fw1), bfhi(fw1)}; } part[i] = acc.x + acc.y; } \
            float p4[4], p2[2], p1; \
            { const bool hi = (L & 32) != 0; _Pragma("unroll") for (int i = 0; i < 4; ++i) { const float send = hi ? part[i] : part[i + 4]; const float recv = __shfl_xor(send, 32); p4[i] = (hi ? part[i + 4] : part[i]) + recv; } } \
            { const bool hi = (L & 16) != 0; _Pragma("unroll") for (int i = 0; i < 2; ++i) { const float send = hi ? p4[i] : p4[i + 2]; const float recv = __shfl_xor(send, 16); p2[i] = (hi ? p4[i + 2] : p4[i]) + recv; } } \
            { const bool hi = (L & 8) != 0; const float send = hi ? p2[0] : p2[1]; const float recv = __shfl_xor(send, 8); p1 = (hi ? p2[1] : p2[0]) + recv; } \
            p1 += __shfl_xor(p1, 4); p1 += __shfl_xor(p1, 2); p1 += __shfl_xor(p1, 1); \
            const float act = gelu_tanh(p1 * __shfl(susrc, l0 + myexp)) * __shfl(gsrc, l0 + myexp); \
            _Pragma("unroll") for (int i = 0; i < 8; ++i) { \
                const float a = __uint_as_float((unsigned)__builtin_amdgcn_readlane((int)__float_as_uint(act), ((i >> 2) & 1) * 32 + ((i >> 1) & 1) * 16 + (i & 1) * 8)); const f32x2p a2 = {a, a}; \
                _Pragma("unroll") for (int k = 0; k < 4; ++k) { out[2 * k] += a2 * __builtin_amdgcn_cvt_pk_f32_fp8((int)va[buf][i][k], false); out[2 * k + 1] += a2 * __builtin_amdgcn_cvt_pk_f32_fp8((int)va[buf][i][k], true); } } } while (0)
        PEER_LOAD(0, 0);
        for (int bt = 0; bt < 16; bt += 2) {
            PEER_LOAD(1, bt + 1);
            PEER_COMPUTE(0, bt);
            if (bt + 2 < 16) PEER_LOAD(0, bt + 2);
            PEER_COMPUTE(1, bt + 1);
        }
#undef PEER_LOAD
#undef PEER_COMPUTE
        const float* m = MOD + ((size_t)layer * 3 + which_of(tok)) * 6144;
        R16 hr = load_r16_f32(H + (size_t)tok * DM, L); const R16 g5 = load_r16_f32(m + 5 * 1024, L);
#pragma unroll
        for (int i = 0; i < 8; ++i) { hr.v[2 * i] += g5.v[2 * i] * out[i].x; hr.v[2 * i + 1] += g5.v[2 * i + 1] * out[i].y; }
        float ss = 0.f;
#pragma unroll
        for (int i = 0; i < 16; ++i) ss += hr.v[i] * hr.v[i];
        const float rs = rsqrtf(wave_sum(ss) * (1.f / 1024.f) + 1e-6f);
        if (!store) continue;
        if (!last) {
            store_r16_f32(H + (size_t)tok * DM, L, hr);
            const float* m2 = MOD + ((size_t)(layer + 1) * 3 + which_of(tok)) * 6144;
            const R16 gg = load_r16_f32(C.in[6] + (layer + 1) * 1024, L), sh = load_r16_f32(m2, L), sc = load_r16_f32(m2 + 1024, L); R16 o;
#pragma unroll
            for (int i = 0; i < 16; ++i) o.v[i] = (hr.v[i] * rs * gg.v[i]) * (1.f + sc.v[i]) + sh.v[i];
            store_r16_bf16(XN + (size_t)tok * DM, L, o);
        } else {
            const R16 fg = load_r16_f32(C.in[41], L); R16 o;
#pragma unroll
            for (int i = 0; i < 16; ++i) o.v[i] = hr.v[i] * rs * fg.v[i];
            store_r16_f32(C.out + (size_t)tok * DM, L, o);
        }
    }
}

#define PM(n) ((MASK >> (n)) & 1u)
constexpr int NPH_LAYER = 9, NPH = 2 + 2 * NPH_LAYER;
template <unsigned MASK> __global__ void __launch_bounds__(512, 2) hybrid_fwd(Args args) {
    extern __shared__ __attribute__((aligned(16))) unsigned char lds_raw[];
    Ctx C0; C0.in = args.in; C0.out = args.out; C0.ws = args.ws; C0.lds = (lds_t)lds_raw;
    C0.wid = __builtin_amdgcn_readfirstlane((int)threadIdx.x >> 6); C0.tid = 0; C0.lane = 0; C0.bid = blockIdx.x; C0.G = gridDim.x;
#define MK_LANE() ((int)__builtin_amdgcn_mbcnt_hi(~0u, __builtin_amdgcn_mbcnt_lo(~0u, 0u)))
#define MK_TID() (C0.wid * 64 + MK_LANE())
    const Ctx& C = C0;
    const int lo = args.ph_lo, hi = args.ph_hi;
    const bool multi = (hi - lo) > 1;
    XcdBarrier bar; bar.w0 = (unsigned)C0.wid; bar.bar = (unsigned*)(C.ws + WS_CTL); bar.x = 0; bar.st = (volatile LAS unsigned*)(C.lds + LDS_XB);
    if (multi) {
        if (C0.wid == 0 && MK_LANE() == 0) *(LAS u32x4*)(C.lds + LDS_XB) = (u32x4){0u, 0u, 0u, 0u};
        __syncthreads();
        bar = xcd_barrier_post((unsigned*)(C.ws + WS_CTL), (volatile LAS unsigned*)(C.lds + LDS_XB), (unsigned)C0.wid);
    }
#define IN(k) (lo <= (k) && (k) < hi)
#define PHASE_CTX(c) Ctx c = C0; { int t_ = MK_TID(); asm volatile("" : "+v"(t_)); c.tid = t_; c.lane = t_ & 63; c.wid = __builtin_amdgcn_readfirstlane(t_ >> 6); }
#ifndef MK_REPEAT
#define MK_REPEAT 0u
#endif
#define RP(k) ((MK_REPEAT >> (k)) & 1u)
#define STAMP(k) do {} while (0)
#define SEAM(k) do { if (IN(k) && IN((k) + 1)) xcd_barrier(bar); STAMP((k) + 1); } while (0)
    STAMP(0);
    if (RP(10)) { for (int i = 0; i < 20; ++i) xcd_barrier(bar); }
    if (PM(0) && IN(0)) { PHASE_CTX(c); ph_prologue(c); if (RP(9)) { xcd_barrier(bar); ph_prologue(c); } } SEAM(0);
    if (PM(1) && IN(1)) { PHASE_CTX(c); ph_norm(c, 0, c.in[6], 0, NROW); } SEAM(1);
    for (int layer = 0; layer < 2; ++layer) {
        const int base = 2 + layer * NPH_LAYER;
        const bool emit = (layer == 0);
        const int nrows = emit ? NROW : NLAT;
        if (PM(2) && IN(base + 0)) {
            pg8::Gemm g{(const bf16_t*)(C.ws + WS_ACT), (const bf16_t*)(C.ws + WS_WIN) + (size_t)layer * NP * DM, NROW, NP, DM};
            pg8::StaticOrder S; S.init(NROW, NP, C.G, C.bid);
            pg8::EpiBf16<0> E{(bf16_t*)(C.ws + WS_P), NP, nullptr, 0, 0};
            pg8::gemm_phase<pg8::EpiBf16<0>, pg8::StaticOrder, false>(C.lds, g, S, E, nullptr, MK_TID());
            if (RP(0)) { xcd_barrier(bar); pg8::gemm_phase<pg8::EpiBf16<0>, pg8::StaticOrder, false>(C.lds, g, S, E, nullptr, MK_TID()); }
            { const int nfull = (NROW / 256) * (NP / 256) - ((NROW / 256) * (NP / 256) / C.G) * C.G; PHASE_CTX(c); if (c.bid >= nfull) convert_tables(c, layer, c.bid - nfull, c.G - nfull); }
        }
        SEAM(base + 0);
        if (PM(3) && IN(base + 1)) {
            const int nD = 2112, nC = 264, nB = emit ? 132 : 128, nA = emit ? 264 : 256, tot = nD + nC + nB + nA;
            for (int rep = 0; rep < (RP(1) ? 2 : 1); ++rep) {
            if (rep) xcd_barrier(bar);
            if (PM(11)) { PHASE_CTX(c); D1Pre pre; pre.hd = -1; for (int it = c.bid; it < nD; it += c.G) item_rwkv_local(c, layer, it, pre, it + c.G < nD ? it + c.G : -1); }
            if (PM(12)) { PHASE_CTX(c); for (int it = (c.bid + 52) % c.G; it < nC; it += c.G) { item_mamba_local(c, layer, it); if (RP(13)) item_mamba_local(c, layer, it); } }
            if (PM(13)) { PHASE_CTX(c); for (int it = (c.bid + 192) % c.G; it < nB; it += c.G) { item_chunkmlp(c, layer, it); if (RP(14)) item_chunkmlp(c, layer, it); } }
            if (PM(14)) { PHASE_CTX(c); for (int it = (c.bid + 60) % c.G; it < nA; it += c.G) { item_conformer(c, layer, it); if (RP(15)) item_conformer(c, layer, it); } }
            }
        }
        SEAM(base + 1);
        if (PM(4) && IN(base + 2)) { PHASE_CTX(c); if (RP(12)) { ph_scan(c, 1, args.ph_hi > 1000, false); xcd_barrier(bar); } ph_scan(c, RP(2) ? 2 : 1); }
        SEAM(base + 2);
        if (PM(5) && IN(base + 3)) {
            const int nc = nrows / 64;
            for (int rep = 0; rep < (RP(3) ? 2 : 1); ++rep) {
            if (rep) xcd_barrier(bar);
            if (PM(15)) { PHASE_CTX(c); load_g2t(c, layer); for (int it = c.bid; it < nc; it += c.G) item_rwkv_out(c, layer, it); }
            __syncthreads();
            if (PM(16)) { PHASE_CTX(c); for (int it = (c.bid + 128) % c.G; it < nc; it += c.G) item_mamba_out(c, layer, it); }
            __syncthreads();
            }
        }
        SEAM(base + 3);
        if (PM(6) && IN(base + 4)) {
            pg8::Gemm g{(const bf16_t*)(C.ws + WS_ACT), (const bf16_t*)(C.ws + WS_WOUT) + (size_t)layer * DM * DM, NLAT, DM, DM};
            pg8::StaticOrder S; S.init(NLAT, DM, C.G, C.bid);
            EpiResid E{(float*)(C.ws + WS_H), (const float*)(C.ws + WS_MOD) + (size_t)layer * 3 * 6144};
            pg8::gemm_phase<EpiResid, pg8::StaticOrder, false>(C.lds, g, S, E, nullptr, MK_TID());
            if (emit) {
                PHASE_CTX(c);
                for (int u = c.bid; u < 256; u += c.G) { const int tr = u >> 4, tc = u & 15;
                    float* Hc = (float*)(c.ws + WS_H) + (size_t)(NLAT + tr * 32) * DM + tc * 64;
                    const float* gate = (const float*)(c.ws + WS_MOD) + ((size_t)layer * 3 + 2) * 6144 + 2 * 1024 + tc * 64;
                    small_gemm_tile<2, 4>(c, (const bf16_t*)(c.ws + WS_ACT) + (size_t)(NLAT + tr * 32) * DM, (const bf16_t*)(c.ws + WS_WOUT) + (size_t)layer * DM * DM + (size_t)(tc * 64) * DM, DM,
                        [=](int r, int cc, const f32x4& acc) {
#pragma unroll
                            for (int j = 0; j < 4; ++j) Hc[(size_t)(r + j) * DM + cc] += gate[cc] * acc[j]; });
                }
            }
        }
        SEAM(base + 4);
        if (PM(7) && IN(base + 5)) { PHASE_CTX(c); for (int rep = 0; rep < (RP(5) ? 2 : 1); ++rep) { if (rep) xcd_barrier(bar); ph_norm(c, layer, c.in[7] + layer * 1024, 3, nrows); } }
        SEAM(base + 5);
        if (PM(8) && IN(base + 6)) {
            pg8::Gemm g{(const bf16_t*)(C.ws + WS_ACT), (const bf16_t*)(C.ws + WS_WQ) + (size_t)layer * 2048 * DM, NLAT, 2048, DM};
            pg8::StaticOrder S; S.init(NLAT, 2048, C.G, C.bid);
            pg8::EpiBf16<0> E{(bf16_t*)(C.ws + WS_Q), 2048, nullptr, 0, 0};
            pg8::gemm_phase<pg8::EpiBf16<0>, pg8::StaticOrder, false>(C.lds, g, S, E, nullptr, MK_TID());
            if (RP(6)) { xcd_barrier(bar); pg8::gemm_phase<pg8::EpiBf16<0>, pg8::StaticOrder, false>(C.lds, g, S, E, nullptr, MK_TID()); }
            if (emit) {
                PHASE_CTX(c);
                for (int u = c.bid; u < 256; u += c.G) { const int tr = u >> 5, tc = u & 31;
                    bf16_t* Qc = (bf16_t*)(c.ws + WS_Q) + (size_t)(NLAT + tr * 64) * 2048 + tc * 64;
                    small_gemm_tile<4, 4>(c, (const bf16_t*)(c.ws + WS_ACT) + (size_t)(NLAT + tr * 64) * DM, (const bf16_t*)(c.ws + WS_WQ) + (size_t)layer * 2048 * DM + (size_t)(tc * 64) * DM, DM,
                        [=](int r, int cc, const f32x4& acc) {
#pragma unroll
                            for (int j = 0; j < 4; ++j) Qc[(size_t)(r + j) * 2048 + cc] = f2bf(acc[j]); });
                }
            }
        }
        SEAM(base + 6);
        if (PM(9) && IN(base + 7)) { PHASE_CTX(c); ph_select(c, layer, nrows); if (RP(7)) { xcd_barrier(bar); ph_select(c, layer, nrows); } }
        SEAM(base + 7);
        if (PM(10) && IN(base + 8)) { PHASE_CTX(c); if (RP(8)) { ph_peer(c, layer, nrows, layer == 1, args.ph_hi > 1000); xcd_barrier(bar); } if (RP(11)) { ph_peer(c, layer, nrows, layer == 1, args.ph_hi > 1000, 1023); xcd_barrier(bar); } ph_peer(c, layer, nrows, layer == 1); }
        SEAM(base + 8);
    }
#undef IN
#undef SEAM
}
}


namespace mk {
struct LaunchEnt { unsigned mask; int ph; };
template <unsigned MASK> static bool prep_kernel() {
    return hipFuncSetAttribute((const void*)hybrid_fwd<MASK>, hipFuncAttributeMaxDynamicSharedMemorySize, LDS_BYTES) == hipSuccess;
}
template <unsigned MASK> static void launch_kernel(int grid, hipStream_t stream, const Args& a) {
    hipLaunchKernelGGL(hybrid_fwd<MASK>, dim3(grid), dim3(512), LDS_BYTES, stream, a);
}
}

#define CENSUS(off, n, kind, stage, lim) do {} while (0)
#ifndef MK_ONE_LAUNCH
#define MK_ONE_LAUNCH 1
#endif
extern "C" void kernel_launch(void* const* d_in, const int* in_sizes, int n_in, void* d_out, int out_size, void* d_ws, size_t ws_size, hipStream_t stream) {
    using namespace mk;
    static int grid = 0;
    if (grid == 0) {
        if (n_in != 42 || ws_size < WS_END) { fprintf(stderr, "kernel_launch: need 42 inputs and %zu bytes of workspace (got %d, %zu)\n", (size_t)WS_END, n_in, ws_size); grid = -1; return; }
        int dev = 0, cus = 0;
        if (hipGetDevice(&dev) != hipSuccess || hipDeviceGetAttribute(&cus, hipDeviceAttributeMultiprocessorCount, dev) != hipSuccess) { grid = -1; return; }
        bool ok = true;
#if MK_ONE_LAUNCH
        ok = ok && prep_kernel<0x1FFFFu>();
#else
        ok = ok && prep_kernel<0x0001u>() && prep_kernel<0x0002u>() && prep_kernel<0x0004u>() && prep_kernel<0x0808u>() && prep_kernel<0x1008u>() && prep_kernel<0x2008u>() && prep_kernel<0x4008u>()
                && prep_kernel<0x0010u>() && prep_kernel<0x8020u>() && prep_kernel<0x10020u>() && prep_kernel<0x0040u>() && prep_kernel<0x0080u>() && prep_kernel<0x0100u>() && prep_kernel<0x0200u>() && prep_kernel<0x0400u>();
#endif
        if (!ok) { fprintf(stderr, "kernel_launch: hipFuncSetAttribute failed\n"); grid = -1; return; }
        (void)hipGetLastError();
        grid = cus;
    }
    if (grid < 0) return;
    (void)hipMemsetAsync((char*)d_ws + WS_CTL, 0, 65536, stream);
    Args a{};
    for (int i = 0; i < 42; ++i) a.in[i] = (const float*)d_in[i];
    a.out = (float*)d_out; a.ws = (unsigned char*)d_ws;
#if MK_ONE_LAUNCH
    a.ph_lo = 0; a.ph_hi = NPH; launch_kernel<0x1FFFFu>(grid, stream, a);
#else
    a.ph_lo = 0; a.ph_hi = 1; launch_kernel<0x0001u>(grid, stream, a);
    CENSUS(WS_H, (size_t)NROW * DM, 0, 1, 1e4f); CENSUS(WS_MOD, 2 * 3 * 6144, 0, 1, 1e4f); CENSUS(WS_WIN, 2ull * NP * DM, 1, 1, 1e4f); CENSUS(WS_UB, 2ull * NEXP * DM, 1, 1, 1e4f);
    a.ph_lo = 1; a.ph_hi = 2; launch_kernel<0x0002u>(grid, stream, a);
    CENSUS(WS_ACT, (size_t)NROW * DM, 1, 2, 1e4f);
    for (int layer = 0; layer < 2; ++layer) {
        const int b = 2 + layer * NPH_LAYER;
        const int so = layer ? 100 : 0; (void)so;
        a.ph_lo = b + 0; a.ph_hi = b + 1; launch_kernel<0x0004u>(grid, stream, a);
        if (!layer) CENSUS(WS_P, (size_t)NROW * NP, 1, 3, 1e4f);
        a.ph_lo = b + 1; a.ph_hi = b + 2; launch_kernel<0x0808u>(grid, stream, a);
        if (!layer) { CENSUS(WS_RG, (size_t)NSLOT * 4096, 1, 4, 1e6f); CENSUS(WS_RJ, (size_t)NSLOT * 4096, 0, 5, 1e6f); CENSUS(WS_RY, (size_t)NSLOT * 4096 * 2, 1, 6, 1e6f); CENSUS(WS_BON, (size_t)NROW * 8, 0, 6, 1e6f); }
        launch_kernel<0x1008u>(grid, stream, a);
        if (!layer) { CENSUS(WS_MST, (size_t)NSLOT * 8192, 0, 7, 1e6f); CENSUS(WS_MCD, NSLOT, 0, 7, 1e6f); }
        launch_kernel<0x2008u>(grid, stream, a); launch_kernel<0x4008u>(grid, stream, a);
        a.ph_lo = b + 2; a.ph_hi = b + 3; launch_kernel<0x0010u>(grid, stream, a);
        if (!layer) { CENSUS(WS_MST, (size_t)NSLOT * 8192, 0, 8, 1e6f); CENSUS(WS_RH, (size_t)NSLOT * 4096, 1, 9, 1e6f); }
        a.ph_lo = b + 3; a.ph_hi = b + 4; launch_kernel<0x8020u>(grid, stream, a); launch_kernel<0x10020u>(grid, stream, a);
        if (!layer) CENSUS(WS_ACT, (size_t)NROW * DM, 1, 10, 1e4f);
        a.ph_lo = b + 4; a.ph_hi = b + 5; launch_kernel<0x0040u>(grid, stream, a);
        if (!layer) CENSUS(WS_H, (size_t)NROW * DM, 0, 11, 1e4f);
        a.ph_lo = b + 5; a.ph_hi = b + 6; launch_kernel<0x0080u>(grid, stream, a);
        a.ph_lo = b + 6; a.ph_hi = b + 7; launch_kernel<0x0100u>(grid, stream, a);
        if (!layer) CENSUS(WS_Q, (size_t)NROW * 2048, 1, 12, 1e4f);
        a.ph_lo = b + 7; a.ph_hi = b + 8; launch_kernel<0x0200u>(grid, stream, a);
        if (!layer) { CENSUS(WS_SELI, (size_t)NROW * 128, 2, 13, 0.f); CENSUS(WS_SELG, (size_t)NROW * 128, 0, 13, 2.f); }
        a.ph_lo = b + 8; a.ph_hi = b + 9; launch_kernel<0x0400u>(grid, stream, a);
        if (!layer) { CENSUS(WS_H, (size_t)NROW * DM, 0, 14, 1e4f); CENSUS(WS_ACT, (size_t)NROW * DM, 1, 15, 1e4f); }
    }
#endif
    (void)in_sizes; (void)out_size;
}
```

```cpp
#include <hip/hip_runtime.h>
#include <cstdio>
#include <cstdint>
namespace pg8 {
#define PG8_LAS __attribute__((address_space(3)))
typedef unsigned short bf16_t;
typedef short bf16x8 __attribute__((ext_vector_type(8)));
typedef float f32x4 __attribute__((ext_vector_type(4)));
typedef unsigned u32x4 __attribute__((ext_vector_type(4)));
constexpr int BM = 256, BK = 64, HALF = 128, HTB = HALF * BK * 2  , STAGE_BYTES = 8 * HTB, NXCD = 8, WGM = 8;

__host__ __device__ __forceinline__ int lds_byte(int r, int c) { const int st = (r >> 4) * 2 + (c >> 5), rr = r & 15, cc = c & 31, ob = rr * 64 + cc * 2; return st * 1024 + (ob ^ (((ob >> 9) & 1) << 5)); }
__host__ __device__ __forceinline__ void stage_rc(int b, int& R, int& C) { const int st = b / 1024, sb = b % 1024, swz = sb ^ (((sb >> 9) & 1) << 5); R = (st >> 1) * 16 + swz / 64; C = (st & 1) * 32 + (swz % 64) / 2; }
__host__ __device__ __forceinline__ int perm32(int rho) { const int n = rho >> 4, i = rho & 15; return 8 * (i >> 2) + 4 * n + (i & 3); }

struct Unit { int pm, pn; };
struct Gemm { const bf16_t* A; const bf16_t* Bt; int M, N, K; };

struct StaticOrder {
    int nM, nN, nwg, G, c;
    __host__ __device__ void init(int M, int N, int G_, int c_) { nM = M / BM; nN = N / BM; nwg = nM * nN; G = G_; c = c_; }
    __host__ __device__ bool next(int i, Unit& u) const {
        const long L = (long)i * G + c; if (L >= nwg) return false;
        int wgid = (int)L; { const int q = nwg / NXCD, r = nwg % NXCD, xcd = wgid % NXCD, off = wgid / NXCD; wgid = (xcd < r ? xcd * (q + 1) : r * (q + 1) + (xcd - r) * q) + off; }
        const int nig = WGM * nN, gid = wgid / nig, fm = gid * WGM, gsz = (nM - fm) < WGM ? (nM - fm) : WGM;
        u.pm = fm + ((wgid % nig) % gsz); u.pn = (wgid % nig) / gsz; return true;
    }
    __device__ __forceinline__ void a_ready(const Unit&) const {}
    __device__ __forceinline__ void done(const Unit&) const {}
};
struct CountedOrder : StaticOrder {
    const unsigned* ready; unsigned need; unsigned* tmo;
    __device__ __forceinline__ void a_ready(const Unit& u) const {
        if (threadIdx.x < 64) {
            const unsigned long long t0 = __builtin_amdgcn_s_memrealtime(); unsigned polls = 0;
            while ((unsigned)__builtin_amdgcn_readfirstlane(__hip_atomic_load(ready + 64 * u.pm, __ATOMIC_RELAXED, __HIP_MEMORY_SCOPE_AGENT)) < need) {
                if ((++polls & 255u) == 0u && __builtin_amdgcn_readfirstlane(__hip_atomic_load(tmo, __ATOMIC_RELAXED, __HIP_MEMORY_SCOPE_AGENT)) != 0u) break;
                if (__builtin_amdgcn_s_memrealtime() - t0 > 2000000ull) {
                    if (threadIdx.x == 0) { unsigned expect = 0u; __hip_atomic_compare_exchange_strong(tmo + 1, &expect, 0x600u | (unsigned)(u.pm & 0xff), __ATOMIC_RELAXED, __ATOMIC_RELAXED, __HIP_MEMORY_SCOPE_AGENT); __hip_atomic_store(tmo, 1u, __ATOMIC_RELAXED, __HIP_MEMORY_SCOPE_AGENT); }
                    break; }
                __builtin_amdgcn_s_sleep(2); }
            __builtin_amdgcn_fence(__ATOMIC_ACQUIRE, "agent");
            asm volatile("s_waitcnt vmcnt(0)" ::: "memory");
        }
#if !defined(BROKEN_HOOK_NO_BARRIER)
        asm volatile("" ::: "memory"); __builtin_amdgcn_s_barrier(); asm volatile("" ::: "memory");
#endif
    }
};

__device__ __forceinline__ unsigned cvt_pk_bf16(float lo, float hi) { unsigned r; asm volatile("v_cvt_pk_bf16_f32 %0, %1, %2" : "=v"(r) : "v"(lo), "v"(hi)); return r; }
typedef float f32x2 __attribute__((ext_vector_type(2)));
__device__ __forceinline__ f32x2 gelu_pk(f32x2 v) {
    const f32x2 av = __builtin_elementwise_abs(v), d = av * 0.2316418882f + 1.0f;
    f32x2 t; t.x = __builtin_amdgcn_rcpf(d.x); t.y = __builtin_amdgcn_rcpf(d.y);
    f32x2 q = t * 0.5307027145f + (-0.7265760135f); q = q * t + 0.7107068705f; q = q * t + (-0.142248368f); q = q * t + 0.127414796f; q = q * t;
    const f32x2 s = (v * v) * (-0.72134752044f);
    f32x2 e; e.x = __builtin_amdgcn_exp2f(s.x); e.y = __builtin_amdgcn_exp2f(s.y);
    const f32x2 m = v * (q * e), r = v - m;
    f32x2 o; o.x = v.x < 0.f ? m.x : r.x; o.y = v.y < 0.f ? m.y : r.y; return o;
}

struct EpiF32 {
    static constexpr bool PERM = false, AFTER_DRAIN = false;
    float* C; int ldc; const float* bias;
    __device__ __forceinline__ void operator()(const f32x4 (&acc)[2][2][4][2], const Unit& u, int wr, int wc, int fr, int fq) const {
        const int row0 = u.pm * BM + wr * 64 + fr, col0 = u.pn * BM + wc * 32 + 4 * fq;
        f32x4 bv[2][2];
#pragma unroll
        for (int bj = 0; bj < 2; ++bj)
#pragma unroll
            for (int n = 0; n < 2; ++n) bv[bj][n] = bias ? *(const f32x4*)(bias + col0 + bj * HALF + n * 16) : (f32x4){0.f, 0.f, 0.f, 0.f};
#pragma unroll
        for (int ai = 0; ai < 2; ++ai)
#pragma unroll
            for (int m = 0; m < 4; ++m) { float* rowp = C + (size_t)(row0 + ai * HALF + m * 16) * ldc + col0;
#pragma unroll
                for (int bj = 0; bj < 2; ++bj)
#pragma unroll
                    for (int n = 0; n < 2; ++n) *(f32x4*)(rowp + bj * HALF + n * 16) = acc[ai][bj][m][n] + bv[bj][n]; }
    }
};
template <int ACT  > struct EpiBf16 {
    static constexpr bool PERM = true, AFTER_DRAIN = false;
    bf16_t* O; int ldc; const float* bias; int split_cols; size_t split_stride;
    __device__ __forceinline__ void operator()(const f32x4 (&acc)[2][2][4][2], const Unit& u, int wr, int wc, int fr, int fq) const {
        const int row0 = u.pm * BM + wr * 64 + fr; int colt = u.pn * BM; bf16_t* base = O;
        if (split_cols) { const int t = colt / split_cols; base += (size_t)t * split_stride; colt -= t * split_cols; }
        const int col0 = colt + wc * 32 + 8 * fq, bcol0 = u.pn * BM + wc * 32 + 8 * fq;
        f32x4 bv[2][2];
#pragma unroll
        for (int bj = 0; bj < 2; ++bj)
#pragma unroll
            for (int n = 0; n < 2; ++n) bv[bj][n] = bias ? *(const f32x4*)(bias + bcol0 + bj * HALF + 4 * n) : (f32x4){0.f, 0.f, 0.f, 0.f};
#pragma unroll
        for (int ai = 0; ai < 2; ++ai)
#pragma unroll
            for (int m = 0; m < 4; ++m) { bf16_t* rowp = base + (size_t)(row0 + ai * HALF + m * 16) * ldc + col0;
#pragma unroll
                for (int bj = 0; bj < 2; ++bj) { f32x4 v0 = acc[ai][bj][m][0] + bv[bj][0], v1 = acc[ai][bj][m][1] + bv[bj][1];
                    if (ACT == 1) { f32x2 a = gelu_pk((f32x2){v0[0], v0[1]}), b = gelu_pk((f32x2){v0[2], v0[3]}), c = gelu_pk((f32x2){v1[0], v1[1]}), d = gelu_pk((f32x2){v1[2], v1[3]});
                        v0 = (f32x4){a.x, a.y, b.x, b.y}; v1 = (f32x4){c.x, c.y, d.x, d.y}; }
                    if (ACT == 2) {
#pragma unroll
                        for (int j = 0; j < 4; ++j) { v0[j] = 0.5f * v0[j] * (1.0f + erff(v0[j] * 0.70710678f)); v1[j] = 0.5f * v1[j] * (1.0f + erff(v1[j] * 0.70710678f)); } }
                    u32x4 w; w.x = cvt_pk_bf16(v0[0], v0[1]); w.y = cvt_pk_bf16(v0[2], v0[3]); w.z = cvt_pk_bf16(v1[0], v1[1]); w.w = cvt_pk_bf16(v1[2], v1[3]);
                    *(u32x4*)(rowp + bj * HALF) = w; } }
    }
};
template <class Epi, class Sched, bool STAMP = false>
__device__ __forceinline__ void gemm_phase(PG8_LAS unsigned char* lds, const Gemm g, const Sched& S, const Epi& E, unsigned long long* stamps, int tid_in) {
    int tid_ = tid_in; asm volatile("" : "+v"(tid_));
    const int tid = tid_, wid = __builtin_amdgcn_readfirstlane(tid >> 6), lane = tid & 63, wr = wid >> 2, wc = wid & 3, fr = lane & 15, fq = lane >> 4;
    const int K = g.K, nt = K / BK;
    int ts_lo = 0, ts_hi = 0, nts = 0; const unsigned long long rt_entry = STAMP ? (unsigned long long)wall_clock64() : 0ull;
#define PG8_STAMP() do { if (STAMP && wid == 0 && nts < 64) { const unsigned long long _c = (unsigned long long)clock64(); \
        ts_lo = (lane == nts) ? (int)(unsigned)_c : ts_lo; ts_hi = (lane == nts) ? (int)(unsigned)(_c >> 32) : ts_hi; ++nts; } } while (0)
    PG8_STAMP();
    unsigned voffA[2], voffB[2];
#pragma unroll
    for (int i = 0; i < 2; ++i) { int R, C; stage_rc(tid * 16 + i * 8192, R, C); const int Rb = Epi::PERM ? ((R & ~31) + perm32(R & 31)) : R;
        voffA[i] = (unsigned)(R * K + C) * 2u; voffB[i] = (unsigned)(Rb * K + C) * 2u; }
    const size_t kstep = (size_t)(BK * 2);
    const size_t hstep = (size_t)HALF * K * 2;
    const size_t tstep = 2 * hstep;
    const unsigned ldsw = (unsigned)wid * 1024u;
    const int aoff = lds_byte(wr * 64 + fr, fq * 8), boff = lds_byte(wc * 32 + fr, fq * 8);
#define PG8_SA(b, h) (((b) * 2 + (h)) * HTB)
#define PG8_SB(b, h) ((4 + (b) * 2 + (h)) * HTB)
#define PG8_STAGE(bufoff, gbase, voff) do { _Pragma("unroll") for (int _i = 0; _i < 2; ++_i) \
        __builtin_amdgcn_global_load_lds((const unsigned*)((const char*)(gbase) + (voff)[_i]), (PG8_LAS unsigned*)(lds + (bufoff) + ldsw + _i * 8192), 16, 0, 0); } while (0)
#define PG8_LDA(dst, b, h) do { _Pragma("unroll") for (int m = 0; m < 4; ++m) _Pragma("unroll") for (int k = 0; k < 2; ++k) dst[m][k] = *(const PG8_LAS bf16x8*)(lds + PG8_SA(b, h) + aoff + m * 2048 + k * 1024); } while (0)
#define PG8_LDB(dst, b, h) do { _Pragma("unroll") for (int n = 0; n < 2; ++n) _Pragma("unroll") for (int k = 0; k < 2; ++k) dst[n][k] = *(const PG8_LAS bf16x8*)(lds + PG8_SB(b, h) + boff + n * 2048 + k * 1024); } while (0)
#define PG8_MMA(ai, bj, At, Bt) do { __builtin_amdgcn_s_setprio(1); _Pragma("unroll") for (int m = 0; m < 4; ++m) _Pragma("unroll") for (int n = 0; n < 2; ++n) _Pragma("unroll") for (int k = 0; k < 2; ++k) \
        acc[ai][bj][m][n] = __builtin_amdgcn_mfma_f32_16x16x32_bf16(Bt[n][k], At[m][k], acc[ai][bj][m][n], 0, 0, 0); __builtin_amdgcn_s_setprio(0); } while (0)
#define PG8_WAIT_V(n) asm volatile("s_waitcnt vmcnt(" #n ")" ::: "memory")
#define PG8_WAIT_L(n) asm volatile("s_waitcnt lgkmcnt(" #n ")" ::: "memory")
#define PG8_BAR __builtin_amdgcn_s_barrier()
#define PG8_SCHED __builtin_amdgcn_sched_barrier(0)
    Unit cur, nxt; int ui = 0;
    if (!S.next(0, cur)) return;
    f32x4 acc[2][2][4][2];
#pragma unroll
    for (int a = 0; a < 2; ++a)
#pragma unroll
        for (int b = 0; b < 2; ++b)
#pragma unroll
            for (int m = 0; m < 4; ++m)
#pragma unroll
                for (int n = 0; n < 2; ++n) acc[a][b][m][n] = (f32x4){0.f, 0.f, 0.f, 0.f};
    bf16x8 At[4][2], B0[2][2], B1[2][2];
    const char* cA = (const char*)g.A + (size_t)cur.pm * tstep; const char* cB = (const char*)g.Bt + (size_t)cur.pn * tstep;
    S.a_ready(cur);
    PG8_STAGE(PG8_SB(0, 0), cB, voffB); PG8_STAGE(PG8_SA(0, 0), cA, voffA); PG8_STAGE(PG8_SB(0, 1), cB + hstep, voffB); PG8_STAGE(PG8_SA(0, 1), cA + hstep, voffA);
    if (wr == 1) PG8_BAR;
    PG8_WAIT_V(4); PG8_BAR;
    PG8_STAGE(PG8_SB(1, 0), cB + kstep, voffB); PG8_STAGE(PG8_SA(1, 0), cA + kstep, voffA); PG8_STAGE(PG8_SB(1, 1), cB + hstep + kstep, voffB);
    PG8_WAIT_V(6); PG8_BAR;
    PG8_STAMP();
    for (;;) {
        const bool has_next = S.next(ui + 1, nxt);
        const char* nA = has_next ? (const char*)g.A + (size_t)nxt.pm * tstep : cA; const char* nB = has_next ? (const char*)g.Bt + (size_t)nxt.pn * tstep : cB;
        for (int t = 0; t < nt; t += 2) {
            const bool last = (t == nt - 2);
            const char* a1 = cA + (size_t)(t + 1) * kstep;
            const char* a2 = last ? nA : cA + (size_t)(t + 2) * kstep; const char* b2 = last ? nB : cB + (size_t)(t + 2) * kstep;
            const char* a3 = a2 + kstep; const char* b3 = b2 + kstep;
            if (last && has_next) S.a_ready(nxt);
            PG8_LDB(B0, 0, 0); PG8_SCHED; PG8_LDA(At, 0, 0); PG8_STAGE(PG8_SA(1, 1), a1 + hstep, voffA);
            PG8_WAIT_L(8); PG8_BAR; PG8_WAIT_L(0); PG8_MMA(0, 0, At, B0); PG8_BAR; PG8_SCHED;
            PG8_LDB(B1, 0, 1); PG8_STAGE(PG8_SB(0, 0), b2, voffB);
            PG8_BAR; PG8_WAIT_L(0); PG8_MMA(0, 1, At, B1); PG8_BAR;
            PG8_LDA(At, 0, 1); PG8_STAGE(PG8_SA(0, 0), a2, voffA);
            PG8_BAR; PG8_WAIT_L(0); PG8_MMA(1, 0, At, B0); PG8_BAR; PG8_SCHED;
            PG8_STAGE(PG8_SB(0, 1), b2 + hstep, voffB);
            PG8_WAIT_V(6); PG8_BAR; PG8_MMA(1, 1, At, B1); PG8_BAR;
            PG8_LDB(B0, 1, 0); PG8_SCHED; PG8_LDA(At, 1, 0); PG8_STAGE(PG8_SA(0, 1), a2 + hstep, voffA);
            PG8_WAIT_L(8); PG8_BAR; PG8_WAIT_L(0); PG8_MMA(0, 0, At, B0); PG8_BAR; PG8_SCHED;
            PG8_LDB(B1, 1, 1); PG8_STAGE(PG8_SB(1, 0), b3, voffB);
            PG8_BAR; PG8_WAIT_L(0); PG8_MMA(0, 1, At, B1); PG8_BAR;
            PG8_LDA(At, 1, 1); PG8_STAGE(PG8_SA(1, 0), a3, voffA);
            PG8_BAR; PG8_WAIT_L(0); PG8_MMA(1, 0, At, B0); PG8_BAR; PG8_SCHED;
            PG8_STAGE(PG8_SB(1, 1), b3 + hstep, voffB);
            PG8_WAIT_V(6); PG8_BAR; PG8_MMA(1, 1, At, B1); PG8_BAR;
        }
        PG8_STAMP();
        if constexpr (!Epi::AFTER_DRAIN) { E(acc, cur, wr, wc, fr, fq); S.done(cur); }
        PG8_STAMP();
        if (!has_next) break;
#pragma unroll
        for (int a = 0; a < 2; ++a)
#pragma unroll
            for (int b = 0; b < 2; ++b)
#pragma unroll
                for (int m = 0; m < 4; ++m)
#pragma unroll
                    for (int n = 0; n < 2; ++n) acc[a][b][m][n] = (f32x4){0.f, 0.f, 0.f, 0.f};
        cur = nxt; cA = nA; cB = nB; ++ui;
    }
    PG8_WAIT_V(0);
    if (wr == 0) PG8_BAR;
    PG8_BAR;
    if constexpr (Epi::AFTER_DRAIN) { E.fused(acc, cur, wr, wc, fr, fq, lds, wid, lane); S.done(cur); }
    PG8_STAMP();
    if (STAMP && wid == 0) { stamps[lane] = lane < nts ? (((unsigned long long)(unsigned)ts_hi << 32) | (unsigned)ts_lo) : 0ull;
        if (lane == 62) stamps[62] = rt_entry; if (lane == 63) stamps[63] = (unsigned long long)wall_clock64(); }
#undef PG8_STAMP
#undef PG8_SA
#undef PG8_SB
#undef PG8_STAGE
#undef PG8_LDA
#undef PG8_LDB
#undef PG8_MMA
#undef PG8_WAIT_V
#undef PG8_WAIT_L
#undef PG8_BAR
#undef PG8_SCHED
}
}
#define XB_TMO      128
#define XB_XCNT(j)  (256  + 64 * (j))
#define XB_XSUB(j)  (1280 + 64 * (j))
#define XB_XGEN(j)  (2304 + 64 * (j))
#define XB_TOP      3328
#define XB_TOPGEN   3392
#define XCD_BAR_WORDS 3456
#define XB_SPIN_CAP (1u << 18)
#define LAS __attribute__((address_space(3)))

__device__ __forceinline__ unsigned xb_ld(unsigned* p)              { return __hip_atomic_load(p, __ATOMIC_RELAXED, __HIP_MEMORY_SCOPE_AGENT); }
__device__ __forceinline__ unsigned xb_add(unsigned* p, unsigned v) { return __hip_atomic_fetch_add(p, v, __ATOMIC_RELAXED, __HIP_MEMORY_SCOPE_AGENT); }
__device__ __forceinline__ unsigned xb_xcc_id() { return (unsigned)__builtin_amdgcn_s_getreg((3 << 11) | 20) & 0xFu; }
#define XB_SPIN(cond, bar) do { unsigned _sp = 0; while (cond) { __builtin_amdgcn_s_sleep(1); \
    if ((++_sp & 255u) == 0u) { if (xb_ld(&(bar)[XB_TMO])) break; if (_sp > XB_SPIN_CAP) { atomicAdd(&(bar)[XB_TMO], 1u); break; } } } } while (0)

#define XB_LANE0() (__builtin_amdgcn_mbcnt_hi(~0u, __builtin_amdgcn_mbcnt_lo(~0u, 0u)) == 0u)
struct XcdBarrier {
    unsigned w0;
    unsigned* bar; unsigned x;
    volatile LAS unsigned* st;
};

__device__ __forceinline__ XcdBarrier xcd_barrier_post(unsigned* bar, volatile LAS unsigned* st, unsigned w0) {
    XcdBarrier b; b.w0 = w0; b.bar = bar; b.x = xb_xcc_id(); b.st = st;
    if (w0 == 0u && XB_LANE0()) (void)xb_add(&bar[XB_XCNT(b.x)], 1u);
    return b;
}
__device__ __forceinline__ void xcd_barrier_complete(unsigned* bar, unsigned x, unsigned& nloc, unsigned& nx) {
    const unsigned G = gridDim.x * gridDim.y * gridDim.z;
    unsigned sum, cnt, mine, sp = 0u;
    for (;;) {
        sum = 0u; cnt = 0u; mine = 0u;
#pragma unroll
        for (unsigned j = 0; j < 16; ++j) { const unsigned c = xb_ld(&bar[XB_XCNT(j)]); sum += c; cnt += (c > 0u) ? 1u : 0u; mine = (j == x) ? c : mine; }
        if (sum == G) break;
        __builtin_amdgcn_s_sleep(1);
        if ((++sp & 255u) == 0u) { if (xb_ld(&bar[XB_TMO])) break; if (sp > XB_SPIN_CAP) { atomicAdd(&bar[XB_TMO], 1u); break; } }
    }
    nloc = mine > 0u ? mine : 1u; nx = cnt > 0u ? cnt : 1u;
}

__device__ __forceinline__ void xcd_barrier(const XcdBarrier& b) {
    asm volatile("s_waitcnt vmcnt(0)" ::: "memory");
    __syncthreads();
    if (b.w0 == 0u && XB_LANE0()) {
        unsigned* bar = b.bar;
        __builtin_amdgcn_s_waitcnt(0);
        unsigned nloc = b.st[0], nx = b.st[1];
        if (nloc == 0u) { xcd_barrier_complete(bar, b.x, nloc, nx); b.st[0] = nloc; b.st[1] = nx; }
        const unsigned old = xb_add(&bar[XB_XSUB(b.x)], 1u);
        const unsigned gen = old / nloc;
        if (old + 1u == (gen + 1u) * nloc) {
            __builtin_amdgcn_fence(__ATOMIC_RELEASE, "agent");
            asm volatile("s_waitcnt vmcnt(0)" ::: "memory");
            const unsigned og = xb_add(&bar[XB_TOP], 1u);
            const unsigned tg = og / nx;
            if (og + 1u == (tg + 1u) * nx) xb_add(&bar[XB_TOPGEN], 1u);
            else XB_SPIN(xb_ld(&bar[XB_TOPGEN]) == tg, bar);
            __builtin_amdgcn_fence(__ATOMIC_ACQUIRE, "agent");
            xb_add(&bar[XB_XGEN(b.x)], 1u);
            asm volatile("s_waitcnt vmcnt(0)" ::: "memory");
        } else {
            XB_SPIN(xb_ld(&bar[XB_XGEN(b.x)]) == gen, bar);
            __builtin_amdgcn_fence(__ATOMIC_ACQUIRE, "agent");
            asm volatile("s_waitcnt vmcnt(0)" ::: "memory");
        }
    }
    __syncthreads();
}

namespace mk {
using pg8::bf16_t; using pg8::bf16x8; using pg8::f32x4; using pg8::u32x4;
typedef unsigned u32x2 __attribute__((ext_vector_type(2)));
typedef __bf16 bf16x2_t __attribute__((ext_vector_type(2)));
typedef LAS unsigned char* lds_t;

constexpr int DM = 1024, NLAT = 16384, NROW = 16896;
constexpr int OFF_B = 512, OFF_C = 1024, OFF_D = 2056, INC = 3208, NP = 3328;
constexpr int NCH = 132, NSLOT = 16 * NCH;
constexpr int NEXP = 16384;

constexpr size_t WS_CTL  = 0;
constexpr size_t WS_MOD  = 65536;
constexpr size_t WS_WIN  = WS_MOD + 147456;
constexpr size_t WS_WOUT = WS_WIN + 2ull * NP * DM * 2;
constexpr size_t WS_WQ   = WS_WOUT + 2ull * DM * DM * 2;
constexpr size_t WS_H    = WS_WQ + 2ull * 2048 * DM * 2;
constexpr size_t WS_ACT  = WS_H + (size_t)NROW * DM * 4;
constexpr size_t WS_UB   = WS_ACT + (size_t)NROW * DM * 2;
constexpr size_t WS_VB   = WS_UB + (size_t)NEXP * DM * 2;
constexpr size_t WS_SU   = WS_UB + (size_t)NEXP * DM;
constexpr size_t WS_SV   = WS_VB + (size_t)NEXP * DM;
constexpr size_t WS_P    = WS_VB + (size_t)NEXP * DM * 2;
constexpr size_t WS_Q    = WS_P;
constexpr size_t WS_SELI = WS_Q + (size_t)NROW * 2048 * 2;
constexpr size_t WS_SELG = WS_SELI + (size_t)NROW * 128 * 4;
constexpr size_t WS_MST  = WS_P + (size_t)NROW * NP * 2;
constexpr size_t WS_MCD  = WS_MST + (size_t)NSLOT * 8192 * 4;
constexpr size_t WS_RG   = WS_MCD + 16384;
constexpr size_t WS_RJ   = WS_RG + (size_t)NSLOT * 8192;
constexpr size_t WS_RY   = WS_RJ + (size_t)NSLOT * 16384;
constexpr size_t WS_RL   = WS_RY + (size_t)NSLOT * 8192;
constexpr size_t WS_RH   = WS_RL + (size_t)NSLOT * 8192;
constexpr size_t WS_BON  = WS_RH + (size_t)NSLOT * 8192;
constexpr size_t WS_END  = WS_BON + (size_t)NROW * 8 * 4;
static_assert(WS_SELG + (size_t)NROW * 128 * 4 <= WS_MST, "Q + selections must fit in P's region");

constexpr int LDS_BYTES = 157440;
constexpr int LDS_XB = 157184;

struct Args { const float* in[42]; float* out; unsigned char* ws; int ph_lo, ph_hi; };

struct Ctx {
    const float* const* in; float* out; unsigned char* ws; lds_t lds;
    int tid, lane, wid, bid, G;
};

__device__ __forceinline__ float bf2f(unsigned short x) { return __uint_as_float(((unsigned)x) << 16); }
__device__ __forceinline__ float bflo(unsigned w) { return __uint_as_float(w << 16); }
__device__ __forceinline__ float bfhi(unsigned w) { return __uint_as_float(w & 0xffff0000u); }
typedef __bf16 bf16pair_t __attribute__((ext_vector_type(2)));
__device__ __forceinline__ unsigned pk2(float lo, float hi) { const bf16pair_t v = {(__bf16)lo, (__bf16)hi}; return __builtin_bit_cast(unsigned, v); }
__device__ __forceinline__ unsigned short f2bf(float f) { return (unsigned short)(pk2(f, 0.f) & 0xffffu); }
#define dpp_f(old, src, ctrl, row_mask, bank_mask) __uint_as_float((unsigned)__builtin_amdgcn_update_dpp((int)__float_as_uint(old), (int)__float_as_uint(src), ctrl, row_mask, bank_mask, true))
__device__ __forceinline__ float wave_sum(float v) {
    v += dpp_f(0.f, v, 0xB1, 0xF, 0xF);
    v += dpp_f(0.f, v, 0x4E, 0xF, 0xF);
    v += dpp_f(0.f, v, 0x141, 0xF, 0xF);
    v += dpp_f(0.f, v, 0x140, 0xF, 0xF);
    v += dpp_f(0.f, v, 0x142, 0xA, 0xF);
    v += dpp_f(0.f, v, 0x143, 0xC, 0xF);
    return __uint_as_float((unsigned)__builtin_amdgcn_readlane((int)__float_as_uint(v), 63));
}
__device__ __forceinline__ float wave_incl_scan(float v, int lane) {
    (void)lane;
    float s = v + dpp_f(0.f, v, 0x111, 0xF, 0xF);
    s += dpp_f(0.f, v, 0x112, 0xF, 0xF);
    s += dpp_f(0.f, v, 0x113, 0xF, 0xF);
    s += dpp_f(0.f, s, 0x114, 0xF, 0xE);
    s += dpp_f(0.f, s, 0x118, 0xF, 0xC);
    s += dpp_f(0.f, s, 0x142, 0xA, 0xF);
    s += dpp_f(0.f, s, 0x143, 0xC, 0xF);
    return s;
}
__device__ __forceinline__ float fexp(float x) { return __expf(x); }
__device__ __forceinline__ float frcp(float x) { return __builtin_amdgcn_rcpf(x); }
__device__ __forceinline__ float sigm(float x) { return frcp(1.f + __expf(-x)); }
__device__ __forceinline__ float silu(float x) { return x * frcp(1.f + __expf(-x)); }
__device__ __forceinline__ float softplus(float x) { return fmaxf(x, 0.f) + __logf(1.f + __expf(-fabsf(x))); }
__device__ __forceinline__ float ftanh(float x) { const float e = __expf(-2.f * fabsf(x)); const float t = (1.f - e) * frcp(1.f + e); return x < 0.f ? -t : t; }
__device__ __forceinline__ float gelu_tanh(float x) { const float u = 0.7978845608028654f * (x + 0.044715f * x * x * x); return 0.5f * x * (1.f + ftanh(u)); }
__device__ __forceinline__ float dot2bf(unsigned a, unsigned b, float acc) { return __builtin_amdgcn_fdot2_f32_bf16(__builtin_bit_cast(bf16x2_t, a), __builtin_bit_cast(bf16x2_t, b), acc, false); }

struct ChunkInfo { int row0, lo, hi, b, tc, isctx; };
__device__ __forceinline__ ChunkInfo chunk_info(int gc) {
    ChunkInfo c; c.row0 = gc * 64;
    if (gc < 256) { c.b = gc >> 7; c.tc = gc & 127; c.isctx = 0; c.lo = c.b * 8192; c.hi = c.lo + 8192; }
    else { const int q = gc - 256; c.b = q >> 2; c.tc = q & 3; c.isctx = 1; c.lo = NLAT + c.b * 256; c.hi = c.lo + 256; }
    return c;
}
__device__ __forceinline__ int cpos_of(const ChunkInfo& c, int d) { return c.isctx ? (d ? 3 - c.tc : c.tc) : (d ? 4 + 127 - c.tc : 4 + c.tc); }
__device__ __forceinline__ int slot_of(int b, int h, int d, int cpos) { return ((b * 4 + h) * 2 + d) * NCH + cpos; }

template <int MT, int NT, int KS, class Epi>
__device__ __forceinline__ void blk_mma(const LAS bf16_t* A, int lda, const LAS bf16_t* Bt, int ldb, int wid, int lane, Epi epi) {
    const int fr = lane & 15, fq = lane >> 4;
    for (int tt = wid; tt < MT * NT; tt += 8) {
        const int tm = tt / NT, tn = tt % NT;
        f32x4 acc = {0.f, 0.f, 0.f, 0.f};
#pragma unroll
        for (int ks = 0; ks < KS; ++ks) {
            const bf16x8 a = *(const LAS bf16x8*)(A + (tm * 16 + fr) * lda + ks * 32 + fq * 8);
            const bf16x8 b = *(const LAS bf16x8*)(Bt + (tn * 16 + fr) * ldb + ks * 32 + fq * 8);
            acc = __builtin_amdgcn_mfma_f32_16x16x32_bf16(a, b, acc, 0, 0, 0);
        }
        epi(tm * 16 + fq * 4, tn * 16 + fr, acc);
    }
}
template <int MT, int NT, int KS, class Epi>
__device__ __forceinline__ void blk_mma2(const LAS bf16_t* A1, const LAS bf16_t* B1, const LAS bf16_t* A2, const LAS bf16_t* B2, int ld, int wid, int lane, Epi epi) {
    const int fr = lane & 15, fq = lane >> 4;
    for (int tt = wid; tt < MT * NT; tt += 8) {
        const int tm = tt / NT, tn = tt % NT;
        f32x4 acc1 = {0.f, 0.f, 0.f, 0.f}, acc2 = {0.f, 0.f, 0.f, 0.f};
#pragma unroll
        for (int ks = 0; ks < KS; ++ks) {
            const bf16x8 a1 = *(const LAS bf16x8*)(A1 + (tm * 16 + fr) * ld + ks * 32 + fq * 8);
            const bf16x8 b1 = *(const LAS bf16x8*)(B1 + (tn * 16 + fr) * ld + ks * 32 + fq * 8);
            acc1 = __builtin_amdgcn_mfma_f32_16x16x32_bf16(a1, b1, acc1, 0, 0, 0);
            const bf16x8 a2 = *(const LAS bf16x8*)(A2 + (tm * 16 + fr) * ld + ks * 32 + fq * 8);
            const bf16x8 b2 = *(const LAS bf16x8*)(B2 + (tn * 16 + fr) * ld + ks * 32 + fq * 8);
            acc2 = __builtin_amdgcn_mfma_f32_16x16x32_bf16(a2, b2, acc2, 0, 0, 0);
        }
        epi(tm * 16 + fq * 4, tn * 16 + fr, acc1, acc2);
    }
}


template <int MT, int NT, class Epi>
__device__ __forceinline__ void small_gemm_tile(const Ctx& C, const bf16_t* A, const bf16_t* Bt, int K, Epi epi) {
    constexpr int AR = MT * 16, BR = NT * 16, PITCH = 264, NA = AR * 32 / 512, NB = BR * 32 / 512;
    LAS bf16_t* As = (LAS bf16_t*)C.lds; LAS bf16_t* Bs = As + AR * PITCH;
    u32x4 ra[NA], rb[NB];
    auto fetch = [&](int k0) {
#pragma unroll
        for (int i = 0; i < NA; ++i) { const int e = C.tid + 512 * i; ra[i] = *(const u32x4*)(A + (size_t)(e >> 5) * K + k0 + (e & 31) * 8); }
#pragma unroll
        for (int i = 0; i < NB; ++i) { const int e = C.tid + 512 * i; rb[i] = *(const u32x4*)(Bt + (size_t)(e >> 5) * K + k0 + (e & 31) * 8); } };
    const int fr = C.lane & 15, fq = C.lane >> 4;
    constexpr int TPW = (MT * NT + 7) / 8;
    f32x4 acc[TPW];
#pragma unroll
    for (int i = 0; i < TPW; ++i) acc[i] = (f32x4){0.f, 0.f, 0.f, 0.f};
    fetch(0);
    for (int k0 = 0; k0 < K; k0 += 256) {
        __syncthreads();
#pragma unroll
        for (int i = 0; i < NA; ++i) { const int e = C.tid + 512 * i; *(LAS u32x4*)(As + (e >> 5) * PITCH + (e & 31) * 8) = ra[i]; }
#pragma unroll
        for (int i = 0; i < NB; ++i) { const int e = C.tid + 512 * i; *(LAS u32x4*)(Bs + (e >> 5) * PITCH + (e & 31) * 8) = rb[i]; }
        if (k0 + 256 < K) fetch(k0 + 256);
        __syncthreads();
#pragma unroll
        for (int i = 0; i < TPW; ++i) { const int tt = C.wid + 8 * i; if (tt < MT * NT) { const int tm = tt / NT, tn = tt % NT;
#pragma unroll
            for (int ks = 0; ks < 8; ++ks) acc[i] = __builtin_amdgcn_mfma_f32_16x16x32_bf16(*(const LAS bf16x8*)(As + (tm * 16 + fr) * PITCH + ks * 32 + fq * 8),
                                                                                           *(const LAS bf16x8*)(Bs + (tn * 16 + fr) * PITCH + ks * 32 + fq * 8), acc[i], 0, 0, 0); } }
    }
#pragma unroll
    for (int i = 0; i < TPW; ++i) { const int tt = C.wid + 8 * i; if (tt < MT * NT) epi((tt / NT) * 16 + fq * 4, (tt % NT) * 16 + fr, acc[i]); }
    __syncthreads();
}

__device__ __forceinline__ void transpose_item(const float* W, int K, int N, int nblk, bf16_t* WT, LAS float* scr, int item, int lane) {
    const int kb = item / nblk, nb = item % nblk, k0 = 64 * kb, n0 = 32 * nb;
    const int nn = n0 + (lane & 31);
#pragma unroll 8
    for (int i = 0; i < 32; ++i) { const int kk = 2 * i + (lane >> 5); scr[kk * 33 + (lane & 31)] = (nn < N) ? W[(size_t)(k0 + kk) * N + nn] : 0.f; }
    asm volatile("s_waitcnt lgkmcnt(0)" ::: "memory");
    const int c = lane & 7;
#pragma unroll
    for (int j = 0; j < 4; ++j) { const int n = (lane >> 3) + 8 * j; const LAS float* s = scr + (8 * c) * 33 + n;
        u32x4 o; o.x = pk2(s[0 * 33], s[1 * 33]); o.y = pk2(s[2 * 33], s[3 * 33]); o.z = pk2(s[4 * 33], s[5 * 33]); o.w = pk2(s[6 * 33], s[7 * 33]);
        *(u32x4*)(WT + (size_t)(n0 + n) * K + k0 + 8 * c) = o; }
    asm volatile("s_waitcnt lgkmcnt(0)" ::: "memory");
}
__device__ __forceinline__ float wave_maxf(float v) {
#pragma unroll
    for (int o = 1; o < 64; o <<= 1) v = fmaxf(v, __shfl_xor(v, o));
    return v;
}
__device__ __forceinline__ void convert_tables(const Ctx& C, int layer, int rank, int nrank) {
    const float* U = C.in[39] + (size_t)layer * NEXP * DM; const float* V = C.in[40] + (size_t)layer * NEXP * DM;
    unsigned char* UB = C.ws + WS_UB; unsigned char* VB = C.ws + WS_VB; float* SU = (float*)(C.ws + WS_SU); float* SV = (float*)(C.ws + WS_SV);
    for (int r4 = (rank * 8 + C.wid) * 2; r4 < 2 * NEXP; r4 += nrank * 8 * 2) {
        const bool isv = r4 >= NEXP; const int row0 = isv ? r4 - NEXP : r4;
        const float* src = (isv ? V : U) + (size_t)row0 * DM + 16 * C.lane;
        f32x4 x[2][4];
#pragma unroll
        for (int q = 0; q < 2; ++q)
#pragma unroll
            for (int k = 0; k < 4; ++k) x[q][k] = *(const f32x4*)(src + (size_t)q * DM + 4 * k);
#pragma unroll
        for (int q = 0; q < 2; ++q) {
            float m = 0.f;
#pragma unroll
            for (int k = 0; k < 4; ++k) m = fmaxf(fmaxf(m, fmaxf(fabsf(x[q][k].x), fabsf(x[q][k].y))), fmaxf(fabsf(x[q][k].z), fabsf(x[q][k].w)));
            m = wave_maxf(m);
            const float sc = m > 0.f ? 224.f / m : 1.f;
            u32x4 o;
#pragma unroll
            for (int k = 0; k < 4; ++k) { int w = __builtin_amdgcn_cvt_pk_fp8_f32(x[q][k].x * sc, x[q][k].y * sc, 0, false); w = __builtin_amdgcn_cvt_pk_fp8_f32(x[q][k].z * sc, x[q][k].w * sc, w, true); o[k] = (unsigned)w; }
            *(u32x4*)((isv ? VB : UB) + (size_t)(row0 + q) * DM + 16 * C.lane) = o;
            if (C.lane == 0) (isv ? SV : SU)[row0 + q] = m > 0.f ? m * (1.f / 224.f) : 1.f;
        }
    }
}
__device__ __forceinline__ void ph_prologue(const Ctx& C) {
    const int gw = C.bid * 8 + C.wid, NGW = C.G * 8;
    {
        LAS float* scr = (LAS float*)(C.lds + C.wid * 16384);
        bf16_t* WIN = (bf16_t*)(C.ws + WS_WIN); bf16_t* WOUT = (bf16_t*)(C.ws + WS_WOUT); bf16_t* WQ = (bf16_t*)(C.ws + WS_WQ);
        for (int it = gw; it < 6400; it += NGW) {
            const int layer = it / 3200; int r = it % 3200;
            if (r < 1664) { transpose_item(C.in[8] + (size_t)layer * DM * INC, DM, INC, 104, WIN + (size_t)layer * NP * DM, scr, r, C.lane); continue; } r -= 1664;
            if (r < 512) { transpose_item(C.in[9] + (size_t)layer * DM * DM, DM, DM, 32, WOUT + (size_t)layer * DM * DM, scr, r, C.lane); continue; } r -= 512;
            transpose_item(C.in[36] + (size_t)layer * DM * 2048, DM, 2048, 64, WQ + (size_t)layer * 2048 * DM, scr, r, C.lane);
        }
    }
    __syncthreads();
    {
        LAS float* sv = (LAS float*)C.lds;
        LAS float* red = (LAS float*)(C.lds + 12288);
        for (int i = C.tid; i < 3 * 1024; i += 512) { const int w = i >> 10, k = i & 1023; const float x = (w < 2) ? C.in[1][w * 1024 + k] : C.in[3][k]; sv[i] = silu(x); }
        __syncthreads();
        float* MOD = (float*)(C.ws + WS_MOD);
        for (int it = C.bid; it < 192; it += C.G) {
            const int layer = it / 96, col0 = (it % 96) * 64, col = C.tid & 63, kg = C.tid >> 6;
            const float* W = C.in[4] + (size_t)layer * DM * 6144 + col0 + col;
            float a0 = 0.f, a1 = 0.f, a2 = 0.f;
#pragma unroll 32
            for (int k = kg * 128; k < kg * 128 + 128; ++k) { const float w = W[(size_t)k * 6144]; a0 += sv[k] * w; a1 += sv[1024 + k] * w; a2 += sv[2048 + k] * w; }
            red[(kg * 3 + 0) * 64 + col] = a0; red[(kg * 3 + 1) * 64 + col] = a1; red[(kg * 3 + 2) * 64 + col] = a2;
            __syncthreads();
            if (C.tid < 192) { const int w = C.tid >> 6, c2 = C.tid & 63; float s = 0.f;
#pragma unroll
                for (int g = 0; g < 8; ++g) s += red[(g * 3 + w) * 64 + c2];
                MOD[((size_t)layer * 3 + w) * 6144 + col0 + c2] = s + C.in[5][layer * 6144 + col0 + c2]; }
            __syncthreads();
        }
    }
    {
        float* H = (float*)(C.ws + WS_H);
        const size_t n4 = (size_t)NROW * 256;
        for (size_t i = (size_t)C.bid * 512 + C.tid; i < n4; i += (size_t)C.G * 512) {
            const int row = (int)(i >> 8), c4 = (int)(i & 255) * 4;
            f32x4 v;
            if (row < NLAT) {
                v = *(const f32x4*)(C.in[0] + (size_t)row * DM + c4);
                const int t = row & 8191, quarter = c4 >> 8; const float pos = (quarter < 2) ? (float)(t >> 6) : (float)(t & 63);
                float e[4];
#pragma unroll
                for (int j = 0; j < 4; ++j) { const int jj = (c4 & 255) + j; const float fr = exp2f(-(float)jj * (13.287712379549449f / 256.f)); const float a = pos * fr; e[j] = (quarter & 1) ? cosf(a) : sinf(a); }
                v.x += e[0]; v.y += e[1]; v.z += e[2]; v.w += e[3];
            } else v = *(const f32x4*)(C.in[2] + (size_t)(row - NLAT) * DM + c4);
            *(f32x4*)(H + (size_t)row * DM + c4) = v;
        }
    }
}

struct Row16 { float v[16]; };
__device__ __forceinline__ Row16 load_row16(const float* p, int lane) {
    Row16 r; const f32x4 a = *(const f32x4*)(p + 8 * lane), b = *(const f32x4*)(p + 8 * lane + 4), c = *(const f32x4*)(p + 512 + 8 * lane), d = *(const f32x4*)(p + 512 + 8 * lane + 4);
    r.v[0] = a.x; r.v[1] = a.y; r.v[2] = a.z; r.v[3] = a.w; r.v[4] = b.x; r.v[5] = b.y; r.v[6] = b.z; r.v[7] = b.w;
    r.v[8] = c.x; r.v[9] = c.y; r.v[10] = c.z; r.v[11] = c.w; r.v[12] = d.x; r.v[13] = d.y; r.v[14] = d.z; r.v[15] = d.w; return r;
}
__device__ __forceinline__ void store_row16_f32(float* p, int lane, const Row16& r) {
    *(f32x4*)(p + 8 * lane) = (f32x4){r.v[0], r.v[1], r.v[2], r.v[3]}; *(f32x4*)(p + 8 * lane + 4) = (f32x4){r.v[4], r.v[5], r.v[6], r.v[7]};
    *(f32x4*)(p + 512 + 8 * lane) = (f32x4){r.v[8], r.v[9], r.v[10], r.v[11]}; *(f32x4*)(p + 512 + 8 * lane + 4) = (f32x4){r.v[12], r.v[13], r.v[14], r.v[15]};
}
__device__ __forceinline__ void store_row16_bf16(bf16_t* p, int lane, const Row16& r) {
    u32x4 a, b; a.x = pk2(r.v[0], r.v[1]); a.y = pk2(r.v[2], r.v[3]); a.z = pk2(r.v[4], r.v[5]); a.w = pk2(r.v[6], r.v[7]);
    b.x = pk2(r.v[8], r.v[9]); b.y = pk2(r.v[10], r.v[11]); b.z = pk2(r.v[12], r.v[13]); b.w = pk2(r.v[14], r.v[15]);
    *(u32x4*)(p + 8 * lane) = a; *(u32x4*)(p + 512 + 8 * lane) = b;
}
__device__ __forceinline__ Row16 norm_mod_row(const Row16& x, const float* g, const float* shift, const float* scale, int lane) {
    float ss = 0.f;
#pragma unroll
    for (int i = 0; i < 16; ++i) ss += x.v[i] * x.v[i];
    const float rs = rsqrtf(wave_sum(ss) * (1.f / 1024.f) + 1e-6f);
    const Row16 gg = load_row16(g, lane), sh = load_row16(shift, lane), sc = load_row16(scale, lane);
    Row16 o;
#pragma unroll
    for (int i = 0; i < 16; ++i) o.v[i] = (x.v[i] * rs * gg.v[i]) * (1.f + sc.v[i]) + sh.v[i];
    return o;
}
__device__ __forceinline__ int which_of(int row) { return row < 8192 ? 0 : (row < NLAT ? 1 : 2); }
__device__ __forceinline__ void ph_norm(const Ctx& C, int layer, const float* gain, int sidx, int nrows) {
    const float* H = (const float*)(C.ws + WS_H); bf16_t* ACT = (bf16_t*)(C.ws + WS_ACT); const float* MOD = (const float*)(C.ws + WS_MOD);
    for (int row = C.bid * 8 + C.wid; row < nrows; row += C.G * 8) {
        const float* m = MOD + ((size_t)layer * 3 + which_of(row)) * 6144;
        const Row16 x = load_row16(H + (size_t)row * DM, C.lane);
        const Row16 o = norm_mod_row(x, gain, m + sidx * 1024, m + (sidx + 1) * 1024, C.lane);
        store_row16_bf16(ACT + (size_t)row * DM, C.lane, o);
    }
}
struct EpiResid {
    static constexpr bool PERM = false, AFTER_DRAIN = false;
    float* H; const float* modl;
    __device__ __forceinline__ void operator()(const f32x4 (&acc)[2][2][4][2], const pg8::Unit& u, int wr, int wc, int fr, int fq) const {
        const int row0 = u.pm * 256 + wr * 64 + fr, col0 = u.pn * 256 + wc * 32 + 4 * fq;
        const int which = u.pm < 32 ? 0 : (u.pm < 64 ? 1 : 2);
        const float* gate = modl + ((size_t)which * 6 + 2) * 1024;
        f32x4 gv[2][2];
#pragma unroll
        for (int bj = 0; bj < 2; ++bj)
#pragma unroll
            for (int n = 0; n < 2; ++n) gv[bj][n] = *(const f32x4*)(gate + col0 + bj * 128 + n * 16);
#pragma unroll
        for (int ai = 0; ai < 2; ++ai)
#pragma unroll
            for (int m = 0; m < 4; ++m) { float* rowp = H + (size_t)(row0 + ai * 128 + m * 16) * DM + col0;
#pragma unroll
                for (int bj = 0; bj < 2; ++bj)
#pragma unroll
                    for (int n = 0; n < 2; ++n) { f32x4* p = (f32x4*)(rowp + bj * 128 + n * 16); *p = *p + gv[bj][n] * acc[ai][bj][m][n]; } }
    }
};

__device__ __forceinline__ void item_conformer(const Ctx& C, int layer, int gc) {
    const ChunkInfo ci = chunk_info(gc);
    const bf16_t* P = (const bf16_t*)(C.ws + WS_P); bf16_t* YC = (bf16_t*)(C.ws + WS_ACT);
    LAS bf16_t* HG = (LAS bf16_t*)C.lds;
    LAS float* CO = (LAS float*)(C.lds + 49152);
    for (int e = C.tid; e < 94 * 128; e += 512) {
        const int rr = e >> 7, cp = e & 127, grow = ci.row0 - 15 + rr;
        const bool ok = grow >= ci.lo && grow < ci.hi; const int gr = ok ? grow : ci.row0;
        const unsigned v = *(const unsigned*)(P + (size_t)gr * NP + 2 * cp), g = *(const unsigned*)(P + (size_t)gr * NP + 256 + 2 * cp);
        const unsigned o = pk2(bflo(v) * sigm(bflo(g)), bfhi(v) * sigm(bfhi(g)));
        *(LAS unsigned*)(HG + rr * 256 + 2 * cp) = ok ? o : 0u;
    }
    __syncthreads();
    {
        const int c = C.tid & 255, half = C.tid >> 8;
        const float* cw = C.in[10] + (size_t)layer * 31 * 256 + c;
        float w[31];
#pragma unroll
        for (int j = 0; j < 31; ++j) w[j] = cw[j * 256];
        const float bias = C.in[11][layer * 256 + c];
        float hv[62];
#pragma unroll
        for (int i = 0; i < 62; ++i) hv[i] = bf2f(HG[(half * 32 + i) * 256 + c]);
#pragma unroll
        for (int tt = 0; tt < 32; ++tt) { float acc = bias;
#pragma unroll
            for (int j = 0; j < 31; ++j) acc += w[j] * hv[tt + j];
            CO[(half * 32 + tt) * 256 + c] = acc; }
    }
    __syncthreads();
    {
        const float* lg = C.in[12] + layer * 256 + 4 * C.lane; const float* lb = C.in[13] + layer * 256 + 4 * C.lane;
        const f32x4 g4 = *(const f32x4*)lg, b4 = *(const f32x4*)lb;
        for (int i = 0; i < 8; ++i) {
            const int t = C.wid * 8 + i;
            const f32x4 x = *(const LAS f32x4*)(CO + t * 256 + 4 * C.lane);
            const float mean = wave_sum((x.x + x.y) + (x.z + x.w)) * (1.f / 256.f);
            const f32x4 d = x - mean;
            const float var = wave_sum((d.x * d.x + d.y * d.y) + (d.z * d.z + d.w * d.w)) * (1.f / 256.f);
            const float rs = rsqrtf(var + 1e-5f);
            const f32x4 y = d * rs * g4 + b4;
            u32x2 o; o.x = pk2(silu(y.x), silu(y.y)); o.y = pk2(silu(y.z), silu(y.w));
            *(u32x2*)(YC + (size_t)(ci.row0 + t) * DM + 4 * C.lane) = o;
        }
    }
    __syncthreads();
}

__device__ __forceinline__ void item_chunkmlp(const Ctx& C, int layer, int gb) {
    const int row0 = gb * 128;
    const bf16_t* P = (const bf16_t*)(C.ws + WS_P); bf16_t* YC = (bf16_t*)(C.ws + WS_ACT);
    LAS bf16_t* VNT = (LAS bf16_t*)C.lds;
    LAS bf16_t* WS = (LAS bf16_t*)(C.lds + 69632);
    {
        const f32x4 g4 = *(const f32x4*)(C.in[14] + layer * 256 + 4 * C.lane), b4 = *(const f32x4*)(C.in[15] + layer * 256 + 4 * C.lane);
        for (int i = 0; i < 16; ++i) {
            const int j = C.wid * 16 + i;
            const u32x2 raw = *(const u32x2*)(P + (size_t)(row0 + j) * NP + 768 + 4 * C.lane);
            const f32x4 x = {bflo(raw.x), bfhi(raw.x), bflo(raw.y), bfhi(raw.y)};
            const float mean = wave_sum((x.x + x.y) + (x.z + x.w)) * (1.f / 256.f);
            const f32x4 d = x - mean;
            const float var = wave_sum((d.x * d.x + d.y * d.y) + (d.z * d.z + d.w * d.w)) * (1.f / 256.f);
            const f32x4 y = d * rsqrtf(var + 1e-5f) * g4 + b4;
            VNT[(4 * C.lane + 0) * 136 + j] = f2bf(y.x); VNT[(4 * C.lane + 1) * 136 + j] = f2bf(y.y);
            VNT[(4 * C.lane + 2) * 136 + j] = f2bf(y.z); VNT[(4 * C.lane + 3) * 136 + j] = f2bf(y.w);
        }
    }
    for (int h = 0; h < 4; ++h) {
        const float* ws = C.in[16] + ((size_t)layer * 4 + h) * 128 * 128;
        for (int e = C.tid; e < 4096; e += 512) { const int i = e >> 5, j4 = (e & 31) * 4; const f32x4 w = *(const f32x4*)(ws + i * 128 + j4);
            u32x2 o; o.x = pk2(w.x, w.y); o.y = pk2(w.z, w.w); *(LAS u32x2*)(WS + i * 136 + j4) = o; }
        __syncthreads();
        const float* bs = C.in[17] + ((size_t)layer * 4 + h) * 128;
        {
            const int fr = C.lane & 15, fq = C.lane >> 4;
            unsigned short ur[4][4];
#pragma unroll
            for (int i = 0; i < 4; ++i) { const int tt = C.wid + 8 * i, tm = tt >> 2, tn = tt & 3;
#pragma unroll
                for (int jj = 0; jj < 4; ++jj) ur[i][jj] = P[(size_t)(row0 + tm * 16 + fq * 4 + jj) * NP + 512 + h * 64 + tn * 16 + fr]; }
#pragma unroll
            for (int i = 0; i < 4; ++i) { const int tt = C.wid + 8 * i, tm = tt >> 2, tn = tt & 3;
                f32x4 acc = {0.f, 0.f, 0.f, 0.f};
#pragma unroll
                for (int ks = 0; ks < 4; ++ks) acc = __builtin_amdgcn_mfma_f32_16x16x32_bf16(*(const LAS bf16x8*)(WS + (tm * 16 + fr) * 136 + ks * 32 + fq * 8),
                                                                                             *(const LAS bf16x8*)(VNT + (h * 64 + tn * 16 + fr) * 136 + ks * 32 + fq * 8), acc, 0, 0, 0);
#pragma unroll
                for (int jj = 0; jj < 4; ++jj) { const int ii = tm * 16 + fq * 4 + jj;
                    YC[(size_t)(row0 + ii) * DM + 256 + h * 64 + tn * 16 + fr] = f2bf((acc[jj] + bs[ii]) * bf2f(ur[i][jj])); }
            }
        }
        __syncthreads();
    }
}

__device__ __forceinline__ void item_mamba_local(const Ctx& C, int layer, int gc) {
    const ChunkInfo ci = chunk_info(gc);
    const bf16_t* P = (const bf16_t*)(C.ws + WS_P);
    bf16_t* MSTb = (bf16_t*)(C.ws + WS_MST); float* MCD = (float*)(C.ws + WS_MCD);
    LAS float* DA = (LAS float*)C.lds;
    LAS float* DT = (LAS float*)(C.lds + 2048);
    LAS float* FAC = (LAS float*)(C.lds + 4096);
    LAS bf16_t* XDT = (LAS bf16_t*)(C.lds + 8192);
    LAS bf16_t* BTT = (LAS bf16_t*)(C.lds + 8192 + 73728);
    {
        const int s = C.lane, dh = C.wid, d = dh >> 2, h = dh & 3;
        const float raw = bf2f(P[(size_t)(ci.row0 + s) * NP + OFF_C + 1024 + dh]);
        const float dt = softplus(raw + C.in[20][layer * 8 + dh]);
        const float da = dt * (-expf(C.in[21][layer * 8 + dh]));
        const float incl = wave_incl_scan(da, s), total = __shfl(incl, 63);
        DT[dh * 64 + s] = dt; DA[dh * 64 + s] = da;
        FAC[dh * 64 + s] = d ? fexp(incl - da) : fexp(total - incl);
        if (s == 0) MCD[slot_of(ci.b, h, d, cpos_of(ci, d))] = expf(total);
    }
    __syncthreads();
    {
        const int cp = C.tid & 255, half = C.tid >> 8, c0 = 2 * cp;
        const float* cw = C.in[18] + (size_t)layer * 5 * 768 + c0; const float* cb = C.in[19] + layer * 768 + c0;
        float w0[5], w1[5];
#pragma unroll
        for (int j = 0; j < 5; ++j) { w0[j] = cw[j * 768]; w1[j] = cw[j * 768 + 1]; }
        const float b0 = cb[0], b1 = cb[1];
        const int s0 = half * 32;
        unsigned wr[36];
        unsigned short ob[4][8];
#pragma unroll
        for (int j = 0; j < 36; ++j) { const int row = ci.row0 + s0 - 2 + j; const bool ok = row >= ci.lo && row < ci.hi; const unsigned v = *(const unsigned*)(P + (size_t)(ok ? row : ci.row0) * NP + OFF_C + 256 + c0); wr[j] = ok ? v : 0u; }
#pragma unroll
        for (int tt = 0; tt < 32; ++tt) {
            const int s = s0 + tt;
            const unsigned* win = wr + tt;
            float a0 = b0, a1 = b1;
#pragma unroll
            for (int j = 0; j < 5; ++j) { a0 += w0[j] * bflo(win[j]); a1 += w1[j] * bfhi(win[j]); }
            a0 = silu(a0); a1 = silu(a1);
            if (c0 < 256) { const int h = c0 >> 6;
#pragma unroll
                for (int d = 0; d < 2; ++d) { const float f = DT[(d * 4 + h) * 64 + s] * FAC[(d * 4 + h) * 64 + s]; ob[d * 2][tt & 7] = f2bf(a0 * f); ob[d * 2 + 1][tt & 7] = f2bf(a1 * f); }
            } else { ob[0][tt & 7] = f2bf(a0); ob[1][tt & 7] = f2bf(a1); }
            if ((tt & 7) == 7) { const int sb = s - 7;
#define C1_PACK8(a) (u32x4){(unsigned)a[0] | ((unsigned)a[1] << 16), (unsigned)a[2] | ((unsigned)a[3] << 16), (unsigned)a[4] | ((unsigned)a[5] << 16), (unsigned)a[6] | ((unsigned)a[7] << 16)}
                if (c0 < 256) {
#pragma unroll
                    for (int d = 0; d < 2; ++d) { *(LAS u32x4*)(XDT + (d * 256 + c0) * 72 + sb) = C1_PACK8(ob[d * 2]); *(LAS u32x4*)(XDT + (d * 256 + c0 + 1) * 72 + sb) = C1_PACK8(ob[d * 2 + 1]); }
                } else { const int q = c0 - 256; *(LAS u32x4*)(BTT + q * 72 + sb) = C1_PACK8(ob[0]); *(LAS u32x4*)(BTT + (q + 1) * 72 + sb) = C1_PACK8(ob[1]); }
#undef C1_PACK8
            }
        }
    }
    __syncthreads();
    for (int hd = 0; hd < 8; ++hd) {
        const int d = hd >> 2, h = hd & 3;
        bf16_t* dst = MSTb + (size_t)slot_of(ci.b, h, d, cpos_of(ci, d)) * 8192;
        blk_mma<8, 4, 2>(BTT + (h >> 1) * 128 * 72, 72, XDT + (d * 256 + h * 64) * 72, 72, C.wid, C.lane, [=](int r0, int col, const f32x4& acc) {
            u32x2 o; o.x = pk2(acc[0], acc[1]); o.y = pk2(acc[2], acc[3]); *(u32x2*)(dst + col * 128 + r0) = o;
        });
    }
    __syncthreads();
}


#ifndef MK_DIAG2
#define MK_DIAG2 0
#endif
#if MK_DIAG2
#define DBGF(stage, cond) do { if (cond) atomicOr((unsigned*)(C.ws + 32768) + (stage), 1u); } while (0)
#define DBGL(stage, cond) do { if (cond) atomicOr(dbgflags + (stage), 1u); } while (0)
#else
#define DBGF(stage, cond) do {} while (0)
#define DBGL(stage, cond) do {} while (0)
#endif
__device__ __forceinline__ bool badv(float x, float lim) { return !(fabsf(x) < lim); }
__device__ __forceinline__ void tri_inverse(const LAS float* ABf, LAS float* Tf, LAS float* Rt, LAS bf16_t* TT, int tid, int wid, int lane) {
    if (wid == 0) {
        const int bi = lane >> 4, j = lane & 15; const LAS float* Ab = ABf + (16 * bi) * 68 + 16 * bi;
        float col[16];
#pragma unroll
        for (int r = 0; r < 16; ++r) { float acc = (r == j) ? 1.f : 0.f;
#pragma unroll
            for (int s = 0; s < r; ++s) acc -= Ab[r * 68 + s] * col[s];
            col[r] = acc; }
#pragma unroll
        for (int r = 0; r < 16; ++r) Tf[(16 * bi + r) * 68 + 16 * bi + j] = col[r];
    } else {
        for (int e = tid - 64; e < 64 * 64; e += 448) { const int t = e >> 6, s2 = e & 63; if ((s2 >> 4) > (t >> 4)) Tf[t * 68 + s2] = 0.f; }
    }
    __syncthreads();
    if (wid < 3) {
        const int tn = wid, fr = lane & 15, fq = lane >> 4;
        LAS float* Rw = Rt + wid * 320;
        for (int i = tn + 1; i < 4; ++i) {
            f32x4 acc = {0.f, 0.f, 0.f, 0.f};
            for (int k = 16 * tn; k < 16 * i; k += 4) acc = __builtin_amdgcn_mfma_f32_16x16x4f32(ABf[(16 * i + fr) * 68 + k + fq], Tf[(k + fq) * 68 + 16 * tn + fr], acc, 0, 0, 0);
#pragma unroll
            for (int j = 0; j < 4; ++j) Rw[(fq * 4 + j) * 20 + fr] = -acc[j];
            asm volatile("s_waitcnt lgkmcnt(0)" ::: "memory");
            f32x4 t = {0.f, 0.f, 0.f, 0.f};
#pragma unroll
            for (int k = 0; k < 16; k += 4) t = __builtin_amdgcn_mfma_f32_16x16x4f32(Tf[(16 * i + fr) * 68 + 16 * i + k + fq], Rw[(k + fq) * 20 + fr], t, 0, 0, 0);
#pragma unroll
            for (int j = 0; j < 4; ++j) Tf[(16 * i + fq * 4 + j) * 68 + 16 * tn + fr] = t[j];
            asm volatile("s_waitcnt lgkmcnt(0)" ::: "memory");
        }
    }
    __syncthreads();
    for (int e = tid; e < 4096; e += 512) { const int t = e >> 6, s2 = e & 63; TT[t * 72 + s2] = f2bf(Tf[t * 68 + s2]); }
}
struct D1Pre { unsigned w[24]; unsigned lw[8]; int hd; };
__device__ __forceinline__ void d1_load_rows(const Ctx& C, int it, unsigned (&w)[24]) {
    const int gc = it >> 3, hd = it & 7, h = hd & 3, d = hd >> 2;
    const ChunkInfo ci = chunk_info(gc);
    const bf16_t* P = (const bf16_t*)(C.ws + WS_P);
    if (C.tid < 480) {
        const int q = C.tid % 160, seg = C.tid / 160, grp = q >> 5, c = (q & 31) * 2;
        const int j = (grp == 0 ? h * 64 : grp == 1 ? 256 + h * 64 : grp == 2 ? 512 + h * 64 : grp == 3 ? 768 + d * 64 : 896 + d * 64) + c;
        const int t0 = seg * 22, nt = seg == 2 ? 20 : 22;
        const bf16_t* pp = P + (size_t)(ci.row0 + t0) * NP + OFF_D + j;
#pragma unroll
        for (int i = 0; i < 24; ++i) { const int row = ci.row0 + t0 - 1 + i; const bool ok = row >= ci.lo && row < ci.hi; const int rc = ok ? row : ci.row0;
            const unsigned v = (i < nt + 2) ? *(const unsigned*)(pp + (ptrdiff_t)(rc - (ci.row0 + t0)) * NP) : 0u; w[i] = ok ? v : 0u; }
    }
}
constexpr int D1_LW = 0, D1_CS = 17408, D1_AA = 34816, D1_RB = 52224, D1_KB = 61440, D1_VB = 70656, D1_TW = 79872, D1_AD = 89088, D1_W2T = 98304, D1_A2T = 107520;
constexpr int D1_Y = 82944;
constexpr int D1_ABF = 0, D1_AK = 17408, D1_ARK = 26624, D1_ARB = 35840, D1_TT = 45056, D1_W1T = 54272, D1_AKVT = 63488, D1_W2TT = 72704;
constexpr int D1_GL = 156672;
__device__ __forceinline__ void item_rwkv_local(const Ctx& C0_, int layer, int it, D1Pre& pre, int it_next) {
    Ctx C = C0_; { int t_ = C0_.tid; asm volatile("" : "+v"(t_)); C.tid = t_; C.lane = t_ & 63; C.wid = __builtin_amdgcn_readfirstlane(t_ >> 6); }
#define D1_RELAUNDER() do { int t_ = C.tid; asm volatile("" : "+v"(t_)); C.tid = t_; C.lane = t_ & 63; C.wid = __builtin_amdgcn_readfirstlane(t_ >> 6); } while (0)
    const int gc = it >> 3, hd = it & 7, h = hd & 3, d = hd >> 2;
    const ChunkInfo ci = chunk_info(gc);
    const int slot = slot_of(ci.b, h, d, cpos_of(ci, d));
    const bf16_t* P = (const bf16_t*)(C.ws + WS_P);
    const float* mup = C.in[24] + layer * 1152; const float* mun = C.in[25] + layer * 1152;
    lds_t L = C.lds;
    LAS float* LW = (LAS float*)(L + D1_LW); LAS float* CS = (LAS float*)(L + D1_CS); LAS float* AA = (LAS float*)(L + D1_AA); LAS float* GL = (LAS float*)(L + D1_GL);
    LAS bf16_t* Rb = (LAS bf16_t*)(L + D1_RB); LAS bf16_t* Kb = (LAS bf16_t*)(L + D1_KB); LAS bf16_t* Vb = (LAS bf16_t*)(L + D1_VB);
    LAS bf16_t* TW = (LAS bf16_t*)(L + D1_TW); LAS bf16_t* AD = (LAS bf16_t*)(L + D1_AD); LAS bf16_t* W2T = (LAS bf16_t*)(L + D1_W2T); LAS bf16_t* A2T = (LAS bf16_t*)(L + D1_A2T);
    LAS bf16_t* KT = (LAS bf16_t*)(L + D1_Y); LAS bf16_t* KTt = KT + 4608; LAS bf16_t* KD = KT + 2 * 4608; LAS bf16_t* KDt = KT + 3 * 4608;
    LAS bf16_t* BT = KT + 4 * 4608; LAS bf16_t* BTt = KT + 5 * 4608; LAS bf16_t* RT = KT + 6 * 4608; LAS bf16_t* Vt = KT + 7 * 4608;
    LAS float* ABf = (LAS float*)(L + D1_ABF); LAS bf16_t* AK = (LAS bf16_t*)(L + D1_AK); LAS bf16_t* ARK = (LAS bf16_t*)(L + D1_ARK); LAS bf16_t* ARB = (LAS bf16_t*)(L + D1_ARB);
    LAS bf16_t* TT = (LAS bf16_t*)(L + D1_TT); LAS bf16_t* W1t = (LAS bf16_t*)(L + D1_W1T); LAS bf16_t* AKVt = (LAS bf16_t*)(L + D1_AKVT); LAS bf16_t* W2t = (LAS bf16_t*)(L + D1_W2TT);

    if (C.tid < 480) {
        const int q = C.tid % 160, seg = C.tid / 160, grp = q >> 5, c = (q & 31) * 2;
        const int j = (grp == 0 ? h * 64 : grp == 1 ? 256 + h * 64 : grp == 2 ? 512 + h * 64 : grp == 3 ? 768 + d * 64 : 896 + d * 64) + c;
        const int t0 = seg * 22, nt = seg == 2 ? 20 : 22;
        const float mp0 = mup[j], mp1 = mup[j + 1], mn0 = mun[j], mn1 = mun[j + 1];
        unsigned w[24]; { const bf16_t* pp = P + (size_t)(ci.row0 + t0) * NP + OFF_D + j;
#pragma unroll
        for (int i = 0; i < 24; ++i) { const int row = ci.row0 + t0 - 1 + i; const bool ok = row >= ci.lo && row < ci.hi; const int rc = ok ? row : ci.row0;
            const unsigned v = (i < nt + 2) ? *(const unsigned*)(pp + (ptrdiff_t)(rc - (ci.row0 + t0)) * NP) : 0u; w[i] = ok ? v : 0u; } }
        LAS bf16_t* dst = (grp == 0 ? Rb : grp == 1 ? Kb : grp == 2 ? Vb : grp == 3 ? TW : AD);
#pragma unroll
        for (int i = 0; i < 22; ++i) if (i < nt) {
            const float x0 = bflo(w[i + 1]), x1 = bfhi(w[i + 1]);
            const float v0 = x0 + mp0 * (bflo(w[i]) - x0) + mn0 * (bflo(w[i + 2]) - x0);
            const float v1 = x1 + mp1 * (bfhi(w[i]) - x1) + mn1 * (bfhi(w[i + 2]) - x1);
            DBGF(1, badv(v0, 1e4f) || badv(v1, 1e4f));
            const unsigned o = (grp == 3) ? pk2(ftanh(v0), ftanh(v1)) : pk2(v0, v1);
            const int tl = t0 + i, l = d ? 63 - tl : tl;
            *(LAS unsigned*)(dst + l * 72 + c) = o;
        }
    }
    {
        if (pre.hd != hd) {
            const float* w2 = C.in[27] + ((size_t)layer * 2 + d) * 64 * 256 + h * 64; const float* a2 = C.in[29] + ((size_t)layer * 2 + d) * 64 * 256 + h * 64;
#pragma unroll
            for (int k = 0; k < 8; ++k) { const int e = C.tid + 512 * k, r = e >> 6, c = e & 63; pre.lw[k] = pk2(w2[r * 256 + c], a2[r * 256 + c]); }
            pre.hd = hd;
        }
#pragma unroll
        for (int k = 0; k < 8; ++k) { const int e = C.tid + 512 * k, r = e >> 6, c = e & 63; W2T[c * 72 + r] = (unsigned short)(pre.lw[k] & 0xffffu); A2T[c * 72 + r] = (unsigned short)(pre.lw[k] >> 16); }
    }
    __syncthreads();
    D1_RELAUNDER();
    {
        unsigned* dbgflags = (unsigned*)(C.ws + 32768); (void)dbgflags;
        const float* w0 = C.in[26] + ((size_t)layer * 2 + d) * 256 + h * 64; const float* a0 = C.in[28] + ((size_t)layer * 2 + d) * 256 + h * 64;
        blk_mma<4, 4, 2>(TW, 72, W2T, 72, C.wid, C.lane, [=](int r0, int col, const f32x4& acc) {
#pragma unroll
            for (int jj = 0; jj < 4; ++jj) { const float w = w0[col] + acc[jj]; DBGL(2, badv(w, 1e4f)); LW[(r0 + jj) * 68 + col] = -fexp(-softplus(-w) - 0.5f); }
        });
        blk_mma<4, 4, 2>(AD, 72, A2T, 72, C.wid, C.lane, [=](int r0, int col, const f32x4& acc) {
#pragma unroll
            for (int jj = 0; jj < 4; ++jj) { DBGL(2, badv(acc[jj], 1e4f)); AA[(r0 + jj) * 68 + col] = sigm(a0[col] + acc[jj]); }
        });
    }
    __syncthreads();
    {
#pragma unroll
        for (int i = 0; i < 8; ++i) { const int c = C.wid * 8 + i; const float incl = wave_incl_scan(LW[C.lane * 68 + c], C.lane); CS[C.lane * 68 + c] = incl; if (C.lane == 63) GL[c] = fexp(incl); }
    }
    __syncthreads();
    D1_RELAUNDER();
    {
        const int c = C.lane, l0 = C.wid * 8;
        const float kkw = C.in[31][layer * 256 + h * 64 + c], kaw = C.in[32][layer * 256 + h * 64 + c], rkw = C.in[33][layer * 256 + h * 64 + c];
        unsigned short kt[8], kd[8], bt[8], vt[8];
#pragma unroll
        for (int i = 0; i < 8; ++i) { const int l = l0 + i;
            const float k = bf2f(Kb[l * 72 + c]), r = bf2f(Rb[l * 72 + c]), v = bf2f(Vb[l * 72 + c]), aa = AA[l * 68 + c];
            const float kkr = k * kkw, kdv = k * (1.f + (aa - 1.f) * kaw);
            const float ss = wave_sum(kkr * kkr), bon = wave_sum(r * kdv * rkw);
            const float kkn = kkr * rsqrtf(ss + 1e-12f);
            if (c == 0) ((float*)(C.ws + WS_BON))[(size_t)(ci.row0 + (d ? 63 - l : l)) * 8 + h * 2 + d] = bon;
            const float cs = CS[l * 68 + c], lw = LW[l * 68 + c];
            const float ge = fexp(cs - lw), gi = fexp(cs), gn = fexp(-cs);
            DBGF(3, badv(cs, 50.f) || cs > 0.f || badv(lw, 1.f)); DBGF(4, badv(kkn * ge, 10.f) || badv(r * gi, 1e4f) || badv(v, 1e4f)); DBGF(5, badv(kdv * gn, 1e25f) || badv(kkn * aa * gn, 1e25f));
            kt[i] = f2bf(kkn * ge); kd[i] = f2bf(kdv * gn); bt[i] = f2bf(kkn * aa * gn); vt[i] = f2bf(v);
            KT[l * 72 + c] = kt[i]; KD[l * 72 + c] = kd[i]; BT[l * 72 + c] = bt[i]; RT[l * 72 + c] = f2bf(r * gi); }
#define D1_PACK8(a) (u32x4){(unsigned)a[0] | ((unsigned)a[1] << 16), (unsigned)a[2] | ((unsigned)a[3] << 16), (unsigned)a[4] | ((unsigned)a[5] << 16), (unsigned)a[6] | ((unsigned)a[7] << 16)}
        *(LAS u32x4*)(KTt + c * 72 + l0) = D1_PACK8(kt); *(LAS u32x4*)(KDt + c * 72 + l0) = D1_PACK8(kd);
        *(LAS u32x4*)(BTt + c * 72 + l0) = D1_PACK8(bt); *(LAS u32x4*)(Vt + c * 72 + l0) = D1_PACK8(vt);
#undef D1_PACK8
    }
    __syncthreads();
    D1_RELAUNDER();
    unsigned* dbgflags = (unsigned*)(C.ws + 32768); (void)dbgflags;
    blk_mma2<4, 4, 2>(BT, KT, KD, KT, 72, C.wid, C.lane, [=](int r0, int col, const f32x4& ab, const f32x4& ak) {
        f32x4 a; float k[4];
#pragma unroll
        for (int jj = 0; jj < 4; ++jj) { const bool lo = r0 + jj < col; DBGL(6, lo && (badv(ab[jj], 1e3f) || badv(ak[jj], 1e4f))); a[jj] = lo ? ab[jj] : 0.f; k[jj] = lo ? ak[jj] : 0.f; }
        *(LAS f32x4*)(ABf + col * 68 + r0) = a;
        u32x2 o; o.x = pk2(k[0], k[1]); o.y = pk2(k[2], k[3]); *(LAS u32x2*)(AK + col * 72 + r0) = o;
    });
    blk_mma2<4, 4, 2>(KD, RT, BT, RT, 72, C.wid, C.lane, [=](int r0, int col, const f32x4& rk, const f32x4& rb) {
        float a[4], b[4];
#pragma unroll
        for (int jj = 0; jj < 4; ++jj) { const bool le = r0 + jj <= col; DBGL(7, le && (badv(rk[jj], 1e5f) || badv(rb[jj], 1e5f))); a[jj] = le ? rk[jj] : 0.f; b[jj] = le ? rb[jj] : 0.f; }
        u32x2 oa, ob; oa.x = pk2(a[0], a[1]); oa.y = pk2(a[2], a[3]); ob.x = pk2(b[0], b[1]); ob.y = pk2(b[2], b[3]);
        *(LAS u32x2*)(ARK + col * 72 + r0) = oa; *(LAS u32x2*)(ARB + col * 72 + r0) = ob;
    });
    __syncthreads();
    tri_inverse(ABf, (LAS float*)(L + 54272), (LAS float*)(L + 71680), TT, C.tid, C.wid, C.lane);
    __syncthreads();
#if MK_DIAG2
    for (int e = C.tid; e < 4096; e += 512) DBGF(8, badv(bf2f(TT[(e >> 6) * 72 + (e & 63)]), 1e3f));
#endif
    D1_RELAUNDER();
    blk_mma2<4, 4, 2>(TT, KTt, AK, Vt, 72, C.wid, C.lane, [=](int r0, int col, const f32x4& w1, const f32x4& akv) {
        DBGL(9, badv(w1[0], 1e3f) || badv(w1[1], 1e3f) || badv(w1[2], 1e3f) || badv(w1[3], 1e3f)); DBGL(10, badv(akv[0], 1e5f) || badv(akv[1], 1e5f) || badv(akv[2], 1e5f) || badv(akv[3], 1e5f));
        u32x2 a, b; a.x = pk2(w1[0], w1[1]); a.y = pk2(w1[2], w1[3]); b.x = pk2(akv[0], akv[1]); b.y = pk2(akv[2], akv[3]);
        *(LAS u32x2*)(W1t + col * 72 + r0) = a; *(LAS u32x2*)(AKVt + col * 72 + r0) = b;
    });
    __syncthreads();
    blk_mma<4, 4, 2>(TT, 72, AKVt, 72, C.wid, C.lane, [=](int r0, int col, const f32x4& w2) {
        DBGL(11, badv(w2[0], 1e5f) || badv(w2[1], 1e5f) || badv(w2[2], 1e5f) || badv(w2[3], 1e5f));
        u32x2 a; a.x = pk2(w2[0], w2[1]); a.y = pk2(w2[2], w2[3]); *(LAS u32x2*)(W2t + col * 72 + r0) = a;
    });
    __syncthreads();
    D1_RELAUNDER();
    {
        bf16_t* Gg = (bf16_t*)(C.ws + WS_RG) + (size_t)slot * 4096; bf16_t* Jg = (bf16_t*)(C.ws + WS_RJ) + (size_t)slot * 4096;
        bf16_t* Ryg = (bf16_t*)(C.ws + WS_RY) + (size_t)slot * 4096; bf16_t* Ylg = (bf16_t*)(C.ws + WS_RL) + (size_t)slot * 4096;
        blk_mma2<4, 4, 2>(W1t, BTt, W1t, ARB, 72, C.wid, C.lane, [=](int r0, int col, const f32x4& gp, const f32x4& rbw) {
            const float gl = GL[col]; float g[4], ry[4];
            const u32x2 rt = *(const LAS u32x2*)(RT + col * 72 + r0);
            const float rtv[4] = {bflo(rt.x), bfhi(rt.x), bflo(rt.y), bfhi(rt.y)};
#pragma unroll
            for (int jj = 0; jj < 4; ++jj) { g[jj] = gl * ((col == r0 + jj ? 1.f : 0.f) - gp[jj]); ry[jj] = rtv[jj] - rbw[jj]; }
            u32x2 og, oy; og.x = pk2(g[0], g[1]); og.y = pk2(g[2], g[3]); oy.x = pk2(ry[0], ry[1]); oy.y = pk2(ry[2], ry[3]);
            *(u32x2*)(Gg + col * 64 + r0) = og;
            *(u32x2*)(Ryg + col * 64 + r0) = oy;
        });
        blk_mma2<4, 4, 2>(KDt, Vt, BTt, W2t, 72, C.wid, C.lane, [=](int r0, int col, const f32x4& kv, const f32x4& bw) {
            f32x4 o;
#pragma unroll
            for (int jj = 0; jj < 4; ++jj) { o[jj] = GL[r0 + jj] * (kv[jj] - bw[jj]); DBGL(12, badv(GL[r0 + jj] * kv[jj], 1e5f)); DBGL(13, badv(GL[r0 + jj] * bw[jj], 1e5f)); DBGL(14, badv(o[jj], 1e5f)); }
            u32x2 oj; oj.x = pk2(o[0], o[1]); oj.y = pk2(o[2], o[3]); *(u32x2*)(Jg + col * 64 + r0) = oj;
        });
        blk_mma2<4, 4, 2>(ARK, Vt, ARB, W2t, 72, C.wid, C.lane, [=](int r0, int col, const f32x4& a, const f32x4& b) {
            u32x2 o; o.x = pk2(a[0] - b[0], a[1] - b[1]); o.y = pk2(a[2] - b[2], a[3] - b[3]);
            *(u32x2*)(Ylg + col * 64 + r0) = o;
        });
    }
    __syncthreads();
}

typedef float f32x2p __attribute__((ext_vector_type(2)));
__device__ __forceinline__ void ph_scan(const Ctx& C, int nrep = 1, bool mstore = true, bool chain = true) {
    if (C.bid < 64) {
      if (chain)
      for (int rep = 0; rep < nrep; ++rep) {
        constexpr int NB = 8;
        const int chain_id = C.bid >> 2, w4 = C.bid & 3, fr = C.lane & 15, fq = C.lane >> 4;
        LAS bf16_t* Gs = (LAS bf16_t*)C.lds;
        LAS bf16_t* Js = Gs + NB * 4608;
        LAS bf16_t* HT = Js + NB * 1152;
        const bf16_t* Gg = (const bf16_t*)(C.ws + WS_RG) + (size_t)chain_id * NCH * 4096;
        const bf16_t* Jg = (const bf16_t*)(C.ws + WS_RJ) + (size_t)chain_id * NCH * 4096 + (size_t)(16 * w4) * 64;
        bf16_t* Hg = (bf16_t*)(C.ws + WS_RH) + (size_t)chain_id * NCH * 4096 + (16 * w4 + fr) * 64 + fq * 4;
        u32x4 pf[10];
#define CHAIN_ISSUE(b0_) do { _Pragma("unroll") for (int i = 0; i < 10; ++i) { const int e = C.tid + 512 * i, st = e / 640, q = e % 640; const size_t cp = (size_t)((b0_) + st < NCH ? (b0_) + st : NCH - 1) * 4096; \
            pf[i] = *(const u32x4*)(q < 512 ? Gg + cp + q * 8 : Jg + cp + (q - 512) * 8); } } while (0)
#define CHAIN_STAGE() do { _Pragma("unroll") for (int i = 0; i < 10; ++i) { const int e = C.tid + 512 * i, st = e / 640, q = e % 640; \
            if (q < 512) *(LAS u32x4*)(Gs + st * 4608 + (q >> 3) * 72 + (q & 7) * 8) = pf[i]; else *(LAS u32x4*)(Js + st * 1152 + ((q - 512) >> 3) * 72 + (q & 7) * 8) = pf[i]; } } while (0)
        f32x4 acc[4];
#pragma unroll
        for (int tm = 0; tm < 4; ++tm) acc[tm] = (f32x4){0.f, 0.f, 0.f, 0.f};
        CHAIN_ISSUE(0);
        for (int b0 = 0; b0 < NCH; b0 += NB) {
            __syncthreads();
            CHAIN_STAGE();
            __syncthreads();
            if (b0 + NB < NCH) CHAIN_ISSUE(b0 + NB);
            if (C.wid == 0) {
                const int nb = NCH - b0 < NB ? NCH - b0 : NB;
                for (int st = 0; st < nb; ++st) {
                    const int cpos = b0 + st;
#pragma unroll
                    for (int tm = 0; tm < 4; ++tm) { u32x2 o; o.x = pk2(acc[tm][0], acc[tm][1]); o.y = pk2(acc[tm][2], acc[tm][3]);
                        *(LAS u32x2*)(HT + fr * 72 + tm * 16 + fq * 4) = o;
                        *(u32x2*)(Hg + (size_t)cpos * 4096 + tm * 16) = o; }
                    const bf16x8 b0v = *(const LAS bf16x8*)(HT + fr * 72 + fq * 8), b1v = *(const LAS bf16x8*)(HT + fr * 72 + 32 + fq * 8);
#pragma unroll
                    for (int tm = 0; tm < 4; ++tm) {
                        const u32x2 jr = *(const LAS u32x2*)(Js + st * 1152 + fr * 72 + tm * 16 + fq * 4);
                        f32x4 a = {bflo(jr.x), bfhi(jr.x), bflo(jr.y), bfhi(jr.y)};
                        a = __builtin_amdgcn_mfma_f32_16x16x32_bf16(*(const LAS bf16x8*)(Gs + st * 4608 + (tm * 16 + fr) * 72 + fq * 8), b0v, a, 0, 0, 0);
                        a = __builtin_amdgcn_mfma_f32_16x16x32_bf16(*(const LAS bf16x8*)(Gs + st * 4608 + (tm * 16 + fr) * 72 + 32 + fq * 8), b1v, a, 0, 0, 0);
                        acc[tm] = a; }
                }
            }
        }
#undef CHAIN_ISSUE
#undef CHAIN_STAGE
        __syncthreads();
      }
    } else {
        unsigned* MST = (unsigned*)(C.ws + WS_MST); const float* MCD = (const float*)(C.ws + WS_MCD);
        const int nthr = (C.G - 64) * 512;
        for (int e = (C.bid - 64) * 512 + C.tid; e < 16 * 4096; e += nthr) {
            const int chain = e >> 12, el = e & 4095; float r0 = 0.f, r1 = 0.f;
            unsigned* p = MST + (size_t)chain * NCH * 4096 + el; const float* cd = MCD + chain * NCH;
#pragma unroll 22
            for (int cpos = 0; cpos < NCH; ++cpos) { const unsigned tmp = p[(size_t)cpos * 4096]; if (mstore) p[(size_t)cpos * 4096] = pk2(r0, r1); const float c = cd[cpos]; r0 = r0 * c + bflo(tmp); r1 = r1 * c + bfhi(tmp); }
            if (!mstore && r0 == 12345.678f) p[0] = 0u;
        }
    }
}

__device__ __forceinline__ void item_mamba_out(const Ctx& C0_, int layer, int gc) {
    Ctx C = C0_;
#define MO_RELAUNDER() do { int t_ = C.tid; asm volatile("" : "+v"(t_)); C.tid = t_; C.lane = t_ & 63; C.wid = __builtin_amdgcn_readfirstlane(t_ >> 6); } while (0)
    MO_RELAUNDER();
    const ChunkInfo ci = chunk_info(gc);
    const bf16_t* P = (const bf16_t*)(C.ws + WS_P); bf16_t* YC = (bf16_t*)(C.ws + WS_ACT); const bf16_t* MST = (const bf16_t*)(C.ws + WS_MST);
    lds_t L = C.lds;
    LAS float* DT = (LAS float*)L;
    LAS float* DA = (LAS float*)(L + 2048);
    LAS float* CSI = (LAS float*)(L + 4096);
    LAS float* SSQ = (LAS float*)(L + 6144);
    LAS bf16_t* CG = (LAS bf16_t*)(L + 10240);
    LAS bf16_t* BG = (LAS bf16_t*)(L + 27648);
    LAS bf16_t* XT = (LAS bf16_t*)(L + 45056);
    LAS float* CBm = (LAS float*)(L + 63488);
    LAS bf16_t* MP = (LAS bf16_t*)(L + 80896);
    LAS bf16_t* S0 = (LAS bf16_t*)(L + 90112);
    LAS bf16_t* YPRE = (LAS bf16_t*)(L + 107520);
    int fr = C.lane & 15, fq = C.lane >> 4;
    {
        const int s = C.lane, dh = C.wid;
        const float raw = bf2f(P[(size_t)(ci.row0 + s) * NP + OFF_C + 1024 + dh]);
        const float dt = softplus(raw + C.in[20][layer * 8 + dh]);
        const float da = dt * (-expf(C.in[21][layer * 8 + dh]));
        const float incl = wave_incl_scan(da, s), total = __shfl(incl, 63);
        DT[dh * 64 + s] = dt; DA[dh * 64 + s] = da;
        CSI[dh * 64 + s] = (dh < 4) ? incl : (total - incl + da);
    }
    for (int g = 0; g < 2; ++g) {
        __syncthreads();
        MO_RELAUNDER(); fr = C.lane & 15; fq = C.lane >> 4;
        {
            const int cp = C.tid & 255, half = C.tid >> 8;
            if (cp < 192) {
                const int kind = cp >> 6, cl = (cp & 63) * 2, c0 = kind * 256 + g * 128 + cl;
                const float* cw = C.in[18] + (size_t)layer * 5 * 768 + c0; const float* cb = C.in[19] + layer * 768 + c0;
                float w0[5], w1[5];
#pragma unroll
                for (int j = 0; j < 5; ++j) { w0[j] = cw[j * 768]; w1[j] = cw[j * 768 + 1]; }
                const float b0 = cb[0], b1 = cb[1];
                const int s0 = half * 32;
                unsigned wr[36];
                unsigned short xb0[8], xb1[8];
#pragma unroll
                for (int j = 0; j < 36; ++j) { const int row = ci.row0 + s0 - 2 + j; const bool ok = row >= ci.lo && row < ci.hi; const unsigned v = *(const unsigned*)(P + (size_t)(ok ? row : ci.row0) * NP + OFF_C + 256 + c0); wr[j] = ok ? v : 0u; }
#pragma unroll
                for (int tt = 0; tt < 32; ++tt) {
                    const int s = s0 + tt;
                    const unsigned* win = wr + tt;
                    float a0 = b0, a1 = b1;
#pragma unroll
                    for (int j = 0; j < 5; ++j) { a0 += w0[j] * bflo(win[j]); a1 += w1[j] * bfhi(win[j]); }
                    const unsigned short o0 = f2bf(silu(a0)), o1 = f2bf(silu(a1));
                    if (kind == 0) { xb0[tt & 7] = o0; xb1[tt & 7] = o1;
                        if ((tt & 7) == 7) { const int sb = s - 7;
                            *(LAS u32x4*)(XT + cl * 72 + sb) = (u32x4){(unsigned)xb0[0] | ((unsigned)xb0[1] << 16), (unsigned)xb0[2] | ((unsigned)xb0[3] << 16), (unsigned)xb0[4] | ((unsigned)xb0[5] << 16), (unsigned)xb0[6] | ((unsigned)xb0[7] << 16)};
                            *(LAS u32x4*)(XT + (cl + 1) * 72 + sb) = (u32x4){(unsigned)xb1[0] | ((unsigned)xb1[1] << 16), (unsigned)xb1[2] | ((unsigned)xb1[3] << 16), (unsigned)xb1[4] | ((unsigned)xb1[5] << 16), (unsigned)xb1[6] | ((unsigned)xb1[7] << 16)}; } }
                    else if (kind == 1) { *(LAS unsigned*)(BG + s * 136 + cl) = (unsigned)o0 | ((unsigned)o1 << 16); }
                    else { *(LAS unsigned*)(CG + s * 136 + cl) = (unsigned)o0 | ((unsigned)o1 << 16); }
                }
            }
        }
        __syncthreads();
        blk_mma<4, 4, 4>(CG, 136, BG, 136, C.wid, C.lane, [=](int r0, int col, const f32x4& acc) {
#pragma unroll
            for (int jj = 0; jj < 4; ++jj) CBm[(r0 + jj) * 68 + col] = acc[jj];
        });
        u32x4 s0r[2];
        { const bf16_t* src = MST + (size_t)slot_of(ci.b, 2 * g, 0, cpos_of(ci, 0)) * 8192;
#pragma unroll
          for (int k = 0; k < 2; ++k) { const int e = C.tid + 512 * k; s0r[k] = *(const u32x4*)(src + (e >> 4) * 128 + (e & 15) * 8); } }
        for (int hh = 0; hh < 2; ++hh) {
            MO_RELAUNDER(); fr = C.lane & 15; fq = C.lane >> 4;
            const int h = 2 * g + hh;
            f32x4 yacc[2] = {{0.f, 0.f, 0.f, 0.f}, {0.f, 0.f, 0.f, 0.f}};
            unsigned short zr[2][4];
#pragma unroll
            for (int i = 0; i < 2; ++i) { const int tt = C.wid + 8 * i, tm = tt >> 2, tn = tt & 3;
#pragma unroll
                for (int j = 0; j < 4; ++j) zr[i][j] = P[(size_t)(ci.row0 + tm * 16 + fq * 4 + j) * NP + OFF_C + h * 64 + tn * 16 + fr]; }
            for (int d = 0; d < 2; ++d) {
                const int dh = d * 4 + h;
                __syncthreads();
                for (int e = C.tid; e < 4096; e += 512) { const int l = e >> 6, s = e & 63; const bool ok = d ? (s >= l) : (s <= l);
                    MP[l * 72 + s] = ok ? f2bf(CBm[l * 68 + s] * fexp(CSI[dh * 64 + l] - CSI[dh * 64 + s]) * DT[dh * 64 + s]) : (unsigned short)0; }
#pragma unroll
                for (int k = 0; k < 2; ++k) { const int e = C.tid + 512 * k; *(LAS u32x4*)(S0 + (e >> 4) * 136 + (e & 15) * 8) = s0r[k]; }
                if (!(hh == 1 && d == 1)) { const int nh = d ? h + 1 : h, nd = d ^ 1; const bf16_t* src = MST + (size_t)slot_of(ci.b, nh, nd, cpos_of(ci, nd)) * 8192;
#pragma unroll
                    for (int k = 0; k < 2; ++k) { const int e = C.tid + 512 * k; s0r[k] = *(const u32x4*)(src + (e >> 4) * 128 + (e & 15) * 8); } }
                __syncthreads();
#pragma unroll
                for (int i = 0; i < 2; ++i) { const int tt = C.wid + 8 * i, tm = tt >> 2, tn = tt & 3;
                    f32x4 a1 = {0.f, 0.f, 0.f, 0.f}, a2 = {0.f, 0.f, 0.f, 0.f};
#pragma unroll
                    for (int ks = 0; ks < 2; ++ks) a1 = __builtin_amdgcn_mfma_f32_16x16x32_bf16(*(const LAS bf16x8*)(MP + (tm * 16 + fr) * 72 + ks * 32 + fq * 8),
                                                                                                 *(const LAS bf16x8*)(XT + (hh * 64 + tn * 16 + fr) * 72 + ks * 32 + fq * 8), a1, 0, 0, 0);
#pragma unroll
                    for (int ks = 0; ks < 4; ++ks) a2 = __builtin_amdgcn_mfma_f32_16x16x32_bf16(*(const LAS bf16x8*)(CG + (tm * 16 + fr) * 136 + ks * 32 + fq * 8),
                                                                                                 *(const LAS bf16x8*)(S0 + (tn * 16 + fr) * 136 + ks * 32 + fq * 8), a2, 0, 0, 0);
#pragma unroll
                    for (int j = 0; j < 4; ++j) yacc[i][j] += a1[j] + a2[j] * fexp(CSI[dh * 64 + tm * 16 + fq * 4 + j]);
                }
            }
            const float dsk = C.in[22][layer * 4 + h];
#pragma unroll
            for (int i = 0; i < 2; ++i) { const int tt = C.wid + 8 * i, tm = tt >> 2, tn = tt & 3;
#pragma unroll
                for (int j = 0; j < 4; ++j) { const int l = tm * 16 + fq * 4 + j, p = tn * 16 + fr, c = h * 64 + p;
                    const float xs = bf2f(XT[(hh * 64 + p) * 72 + l]);
                    const float z = bf2f(zr[i][j]);
                    const float pre = (yacc[i][j] + dsk * xs) * silu(z);
                    YPRE[l * 264 + c] = f2bf(pre);
                    float q = pre * pre; q += __shfl_xor(q, 1); q += __shfl_xor(q, 2); q += __shfl_xor(q, 4); q += __shfl_xor(q, 8);
                    if (fr == 0) SSQ[l * 16 + h * 4 + tn] = q; }
            }
        }
    }
    __syncthreads();
    {
        const int l = C.tid >> 3, sub = C.tid & 7; float ss = 0.f;
#pragma unroll
        for (int i = 0; i < 16; ++i) ss += SSQ[l * 16 + i];
        const float rs = rsqrtf(ss * (1.f / 256.f) + 1e-6f);
        const float* ng = C.in[23] + layer * 256 + sub * 32;
        bf16_t* dst = YC + (size_t)(ci.row0 + l) * DM + 512 + sub * 32;
#pragma unroll
        for (int i = 0; i < 32; i += 2) { const float a = bf2f(YPRE[l * 264 + sub * 32 + i]) * rs * ng[i], b = bf2f(YPRE[l * 264 + sub * 32 + i + 1]) * rs * ng[i + 1]; *(unsigned*)(dst + i) = pk2(a, b); }
    }
    __syncthreads();
}

constexpr int D3_G2T = 0, D3_SG = 69632;
__device__ __forceinline__ void load_g2t(const Ctx& C, int layer) {
    LAS bf16_t* G2T = (LAS bf16_t*)(C.lds + D3_G2T); const float* g2 = C.in[30] + (size_t)layer * 128 * 256;
    for (int e = C.tid; e < 128 * 256; e += 512) { const int r = e >> 8, c = e & 255; G2T[c * 136 + r] = f2bf(g2[e]); }
}
__device__ __forceinline__ float lerp_d(const bf16_t* P, const ChunkInfo& ci, int row, int j, const float* mup, const float* mun) {
    const bf16_t* pp = P + (size_t)row * NP + OFF_D + j;
    const bool okp = row - 1 >= ci.lo, okn = row + 1 < ci.hi;
    const float x = bf2f(*pp), xpv = bf2f(*(okp ? pp - NP : pp)), xnv = bf2f(*(okn ? pp + NP : pp)); const float xp = okp ? xpv : 0.f, xn = okn ? xnv : 0.f;
    return x + mup[j] * (xp - x) + mun[j] * (xn - x);
}
__device__ __forceinline__ void item_rwkv_out(const Ctx& C, int layer, int gc) {
    const ChunkInfo ci = chunk_info(gc);
    const bf16_t* P = (const bf16_t*)(C.ws + WS_P); bf16_t* YC = (bf16_t*)(C.ws + WS_ACT);
    const float* mup = C.in[24] + layer * 1152; const float* mun = C.in[25] + layer * 1152;
    LAS bf16_t* G2T = (LAS bf16_t*)(C.lds + D3_G2T); LAS bf16_t* SG = (LAS bf16_t*)(C.lds + D3_SG);
    int ln_ = C.lane; asm volatile("" : "+v"(ln_));
    const int fr = ln_ & 15, fq = ln_ >> 4;
    __syncthreads();
    for (int e = C.tid; e < 64 * 128; e += 512) { const int l = e >> 7, r = e & 127; SG[l * 136 + r] = f2bf(sigm(lerp_d(P, ci, ci.row0 + l, 1024 + r, mup, mun))); }
    __syncthreads();
    const int h = C.wid >> 1, tmb = (C.wid & 1) * 2;
    const bf16_t* Ryg = (const bf16_t*)(C.ws + WS_RY); const bf16_t* Ylg = (const bf16_t*)(C.ws + WS_RL); const bf16_t* Hg = (const bf16_t*)(C.ws + WS_RH);
    const float* BON = (const float*)(C.ws + WS_BON);
#pragma unroll
    for (int ti = 0; ti < 2; ++ti) {
        const int tm = tmb + ti;
        f32x4 gacc[4], yacc[4];
#pragma unroll
        for (int tn = 0; tn < 4; ++tn) { f32x4 a = {0.f, 0.f, 0.f, 0.f};
#pragma unroll
            for (int ks = 0; ks < 4; ++ks) a = __builtin_amdgcn_mfma_f32_16x16x32_bf16(*(const LAS bf16x8*)(SG + (tm * 16 + fr) * 136 + ks * 32 + fq * 8),
                                                                                        *(const LAS bf16x8*)(G2T + (h * 64 + tn * 16 + fr) * 136 + ks * 32 + fq * 8), a, 0, 0, 0);
            gacc[tn] = a; yacc[tn] = (f32x4){0.f, 0.f, 0.f, 0.f}; }
#pragma unroll
        for (int d = 0; d < 2; ++d) {
            const size_t slot = (size_t)slot_of(ci.b, h, d, cpos_of(ci, d));
            const int arow = d ? 63 - (tm * 16 + fr) : tm * 16 + fr;
            bf16x8 af[2];
#pragma unroll
            for (int ks = 0; ks < 2; ++ks) af[ks] = *(const bf16x8*)(Ryg + slot * 4096 + arow * 64 + ks * 32 + fq * 8);
#pragma unroll
            for (int tn = 0; tn < 4; ++tn) {
                f32x4 a;
                if (d == 0) { const u32x2 yl = *(const u32x2*)(Ylg + slot * 4096 + (tn * 16 + fr) * 64 + tm * 16 + fq * 4); a = (f32x4){bflo(yl.x), bfhi(yl.x), bflo(yl.y), bfhi(yl.y)}; }
                else { const u32x2 yl = *(const u32x2*)(Ylg + slot * 4096 + (tn * 16 + fr) * 64 + 60 - (tm * 16 + fq * 4)); a = (f32x4){bfhi(yl.y), bflo(yl.y), bfhi(yl.x), bflo(yl.x)}; }
#pragma unroll
                for (int ks = 0; ks < 2; ++ks) a = __builtin_amdgcn_mfma_f32_16x16x32_bf16(af[ks], *(const bf16x8*)(Hg + slot * 4096 + (tn * 16 + fr) * 64 + ks * 32 + fq * 8), a, 0, 0, 0);
                yacc[tn] += a;
            }
        }
#pragma unroll
        for (int j = 0; j < 4; ++j) {
            const int l = tm * 16 + fq * 4 + j, row = ci.row0 + l;
            float s = (yacc[0][j] + yacc[1][j]) + (yacc[2][j] + yacc[3][j]);
            s += __shfl_xor(s, 1); s += __shfl_xor(s, 2); s += __shfl_xor(s, 4); s += __shfl_xor(s, 8);
            const float mu = s * (1.f / 64.f);
            float q = 0.f;
#pragma unroll
            for (int tn = 0; tn < 4; ++tn) { const float dd = yacc[tn][j] - mu; q += dd * dd; }
            q += __shfl_xor(q, 1); q += __shfl_xor(q, 2); q += __shfl_xor(q, 4); q += __shfl_xor(q, 8);
            const float rs = rsqrtf(q * (1.f / 64.f) + 64e-5f);
            const float bon = BON[(size_t)row * 8 + h * 2] + BON[(size_t)row * 8 + h * 2 + 1];
#pragma unroll
            for (int tn = 0; tn < 4; ++tn) { const int c = h * 64 + tn * 16 + fr;
                const float yn = (yacc[tn][j] - mu) * rs * C.in[34][layer * 256 + c] + C.in[35][layer * 256 + c];
                const float vv = lerp_d(P, ci, row, 512 + c, mup, mun);
                YC[(size_t)row * DM + 768 + c] = f2bf((yn + bon * vv) * gacc[tn][j]); }
        }
    }
}

__device__ __forceinline__ unsigned ordf(float f) { const unsigned u = __float_as_uint(f); return u ^ ((u >> 31) ? 0xFFFFFFFFu : 0x80000000u); }
__device__ __forceinline__ unsigned wave_max_u32(unsigned v) {
    unsigned t;
    t = (unsigned)__builtin_amdgcn_update_dpp((int)v, (int)v, 0xB1, 0xF, 0xF, false); v = t > v ? t : v;
    t = (unsigned)__builtin_amdgcn_update_dpp((int)v, (int)v, 0x4E, 0xF, 0xF, false); v = t > v ? t : v;
    t = (unsigned)__builtin_amdgcn_update_dpp((int)v, (int)v, 0x141, 0xF, 0xF, false); v = t > v ? t : v;
    t = (unsigned)__builtin_amdgcn_update_dpp((int)v, (int)v, 0x140, 0xF, 0xF, false); v = t > v ? t : v;
    t = (unsigned)__builtin_amdgcn_update_dpp((int)v, (int)v, 0x142, 0xA, 0xF, false); v = t > v ? t : v;
    t = (unsigned)__builtin_amdgcn_update_dpp((int)v, (int)v, 0x143, 0xC, 0xF, false); v = t > v ? t : v;
    return (unsigned)__builtin_amdgcn_readlane((int)v, 63);
}
constexpr int SEL_K1 = 0, SEL_K2 = 34816;
__device__ __forceinline__ float unordf(unsigned k) { return __uint_as_float((k & 0x80000000u) ? (k ^ 0x80000000u) : ~k); }
template <int N> __device__ __forceinline__ void bitonic_sort_desc(unsigned (&x)[N]) {
#pragma unroll
    for (int k = 2; k <= N; k <<= 1)
#pragma unroll
        for (int j = k >> 1; j > 0; j >>= 1)
#pragma unroll
            for (int i = 0; i < N; ++i) { const int l = i ^ j;
                if (l > i) { const unsigned p = x[i], q = x[l]; const unsigned hi = p > q ? p : q, lo = p > q ? q : p; if ((i & k) == 0) { x[i] = hi; x[l] = lo; } else { x[i] = lo; x[l] = hi; } } }
}
__device__ __forceinline__ void merge_top16(unsigned (&a)[16], const unsigned (&b)[16]) {
#pragma unroll
    for (int i = 0; i < 16; ++i) a[i] = a[i] > b[15 - i] ? a[i] : b[15 - i];
#pragma unroll
    for (int j = 8; j > 0; j >>= 1)
#pragma unroll
        for (int i = 0; i < 16; ++i) { const int l = i ^ j; if (l > i) { const unsigned p = a[i], q = a[l]; a[i] = p > q ? p : q; a[l] = p > q ? q : p; } }
}
__device__ __forceinline__ void ph_select(const Ctx& C, int layer, int nrows) {
    const bf16_t* Q = (const bf16_t*)(C.ws + WS_Q); int* SELI = (int*)(C.ws + WS_SELI); float* SELG = (float*)(C.ws + WS_SELG);
    LAS bf16_t* K1 = (LAS bf16_t*)(C.lds + SEL_K1); LAS bf16_t* K2 = (LAS bf16_t*)(C.lds + SEL_K2);
    {
        const float* k1 = C.in[37] + (size_t)layer * 128 * 128; const float* k2 = C.in[38] + (size_t)layer * 128 * 128;
        for (int e = C.tid; e < 4096; e += 512) { const int r = e >> 5, c4 = (e & 31) * 4; const f32x4 a = *(const f32x4*)(k1 + r * 128 + c4), b = *(const f32x4*)(k2 + r * 128 + c4);
            u32x2 oa, ob; oa.x = pk2(a.x, a.y); oa.y = pk2(a.z, a.w); ob.x = pk2(b.x, b.y); ob.y = pk2(b.z, b.w);
            *(LAS u32x2*)(K1 + r * 136 + c4) = oa; *(LAS u32x2*)(K2 + r * 136 + c4) = ob; }
    }
    __syncthreads();
    const int nunits = (nrows / 16) * 8;
    for (int u = C.bid * 8 + C.wid; u < nunits; u += C.G * 8) {
        int ln_ = C.lane; asm volatile("" : "+v"(ln_));
        const int fr = ln_ & 15, fq = ln_ >> 4;
        const int tile = u >> 3, h = u & 7, row = tile * 16 + fr;
        const bf16_t* qp = Q + (size_t)row * 2048 + h * 256 + fq * 8;
        bf16x8 qf[8];
#pragma unroll
        for (int i = 0; i < 8; ++i) qf[i] = *(const bf16x8*)(qp + i * 32);
        unsigned T[2][16];
#pragma unroll
        for (int half = 0; half < 2; ++half) {
            const LAS bf16_t* K = half ? K2 : K1;
            unsigned lo16[16], hi16[16];
#pragma unroll
            for (int kt = 0; kt < 8; ++kt) {
                f32x4 acc = {0.f, 0.f, 0.f, 0.f};
#pragma unroll
                for (int ks = 0; ks < 4; ++ks) acc = __builtin_amdgcn_mfma_f32_16x16x32_bf16(*(const LAS bf16x8*)(K + (kt * 16 + fr) * 136 + ks * 32 + fq * 8), qf[half * 4 + ks], acc, 0, 0, 0);
#pragma unroll
                for (int j = 0; j < 4; ++j) { const unsigned key = (ordf(acc[j]) & ~0x7Fu) | (unsigned)(127 - (kt * 16 + fq * 4 + j));
                    if (kt < 4) lo16[kt * 4 + j] = key; else hi16[(kt - 4) * 4 + j] = key; }
            }
            bitonic_sort_desc<16>(lo16); bitonic_sort_desc<16>(hi16); merge_top16(lo16, hi16);
#pragma unroll
            for (int rnd = 16; rnd <= 32; rnd <<= 1) { unsigned o[16];
#pragma unroll
                for (int i = 0; i < 16; ++i) o[i] = (unsigned)__shfl_xor((int)lo16[i], rnd);
                merge_top16(lo16, o); }
#pragma unroll
            for (int i = 0; i < 16; ++i) T[half][i] = lo16[i];
        }
        unsigned ck[50]; unsigned R0[16];
        {
            int id = 0;
#pragma unroll
            for (int a = 0; a < 16; ++a) {
                const float va = unordf(T[0][a] & ~0x7Fu);
#pragma unroll
                for (int b = 0; b < 16; ++b) if ((a + 1) * (b + 1) <= 16) { ck[id] = (ordf(va + unordf(T[1][b] & ~0x7Fu)) & ~0x3Fu) | (unsigned)(63 - id); ++id; }
            }
        }
#pragma unroll
        for (int i = 0; i < 16; ++i) R0[i] = ck[i];
        {
            int base = 16;
#pragma unroll
            for (int a = 1; a < 8; ++a) { const int n = 16 / (a + 1); unsigned rw[16];
#pragma unroll
                for (int i = 0; i < 16; ++i) rw[i] = i < n ? ck[base + i] : 0u;
                merge_top16(R0, rw); base += n; }
            unsigned rw[16];
#pragma unroll
            for (int i = 0; i < 16; ++i) rw[i] = i < 8 ? ck[base + i] : 0u;
            merge_top16(R0, rw);
        }
        const unsigned thr = R0[15]; const float mx = unordf(R0[0] & ~0x3Fu);
        float sum = 0.f;
#pragma unroll
        for (int c = 0; c < 50; ++c) sum += ck[c] >= thr ? __expf(unordf(ck[c] & ~0x3Fu) - mx) : 0.f;
        const float rsum = 1.f / sum;
        int* oi = SELI + ((size_t)row * 8 + h) * 16; float* og = SELG + ((size_t)row * 8 + h) * 16;
        {
            int id = 0, cnt = 0;
#pragma unroll
            for (int a = 0; a < 16; ++a)
#pragma unroll
                for (int b = 0; b < 16; ++b) if ((a + 1) * (b + 1) <= 16) {
                    if (ck[id] >= thr) { if (fq == 0 && cnt < 16) { oi[cnt] = (127 - (int)(T[0][a] & 0x7Fu)) * 128 + (127 - (int)(T[1][b] & 0x7Fu)); og[cnt] = __expf(unordf(ck[id] & ~0x3Fu) - mx) * rsum; } ++cnt; }
                    ++id; }
        }
    }
}

struct R16 { float v[16]; };
__device__ __forceinline__ R16 load_r16_f32(const float* p, int lane) { R16 r;
#pragma unroll
    for (int k = 0; k < 4; ++k) { const f32x4 a = *(const f32x4*)(p + 16 * lane + 4 * k); r.v[4 * k] = a.x; r.v[4 * k + 1] = a.y; r.v[4 * k + 2] = a.z; r.v[4 * k + 3] = a.w; }
    return r; }
__device__ __forceinline__ void store_r16_f32(float* p, int lane, const R16& r) {
#pragma unroll
    for (int k = 0; k < 4; ++k) *(f32x4*)(p + 16 * lane + 4 * k) = (f32x4){r.v[4 * k], r.v[4 * k + 1], r.v[4 * k + 2], r.v[4 * k + 3]}; }
__device__ __forceinline__ R16 load_r16_bf16(const bf16_t* p, int lane) { R16 r;
#pragma unroll
    for (int k = 0; k < 2; ++k) { const u32x4 a = *(const u32x4*)(p + 16 * lane + 8 * k);
        r.v[8 * k] = bflo(a.x); r.v[8 * k + 1] = bfhi(a.x); r.v[8 * k + 2] = bflo(a.y); r.v[8 * k + 3] = bfhi(a.y); r.v[8 * k + 4] = bflo(a.z); r.v[8 * k + 5] = bfhi(a.z); r.v[8 * k + 6] = bflo(a.w); r.v[8 * k + 7] = bfhi(a.w); }
    return r; }
__device__ __forceinline__ void store_r16_bf16(bf16_t* p, int lane, const R16& r) {
#pragma unroll
    for (int k = 0; k < 2; ++k) { u32x4 a; a.x = pk2(r.v[8 * k], r.v[8 * k + 1]); a.y = pk2(r.v[8 * k + 2], r.v[8 * k + 3]); a.z = pk2(r.v[8 * k + 4], r.v[8 * k + 5]); a.w = pk2(r.v[8 * k + 6], r.v[8 * k + 7]);
        *(u32x4*)(p + 16 * lane + 8 * k) = a; } }
typedef float f32x2p __attribute__((ext_vector_type(2)));
struct PeerHdr { int idx0, idx1; float su0, su1, gsv0, gsv1; };
__device__ __forceinline__ void ph_peer(const Ctx& C, int layer, int nrows, bool last, bool store = true, int idmask = 0x3FFF) {
    const bf16_t* F = (const bf16_t*)(C.ws + WS_ACT); bf16_t* XN = (bf16_t*)(C.ws + WS_ACT);
    const unsigned char* UB = C.ws + WS_UB; const unsigned char* VB = C.ws + WS_VB; const float* SU = (const float*)(C.ws + WS_SU); const float* SV = (const float*)(C.ws + WS_SV);
    const int* SELI = (const int*)(C.ws + WS_SELI); const float* SELG = (const float*)(C.ws + WS_SELG);
    float* H = (float*)(C.ws + WS_H); const float* MOD = (const float*)(C.ws + WS_MOD);
    const int step = C.G * 8;
    auto load_hdr = [&](int tok, int L) { PeerHdr h; h.idx0 = SELI[(size_t)tok * 128 + L] & idmask; h.idx1 = SELI[(size_t)tok * 128 + 64 + L] & idmask;
        h.su0 = SU[h.idx0]; h.su1 = SU[h.idx1]; h.gsv0 = SELG[(size_t)tok * 128 + L] * SV[h.idx0]; h.gsv1 = SELG[(size_t)tok * 128 + 64 + L] * SV[h.idx1]; return h; };
    int tok = C.bid * 8 + C.wid;
    for (; tok < nrows; tok += step) {
        int L = C.lane; asm volatile("" : "+v"(L));
        const int myexp = ((L >> 5) & 1) * 4 + ((L >> 4) & 1) * 2 + ((L >> 3) & 1);
        const PeerHdr hd = load_hdr(tok, L);
        const u32x4 fpa = *(const u32x4*)(F + (size_t)tok * DM + 16 * L), fpb = *(const u32x4*)(F + (size_t)tok * DM + 16 * L + 8);
        f32x2p out[8];
#pragma unroll
        for (int i = 0; i < 8; ++i) out[i] = (f32x2p){0.f, 0.f};
        u32x4 ua[2][8], va[2][8];
#define PEER_LOAD(buf, bt) do { const int src_ = (bt) < 8 ? hd.idx0 : hd.idx1; const int l0_ = ((bt) & 7) * 8; _Pragma("unroll") for (int i = 0; i < 8; ++i) { const int ei = __builtin_amdgcn_readlane(src_, l0_ + i); \
            ua[buf][i] = *(const u32x4*)(UB + (size_t)ei * DM + 16 * L); va[buf][i] = *(const u32x4*)(VB + (size_t)ei * DM + 16 * L); } } while (0)
#define PEER_COMPUTE(buf, bt) do { const float susrc = (bt) < 8 ? hd.su0 : hd.su1, gsrc = (bt) < 8 ? hd.gsv0 : hd.gsv1; const int l0 = ((bt) & 7) * 8; float part[8]; \
            _Pragma("unroll") for (int i = 0; i < 8; ++i) { f32x2p acc = {0.f, 0.f}; _Pragma("unroll") for (int k = 0; k < 4; ++k) { \
                const f32x2p lo = __builtin_amdgcn_cvt_pk_f32_fp8((int)ua[buf][i][k], false), hi = __builtin_amdgcn_cvt_pk_f32_fp8((int)ua[buf][i][k], true); \
                const unsigned fw0 = (k < 2 ? fpa : fpb)[(2 * k) & 3], fw1 = (k < 2 ? fpa : fpb)[(2 * k + 1) & 3]; \
                acc += lo * (f32x2p){bflo(fw0), bfhi(fw0)}; acc += hi * (f32x2p){bflo(fw1), bfhi(fw1)}; } part[i] = acc.x + acc.y; } \
            float p4[4], p2[2], p1; \
            { const bool hi = (L & 32) != 0; _Pragma("unroll") for (int i = 0; i < 4; ++i) { const float send = hi ? part[i] : part[i + 4]; const float recv = __shfl_xor(send, 32); p4[i] = (hi ? part[i + 4] : part[i]) + recv; } } \
            { const bool hi = (L & 16) != 0; _Pragma("unroll") for (int i = 0; i < 2; ++i) { const float send = hi ? p4[i] : p4[i + 2]; const float recv = __shfl_xor(send, 16); p2[i] = (hi ? p4[i + 2] : p4[i]) + recv; } } \
            { const bool hi = (L & 8) != 0; const float send = hi ? p2[0] : p2[1]; const float recv = __shfl_xor(send, 8); p1 = (hi ? p2[1] : p2[0]) + recv; } \
            p1 += __shfl_xor(p1, 4); p1 += __shfl_xor(p1, 2); p1 += __shfl_xor(p1, 1); \
            const float act = gelu_tanh(p1 * __shfl(susrc, l0 + myexp)) * __shfl(gsrc, l0 + myexp); \
            _Pragma("unroll") for (int i = 0; i < 8; ++i) { \
                const float a = __uint_as_float((unsigned)__builtin_amdgcn_readlane((int)__float_as_uint(act), ((i >> 2) & 1) * 32 + ((i >> 1) & 1) * 16 + (i & 1) * 8)); const f32x2p a2 = {a, a}; \
                _Pragma("unroll") for (int k = 0; k < 4; ++k) { out[2 * k] += a2 * __builtin_amdgcn_cvt_pk_f32_fp8((int)va[buf][i][k], false); out[2 * k + 1] += a2 * __builtin_amdgcn_cvt_pk_f32_fp8((int)va[buf][i][k], true); } } } while (0)
        PEER_LOAD(0, 0);
        for (int bt = 0; bt < 16; bt += 2) {
            PEER_LOAD(1, bt + 1);
            PEER_COMPUTE(0, bt);
            if (bt + 2 < 16) PEER_LOAD(0, bt + 2);
            PEER_COMPUTE(1, bt + 1);
        }
#undef PEER_LOAD
#undef PEER_COMPUTE
        const float* m = MOD + ((size_t)layer * 3 + which_of(tok)) * 6144;
        R16 hr = load_r16_f32(H + (size_t)tok * DM, L); const R16 g5 = load_r16_f32(m + 5 * 1024, L);
#pragma unroll
        for (int i = 0; i < 8; ++i) { hr.v[2 * i] += g5.v[2 * i] * out[i].x; hr.v[2 * i + 1] += g5.v[2 * i + 1] * out[i].y; }
        float ss = 0.f;
#pragma unroll
        for (int i = 0; i < 16; ++i) ss += hr.v[i] * hr.v[i];
        const float rs = rsqrtf(wave_sum(ss) * (1.f / 1024.f) + 1e-6f);
        if (!store) continue;
        if (!last) {
            store_r16_f32(H + (size_t)tok * DM, L, hr);
            const float* m2 = MOD + ((size_t)(layer + 1) * 3 + which_of(tok)) * 6144;
            const R16 gg = load_r16_f32(C.in[6] + (layer + 1) * 1024, L), sh = load_r16_f32(m2, L), sc = load_r16_f32(m2 + 1024, L); R16 o;
#pragma unroll
            for (int i = 0; i < 16; ++i) o.v[i] = (hr.v[i] * rs * gg.v[i]) * (1.f + sc.v[i]) + sh.v[i];
            store_r16_bf16(XN + (size_t)tok * DM, L, o);
        } else {
            const R16 fg = load_r16_f32(C.in[41], L); R16 o;
#pragma unroll
            for (int i = 0; i < 16; ++i) o.v[i] = hr.v[i] * rs * fg.v[i];
            store_r16_f32(C.out + (size_t)tok * DM, L, o);
        }
    }
}

#define PM(n) ((MASK >> (n)) & 1u)
constexpr int NPH_LAYER = 9, NPH = 2 + 2 * NPH_LAYER;
template <unsigned MASK> __global__ void __launch_bounds__(512, 2) hybrid_fwd(Args args) {
    extern __shared__ __attribute__((aligned(16))) unsigned char lds_raw[];
    Ctx C0; C0.in = args.in; C0.out = args.out; C0.ws = args.ws; C0.lds = (lds_t)lds_raw;
    C0.wid = __builtin_amdgcn_readfirstlane((int)threadIdx.x >> 6); C0.tid = 0; C0.lane = 0; C0.bid = blockIdx.x; C0.G = gridDim.x;
#define MK_LANE() ((int)__builtin_amdgcn_mbcnt_hi(~0u, __builtin_amdgcn_mbcnt_lo(~0u, 0u)))
#define MK_TID() (C0.wid * 64 + MK_LANE())
    const Ctx& C = C0;
    const int lo = args.ph_lo, hi = args.ph_hi;
    const bool multi = (hi - lo) > 1;
    XcdBarrier bar; bar.w0 = (unsigned)C0.wid; bar.bar = (unsigned*)(C.ws + WS_CTL); bar.x = 0; bar.st = (volatile LAS unsigned*)(C.lds + LDS_XB);
    if (multi) {
        if (C0.wid == 0 && MK_LANE() == 0) *(LAS u32x4*)(C.lds + LDS_XB) = (u32x4){0u, 0u, 0u, 0u};
        __syncthreads();
        bar = xcd_barrier_post((unsigned*)(C.ws + WS_CTL), (volatile LAS unsigned*)(C.lds + LDS_XB), (unsigned)C0.wid);
    }
#define IN(k) (lo <= (k) && (k) < hi)
#define PHASE_CTX(c) Ctx c = C0; { int t_ = MK_TID(); asm volatile("" : "+v"(t_)); c.tid = t_; c.lane = t_ & 63; c.wid = __builtin_amdgcn_readfirstlane(t_ >> 6); }
#ifndef MK_REPEAT
#define MK_REPEAT 0u
#endif
#define RP(k) ((MK_REPEAT >> (k)) & 1u)
#define STAMP(k) do {} while (0)
#define SEAM(k) do { if (IN(k) && IN((k) + 1)) xcd_barrier(bar); STAMP((k) + 1); } while (0)
    STAMP(0);
    if (RP(10)) { for (int i = 0; i < 20; ++i) xcd_barrier(bar); }
    if (PM(0) && IN(0)) { PHASE_CTX(c); ph_prologue(c); if (RP(9)) { xcd_barrier(bar); ph_prologue(c); } } SEAM(0);
    if (PM(1) && IN(1)) { PHASE_CTX(c); ph_norm(c, 0, c.in[6], 0, NROW); } SEAM(1);
    for (int layer = 0; layer < 2; ++layer) {
        const int base = 2 + layer * NPH_LAYER;
        const bool emit = (layer == 0);
        const int nrows = emit ? NROW : NLAT;
        if (PM(2) && IN(base + 0)) {
            pg8::Gemm g{(const bf16_t*)(C.ws + WS_ACT), (const bf16_t*)(C.ws + WS_WIN) + (size_t)layer * NP * DM, NROW, NP, DM};
            pg8::StaticOrder S; S.init(NROW, NP, C.G, C.bid);
            pg8::EpiBf16<0> E{(bf16_t*)(C.ws + WS_P), NP, nullptr, 0, 0};
            pg8::gemm_phase<pg8::EpiBf16<0>, pg8::StaticOrder, false>(C.lds, g, S, E, nullptr, MK_TID());
            if (RP(0)) { xcd_barrier(bar); pg8::gemm_phase<pg8::EpiBf16<0>, pg8::StaticOrder, false>(C.lds, g, S, E, nullptr, MK_TID()); }
            { const int nfull = (NROW / 256) * (NP / 256) - ((NROW / 256) * (NP / 256) / C.G) * C.G; PHASE_CTX(c); if (c.bid >= nfull) convert_tables(c, layer, c.bid - nfull, c.G - nfull); }
        }
        SEAM(base + 0);
        if (PM(3) && IN(base + 1)) {
            const int nD = 2112, nC = 264, nB = emit ? 132 : 128, nA = emit ? 264 : 256, tot = nD + nC + nB + nA;
            for (int rep = 0; rep < (RP(1) ? 2 : 1); ++rep) {
            if (rep) xcd_barrier(bar);
#define MK_QUEUE(TYPE_IDX, COUNT, FIRST, CALL) { unsigned* ctr = (unsigned*)(c.ws + 49152) + 64 * ((layer * 2 + rep) * 4 + (TYPE_IDX)); LAS int* nxt = (LAS int*)(c.lds + LDS_XB + 32); \
                for (int it = (FIRST); it < (COUNT); ) { CALL; __syncthreads(); if (c.tid == 0) *nxt = (int)c.G + (int)__hip_atomic_fetch_add(ctr, 1u, __ATOMIC_RELAXED, __HIP_MEMORY_SCOPE_AGENT); __syncthreads(); it = *nxt; } }
            if (PM(12)) { PHASE_CTX(c); MK_QUEUE(1, nC, c.bid, { item_mamba_local(c, layer, it); if (RP(13)) item_mamba_local(c, layer, it); }) }
            if (PM(13)) { PHASE_CTX(c); MK_QUEUE(2, nB, c.bid, { item_chunkmlp(c, layer, it); if (RP(14)) item_chunkmlp(c, layer, it); }) }
            if (PM(14)) { PHASE_CTX(c); MK_QUEUE(3, nA, c.bid, { item_conformer(c, layer, it); if (RP(15)) item_conformer(c, layer, it); }) }
            if (PM(11)) { PHASE_CTX(c); D1Pre pre; pre.hd = -1; MK_QUEUE(0, nD, c.bid, item_rwkv_local(c, layer, it, pre, -1)) }
#undef MK_QUEUE
            }
        }
        SEAM(base + 1);
        if (PM(4) && IN(base + 2)) { PHASE_CTX(c); if (RP(12)) { ph_scan(c, 1, args.ph_hi > 1000, false); xcd_barrier(bar); } ph_scan(c, RP(2) ? 2 : 1); }
        SEAM(base + 2);
        if (PM(5) && IN(base + 3)) {
            const int nc = nrows / 64;
            for (int rep = 0; rep < (RP(3) ? 2 : 1); ++rep) {
            if (rep) xcd_barrier(bar);
            if (PM(15)) { PHASE_CTX(c); load_g2t(c, layer); for (int it = c.bid; it < nc; it += c.G) item_rwkv_out(c, layer, it); }
            __syncthreads();
            if (PM(16)) { PHASE_CTX(c); for (int it = (c.bid + 128) % c.G; it < nc; it += c.G) item_mamba_out(c, layer, it); }
            __syncthreads();
            }
        }
        SEAM(base + 3);
        if (PM(6) && IN(base + 4)) {
            pg8::Gemm g{(const bf16_t*)(C.ws + WS_ACT), (const bf16_t*)(C.ws + WS_WOUT) + (size_t)layer * DM * DM, NLAT, DM, DM};
            pg8::StaticOrder S; S.init(NLAT, DM, C.G, C.bid);
            EpiResid E{(float*)(C.ws + WS_H), (const float*)(C.ws + WS_MOD) + (size_t)layer * 3 * 6144};
            pg8::gemm_phase<EpiResid, pg8::StaticOrder, false>(C.lds, g, S, E, nullptr, MK_TID());
            if (emit) {
                PHASE_CTX(c);
                for (int u = c.bid; u < 256; u += c.G) { const int tr = u >> 4, tc = u & 15;
                    float* Hc = (float*)(c.ws + WS_H) + (size_t)(NLAT + tr * 32) * DM + tc * 64;
                    const float* gate = (const float*)(c.ws + WS_MOD) + ((size_t)layer * 3 + 2) * 6144 + 2 * 1024 + tc * 64;
                    small_gemm_tile<2, 4>(c, (const bf16_t*)(c.ws + WS_ACT) + (size_t)(NLAT + tr * 32) * DM, (const bf16_t*)(c.ws + WS_WOUT) + (size_t)layer * DM * DM + (size_t)(tc * 64) * DM, DM,
                        [=](int r, int cc, const f32x4& acc) {
#pragma unroll
                            for (int j = 0; j < 4; ++j) Hc[(size_t)(r + j) * DM + cc] += gate[cc] * acc[j]; });
                }
            }
        }
        SEAM(base + 4);
        if (PM(7) && IN(base + 5)) { PHASE_CTX(c); for (int rep = 0; rep < (RP(5) ? 2 : 1); ++rep) { if (rep) xcd_barrier(bar); ph_norm(c, layer, c.in[7] + layer * 1024, 3, nrows); } }
        SEAM(base + 5);
        if (PM(8) && IN(base + 6)) {
            pg8::Gemm g{(const bf16_t*)(C.ws + WS_ACT), (const bf16_t*)(C.ws + WS_WQ) + (size_t)layer * 2048 * DM, NLAT, 2048, DM};
            pg8::StaticOrder S; S.init(NLAT, 2048, C.G, C.bid);
            pg8::EpiBf16<0> E{(bf16_t*)(C.ws + WS_Q), 2048, nullptr, 0, 0};
            pg8::gemm_phase<pg8::EpiBf16<0>, pg8::StaticOrder, false>(C.lds, g, S, E, nullptr, MK_TID());
            if (RP(6)) { xcd_barrier(bar); pg8::gemm_phase<pg8::EpiBf16<0>, pg8::StaticOrder, false>(C.lds, g, S, E, nullptr, MK_TID()); }
            if (emit) {
                PHASE_CTX(c);
                for (int u = c.bid; u < 256; u += c.G) { const int tr = u >> 5, tc = u & 31;
                    bf16_t* Qc = (bf16_t*)(c.ws + WS_Q) + (size_t)(NLAT + tr * 64) * 2048 + tc * 64;
                    small_gemm_tile<4, 4>(c, (const bf16_t*)(c.ws + WS_ACT) + (size_t)(NLAT + tr * 64) * DM, (const bf16_t*)(c.ws + WS_WQ) + (size_t)layer * 2048 * DM + (size_t)(tc * 64) * DM, DM,
                        [=](int r, int cc, const f32x4& acc) {
#pragma unroll
                            for (int j = 0; j < 4; ++j) Qc[(size_t)(r + j) * 2048 + cc] = f2bf(acc[j]); });
                }
            }
        }
        SEAM(base + 6);
        if (PM(9) && IN(base + 7)) { PHASE_CTX(c); ph_select(c, layer, nrows); if (RP(7)) { xcd_barrier(bar); ph_select(c, layer, nrows); } }
        SEAM(base + 7);
        if (PM(10) && IN(base + 8)) { PHASE_CTX(c); if (RP(8)) { ph_peer(c, layer, nrows, layer == 1, args.ph_hi > 1000); xcd_barrier(bar); } if (RP(11)) { ph_peer(c, layer, nrows, layer == 1, args.ph_hi > 1000, 1023); xcd_barrier(bar); } ph_peer(c, layer, nrows, layer == 1); }
        SEAM(base + 8);
    }
#undef IN
#undef SEAM
}
}


namespace mk {
struct LaunchEnt { unsigned mask; int ph; };
template <unsigned MASK> static bool prep_kernel() {
    return hipFuncSetAttribute((const void*)hybrid_fwd<MASK>, hipFuncAttributeMaxDynamicSharedMemorySize, LDS_BYTES) == hipSuccess;
}
template <unsigned MASK> static void launch_kernel(int grid, hipStream_t stream, const Args& a) {
    hipLaunchKernelGGL(hybrid_fwd<MASK>, dim3(grid), dim3(512), LDS_BYTES, stream, a);
}
}

#define CENSUS(off, n, kind, stage, lim) do {} while (0)
#ifndef MK_ONE_LAUNCH
#define MK_ONE_LAUNCH 1
#endif
extern "C" void kernel_launch(void* const* d_in, const int* in_sizes, int n_in, void* d_out, int out_size, void* d_ws, size_t ws_size, hipStream_t stream) {
    using namespace mk;
    static int grid = 0;
    if (grid == 0) {
        if (n_in != 42 || ws_size < WS_END) { fprintf(stderr, "kernel_launch: need 42 inputs and %zu bytes of workspace (got %d, %zu)\n", (size_t)WS_END, n_in, ws_size); grid = -1; return; }
        int dev = 0, cus = 0;
        if (hipGetDevice(&dev) != hipSuccess || hipDeviceGetAttribute(&cus, hipDeviceAttributeMultiprocessorCount, dev) != hipSuccess) { grid = -1; return; }
        bool ok = true;
#if MK_ONE_LAUNCH
        ok = ok && prep_kernel<0x1FFFFu>();
#else
        ok = ok && prep_kernel<0x0001u>() && prep_kernel<0x0002u>() && prep_kernel<0x0004u>() && prep_kernel<0x0808u>() && prep_kernel<0x1008u>() && prep_kernel<0x2008u>() && prep_kernel<0x4008u>()
                && prep_kernel<0x0010u>() && prep_kernel<0x8020u>() && prep_kernel<0x10020u>() && prep_kernel<0x0040u>() && prep_kernel<0x0080u>() && prep_kernel<0x0100u>() && prep_kernel<0x0200u>() && prep_kernel<0x0400u>();
#endif
        if (!ok) { fprintf(stderr, "kernel_launch: hipFuncSetAttribute failed\n"); grid = -1; return; }
        (void)hipGetLastError();
        grid = cus;
    }
    if (grid < 0) return;
    (void)hipMemsetAsync((char*)d_ws + WS_CTL, 0, 65536, stream);
    Args a{};
    for (int i = 0; i < 42; ++i) a.in[i] = (const float*)d_in[i];
    a.out = (float*)d_out; a.ws = (unsigned char*)d_ws;
#if MK_ONE_LAUNCH
    a.ph_lo = 0; a.ph_hi = NPH; launch_kernel<0x1FFFFu>(grid, stream, a);
#else
    a.ph_lo = 0; a.ph_hi = 1; launch_kernel<0x0001u>(grid, stream, a);
    CENSUS(WS_H, (size_t)NROW * DM, 0, 1, 1e4f); CENSUS(WS_MOD, 2 * 3 * 6144, 0, 1, 1e4f); CENSUS(WS_WIN, 2ull * NP * DM, 1, 1, 1e4f); CENSUS(WS_UB, 2ull * NEXP * DM, 1, 1, 1e4f);
    a.ph_lo = 1; a.ph_hi = 2; launch_kernel<0x0002u>(grid, stream, a);
    CENSUS(WS_ACT, (size_t)NROW * DM, 1, 2, 1e4f);
    for (int layer = 0; layer < 2; ++layer) {
        const int b = 2 + layer * NPH_LAYER;
        const int so = layer ? 100 : 0; (void)so;
        a.ph_lo = b + 0; a.ph_hi = b + 1; launch_kernel<0x0004u>(grid, stream, a);
        if (!layer) CENSUS(WS_P, (size_t)NROW * NP, 1, 3, 1e4f);
        a.ph_lo = b + 1; a.ph_hi = b + 2; launch_kernel<0x0808u>(grid, stream, a);
        if (!layer) { CENSUS(WS_RG, (size_t)NSLOT * 4096, 1, 4, 1e6f); CENSUS(WS_RJ, (size_t)NSLOT * 4096, 0, 5, 1e6f); CENSUS(WS_RY, (size_t)NSLOT * 4096 * 2, 1, 6, 1e6f); CENSUS(WS_BON, (size_t)NROW * 8, 0, 6, 1e6f); }
        launch_kernel<0x1008u>(grid, stream, a);
        if (!layer) { CENSUS(WS_MST, (size_t)NSLOT * 8192, 0, 7, 1e6f); CENSUS(WS_MCD, NSLOT, 0, 7, 1e6f); }
        launch_kernel<0x2008u>(grid, stream, a); launch_kernel<0x4008u>(grid, stream, a);
        a.ph_lo = b + 2; a.ph_hi = b + 3; launch_kernel<0x0010u>(grid, stream, a);
        if (!layer) { CENSUS(WS_MST, (size_t)NSLOT * 8192, 0, 8, 1e6f); CENSUS(WS_RH, (size_t)NSLOT * 4096, 1, 9, 1e6f); }
        a.ph_lo = b + 3; a.ph_hi = b + 4; launch_kernel<0x8020u>(grid, stream, a); launch_kernel<0x10020u>(grid, stream, a);
        if (!layer) CENSUS(WS_ACT, (size_t)NROW * DM, 1, 10, 1e4f);
        a.ph_lo = b + 4; a.ph_hi = b + 5; launch_kernel<0x0040u>(grid, stream, a);
        if (!layer) CENSUS(WS_H, (size_t)NROW * DM, 0, 11, 1e4f);
        a.ph_lo = b + 5; a.ph_hi = b + 6; launch_kernel<0x0080u>(grid, stream, a);
        a.ph_lo = b + 6; a.ph_hi = b + 7; launch_kernel<0x0100u>(grid, stream, a);
        if (!layer) CENSUS(WS_Q, (size_t)NROW * 2048, 1, 12, 1e4f);
        a.ph_lo = b + 7; a.ph_hi = b + 8; launch_kernel<0x0200u>(grid, stream, a);
        if (!layer) { CENSUS(WS_SELI, (size_t)NROW * 128, 2, 13, 0.f); CENSUS(WS_SELG, (size_t)NROW * 128, 0, 13, 2.f); }
        a.ph_lo = b + 8; a.ph_hi = b + 9; launch_kernel<0x0400u>(grid, stream, a);
        if (!layer) { CENSUS(WS_H, (size_t)NROW * DM, 0, 14, 1e4f); CENSUS(WS_ACT, (size_t)NROW * DM, 1, 15, 1e4f); }
    }
#endif
    (void)in_sizes; (void)out_size;
}
```

```cpp
#include <hip/hip_runtime.h>
#include <cstdio>
#include <cstdint>
namespace pg8 {
#define PG8_LAS __attribute__((address_space(3)))
typedef unsigned short bf16_t;
typedef short bf16x8 __attribute__((ext_vector_type(8)));
typedef float f32x4 __attribute__((ext_vector_type(4)));
typedef unsigned u32x4 __attribute__((ext_vector_type(4)));
constexpr int BM = 256, BK = 64, HALF = 128, HTB = HALF * BK * 2  , STAGE_BYTES = 8 * HTB, NXCD = 8, WGM = 8;

__host__ __device__ __forceinline__ int lds_byte(int r, int c) { const int st = (r >> 4) * 2 + (c >> 5), rr = r & 15, cc = c & 31, ob = rr * 64 + cc * 2; return st * 1024 + (ob ^ (((ob >> 9) & 1) << 5)); }
__host__ __device__ __forceinline__ void stage_rc(int b, int& R, int& C) { const int st = b / 1024, sb = b % 1024, swz = sb ^ (((sb >> 9) & 1) << 5); R = (st >> 1) * 16 + swz / 64; C = (st & 1) * 32 + (swz % 64) / 2; }
__host__ __device__ __forceinline__ int perm32(int rho) { const int n = rho >> 4, i = rho & 15; return 8 * (i >> 2) + 4 * n + (i & 3); }

struct Unit { int pm, pn; };
struct Gemm { const bf16_t* A; const bf16_t* Bt; int M, N, K; };

struct StaticOrder {
    int nM, nN, nwg, G, c;
    __host__ __device__ void init(int M, int N, int G_, int c_) { nM = M / BM; nN = N / BM; nwg = nM * nN; G = G_; c = c_; }
    __host__ __device__ bool next(int i, Unit& u) const {
        const long L = (long)i * G + c; if (L >= nwg) return false;
        int wgid = (int)L; { const int q = nwg / NXCD, r = nwg % NXCD, xcd = wgid % NXCD, off = wgid / NXCD; wgid = (xcd < r ? xcd * (q + 1) : r * (q + 1) + (xcd - r) * q) + off; }
        const int nig = WGM * nN, gid = wgid / nig, fm = gid * WGM, gsz = (nM - fm) < WGM ? (nM - fm) : WGM;
        u.pm = fm + ((wgid % nig) % gsz); u.pn = (wgid % nig) / gsz; return true;
    }
    __device__ __forceinline__ void a_ready(const Unit&) const {}
    __device__ __forceinline__ void done(const Unit&) const {}
};
struct CountedOrder : StaticOrder {
    const unsigned* ready; unsigned need; unsigned* tmo;
    __device__ __forceinline__ void a_ready(const Unit& u) const {
        if (threadIdx.x < 64) {
            const unsigned long long t0 = __builtin_amdgcn_s_memrealtime(); unsigned polls = 0;
            while ((unsigned)__builtin_amdgcn_readfirstlane(__hip_atomic_load(ready + 64 * u.pm, __ATOMIC_RELAXED, __HIP_MEMORY_SCOPE_AGENT)) < need) {
                if ((++polls & 255u) == 0u && __builtin_amdgcn_readfirstlane(__hip_atomic_load(tmo, __ATOMIC_RELAXED, __HIP_MEMORY_SCOPE_AGENT)) != 0u) break;
                if (__builtin_amdgcn_s_memrealtime() - t0 > 2000000ull) {
                    if (threadIdx.x == 0) { unsigned expect = 0u; __hip_atomic_compare_exchange_strong(tmo + 1, &expect, 0x600u | (unsigned)(u.pm & 0xff), __ATOMIC_RELAXED, __ATOMIC_RELAXED, __HIP_MEMORY_SCOPE_AGENT); __hip_atomic_store(tmo, 1u, __ATOMIC_RELAXED, __HIP_MEMORY_SCOPE_AGENT); }
                    break; }
                __builtin_amdgcn_s_sleep(2); }
            __builtin_amdgcn_fence(__ATOMIC_ACQUIRE, "agent");
            asm volatile("s_waitcnt vmcnt(0)" ::: "memory");
        }
#if !defined(BROKEN_HOOK_NO_BARRIER)
        asm volatile("" ::: "memory"); __builtin_amdgcn_s_barrier(); asm volatile("" ::: "memory");
#endif
    }
};

__device__ __forceinline__ unsigned cvt_pk_bf16(float lo, float hi) { unsigned r; asm volatile("v_cvt_pk_bf16_f32 %0, %1, %2" : "=v"(r) : "v"(lo), "v"(hi)); return r; }
typedef float f32x2 __attribute__((ext_vector_type(2)));
__device__ __forceinline__ f32x2 gelu_pk(f32x2 v) {
    const f32x2 av = __builtin_elementwise_abs(v), d = av * 0.2316418882f + 1.0f;
    f32x2 t; t.x = __builtin_amdgcn_rcpf(d.x); t.y = __builtin_amdgcn_rcpf(d.y);
    f32x2 q = t * 0.5307027145f + (-0.7265760135f); q = q * t + 0.7107068705f; q = q * t + (-0.142248368f); q = q * t + 0.127414796f; q = q * t;
    const f32x2 s = (v * v) * (-0.72134752044f);
    f32x2 e; e.x = __builtin_amdgcn_exp2f(s.x); e.y = __builtin_amdgcn_exp2f(s.y);
    const f32x2 m = v * (q * e), r = v - m;
    f32x2 o; o.x = v.x < 0.f ? m.x : r.x; o.y = v.y < 0.f ? m.y : r.y; return o;
}

struct EpiF32 {
    static constexpr bool PERM = false, AFTER_DRAIN = false;
    float* C; int ldc; const float* bias;
    __device__ __forceinline__ void operator()(const f32x4 (&acc)[2][2][4][2], const Unit& u, int wr, int wc, int fr, int fq) const {
        const int row0 = u.pm * BM + wr * 64 + fr, col0 = u.pn * BM + wc * 32 + 4 * fq;
        f32x4 bv[2][2];
#pragma unroll
        for (int bj = 0; bj < 2; ++bj)
#pragma unroll
            for (int n = 0; n < 2; ++n) bv[bj][n] = bias ? *(const f32x4*)(bias + col0 + bj * HALF + n * 16) : (f32x4){0.f, 0.f, 0.f, 0.f};
#pragma unroll
        for (int ai = 0; ai < 2; ++ai)
#pragma unroll
            for (int m = 0; m < 4; ++m) { float* rowp = C + (size_t)(row0 + ai * HALF + m * 16) * ldc + col0;
#pragma unroll
                for (int bj = 0; bj < 2; ++bj)
#pragma unroll
                    for (int n = 0; n < 2; ++n) *(f32x4*)(rowp + bj * HALF + n * 16) = acc[ai][bj][m][n] + bv[bj][n]; }
    }
};
template <int ACT  > struct EpiBf16 {
    static constexpr bool PERM = true, AFTER_DRAIN = false;
    bf16_t* O; int ldc; const float* bias; int split_cols; size_t split_stride;
    __device__ __forceinline__ void operator()(const f32x4 (&acc)[2][2][4][2], const Unit& u, int wr, int wc, int fr, int fq) const {
        const int row0 = u.pm * BM + wr * 64 + fr; int colt = u.pn * BM; bf16_t* base = O;
        if (split_cols) { const int t = colt / split_cols; base += (size_t)t * split_stride; colt -= t * split_cols; }
        const int col0 = colt + wc * 32 + 8 * fq, bcol0 = u.pn * BM + wc * 32 + 8 * fq;
        f32x4 bv[2][2];
#pragma unroll
        for (int bj = 0; bj < 2; ++bj)
#pragma unroll
            for (int n = 0; n < 2; ++n) bv[bj][n] = bias ? *(const f32x4*)(bias + bcol0 + bj * HALF + 4 * n) : (f32x4){0.f, 0.f, 0.f, 0.f};
#pragma unroll
        for (int ai = 0; ai < 2; ++ai)
#pragma unroll
            for (int m = 0; m < 4; ++m) { bf16_t* rowp = base + (size_t)(row0 + ai * HALF + m * 16) * ldc + col0;
#pragma unroll
                for (int bj = 0; bj < 2; ++bj) { f32x4 v0 = acc[ai][bj][m][0] + bv[bj][0], v1 = acc[ai][bj][m][1] + bv[bj][1];
                    if (ACT == 1) { f32x2 a = gelu_pk((f32x2){v0[0], v0[1]}), b = gelu_pk((f32x2){v0[2], v0[3]}), c = gelu_pk((f32x2){v1[0], v1[1]}), d = gelu_pk((f32x2){v1[2], v1[3]});
                        v0 = (f32x4){a.x, a.y, b.x, b.y}; v1 = (f32x4){c.x, c.y, d.x, d.y}; }
                    if (ACT == 2) {
#pragma unroll
                        for (int j = 0; j < 4; ++j) { v0[j] = 0.5f * v0[j] * (1.0f + erff(v0[j] * 0.70710678f)); v1[j] = 0.5f * v1[j] * (1.0f + erff(v1[j] * 0.70710678f)); } }
                    u32x4 w; w.x = cvt_pk_bf16(v0[0], v0[1]); w.y = cvt_pk_bf16(v0[2], v0[3]); w.z = cvt_pk_bf16(v1[0], v1[1]); w.w = cvt_pk_bf16(v1[2], v1[3]);
                    *(u32x4*)(rowp + bj * HALF) = w; } }
    }
};
template <class Epi, class Sched, bool STAMP = false>
__device__ __forceinline__ void gemm_phase(PG8_LAS unsigned char* lds, const Gemm g, const Sched& S, const Epi& E, unsigned long long* stamps, int tid_in) {
    int tid_ = tid_in; asm volatile("" : "+v"(tid_));
    const int tid = tid_, wid = __builtin_amdgcn_readfirstlane(tid >> 6), lane = tid & 63, wr = wid >> 2, wc = wid & 3, fr = lane & 15, fq = lane >> 4;
    const int K = g.K, nt = K / BK;
    int ts_lo = 0, ts_hi = 0, nts = 0; const unsigned long long rt_entry = STAMP ? (unsigned long long)wall_clock64() : 0ull;
#define PG8_STAMP() do { if (STAMP && wid == 0 && nts < 64) { const unsigned long long _c = (unsigned long long)clock64(); \
        ts_lo = (lane == nts) ? (int)(unsigned)_c : ts_lo; ts_hi = (lane == nts) ? (int)(unsigned)(_c >> 32) : ts_hi; ++nts; } } while (0)
    PG8_STAMP();
    unsigned voffA[2], voffB[2];
#pragma unroll
    for (int i = 0; i < 2; ++i) { int R, C; stage_rc(tid * 16 + i * 8192, R, C); const int Rb = Epi::PERM ? ((R & ~31) + perm32(R & 31)) : R;
        voffA[i] = (unsigned)(R * K + C) * 2u; voffB[i] = (unsigned)(Rb * K + C) * 2u; }
    const size_t kstep = (size_t)(BK * 2);
    const size_t hstep = (size_t)HALF * K * 2;
    const size_t tstep = 2 * hstep;
    const unsigned ldsw = (unsigned)wid * 1024u;
    const int aoff = lds_byte(wr * 64 + fr, fq * 8), boff = lds_byte(wc * 32 + fr, fq * 8);
#define PG8_SA(b, h) (((b) * 2 + (h)) * HTB)
#define PG8_SB(b, h) ((4 + (b) * 2 + (h)) * HTB)
#define PG8_STAGE(bufoff, gbase, voff) do { _Pragma("unroll") for (int _i = 0; _i < 2; ++_i) \
        __builtin_amdgcn_global_load_lds((const unsigned*)((const char*)(gbase) + (voff)[_i]), (PG8_LAS unsigned*)(lds + (bufoff) + ldsw + _i * 8192), 16, 0, 0); } while (0)
#define PG8_LDA(dst, b, h) do { _Pragma("unroll") for (int m = 0; m < 4; ++m) _Pragma("unroll") for (int k = 0; k < 2; ++k) dst[m][k] = *(const PG8_LAS bf16x8*)(lds + PG8_SA(b, h) + aoff + m * 2048 + k * 1024); } while (0)
#define PG8_LDB(dst, b, h) do { _Pragma("unroll") for (int n = 0; n < 2; ++n) _Pragma("unroll") for (int k = 0; k < 2; ++k) dst[n][k] = *(const PG8_LAS bf16x8*)(lds + PG8_SB(b, h) + boff + n * 2048 + k * 1024); } while (0)
#define PG8_MMA(ai, bj, At, Bt) do { __builtin_amdgcn_s_setprio(1); _Pragma("unroll") for (int m = 0; m < 4; ++m) _Pragma("unroll") for (int n = 0; n < 2; ++n) _Pragma("unroll") for (int k = 0; k < 2; ++k) \
        acc[ai][bj][m][n] = __builtin_amdgcn_mfma_f32_16x16x32_bf16(Bt[n][k], At[m][k], acc[ai][bj][m][n], 0, 0, 0); __builtin_amdgcn_s_setprio(0); } while (0)
#define PG8_WAIT_V(n) asm volatile("s_waitcnt vmcnt(" #n ")" ::: "memory")
#define PG8_WAIT_L(n) asm volatile("s_waitcnt lgkmcnt(" #n ")" ::: "memory")
#define PG8_BAR __builtin_amdgcn_s_barrier()
#define PG8_SCHED __builtin_amdgcn_sched_barrier(0)
    Unit cur, nxt; int ui = 0;
    if (!S.next(0, cur)) return;
    f32x4 acc[2][2][4][2];
#pragma unroll
    for (int a = 0; a < 2; ++a)
#pragma unroll
        for (int b = 0; b < 2; ++b)
#pragma unroll
            for (int m = 0; m < 4; ++m)
#pragma unroll
                for (int n = 0; n < 2; ++n) acc[a][b][m][n] = (f32x4){0.f, 0.f, 0.f, 0.f};
    bf16x8 At[4][2], B0[2][2], B1[2][2];
    const char* cA = (const char*)g.A + (size_t)cur.pm * tstep; const char* cB = (const char*)g.Bt + (size_t)cur.pn * tstep;
    S.a_ready(cur);
    PG8_STAGE(PG8_SB(0, 0), cB, voffB); PG8_STAGE(PG8_SA(0, 0), cA, voffA); PG8_STAGE(PG8_SB(0, 1), cB + hstep, voffB); PG8_STAGE(PG8_SA(0, 1), cA + hstep, voffA);
    if (wr == 1) PG8_BAR;
    PG8_WAIT_V(4); PG8_BAR;
    PG8_STAGE(PG8_SB(1, 0), cB + kstep, voffB); PG8_STAGE(PG8_SA(1, 0), cA + kstep, voffA); PG8_STAGE(PG8_SB(1, 1), cB + hstep + kstep, voffB);
    PG8_WAIT_V(6); PG8_BAR;
    PG8_STAMP();
    for (;;) {
        const bool has_next = S.next(ui + 1, nxt);
        const char* nA = has_next ? (const char*)g.A + (size_t)nxt.pm * tstep : cA; const char* nB = has_next ? (const char*)g.Bt + (size_t)nxt.pn * tstep : cB;
        for (int t = 0; t < nt; t += 2) {
            const bool last = (t == nt - 2);
            const char* a1 = cA + (size_t)(t + 1) * kstep;
            const char* a2 = last ? nA : cA + (size_t)(t + 2) * kstep; const char* b2 = last ? nB : cB + (size_t)(t + 2) * kstep;
            const char* a3 = a2 + kstep; const char* b3 = b2 + kstep;
            if (last && has_next) S.a_ready(nxt);
            PG8_LDB(B0, 0, 0); PG8_SCHED; PG8_LDA(At, 0, 0); PG8_STAGE(PG8_SA(1, 1), a1 + hstep, voffA);
            PG8_WAIT_L(8); PG8_BAR; PG8_WAIT_L(0); PG8_MMA(0, 0, At, B0); PG8_BAR; PG8_SCHED;
            PG8_LDB(B1, 0, 1); PG8_STAGE(PG8_SB(0, 0), b2, voffB);
            PG8_BAR; PG8_WAIT_L(0); PG8_MMA(0, 1, At, B1); PG8_BAR;
            PG8_LDA(At, 0, 1); PG8_STAGE(PG8_SA(0, 0), a2, voffA);
            PG8_BAR; PG8_WAIT_L(0); PG8_MMA(1, 0, At, B0); PG8_BAR; PG8_SCHED;
            PG8_STAGE(PG8_SB(0, 1), b2 + hstep, voffB);
            PG8_WAIT_V(6); PG8_BAR; PG8_MMA(1, 1, At, B1); PG8_BAR;
            PG8_LDB(B0, 1, 0); PG8_SCHED; PG8_LDA(At, 1, 0); PG8_STAGE(PG8_SA(0, 1), a2 + hstep, voffA);
            PG8_WAIT_L(8); PG8_BAR; PG8_WAIT_L(0); PG8_MMA(0, 0, At, B0); PG8_BAR; PG8_SCHED;
            PG8_LDB(B1, 1, 1); PG8_STAGE(PG8_SB(1, 0), b3, voffB);
            PG8_BAR; PG8_WAIT_L(0); PG8_MMA(0, 1, At, B1); PG8_BAR;
            PG8_LDA(At, 1, 1); PG8_STAGE(PG8_SA(1, 0), a3, voffA);
            PG8_BAR; PG8_WAIT_L(0); PG8_MMA(1, 0, At, B0); PG8_BAR; PG8_SCHED;
            PG8_STAGE(PG8_SB(1, 1), b3 + hstep, voffB);
            PG8_WAIT_V(6); PG8_BAR; PG8_MMA(1, 1, At, B1); PG8_BAR;
        }
        PG8_STAMP();
        if constexpr (!Epi::AFTER_DRAIN) { E(acc, cur, wr, wc, fr, fq); S.done(cur); }
        PG8_STAMP();
        if (!has_next) break;
#pragma unroll
        for (int a = 0; a < 2; ++a)
#pragma unroll
            for (int b = 0; b < 2; ++b)
#pragma unroll
                for (int m = 0; m < 4; ++m)
#pragma unroll
                    for (int n = 0; n < 2; ++n) acc[a][b][m][n] = (f32x4){0.f, 0.f, 0.f, 0.f};
        cur = nxt; cA = nA; cB = nB; ++ui;
    }
    PG8_WAIT_V(0);
    if (wr == 0) PG8_BAR;
    PG8_BAR;
    if constexpr (Epi::AFTER_DRAIN) { E.fused(acc, cur, wr, wc, fr, fq, lds, wid, lane); S.done(cur); }
    PG8_STAMP();
    if (STAMP && wid == 0) { stamps[lane] = lane < nts ? (((unsigned long long)(unsigned)ts_hi << 32) | (unsigned)ts_lo) : 0ull;
        if (lane == 62) stamps[62] = rt_entry; if (lane == 63) stamps[63] = (unsigned long long)wall_clock64(); }
#undef PG8_STAMP
#undef PG8_SA
#undef PG8_SB
#undef PG8_STAGE
#undef PG8_LDA
#undef PG8_LDB
#undef PG8_MMA
#undef PG8_WAIT_V
#undef PG8_WAIT_L
#undef PG8_BAR
#undef PG8_SCHED
}
}
#define XB_TMO      128
#define XB_XCNT(j)  (256  + 64 * (j))
#define XB_XSUB(j)  (1280 + 64 * (j))
#define XB_XGEN(j)  (2304 + 64 * (j))
#define XB_TOP      3328
#define XB_TOPGEN   3392
#define XCD_BAR_WORDS 3456
#define XB_SPIN_CAP (1u << 18)
#define LAS __attribute__((address_space(3)))

__device__ __forceinline__ unsigned xb_ld(unsigned* p)              { return __hip_atomic_load(p, __ATOMIC_RELAXED, __HIP_MEMORY_SCOPE_AGENT); }
__device__ __forceinline__ unsigned xb_add(unsigned* p, unsigned v) { return __hip_atomic_fetch_add(p, v, __ATOMIC_RELAXED, __HIP_MEMORY_SCOPE_AGENT); }
__device__ __forceinline__ unsigned xb_xcc_id() { return (unsigned)__builtin_amdgcn_s_getreg((3 << 11) | 20) & 0xFu; }
#define XB_SPIN(cond, bar) do { unsigned _sp = 0; while (cond) { __builtin_amdgcn_s_sleep(1); \
    if ((++_sp & 255u) == 0u) { if (xb_ld(&(bar)[XB_TMO])) break; if (_sp > XB_SPIN_CAP) { atomicAdd(&(bar)[XB_TMO], 1u); break; } } } } while (0)

#define XB_LANE0() (__builtin_amdgcn_mbcnt_hi(~0u, __builtin_amdgcn_mbcnt_lo(~0u, 0u)) == 0u)
struct XcdBarrier {
    unsigned w0;
    unsigned* bar; unsigned x;
    volatile LAS unsigned* st;
};

__device__ __forceinline__ XcdBarrier xcd_barrier_post(unsigned* bar, volatile LAS unsigned* st, unsigned w0) {
    XcdBarrier b; b.w0 = w0; b.bar = bar; b.x = xb_xcc_id(); b.st = st;
    if (w0 == 0u && XB_LANE0()) (void)xb_add(&bar[XB_XCNT(b.x)], 1u);
    return b;
}
__device__ __forceinline__ void xcd_barrier_complete(unsigned* bar, unsigned x, unsigned& nloc, unsigned& nx) {
    const unsigned G = gridDim.x * gridDim.y * gridDim.z;
    unsigned sum, cnt, mine, sp = 0u;
    for (;;) {
        sum = 0u; cnt = 0u; mine = 0u;
#pragma unroll
        for (unsigned j = 0; j < 16; ++j) { const unsigned c = xb_ld(&bar[XB_XCNT(j)]); sum += c; cnt += (c > 0u) ? 1u : 0u; mine = (j == x) ? c : mine; }
        if (sum == G) break;
        __builtin_amdgcn_s_sleep(1);
        if ((++sp & 255u) == 0u) { if (xb_ld(&bar[XB_TMO])) break; if (sp > XB_SPIN_CAP) { atomicAdd(&bar[XB_TMO], 1u); break; } }
    }
    nloc = mine > 0u ? mine : 1u; nx = cnt > 0u ? cnt : 1u;
}

__device__ __forceinline__ void xcd_barrier(const XcdBarrier& b) {
    asm volatile("s_waitcnt vmcnt(0)" ::: "memory");
    __syncthreads();
    if (b.w0 == 0u && XB_LANE0()) {
        unsigned* bar = b.bar;
        __builtin_amdgcn_s_waitcnt(0);
        unsigned nloc = b.st[0], nx = b.st[1];
        if (nloc == 0u) { xcd_barrier_complete(bar, b.x, nloc, nx); b.st[0] = nloc; b.st[1] = nx; }
        const unsigned old = xb_add(&bar[XB_XSUB(b.x)], 1u);
        const unsigned gen = old / nloc;
        if (old + 1u == (gen + 1u) * nloc) {
            __builtin_amdgcn_fence(__ATOMIC_RELEASE, "agent");
            asm volatile("s_waitcnt vmcnt(0)" ::: "memory");
            const unsigned og = xb_add(&bar[XB_TOP], 1u);
            const unsigned tg = og / nx;
            if (og + 1u == (tg + 1u) * nx) xb_add(&bar[XB_TOPGEN], 1u);
            else XB_SPIN(xb_ld(&bar[XB_TOPGEN]) == tg, bar);
            __builtin_amdgcn_fence(__ATOMIC_ACQUIRE, "agent");
            xb_add(&bar[XB_XGEN(b.x)], 1u);
            asm volatile("s_waitcnt vmcnt(0)" ::: "memory");
        } else {
            XB_SPIN(xb_ld(&bar[XB_XGEN(b.x)]) == gen, bar);
            __builtin_amdgcn_fence(__ATOMIC_ACQUIRE, "agent");
            asm volatile("s_waitcnt vmcnt(0)" ::: "memory");
        }
    }
    __syncthreads();
}

namespace mk {
using pg8::bf16_t; using pg8::bf16x8; using pg8::f32x4; using pg8::u32x4;
typedef unsigned u32x2 __attribute__((ext_vector_type(2)));
typedef __bf16 bf16x2_t __attribute__((ext_vector_type(2)));
typedef LAS unsigned char* lds_t;

constexpr int DM = 1024, NLAT = 16384, NROW = 16896;
constexpr int OFF_B = 512, OFF_C = 1024, OFF_D = 2056, INC = 3208, NP = 3328;
constexpr int NCH = 132, NSLOT = 16 * NCH;
constexpr int NEXP = 16384;

constexpr size_t WS_CTL  = 0;
constexpr size_t WS_MOD  = 65536;
constexpr size_t WS_WIN  = WS_MOD + 147456;
constexpr size_t WS_WOUT = WS_WIN + 2ull * NP * DM * 2;
constexpr size_t WS_WQ   = WS_WOUT + 2ull * DM * DM * 2;
constexpr size_t WS_H    = WS_WQ + 2ull * 2048 * DM * 2;
constexpr size_t WS_ACT  = WS_H + (size_t)NROW * DM * 4;
constexpr size_t WS_UB   = WS_ACT + (size_t)NROW * DM * 2;
constexpr size_t WS_VB   = WS_UB + (size_t)NEXP * DM * 2;
constexpr size_t WS_SU   = WS_UB + (size_t)NEXP * DM;
constexpr size_t WS_SV   = WS_VB + (size_t)NEXP * DM;
constexpr size_t WS_P    = WS_VB + (size_t)NEXP * DM * 2;
constexpr size_t WS_Q    = WS_P;
constexpr size_t WS_SELI = WS_Q + (size_t)NROW * 2048 * 2;
constexpr size_t WS_SELG = WS_SELI + (size_t)NROW * 128 * 4;
constexpr size_t WS_MST  = WS_P + (size_t)NROW * NP * 2;
constexpr size_t WS_MCD  = WS_MST + (size_t)NSLOT * 8192 * 4;
constexpr size_t WS_RG   = WS_MCD + 16384;
constexpr size_t WS_RJ   = WS_RG + (size_t)NSLOT * 8192;
constexpr size_t WS_RY   = WS_RJ + (size_t)NSLOT * 16384;
constexpr size_t WS_RL   = WS_RY + (size_t)NSLOT * 8192;
constexpr size_t WS_RH   = WS_RL + (size_t)NSLOT * 8192;
constexpr size_t WS_BON  = WS_RH + (size_t)NSLOT * 8192;
constexpr size_t WS_END  = WS_BON + (size_t)NROW * 8 * 4;
static_assert(WS_SELG + (size_t)NROW * 128 * 4 <= WS_MST, "Q + selections must fit in P's region");

constexpr int LDS_BYTES = 157440;
constexpr int LDS_XB = 157184;

struct Args { const float* in[42]; float* out; unsigned char* ws; int ph_lo, ph_hi; };

struct Ctx {
    const float* const* in; float* out; unsigned char* ws; lds_t lds;
    int tid, lane, wid, bid, G;
};

__device__ __forceinline__ float bf2f(unsigned short x) { return __uint_as_float(((unsigned)x) << 16); }
__device__ __forceinline__ float bflo(unsigned w) { return __uint_as_float(w << 16); }
__device__ __forceinline__ float bfhi(unsigned w) { return __uint_as_float(w & 0xffff0000u); }
typedef __bf16 bf16pair_t __attribute__((ext_vector_type(2)));
__device__ __forceinline__ unsigned pk2(float lo, float hi) { const bf16pair_t v = {(__bf16)lo, (__bf16)hi}; return __builtin_bit_cast(unsigned, v); }
__device__ __forceinline__ unsigned short f2bf(float f) { return (unsigned short)(pk2(f, 0.f) & 0xffffu); }
#define dpp_f(old, src, ctrl, row_mask, bank_mask) __uint_as_float((unsigned)__builtin_amdgcn_update_dpp((int)__float_as_uint(old), (int)__float_as_uint(src), ctrl, row_mask, bank_mask, true))
__device__ __forceinline__ float wave_sum(float v) {
    v += dpp_f(0.f, v, 0xB1, 0xF, 0xF);
    v += dpp_f(0.f, v, 0x4E, 0xF, 0xF);
    v += dpp_f(0.f, v, 0x141, 0xF, 0xF);
    v += dpp_f(0.f, v, 0x140, 0xF, 0xF);
    v += dpp_f(0.f, v, 0x142, 0xA, 0xF);
    v += dpp_f(0.f, v, 0x143, 0xC, 0xF);
    return __uint_as_float((unsigned)__builtin_amdgcn_readlane((int)__float_as_uint(v), 63));
}
__device__ __forceinline__ float wave_incl_scan(float v, int lane) {
    (void)lane;
    float s = v + dpp_f(0.f, v, 0x111, 0xF, 0xF);
    s += dpp_f(0.f, v, 0x112, 0xF, 0xF);
    s += dpp_f(0.f, v, 0x113, 0xF, 0xF);
    s += dpp_f(0.f, s, 0x114, 0xF, 0xE);
    s += dpp_f(0.f, s, 0x118, 0xF, 0xC);
    s += dpp_f(0.f, s, 0x142, 0xA, 0xF);
    s += dpp_f(0.f, s, 0x143, 0xC, 0xF);
    return s;
}
__device__ __forceinline__ float fexp(float x) { return __expf(x); }
__device__ __forceinline__ float frcp(float x) { return __builtin_amdgcn_rcpf(x); }
__device__ __forceinline__ float sigm(float x) { return frcp(1.f + __expf(-x)); }
__device__ __forceinline__ float silu(float x) { return x * frcp(1.f + __expf(-x)); }
__device__ __forceinline__ float softplus(float x) { return fmaxf(x, 0.f) + __logf(1.f + __expf(-fabsf(x))); }
__device__ __forceinline__ float ftanh(float x) { const float e = __expf(-2.f * fabsf(x)); const float t = (1.f - e) * frcp(1.f + e); return x < 0.f ? -t : t; }
__device__ __forceinline__ float gelu_tanh(float x) { const float u = 0.7978845608028654f * (x + 0.044715f * x * x * x); return 0.5f * x * (1.f + ftanh(u)); }
__device__ __forceinline__ float dot2bf(unsigned a, unsigned b, float acc) { return __builtin_amdgcn_fdot2_f32_bf16(__builtin_bit_cast(bf16x2_t, a), __builtin_bit_cast(bf16x2_t, b), acc, false); }

struct ChunkInfo { int row0, lo, hi, b, tc, isctx; };
__device__ __forceinline__ ChunkInfo chunk_info(int gc) {
    ChunkInfo c; c.row0 = gc * 64;
    if (gc < 256) { c.b = gc >> 7; c.tc = gc & 127; c.isctx = 0; c.lo = c.b * 8192; c.hi = c.lo + 8192; }
    else { const int q = gc - 256; c.b = q >> 2; c.tc = q & 3; c.isctx = 1; c.lo = NLAT + c.b * 256; c.hi = c.lo + 256; }
    return c;
}
__device__ __forceinline__ int cpos_of(const ChunkInfo& c, int d) { return c.isctx ? (d ? 3 - c.tc : c.tc) : (d ? 4 + 127 - c.tc : 4 + c.tc); }
__device__ __forceinline__ int slot_of(int b, int h, int d, int cpos) { return ((b * 4 + h) * 2 + d) * NCH + cpos; }

template <int MT, int NT, int KS, class Epi>
__device__ __forceinline__ void blk_mma(const LAS bf16_t* A, int lda, const LAS bf16_t* Bt, int ldb, int wid, int lane, Epi epi) {
    const int fr = lane & 15, fq = lane >> 4;
    for (int tt = wid; tt < MT * NT; tt += 8) {
        const int tm = tt / NT, tn = tt % NT;
        f32x4 acc = {0.f, 0.f, 0.f, 0.f};
#pragma unroll
        for (int ks = 0; ks < KS; ++ks) {
            const bf16x8 a = *(const LAS bf16x8*)(A + (tm * 16 + fr) * lda + ks * 32 + fq * 8);
            const bf16x8 b = *(const LAS bf16x8*)(Bt + (tn * 16 + fr) * ldb + ks * 32 + fq * 8);
            acc = __builtin_amdgcn_mfma_f32_16x16x32_bf16(a, b, acc, 0, 0, 0);
        }
        epi(tm * 16 + fq * 4, tn * 16 + fr, acc);
    }
}
template <int MT, int NT, int KS, class Epi>
__device__ __forceinline__ void blk_mma2(const LAS bf16_t* A1, const LAS bf16_t* B1, const LAS bf16_t* A2, const LAS bf16_t* B2, int ld, int wid, int lane, Epi epi) {
    const int fr = lane & 15, fq = lane >> 4;
    for (int tt = wid; tt < MT * NT; tt += 8) {
        const int tm = tt / NT, tn = tt % NT;
        f32x4 acc1 = {0.f, 0.f, 0.f, 0.f}, acc2 = {0.f, 0.f, 0.f, 0.f};
#pragma unroll
        for (int ks = 0; ks < KS; ++ks) {
            const bf16x8 a1 = *(const LAS bf16x8*)(A1 + (tm * 16 + fr) * ld + ks * 32 + fq * 8);
            const bf16x8 b1 = *(const LAS bf16x8*)(B1 + (tn * 16 + fr) * ld + ks * 32 + fq * 8);
            acc1 = __builtin_amdgcn_mfma_f32_16x16x32_bf16(a1, b1, acc1, 0, 0, 0);
            const bf16x8 a2 = *(const LAS bf16x8*)(A2 + (tm * 16 + fr) * ld + ks * 32 + fq * 8);
            const bf16x8 b2 = *(const LAS bf16x8*)(B2 + (tn * 16 + fr) * ld + ks * 32 + fq * 8);
            acc2 = __builtin_amdgcn_mfma_f32_16x16x32_bf16(a2, b2, acc2, 0, 0, 0);
        }
        epi(tm * 16 + fq * 4, tn * 16 + fr, acc1, acc2);
    }
}


template <int MT, int NT, class Epi>
__device__ __forceinline__ void small_gemm_tile(const Ctx& C, const bf16_t* A, const bf16_t* Bt, int K, Epi epi) {
    constexpr int AR = MT * 16, BR = NT * 16, PITCH = 264, NA = AR * 32 / 512, NB = BR * 32 / 512;
    LAS bf16_t* As = (LAS bf16_t*)C.lds; LAS bf16_t* Bs = As + AR * PITCH;
    u32x4 ra[NA], rb[NB];
    auto fetch = [&](int k0) {
#pragma unroll
        for (int i = 0; i < NA; ++i) { const int e = C.tid + 512 * i; ra[i] = *(const u32x4*)(A + (size_t)(e >> 5) * K + k0 + (e & 31) * 8); }
#pragma unroll
        for (int i = 0; i < NB; ++i) { const int e = C.tid + 512 * i; rb[i] = *(const u32x4*)(Bt + (size_t)(e >> 5) * K + k0 + (e & 31) * 8); } };
    const int fr = C.lane & 15, fq = C.lane >> 4;
    constexpr int TPW = (MT * NT + 7) / 8;
    f32x4 acc[TPW];
#pragma unroll
    for (int i = 0; i < TPW; ++i) acc[i] = (f32x4){0.f, 0.f, 0.f, 0.f};
    fetch(0);
    for (int k0 = 0; k0 < K; k0 += 256) {
        __syncthreads();
#pragma unroll
        for (int i = 0; i < NA; ++i) { const int e = C.tid + 512 * i; *(LAS u32x4*)(As + (e >> 5) * PITCH + (e & 31) * 8) = ra[i]; }
#pragma unroll
        for (int i = 0; i < NB; ++i) { const int e = C.tid + 512 * i; *(LAS u32x4*)(Bs + (e >> 5) * PITCH + (e & 31) * 8) = rb[i]; }
        if (k0 + 256 < K) fetch(k0 + 256);
        __syncthreads();
#pragma unroll
        for (int i = 0; i < TPW; ++i) { const int tt = C.wid + 8 * i; if (tt < MT * NT) { const int tm = tt / NT, tn = tt % NT;
#pragma unroll
            for (int ks = 0; ks < 8; ++ks) acc[i] = __builtin_amdgcn_mfma_f32_16x16x32_bf16(*(const LAS bf16x8*)(As + (tm * 16 + fr) * PITCH + ks * 32 + fq * 8),
                                                                                           *(const LAS bf16x8*)(Bs + (tn * 16 + fr) * PITCH + ks * 32 + fq * 8), acc[i], 0, 0, 0); } }
    }
#pragma unroll
    for (int i = 0; i < TPW; ++i) { const int tt = C.wid + 8 * i; if (tt < MT * NT) epi((tt / NT) * 16 + fq * 4, (tt % NT) * 16 + fr, acc[i]); }
    __syncthreads();
}

__device__ __forceinline__ void transpose_item(const float* W, int K, int N, int nblk, bf16_t* WT, LAS float* scr, int item, int lane) {
    const int kb = item / nblk, nb = item % nblk, k0 = 64 * kb, n0 = 32 * nb;
    const int nn = n0 + (lane & 31);
#pragma unroll 8
    for (int i = 0; i < 32; ++i) { const int kk = 2 * i + (lane >> 5); scr[kk * 33 + (lane & 31)] = (nn < N) ? W[(size_t)(k0 + kk) * N + nn] : 0.f; }
    asm volatile("s_waitcnt lgkmcnt(0)" ::: "memory");
    const int c = lane & 7;
#pragma unroll
    for (int j = 0; j < 4; ++j) { const int n = (lane >> 3) + 8 * j; const LAS float* s = scr + (8 * c) * 33 + n;
        u32x4 o; o.x = pk2(s[0 * 33], s[1 * 33]); o.y = pk2(s[2 * 33], s[3 * 33]); o.z = pk2(s[4 * 33], s[5 * 33]); o.w = pk2(s[6 * 33], s[7 * 33]);
        *(u32x4*)(WT + (size_t)(n0 + n) * K + k0 + 8 * c) = o; }
    asm volatile("s_waitcnt lgkmcnt(0)" ::: "memory");
}
__device__ __forceinline__ float wave_maxf(float v) {
#pragma unroll
    for (int o = 1; o < 64; o <<= 1) v = fmaxf(v, __shfl_xor(v, o));
    return v;
}
__device__ __forceinline__ void convert_tables(const Ctx& C, int layer, int rank, int nrank) {
    const float* U = C.in[39] + (size_t)layer * NEXP * DM; const float* V = C.in[40] + (size_t)layer * NEXP * DM;
    unsigned char* UB = C.ws + WS_UB; unsigned char* VB = C.ws + WS_VB; float* SU = (float*)(C.ws + WS_SU); float* SV = (float*)(C.ws + WS_SV);
    for (int r4 = (rank * 8 + C.wid) * 2; r4 < 2 * NEXP; r4 += nrank * 8 * 2) {
        const bool isv = r4 >= NEXP; const int row0 = isv ? r4 - NEXP : r4;
        const float* src = (isv ? V : U) + (size_t)row0 * DM + 16 * C.lane;
        f32x4 x[2][4];
#pragma unroll
        for (int q = 0; q < 2; ++q)
#pragma unroll
            for (int k = 0; k < 4; ++k) x[q][k] = *(const f32x4*)(src + (size_t)q * DM + 4 * k);
#pragma unroll
        for (int q = 0; q < 2; ++q) {
            float m = 0.f;
#pragma unroll
            for (int k = 0; k < 4; ++k) m = fmaxf(fmaxf(m, fmaxf(fabsf(x[q][k].x), fabsf(x[q][k].y))), fmaxf(fabsf(x[q][k].z), fabsf(x[q][k].w)));
            m = wave_maxf(m);
            const float sc = m > 0.f ? 224.f / m : 1.f;
            u32x4 o;
#pragma unroll
            for (int k = 0; k < 4; ++k) { int w = __builtin_amdgcn_cvt_pk_fp8_f32(x[q][k].x * sc, x[q][k].y * sc, 0, false); w = __builtin_amdgcn_cvt_pk_fp8_f32(x[q][k].z * sc, x[q][k].w * sc, w, true); o[k] = (unsigned)w; }
            *(u32x4*)((isv ? VB : UB) + (size_t)(row0 + q) * DM + 16 * C.lane) = o;
            if (C.lane == 0) (isv ? SV : SU)[row0 + q] = m > 0.f ? m * (1.f / 224.f) : 1.f;
        }
    }
}
__device__ __forceinline__ void ph_prologue(const Ctx& C) {
    const int gw = C.bid * 8 + C.wid, NGW = C.G * 8;
    {
        LAS float* scr = (LAS float*)(C.lds + C.wid * 16384);
        bf16_t* WIN = (bf16_t*)(C.ws + WS_WIN); bf16_t* WOUT = (bf16_t*)(C.ws + WS_WOUT); bf16_t* WQ = (bf16_t*)(C.ws + WS_WQ);
        for (int it = gw; it < 6400; it += NGW) {
            const int layer = it / 3200; int r = it % 3200;
            if (r < 1664) { transpose_item(C.in[8] + (size_t)layer * DM * INC, DM, INC, 104, WIN + (size_t)layer * NP * DM, scr, r, C.lane); continue; } r -= 1664;
            if (r < 512) { transpose_item(C.in[9] + (size_t)layer * DM * DM, DM, DM, 32, WOUT + (size_t)layer * DM * DM, scr, r, C.lane); continue; } r -= 512;
            transpose_item(C.in[36] + (size_t)layer * DM * 2048, DM, 2048, 64, WQ + (size_t)layer * 2048 * DM, scr, r, C.lane);
        }
    }
    __syncthreads();
    {
        LAS float* sv = (LAS float*)C.lds;
        LAS float* red = (LAS float*)(C.lds + 12288);
        for (int i = C.tid; i < 3 * 1024; i += 512) { const int w = i >> 10, k = i & 1023; const float x = (w < 2) ? C.in[1][w * 1024 + k] : C.in[3][k]; sv[i] = silu(x); }
        __syncthreads();
        float* MOD = (float*)(C.ws + WS_MOD);
        for (int it = C.bid; it < 192; it += C.G) {
            const int layer = it / 96, col0 = (it % 96) * 64, col = C.tid & 63, kg = C.tid >> 6;
            const float* W = C.in[4] + (size_t)layer * DM * 6144 + col0 + col;
            float a0 = 0.f, a1 = 0.f, a2 = 0.f;
#pragma unroll 32
            for (int k = kg * 128; k < kg * 128 + 128; ++k) { const float w = W[(size_t)k * 6144]; a0 += sv[k] * w; a1 += sv[1024 + k] * w; a2 += sv[2048 + k] * w; }
            red[(kg * 3 + 0) * 64 + col] = a0; red[(kg * 3 + 1) * 64 + col] = a1; red[(kg * 3 + 2) * 64 + col] = a2;
            __syncthreads();
            if (C.tid < 192) { const int w = C.tid >> 6, c2 = C.tid & 63; float s = 0.f;
#pragma unroll
                for (int g = 0; g < 8; ++g) s += red[(g * 3 + w) * 64 + c2];
                MOD[((size_t)layer * 3 + w) * 6144 + col0 + c2] = s + C.in[5][layer * 6144 + col0 + c2]; }
            __syncthreads();
        }
    }
    {
        float* H = (float*)(C.ws + WS_H);
        const size_t n4 = (size_t)NROW * 256;
        for (size_t i = (size_t)C.bid * 512 + C.tid; i < n4; i += (size_t)C.G * 512) {
            const int row = (int)(i >> 8), c4 = (int)(i & 255) * 4;
            f32x4 v;
            if (row < NLAT) {
                v = *(const f32x4*)(C.in[0] + (size_t)row * DM + c4);
                const int t = row & 8191, quarter = c4 >> 8; const float pos = (quarter < 2) ? (float)(t >> 6) : (float)(t & 63);
                float e[4];
#pragma unroll
                for (int j = 0; j < 4; ++j) { const int jj = (c4 & 255) + j; const float fr = exp2f(-(float)jj * (13.287712379549449f / 256.f)); const float a = pos * fr; e[j] = (quarter & 1) ? __cosf(a) : __sinf(a); }
                v.x += e[0]; v.y += e[1]; v.z += e[2]; v.w += e[3];
            } else v = *(const f32x4*)(C.in[2] + (size_t)(row - NLAT) * DM + c4);
            *(f32x4*)(H + (size_t)row * DM + c4) = v;
        }
    }
}

struct Row16 { float v[16]; };
__device__ __forceinline__ Row16 load_row16(const float* p, int lane) {
    Row16 r; const f32x4 a = *(const f32x4*)(p + 8 * lane), b = *(const f32x4*)(p + 8 * lane + 4), c = *(const f32x4*)(p + 512 + 8 * lane), d = *(const f32x4*)(p + 512 + 8 * lane + 4);
    r.v[0] = a.x; r.v[1] = a.y; r.v[2] = a.z; r.v[3] = a.w; r.v[4] = b.x; r.v[5] = b.y; r.v[6] = b.z; r.v[7] = b.w;
    r.v[8] = c.x; r.v[9] = c.y; r.v[10] = c.z; r.v[11] = c.w; r.v[12] = d.x; r.v[13] = d.y; r.v[14] = d.z; r.v[15] = d.w; return r;
}
__device__ __forceinline__ void store_row16_f32(float* p, int lane, const Row16& r) {
    *(f32x4*)(p + 8 * lane) = (f32x4){r.v[0], r.v[1], r.v[2], r.v[3]}; *(f32x4*)(p + 8 * lane + 4) = (f32x4){r.v[4], r.v[5], r.v[6], r.v[7]};
    *(f32x4*)(p + 512 + 8 * lane) = (f32x4){r.v[8], r.v[9], r.v[10], r.v[11]}; *(f32x4*)(p + 512 + 8 * lane + 4) = (f32x4){r.v[12], r.v[13], r.v[14], r.v[15]};
}
__device__ __forceinline__ void store_row16_bf16(bf16_t* p, int lane, const Row16& r) {
    u32x4 a, b; a.x = pk2(r.v[0], r.v[1]); a.y = pk2(r.v[2], r.v[3]); a.z = pk2(r.v[4], r.v[5]); a.w = pk2(r.v[6], r.v[7]);
    b.x = pk2(r.v[8], r.v[9]); b.y = pk2(r.v[10], r.v[11]); b.z = pk2(r.v[12], r.v[13]); b.w = pk2(r.v[14], r.v[15]);
    *(u32x4*)(p + 8 * lane) = a; *(u32x4*)(p + 512 + 8 * lane) = b;
}
__device__ __forceinline__ Row16 norm_mod_row(const Row16& x, const float* g, const float* shift, const float* scale, int lane) {
    float ss = 0.f;
#pragma unroll
    for (int i = 0; i < 16; ++i) ss += x.v[i] * x.v[i];
    const float rs = rsqrtf(wave_sum(ss) * (1.f / 1024.f) + 1e-6f);
    const Row16 gg = load_row16(g, lane), sh = load_row16(shift, lane), sc = load_row16(scale, lane);
    Row16 o;
#pragma unroll
    for (int i = 0; i < 16; ++i) o.v[i] = (x.v[i] * rs * gg.v[i]) * (1.f + sc.v[i]) + sh.v[i];
    return o;
}
__device__ __forceinline__ int which_of(int row) { return row < 8192 ? 0 : (row < NLAT ? 1 : 2); }
__device__ __forceinline__ void ph_norm(const Ctx& C, int layer, const float* gain, int sidx, int nrows) {
    const float* H = (const float*)(C.ws + WS_H); bf16_t* ACT = (bf16_t*)(C.ws + WS_ACT); const float* MOD = (const float*)(C.ws + WS_MOD);
    for (int row = C.bid * 8 + C.wid; row < nrows; row += C.G * 8) {
        const float* m = MOD + ((size_t)layer * 3 + which_of(row)) * 6144;
        const Row16 x = load_row16(H + (size_t)row * DM, C.lane);
        const Row16 o = norm_mod_row(x, gain, m + sidx * 1024, m + (sidx + 1) * 1024, C.lane);
        store_row16_bf16(ACT + (size_t)row * DM, C.lane, o);
    }
}
struct EpiResid {
    static constexpr bool PERM = false, AFTER_DRAIN = false;
    float* H; const float* modl;
    __device__ __forceinline__ void operator()(const f32x4 (&acc)[2][2][4][2], const pg8::Unit& u, int wr, int wc, int fr, int fq) const {
        const int row0 = u.pm * 256 + wr * 64 + fr, col0 = u.pn * 256 + wc * 32 + 4 * fq;
        const int which = u.pm < 32 ? 0 : (u.pm < 64 ? 1 : 2);
        const float* gate = modl + ((size_t)which * 6 + 2) * 1024;
        f32x4 gv[2][2];
#pragma unroll
        for (int bj = 0; bj < 2; ++bj)
#pragma unroll
            for (int n = 0; n < 2; ++n) gv[bj][n] = *(const f32x4*)(gate + col0 + bj * 128 + n * 16);
#pragma unroll
        for (int ai = 0; ai < 2; ++ai)
#pragma unroll
            for (int m = 0; m < 4; ++m) { float* rowp = H + (size_t)(row0 + ai * 128 + m * 16) * DM + col0;
#pragma unroll
                for (int bj = 0; bj < 2; ++bj)
#pragma unroll
                    for (int n = 0; n < 2; ++n) { f32x4* p = (f32x4*)(rowp + bj * 128 + n * 16); *p = *p + gv[bj][n] * acc[ai][bj][m][n]; } }
    }
};

__device__ __forceinline__ void item_conformer(const Ctx& C, int layer, int gc) {
    const ChunkInfo ci = chunk_info(gc);
    const bf16_t* P = (const bf16_t*)(C.ws + WS_P); bf16_t* YC = (bf16_t*)(C.ws + WS_ACT);
    LAS bf16_t* HG = (LAS bf16_t*)C.lds;
    LAS float* CO = (LAS float*)(C.lds + 49152);
    for (int e = C.tid; e < 94 * 128; e += 512) {
        const int rr = e >> 7, cp = e & 127, grow = ci.row0 - 15 + rr;
        const bool ok = grow >= ci.lo && grow < ci.hi; const int gr = ok ? grow : ci.row0;
        const unsigned v = *(const unsigned*)(P + (size_t)gr * NP + 2 * cp), g = *(const unsigned*)(P + (size_t)gr * NP + 256 + 2 * cp);
        const unsigned o = pk2(bflo(v) * sigm(bflo(g)), bfhi(v) * sigm(bfhi(g)));
        *(LAS unsigned*)(HG + rr * 256 + 2 * cp) = ok ? o : 0u;
    }
    __syncthreads();
    {
        const int c = C.tid & 255, half = C.tid >> 8;
        const float* cw = C.in[10] + (size_t)layer * 31 * 256 + c;
        float w[31];
#pragma unroll
        for (int j = 0; j < 31; ++j) w[j] = cw[j * 256];
        const float bias = C.in[11][layer * 256 + c];
        float hv[62];
#pragma unroll
        for (int i = 0; i < 62; ++i) hv[i] = bf2f(HG[(half * 32 + i) * 256 + c]);
#pragma unroll
        for (int tt = 0; tt < 32; ++tt) { float acc = bias;
#pragma unroll
            for (int j = 0; j < 31; ++j) acc += w[j] * hv[tt + j];
            CO[(half * 32 + tt) * 256 + c] = acc; }
    }
    __syncthreads();
    {
        const float* lg = C.in[12] + layer * 256 + 4 * C.lane; const float* lb = C.in[13] + layer * 256 + 4 * C.lane;
        const f32x4 g4 = *(const f32x4*)lg, b4 = *(const f32x4*)lb;
        for (int i = 0; i < 8; ++i) {
            const int t = C.wid * 8 + i;
            const f32x4 x = *(const LAS f32x4*)(CO + t * 256 + 4 * C.lane);
            const float mean = wave_sum((x.x + x.y) + (x.z + x.w)) * (1.f / 256.f);
            const f32x4 d = x - mean;
            const float var = wave_sum((d.x * d.x + d.y * d.y) + (d.z * d.z + d.w * d.w)) * (1.f / 256.f);
            const float rs = rsqrtf(var + 1e-5f);
            const f32x4 y = d * rs * g4 + b4;
            u32x2 o; o.x = pk2(silu(y.x), silu(y.y)); o.y = pk2(silu(y.z), silu(y.w));
            *(u32x2*)(YC + (size_t)(ci.row0 + t) * DM + 4 * C.lane) = o;
        }
    }
    __syncthreads();
}

__device__ __forceinline__ void item_chunkmlp(const Ctx& C, int layer, int gb) {
    const int row0 = gb * 128;
    const bf16_t* P = (const bf16_t*)(C.ws + WS_P); bf16_t* YC = (bf16_t*)(C.ws + WS_ACT);
    LAS bf16_t* VNT = (LAS bf16_t*)C.lds;
    LAS bf16_t* WS = (LAS bf16_t*)(C.lds + 69632);
    {
        const f32x4 g4 = *(const f32x4*)(C.in[14] + layer * 256 + 4 * C.lane), b4 = *(const f32x4*)(C.in[15] + layer * 256 + 4 * C.lane);
        for (int i = 0; i < 16; ++i) {
            const int j = C.wid * 16 + i;
            const u32x2 raw = *(const u32x2*)(P + (size_t)(row0 + j) * NP + 768 + 4 * C.lane);
            const f32x4 x = {bflo(raw.x), bfhi(raw.x), bflo(raw.y), bfhi(raw.y)};
            const float mean = wave_sum((x.x + x.y) + (x.z + x.w)) * (1.f / 256.f);
            const f32x4 d = x - mean;
            const float var = wave_sum((d.x * d.x + d.y * d.y) + (d.z * d.z + d.w * d.w)) * (1.f / 256.f);
            const f32x4 y = d * rsqrtf(var + 1e-5f) * g4 + b4;
            VNT[(4 * C.lane + 0) * 136 + j] = f2bf(y.x); VNT[(4 * C.lane + 1) * 136 + j] = f2bf(y.y);
            VNT[(4 * C.lane + 2) * 136 + j] = f2bf(y.z); VNT[(4 * C.lane + 3) * 136 + j] = f2bf(y.w);
        }
    }
    for (int h = 0; h < 4; ++h) {
        const float* ws = C.in[16] + ((size_t)layer * 4 + h) * 128 * 128;
        for (int e = C.tid; e < 4096; e += 512) { const int i = e >> 5, j4 = (e & 31) * 4; const f32x4 w = *(const f32x4*)(ws + i * 128 + j4);
            u32x2 o; o.x = pk2(w.x, w.y); o.y = pk2(w.z, w.w); *(LAS u32x2*)(WS + i * 136 + j4) = o; }
        __syncthreads();
        const float* bs = C.in[17] + ((size_t)layer * 4 + h) * 128;
        {
            const int fr = C.lane & 15, fq = C.lane >> 4;
            unsigned short ur[4][4];
#pragma unroll
            for (int i = 0; i < 4; ++i) { const int tt = C.wid + 8 * i, tm = tt >> 2, tn = tt & 3;
#pragma unroll
                for (int jj = 0; jj < 4; ++jj) ur[i][jj] = P[(size_t)(row0 + tm * 16 + fq * 4 + jj) * NP + 512 + h * 64 + tn * 16 + fr]; }
#pragma unroll
            for (int i = 0; i < 4; ++i) { const int tt = C.wid + 8 * i, tm = tt >> 2, tn = tt & 3;
                f32x4 acc = {0.f, 0.f, 0.f, 0.f};
#pragma unroll
                for (int ks = 0; ks < 4; ++ks) acc = __builtin_amdgcn_mfma_f32_16x16x32_bf16(*(const LAS bf16x8*)(WS + (tm * 16 + fr) * 136 + ks * 32 + fq * 8),
                                                                                             *(const LAS bf16x8*)(VNT + (h * 64 + tn * 16 + fr) * 136 + ks * 32 + fq * 8), acc, 0, 0, 0);
#pragma unroll
                for (int jj = 0; jj < 4; ++jj) { const int ii = tm * 16 + fq * 4 + jj;
                    YC[(size_t)(row0 + ii) * DM + 256 + h * 64 + tn * 16 + fr] = f2bf((acc[jj] + bs[ii]) * bf2f(ur[i][jj])); }
            }
        }
        __syncthreads();
    }
}

__device__ __forceinline__ void item_mamba_local(const Ctx& C, int layer, int gc) {
    const ChunkInfo ci = chunk_info(gc);
    const bf16_t* P = (const bf16_t*)(C.ws + WS_P);
    bf16_t* MSTb = (bf16_t*)(C.ws + WS_MST); float* MCD = (float*)(C.ws + WS_MCD);
    LAS float* DA = (LAS float*)C.lds;
    LAS float* DT = (LAS float*)(C.lds + 2048);
    LAS float* FAC = (LAS float*)(C.lds + 4096);
    LAS bf16_t* XDT = (LAS bf16_t*)(C.lds + 8192);
    LAS bf16_t* BTT = (LAS bf16_t*)(C.lds + 8192 + 73728);
    {
        const int s = C.lane, dh = C.wid, d = dh >> 2, h = dh & 3;
        const float raw = bf2f(P[(size_t)(ci.row0 + s) * NP + OFF_C + 1024 + dh]);
        const float dt = softplus(raw + C.in[20][layer * 8 + dh]);
        const float da = dt * (-expf(C.in[21][layer * 8 + dh]));
        const float incl = wave_incl_scan(da, s), total = __shfl(incl, 63);
        DT[dh * 64 + s] = dt; DA[dh * 64 + s] = da;
        FAC[dh * 64 + s] = d ? fexp(incl - da) : fexp(total - incl);
        if (s == 0) MCD[slot_of(ci.b, h, d, cpos_of(ci, d))] = expf(total);
    }
    __syncthreads();
    {
        const int cp = C.tid & 255, half = C.tid >> 8, c0 = 2 * cp;
        const float* cw = C.in[18] + (size_t)layer * 5 * 768 + c0; const float* cb = C.in[19] + layer * 768 + c0;
        float w0[5], w1[5];
#pragma unroll
        for (int j = 0; j < 5; ++j) { w0[j] = cw[j * 768]; w1[j] = cw[j * 768 + 1]; }
        const float b0 = cb[0], b1 = cb[1];
        const int s0 = half * 32;
        unsigned wr[36];
        unsigned short ob[4][8];
#pragma unroll
        for (int j = 0; j < 36; ++j) { const int row = ci.row0 + s0 - 2 + j; const bool ok = row >= ci.lo && row < ci.hi; const unsigned v = *(const unsigned*)(P + (size_t)(ok ? row : ci.row0) * NP + OFF_C + 256 + c0); wr[j] = ok ? v : 0u; }
#pragma unroll
        for (int tt = 0; tt < 32; ++tt) {
            const int s = s0 + tt;
            const unsigned* win = wr + tt;
            float a0 = b0, a1 = b1;
#pragma unroll
            for (int j = 0; j < 5; ++j) { a0 += w0[j] * bflo(win[j]); a1 += w1[j] * bfhi(win[j]); }
            a0 = silu(a0); a1 = silu(a1);
            if (c0 < 256) { const int h = c0 >> 6;
#pragma unroll
                for (int d = 0; d < 2; ++d) { const float f = DT[(d * 4 + h) * 64 + s] * FAC[(d * 4 + h) * 64 + s]; ob[d * 2][tt & 7] = f2bf(a0 * f); ob[d * 2 + 1][tt & 7] = f2bf(a1 * f); }
            } else { ob[0][tt & 7] = f2bf(a0); ob[1][tt & 7] = f2bf(a1); }
            if ((tt & 7) == 7) { const int sb = s - 7;
#define C1_PACK8(a) (u32x4){(unsigned)a[0] | ((unsigned)a[1] << 16), (unsigned)a[2] | ((unsigned)a[3] << 16), (unsigned)a[4] | ((unsigned)a[5] << 16), (unsigned)a[6] | ((unsigned)a[7] << 16)}
                if (c0 < 256) {
#pragma unroll
                    for (int d = 0; d < 2; ++d) { *(LAS u32x4*)(XDT + (d * 256 + c0) * 72 + sb) = C1_PACK8(ob[d * 2]); *(LAS u32x4*)(XDT + (d * 256 + c0 + 1) * 72 + sb) = C1_PACK8(ob[d * 2 + 1]); }
                } else { const int q = c0 - 256; *(LAS u32x4*)(BTT + q * 72 + sb) = C1_PACK8(ob[0]); *(LAS u32x4*)(BTT + (q + 1) * 72 + sb) = C1_PACK8(ob[1]); }
#undef C1_PACK8
            }
        }
    }
    __syncthreads();
    for (int hd = 0; hd < 8; ++hd) {
        const int d = hd >> 2, h = hd & 3;
        bf16_t* dst = MSTb + (size_t)slot_of(ci.b, h, d, cpos_of(ci, d)) * 8192;
        blk_mma<8, 4, 2>(BTT + (h >> 1) * 128 * 72, 72, XDT + (d * 256 + h * 64) * 72, 72, C.wid, C.lane, [=](int r0, int col, const f32x4& acc) {
            u32x2 o; o.x = pk2(acc[0], acc[1]); o.y = pk2(acc[2], acc[3]); *(u32x2*)(dst + col * 128 + r0) = o;
        });
    }
    __syncthreads();
}


#ifndef MK_DIAG2
#define MK_DIAG2 0
#endif
#if MK_DIAG2
#define DBGF(stage, cond) do { if (cond) atomicOr((unsigned*)(C.ws + 32768) + (stage), 1u); } while (0)
#define DBGL(stage, cond) do { if (cond) atomicOr(dbgflags + (stage), 1u); } while (0)
#else
#define DBGF(stage, cond) do {} while (0)
#define DBGL(stage, cond) do {} while (0)
#endif
__device__ __forceinline__ bool badv(float x, float lim) { return !(fabsf(x) < lim); }
__device__ __forceinline__ void tri_inverse(const LAS float* ABf, LAS float* Tf, LAS float* Rt, LAS bf16_t* TT, int tid, int wid, int lane) {
    if (wid == 0) {
        const int bi = lane >> 4, j = lane & 15; const LAS float* Ab = ABf + (16 * bi) * 68 + 16 * bi;
        float col[16];
#pragma unroll
        for (int r = 0; r < 16; ++r) { float acc = (r == j) ? 1.f : 0.f;
#pragma unroll
            for (int s = 0; s < r; ++s) acc -= Ab[r * 68 + s] * col[s];
            col[r] = acc; }
#pragma unroll
        for (int r = 0; r < 16; ++r) Tf[(16 * bi + r) * 68 + 16 * bi + j] = col[r];
    } else {
        for (int e = tid - 64; e < 64 * 64; e += 448) { const int t = e >> 6, s2 = e & 63; if ((s2 >> 4) > (t >> 4)) Tf[t * 68 + s2] = 0.f; }
    }
    __syncthreads();
    if (wid < 3) {
        const int tn = wid, fr = lane & 15, fq = lane >> 4;
        LAS float* Rw = Rt + wid * 320;
        for (int i = tn + 1; i < 4; ++i) {
            f32x4 acc = {0.f, 0.f, 0.f, 0.f};
            for (int k = 16 * tn; k < 16 * i; k += 4) acc = __builtin_amdgcn_mfma_f32_16x16x4f32(ABf[(16 * i + fr) * 68 + k + fq], Tf[(k + fq) * 68 + 16 * tn + fr], acc, 0, 0, 0);
#pragma unroll
            for (int j = 0; j < 4; ++j) Rw[(fq * 4 + j) * 20 + fr] = -acc[j];
            asm volatile("s_waitcnt lgkmcnt(0)" ::: "memory");
            f32x4 t = {0.f, 0.f, 0.f, 0.f};
#pragma unroll
            for (int k = 0; k < 16; k += 4) t = __builtin_amdgcn_mfma_f32_16x16x4f32(Tf[(16 * i + fr) * 68 + 16 * i + k + fq], Rw[(k + fq) * 20 + fr], t, 0, 0, 0);
#pragma unroll
            for (int j = 0; j < 4; ++j) Tf[(16 * i + fq * 4 + j) * 68 + 16 * tn + fr] = t[j];
            asm volatile("s_waitcnt lgkmcnt(0)" ::: "memory");
        }
    }
    __syncthreads();
    for (int e = tid; e < 4096; e += 512) { const int t = e >> 6, s2 = e & 63; TT[t * 72 + s2] = f2bf(Tf[t * 68 + s2]); }
}
struct D1Pre { unsigned w[24]; unsigned lw[8]; int hd; };
__device__ __forceinline__ void d1_load_rows(const Ctx& C, int it, unsigned (&w)[24]) {
    const int gc = it >> 3, hd = it & 7, h = hd & 3, d = hd >> 2;
    const ChunkInfo ci = chunk_info(gc);
    const bf16_t* P = (const bf16_t*)(C.ws + WS_P);
    if (C.tid < 480) {
        const int q = C.tid % 160, seg = C.tid / 160, grp = q >> 5, c = (q & 31) * 2;
        const int j = (grp == 0 ? h * 64 : grp == 1 ? 256 + h * 64 : grp == 2 ? 512 + h * 64 : grp == 3 ? 768 + d * 64 : 896 + d * 64) + c;
        const int t0 = seg * 22, nt = seg == 2 ? 20 : 22;
        const bf16_t* pp = P + (size_t)(ci.row0 + t0) * NP + OFF_D + j;
#pragma unroll
        for (int i = 0; i < 24; ++i) { const int row = ci.row0 + t0 - 1 + i; const bool ok = row >= ci.lo && row < ci.hi; const int rc = ok ? row : ci.row0;
            const unsigned v = (i < nt + 2) ? *(const unsigned*)(pp + (ptrdiff_t)(rc - (ci.row0 + t0)) * NP) : 0u; w[i] = ok ? v : 0u; }
    }
}
constexpr int D1_LW = 0, D1_CS = 17408, D1_AA = 34816, D1_RB = 52224, D1_KB = 61440, D1_VB = 70656, D1_TW = 79872, D1_AD = 89088, D1_W2T = 98304, D1_A2T = 107520;
constexpr int D1_Y = 82944;
constexpr int D1_ABF = 0, D1_AK = 17408, D1_ARK = 26624, D1_ARB = 35840, D1_TT = 45056, D1_W1T = 54272, D1_AKVT = 63488, D1_W2TT = 72704;
constexpr int D1_GL = 156672;
__device__ __forceinline__ void item_rwkv_local(const Ctx& C0_, int layer, int it, D1Pre& pre, int it_next) {
    Ctx C = C0_; { int t_ = C0_.tid; asm volatile("" : "+v"(t_)); C.tid = t_; C.lane = t_ & 63; C.wid = __builtin_amdgcn_readfirstlane(t_ >> 6); }
#define D1_RELAUNDER() do { int t_ = C.tid; asm volatile("" : "+v"(t_)); C.tid = t_; C.lane = t_ & 63; C.wid = __builtin_amdgcn_readfirstlane(t_ >> 6); } while (0)
    const int gc = it >> 3, hd = it & 7, h = hd & 3, d = hd >> 2;
    const ChunkInfo ci = chunk_info(gc);
    const int slot = slot_of(ci.b, h, d, cpos_of(ci, d));
    const bf16_t* P = (const bf16_t*)(C.ws + WS_P);
    const float* mup = C.in[24] + layer * 1152; const float* mun = C.in[25] + layer * 1152;
    lds_t L = C.lds;
    LAS float* LW = (LAS float*)(L + D1_LW); LAS float* CS = (LAS float*)(L + D1_CS); LAS float* AA = (LAS float*)(L + D1_AA); LAS float* GL = (LAS float*)(L + D1_GL);
    LAS bf16_t* Rb = (LAS bf16_t*)(L + D1_RB); LAS bf16_t* Kb = (LAS bf16_t*)(L + D1_KB); LAS bf16_t* Vb = (LAS bf16_t*)(L + D1_VB);
    LAS bf16_t* TW = (LAS bf16_t*)(L + D1_TW); LAS bf16_t* AD = (LAS bf16_t*)(L + D1_AD); LAS bf16_t* W2T = (LAS bf16_t*)(L + D1_W2T); LAS bf16_t* A2T = (LAS bf16_t*)(L + D1_A2T);
    LAS bf16_t* KT = (LAS bf16_t*)(L + D1_Y); LAS bf16_t* KTt = KT + 4608; LAS bf16_t* KD = KT + 2 * 4608; LAS bf16_t* KDt = KT + 3 * 4608;
    LAS bf16_t* BT = KT + 4 * 4608; LAS bf16_t* BTt = KT + 5 * 4608; LAS bf16_t* RT = KT + 6 * 4608; LAS bf16_t* Vt = KT + 7 * 4608;
    LAS float* ABf = (LAS float*)(L + D1_ABF); LAS bf16_t* AK = (LAS bf16_t*)(L + D1_AK); LAS bf16_t* ARK = (LAS bf16_t*)(L + D1_ARK); LAS bf16_t* ARB = (LAS bf16_t*)(L + D1_ARB);
    LAS bf16_t* TT = (LAS bf16_t*)(L + D1_TT); LAS bf16_t* W1t = (LAS bf16_t*)(L + D1_W1T); LAS bf16_t* AKVt = (LAS bf16_t*)(L + D1_AKVT); LAS bf16_t* W2t = (LAS bf16_t*)(L + D1_W2TT);

    if (C.tid < 480) {
        const int q = C.tid % 160, seg = C.tid / 160, grp = q >> 5, c = (q & 31) * 2;
        const int j = (grp == 0 ? h * 64 : grp == 1 ? 256 + h * 64 : grp == 2 ? 512 + h * 64 : grp == 3 ? 768 + d * 64 : 896 + d * 64) + c;
        const int t0 = seg * 22, nt = seg == 2 ? 20 : 22;
        const float mp0 = mup[j], mp1 = mup[j + 1], mn0 = mun[j], mn1 = mun[j + 1];
        unsigned w[24]; { const bf16_t* pp = P + (size_t)(ci.row0 + t0) * NP + OFF_D + j;
#pragma unroll
        for (int i = 0; i < 24; ++i) { const int row = ci.row0 + t0 - 1 + i; const bool ok = row >= ci.lo && row < ci.hi; const int rc = ok ? row : ci.row0;
            const unsigned v = (i < nt + 2) ? *(const unsigned*)(pp + (ptrdiff_t)(rc - (ci.row0 + t0)) * NP) : 0u; w[i] = ok ? v : 0u; } }
        LAS bf16_t* dst = (grp == 0 ? Rb : grp == 1 ? Kb : grp == 2 ? Vb : grp == 3 ? TW : AD);
#pragma unroll
        for (int i = 0; i < 22; ++i) if (i < nt) {
            const float x0 = bflo(w[i + 1]), x1 = bfhi(w[i + 1]);
            const float v0 = x0 + mp0 * (bflo(w[i]) - x0) + mn0 * (bflo(w[i + 2]) - x0);
            const float v1 = x1 + mp1 * (bfhi(w[i]) - x1) + mn1 * (bfhi(w[i + 2]) - x1);
            DBGF(1, badv(v0, 1e4f) || badv(v1, 1e4f));
            const unsigned o = (grp == 3) ? pk2(ftanh(v0), ftanh(v1)) : pk2(v0, v1);
            const int tl = t0 + i, l = d ? 63 - tl : tl;
            *(LAS unsigned*)(dst + l * 72 + c) = o;
        }
    }
    {
        if (pre.hd != hd) {
            const float* w2 = C.in[27] + ((size_t)layer * 2 + d) * 64 * 256 + h * 64; const float* a2 = C.in[29] + ((size_t)layer * 2 + d) * 64 * 256 + h * 64;
#pragma unroll
            for (int k = 0; k < 8; ++k) { const int e = C.tid + 512 * k, r = e >> 6, c = e & 63; pre.lw[k] = pk2(w2[r * 256 + c], a2[r * 256 + c]); }
            pre.hd = hd;
        }
#pragma unroll
        for (int k = 0; k < 8; ++k) { const int e = C.tid + 512 * k, r = e >> 6, c = e & 63; W2T[c * 72 + r] = (unsigned short)(pre.lw[k] & 0xffffu); A2T[c * 72 + r] = (unsigned short)(pre.lw[k] >> 16); }
    }
    __syncthreads();
    D1_RELAUNDER();
    {
        unsigned* dbgflags = (unsigned*)(C.ws + 32768); (void)dbgflags;
        const float* w0 = C.in[26] + ((size_t)layer * 2 + d) * 256 + h * 64; const float* a0 = C.in[28] + ((size_t)layer * 2 + d) * 256 + h * 64;
        blk_mma<4, 4, 2>(TW, 72, W2T, 72, C.wid, C.lane, [=](int r0, int col, const f32x4& acc) {
#pragma unroll
            for (int jj = 0; jj < 4; ++jj) { const float w = w0[col] + acc[jj]; DBGL(2, badv(w, 1e4f)); LW[(r0 + jj) * 68 + col] = -fexp(-softplus(-w) - 0.5f); }
        });
        blk_mma<4, 4, 2>(AD, 72, A2T, 72, C.wid, C.lane, [=](int r0, int col, const f32x4& acc) {
#pragma unroll
            for (int jj = 0; jj < 4; ++jj) { DBGL(2, badv(acc[jj], 1e4f)); AA[(r0 + jj) * 68 + col] = sigm(a0[col] + acc[jj]); }
        });
    }
    __syncthreads();
    {
#pragma unroll
        for (int i = 0; i < 8; ++i) { const int c = C.wid * 8 + i; const float incl = wave_incl_scan(LW[C.lane * 68 + c], C.lane); CS[C.lane * 68 + c] = incl; if (C.lane == 63) GL[c] = fexp(incl); }
    }
    __syncthreads();
    D1_RELAUNDER();
    {
        const int c = C.lane, l0 = C.wid * 8;
        const float kkw = C.in[31][layer * 256 + h * 64 + c], kaw = C.in[32][layer * 256 + h * 64 + c], rkw = C.in[33][layer * 256 + h * 64 + c];
        unsigned short kt[8], kd[8], bt[8], vt[8];
#pragma unroll
        for (int i = 0; i < 8; ++i) { const int l = l0 + i;
            const float k = bf2f(Kb[l * 72 + c]), r = bf2f(Rb[l * 72 + c]), v = bf2f(Vb[l * 72 + c]), aa = AA[l * 68 + c];
            const float kkr = k * kkw, kdv = k * (1.f + (aa - 1.f) * kaw);
            const float ss = wave_sum(kkr * kkr), bon = wave_sum(r * kdv * rkw);
            const float kkn = kkr * rsqrtf(ss + 1e-12f);
            if (c == 0) ((float*)(C.ws + WS_BON))[(size_t)(ci.row0 + (d ? 63 - l : l)) * 8 + h * 2 + d] = bon;
            const float cs = CS[l * 68 + c], lw = LW[l * 68 + c];
            const float ge = fexp(cs - lw), gi = fexp(cs), gn = fexp(-cs);
            DBGF(3, badv(cs, 50.f) || cs > 0.f || badv(lw, 1.f)); DBGF(4, badv(kkn * ge, 10.f) || badv(r * gi, 1e4f) || badv(v, 1e4f)); DBGF(5, badv(kdv * gn, 1e25f) || badv(kkn * aa * gn, 1e25f));
            kt[i] = f2bf(kkn * ge); kd[i] = f2bf(kdv * gn); bt[i] = f2bf(kkn * aa * gn); vt[i] = f2bf(v);
            KT[l * 72 + c] = kt[i]; KD[l * 72 + c] = kd[i]; BT[l * 72 + c] = bt[i]; RT[l * 72 + c] = f2bf(r * gi); }
#define D1_PACK8(a) (u32x4){(unsigned)a[0] | ((unsigned)a[1] << 16), (unsigned)a[2] | ((unsigned)a[3] << 16), (unsigned)a[4] | ((unsigned)a[5] << 16), (unsigned)a[6] | ((unsigned)a[7] << 16)}
        *(LAS u32x4*)(KTt + c * 72 + l0) = D1_PACK8(kt); *(LAS u32x4*)(KDt + c * 72 + l0) = D1_PACK8(kd);
        *(LAS u32x4*)(BTt + c * 72 + l0) = D1_PACK8(bt); *(LAS u32x4*)(Vt + c * 72 + l0) = D1_PACK8(vt);
#undef D1_PACK8
    }
    __syncthreads();
    D1_RELAUNDER();
    unsigned* dbgflags = (unsigned*)(C.ws + 32768); (void)dbgflags;
    blk_mma2<4, 4, 2>(BT, KT, KD, KT, 72, C.wid, C.lane, [=](int r0, int col, const f32x4& ab, const f32x4& ak) {
        f32x4 a; float k[4];
#pragma unroll
        for (int jj = 0; jj < 4; ++jj) { const bool lo = r0 + jj < col; DBGL(6, lo && (badv(ab[jj], 1e3f) || badv(ak[jj], 1e4f))); a[jj] = lo ? ab[jj] : 0.f; k[jj] = lo ? ak[jj] : 0.f; }
        *(LAS f32x4*)(ABf + col * 68 + r0) = a;
        u32x2 o; o.x = pk2(k[0], k[1]); o.y = pk2(k[2], k[3]); *(LAS u32x2*)(AK + col * 72 + r0) = o;
    });
    blk_mma2<4, 4, 2>(KD, RT, BT, RT, 72, C.wid, C.lane, [=](int r0, int col, const f32x4& rk, const f32x4& rb) {
        float a[4], b[4];
#pragma unroll
        for (int jj = 0; jj < 4; ++jj) { const bool le = r0 + jj <= col; DBGL(7, le && (badv(rk[jj], 1e5f) || badv(rb[jj], 1e5f))); a[jj] = le ? rk[jj] : 0.f; b[jj] = le ? rb[jj] : 0.f; }
        u32x2 oa, ob; oa.x = pk2(a[0], a[1]); oa.y = pk2(a[2], a[3]); ob.x = pk2(b[0], b[1]); ob.y = pk2(b[2], b[3]);
        *(LAS u32x2*)(ARK + col * 72 + r0) = oa; *(LAS u32x2*)(ARB + col * 72 + r0) = ob;
    });
    __syncthreads();
    tri_inverse(ABf, (LAS float*)(L + 54272), (LAS float*)(L + 71680), TT, C.tid, C.wid, C.lane);
    __syncthreads();
#if MK_DIAG2
    for (int e = C.tid; e < 4096; e += 512) DBGF(8, badv(bf2f(TT[(e >> 6) * 72 + (e & 63)]), 1e3f));
#endif
    D1_RELAUNDER();
    blk_mma2<4, 4, 2>(TT, KTt, AK, Vt, 72, C.wid, C.lane, [=](int r0, int col, const f32x4& w1, const f32x4& akv) {
        DBGL(9, badv(w1[0], 1e3f) || badv(w1[1], 1e3f) || badv(w1[2], 1e3f) || badv(w1[3], 1e3f)); DBGL(10, badv(akv[0], 1e5f) || badv(akv[1], 1e5f) || badv(akv[2], 1e5f) || badv(akv[3], 1e5f));
        u32x2 a, b; a.x = pk2(w1[0], w1[1]); a.y = pk2(w1[2], w1[3]); b.x = pk2(akv[0], akv[1]); b.y = pk2(akv[2], akv[3]);
        *(LAS u32x2*)(W1t + col * 72 + r0) = a; *(LAS u32x2*)(AKVt + col * 72 + r0) = b;
    });
    __syncthreads();
    blk_mma<4, 4, 2>(TT, 72, AKVt, 72, C.wid, C.lane, [=](int r0, int col, const f32x4& w2) {
        DBGL(11, badv(w2[0], 1e5f) || badv(w2[1], 1e5f) || badv(w2[2], 1e5f) || badv(w2[3], 1e5f));
        u32x2 a; a.x = pk2(w2[0], w2[1]); a.y = pk2(w2[2], w2[3]); *(LAS u32x2*)(W2t + col * 72 + r0) = a;
    });
    __syncthreads();
    D1_RELAUNDER();
    {
        bf16_t* Gg = (bf16_t*)(C.ws + WS_RG) + (size_t)slot * 4096; bf16_t* Jg = (bf16_t*)(C.ws + WS_RJ) + (size_t)slot * 4096;
        bf16_t* Ryg = (bf16_t*)(C.ws + WS_RY) + (size_t)slot * 4096; bf16_t* Ylg = (bf16_t*)(C.ws + WS_RL) + (size_t)slot * 4096;
        blk_mma2<4, 4, 2>(W1t, BTt, W1t, ARB, 72, C.wid, C.lane, [=](int r0, int col, const f32x4& gp, const f32x4& rbw) {
            const float gl = GL[col]; float g[4], ry[4];
            const u32x2 rt = *(const LAS u32x2*)(RT + col * 72 + r0);
            const float rtv[4] = {bflo(rt.x), bfhi(rt.x), bflo(rt.y), bfhi(rt.y)};
#pragma unroll
            for (int jj = 0; jj < 4; ++jj) { g[jj] = gl * ((col == r0 + jj ? 1.f : 0.f) - gp[jj]); ry[jj] = rtv[jj] - rbw[jj]; }
            u32x2 og, oy; og.x = pk2(g[0], g[1]); og.y = pk2(g[2], g[3]); oy.x = pk2(ry[0], ry[1]); oy.y = pk2(ry[2], ry[3]);
            *(u32x2*)(Gg + col * 64 + r0) = og;
            *(u32x2*)(Ryg + col * 64 + r0) = oy;
        });
        blk_mma2<4, 4, 2>(KDt, Vt, BTt, W2t, 72, C.wid, C.lane, [=](int r0, int col, const f32x4& kv, const f32x4& bw) {
            f32x4 o;
#pragma unroll
            for (int jj = 0; jj < 4; ++jj) { o[jj] = GL[r0 + jj] * (kv[jj] - bw[jj]); DBGL(12, badv(GL[r0 + jj] * kv[jj], 1e5f)); DBGL(13, badv(GL[r0 + jj] * bw[jj], 1e5f)); DBGL(14, badv(o[jj], 1e5f)); }
            u32x2 oj; oj.x = pk2(o[0], o[1]); oj.y = pk2(o[2], o[3]); *(u32x2*)(Jg + col * 64 + r0) = oj;
        });
        blk_mma2<4, 4, 2>(ARK, Vt, ARB, W2t, 72, C.wid, C.lane, [=](int r0, int col, const f32x4& a, const f32x4& b) {
            u32x2 o; o.x = pk2(a[0] - b[0], a[1] - b[1]); o.y = pk2(a[2] - b[2], a[3] - b[3]);
            *(u32x2*)(Ylg + col * 64 + r0) = o;
        });
    }
    __syncthreads();
}

typedef float f32x2p __attribute__((ext_vector_type(2)));
__device__ __forceinline__ void ph_scan(const Ctx& C, int nrep = 1, bool mstore = true, bool chain = true) {
    if (C.bid < 64) {
      if (chain)
      for (int rep = 0; rep < nrep; ++rep) {
        constexpr int NB = 8;
        const int chain_id = C.bid >> 2, w4 = C.bid & 3, fr = C.lane & 15, fq = C.lane >> 4;
        LAS bf16_t* Gs = (LAS bf16_t*)C.lds;
        LAS bf16_t* Js = Gs + NB * 4608;
        LAS bf16_t* HT = Js + NB * 1152;
        const bf16_t* Gg = (const bf16_t*)(C.ws + WS_RG) + (size_t)chain_id * NCH * 4096;
        const bf16_t* Jg = (const bf16_t*)(C.ws + WS_RJ) + (size_t)chain_id * NCH * 4096 + (size_t)(16 * w4) * 64;
        bf16_t* Hg = (bf16_t*)(C.ws + WS_RH) + (size_t)chain_id * NCH * 4096 + (16 * w4 + fr) * 64 + fq * 4;
        u32x4 pf[10];
#define CHAIN_ISSUE(b0_) do { _Pragma("unroll") for (int i = 0; i < 10; ++i) { const int e = C.tid + 512 * i, st = e / 640, q = e % 640; const size_t cp = (size_t)((b0_) + st < NCH ? (b0_) + st : NCH - 1) * 4096; \
            pf[i] = *(const u32x4*)(q < 512 ? Gg + cp + q * 8 : Jg + cp + (q - 512) * 8); } } while (0)
#define CHAIN_STAGE() do { _Pragma("unroll") for (int i = 0; i < 10; ++i) { const int e = C.tid + 512 * i, st = e / 640, q = e % 640; \
            if (q < 512) *(LAS u32x4*)(Gs + st * 4608 + (q >> 3) * 72 + (q & 7) * 8) = pf[i]; else *(LAS u32x4*)(Js + st * 1152 + ((q - 512) >> 3) * 72 + (q & 7) * 8) = pf[i]; } } while (0)
        f32x4 acc[4];
#pragma unroll
        for (int tm = 0; tm < 4; ++tm) acc[tm] = (f32x4){0.f, 0.f, 0.f, 0.f};
        CHAIN_ISSUE(0);
        for (int b0 = 0; b0 < NCH; b0 += NB) {
            __syncthreads();
            CHAIN_STAGE();
            __syncthreads();
            if (b0 + NB < NCH) CHAIN_ISSUE(b0 + NB);
            if (C.wid == 0) {
                const int nb = NCH - b0 < NB ? NCH - b0 : NB;
                for (int st = 0; st < nb; ++st) {
                    const int cpos = b0 + st;
#pragma unroll
                    for (int tm = 0; tm < 4; ++tm) { u32x2 o; o.x = pk2(acc[tm][0], acc[tm][1]); o.y = pk2(acc[tm][2], acc[tm][3]);
                        *(LAS u32x2*)(HT + fr * 72 + tm * 16 + fq * 4) = o;
                        *(u32x2*)(Hg + (size_t)cpos * 4096 + tm * 16) = o; }
                    const bf16x8 b0v = *(const LAS bf16x8*)(HT + fr * 72 + fq * 8), b1v = *(const LAS bf16x8*)(HT + fr * 72 + 32 + fq * 8);
#pragma unroll
                    for (int tm = 0; tm < 4; ++tm) {
                        const u32x2 jr = *(const LAS u32x2*)(Js + st * 1152 + fr * 72 + tm * 16 + fq * 4);
                        f32x4 a = {bflo(jr.x), bfhi(jr.x), bflo(jr.y), bfhi(jr.y)};
                        a = __builtin_amdgcn_mfma_f32_16x16x32_bf16(*(const LAS bf16x8*)(Gs + st * 4608 + (tm * 16 + fr) * 72 + fq * 8), b0v, a, 0, 0, 0);
                        a = __builtin_amdgcn_mfma_f32_16x16x32_bf16(*(const LAS bf16x8*)(Gs + st * 4608 + (tm * 16 + fr) * 72 + 32 + fq * 8), b1v, a, 0, 0, 0);
                        acc[tm] = a; }
                }
            }
        }
#undef CHAIN_ISSUE
#undef CHAIN_STAGE
        __syncthreads();
      }
    } else {
        unsigned* MST = (unsigned*)(C.ws + WS_MST); const float* MCD = (const float*)(C.ws + WS_MCD);
        const int nthr = (C.G - 64) * 512;
        for (int e = (C.bid - 64) * 512 + C.tid; e < 16 * 4096; e += nthr) {
            const int chain = e >> 12, el = e & 4095; float r0 = 0.f, r1 = 0.f;
            unsigned* p = MST + (size_t)chain * NCH * 4096 + el; const float* cd = MCD + chain * NCH;
#pragma unroll 22
            for (int cpos = 0; cpos < NCH; ++cpos) { const unsigned tmp = p[(size_t)cpos * 4096]; if (mstore) p[(size_t)cpos * 4096] = pk2(r0, r1); const float c = cd[cpos]; r0 = r0 * c + bflo(tmp); r1 = r1 * c + bfhi(tmp); }
            if (!mstore && r0 == 12345.678f) p[0] = 0u;
        }
    }
}

__device__ __forceinline__ void item_mamba_out(const Ctx& C0_, int layer, int gc) {
    Ctx C = C0_;
#define MO_RELAUNDER() do { int t_ = C.tid; asm volatile("" : "+v"(t_)); C.tid = t_; C.lane = t_ & 63; C.wid = __builtin_amdgcn_readfirstlane(t_ >> 6); } while (0)
    MO_RELAUNDER();
    const ChunkInfo ci = chunk_info(gc);
    const bf16_t* P = (const bf16_t*)(C.ws + WS_P); bf16_t* YC = (bf16_t*)(C.ws + WS_ACT); const bf16_t* MST = (const bf16_t*)(C.ws + WS_MST);
    lds_t L = C.lds;
    LAS float* DT = (LAS float*)L;
    LAS float* DA = (LAS float*)(L + 2048);
    LAS float* CSI = (LAS float*)(L + 4096);
    LAS float* SSQ = (LAS float*)(L + 6144);
    LAS bf16_t* CG = (LAS bf16_t*)(L + 10240);
    LAS bf16_t* BG = (LAS bf16_t*)(L + 27648);
    LAS bf16_t* XT = (LAS bf16_t*)(L + 45056);
    LAS float* CBm = (LAS float*)(L + 63488);
    LAS bf16_t* MP = (LAS bf16_t*)(L + 80896);
    LAS bf16_t* S0 = (LAS bf16_t*)(L + 90112);
    LAS bf16_t* YPRE = (LAS bf16_t*)(L + 107520);
    int fr = C.lane & 15, fq = C.lane >> 4;
    {
        const int s = C.lane, dh = C.wid;
        const float raw = bf2f(P[(size_t)(ci.row0 + s) * NP + OFF_C + 1024 + dh]);
        const float dt = softplus(raw + C.in[20][layer * 8 + dh]);
        const float da = dt * (-expf(C.in[21][layer * 8 + dh]));
        const float incl = wave_incl_scan(da, s), total = __shfl(incl, 63);
        DT[dh * 64 + s] = dt; DA[dh * 64 + s] = da;
        CSI[dh * 64 + s] = (dh < 4) ? incl : (total - incl + da);
    }
    for (int g = 0; g < 2; ++g) {
        __syncthreads();
        MO_RELAUNDER(); fr = C.lane & 15; fq = C.lane >> 4;
        {
            const int cp = C.tid & 255, half = C.tid >> 8;
            if (cp < 192) {
                const int kind = cp >> 6, cl = (cp & 63) * 2, c0 = kind * 256 + g * 128 + cl;
                const float* cw = C.in[18] + (size_t)layer * 5 * 768 + c0; const float* cb = C.in[19] + layer * 768 + c0;
                float w0[5], w1[5];
#pragma unroll
                for (int j = 0; j < 5; ++j) { w0[j] = cw[j * 768]; w1[j] = cw[j * 768 + 1]; }
                const float b0 = cb[0], b1 = cb[1];
                const int s0 = half * 32;
                unsigned wr[36];
                unsigned short xb0[8], xb1[8];
#pragma unroll
                for (int j = 0; j < 36; ++j) { const int row = ci.row0 + s0 - 2 + j; const bool ok = row >= ci.lo && row < ci.hi; const unsigned v = *(const unsigned*)(P + (size_t)(ok ? row : ci.row0) * NP + OFF_C + 256 + c0); wr[j] = ok ? v : 0u; }
#pragma unroll
                for (int tt = 0; tt < 32; ++tt) {
                    const int s = s0 + tt;
                    const unsigned* win = wr + tt;
                    float a0 = b0, a1 = b1;
#pragma unroll
                    for (int j = 0; j < 5; ++j) { a0 += w0[j] * bflo(win[j]); a1 += w1[j] * bfhi(win[j]); }
                    const unsigned short o0 = f2bf(silu(a0)), o1 = f2bf(silu(a1));
                    if (kind == 0) { xb0[tt & 7] = o0; xb1[tt & 7] = o1;
                        if ((tt & 7) == 7) { const int sb = s - 7;
                            *(LAS u32x4*)(XT + cl * 72 + sb) = (u32x4){(unsigned)xb0[0] | ((unsigned)xb0[1] << 16), (unsigned)xb0[2] | ((unsigned)xb0[3] << 16), (unsigned)xb0[4] | ((unsigned)xb0[5] << 16), (unsigned)xb0[6] | ((unsigned)xb0[7] << 16)};
                            *(LAS u32x4*)(XT + (cl + 1) * 72 + sb) = (u32x4){(unsigned)xb1[0] | ((unsigned)xb1[1] << 16), (unsigned)xb1[2] | ((unsigned)xb1[3] << 16), (unsigned)xb1[4] | ((unsigned)xb1[5] << 16), (unsigned)xb1[6] | ((unsigned)xb1[7] << 16)}; } }
                    else if (kind == 1) { *(LAS unsigned*)(BG + s * 136 + cl) = (unsigned)o0 | ((unsigned)o1 << 16); }
                    else { *(LAS unsigned*)(CG + s * 136 + cl) = (unsigned)o0 | ((unsigned)o1 << 16); }
                }
            }
        }
        __syncthreads();
        blk_mma<4, 4, 4>(CG, 136, BG, 136, C.wid, C.lane, [=](int r0, int col, const f32x4& acc) {
#pragma unroll
            for (int jj = 0; jj < 4; ++jj) CBm[(r0 + jj) * 68 + col] = acc[jj];
        });
        u32x4 s0r[2];
        { const bf16_t* src = MST + (size_t)slot_of(ci.b, 2 * g, 0, cpos_of(ci, 0)) * 8192;
#pragma unroll
          for (int k = 0; k < 2; ++k) { const int e = C.tid + 512 * k; s0r[k] = *(const u32x4*)(src + (e >> 4) * 128 + (e & 15) * 8); } }
        for (int hh = 0; hh < 2; ++hh) {
            MO_RELAUNDER(); fr = C.lane & 15; fq = C.lane >> 4;
            const int h = 2 * g + hh;
            f32x4 yacc[2] = {{0.f, 0.f, 0.f, 0.f}, {0.f, 0.f, 0.f, 0.f}};
            unsigned short zr[2][4];
#pragma unroll
            for (int i = 0; i < 2; ++i) { const int tt = C.wid + 8 * i, tm = tt >> 2, tn = tt & 3;
#pragma unroll
                for (int j = 0; j < 4; ++j) zr[i][j] = P[(size_t)(ci.row0 + tm * 16 + fq * 4 + j) * NP + OFF_C + h * 64 + tn * 16 + fr]; }
            for (int d = 0; d < 2; ++d) {
                const int dh = d * 4 + h;
                __syncthreads();
                for (int e = C.tid; e < 4096; e += 512) { const int l = e >> 6, s = e & 63; const bool ok = d ? (s >= l) : (s <= l);
                    MP[l * 72 + s] = ok ? f2bf(CBm[l * 68 + s] * fexp(CSI[dh * 64 + l] - CSI[dh * 64 + s]) * DT[dh * 64 + s]) : (unsigned short)0; }
#pragma unroll
                for (int k = 0; k < 2; ++k) { const int e = C.tid + 512 * k; *(LAS u32x4*)(S0 + (e >> 4) * 136 + (e & 15) * 8) = s0r[k]; }
                if (!(hh == 1 && d == 1)) { const int nh = d ? h + 1 : h, nd = d ^ 1; const bf16_t* src = MST + (size_t)slot_of(ci.b, nh, nd, cpos_of(ci, nd)) * 8192;
#pragma unroll
                    for (int k = 0; k < 2; ++k) { const int e = C.tid + 512 * k; s0r[k] = *(const u32x4*)(src + (e >> 4) * 128 + (e & 15) * 8); } }
                __syncthreads();
#pragma unroll
                for (int i = 0; i < 2; ++i) { const int tt = C.wid + 8 * i, tm = tt >> 2, tn = tt & 3;
                    f32x4 a1 = {0.f, 0.f, 0.f, 0.f}, a2 = {0.f, 0.f, 0.f, 0.f};
#pragma unroll
                    for (int ks = 0; ks < 2; ++ks) a1 = __builtin_amdgcn_mfma_f32_16x16x32_bf16(*(const LAS bf16x8*)(MP + (tm * 16 + fr) * 72 + ks * 32 + fq * 8),
                                                                                                 *(const LAS bf16x8*)(XT + (hh * 64 + tn * 16 + fr) * 72 + ks * 32 + fq * 8), a1, 0, 0, 0);
#pragma unroll
                    for (int ks = 0; ks < 4; ++ks) a2 = __builtin_amdgcn_mfma_f32_16x16x32_bf16(*(const LAS bf16x8*)(CG + (tm * 16 + fr) * 136 + ks * 32 + fq * 8),
                                                                                                 *(const LAS bf16x8*)(S0 + (tn * 16 + fr) * 136 + ks * 32 + fq * 8), a2, 0, 0, 0);
#pragma unroll
                    for (int j = 0; j < 4; ++j) yacc[i][j] += a1[j] + a2[j] * fexp(CSI[dh * 64 + tm * 16 + fq * 4 + j]);
                }
            }
            const float dsk = C.in[22][layer * 4 + h];
#pragma unroll
            for (int i = 0; i < 2; ++i) { const int tt = C.wid + 8 * i, tm = tt >> 2, tn = tt & 3;
#pragma unroll
                for (int j = 0; j < 4; ++j) { const int l = tm * 16 + fq * 4 + j, p = tn * 16 + fr, c = h * 64 + p;
                    const float xs = bf2f(XT[(hh * 64 + p) * 72 + l]);
                    const float z = bf2f(zr[i][j]);
                    const float pre = (yacc[i][j] + dsk * xs) * silu(z);
                    YPRE[l * 264 + c] = f2bf(pre);
                    float q = pre * pre; q += __shfl_xor(q, 1); q += __shfl_xor(q, 2); q += __shfl_xor(q, 4); q += __shfl_xor(q, 8);
                    if (fr == 0) SSQ[l * 16 + h * 4 + tn] = q; }
            }
        }
    }
    __syncthreads();
    {
        const int l = C.tid >> 3, sub = C.tid & 7; float ss = 0.f;
#pragma unroll
        for (int i = 0; i < 16; ++i) ss += SSQ[l * 16 + i];
        const float rs = rsqrtf(ss * (1.f / 256.f) + 1e-6f);
        const float* ng = C.in[23] + layer * 256 + sub * 32;
        bf16_t* dst = YC + (size_t)(ci.row0 + l) * DM + 512 + sub * 32;
#pragma unroll
        for (int i = 0; i < 32; i += 2) { const float a = bf2f(YPRE[l * 264 + sub * 32 + i]) * rs * ng[i], b = bf2f(YPRE[l * 264 + sub * 32 + i + 1]) * rs * ng[i + 1]; *(unsigned*)(dst + i) = pk2(a, b); }
    }
    __syncthreads();
}

constexpr int D3_G2T = 0, D3_SG = 69632, D3_VL = 87040, D3_BON = 120832;
__device__ __forceinline__ void load_g2t(const Ctx& C, int layer) {
    LAS bf16_t* G2T = (LAS bf16_t*)(C.lds + D3_G2T); const float* g2 = C.in[30] + (size_t)layer * 128 * 256;
    for (int e = C.tid; e < 128 * 256; e += 512) { const int r = e >> 8, c = e & 255; G2T[c * 136 + r] = f2bf(g2[e]); }
}
__device__ __forceinline__ float lerp_d(const bf16_t* P, const ChunkInfo& ci, int row, int j, const float* mup, const float* mun) {
    const bf16_t* pp = P + (size_t)row * NP + OFF_D + j;
    const bool okp = row - 1 >= ci.lo, okn = row + 1 < ci.hi;
    const float x = bf2f(*pp), xpv = bf2f(*(okp ? pp - NP : pp)), xnv = bf2f(*(okn ? pp + NP : pp)); const float xp = okp ? xpv : 0.f, xn = okn ? xnv : 0.f;
    return x + mup[j] * (xp - x) + mun[j] * (xn - x);
}
__device__ __forceinline__ void item_rwkv_out(const Ctx& C, int layer, int gc) {
    const ChunkInfo ci = chunk_info(gc);
    const bf16_t* P = (const bf16_t*)(C.ws + WS_P); bf16_t* YC = (bf16_t*)(C.ws + WS_ACT);
    const float* mup = C.in[24] + layer * 1152; const float* mun = C.in[25] + layer * 1152;
    LAS bf16_t* G2T = (LAS bf16_t*)(C.lds + D3_G2T); LAS bf16_t* SG = (LAS bf16_t*)(C.lds + D3_SG);
    int ln_ = C.lane; asm volatile("" : "+v"(ln_));
    const int fr = ln_ & 15, fq = ln_ >> 4;
    __syncthreads();
    for (int e = C.tid; e < 64 * 128; e += 512) { const int l = e >> 7, r = e & 127; SG[l * 136 + r] = f2bf(sigm(lerp_d(P, ci, ci.row0 + l, 1024 + r, mup, mun))); }
    LAS bf16_t* VL = (LAS bf16_t*)(C.lds + D3_VL); LAS float* BONS = (LAS float*)(C.lds + D3_BON);
    for (int e = C.tid; e < 64 * 256; e += 512) { const int l = e >> 8, c = e & 255; VL[l * 264 + c] = f2bf(lerp_d(P, ci, ci.row0 + l, 512 + c, mup, mun)); }
    if (C.tid < 256) { const int l = C.tid >> 2, hh = C.tid & 3; const float* bp = (const float*)(C.ws + WS_BON) + (size_t)(ci.row0 + l) * 8 + hh * 2; BONS[l * 4 + hh] = bp[0] + bp[1]; }
    __syncthreads();
    const int h = C.wid >> 1, tmb = (C.wid & 1) * 2;
    const bf16_t* Ryg = (const bf16_t*)(C.ws + WS_RY); const bf16_t* Ylg = (const bf16_t*)(C.ws + WS_RL); const bf16_t* Hg = (const bf16_t*)(C.ws + WS_RH);
    const float* BON = (const float*)(C.ws + WS_BON);
#pragma unroll
    for (int ti = 0; ti < 2; ++ti) {
        const int tm = tmb + ti;
        f32x4 gacc[4], yacc[4];
#pragma unroll
        for (int tn = 0; tn < 4; ++tn) { f32x4 a = {0.f, 0.f, 0.f, 0.f};
#pragma unroll
            for (int ks = 0; ks < 4; ++ks) a = __builtin_amdgcn_mfma_f32_16x16x32_bf16(*(const LAS bf16x8*)(SG + (tm * 16 + fr) * 136 + ks * 32 + fq * 8),
                                                                                        *(const LAS bf16x8*)(G2T + (h * 64 + tn * 16 + fr) * 136 + ks * 32 + fq * 8), a, 0, 0, 0);
            gacc[tn] = a; yacc[tn] = (f32x4){0.f, 0.f, 0.f, 0.f}; }
#pragma unroll
        for (int d = 0; d < 2; ++d) {
            const size_t slot = (size_t)slot_of(ci.b, h, d, cpos_of(ci, d));
            const int arow = d ? 63 - (tm * 16 + fr) : tm * 16 + fr;
            bf16x8 af[2];
#pragma unroll
            for (int ks = 0; ks < 2; ++ks) af[ks] = *(const bf16x8*)(Ryg + slot * 4096 + arow * 64 + ks * 32 + fq * 8);
#pragma unroll
            for (int tn = 0; tn < 4; ++tn) {
                f32x4 a;
                if (d == 0) { const u32x2 yl = *(const u32x2*)(Ylg + slot * 4096 + (tn * 16 + fr) * 64 + tm * 16 + fq * 4); a = (f32x4){bflo(yl.x), bfhi(yl.x), bflo(yl.y), bfhi(yl.y)}; }
                else { const u32x2 yl = *(const u32x2*)(Ylg + slot * 4096 + (tn * 16 + fr) * 64 + 60 - (tm * 16 + fq * 4)); a = (f32x4){bfhi(yl.y), bflo(yl.y), bfhi(yl.x), bflo(yl.x)}; }
#pragma unroll
                for (int ks = 0; ks < 2; ++ks) a = __builtin_amdgcn_mfma_f32_16x16x32_bf16(af[ks], *(const bf16x8*)(Hg + slot * 4096 + (tn * 16 + fr) * 64 + ks * 32 + fq * 8), a, 0, 0, 0);
                yacc[tn] += a;
            }
        }
#pragma unroll
        for (int j = 0; j < 4; ++j) {
            const int l = tm * 16 + fq * 4 + j, row = ci.row0 + l;
            float s = (yacc[0][j] + yacc[1][j]) + (yacc[2][j] + yacc[3][j]);
            s += __shfl_xor(s, 1); s += __shfl_xor(s, 2); s += __shfl_xor(s, 4); s += __shfl_xor(s, 8);
            const float mu = s * (1.f / 64.f);
            float q = 0.f;
#pragma unroll
            for (int tn = 0; tn < 4; ++tn) { const float dd = yacc[tn][j] - mu; q += dd * dd; }
            q += __shfl_xor(q, 1); q += __shfl_xor(q, 2); q += __shfl_xor(q, 4); q += __shfl_xor(q, 8);
            const float rs = rsqrtf(q * (1.f / 64.f) + 64e-5f);
            const float bon = BONS[l * 4 + h];
#pragma unroll
            for (int tn = 0; tn < 4; ++tn) { const int c = h * 64 + tn * 16 + fr;
                const float yn = (yacc[tn][j] - mu) * rs * C.in[34][layer * 256 + c] + C.in[35][layer * 256 + c];
                const float vv = bf2f(VL[l * 264 + c]);
                YC[(size_t)row * DM + 768 + c] = f2bf((yn + bon * vv) * gacc[tn][j]); }
        }
    }
}

__device__ __forceinline__ unsigned ordf(float f) { const unsigned u = __float_as_uint(f); return u ^ ((u >> 31) ? 0xFFFFFFFFu : 0x80000000u); }
__device__ __forceinline__ unsigned wave_max_u32(unsigned v) {
    unsigned t;
    t = (unsigned)__builtin_amdgcn_update_dpp((int)v, (int)v, 0xB1, 0xF, 0xF, false); v = t > v ? t : v;
    t = (unsigned)__builtin_amdgcn_update_dpp((int)v, (int)v, 0x4E, 0xF, 0xF, false); v = t > v ? t : v;
    t = (unsigned)__builtin_amdgcn_update_dpp((int)v, (int)v, 0x141, 0xF, 0xF, false); v = t > v ? t : v;
    t = (unsigned)__builtin_amdgcn_update_dpp((int)v, (int)v, 0x140, 0xF, 0xF, false); v = t > v ? t : v;
    t = (unsigned)__builtin_amdgcn_update_dpp((int)v, (int)v, 0x142, 0xA, 0xF, false); v = t > v ? t : v;
    t = (unsigned)__builtin_amdgcn_update_dpp((int)v, (int)v, 0x143, 0xC, 0xF, false); v = t > v ? t : v;
    return (unsigned)__builtin_amdgcn_readlane((int)v, 63);
}
constexpr int SEL_K1 = 0, SEL_K2 = 34816;
__device__ __forceinline__ float unordf(unsigned k) { return __uint_as_float((k & 0x80000000u) ? (k ^ 0x80000000u) : ~k); }
template <int N> __device__ __forceinline__ void bitonic_sort_desc(unsigned (&x)[N]) {
#pragma unroll
    for (int k = 2; k <= N; k <<= 1)
#pragma unroll
        for (int j = k >> 1; j > 0; j >>= 1)
#pragma unroll
            for (int i = 0; i < N; ++i) { const int l = i ^ j;
                if (l > i) { const unsigned p = x[i], q = x[l]; const unsigned hi = p > q ? p : q, lo = p > q ? q : p; if ((i & k) == 0) { x[i] = hi; x[l] = lo; } else { x[i] = lo; x[l] = hi; } } }
}
__device__ __forceinline__ void merge_top16(unsigned (&a)[16], const unsigned (&b)[16]) {
#pragma unroll
    for (int i = 0; i < 16; ++i) a[i] = a[i] > b[15 - i] ? a[i] : b[15 - i];
#pragma unroll
    for (int j = 8; j > 0; j >>= 1)
#pragma unroll
        for (int i = 0; i < 16; ++i) { const int l = i ^ j; if (l > i) { const unsigned p = a[i], q = a[l]; a[i] = p > q ? p : q; a[l] = p > q ? q : p; } }
}
__device__ __forceinline__ void ph_select(const Ctx& C, int layer, int nrows) {
    const bf16_t* Q = (const bf16_t*)(C.ws + WS_Q); int* SELI = (int*)(C.ws + WS_SELI); float* SELG = (float*)(C.ws + WS_SELG);
    LAS bf16_t* K1 = (LAS bf16_t*)(C.lds + SEL_K1); LAS bf16_t* K2 = (LAS bf16_t*)(C.lds + SEL_K2);
    {
        const float* k1 = C.in[37] + (size_t)layer * 128 * 128; const float* k2 = C.in[38] + (size_t)layer * 128 * 128;
        for (int e = C.tid; e < 4096; e += 512) { const int r = e >> 5, c4 = (e & 31) * 4; const f32x4 a = *(const f32x4*)(k1 + r * 128 + c4), b = *(const f32x4*)(k2 + r * 128 + c4);
            u32x2 oa, ob; oa.x = pk2(a.x, a.y); oa.y = pk2(a.z, a.w); ob.x = pk2(b.x, b.y); ob.y = pk2(b.z, b.w);
            *(LAS u32x2*)(K1 + r * 136 + c4) = oa; *(LAS u32x2*)(K2 + r * 136 + c4) = ob; }
    }
    __syncthreads();
    const int nunits = (nrows / 16) * 8;
    for (int u = C.bid * 8 + C.wid; u < nunits; u += C.G * 8) {
        int ln_ = C.lane; asm volatile("" : "+v"(ln_));
        const int fr = ln_ & 15, fq = ln_ >> 4;
        const int tile = u >> 3, h = u & 7, row = tile * 16 + fr;
        const bf16_t* qp = Q + (size_t)row * 2048 + h * 256 + fq * 8;
        bf16x8 qf[8];
#pragma unroll
        for (int i = 0; i < 8; ++i) qf[i] = *(const bf16x8*)(qp + i * 32);
        unsigned T[2][16];
#pragma unroll
        for (int half = 0; half < 2; ++half) {
            const LAS bf16_t* K = half ? K2 : K1;
            unsigned lo16[16], hi16[16];
#pragma unroll
            for (int kt = 0; kt < 8; ++kt) {
                f32x4 acc = {0.f, 0.f, 0.f, 0.f};
#pragma unroll
                for (int ks = 0; ks < 4; ++ks) acc = __builtin_amdgcn_mfma_f32_16x16x32_bf16(*(const LAS bf16x8*)(K + (kt * 16 + fr) * 136 + ks * 32 + fq * 8), qf[half * 4 + ks], acc, 0, 0, 0);
#pragma unroll
                for (int j = 0; j < 4; ++j) { const unsigned key = (ordf(acc[j]) & ~0x7Fu) | (unsigned)(127 - (kt * 16 + fq * 4 + j));
                    if (kt < 4) lo16[kt * 4 + j] = key; else hi16[(kt - 4) * 4 + j] = key; }
            }
            bitonic_sort_desc<16>(lo16); bitonic_sort_desc<16>(hi16); merge_top16(lo16, hi16);
#pragma unroll
            for (int rnd = 16; rnd <= 32; rnd <<= 1) { unsigned o[16];
#pragma unroll
                for (int i = 0; i < 16; ++i) o[i] = (unsigned)__shfl_xor((int)lo16[i], rnd);
                merge_top16(lo16, o); }
#pragma unroll
            for (int i = 0; i < 16; ++i) T[half][i] = lo16[i];
        }
        unsigned ck[50]; unsigned R0[16];
        {
            int id = 0;
#pragma unroll
            for (int a = 0; a < 16; ++a) {
                const float va = unordf(T[0][a] & ~0x7Fu);
#pragma unroll
                for (int b = 0; b < 16; ++b) if ((a + 1) * (b + 1) <= 16) { ck[id] = (ordf(va + unordf(T[1][b] & ~0x7Fu)) & ~0x3Fu) | (unsigned)(63 - id); ++id; }
            }
        }
#pragma unroll
        for (int i = 0; i < 16; ++i) R0[i] = ck[i];
        {
            int base = 16;
#pragma unroll
            for (int a = 1; a < 8; ++a) { const int n = 16 / (a + 1); unsigned rw[16];
#pragma unroll
                for (int i = 0; i < 16; ++i) rw[i] = i < n ? ck[base + i] : 0u;
                merge_top16(R0, rw); base += n; }
            unsigned rw[16];
#pragma unroll
            for (int i = 0; i < 16; ++i) rw[i] = i < 8 ? ck[base + i] : 0u;
            merge_top16(R0, rw);
        }
        const unsigned thr = R0[15]; const float mx = unordf(R0[0] & ~0x3Fu);
        float sum = 0.f;
#pragma unroll
        for (int c = 0; c < 50; ++c) sum += ck[c] >= thr ? __expf(unordf(ck[c] & ~0x3Fu) - mx) : 0.f;
        const float rsum = 1.f / sum;
        int* oi = SELI + ((size_t)row * 8 + h) * 16; float* og = SELG + ((size_t)row * 8 + h) * 16;
        {
            int id = 0, cnt = 0;
#pragma unroll
            for (int a = 0; a < 16; ++a)
#pragma unroll
                for (int b = 0; b < 16; ++b) if ((a + 1) * (b + 1) <= 16) {
                    if (ck[id] >= thr) { if (fq == 0 && cnt < 16) { oi[cnt] = (127 - (int)(T[0][a] & 0x7Fu)) * 128 + (127 - (int)(T[1][b] & 0x7Fu)); og[cnt] = __expf(unordf(ck[id] & ~0x3Fu) - mx) * rsum; } ++cnt; }
                    ++id; }
        }
    }
}

struct R16 { float v[16]; };
__device__ __forceinline__ R16 load_r16_f32(const float* p, int lane) { R16 r;
#pragma unroll
    for (int k = 0; k < 4; ++k) { const f32x4 a = *(const f32x4*)(p + 16 * lane + 4 * k); r.v[4 * k] = a.x; r.v[4 * k + 1] = a.y; r.v[4 * k + 2] = a.z; r.v[4 * k + 3] = a.w; }
    return r; }
__device__ __forceinline__ void store_r16_f32(float* p, int lane, const R16& r) {
#pragma unroll
    for (int k = 0; k < 4; ++k) *(f32x4*)(p + 16 * lane + 4 * k) = (f32x4){r.v[4 * k], r.v[4 * k + 1], r.v[4 * k + 2], r.v[4 * k + 3]}; }
__device__ __forceinline__ R16 load_r16_bf16(const bf16_t* p, int lane) { R16 r;
#pragma unroll
    for (int k = 0; k < 2; ++k) { const u32x4 a = *(const u32x4*)(p + 16 * lane + 8 * k);
        r.v[8 * k] = bflo(a.x); r.v[8 * k + 1] = bfhi(a.x); r.v[8 * k + 2] = bflo(a.y); r.v[8 * k + 3] = bfhi(a.y); r.v[8 * k + 4] = bflo(a.z); r.v[8 * k + 5] = bfhi(a.z); r.v[8 * k + 6] = bflo(a.w); r.v[8 * k + 7] = bfhi(a.w); }
    return r; }
__device__ __forceinline__ void store_r16_bf16(bf16_t* p, int lane, const R16& r) {
#pragma unroll
    for (int k = 0; k < 2; ++k) { u32x4 a; a.x = pk2(r.v[8 * k], r.v[8 * k + 1]); a.y = pk2(r.v[8 * k + 2], r.v[8 * k + 3]); a.z = pk2(r.v[8 * k + 4], r.v[8 * k + 5]); a.w = pk2(r.v[8 * k + 6], r.v[8 * k + 7]);
        *(u32x4*)(p + 16 * lane + 8 * k) = a; } }
typedef float f32x2p __attribute__((ext_vector_type(2)));
struct PeerHdr { int idx0, idx1; float su0, su1, gsv0, gsv1; };
__device__ __forceinline__ void ph_peer(const Ctx& C, int layer, int nrows, bool last, bool store = true, int idmask = 0x3FFF) {
    const bf16_t* F = (const bf16_t*)(C.ws + WS_ACT); bf16_t* XN = (bf16_t*)(C.ws + WS_ACT);
    const unsigned char* UB = C.ws + WS_UB; const unsigned char* VB = C.ws + WS_VB; const float* SU = (const float*)(C.ws + WS_SU); const float* SV = (const float*)(C.ws + WS_SV);
    const int* SELI = (const int*)(C.ws + WS_SELI); const float* SELG = (const float*)(C.ws + WS_SELG);
    float* H = (float*)(C.ws + WS_H); const float* MOD = (const float*)(C.ws + WS_MOD);
    const int step = C.G * 8;
    auto load_hdr = [&](int tok, int L) { PeerHdr h; h.idx0 = SELI[(size_t)tok * 128 + L] & idmask; h.idx1 = SELI[(size_t)tok * 128 + 64 + L] & idmask;
        h.su0 = SU[h.idx0]; h.su1 = SU[h.idx1]; h.gsv0 = SELG[(size_t)tok * 128 + L] * SV[h.idx0]; h.gsv1 = SELG[(size_t)tok * 128 + 64 + L] * SV[h.idx1]; return h; };
    int tok = C.bid * 8 + C.wid;
    for (; tok < nrows; tok += step) {
        int L = C.lane; asm volatile("" : "+v"(L));
        const int myexp = ((L >> 5) & 1) * 4 + ((L >> 4) & 1) * 2 + ((L >> 3) & 1);
        const PeerHdr hd = load_hdr(tok, L);
        const u32x4 fpa = *(const u32x4*)(F + (size_t)tok * DM + 16 * L), fpb = *(const u32x4*)(F + (size_t)tok * DM + 16 * L + 8);
        f32x2p out[8];
#pragma unroll
        for (int i = 0; i < 8; ++i) out[i] = (f32x2p){0.f, 0.f};
        u32x4 ua[2][8], va[2][8];
#define PEER_LOAD(buf, bt) do { const int src_ = (bt) < 8 ? hd.idx0 : hd.idx1; const int l0_ = ((bt) & 7) * 8; _Pragma("unroll") for (int i = 0; i < 8; ++i) { const int ei = __builtin_amdgcn_readlane(src_, l0_ + i); \
            ua[buf][i] = *(const u32x4*)(UB + (size_t)ei * DM + 16 * L); va[buf][i] = *(const u32x4*)(VB + (size_t)ei * DM + 16 * L); } } while (0)
#define PEER_COMPUTE(buf, bt) do { const float susrc = (bt) < 8 ? hd.su0 : hd.su1, gsrc = (bt) < 8 ? hd.gsv0 : hd.gsv1; const int l0 = ((bt) & 7) * 8; float part[8]; \
            _Pragma("unroll") for (int i = 0; i < 8; ++i) { f32x2p acc = {0.f, 0.f}; _Pragma("unroll") for (int k = 0; k < 4; ++k) { \
                const f32x2p lo = __builtin_amdgcn_cvt_pk_f32_fp8((int)ua[buf][i][k], false), hi = __builtin_amdgcn_cvt_pk_f32_fp8((int)ua[buf][i][k], true); \
                const unsigned fw0 = (k < 2 ? fpa : fpb)[(2 * k) & 3], fw1 = (k < 2 ? fpa : fpb)[(2 * k + 1) & 3]; \
                acc += lo * (f32x2p){bflo(fw0), bfhi(fw0)}; acc += hi * (f32x2p){bflo(fw1), bfhi(fw1)}; } part[i] = acc.x + acc.y; } \
            float p4[4], p2[2], p1; \
            { const bool hi = (L & 32) != 0; _Pragma("unroll") for (int i = 0; i < 4; ++i) { const float send = hi ? part[i] : part[i + 4]; const float recv = __shfl_xor(send, 32); p4[i] = (hi ? part[i + 4] : part[i]) + recv; } } \
            { const bool hi = (L & 16) != 0; _Pragma("unroll") for (int i = 0; i < 2; ++i) { const float send = hi ? p4[i] : p4[i + 2]; const float recv = __shfl_xor(send, 16); p2[i] = (hi ? p4[i + 2] : p4[i]) + recv; } } \
            { const bool hi = (L & 8) != 0; const float send = hi ? p2[0] : p2[1]; const float recv = __shfl_xor(send, 8); p1 = (hi ? p2[1] : p2[0]) + recv; } \
            p1 += __shfl_xor(p1, 4); p1 += __shfl_xor(p1, 2); p1 += __shfl_xor(p1, 1); \
            const float act = gelu_tanh(p1 * __shfl(susrc, l0 + myexp)) * __shfl(gsrc, l0 + myexp); \
            _Pragma("unroll") for (int i = 0; i < 8; ++i) { \
                const float a = __uint_as_float((unsigned)__builtin_amdgcn_readlane((int)__float_as_uint(act), ((i >> 2) & 1) * 32 + ((i >> 1) & 1) * 16 + (i & 1) * 8)); const f32x2p a2 = {a, a}; \
                _Pragma("unroll") for (int k = 0; k < 4; ++k) { out[2 * k] += a2 * __builtin_amdgcn_cvt_pk_f32_fp8((int)va[buf][i][k], false); out[2 * k + 1] += a2 * __builtin_amdgcn_cvt_pk_f32_fp8((int)va[buf][i][k], true); } } } while (0)
        PEER_LOAD(0, 0);
        for (int bt = 0; bt < 16; bt += 2) {
            PEER_LOAD(1, bt + 1);
            PEER_COMPUTE(0, bt);
            if (bt + 2 < 16) PEER_LOAD(0, bt + 2);
            PEER_COMPUTE(1, bt + 1);
        }
#undef PEER_LOAD
#undef PEER_COMPUTE
        const float* m = MOD + ((size_t)layer * 3 + which_of(tok)) * 6144;
        R16 hr = load_r16_f32(H + (size_t)tok * DM, L); const R16 g5 = load_r16_f32(m + 5 * 1024, L);
#pragma unroll
        for (int i = 0; i < 8; ++i) { hr.v[2 * i] += g5.v[2 * i] * out[i].x; hr.v[2 * i + 1] += g5.v[2 * i + 1] * out[i].y; }
        float ss = 0.f;
#pragma unroll
        for (int i = 0; i < 16; ++i) ss += hr.v[i] * hr.v[i];
        const float rs = rsqrtf(wave_sum(ss) * (1.f / 1024.f) + 1e-6f);
        if (!store) continue;
        if (!last) {
            store_r16_f32(H + (size_t)tok * DM, L, hr);
            const float* m2 = MOD + ((size_t)(layer + 1) * 3 + which_of(tok)) * 6144;
            const R16 gg = load_r16_f32(C.in[6] + (layer + 1) * 1024, L), sh = load_r16_f32(m2, L), sc = load_r16_f32(m2 + 1024, L); R16 o;
#pragma unroll
            for (int i = 0; i < 16; ++i) o.v[i] = (hr.v[i] * rs * gg.v[i]) * (1.f + sc.v[i]) + sh.v[i];
            store_r16_bf16(XN + (size_t)tok * DM, L, o);
        } else {
            const R16 fg = load_r16_f32(C.in[41], L); R16 o;
#pragma unroll
            for (int i = 0; i < 16; ++i) o.v[i] = hr.v[i] * rs * fg.v[i];
            store_r16_f32(C.out + (size_t)tok * DM, L, o);
        }
    }
}

#define PM(n) ((MASK >> (n)) & 1u)
constexpr int NPH_LAYER = 9, NPH = 2 + 2 * NPH_LAYER;
template <unsigned MASK> __global__ void __launch_bounds__(512, 2) hybrid_fwd(Args args) {
    extern __shared__ __attribute__((aligned(16))) unsigned char lds_raw[];
    Ctx C0; C0.in = args.in; C0.out = args.out; C0.ws = args.ws; C0.lds = (lds_t)lds_raw;
    C0.wid = __builtin_amdgcn_readfirstlane((int)threadIdx.x >> 6); C0.tid = 0; C0.lane = 0; C0.bid = blockIdx.x; C0.G = gridDim.x;
#define MK_LANE() ((int)__builtin_amdgcn_mbcnt_hi(~0u, __builtin_amdgcn_mbcnt_lo(~0u, 0u)))
#define MK_TID() (C0.wid * 64 + MK_LANE())
    const Ctx& C = C0;
    const int lo = args.ph_lo, hi = args.ph_hi;
    const bool multi = (hi - lo) > 1;
    XcdBarrier bar; bar.w0 = (unsigned)C0.wid; bar.bar = (unsigned*)(C.ws + WS_CTL); bar.x = 0; bar.st = (volatile LAS unsigned*)(C.lds + LDS_XB);
    if (multi) {
        if (C0.wid == 0 && MK_LANE() == 0) *(LAS u32x4*)(C.lds + LDS_XB) = (u32x4){0u, 0u, 0u, 0u};
        __syncthreads();
        bar = xcd_barrier_post((unsigned*)(C.ws + WS_CTL), (volatile LAS unsigned*)(C.lds + LDS_XB), (unsigned)C0.wid);
    }
#define IN(k) (lo <= (k) && (k) < hi)
#define PHASE_CTX(c) Ctx c = C0; { int t_ = MK_TID(); asm volatile("" : "+v"(t_)); c.tid = t_; c.lane = t_ & 63; c.wid = __builtin_amdgcn_readfirstlane(t_ >> 6); }
#ifndef MK_REPEAT
#define MK_REPEAT 0u
#endif
#define RP(k) ((MK_REPEAT >> (k)) & 1u)
#define STAMP(k) do {} while (0)
#define SEAM(k) do { if (IN(k) && IN((k) + 1)) xcd_barrier(bar); STAMP((k) + 1); } while (0)
    STAMP(0);
    if (RP(10)) { for (int i = 0; i < 20; ++i) xcd_barrier(bar); }
    if (PM(0) && IN(0)) { PHASE_CTX(c); ph_prologue(c); if (RP(9)) { xcd_barrier(bar); ph_prologue(c); } } SEAM(0);
    if (PM(1) && IN(1)) { PHASE_CTX(c); ph_norm(c, 0, c.in[6], 0, NROW); } SEAM(1);
    for (int layer = 0; layer < 2; ++layer) {
        const int base = 2 + layer * NPH_LAYER;
        const bool emit = (layer == 0);
        const int nrows = emit ? NROW : NLAT;
        if (PM(2) && IN(base + 0)) {
            pg8::Gemm g{(const bf16_t*)(C.ws + WS_ACT), (const bf16_t*)(C.ws + WS_WIN) + (size_t)layer * NP * DM, NROW, NP, DM};
            pg8::StaticOrder S; S.init(NROW, NP, C.G, C.bid);
            pg8::EpiBf16<0> E{(bf16_t*)(C.ws + WS_P), NP, nullptr, 0, 0};
            pg8::gemm_phase<pg8::EpiBf16<0>, pg8::StaticOrder, false>(C.lds, g, S, E, nullptr, MK_TID());
            if (RP(0)) { xcd_barrier(bar); pg8::gemm_phase<pg8::EpiBf16<0>, pg8::StaticOrder, false>(C.lds, g, S, E, nullptr, MK_TID()); }
            { const int nfull = (NROW / 256) * (NP / 256) - ((NROW / 256) * (NP / 256) / C.G) * C.G; PHASE_CTX(c); if (c.bid >= nfull) convert_tables(c, layer, c.bid - nfull, c.G - nfull); }
        }
        SEAM(base + 0);
        if (PM(3) && IN(base + 1)) {
            const int nD = 2112, nC = 264, nB = emit ? 132 : 128, nA = emit ? 264 : 256, tot = nD + nC + nB + nA;
            for (int rep = 0; rep < (RP(1) ? 2 : 1); ++rep) {
            if (rep) xcd_barrier(bar);
#define MK_QUEUE(TYPE_IDX, COUNT, FIRST, CALL) { unsigned* ctr = (unsigned*)(c.ws + 49152) + 64 * ((layer * 2 + rep) * 4 + (TYPE_IDX)); LAS int* nxt = (LAS int*)(c.lds + LDS_XB + 32); \
                for (int it = (FIRST); it < (COUNT); ) { CALL; __syncthreads(); if (c.tid == 0) *nxt = (int)c.G + (int)__hip_atomic_fetch_add(ctr, 1u, __ATOMIC_RELAXED, __HIP_MEMORY_SCOPE_AGENT); __syncthreads(); it = *nxt; } }
            if (PM(12)) { PHASE_CTX(c); MK_QUEUE(1, nC, c.bid, { item_mamba_local(c, layer, it); if (RP(13)) item_mamba_local(c, layer, it); }) }
            if (PM(13)) { PHASE_CTX(c); MK_QUEUE(2, nB, c.bid, { item_chunkmlp(c, layer, it); if (RP(14)) item_chunkmlp(c, layer, it); }) }
            if (PM(14)) { PHASE_CTX(c); MK_QUEUE(3, nA, c.bid, { item_conformer(c, layer, it); if (RP(15)) item_conformer(c, layer, it); }) }
            if (PM(11)) { PHASE_CTX(c); D1Pre pre; pre.hd = -1; MK_QUEUE(0, nD, c.bid, item_rwkv_local(c, layer, it, pre, -1)) }
#undef MK_QUEUE
            }
        }
        SEAM(base + 1);
        if (PM(4) && IN(base + 2)) { PHASE_CTX(c); if (RP(12)) { ph_scan(c, 1, args.ph_hi > 1000, false); xcd_barrier(bar); } ph_scan(c, RP(2) ? 2 : 1); }
        SEAM(base + 2);
        if (PM(5) && IN(base + 3)) {
            const int nc = nrows / 64;
            for (int rep = 0; rep < (RP(3) ? 2 : 1); ++rep) {
            if (rep) xcd_barrier(bar);
            if (PM(15)) { PHASE_CTX(c); load_g2t(c, layer); for (int it = c.bid; it < nc; it += c.G) item_rwkv_out(c, layer, it); }
            __syncthreads();
            if (PM(16)) { PHASE_CTX(c); for (int it = (c.bid + 128) % c.G; it < nc; it += c.G) item_mamba_out(c, layer, it); }
            __syncthreads();
            }
        }
        SEAM(base + 3);
        if (PM(6) && IN(base + 4)) {
            pg8::Gemm g{(const bf16_t*)(C.ws + WS_ACT), (const bf16_t*)(C.ws + WS_WOUT) + (size_t)layer * DM * DM, NLAT, DM, DM};
            pg8::StaticOrder S; S.init(NLAT, DM, C.G, C.bid);
            EpiResid E{(float*)(C.ws + WS_H), (const float*)(C.ws + WS_MOD) + (size_t)layer * 3 * 6144};
            pg8::gemm_phase<EpiResid, pg8::StaticOrder, false>(C.lds, g, S, E, nullptr, MK_TID());
            if (emit) {
                PHASE_CTX(c);
                for (int u = c.bid; u < 256; u += c.G) { const int tr = u >> 4, tc = u & 15;
                    float* Hc = (float*)(c.ws + WS_H) + (size_t)(NLAT + tr * 32) * DM + tc * 64;
                    const float* gate = (const float*)(c.ws + WS_MOD) + ((size_t)layer * 3 + 2) * 6144 + 2 * 1024 + tc * 64;
                    small_gemm_tile<2, 4>(c, (const bf16_t*)(c.ws + WS_ACT) + (size_t)(NLAT + tr * 32) * DM, (const bf16_t*)(c.ws + WS_WOUT) + (size_t)layer * DM * DM + (size_t)(tc * 64) * DM, DM,
                        [=](int r, int cc, const f32x4& acc) {
#pragma unroll
                            for (int j = 0; j < 4; ++j) Hc[(size_t)(r + j) * DM + cc] += gate[cc] * acc[j]; });
                }
            }
        }
        SEAM(base + 4);
        if (PM(7) && IN(base + 5)) { PHASE_CTX(c); for (int rep = 0; rep < (RP(5) ? 2 : 1); ++rep) { if (rep) xcd_barrier(bar); ph_norm(c, layer, c.in[7] + layer * 1024, 3, nrows); } }
        SEAM(base + 5);
        if (PM(8) && IN(base + 6)) {
            pg8::Gemm g{(const bf16_t*)(C.ws + WS_ACT), (const bf16_t*)(C.ws + WS_WQ) + (size_t)layer * 2048 * DM, NLAT, 2048, DM};
            pg8::StaticOrder S; S.init(NLAT, 2048, C.G, C.bid);
            pg8::EpiBf16<0> E{(bf16_t*)(C.ws + WS_Q), 2048, nullptr, 0, 0};
            pg8::gemm_phase<pg8::EpiBf16<0>, pg8::StaticOrder, false>(C.lds, g, S, E, nullptr, MK_TID());
            if (RP(6)) { xcd_barrier(bar); pg8::gemm_phase<pg8::EpiBf16<0>, pg8::StaticOrder, false>(C.lds, g, S, E, nullptr, MK_TID()); }
            if (emit) {
                PHASE_CTX(c);
                for (int u = c.bid; u < 256; u += c.G) { const int tr = u >> 5, tc = u & 31;
                    bf16_t* Qc = (bf16_t*)(c.ws + WS_Q) + (size_t)(NLAT + tr * 64) * 2048 + tc * 64;
                    small_gemm_tile<4, 4>(c, (const bf16_t*)(c.ws + WS_ACT) + (size_t)(NLAT + tr * 64) * DM, (const bf16_t*)(c.ws + WS_WQ) + (size_t)layer * 2048 * DM + (size_t)(tc * 64) * DM, DM,
                        [=](int r, int cc, const f32x4& acc) {
#pragma unroll
                            for (int j = 0; j < 4; ++j) Qc[(size_t)(r + j) * 2048 + cc] = f2bf(acc[j]); });
                }
            }
        }
        SEAM(base + 6);
        if (PM(9) && IN(base + 7)) { PHASE_CTX(c); ph_select(c, layer, nrows); if (RP(7)) { xcd_barrier(bar); ph_select(c, layer, nrows); } }
        SEAM(base + 7);
        if (PM(10) && IN(base + 8)) { PHASE_CTX(c); if (RP(8)) { ph_peer(c, layer, nrows, layer == 1, args.ph_hi > 1000); xcd_barrier(bar); } if (RP(11)) { ph_peer(c, layer, nrows, layer == 1, args.ph_hi > 1000, 1023); xcd_barrier(bar); } ph_peer(c, layer, nrows, layer == 1); }
        SEAM(base + 8);
    }
#undef IN
#undef SEAM
}
}


namespace mk {
struct LaunchEnt { unsigned mask; int ph; };
template <unsigned MASK> static bool prep_kernel() {
    return hipFuncSetAttribute((const void*)hybrid_fwd<MASK>, hipFuncAttributeMaxDynamicSharedMemorySize, LDS_BYTES) == hipSuccess;
}
template <unsigned MASK> static void launch_kernel(int grid, hipStream_t stream, const Args& a) {
    hipLaunchKernelGGL(hybrid_fwd<MASK>, dim3(grid), dim3(512), LDS_BYTES, stream, a);
}
}

#define CENSUS(off, n, kind, stage, lim) do {} while (0)
#ifndef MK_ONE_LAUNCH
#define MK_ONE_LAUNCH 1
#endif
extern "C" void kernel_launch(void* const* d_in, const int* in_sizes, int n_in, void* d_out, int out_size, void* d_ws, size_t ws_size, hipStream_t stream) {
    using namespace mk;
    static int grid = 0;
    if (grid == 0) {
        if (n_in != 42 || ws_size < WS_END) { fprintf(stderr, "kernel_launch: need 42 inputs and %zu bytes of workspace (got %d, %zu)\n", (size_t)WS_END, n_in, ws_size); grid = -1; return; }
        int dev = 0, cus = 0;
        if (hipGetDevice(&dev) != hipSuccess || hipDeviceGetAttribute(&cus, hipDeviceAttributeMultiprocessorCount, dev) != hipSuccess) { grid = -1; return; }
        bool ok = true;
#if MK_ONE_LAUNCH
        ok = ok && prep_kernel<0x1FFFFu>();
#else
        ok = ok && prep_kernel<0x0001u>() && prep_kernel<0x0002u>() && prep_kernel<0x0004u>() && prep_kernel<0x0808u>() && prep_kernel<0x1008u>() && prep_kernel<0x2008u>() && prep_kernel<0x4008u>()
                && prep_kernel<0x0010u>() && prep_kernel<0x8020u>() && prep_kernel<0x10020u>() && prep_kernel<0x0040u>() && prep_kernel<0x0080u>() && prep_kernel<0x0100u>() && prep_kernel<0x0200u>() && prep_kernel<0x0400u>();
#endif
        if (!ok) { fprintf(stderr, "kernel_launch: hipFuncSetAttribute failed\n"); grid = -1; return; }
        (void)hipGetLastError();
        grid = cus;
    }
    if (grid < 0) return;
    (void)hipMemsetAsync((char*)d_ws + WS_CTL, 0, 65536, stream);
    Args a{};
    for (int i = 0; i < 42; ++i) a.in[i] = (const float*)d_in[i];
    a.out = (float*)d_out; a.ws = (unsigned char*)d_ws;
#if MK_ONE_LAUNCH
    a.ph_lo = 0; a.ph_hi = NPH; launch_kernel<0x1FFFFu>(grid, stream, a);
#else
    a.ph_lo = 0; a.ph_hi = 1; launch_kernel<0x0001u>(grid, stream, a);
    CENSUS(WS_H, (size_t)NROW * DM, 0, 1, 1e4f); CENSUS(WS_MOD, 2 * 3 * 6144, 0, 1, 1e4f); CENSUS(WS_WIN, 2ull * NP * DM, 1, 1, 1e4f); CENSUS(WS_UB, 2ull * NEXP * DM, 1, 1, 1e4f);
    a.ph_lo = 1; a.ph_hi = 2; launch_kernel<0x0002u>(grid, stream, a);
    CENSUS(WS_ACT, (size_t)NROW * DM, 1, 2, 1e4f);
    for (int layer = 0; layer < 2; ++layer) {
        const int b = 2 + layer * NPH_LAYER;
        const int so = layer ? 100 : 0; (void)so;
        a.ph_lo = b + 0; a.ph_hi = b + 1; launch_kernel<0x0004u>(grid, stream, a);
        if (!layer) CENSUS(WS_P, (size_t)NROW * NP, 1, 3, 1e4f);
        a.ph_lo = b + 1; a.ph_hi = b + 2; launch_kernel<0x0808u>(grid, stream, a);
        if (!layer) { CENSUS(WS_RG, (size_t)NSLOT * 4096, 1, 4, 1e6f); CENSUS(WS_RJ, (size_t)NSLOT * 4096, 0, 5, 1e6f); CENSUS(WS_RY, (size_t)NSLOT * 4096 * 2, 1, 6, 1e6f); CENSUS(WS_BON, (size_t)NROW * 8, 0, 6, 1e6f); }
        launch_kernel<0x1008u>(grid, stream, a);
        if (!layer) { CENSUS(WS_MST, (size_t)NSLOT * 8192, 0, 7, 1e6f); CENSUS(WS_MCD, NSLOT, 0, 7, 1e6f); }
        launch_kernel<0x2008u>(grid, stream, a); launch_kernel<0x4008u>(grid, stream, a);
        a.ph_lo = b + 2; a.ph_hi = b + 3; launch_kernel<0x0010u>(grid, stream, a);
        if (!layer) { CENSUS(WS_MST, (size_t)NSLOT * 8192, 0, 8, 1e6f); CENSUS(WS_RH, (size_t)NSLOT * 4096, 1, 9, 1e6f); }
        a.ph_lo = b + 3; a.ph_hi = b + 4; launch_kernel<0x8020u>(grid, stream, a); launch_kernel<0x10020u>(grid, stream, a);
        if (!layer) CENSUS(WS_ACT, (size_t)NROW * DM, 1, 10, 1e4f);
        a.ph_lo = b + 4; a.ph_hi = b + 5; launch_kernel<0x0040u>(grid, stream, a);
        if (!layer) CENSUS(WS_H, (size_t)NROW * DM, 0, 11, 1e4f);
        a.ph_lo = b + 5; a.ph_hi = b + 6; launch_kernel<0x0080u>(grid, stream, a);
        a.ph_lo = b + 6; a.ph_hi = b + 7; launch_kernel<0x0100u>(grid, stream, a);
        if (!layer) CENSUS(WS_Q, (size_t)NROW * 2048, 1, 12, 1e4f);
        a.ph_lo = b + 7; a.ph_hi = b + 8; launch_kernel<0x0200u>(grid, stream, a);
        if (!layer) { CENSUS(WS_SELI, (size_t)NROW * 128, 2, 13, 0.f); CENSUS(WS_SELG, (size_t)NROW * 128, 0, 13, 2.f); }
        a.ph_lo = b + 8; a.ph_hi = b + 9; launch_kernel<0x0400u>(grid, stream, a);
        if (!layer) { CENSUS(WS_H, (size_t)NROW * DM, 0, 14, 1e4f); CENSUS(WS_ACT, (size_t)NROW * DM, 1, 15, 1e4f); }
    }
#endif
    (void)in_sizes; (void)out_size;
}
```

```cpp
#include <hip/hip_runtime.h>
#include <cstdio>
#include <cstdint>
namespace pg8 {
#define PG8_LAS __attribute__((address_space(3)))
typedef unsigned short bf16_t;
typedef short bf16x8 __attribute__((ext_vector_type(8)));
typedef float f32x4 __attribute__((ext_vector_type(4)));
typedef unsigned u32x4 __attribute__((ext_vector_type(4)));
constexpr int BM = 256, BK = 64, HALF = 128, HTB = HALF * BK * 2  , STAGE_BYTES = 8 * HTB, NXCD = 8, WGM = 8;

__host__ __device__ __forceinline__ int lds_byte(int r, int c) { const int st = (r >> 4) * 2 + (c >> 5), rr = r & 15, cc = c & 31, ob = rr * 64 + cc * 2; return st * 1024 + (ob ^ (((ob >> 9) & 1) << 5)); }
__host__ __device__ __forceinline__ void stage_rc(int b, int& R, int& C) { const int st = b / 1024, sb = b % 1024, swz = sb ^ (((sb >> 9) & 1) << 5); R = (st >> 1) * 16 + swz / 64; C = (st & 1) * 32 + (swz % 64) / 2; }
__host__ __device__ __forceinline__ int perm32(int rho) { const int n = rho >> 4, i = rho & 15; return 8 * (i >> 2) + 4 * n + (i & 3); }

struct Unit { int pm, pn; };
struct Gemm { const bf16_t* A; const bf16_t* Bt; int M, N, K; };

struct StaticOrder {
    int nM, nN, nwg, G, c;
    __host__ __device__ void init(int M, int N, int G_, int c_) { nM = M / BM; nN = N / BM; nwg = nM * nN; G = G_; c = c_; }
    __host__ __device__ bool next(int i, Unit& u) const {
        const long L = (long)i * G + c; if (L >= nwg) return false;
        int wgid = (int)L; { const int q = nwg / NXCD, r = nwg % NXCD, xcd = wgid % NXCD, off = wgid / NXCD; wgid = (xcd < r ? xcd * (q + 1) : r * (q + 1) + (xcd - r) * q) + off; }
        const int nig = WGM * nN, gid = wgid / nig, fm = gid * WGM, gsz = (nM - fm) < WGM ? (nM - fm) : WGM;
        u.pm = fm + ((wgid % nig) % gsz); u.pn = (wgid % nig) / gsz; return true;
    }
    __device__ __forceinline__ void a_ready(const Unit&) const {}
    __device__ __forceinline__ void done(const Unit&) const {}
};
struct CountedOrder : StaticOrder {
    const unsigned* ready; unsigned need; unsigned* tmo;
    __device__ __forceinline__ void a_ready(const Unit& u) const {
        if (threadIdx.x < 64) {
            const unsigned long long t0 = __builtin_amdgcn_s_memrealtime(); unsigned polls = 0;
            while ((unsigned)__builtin_amdgcn_readfirstlane(__hip_atomic_load(ready + 64 * u.pm, __ATOMIC_RELAXED, __HIP_MEMORY_SCOPE_AGENT)) < need) {
                if ((++polls & 255u) == 0u && __builtin_amdgcn_readfirstlane(__hip_atomic_load(tmo, __ATOMIC_RELAXED, __HIP_MEMORY_SCOPE_AGENT)) != 0u) break;
                if (__builtin_amdgcn_s_memrealtime() - t0 > 2000000ull) {
                    if (threadIdx.x == 0) { unsigned expect = 0u; __hip_atomic_compare_exchange_strong(tmo + 1, &expect, 0x600u | (unsigned)(u.pm & 0xff), __ATOMIC_RELAXED, __ATOMIC_RELAXED, __HIP_MEMORY_SCOPE_AGENT); __hip_atomic_store(tmo, 1u, __ATOMIC_RELAXED, __HIP_MEMORY_SCOPE_AGENT); }
                    break; }
                __builtin_amdgcn_s_sleep(2); }
            __builtin_amdgcn_fence(__ATOMIC_ACQUIRE, "agent");
            asm volatile("s_waitcnt vmcnt(0)" ::: "memory");
        }
#if !defined(BROKEN_HOOK_NO_BARRIER)
        asm volatile("" ::: "memory"); __builtin_amdgcn_s_barrier(); asm volatile("" ::: "memory");
#endif
    }
};

__device__ __forceinline__ unsigned cvt_pk_bf16(float lo, float hi) { unsigned r; asm volatile("v_cvt_pk_bf16_f32 %0, %1, %2" : "=v"(r) : "v"(lo), "v"(hi)); return r; }
typedef float f32x2 __attribute__((ext_vector_type(2)));
__device__ __forceinline__ f32x2 gelu_pk(f32x2 v) {
    const f32x2 av = __builtin_elementwise_abs(v), d = av * 0.2316418882f + 1.0f;
    f32x2 t; t.x = __builtin_amdgcn_rcpf(d.x); t.y = __builtin_amdgcn_rcpf(d.y);
    f32x2 q = t * 0.5307027145f + (-0.7265760135f); q = q * t + 0.7107068705f; q = q * t + (-0.142248368f); q = q * t + 0.127414796f; q = q * t;
    const f32x2 s = (v * v) * (-0.72134752044f);
    f32x2 e; e.x = __builtin_amdgcn_exp2f(s.x); e.y = __builtin_amdgcn_exp2f(s.y);
    const f32x2 m = v * (q * e), r = v - m;
    f32x2 o; o.x = v.x < 0.f ? m.x : r.x; o.y = v.y < 0.f ? m.y : r.y; return o;
}

struct EpiF32 {
    static constexpr bool PERM = false, AFTER_DRAIN = false;
    float* C; int ldc; const float* bias;
    __device__ __forceinline__ void operator()(const f32x4 (&acc)[2][2][4][2], const Unit& u, int wr, int wc, int fr, int fq) const {
        const int row0 = u.pm * BM + wr * 64 + fr, col0 = u.pn * BM + wc * 32 + 4 * fq;
        f32x4 bv[2][2];
#pragma unroll
        for (int bj = 0; bj < 2; ++bj)
#pragma unroll
            for (int n = 0; n < 2; ++n) bv[bj][n] = bias ? *(const f32x4*)(bias + col0 + bj * HALF + n * 16) : (f32x4){0.f, 0.f, 0.f, 0.f};
#pragma unroll
        for (int ai = 0; ai < 2; ++ai)
#pragma unroll
            for (int m = 0; m < 4; ++m) { float* rowp = C + (size_t)(row0 + ai * HALF + m * 16) * ldc + col0;
#pragma unroll
                for (int bj = 0; bj < 2; ++bj)
#pragma unroll
                    for (int n = 0; n < 2; ++n) *(f32x4*)(rowp + bj * HALF + n * 16) = acc[ai][bj][m][n] + bv[bj][n]; }
    }
};
template <int ACT  > struct EpiBf16 {
    static constexpr bool PERM = true, AFTER_DRAIN = false;
    bf16_t* O; int ldc; const float* bias; int split_cols; size_t split_stride;
    __device__ __forceinline__ void operator()(const f32x4 (&acc)[2][2][4][2], const Unit& u, int wr, int wc, int fr, int fq) const {
        const int row0 = u.pm * BM + wr * 64 + fr; int colt = u.pn * BM; bf16_t* base = O;
        if (split_cols) { const int t = colt / split_cols; base += (size_t)t * split_stride; colt -= t * split_cols; }
        const int col0 = colt + wc * 32 + 8 * fq, bcol0 = u.pn * BM + wc * 32 + 8 * fq;
        f32x4 bv[2][2];
#pragma unroll
        for (int bj = 0; bj < 2; ++bj)
#pragma unroll
            for (int n = 0; n < 2; ++n) bv[bj][n] = bias ? *(const f32x4*)(bias + bcol0 + bj * HALF + 4 * n) : (f32x4){0.f, 0.f, 0.f, 0.f};
#pragma unroll
        for (int ai = 0; ai < 2; ++ai)
#pragma unroll
            for (int m = 0; m < 4; ++m) { bf16_t* rowp = base + (size_t)(row0 + ai * HALF + m * 16) * ldc + col0;
#pragma unroll
                for (int bj = 0; bj < 2; ++bj) { f32x4 v0 = acc[ai][bj][m][0] + bv[bj][0], v1 = acc[ai][bj][m][1] + bv[bj][1];
                    if (ACT == 1) { f32x2 a = gelu_pk((f32x2){v0[0], v0[1]}), b = gelu_pk((f32x2){v0[2], v0[3]}), c = gelu_pk((f32x2){v1[0], v1[1]}), d = gelu_pk((f32x2){v1[2], v1[3]});
                        v0 = (f32x4){a.x, a.y, b.x, b.y}; v1 = (f32x4){c.x, c.y, d.x, d.y}; }
                    if (ACT == 2) {
#pragma unroll
                        for (int j = 0; j < 4; ++j) { v0[j] = 0.5f * v0[j] * (1.0f + erff(v0[j] * 0.70710678f)); v1[j] = 0.5f * v1[j] * (1.0f + erff(v1[j] * 0.70710678f)); } }
                    u32x4 w; w.x = cvt_pk_bf16(v0[0], v0[1]); w.y = cvt_pk_bf16(v0[2], v0[3]); w.z = cvt_pk_bf16(v1[0], v1[1]); w.w = cvt_pk_bf16(v1[2], v1[3]);
                    *(u32x4*)(rowp + bj * HALF) = w; } }
    }
};
template <class Epi, class Sched, bool STAMP = false>
__device__ __forceinline__ void gemm_phase(PG8_LAS unsigned char* lds, const Gemm g, const Sched& S, const Epi& E, unsigned long long* stamps, int tid_in) {
    int tid_ = tid_in; asm volatile("" : "+v"(tid_));
    const int tid = tid_, wid = __builtin_amdgcn_readfirstlane(tid >> 6), lane = tid & 63, wr = wid >> 2, wc = wid & 3, fr = lane & 15, fq = lane >> 4;
    const int K = g.K, nt = K / BK;
    int ts_lo = 0, ts_hi = 0, nts = 0; const unsigned long long rt_entry = STAMP ? (unsigned long long)wall_clock64() : 0ull;
#define PG8_STAMP() do { if (STAMP && wid == 0 && nts < 64) { const unsigned long long _c = (unsigned long long)clock64(); \
        ts_lo = (lane == nts) ? (int)(unsigned)_c : ts_lo; ts_hi = (lane == nts) ? (int)(unsigned)(_c >> 32) : ts_hi; ++nts; } } while (0)
    PG8_STAMP();
    unsigned voffA[2], voffB[2];
#pragma unroll
    for (int i = 0; i < 2; ++i) { int R, C; stage_rc(tid * 16 + i * 8192, R, C); const int Rb = Epi::PERM ? ((R & ~31) + perm32(R & 31)) : R;
        voffA[i] = (unsigned)(R * K + C) * 2u; voffB[i] = (unsigned)(Rb * K + C) * 2u; }
    const size_t kstep = (size_t)(BK * 2);
    const size_t hstep = (size_t)HALF * K * 2;
    const size_t tstep = 2 * hstep;
    const unsigned ldsw = (unsigned)wid * 1024u;
    const int aoff = lds_byte(wr * 64 + fr, fq * 8), boff = lds_byte(wc * 32 + fr, fq * 8);
#define PG8_SA(b, h) (((b) * 2 + (h)) * HTB)
#define PG8_SB(b, h) ((4 + (b) * 2 + (h)) * HTB)
#define PG8_STAGE(bufoff, gbase, voff) do { _Pragma("unroll") for (int _i = 0; _i < 2; ++_i) \
        __builtin_amdgcn_global_load_lds((const unsigned*)((const char*)(gbase) + (voff)[_i]), (PG8_LAS unsigned*)(lds + (bufoff) + ldsw + _i * 8192), 16, 0, 0); } while (0)
#define PG8_LDA(dst, b, h) do { _Pragma("unroll") for (int m = 0; m < 4; ++m) _Pragma("unroll") for (int k = 0; k < 2; ++k) dst[m][k] = *(const PG8_LAS bf16x8*)(lds + PG8_SA(b, h) + aoff + m * 2048 + k * 1024); } while (0)
#define PG8_LDB(dst, b, h) do { _Pragma("unroll") for (int n = 0; n < 2; ++n) _Pragma("unroll") for (int k = 0; k < 2; ++k) dst[n][k] = *(const PG8_LAS bf16x8*)(lds + PG8_SB(b, h) + boff + n * 2048 + k * 1024); } while (0)
#define PG8_MMA(ai, bj, At, Bt) do { __builtin_amdgcn_s_setprio(1); _Pragma("unroll") for (int m = 0; m < 4; ++m) _Pragma("unroll") for (int n = 0; n < 2; ++n) _Pragma("unroll") for (int k = 0; k < 2; ++k) \
        acc[ai][bj][m][n] = __builtin_amdgcn_mfma_f32_16x16x32_bf16(Bt[n][k], At[m][k], acc[ai][bj][m][n], 0, 0, 0); __builtin_amdgcn_s_setprio(0); } while (0)
#define PG8_WAIT_V(n) asm volatile("s_waitcnt vmcnt(" #n ")" ::: "memory")
#define PG8_WAIT_L(n) asm volatile("s_waitcnt lgkmcnt(" #n ")" ::: "memory")
#define PG8_BAR __builtin_amdgcn_s_barrier()
#define PG8_SCHED __builtin_amdgcn_sched_barrier(0)
    Unit cur, nxt; int ui = 0;
    if (!S.next(0, cur)) return;
    f32x4 acc[2][2][4][2];
#pragma unroll
    for (int a = 0; a < 2; ++a)
#pragma unroll
        for (int b = 0; b < 2; ++b)
#pragma unroll
            for (int m = 0; m < 4; ++m)
#pragma unroll
                for (int n = 0; n < 2; ++n) acc[a][b][m][n] = (f32x4){0.f, 0.f, 0.f, 0.f};
    bf16x8 At[4][2], B0[2][2], B1[2][2];
    const char* cA = (const char*)g.A + (size_t)cur.pm * tstep; const char* cB = (const char*)g.Bt + (size_t)cur.pn * tstep;
    S.a_ready(cur);
    PG8_STAGE(PG8_SB(0, 0), cB, voffB); PG8_STAGE(PG8_SA(0, 0), cA, voffA); PG8_STAGE(PG8_SB(0, 1), cB + hstep, voffB); PG8_STAGE(PG8_SA(0, 1), cA + hstep, voffA);
    if (wr == 1) PG8_BAR;
    PG8_WAIT_V(4); PG8_BAR;
    PG8_STAGE(PG8_SB(1, 0), cB + kstep, voffB); PG8_STAGE(PG8_SA(1, 0), cA + kstep, voffA); PG8_STAGE(PG8_SB(1, 1), cB + hstep + kstep, voffB);
    PG8_WAIT_V(6); PG8_BAR;
    PG8_STAMP();
    for (;;) {
        const bool has_next = S.next(ui + 1, nxt);
        const char* nA = has_next ? (const char*)g.A + (size_t)nxt.pm * tstep : cA; const char* nB = has_next ? (const char*)g.Bt + (size_t)nxt.pn * tstep : cB;
        for (int t = 0; t < nt; t += 2) {
            const bool last = (t == nt - 2);
            const char* a1 = cA + (size_t)(t + 1) * kstep;
            const char* a2 = last ? nA : cA + (size_t)(t + 2) * kstep; const char* b2 = last ? nB : cB + (size_t)(t + 2) * kstep;
            const char* a3 = a2 + kstep; const char* b3 = b2 + kstep;
            if (last && has_next) S.a_ready(nxt);
            PG8_LDB(B0, 0, 0); PG8_SCHED; PG8_LDA(At, 0, 0); PG8_STAGE(PG8_SA(1, 1), a1 + hstep, voffA);
            PG8_WAIT_L(8); PG8_BAR; PG8_WAIT_L(0); PG8_MMA(0, 0, At, B0); PG8_BAR; PG8_SCHED;
            PG8_LDB(B1, 0, 1); PG8_STAGE(PG8_SB(0, 0), b2, voffB);
            PG8_BAR; PG8_WAIT_L(0); PG8_MMA(0, 1, At, B1); PG8_BAR;
            PG8_LDA(At, 0, 1); PG8_STAGE(PG8_SA(0, 0), a2, voffA);
            PG8_BAR; PG8_WAIT_L(0); PG8_MMA(1, 0, At, B0); PG8_BAR; PG8_SCHED;
            PG8_STAGE(PG8_SB(0, 1), b2 + hstep, voffB);
            PG8_WAIT_V(6); PG8_BAR; PG8_MMA(1, 1, At, B1); PG8_BAR;
            PG8_LDB(B0, 1, 0); PG8_SCHED; PG8_LDA(At, 1, 0); PG8_STAGE(PG8_SA(0, 1), a2 + hstep, voffA);
            PG8_WAIT_L(8); PG8_BAR; PG8_WAIT_L(0); PG8_MMA(0, 0, At, B0); PG8_BAR; PG8_SCHED;
            PG8_LDB(B1, 1, 1); PG8_STAGE(PG8_SB(1, 0), b3, voffB);
            PG8_BAR; PG8_WAIT_L(0); PG8_MMA(0, 1, At, B1); PG8_BAR;
            PG8_LDA(At, 1, 1); PG8_STAGE(PG8_SA(1, 0), a3, voffA);
            PG8_BAR; PG8_WAIT_L(0); PG8_MMA(1, 0, At, B0); PG8_BAR; PG8_SCHED;
            PG8_STAGE(PG8_SB(1, 1), b3 + hstep, voffB);
            PG8_WAIT_V(6); PG8_BAR; PG8_MMA(1, 1, At, B1); PG8_BAR;
        }
        PG8_STAMP();
        if constexpr (!Epi::AFTER_DRAIN) { E(acc, cur, wr, wc, fr, fq); S.done(cur); }
        PG8_STAMP();
        if (!has_next) break;
#pragma unroll
        for (int a = 0; a < 2; ++a)
#pragma unroll
            for (int b = 0; b < 2; ++b)
#pragma unroll
                for (int m = 0; m < 4; ++m)
#pragma unroll
                    for (int n = 0; n < 2; ++n) acc[a][b][m][n] = (f32x4){0.f, 0.f, 0.f, 0.f};
        cur = nxt; cA = nA; cB = nB; ++ui;
    }
    PG8_WAIT_V(0);
    if (wr == 0) PG8_BAR;
    PG8_BAR;
    if constexpr (Epi::AFTER_DRAIN) { E.fused(acc, cur, wr, wc, fr, fq, lds, wid, lane); S.done(cur); }
    PG8_STAMP();
    if (STAMP && wid == 0) { stamps[lane] = lane < nts ? (((unsigned long long)(unsigned)ts_hi << 32) | (unsigned)ts_lo) : 0ull;
        if (lane == 62) stamps[62] = rt_entry; if (lane == 63) stamps[63] = (unsigned long long)wall_clock64(); }
#undef PG8_STAMP
#undef PG8_SA
#undef PG8_SB
#undef PG8_STAGE
#undef PG8_LDA
#undef PG8_LDB
#undef PG8_MMA
#undef PG8_WAIT_V
#undef PG8_WAIT_L
#undef PG8_BAR
#undef PG8_SCHED
}
}
#define XB_TMO      128
#define XB_XCNT(j)  (256  + 64 * (j))
#define XB_XSUB(j)  (1280 + 64 * (j))
#define XB_XGEN(j)  (2304 + 64 * (j))
#define XB_TOP      3328
#define XB_TOPGEN   3392
#define XCD_BAR_WORDS 3456
#define XB_SPIN_CAP (1u << 18)
#define LAS __attribute__((address_space(3)))

__device__ __forceinline__ unsigned xb_ld(unsigned* p)              { return __hip_atomic_load(p, __ATOMIC_RELAXED, __HIP_MEMORY_SCOPE_AGENT); }
__device__ __forceinline__ unsigned xb_add(unsigned* p, unsigned v) { return __hip_atomic_fetch_add(p, v, __ATOMIC_RELAXED, __HIP_MEMORY_SCOPE_AGENT); }
__device__ __forceinline__ unsigned xb_xcc_id() { return (unsigned)__builtin_amdgcn_s_getreg((3 << 11) | 20) & 0xFu; }
#define XB_SPIN(cond, bar) do { unsigned _sp = 0; while (cond) { __builtin_amdgcn_s_sleep(1); \
    if ((++_sp & 255u) == 0u) { if (xb_ld(&(bar)[XB_TMO])) break; if (_sp > XB_SPIN_CAP) { atomicAdd(&(bar)[XB_TMO], 1u); break; } } } } while (0)

#define XB_LANE0() (__builtin_amdgcn_mbcnt_hi(~0u, __builtin_amdgcn_mbcnt_lo(~0u, 0u)) == 0u)
struct XcdBarrier {
    unsigned w0;
    unsigned* bar; unsigned x;
    volatile LAS unsigned* st;
};

__device__ __forceinline__ XcdBarrier xcd_barrier_post(unsigned* bar, volatile LAS unsigned* st, unsigned w0) {
    XcdBarrier b; b.w0 = w0; b.bar = bar; b.x = xb_xcc_id(); b.st = st;
    if (w0 == 0u && XB_LANE0()) (void)xb_add(&bar[XB_XCNT(b.x)], 1u);
    return b;
}
__device__ __forceinline__ void xcd_barrier_complete(unsigned* bar, unsigned x, unsigned& nloc, unsigned& nx) {
    const unsigned G = gridDim.x * gridDim.y * gridDim.z;
    unsigned sum, cnt, mine, sp = 0u;
    for (;;) {
        sum = 0u; cnt = 0u; mine = 0u;
#pragma unroll
        for (unsigned j = 0; j < 16; ++j) { const unsigned c = xb_ld(&bar[XB_XCNT(j)]); sum += c; cnt += (c > 0u) ? 1u : 0u; mine = (j == x) ? c : mine; }
        if (sum == G) break;
        __builtin_amdgcn_s_sleep(1);
        if ((++sp & 255u) == 0u) { if (xb_ld(&bar[XB_TMO])) break; if (sp > XB_SPIN_CAP) { atomicAdd(&bar[XB_TMO], 1u); break; } }
    }
    nloc = mine > 0u ? mine : 1u; nx = cnt > 0u ? cnt : 1u;
}

__device__ __forceinline__ void xcd_barrier(const XcdBarrier& b) {
    asm volatile("s_waitcnt vmcnt(0)" ::: "memory");
    __syncthreads();
    if (b.w0 == 0u && XB_LANE0()) {
        unsigned* bar = b.bar;
        __builtin_amdgcn_s_waitcnt(0);
        unsigned nloc = b.st[0], nx = b.st[1];
        if (nloc == 0u) { xcd_barrier_complete(bar, b.x, nloc, nx); b.st[0] = nloc; b.st[1] = nx; }
        const unsigned old = xb_add(&bar[XB_XSUB(b.x)], 1u);
        const unsigned gen = old / nloc;
        if (old + 1u == (gen + 1u) * nloc) {
            __builtin_amdgcn_fence(__ATOMIC_RELEASE, "agent");
            asm volatile("s_waitcnt vmcnt(0)" ::: "memory");
            const unsigned og = xb_add(&bar[XB_TOP], 1u);
            const unsigned tg = og / nx;
            if (og + 1u == (tg + 1u) * nx) xb_add(&bar[XB_TOPGEN], 1u);
            else XB_SPIN(xb_ld(&bar[XB_TOPGEN]) == tg, bar);
            __builtin_amdgcn_fence(__ATOMIC_ACQUIRE, "agent");
            xb_add(&bar[XB_XGEN(b.x)], 1u);
            asm volatile("s_waitcnt vmcnt(0)" ::: "memory");
        } else {
            XB_SPIN(xb_ld(&bar[XB_XGEN(b.x)]) == gen, bar);
            __builtin_amdgcn_fence(__ATOMIC_ACQUIRE, "agent");
            asm volatile("s_waitcnt vmcnt(0)" ::: "memory");
        }
    }
    __syncthreads();
}

namespace mk {
using pg8::bf16_t; using pg8::bf16x8; using pg8::f32x4; using pg8::u32x4;
typedef unsigned u32x2 __attribute__((ext_vector_type(2)));
typedef __bf16 bf16x2_t __attribute__((ext_vector_type(2)));
typedef LAS unsigned char* lds_t;

constexpr int DM = 1024, NLAT = 16384, NROW = 16896;
constexpr int OFF_B = 512, OFF_C = 1024, OFF_D = 2056, INC = 3208, NP = 3328;
constexpr int NCH = 132, NSLOT = 16 * NCH;
constexpr int NEXP = 16384;

constexpr size_t WS_CTL  = 0;
constexpr size_t WS_MOD  = 65536;
constexpr size_t WS_WIN  = WS_MOD + 147456;
constexpr size_t WS_WOUT = WS_WIN + 2ull * NP * DM * 2;
constexpr size_t WS_WQ   = WS_WOUT + 2ull * DM * DM * 2;
constexpr size_t WS_H    = WS_WQ + 2ull * 2048 * DM * 2;
constexpr size_t WS_ACT  = WS_H + (size_t)NROW * DM * 4;
constexpr size_t WS_UB   = WS_ACT + (size_t)NROW * DM * 2;
constexpr size_t WS_VB   = WS_UB + (size_t)NEXP * DM * 2;
constexpr size_t WS_SU   = WS_UB + (size_t)NEXP * DM;
constexpr size_t WS_SV   = WS_VB + (size_t)NEXP * DM;
constexpr size_t WS_P    = WS_VB + (size_t)NEXP * DM * 2;
constexpr size_t WS_Q    = WS_P;
constexpr size_t WS_SELI = WS_Q + (size_t)NROW * 2048 * 2;
constexpr size_t WS_SELG = WS_SELI + (size_t)NROW * 128 * 4;
constexpr size_t WS_MST  = WS_P + (size_t)NROW * NP * 2;
constexpr size_t WS_MCD  = WS_MST + (size_t)NSLOT * 8192 * 4;
constexpr size_t WS_RG   = WS_MCD + 16384;
constexpr size_t WS_RJ   = WS_RG + (size_t)NSLOT * 8192;
constexpr size_t WS_RY   = WS_RJ + (size_t)NSLOT * 16384;
constexpr size_t WS_RL   = WS_RY + (size_t)NSLOT * 8192;
constexpr size_t WS_RH   = WS_RL + (size_t)NSLOT * 8192;
constexpr size_t WS_BON  = WS_RH + (size_t)NSLOT * 8192;
constexpr size_t WS_END  = WS_BON + (size_t)NROW * 8 * 4;
static_assert(WS_SELG + (size_t)NROW * 128 * 4 <= WS_MST, "Q + selections must fit in P's region");

constexpr int LDS_BYTES = 157440;
constexpr int LDS_XB = 157184;

struct Args { const float* in[42]; float* out; unsigned char* ws; int ph_lo, ph_hi; };

struct Ctx {
    const float* const* in; float* out; unsigned char* ws; lds_t lds;
    int tid, lane, wid, bid, G;
};

__device__ __forceinline__ float bf2f(unsigned short x) { return __uint_as_float(((unsigned)x) << 16); }
__device__ __forceinline__ float bflo(unsigned w) { return __uint_as_float(w << 16); }
__device__ __forceinline__ float bfhi(unsigned w) { return __uint_as_float(w & 0xffff0000u); }
typedef __bf16 bf16pair_t __attribute__((ext_vector_type(2)));
__device__ __forceinline__ unsigned pk2(float lo, float hi) { const bf16pair_t v = {(__bf16)lo, (__bf16)hi}; return __builtin_bit_cast(unsigned, v); }
__device__ __forceinline__ unsigned short f2bf(float f) { return (unsigned short)(pk2(f, 0.f) & 0xffffu); }
#define dpp_f(old, src, ctrl, row_mask, bank_mask) __uint_as_float((unsigned)__builtin_amdgcn_update_dpp((int)__float_as_uint(old), (int)__float_as_uint(src), ctrl, row_mask, bank_mask, true))
__device__ __forceinline__ float wave_sum(float v) {
    v += dpp_f(0.f, v, 0xB1, 0xF, 0xF);
    v += dpp_f(0.f, v, 0x4E, 0xF, 0xF);
    v += dpp_f(0.f, v, 0x141, 0xF, 0xF);
    v += dpp_f(0.f, v, 0x140, 0xF, 0xF);
    v += dpp_f(0.f, v, 0x142, 0xA, 0xF);
    v += dpp_f(0.f, v, 0x143, 0xC, 0xF);
    return __uint_as_float((unsigned)__builtin_amdgcn_readlane((int)__float_as_uint(v), 63));
}
__device__ __forceinline__ float wave_incl_scan(float v, int lane) {
    (void)lane;
    float s = v + dpp_f(0.f, v, 0x111, 0xF, 0xF);
    s += dpp_f(0.f, v, 0x112, 0xF, 0xF);
    s += dpp_f(0.f, v, 0x113, 0xF, 0xF);
    s += dpp_f(0.f, s, 0x114, 0xF, 0xE);
    s += dpp_f(0.f, s, 0x118, 0xF, 0xC);
    s += dpp_f(0.f, s, 0x142, 0xA, 0xF);
    s += dpp_f(0.f, s, 0x143, 0xC, 0xF);
    return s;
}
__device__ __forceinline__ float fexp(float x) { return __expf(x); }
__device__ __forceinline__ float frcp(float x) { return __builtin_amdgcn_rcpf(x); }
__device__ __forceinline__ float sigm(float x) { return frcp(1.f + __expf(-x)); }
__device__ __forceinline__ float silu(float x) { return x * frcp(1.f + __expf(-x)); }
__device__ __forceinline__ float softplus(float x) { return fmaxf(x, 0.f) + __logf(1.f + __expf(-fabsf(x))); }
__device__ __forceinline__ float ftanh(float x) { const float e = __expf(-2.f * fabsf(x)); const float t = (1.f - e) * frcp(1.f + e); return x < 0.f ? -t : t; }
__device__ __forceinline__ float gelu_tanh(float x) { const float u = 0.7978845608028654f * (x + 0.044715f * x * x * x); return 0.5f * x * (1.f + ftanh(u)); }
__device__ __forceinline__ float dot2bf(unsigned a, unsigned b, float acc) { return __builtin_amdgcn_fdot2_f32_bf16(__builtin_bit_cast(bf16x2_t, a), __builtin_bit_cast(bf16x2_t, b), acc, false); }

struct ChunkInfo { int row0, lo, hi, b, tc, isctx; };
__device__ __forceinline__ ChunkInfo chunk_info(int gc) {
    ChunkInfo c; c.row0 = gc * 64;
    if (gc < 256) { c.b = gc >> 7; c.tc = gc & 127; c.isctx = 0; c.lo = c.b * 8192; c.hi = c.lo + 8192; }
    else { const int q = gc - 256; c.b = q >> 2; c.tc = q & 3; c.isctx = 1; c.lo = NLAT + c.b * 256; c.hi = c.lo + 256; }
    return c;
}
__device__ __forceinline__ int cpos_of(const ChunkInfo& c, int d) { return c.isctx ? (d ? 3 - c.tc : c.tc) : (d ? 4 + 127 - c.tc : 4 + c.tc); }
__device__ __forceinline__ int slot_of(int b, int h, int d, int cpos) { return ((b * 4 + h) * 2 + d) * NCH + cpos; }

template <int MT, int NT, int KS, class Epi>
__device__ __forceinline__ void blk_mma(const LAS bf16_t* A, int lda, const LAS bf16_t* Bt, int ldb, int wid, int lane, Epi epi) {
    const int fr = lane & 15, fq = lane >> 4;
    for (int tt = wid; tt < MT * NT; tt += 8) {
        const int tm = tt / NT, tn = tt % NT;
        f32x4 acc = {0.f, 0.f, 0.f, 0.f};
#pragma unroll
        for (int ks = 0; ks < KS; ++ks) {
            const bf16x8 a = *(const LAS bf16x8*)(A + (tm * 16 + fr) * lda + ks * 32 + fq * 8);
            const bf16x8 b = *(const LAS bf16x8*)(Bt + (tn * 16 + fr) * ldb + ks * 32 + fq * 8);
            acc = __builtin_amdgcn_mfma_f32_16x16x32_bf16(a, b, acc, 0, 0, 0);
        }
        epi(tm * 16 + fq * 4, tn * 16 + fr, acc);
    }
}
template <int MT, int NT, int KS, class Epi>
__device__ __forceinline__ void blk_mma2(const LAS bf16_t* A1, const LAS bf16_t* B1, const LAS bf16_t* A2, const LAS bf16_t* B2, int ld, int wid, int lane, Epi epi) {
    const int fr = lane & 15, fq = lane >> 4;
    for (int tt = wid; tt < MT * NT; tt += 8) {
        const int tm = tt / NT, tn = tt % NT;
        f32x4 acc1 = {0.f, 0.f, 0.f, 0.f}, acc2 = {0.f, 0.f, 0.f, 0.f};
#pragma unroll
        for (int ks = 0; ks < KS; ++ks) {
            const bf16x8 a1 = *(const LAS bf16x8*)(A1 + (tm * 16 + fr) * ld + ks * 32 + fq * 8);
            const bf16x8 b1 = *(const LAS bf16x8*)(B1 + (tn * 16 + fr) * ld + ks * 32 + fq * 8);
            acc1 = __builtin_amdgcn_mfma_f32_16x16x32_bf16(a1, b1, acc1, 0, 0, 0);
            const bf16x8 a2 = *(const LAS bf16x8*)(A2 + (tm * 16 + fr) * ld + ks * 32 + fq * 8);
            const bf16x8 b2 = *(const LAS bf16x8*)(B2 + (tn * 16 + fr) * ld + ks * 32 + fq * 8);
            acc2 = __builtin_amdgcn_mfma_f32_16x16x32_bf16(a2, b2, acc2, 0, 0, 0);
        }
        epi(tm * 16 + fq * 4, tn * 16 + fr, acc1, acc2);
    }
}


template <int MT, int NT, class Epi>
__device__ __forceinline__ void small_gemm_tile(const Ctx& C, const bf16_t* A, const bf16_t* Bt, int K, Epi epi) {
    constexpr int AR = MT * 16, BR = NT * 16, PITCH = 264, NA = AR * 32 / 512, NB = BR * 32 / 512;
    LAS bf16_t* As = (LAS bf16_t*)C.lds; LAS bf16_t* Bs = As + AR * PITCH;
    u32x4 ra[NA], rb[NB];
    auto fetch = [&](int k0) {
#pragma unroll
        for (int i = 0; i < NA; ++i) { const int e = C.tid + 512 * i; ra[i] = *(const u32x4*)(A + (size_t)(e >> 5) * K + k0 + (e & 31) * 8); }
#pragma unroll
        for (int i = 0; i < NB; ++i) { const int e = C.tid + 512 * i; rb[i] = *(const u32x4*)(Bt + (size_t)(e >> 5) * K + k0 + (e & 31) * 8); } };
    const int fr = C.lane & 15, fq = C.lane >> 4;
    constexpr int TPW = (MT * NT + 7) / 8;
    f32x4 acc[TPW];
#pragma unroll
    for (int i = 0; i < TPW; ++i) acc[i] = (f32x4){0.f, 0.f, 0.f, 0.f};
    fetch(0);
    for (int k0 = 0; k0 < K; k0 += 256) {
        __syncthreads();
#pragma unroll
        for (int i = 0; i < NA; ++i) { const int e = C.tid + 512 * i; *(LAS u32x4*)(As + (e >> 5) * PITCH + (e & 31) * 8) = ra[i]; }
#pragma unroll
        for (int i = 0; i < NB; ++i) { const int e = C.tid + 512 * i; *(LAS u32x4*)(Bs + (e >> 5) * PITCH + (e & 31) * 8) = rb[i]; }
        if (k0 + 256 < K) fetch(k0 + 256);
        __syncthreads();
#pragma unroll
        for (int i = 0; i < TPW; ++i) { const int tt = C.wid + 8 * i; if (tt < MT * NT) { const int tm = tt / NT, tn = tt % NT;
#pragma unroll
            for (int ks = 0; ks < 8; ++ks) acc[i] = __builtin_amdgcn_mfma_f32_16x16x32_bf16(*(const LAS bf16x8*)(As + (tm * 16 + fr) * PITCH + ks * 32 + fq * 8),
                                                                                           *(const LAS bf16x8*)(Bs + (tn * 16 + fr) * PITCH + ks * 32 + fq * 8), acc[i], 0, 0, 0); } }
    }
#pragma unroll
    for (int i = 0; i < TPW; ++i) { const int tt = C.wid + 8 * i; if (tt < MT * NT) epi((tt / NT) * 16 + fq * 4, (tt % NT) * 16 + fr, acc[i]); }
    __syncthreads();
}

__device__ __forceinline__ void transpose_item(const float* W, int K, int N, int nblk, bf16_t* WT, LAS float* scr, int item, int lane) {
    const int kb = item / nblk, nb = item % nblk, k0 = 64 * kb, n0 = 32 * nb;
    const int nn = n0 + (lane & 31);
#pragma unroll 8
    for (int i = 0; i < 32; ++i) { const int kk = 2 * i + (lane >> 5); scr[kk * 33 + (lane & 31)] = (nn < N) ? W[(size_t)(k0 + kk) * N + nn] : 0.f; }
    asm volatile("s_waitcnt lgkmcnt(0)" ::: "memory");
    const int c = lane & 7;
#pragma unroll
    for (int j = 0; j < 4; ++j) { const int n = (lane >> 3) + 8 * j; const LAS float* s = scr + (8 * c) * 33 + n;
        u32x4 o; o.x = pk2(s[0 * 33], s[1 * 33]); o.y = pk2(s[2 * 33], s[3 * 33]); o.z = pk2(s[4 * 33], s[5 * 33]); o.w = pk2(s[6 * 33], s[7 * 33]);
        *(u32x4*)(WT + (size_t)(n0 + n) * K + k0 + 8 * c) = o; }
    asm volatile("s_waitcnt lgkmcnt(0)" ::: "memory");
}
__device__ __forceinline__ float wave_maxf(float v) {
#pragma unroll
    for (int o = 1; o < 64; o <<= 1) v = fmaxf(v, __shfl_xor(v, o));
    return v;
}
__device__ __forceinline__ void convert_tables(const Ctx& C, int layer, int rank, int nrank) {
    const float* U = C.in[39] + (size_t)layer * NEXP * DM; const float* V = C.in[40] + (size_t)layer * NEXP * DM;
    unsigned char* UB = C.ws + WS_UB; unsigned char* VB = C.ws + WS_VB; float* SU = (float*)(C.ws + WS_SU); float* SV = (float*)(C.ws + WS_SV);
    for (int r4 = (rank * 8 + C.wid) * 2; r4 < 2 * NEXP; r4 += nrank * 8 * 2) {
        const bool isv = r4 >= NEXP; const int row0 = isv ? r4 - NEXP : r4;
        const float* src = (isv ? V : U) + (size_t)row0 * DM + 16 * C.lane;
        f32x4 x[2][4];
#pragma unroll
        for (int q = 0; q < 2; ++q)
#pragma unroll
            for (int k = 0; k < 4; ++k) x[q][k] = *(const f32x4*)(src + (size_t)q * DM + 4 * k);
#pragma unroll
        for (int q = 0; q < 2; ++q) {
            float m = 0.f;
#pragma unroll
            for (int k = 0; k < 4; ++k) m = fmaxf(fmaxf(m, fmaxf(fabsf(x[q][k].x), fabsf(x[q][k].y))), fmaxf(fabsf(x[q][k].z), fabsf(x[q][k].w)));
            m = wave_maxf(m);
            const float sc = m > 0.f ? 224.f / m : 1.f;
            u32x4 o;
#pragma unroll
            for (int k = 0; k < 4; ++k) { int w = __builtin_amdgcn_cvt_pk_fp8_f32(x[q][k].x * sc, x[q][k].y * sc, 0, false); w = __builtin_amdgcn_cvt_pk_fp8_f32(x[q][k].z * sc, x[q][k].w * sc, w, true); o[k] = (unsigned)w; }
            *(u32x4*)((isv ? VB : UB) + (size_t)(row0 + q) * DM + 16 * C.lane) = o;
            if (C.lane == 0) (isv ? SV : SU)[row0 + q] = m > 0.f ? m * (1.f / 224.f) : 1.f;
        }
    }
}
__device__ __forceinline__ void ph_prologue(const Ctx& C) {
    const int gw = C.bid * 8 + C.wid, NGW = C.G * 8;
    {
        LAS float* scr = (LAS float*)(C.lds + C.wid * 16384);
        bf16_t* WIN = (bf16_t*)(C.ws + WS_WIN); bf16_t* WOUT = (bf16_t*)(C.ws + WS_WOUT); bf16_t* WQ = (bf16_t*)(C.ws + WS_WQ);
        for (int it = gw; it < 6400; it += NGW) {
            const int layer = it / 3200; int r = it % 3200;
            if (r < 1664) { transpose_item(C.in[8] + (size_t)layer * DM * INC, DM, INC, 104, WIN + (size_t)layer * NP * DM, scr, r, C.lane); continue; } r -= 1664;
            if (r < 512) { transpose_item(C.in[9] + (size_t)layer * DM * DM, DM, DM, 32, WOUT + (size_t)layer * DM * DM, scr, r, C.lane); continue; } r -= 512;
            transpose_item(C.in[36] + (size_t)layer * DM * 2048, DM, 2048, 64, WQ + (size_t)layer * 2048 * DM, scr, r, C.lane);
        }
    }
    __syncthreads();
    {
        LAS float* sv = (LAS float*)C.lds;
        LAS float* red = (LAS float*)(C.lds + 12288);
        for (int i = C.tid; i < 3 * 1024; i += 512) { const int w = i >> 10, k = i & 1023; const float x = (w < 2) ? C.in[1][w * 1024 + k] : C.in[3][k]; sv[i] = silu(x); }
        __syncthreads();
        float* MOD = (float*)(C.ws + WS_MOD);
        for (int it = C.bid; it < 192; it += C.G) {
            const int layer = it / 96, col0 = (it % 96) * 64, col = C.tid & 63, kg = C.tid >> 6;
            const float* W = C.in[4] + (size_t)layer * DM * 6144 + col0 + col;
            float a0 = 0.f, a1 = 0.f, a2 = 0.f;
#pragma unroll 32
            for (int k = kg * 128; k < kg * 128 + 128; ++k) { const float w = W[(size_t)k * 6144]; a0 += sv[k] * w; a1 += sv[1024 + k] * w; a2 += sv[2048 + k] * w; }
            red[(kg * 3 + 0) * 64 + col] = a0; red[(kg * 3 + 1) * 64 + col] = a1; red[(kg * 3 + 2) * 64 + col] = a2;
            __syncthreads();
            if (C.tid < 192) { const int w = C.tid >> 6, c2 = C.tid & 63; float s = 0.f;
#pragma unroll
                for (int g = 0; g < 8; ++g) s += red[(g * 3 + w) * 64 + c2];
                MOD[((size_t)layer * 3 + w) * 6144 + col0 + c2] = s + C.in[5][layer * 6144 + col0 + c2]; }
            __syncthreads();
        }
    }
    {
        float* H = (float*)(C.ws + WS_H);
        const size_t n4 = (size_t)NROW * 256;
        for (size_t i = (size_t)C.bid * 512 + C.tid; i < n4; i += (size_t)C.G * 512) {
            const int row = (int)(i >> 8), c4 = (int)(i & 255) * 4;
            f32x4 v;
            if (row < NLAT) {
                v = *(const f32x4*)(C.in[0] + (size_t)row * DM + c4);
                const int t = row & 8191, quarter = c4 >> 8; const float pos = (quarter < 2) ? (float)(t >> 6) : (float)(t & 63);
                float e[4];
#pragma unroll
                for (int j = 0; j < 4; ++j) { const int jj = (c4 & 255) + j; const float fr = exp2f(-(float)jj * (13.287712379549449f / 256.f)); const float a = pos * fr; e[j] = (quarter & 1) ? __cosf(a) : __sinf(a); }
                v.x += e[0]; v.y += e[1]; v.z += e[2]; v.w += e[3];
            } else v = *(const f32x4*)(C.in[2] + (size_t)(row - NLAT) * DM + c4);
            *(f32x4*)(H + (size_t)row * DM + c4) = v;
        }
    }
}

struct Row16 { float v[16]; };
__device__ __forceinline__ Row16 load_row16(const float* p, int lane) {
    Row16 r; const f32x4 a = *(const f32x4*)(p + 8 * lane), b = *(const f32x4*)(p + 8 * lane + 4), c = *(const f32x4*)(p + 512 + 8 * lane), d = *(const f32x4*)(p + 512 + 8 * lane + 4);
    r.v[0] = a.x; r.v[1] = a.y; r.v[2] = a.z; r.v[3] = a.w; r.v[4] = b.x; r.v[5] = b.y; r.v[6] = b.z; r.v[7] = b.w;
    r.v[8] = c.x; r.v[9] = c.y; r.v[10] = c.z; r.v[11] = c.w; r.v[12] = d.x; r.v[13] = d.y; r.v[14] = d.z; r.v[15] = d.w; return r;
}
__device__ __forceinline__ void store_row16_f32(float* p, int lane, const Row16& r) {
    *(f32x4*)(p + 8 * lane) = (f32x4){r.v[0], r.v[1], r.v[2], r.v[3]}; *(f32x4*)(p + 8 * lane + 4) = (f32x4){r.v[4], r.v[5], r.v[6], r.v[7]};
    *(f32x4*)(p + 512 + 8 * lane) = (f32x4){r.v[8], r.v[9], r.v[10], r.v[11]}; *(f32x4*)(p + 512 + 8 * lane + 4) = (f32x4){r.v[12], r.v[13], r.v[14], r.v[15]};
}
__device__ __forceinline__ void store_row16_bf16(bf16_t* p, int lane, const Row16& r) {
    u32x4 a, b; a.x = pk2(r.v[0], r.v[1]); a.y = pk2(r.v[2], r.v[3]); a.z = pk2(r.v[4], r.v[5]); a.w = pk2(r.v[6], r.v[7]);
    b.x = pk2(r.v[8], r.v[9]); b.y = pk2(r.v[10], r.v[11]); b.z = pk2(r.v[12], r.v[13]); b.w = pk2(r.v[14], r.v[15]);
    *(u32x4*)(p + 8 * lane) = a; *(u32x4*)(p + 512 + 8 * lane) = b;
}
__device__ __forceinline__ Row16 norm_mod_row(const Row16& x, const float* g, const float* shift, const float* scale, int lane) {
    float ss = 0.f;
#pragma unroll
    for (int i = 0; i < 16; ++i) ss += x.v[i] * x.v[i];
    const float rs = rsqrtf(wave_sum(ss) * (1.f / 1024.f) + 1e-6f);
    const Row16 gg = load_row16(g, lane), sh = load_row16(shift, lane), sc = load_row16(scale, lane);
    Row16 o;
#pragma unroll
    for (int i = 0; i < 16; ++i) o.v[i] = (x.v[i] * rs * gg.v[i]) * (1.f + sc.v[i]) + sh.v[i];
    return o;
}
__device__ __forceinline__ int which_of(int row) { return row < 8192 ? 0 : (row < NLAT ? 1 : 2); }
__device__ __forceinline__ void ph_norm(const Ctx& C, int layer, const float* gain, int sidx, int nrows) {
    const float* H = (const float*)(C.ws + WS_H); bf16_t* ACT = (bf16_t*)(C.ws + WS_ACT); const float* MOD = (const float*)(C.ws + WS_MOD);
    for (int row = C.bid * 8 + C.wid; row < nrows; row += C.G * 8) {
        const float* m = MOD + ((size_t)layer * 3 + which_of(row)) * 6144;
        const Row16 x = load_row16(H + (size_t)row * DM, C.lane);
        const Row16 o = norm_mod_row(x, gain, m + sidx * 1024, m + (sidx + 1) * 1024, C.lane);
        store_row16_bf16(ACT + (size_t)row * DM, C.lane, o);
    }
}
struct EpiResid {
    static constexpr bool PERM = false, AFTER_DRAIN = false;
    float* H; const float* modl;
    __device__ __forceinline__ void operator()(const f32x4 (&acc)[2][2][4][2], const pg8::Unit& u, int wr, int wc, int fr, int fq) const {
        const int row0 = u.pm * 256 + wr * 64 + fr, col0 = u.pn * 256 + wc * 32 + 4 * fq;
        const int which = u.pm < 32 ? 0 : (u.pm < 64 ? 1 : 2);
        const float* gate = modl + ((size_t)which * 6 + 2) * 1024;
        f32x4 gv[2][2];
#pragma unroll
        for (int bj = 0; bj < 2; ++bj)
#pragma unroll
            for (int n = 0; n < 2; ++n) gv[bj][n] = *(const f32x4*)(gate + col0 + bj * 128 + n * 16);
#pragma unroll
        for (int ai = 0; ai < 2; ++ai)
#pragma unroll
            for (int m = 0; m < 4; ++m) { float* rowp = H + (size_t)(row0 + ai * 128 + m * 16) * DM + col0;
#pragma unroll
                for (int bj = 0; bj < 2; ++bj)
#pragma unroll
                    for (int n = 0; n < 2; ++n) { f32x4* p = (f32x4*)(rowp + bj * 128 + n * 16); *p = *p + gv[bj][n] * acc[ai][bj][m][n]; } }
    }
};

__device__ __forceinline__ void item_conformer(const Ctx& C, int layer, int gc) {
    const ChunkInfo ci = chunk_info(gc);
    const bf16_t* P = (const bf16_t*)(C.ws + WS_P); bf16_t* YC = (bf16_t*)(C.ws + WS_ACT);
    LAS bf16_t* HG = (LAS bf16_t*)C.lds;
    LAS float* CO = (LAS float*)(C.lds + 49152);
    for (int e = C.tid; e < 94 * 128; e += 512) {
        const int rr = e >> 7, cp = e & 127, grow = ci.row0 - 15 + rr;
        const bool ok = grow >= ci.lo && grow < ci.hi; const int gr = ok ? grow : ci.row0;
        const unsigned v = *(const unsigned*)(P + (size_t)gr * NP + 2 * cp), g = *(const unsigned*)(P + (size_t)gr * NP + 256 + 2 * cp);
        const unsigned o = pk2(bflo(v) * sigm(bflo(g)), bfhi(v) * sigm(bfhi(g)));
        *(LAS unsigned*)(HG + rr * 256 + 2 * cp) = ok ? o : 0u;
    }
    __syncthreads();
    {
        const int c = C.tid & 255, half = C.tid >> 8;
        const float* cw = C.in[10] + (size_t)layer * 31 * 256 + c;
        float w[31];
#pragma unroll
        for (int j = 0; j < 31; ++j) w[j] = cw[j * 256];
        const float bias = C.in[11][layer * 256 + c];
        float hv[62];
#pragma unroll
        for (int i = 0; i < 62; ++i) hv[i] = bf2f(HG[(half * 32 + i) * 256 + c]);
#pragma unroll
        for (int tt = 0; tt < 32; ++tt) { float acc = bias;
#pragma unroll
            for (int j = 0; j < 31; ++j) acc += w[j] * hv[tt + j];
            CO[(half * 32 + tt) * 256 + c] = acc; }
    }
    __syncthreads();
    {
        const float* lg = C.in[12] + layer * 256 + 4 * C.lane; const float* lb = C.in[13] + layer * 256 + 4 * C.lane;
        const f32x4 g4 = *(const f32x4*)lg, b4 = *(const f32x4*)lb;
        for (int i = 0; i < 8; ++i) {
            const int t = C.wid * 8 + i;
            const f32x4 x = *(const LAS f32x4*)(CO + t * 256 + 4 * C.lane);
            const float mean = wave_sum((x.x + x.y) + (x.z + x.w)) * (1.f / 256.f);
            const f32x4 d = x - mean;
            const float var = wave_sum((d.x * d.x + d.y * d.y) + (d.z * d.z + d.w * d.w)) * (1.f / 256.f);
            const float rs = rsqrtf(var + 1e-5f);
            const f32x4 y = d * rs * g4 + b4;
            u32x2 o; o.x = pk2(silu(y.x), silu(y.y)); o.y = pk2(silu(y.z), silu(y.w));
            *(u32x2*)(YC + (size_t)(ci.row0 + t) * DM + 4 * C.lane) = o;
        }
    }
    __syncthreads();
}

__device__ __forceinline__ void item_chunkmlp(const Ctx& C, int layer, int gb) {
    const int row0 = gb * 128;
    const bf16_t* P = (const bf16_t*)(C.ws + WS_P); bf16_t* YC = (bf16_t*)(C.ws + WS_ACT);
    LAS bf16_t* VNT = (LAS bf16_t*)C.lds;
    LAS bf16_t* WS = (LAS bf16_t*)(C.lds + 69632);
    {
        const f32x4 g4 = *(const f32x4*)(C.in[14] + layer * 256 + 4 * C.lane), b4 = *(const f32x4*)(C.in[15] + layer * 256 + 4 * C.lane);
        for (int i = 0; i < 16; ++i) {
            const int j = C.wid * 16 + i;
            const u32x2 raw = *(const u32x2*)(P + (size_t)(row0 + j) * NP + 768 + 4 * C.lane);
            const f32x4 x = {bflo(raw.x), bfhi(raw.x), bflo(raw.y), bfhi(raw.y)};
            const float mean = wave_sum((x.x + x.y) + (x.z + x.w)) * (1.f / 256.f);
            const f32x4 d = x - mean;
            const float var = wave_sum((d.x * d.x + d.y * d.y) + (d.z * d.z + d.w * d.w)) * (1.f / 256.f);
            const f32x4 y = d * rsqrtf(var + 1e-5f) * g4 + b4;
            VNT[(4 * C.lane + 0) * 136 + j] = f2bf(y.x); VNT[(4 * C.lane + 1) * 136 + j] = f2bf(y.y);
            VNT[(4 * C.lane + 2) * 136 + j] = f2bf(y.z); VNT[(4 * C.lane + 3) * 136 + j] = f2bf(y.w);
        }
    }
    for (int h = 0; h < 4; ++h) {
        const float* ws = C.in[16] + ((size_t)layer * 4 + h) * 128 * 128;
        for (int e = C.tid; e < 4096; e += 512) { const int i = e >> 5, j4 = (e & 31) * 4; const f32x4 w = *(const f32x4*)(ws + i * 128 + j4);
            u32x2 o; o.x = pk2(w.x, w.y); o.y = pk2(w.z, w.w); *(LAS u32x2*)(WS + i * 136 + j4) = o; }
        __syncthreads();
        const float* bs = C.in[17] + ((size_t)layer * 4 + h) * 128;
        {
            const int fr = C.lane & 15, fq = C.lane >> 4;
            unsigned short ur[4][4];
#pragma unroll
            for (int i = 0; i < 4; ++i) { const int tt = C.wid + 8 * i, tm = tt >> 2, tn = tt & 3;
#pragma unroll
                for (int jj = 0; jj < 4; ++jj) ur[i][jj] = P[(size_t)(row0 + tm * 16 + fq * 4 + jj) * NP + 512 + h * 64 + tn * 16 + fr]; }
#pragma unroll
            for (int i = 0; i < 4; ++i) { const int tt = C.wid + 8 * i, tm = tt >> 2, tn = tt & 3;
                f32x4 acc = {0.f, 0.f, 0.f, 0.f};
#pragma unroll
                for (int ks = 0; ks < 4; ++ks) acc = __builtin_amdgcn_mfma_f32_16x16x32_bf16(*(const LAS bf16x8*)(WS + (tm * 16 + fr) * 136 + ks * 32 + fq * 8),
                                                                                             *(const LAS bf16x8*)(VNT + (h * 64 + tn * 16 + fr) * 136 + ks * 32 + fq * 8), acc, 0, 0, 0);
#pragma unroll
                for (int jj = 0; jj < 4; ++jj) { const int ii = tm * 16 + fq * 4 + jj;
                    YC[(size_t)(row0 + ii) * DM + 256 + h * 64 + tn * 16 + fr] = f2bf((acc[jj] + bs[ii]) * bf2f(ur[i][jj])); }
            }
        }
        __syncthreads();
    }
}

__device__ __forceinline__ void item_mamba_local(const Ctx& C, int layer, int gc) {
    const ChunkInfo ci = chunk_info(gc);
    const bf16_t* P = (const bf16_t*)(C.ws + WS_P);
    bf16_t* MSTb = (bf16_t*)(C.ws + WS_MST); float* MCD = (float*)(C.ws + WS_MCD);
    LAS float* DA = (LAS float*)C.lds;
    LAS float* DT = (LAS float*)(C.lds + 2048);
    LAS float* FAC = (LAS float*)(C.lds + 4096);
    LAS bf16_t* XDT = (LAS bf16_t*)(C.lds + 8192);
    LAS bf16_t* BTT = (LAS bf16_t*)(C.lds + 8192 + 73728);
    {
        const int s = C.lane, dh = C.wid, d = dh >> 2, h = dh & 3;
        const float raw = bf2f(P[(size_t)(ci.row0 + s) * NP + OFF_C + 1024 + dh]);
        const float dt = softplus(raw + C.in[20][layer * 8 + dh]);
        const float da = dt * (-expf(C.in[21][layer * 8 + dh]));
        const float incl = wave_incl_scan(da, s), total = __shfl(incl, 63);
        DT[dh * 64 + s] = dt; DA[dh * 64 + s] = da;
        FAC[dh * 64 + s] = d ? fexp(incl - da) : fexp(total - incl);
        if (s == 0) MCD[slot_of(ci.b, h, d, cpos_of(ci, d))] = expf(total);
    }
    __syncthreads();
    {
        const int cp = C.tid & 255, half = C.tid >> 8, c0 = 2 * cp;
        const float* cw = C.in[18] + (size_t)layer * 5 * 768 + c0; const float* cb = C.in[19] + layer * 768 + c0;
        float w0[5], w1[5];
#pragma unroll
        for (int j = 0; j < 5; ++j) { w0[j] = cw[j * 768]; w1[j] = cw[j * 768 + 1]; }
        const float b0 = cb[0], b1 = cb[1];
        const int s0 = half * 32;
        unsigned wr[36];
        unsigned short ob[4][8];
#pragma unroll
        for (int j = 0; j < 36; ++j) { const int row = ci.row0 + s0 - 2 + j; const bool ok = row >= ci.lo && row < ci.hi; const unsigned v = *(const unsigned*)(P + (size_t)(ok ? row : ci.row0) * NP + OFF_C + 256 + c0); wr[j] = ok ? v : 0u; }
#pragma unroll
        for (int tt = 0; tt < 32; ++tt) {
            const int s = s0 + tt;
            const unsigned* win = wr + tt;
            float a0 = b0, a1 = b1;
#pragma unroll
            for (int j = 0; j < 5; ++j) { a0 += w0[j] * bflo(win[j]); a1 += w1[j] * bfhi(win[j]); }
            a0 = silu(a0); a1 = silu(a1);
            if (c0 < 256) { const int h = c0 >> 6;
#pragma unroll
                for (int d = 0; d < 2; ++d) { const float f = DT[(d * 4 + h) * 64 + s] * FAC[(d * 4 + h) * 64 + s]; ob[d * 2][tt & 7] = f2bf(a0 * f); ob[d * 2 + 1][tt & 7] = f2bf(a1 * f); }
            } else { ob[0][tt & 7] = f2bf(a0); ob[1][tt & 7] = f2bf(a1); }
            if ((tt & 7) == 7) { const int sb = s - 7;
#define C1_PACK8(a) (u32x4){(unsigned)a[0] | ((unsigned)a[1] << 16), (unsigned)a[2] | ((unsigned)a[3] << 16), (unsigned)a[4] | ((unsigned)a[5] << 16), (unsigned)a[6] | ((unsigned)a[7] << 16)}
                if (c0 < 256) {
#pragma unroll
                    for (int d = 0; d < 2; ++d) { *(LAS u32x4*)(XDT + (d * 256 + c0) * 72 + sb) = C1_PACK8(ob[d * 2]); *(LAS u32x4*)(XDT + (d * 256 + c0 + 1) * 72 + sb) = C1_PACK8(ob[d * 2 + 1]); }
                } else { const int q = c0 - 256; *(LAS u32x4*)(BTT + q * 72 + sb) = C1_PACK8(ob[0]); *(LAS u32x4*)(BTT + (q + 1) * 72 + sb) = C1_PACK8(ob[1]); }
#undef C1_PACK8
            }
        }
    }
    __syncthreads();
    for (int hd = 0; hd < 8; ++hd) {
        const int d = hd >> 2, h = hd & 3;
        bf16_t* dst = MSTb + (size_t)slot_of(ci.b, h, d, cpos_of(ci, d)) * 8192;
        blk_mma<8, 4, 2>(BTT + (h >> 1) * 128 * 72, 72, XDT + (d * 256 + h * 64) * 72, 72, C.wid, C.lane, [=](int r0, int col, const f32x4& acc) {
            u32x2 o; o.x = pk2(acc[0], acc[1]); o.y = pk2(acc[2], acc[3]); *(u32x2*)(dst + col * 128 + r0) = o;
        });
    }
    __syncthreads();
}


#ifndef MK_DIAG2
#define MK_DIAG2 0
#endif
#if MK_DIAG2
#define DBGF(stage, cond) do { if (cond) atomicOr((unsigned*)(C.ws + 32768) + (stage), 1u); } while (0)
#define DBGL(stage, cond) do { if (cond) atomicOr(dbgflags + (stage), 1u); } while (0)
#else
#define DBGF(stage, cond) do {} while (0)
#define DBGL(stage, cond) do {} while (0)
#endif
__device__ __forceinline__ bool badv(float x, float lim) { return !(fabsf(x) < lim); }
__device__ __forceinline__ void tri_inverse(const LAS float* ABf, LAS float* Tf, LAS float* Rt, LAS bf16_t* TT, int tid, int wid, int lane) {
    if (wid == 0) {
        const int bi = lane >> 4, j = lane & 15; const LAS float* Ab = ABf + (16 * bi) * 68 + 16 * bi;
        float col[16];
#pragma unroll
        for (int r = 0; r < 16; ++r) { float acc = (r == j) ? 1.f : 0.f;
#pragma unroll
            for (int s = 0; s < r; ++s) acc -= Ab[r * 68 + s] * col[s];
            col[r] = acc; }
#pragma unroll
        for (int r = 0; r < 16; ++r) Tf[(16 * bi + r) * 68 + 16 * bi + j] = col[r];
    } else {
        for (int e = tid - 64; e < 64 * 64; e += 448) { const int t = e >> 6, s2 = e & 63; if ((s2 >> 4) > (t >> 4)) Tf[t * 68 + s2] = 0.f; }
    }
    __syncthreads();
    if (wid < 3) {
        const int tn = wid, fr = lane & 15, fq = lane >> 4;
        LAS float* Rw = Rt + wid * 320;
        for (int i = tn + 1; i < 4; ++i) {
            f32x4 acc = {0.f, 0.f, 0.f, 0.f};
            for (int k = 16 * tn; k < 16 * i; k += 4) acc = __builtin_amdgcn_mfma_f32_16x16x4f32(ABf[(16 * i + fr) * 68 + k + fq], Tf[(k + fq) * 68 + 16 * tn + fr], acc, 0, 0, 0);
#pragma unroll
            for (int j = 0; j < 4; ++j) Rw[(fq * 4 + j) * 20 + fr] = -acc[j];
            asm volatile("s_waitcnt lgkmcnt(0)" ::: "memory");
            f32x4 t = {0.f, 0.f, 0.f, 0.f};
#pragma unroll
            for (int k = 0; k < 16; k += 4) t = __builtin_amdgcn_mfma_f32_16x16x4f32(Tf[(16 * i + fr) * 68 + 16 * i + k + fq], Rw[(k + fq) * 20 + fr], t, 0, 0, 0);
#pragma unroll
            for (int j = 0; j < 4; ++j) Tf[(16 * i + fq * 4 + j) * 68 + 16 * tn + fr] = t[j];
            asm volatile("s_waitcnt lgkmcnt(0)" ::: "memory");
        }
    }
    __syncthreads();
    for (int e = tid; e < 4096; e += 512) { const int t = e >> 6, s2 = e & 63; TT[t * 72 + s2] = f2bf(Tf[t * 68 + s2]); }
}
struct D1Pre { unsigned w[24]; unsigned lw[8]; int hd; };
__device__ __forceinline__ void d1_load_rows(const Ctx& C, int it, unsigned (&w)[24]) {
    const int gc = it >> 3, hd = it & 7, h = hd & 3, d = hd >> 2;
    const ChunkInfo ci = chunk_info(gc);
    const bf16_t* P = (const bf16_t*)(C.ws + WS_P);
    if (C.tid < 480) {
        const int q = C.tid % 160, seg = C.tid / 160, grp = q >> 5, c = (q & 31) * 2;
        const int j = (grp == 0 ? h * 64 : grp == 1 ? 256 + h * 64 : grp == 2 ? 512 + h * 64 : grp == 3 ? 768 + d * 64 : 896 + d * 64) + c;
        const int t0 = seg * 22, nt = seg == 2 ? 20 : 22;
        const bf16_t* pp = P + (size_t)(ci.row0 + t0) * NP + OFF_D + j;
#pragma unroll
        for (int i = 0; i < 24; ++i) { const int row = ci.row0 + t0 - 1 + i; const bool ok = row >= ci.lo && row < ci.hi; const int rc = ok ? row : ci.row0;
            const unsigned v = (i < nt + 2) ? *(const unsigned*)(pp + (ptrdiff_t)(rc - (ci.row0 + t0)) * NP) : 0u; w[i] = ok ? v : 0u; }
    }
}
constexpr int D1_LW = 0, D1_CS = 17408, D1_AA = 34816, D1_RB = 52224, D1_KB = 61440, D1_VB = 70656, D1_TW = 79872, D1_AD = 89088, D1_W2T = 98304, D1_A2T = 107520;
constexpr int D1_Y = 82944;
constexpr int D1_ABF = 0, D1_AK = 17408, D1_ARK = 26624, D1_ARB = 35840, D1_TT = 45056, D1_W1T = 54272, D1_AKVT = 63488, D1_W2TT = 72704;
constexpr int D1_GL = 156672;
__device__ __forceinline__ void item_rwkv_local(const Ctx& C0_, int layer, int it, D1Pre& pre, int it_next) {
    Ctx C = C0_; { int t_ = C0_.tid; asm volatile("" : "+v"(t_)); C.tid = t_; C.lane = t_ & 63; C.wid = __builtin_amdgcn_readfirstlane(t_ >> 6); }
#define D1_RELAUNDER() do { int t_ = C.tid; asm volatile("" : "+v"(t_)); C.tid = t_; C.lane = t_ & 63; C.wid = __builtin_amdgcn_readfirstlane(t_ >> 6); } while (0)
    const int gc = it >> 3, hd = it & 7, h = hd & 3, d = hd >> 2;
    const ChunkInfo ci = chunk_info(gc);
    const int slot = slot_of(ci.b, h, d, cpos_of(ci, d));
    const bf16_t* P = (const bf16_t*)(C.ws + WS_P);
    const float* mup = C.in[24] + layer * 1152; const float* mun = C.in[25] + layer * 1152;
    lds_t L = C.lds;
    LAS float* LW = (LAS float*)(L + D1_LW); LAS float* CS = (LAS float*)(L + D1_CS); LAS float* AA = (LAS float*)(L + D1_AA); LAS float* GL = (LAS float*)(L + D1_GL);
    LAS bf16_t* Rb = (LAS bf16_t*)(L + D1_RB); LAS bf16_t* Kb = (LAS bf16_t*)(L + D1_KB); LAS bf16_t* Vb = (LAS bf16_t*)(L + D1_VB);
    LAS bf16_t* TW = (LAS bf16_t*)(L + D1_TW); LAS bf16_t* AD = (LAS bf16_t*)(L + D1_AD); LAS bf16_t* W2T = (LAS bf16_t*)(L + D1_W2T); LAS bf16_t* A2T = (LAS bf16_t*)(L + D1_A2T);
    LAS bf16_t* KT = (LAS bf16_t*)(L + D1_Y); LAS bf16_t* KTt = KT + 4608; LAS bf16_t* KD = KT + 2 * 4608; LAS bf16_t* KDt = KT + 3 * 4608;
    LAS bf16_t* BT = KT + 4 * 4608; LAS bf16_t* BTt = KT + 5 * 4608; LAS bf16_t* RT = KT + 6 * 4608; LAS bf16_t* Vt = KT + 7 * 4608;
    LAS float* ABf = (LAS float*)(L + D1_ABF); LAS bf16_t* AK = (LAS bf16_t*)(L + D1_AK); LAS bf16_t* ARK = (LAS bf16_t*)(L + D1_ARK); LAS bf16_t* ARB = (LAS bf16_t*)(L + D1_ARB);
    LAS bf16_t* TT = (LAS bf16_t*)(L + D1_TT); LAS bf16_t* W1t = (LAS bf16_t*)(L + D1_W1T); LAS bf16_t* AKVt = (LAS bf16_t*)(L + D1_AKVT); LAS bf16_t* W2t = (LAS bf16_t*)(L + D1_W2TT);

    if (C.tid < 480) {
        const int q = C.tid % 160, seg = C.tid / 160, grp = q >> 5, c = (q & 31) * 2;
        const int j = (grp == 0 ? h * 64 : grp == 1 ? 256 + h * 64 : grp == 2 ? 512 + h * 64 : grp == 3 ? 768 + d * 64 : 896 + d * 64) + c;
        const int t0 = seg * 22, nt = seg == 2 ? 20 : 22;
        const float mp0 = mup[j], mp1 = mup[j + 1], mn0 = mun[j], mn1 = mun[j + 1];
        unsigned w[24]; { const bf16_t* pp = P + (size_t)(ci.row0 + t0) * NP + OFF_D + j;
#pragma unroll
        for (int i = 0; i < 24; ++i) { const int row = ci.row0 + t0 - 1 + i; const bool ok = row >= ci.lo && row < ci.hi; const int rc = ok ? row : ci.row0;
            const unsigned v = (i < nt + 2) ? *(const unsigned*)(pp + (ptrdiff_t)(rc - (ci.row0 + t0)) * NP) : 0u; w[i] = ok ? v : 0u; } }
        LAS bf16_t* dst = (grp == 0 ? Rb : grp == 1 ? Kb : grp == 2 ? Vb : grp == 3 ? TW : AD);
#pragma unroll
        for (int i = 0; i < 22; ++i) if (i < nt) {
            const float x0 = bflo(w[i + 1]), x1 = bfhi(w[i + 1]);
            const float v0 = x0 + mp0 * (bflo(w[i]) - x0) + mn0 * (bflo(w[i + 2]) - x0);
            const float v1 = x1 + mp1 * (bfhi(w[i]) - x1) + mn1 * (bfhi(w[i + 2]) - x1);
            DBGF(1, badv(v0, 1e4f) || badv(v1, 1e4f));
            const unsigned o = (grp == 3) ? pk2(ftanh(v0), ftanh(v1)) : pk2(v0, v1);
            const int tl = t0 + i, l = d ? 63 - tl : tl;
            *(LAS unsigned*)(dst + l * 72 + c) = o;
        }
    }
    {
        if (pre.hd != hd) {
            const float* w2 = C.in[27] + ((size_t)layer * 2 + d) * 64 * 256 + h * 64; const float* a2 = C.in[29] + ((size_t)layer * 2 + d) * 64 * 256 + h * 64;
#pragma unroll
            for (int k = 0; k < 8; ++k) { const int e = C.tid + 512 * k, r = e >> 6, c = e & 63; pre.lw[k] = pk2(w2[r * 256 + c], a2[r * 256 + c]); }
            pre.hd = hd;
        }
#pragma unroll
        for (int k = 0; k < 8; ++k) { const int e = C.tid + 512 * k, r = e >> 6, c = e & 63; W2T[c * 72 + r] = (unsigned short)(pre.lw[k] & 0xffffu); A2T[c * 72 + r] = (unsigned short)(pre.lw[k] >> 16); }
    }
    __syncthreads();
    D1_RELAUNDER();
    {
        unsigned* dbgflags = (unsigned*)(C.ws + 32768); (void)dbgflags;
        const float* w0 = C.in[26] + ((size_t)layer * 2 + d) * 256 + h * 64; const float* a0 = C.in[28] + ((size_t)layer * 2 + d) * 256 + h * 64;
        blk_mma<4, 4, 2>(TW, 72, W2T, 72, C.wid, C.lane, [=](int r0, int col, const f32x4& acc) {
#pragma unroll
            for (int jj = 0; jj < 4; ++jj) { const float w = w0[col] + acc[jj]; DBGL(2, badv(w, 1e4f)); LW[(r0 + jj) * 68 + col] = -fexp(-softplus(-w) - 0.5f); }
        });
        blk_mma<4, 4, 2>(AD, 72, A2T, 72, C.wid, C.lane, [=](int r0, int col, const f32x4& acc) {
#pragma unroll
            for (int jj = 0; jj < 4; ++jj) { DBGL(2, badv(acc[jj], 1e4f)); AA[(r0 + jj) * 68 + col] = sigm(a0[col] + acc[jj]); }
        });
    }
    __syncthreads();
    {
#pragma unroll
        for (int i = 0; i < 8; ++i) { const int c = C.wid * 8 + i; const float incl = wave_incl_scan(LW[C.lane * 68 + c], C.lane); CS[C.lane * 68 + c] = incl; if (C.lane == 63) GL[c] = fexp(incl); }
    }
    __syncthreads();
    D1_RELAUNDER();
    {
        const int c = C.lane, l0 = C.wid * 8;
        const float kkw = C.in[31][layer * 256 + h * 64 + c], kaw = C.in[32][layer * 256 + h * 64 + c], rkw = C.in[33][layer * 256 + h * 64 + c];
        unsigned short kt[8], kd[8], bt[8], vt[8];
#pragma unroll
        for (int i = 0; i < 8; ++i) { const int l = l0 + i;
            const float k = bf2f(Kb[l * 72 + c]), r = bf2f(Rb[l * 72 + c]), v = bf2f(Vb[l * 72 + c]), aa = AA[l * 68 + c];
            const float kkr = k * kkw, kdv = k * (1.f + (aa - 1.f) * kaw);
            const float ss = wave_sum(kkr * kkr), bon = wave_sum(r * kdv * rkw);
            const float kkn = kkr * rsqrtf(ss + 1e-12f);
            if (c == 0) ((float*)(C.ws + WS_BON))[(size_t)(ci.row0 + (d ? 63 - l : l)) * 8 + h * 2 + d] = bon;
            const float cs = CS[l * 68 + c], lw = LW[l * 68 + c];
            const float ge = fexp(cs - lw), gi = fexp(cs), gn = fexp(-cs);
            DBGF(3, badv(cs, 50.f) || cs > 0.f || badv(lw, 1.f)); DBGF(4, badv(kkn * ge, 10.f) || badv(r * gi, 1e4f) || badv(v, 1e4f)); DBGF(5, badv(kdv * gn, 1e25f) || badv(kkn * aa * gn, 1e25f));
            kt[i] = f2bf(kkn * ge); kd[i] = f2bf(kdv * gn); bt[i] = f2bf(kkn * aa * gn); vt[i] = f2bf(v);
            KT[l * 72 + c] = kt[i]; KD[l * 72 + c] = kd[i]; BT[l * 72 + c] = bt[i]; RT[l * 72 + c] = f2bf(r * gi); }
#define D1_PACK8(a) (u32x4){(unsigned)a[0] | ((unsigned)a[1] << 16), (unsigned)a[2] | ((unsigned)a[3] << 16), (unsigned)a[4] | ((unsigned)a[5] << 16), (unsigned)a[6] | ((unsigned)a[7] << 16)}
        *(LAS u32x4*)(KTt + c * 72 + l0) = D1_PACK8(kt); *(LAS u32x4*)(KDt + c * 72 + l0) = D1_PACK8(kd);
        *(LAS u32x4*)(BTt + c * 72 + l0) = D1_PACK8(bt); *(LAS u32x4*)(Vt + c * 72 + l0) = D1_PACK8(vt);
#undef D1_PACK8
    }
    __syncthreads();
    D1_RELAUNDER();
    unsigned* dbgflags = (unsigned*)(C.ws + 32768); (void)dbgflags;
    blk_mma2<4, 4, 2>(BT, KT, KD, KT, 72, C.wid, C.lane, [=](int r0, int col, const f32x4& ab, const f32x4& ak) {
        f32x4 a; float k[4];
#pragma unroll
        for (int jj = 0; jj < 4; ++jj) { const bool lo = r0 + jj < col; DBGL(6, lo && (badv(ab[jj], 1e3f) || badv(ak[jj], 1e4f))); a[jj] = lo ? ab[jj] : 0.f; k[jj] = lo ? ak[jj] : 0.f; }
        *(LAS f32x4*)(ABf + col * 68 + r0) = a;
        u32x2 o; o.x = pk2(k[0], k[1]); o.y = pk2(k[2], k[3]); *(LAS u32x2*)(AK + col * 72 + r0) = o;
    });
    blk_mma2<4, 4, 2>(KD, RT, BT, RT, 72, C.wid, C.lane, [=](int r0, int col, const f32x4& rk, const f32x4& rb) {
        float a[4], b[4];
#pragma unroll
        for (int jj = 0; jj < 4; ++jj) { const bool le = r0 + jj <= col; DBGL(7, le && (badv(rk[jj], 1e5f) || badv(rb[jj], 1e5f))); a[jj] = le ? rk[jj] : 0.f; b[jj] = le ? rb[jj] : 0.f; }
        u32x2 oa, ob; oa.x = pk2(a[0], a[1]); oa.y = pk2(a[2], a[3]); ob.x = pk2(b[0], b[1]); ob.y = pk2(b[2], b[3]);
        *(LAS u32x2*)(ARK + col * 72 + r0) = oa; *(LAS u32x2*)(ARB + col * 72 + r0) = ob;
    });
    __syncthreads();
    tri_inverse(ABf, (LAS float*)(L + 54272), (LAS float*)(L + 71680), TT, C.tid, C.wid, C.lane);
    __syncthreads();
#if MK_DIAG2
    for (int e = C.tid; e < 4096; e += 512) DBGF(8, badv(bf2f(TT[(e >> 6) * 72 + (e & 63)]), 1e3f));
#endif
    D1_RELAUNDER();
    blk_mma2<4, 4, 2>(TT, KTt, AK, Vt, 72, C.wid, C.lane, [=](int r0, int col, const f32x4& w1, const f32x4& akv) {
        DBGL(9, badv(w1[0], 1e3f) || badv(w1[1], 1e3f) || badv(w1[2], 1e3f) || badv(w1[3], 1e3f)); DBGL(10, badv(akv[0], 1e5f) || badv(akv[1], 1e5f) || badv(akv[2], 1e5f) || badv(akv[3], 1e5f));
        u32x2 a, b; a.x = pk2(w1[0], w1[1]); a.y = pk2(w1[2], w1[3]); b.x = pk2(akv[0], akv[1]); b.y = pk2(akv[2], akv[3]);
        *(LAS u32x2*)(W1t + col * 72 + r0) = a; *(LAS u32x2*)(AKVt + col * 72 + r0) = b;
    });
    __syncthreads();
    blk_mma<4, 4, 2>(TT, 72, AKVt, 72, C.wid, C.lane, [=](int r0, int col, const f32x4& w2) {
        DBGL(11, badv(w2[0], 1e5f) || badv(w2[1], 1e5f) || badv(w2[2], 1e5f) || badv(w2[3], 1e5f));
        u32x2 a; a.x = pk2(w2[0], w2[1]); a.y = pk2(w2[2], w2[3]); *(LAS u32x2*)(W2t + col * 72 + r0) = a;
    });
    __syncthreads();
    D1_RELAUNDER();
    {
        bf16_t* Gg = (bf16_t*)(C.ws + WS_RG) + (size_t)slot * 4096; bf16_t* Jg = (bf16_t*)(C.ws + WS_RJ) + (size_t)slot * 4096;
        bf16_t* Ryg = (bf16_t*)(C.ws + WS_RY) + (size_t)slot * 4096; bf16_t* Ylg = (bf16_t*)(C.ws + WS_RL) + (size_t)slot * 4096;
        blk_mma2<4, 4, 2>(W1t, BTt, W1t, ARB, 72, C.wid, C.lane, [=](int r0, int col, const f32x4& gp, const f32x4& rbw) {
            const float gl = GL[col]; float g[4], ry[4];
            const u32x2 rt = *(const LAS u32x2*)(RT + col * 72 + r0);
            const float rtv[4] = {bflo(rt.x), bfhi(rt.x), bflo(rt.y), bfhi(rt.y)};
#pragma unroll
            for (int jj = 0; jj < 4; ++jj) { g[jj] = gl * ((col == r0 + jj ? 1.f : 0.f) - gp[jj]); ry[jj] = rtv[jj] - rbw[jj]; }
            u32x2 og, oy; og.x = pk2(g[0], g[1]); og.y = pk2(g[2], g[3]); oy.x = pk2(ry[0], ry[1]); oy.y = pk2(ry[2], ry[3]);
            *(u32x2*)(Gg + col * 64 + r0) = og;
            *(u32x2*)(Ryg + col * 64 + r0) = oy;
        });
        blk_mma2<4, 4, 2>(KDt, Vt, BTt, W2t, 72, C.wid, C.lane, [=](int r0, int col, const f32x4& kv, const f32x4& bw) {
            f32x4 o;
#pragma unroll
            for (int jj = 0; jj < 4; ++jj) { o[jj] = GL[r0 + jj] * (kv[jj] - bw[jj]); DBGL(12, badv(GL[r0 + jj] * kv[jj], 1e5f)); DBGL(13, badv(GL[r0 + jj] * bw[jj], 1e5f)); DBGL(14, badv(o[jj], 1e5f)); }
            u32x2 oj; oj.x = pk2(o[0], o[1]); oj.y = pk2(o[2], o[3]); *(u32x2*)(Jg + col * 64 + r0) = oj;
        });
        blk_mma2<4, 4, 2>(ARK, Vt, ARB, W2t, 72, C.wid, C.lane, [=](int r0, int col, const f32x4& a, const f32x4& b) {
            u32x2 o; o.x = pk2(a[0] - b[0], a[1] - b[1]); o.y = pk2(a[2] - b[2], a[3] - b[3]);
            *(u32x2*)(Ylg + col * 64 + r0) = o;
        });
    }
    __syncthreads();
}

typedef float f32x2p __attribute__((ext_vector_type(2)));
__device__ __forceinline__ void ph_scan(const Ctx& C, int nrep = 1, bool mstore = true, bool chain = true) {
    if (C.bid < 64) {
      if (chain)
      for (int rep = 0; rep < nrep; ++rep) {
        constexpr int NB = 8;
        const int chain_id = C.bid >> 2, w4 = C.bid & 3, fr = C.lane & 15, fq = C.lane >> 4;
        LAS bf16_t* Gs = (LAS bf16_t*)C.lds;
        LAS bf16_t* Js = Gs + NB * 4608;
        const bf16_t* Gg = (const bf16_t*)(C.ws + WS_RG) + (size_t)chain_id * NCH * 4096;
        const bf16_t* Jg = (const bf16_t*)(C.ws + WS_RJ) + (size_t)chain_id * NCH * 4096 + (size_t)(16 * w4) * 64;
        bf16_t* Hg = (bf16_t*)(C.ws + WS_RH) + (size_t)chain_id * NCH * 4096 + (16 * w4 + fr) * 64 + fq * 4;
        u32x4 pf[10];
#define CHAIN_ISSUE(b0_) do { _Pragma("unroll") for (int i = 0; i < 10; ++i) { const int e = C.tid + 512 * i, st = e / 640, q = e % 640; const size_t cp = (size_t)((b0_) + st < NCH ? (b0_) + st : NCH - 1) * 4096; \
            pf[i] = *(const u32x4*)(q < 512 ? Gg + cp + q * 8 : Jg + cp + (q - 512) * 8); } } while (0)
#define CHAIN_STAGE() do { _Pragma("unroll") for (int i = 0; i < 10; ++i) { const int e = C.tid + 512 * i, st = e / 640, q = e % 640; \
            if (q < 512) *(LAS u32x4*)(Gs + st * 4608 + (q >> 3) * 72 + (q & 7) * 8) = pf[i]; else *(LAS u32x4*)(Js + st * 1152 + ((q - 512) >> 3) * 72 + (q & 7) * 8) = pf[i]; } } while (0)
        f32x4 acc[4];
#pragma unroll
        for (int tm = 0; tm < 4; ++tm) acc[tm] = (f32x4){0.f, 0.f, 0.f, 0.f};
        CHAIN_ISSUE(0);
        for (int b0 = 0; b0 < NCH; b0 += NB) {
            __syncthreads();
            CHAIN_STAGE();
            __syncthreads();
            if (b0 + NB < NCH) CHAIN_ISSUE(b0 + NB);
            if (C.wid == 0) {
                const int nb = NCH - b0 < NB ? NCH - b0 : NB;
                u32x2 ga[2][4][2][2], jn[2][4];
#define CHAIN_LDG(buf_, st_) do { const int s_ = (st_) < NB ? (st_) : NB - 1; _Pragma("unroll") for (int tm = 0; tm < 4; ++tm) { \
                    jn[buf_][tm] = *(const LAS u32x2*)(Js + s_ * 1152 + fr * 72 + tm * 16 + fq * 4); \
                    _Pragma("unroll") for (int c = 0; c < 2; ++c) { ga[buf_][tm][c][0] = *(const LAS u32x2*)(Gs + s_ * 4608 + (tm * 16 + fr) * 72 + c * 32 + fq * 4); \
                                                                   ga[buf_][tm][c][1] = *(const LAS u32x2*)(Gs + s_ * 4608 + (tm * 16 + fr) * 72 + c * 32 + 16 + fq * 4); } } } while (0)
#define CHAIN_STEP(cur_, st_) do { const int cpos = b0 + (st_); u32x2 o[4]; \
                    _Pragma("unroll") for (int tm = 0; tm < 4; ++tm) { o[tm].x = pk2(acc[tm][0], acc[tm][1]); o[tm].y = pk2(acc[tm][2], acc[tm][3]); } \
                    const bf16x8 b0v = (bf16x8)((u32x4){o[0].x, o[0].y, o[1].x, o[1].y}), b1v = (bf16x8)((u32x4){o[2].x, o[2].y, o[3].x, o[3].y}); \
                    CHAIN_LDG((cur_) ^ 1, (st_) + 1); \
                    _Pragma("unroll") for (int tm = 0; tm < 4; ++tm) { const u32x2 jr = jn[cur_][tm]; \
                        f32x4 a = {bflo(jr.x), bfhi(jr.x), bflo(jr.y), bfhi(jr.y)}; \
                        a = __builtin_amdgcn_mfma_f32_16x16x32_bf16((bf16x8)((u32x4){ga[cur_][tm][0][0].x, ga[cur_][tm][0][0].y, ga[cur_][tm][0][1].x, ga[cur_][tm][0][1].y}), b0v, a, 0, 0, 0); \
                        a = __builtin_amdgcn_mfma_f32_16x16x32_bf16((bf16x8)((u32x4){ga[cur_][tm][1][0].x, ga[cur_][tm][1][0].y, ga[cur_][tm][1][1].x, ga[cur_][tm][1][1].y}), b1v, a, 0, 0, 0); \
                        acc[tm] = a; } \
                    _Pragma("unroll") for (int tm = 0; tm < 4; ++tm) *(u32x2*)(Hg + (size_t)cpos * 4096 + tm * 16) = o[tm]; } while (0)
                CHAIN_LDG(0, 0);
                for (int st = 0; st < nb; st += 2) { CHAIN_STEP(0, st); CHAIN_STEP(1, st + 1); }
#undef CHAIN_LDG
#undef CHAIN_STEP
            }
        }
#undef CHAIN_ISSUE
#undef CHAIN_STAGE
        __syncthreads();
      }
    } else {
        unsigned* MST = (unsigned*)(C.ws + WS_MST); const float* MCD = (const float*)(C.ws + WS_MCD);
        const int nthr = (C.G - 64) * 512;
        for (int e = (C.bid - 64) * 512 + C.tid; e < 16 * 4096; e += nthr) {
            const int chain = __builtin_amdgcn_readfirstlane(e >> 12), el = e & 4095; float r0 = 0.f, r1 = 0.f;
            unsigned* p = MST + (size_t)chain * NCH * 4096 + el; const float* cd = MCD + chain * NCH;
            constexpr int GRP = 33;
            unsigned cur[GRP], nxt[GRP];
#pragma unroll
            for (int j = 0; j < GRP; ++j) cur[j] = p[(size_t)j * 4096];
#pragma unroll
            for (int g = 0; g < NCH / GRP; ++g) {
                if (g + 1 < NCH / GRP) {
#pragma unroll
                    for (int j = 0; j < GRP; ++j) nxt[j] = p[(size_t)((g + 1) * GRP + j) * 4096];
                }
#pragma unroll
                for (int j = 0; j < GRP; ++j) { const int cpos = g * GRP + j; const unsigned tmp = cur[j]; if (mstore) p[(size_t)cpos * 4096] = pk2(r0, r1); const float c = cd[cpos]; r0 = r0 * c + bflo(tmp); r1 = r1 * c + bfhi(tmp); }
                if (g + 1 < NCH / GRP) {
#pragma unroll
                    for (int j = 0; j < GRP; ++j) cur[j] = nxt[j];
                }
            }
            if (!mstore && r0 == 12345.678f) p[0] = 0u;
        }
    }
}

__device__ __forceinline__ void item_mamba_out(const Ctx& C0_, int layer, int gc) {
    Ctx C = C0_;
#define MO_RELAUNDER() do { int t_ = C.tid; asm volatile("" : "+v"(t_)); C.tid = t_; C.lane = t_ & 63; C.wid = __builtin_amdgcn_readfirstlane(t_ >> 6); } while (0)
    MO_RELAUNDER();
    const ChunkInfo ci = chunk_info(gc);
    const bf16_t* P = (const bf16_t*)(C.ws + WS_P); bf16_t* YC = (bf16_t*)(C.ws + WS_ACT); const bf16_t* MST = (const bf16_t*)(C.ws + WS_MST);
    lds_t L = C.lds;
    LAS float* DT = (LAS float*)L;
    LAS float* DA = (LAS float*)(L + 2048);
    LAS float* CSI = (LAS float*)(L + 4096);
    LAS float* SSQ = (LAS float*)(L + 6144);
    LAS bf16_t* CG = (LAS bf16_t*)(L + 10240);
    LAS bf16_t* BG = (LAS bf16_t*)(L + 27648);
    LAS bf16_t* XT = (LAS bf16_t*)(L + 45056);
    LAS float* CBm = (LAS float*)(L + 63488);
    LAS bf16_t* MP = (LAS bf16_t*)(L + 80896);
    LAS bf16_t* S0 = (LAS bf16_t*)(L + 90112);
    LAS bf16_t* YPRE = (LAS bf16_t*)(L + 107520);
    int fr = C.lane & 15, fq = C.lane >> 4;
    {
        const int s = C.lane, dh = C.wid;
        const float raw = bf2f(P[(size_t)(ci.row0 + s) * NP + OFF_C + 1024 + dh]);
        const float dt = softplus(raw + C.in[20][layer * 8 + dh]);
        const float da = dt * (-expf(C.in[21][layer * 8 + dh]));
        const float incl = wave_incl_scan(da, s), total = __shfl(incl, 63);
        DT[dh * 64 + s] = dt; DA[dh * 64 + s] = da;
        CSI[dh * 64 + s] = (dh < 4) ? incl : (total - incl + da);
    }
    for (int g = 0; g < 2; ++g) {
        __syncthreads();
        MO_RELAUNDER(); fr = C.lane & 15; fq = C.lane >> 4;
        {
            const int cp = C.tid & 255, half = C.tid >> 8;
            if (cp < 192) {
                const int kind = cp >> 6, cl = (cp & 63) * 2, c0 = kind * 256 + g * 128 + cl;
                const float* cw = C.in[18] + (size_t)layer * 5 * 768 + c0; const float* cb = C.in[19] + layer * 768 + c0;
                float w0[5], w1[5];
#pragma unroll
                for (int j = 0; j < 5; ++j) { w0[j] = cw[j * 768]; w1[j] = cw[j * 768 + 1]; }
                const float b0 = cb[0], b1 = cb[1];
                const int s0 = half * 32;
                unsigned wr[36];
                unsigned short xb0[8], xb1[8];
#pragma unroll
                for (int j = 0; j < 36; ++j) { const int row = ci.row0 + s0 - 2 + j; const bool ok = row >= ci.lo && row < ci.hi; const unsigned v = *(const unsigned*)(P + (size_t)(ok ? row : ci.row0) * NP + OFF_C + 256 + c0); wr[j] = ok ? v : 0u; }
#pragma unroll
                for (int tt = 0; tt < 32; ++tt) {
                    const int s = s0 + tt;
                    const unsigned* win = wr + tt;
                    float a0 = b0, a1 = b1;
#pragma unroll
                    for (int j = 0; j < 5; ++j) { a0 += w0[j] * bflo(win[j]); a1 += w1[j] * bfhi(win[j]); }
                    const unsigned short o0 = f2bf(silu(a0)), o1 = f2bf(silu(a1));
                    if (kind == 0) { xb0[tt & 7] = o0; xb1[tt & 7] = o1;
                        if ((tt & 7) == 7) { const int sb = s - 7;
                            *(LAS u32x4*)(XT + cl * 72 + sb) = (u32x4){(unsigned)xb0[0] | ((unsigned)xb0[1] << 16), (unsigned)xb0[2] | ((unsigned)xb0[3] << 16), (unsigned)xb0[4] | ((unsigned)xb0[5] << 16), (unsigned)xb0[6] | ((unsigned)xb0[7] << 16)};
                            *(LAS u32x4*)(XT + (cl + 1) * 72 + sb) = (u32x4){(unsigned)xb1[0] | ((unsigned)xb1[1] << 16), (unsigned)xb1[2] | ((unsigned)xb1[3] << 16), (unsigned)xb1[4] | ((unsigned)xb1[5] << 16), (unsigned)xb1[6] | ((unsigned)xb1[7] << 16)}; } }
                    else if (kind == 1) { *(LAS unsigned*)(BG + s * 136 + cl) = (unsigned)o0 | ((unsigned)o1 << 16); }
                    else { *(LAS unsigned*)(CG + s * 136 + cl) = (unsigned)o0 | ((unsigned)o1 << 16); }
                }
            }
        }
        __syncthreads();
        blk_mma<4, 4, 4>(CG, 136, BG, 136, C.wid, C.lane, [=](int r0, int col, const f32x4& acc) {
#pragma unroll
            for (int jj = 0; jj < 4; ++jj) CBm[(r0 + jj) * 68 + col] = acc[jj];
        });
        u32x4 s0r[2];
        { const bf16_t* src = MST + (size_t)slot_of(ci.b, 2 * g, 0, cpos_of(ci, 0)) * 8192;
#pragma unroll
          for (int k = 0; k < 2; ++k) { const int e = C.tid + 512 * k; s0r[k] = *(const u32x4*)(src + (e >> 4) * 128 + (e & 15) * 8); } }
        for (int hh = 0; hh < 2; ++hh) {
            MO_RELAUNDER(); fr = C.lane & 15; fq = C.lane >> 4;
            const int h = 2 * g + hh;
            f32x4 yacc[2] = {{0.f, 0.f, 0.f, 0.f}, {0.f, 0.f, 0.f, 0.f}};
            unsigned short zr[2][4];
#pragma unroll
            for (int i = 0; i < 2; ++i) { const int tt = C.wid + 8 * i, tm = tt >> 2, tn = tt & 3;
#pragma unroll
                for (int j = 0; j < 4; ++j) zr[i][j] = P[(size_t)(ci.row0 + tm * 16 + fq * 4 + j) * NP + OFF_C + h * 64 + tn * 16 + fr]; }
            for (int d = 0; d < 2; ++d) {
                const int dh = d * 4 + h;
                __syncthreads();
                for (int e = C.tid; e < 4096; e += 512) { const int l = e >> 6, s = e & 63; const bool ok = d ? (s >= l) : (s <= l);
                    MP[l * 72 + s] = ok ? f2bf(CBm[l * 68 + s] * fexp(CSI[dh * 64 + l] - CSI[dh * 64 + s]) * DT[dh * 64 + s]) : (unsigned short)0; }
#pragma unroll
                for (int k = 0; k < 2; ++k) { const int e = C.tid + 512 * k; *(LAS u32x4*)(S0 + (e >> 4) * 136 + (e & 15) * 8) = s0r[k]; }
                if (!(hh == 1 && d == 1)) { const int nh = d ? h + 1 : h, nd = d ^ 1; const bf16_t* src = MST + (size_t)slot_of(ci.b, nh, nd, cpos_of(ci, nd)) * 8192;
#pragma unroll
                    for (int k = 0; k < 2; ++k) { const int e = C.tid + 512 * k; s0r[k] = *(const u32x4*)(src + (e >> 4) * 128 + (e & 15) * 8); } }
                __syncthreads();
#pragma unroll
                for (int i = 0; i < 2; ++i) { const int tt = C.wid + 8 * i, tm = tt >> 2, tn = tt & 3;
                    f32x4 a1 = {0.f, 0.f, 0.f, 0.f}, a2 = {0.f, 0.f, 0.f, 0.f};
#pragma unroll
                    for (int ks = 0; ks < 2; ++ks) a1 = __builtin_amdgcn_mfma_f32_16x16x32_bf16(*(const LAS bf16x8*)(MP + (tm * 16 + fr) * 72 + ks * 32 + fq * 8),
                                                                                                 *(const LAS bf16x8*)(XT + (hh * 64 + tn * 16 + fr) * 72 + ks * 32 + fq * 8), a1, 0, 0, 0);
#pragma unroll
                    for (int ks = 0; ks < 4; ++ks) a2 = __builtin_amdgcn_mfma_f32_16x16x32_bf16(*(const LAS bf16x8*)(CG + (tm * 16 + fr) * 136 + ks * 32 + fq * 8),
                                                                                                 *(const LAS bf16x8*)(S0 + (tn * 16 + fr) * 136 + ks * 32 + fq * 8), a2, 0, 0, 0);
#pragma unroll
                    for (int j = 0; j < 4; ++j) yacc[i][j] += a1[j] + a2[j] * fexp(CSI[dh * 64 + tm * 16 + fq * 4 + j]);
                }
            }
            const float dsk = C.in[22][layer * 4 + h];
#pragma unroll
            for (int i = 0; i < 2; ++i) { const int tt = C.wid + 8 * i, tm = tt >> 2, tn = tt & 3;
#pragma unroll
                for (int j = 0; j < 4; ++j) { const int l = tm * 16 + fq * 4 + j, p = tn * 16 + fr, c = h * 64 + p;
                    const float xs = bf2f(XT[(hh * 64 + p) * 72 + l]);
                    const float z = bf2f(zr[i][j]);
                    const float pre = (yacc[i][j] + dsk * xs) * silu(z);
                    YPRE[l * 264 + c] = f2bf(pre);
                    float q = pre * pre; q += __shfl_xor(q, 1); q += __shfl_xor(q, 2); q += __shfl_xor(q, 4); q += __shfl_xor(q, 8);
                    if (fr == 0) SSQ[l * 16 + h * 4 + tn] = q; }
            }
        }
    }
    __syncthreads();
    {
        const int l = C.tid >> 3, sub = C.tid & 7; float ss = 0.f;
#pragma unroll
        for (int i = 0; i < 16; ++i) ss += SSQ[l * 16 + i];
        const float rs = rsqrtf(ss * (1.f / 256.f) + 1e-6f);
        const float* ng = C.in[23] + layer * 256 + sub * 32;
        bf16_t* dst = YC + (size_t)(ci.row0 + l) * DM + 512 + sub * 32;
#pragma unroll
        for (int i = 0; i < 32; i += 2) { const float a = bf2f(YPRE[l * 264 + sub * 32 + i]) * rs * ng[i], b = bf2f(YPRE[l * 264 + sub * 32 + i + 1]) * rs * ng[i + 1]; *(unsigned*)(dst + i) = pk2(a, b); }
    }
    __syncthreads();
}

constexpr int D3_G2T = 0, D3_SG = 69632, D3_VL = 87040, D3_BON = 120832;
__device__ __forceinline__ void load_g2t(const Ctx& C, int layer) {
    LAS bf16_t* G2T = (LAS bf16_t*)(C.lds + D3_G2T); const float* g2 = C.in[30] + (size_t)layer * 128 * 256;
    for (int e = C.tid; e < 128 * 256; e += 512) { const int r = e >> 8, c = e & 255; G2T[c * 136 + r] = f2bf(g2[e]); }
}
__device__ __forceinline__ float lerp_d(const bf16_t* P, const ChunkInfo& ci, int row, int j, const float* mup, const float* mun) {
    const bf16_t* pp = P + (size_t)row * NP + OFF_D + j;
    const bool okp = row - 1 >= ci.lo, okn = row + 1 < ci.hi;
    const float x = bf2f(*pp), xpv = bf2f(*(okp ? pp - NP : pp)), xnv = bf2f(*(okn ? pp + NP : pp)); const float xp = okp ? xpv : 0.f, xn = okn ? xnv : 0.f;
    return x + mup[j] * (xp - x) + mun[j] * (xn - x);
}
__device__ __forceinline__ void item_rwkv_out(const Ctx& C, int layer, int gc) {
    const ChunkInfo ci = chunk_info(gc);
    const bf16_t* P = (const bf16_t*)(C.ws + WS_P); bf16_t* YC = (bf16_t*)(C.ws + WS_ACT);
    const float* mup = C.in[24] + layer * 1152; const float* mun = C.in[25] + layer * 1152;
    LAS bf16_t* G2T = (LAS bf16_t*)(C.lds + D3_G2T); LAS bf16_t* SG = (LAS bf16_t*)(C.lds + D3_SG);
    int ln_ = C.lane; asm volatile("" : "+v"(ln_));
    const int fr = ln_ & 15, fq = ln_ >> 4;
    __syncthreads();
    for (int e = C.tid; e < 64 * 128; e += 512) { const int l = e >> 7, r = e & 127; SG[l * 136 + r] = f2bf(sigm(lerp_d(P, ci, ci.row0 + l, 1024 + r, mup, mun))); }
    LAS bf16_t* VL = (LAS bf16_t*)(C.lds + D3_VL); LAS float* BONS = (LAS float*)(C.lds + D3_BON);
    for (int e = C.tid; e < 64 * 256; e += 512) { const int l = e >> 8, c = e & 255; VL[l * 264 + c] = f2bf(lerp_d(P, ci, ci.row0 + l, 512 + c, mup, mun)); }
    if (C.tid < 256) { const int l = C.tid >> 2, hh = C.tid & 3; const float* bp = (const float*)(C.ws + WS_BON) + (size_t)(ci.row0 + l) * 8 + hh * 2; BONS[l * 4 + hh] = bp[0] + bp[1]; }
    __syncthreads();
    const int h = C.wid >> 1, tmb = (C.wid & 1) * 2;
    const bf16_t* Ryg = (const bf16_t*)(C.ws + WS_RY); const bf16_t* Ylg = (const bf16_t*)(C.ws + WS_RL); const bf16_t* Hg = (const bf16_t*)(C.ws + WS_RH);
    const float* BON = (const float*)(C.ws + WS_BON);
#pragma unroll
    for (int ti = 0; ti < 2; ++ti) {
        const int tm = tmb + ti;
        f32x4 gacc[4], yacc[4];
#pragma unroll
        for (int tn = 0; tn < 4; ++tn) { f32x4 a = {0.f, 0.f, 0.f, 0.f};
#pragma unroll
            for (int ks = 0; ks < 4; ++ks) a = __builtin_amdgcn_mfma_f32_16x16x32_bf16(*(const LAS bf16x8*)(SG + (tm * 16 + fr) * 136 + ks * 32 + fq * 8),
                                                                                        *(const LAS bf16x8*)(G2T + (h * 64 + tn * 16 + fr) * 136 + ks * 32 + fq * 8), a, 0, 0, 0);
            gacc[tn] = a; yacc[tn] = (f32x4){0.f, 0.f, 0.f, 0.f}; }
#pragma unroll
        for (int d = 0; d < 2; ++d) {
            const size_t slot = (size_t)slot_of(ci.b, h, d, cpos_of(ci, d));
            const int arow = d ? 63 - (tm * 16 + fr) : tm * 16 + fr;
            bf16x8 af[2];
#pragma unroll
            for (int ks = 0; ks < 2; ++ks) af[ks] = *(const bf16x8*)(Ryg + slot * 4096 + arow * 64 + ks * 32 + fq * 8);
#pragma unroll
            for (int tn = 0; tn < 4; ++tn) {
                f32x4 a;
                if (d == 0) { const u32x2 yl = *(const u32x2*)(Ylg + slot * 4096 + (tn * 16 + fr) * 64 + tm * 16 + fq * 4); a = (f32x4){bflo(yl.x), bfhi(yl.x), bflo(yl.y), bfhi(yl.y)}; }
                else { const u32x2 yl = *(const u32x2*)(Ylg + slot * 4096 + (tn * 16 + fr) * 64 + 60 - (tm * 16 + fq * 4)); a = (f32x4){bfhi(yl.y), bflo(yl.y), bfhi(yl.x), bflo(yl.x)}; }
#pragma unroll
                for (int ks = 0; ks < 2; ++ks) a = __builtin_amdgcn_mfma_f32_16x16x32_bf16(af[ks], *(const bf16x8*)(Hg + slot * 4096 + (tn * 16 + fr) * 64 + ks * 32 + fq * 8), a, 0, 0, 0);
                yacc[tn] += a;
            }
        }
#pragma unroll
        for (int j = 0; j < 4; ++j) {
            const int l = tm * 16 + fq * 4 + j, row = ci.row0 + l;
            float s = (yacc[0][j] + yacc[1][j]) + (yacc[2][j] + yacc[3][j]);
            s += __shfl_xor(s, 1); s += __shfl_xor(s, 2); s += __shfl_xor(s, 4); s += __shfl_xor(s, 8);
            const float mu = s * (1.f / 64.f);
            float q = 0.f;
#pragma unroll
            for (int tn = 0; tn < 4; ++tn) { const float dd = yacc[tn][j] - mu; q += dd * dd; }
            q += __shfl_xor(q, 1); q += __shfl_xor(q, 2); q += __shfl_xor(q, 4); q += __shfl_xor(q, 8);
            const float rs = rsqrtf(q * (1.f / 64.f) + 64e-5f);
            const float bon = BONS[l * 4 + h];
#pragma unroll
            for (int tn = 0; tn < 4; ++tn) { const int c = h * 64 + tn * 16 + fr;
                const float yn = (yacc[tn][j] - mu) * rs * C.in[34][layer * 256 + c] + C.in[35][layer * 256 + c];
                const float vv = bf2f(VL[l * 264 + c]);
                YC[(size_t)row * DM + 768 + c] = f2bf((yn + bon * vv) * gacc[tn][j]); }
        }
    }
}

__device__ __forceinline__ unsigned ordf(float f) { const unsigned u = __float_as_uint(f); return u ^ ((u >> 31) ? 0xFFFFFFFFu : 0x80000000u); }
__device__ __forceinline__ unsigned wave_max_u32(unsigned v) {
    unsigned t;
    t = (unsigned)__builtin_amdgcn_update_dpp((int)v, (int)v, 0xB1, 0xF, 0xF, false); v = t > v ? t : v;
    t = (unsigned)__builtin_amdgcn_update_dpp((int)v, (int)v, 0x4E, 0xF, 0xF, false); v = t > v ? t : v;
    t = (unsigned)__builtin_amdgcn_update_dpp((int)v, (int)v, 0x141, 0xF, 0xF, false); v = t > v ? t : v;
    t = (unsigned)__builtin_amdgcn_update_dpp((int)v, (int)v, 0x140, 0xF, 0xF, false); v = t > v ? t : v;
    t = (unsigned)__builtin_amdgcn_update_dpp((int)v, (int)v, 0x142, 0xA, 0xF, false); v = t > v ? t : v;
    t = (unsigned)__builtin_amdgcn_update_dpp((int)v, (int)v, 0x143, 0xC, 0xF, false); v = t > v ? t : v;
    return (unsigned)__builtin_amdgcn_readlane((int)v, 63);
}
constexpr int SEL_K1 = 0, SEL_K2 = 34816;
__device__ __forceinline__ float unordf(unsigned k) { return __uint_as_float((k & 0x80000000u) ? (k ^ 0x80000000u) : ~k); }
template <int N> __device__ __forceinline__ void bitonic_sort_desc(unsigned (&x)[N]) {
#pragma unroll
    for (int k = 2; k <= N; k <<= 1)
#pragma unroll
        for (int j = k >> 1; j > 0; j >>= 1)
#pragma unroll
            for (int i = 0; i < N; ++i) { const int l = i ^ j;
                if (l > i) { const unsigned p = x[i], q = x[l]; const unsigned hi = p > q ? p : q, lo = p > q ? q : p; if ((i & k) == 0) { x[i] = hi; x[l] = lo; } else { x[i] = lo; x[l] = hi; } } }
}
__device__ __forceinline__ void merge_top16(unsigned (&a)[16], const unsigned (&b)[16]) {
#pragma unroll
    for (int i = 0; i < 16; ++i) a[i] = a[i] > b[15 - i] ? a[i] : b[15 - i];
#pragma unroll
    for (int j = 8; j > 0; j >>= 1)
#pragma unroll
        for (int i = 0; i < 16; ++i) { const int l = i ^ j; if (l > i) { const unsigned p = a[i], q = a[l]; a[i] = p > q ? p : q; a[l] = p > q ? q : p; } }
}
__device__ __forceinline__ void ph_select(const Ctx& C, int layer, int nrows) {
    const bf16_t* Q = (const bf16_t*)(C.ws + WS_Q); int* SELI = (int*)(C.ws + WS_SELI); float* SELG = (float*)(C.ws + WS_SELG);
    LAS bf16_t* K1 = (LAS bf16_t*)(C.lds + SEL_K1); LAS bf16_t* K2 = (LAS bf16_t*)(C.lds + SEL_K2);
    {
        const float* k1 = C.in[37] + (size_t)layer * 128 * 128; const float* k2 = C.in[38] + (size_t)layer * 128 * 128;
        for (int e = C.tid; e < 4096; e += 512) { const int r = e >> 5, c4 = (e & 31) * 4; const f32x4 a = *(const f32x4*)(k1 + r * 128 + c4), b = *(const f32x4*)(k2 + r * 128 + c4);
            u32x2 oa, ob; oa.x = pk2(a.x, a.y); oa.y = pk2(a.z, a.w); ob.x = pk2(b.x, b.y); ob.y = pk2(b.z, b.w);
            *(LAS u32x2*)(K1 + r * 136 + c4) = oa; *(LAS u32x2*)(K2 + r * 136 + c4) = ob; }
    }
    __syncthreads();
    const int nunits = (nrows / 16) * 8;
    for (int u = C.bid * 8 + C.wid; u < nunits; u += C.G * 8) {
        int ln_ = C.lane; asm volatile("" : "+v"(ln_));
        const int fr = ln_ & 15, fq = ln_ >> 4;
        const int tile = u >> 3, h = u & 7, row = tile * 16 + fr;
        const bf16_t* qp = Q + (size_t)row * 2048 + h * 256 + fq * 8;
        bf16x8 qf[8];
#pragma unroll
        for (int i = 0; i < 8; ++i) qf[i] = *(const bf16x8*)(qp + i * 32);
        unsigned T[2][16];
#pragma unroll
        for (int half = 0; half < 2; ++half) {
            const LAS bf16_t* K = half ? K2 : K1;
            unsigned lo16[16], hi16[16];
#pragma unroll
            for (int kt = 0; kt < 8; ++kt) {
                f32x4 acc = {0.f, 0.f, 0.f, 0.f};
#pragma unroll
                for (int ks = 0; ks < 4; ++ks) acc = __builtin_amdgcn_mfma_f32_16x16x32_bf16(*(const LAS bf16x8*)(K + (kt * 16 + fr) * 136 + ks * 32 + fq * 8), qf[half * 4 + ks], acc, 0, 0, 0);
#pragma unroll
                for (int j = 0; j < 4; ++j) { const unsigned key = (ordf(acc[j]) & ~0x7Fu) | (unsigned)(127 - (kt * 16 + fq * 4 + j));
                    if (kt < 4) lo16[kt * 4 + j] = key; else hi16[(kt - 4) * 4 + j] = key; }
            }
            bitonic_sort_desc<16>(lo16); bitonic_sort_desc<16>(hi16); merge_top16(lo16, hi16);
#pragma unroll
            for (int rnd = 16; rnd <= 32; rnd <<= 1) { unsigned o[16];
#pragma unroll
                for (int i = 0; i < 16; ++i) o[i] = (unsigned)__shfl_xor((int)lo16[i], rnd);
                merge_top16(lo16, o); }
#pragma unroll
            for (int i = 0; i < 16; ++i) T[half][i] = lo16[i];
        }
        unsigned ck[50]; unsigned R0[16];
        {
            int id = 0;
#pragma unroll
            for (int a = 0; a < 16; ++a) {
                const float va = unordf(T[0][a] & ~0x7Fu);
#pragma unroll
                for (int b = 0; b < 16; ++b) if ((a + 1) * (b + 1) <= 16) { ck[id] = (ordf(va + unordf(T[1][b] & ~0x7Fu)) & ~0x3Fu) | (unsigned)(63 - id); ++id; }
            }
        }
#pragma unroll
        for (int i = 0; i < 16; ++i) R0[i] = ck[i];
        {
            int base = 16;
#pragma unroll
            for (int a = 1; a < 8; ++a) { const int n = 16 / (a + 1); unsigned rw[16];
#pragma unroll
                for (int i = 0; i < 16; ++i) rw[i] = i < n ? ck[base + i] : 0u;
                merge_top16(R0, rw); base += n; }
            unsigned rw[16];
#pragma unroll
            for (int i = 0; i < 16; ++i) rw[i] = i < 8 ? ck[base + i] : 0u;
            merge_top16(R0, rw);
        }
        const unsigned thr = R0[15]; const float mx = unordf(R0[0] & ~0x3Fu);
        float sum = 0.f;
#pragma unroll
        for (int c = 0; c < 50; ++c) sum += ck[c] >= thr ? __expf(unordf(ck[c] & ~0x3Fu) - mx) : 0.f;
        const float rsum = 1.f / sum;
        int* oi = SELI + ((size_t)row * 8 + h) * 16; float* og = SELG + ((size_t)row * 8 + h) * 16;
        {
            int id = 0, cnt = 0;
#pragma unroll
            for (int a = 0; a < 16; ++a)
#pragma unroll
                for (int b = 0; b < 16; ++b) if ((a + 1) * (b + 1) <= 16) {
                    if (ck[id] >= thr) { if (fq == 0 && cnt < 16) { oi[cnt] = (127 - (int)(T[0][a] & 0x7Fu)) * 128 + (127 - (int)(T[1][b] & 0x7Fu)); og[cnt] = __expf(unordf(ck[id] & ~0x3Fu) - mx) * rsum; } ++cnt; }
                    ++id; }
        }
    }
}

struct R16 { float v[16]; };
__device__ __forceinline__ R16 load_r16_f32(const float* p, int lane) { R16 r;
#pragma unroll
    for (int k = 0; k < 4; ++k) { const f32x4 a = *(const f32x4*)(p + 16 * lane + 4 * k); r.v[4 * k] = a.x; r.v[4 * k + 1] = a.y; r.v[4 * k + 2] = a.z; r.v[4 * k + 3] = a.w; }
    return r; }
__device__ __forceinline__ void store_r16_f32(float* p, int lane, const R16& r) {
#pragma unroll
    for (int k = 0; k < 4; ++k) *(f32x4*)(p + 16 * lane + 4 * k) = (f32x4){r.v[4 * k], r.v[4 * k + 1], r.v[4 * k + 2], r.v[4 * k + 3]}; }
__device__ __forceinline__ R16 load_r16_bf16(const bf16_t* p, int lane) { R16 r;
#pragma unroll
    for (int k = 0; k < 2; ++k) { const u32x4 a = *(const u32x4*)(p + 16 * lane + 8 * k);
        r.v[8 * k] = bflo(a.x); r.v[8 * k + 1] = bfhi(a.x); r.v[8 * k + 2] = bflo(a.y); r.v[8 * k + 3] = bfhi(a.y); r.v[8 * k + 4] = bflo(a.z); r.v[8 * k + 5] = bfhi(a.z); r.v[8 * k + 6] = bflo(a.w); r.v[8 * k + 7] = bfhi(a.w); }
    return r; }
__device__ __forceinline__ void store_r16_bf16(bf16_t* p, int lane, const R16& r) {
#pragma unroll
    for (int k = 0; k < 2; ++k) { u32x4 a; a.x = pk2(r.v[8 * k], r.v[8 * k + 1]); a.y = pk2(r.v[8 * k + 2], r.v[8 * k + 3]); a.z = pk2(r.v[8 * k + 4], r.v[8 * k + 5]); a.w = pk2(r.v[8 * k + 6], r.v[8 * k + 7]);
        *(u32x4*)(p + 16 * lane + 8 * k) = a; } }
typedef float f32x2p __attribute__((ext_vector_type(2)));
struct PeerHdr { int idx0, idx1; float su0, su1, gsv0, gsv1; };
__device__ __forceinline__ void ph_peer(const Ctx& C, int layer, int nrows, bool last, bool store = true, int idmask = 0x3FFF) {
    const bf16_t* F = (const bf16_t*)(C.ws + WS_ACT); bf16_t* XN = (bf16_t*)(C.ws + WS_ACT);
    const unsigned char* UB = C.ws + WS_UB; const unsigned char* VB = C.ws + WS_VB; const float* SU = (const float*)(C.ws + WS_SU); const float* SV = (const float*)(C.ws + WS_SV);
    const int* SELI = (const int*)(C.ws + WS_SELI); const float* SELG = (const float*)(C.ws + WS_SELG);
    float* H = (float*)(C.ws + WS_H); const float* MOD = (const float*)(C.ws + WS_MOD);
    const int step = C.G * 8;
    auto load_hdr = [&](int tok, int L) { PeerHdr h; h.idx0 = SELI[(size_t)tok * 128 + L] & idmask; h.idx1 = SELI[(size_t)tok * 128 + 64 + L] & idmask;
        h.su0 = SU[h.idx0]; h.su1 = SU[h.idx1]; h.gsv0 = SELG[(size_t)tok * 128 + L] * SV[h.idx0]; h.gsv1 = SELG[(size_t)tok * 128 + 64 + L] * SV[h.idx1]; return h; };
    int tok = C.bid * 8 + C.wid;
    for (; tok < nrows; tok += step) {
        int L = C.lane; asm volatile("" : "+v"(L));
        const int myexp = ((L >> 5) & 1) * 4 + ((L >> 4) & 1) * 2 + ((L >> 3) & 1);
        const PeerHdr hd = load_hdr(tok, L);
        const u32x4 fpa = *(const u32x4*)(F + (size_t)tok * DM + 16 * L), fpb = *(const u32x4*)(F + (size_t)tok * DM + 16 * L + 8);
        f32x2p out[8];
#pragma unroll
        for (int i = 0; i < 8; ++i) out[i] = (f32x2p){0.f, 0.f};
        u32x4 ua[2][8], va[2][8];
#define PEER_LOAD(buf, bt) do { const int src_ = (bt) < 8 ? hd.idx0 : hd.idx1; const int l0_ = ((bt) & 7) * 8; _Pragma("unroll") for (int i = 0; i < 8; ++i) { const int ei = __builtin_amdgcn_readlane(src_, l0_ + i); \
            ua[buf][i] = *(const u32x4*)(UB + (size_t)ei * DM + 16 * L); va[buf][i] = *(const u32x4*)(VB + (size_t)ei * DM + 16 * L); } } while (0)
#define PEER_COMPUTE(buf, bt) do { const float susrc = (bt) < 8 ? hd.su0 : hd.su1, gsrc = (bt) < 8 ? hd.gsv0 : hd.gsv1; const int l0 = ((bt) & 7) * 8; float part[8]; \
            _Pragma("unroll") for (int i = 0; i < 8; ++i) { f32x2p acc = {0.f, 0.f}; _Pragma("unroll") for (int k = 0; k < 4; ++k) { \
                const f32x2p lo = __builtin_amdgcn_cvt_pk_f32_fp8((int)ua[buf][i][k], false), hi = __builtin_amdgcn_cvt_pk_f32_fp8((int)ua[buf][i][k], true); \
                const unsigned fw0 = (k < 2 ? fpa : fpb)[(2 * k) & 3], fw1 = (k < 2 ? fpa : fpb)[(2 * k + 1) & 3]; \
                acc += lo * (f32x2p){bflo(fw0), bfhi(fw0)}; acc += hi * (f32x2p){bflo(fw1), bfhi(fw1)}; } part[i] = acc.x + acc.y; } \
            float p4[4], p2[2], p1; \
            { const bool hi = (L & 32) != 0; _Pragma("unroll") for (int i = 0; i < 4; ++i) { const float send = hi ? part[i] : part[i + 4]; const float recv = __shfl_xor(send, 32); p4[i] = (hi ? part[i + 4] : part[i]) + recv; } } \
            { const bool hi = (L & 16) != 0; _Pragma("unroll") for (int i = 0; i < 2; ++i) { const float send = hi ? p4[i] : p4[i + 2]; const float recv = __shfl_xor(send, 16); p2[i] = (hi ? p4[i + 2] : p4[i]) + recv; } } \
            { const bool hi = (L & 8) != 0; const float send = hi ? p2[0] : p2[1]; const float recv = __shfl_xor(send, 8); p1 = (hi ? p2[1] : p2[0]) + recv; } \
            p1 += __shfl_xor(p1, 4); p1 += __shfl_xor(p1, 2); p1 += __shfl_xor(p1, 1); \
            const float act = gelu_tanh(p1 * __shfl(susrc, l0 + myexp)) * __shfl(gsrc, l0 + myexp); \
            _Pragma("unroll") for (int i = 0; i < 8; ++i) { \
                const float a = __uint_as_float((unsigned)__builtin_amdgcn_readlane((int)__float_as_uint(act), ((i >> 2) & 1) * 32 + ((i >> 1) & 1) * 16 + (i & 1) * 8)); const f32x2p a2 = {a, a}; \
                _Pragma("unroll") for (int k = 0; k < 4; ++k) { out[2 * k] += a2 * __builtin_amdgcn_cvt_pk_f32_fp8((int)va[buf][i][k], false); out[2 * k + 1] += a2 * __builtin_amdgcn_cvt_pk_f32_fp8((int)va[buf][i][k], true); } } } while (0)
        PEER_LOAD(0, 0);
        for (int bt = 0; bt < 16; bt += 2) {
            PEER_LOAD(1, bt + 1);
            PEER_COMPUTE(0, bt);
            if (bt + 2 < 16) PEER_LOAD(0, bt + 2);
            PEER_COMPUTE(1, bt + 1);
        }
#undef PEER_LOAD
#undef PEER_COMPUTE
        const float* m = MOD + ((size_t)layer * 3 + which_of(tok)) * 6144;
        R16 hr = load_r16_f32(H + (size_t)tok * DM, L); const R16 g5 = load_r16_f32(m + 5 * 1024, L);
#pragma unroll
        for (int i = 0; i < 8; ++i) { hr.v[2 * i] += g5.v[2 * i] * out[i].x; hr.v[2 * i + 1] += g5.v[2 * i + 1] * out[i].y; }
        float ss = 0.f;
#pragma unroll
        for (int i = 0; i < 16; ++i) ss += hr.v[i] * hr.v[i];
        const float rs = rsqrtf(wave_sum(ss) * (1.f / 1024.f) + 1e-6f);
        if (!store) continue;
        if (!last) {
            store_r16_f32(H + (size_t)tok * DM, L, hr);
            const float* m2 = MOD + ((size_t)(layer + 1) * 3 + which_of(tok)) * 6144;
            const R16 gg = load_r16_f32(C.in[6] + (layer + 1) * 1024, L), sh = load_r16_f32(m2, L), sc = load_r16_f32(m2 + 1024, L); R16 o;
#pragma unroll
            for (int i = 0; i < 16; ++i) o.v[i] = (hr.v[i] * rs * gg.v[i]) * (1.f + sc.v[i]) + sh.v[i];
            store_r16_bf16(XN + (size_t)tok * DM, L, o);
        } else {
            const R16 fg = load_r16_f32(C.in[41], L); R16 o;
#pragma unroll
            for (int i = 0; i < 16; ++i) o.v[i] = hr.v[i] * rs * fg.v[i];
            store_r16_f32(C.out + (size_t)tok * DM, L, o);
        }
    }
}

#define PM(n) ((MASK >> (n)) & 1u)
constexpr int NPH_LAYER = 9, NPH = 2 + 2 * NPH_LAYER;
template <unsigned MASK> __global__ void __launch_bounds__(512, 2) hybrid_fwd(Args args) {
    extern __shared__ __attribute__((aligned(16))) unsigned char lds_raw[];
    Ctx C0; C0.in = args.in; C0.out = args.out; C0.ws = args.ws; C0.lds = (lds_t)lds_raw;
    C0.wid = __builtin_amdgcn_readfirstlane((int)threadIdx.x >> 6); C0.tid = 0; C0.lane = 0; C0.bid = blockIdx.x; C0.G = gridDim.x;
#define MK_LANE() ((int)__builtin_amdgcn_mbcnt_hi(~0u, __builtin_amdgcn_mbcnt_lo(~0u, 0u)))
#define MK_TID() (C0.wid * 64 + MK_LANE())
    const Ctx& C = C0;
    const int lo = args.ph_lo, hi = args.ph_hi;
    const bool multi = (hi - lo) > 1;
    XcdBarrier bar; bar.w0 = (unsigned)C0.wid; bar.bar = (unsigned*)(C.ws + WS_CTL); bar.x = 0; bar.st = (volatile LAS unsigned*)(C.lds + LDS_XB);
    if (multi) {
        if (C0.wid == 0 && MK_LANE() == 0) *(LAS u32x4*)(C.lds + LDS_XB) = (u32x4){0u, 0u, 0u, 0u};
        __syncthreads();
        bar = xcd_barrier_post((unsigned*)(C.ws + WS_CTL), (volatile LAS unsigned*)(C.lds + LDS_XB), (unsigned)C0.wid);
    }
#define IN(k) (lo <= (k) && (k) < hi)
#define PHASE_CTX(c) Ctx c = C0; { int t_ = MK_TID(); asm volatile("" : "+v"(t_)); c.tid = t_; c.lane = t_ & 63; c.wid = __builtin_amdgcn_readfirstlane(t_ >> 6); }
#ifndef MK_REPEAT
#define MK_REPEAT 0u
#endif
#define RP(k) ((MK_REPEAT >> (k)) & 1u)
#define STAMP(k) do {} while (0)
#define SEAM(k) do { if (IN(k) && IN((k) + 1)) xcd_barrier(bar); STAMP((k) + 1); } while (0)
    STAMP(0);
    if (RP(10)) { for (int i = 0; i < 20; ++i) xcd_barrier(bar); }
    if (PM(0) && IN(0)) { PHASE_CTX(c); ph_prologue(c); if (RP(9)) { xcd_barrier(bar); ph_prologue(c); } } SEAM(0);
    if (PM(1) && IN(1)) { PHASE_CTX(c); ph_norm(c, 0, c.in[6], 0, NROW); } SEAM(1);
    for (int layer = 0; layer < 2; ++layer) {
        const int base = 2 + layer * NPH_LAYER;
        const bool emit = (layer == 0);
        const int nrows = emit ? NROW : NLAT;
        if (PM(2) && IN(base + 0)) {
            pg8::Gemm g{(const bf16_t*)(C.ws + WS_ACT), (const bf16_t*)(C.ws + WS_WIN) + (size_t)layer * NP * DM, NROW, NP, DM};
            pg8::StaticOrder S; S.init(NROW, NP, C.G, C.bid);
            pg8::EpiBf16<0> E{(bf16_t*)(C.ws + WS_P), NP, nullptr, 0, 0};
            pg8::gemm_phase<pg8::EpiBf16<0>, pg8::StaticOrder, false>(C.lds, g, S, E, nullptr, MK_TID());
            if (RP(0)) { xcd_barrier(bar); pg8::gemm_phase<pg8::EpiBf16<0>, pg8::StaticOrder, false>(C.lds, g, S, E, nullptr, MK_TID()); }
            { const int nfull = (NROW / 256) * (NP / 256) - ((NROW / 256) * (NP / 256) / C.G) * C.G; PHASE_CTX(c); if (c.bid >= nfull) convert_tables(c, layer, c.bid - nfull, c.G - nfull); }
        }
        SEAM(base + 0);
        if (PM(3) && IN(base + 1)) {
            const int nD = 2112, nC = 264, nB = emit ? 132 : 128, nA = emit ? 264 : 256, tot = nD + nC + nB + nA;
            for (int rep = 0; rep < (RP(1) ? 2 : 1); ++rep) {
            if (rep) xcd_barrier(bar);
#define MK_QUEUE(TYPE_IDX, COUNT, FIRST, CALL) { unsigned* ctr = (unsigned*)(c.ws + 49152) + 64 * ((layer * 2 + rep) * 4 + (TYPE_IDX)); LAS int* nxt = (LAS int*)(c.lds + LDS_XB + 32); \
                for (int it = (FIRST); it < (COUNT); ) { CALL; __syncthreads(); if (c.tid == 0) *nxt = (int)c.G + (int)__hip_atomic_fetch_add(ctr, 1u, __ATOMIC_RELAXED, __HIP_MEMORY_SCOPE_AGENT); __syncthreads(); it = *nxt; } }
            if (PM(12)) { PHASE_CTX(c); MK_QUEUE(1, nC, c.bid, { item_mamba_local(c, layer, it); if (RP(13)) item_mamba_local(c, layer, it); }) }
            if (PM(13)) { PHASE_CTX(c); MK_QUEUE(2, nB, c.bid, { item_chunkmlp(c, layer, it); if (RP(14)) item_chunkmlp(c, layer, it); }) }
            if (PM(14)) { PHASE_CTX(c); MK_QUEUE(3, nA, c.bid, { item_conformer(c, layer, it); if (RP(15)) item_conformer(c, layer, it); }) }
            if (PM(11)) { PHASE_CTX(c); D1Pre pre; pre.hd = -1; MK_QUEUE(0, nD, c.bid, item_rwkv_local(c, layer, it, pre, -1)) }
#undef MK_QUEUE
            }
        }
        SEAM(base + 1);
        if (PM(4) && IN(base + 2)) { PHASE_CTX(c); if (RP(12)) { ph_scan(c, 1, args.ph_hi > 1000, false); xcd_barrier(bar); } ph_scan(c, RP(2) ? 2 : 1); }
        SEAM(base + 2);
        if (PM(5) && IN(base + 3)) {
            const int nc = nrows / 64;
            for (int rep = 0; rep < (RP(3) ? 2 : 1); ++rep) {
            if (rep) xcd_barrier(bar);
            if (PM(15)) { PHASE_CTX(c); load_g2t(c, layer); for (int it = c.bid; it < nc; it += c.G) item_rwkv_out(c, layer, it); }
            __syncthreads();
            if (PM(16)) { PHASE_CTX(c); for (int it = (c.bid + 128) % c.G; it < nc; it += c.G) item_mamba_out(c, layer, it); }
            __syncthreads();
            }
        }
        SEAM(base + 3);
        if (PM(6) && IN(base + 4)) {
            pg8::Gemm g{(const bf16_t*)(C.ws + WS_ACT), (const bf16_t*)(C.ws + WS_WOUT) + (size_t)layer * DM * DM, NLAT, DM, DM};
            pg8::StaticOrder S; S.init(NLAT, DM, C.G, C.bid);
            EpiResid E{(float*)(C.ws + WS_H), (const float*)(C.ws + WS_MOD) + (size_t)layer * 3 * 6144};
            pg8::gemm_phase<EpiResid, pg8::StaticOrder, false>(C.lds, g, S, E, nullptr, MK_TID());
            if (emit) {
                PHASE_CTX(c);
                for (int u = c.bid; u < 256; u += c.G) { const int tr = u >> 4, tc = u & 15;
                    float* Hc = (float*)(c.ws + WS_H) + (size_t)(NLAT + tr * 32) * DM + tc * 64;
                    const float* gate = (const float*)(c.ws + WS_MOD) + ((size_t)layer * 3 + 2) * 6144 + 2 * 1024 + tc * 64;
                    small_gemm_tile<2, 4>(c, (const bf16_t*)(c.ws + WS_ACT) + (size_t)(NLAT + tr * 32) * DM, (const bf16_t*)(c.ws + WS_WOUT) + (size_t)layer * DM * DM + (size_t)(tc * 64) * DM, DM,
                        [=](int r, int cc, const f32x4& acc) {
#pragma unroll
                            for (int j = 0; j < 4; ++j) Hc[(size_t)(r + j) * DM + cc] += gate[cc] * acc[j]; });
                }
            }
        }
        SEAM(base + 4);
        if (PM(7) && IN(base + 5)) { PHASE_CTX(c); for (int rep = 0; rep < (RP(5) ? 2 : 1); ++rep) { if (rep) xcd_barrier(bar); ph_norm(c, layer, c.in[7] + layer * 1024, 3, nrows); } }
        SEAM(base + 5);
        if (PM(8) && IN(base + 6)) {
            pg8::Gemm g{(const bf16_t*)(C.ws + WS_ACT), (const bf16_t*)(C.ws + WS_WQ) + (size_t)layer * 2048 * DM, NLAT, 2048, DM};
            pg8::StaticOrder S; S.init(NLAT, 2048, C.G, C.bid);
            pg8::EpiBf16<0> E{(bf16_t*)(C.ws + WS_Q), 2048, nullptr, 0, 0};
            pg8::gemm_phase<pg8::EpiBf16<0>, pg8::StaticOrder, false>(C.lds, g, S, E, nullptr, MK_TID());
            if (RP(6)) { xcd_barrier(bar); pg8::gemm_phase<pg8::EpiBf16<0>, pg8::StaticOrder, false>(C.lds, g, S, E, nullptr, MK_TID()); }
            if (emit) {
                PHASE_CTX(c);
                for (int u = c.bid; u < 256; u += c.G) { const int tr = u >> 5, tc = u & 31;
                    bf16_t* Qc = (bf16_t*)(c.ws + WS_Q) + (size_t)(NLAT + tr * 64) * 2048 + tc * 64;
                    small_gemm_tile<4, 4>(c, (const bf16_t*)(c.ws + WS_ACT) + (size_t)(NLAT + tr * 64) * DM, (const bf16_t*)(c.ws + WS_WQ) + (size_t)layer * 2048 * DM + (size_t)(tc * 64) * DM, DM,
                        [=](int r, int cc, const f32x4& acc) {
#pragma unroll
                            for (int j = 0; j < 4; ++j) Qc[(size_t)(r + j) * 2048 + cc] = f2bf(acc[j]); });
                }
            }
        }
        SEAM(base + 6);
        if (PM(9) && IN(base + 7)) { PHASE_CTX(c); ph_select(c, layer, nrows); if (RP(7)) { xcd_barrier(bar); ph_select(c, layer, nrows); } }
        SEAM(base + 7);
        if (PM(10) && IN(base + 8)) { PHASE_CTX(c); if (RP(8)) { ph_peer(c, layer, nrows, layer == 1, args.ph_hi > 1000); xcd_barrier(bar); } if (RP(11)) { ph_peer(c, layer, nrows, layer == 1, args.ph_hi > 1000, 1023); xcd_barrier(bar); } ph_peer(c, layer, nrows, layer == 1); }
        SEAM(base + 8);
    }
#undef IN
#undef SEAM
}
}


namespace mk {
struct LaunchEnt { unsigned mask; int ph; };
template <unsigned MASK> static bool prep_kernel() {
    return hipFuncSetAttribute((const void*)hybrid_fwd<MASK>, hipFuncAttributeMaxDynamicSharedMemorySize, LDS_BYTES) == hipSuccess;
}
template <unsigned MASK> static void launch_kernel(int grid, hipStream_t stream, const Args& a) {
    hipLaunchKernelGGL(hybrid_fwd<MASK>, dim3(grid), dim3(512), LDS_BYTES, stream, a);
}
}

#define CENSUS(off, n, kind, stage, lim) do {} while (0)
#ifndef MK_ONE_LAUNCH
#define MK_ONE_LAUNCH 1
#endif
extern "C" void kernel_launch(void* const* d_in, const int* in_sizes, int n_in, void* d_out, int out_size, void* d_ws, size_t ws_size, hipStream_t stream) {
    using namespace mk;
    static int grid = 0;
    if (grid == 0) {
        if (n_in != 42 || ws_size < WS_END) { fprintf(stderr, "kernel_launch: need 42 inputs and %zu bytes of workspace (got %d, %zu)\n", (size_t)WS_END, n_in, ws_size); grid = -1; return; }
        int dev = 0, cus = 0;
        if (hipGetDevice(&dev) != hipSuccess || hipDeviceGetAttribute(&cus, hipDeviceAttributeMultiprocessorCount, dev) != hipSuccess) { grid = -1; return; }
        bool ok = true;
#if MK_ONE_LAUNCH
        ok = ok && prep_kernel<0x1FFFFu>();
#else
        ok = ok && prep_kernel<0x0001u>() && prep_kernel<0x0002u>() && prep_kernel<0x0004u>() && prep_kernel<0x0808u>() && prep_kernel<0x1008u>() && prep_kernel<0x2008u>() && prep_kernel<0x4008u>()
                && prep_kernel<0x0010u>() && prep_kernel<0x8020u>() && prep_kernel<0x10020u>() && prep_kernel<0x0040u>() && prep_kernel<0x0080u>() && prep_kernel<0x0100u>() && prep_kernel<0x0200u>() && prep_kernel<0x0400u>();
#endif
        if (!ok) { fprintf(stderr, "kernel_launch: hipFuncSetAttribute failed\n"); grid = -1; return; }
        (void)hipGetLastError();
        grid = cus;
    }
    if (grid < 0) return;
    (void)hipMemsetAsync((char*)d_ws + WS_CTL, 0, 65536, stream);
    Args a{};
    for (int i = 0; i < 42; ++i) a.in[i] = (const float*)d_in[i];
    a.out = (float*)d_out; a.ws = (unsigned char*)d_ws;
#if MK_ONE_LAUNCH
    a.ph_lo = 0; a.ph_hi = NPH; launch_kernel<0x1FFFFu>(grid, stream, a);
#else
    a.ph_lo = 0; a.ph_hi = 1; launch_kernel<0x0001u>(grid, stream, a);
    CENSUS(WS_H, (size_t)NROW * DM, 0, 1, 1e4f); CENSUS(WS_MOD, 2 * 3 * 6144, 0, 1, 1e4f); CENSUS(WS_WIN, 2ull * NP * DM, 1, 1, 1e4f); CENSUS(WS_UB, 2ull * NEXP * DM, 1, 1, 1e4f);
    a.ph_lo = 1; a.ph_hi = 2; launch_kernel<0x0002u>(grid, stream, a);
    CENSUS(WS_ACT, (size_t)NROW * DM, 1, 2, 1e4f);
    for (int layer = 0; layer < 2; ++layer) {
        const int b = 2 + layer * NPH_LAYER;
        const int so = layer ? 100 : 0; (void)so;
        a.ph_lo = b + 0; a.ph_hi = b + 1; launch_kernel<0x0004u>(grid, stream, a);
        if (!layer) CENSUS(WS_P, (size_t)NROW * NP, 1, 3, 1e4f);
        a.ph_lo = b + 1; a.ph_hi = b + 2; launch_kernel<0x0808u>(grid, stream, a);
        if (!layer) { CENSUS(WS_RG, (size_t)NSLOT * 4096, 1, 4, 1e6f); CENSUS(WS_RJ, (size_t)NSLOT * 4096, 0, 5, 1e6f); CENSUS(WS_RY, (size_t)NSLOT * 4096 * 2, 1, 6, 1e6f); CENSUS(WS_BON, (size_t)NROW * 8, 0, 6, 1e6f); }
        launch_kernel<0x1008u>(grid, stream, a);
        if (!layer) { CENSUS(WS_MST, (size_t)NSLOT * 8192, 0, 7, 1e6f); CENSUS(WS_MCD, NSLOT, 0, 7, 1e6f); }
        launch_kernel<0x2008u>(grid, stream, a); launch_kernel<0x4008u>(grid, stream, a);
        a.ph_lo = b + 2; a.ph_hi = b + 3; launch_kernel<0x0010u>(grid, stream, a);
        if (!layer) { CENSUS(WS_MST, (size_t)NSLOT * 8192, 0, 8, 1e6f); CENSUS(WS_RH, (size_t)NSLOT * 4096, 1, 9, 1e6f); }
        a.ph_lo = b + 3; a.ph_hi = b + 4; launch_kernel<0x8020u>(grid, stream, a); launch_kernel<0x10020u>(grid, stream, a);
        if (!layer) CENSUS(WS_ACT, (size_t)NROW * DM, 1, 10, 1e4f);
        a.ph_lo = b + 4; a.ph_hi = b + 5; launch_kernel<0x0040u>(grid, stream, a);
        if (!layer) CENSUS(WS_H, (size_t)NROW * DM, 0, 11, 1e4f);
        a.ph_lo = b + 5; a.ph_hi = b + 6; launch_kernel<0x0080u>(grid, stream, a);
        a.ph_lo = b + 6; a.ph_hi = b + 7; launch_kernel<0x0100u>(grid, stream, a);
        if (!layer) CENSUS(WS_Q, (size_t)NROW * 2048, 1, 12, 1e4f);
        a.ph_lo = b + 7; a.ph_hi = b + 8; launch_kernel<0x0200u>(grid, stream, a);
        if (!layer) { CENSUS(WS_SELI, (size_t)NROW * 128, 2, 13, 0.f); CENSUS(WS_SELG, (size_t)NROW * 128, 0, 13, 2.f); }
        a.ph_lo = b + 8; a.ph_hi = b + 9; launch_kernel<0x0400u>(grid, stream, a);
        if (!layer) { CENSUS(WS_H, (size_t)NROW * DM, 0, 14, 1e4f); CENSUS(WS_ACT, (size_t)NROW * DM, 1, 15, 1e4f); }
    }
#endif
    (void)in_sizes; (void)out_size;
}
```
